# Optimizing an MI355X kernel written in HIP

```python
import math
import jax
import jax.numpy as jnp
from jax import lax
import numpy as np

D_MODEL = 1024
BATCH = 8
SEQ = 4096
DEPTH = 4

CTX_LEN = 256
GRID_W = 64
N_MIXERS = 3
N_ATTN = (DEPTH + 2) // N_MIXERS
N_FNET = (DEPTH + 1) // N_MIXERS
N_RWKV = DEPTH // N_MIXERS
NORM_EPS = 1e-6

DA_HEADS = 8
DA_HEAD_DIM = D_MODEL // DA_HEADS // 2
Q_BLOCK = 128
ROPE_BASE = 10000.0
SUBLN_EPS = 1e-5

FN_GROUPS = 8
FN_GROUP_DIM = D_MODEL // FN_GROUPS

RW_HEAD_DIM = 64
RW_HEADS = D_MODEL // RW_HEAD_DIM
RW_DECAY_RANK = 64
RW_ICLR_RANK = 64
RW_GN_EPS = 64e-5

kernel_name = 'hybrid_diffattn_fnet_rwkv7_dit'


def rms_norm(x, gain, eps=NORM_EPS):
    xf = x.astype(jnp.float32)
    y = xf * lax.rsqrt(jnp.mean(xf * xf, axis=-1, keepdims=True) + eps)
    return (y * gain.astype(jnp.float32)).astype(x.dtype)


def ada_modulation(cond, w, b):
    m = jax.nn.silu(cond) @ w + b
    return jnp.split(m, 3, axis=-1)


def axial_rope_tables(n):
    rows = n // GRID_W
    row = jnp.repeat(jnp.arange(rows), GRID_W).astype(jnp.float32)
    col = jnp.tile(jnp.arange(GRID_W), rows).astype(jnp.float32)
    axis_dim = DA_HEAD_DIM // 2
    inv_freq = ROPE_BASE ** (-jnp.arange(0, axis_dim, 2, dtype=jnp.float32) / axis_dim)
    ang = jnp.stack([row[:, None] * inv_freq, col[:, None] * inv_freq], axis=1)
    return jnp.cos(ang), jnp.sin(ang)


def apply_axial_rope(t, cos, sin):
    quarter = DA_HEAD_DIM // 4
    tf = t.astype(jnp.float32).reshape(t.shape[:-1] + (2, 2, quarter))
    t1, t2 = tf[..., 0, :], tf[..., 1, :]
    c = cos[:, None, None]
    s = sin[:, None, None]
    out = jnp.stack([t1 * c - t2 * s, t2 * c + t1 * s], axis=-2)
    return out.reshape(t.shape).astype(t.dtype)


def diff_attend(q, k, v, lam):
    s = jnp.einsum('bqhzd,bkhzd->bhzqk', q, k).astype(jnp.float32)
    p = jax.nn.softmax(s, axis=-1)
    a = p[:, :, 0] - lam * p[:, :, 1]
    return jnp.einsum('bhqk,bkhe->bqhe', a.astype(v.dtype), v)


def diff_attention(h_lat, h_ctx, cos, sin, w_in, lam_q, lam_k, subln_gain, w_out, lambda_init, need_ctx_out):
    B, N, D = h_lat.shape
    H, d = DA_HEADS, DA_HEAD_DIM
    scale = d ** -0.5

    def project(h):
        L = h.shape[1]
        q, k, v, z = jnp.split(h @ w_in, 4, axis=-1)
        return (q.reshape(B, L, H, 2, d) * scale, k.reshape(B, L, H, 2, d),
                v.reshape(B, L, H, 2 * d), z)

    q_l, k_l, v_l, z_l = project(h_lat)
    q_c, k_c, v_c, z_c = project(h_ctx)
    q_l = apply_axial_rope(q_l, cos, sin)
    k_l = apply_axial_rope(k_l, cos, sin)
    lq = lam_q.astype(jnp.float32)
    lk = lam_k.astype(jnp.float32)
    lam = jnp.exp(jnp.sum(lq[0] * lk[0])) - jnp.exp(jnp.sum(lq[1] * lk[1])) + lambda_init

    def finish(o, z):
        L = o.shape[1]
        of = o.astype(jnp.float32)
        of = of * lax.rsqrt(jnp.mean(of * of, axis=-1, keepdims=True) + SUBLN_EPS)
        of = of * subln_gain.astype(jnp.float32) * (1.0 - lambda_init)
        return (of.reshape(B, L, D).astype(z.dtype) * jax.nn.silu(z)) @ w_out

    k_all = jnp.concatenate([k_c, k_l], axis=1)
    v_all = jnp.concatenate([v_c, v_l], axis=1)
    n_blocks = N // Q_BLOCK
    q_blocks = q_l.reshape(B, n_blocks, Q_BLOCK, H, 2, d).swapaxes(0, 1)
    o_l = lax.map(lambda qb: diff_attend(qb, k_all, v_all, lam), q_blocks)
    o_l = o_l.swapaxes(0, 1).reshape(B, N, H, 2 * d)
    y_l = finish(o_l, z_l)
    y_c = finish(diff_attend(q_c, k_c, v_c, lam), z_c) if need_ctx_out else None
    return y_l, y_c


def fourier_mix(h, w_in, w_group, w_out):
    B, L, D = h.shape
    u, z = jnp.split(h @ w_in, 2, axis=-1)
    ug = u.astype(jnp.float32).reshape(B, L, FN_GROUPS, FN_GROUP_DIM)
    f = jnp.fft.fftn(ug, axes=(1, 3), norm='ortho').real.astype(h.dtype)
    y = jnp.einsum('blgc,gce->blge', f, w_group).reshape(B, L, D)
    return (y * jax.nn.silu(z)) @ w_out


def centred_shift(s):
    sp = jnp.pad(s, ((0, 0), (1, 1), (0, 0)))
    return 0.5 * (sp[:, :-2] + sp[:, 2:])


def rwkv7_features(h, w_in, mu, w0, w_up, a0, a_up, k_k, k_a):
    B, L, D = h.shape
    p = h @ w_in
    s, z = p[..., :-D], p[..., -D:]
    s = s + mu * (centred_shift(s) - s)
    r, k, v = s[..., :D], s[..., D:2 * D], s[..., 2 * D:3 * D]
    wd = s[..., 3 * D:3 * D + 2 * RW_DECAY_RANK].reshape(B, L, 2, RW_DECAY_RANK)
    ad = s[..., 3 * D + 2 * RW_DECAY_RANK:].reshape(B, L, 2, RW_ICLR_RANK)
    w_pre = (w0 + jnp.einsum('blzr,zrd->blzd', jnp.tanh(wd), w_up)).astype(jnp.float32)
    decay = jnp.exp(-jnp.exp(-jax.nn.softplus(-w_pre) - 0.5))
    a = jax.nn.sigmoid((a0 + jnp.einsum('blzr,zrd->blzd', ad, a_up)).astype(jnp.float32))
    kk = (k * k_k).astype(jnp.float32).reshape(B, L, RW_HEADS, RW_HEAD_DIM)
    kk = (kk * lax.rsqrt(jnp.sum(kk * kk, axis=-1, keepdims=True) + 1e-12)).reshape(B, L, D)
    k_dir = k.astype(jnp.float32)[:, :, None] * (1.0 + (a - 1.0) * k_a.astype(jnp.float32))
    b = kk[:, :, None] * a
    return r.astype(jnp.float32), v.astype(jnp.float32), z, decay, kk, k_dir, b


def to_scan_layout(t):
    B, L = t.shape[:2]
    t = jnp.stack([t[:, :, 0], jnp.flip(t[:, :, 1], axis=1)], axis=0)
    return t.transpose(2, 0, 1, 3).reshape(L, 2, B, RW_HEADS, RW_HEAD_DIM)


def wkv7_step(S, inp):
    r, w, k, v, a, b = inp
    sa = jnp.einsum('zbhij,zbhj->zbhi', S, a)
    S = S * w[..., None, :] + sa[..., :, None] * b[..., None, :] + v[..., :, None] * k[..., None, :]
    return S, jnp.einsum('zbhij,zbhj->zbhi', S, r)


def wkv7_bidirectional(S0, r, decay, k_dir, v, kk, b):
    both = lambda t: jnp.stack([t, t], axis=2)
    seqs = (to_scan_layout(both(r)), to_scan_layout(decay), to_scan_layout(k_dir),
            to_scan_layout(both(v)), to_scan_layout(both(-kk)), to_scan_layout(b))
    S, y = lax.scan(wkv7_step, S0, seqs)
    y = y[:, 0] + jnp.flip(y[:, 1], axis=0)
    return S, y.transpose(1, 0, 2, 3)


def rwkv7_output(y, r, k_dir, v, z, r_k, ln_w, ln_b, w_out):
    B, L = y.shape[:2]
    yc = y - jnp.mean(y, axis=-1, keepdims=True)
    yn = yc * lax.rsqrt(jnp.mean(yc * yc, axis=-1, keepdims=True) + RW_GN_EPS)
    yn = yn.reshape(B, L, D_MODEL) * ln_w.astype(jnp.float32) + ln_b.astype(jnp.float32)
    heads = lambda t: t.reshape(B, L, RW_HEADS, RW_HEAD_DIM)
    bonus = jnp.sum(heads(r * jnp.mean(k_dir, axis=2) * r_k.astype(jnp.float32)), axis=-1, keepdims=True) * heads(v)
    o = (yn + bonus.reshape(B, L, D_MODEL)).astype(z.dtype) * jax.nn.silu(z)
    return o @ w_out


def rwkv7_mix(h_lat, h_ctx, w_in, mu, w0, w_up, a0, a_up, k_k, k_a, r_k, ln_w, ln_b, w_out, need_ctx_out):
    B = h_lat.shape[0]
    r_c, v_c, z_c, dec_c, kk_c, kd_c, b_c = rwkv7_features(h_ctx, w_in, mu, w0, w_up, a0, a_up, k_k, k_a)
    r_l, v_l, z_l, dec_l, kk_l, kd_l, b_l = rwkv7_features(h_lat, w_in, mu, w0, w_up, a0, a_up, k_k, k_a)
    S0 = jnp.zeros((2, B, RW_HEADS, RW_HEAD_DIM, RW_HEAD_DIM), jnp.float32)
    S_c, y_c = wkv7_bidirectional(S0, r_c, dec_c, kd_c, v_c, kk_c, b_c)
    _, y_l = wkv7_bidirectional(S_c, r_l, dec_l, kd_l, v_l, kk_l, b_l)
    out_l = rwkv7_output(y_l, r_l, kd_l, v_l, z_l, r_k, ln_w, ln_b, w_out)
    out_c = rwkv7_output(y_c, r_c, kd_c, v_c, z_c, r_k, ln_w, ln_b, w_out) if need_ctx_out else None
    return out_l, out_c


def setup_inputs(seed: int = 0) -> dict:
    key = jax.random.key(seed)
    ks = iter(jax.random.split(key, 32))
    D = D_MODEL
    R_ALL = 2 * RW_DECAY_RANK + 2 * RW_ICLR_RANK

    def nrm(shape, scale):
        return jax.random.normal(next(ks), shape, jnp.float32) * scale

    inputs = {}
    inputs['x'] = nrm((BATCH, SEQ, D), 1.0)
    inputs['c'] = nrm((BATCH, D), 1.0)
    inputs['ctx'] = nrm((BATCH, CTX_LEN, D), 1.0)
    inputs['c_ctx'] = nrm((D,), 1.0)
    inputs['norm_gain'] = 1.0 + nrm((DEPTH, D), 0.02)
    inputs['ada_w'] = nrm((DEPTH, D, 3 * D), 0.3 * D ** -0.5)
    inputs['ada_b'] = nrm((DEPTH, 3 * D), 0.02)
    inputs['final_gain'] = 1.0 + nrm((D,), 0.02)
    inputs['da_w_in'] = nrm((N_ATTN, D, 4 * D), D ** -0.5)
    inputs['da_lam_q'] = nrm((N_ATTN, 2, DA_HEAD_DIM), 0.1)
    inputs['da_lam_k'] = nrm((N_ATTN, 2, DA_HEAD_DIM), 0.1)
    inputs['da_subln_gain'] = 1.0 + nrm((N_ATTN, 2 * DA_HEAD_DIM), 0.02)
    inputs['da_w_out'] = nrm((N_ATTN, D, D), D ** -0.5)
    inputs['fn_w_in'] = nrm((N_FNET, D, 2 * D), D ** -0.5)
    inputs['fn_w_group'] = nrm((N_FNET, FN_GROUPS, FN_GROUP_DIM, FN_GROUP_DIM), FN_GROUP_DIM ** -0.5)
    inputs['fn_w_out'] = nrm((N_FNET, D, D), D ** -0.5)
    inputs['rw_w_in'] = nrm((N_RWKV, D, 4 * D + R_ALL), D ** -0.5)
    inputs['rw_mu'] = jax.random.uniform(next(ks), (N_RWKV, 3 * D + R_ALL), jnp.float32, 0.0, 1.0)
    inputs['rw_w0'] = jax.random.uniform(next(ks), (N_RWKV, 2, D), jnp.float32, -6.5, -1.5)
    inputs['rw_w_up'] = nrm((N_RWKV, 2, RW_DECAY_RANK, D), 0.1)
    inputs['rw_a0'] = nrm((N_RWKV, 2, D), 0.1)
    inputs['rw_a_up'] = nrm((N_RWKV, 2, RW_ICLR_RANK, D), RW_ICLR_RANK ** -0.5)
    inputs['rw_k_k'] = 0.85 + nrm((N_RWKV, D), 0.02)
    inputs['rw_k_a'] = 1.0 + nrm((N_RWKV, D), 0.02)
    inputs['rw_r_k'] = nrm((N_RWKV, D), 0.1)
    inputs['rw_ln_w'] = 1.0 + nrm((N_RWKV, D), 0.02)
    inputs['rw_ln_b'] = nrm((N_RWKV, D), 0.02)
    inputs['rw_w_out'] = nrm((N_RWKV, D, D), D ** -0.5)
    return inputs


def reference(x, c, ctx, c_ctx, norm_gain, ada_w, ada_b, final_gain,
              da_w_in, da_lam_q, da_lam_k, da_subln_gain, da_w_out,
              fn_w_in, fn_w_group, fn_w_out,
              rw_w_in, rw_mu, rw_w0, rw_w_up, rw_a0, rw_a_up, rw_k_k, rw_k_a, rw_r_k,
              rw_ln_w, rw_ln_b, rw_w_out):
    cos, sin = axial_rope_tables(x.shape[1])
    x_lat, x_ctx = x, ctx
    for i in range(DEPTH):
        last = i == DEPTH - 1
        kind = i % N_MIXERS
        j = i // N_MIXERS
        sh, sc, gt = ada_modulation(c, ada_w[i], ada_b[i])
        sh_c, sc_c, gt_c = ada_modulation(c_ctx, ada_w[i], ada_b[i])
        h_lat = rms_norm(x_lat, norm_gain[i]) * (1.0 + sc[:, None, :]) + sh[:, None, :]
        h_ctx = rms_norm(x_ctx, norm_gain[i]) * (1.0 + sc_c) + sh_c
        if kind == 0:
            lambda_init = 0.8 - 0.6 * math.exp(-0.3 * i)
            y_lat, y_ctx = diff_attention(h_lat, h_ctx, cos, sin, da_w_in[j], da_lam_q[j], da_lam_k[j],
                                          da_subln_gain[j], da_w_out[j], lambda_init, not last)
        elif kind == 1:
            y_lat = fourier_mix(h_lat, fn_w_in[j], fn_w_group[j], fn_w_out[j])
            y_ctx = None if last else fourier_mix(h_ctx, fn_w_in[j], fn_w_group[j], fn_w_out[j])
        else:
            y_lat, y_ctx = rwkv7_mix(h_lat, h_ctx, rw_w_in[j], rw_mu[j], rw_w0[j], rw_w_up[j], rw_a0[j],
                                     rw_a_up[j], rw_k_k[j], rw_k_a[j], rw_r_k[j], rw_ln_w[j], rw_ln_b[j],
                                     rw_w_out[j], not last)
        x_lat = x_lat + gt[:, None, :] * y_lat
        if not last:
            x_ctx = x_ctx + gt_c * y_ctx
    return rms_norm(x_lat, final_gain)
```

```cpp
#include <hip/hip_runtime.h>
#include <hip/hip_cooperative_groups.h>
#include <cstdio>
#include <cstdint>
#include <cmath>
namespace cg = cooperative_groups;

constexpr int TL = 32768, TCX = 2048, TT = TL + TCX, DM = 1024;
constexpr float QK_C2 = 0.125f * 1.4426950408889634f;
typedef float f32x2_t __attribute__((ext_vector_type(2)));
typedef __bf16 bf16x2_t __attribute__((ext_vector_type(2)));
__device__ __forceinline__ unsigned pkbf(float lo, float hi) { f32x2_t v = {lo, hi}; bf16x2_t b = __builtin_convertvector(v, bf16x2_t); return __builtin_bit_cast(unsigned, b); }
__device__ __forceinline__ float bflo(unsigned u) { return __uint_as_float(u << 16); }
__device__ __forceinline__ float bfhi(unsigned u) { return __uint_as_float(u & 0xffff0000u); }
__device__ __forceinline__ float bf1(unsigned short u) { return __uint_as_float(((unsigned)u) << 16); }
__device__ __forceinline__ float silu_f(float z) { return z / (1.f + __expf(-z)); }
__device__ __forceinline__ int opaque_tid() { int t = threadIdx.x; asm volatile("" : "+v"(t)); return t; }
namespace pg8 {
#define PG8_LAS __attribute__((address_space(3)))
typedef unsigned short bf16_t;
typedef short bf16x8 __attribute__((ext_vector_type(8)));
typedef float f32x4 __attribute__((ext_vector_type(4)));
typedef unsigned u32x4 __attribute__((ext_vector_type(4)));
constexpr int BM = 256, BK = 64, HALF = 128, HTB = HALF * BK * 2  , STAGE_BYTES = 8 * HTB, NXCD = 8, WGM = 8;

__host__ __device__ __forceinline__ int lds_byte(int r, int c) { const int st = (r >> 4) * 2 + (c >> 5), rr = r & 15, cc = c & 31, ob = rr * 64 + cc * 2; return st * 1024 + (ob ^ (((ob >> 9) & 1) << 5)); }
__host__ __device__ __forceinline__ void stage_rc(int b, int& R, int& C) { const int st = b / 1024, sb = b % 1024, swz = sb ^ (((sb >> 9) & 1) << 5); R = (st >> 1) * 16 + swz / 64; C = (st & 1) * 32 + (swz % 64) / 2; }
__host__ __device__ __forceinline__ int perm32(int rho) { const int n = rho >> 4, i = rho & 15; return 8 * (i >> 2) + 4 * n + (i & 3); }

struct Unit { int pm, pn; };
struct Gemm { const bf16_t* A; const bf16_t* Bt; int M, N, K; };

struct StaticOrder {
    int nM, nN, nwg, G, c;
    __host__ __device__ void init(int M, int N, int G_, int c_) { nM = M / BM; nN = N / BM; nwg = nM * nN; G = G_; c = c_; }
    __host__ __device__ bool next(int i, Unit& u) const {
        const long L = (long)i * G + c; if (L >= nwg) return false;
        int wgid = (int)L; { const int q = nwg / NXCD, r = nwg % NXCD, xcd = wgid % NXCD, off = wgid / NXCD; wgid = (xcd < r ? xcd * (q + 1) : r * (q + 1) + (xcd - r) * q) + off; }
        const int nig = WGM * nN, gid = wgid / nig, fm = gid * WGM, gsz = (nM - fm) < WGM ? (nM - fm) : WGM;
        u.pm = fm + ((wgid % nig) % gsz); u.pn = (wgid % nig) / gsz; return true;
    }
    __device__ __forceinline__ void a_ready(const Unit&) const {}
    __device__ __forceinline__ void done(const Unit&) const {}
};

struct EpiAttnIn {
    static constexpr bool PERM = true, AFTER_DRAIN = false;
    bf16_t* Q; bf16_t* Kb; bf16_t* V; bf16_t* Z; const float* ropeC; const float* ropeS;
    __device__ __forceinline__ void operator()(const f32x4 (&acc)[2][2][4][2], const Unit& u, int wr, int wc, int fr, int fq) const {
        const int sect = u.pn >> 2;
        bf16_t* base = sect == 0 ? Q : sect == 1 ? Kb : sect == 2 ? V : Z;
        const int colt = (u.pn & 3) * 256 + wc * 32 + 8 * fq;
        const int row0 = u.pm * BM + wr * 64 + fr;
        const bool rope = (u.pm < 128) && (sect < 2);
        const float sc = (sect == 0) ? QK_C2 : 1.f;
        const int axis = wc & 1;
#pragma unroll
        for (int ai = 0; ai < 2; ++ai)
#pragma unroll
            for (int m = 0; m < 4; ++m) {
                const int row = row0 + ai * HALF + m * 16;
                const int ntok = row & 4095;
                const int pos = axis ? (ntok & 63) : (ntok >> 6);
                bf16_t* rowp = base + (size_t)row * 1024 + colt;
#pragma unroll
                for (int bj = 0; bj < 2; ++bj) {
                    f32x4 v0 = acc[ai][bj][m][0], v1 = acc[ai][bj][m][1];
                    if (rope) {
                        const f32x4 c0 = *(const f32x4*)(ropeC + pos * 16 + 8 * (fq & 1)), c1 = *(const f32x4*)(ropeC + pos * 16 + 8 * (fq & 1) + 4);
                        const f32x4 s0 = *(const f32x4*)(ropeS + pos * 16 + 8 * (fq & 1)), s1 = *(const f32x4*)(ropeS + pos * 16 + 8 * (fq & 1) + 4);
                        f32x4 p0, p1;
#pragma unroll
                        for (int i = 0; i < 4; ++i) { p0[i] = __shfl_xor(v0[i], 32); p1[i] = __shfl_xor(v1[i], 32); }
                        if (fq < 2) { v0 = v0 * c0 - p0 * s0; v1 = v1 * c1 - p1 * s1; }
                        else        { v0 = v0 * c0 + p0 * s0; v1 = v1 * c1 + p1 * s1; }
                    }
                    v0 = v0 * sc; v1 = v1 * sc;
                    u32x4 w; w.x = pkbf(v0[0], v0[1]); w.y = pkbf(v0[2], v0[3]); w.z = pkbf(v1[0], v1[1]); w.w = pkbf(v1[2], v1[3]);
                    *(u32x4*)(rowp + bj * HALF) = w;
                }
            }
    }
};
struct EpiPlain {
    static constexpr bool PERM = true, AFTER_DRAIN = false;
    bf16_t* O; int ldc;
    __device__ __forceinline__ void operator()(const f32x4 (&acc)[2][2][4][2], const Unit& u, int wr, int wc, int fr, int fq) const {
        const int row0 = u.pm * BM + wr * 64 + fr, col0 = u.pn * BM + wc * 32 + 8 * fq;
#pragma unroll
        for (int ai = 0; ai < 2; ++ai)
#pragma unroll
            for (int m = 0; m < 4; ++m) { bf16_t* rowp = O + (size_t)(row0 + ai * HALF + m * 16) * ldc + col0;
#pragma unroll
                for (int bj = 0; bj < 2; ++bj) { const f32x4 v0 = acc[ai][bj][m][0], v1 = acc[ai][bj][m][1];
                    u32x4 w; w.x = pkbf(v0[0], v0[1]); w.y = pkbf(v0[2], v0[3]); w.z = pkbf(v1[0], v1[1]); w.w = pkbf(v1[2], v1[3]);
                    *(u32x4*)(rowp + bj * HALF) = w; } }
    }
};
struct EpiResid {
    static constexpr bool PERM = false, AFTER_DRAIN = false;
    const float* xin_lat; const float* xin_ctx; float* xout_lat; float* xout_ctx; const float* gate;
    __device__ __forceinline__ void operator()(const f32x4 (&acc)[2][2][4][2], const Unit& u, int wr, int wc, int fr, int fq) const {
        const int row0 = u.pm * BM + wr * 64 + fr, col0 = u.pn * BM + wc * 32 + 4 * fq;
#pragma unroll
        for (int ai = 0; ai < 2; ++ai)
#pragma unroll
            for (int m = 0; m < 4; ++m) {
                const int row = row0 + ai * HALF + m * 16; const bool lat = row < TL; const int r = lat ? (row >> 12) : 8;
                const float* xi = lat ? xin_lat + (size_t)row * 1024 : xin_ctx + (size_t)(row - TL) * 1024;
                float* xo = lat ? xout_lat + (size_t)row * 1024 : xout_ctx + (size_t)(row - TL) * 1024;
                const float* g = gate + r * 3072;
#pragma unroll
                for (int bj = 0; bj < 2; ++bj)
#pragma unroll
                    for (int n = 0; n < 2; ++n) { const int col = col0 + bj * HALF + n * 16;
                        const f32x4 g4 = *(const f32x4*)(g + col), x4 = *(const f32x4*)(xi + col);
                        *(f32x4*)(xo + col) = x4 + g4 * acc[ai][bj][m][n]; }
            }
    }
};
struct EpiFnT {
    static constexpr bool PERM = true, AFTER_DRAIN = false;
    bf16_t* ATL; bf16_t* ATC;
    __device__ __forceinline__ void operator()(const f32x4 (&acc)[2][2][4][2], const Unit& u, int wr, int wc, int fr, int fq) const {
        const int row0 = u.pm * BM + wr * 64 + fr, col0 = u.pn * BM + wc * 32 + 8 * fq;
#pragma unroll
        for (int ai = 0; ai < 2; ++ai)
#pragma unroll
            for (int m = 0; m < 4; ++m) { const int mp = row0 + ai * HALF + m * 16, cs = mp >> 10, n = mp & 1023;
#pragma unroll
                for (int bj = 0; bj < 2; ++bj) { const int t0 = col0 + bj * HALF; bf16_t* dst;
                    if (t0 < TL) { const int b = t0 >> 12, l = t0 & 4095; dst = ATL + ((size_t)((b * 1024 + n) * 2 + cs)) * 4096 + l; }
                    else { const int tc = t0 - TL, b = tc >> 8, l = tc & 255; dst = ATC + ((size_t)((b * 1024 + n) * 2 + cs)) * 256 + l; }
                    const f32x4 v0 = acc[ai][bj][m][0], v1 = acc[ai][bj][m][1];
                    u32x4 w; w.x = pkbf(v0[0], v0[1]); w.y = pkbf(v0[2], v0[3]); w.z = pkbf(v1[0], v1[1]); w.w = pkbf(v1[2], v1[3]);
                    *(u32x4*)dst = w; } }
    }
};
struct EpiDft {
    static constexpr bool PERM = true, AFTER_DRAIN = false;
    const bf16_t* Z; bf16_t* OG; int rowbase; int L;
    __device__ __forceinline__ void operator()(const f32x4 (&acc)[2][2][4][2], const Unit& u, int wr, int wc, int fr, int fq) const {
        const int k0 = u.pm * BM + wr * 64 + fr; const int b = u.pn >> 2; const int n0 = (u.pn & 3) * 256 + wc * 32 + 8 * fq;
#pragma unroll
        for (int ai = 0; ai < 2; ++ai)
#pragma unroll
            for (int m = 0; m < 4; ++m) { const size_t R = (size_t)(rowbase + b * L + k0 + ai * HALF + m * 16);
#pragma unroll
                for (int bj = 0; bj < 2; ++bj) { const size_t off = R * 1024 + n0 + bj * HALF;
                    const u32x4 zz = *(const u32x4*)(Z + off);
                    const f32x4 v0 = acc[ai][bj][m][0], v1 = acc[ai][bj][m][1];
                    u32x4 w;
                    w.x = pkbf(v0[0] * silu_f(bflo(zz.x)), v0[1] * silu_f(bfhi(zz.x))); w.y = pkbf(v0[2] * silu_f(bflo(zz.y)), v0[3] * silu_f(bfhi(zz.y)));
                    w.z = pkbf(v1[0] * silu_f(bflo(zz.z)), v1[1] * silu_f(bfhi(zz.z))); w.w = pkbf(v1[2] * silu_f(bflo(zz.w)), v1[3] * silu_f(bfhi(zz.w)));
                    *(u32x4*)(OG + off) = w; } }
    }
};
template <class Epi, class Sched, bool ALIGN_EPI = false, bool SP2 = false>
__device__ __forceinline__ void gemm_phase(PG8_LAS unsigned char* lds, const Gemm g, const Sched& S, const Epi& E) {
    const int tid = opaque_tid(), wid = __builtin_amdgcn_readfirstlane(tid >> 6), lane = tid & 63, wr = wid >> 2, wc = wid & 3, fr = lane & 15, fq = lane >> 4;
    const int K = g.K, nt = K / BK;
    unsigned voffA[2], voffB[2];
#pragma unroll
    for (int i = 0; i < 2; ++i) { int R, C; stage_rc(tid * 16 + i * 8192, R, C); const int Rb = Epi::PERM ? ((R & ~31) + perm32(R & 31)) : R;
        voffA[i] = (unsigned)(R * K + C) * 2u; voffB[i] = (unsigned)(Rb * K + C) * 2u; }
    const size_t kstep = (size_t)(BK * 2);
    const size_t hstep = (size_t)HALF * K * 2;
    const size_t tstep = 2 * hstep;
    const unsigned ldsw = (unsigned)wid * 1024u;
    const int aoff = lds_byte(wr * 64 + fr, fq * 8), boff = lds_byte(wc * 32 + fr, fq * 8);
#define PG8_SA(b, h) (((b) * 2 + (h)) * HTB)
#define PG8_SB(b, h) ((4 + (b) * 2 + (h)) * HTB)
#define PG8_STAGE(bufoff, gbase, voff) do { _Pragma("unroll") for (int _i = 0; _i < 2; ++_i) \
        __builtin_amdgcn_global_load_lds((const unsigned*)((const char*)(gbase) + (voff)[_i]), (PG8_LAS unsigned*)(lds + (bufoff) + ldsw + _i * 8192), 16, 0, 0); } while (0)
#define PG8_LDA(dst, b, h) do { _Pragma("unroll") for (int m = 0; m < 4; ++m) _Pragma("unroll") for (int k = 0; k < 2; ++k) dst[m][k] = *(const PG8_LAS bf16x8*)(lds + PG8_SA(b, h) + aoff + m * 2048 + k * 1024); } while (0)
#define PG8_LDB(dst, b, h) do { _Pragma("unroll") for (int n = 0; n < 2; ++n) _Pragma("unroll") for (int k = 0; k < 2; ++k) dst[n][k] = *(const PG8_LAS bf16x8*)(lds + PG8_SB(b, h) + boff + n * 2048 + k * 1024); } while (0)
#define PG8_MMA(ai, bj, At, Bt) do { __builtin_amdgcn_s_setprio(1); _Pragma("unroll") for (int m = 0; m < 4; ++m) _Pragma("unroll") for (int n = 0; n < 2; ++n) _Pragma("unroll") for (int k = 0; k < 2; ++k) \
        acc[ai][bj][m][n] = __builtin_amdgcn_mfma_f32_16x16x32_bf16(Bt[n][k], At[m][k], acc[ai][bj][m][n], 0, 0, 0); __builtin_amdgcn_s_setprio(0); } while (0)
#define PG8_WAIT_V(n) asm volatile("s_waitcnt vmcnt(" #n ")" ::: "memory")
#define PG8_WAIT_L(n) asm volatile("s_waitcnt lgkmcnt(" #n ")" ::: "memory")
#define PG8_BAR __builtin_amdgcn_s_barrier()
#define PG8_SCHED __builtin_amdgcn_sched_barrier(0)
    Unit cur, nxt; int ui = 0;
    if (!S.next(0, cur)) return;
    f32x4 acc[2][2][4][2];
#pragma unroll
    for (int a = 0; a < 2; ++a)
#pragma unroll
        for (int b = 0; b < 2; ++b)
#pragma unroll
            for (int m = 0; m < 4; ++m)
#pragma unroll
                for (int n = 0; n < 2; ++n) acc[a][b][m][n] = (f32x4){0.f, 0.f, 0.f, 0.f};
    bf16x8 At[4][2], B0[2][2], B1[2][2];
    const char* cA = (const char*)g.A + (size_t)cur.pm * tstep; const char* cB = (const char*)g.Bt + (size_t)cur.pn * tstep;
    S.a_ready(cur);
    if constexpr (SP2) {
        PG8_STAGE(PG8_SB(0, 0), cB, voffB); PG8_STAGE(PG8_SB(0, 1), cB + hstep, voffB); PG8_STAGE(PG8_SA(0, 0), cA, voffA); PG8_STAGE(PG8_SA(0, 1), cA + hstep, voffA);
        if (wr == 1) PG8_BAR;
        PG8_WAIT_V(2); PG8_BAR;
        PG8_STAGE(PG8_SB(1, 0), cB + kstep, voffB); PG8_STAGE(PG8_SA(1, 0), cA + kstep, voffA); PG8_STAGE(PG8_SB(1, 1), cB + hstep + kstep, voffB);
        PG8_WAIT_V(6); PG8_BAR;
    } else {
        PG8_STAGE(PG8_SB(0, 0), cB, voffB); PG8_STAGE(PG8_SA(0, 0), cA, voffA); PG8_STAGE(PG8_SB(0, 1), cB + hstep, voffB); PG8_STAGE(PG8_SA(0, 1), cA + hstep, voffA);
        if (wr == 1) PG8_BAR;
        PG8_WAIT_V(4); PG8_BAR;
        PG8_STAGE(PG8_SB(1, 0), cB + kstep, voffB); PG8_STAGE(PG8_SA(1, 0), cA + kstep, voffA); PG8_STAGE(PG8_SB(1, 1), cB + hstep + kstep, voffB);
        PG8_WAIT_V(6); PG8_BAR;
    }
    for (;;) {
        const bool has_next = S.next(ui + 1, nxt);
        const char* nA = has_next ? (const char*)g.A + (size_t)nxt.pm * tstep : cA; const char* nB = has_next ? (const char*)g.Bt + (size_t)nxt.pn * tstep : cB;
        for (int t = 0; t < nt; t += 2) {
            const bool last = (t == nt - 2);
            const char* a1 = cA + (size_t)(t + 1) * kstep;
            const char* a2 = last ? nA : cA + (size_t)(t + 2) * kstep; const char* b2 = last ? nB : cB + (size_t)(t + 2) * kstep;
            const char* a3 = a2 + kstep; const char* b3 = b2 + kstep;
            if (last && has_next) S.a_ready(nxt);
            if constexpr (SP2) {
            PG8_LDB(B0, 0, 0); PG8_LDB(B1, 0, 1); PG8_SCHED; PG8_LDA(At, 0, 0); PG8_STAGE(PG8_SA(1, 1), a1 + hstep, voffA);
            PG8_WAIT_V(8); PG8_WAIT_L(0); PG8_BAR; PG8_MMA(0, 0, At, B0); PG8_MMA(0, 1, At, B1); PG8_BAR; PG8_SCHED;
            PG8_LDA(At, 0, 1); PG8_STAGE(PG8_SB(0, 0), b2, voffB); PG8_STAGE(PG8_SB(0, 1), b2 + hstep, voffB); PG8_STAGE(PG8_SA(0, 0), a2, voffA);
            PG8_WAIT_V(8); PG8_WAIT_L(0); PG8_BAR; PG8_MMA(1, 0, At, B0); PG8_MMA(1, 1, At, B1); PG8_BAR; PG8_SCHED;
            PG8_LDB(B0, 1, 0); PG8_LDB(B1, 1, 1); PG8_SCHED; PG8_LDA(At, 1, 0); PG8_STAGE(PG8_SA(0, 1), a2 + hstep, voffA);
            PG8_WAIT_V(8); PG8_WAIT_L(0); PG8_BAR; PG8_MMA(0, 0, At, B0); PG8_MMA(0, 1, At, B1); PG8_BAR; PG8_SCHED;
            PG8_LDA(At, 1, 1); PG8_STAGE(PG8_SB(1, 0), b3, voffB); PG8_STAGE(PG8_SB(1, 1), b3 + hstep, voffB); PG8_STAGE(PG8_SA(1, 0), a3, voffA);
            PG8_WAIT_V(8); PG8_WAIT_L(0); PG8_BAR; PG8_MMA(1, 0, At, B0); PG8_MMA(1, 1, At, B1); PG8_BAR; PG8_SCHED;
            } else {
            PG8_LDB(B0, 0, 0); PG8_SCHED; PG8_LDA(At, 0, 0); PG8_STAGE(PG8_SA(1, 1), a1 + hstep, voffA);
            PG8_WAIT_L(8); PG8_BAR; PG8_WAIT_L(0); PG8_MMA(0, 0, At, B0); PG8_BAR; PG8_SCHED;
            PG8_LDB(B1, 0, 1); PG8_STAGE(PG8_SB(0, 0), b2, voffB);
            PG8_BAR; PG8_WAIT_L(0); PG8_MMA(0, 1, At, B1); PG8_BAR;
            PG8_LDA(At, 0, 1); PG8_STAGE(PG8_SA(0, 0), a2, voffA);
            PG8_BAR; PG8_WAIT_L(0); PG8_MMA(1, 0, At, B0); PG8_BAR; PG8_SCHED;
            PG8_STAGE(PG8_SB(0, 1), b2 + hstep, voffB);
            PG8_WAIT_V(6); PG8_BAR; PG8_MMA(1, 1, At, B1); PG8_BAR;
            PG8_LDB(B0, 1, 0); PG8_SCHED; PG8_LDA(At, 1, 0); PG8_STAGE(PG8_SA(0, 1), a2 + hstep, voffA);
            PG8_WAIT_L(8); PG8_BAR; PG8_WAIT_L(0); PG8_MMA(0, 0, At, B0); PG8_BAR; PG8_SCHED;
            PG8_LDB(B1, 1, 1); PG8_STAGE(PG8_SB(1, 0), b3, voffB);
            PG8_BAR; PG8_WAIT_L(0); PG8_MMA(0, 1, At, B1); PG8_BAR;
            PG8_LDA(At, 1, 1); PG8_STAGE(PG8_SA(1, 0), a3, voffA);
            PG8_BAR; PG8_WAIT_L(0); PG8_MMA(1, 0, At, B0); PG8_BAR; PG8_SCHED;
            PG8_STAGE(PG8_SB(1, 1), b3 + hstep, voffB);
            PG8_WAIT_V(6); PG8_BAR; PG8_MMA(1, 1, At, B1); PG8_BAR;
            }
        }
        if constexpr (ALIGN_EPI) { if (wr == 0) PG8_BAR; }
        if constexpr (!Epi::AFTER_DRAIN) { E(acc, cur, wr, wc, fr, fq); S.done(cur); }
        if (!has_next) break;
#pragma unroll
        for (int a = 0; a < 2; ++a)
#pragma unroll
            for (int b = 0; b < 2; ++b)
#pragma unroll
                for (int m = 0; m < 4; ++m)
#pragma unroll
                    for (int n = 0; n < 2; ++n) acc[a][b][m][n] = (f32x4){0.f, 0.f, 0.f, 0.f};
        cur = nxt; cA = nA; cB = nB; ++ui;
        if constexpr (ALIGN_EPI) { if (wr == 1) PG8_BAR; }
    }
    PG8_WAIT_V(0);
    if constexpr (!ALIGN_EPI) { if (wr == 0) PG8_BAR; }
    PG8_BAR;
    if constexpr (Epi::AFTER_DRAIN) { E.fused(acc, cur, wr, wc, fr, fq, lds, wid, lane); S.done(cur); }
#undef PG8_SA
#undef PG8_SB
#undef PG8_STAGE
#undef PG8_LDA
#undef PG8_LDB
#undef PG8_MMA
#undef PG8_WAIT_V
#undef PG8_WAIT_L
#undef PG8_BAR
#undef PG8_SCHED
}
}
#define LAS __attribute__((address_space(3)))
namespace att {
using bf16x8 = __attribute__((ext_vector_type(8))) short;
using s16x4 = __attribute__((ext_vector_type(4))) short;
using f32x16 = __attribute__((ext_vector_type(16))) float;
using u32x4 = __attribute__((ext_vector_type(4))) unsigned;
typedef unsigned short bf16_t;
__device__ __forceinline__ int crow(int r, int hi) { return (r & 3) + 8 * (r >> 2) + 4 * hi; }
constexpr int KSLOT = 8192, VSLOT = 16384, LDS_K = 0, LDS_V = 2 * KSLOT, LDS_WS = LDS_V + 2 * VSLOT, LDS_O1 = LDS_WS + 2048;
struct Args { const bf16_t* Q; const bf16_t* K; const bf16_t* V; const bf16_t* Z; bf16_t* O; const float* gain; float lam; float oml; int n_units; };

__device__ __forceinline__ void qkt(f32x16& p0, f32x16& p1, const LAS char* Kslot, const bf16x8* qr, int r32, int hi) {
    const f32x16 negm = f32x16{};
    const LAS char* kb = Kslot + hi * 1024 + r32 * 16;
#pragma unroll
    for (int d0 = 0; d0 < 4; ++d0) {
        const bf16x8 b0 = *(const LAS bf16x8*)(kb + d0 * 2048);
        const bf16x8 b1 = *(const LAS bf16x8*)(kb + d0 * 2048 + 512);
        if (d0 == 0) { p0 = __builtin_amdgcn_mfma_f32_32x32x16_bf16(b0, qr[0], negm, 0, 0, 0); p1 = __builtin_amdgcn_mfma_f32_32x32x16_bf16(b1, qr[0], negm, 0, 0, 0); }
        else { p0 = __builtin_amdgcn_mfma_f32_32x32x16_bf16(b0, qr[d0], p0, 0, 0, 0); p1 = __builtin_amdgcn_mfma_f32_32x32x16_bf16(b1, qr[d0], p1, 0, 0, 0); }
    }
}
__device__ __forceinline__ float rowmax(const f32x16& p0, const f32x16& p1) {
    float a = fmaxf(p0[0], p1[0]);
#pragma unroll
    for (int r = 1; r < 16; ++r) a = fmaxf(a, fmaxf(p0[r], p1[r]));
    auto rr = __builtin_amdgcn_permlane32_swap(__float_as_uint(a), __float_as_uint(a), false, false);
    return fmaxf(__uint_as_float(rr[0]), __uint_as_float(rr[1]));
}
__device__ __forceinline__ void pv(f32x16* o, int vb, bf16x8 pa0, bf16x8 pa1, bf16x8 pa2, bf16x8 pa3) {
#pragma unroll
    for (int d0 = 0; d0 < 4; ++d0) { s16x4 lo[4], hi[4];
#pragma unroll
        for (int ks = 0; ks < 4; ++ks) {
            asm volatile("ds_read_b64_tr_b16 %0,%1 offset:%c2" : "=&v"(lo[ks]) : "v"(vb), "i"(d0 * 4096 + ks * 1024) : "memory");
            asm volatile("ds_read_b64_tr_b16 %0,%1 offset:%c2" : "=&v"(hi[ks]) : "v"(vb), "i"(d0 * 4096 + ks * 1024 + 512) : "memory"); }
        asm volatile("s_waitcnt lgkmcnt(0)" ::: "memory"); __builtin_amdgcn_sched_barrier(0);
#define ATT_PK(k) (bf16x8){lo[k][0], lo[k][1], lo[k][2], lo[k][3], hi[k][0], hi[k][1], hi[k][2], hi[k][3]}
        o[d0] = __builtin_amdgcn_mfma_f32_32x32x16_bf16(pa0, ATT_PK(0), o[d0], 0, 0, 0);
        o[d0] = __builtin_amdgcn_mfma_f32_32x32x16_bf16(pa1, ATT_PK(1), o[d0], 0, 0, 0);
        o[d0] = __builtin_amdgcn_mfma_f32_32x32x16_bf16(pa2, ATT_PK(2), o[d0], 0, 0, 0);
        o[d0] = __builtin_amdgcn_mfma_f32_32x32x16_bf16(pa3, ATT_PK(3), o[d0], 0, 0, 0);
#undef ATT_PK
    }
}
__device__ __forceinline__ void attn_pass(const Args& A, int z, int b, int h, int qrow0, bool isctx, LAS char* shm, f32x16* o) {
    const int tid = opaque_tid(), lane = tid & 63, r32 = lane & 31, hi = lane >> 5; const int wid = __builtin_amdgcn_readfirstlane(tid >> 6);
    const int NT = isctx ? 4 : 68;
    LAS float* wsf = (LAS float*)(shm + LDS_WS) + wid * 64;
    const int vb0 = (int)(unsigned)(size_t)(shm + LDS_V) + ((lane >> 4) & 1) * 32 + (lane & 3) * 8 + (4 * hi + ((lane & 15) >> 2)) * 64;
    const bf16_t* Qw = A.Q + (size_t)(qrow0 + wid * 32 + r32) * 1024 + h * 128 + z * 64;
    bf16x8 qr[4];
#pragma unroll
    for (int d0 = 0; d0 < 4; ++d0) qr[d0] = *(const bf16x8*)(Qw + d0 * 16 + hi * 8);
    const bf16_t* Kh = A.K + h * 128 + z * 64 + wid * 8 + (size_t)lane * 1024;
    const int pc0 = wid, pc1 = wid + 8;
    const bf16_t* Vh0 = A.V + h * 128 + (pc0 >> 2) * 32 + (lane & 3) * 8 + (size_t)(16 * (pc0 & 3) + (lane >> 2)) * 1024;
    const bf16_t* Vh1 = A.V + h * 128 + (pc1 >> 2) * 32 + (lane & 3) * 8 + (size_t)(16 * (pc1 & 3) + (lane >> 2)) * 1024;
    const int ctxrow = TL + b * 256, latrow = b * 4096;
#define ATT_TROW(t) ((isctx || (t) < 4) ? (ctxrow + 64 * (t)) : (latrow + 64 * ((t) - 4)))
#define ATT_DMA(t, slot) do { const size_t ro_ = (size_t)ATT_TROW(t) * 1024; \
        __builtin_amdgcn_global_load_lds((const unsigned*)(Kh + ro_), (LAS unsigned*)(shm + LDS_K + (slot) * KSLOT + wid * 1024), 16, 0, 0); \
        __builtin_amdgcn_global_load_lds((const unsigned*)(Vh0 + ro_), (LAS unsigned*)(shm + LDS_V + (slot) * VSLOT + pc0 * 1024), 16, 0, 0); \
        __builtin_amdgcn_global_load_lds((const unsigned*)(Vh1 + ro_), (LAS unsigned*)(shm + LDS_V + (slot) * VSLOT + pc1 * 1024), 16, 0, 0); } while (0)
    float mhat = 0.f, l_reg = 0.f;
#pragma unroll
    for (int d = 0; d < 4; ++d) o[d] = f32x16{};
    ATT_DMA(0, 0);
#pragma unroll 1
    for (int t = 0; t < NT; ++t) {
        asm volatile("s_waitcnt vmcnt(0) lgkmcnt(0)\n\ts_barrier" ::: "memory");
        if (t + 1 < NT) ATT_DMA(t + 1, (t + 1) & 1);
        f32x16 p0, p1;
        qkt(p0, p1, shm + LDS_K + (t & 1) * KSLOT, qr, r32, hi);
        const float rm = rowmax(p0, p1);
        if (t == 0) { mhat = rm; }
        else if (__any(rm - mhat > 8.f)) {
            const float dl = fmaxf(rm - mhat, 0.f); mhat += dl;
            const float f = __builtin_amdgcn_exp2f(-dl); l_reg *= f;
            if (hi == 0) wsf[r32] = f;
            asm volatile("s_waitcnt lgkmcnt(0)" ::: "memory");
#pragma unroll
            for (int r = 0; r < 16; ++r) { const float fr_ = wsf[crow(r, hi)];
#pragma unroll
                for (int d = 0; d < 4; ++d) o[d][r] *= fr_; }
            asm volatile("s_waitcnt lgkmcnt(0)" ::: "memory");
        }
        float sacc = 0.f;
#pragma unroll
        for (int r = 0; r < 16; ++r) { p0[r] = __builtin_amdgcn_exp2f(p0[r] - mhat); p1[r] = __builtin_amdgcn_exp2f(p1[r] - mhat); sacc += p0[r] + p1[r]; }
        l_reg += sacc;
        u32x4 pw0, pw1, pw2, pw3;
        pw0 = (u32x4){pkbf(p0[0], p0[1]), pkbf(p0[2], p0[3]), pkbf(p0[4], p0[5]), pkbf(p0[6], p0[7])};
        pw1 = (u32x4){pkbf(p0[8], p0[9]), pkbf(p0[10], p0[11]), pkbf(p0[12], p0[13]), pkbf(p0[14], p0[15])};
        pw2 = (u32x4){pkbf(p1[0], p1[1]), pkbf(p1[2], p1[3]), pkbf(p1[4], p1[5]), pkbf(p1[6], p1[7])};
        pw3 = (u32x4){pkbf(p1[8], p1[9]), pkbf(p1[10], p1[11]), pkbf(p1[12], p1[13]), pkbf(p1[14], p1[15])};
        __builtin_amdgcn_sched_barrier(0);
        pv(o, vb0 + (t & 1) * VSLOT, __builtin_bit_cast(bf16x8, pw0), __builtin_bit_cast(bf16x8, pw1), __builtin_bit_cast(bf16x8, pw2), __builtin_bit_cast(bf16x8, pw3));
    }
#undef ATT_DMA
#undef ATT_TROW
    { auto rr = __builtin_amdgcn_permlane32_swap(__float_as_uint(l_reg), __float_as_uint(l_reg), false, false); l_reg = __uint_as_float(rr[0]) + __uint_as_float(rr[1]); }
    asm volatile("s_waitcnt lgkmcnt(0)" ::: "memory");
    if (hi == 0) wsf[32 + r32] = l_reg;
    asm volatile("s_waitcnt lgkmcnt(0)" ::: "memory");
#pragma unroll
    for (int r = 0; r < 16; ++r) { const float rl = 1.0f / wsf[32 + crow(r, hi)];
#pragma unroll
        for (int d = 0; d < 4; ++d) o[d][r] *= rl; }
    asm volatile("s_waitcnt lgkmcnt(0)" ::: "memory");
}
__device__ __forceinline__ void attn_unit(const Args& A, int b, int h, int qb, bool isctx, LAS char* shm) {
    const int tid = opaque_tid(), lane = tid & 63, r32 = lane & 31, hi = lane >> 5; const int wid = __builtin_amdgcn_readfirstlane(tid >> 6);
    const int qrow0 = isctx ? (TL + b * 256) : (b * 4096 + qb * 256);
    f32x16 o[4];
    LAS unsigned* o1s = (LAS unsigned*)(shm + LDS_O1) + wid * 2048 + lane;
    attn_pass(A, 0, b, h, qrow0, isctx, shm, o);
#pragma unroll
    for (int d = 0; d < 4; ++d)
#pragma unroll
        for (int r = 0; r < 16; r += 2) o1s[(d * 8 + (r >> 1)) * 64] = pkbf(o[d][r], o[d][r + 1]);
    asm volatile("s_waitcnt lgkmcnt(0)" ::: "memory");
    attn_pass(A, 1, b, h, qrow0, isctx, shm, o);
    float ss[16];
#pragma unroll
    for (int r = 0; r < 16; r += 2) { float s0 = 0.f, s1 = 0.f;
#pragma unroll
        for (int d = 0; d < 4; ++d) { const unsigned pk = o1s[(d * 8 + (r >> 1)) * 64];
            const float v0 = bflo(pk) - A.lam * o[d][r], v1 = bfhi(pk) - A.lam * o[d][r + 1]; o[d][r] = v0; o[d][r + 1] = v1; s0 += v0 * v0; s1 += v1 * v1; }
        ss[r] = s0; ss[r + 1] = s1; }
#pragma unroll
    for (int msk = 1; msk < 32; msk <<= 1)
#pragma unroll
        for (int r = 0; r < 16; ++r) ss[r] += __shfl_xor(ss[r], msk);
    float gn[4];
#pragma unroll
    for (int d = 0; d < 4; ++d) gn[d] = A.gain[d * 32 + r32] * A.oml;
#pragma unroll
    for (int r = 0; r < 16; ++r) {
        const float rstd = rsqrtf(ss[r] * (1.0f / 128.0f) + 1e-5f);
        const size_t off = (size_t)(qrow0 + wid * 32 + crow(r, hi)) * 1024 + h * 128 + r32;
#pragma unroll
        for (int d = 0; d < 4; ++d) { const float zv = bf1(A.Z[off + d * 32]); const float v = o[d][r] * rstd * gn[d] * silu_f(zv);
            A.O[off + d * 32] = (bf16_t)(pkbf(v, 0.f) & 0xffffu); }
        asm volatile("" ::: "memory");
    }
}
__device__ __forceinline__ void attn_phase(const Args& A, LAS char* shm, int G, int bid) {
#pragma unroll 1
    for (int u = bid; u < A.n_units; u += G) {
        const bool isctx = u >= 1024; const int bh = isctx ? (u - 1024) : (u >> 4); const int qb = isctx ? 0 : (u & 15);
        attn_unit(A, bh >> 3, bh & 7, qb, isctx, shm);
        asm volatile("s_waitcnt vmcnt(0) lgkmcnt(0)\n\ts_barrier" ::: "memory");
    }
}
}
typedef unsigned short bf16_t;
typedef float f32x4 __attribute__((ext_vector_type(4)));
typedef unsigned u32x4 __attribute__((ext_vector_type(4)));
typedef unsigned u32x2 __attribute__((ext_vector_type(2)));
constexpr size_t MiB = 1u << 20;
constexpr size_t WS_MOD = 1 * MiB, WS_ROPE = 1 * MiB + 512 * 1024, WS_BZ = 2 * MiB;
constexpr size_t WS_WDAIN = 9 * MiB, WS_WDAOUT = 25 * MiB, WS_WFNT = 29 * MiB, WS_WFNZ = 33 * MiB, WS_WFNOUT = 35 * MiB, WS_WRWIN = 37 * MiB, WS_WRWOUT = 46 * MiB;
constexpr size_t WS_XC = 48 * MiB, WS_HB = 56 * MiB, WS_BIG = 124 * MiB;
constexpr size_t WS_Q = WS_BIG, WS_K = WS_BIG + 68 * MiB, WS_V = WS_BIG + 136 * MiB, WS_Z = WS_BIG + 204 * MiB;
constexpr size_t WS_ATL = WS_BIG, WS_ATC = WS_BIG + 128 * MiB, WS_ZB = WS_BIG + 136 * MiB, WS_DFTL = 396 * MiB, WS_DFTC = 460 * MiB;
constexpr size_t WS_P = WS_BIG, WS_Y1 = 413 * MiB, WS_END = 482 * MiB;
constexpr int RWN = 4352;
constexpr int LDS_BYTES = 147456;

struct Params { const float* in[28]; float* out; unsigned char* ws; };

__device__ __forceinline__ float wave_sum(float v) {
#pragma unroll
    for (int o = 1; o < 64; o <<= 1) v += __shfl_xor(v, o);
    return v;
}
__device__ __forceinline__ void tr_item(const float* W, int ldw, int N, bf16_t* WT, int ldt, LAS float* scr, int item, int lane) {
    const int nblk = N / 32, kb = item / nblk, nb = item % nblk, k0 = 64 * kb, n0 = 32 * nb;
#pragma unroll 8
    for (int i = 0; i < 32; ++i) { const int kk = 2 * i + (lane >> 5); scr[kk * 33 + (lane & 31)] = W[(size_t)(k0 + kk) * ldw + n0 + (lane & 31)]; }
    asm volatile("s_waitcnt lgkmcnt(0)" ::: "memory");
    const int c = lane & 7;
#pragma unroll
    for (int j = 0; j < 4; ++j) { const int n = (lane >> 3) + 8 * j; const LAS float* s = scr + (8 * c) * 33 + n;
        u32x4 o; o.x = pkbf(s[0 * 33], s[1 * 33]); o.y = pkbf(s[2 * 33], s[3 * 33]); o.z = pkbf(s[4 * 33], s[5 * 33]); o.w = pkbf(s[6 * 33], s[7 * 33]);
        *(u32x4*)(WT + (size_t)(n0 + n) * ldt + k0 + 8 * c) = o; }
    asm volatile("s_waitcnt lgkmcnt(0)" ::: "memory");
}
__device__ __forceinline__ void prologue(const Params& p, LAS char* lds, int G, int bid) {
    const int tid = opaque_tid(), lane = tid & 63, wid = tid >> 6;
    unsigned char* ws = p.ws;
    {
        LAS float* scr = (LAS float*)(lds + wid * 8448);
        const int gw = bid * 8 + wid, NGW = G * 8;
        for (int it = gw; it < 8832; it += NGW) {
            int r = it;
            if (r < 2048) { tr_item(p.in[8], 4096, 4096, (bf16_t*)(ws + WS_WDAIN), 1024, scr, r, lane); continue; } r -= 2048;
            if (r < 2048) { tr_item(p.in[8] + (size_t)1024 * 4096, 4096, 4096, (bf16_t*)(ws + WS_WDAIN + 8 * MiB), 1024, scr, r, lane); continue; } r -= 2048;
            if (r < 512) { tr_item(p.in[12], 1024, 1024, (bf16_t*)(ws + WS_WDAOUT), 1024, scr, r, lane); continue; } r -= 512;
            if (r < 512) { tr_item(p.in[12] + (size_t)1024 * 1024, 1024, 1024, (bf16_t*)(ws + WS_WDAOUT + 2 * MiB), 1024, scr, r, lane); continue; } r -= 512;
            if (r < 512) { tr_item(p.in[13] + 1024, 2048, 1024, (bf16_t*)(ws + WS_WFNZ), 1024, scr, r, lane); continue; } r -= 512;
            if (r < 512) { tr_item(p.in[15], 1024, 1024, (bf16_t*)(ws + WS_WFNOUT), 1024, scr, r, lane); continue; } r -= 512;
            if (r < 2176) { tr_item(p.in[16], RWN, RWN, (bf16_t*)(ws + WS_WRWIN), 1024, scr, r, lane); continue; } r -= 2176;
            tr_item(p.in[27], 1024, 1024, (bf16_t*)(ws + WS_WRWOUT), 1024, scr, r, lane);
        }
    }
    __syncthreads();
    for (int it = bid; it < 256; it += G) {
        const int g = it >> 5, cs = (it >> 4) & 1, kq = it & 15;
        LAS float* Wcs = (LAS float*)lds; LAS float* win = (LAS float*)(lds + 65536); LAS float* tab = (LAS float*)(lds + 65536 + 33024);
        if (tid < 128) { float s, c; sincospif((float)tid / 64.f, &s, &c); tab[tid] = (cs ? s : c) * 0.08838834764831845f; }
        __syncthreads();
        {
            const int e = tid & 127, cq = tid >> 7; float acc[32];
#pragma unroll
            for (int i = 0; i < 32; ++i) acc[i] = 0.f;
            const float* Wg = p.in[14] + (size_t)g * 128 * 128;
            for (int m = 0; m < 128; ++m) { const float wg = Wg[m * 128 + e];
#pragma unroll
                for (int i = 0; i < 32; ++i) acc[i] += tab[(m * (cq + 4 * i)) & 127] * wg; }
#pragma unroll
            for (int i = 0; i < 32; ++i) Wcs[(cq + 4 * i) * 128 + e] = acc[i];
        }
#pragma unroll
        for (int i = 0; i < 16; ++i) { const int idx = tid + 512 * i, kin = idx >> 7, c = idx & 127; win[kin * 129 + c] = p.in[13][(size_t)(kq * 64 + kin) * 2048 + g * 128 + c]; }
        __syncthreads();
        {
            const int kin = tid & 63, eg = tid >> 6; float acc[16];
#pragma unroll
            for (int i = 0; i < 16; ++i) acc[i] = 0.f;
            for (int c = 0; c < 128; ++c) { const float a = win[kin * 129 + c];
#pragma unroll
                for (int i = 0; i < 16; ++i) acc[i] += a * Wcs[c * 128 + eg * 16 + i]; }
            bf16_t* WT = (bf16_t*)(ws + WS_WFNT);
#pragma unroll
            for (int i = 0; i < 16; ++i) WT[(size_t)(cs * 1024 + g * 128 + eg * 16 + i) * 1024 + kq * 64 + kin] = (bf16_t)(pkbf(acc[i], 0.f) & 0xffffu);
        }
        __syncthreads();
    }
    {
        LAS float* tc = (LAS float*)lds; LAS float* ts = (LAS float*)(lds + 16384);
        for (int j = tid; j < 4096; j += 512) { float s, c; sincospif((float)j / 2048.f, &s, &c); tc[j] = c; ts[j] = -s; }
        __syncthreads();
        bf16_t* DL = (bf16_t*)(ws + WS_DFTL); bf16_t* DC = (bf16_t*)(ws + WS_DFTC);
        for (int k = bid; k < 4096; k += G) {
            const int l0 = tid * 8; float c8[8], s8[8];
#pragma unroll
            for (int i = 0; i < 8; ++i) { const int idx = (k * (l0 + i)) & 4095; c8[i] = tc[idx] * 0.015625f; s8[i] = ts[idx] * 0.015625f; }
            u32x4 o; o.x = pkbf(c8[0], c8[1]); o.y = pkbf(c8[2], c8[3]); o.z = pkbf(c8[4], c8[5]); o.w = pkbf(c8[6], c8[7]);
            *(u32x4*)(DL + (size_t)k * 8192 + l0) = o;
            o.x = pkbf(s8[0], s8[1]); o.y = pkbf(s8[2], s8[3]); o.z = pkbf(s8[4], s8[5]); o.w = pkbf(s8[6], s8[7]);
            *(u32x4*)(DL + (size_t)k * 8192 + 4096 + l0) = o;
        }
        for (int k = bid; k < 256; k += G) {
            if (tid < 64) { const int cs = tid >> 5, l0 = (tid & 31) * 8; float v8[8];
#pragma unroll
                for (int i = 0; i < 8; ++i) { const int idx = ((k * (l0 + i)) & 255) * 16; v8[i] = (cs ? ts[idx] : tc[idx]) * 0.0625f; }
                u32x4 o; o.x = pkbf(v8[0], v8[1]); o.y = pkbf(v8[2], v8[3]); o.z = pkbf(v8[4], v8[5]); o.w = pkbf(v8[6], v8[7]);
                *(u32x4*)(DC + (size_t)k * 512 + cs * 256 + l0) = o; }
        }
        __syncthreads();
    }
    {
        LAS float* sc = (LAS float*)lds; LAS float* red = (LAS float*)(lds + 40960);
        bool have = false;
        for (int it = bid; it < 192; it += G) {
            if (!have) { for (int idx = tid; idx < 9216; idx += 512) { const int r = idx >> 10, k = idx & 1023; const float cv = r < 8 ? p.in[1][r * 1024 + k] : p.in[3][k]; sc[idx] = cv / (1.f + __expf(-cv)); } have = true; __syncthreads(); }
            const int i = it / 48, n = (it % 48) * 64 + (tid & 63), kq = tid >> 6;
            const float* w = p.in[5] + (size_t)i * 1024 * 3072 + n;
            float acc[9];
#pragma unroll
            for (int r = 0; r < 9; ++r) acc[r] = 0.f;
            for (int k = kq * 128; k < kq * 128 + 128; ++k) { const float wv = w[(size_t)k * 3072];
#pragma unroll
                for (int r = 0; r < 9; ++r) acc[r] += sc[r * 1024 + k] * wv; }
#pragma unroll
            for (int r = 0; r < 9; ++r) red[(kq * 9 + r) * 64 + (tid & 63)] = acc[r];
            __syncthreads();
            for (int idx = tid; idx < 576; idx += 512) { const int r = idx >> 6, col = idx & 63; float s = 0.f;
#pragma unroll
                for (int q = 0; q < 8; ++q) s += red[(q * 9 + r) * 64 + col];
                const int nn = (it % 48) * 64 + col;
                ((float*)(ws + WS_MOD))[(size_t)(i * 9 + r) * 3072 + nn] = s + p.in[6][i * 3072 + nn]; }
            __syncthreads();
        }
    }
    if (bid == 0) { for (int t = tid; t < 1024; t += 512) { const int pos = t >> 4, qd = t & 15; const float inv = powf(10000.f, -(float)qd / 16.f); const float ang = (float)pos * inv;
            ((float*)(ws + WS_ROPE))[t] = cosf(ang); ((float*)(ws + WS_ROPE))[1024 + t] = sinf(ang); } }
}
__device__ __forceinline__ void ph_phase(const float* xlat, const float* xctx, const float* gain, const float* mod, bf16_t* Hb, int G, int bid) {
    const int tid_ = opaque_tid(); const int lane = tid_ & 63, wid = tid_ >> 6;
    for (int row = bid * 8 + wid; row < TT; row += G * 8) {
        const bool lat = row < TL; const float* src = lat ? xlat + (size_t)row * 1024 : xctx + (size_t)(row - TL) * 1024; const int r = lat ? (row >> 12) : 8;
        f32x4 v[4]; float ss = 0.f;
#pragma unroll
        for (int j = 0; j < 4; ++j) { v[j] = *(const f32x4*)(src + 4 * lane + 256 * j); ss += (v[j].x * v[j].x + v[j].y * v[j].y) + (v[j].z * v[j].z + v[j].w * v[j].w); }
        const float rstd = rsqrtf(wave_sum(ss) * (1.f / 1024.f) + 1e-6f);
        const float* mr = mod + r * 3072;
#pragma unroll
        for (int j = 0; j < 4; ++j) { const int col = 4 * lane + 256 * j; const f32x4 g4 = *(const f32x4*)(gain + col), sh = *(const f32x4*)(mr + col), sc = *(const f32x4*)(mr + 1024 + col);
            const f32x4 y = v[j] * rstd * g4 * (sc + 1.f) + sh; u32x2 o; o.x = pkbf(y.x, y.y); o.y = pkbf(y.z, y.w);
            *(u32x2*)(Hb + (size_t)row * 1024 + col) = o; }
    }
}
__device__ __forceinline__ void final_phase(float* x, const float* gain, int G, int bid) {
    const int tid_ = opaque_tid(); const int lane = tid_ & 63, wid = tid_ >> 6;
    for (int row = bid * 8 + wid; row < TL; row += G * 8) {
        float* src = x + (size_t)row * 1024; f32x4 v[4]; float ss = 0.f;
#pragma unroll
        for (int j = 0; j < 4; ++j) { v[j] = *(const f32x4*)(src + 4 * lane + 256 * j); ss += (v[j].x * v[j].x + v[j].y * v[j].y) + (v[j].z * v[j].z + v[j].w * v[j].w); }
        const float rstd = rsqrtf(wave_sum(ss) * (1.f / 1024.f) + 1e-6f);
#pragma unroll
        for (int j = 0; j < 4; ++j) { const int col = 4 * lane + 256 * j; const f32x4 g4 = *(const f32x4*)(gain + col); *(f32x4*)(src + col) = v[j] * rstd * g4; }
    }
}
__device__ __forceinline__ void sh8(const bf16_t* P, size_t row, int co, bool hm, bool hp, const float* mu, float* out) {
    const u32x4 z4 = {0u, 0u, 0u, 0u};
    const u32x4 c0 = *(const u32x4*)(P + row * RWN + co);
    const u32x4 cm = hm ? *(const u32x4*)(P + (row - 1) * RWN + co) : z4;
    const u32x4 cp = hp ? *(const u32x4*)(P + (row + 1) * RWN + co) : z4;
    const f32x4 m0 = *(const f32x4*)(mu + co), m1 = *(const f32x4*)(mu + co + 4);
#pragma unroll
    for (int i = 0; i < 4; ++i) {
        const float a0 = bflo(c0[i]), a1 = bfhi(c0[i]);
        const float n0 = 0.5f * (bflo(cm[i]) + bflo(cp[i])), n1 = 0.5f * (bfhi(cm[i]) + bfhi(cp[i]));
        const float mu0 = (2 * i < 4) ? m0[(2 * i) & 3] : m1[(2 * i) & 3], mu1 = (2 * i + 1 < 4) ? m0[(2 * i + 1) & 3] : m1[(2 * i + 1) & 3];
        out[2 * i] = a0 + mu0 * (n0 - a0); out[2 * i + 1] = a1 + mu1 * (n1 - a1);
    }
}
struct RwArgs { const bf16_t* P; bf16_t* Y0; bf16_t* Y1; float* BZ; const float *mu, *w0, *w_up, *a0, *a_up, *k_k, *k_a, *r_k; };
__device__ __forceinline__ void rwkv_scan(const RwArgs& A, LAS char* lds, int G, int bid) {
    const int tid = opaque_tid(), lane = tid & 63; const int q = __builtin_amdgcn_readfirstlane(tid >> 6);
    LAS float* sW = (LAS float*)lds; LAS float* sA = sW + 4096; LAS float* sB = sA + 4096; LAS float* sKD = sB + 4096; LAS float* sR = sKD + 4096; LAS float* sV = sR + 4096;
    LAS float* WUP = sV + 4096; LAS float* AUP = WUP + 4096; LAS float* PP = AUP + 4096; LAS float* YP = PP + 1024;
    const int s = tid >> 3, dg = tid & 7, d0 = dg * 8;
#pragma unroll 1
    for (int chain = bid; chain < 256; chain += G) {
        const int z = chain >> 7, b = (chain >> 4) & 7, hh = chain & 15;
        __syncthreads();
        for (int idx = tid; idx < 4096; idx += 512) { const int r = idx >> 6, d = idx & 63; WUP[idx] = A.w_up[(size_t)(z * 64 + r) * 1024 + hh * 64 + d]; AUP[idx] = A.a_up[(size_t)(z * 64 + r) * 1024 + hh * 64 + d]; }
        float S[8];
#pragma unroll
        for (int j = 0; j < 8; ++j) S[j] = 0.f;
        bf16_t* Yz = z ? A.Y1 : A.Y0;
#pragma unroll 1
        for (int c = 0; c < 68; ++c) {
            asm volatile("" ::: "memory");
            const int sidx = c * 64 + s; int L, n, rowbase;
            if (c < 4) { L = 256; n = z ? (255 - sidx) : sidx; rowbase = TL + b * 256; }
            else { L = 4096; const int sl = sidx - 256; n = z ? (4095 - sl) : sl; rowbase = b * 4096; }
            const size_t row = (size_t)(rowbase + n); const bool hm = n > 0, hp = n < L - 1;
            float r8[8], k8[8], v8[8], t8[8];
            sh8(A.P, row, hh * 64 + d0, hm, hp, A.mu, r8);
            sh8(A.P, row, 1024 + hh * 64 + d0, hm, hp, A.mu, k8);
            sh8(A.P, row, 2048 + hh * 64 + d0, hm, hp, A.mu, v8);
#pragma unroll
            for (int i = 0; i < 8; ++i) { sR[s * 64 + d0 + i] = r8[i]; sV[s * 64 + d0 + i] = v8[i]; }
            sh8(A.P, row, 3072 + z * 64 + d0, hm, hp, A.mu, t8);
#pragma unroll
            for (int i = 0; i < 8; ++i) sB[s * 64 + d0 + i] = tanhf(t8[i]);
            sh8(A.P, row, 3200 + z * 64 + d0, hm, hp, A.mu, t8);
#pragma unroll
            for (int i = 0; i < 8; ++i) sA[s * 64 + d0 + i] = t8[i];
            __syncthreads();
            float accw[8], acca[8];
#pragma unroll
            for (int i = 0; i < 8; ++i) { accw[i] = 0.f; acca[i] = 0.f; }
#pragma unroll 4
            for (int r = 0; r < 64; ++r) { const float tw = sB[s * 64 + r], ta = sA[s * 64 + r];
                const f32x4 w0v = *(const LAS f32x4*)(WUP + r * 64 + d0), w1v = *(const LAS f32x4*)(WUP + r * 64 + d0 + 4);
                const f32x4 a0v = *(const LAS f32x4*)(AUP + r * 64 + d0), a1v = *(const LAS f32x4*)(AUP + r * 64 + d0 + 4);
#pragma unroll
                for (int i = 0; i < 4; ++i) { accw[i] += tw * w0v[i]; accw[4 + i] += tw * w1v[i]; acca[i] += ta * a0v[i]; acca[4 + i] += ta * a1v[i]; } }
            __syncthreads();
            {
                const int dcol = hh * 64 + d0; float kkr[8], ssq = 0.f, bz = 0.f;
#pragma unroll
                for (int i = 0; i < 8; ++i) { kkr[i] = k8[i] * A.k_k[dcol + i]; ssq += kkr[i] * kkr[i]; }
                ssq += __shfl_xor(ssq, 1); ssq += __shfl_xor(ssq, 2); ssq += __shfl_xor(ssq, 4);
                const float rs = rsqrtf(ssq + 1e-12f);
#pragma unroll
                for (int i = 0; i < 8; ++i) {
                    const float wpre = A.w0[z * 1024 + dcol + i] + accw[i]; const float x = -wpre;
                    const float sp = fmaxf(x, 0.f) + log1pf(__expf(-fabsf(x)));
                    const float w = __expf(-__expf(-sp - 0.5f));
                    const float asig = 1.f / (1.f + __expf(-(A.a0[z * 1024 + dcol + i] + acca[i])));
                    const float kk = kkr[i] * rs; const float kd = k8[i] * (1.f + (asig - 1.f) * A.k_a[dcol + i]);
                    sW[s * 64 + d0 + i] = w; sA[s * 64 + d0 + i] = -kk; sB[s * 64 + d0 + i] = kk * asig; sKD[s * 64 + d0 + i] = kd;
                    bz += r8[i] * kd * A.r_k[dcol + i];
                }
                bz += __shfl_xor(bz, 1); bz += __shfl_xor(bz, 2); bz += __shfl_xor(bz, 4);
                if (dg == 0) A.BZ[((size_t)z * TT + row) * 16 + hh] = bz;
            }
            __syncthreads();
#pragma unroll 1
            for (int st = 0; st < 64; ++st) {
                const int o8 = st * 64 + 8 * q;
                const f32x4 wa = *(const LAS f32x4*)(sW + o8), wb = *(const LAS f32x4*)(sW + o8 + 4);
                const f32x4 aa = *(const LAS f32x4*)(sA + o8), ab = *(const LAS f32x4*)(sA + o8 + 4);
                const f32x4 ba = *(const LAS f32x4*)(sB + o8), bb = *(const LAS f32x4*)(sB + o8 + 4);
                const f32x4 ka = *(const LAS f32x4*)(sKD + o8), kb = *(const LAS f32x4*)(sKD + o8 + 4);
                const f32x4 ra = *(const LAS f32x4*)(sR + o8), rb = *(const LAS f32x4*)(sR + o8 + 4);
                const float vi = sV[st * 64 + lane];
                float pp = 0.f;
#pragma unroll
                for (int j = 0; j < 4; ++j) { pp += S[j] * aa[j]; pp += S[4 + j] * ab[j]; }
                PP[(st & 1) * 512 + lane * 8 + q] = pp;
                __syncthreads();
                if (st > 0 && q == ((st - 1) & 7)) { const f32x4 y0 = *(const LAS f32x4*)(YP + ((st - 1) & 1) * 512 + lane * 8), y1 = *(const LAS f32x4*)(YP + ((st - 1) & 1) * 512 + lane * 8 + 4);
                    sR[(st - 1) * 64 + lane] = ((y0[0] + y0[1]) + (y0[2] + y0[3])) + ((y1[0] + y1[1]) + (y1[2] + y1[3])); }
                const f32x4 p0 = *(const LAS f32x4*)(PP + (st & 1) * 512 + lane * 8), p1 = *(const LAS f32x4*)(PP + (st & 1) * 512 + lane * 8 + 4);
                const float sa = ((p0[0] + p0[1]) + (p0[2] + p0[3])) + ((p1[0] + p1[1]) + (p1[2] + p1[3]));
                float yp = 0.f;
#pragma unroll
                for (int j = 0; j < 4; ++j) {
                    S[j] = S[j] * wa[j] + sa * ba[j] + vi * ka[j]; S[4 + j] = S[4 + j] * wb[j] + sa * bb[j] + vi * kb[j];
                    yp += S[j] * ra[j]; yp += S[4 + j] * rb[j]; }
                YP[(st & 1) * 512 + lane * 8 + q] = yp;
            }
            __syncthreads();
            if (q == 7) { const f32x4 y0 = *(const LAS f32x4*)(YP + 512 + lane * 8), y1 = *(const LAS f32x4*)(YP + 512 + lane * 8 + 4);
                sR[63 * 64 + lane] = ((y0[0] + y0[1]) + (y0[2] + y0[3])) + ((y1[0] + y1[1]) + (y1[2] + y1[3])); }
            __syncthreads();
            { u32x4 o; const LAS float* yr = sR + s * 64 + d0;
              o.x = pkbf(yr[0], yr[1]); o.y = pkbf(yr[2], yr[3]); o.z = pkbf(yr[4], yr[5]); o.w = pkbf(yr[6], yr[7]);
              *(u32x4*)(Yz + row * 1024 + hh * 64 + d0) = o; }
            __syncthreads();
        }
    }
}
__device__ __forceinline__ void rwkv_out(const RwArgs& A, const float* ln_w, const float* ln_b, bf16_t* OG, int G, int bid) {
    const int tid_ = opaque_tid(); const int lane = tid_ & 63, wid = tid_ >> 6; const int c0 = lane * 16, head = lane >> 2;
    for (int row = bid * 8 + wid; row < TT; row += G * 8) {
        const bool lat = row < TL; const int L = lat ? 4096 : 256; const int n = lat ? (row & 4095) : ((row - TL) & 255); const bool hm = n > 0, hp = n < L - 1;
        float y[16], vv[16];
        { const u32x4 a0 = *(const u32x4*)(A.Y0 + (size_t)row * 1024 + c0), a1 = *(const u32x4*)(A.Y0 + (size_t)row * 1024 + c0 + 8);
          const u32x4 b0 = *(const u32x4*)(A.Y1 + (size_t)row * 1024 + c0), b1 = *(const u32x4*)(A.Y1 + (size_t)row * 1024 + c0 + 8);
#pragma unroll
          for (int i = 0; i < 4; ++i) { y[2 * i] = bflo(a0[i]) + bflo(b0[i]); y[2 * i + 1] = bfhi(a0[i]) + bfhi(b0[i]); y[8 + 2 * i] = bflo(a1[i]) + bflo(b1[i]); y[8 + 2 * i + 1] = bfhi(a1[i]) + bfhi(b1[i]); } }
        float s1 = 0.f;
#pragma unroll
        for (int i = 0; i < 16; ++i) s1 += y[i];
        s1 += __shfl_xor(s1, 1); s1 += __shfl_xor(s1, 2); const float mean = s1 * (1.f / 64.f);
        float s2 = 0.f;
#pragma unroll
        for (int i = 0; i < 16; ++i) { y[i] -= mean; s2 += y[i] * y[i]; }
        s2 += __shfl_xor(s2, 1); s2 += __shfl_xor(s2, 2); const float rstd = rsqrtf(s2 * (1.f / 64.f) + 64e-5f);
        sh8(A.P, (size_t)row, 2048 + c0, hm, hp, A.mu, vv); sh8(A.P, (size_t)row, 2048 + c0 + 8, hm, hp, A.mu, vv + 8);
        const float bz = 0.5f * (A.BZ[(size_t)row * 16 + head] + A.BZ[((size_t)TT + row) * 16 + head]);
        const u32x4 z0 = *(const u32x4*)(A.P + (size_t)row * RWN + 3328 + c0), z1 = *(const u32x4*)(A.P + (size_t)row * RWN + 3328 + c0 + 8);
        float ov[16];
#pragma unroll
        for (int i = 0; i < 16; ++i) { const unsigned zw = (i < 8) ? z0[(i >> 1) & 3] : z1[(i >> 1) & 3]; const float zz = (i & 1) ? bfhi(zw) : bflo(zw);
            ov[i] = (y[i] * rstd * ln_w[c0 + i] + ln_b[c0 + i] + bz * vv[i]) * silu_f(zz); }
        u32x4 o0, o1; o0.x = pkbf(ov[0], ov[1]); o0.y = pkbf(ov[2], ov[3]); o0.z = pkbf(ov[4], ov[5]); o0.w = pkbf(ov[6], ov[7]);
        o1.x = pkbf(ov[8], ov[9]); o1.y = pkbf(ov[10], ov[11]); o1.z = pkbf(ov[12], ov[13]); o1.w = pkbf(ov[14], ov[15]);
        *(u32x4*)(OG + (size_t)row * 1024 + c0) = o0; *(u32x4*)(OG + (size_t)row * 1024 + c0 + 8) = o1;
    }
}
#ifdef SKIP_GEMM
#define GEMM_PHASE(EPI, AP, BP, MM, NN, KK, EOBJ) do { (void)EOBJ; } while (0)
#else
#define GEMM_PHASE(EPI, AP, BP, MM, NN, KK, EOBJ) do { pg8::Gemm g_{(const bf16_t*)(AP), (const bf16_t*)(BP), (MM), (NN), (KK)}; pg8::StaticOrder S_; S_.init((MM), (NN), G, bid); \
    pg8::gemm_phase<EPI, pg8::StaticOrder, true, true>((PG8_LAS unsigned char*)lds, g_, S_, EOBJ); } while (0)
#endif
#ifdef SKIP_EpiAttnIn
#define GEMM_PHASE_EpiAttnIn(EPI, AP, BP, MM, NN, KK, EOBJ) do { (void)EOBJ; } while (0)
#else
#define GEMM_PHASE_EpiAttnIn GEMM_PHASE
#endif
#ifdef SKIP_EpiFnT
#define GEMM_PHASE_EpiFnT(EPI, AP, BP, MM, NN, KK, EOBJ) do { (void)EOBJ; } while (0)
#else
#define GEMM_PHASE_EpiFnT GEMM_PHASE
#endif
#ifdef SKIP_EpiPlain
#define GEMM_PHASE_EpiPlain(EPI, AP, BP, MM, NN, KK, EOBJ) do { (void)EOBJ; } while (0)
#else
#define GEMM_PHASE_EpiPlain GEMM_PHASE
#endif
#ifdef SKIP_EpiDft
#define GEMM_PHASE_EpiDft(EPI, AP, BP, MM, NN, KK, EOBJ) do { (void)EOBJ; } while (0)
#else
#define GEMM_PHASE_EpiDft GEMM_PHASE
#endif
#ifdef SKIP_EpiResid
#define GEMM_PHASE_EpiResid(EPI, AP, BP, MM, NN, KK, EOBJ) do { (void)EOBJ; } while (0)
#else
#define GEMM_PHASE_EpiResid GEMM_PHASE
#endif
template <int layer> __device__ __forceinline__ void layer_body(const Params& p, LAS char* lds, cg::grid_group& grid, int G, int bid) {
    unsigned char* ws = p.ws;
    float* mod = (float*)(ws + WS_MOD);
    const float* ropeC = (const float*)(ws + WS_ROPE); const float* ropeS = ropeC + 1024;
    bf16_t* Hb = (bf16_t*)(ws + WS_HB);
    float* XC = (float*)(ws + WS_XC);
    const float* x_in = p.in[0]; const float* ctx_in = p.in[2];
        const float* xl = layer == 0 ? x_in : p.out; const float* xc = layer == 0 ? ctx_in : XC;
        const float* modl = mod + (size_t)layer * 9 * 3072;
        ph_phase(xl, xc, p.in[4] + layer * 1024, modl, Hb, G, bid);
        grid.sync();
        const int Mout = (layer == 3) ? TL : TT;
        const bf16_t* Wout;
        if constexpr (layer == 0 || layer == 3) {
            const int j = layer == 0 ? 0 : 1;
            pg8::EpiAttnIn E{(bf16_t*)(ws + WS_Q), (bf16_t*)(ws + WS_K), (bf16_t*)(ws + WS_V), (bf16_t*)(ws + WS_Z), ropeC, ropeS};
            GEMM_PHASE_EpiAttnIn(pg8::EpiAttnIn, Hb, ws + WS_WDAIN + (size_t)j * 8 * MiB, TT, 4096, 1024, E);
            grid.sync();
            float lam;
            { const int lane = opaque_tid() & 63; const float* lq = p.in[9] + j * 128; const float* lk = p.in[10] + j * 128;
              const float s0 = wave_sum(lq[lane] * lk[lane]), s1 = wave_sum(lq[64 + lane] * lk[64 + lane]);
              const float li = 0.8f - 0.6f * expf(-0.3f * (float)layer); lam = expf(s0) - expf(s1) + li;
              att::Args A{(const bf16_t*)(ws + WS_Q), (const bf16_t*)(ws + WS_K), (const bf16_t*)(ws + WS_V), (const bf16_t*)(ws + WS_Z), Hb, p.in[11] + j * 128, lam, 1.f - li, layer == 3 ? 1024 : 1088};
#ifndef SKIP_ATT
              att::attn_phase(A, lds, G, bid);
#endif
            }
            grid.sync();
            Wout = (const bf16_t*)(ws + WS_WDAOUT + (size_t)j * 2 * MiB);
        } else if constexpr (layer == 1) {
            { pg8::EpiFnT E{(bf16_t*)(ws + WS_ATL), (bf16_t*)(ws + WS_ATC)};
              GEMM_PHASE_EpiFnT(pg8::EpiFnT, ws + WS_WFNT, Hb, 2048, TT, 1024, E); }
            { pg8::EpiPlain E{(bf16_t*)(ws + WS_ZB), 1024};
              GEMM_PHASE_EpiPlain(pg8::EpiPlain, Hb, ws + WS_WFNZ, TT, 1024, 1024, E); }
            grid.sync();
            { pg8::EpiDft E{(const bf16_t*)(ws + WS_ZB), Hb, 0, 4096};
              GEMM_PHASE_EpiDft(pg8::EpiDft, ws + WS_DFTL, ws + WS_ATL, 4096, 8192, 8192, E); }
            { pg8::EpiDft E{(const bf16_t*)(ws + WS_ZB), Hb, TL, 256};
              GEMM_PHASE_EpiDft(pg8::EpiDft, ws + WS_DFTC, ws + WS_ATC, 256, 8192, 512, E); }
            grid.sync();
            Wout = (const bf16_t*)(ws + WS_WFNOUT);
        } else {
            { pg8::EpiPlain E{(bf16_t*)(ws + WS_P), RWN};
              GEMM_PHASE_EpiPlain(pg8::EpiPlain, Hb, ws + WS_WRWIN, TT, RWN, 1024, E); }
            grid.sync();
            RwArgs A{(const bf16_t*)(ws + WS_P), Hb, (bf16_t*)(ws + WS_Y1), (float*)(ws + WS_BZ), p.in[17], p.in[18], p.in[19], p.in[20], p.in[21], p.in[22], p.in[23], p.in[24]};
#ifndef SKIP_SCAN
            rwkv_scan(A, lds, G, bid);
#endif
            grid.sync();
#ifndef SKIP_RWOUT
            rwkv_out(A, p.in[25], p.in[26], Hb, G, bid);
#endif
            grid.sync();
            Wout = (const bf16_t*)(ws + WS_WRWOUT);
        }
        { pg8::EpiResid E{xl, xc, p.out, XC, modl + 2048};
          GEMM_PHASE_EpiResid(pg8::EpiResid, Hb, Wout, Mout, 1024, 1024, E); }
        grid.sync();
    }
__global__ void __launch_bounds__(512, 2) fwd_megakernel(Params p) {
    extern __shared__ __attribute__((aligned(16))) unsigned char lds_raw[];
    LAS char* lds = (LAS char*)lds_raw;
    cg::grid_group grid = cg::this_grid();
    const int G = gridDim.x, bid = blockIdx.x;
    unsigned char* ws = p.ws;
    float* mod = (float*)(ws + WS_MOD);
    const float* ropeC = (const float*)(ws + WS_ROPE); const float* ropeS = ropeC + 1024;
    bf16_t* Hb = (bf16_t*)(ws + WS_HB);
    float* XC = (float*)(ws + WS_XC);
    const float* x_in = p.in[0]; const float* ctx_in = p.in[2];

#ifndef SKIP_PRO
    prologue(p, lds, G, bid);
#endif
    grid.sync();
    layer_body<0>(p, lds, grid, G, bid);
    layer_body<1>(p, lds, grid, G, bid);
    layer_body<2>(p, lds, grid, G, bid);
    layer_body<3>(p, lds, grid, G, bid);
    final_phase(p.out, p.in[7], G, bid);
}

extern "C" void kernel_launch(void* const* d_in, const int* in_sizes, int n_in, void* d_out, int out_size, void* d_ws, size_t ws_size, hipStream_t stream) {
    static int grid = 0;
    if (grid == 0) {
        if (n_in != 28 || out_size != TL * 1024 || ws_size < WS_END) { fprintf(stderr, "kernel_launch: unexpected shapes: n_in %d out %d ws %zu\n", n_in, out_size, ws_size); grid = -1; return; }
        int dev = 0, cus = 0, per_cu = 0;
        hipGetDevice(&dev); hipDeviceGetAttribute(&cus, hipDeviceAttributeMultiprocessorCount, dev);
        if (hipFuncSetAttribute((const void*)fwd_megakernel, hipFuncAttributeMaxDynamicSharedMemorySize, LDS_BYTES) != hipSuccess) { fprintf(stderr, "kernel_launch: hipFuncSetAttribute failed\n"); grid = -1; return; }
        if (hipOccupancyMaxActiveBlocksPerMultiprocessor(&per_cu, (const void*)fwd_megakernel, 512, LDS_BYTES) != hipSuccess || per_cu < 1) { fprintf(stderr, "kernel_launch: occupancy query failed (%d)\n", per_cu); per_cu = 1; }
        (void)hipGetLastError();
        grid = cus * per_cu;
    }
    if (grid < 0) return;
    Params p{};
    for (int i = 0; i < 28; ++i) p.in[i] = (const float*)d_in[i];
    p.out = (float*)d_out; p.ws = (unsigned char*)d_ws;
    void* args[] = {&p};
    hipError_t e = hipLaunchCooperativeKernel((const void*)fwd_megakernel, dim3(grid), dim3(512), args, LDS_BYTES, stream);
    if (e != hipSuccess) fprintf(stderr, "cooperative launch failed: %s (grid %d)\n", hipGetErrorString(e), grid);
}
```

```cpp
#include <hip/hip_runtime.h>
#include <hip/hip_cooperative_groups.h>
#include <cstdio>
#include <cstdint>
#include <cmath>
namespace cg = cooperative_groups;

constexpr int TL = 32768, TCX = 2048, TT = TL + TCX, DM = 1024;
constexpr float QK_C2 = 0.125f * 1.4426950408889634f;
typedef float f32x2_t __attribute__((ext_vector_type(2)));
typedef __bf16 bf16x2_t __attribute__((ext_vector_type(2)));
__device__ __forceinline__ unsigned pkbf(float lo, float hi) { f32x2_t v = {lo, hi}; bf16x2_t b = __builtin_convertvector(v, bf16x2_t); return __builtin_bit_cast(unsigned, b); }
__device__ __forceinline__ float bflo(unsigned u) { return __uint_as_float(u << 16); }
__device__ __forceinline__ float bfhi(unsigned u) { return __uint_as_float(u & 0xffff0000u); }
__device__ __forceinline__ float bf1(unsigned short u) { return __uint_as_float(((unsigned)u) << 16); }
__device__ __forceinline__ float silu_f(float z) { return z / (1.f + __expf(-z)); }
__device__ __forceinline__ int opaque_tid() { int t = threadIdx.x; asm volatile("" : "+v"(t)); return t; }
namespace pg8 {
#define PG8_LAS __attribute__((address_space(3)))
typedef unsigned short bf16_t;
typedef short bf16x8 __attribute__((ext_vector_type(8)));
typedef float f32x4 __attribute__((ext_vector_type(4)));
typedef unsigned u32x4 __attribute__((ext_vector_type(4)));
constexpr int BM = 256, BK = 64, HALF = 128, HTB = HALF * BK * 2  , STAGE_BYTES = 8 * HTB, NXCD = 8, WGM = 8;

__host__ __device__ __forceinline__ int lds_byte(int r, int c) { const int st = (r >> 4) * 2 + (c >> 5), rr = r & 15, cc = c & 31, ob = rr * 64 + cc * 2; return st * 1024 + (ob ^ (((ob >> 9) & 1) << 5)); }
__host__ __device__ __forceinline__ void stage_rc(int b, int& R, int& C) { const int st = b / 1024, sb = b % 1024, swz = sb ^ (((sb >> 9) & 1) << 5); R = (st >> 1) * 16 + swz / 64; C = (st & 1) * 32 + (swz % 64) / 2; }
__host__ __device__ __forceinline__ int perm32(int rho) { const int n = rho >> 4, i = rho & 15; return 8 * (i >> 2) + 4 * n + (i & 3); }

struct Unit { int pm, pn; };
struct Gemm { const bf16_t* A; const bf16_t* Bt; int M, N, K; };

struct StaticOrder {
    int nM, nN, nwg, G, c;
    __host__ __device__ void init(int M, int N, int G_, int c_) { nM = M / BM; nN = N / BM; nwg = nM * nN; G = G_; c = c_; }
    __host__ __device__ bool next(int i, Unit& u) const {
        const long L = (long)i * G + c; if (L >= nwg) return false;
        int wgid = (int)L; { const int q = nwg / NXCD, r = nwg % NXCD, xcd = wgid % NXCD, off = wgid / NXCD; wgid = (xcd < r ? xcd * (q + 1) : r * (q + 1) + (xcd - r) * q) + off; }
        const int nig = WGM * nN, gid = wgid / nig, fm = gid * WGM, gsz = (nM - fm) < WGM ? (nM - fm) : WGM;
        u.pm = fm + ((wgid % nig) % gsz); u.pn = (wgid % nig) / gsz; return true;
    }
    __device__ __forceinline__ void a_ready(const Unit&) const {}
    __device__ __forceinline__ void done(const Unit&) const {}
};

struct EpiAttnIn {
    static constexpr bool PERM = true, AFTER_DRAIN = false;
    bf16_t* Q; bf16_t* Kb; bf16_t* V; bf16_t* Z; const float* ropeC; const float* ropeS;
    __device__ __forceinline__ void operator()(const f32x4 (&acc)[2][2][4][2], const Unit& u, int wr, int wc, int fr, int fq) const {
        const int sect = u.pn >> 2;
        bf16_t* base = sect == 0 ? Q : sect == 1 ? Kb : sect == 2 ? V : Z;
        const int colt = (u.pn & 3) * 256 + wc * 32 + 8 * fq;
        const int row0 = u.pm * BM + wr * 64 + fr;
        const bool rope = (u.pm < 128) && (sect < 2);
        const float sc = (sect == 0) ? QK_C2 : 1.f;
        const int axis = wc & 1;
#pragma unroll
        for (int ai = 0; ai < 2; ++ai)
#pragma unroll
            for (int m = 0; m < 4; ++m) {
                const int row = row0 + ai * HALF + m * 16;
                const int ntok = row & 4095;
                const int pos = axis ? (ntok & 63) : (ntok >> 6);
                bf16_t* rowp = base + (size_t)row * 1024 + colt;
#pragma unroll
                for (int bj = 0; bj < 2; ++bj) {
                    f32x4 v0 = acc[ai][bj][m][0], v1 = acc[ai][bj][m][1];
                    if (rope) {
                        const f32x4 c0 = *(const f32x4*)(ropeC + pos * 16 + 8 * (fq & 1)), c1 = *(const f32x4*)(ropeC + pos * 16 + 8 * (fq & 1) + 4);
                        const f32x4 s0 = *(const f32x4*)(ropeS + pos * 16 + 8 * (fq & 1)), s1 = *(const f32x4*)(ropeS + pos * 16 + 8 * (fq & 1) + 4);
                        f32x4 p0, p1;
#pragma unroll
                        for (int i = 0; i < 4; ++i) { p0[i] = __shfl_xor(v0[i], 32); p1[i] = __shfl_xor(v1[i], 32); }
                        if (fq < 2) { v0 = v0 * c0 - p0 * s0; v1 = v1 * c1 - p1 * s1; }
                        else        { v0 = v0 * c0 + p0 * s0; v1 = v1 * c1 + p1 * s1; }
                    }
                    v0 = v0 * sc; v1 = v1 * sc;
                    u32x4 w; w.x = pkbf(v0[0], v0[1]); w.y = pkbf(v0[2], v0[3]); w.z = pkbf(v1[0], v1[1]); w.w = pkbf(v1[2], v1[3]);
                    *(u32x4*)(rowp + bj * HALF) = w;
                }
            }
    }
};
struct EpiPlain {
    static constexpr bool PERM = true, AFTER_DRAIN = false;
    bf16_t* O; int ldc;
    __device__ __forceinline__ void operator()(const f32x4 (&acc)[2][2][4][2], const Unit& u, int wr, int wc, int fr, int fq) const {
        const int row0 = u.pm * BM + wr * 64 + fr, col0 = u.pn * BM + wc * 32 + 8 * fq;
#pragma unroll
        for (int ai = 0; ai < 2; ++ai)
#pragma unroll
            for (int m = 0; m < 4; ++m) { bf16_t* rowp = O + (size_t)(row0 + ai * HALF + m * 16) * ldc + col0;
#pragma unroll
                for (int bj = 0; bj < 2; ++bj) { const f32x4 v0 = acc[ai][bj][m][0], v1 = acc[ai][bj][m][1];
                    u32x4 w; w.x = pkbf(v0[0], v0[1]); w.y = pkbf(v0[2], v0[3]); w.z = pkbf(v1[0], v1[1]); w.w = pkbf(v1[2], v1[3]);
                    *(u32x4*)(rowp + bj * HALF) = w; } }
    }
};
struct EpiResid {
    static constexpr bool PERM = false, AFTER_DRAIN = false;
    const float* xin_lat; const float* xin_ctx; float* xout_lat; float* xout_ctx; const float* gate;
    __device__ __forceinline__ void operator()(const f32x4 (&acc)[2][2][4][2], const Unit& u, int wr, int wc, int fr, int fq) const {
        const int row0 = u.pm * BM + wr * 64 + fr, col0 = u.pn * BM + wc * 32 + 4 * fq;
#pragma unroll
        for (int ai = 0; ai < 2; ++ai)
#pragma unroll
            for (int m = 0; m < 4; ++m) {
                const int row = row0 + ai * HALF + m * 16; const bool lat = row < TL; const int r = lat ? (row >> 12) : 8;
                const float* xi = lat ? xin_lat + (size_t)row * 1024 : xin_ctx + (size_t)(row - TL) * 1024;
                float* xo = lat ? xout_lat + (size_t)row * 1024 : xout_ctx + (size_t)(row - TL) * 1024;
                const float* g = gate + r * 3072;
#pragma unroll
                for (int bj = 0; bj < 2; ++bj)
#pragma unroll
                    for (int n = 0; n < 2; ++n) { const int col = col0 + bj * HALF + n * 16;
                        const f32x4 g4 = *(const f32x4*)(g + col), x4 = *(const f32x4*)(xi + col);
                        *(f32x4*)(xo + col) = x4 + g4 * acc[ai][bj][m][n]; }
            }
    }
};
struct EpiFnT {
    static constexpr bool PERM = true, AFTER_DRAIN = false;
    bf16_t* ATL; bf16_t* ATC;
    __device__ __forceinline__ void operator()(const f32x4 (&acc)[2][2][4][2], const Unit& u, int wr, int wc, int fr, int fq) const {
        const int row0 = u.pm * BM + wr * 64 + fr, col0 = u.pn * BM + wc * 32 + 8 * fq;
#pragma unroll
        for (int ai = 0; ai < 2; ++ai)
#pragma unroll
            for (int m = 0; m < 4; ++m) { const int mp = row0 + ai * HALF + m * 16, cs = mp >> 10, n = mp & 1023;
#pragma unroll
                for (int bj = 0; bj < 2; ++bj) { const int t0 = col0 + bj * HALF; bf16_t* dst;
                    if (t0 < TL) { const int b = t0 >> 12, l = t0 & 4095; dst = ATL + ((size_t)((b * 1024 + n) * 2 + cs)) * 4096 + l; }
                    else { const int tc = t0 - TL, b = tc >> 8, l = tc & 255; dst = ATC + ((size_t)((b * 1024 + n) * 2 + cs)) * 256 + l; }
                    const f32x4 v0 = acc[ai][bj][m][0], v1 = acc[ai][bj][m][1];
                    u32x4 w; w.x = pkbf(v0[0], v0[1]); w.y = pkbf(v0[2], v0[3]); w.z = pkbf(v1[0], v1[1]); w.w = pkbf(v1[2], v1[3]);
                    *(u32x4*)dst = w; } }
    }
};
struct EpiDft {
    static constexpr bool PERM = true, AFTER_DRAIN = false;
    const bf16_t* Z; bf16_t* OG; int rowbase; int L;
    __device__ __forceinline__ void operator()(const f32x4 (&acc)[2][2][4][2], const Unit& u, int wr, int wc, int fr, int fq) const {
        const int k0 = u.pm * BM + wr * 64 + fr; const int b = u.pn >> 2; const int n0 = (u.pn & 3) * 256 + wc * 32 + 8 * fq;
#pragma unroll
        for (int ai = 0; ai < 2; ++ai)
#pragma unroll
            for (int m = 0; m < 4; ++m) { const size_t R = (size_t)(rowbase + b * L + k0 + ai * HALF + m * 16);
#pragma unroll
                for (int bj = 0; bj < 2; ++bj) { const size_t off = R * 1024 + n0 + bj * HALF;
                    const u32x4 zz = *(const u32x4*)(Z + off);
                    const f32x4 v0 = acc[ai][bj][m][0], v1 = acc[ai][bj][m][1];
                    u32x4 w;
                    w.x = pkbf(v0[0] * silu_f(bflo(zz.x)), v0[1] * silu_f(bfhi(zz.x))); w.y = pkbf(v0[2] * silu_f(bflo(zz.y)), v0[3] * silu_f(bfhi(zz.y)));
                    w.z = pkbf(v1[0] * silu_f(bflo(zz.z)), v1[1] * silu_f(bfhi(zz.z))); w.w = pkbf(v1[2] * silu_f(bflo(zz.w)), v1[3] * silu_f(bfhi(zz.w)));
                    *(u32x4*)(OG + off) = w; } }
    }
};
template <class Epi, class Sched, bool ALIGN_EPI = false, bool SP2 = false>
__device__ __forceinline__ void gemm_phase(PG8_LAS unsigned char* lds, const Gemm g, const Sched& S, const Epi& E) {
    const int tid = opaque_tid(), wid = __builtin_amdgcn_readfirstlane(tid >> 6), lane = tid & 63, wr = wid >> 2, wc = wid & 3, fr = lane & 15, fq = lane >> 4;
    const int K = g.K, nt = K / BK;
    unsigned voffA[2], voffB[2];
#pragma unroll
    for (int i = 0; i < 2; ++i) { int R, C; stage_rc(tid * 16 + i * 8192, R, C); const int Rb = Epi::PERM ? ((R & ~31) + perm32(R & 31)) : R;
        voffA[i] = (unsigned)(R * K + C) * 2u; voffB[i] = (unsigned)(Rb * K + C) * 2u; }
    const size_t kstep = (size_t)(BK * 2);
    const size_t hstep = (size_t)HALF * K * 2;
    const size_t tstep = 2 * hstep;
    const unsigned ldsw = (unsigned)wid * 1024u;
    const int aoff = lds_byte(wr * 64 + fr, fq * 8), boff = lds_byte(wc * 32 + fr, fq * 8);
#define PG8_SA(b, h) (((b) * 2 + (h)) * HTB)
#define PG8_SB(b, h) ((4 + (b) * 2 + (h)) * HTB)
#define PG8_STAGE(bufoff, gbase, voff) do { _Pragma("unroll") for (int _i = 0; _i < 2; ++_i) \
        __builtin_amdgcn_global_load_lds((const unsigned*)((const char*)(gbase) + (voff)[_i]), (PG8_LAS unsigned*)(lds + (bufoff) + ldsw + _i * 8192), 16, 0, 0); } while (0)
#define PG8_LDA(dst, b, h) do { _Pragma("unroll") for (int m = 0; m < 4; ++m) _Pragma("unroll") for (int k = 0; k < 2; ++k) dst[m][k] = *(const PG8_LAS bf16x8*)(lds + PG8_SA(b, h) + aoff + m * 2048 + k * 1024); } while (0)
#define PG8_LDB(dst, b, h) do { _Pragma("unroll") for (int n = 0; n < 2; ++n) _Pragma("unroll") for (int k = 0; k < 2; ++k) dst[n][k] = *(const PG8_LAS bf16x8*)(lds + PG8_SB(b, h) + boff + n * 2048 + k * 1024); } while (0)
#define PG8_MMA(ai, bj, At, Bt) do { __builtin_amdgcn_s_setprio(1); _Pragma("unroll") for (int m = 0; m < 4; ++m) _Pragma("unroll") for (int n = 0; n < 2; ++n) _Pragma("unroll") for (int k = 0; k < 2; ++k) \
        acc[ai][bj][m][n] = __builtin_amdgcn_mfma_f32_16x16x32_bf16(Bt[n][k], At[m][k], acc[ai][bj][m][n], 0, 0, 0); __builtin_amdgcn_s_setprio(0); } while (0)
#define PG8_WAIT_V(n) asm volatile("s_waitcnt vmcnt(" #n ")" ::: "memory")
#define PG8_WAIT_L(n) asm volatile("s_waitcnt lgkmcnt(" #n ")" ::: "memory")
#define PG8_BAR __builtin_amdgcn_s_barrier()
#define PG8_SCHED __builtin_amdgcn_sched_barrier(0)
    Unit cur, nxt; int ui = 0;
    if (!S.next(0, cur)) return;
    f32x4 acc[2][2][4][2];
#pragma unroll
    for (int a = 0; a < 2; ++a)
#pragma unroll
        for (int b = 0; b < 2; ++b)
#pragma unroll
            for (int m = 0; m < 4; ++m)
#pragma unroll
                for (int n = 0; n < 2; ++n) acc[a][b][m][n] = (f32x4){0.f, 0.f, 0.f, 0.f};
    bf16x8 At[4][2], B0[2][2], B1[2][2];
    const char* cA = (const char*)g.A + (size_t)cur.pm * tstep; const char* cB = (const char*)g.Bt + (size_t)cur.pn * tstep;
    S.a_ready(cur);
    if constexpr (SP2) {
        PG8_STAGE(PG8_SB(0, 0), cB, voffB); PG8_STAGE(PG8_SB(0, 1), cB + hstep, voffB); PG8_STAGE(PG8_SA(0, 0), cA, voffA); PG8_STAGE(PG8_SA(0, 1), cA + hstep, voffA);
        if (wr == 1) PG8_BAR;
        PG8_WAIT_V(2); PG8_BAR;
        PG8_STAGE(PG8_SB(1, 0), cB + kstep, voffB); PG8_STAGE(PG8_SA(1, 0), cA + kstep, voffA); PG8_STAGE(PG8_SB(1, 1), cB + hstep + kstep, voffB);
        PG8_WAIT_V(6); PG8_BAR;
    } else {
        PG8_STAGE(PG8_SB(0, 0), cB, voffB); PG8_STAGE(PG8_SA(0, 0), cA, voffA); PG8_STAGE(PG8_SB(0, 1), cB + hstep, voffB); PG8_STAGE(PG8_SA(0, 1), cA + hstep, voffA);
        if (wr == 1) PG8_BAR;
        PG8_WAIT_V(4); PG8_BAR;
        PG8_STAGE(PG8_SB(1, 0), cB + kstep, voffB); PG8_STAGE(PG8_SA(1, 0), cA + kstep, voffA); PG8_STAGE(PG8_SB(1, 1), cB + hstep + kstep, voffB);
        PG8_WAIT_V(6); PG8_BAR;
    }
    for (;;) {
        const bool has_next = S.next(ui + 1, nxt);
        const char* nA = has_next ? (const char*)g.A + (size_t)nxt.pm * tstep : cA; const char* nB = has_next ? (const char*)g.Bt + (size_t)nxt.pn * tstep : cB;
        for (int t = 0; t < nt; t += 2) {
            const bool last = (t == nt - 2);
            const char* a1 = cA + (size_t)(t + 1) * kstep;
            const char* a2 = last ? nA : cA + (size_t)(t + 2) * kstep; const char* b2 = last ? nB : cB + (size_t)(t + 2) * kstep;
            const char* a3 = a2 + kstep; const char* b3 = b2 + kstep;
            if (last && has_next) S.a_ready(nxt);
            if constexpr (SP2) {
            PG8_LDB(B0, 0, 0); PG8_LDB(B1, 0, 1); PG8_SCHED; PG8_LDA(At, 0, 0); PG8_STAGE(PG8_SA(1, 1), a1 + hstep, voffA);
            PG8_WAIT_V(8); PG8_WAIT_L(0); PG8_BAR; PG8_MMA(0, 0, At, B0); PG8_MMA(0, 1, At, B1); PG8_BAR; PG8_SCHED;
            PG8_LDA(At, 0, 1); PG8_STAGE(PG8_SB(0, 0), b2, voffB); PG8_STAGE(PG8_SB(0, 1), b2 + hstep, voffB); PG8_STAGE(PG8_SA(0, 0), a2, voffA);
            PG8_WAIT_V(8); PG8_WAIT_L(0); PG8_BAR; PG8_MMA(1, 0, At, B0); PG8_MMA(1, 1, At, B1); PG8_BAR; PG8_SCHED;
            PG8_LDB(B0, 1, 0); PG8_LDB(B1, 1, 1); PG8_SCHED; PG8_LDA(At, 1, 0); PG8_STAGE(PG8_SA(0, 1), a2 + hstep, voffA);
            PG8_WAIT_V(8); PG8_WAIT_L(0); PG8_BAR; PG8_MMA(0, 0, At, B0); PG8_MMA(0, 1, At, B1); PG8_BAR; PG8_SCHED;
            PG8_LDA(At, 1, 1); PG8_STAGE(PG8_SB(1, 0), b3, voffB); PG8_STAGE(PG8_SB(1, 1), b3 + hstep, voffB); PG8_STAGE(PG8_SA(1, 0), a3, voffA);
            PG8_WAIT_V(8); PG8_WAIT_L(0); PG8_BAR; PG8_MMA(1, 0, At, B0); PG8_MMA(1, 1, At, B1); PG8_BAR; PG8_SCHED;
            } else {
            PG8_LDB(B0, 0, 0); PG8_SCHED; PG8_LDA(At, 0, 0); PG8_STAGE(PG8_SA(1, 1), a1 + hstep, voffA);
            PG8_WAIT_L(8); PG8_BAR; PG8_WAIT_L(0); PG8_MMA(0, 0, At, B0); PG8_BAR; PG8_SCHED;
            PG8_LDB(B1, 0, 1); PG8_STAGE(PG8_SB(0, 0), b2, voffB);
            PG8_BAR; PG8_WAIT_L(0); PG8_MMA(0, 1, At, B1); PG8_BAR;
            PG8_LDA(At, 0, 1); PG8_STAGE(PG8_SA(0, 0), a2, voffA);
            PG8_BAR; PG8_WAIT_L(0); PG8_MMA(1, 0, At, B0); PG8_BAR; PG8_SCHED;
            PG8_STAGE(PG8_SB(0, 1), b2 + hstep, voffB);
            PG8_WAIT_V(6); PG8_BAR; PG8_MMA(1, 1, At, B1); PG8_BAR;
            PG8_LDB(B0, 1, 0); PG8_SCHED; PG8_LDA(At, 1, 0); PG8_STAGE(PG8_SA(0, 1), a2 + hstep, voffA);
            PG8_WAIT_L(8); PG8_BAR; PG8_WAIT_L(0); PG8_MMA(0, 0, At, B0); PG8_BAR; PG8_SCHED;
            PG8_LDB(B1, 1, 1); PG8_STAGE(PG8_SB(1, 0), b3, voffB);
            PG8_BAR; PG8_WAIT_L(0); PG8_MMA(0, 1, At, B1); PG8_BAR;
            PG8_LDA(At, 1, 1); PG8_STAGE(PG8_SA(1, 0), a3, voffA);
            PG8_BAR; PG8_WAIT_L(0); PG8_MMA(1, 0, At, B0); PG8_BAR; PG8_SCHED;
            PG8_STAGE(PG8_SB(1, 1), b3 + hstep, voffB);
            PG8_WAIT_V(6); PG8_BAR; PG8_MMA(1, 1, At, B1); PG8_BAR;
            }
        }
        if constexpr (ALIGN_EPI) { if (wr == 0) PG8_BAR; }
        if constexpr (!Epi::AFTER_DRAIN) { E(acc, cur, wr, wc, fr, fq); S.done(cur); }
        if (!has_next) break;
#pragma unroll
        for (int a = 0; a < 2; ++a)
#pragma unroll
            for (int b = 0; b < 2; ++b)
#pragma unroll
                for (int m = 0; m < 4; ++m)
#pragma unroll
                    for (int n = 0; n < 2; ++n) acc[a][b][m][n] = (f32x4){0.f, 0.f, 0.f, 0.f};
        cur = nxt; cA = nA; cB = nB; ++ui;
        if constexpr (ALIGN_EPI) { if (wr == 1) PG8_BAR; }
    }
    PG8_WAIT_V(0);
    if constexpr (!ALIGN_EPI) { if (wr == 0) PG8_BAR; }
    PG8_BAR;
    if constexpr (Epi::AFTER_DRAIN) { E.fused(acc, cur, wr, wc, fr, fq, lds, wid, lane); S.done(cur); }
#undef PG8_SA
#undef PG8_SB
#undef PG8_STAGE
#undef PG8_LDA
#undef PG8_LDB
#undef PG8_MMA
#undef PG8_WAIT_V
#undef PG8_WAIT_L
#undef PG8_BAR
#undef PG8_SCHED
}
}
#define LAS __attribute__((address_space(3)))
namespace att {
using bf16x8 = __attribute__((ext_vector_type(8))) short;
using s16x4 = __attribute__((ext_vector_type(4))) short;
using f32x16 = __attribute__((ext_vector_type(16))) float;
using u32x4 = __attribute__((ext_vector_type(4))) unsigned;
typedef unsigned short bf16_t;
__device__ __forceinline__ int crow(int r, int hi) { return (r & 3) + 8 * (r >> 2) + 4 * hi; }
constexpr int KSLOT = 8192, VSLOT = 16384, LDS_K = 0, LDS_V = 2 * KSLOT, LDS_WS = LDS_V + 2 * VSLOT, LDS_O1 = LDS_WS + 2048;
struct Args { const bf16_t* Q; const bf16_t* K; const bf16_t* V; const bf16_t* Z; bf16_t* O; const float* gain; float lam; float oml; int n_units; };

__device__ __forceinline__ void qkt(f32x16& p0, f32x16& p1, const LAS char* Kslot, const bf16x8* qr, int r32, int hi) {
    const f32x16 negm = f32x16{};
    const LAS char* kb = Kslot + hi * 1024 + r32 * 16;
#pragma unroll
    for (int d0 = 0; d0 < 4; ++d0) {
        const bf16x8 b0 = *(const LAS bf16x8*)(kb + d0 * 2048);
        const bf16x8 b1 = *(const LAS bf16x8*)(kb + d0 * 2048 + 512);
        if (d0 == 0) { p0 = __builtin_amdgcn_mfma_f32_32x32x16_bf16(b0, qr[0], negm, 0, 0, 0); p1 = __builtin_amdgcn_mfma_f32_32x32x16_bf16(b1, qr[0], negm, 0, 0, 0); }
        else { p0 = __builtin_amdgcn_mfma_f32_32x32x16_bf16(b0, qr[d0], p0, 0, 0, 0); p1 = __builtin_amdgcn_mfma_f32_32x32x16_bf16(b1, qr[d0], p1, 0, 0, 0); }
    }
}
__device__ __forceinline__ float rowmax(const f32x16& p0, const f32x16& p1) {
    float a = fmaxf(p0[0], p1[0]);
#pragma unroll
    for (int r = 1; r < 16; ++r) a = fmaxf(a, fmaxf(p0[r], p1[r]));
    auto rr = __builtin_amdgcn_permlane32_swap(__float_as_uint(a), __float_as_uint(a), false, false);
    return fmaxf(__uint_as_float(rr[0]), __uint_as_float(rr[1]));
}
__device__ __forceinline__ void pv(f32x16* o, int vb, bf16x8 pa0, bf16x8 pa1, bf16x8 pa2, bf16x8 pa3) {
#pragma unroll
    for (int d0 = 0; d0 < 4; ++d0) { s16x4 lo[4], hi[4];
#pragma unroll
        for (int ks = 0; ks < 4; ++ks) {
            asm volatile("ds_read_b64_tr_b16 %0,%1 offset:%c2" : "=&v"(lo[ks]) : "v"(vb), "i"(d0 * 4096 + ks * 1024) : "memory");
            asm volatile("ds_read_b64_tr_b16 %0,%1 offset:%c2" : "=&v"(hi[ks]) : "v"(vb), "i"(d0 * 4096 + ks * 1024 + 512) : "memory"); }
        asm volatile("s_waitcnt lgkmcnt(0)" ::: "memory"); __builtin_amdgcn_sched_barrier(0);
#define ATT_PK(k) (bf16x8){lo[k][0], lo[k][1], lo[k][2], lo[k][3], hi[k][0], hi[k][1], hi[k][2], hi[k][3]}
        o[d0] = __builtin_amdgcn_mfma_f32_32x32x16_bf16(pa0, ATT_PK(0), o[d0], 0, 0, 0);
        o[d0] = __builtin_amdgcn_mfma_f32_32x32x16_bf16(pa1, ATT_PK(1), o[d0], 0, 0, 0);
        o[d0] = __builtin_amdgcn_mfma_f32_32x32x16_bf16(pa2, ATT_PK(2), o[d0], 0, 0, 0);
        o[d0] = __builtin_amdgcn_mfma_f32_32x32x16_bf16(pa3, ATT_PK(3), o[d0], 0, 0, 0);
#undef ATT_PK
    }
}
__device__ __forceinline__ void attn_pass(const Args& A, int z, int b, int h, int qrow0, bool isctx, LAS char* shm, f32x16* o) {
    const int tid = opaque_tid(), lane = tid & 63, r32 = lane & 31, hi = lane >> 5; const int wid = __builtin_amdgcn_readfirstlane(tid >> 6);
    const int NT = isctx ? 4 : 68;
    LAS float* wsf = (LAS float*)(shm + LDS_WS) + wid * 64;
    const int vb0 = (int)(unsigned)(size_t)(shm + LDS_V) + ((lane >> 4) & 1) * 32 + (lane & 3) * 8 + (4 * hi + ((lane & 15) >> 2)) * 64;
    const bf16_t* Qw = A.Q + (size_t)(qrow0 + wid * 32 + r32) * 1024 + h * 128 + z * 64;
    bf16x8 qr[4];
#pragma unroll
    for (int d0 = 0; d0 < 4; ++d0) qr[d0] = *(const bf16x8*)(Qw + d0 * 16 + hi * 8);
    const bf16_t* Kh = A.K + h * 128 + z * 64 + wid * 8 + (size_t)lane * 1024;
    const int pc0 = wid, pc1 = wid + 8;
    const bf16_t* Vh0 = A.V + h * 128 + (pc0 >> 2) * 32 + (lane & 3) * 8 + (size_t)(16 * (pc0 & 3) + (lane >> 2)) * 1024;
    const bf16_t* Vh1 = A.V + h * 128 + (pc1 >> 2) * 32 + (lane & 3) * 8 + (size_t)(16 * (pc1 & 3) + (lane >> 2)) * 1024;
    const int ctxrow = TL + b * 256, latrow = b * 4096;
#define ATT_TROW(t) ((isctx || (t) < 4) ? (ctxrow + 64 * (t)) : (latrow + 64 * ((t) - 4)))
#define ATT_DMA(t, slot) do { const size_t ro_ = (size_t)ATT_TROW(t) * 1024; \
        __builtin_amdgcn_global_load_lds((const unsigned*)(Kh + ro_), (LAS unsigned*)(shm + LDS_K + (slot) * KSLOT + wid * 1024), 16, 0, 0); \
        __builtin_amdgcn_global_load_lds((const unsigned*)(Vh0 + ro_), (LAS unsigned*)(shm + LDS_V + (slot) * VSLOT + pc0 * 1024), 16, 0, 0); \
        __builtin_amdgcn_global_load_lds((const unsigned*)(Vh1 + ro_), (LAS unsigned*)(shm + LDS_V + (slot) * VSLOT + pc1 * 1024), 16, 0, 0); } while (0)
    float mhat = 0.f, l_reg = 0.f;
#pragma unroll
    for (int d = 0; d < 4; ++d) o[d] = f32x16{};
    ATT_DMA(0, 0);
#pragma unroll 1
    for (int t = 0; t < NT; ++t) {
        asm volatile("s_waitcnt vmcnt(0) lgkmcnt(0)\n\ts_barrier" ::: "memory");
        if (t + 1 < NT) ATT_DMA(t + 1, (t + 1) & 1);
        f32x16 p0, p1;
        qkt(p0, p1, shm + LDS_K + (t & 1) * KSLOT, qr, r32, hi);
        const float rm = rowmax(p0, p1);
        if (t == 0) { mhat = rm; }
        else if (__any(rm - mhat > 8.f)) {
            const float dl = fmaxf(rm - mhat, 0.f); mhat += dl;
            const float f = __builtin_amdgcn_exp2f(-dl); l_reg *= f;
            if (hi == 0) wsf[r32] = f;
            asm volatile("s_waitcnt lgkmcnt(0)" ::: "memory");
#pragma unroll
            for (int r = 0; r < 16; ++r) { const float fr_ = wsf[crow(r, hi)];
#pragma unroll
                for (int d = 0; d < 4; ++d) o[d][r] *= fr_; }
            asm volatile("s_waitcnt lgkmcnt(0)" ::: "memory");
        }
        float sacc = 0.f;
#pragma unroll
        for (int r = 0; r < 16; ++r) { p0[r] = __builtin_amdgcn_exp2f(p0[r] - mhat); p1[r] = __builtin_amdgcn_exp2f(p1[r] - mhat); sacc += p0[r] + p1[r]; }
        l_reg += sacc;
        u32x4 pw0, pw1, pw2, pw3;
        pw0 = (u32x4){pkbf(p0[0], p0[1]), pkbf(p0[2], p0[3]), pkbf(p0[4], p0[5]), pkbf(p0[6], p0[7])};
        pw1 = (u32x4){pkbf(p0[8], p0[9]), pkbf(p0[10], p0[11]), pkbf(p0[12], p0[13]), pkbf(p0[14], p0[15])};
        pw2 = (u32x4){pkbf(p1[0], p1[1]), pkbf(p1[2], p1[3]), pkbf(p1[4], p1[5]), pkbf(p1[6], p1[7])};
        pw3 = (u32x4){pkbf(p1[8], p1[9]), pkbf(p1[10], p1[11]), pkbf(p1[12], p1[13]), pkbf(p1[14], p1[15])};
        __builtin_amdgcn_sched_barrier(0);
        pv(o, vb0 + (t & 1) * VSLOT, __builtin_bit_cast(bf16x8, pw0), __builtin_bit_cast(bf16x8, pw1), __builtin_bit_cast(bf16x8, pw2), __builtin_bit_cast(bf16x8, pw3));
    }
#undef ATT_DMA
#undef ATT_TROW
    { auto rr = __builtin_amdgcn_permlane32_swap(__float_as_uint(l_reg), __float_as_uint(l_reg), false, false); l_reg = __uint_as_float(rr[0]) + __uint_as_float(rr[1]); }
    asm volatile("s_waitcnt lgkmcnt(0)" ::: "memory");
    if (hi == 0) wsf[32 + r32] = l_reg;
    asm volatile("s_waitcnt lgkmcnt(0)" ::: "memory");
#pragma unroll
    for (int r = 0; r < 16; ++r) { const float rl = 1.0f / wsf[32 + crow(r, hi)];
#pragma unroll
        for (int d = 0; d < 4; ++d) o[d][r] *= rl; }
    asm volatile("s_waitcnt lgkmcnt(0)" ::: "memory");
}
__device__ __forceinline__ void attn_unit(const Args& A, int b, int h, int qb, bool isctx, LAS char* shm) {
    const int tid = opaque_tid(), lane = tid & 63, r32 = lane & 31, hi = lane >> 5; const int wid = __builtin_amdgcn_readfirstlane(tid >> 6);
    const int qrow0 = isctx ? (TL + b * 256) : (b * 4096 + qb * 256);
    f32x16 o[4];
    LAS unsigned* o1s = (LAS unsigned*)(shm + LDS_O1) + wid * 2048 + lane;
    attn_pass(A, 0, b, h, qrow0, isctx, shm, o);
#pragma unroll
    for (int d = 0; d < 4; ++d)
#pragma unroll
        for (int r = 0; r < 16; r += 2) o1s[(d * 8 + (r >> 1)) * 64] = pkbf(o[d][r], o[d][r + 1]);
    asm volatile("s_waitcnt lgkmcnt(0)" ::: "memory");
    attn_pass(A, 1, b, h, qrow0, isctx, shm, o);
    float ss[16];
#pragma unroll
    for (int r = 0; r < 16; r += 2) { float s0 = 0.f, s1 = 0.f;
#pragma unroll
        for (int d = 0; d < 4; ++d) { const unsigned pk = o1s[(d * 8 + (r >> 1)) * 64];
            const float v0 = bflo(pk) - A.lam * o[d][r], v1 = bfhi(pk) - A.lam * o[d][r + 1]; o[d][r] = v0; o[d][r + 1] = v1; s0 += v0 * v0; s1 += v1 * v1; }
        ss[r] = s0; ss[r + 1] = s1; }
#pragma unroll
    for (int msk = 1; msk < 32; msk <<= 1)
#pragma unroll
        for (int r = 0; r < 16; ++r) ss[r] += __shfl_xor(ss[r], msk);
    float gn[4];
#pragma unroll
    for (int d = 0; d < 4; ++d) gn[d] = A.gain[d * 32 + r32] * A.oml;
#pragma unroll
    for (int r = 0; r < 16; ++r) {
        const float rstd = rsqrtf(ss[r] * (1.0f / 128.0f) + 1e-5f);
        const size_t off = (size_t)(qrow0 + wid * 32 + crow(r, hi)) * 1024 + h * 128 + r32;
#pragma unroll
        for (int d = 0; d < 4; ++d) { const float zv = bf1(A.Z[off + d * 32]); const float v = o[d][r] * rstd * gn[d] * silu_f(zv);
            A.O[off + d * 32] = (bf16_t)(pkbf(v, 0.f) & 0xffffu); }
        asm volatile("" ::: "memory");
    }
}
__device__ __forceinline__ void attn_phase(const Args& A, LAS char* shm, int G, int bid) {
#pragma unroll 1
    for (int u = bid; u < A.n_units; u += G) {
        const bool isctx = u >= 1024; const int bh = isctx ? (u - 1024) : (u >> 4); const int qb = isctx ? 0 : (u & 15);
        attn_unit(A, bh >> 3, bh & 7, qb, isctx, shm);
        asm volatile("s_waitcnt vmcnt(0) lgkmcnt(0)\n\ts_barrier" ::: "memory");
    }
}
}
typedef unsigned short bf16_t;
typedef float f32x4 __attribute__((ext_vector_type(4)));
typedef unsigned u32x4 __attribute__((ext_vector_type(4)));
typedef unsigned u32x2 __attribute__((ext_vector_type(2)));
constexpr size_t MiB = 1u << 20;
constexpr size_t WS_MOD = 1 * MiB, WS_ROPE = 1 * MiB + 512 * 1024, WS_BZ = 2 * MiB;
constexpr size_t WS_WDAIN = 9 * MiB, WS_WDAOUT = 25 * MiB, WS_WFNT = 29 * MiB, WS_WFNZ = 33 * MiB, WS_WFNOUT = 35 * MiB, WS_WRWIN = 37 * MiB, WS_WRWOUT = 46 * MiB;
constexpr size_t WS_XC = 48 * MiB, WS_HB = 56 * MiB, WS_BIG = 124 * MiB;
constexpr size_t WS_Q = WS_BIG, WS_K = WS_BIG + 68 * MiB, WS_V = WS_BIG + 136 * MiB, WS_Z = WS_BIG + 204 * MiB;
constexpr size_t WS_ATL = WS_BIG, WS_ATC = WS_BIG + 128 * MiB, WS_ZB = WS_BIG + 136 * MiB, WS_DFTL = 396 * MiB, WS_DFTC = 460 * MiB;
constexpr size_t WS_P = WS_BIG, WS_Y1 = 413 * MiB, WS_END = 482 * MiB;
constexpr int RWN = 4352;
constexpr int LDS_BYTES = 147456;

struct Params { const float* in[28]; float* out; unsigned char* ws; };

__device__ __forceinline__ float wave_sum(float v) {
#pragma unroll
    for (int o = 1; o < 64; o <<= 1) v += __shfl_xor(v, o);
    return v;
}
__device__ __forceinline__ void tr_item(const float* W, int ldw, int N, bf16_t* WT, int ldt, LAS float* scr, int item, int lane) {
    const int nblk = N / 32, kb = item / nblk, nb = item % nblk, k0 = 64 * kb, n0 = 32 * nb;
#pragma unroll 8
    for (int i = 0; i < 32; ++i) { const int kk = 2 * i + (lane >> 5); scr[kk * 33 + (lane & 31)] = W[(size_t)(k0 + kk) * ldw + n0 + (lane & 31)]; }
    asm volatile("s_waitcnt lgkmcnt(0)" ::: "memory");
    const int c = lane & 7;
#pragma unroll
    for (int j = 0; j < 4; ++j) { const int n = (lane >> 3) + 8 * j; const LAS float* s = scr + (8 * c) * 33 + n;
        u32x4 o; o.x = pkbf(s[0 * 33], s[1 * 33]); o.y = pkbf(s[2 * 33], s[3 * 33]); o.z = pkbf(s[4 * 33], s[5 * 33]); o.w = pkbf(s[6 * 33], s[7 * 33]);
        *(u32x4*)(WT + (size_t)(n0 + n) * ldt + k0 + 8 * c) = o; }
    asm volatile("s_waitcnt lgkmcnt(0)" ::: "memory");
}
__device__ __forceinline__ void prologue(const Params& p, LAS char* lds, int G, int bid) {
    const int tid = opaque_tid(), lane = tid & 63, wid = tid >> 6;
    unsigned char* ws = p.ws;
    {
        LAS float* scr = (LAS float*)(lds + wid * 8448);
        const int gw = bid * 8 + wid, NGW = G * 8;
        for (int it = gw; it < 8832; it += NGW) {
            int r = it;
            if (r < 2048) { tr_item(p.in[8], 4096, 4096, (bf16_t*)(ws + WS_WDAIN), 1024, scr, r, lane); continue; } r -= 2048;
            if (r < 2048) { tr_item(p.in[8] + (size_t)1024 * 4096, 4096, 4096, (bf16_t*)(ws + WS_WDAIN + 8 * MiB), 1024, scr, r, lane); continue; } r -= 2048;
            if (r < 512) { tr_item(p.in[12], 1024, 1024, (bf16_t*)(ws + WS_WDAOUT), 1024, scr, r, lane); continue; } r -= 512;
            if (r < 512) { tr_item(p.in[12] + (size_t)1024 * 1024, 1024, 1024, (bf16_t*)(ws + WS_WDAOUT + 2 * MiB), 1024, scr, r, lane); continue; } r -= 512;
            if (r < 512) { tr_item(p.in[13] + 1024, 2048, 1024, (bf16_t*)(ws + WS_WFNZ), 1024, scr, r, lane); continue; } r -= 512;
            if (r < 512) { tr_item(p.in[15], 1024, 1024, (bf16_t*)(ws + WS_WFNOUT), 1024, scr, r, lane); continue; } r -= 512;
            if (r < 2176) { tr_item(p.in[16], RWN, RWN, (bf16_t*)(ws + WS_WRWIN), 1024, scr, r, lane); continue; } r -= 2176;
            tr_item(p.in[27], 1024, 1024, (bf16_t*)(ws + WS_WRWOUT), 1024, scr, r, lane);
        }
    }
    __syncthreads();
    for (int it = bid; it < 256; it += G) {
        const int g = it >> 5, cs = (it >> 4) & 1, kq = it & 15;
        LAS float* Wcs = (LAS float*)lds; LAS float* win = (LAS float*)(lds + 65536); LAS float* tab = (LAS float*)(lds + 65536 + 33024);
        if (tid < 128) { float s, c; sincospif((float)tid / 64.f, &s, &c); tab[tid] = (cs ? s : c) * 0.08838834764831845f; }
        __syncthreads();
        {
            const int e = tid & 127, cq = tid >> 7; float acc[32];
#pragma unroll
            for (int i = 0; i < 32; ++i) acc[i] = 0.f;
            const float* Wg = p.in[14] + (size_t)g * 128 * 128;
            for (int m = 0; m < 128; ++m) { const float wg = Wg[m * 128 + e];
#pragma unroll
                for (int i = 0; i < 32; ++i) acc[i] += tab[(m * (cq + 4 * i)) & 127] * wg; }
#pragma unroll
            for (int i = 0; i < 32; ++i) Wcs[(cq + 4 * i) * 128 + e] = acc[i];
        }
#pragma unroll
        for (int i = 0; i < 16; ++i) { const int idx = tid + 512 * i, kin = idx >> 7, c = idx & 127; win[kin * 129 + c] = p.in[13][(size_t)(kq * 64 + kin) * 2048 + g * 128 + c]; }
        __syncthreads();
        {
            const int kin = tid & 63, eg = tid >> 6; float acc[16];
#pragma unroll
            for (int i = 0; i < 16; ++i) acc[i] = 0.f;
            for (int c = 0; c < 128; ++c) { const float a = win[kin * 129 + c];
#pragma unroll
                for (int i = 0; i < 16; ++i) acc[i] += a * Wcs[c * 128 + eg * 16 + i]; }
            bf16_t* WT = (bf16_t*)(ws + WS_WFNT);
#pragma unroll
            for (int i = 0; i < 16; ++i) WT[(size_t)(cs * 1024 + g * 128 + eg * 16 + i) * 1024 + kq * 64 + kin] = (bf16_t)(pkbf(acc[i], 0.f) & 0xffffu);
        }
        __syncthreads();
    }
    {
        LAS float* tc = (LAS float*)lds; LAS float* ts = (LAS float*)(lds + 16384);
        for (int j = tid; j < 4096; j += 512) { float s, c; sincospif((float)j / 2048.f, &s, &c); tc[j] = c; ts[j] = -s; }
        __syncthreads();
        bf16_t* DL = (bf16_t*)(ws + WS_DFTL); bf16_t* DC = (bf16_t*)(ws + WS_DFTC);
        for (int k = bid; k < 4096; k += G) {
            const int l0 = tid * 8; float c8[8], s8[8];
#pragma unroll
            for (int i = 0; i < 8; ++i) { const int idx = (k * (l0 + i)) & 4095; c8[i] = tc[idx] * 0.015625f; s8[i] = ts[idx] * 0.015625f; }
            u32x4 o; o.x = pkbf(c8[0], c8[1]); o.y = pkbf(c8[2], c8[3]); o.z = pkbf(c8[4], c8[5]); o.w = pkbf(c8[6], c8[7]);
            *(u32x4*)(DL + (size_t)k * 8192 + l0) = o;
            o.x = pkbf(s8[0], s8[1]); o.y = pkbf(s8[2], s8[3]); o.z = pkbf(s8[4], s8[5]); o.w = pkbf(s8[6], s8[7]);
            *(u32x4*)(DL + (size_t)k * 8192 + 4096 + l0) = o;
        }
        for (int k = bid; k < 256; k += G) {
            if (tid < 64) { const int cs = tid >> 5, l0 = (tid & 31) * 8; float v8[8];
#pragma unroll
                for (int i = 0; i < 8; ++i) { const int idx = ((k * (l0 + i)) & 255) * 16; v8[i] = (cs ? ts[idx] : tc[idx]) * 0.0625f; }
                u32x4 o; o.x = pkbf(v8[0], v8[1]); o.y = pkbf(v8[2], v8[3]); o.z = pkbf(v8[4], v8[5]); o.w = pkbf(v8[6], v8[7]);
                *(u32x4*)(DC + (size_t)k * 512 + cs * 256 + l0) = o; }
        }
        __syncthreads();
    }
    {
        LAS float* sc = (LAS float*)lds; LAS float* red = (LAS float*)(lds + 40960);
        bool have = false;
        for (int it = bid; it < 192; it += G) {
            if (!have) { for (int idx = tid; idx < 9216; idx += 512) { const int r = idx >> 10, k = idx & 1023; const float cv = r < 8 ? p.in[1][r * 1024 + k] : p.in[3][k]; sc[idx] = cv / (1.f + __expf(-cv)); } have = true; __syncthreads(); }
            const int i = it / 48, n = (it % 48) * 64 + (tid & 63), kq = tid >> 6;
            const float* w = p.in[5] + (size_t)i * 1024 * 3072 + n;
            float acc[9];
#pragma unroll
            for (int r = 0; r < 9; ++r) acc[r] = 0.f;
            for (int k = kq * 128; k < kq * 128 + 128; ++k) { const float wv = w[(size_t)k * 3072];
#pragma unroll
                for (int r = 0; r < 9; ++r) acc[r] += sc[r * 1024 + k] * wv; }
#pragma unroll
            for (int r = 0; r < 9; ++r) red[(kq * 9 + r) * 64 + (tid & 63)] = acc[r];
            __syncthreads();
            for (int idx = tid; idx < 576; idx += 512) { const int r = idx >> 6, col = idx & 63; float s = 0.f;
#pragma unroll
                for (int q = 0; q < 8; ++q) s += red[(q * 9 + r) * 64 + col];
                const int nn = (it % 48) * 64 + col;
                ((float*)(ws + WS_MOD))[(size_t)(i * 9 + r) * 3072 + nn] = s + p.in[6][i * 3072 + nn]; }
            __syncthreads();
        }
    }
    if (bid == 0) { for (int t = tid; t < 1024; t += 512) { const int pos = t >> 4, qd = t & 15; const float inv = powf(10000.f, -(float)qd / 16.f); const float ang = (float)pos * inv;
            ((float*)(ws + WS_ROPE))[t] = cosf(ang); ((float*)(ws + WS_ROPE))[1024 + t] = sinf(ang); } }
}
__device__ __forceinline__ void ph_phase(const float* xlat, const float* xctx, const float* gain, const float* mod, bf16_t* Hb, int G, int bid) {
    const int tid_ = opaque_tid(); const int lane = tid_ & 63, wid = tid_ >> 6;
    for (int row = bid * 8 + wid; row < TT; row += G * 8) {
        const bool lat = row < TL; const float* src = lat ? xlat + (size_t)row * 1024 : xctx + (size_t)(row - TL) * 1024; const int r = lat ? (row >> 12) : 8;
        f32x4 v[4]; float ss = 0.f;
#pragma unroll
        for (int j = 0; j < 4; ++j) { v[j] = *(const f32x4*)(src + 4 * lane + 256 * j); ss += (v[j].x * v[j].x + v[j].y * v[j].y) + (v[j].z * v[j].z + v[j].w * v[j].w); }
        const float rstd = rsqrtf(wave_sum(ss) * (1.f / 1024.f) + 1e-6f);
        const float* mr = mod + r * 3072;
#pragma unroll
        for (int j = 0; j < 4; ++j) { const int col = 4 * lane + 256 * j; const f32x4 g4 = *(const f32x4*)(gain + col), sh = *(const f32x4*)(mr + col), sc = *(const f32x4*)(mr + 1024 + col);
            const f32x4 y = v[j] * rstd * g4 * (sc + 1.f) + sh; u32x2 o; o.x = pkbf(y.x, y.y); o.y = pkbf(y.z, y.w);
            *(u32x2*)(Hb + (size_t)row * 1024 + col) = o; }
    }
}
__device__ __forceinline__ void final_phase(float* x, const float* gain, int G, int bid) {
    const int tid_ = opaque_tid(); const int lane = tid_ & 63, wid = tid_ >> 6;
    for (int row = bid * 8 + wid; row < TL; row += G * 8) {
        float* src = x + (size_t)row * 1024; f32x4 v[4]; float ss = 0.f;
#pragma unroll
        for (int j = 0; j < 4; ++j) { v[j] = *(const f32x4*)(src + 4 * lane + 256 * j); ss += (v[j].x * v[j].x + v[j].y * v[j].y) + (v[j].z * v[j].z + v[j].w * v[j].w); }
        const float rstd = rsqrtf(wave_sum(ss) * (1.f / 1024.f) + 1e-6f);
#pragma unroll
        for (int j = 0; j < 4; ++j) { const int col = 4 * lane + 256 * j; const f32x4 g4 = *(const f32x4*)(gain + col); *(f32x4*)(src + col) = v[j] * rstd * g4; }
    }
}
__device__ __forceinline__ void sh8(const bf16_t* P, size_t row, int co, bool hm, bool hp, const float* mu, float* out) {
    const u32x4 z4 = {0u, 0u, 0u, 0u};
    const u32x4 c0 = *(const u32x4*)(P + row * RWN + co);
    const u32x4 cm = hm ? *(const u32x4*)(P + (row - 1) * RWN + co) : z4;
    const u32x4 cp = hp ? *(const u32x4*)(P + (row + 1) * RWN + co) : z4;
    const f32x4 m0 = *(const f32x4*)(mu + co), m1 = *(const f32x4*)(mu + co + 4);
#pragma unroll
    for (int i = 0; i < 4; ++i) {
        const float a0 = bflo(c0[i]), a1 = bfhi(c0[i]);
        const float n0 = 0.5f * (bflo(cm[i]) + bflo(cp[i])), n1 = 0.5f * (bfhi(cm[i]) + bfhi(cp[i]));
        const float mu0 = (2 * i < 4) ? m0[(2 * i) & 3] : m1[(2 * i) & 3], mu1 = (2 * i + 1 < 4) ? m0[(2 * i + 1) & 3] : m1[(2 * i + 1) & 3];
        out[2 * i] = a0 + mu0 * (n0 - a0); out[2 * i + 1] = a1 + mu1 * (n1 - a1);
    }
}
template <int CTRL> __device__ __forceinline__ float dpp_f(float v) { return __int_as_float(__builtin_amdgcn_update_dpp(0, __float_as_int(v), CTRL, 0xf, 0xf, true)); }
__device__ __forceinline__ float sum8(float v) { v += dpp_f<0xB1>(v); v += dpp_f<0x4E>(v); v += dpp_f<0x141>(v); return v; }
__device__ __forceinline__ float fast_tanh(float x) { const float e = __expf(2.f * x); return 1.f - 2.f * __builtin_amdgcn_rcpf(e + 1.f); }
__device__ __forceinline__ float fast_sigmoid(float x) { return __builtin_amdgcn_rcpf(1.f + __expf(-x)); }
struct RwArgs { const bf16_t* P; bf16_t* Y0; bf16_t* Y1; float* BZ; const float *mu, *w0, *w_up, *a0, *a_up, *k_k, *k_a, *r_k; };
__device__ __forceinline__ void rwkv_scan(const RwArgs& A, LAS char* lds, int G, int bid) {
    const int tid = opaque_tid(), lane = tid & 63; const int q = __builtin_amdgcn_readfirstlane(tid >> 6);
    LAS float* sW = (LAS float*)lds; LAS float* sA = sW + 4096; LAS float* sB = sA + 4096; LAS float* sKD = sB + 4096; LAS float* sR = sKD + 4096; LAS float* sV = sR + 4096;
    LAS float* WUP = sV + 4096; LAS float* AUP = WUP + 4096; LAS float* PP = AUP + 4096; LAS float* YP = PP + 1024;
    const int s = tid >> 3, dg = tid & 7, d0 = dg * 8;
#pragma unroll 1
    for (int chain = bid; chain < 256; chain += G) {
        const int z = chain >> 7, b = (chain >> 4) & 7, hh = chain & 15;
        __syncthreads();
        for (int idx = tid; idx < 4096; idx += 512) { const int r = idx >> 6, d = idx & 63; WUP[idx] = A.w_up[(size_t)(z * 64 + r) * 1024 + hh * 64 + d]; AUP[idx] = A.a_up[(size_t)(z * 64 + r) * 1024 + hh * 64 + d]; }
        f32x2_t S2[4];
#pragma unroll
        for (int j = 0; j < 4; ++j) S2[j] = (f32x2_t){0.f, 0.f};
        bf16_t* Yz = z ? A.Y1 : A.Y0;
#pragma unroll 1
        for (int c = 0; c < 68; ++c) {
            asm volatile("" ::: "memory");
            const int sidx = c * 64 + s; int L, n, rowbase;
            if (c < 4) { L = 256; n = z ? (255 - sidx) : sidx; rowbase = TL + b * 256; }
            else { L = 4096; const int sl = sidx - 256; n = z ? (4095 - sl) : sl; rowbase = b * 4096; }
            const size_t row = (size_t)(rowbase + n); const bool hm = n > 0, hp = n < L - 1;
            float r8[8], k8[8], v8[8], t8[8];
            sh8(A.P, row, hh * 64 + d0, hm, hp, A.mu, r8);
            sh8(A.P, row, 1024 + hh * 64 + d0, hm, hp, A.mu, k8);
            sh8(A.P, row, 2048 + hh * 64 + d0, hm, hp, A.mu, v8);
#pragma unroll
            for (int i = 0; i < 8; ++i) { sR[s * 64 + d0 + i] = r8[i]; sV[s * 64 + d0 + i] = v8[i]; }
            sh8(A.P, row, 3072 + z * 64 + d0, hm, hp, A.mu, t8);
#pragma unroll
            for (int i = 0; i < 8; ++i) sB[s * 64 + d0 + i] = fast_tanh(t8[i]);
            sh8(A.P, row, 3200 + z * 64 + d0, hm, hp, A.mu, t8);
#pragma unroll
            for (int i = 0; i < 8; ++i) sA[s * 64 + d0 + i] = t8[i];
            __syncthreads();
            float accw[8], acca[8];
#pragma unroll
            for (int i = 0; i < 8; ++i) { accw[i] = 0.f; acca[i] = 0.f; }
#pragma unroll 4
            for (int r = 0; r < 64; ++r) { const float tw = sB[s * 64 + r], ta = sA[s * 64 + r];
                const f32x4 w0v = *(const LAS f32x4*)(WUP + r * 64 + d0), w1v = *(const LAS f32x4*)(WUP + r * 64 + d0 + 4);
                const f32x4 a0v = *(const LAS f32x4*)(AUP + r * 64 + d0), a1v = *(const LAS f32x4*)(AUP + r * 64 + d0 + 4);
#pragma unroll
                for (int i = 0; i < 4; ++i) { accw[i] += tw * w0v[i]; accw[4 + i] += tw * w1v[i]; acca[i] += ta * a0v[i]; acca[4 + i] += ta * a1v[i]; } }
            __syncthreads();
            {
                const int dcol = hh * 64 + d0; float kkr[8], ssq = 0.f, bz = 0.f;
#pragma unroll
                for (int i = 0; i < 8; ++i) { kkr[i] = k8[i] * A.k_k[dcol + i]; ssq += kkr[i] * kkr[i]; }
                ssq += __shfl_xor(ssq, 1); ssq += __shfl_xor(ssq, 2); ssq += __shfl_xor(ssq, 4);
                const float rs = rsqrtf(ssq + 1e-12f);
#pragma unroll
                for (int i = 0; i < 8; ++i) {
                    const float wpre = A.w0[z * 1024 + dcol + i] + accw[i]; const float x = -wpre;
                    const float sp = fmaxf(x, 0.f) + __logf(1.f + __expf(-fabsf(x)));
                    const float w = __expf(-__expf(-sp - 0.5f));
                    const float asig = fast_sigmoid(A.a0[z * 1024 + dcol + i] + acca[i]);
                    const float kk = kkr[i] * rs; const float kd = k8[i] * (1.f + (asig - 1.f) * A.k_a[dcol + i]);
                    sW[s * 64 + d0 + i] = w; sA[s * 64 + d0 + i] = -kk; sB[s * 64 + d0 + i] = kk * asig; sKD[s * 64 + d0 + i] = kd;
                    bz += r8[i] * kd * A.r_k[dcol + i];
                }
                bz += __shfl_xor(bz, 1); bz += __shfl_xor(bz, 2); bz += __shfl_xor(bz, 4);
                if (dg == 0) A.BZ[((size_t)z * TT + row) * 16 + hh] = bz;
            }
            __syncthreads();
            {
                const int rl = lane >> 3, cg = lane & 7, irow = 8 * q + rl;
                const LAS float* bw = sW + 8 * cg; const LAS float* ba_ = sA + 8 * cg; const LAS float* bb_ = sB + 8 * cg; const LAS float* bk = sKD + 8 * cg; const LAS float* br = sR + 8 * cg;
                LAS float* bv = sV + irow;
                f32x4 w0 = *(const LAS f32x4*)(bw), w1 = *(const LAS f32x4*)(bw + 4), a0 = *(const LAS f32x4*)(ba_), a1 = *(const LAS f32x4*)(ba_ + 4);
                f32x4 b0 = *(const LAS f32x4*)(bb_), b1 = *(const LAS f32x4*)(bb_ + 4), k0 = *(const LAS f32x4*)(bk), k1 = *(const LAS f32x4*)(bk + 4);
                f32x4 r0 = *(const LAS f32x4*)(br), r1 = *(const LAS f32x4*)(br + 4); float vi = bv[0];
#pragma unroll 2
                for (int st = 0; st < 64; ++st) {
                    const int on = ((st + 1) & 63) * 64;
                    const f32x4 nw0 = *(const LAS f32x4*)(bw + on), nw1 = *(const LAS f32x4*)(bw + on + 4), na0 = *(const LAS f32x4*)(ba_ + on), na1 = *(const LAS f32x4*)(ba_ + on + 4);
                    const f32x4 nb0 = *(const LAS f32x4*)(bb_ + on), nb1 = *(const LAS f32x4*)(bb_ + on + 4), nk0 = *(const LAS f32x4*)(bk + on), nk1 = *(const LAS f32x4*)(bk + on + 4);
                    const f32x4 nr0 = *(const LAS f32x4*)(br + on), nr1 = *(const LAS f32x4*)(br + on + 4); const float nvi = bv[on];
                    f32x2_t pp2 = S2[0] * (f32x2_t){a0[0], a0[1]};
                    pp2 = S2[1] * (f32x2_t){a0[2], a0[3]} + pp2; pp2 = S2[2] * (f32x2_t){a1[0], a1[1]} + pp2; pp2 = S2[3] * (f32x2_t){a1[2], a1[3]} + pp2;
                    const float sa = sum8(pp2.x + pp2.y);
                    const f32x2_t sa2 = {sa, sa}, v2 = {vi, vi};
                    S2[0] = S2[0] * (f32x2_t){w0[0], w0[1]} + sa2 * (f32x2_t){b0[0], b0[1]} + v2 * (f32x2_t){k0[0], k0[1]};
                    S2[1] = S2[1] * (f32x2_t){w0[2], w0[3]} + sa2 * (f32x2_t){b0[2], b0[3]} + v2 * (f32x2_t){k0[2], k0[3]};
                    S2[2] = S2[2] * (f32x2_t){w1[0], w1[1]} + sa2 * (f32x2_t){b1[0], b1[1]} + v2 * (f32x2_t){k1[0], k1[1]};
                    S2[3] = S2[3] * (f32x2_t){w1[2], w1[3]} + sa2 * (f32x2_t){b1[2], b1[3]} + v2 * (f32x2_t){k1[2], k1[3]};
                    f32x2_t y2 = S2[0] * (f32x2_t){r0[0], r0[1]};
                    y2 = S2[1] * (f32x2_t){r0[2], r0[3]} + y2; y2 = S2[2] * (f32x2_t){r1[0], r1[1]} + y2; y2 = S2[3] * (f32x2_t){r1[2], r1[3]} + y2;
                    const float yv = sum8(y2.x + y2.y);
                    if (cg == 0) bv[st * 64] = yv;
                    w0 = nw0; w1 = nw1; a0 = na0; a1 = na1; b0 = nb0; b1 = nb1; k0 = nk0; k1 = nk1; r0 = nr0; r1 = nr1; vi = nvi;
                }
            }
            __syncthreads();
            { u32x4 o; const LAS float* yr = sV + s * 64 + d0;
              o.x = pkbf(yr[0], yr[1]); o.y = pkbf(yr[2], yr[3]); o.z = pkbf(yr[4], yr[5]); o.w = pkbf(yr[6], yr[7]);
              *(u32x4*)(Yz + row * 1024 + hh * 64 + d0) = o; }
            __syncthreads();
        }
    }
}
__device__ __forceinline__ void rwkv_out(const RwArgs& A, const float* ln_w, const float* ln_b, bf16_t* OG, int G, int bid) {
    const int tid_ = opaque_tid(); const int lane = tid_ & 63, wid = tid_ >> 6; const int c0 = lane * 16, head = lane >> 2;
    for (int row = bid * 8 + wid; row < TT; row += G * 8) {
        const bool lat = row < TL; const int L = lat ? 4096 : 256; const int n = lat ? (row & 4095) : ((row - TL) & 255); const bool hm = n > 0, hp = n < L - 1;
        float y[16], vv[16];
        { const u32x4 a0 = *(const u32x4*)(A.Y0 + (size_t)row * 1024 + c0), a1 = *(const u32x4*)(A.Y0 + (size_t)row * 1024 + c0 + 8);
          const u32x4 b0 = *(const u32x4*)(A.Y1 + (size_t)row * 1024 + c0), b1 = *(const u32x4*)(A.Y1 + (size_t)row * 1024 + c0 + 8);
#pragma unroll
          for (int i = 0; i < 4; ++i) { y[2 * i] = bflo(a0[i]) + bflo(b0[i]); y[2 * i + 1] = bfhi(a0[i]) + bfhi(b0[i]); y[8 + 2 * i] = bflo(a1[i]) + bflo(b1[i]); y[8 + 2 * i + 1] = bfhi(a1[i]) + bfhi(b1[i]); } }
        float s1 = 0.f;
#pragma unroll
        for (int i = 0; i < 16; ++i) s1 += y[i];
        s1 += __shfl_xor(s1, 1); s1 += __shfl_xor(s1, 2); const float mean = s1 * (1.f / 64.f);
        float s2 = 0.f;
#pragma unroll
        for (int i = 0; i < 16; ++i) { y[i] -= mean; s2 += y[i] * y[i]; }
        s2 += __shfl_xor(s2, 1); s2 += __shfl_xor(s2, 2); const float rstd = rsqrtf(s2 * (1.f / 64.f) + 64e-5f);
        sh8(A.P, (size_t)row, 2048 + c0, hm, hp, A.mu, vv); sh8(A.P, (size_t)row, 2048 + c0 + 8, hm, hp, A.mu, vv + 8);
        const float bz = 0.5f * (A.BZ[(size_t)row * 16 + head] + A.BZ[((size_t)TT + row) * 16 + head]);
        const u32x4 z0 = *(const u32x4*)(A.P + (size_t)row * RWN + 3328 + c0), z1 = *(const u32x4*)(A.P + (size_t)row * RWN + 3328 + c0 + 8);
        float ov[16];
#pragma unroll
        for (int i = 0; i < 16; ++i) { const unsigned zw = (i < 8) ? z0[(i >> 1) & 3] : z1[(i >> 1) & 3]; const float zz = (i & 1) ? bfhi(zw) : bflo(zw);
            ov[i] = (y[i] * rstd * ln_w[c0 + i] + ln_b[c0 + i] + bz * vv[i]) * silu_f(zz); }
        u32x4 o0, o1; o0.x = pkbf(ov[0], ov[1]); o0.y = pkbf(ov[2], ov[3]); o0.z = pkbf(ov[4], ov[5]); o0.w = pkbf(ov[6], ov[7]);
        o1.x = pkbf(ov[8], ov[9]); o1.y = pkbf(ov[10], ov[11]); o1.z = pkbf(ov[12], ov[13]); o1.w = pkbf(ov[14], ov[15]);
        *(u32x4*)(OG + (size_t)row * 1024 + c0) = o0; *(u32x4*)(OG + (size_t)row * 1024 + c0 + 8) = o1;
    }
}
#ifdef SKIP_GEMM
#define GEMM_PHASE(EPI, AP, BP, MM, NN, KK, EOBJ) do { (void)EOBJ; } while (0)
#else
#define GEMM_PHASE(EPI, AP, BP, MM, NN, KK, EOBJ) do { pg8::Gemm g_{(const bf16_t*)(AP), (const bf16_t*)(BP), (MM), (NN), (KK)}; pg8::StaticOrder S_; S_.init((MM), (NN), G, bid); \
    pg8::gemm_phase<EPI, pg8::StaticOrder, true, true>((PG8_LAS unsigned char*)lds, g_, S_, EOBJ); } while (0)
#endif
#ifdef SKIP_EpiAttnIn
#define GEMM_PHASE_EpiAttnIn(EPI, AP, BP, MM, NN, KK, EOBJ) do { (void)EOBJ; } while (0)
#else
#define GEMM_PHASE_EpiAttnIn GEMM_PHASE
#endif
#ifdef SKIP_EpiFnT
#define GEMM_PHASE_EpiFnT(EPI, AP, BP, MM, NN, KK, EOBJ) do { (void)EOBJ; } while (0)
#else
#define GEMM_PHASE_EpiFnT GEMM_PHASE
#endif
#ifdef SKIP_EpiPlain
#define GEMM_PHASE_EpiPlain(EPI, AP, BP, MM, NN, KK, EOBJ) do { (void)EOBJ; } while (0)
#else
#define GEMM_PHASE_EpiPlain GEMM_PHASE
#endif
#ifdef SKIP_EpiDft
#define GEMM_PHASE_EpiDft(EPI, AP, BP, MM, NN, KK, EOBJ) do { (void)EOBJ; } while (0)
#else
#define GEMM_PHASE_EpiDft GEMM_PHASE
#endif
#ifdef SKIP_EpiResid
#define GEMM_PHASE_EpiResid(EPI, AP, BP, MM, NN, KK, EOBJ) do { (void)EOBJ; } while (0)
#else
#define GEMM_PHASE_EpiResid GEMM_PHASE
#endif
template <int layer> __device__ __forceinline__ void layer_body(const Params& p, LAS char* lds, cg::grid_group& grid, int G, int bid) {
    unsigned char* ws = p.ws;
    float* mod = (float*)(ws + WS_MOD);
    const float* ropeC = (const float*)(ws + WS_ROPE); const float* ropeS = ropeC + 1024;
    bf16_t* Hb = (bf16_t*)(ws + WS_HB);
    float* XC = (float*)(ws + WS_XC);
    const float* x_in = p.in[0]; const float* ctx_in = p.in[2];
        const float* xl = layer == 0 ? x_in : p.out; const float* xc = layer == 0 ? ctx_in : XC;
        const float* modl = mod + (size_t)layer * 9 * 3072;
        ph_phase(xl, xc, p.in[4] + layer * 1024, modl, Hb, G, bid);
        grid.sync();
        const int Mout = (layer == 3) ? TL : TT;
        const bf16_t* Wout;
        if constexpr (layer == 0 || layer == 3) {
            const int j = layer == 0 ? 0 : 1;
            pg8::EpiAttnIn E{(bf16_t*)(ws + WS_Q), (bf16_t*)(ws + WS_K), (bf16_t*)(ws + WS_V), (bf16_t*)(ws + WS_Z), ropeC, ropeS};
            GEMM_PHASE_EpiAttnIn(pg8::EpiAttnIn, Hb, ws + WS_WDAIN + (size_t)j * 8 * MiB, TT, 4096, 1024, E);
            grid.sync();
            float lam;
            { const int lane = opaque_tid() & 63; const float* lq = p.in[9] + j * 128; const float* lk = p.in[10] + j * 128;
              const float s0 = wave_sum(lq[lane] * lk[lane]), s1 = wave_sum(lq[64 + lane] * lk[64 + lane]);
              const float li = 0.8f - 0.6f * expf(-0.3f * (float)layer); lam = expf(s0) - expf(s1) + li;
              att::Args A{(const bf16_t*)(ws + WS_Q), (const bf16_t*)(ws + WS_K), (const bf16_t*)(ws + WS_V), (const bf16_t*)(ws + WS_Z), Hb, p.in[11] + j * 128, lam, 1.f - li, layer == 3 ? 1024 : 1088};
#ifndef SKIP_ATT
              att::attn_phase(A, lds, G, bid);
#endif
#ifdef PROBE_ATT2
              att::attn_phase(A, lds, G, bid);
#endif
            }
            grid.sync();
            Wout = (const bf16_t*)(ws + WS_WDAOUT + (size_t)j * 2 * MiB);
        } else if constexpr (layer == 1) {
            { pg8::EpiFnT E{(bf16_t*)(ws + WS_ATL), (bf16_t*)(ws + WS_ATC)};
              GEMM_PHASE_EpiFnT(pg8::EpiFnT, ws + WS_WFNT, Hb, 2048, TT, 1024, E); }
            { pg8::EpiPlain E{(bf16_t*)(ws + WS_ZB), 1024};
              GEMM_PHASE_EpiPlain(pg8::EpiPlain, Hb, ws + WS_WFNZ, TT, 1024, 1024, E); }
            grid.sync();
            { pg8::EpiDft E{(const bf16_t*)(ws + WS_ZB), Hb, 0, 4096};
              GEMM_PHASE_EpiDft(pg8::EpiDft, ws + WS_DFTL, ws + WS_ATL, 4096, 8192, 8192, E); }
            { pg8::EpiDft E{(const bf16_t*)(ws + WS_ZB), Hb, TL, 256};
              GEMM_PHASE_EpiDft(pg8::EpiDft, ws + WS_DFTC, ws + WS_ATC, 256, 8192, 512, E); }
            grid.sync();
            Wout = (const bf16_t*)(ws + WS_WFNOUT);
        } else {
            { pg8::EpiPlain E{(bf16_t*)(ws + WS_P), RWN};
              GEMM_PHASE_EpiPlain(pg8::EpiPlain, Hb, ws + WS_WRWIN, TT, RWN, 1024, E); }
            grid.sync();
            RwArgs A{(const bf16_t*)(ws + WS_P), Hb, (bf16_t*)(ws + WS_Y1), (float*)(ws + WS_BZ), p.in[17], p.in[18], p.in[19], p.in[20], p.in[21], p.in[22], p.in[23], p.in[24]};
#ifndef SKIP_SCAN
            rwkv_scan(A, lds, G, bid);
#endif
#ifdef PROBE_SCAN2
            rwkv_scan(A, lds, G, bid);
#endif
            grid.sync();
#ifndef SKIP_RWOUT
            rwkv_out(A, p.in[25], p.in[26], Hb, G, bid);
#endif
            grid.sync();
            Wout = (const bf16_t*)(ws + WS_WRWOUT);
        }
        { pg8::EpiResid E{xl, xc, p.out, XC, modl + 2048};
          GEMM_PHASE_EpiResid(pg8::EpiResid, Hb, Wout, Mout, 1024, 1024, E); }
        grid.sync();
    }
__global__ void __launch_bounds__(512, 2) fwd_megakernel(Params p) {
    extern __shared__ __attribute__((aligned(16))) unsigned char lds_raw[];
    LAS char* lds = (LAS char*)lds_raw;
    cg::grid_group grid = cg::this_grid();
    const int G = gridDim.x, bid = blockIdx.x;
    unsigned char* ws = p.ws;
    float* mod = (float*)(ws + WS_MOD);
    const float* ropeC = (const float*)(ws + WS_ROPE); const float* ropeS = ropeC + 1024;
    bf16_t* Hb = (bf16_t*)(ws + WS_HB);
    float* XC = (float*)(ws + WS_XC);
    const float* x_in = p.in[0]; const float* ctx_in = p.in[2];

#ifndef SKIP_PRO
    prologue(p, lds, G, bid);
#endif
#ifdef PROBE_PRO2
    __syncthreads(); prologue(p, lds, G, bid);
#endif
    grid.sync();
    layer_body<0>(p, lds, grid, G, bid);
    layer_body<1>(p, lds, grid, G, bid);
    layer_body<2>(p, lds, grid, G, bid);
    layer_body<3>(p, lds, grid, G, bid);
    final_phase(p.out, p.in[7], G, bid);
}

extern "C" void kernel_launch(void* const* d_in, const int* in_sizes, int n_in, void* d_out, int out_size, void* d_ws, size_t ws_size, hipStream_t stream) {
    static int grid = 0;
    if (grid == 0) {
        if (n_in != 28 || out_size != TL * 1024 || ws_size < WS_END) { fprintf(stderr, "kernel_launch: unexpected shapes: n_in %d out %d ws %zu\n", n_in, out_size, ws_size); grid = -1; return; }
        int dev = 0, cus = 0, per_cu = 0;
        hipGetDevice(&dev); hipDeviceGetAttribute(&cus, hipDeviceAttributeMultiprocessorCount, dev);
        if (hipFuncSetAttribute((const void*)fwd_megakernel, hipFuncAttributeMaxDynamicSharedMemorySize, LDS_BYTES) != hipSuccess) { fprintf(stderr, "kernel_launch: hipFuncSetAttribute failed\n"); grid = -1; return; }
        if (hipOccupancyMaxActiveBlocksPerMultiprocessor(&per_cu, (const void*)fwd_megakernel, 512, LDS_BYTES) != hipSuccess || per_cu < 1) { fprintf(stderr, "kernel_launch: occupancy query failed (%d)\n", per_cu); per_cu = 1; }
        (void)hipGetLastError();
        grid = cus * per_cu;
    }
    if (grid < 0) return;
    Params p{};
    for (int i = 0; i < 28; ++i) p.in[i] = (const float*)d_in[i];
    p.out = (float*)d_out; p.ws = (unsigned char*)d_ws;
    void* args[] = {&p};
    hipError_t e = hipLaunchCooperativeKernel((const void*)fwd_megakernel, dim3(grid), dim3(512), args, LDS_BYTES, stream);
    if (e != hipSuccess) fprintf(stderr, "cooperative launch failed: %s (grid %d)\n", hipGetErrorString(e), grid);
}
```

```cpp
#include <hip/hip_runtime.h>
#include <hip/hip_cooperative_groups.h>
#include <cstdio>
#include <cstdint>
#include <cmath>
namespace cg = cooperative_groups;

constexpr int TL = 32768, TCX = 2048, TT = TL + TCX, DM = 1024;
constexpr float QK_C2 = 0.125f * 1.4426950408889634f;
typedef float f32x2_t __attribute__((ext_vector_type(2)));
typedef __bf16 bf16x2_t __attribute__((ext_vector_type(2)));
__device__ __forceinline__ unsigned pkbf(float lo, float hi) { f32x2_t v = {lo, hi}; bf16x2_t b = __builtin_convertvector(v, bf16x2_t); return __builtin_bit_cast(unsigned, b); }
__device__ __forceinline__ float bflo(unsigned u) { return __uint_as_float(u << 16); }
__device__ __forceinline__ float bfhi(unsigned u) { return __uint_as_float(u & 0xffff0000u); }
__device__ __forceinline__ float bf1(unsigned short u) { return __uint_as_float(((unsigned)u) << 16); }
__device__ __forceinline__ float silu_f(float z) { return z * __builtin_amdgcn_rcpf(1.f + __expf(-z)); }
__device__ __forceinline__ int opaque_tid() { int t = threadIdx.x; asm volatile("" : "+v"(t)); return t; }
namespace pg8 {
#define PG8_LAS __attribute__((address_space(3)))
typedef unsigned short bf16_t;
typedef short bf16x8 __attribute__((ext_vector_type(8)));
typedef float f32x4 __attribute__((ext_vector_type(4)));
typedef unsigned u32x4 __attribute__((ext_vector_type(4)));
constexpr int BM = 256, BK = 64, HALF = 128, HTB = HALF * BK * 2  , STAGE_BYTES = 8 * HTB, NXCD = 8, WGM = 8;

__host__ __device__ __forceinline__ int lds_byte(int r, int c) { const int st = (r >> 4) * 2 + (c >> 5), rr = r & 15, cc = c & 31, ob = rr * 64 + cc * 2; return st * 1024 + (ob ^ (((ob >> 9) & 1) << 5)); }
__host__ __device__ __forceinline__ void stage_rc(int b, int& R, int& C) { const int st = b / 1024, sb = b % 1024, swz = sb ^ (((sb >> 9) & 1) << 5); R = (st >> 1) * 16 + swz / 64; C = (st & 1) * 32 + (swz % 64) / 2; }
__host__ __device__ __forceinline__ int perm32(int rho) { const int n = rho >> 4, i = rho & 15; return 8 * (i >> 2) + 4 * n + (i & 3); }

struct Unit { int pm, pn; };
struct Gemm { const bf16_t* A; const bf16_t* Bt; int M, N, K; };

struct StaticOrder {
    int nM, nN, nwg, G, c;
    __host__ __device__ void init(int M, int N, int G_, int c_) { nM = M / BM; nN = N / BM; nwg = nM * nN; G = G_; c = c_; }
    __host__ __device__ bool next(int i, Unit& u) const {
        const long L = (long)i * G + c; if (L >= nwg) return false;
        int wgid = (int)L; { const int q = nwg / NXCD, r = nwg % NXCD, xcd = wgid % NXCD, off = wgid / NXCD; wgid = (xcd < r ? xcd * (q + 1) : r * (q + 1) + (xcd - r) * q) + off; }
        const int nig = WGM * nN, gid = wgid / nig, fm = gid * WGM, gsz = (nM - fm) < WGM ? (nM - fm) : WGM;
        u.pm = fm + ((wgid % nig) % gsz); u.pn = (wgid % nig) / gsz; return true;
    }
    __device__ __forceinline__ void a_ready(const Unit&) const {}
    __device__ __forceinline__ void done(const Unit&) const {}
};

struct EpiAttnIn {
    static constexpr bool PERM = true, AFTER_DRAIN = false;
    bf16_t* Q; bf16_t* Kb; bf16_t* V; bf16_t* Z; const float* ropeC; const float* ropeS;
    __device__ __forceinline__ void operator()(const f32x4 (&acc)[2][2][4][2], const Unit& u, int wr, int wc, int fr, int fq) const {
        const int sect = u.pn >> 2;
        bf16_t* base = sect == 0 ? Q : sect == 1 ? Kb : sect == 2 ? V : Z;
        const int colt = (u.pn & 3) * 256 + wc * 32 + 8 * fq;
        const int row0 = u.pm * BM + wr * 64 + fr;
        const bool rope = (u.pm < 128) && (sect < 2);
        const float sc = (sect == 0) ? QK_C2 : 1.f;
        const int axis = wc & 1;
#pragma unroll
        for (int ai = 0; ai < 2; ++ai)
#pragma unroll
            for (int m = 0; m < 4; ++m) {
                const int row = row0 + ai * HALF + m * 16;
                const int ntok = row & 4095;
                const int pos = axis ? (ntok & 63) : (ntok >> 6);
                bf16_t* rowp = base + (size_t)row * 1024 + colt;
#pragma unroll
                for (int bj = 0; bj < 2; ++bj) {
                    f32x4 v0 = acc[ai][bj][m][0], v1 = acc[ai][bj][m][1];
                    if (rope) {
                        const f32x4 c0 = *(const f32x4*)(ropeC + pos * 16 + 8 * (fq & 1)), c1 = *(const f32x4*)(ropeC + pos * 16 + 8 * (fq & 1) + 4);
                        const f32x4 s0 = *(const f32x4*)(ropeS + pos * 16 + 8 * (fq & 1)), s1 = *(const f32x4*)(ropeS + pos * 16 + 8 * (fq & 1) + 4);
                        f32x4 p0, p1;
#pragma unroll
                        for (int i = 0; i < 4; ++i) { p0[i] = __shfl_xor(v0[i], 32); p1[i] = __shfl_xor(v1[i], 32); }
                        if (fq < 2) { v0 = v0 * c0 - p0 * s0; v1 = v1 * c1 - p1 * s1; }
                        else        { v0 = v0 * c0 + p0 * s0; v1 = v1 * c1 + p1 * s1; }
                    }
                    v0 = v0 * sc; v1 = v1 * sc;
                    u32x4 w; w.x = pkbf(v0[0], v0[1]); w.y = pkbf(v0[2], v0[3]); w.z = pkbf(v1[0], v1[1]); w.w = pkbf(v1[2], v1[3]);
                    *(u32x4*)(rowp + bj * HALF) = w;
                }
            }
    }
};
struct EpiPlain {
    static constexpr bool PERM = true, AFTER_DRAIN = false;
    bf16_t* O; int ldc;
    __device__ __forceinline__ void operator()(const f32x4 (&acc)[2][2][4][2], const Unit& u, int wr, int wc, int fr, int fq) const {
        const int row0 = u.pm * BM + wr * 64 + fr, col0 = u.pn * BM + wc * 32 + 8 * fq;
#pragma unroll
        for (int ai = 0; ai < 2; ++ai)
#pragma unroll
            for (int m = 0; m < 4; ++m) { bf16_t* rowp = O + (size_t)(row0 + ai * HALF + m * 16) * ldc + col0;
#pragma unroll
                for (int bj = 0; bj < 2; ++bj) { const f32x4 v0 = acc[ai][bj][m][0], v1 = acc[ai][bj][m][1];
                    u32x4 w; w.x = pkbf(v0[0], v0[1]); w.y = pkbf(v0[2], v0[3]); w.z = pkbf(v1[0], v1[1]); w.w = pkbf(v1[2], v1[3]);
                    *(u32x4*)(rowp + bj * HALF) = w; } }
    }
};
struct EpiResid {
    static constexpr bool PERM = false, AFTER_DRAIN = false;
    const float* xin_lat; const float* xin_ctx; float* xout_lat; float* xout_ctx; const float* gate;
    __device__ __forceinline__ void operator()(const f32x4 (&acc)[2][2][4][2], const Unit& u, int wr, int wc, int fr, int fq) const {
        const int row0 = u.pm * BM + wr * 64 + fr, col0 = u.pn * BM + wc * 32 + 4 * fq;
#pragma unroll
        for (int ai = 0; ai < 2; ++ai)
#pragma unroll
            for (int m = 0; m < 4; ++m) {
                const int row = row0 + ai * HALF + m * 16; const bool lat = row < TL; const int r = lat ? (row >> 12) : 8;
                const float* xi = lat ? xin_lat + (size_t)row * 1024 : xin_ctx + (size_t)(row - TL) * 1024;
                float* xo = lat ? xout_lat + (size_t)row * 1024 : xout_ctx + (size_t)(row - TL) * 1024;
                const float* g = gate + r * 3072;
#pragma unroll
                for (int bj = 0; bj < 2; ++bj)
#pragma unroll
                    for (int n = 0; n < 2; ++n) { const int col = col0 + bj * HALF + n * 16;
                        const f32x4 g4 = *(const f32x4*)(g + col), x4 = *(const f32x4*)(xi + col);
                        *(f32x4*)(xo + col) = x4 + g4 * acc[ai][bj][m][n]; }
            }
    }
};
struct EpiFnT {
    static constexpr bool PERM = true, AFTER_DRAIN = false;
    bf16_t* ATL; bf16_t* ATC;
    __device__ __forceinline__ void operator()(const f32x4 (&acc)[2][2][4][2], const Unit& u, int wr, int wc, int fr, int fq) const {
        const int row0 = u.pm * BM + wr * 64 + fr, col0 = u.pn * BM + wc * 32 + 8 * fq;
#pragma unroll
        for (int ai = 0; ai < 2; ++ai)
#pragma unroll
            for (int m = 0; m < 4; ++m) { const int mp = row0 + ai * HALF + m * 16, cs = mp >> 10, n = mp & 1023;
#pragma unroll
                for (int bj = 0; bj < 2; ++bj) { const int t0 = col0 + bj * HALF; bf16_t* dst;
                    if (t0 < TL) { const int b = t0 >> 12, l = t0 & 4095; dst = ATL + ((size_t)((b * 1024 + n) * 2 + cs)) * 4096 + l; }
                    else { const int tc = t0 - TL, b = tc >> 8, l = tc & 255; dst = ATC + ((size_t)((b * 1024 + n) * 2 + cs)) * 256 + l; }
                    const f32x4 v0 = acc[ai][bj][m][0], v1 = acc[ai][bj][m][1];
                    u32x4 w; w.x = pkbf(v0[0], v0[1]); w.y = pkbf(v0[2], v0[3]); w.z = pkbf(v1[0], v1[1]); w.w = pkbf(v1[2], v1[3]);
                    *(u32x4*)dst = w; } }
    }
};
struct EpiDft {
    static constexpr bool PERM = true, AFTER_DRAIN = false;
    const bf16_t* Z; bf16_t* OG; int rowbase; int L;
    __device__ __forceinline__ void operator()(const f32x4 (&acc)[2][2][4][2], const Unit& u, int wr, int wc, int fr, int fq) const {
        const int k0 = u.pm * BM + wr * 64 + fr; const int b = u.pn >> 2; const int n0 = (u.pn & 3) * 256 + wc * 32 + 8 * fq;
#pragma unroll
        for (int ai = 0; ai < 2; ++ai)
#pragma unroll
            for (int m = 0; m < 4; ++m) { const size_t R = (size_t)(rowbase + b * L + k0 + ai * HALF + m * 16);
#pragma unroll
                for (int bj = 0; bj < 2; ++bj) { const size_t off = R * 1024 + n0 + bj * HALF;
                    const u32x4 zz = *(const u32x4*)(Z + off);
                    const f32x4 v0 = acc[ai][bj][m][0], v1 = acc[ai][bj][m][1];
                    u32x4 w;
                    w.x = pkbf(v0[0] * silu_f(bflo(zz.x)), v0[1] * silu_f(bfhi(zz.x))); w.y = pkbf(v0[2] * silu_f(bflo(zz.y)), v0[3] * silu_f(bfhi(zz.y)));
                    w.z = pkbf(v1[0] * silu_f(bflo(zz.z)), v1[1] * silu_f(bfhi(zz.z))); w.w = pkbf(v1[2] * silu_f(bflo(zz.w)), v1[3] * silu_f(bfhi(zz.w)));
                    *(u32x4*)(OG + off) = w; } }
    }
};
template <class Epi, class Sched, bool ALIGN_EPI = false, bool SP2 = false>
__device__ __forceinline__ void gemm_phase(PG8_LAS unsigned char* lds, const Gemm g, const Sched& S, const Epi& E) {
    const int tid = opaque_tid(), wid = __builtin_amdgcn_readfirstlane(tid >> 6), lane = tid & 63, wr = wid >> 2, wc = wid & 3, fr = lane & 15, fq = lane >> 4;
    const int K = g.K, nt = K / BK;
    unsigned voffA[2], voffB[2];
#pragma unroll
    for (int i = 0; i < 2; ++i) { int R, C; stage_rc(tid * 16 + i * 8192, R, C); const int Rb = Epi::PERM ? ((R & ~31) + perm32(R & 31)) : R;
        voffA[i] = (unsigned)(R * K + C) * 2u; voffB[i] = (unsigned)(Rb * K + C) * 2u; }
    const size_t kstep = (size_t)(BK * 2);
    const size_t hstep = (size_t)HALF * K * 2;
    const size_t tstep = 2 * hstep;
    const unsigned ldsw = (unsigned)wid * 1024u;
    const int aoff = lds_byte(wr * 64 + fr, fq * 8), boff = lds_byte(wc * 32 + fr, fq * 8);
#define PG8_SA(b, h) (((b) * 2 + (h)) * HTB)
#define PG8_SB(b, h) ((4 + (b) * 2 + (h)) * HTB)
#define PG8_STAGE(bufoff, gbase, voff) do { _Pragma("unroll") for (int _i = 0; _i < 2; ++_i) \
        __builtin_amdgcn_global_load_lds((const unsigned*)((const char*)(gbase) + (voff)[_i]), (PG8_LAS unsigned*)(lds + (bufoff) + ldsw + _i * 8192), 16, 0, 0); } while (0)
#define PG8_LDA(dst, b, h) do { _Pragma("unroll") for (int m = 0; m < 4; ++m) _Pragma("unroll") for (int k = 0; k < 2; ++k) dst[m][k] = *(const PG8_LAS bf16x8*)(lds + PG8_SA(b, h) + aoff + m * 2048 + k * 1024); } while (0)
#define PG8_LDB(dst, b, h) do { _Pragma("unroll") for (int n = 0; n < 2; ++n) _Pragma("unroll") for (int k = 0; k < 2; ++k) dst[n][k] = *(const PG8_LAS bf16x8*)(lds + PG8_SB(b, h) + boff + n * 2048 + k * 1024); } while (0)
#define PG8_MMA(ai, bj, At, Bt) do { __builtin_amdgcn_s_setprio(1); _Pragma("unroll") for (int m = 0; m < 4; ++m) _Pragma("unroll") for (int n = 0; n < 2; ++n) _Pragma("unroll") for (int k = 0; k < 2; ++k) \
        acc[ai][bj][m][n] = __builtin_amdgcn_mfma_f32_16x16x32_bf16(Bt[n][k], At[m][k], acc[ai][bj][m][n], 0, 0, 0); __builtin_amdgcn_s_setprio(0); } while (0)
#define PG8_WAIT_V(n) asm volatile("s_waitcnt vmcnt(" #n ")" ::: "memory")
#define PG8_WAIT_L(n) asm volatile("s_waitcnt lgkmcnt(" #n ")" ::: "memory")
#define PG8_BAR __builtin_amdgcn_s_barrier()
#define PG8_SCHED __builtin_amdgcn_sched_barrier(0)
    Unit cur, nxt; int ui = 0;
    if (!S.next(0, cur)) return;
    f32x4 acc[2][2][4][2];
#pragma unroll
    for (int a = 0; a < 2; ++a)
#pragma unroll
        for (int b = 0; b < 2; ++b)
#pragma unroll
            for (int m = 0; m < 4; ++m)
#pragma unroll
                for (int n = 0; n < 2; ++n) acc[a][b][m][n] = (f32x4){0.f, 0.f, 0.f, 0.f};
    bf16x8 At[4][2], B0[2][2], B1[2][2];
    const char* cA = (const char*)g.A + (size_t)cur.pm * tstep; const char* cB = (const char*)g.Bt + (size_t)cur.pn * tstep;
    S.a_ready(cur);
    if constexpr (SP2) {
        PG8_STAGE(PG8_SB(0, 0), cB, voffB); PG8_STAGE(PG8_SB(0, 1), cB + hstep, voffB); PG8_STAGE(PG8_SA(0, 0), cA, voffA); PG8_STAGE(PG8_SA(0, 1), cA + hstep, voffA);
        if (wr == 1) PG8_BAR;
        PG8_WAIT_V(2); PG8_BAR;
        PG8_STAGE(PG8_SB(1, 0), cB + kstep, voffB); PG8_STAGE(PG8_SA(1, 0), cA + kstep, voffA); PG8_STAGE(PG8_SB(1, 1), cB + hstep + kstep, voffB);
        PG8_WAIT_V(6); PG8_BAR;
    } else {
        PG8_STAGE(PG8_SB(0, 0), cB, voffB); PG8_STAGE(PG8_SA(0, 0), cA, voffA); PG8_STAGE(PG8_SB(0, 1), cB + hstep, voffB); PG8_STAGE(PG8_SA(0, 1), cA + hstep, voffA);
        if (wr == 1) PG8_BAR;
        PG8_WAIT_V(4); PG8_BAR;
        PG8_STAGE(PG8_SB(1, 0), cB + kstep, voffB); PG8_STAGE(PG8_SA(1, 0), cA + kstep, voffA); PG8_STAGE(PG8_SB(1, 1), cB + hstep + kstep, voffB);
        PG8_WAIT_V(6); PG8_BAR;
    }
    for (;;) {
        const bool has_next = S.next(ui + 1, nxt);
        const char* nA = has_next ? (const char*)g.A + (size_t)nxt.pm * tstep : cA; const char* nB = has_next ? (const char*)g.Bt + (size_t)nxt.pn * tstep : cB;
        for (int t = 0; t < nt; t += 2) {
            const bool last = (t == nt - 2);
            const char* a1 = cA + (size_t)(t + 1) * kstep;
            const char* a2 = last ? nA : cA + (size_t)(t + 2) * kstep; const char* b2 = last ? nB : cB + (size_t)(t + 2) * kstep;
            const char* a3 = a2 + kstep; const char* b3 = b2 + kstep;
            if (last && has_next) S.a_ready(nxt);
            if constexpr (SP2) {
            PG8_LDB(B0, 0, 0); PG8_LDB(B1, 0, 1); PG8_SCHED; PG8_LDA(At, 0, 0); PG8_STAGE(PG8_SA(1, 1), a1 + hstep, voffA);
            PG8_WAIT_V(8); PG8_WAIT_L(0); PG8_BAR; PG8_MMA(0, 0, At, B0); PG8_MMA(0, 1, At, B1); PG8_BAR; PG8_SCHED;
            PG8_LDA(At, 0, 1); PG8_STAGE(PG8_SB(0, 0), b2, voffB); PG8_STAGE(PG8_SB(0, 1), b2 + hstep, voffB); PG8_STAGE(PG8_SA(0, 0), a2, voffA);
            PG8_WAIT_V(8); PG8_WAIT_L(0); PG8_BAR; PG8_MMA(1, 0, At, B0); PG8_MMA(1, 1, At, B1); PG8_BAR; PG8_SCHED;
            PG8_LDB(B0, 1, 0); PG8_LDB(B1, 1, 1); PG8_SCHED; PG8_LDA(At, 1, 0); PG8_STAGE(PG8_SA(0, 1), a2 + hstep, voffA);
            PG8_WAIT_V(8); PG8_WAIT_L(0); PG8_BAR; PG8_MMA(0, 0, At, B0); PG8_MMA(0, 1, At, B1); PG8_BAR; PG8_SCHED;
            PG8_LDA(At, 1, 1); PG8_STAGE(PG8_SB(1, 0), b3, voffB); PG8_STAGE(PG8_SB(1, 1), b3 + hstep, voffB); PG8_STAGE(PG8_SA(1, 0), a3, voffA);
            PG8_WAIT_V(8); PG8_WAIT_L(0); PG8_BAR; PG8_MMA(1, 0, At, B0); PG8_MMA(1, 1, At, B1); PG8_BAR; PG8_SCHED;
            } else {
            PG8_LDB(B0, 0, 0); PG8_SCHED; PG8_LDA(At, 0, 0); PG8_STAGE(PG8_SA(1, 1), a1 + hstep, voffA);
            PG8_WAIT_L(8); PG8_BAR; PG8_WAIT_L(0); PG8_MMA(0, 0, At, B0); PG8_BAR; PG8_SCHED;
            PG8_LDB(B1, 0, 1); PG8_STAGE(PG8_SB(0, 0), b2, voffB);
            PG8_BAR; PG8_WAIT_L(0); PG8_MMA(0, 1, At, B1); PG8_BAR;
            PG8_LDA(At, 0, 1); PG8_STAGE(PG8_SA(0, 0), a2, voffA);
            PG8_BAR; PG8_WAIT_L(0); PG8_MMA(1, 0, At, B0); PG8_BAR; PG8_SCHED;
            PG8_STAGE(PG8_SB(0, 1), b2 + hstep, voffB);
            PG8_WAIT_V(6); PG8_BAR; PG8_MMA(1, 1, At, B1); PG8_BAR;
            PG8_LDB(B0, 1, 0); PG8_SCHED; PG8_LDA(At, 1, 0); PG8_STAGE(PG8_SA(0, 1), a2 + hstep, voffA);
            PG8_WAIT_L(8); PG8_BAR; PG8_WAIT_L(0); PG8_MMA(0, 0, At, B0); PG8_BAR; PG8_SCHED;
            PG8_LDB(B1, 1, 1); PG8_STAGE(PG8_SB(1, 0), b3, voffB);
            PG8_BAR; PG8_WAIT_L(0); PG8_MMA(0, 1, At, B1); PG8_BAR;
            PG8_LDA(At, 1, 1); PG8_STAGE(PG8_SA(1, 0), a3, voffA);
            PG8_BAR; PG8_WAIT_L(0); PG8_MMA(1, 0, At, B0); PG8_BAR; PG8_SCHED;
            PG8_STAGE(PG8_SB(1, 1), b3 + hstep, voffB);
            PG8_WAIT_V(6); PG8_BAR; PG8_MMA(1, 1, At, B1); PG8_BAR;
            }
        }
        if constexpr (ALIGN_EPI) { if (wr == 0) PG8_BAR; }
        if constexpr (!Epi::AFTER_DRAIN) { E(acc, cur, wr, wc, fr, fq); S.done(cur); }
        if (!has_next) break;
#pragma unroll
        for (int a = 0; a < 2; ++a)
#pragma unroll
            for (int b = 0; b < 2; ++b)
#pragma unroll
                for (int m = 0; m < 4; ++m)
#pragma unroll
                    for (int n = 0; n < 2; ++n) acc[a][b][m][n] = (f32x4){0.f, 0.f, 0.f, 0.f};
        cur = nxt; cA = nA; cB = nB; ++ui;
        if constexpr (ALIGN_EPI) { if (wr == 1) PG8_BAR; }
    }
    PG8_WAIT_V(0);
    if constexpr (!ALIGN_EPI) { if (wr == 0) PG8_BAR; }
    PG8_BAR;
    if constexpr (Epi::AFTER_DRAIN) { E.fused(acc, cur, wr, wc, fr, fq, lds, wid, lane); S.done(cur); }
#undef PG8_SA
#undef PG8_SB
#undef PG8_STAGE
#undef PG8_LDA
#undef PG8_LDB
#undef PG8_MMA
#undef PG8_WAIT_V
#undef PG8_WAIT_L
#undef PG8_BAR
#undef PG8_SCHED
}
}
#define LAS __attribute__((address_space(3)))
namespace att {
using bf16x8 = __attribute__((ext_vector_type(8))) short;
using s16x4 = __attribute__((ext_vector_type(4))) short;
using f32x16 = __attribute__((ext_vector_type(16))) float;
using u32x4 = __attribute__((ext_vector_type(4))) unsigned;
typedef unsigned short bf16_t;
__device__ __forceinline__ int crow(int r, int hi) { return (r & 3) + 8 * (r >> 2) + 4 * hi; }
constexpr int KSLOT = 8192, VSLOT = 16384, LDS_K = 0, LDS_V = 2 * KSLOT, LDS_WS = LDS_V + 3 * VSLOT, LDS_O1 = LDS_WS + 2048;
struct Args { const bf16_t* Q; const bf16_t* K; const bf16_t* V; const bf16_t* Z; bf16_t* O; const float* gain; float lam; float oml; int n_units; };

__device__ __forceinline__ void qkt(f32x16& p0, f32x16& p1, const LAS char* Kslot, const bf16x8* qr, const f32x16& negm, int r32, int hi) {
    const LAS char* kb = Kslot + hi * 1024 + r32 * 16;
    bf16x8 kf[8];
#pragma unroll
    for (int d0 = 0; d0 < 4; ++d0) { kf[2 * d0] = *(const LAS bf16x8*)(kb + d0 * 2048); kf[2 * d0 + 1] = *(const LAS bf16x8*)(kb + d0 * 2048 + 512); }
    asm volatile("s_waitcnt lgkmcnt(0)" ::: "memory"); __builtin_amdgcn_sched_barrier(0);
    p0 = __builtin_amdgcn_mfma_f32_32x32x16_bf16(kf[0], qr[0], negm, 0, 0, 0); p1 = __builtin_amdgcn_mfma_f32_32x32x16_bf16(kf[1], qr[0], negm, 0, 0, 0);
#pragma unroll
    for (int d0 = 1; d0 < 4; ++d0) { p0 = __builtin_amdgcn_mfma_f32_32x32x16_bf16(kf[2 * d0], qr[d0], p0, 0, 0, 0); p1 = __builtin_amdgcn_mfma_f32_32x32x16_bf16(kf[2 * d0 + 1], qr[d0], p1, 0, 0, 0); }
}
__device__ __forceinline__ float rowmax(const f32x16& p0, const f32x16& p1) {
    float a = fmaxf(p0[0], p1[0]);
#pragma unroll
    for (int r = 1; r < 16; ++r) a = fmaxf(a, fmaxf(p0[r], p1[r]));
    auto rr = __builtin_amdgcn_permlane32_swap(__float_as_uint(a), __float_as_uint(a), false, false);
    return fmaxf(__uint_as_float(rr[0]), __uint_as_float(rr[1]));
}
#define ATT_VRD(buf, d0) do { _Pragma("unroll") for (int ks = 0; ks < 4; ++ks) { \
        asm volatile("ds_read_b64_tr_b16 %0,%1 offset:%c2" : "=&v"(lo[buf][ks]) : "v"(vb), "i"((d0) * 4096 + ks * 1024) : "memory"); \
        asm volatile("ds_read_b64_tr_b16 %0,%1 offset:%c2" : "=&v"(hi[buf][ks]) : "v"(vb), "i"((d0) * 4096 + ks * 1024 + 512) : "memory"); } } while (0)
#define ATT_PK(b, k) (bf16x8){lo[b][k][0], lo[b][k][1], lo[b][k][2], lo[b][k][3], hi[b][k][0], hi[b][k][1], hi[b][k][2], hi[b][k][3]}
#define ATT_MM2(da, db) do { \
        o[da] = __builtin_amdgcn_mfma_f32_32x32x16_bf16(pa0, ATT_PK(0, 0), o[da], 0, 0, 0); o[db] = __builtin_amdgcn_mfma_f32_32x32x16_bf16(pa0, ATT_PK(1, 0), o[db], 0, 0, 0); \
        o[da] = __builtin_amdgcn_mfma_f32_32x32x16_bf16(pa1, ATT_PK(0, 1), o[da], 0, 0, 0); o[db] = __builtin_amdgcn_mfma_f32_32x32x16_bf16(pa1, ATT_PK(1, 1), o[db], 0, 0, 0); \
        o[da] = __builtin_amdgcn_mfma_f32_32x32x16_bf16(pa2, ATT_PK(0, 2), o[da], 0, 0, 0); o[db] = __builtin_amdgcn_mfma_f32_32x32x16_bf16(pa2, ATT_PK(1, 2), o[db], 0, 0, 0); \
        o[da] = __builtin_amdgcn_mfma_f32_32x32x16_bf16(pa3, ATT_PK(0, 3), o[da], 0, 0, 0); o[db] = __builtin_amdgcn_mfma_f32_32x32x16_bf16(pa3, ATT_PK(1, 3), o[db], 0, 0, 0); } while (0)
__device__ __forceinline__ void pv(f32x16* o, int vb, bf16x8 pa0, bf16x8 pa1, bf16x8 pa2, bf16x8 pa3) {
    s16x4 lo[2][4], hi[2][4];
    ATT_VRD(0, 0);
    ATT_VRD(1, 1);
    asm volatile("s_waitcnt lgkmcnt(0)" ::: "memory"); __builtin_amdgcn_sched_barrier(0);
    ATT_MM2(0, 1); __builtin_amdgcn_sched_barrier(0);
    ATT_VRD(0, 2);
    ATT_VRD(1, 3);
    asm volatile("s_waitcnt lgkmcnt(0)" ::: "memory"); __builtin_amdgcn_sched_barrier(0);
    ATT_MM2(2, 3);
}
#undef ATT_MM2
#undef ATT_VRD
#undef ATT_PK
__device__ __forceinline__ void attn_pass(const Args& A, int z, int b, int h, int qrow0, bool isctx, LAS char* shm, f32x16* o) {
    const int tid = opaque_tid(), lane = tid & 63, r32 = lane & 31, hi = lane >> 5; const int wid = __builtin_amdgcn_readfirstlane(tid >> 6);
    const int NT = isctx ? 4 : 68;
    LAS float* wsf = (LAS float*)(shm + LDS_WS) + wid * 64;
    const int vb0 = (int)(unsigned)(size_t)(shm + LDS_V) + ((lane >> 4) & 1) * 32 + (lane & 3) * 8 + (4 * hi + ((lane & 15) >> 2)) * 64;
    const bf16_t* Qw = A.Q + (size_t)(qrow0 + wid * 32 + r32) * 1024 + h * 128 + z * 64;
    bf16x8 qr[4];
#pragma unroll
    for (int d0 = 0; d0 < 4; ++d0) qr[d0] = *(const bf16x8*)(Qw + d0 * 16 + hi * 8);
    const bf16_t* Kh = A.K + h * 128 + z * 64 + wid * 8 + (size_t)lane * 1024;
    const int pc0 = wid, pc1 = wid + 8;
    const bf16_t* Vh0 = A.V + h * 128 + (pc0 >> 2) * 32 + (lane & 3) * 8 + (size_t)(16 * (pc0 & 3) + (lane >> 2)) * 1024;
    const bf16_t* Vh1 = A.V + h * 128 + (pc1 >> 2) * 32 + (lane & 3) * 8 + (size_t)(16 * (pc1 & 3) + (lane >> 2)) * 1024;
    const int ctxrow = TL + b * 256, latrow = b * 4096;
#define ATT_TROW(t) ((isctx || (t) < 4) ? (ctxrow + 64 * (t)) : (latrow + 64 * ((t) - 4)))
#define ATT_DMA(t, slot, vslot) do { const size_t ro_ = (size_t)ATT_TROW(t) * 1024; \
        __builtin_amdgcn_global_load_lds((const unsigned*)(Kh + ro_), (LAS unsigned*)(shm + LDS_K + (slot) * KSLOT + wid * 1024), 16, 0, 0); \
        __builtin_amdgcn_global_load_lds((const unsigned*)(Vh0 + ro_), (LAS unsigned*)(shm + LDS_V + (vslot) * VSLOT + pc0 * 1024), 16, 0, 0); \
        __builtin_amdgcn_global_load_lds((const unsigned*)(Vh1 + ro_), (LAS unsigned*)(shm + LDS_V + (vslot) * VSLOT + pc1 * 1024), 16, 0, 0); } while (0)
    float mhat = 0.f, l_reg = 0.f;
    f32x16 negm = f32x16{};
#pragma unroll
    for (int d = 0; d < 4; ++d) o[d] = f32x16{};
    const bool pathB = wid >= 4;
    u32x4 pw0 = {0u, 0u, 0u, 0u}, pw1 = pw0, pw2 = pw0, pw3 = pw0;
    int vs_cur = 0, vs_prev = 2;
    ATT_DMA(0, 0, 0);
#pragma unroll 1
    for (int t = 0; t <= NT; ++t) {
        asm volatile("s_waitcnt vmcnt(0) lgkmcnt(0)\n\ts_barrier" ::: "memory");
        const int vs_next = (vs_cur == 2) ? 0 : vs_cur + 1;
        if (t + 1 < NT) ATT_DMA(t + 1, (t + 1) & 1, vs_next);
        if (pathB && t > 0) pv(o, vb0 + vs_prev * VSLOT, __builtin_bit_cast(bf16x8, pw0), __builtin_bit_cast(bf16x8, pw1), __builtin_bit_cast(bf16x8, pw2), __builtin_bit_cast(bf16x8, pw3));
        if (t < NT) {
            f32x16 p0, p1;
            qkt(p0, p1, shm + LDS_K + (t & 1) * KSLOT, qr, negm, r32, hi);
            const float rm = rowmax(p0, p1);
            if (t == 0 || __any(rm > 8.f)) {
                const float dl = (t == 0) ? rm : fmaxf(rm, 0.f); mhat += dl;
#pragma unroll
                for (int r = 0; r < 16; ++r) { p0[r] -= dl; p1[r] -= dl; negm[r] = -mhat; }
                if (t > 0) {
                    const float f = __builtin_amdgcn_exp2f(-dl); l_reg *= f;
                    if (hi == 0) wsf[r32] = f;
                    asm volatile("s_waitcnt lgkmcnt(0)" ::: "memory");
#pragma unroll
                    for (int r = 0; r < 16; ++r) { const float fr_ = wsf[crow(r, hi)];
#pragma unroll
                        for (int d = 0; d < 4; ++d) o[d][r] *= fr_; }
                    asm volatile("s_waitcnt lgkmcnt(0)" ::: "memory");
                }
            }
            f32x2_t sacc = {0.f, 0.f};
#pragma unroll
            for (int r = 0; r < 16; r += 2) { p0[r] = __builtin_amdgcn_exp2f(p0[r]); p0[r + 1] = __builtin_amdgcn_exp2f(p0[r + 1]); p1[r] = __builtin_amdgcn_exp2f(p1[r]); p1[r + 1] = __builtin_amdgcn_exp2f(p1[r + 1]);
                sacc += (f32x2_t){p0[r], p0[r + 1]}; sacc += (f32x2_t){p1[r], p1[r + 1]}; }
            l_reg += sacc.x + sacc.y;
            pw0 = (u32x4){pkbf(p0[0], p0[1]), pkbf(p0[2], p0[3]), pkbf(p0[4], p0[5]), pkbf(p0[6], p0[7])};
            pw1 = (u32x4){pkbf(p0[8], p0[9]), pkbf(p0[10], p0[11]), pkbf(p0[12], p0[13]), pkbf(p0[14], p0[15])};
            pw2 = (u32x4){pkbf(p1[0], p1[1]), pkbf(p1[2], p1[3]), pkbf(p1[4], p1[5]), pkbf(p1[6], p1[7])};
            pw3 = (u32x4){pkbf(p1[8], p1[9]), pkbf(p1[10], p1[11]), pkbf(p1[12], p1[13]), pkbf(p1[14], p1[15])};
            __builtin_amdgcn_sched_barrier(0);
            if (!pathB) pv(o, vb0 + vs_cur * VSLOT, __builtin_bit_cast(bf16x8, pw0), __builtin_bit_cast(bf16x8, pw1), __builtin_bit_cast(bf16x8, pw2), __builtin_bit_cast(bf16x8, pw3));
        }
        vs_prev = vs_cur; vs_cur = vs_next;
    }
    asm volatile("s_waitcnt lgkmcnt(0)\n\ts_barrier" ::: "memory");
#undef ATT_DMA
#undef ATT_TROW
    { auto rr = __builtin_amdgcn_permlane32_swap(__float_as_uint(l_reg), __float_as_uint(l_reg), false, false); l_reg = __uint_as_float(rr[0]) + __uint_as_float(rr[1]); }
    asm volatile("s_waitcnt lgkmcnt(0)" ::: "memory");
    if (hi == 0) wsf[32 + r32] = l_reg;
    asm volatile("s_waitcnt lgkmcnt(0)" ::: "memory");
#pragma unroll
    for (int r = 0; r < 16; ++r) { const float rl = 1.0f / wsf[32 + crow(r, hi)];
#pragma unroll
        for (int d = 0; d < 4; ++d) o[d][r] *= rl; }
    asm volatile("s_waitcnt lgkmcnt(0)" ::: "memory");
}
__device__ __forceinline__ void attn_unit(const Args& A, int b, int h, int qb, bool isctx, LAS char* shm) {
    const int tid = opaque_tid(), lane = tid & 63, r32 = lane & 31, hi = lane >> 5; const int wid = __builtin_amdgcn_readfirstlane(tid >> 6);
    const int qrow0 = isctx ? (TL + b * 256) : (b * 4096 + qb * 256);
    f32x16 o[4];
    LAS unsigned* o1s = (LAS unsigned*)(shm + LDS_O1) + wid * 2048 + lane;
    attn_pass(A, 0, b, h, qrow0, isctx, shm, o);
#pragma unroll
    for (int d = 0; d < 4; ++d)
#pragma unroll
        for (int r = 0; r < 16; r += 2) o1s[(d * 8 + (r >> 1)) * 64] = pkbf(o[d][r], o[d][r + 1]);
    asm volatile("s_waitcnt lgkmcnt(0)" ::: "memory");
    attn_pass(A, 1, b, h, qrow0, isctx, shm, o);
    float ss[16];
#pragma unroll
    for (int r = 0; r < 16; r += 2) { float s0 = 0.f, s1 = 0.f;
#pragma unroll
        for (int d = 0; d < 4; ++d) { const unsigned pk = o1s[(d * 8 + (r >> 1)) * 64];
            const float v0 = bflo(pk) - A.lam * o[d][r], v1 = bfhi(pk) - A.lam * o[d][r + 1]; o[d][r] = v0; o[d][r + 1] = v1; s0 += v0 * v0; s1 += v1 * v1; }
        ss[r] = s0; ss[r + 1] = s1; }
#pragma unroll
    for (int msk = 1; msk < 32; msk <<= 1)
#pragma unroll
        for (int r = 0; r < 16; ++r) ss[r] += __shfl_xor(ss[r], msk);
    float gn[4];
#pragma unroll
    for (int d = 0; d < 4; ++d) gn[d] = A.gain[d * 32 + r32] * A.oml;
#pragma unroll
    for (int r = 0; r < 16; ++r) {
        const float rstd = rsqrtf(ss[r] * (1.0f / 128.0f) + 1e-5f);
        const size_t off = (size_t)(qrow0 + wid * 32 + crow(r, hi)) * 1024 + h * 128 + r32;
#pragma unroll
        for (int d = 0; d < 4; ++d) { const float zv = bf1(A.Z[off + d * 32]); const float v = o[d][r] * rstd * gn[d] * silu_f(zv);
            A.O[off + d * 32] = (bf16_t)(pkbf(v, 0.f) & 0xffffu); }
        asm volatile("" ::: "memory");
    }
}
__device__ __forceinline__ void attn_phase(const Args& A, LAS char* shm, int G, int bid) {
    const int vcu = (G % 8 == 0) ? (bid % 8) * (G / 8) + bid / 8 : bid;
#pragma unroll 1
    for (int u = vcu; u < A.n_units; u += G) {
        const bool isctx = u >= 1024; const int bh = isctx ? (u - 1024) : (u >> 4); const int qb = isctx ? 0 : (u & 15);
        attn_unit(A, bh >> 3, bh & 7, qb, isctx, shm);
        asm volatile("s_waitcnt vmcnt(0) lgkmcnt(0)\n\ts_barrier" ::: "memory");
    }
}
}
typedef unsigned short bf16_t;
typedef float f32x4 __attribute__((ext_vector_type(4)));
typedef unsigned u32x4 __attribute__((ext_vector_type(4)));
typedef unsigned u32x2 __attribute__((ext_vector_type(2)));
constexpr size_t MiB = 1u << 20;
constexpr size_t WS_CTL = 0, WS_MOD = 1 * MiB, WS_ROPE = 1 * MiB + 512 * 1024, WS_BZ = 2 * MiB;
constexpr size_t WS_WDAIN = 9 * MiB, WS_WDAOUT = 25 * MiB, WS_WFNT = 29 * MiB, WS_WFNZ = 33 * MiB, WS_WFNOUT = 35 * MiB, WS_WRWIN = 37 * MiB, WS_WRWOUT = 46 * MiB;
constexpr size_t WS_XC = 48 * MiB, WS_HB = 56 * MiB, WS_BIG = 124 * MiB;
constexpr size_t WS_Q = WS_BIG, WS_K = WS_BIG + 68 * MiB, WS_V = WS_BIG + 136 * MiB, WS_Z = WS_BIG + 204 * MiB;
constexpr size_t WS_ATL = WS_BIG, WS_ATC = WS_BIG + 128 * MiB, WS_ZB = WS_BIG + 136 * MiB, WS_DFTL = 396 * MiB, WS_DFTC = 460 * MiB;
constexpr size_t WS_P = WS_BIG, WS_Y1 = 413 * MiB, WS_END = 482 * MiB;
constexpr int RWN = 4352;
constexpr int LDS_BYTES = 147456;

struct Params { const float* in[28]; float* out; unsigned char* ws; };

__device__ __forceinline__ float wave_sum(float v) {
#pragma unroll
    for (int o = 1; o < 64; o <<= 1) v += __shfl_xor(v, o);
    return v;
}
__device__ __forceinline__ void tr_item(const float* W, int ldw, int N, bf16_t* WT, int ldt, LAS float* scr, int item, int lane) {
    const int nblk = N / 32, kb = item / nblk, nb = item % nblk, k0 = 64 * kb, n0 = 32 * nb;
#pragma unroll 8
    for (int i = 0; i < 32; ++i) { const int kk = 2 * i + (lane >> 5); scr[kk * 33 + (lane & 31)] = W[(size_t)(k0 + kk) * ldw + n0 + (lane & 31)]; }
    asm volatile("s_waitcnt lgkmcnt(0)" ::: "memory");
    const int c = lane & 7;
#pragma unroll
    for (int j = 0; j < 4; ++j) { const int n = (lane >> 3) + 8 * j; const LAS float* s = scr + (8 * c) * 33 + n;
        u32x4 o; o.x = pkbf(s[0 * 33], s[1 * 33]); o.y = pkbf(s[2 * 33], s[3 * 33]); o.z = pkbf(s[4 * 33], s[5 * 33]); o.w = pkbf(s[6 * 33], s[7 * 33]);
        *(u32x4*)(WT + (size_t)(n0 + n) * ldt + k0 + 8 * c) = o; }
    asm volatile("s_waitcnt lgkmcnt(0)" ::: "memory");
}
__device__ __forceinline__ void prologue(const Params& p, LAS char* lds, int G, int bid) {
    const int tid = opaque_tid(), lane = tid & 63, wid = tid >> 6;
    unsigned char* ws = p.ws;
    {
        LAS float* scr = (LAS float*)(lds + wid * 8448);
        const int gw = bid * 8 + wid, NGW = G * 8;
        for (int it = gw; it < 8832; it += NGW) {
            int r = it;
            if (r < 2048) { tr_item(p.in[8], 4096, 4096, (bf16_t*)(ws + WS_WDAIN), 1024, scr, r, lane); continue; } r -= 2048;
            if (r < 2048) { tr_item(p.in[8] + (size_t)1024 * 4096, 4096, 4096, (bf16_t*)(ws + WS_WDAIN + 8 * MiB), 1024, scr, r, lane); continue; } r -= 2048;
            if (r < 512) { tr_item(p.in[12], 1024, 1024, (bf16_t*)(ws + WS_WDAOUT), 1024, scr, r, lane); continue; } r -= 512;
            if (r < 512) { tr_item(p.in[12] + (size_t)1024 * 1024, 1024, 1024, (bf16_t*)(ws + WS_WDAOUT + 2 * MiB), 1024, scr, r, lane); continue; } r -= 512;
            if (r < 512) { tr_item(p.in[13] + 1024, 2048, 1024, (bf16_t*)(ws + WS_WFNZ), 1024, scr, r, lane); continue; } r -= 512;
            if (r < 512) { tr_item(p.in[15], 1024, 1024, (bf16_t*)(ws + WS_WFNOUT), 1024, scr, r, lane); continue; } r -= 512;
            if (r < 2176) { tr_item(p.in[16], RWN, RWN, (bf16_t*)(ws + WS_WRWIN), 1024, scr, r, lane); continue; } r -= 2176;
            tr_item(p.in[27], 1024, 1024, (bf16_t*)(ws + WS_WRWOUT), 1024, scr, r, lane);
        }
    }
    __syncthreads();
    for (int it = bid; it < 256; it += G) {
        const int g = it >> 5, cs = (it >> 4) & 1, kq = it & 15;
        LAS float* Wcs = (LAS float*)lds; LAS float* win = (LAS float*)(lds + 65536); LAS float* tab = (LAS float*)(lds + 65536 + 33024);
        if (tid < 128) { float s, c; sincospif((float)tid / 64.f, &s, &c); tab[tid] = (cs ? s : c) * 0.08838834764831845f; }
        __syncthreads();
        {
            const int e = tid & 127, cq = tid >> 7; float acc[32];
#pragma unroll
            for (int i = 0; i < 32; ++i) acc[i] = 0.f;
            const float* Wg = p.in[14] + (size_t)g * 128 * 128;
            for (int m = 0; m < 128; ++m) { const float wg = Wg[m * 128 + e];
#pragma unroll
                for (int i = 0; i < 32; ++i) acc[i] += tab[(m * (cq + 4 * i)) & 127] * wg; }
#pragma unroll
            for (int i = 0; i < 32; ++i) Wcs[(cq + 4 * i) * 128 + e] = acc[i];
        }
#pragma unroll
        for (int i = 0; i < 16; ++i) { const int idx = tid + 512 * i, kin = idx >> 7, c = idx & 127; win[kin * 129 + c] = p.in[13][(size_t)(kq * 64 + kin) * 2048 + g * 128 + c]; }
        __syncthreads();
        {
            const int kin = tid & 63, eg = tid >> 6; float acc[16];
#pragma unroll
            for (int i = 0; i < 16; ++i) acc[i] = 0.f;
            for (int c = 0; c < 128; ++c) { const float a = win[kin * 129 + c];
#pragma unroll
                for (int i = 0; i < 16; ++i) acc[i] += a * Wcs[c * 128 + eg * 16 + i]; }
            bf16_t* WT = (bf16_t*)(ws + WS_WFNT);
#pragma unroll
            for (int i = 0; i < 16; ++i) WT[(size_t)(cs * 1024 + g * 128 + eg * 16 + i) * 1024 + kq * 64 + kin] = (bf16_t)(pkbf(acc[i], 0.f) & 0xffffu);
        }
        __syncthreads();
    }
    {
        LAS float* tc = (LAS float*)lds; LAS float* ts = (LAS float*)(lds + 16384);
        for (int j = tid; j < 4096; j += 512) { float s, c; sincospif((float)j / 2048.f, &s, &c); tc[j] = c; ts[j] = -s; }
        __syncthreads();
        bf16_t* DL = (bf16_t*)(ws + WS_DFTL); bf16_t* DC = (bf16_t*)(ws + WS_DFTC);
        for (int k = bid; k < 4096; k += G) {
            const int l0 = tid * 8; float c8[8], s8[8];
#pragma unroll
            for (int i = 0; i < 8; ++i) { const int idx = (k * (l0 + i)) & 4095; c8[i] = tc[idx] * 0.015625f; s8[i] = ts[idx] * 0.015625f; }
            u32x4 o; o.x = pkbf(c8[0], c8[1]); o.y = pkbf(c8[2], c8[3]); o.z = pkbf(c8[4], c8[5]); o.w = pkbf(c8[6], c8[7]);
            *(u32x4*)(DL + (size_t)k * 8192 + l0) = o;
            o.x = pkbf(s8[0], s8[1]); o.y = pkbf(s8[2], s8[3]); o.z = pkbf(s8[4], s8[5]); o.w = pkbf(s8[6], s8[7]);
            *(u32x4*)(DL + (size_t)k * 8192 + 4096 + l0) = o;
        }
        for (int k = bid; k < 256; k += G) {
            if (tid < 64) { const int cs = tid >> 5, l0 = (tid & 31) * 8; float v8[8];
#pragma unroll
                for (int i = 0; i < 8; ++i) { const int idx = ((k * (l0 + i)) & 255) * 16; v8[i] = (cs ? ts[idx] : tc[idx]) * 0.0625f; }
                u32x4 o; o.x = pkbf(v8[0], v8[1]); o.y = pkbf(v8[2], v8[3]); o.z = pkbf(v8[4], v8[5]); o.w = pkbf(v8[6], v8[7]);
                *(u32x4*)(DC + (size_t)k * 512 + cs * 256 + l0) = o; }
        }
        __syncthreads();
    }
    {
        LAS float* sc = (LAS float*)lds; LAS float* red = (LAS float*)(lds + 40960);
        bool have = false;
        for (int it = bid; it < 192; it += G) {
            if (!have) { for (int idx = tid; idx < 9216; idx += 512) { const int r = idx >> 10, k = idx & 1023; const float cv = r < 8 ? p.in[1][r * 1024 + k] : p.in[3][k]; sc[idx] = cv / (1.f + __expf(-cv)); } have = true; __syncthreads(); }
            const int i = it / 48, n = (it % 48) * 64 + (tid & 63), kq = tid >> 6;
            const float* w = p.in[5] + (size_t)i * 1024 * 3072 + n;
            float acc[9];
#pragma unroll
            for (int r = 0; r < 9; ++r) acc[r] = 0.f;
            for (int k = kq * 128; k < kq * 128 + 128; ++k) { const float wv = w[(size_t)k * 3072];
#pragma unroll
                for (int r = 0; r < 9; ++r) acc[r] += sc[r * 1024 + k] * wv; }
#pragma unroll
            for (int r = 0; r < 9; ++r) red[(kq * 9 + r) * 64 + (tid & 63)] = acc[r];
            __syncthreads();
            for (int idx = tid; idx < 576; idx += 512) { const int r = idx >> 6, col = idx & 63; float s = 0.f;
#pragma unroll
                for (int q = 0; q < 8; ++q) s += red[(q * 9 + r) * 64 + col];
                const int nn = (it % 48) * 64 + col;
                ((float*)(ws + WS_MOD))[(size_t)(i * 9 + r) * 3072 + nn] = s + p.in[6][i * 3072 + nn]; }
            __syncthreads();
        }
    }
    if (bid == 0) { for (int t = tid; t < 1024; t += 512) { const int pos = t >> 4, qd = t & 15; const float inv = powf(10000.f, -(float)qd / 16.f); const float ang = (float)pos * inv;
            ((float*)(ws + WS_ROPE))[t] = cosf(ang); ((float*)(ws + WS_ROPE))[1024 + t] = sinf(ang); } }
}
__device__ __forceinline__ void ph_phase(const float* xlat, const float* xctx, const float* gain, const float* mod, bf16_t* Hb, int G, int bid) {
    const int tid_ = opaque_tid(); const int lane = tid_ & 63, wid = tid_ >> 6;
    for (int row = bid * 8 + wid; row < TT; row += G * 8) {
        const bool lat = row < TL; const float* src = lat ? xlat + (size_t)row * 1024 : xctx + (size_t)(row - TL) * 1024; const int r = lat ? (row >> 12) : 8;
        f32x4 v[4]; float ss = 0.f;
#pragma unroll
        for (int j = 0; j < 4; ++j) { v[j] = *(const f32x4*)(src + 4 * lane + 256 * j); ss += (v[j].x * v[j].x + v[j].y * v[j].y) + (v[j].z * v[j].z + v[j].w * v[j].w); }
        const float rstd = rsqrtf(wave_sum(ss) * (1.f / 1024.f) + 1e-6f);
        const float* mr = mod + r * 3072;
#pragma unroll
        for (int j = 0; j < 4; ++j) { const int col = 4 * lane + 256 * j; const f32x4 g4 = *(const f32x4*)(gain + col), sh = *(const f32x4*)(mr + col), sc = *(const f32x4*)(mr + 1024 + col);
            const f32x4 y = v[j] * rstd * g4 * (sc + 1.f) + sh; u32x2 o; o.x = pkbf(y.x, y.y); o.y = pkbf(y.z, y.w);
            *(u32x2*)(Hb + (size_t)row * 1024 + col) = o; }
    }
}
__device__ __forceinline__ void final_phase(float* x, const float* gain, int G, int bid) {
    const int tid_ = opaque_tid(); const int lane = tid_ & 63, wid = tid_ >> 6;
    for (int row = bid * 8 + wid; row < TL; row += G * 8) {
        float* src = x + (size_t)row * 1024; f32x4 v[4]; float ss = 0.f;
#pragma unroll
        for (int j = 0; j < 4; ++j) { v[j] = *(const f32x4*)(src + 4 * lane + 256 * j); ss += (v[j].x * v[j].x + v[j].y * v[j].y) + (v[j].z * v[j].z + v[j].w * v[j].w); }
        const float rstd = rsqrtf(wave_sum(ss) * (1.f / 1024.f) + 1e-6f);
#pragma unroll
        for (int j = 0; j < 4; ++j) { const int col = 4 * lane + 256 * j; const f32x4 g4 = *(const f32x4*)(gain + col); *(f32x4*)(src + col) = v[j] * rstd * g4; }
    }
}
__device__ __forceinline__ void sh8(const bf16_t* P, size_t row, int co, bool hm, bool hp, const float* mu, float* out) {
    const u32x4 z4 = {0u, 0u, 0u, 0u};
    const u32x4 c0 = *(const u32x4*)(P + row * RWN + co);
    const u32x4 cm = hm ? *(const u32x4*)(P + (row - 1) * RWN + co) : z4;
    const u32x4 cp = hp ? *(const u32x4*)(P + (row + 1) * RWN + co) : z4;
    const f32x4 m0 = *(const f32x4*)(mu + co), m1 = *(const f32x4*)(mu + co + 4);
#pragma unroll
    for (int i = 0; i < 4; ++i) {
        const float a0 = bflo(c0[i]), a1 = bfhi(c0[i]);
        const float n0 = 0.5f * (bflo(cm[i]) + bflo(cp[i])), n1 = 0.5f * (bfhi(cm[i]) + bfhi(cp[i]));
        const float mu0 = (2 * i < 4) ? m0[(2 * i) & 3] : m1[(2 * i) & 3], mu1 = (2 * i + 1 < 4) ? m0[(2 * i + 1) & 3] : m1[(2 * i + 1) & 3];
        out[2 * i] = a0 + mu0 * (n0 - a0); out[2 * i + 1] = a1 + mu1 * (n1 - a1);
    }
}
template <int CTRL> __device__ __forceinline__ float dpp_f(float v) { return __int_as_float(__builtin_amdgcn_update_dpp(0, __float_as_int(v), CTRL, 0xf, 0xf, true)); }
__device__ __forceinline__ float sum8(float v) { v += dpp_f<0xB1>(v); v += dpp_f<0x4E>(v); v += dpp_f<0x141>(v); return v; }
__device__ __forceinline__ float fast_tanh(float x) { const float e = __expf(2.f * x); return 1.f - 2.f * __builtin_amdgcn_rcpf(e + 1.f); }
__device__ __forceinline__ float fast_sigmoid(float x) { return __builtin_amdgcn_rcpf(1.f + __expf(-x)); }
struct RwArgs { const bf16_t* P; bf16_t* Y0; bf16_t* Y1; float* BZ; const float *mu, *w0, *w_up, *a0, *a_up, *k_k, *k_a, *r_k; };
struct Raw3 { u32x4 c0, cm, cp; };
__device__ __forceinline__ Raw3 ld3(const bf16_t* P, size_t row, int co, bool hm, bool hp) {
    const u32x4 z4 = {0u, 0u, 0u, 0u}; Raw3 r;
    r.c0 = *(const u32x4*)(P + row * RWN + co);
    r.cm = hm ? *(const u32x4*)(P + (row - 1) * RWN + co) : z4;
    r.cp = hp ? *(const u32x4*)(P + (row + 1) * RWN + co) : z4;
    return r;
}
__device__ __forceinline__ void shift8(const Raw3& R, const float* mu, int co, float* out) {
    const f32x4 m0 = *(const f32x4*)(mu + co), m1 = *(const f32x4*)(mu + co + 4);
#pragma unroll
    for (int i = 0; i < 4; ++i) {
        const float a0 = bflo(R.c0[i]), a1 = bfhi(R.c0[i]);
        const float n0 = 0.5f * (bflo(R.cm[i]) + bflo(R.cp[i])), n1 = 0.5f * (bfhi(R.cm[i]) + bfhi(R.cp[i]));
        const float mu0 = (2 * i < 4) ? m0[(2 * i) & 3] : m1[(2 * i) & 3], mu1 = (2 * i + 1 < 4) ? m0[(2 * i + 1) & 3] : m1[(2 * i + 1) & 3];
        out[2 * i] = a0 + mu0 * (n0 - a0); out[2 * i + 1] = a1 + mu1 * (n1 - a1);
    }
}
__device__ __forceinline__ void rwkv_scan(const RwArgs& A, LAS char* lds, int G, int bid) {
    typedef short bfx8 __attribute__((ext_vector_type(8)));
    const int tid = opaque_tid(), lane = tid & 63; const int q = __builtin_amdgcn_readfirstlane(tid >> 6);
    LAS float* sW = (LAS float*)lds; LAS float* sA = sW + 4096; LAS float* sB = sA + 4096; LAS float* sKD = sB + 4096; LAS float* sR = sKD + 4096; LAS float* sV = sR + 4096;
    LAS bf16_t* WUPt = (LAS bf16_t*)(sV + 4096); LAS bf16_t* AUPt = WUPt + 64 * 72;
    LAS bf16_t* T1 = (LAS bf16_t*)sW; LAS bf16_t* T2 = (LAS bf16_t*)sKD;
    const int s = tid >> 3, dg = tid & 7, d0 = dg * 8;
#pragma unroll 1
    for (int chain = bid; chain < 256; chain += G) {
        const int z = chain >> 7, b = (chain >> 4) & 7, hh = chain & 15;
        __syncthreads();
        for (int idx = tid; idx < 4096; idx += 512) { const int r = idx >> 6, d = idx & 63;
            WUPt[d * 72 + r] = (bf16_t)(pkbf(A.w_up[(size_t)(z * 64 + r) * 1024 + hh * 64 + d], 0.f) & 0xffffu);
            AUPt[d * 72 + r] = (bf16_t)(pkbf(A.a_up[(size_t)(z * 64 + r) * 1024 + hh * 64 + d], 0.f) & 0xffffu); }
        f32x2_t S2[4];
#pragma unroll
        for (int j = 0; j < 4; ++j) S2[j] = (f32x2_t){0.f, 0.f};
        bf16_t* Yz = z ? A.Y1 : A.Y0;
        const int c_r = hh * 64 + d0, c_k = 1024 + hh * 64 + d0, c_v = 2048 + hh * 64 + d0, c_wd = 3072 + z * 64 + d0, c_ad = 3200 + z * 64 + d0;
#define RW_ROWOF(c, rowv, hmv, hpv) do { const int sidx_ = (c) * 64 + s; int L_, n_, rb_; \
            if ((c) < 4) { L_ = 256; n_ = z ? (255 - sidx_) : sidx_; rb_ = TL + b * 256; } else { L_ = 4096; const int sl_ = sidx_ - 256; n_ = z ? (4095 - sl_) : sl_; rb_ = b * 4096; } \
            rowv = (size_t)(rb_ + n_); hmv = n_ > 0; hpv = n_ < L_ - 1; } while (0)
        size_t row; bool hm, hp;
        RW_ROWOF(0, row, hm, hp);
        Raw3 Rr = ld3(A.P, row, c_r, hm, hp), Rk = ld3(A.P, row, c_k, hm, hp), Rv = ld3(A.P, row, c_v, hm, hp), Rw = ld3(A.P, row, c_wd, hm, hp), Ra = ld3(A.P, row, c_ad, hm, hp);
#pragma unroll 1
        for (int c = 0; c < 68; ++c) {
            asm volatile("" ::: "memory");
            const size_t crow_ = row;
            {
                float r8[8], k8[8], v8[8], t8[8];
                shift8(Rr, A.mu, c_r, r8); shift8(Rk, A.mu, c_k, k8); shift8(Rv, A.mu, c_v, v8);
                *(LAS f32x4*)(sR + s * 64 + d0) = (f32x4){r8[0], r8[1], r8[2], r8[3]}; *(LAS f32x4*)(sR + s * 64 + d0 + 4) = (f32x4){r8[4], r8[5], r8[6], r8[7]};
                *(LAS f32x4*)(sV + s * 64 + d0) = (f32x4){v8[0], v8[1], v8[2], v8[3]}; *(LAS f32x4*)(sV + s * 64 + d0 + 4) = (f32x4){v8[4], v8[5], v8[6], v8[7]};
                *(LAS f32x4*)(sB + s * 64 + d0) = (f32x4){k8[0], k8[1], k8[2], k8[3]}; *(LAS f32x4*)(sB + s * 64 + d0 + 4) = (f32x4){k8[4], k8[5], k8[6], k8[7]};
                float kkr[8], ssq = 0.f;
                const f32x4 kk0 = *(const f32x4*)(A.k_k + hh * 64 + d0), kk1 = *(const f32x4*)(A.k_k + hh * 64 + d0 + 4);
#pragma unroll
                for (int i = 0; i < 8; ++i) { kkr[i] = k8[i] * (i < 4 ? kk0[i & 3] : kk1[i & 3]); ssq += kkr[i] * kkr[i]; }
                ssq = sum8(ssq);
                const float rs = -rsqrtf(ssq + 1e-12f);
                *(LAS f32x4*)(sA + s * 64 + d0) = (f32x4){kkr[0] * rs, kkr[1] * rs, kkr[2] * rs, kkr[3] * rs}; *(LAS f32x4*)(sA + s * 64 + d0 + 4) = (f32x4){kkr[4] * rs, kkr[5] * rs, kkr[6] * rs, kkr[7] * rs};
                shift8(Rw, A.mu, c_wd, t8);
                { u32x4 o; o.x = pkbf(fast_tanh(t8[0]), fast_tanh(t8[1])); o.y = pkbf(fast_tanh(t8[2]), fast_tanh(t8[3])); o.z = pkbf(fast_tanh(t8[4]), fast_tanh(t8[5])); o.w = pkbf(fast_tanh(t8[6]), fast_tanh(t8[7]));
                  *(LAS u32x4*)(T1 + s * 72 + d0) = o; }
                shift8(Ra, A.mu, c_ad, t8);
                { u32x4 o; o.x = pkbf(t8[0], t8[1]); o.y = pkbf(t8[2], t8[3]); o.z = pkbf(t8[4], t8[5]); o.w = pkbf(t8[6], t8[7]);
                  *(LAS u32x4*)(T2 + s * 72 + d0) = o; }
            }
            if (c + 1 < 68) { RW_ROWOF(c + 1, row, hm, hp);
                Rr = ld3(A.P, row, c_r, hm, hp); Rk = ld3(A.P, row, c_k, hm, hp); Rv = ld3(A.P, row, c_v, hm, hp); Rw = ld3(A.P, row, c_wd, hm, hp); Ra = ld3(A.P, row, c_ad, hm, hp); }
            __syncthreads();
            const int mt = q & 3, nh = q >> 2, fr = lane & 15, fq = lane >> 4;
            f32x4 accw[2], acca[2];
            {
                bfx8 aw[2], aa[2];
#pragma unroll
                for (int kk = 0; kk < 2; ++kk) { aw[kk] = *(const LAS bfx8*)(T1 + (16 * mt + fr) * 72 + kk * 32 + fq * 8); aa[kk] = *(const LAS bfx8*)(T2 + (16 * mt + fr) * 72 + kk * 32 + fq * 8); }
#pragma unroll
                for (int nt = 0; nt < 2; ++nt) { accw[nt] = (f32x4){0.f, 0.f, 0.f, 0.f}; acca[nt] = (f32x4){0.f, 0.f, 0.f, 0.f};
#pragma unroll
                    for (int kk = 0; kk < 2; ++kk) {
                        const bfx8 bw = *(const LAS bfx8*)(WUPt + (32 * nh + 16 * nt + fr) * 72 + kk * 32 + fq * 8), ba = *(const LAS bfx8*)(AUPt + (32 * nh + 16 * nt + fr) * 72 + kk * 32 + fq * 8);
                        accw[nt] = __builtin_amdgcn_mfma_f32_16x16x32_bf16(aw[kk], bw, accw[nt], 0, 0, 0);
                        acca[nt] = __builtin_amdgcn_mfma_f32_16x16x32_bf16(aa[kk], ba, acca[nt], 0, 0, 0); } }
            }
            __syncthreads();
#pragma unroll
            for (int nt = 0; nt < 2; ++nt) { const int d = 32 * nh + 16 * nt + fr, dcol = hh * 64 + d;
                const float w0d = A.w0[z * 1024 + dcol], a0d = A.a0[z * 1024 + dcol], kad = A.k_a[dcol];
#pragma unroll
                for (int j = 0; j < 4; ++j) { const int idx = (16 * mt + 4 * fq + j) * 64 + d;
                    const float x = -(w0d + accw[nt][j]);
                    const float sp = fmaxf(x, 0.f) + __logf(1.f + __expf(-fabsf(x)));
                    const float w = __expf(-__expf(-sp - 0.5f));
                    const float asig = fast_sigmoid(a0d + acca[nt][j]);
                    const float nkk = sA[idx], kraw = sB[idx];
                    sW[idx] = w; sB[idx] = -nkk * asig; sKD[idx] = kraw * (1.f + (asig - 1.f) * kad); } }
            __syncthreads();
            {
                const f32x4 ra = *(const LAS f32x4*)(sR + s * 64 + d0), rb = *(const LAS f32x4*)(sR + s * 64 + d0 + 4), ka = *(const LAS f32x4*)(sKD + s * 64 + d0), kb = *(const LAS f32x4*)(sKD + s * 64 + d0 + 4);
                const f32x4 q0 = *(const f32x4*)(A.r_k + hh * 64 + d0), q1 = *(const f32x4*)(A.r_k + hh * 64 + d0 + 4);
                float bz = 0.f;
#pragma unroll
                for (int i = 0; i < 4; ++i) { bz += ra[i] * ka[i] * q0[i]; bz += rb[i] * kb[i] * q1[i]; }
                bz = sum8(bz);
                if (dg == 0) A.BZ[((size_t)z * TT + crow_) * 16 + hh] = bz;
            }
            {
                const int rl = lane >> 3, cg = lane & 7, irow = 8 * q + rl;
                const LAS float* bw = sW + 8 * cg; const LAS float* ba_ = sA + 8 * cg; const LAS float* bb_ = sB + 8 * cg; const LAS float* bk = sKD + 8 * cg; const LAS float* br = sR + 8 * cg;
                LAS float* bv = sV + irow;
                f32x4 w0 = *(const LAS f32x4*)(bw), w1 = *(const LAS f32x4*)(bw + 4), a0 = *(const LAS f32x4*)(ba_), a1 = *(const LAS f32x4*)(ba_ + 4);
                f32x4 b0 = *(const LAS f32x4*)(bb_), b1 = *(const LAS f32x4*)(bb_ + 4), k0 = *(const LAS f32x4*)(bk), k1 = *(const LAS f32x4*)(bk + 4);
                f32x4 r0 = *(const LAS f32x4*)(br), r1 = *(const LAS f32x4*)(br + 4); float vi = bv[0];
#pragma unroll 2
                for (int st = 0; st < 64; ++st) {
                    const int on = ((st + 1) & 63) * 64;
                    const f32x4 nw0 = *(const LAS f32x4*)(bw + on), nw1 = *(const LAS f32x4*)(bw + on + 4), na0 = *(const LAS f32x4*)(ba_ + on), na1 = *(const LAS f32x4*)(ba_ + on + 4);
                    const f32x4 nb0 = *(const LAS f32x4*)(bb_ + on), nb1 = *(const LAS f32x4*)(bb_ + on + 4), nk0 = *(const LAS f32x4*)(bk + on), nk1 = *(const LAS f32x4*)(bk + on + 4);
                    const f32x4 nr0 = *(const LAS f32x4*)(br + on), nr1 = *(const LAS f32x4*)(br + on + 4); const float nvi = bv[on];
                    f32x2_t pp2 = S2[0] * (f32x2_t){a0[0], a0[1]};
                    pp2 = S2[1] * (f32x2_t){a0[2], a0[3]} + pp2; pp2 = S2[2] * (f32x2_t){a1[0], a1[1]} + pp2; pp2 = S2[3] * (f32x2_t){a1[2], a1[3]} + pp2;
                    const float sa = sum8(pp2.x + pp2.y);
                    const f32x2_t sa2 = {sa, sa}, v2 = {vi, vi};
                    S2[0] = S2[0] * (f32x2_t){w0[0], w0[1]} + sa2 * (f32x2_t){b0[0], b0[1]} + v2 * (f32x2_t){k0[0], k0[1]};
                    S2[1] = S2[1] * (f32x2_t){w0[2], w0[3]} + sa2 * (f32x2_t){b0[2], b0[3]} + v2 * (f32x2_t){k0[2], k0[3]};
                    S2[2] = S2[2] * (f32x2_t){w1[0], w1[1]} + sa2 * (f32x2_t){b1[0], b1[1]} + v2 * (f32x2_t){k1[0], k1[1]};
                    S2[3] = S2[3] * (f32x2_t){w1[2], w1[3]} + sa2 * (f32x2_t){b1[2], b1[3]} + v2 * (f32x2_t){k1[2], k1[3]};
                    f32x2_t y2 = S2[0] * (f32x2_t){r0[0], r0[1]};
                    y2 = S2[1] * (f32x2_t){r0[2], r0[3]} + y2; y2 = S2[2] * (f32x2_t){r1[0], r1[1]} + y2; y2 = S2[3] * (f32x2_t){r1[2], r1[3]} + y2;
                    const float yv = sum8(y2.x + y2.y);
                    if (cg == 0) bv[st * 64] = yv;
                    w0 = nw0; w1 = nw1; a0 = na0; a1 = na1; b0 = nb0; b1 = nb1; k0 = nk0; k1 = nk1; r0 = nr0; r1 = nr1; vi = nvi;
                }
            }
            __syncthreads();
            { u32x4 o; const LAS float* yr = sV + s * 64 + d0;
              o.x = pkbf(yr[0], yr[1]); o.y = pkbf(yr[2], yr[3]); o.z = pkbf(yr[4], yr[5]); o.w = pkbf(yr[6], yr[7]);
              *(u32x4*)(Yz + crow_ * 1024 + hh * 64 + d0) = o; }
            __syncthreads();
        }
#undef RW_ROWOF
    }
}
__device__ __forceinline__ void rwkv_out(const RwArgs& A, const float* ln_w, const float* ln_b, bf16_t* OG, int G, int bid) {
    const int tid_ = opaque_tid(); const int lane = tid_ & 63, wid = tid_ >> 6; const int c0 = lane * 16, head = lane >> 2;
    for (int row = bid * 8 + wid; row < TT; row += G * 8) {
        const bool lat = row < TL; const int L = lat ? 4096 : 256; const int n = lat ? (row & 4095) : ((row - TL) & 255); const bool hm = n > 0, hp = n < L - 1;
        float y[16], vv[16];
        { const u32x4 a0 = *(const u32x4*)(A.Y0 + (size_t)row * 1024 + c0), a1 = *(const u32x4*)(A.Y0 + (size_t)row * 1024 + c0 + 8);
          const u32x4 b0 = *(const u32x4*)(A.Y1 + (size_t)row * 1024 + c0), b1 = *(const u32x4*)(A.Y1 + (size_t)row * 1024 + c0 + 8);
#pragma unroll
          for (int i = 0; i < 4; ++i) { y[2 * i] = bflo(a0[i]) + bflo(b0[i]); y[2 * i + 1] = bfhi(a0[i]) + bfhi(b0[i]); y[8 + 2 * i] = bflo(a1[i]) + bflo(b1[i]); y[8 + 2 * i + 1] = bfhi(a1[i]) + bfhi(b1[i]); } }
        float s1 = 0.f;
#pragma unroll
        for (int i = 0; i < 16; ++i) s1 += y[i];
        s1 += __shfl_xor(s1, 1); s1 += __shfl_xor(s1, 2); const float mean = s1 * (1.f / 64.f);
        float s2 = 0.f;
#pragma unroll
        for (int i = 0; i < 16; ++i) { y[i] -= mean; s2 += y[i] * y[i]; }
        s2 += __shfl_xor(s2, 1); s2 += __shfl_xor(s2, 2); const float rstd = rsqrtf(s2 * (1.f / 64.f) + 64e-5f);
        sh8(A.P, (size_t)row, 2048 + c0, hm, hp, A.mu, vv); sh8(A.P, (size_t)row, 2048 + c0 + 8, hm, hp, A.mu, vv + 8);
        const float bz = 0.5f * (A.BZ[(size_t)row * 16 + head] + A.BZ[((size_t)TT + row) * 16 + head]);
        const u32x4 z0 = *(const u32x4*)(A.P + (size_t)row * RWN + 3328 + c0), z1 = *(const u32x4*)(A.P + (size_t)row * RWN + 3328 + c0 + 8);
        float ov[16];
#pragma unroll
        for (int i = 0; i < 16; ++i) { const unsigned zw = (i < 8) ? z0[(i >> 1) & 3] : z1[(i >> 1) & 3]; const float zz = (i & 1) ? bfhi(zw) : bflo(zw);
            ov[i] = (y[i] * rstd * ln_w[c0 + i] + ln_b[c0 + i] + bz * vv[i]) * silu_f(zz); }
        u32x4 o0, o1; o0.x = pkbf(ov[0], ov[1]); o0.y = pkbf(ov[2], ov[3]); o0.z = pkbf(ov[4], ov[5]); o0.w = pkbf(ov[6], ov[7]);
        o1.x = pkbf(ov[8], ov[9]); o1.y = pkbf(ov[10], ov[11]); o1.z = pkbf(ov[12], ov[13]); o1.w = pkbf(ov[14], ov[15]);
        *(u32x4*)(OG + (size_t)row * 1024 + c0) = o0; *(u32x4*)(OG + (size_t)row * 1024 + c0 + 8) = o1;
    }
}
#ifdef SKIP_GEMM
#define GEMM_PHASE(EPI, AP, BP, MM, NN, KK, EOBJ) do { (void)EOBJ; } while (0)
#else
#define GEMM_PHASE(EPI, AP, BP, MM, NN, KK, EOBJ) do { pg8::Gemm g_{(const bf16_t*)(AP), (const bf16_t*)(BP), (MM), (NN), (KK)}; pg8::StaticOrder S_; S_.init((MM), (NN), G, bid); \
    pg8::gemm_phase<EPI, pg8::StaticOrder, true, true>((PG8_LAS unsigned char*)lds, g_, S_, EOBJ); } while (0)
#endif
#ifdef SKIP_EpiAttnIn
#define GEMM_PHASE_EpiAttnIn(EPI, AP, BP, MM, NN, KK, EOBJ) do { (void)EOBJ; } while (0)
#else
#define GEMM_PHASE_EpiAttnIn GEMM_PHASE
#endif
#ifdef SKIP_EpiFnT
#define GEMM_PHASE_EpiFnT(EPI, AP, BP, MM, NN, KK, EOBJ) do { (void)EOBJ; } while (0)
#else
#define GEMM_PHASE_EpiFnT GEMM_PHASE
#endif
#ifdef SKIP_EpiPlain
#define GEMM_PHASE_EpiPlain(EPI, AP, BP, MM, NN, KK, EOBJ) do { (void)EOBJ; } while (0)
#else
#define GEMM_PHASE_EpiPlain GEMM_PHASE
#endif
#ifdef SKIP_EpiDft
#define GEMM_PHASE_EpiDft(EPI, AP, BP, MM, NN, KK, EOBJ) do { (void)EOBJ; } while (0)
#else
#define GEMM_PHASE_EpiDft GEMM_PHASE
#endif
#ifdef SKIP_EpiResid
#define GEMM_PHASE_EpiResid(EPI, AP, BP, MM, NN, KK, EOBJ) do { (void)EOBJ; } while (0)
#else
#define GEMM_PHASE_EpiResid GEMM_PHASE
#endif
#define XB_TMO      128
#define XB_XCNT(j)  (256  + 64 * (j))
#define XB_XSUB(j)  (1280 + 64 * (j))
#define XB_XGEN(j)  (2304 + 64 * (j))
#define XB_TOP      3328
#define XB_TOPGEN   3392
#define XCD_BAR_WORDS 3456
#define XB_SPIN_CAP (1u << 18)

__device__ __forceinline__ unsigned xb_ld(unsigned* p)              { return __hip_atomic_load(p, __ATOMIC_RELAXED, __HIP_MEMORY_SCOPE_AGENT); }
__device__ __forceinline__ unsigned xb_add(unsigned* p, unsigned v) { return __hip_atomic_fetch_add(p, v, __ATOMIC_RELAXED, __HIP_MEMORY_SCOPE_AGENT); }
__device__ __forceinline__ unsigned xb_xcc_id() { return (unsigned)__builtin_amdgcn_s_getreg((3 << 11) | 20) & 0xFu; }
#define XB_SPIN(cond, bar) do { unsigned _sp = 0; while (cond) { __builtin_amdgcn_s_sleep(1); \
    if ((++_sp & 255u) == 0u) { if (xb_ld(&(bar)[XB_TMO])) break; if (_sp > XB_SPIN_CAP) { atomicAdd(&(bar)[XB_TMO], 1u); break; } } } } while (0)

struct XcdBarrier {
    unsigned* bar; unsigned x;
    volatile LAS unsigned* st;
};

__device__ __forceinline__ XcdBarrier xcd_barrier_post(unsigned* bar, volatile LAS unsigned* st) {
    XcdBarrier b; b.bar = bar; b.x = xb_xcc_id(); b.st = st;
    if (threadIdx.x == 0) (void)xb_add(&bar[XB_XCNT(b.x)], 1u);
    return b;
}
__device__ __forceinline__ void xcd_barrier_complete(unsigned* bar, unsigned x, unsigned& nloc, unsigned& nx) {
    const unsigned G = gridDim.x * gridDim.y * gridDim.z;
    unsigned sum, cnt, mine, sp = 0u;
    for (;;) {
        sum = 0u; cnt = 0u; mine = 0u;
#pragma unroll
        for (unsigned j = 0; j < 16; ++j) { const unsigned c = xb_ld(&bar[XB_XCNT(j)]); sum += c; cnt += (c > 0u) ? 1u : 0u; mine = (j == x) ? c : mine; }
        if (sum == G) break;
        __builtin_amdgcn_s_sleep(1);
        if ((++sp & 255u) == 0u) { if (xb_ld(&bar[XB_TMO])) break; if (sp > XB_SPIN_CAP) { atomicAdd(&bar[XB_TMO], 1u); break; } }
    }
    nloc = mine > 0u ? mine : 1u; nx = cnt > 0u ? cnt : 1u;
}

__device__ __forceinline__ void xcd_barrier(const XcdBarrier& b) {
    asm volatile("s_waitcnt vmcnt(0)" ::: "memory");
    __syncthreads();
    if (threadIdx.x == 0) {
        unsigned* bar = b.bar;
        __builtin_amdgcn_s_waitcnt(0);
        unsigned nloc = b.st[0], nx = b.st[1];
        if (nloc == 0u) { xcd_barrier_complete(bar, b.x, nloc, nx); b.st[0] = nloc; b.st[1] = nx; }
        const unsigned old = xb_add(&bar[XB_XSUB(b.x)], 1u);
        const unsigned gen = old / nloc;
        if (old + 1u == (gen + 1u) * nloc) {
            __builtin_amdgcn_fence(__ATOMIC_RELEASE, "agent");
            asm volatile("s_waitcnt vmcnt(0)" ::: "memory");
            const unsigned og = xb_add(&bar[XB_TOP], 1u);
            const unsigned tg = og / nx;
            if (og + 1u == (tg + 1u) * nx) xb_add(&bar[XB_TOPGEN], 1u);
            else XB_SPIN(xb_ld(&bar[XB_TOPGEN]) == tg, bar);
            __builtin_amdgcn_fence(__ATOMIC_ACQUIRE, "agent");
            xb_add(&bar[XB_XGEN(b.x)], 1u);
            asm volatile("s_waitcnt vmcnt(0)" ::: "memory");
        } else {
            XB_SPIN(xb_ld(&bar[XB_XGEN(b.x)]) == gen, bar);
            __builtin_amdgcn_fence(__ATOMIC_ACQUIRE, "agent");
            asm volatile("s_waitcnt vmcnt(0)" ::: "memory");
        }
    }
    __syncthreads();
}

#define GRID_SYNC() xcd_barrier(xbar)
template <int layer> __device__ __forceinline__ void layer_body(const Params& p, LAS char* lds, const XcdBarrier& xbar, int G, int bid) {
    unsigned char* ws = p.ws;
    float* mod = (float*)(ws + WS_MOD);
    const float* ropeC = (const float*)(ws + WS_ROPE); const float* ropeS = ropeC + 1024;
    bf16_t* Hb = (bf16_t*)(ws + WS_HB);
    float* XC = (float*)(ws + WS_XC);
    const float* x_in = p.in[0]; const float* ctx_in = p.in[2];
        const float* xl = layer == 0 ? x_in : p.out; const float* xc = layer == 0 ? ctx_in : XC;
        const float* modl = mod + (size_t)layer * 9 * 3072;
        ph_phase(xl, xc, p.in[4] + layer * 1024, modl, Hb, G, bid);
        GRID_SYNC();
        const int Mout = (layer == 3) ? TL : TT;
        const bf16_t* Wout;
        if constexpr (layer == 0 || layer == 3) {
            const int j = layer == 0 ? 0 : 1;
            pg8::EpiAttnIn E{(bf16_t*)(ws + WS_Q), (bf16_t*)(ws + WS_K), (bf16_t*)(ws + WS_V), (bf16_t*)(ws + WS_Z), ropeC, ropeS};
            GEMM_PHASE_EpiAttnIn(pg8::EpiAttnIn, Hb, ws + WS_WDAIN + (size_t)j * 8 * MiB, TT, 4096, 1024, E);
            GRID_SYNC();
            float lam;
            { const int lane = opaque_tid() & 63; const float* lq = p.in[9] + j * 128; const float* lk = p.in[10] + j * 128;
              const float s0 = wave_sum(lq[lane] * lk[lane]), s1 = wave_sum(lq[64 + lane] * lk[64 + lane]);
              const float li = 0.8f - 0.6f * expf(-0.3f * (float)layer); lam = expf(s0) - expf(s1) + li;
              att::Args A{(const bf16_t*)(ws + WS_Q), (const bf16_t*)(ws + WS_K), (const bf16_t*)(ws + WS_V), (const bf16_t*)(ws + WS_Z), Hb, p.in[11] + j * 128, lam, 1.f - li, layer == 3 ? 1024 : 1088};
#ifndef SKIP_ATT
              att::attn_phase(A, lds, G, bid);
#endif
#ifdef PROBE_ATT2
              att::attn_phase(A, lds, G, bid);
#endif
            }
            GRID_SYNC();
            Wout = (const bf16_t*)(ws + WS_WDAOUT + (size_t)j * 2 * MiB);
        } else if constexpr (layer == 1) {
            { pg8::EpiFnT E{(bf16_t*)(ws + WS_ATL), (bf16_t*)(ws + WS_ATC)};
              GEMM_PHASE_EpiFnT(pg8::EpiFnT, ws + WS_WFNT, Hb, 2048, TT, 1024, E); }
            { pg8::EpiPlain E{(bf16_t*)(ws + WS_ZB), 1024};
              GEMM_PHASE_EpiPlain(pg8::EpiPlain, Hb, ws + WS_WFNZ, TT, 1024, 1024, E); }
            GRID_SYNC();
            { pg8::EpiDft E{(const bf16_t*)(ws + WS_ZB), Hb, 0, 4096};
              GEMM_PHASE_EpiDft(pg8::EpiDft, ws + WS_DFTL, ws + WS_ATL, 4096, 8192, 8192, E); }
            { pg8::EpiDft E{(const bf16_t*)(ws + WS_ZB), Hb, TL, 256};
              GEMM_PHASE_EpiDft(pg8::EpiDft, ws + WS_DFTC, ws + WS_ATC, 256, 8192, 512, E); }
            GRID_SYNC();
            Wout = (const bf16_t*)(ws + WS_WFNOUT);
        } else {
            { pg8::EpiPlain E{(bf16_t*)(ws + WS_P), RWN};
              GEMM_PHASE_EpiPlain(pg8::EpiPlain, Hb, ws + WS_WRWIN, TT, RWN, 1024, E); }
            GRID_SYNC();
            RwArgs A{(const bf16_t*)(ws + WS_P), Hb, (bf16_t*)(ws + WS_Y1), (float*)(ws + WS_BZ), p.in[17], p.in[18], p.in[19], p.in[20], p.in[21], p.in[22], p.in[23], p.in[24]};
#ifndef SKIP_SCAN
            rwkv_scan(A, lds, G, bid);
#endif
#ifdef PROBE_SCAN2
            rwkv_scan(A, lds, G, bid);
#endif
            GRID_SYNC();
#ifndef SKIP_RWOUT
            rwkv_out(A, p.in[25], p.in[26], Hb, G, bid);
#endif
            GRID_SYNC();
            Wout = (const bf16_t*)(ws + WS_WRWOUT);
        }
        { pg8::EpiResid E{xl, xc, p.out, XC, modl + 2048};
          GEMM_PHASE_EpiResid(pg8::EpiResid, Hb, Wout, Mout, 1024, 1024, E); }
        GRID_SYNC();
    }
__global__ void __launch_bounds__(512, 2) fwd_megakernel(Params p) {
    extern __shared__ __attribute__((aligned(16))) unsigned char lds_raw[];
    LAS char* lds = (LAS char*)lds_raw;
    cg::grid_group grid = cg::this_grid();
    const int G = gridDim.x, bid = blockIdx.x;
    volatile LAS unsigned* xst = (volatile LAS unsigned*)(lds + LDS_BYTES - 256);
    if (threadIdx.x < 2) xst[threadIdx.x] = 0u;
    __syncthreads();
    const XcdBarrier xbar = xcd_barrier_post((unsigned*)(p.ws + WS_CTL), xst);

#ifndef SKIP_PRO
    prologue(p, lds, G, bid);
#endif
#ifdef PROBE_PRO2
    __syncthreads(); prologue(p, lds, G, bid);
#endif
    grid.sync();
    layer_body<0>(p, lds, xbar, G, bid);
    layer_body<1>(p, lds, xbar, G, bid);
    layer_body<2>(p, lds, xbar, G, bid);
    layer_body<3>(p, lds, xbar, G, bid);
    final_phase(p.out, p.in[7], G, bid);
}

extern "C" void kernel_launch(void* const* d_in, const int* in_sizes, int n_in, void* d_out, int out_size, void* d_ws, size_t ws_size, hipStream_t stream) {
    static int grid = 0;
    if (grid == 0) {
        if (n_in != 28 || out_size != TL * 1024 || ws_size < WS_END) { fprintf(stderr, "kernel_launch: unexpected shapes: n_in %d out %d ws %zu\n", n_in, out_size, ws_size); grid = -1; return; }
        int dev = 0, cus = 0, per_cu = 0;
        hipGetDevice(&dev); hipDeviceGetAttribute(&cus, hipDeviceAttributeMultiprocessorCount, dev);
        if (hipFuncSetAttribute((const void*)fwd_megakernel, hipFuncAttributeMaxDynamicSharedMemorySize, LDS_BYTES) != hipSuccess) { fprintf(stderr, "kernel_launch: hipFuncSetAttribute failed\n"); grid = -1; return; }
        if (hipOccupancyMaxActiveBlocksPerMultiprocessor(&per_cu, (const void*)fwd_megakernel, 512, LDS_BYTES) != hipSuccess || per_cu < 1) { fprintf(stderr, "kernel_launch: occupancy query failed (%d)\n", per_cu); per_cu = 1; }
        (void)hipGetLastError();
        grid = cus * per_cu;
    }
    if (grid < 0) return;
    if (hipMemsetAsync((char*)d_ws + WS_CTL, 0, 65536, stream) != hipSuccess) { fprintf(stderr, "kernel_launch: hipMemsetAsync failed\n"); return; }
    Params p{};
    for (int i = 0; i < 28; ++i) p.in[i] = (const float*)d_in[i];
    p.out = (float*)d_out; p.ws = (unsigned char*)d_ws;
    void* args[] = {&p};
    hipError_t e = hipLaunchCooperativeKernel((const void*)fwd_megakernel, dim3(grid), dim3(512), args, LDS_BYTES, stream);
    if (e != hipSuccess) fprintf(stderr, "cooperative launch failed: %s (grid %d)\n", hipGetErrorString(e), grid);
}
```

```cpp
#include <hip/hip_runtime.h>
#include <hip/hip_cooperative_groups.h>
#include <cstdio>
#include <cstdint>
#include <cmath>
namespace cg = cooperative_groups;

constexpr int TL = 32768, TCX = 2048, TT = TL + TCX, DM = 1024;
constexpr float QK_C2 = 0.125f * 1.4426950408889634f;
typedef float f32x2_t __attribute__((ext_vector_type(2)));
typedef __bf16 bf16x2_t __attribute__((ext_vector_type(2)));
__device__ __forceinline__ unsigned pkbf(float lo, float hi) { f32x2_t v = {lo, hi}; bf16x2_t b = __builtin_convertvector(v, bf16x2_t); return __builtin_bit_cast(unsigned, b); }
__device__ __forceinline__ float bflo(unsigned u) { return __uint_as_float(u << 16); }
__device__ __forceinline__ float bfhi(unsigned u) { return __uint_as_float(u & 0xffff0000u); }
__device__ __forceinline__ float bf1(unsigned short u) { return __uint_as_float(((unsigned)u) << 16); }
__device__ __forceinline__ float silu_f(float z) { return z * __builtin_amdgcn_rcpf(1.f + __expf(-z)); }
__device__ __forceinline__ int opaque_tid() { int t = threadIdx.x; asm volatile("" : "+v"(t)); return t; }
namespace pg8 {
#define PG8_LAS __attribute__((address_space(3)))
typedef unsigned short bf16_t;
typedef short bf16x8 __attribute__((ext_vector_type(8)));
typedef float f32x4 __attribute__((ext_vector_type(4)));
typedef unsigned u32x4 __attribute__((ext_vector_type(4)));
constexpr int BM = 256, BK = 64, HALF = 128, HTB = HALF * BK * 2  , STAGE_BYTES = 8 * HTB, NXCD = 8, WGM = 8;

__host__ __device__ __forceinline__ int lds_byte(int r, int c) { const int st = (r >> 4) * 2 + (c >> 5), rr = r & 15, cc = c & 31, ob = rr * 64 + cc * 2; return st * 1024 + (ob ^ (((ob >> 9) & 1) << 5)); }
__host__ __device__ __forceinline__ void stage_rc(int b, int& R, int& C) { const int st = b / 1024, sb = b % 1024, swz = sb ^ (((sb >> 9) & 1) << 5); R = (st >> 1) * 16 + swz / 64; C = (st & 1) * 32 + (swz % 64) / 2; }
__host__ __device__ __forceinline__ int perm32(int rho) { const int n = rho >> 4, i = rho & 15; return 8 * (i >> 2) + 4 * n + (i & 3); }

struct Unit { int pm, pn; };
struct Gemm { const bf16_t* A; const bf16_t* Bt; int M, N, K; };

struct StaticOrder {
    int nM, nN, nwg, G, c;
    __host__ __device__ void init(int M, int N, int G_, int c_) { nM = M / BM; nN = N / BM; nwg = nM * nN; G = G_; c = c_; }
    __host__ __device__ bool next(int i, Unit& u) const {
        const long L = (long)i * G + c; if (L >= nwg) return false;
        int wgid = (int)L; { const int q = nwg / NXCD, r = nwg % NXCD, xcd = wgid % NXCD, off = wgid / NXCD; wgid = (xcd < r ? xcd * (q + 1) : r * (q + 1) + (xcd - r) * q) + off; }
        const int nig = WGM * nN, gid = wgid / nig, fm = gid * WGM, gsz = (nM - fm) < WGM ? (nM - fm) : WGM;
        u.pm = fm + ((wgid % nig) % gsz); u.pn = (wgid % nig) / gsz; return true;
    }
    __device__ __forceinline__ void a_ready(const Unit&) const {}
    __device__ __forceinline__ void done(const Unit&) const {}
};

struct EpiAttnIn {
    static constexpr bool PERM = true, AFTER_DRAIN = false;
    bf16_t* Q; bf16_t* Kb; bf16_t* V; bf16_t* Z; const float* ropeC; const float* ropeS;
    __device__ __forceinline__ void operator()(const f32x4 (&acc)[2][2][4][2], const Unit& u, int wr, int wc, int fr, int fq) const {
        const int sect = u.pn >> 2;
        bf16_t* base = sect == 0 ? Q : sect == 1 ? Kb : sect == 2 ? V : Z;
        const int colt = (u.pn & 3) * 256 + wc * 32 + 8 * fq;
        const int row0 = u.pm * BM + wr * 64 + fr;
        const bool rope = (u.pm < 128) && (sect < 2);
        const float sc = (sect == 0) ? QK_C2 : 1.f;
        const int axis = wc & 1;
#pragma unroll
        for (int ai = 0; ai < 2; ++ai)
#pragma unroll
            for (int m = 0; m < 4; ++m) {
                const int row = row0 + ai * HALF + m * 16;
                const int ntok = row & 4095;
                const int pos = axis ? (ntok & 63) : (ntok >> 6);
                bf16_t* rowp = base + (size_t)row * 1024 + colt;
#pragma unroll
                for (int bj = 0; bj < 2; ++bj) {
                    f32x4 v0 = acc[ai][bj][m][0], v1 = acc[ai][bj][m][1];
                    if (rope) {
                        const f32x4 c0 = *(const f32x4*)(ropeC + pos * 16 + 8 * (fq & 1)), c1 = *(const f32x4*)(ropeC + pos * 16 + 8 * (fq & 1) + 4);
                        const f32x4 s0 = *(const f32x4*)(ropeS + pos * 16 + 8 * (fq & 1)), s1 = *(const f32x4*)(ropeS + pos * 16 + 8 * (fq & 1) + 4);
                        f32x4 p0, p1;
#pragma unroll
                        for (int i = 0; i < 4; ++i) { p0[i] = __shfl_xor(v0[i], 32); p1[i] = __shfl_xor(v1[i], 32); }
                        if (fq < 2) { v0 = v0 * c0 - p0 * s0; v1 = v1 * c1 - p1 * s1; }
                        else        { v0 = v0 * c0 + p0 * s0; v1 = v1 * c1 + p1 * s1; }
                    }
                    v0 = v0 * sc; v1 = v1 * sc;
                    u32x4 w; w.x = pkbf(v0[0], v0[1]); w.y = pkbf(v0[2], v0[3]); w.z = pkbf(v1[0], v1[1]); w.w = pkbf(v1[2], v1[3]);
                    *(u32x4*)(rowp + bj * HALF) = w;
                }
            }
    }
};
struct EpiPlain {
    static constexpr bool PERM = true, AFTER_DRAIN = false;
    bf16_t* O; int ldc;
    __device__ __forceinline__ void operator()(const f32x4 (&acc)[2][2][4][2], const Unit& u, int wr, int wc, int fr, int fq) const {
        const int row0 = u.pm * BM + wr * 64 + fr, col0 = u.pn * BM + wc * 32 + 8 * fq;
#pragma unroll
        for (int ai = 0; ai < 2; ++ai)
#pragma unroll
            for (int m = 0; m < 4; ++m) { bf16_t* rowp = O + (size_t)(row0 + ai * HALF + m * 16) * ldc + col0;
#pragma unroll
                for (int bj = 0; bj < 2; ++bj) { const f32x4 v0 = acc[ai][bj][m][0], v1 = acc[ai][bj][m][1];
                    u32x4 w; w.x = pkbf(v0[0], v0[1]); w.y = pkbf(v0[2], v0[3]); w.z = pkbf(v1[0], v1[1]); w.w = pkbf(v1[2], v1[3]);
                    *(u32x4*)(rowp + bj * HALF) = w; } }
    }
};
struct EpiResid {
    static constexpr bool PERM = false, AFTER_DRAIN = false;
    const float* xin_lat; const float* xin_ctx; float* xout_lat; float* xout_ctx; const float* gate;
    __device__ __forceinline__ void operator()(const f32x4 (&acc)[2][2][4][2], const Unit& u, int wr, int wc, int fr, int fq) const {
        const int row0 = u.pm * BM + wr * 64 + fr, col0 = u.pn * BM + wc * 32 + 4 * fq;
#pragma unroll
        for (int ai = 0; ai < 2; ++ai)
#pragma unroll
            for (int m = 0; m < 4; ++m) {
                const int row = row0 + ai * HALF + m * 16; const bool lat = row < TL; const int r = lat ? (row >> 12) : 8;
                const float* xi = lat ? xin_lat + (size_t)row * 1024 : xin_ctx + (size_t)(row - TL) * 1024;
                float* xo = lat ? xout_lat + (size_t)row * 1024 : xout_ctx + (size_t)(row - TL) * 1024;
                const float* g = gate + r * 3072;
#pragma unroll
                for (int bj = 0; bj < 2; ++bj)
#pragma unroll
                    for (int n = 0; n < 2; ++n) { const int col = col0 + bj * HALF + n * 16;
                        const f32x4 g4 = *(const f32x4*)(g + col), x4 = *(const f32x4*)(xi + col);
                        *(f32x4*)(xo + col) = x4 + g4 * acc[ai][bj][m][n]; }
            }
    }
};
struct EpiFnT {
    static constexpr bool PERM = true, AFTER_DRAIN = false;
    bf16_t* ATL; bf16_t* ATC;
    __device__ __forceinline__ void operator()(const f32x4 (&acc)[2][2][4][2], const Unit& u, int wr, int wc, int fr, int fq) const {
        const int row0 = u.pm * BM + wr * 64 + fr, col0 = u.pn * BM + wc * 32 + 8 * fq;
#pragma unroll
        for (int ai = 0; ai < 2; ++ai)
#pragma unroll
            for (int m = 0; m < 4; ++m) { const int mp = row0 + ai * HALF + m * 16, cs = mp >> 10, n = mp & 1023;
#pragma unroll
                for (int bj = 0; bj < 2; ++bj) { const int t0 = col0 + bj * HALF; bf16_t* dst;
                    if (t0 < TL) { const int b = t0 >> 12, l = t0 & 4095; dst = ATL + ((size_t)((b * 1024 + n) * 2 + cs)) * 4096 + l; }
                    else { const int tc = t0 - TL, b = tc >> 8, l = tc & 255; dst = ATC + ((size_t)((b * 1024 + n) * 2 + cs)) * 256 + l; }
                    const f32x4 v0 = acc[ai][bj][m][0], v1 = acc[ai][bj][m][1];
                    u32x4 w; w.x = pkbf(v0[0], v0[1]); w.y = pkbf(v0[2], v0[3]); w.z = pkbf(v1[0], v1[1]); w.w = pkbf(v1[2], v1[3]);
                    *(u32x4*)dst = w; } }
    }
};
struct EpiDft {
    static constexpr bool PERM = true, AFTER_DRAIN = false;
    const bf16_t* Z; bf16_t* OG; int rowbase; int L;
    __device__ __forceinline__ void operator()(const f32x4 (&acc)[2][2][4][2], const Unit& u, int wr, int wc, int fr, int fq) const {
        const int k0 = u.pm * BM + wr * 64 + fr; const int b = u.pn >> 2; const int n0 = (u.pn & 3) * 256 + wc * 32 + 8 * fq;
#pragma unroll
        for (int ai = 0; ai < 2; ++ai)
#pragma unroll
            for (int m = 0; m < 4; ++m) { const size_t R = (size_t)(rowbase + b * L + k0 + ai * HALF + m * 16);
#pragma unroll
                for (int bj = 0; bj < 2; ++bj) { const size_t off = R * 1024 + n0 + bj * HALF;
                    const u32x4 zz = *(const u32x4*)(Z + off);
                    const f32x4 v0 = acc[ai][bj][m][0], v1 = acc[ai][bj][m][1];
                    u32x4 w;
                    w.x = pkbf(v0[0] * silu_f(bflo(zz.x)), v0[1] * silu_f(bfhi(zz.x))); w.y = pkbf(v0[2] * silu_f(bflo(zz.y)), v0[3] * silu_f(bfhi(zz.y)));
                    w.z = pkbf(v1[0] * silu_f(bflo(zz.z)), v1[1] * silu_f(bfhi(zz.z))); w.w = pkbf(v1[2] * silu_f(bflo(zz.w)), v1[3] * silu_f(bfhi(zz.w)));
                    *(u32x4*)(OG + off) = w; } }
    }
};
struct EpiDftSym {
    static constexpr bool PERM = true, AFTER_DRAIN = false;
    const bf16_t* Pb; const float* TA; const bf16_t* Z; bf16_t* OG;
    __device__ __forceinline__ void operator()(const f32x4 (&acc)[2][2][4][2], const Unit& u, int wr, int wc, int fr, int fq) const {
        const int k0 = u.pm * BM + wr * 64 + fr; const int b = u.pn >> 2; const int c0 = u.pn * BM + wc * 32 + 8 * fq; const int n0 = c0 & 1023;
#pragma unroll
        for (int bj = 0; bj < 2; ++bj) {
            const f32x4 t0 = *(const f32x4*)(TA + c0 + bj * HALF), t1 = *(const f32x4*)(TA + c0 + bj * HALF + 4);
#pragma unroll
            for (int ai = 0; ai < 2; ++ai)
#pragma unroll
                for (int m = 0; m < 4; ++m) { const int k = k0 + ai * HALF + m * 16; const float sg = (k & 1) ? -1.f : 1.f;
                    const u32x4 pp = *(const u32x4*)(Pb + (size_t)k * 8192 + c0 + bj * HALF);
                    const f32x4 q0 = acc[ai][bj][m][0], q1 = acc[ai][bj][m][1];
                    float pt[8];
                    pt[0] = bflo(pp.x) + sg * t0[0]; pt[1] = bfhi(pp.x) + sg * t0[1]; pt[2] = bflo(pp.y) + sg * t0[2]; pt[3] = bfhi(pp.y) + sg * t0[3];
                    pt[4] = bflo(pp.z) + sg * t1[0]; pt[5] = bfhi(pp.z) + sg * t1[1]; pt[6] = bflo(pp.w) + sg * t1[2]; pt[7] = bfhi(pp.w) + sg * t1[3];
                    { const size_t off = (size_t)(b * 4096 + k) * 1024 + n0 + bj * HALF; const u32x4 zz = *(const u32x4*)(Z + off); u32x4 w;
                      w.x = pkbf((pt[0] - q0[0]) * silu_f(bflo(zz.x)), (pt[1] - q0[1]) * silu_f(bfhi(zz.x))); w.y = pkbf((pt[2] - q0[2]) * silu_f(bflo(zz.y)), (pt[3] - q0[3]) * silu_f(bfhi(zz.y)));
                      w.z = pkbf((pt[4] - q1[0]) * silu_f(bflo(zz.z)), (pt[5] - q1[1]) * silu_f(bfhi(zz.z))); w.w = pkbf((pt[6] - q1[2]) * silu_f(bflo(zz.w)), (pt[7] - q1[3]) * silu_f(bfhi(zz.w)));
                      *(u32x4*)(OG + off) = w; }
                    if (k >= 1) { const size_t off = (size_t)(b * 4096 + 4096 - k) * 1024 + n0 + bj * HALF; const u32x4 zz = *(const u32x4*)(Z + off); u32x4 w;
                      w.x = pkbf((pt[0] + q0[0]) * silu_f(bflo(zz.x)), (pt[1] + q0[1]) * silu_f(bfhi(zz.x))); w.y = pkbf((pt[2] + q0[2]) * silu_f(bflo(zz.y)), (pt[3] + q0[3]) * silu_f(bfhi(zz.y)));
                      w.z = pkbf((pt[4] + q1[0]) * silu_f(bflo(zz.z)), (pt[5] + q1[1]) * silu_f(bfhi(zz.z))); w.w = pkbf((pt[6] + q1[2]) * silu_f(bflo(zz.w)), (pt[7] + q1[3]) * silu_f(bfhi(zz.w)));
                      *(u32x4*)(OG + off) = w; }
                    asm volatile("" ::: "memory");
                }
        }
    }
};
template <class Epi, class Sched, bool ALIGN_EPI = false, bool SP2 = false>
__device__ __forceinline__ void gemm_phase(PG8_LAS unsigned char* lds, const Gemm g, const Sched& S, const Epi& E) {
    const int tid = opaque_tid(), wid = __builtin_amdgcn_readfirstlane(tid >> 6), lane = tid & 63, wr = wid >> 2, wc = wid & 3, fr = lane & 15, fq = lane >> 4;
    const int K = g.K, nt = K / BK;
    unsigned voffA[2], voffB[2];
#pragma unroll
    for (int i = 0; i < 2; ++i) { int R, C; stage_rc(tid * 16 + i * 8192, R, C); const int Rb = Epi::PERM ? ((R & ~31) + perm32(R & 31)) : R;
        voffA[i] = (unsigned)(R * K + C) * 2u; voffB[i] = (unsigned)(Rb * K + C) * 2u; }
    const size_t kstep = (size_t)(BK * 2);
    const size_t hstep = (size_t)HALF * K * 2;
    const size_t tstep = 2 * hstep;
    const unsigned ldsw = (unsigned)wid * 1024u;
    const int aoff = lds_byte(wr * 64 + fr, fq * 8), boff = lds_byte(wc * 32 + fr, fq * 8);
#define PG8_SA(b, h) (((b) * 2 + (h)) * HTB)
#define PG8_SB(b, h) ((4 + (b) * 2 + (h)) * HTB)
#define PG8_STAGE(bufoff, gbase, voff) do { _Pragma("unroll") for (int _i = 0; _i < 2; ++_i) \
        __builtin_amdgcn_global_load_lds((const unsigned*)((const char*)(gbase) + (voff)[_i]), (PG8_LAS unsigned*)(lds + (bufoff) + ldsw + _i * 8192), 16, 0, 0); } while (0)
#define PG8_LDA(dst, b, h) do { _Pragma("unroll") for (int m = 0; m < 4; ++m) _Pragma("unroll") for (int k = 0; k < 2; ++k) dst[m][k] = *(const PG8_LAS bf16x8*)(lds + PG8_SA(b, h) + aoff + m * 2048 + k * 1024); } while (0)
#define PG8_LDB(dst, b, h) do { _Pragma("unroll") for (int n = 0; n < 2; ++n) _Pragma("unroll") for (int k = 0; k < 2; ++k) dst[n][k] = *(const PG8_LAS bf16x8*)(lds + PG8_SB(b, h) + boff + n * 2048 + k * 1024); } while (0)
#define PG8_MMA(ai, bj, At, Bt) do { __builtin_amdgcn_s_setprio(1); _Pragma("unroll") for (int m = 0; m < 4; ++m) _Pragma("unroll") for (int n = 0; n < 2; ++n) _Pragma("unroll") for (int k = 0; k < 2; ++k) \
        acc[ai][bj][m][n] = __builtin_amdgcn_mfma_f32_16x16x32_bf16(Bt[n][k], At[m][k], acc[ai][bj][m][n], 0, 0, 0); __builtin_amdgcn_s_setprio(0); } while (0)
#define PG8_WAIT_V(n) asm volatile("s_waitcnt vmcnt(" #n ")" ::: "memory")
#define PG8_WAIT_L(n) asm volatile("s_waitcnt lgkmcnt(" #n ")" ::: "memory")
#define PG8_BAR __builtin_amdgcn_s_barrier()
#define PG8_SCHED __builtin_amdgcn_sched_barrier(0)
    Unit cur, nxt; int ui = 0;
    if (!S.next(0, cur)) return;
    f32x4 acc[2][2][4][2];
#pragma unroll
    for (int a = 0; a < 2; ++a)
#pragma unroll
        for (int b = 0; b < 2; ++b)
#pragma unroll
            for (int m = 0; m < 4; ++m)
#pragma unroll
                for (int n = 0; n < 2; ++n) acc[a][b][m][n] = (f32x4){0.f, 0.f, 0.f, 0.f};
    bf16x8 At[4][2], B0[2][2], B1[2][2];
    const char* cA = (const char*)g.A + (size_t)cur.pm * tstep; const char* cB = (const char*)g.Bt + (size_t)cur.pn * tstep;
    S.a_ready(cur);
    if constexpr (SP2) {
        PG8_STAGE(PG8_SB(0, 0), cB, voffB); PG8_STAGE(PG8_SB(0, 1), cB + hstep, voffB); PG8_STAGE(PG8_SA(0, 0), cA, voffA); PG8_STAGE(PG8_SA(0, 1), cA + hstep, voffA);
        if (wr == 1) PG8_BAR;
        PG8_WAIT_V(2); PG8_BAR;
        PG8_STAGE(PG8_SB(1, 0), cB + kstep, voffB); PG8_STAGE(PG8_SA(1, 0), cA + kstep, voffA); PG8_STAGE(PG8_SB(1, 1), cB + hstep + kstep, voffB);
        PG8_WAIT_V(6); PG8_BAR;
    } else {
        PG8_STAGE(PG8_SB(0, 0), cB, voffB); PG8_STAGE(PG8_SA(0, 0), cA, voffA); PG8_STAGE(PG8_SB(0, 1), cB + hstep, voffB); PG8_STAGE(PG8_SA(0, 1), cA + hstep, voffA);
        if (wr == 1) PG8_BAR;
        PG8_WAIT_V(4); PG8_BAR;
        PG8_STAGE(PG8_SB(1, 0), cB + kstep, voffB); PG8_STAGE(PG8_SA(1, 0), cA + kstep, voffA); PG8_STAGE(PG8_SB(1, 1), cB + hstep + kstep, voffB);
        PG8_WAIT_V(6); PG8_BAR;
    }
    for (;;) {
        const bool has_next = S.next(ui + 1, nxt);
        const char* nA = has_next ? (const char*)g.A + (size_t)nxt.pm * tstep : cA; const char* nB = has_next ? (const char*)g.Bt + (size_t)nxt.pn * tstep : cB;
        for (int t = 0; t < nt; t += 2) {
            const bool last = (t == nt - 2);
            const char* a1 = cA + (size_t)(t + 1) * kstep;
            const char* a2 = last ? nA : cA + (size_t)(t + 2) * kstep; const char* b2 = last ? nB : cB + (size_t)(t + 2) * kstep;
            const char* a3 = a2 + kstep; const char* b3 = b2 + kstep;
            if (last && has_next) S.a_ready(nxt);
            if constexpr (SP2) {
            PG8_LDB(B0, 0, 0); PG8_LDB(B1, 0, 1); PG8_SCHED; PG8_LDA(At, 0, 0); PG8_STAGE(PG8_SA(1, 1), a1 + hstep, voffA);
            PG8_WAIT_V(8); PG8_WAIT_L(0); PG8_BAR; PG8_MMA(0, 0, At, B0); PG8_MMA(0, 1, At, B1); PG8_BAR; PG8_SCHED;
            PG8_LDA(At, 0, 1); PG8_STAGE(PG8_SB(0, 0), b2, voffB); PG8_STAGE(PG8_SB(0, 1), b2 + hstep, voffB); PG8_STAGE(PG8_SA(0, 0), a2, voffA);
            PG8_WAIT_V(8); PG8_WAIT_L(0); PG8_BAR; PG8_MMA(1, 0, At, B0); PG8_MMA(1, 1, At, B1); PG8_BAR; PG8_SCHED;
            PG8_LDB(B0, 1, 0); PG8_LDB(B1, 1, 1); PG8_SCHED; PG8_LDA(At, 1, 0); PG8_STAGE(PG8_SA(0, 1), a2 + hstep, voffA);
            PG8_WAIT_V(8); PG8_WAIT_L(0); PG8_BAR; PG8_MMA(0, 0, At, B0); PG8_MMA(0, 1, At, B1); PG8_BAR; PG8_SCHED;
            PG8_LDA(At, 1, 1); PG8_STAGE(PG8_SB(1, 0), b3, voffB); PG8_STAGE(PG8_SB(1, 1), b3 + hstep, voffB); PG8_STAGE(PG8_SA(1, 0), a3, voffA);
            PG8_WAIT_V(8); PG8_WAIT_L(0); PG8_BAR; PG8_MMA(1, 0, At, B0); PG8_MMA(1, 1, At, B1); PG8_BAR; PG8_SCHED;
            } else {
            PG8_LDB(B0, 0, 0); PG8_SCHED; PG8_LDA(At, 0, 0); PG8_STAGE(PG8_SA(1, 1), a1 + hstep, voffA);
            PG8_WAIT_L(8); PG8_BAR; PG8_WAIT_L(0); PG8_MMA(0, 0, At, B0); PG8_BAR; PG8_SCHED;
            PG8_LDB(B1, 0, 1); PG8_STAGE(PG8_SB(0, 0), b2, voffB);
            PG8_BAR; PG8_WAIT_L(0); PG8_MMA(0, 1, At, B1); PG8_BAR;
            PG8_LDA(At, 0, 1); PG8_STAGE(PG8_SA(0, 0), a2, voffA);
            PG8_BAR; PG8_WAIT_L(0); PG8_MMA(1, 0, At, B0); PG8_BAR; PG8_SCHED;
            PG8_STAGE(PG8_SB(0, 1), b2 + hstep, voffB);
            PG8_WAIT_V(6); PG8_BAR; PG8_MMA(1, 1, At, B1); PG8_BAR;
            PG8_LDB(B0, 1, 0); PG8_SCHED; PG8_LDA(At, 1, 0); PG8_STAGE(PG8_SA(0, 1), a2 + hstep, voffA);
            PG8_WAIT_L(8); PG8_BAR; PG8_WAIT_L(0); PG8_MMA(0, 0, At, B0); PG8_BAR; PG8_SCHED;
            PG8_LDB(B1, 1, 1); PG8_STAGE(PG8_SB(1, 0), b3, voffB);
            PG8_BAR; PG8_WAIT_L(0); PG8_MMA(0, 1, At, B1); PG8_BAR;
            PG8_LDA(At, 1, 1); PG8_STAGE(PG8_SA(1, 0), a3, voffA);
            PG8_BAR; PG8_WAIT_L(0); PG8_MMA(1, 0, At, B0); PG8_BAR; PG8_SCHED;
            PG8_STAGE(PG8_SB(1, 1), b3 + hstep, voffB);
            PG8_WAIT_V(6); PG8_BAR; PG8_MMA(1, 1, At, B1); PG8_BAR;
            }
        }
        if constexpr (ALIGN_EPI) { if (wr == 0) PG8_BAR; }
        if constexpr (!Epi::AFTER_DRAIN) { E(acc, cur, wr, wc, fr, fq); S.done(cur); }
        if (!has_next) break;
#pragma unroll
        for (int a = 0; a < 2; ++a)
#pragma unroll
            for (int b = 0; b < 2; ++b)
#pragma unroll
                for (int m = 0; m < 4; ++m)
#pragma unroll
                    for (int n = 0; n < 2; ++n) acc[a][b][m][n] = (f32x4){0.f, 0.f, 0.f, 0.f};
        cur = nxt; cA = nA; cB = nB; ++ui;
        if constexpr (ALIGN_EPI) { if (wr == 1) PG8_BAR; }
    }
    PG8_WAIT_V(0);
    if constexpr (!ALIGN_EPI) { if (wr == 0) PG8_BAR; }
    PG8_BAR;
    if constexpr (Epi::AFTER_DRAIN) { E.fused(acc, cur, wr, wc, fr, fq, lds, wid, lane); S.done(cur); }
#undef PG8_SA
#undef PG8_SB
#undef PG8_STAGE
#undef PG8_LDA
#undef PG8_LDB
#undef PG8_MMA
#undef PG8_WAIT_V
#undef PG8_WAIT_L
#undef PG8_BAR
#undef PG8_SCHED
}
}
#define LAS __attribute__((address_space(3)))
namespace att {
using bf16x8 = __attribute__((ext_vector_type(8))) short;
using s16x4 = __attribute__((ext_vector_type(4))) short;
using f32x16 = __attribute__((ext_vector_type(16))) float;
using u32x4 = __attribute__((ext_vector_type(4))) unsigned;
typedef unsigned short bf16_t;
__device__ __forceinline__ int crow(int r, int hi) { return (r & 3) + 8 * (r >> 2) + 4 * hi; }
constexpr int KSLOT = 8192, VSLOT = 16384, LDS_K = 0, LDS_V = 3 * KSLOT, LDS_WS = LDS_V + 3 * VSLOT, LDS_O1 = LDS_WS + 2048;
struct Args { const bf16_t* Q; const bf16_t* K; const bf16_t* V; const bf16_t* Z; bf16_t* O; const float* gain; float lam; float oml; int n_units; };

__device__ __forceinline__ void qkt(f32x16& p0, f32x16& p1, const LAS char* Kslot, const bf16x8* qr, const f32x16& negm, int r32, int hi) {
    const LAS char* kb = Kslot + hi * 1024 + r32 * 16;
    bf16x8 kf[8];
#pragma unroll
    for (int d0 = 0; d0 < 4; ++d0) { kf[2 * d0] = *(const LAS bf16x8*)(kb + d0 * 2048); kf[2 * d0 + 1] = *(const LAS bf16x8*)(kb + d0 * 2048 + 512); }
    asm volatile("s_waitcnt lgkmcnt(0)" ::: "memory"); __builtin_amdgcn_sched_barrier(0);
    p0 = __builtin_amdgcn_mfma_f32_32x32x16_bf16(kf[0], qr[0], negm, 0, 0, 0); p1 = __builtin_amdgcn_mfma_f32_32x32x16_bf16(kf[1], qr[0], negm, 0, 0, 0);
#pragma unroll
    for (int d0 = 1; d0 < 4; ++d0) { p0 = __builtin_amdgcn_mfma_f32_32x32x16_bf16(kf[2 * d0], qr[d0], p0, 0, 0, 0); p1 = __builtin_amdgcn_mfma_f32_32x32x16_bf16(kf[2 * d0 + 1], qr[d0], p1, 0, 0, 0); }
}
__device__ __forceinline__ void kload(bf16x8* kf, const LAS char* Kslot, int r32, int hi) {
    const LAS char* kb = Kslot + hi * 1024 + r32 * 16;
#pragma unroll
    for (int d0 = 0; d0 < 4; ++d0) { kf[2 * d0] = *(const LAS bf16x8*)(kb + d0 * 2048); kf[2 * d0 + 1] = *(const LAS bf16x8*)(kb + d0 * 2048 + 512); }
}
__device__ __forceinline__ void qk_mm(f32x16& p0, f32x16& p1, const bf16x8* kf, const bf16x8* qr) {
    const f32x16 z = f32x16{};
    p0 = __builtin_amdgcn_mfma_f32_32x32x16_bf16(kf[0], qr[0], z, 0, 0, 0); p1 = __builtin_amdgcn_mfma_f32_32x32x16_bf16(kf[1], qr[0], z, 0, 0, 0);
#pragma unroll
    for (int d0 = 1; d0 < 4; ++d0) { p0 = __builtin_amdgcn_mfma_f32_32x32x16_bf16(kf[2 * d0], qr[d0], p0, 0, 0, 0); p1 = __builtin_amdgcn_mfma_f32_32x32x16_bf16(kf[2 * d0 + 1], qr[d0], p1, 0, 0, 0); }
}
__device__ __forceinline__ float rowmax(const f32x16& p0, const f32x16& p1) {
    float a = fmaxf(p0[0], p1[0]);
#pragma unroll
    for (int r = 1; r < 16; ++r) a = fmaxf(a, fmaxf(p0[r], p1[r]));
    auto rr = __builtin_amdgcn_permlane32_swap(__float_as_uint(a), __float_as_uint(a), false, false);
    return fmaxf(__uint_as_float(rr[0]), __uint_as_float(rr[1]));
}
#define ATT_VRD(buf, d0) do { _Pragma("unroll") for (int ks = 0; ks < 4; ++ks) { \
        asm volatile("ds_read_b64_tr_b16 %0,%1 offset:%c2" : "=&v"(lo[buf][ks]) : "v"(vb), "i"((d0) * 4096 + ks * 1024) : "memory"); \
        asm volatile("ds_read_b64_tr_b16 %0,%1 offset:%c2" : "=&v"(hi[buf][ks]) : "v"(vb), "i"((d0) * 4096 + ks * 1024 + 512) : "memory"); } } while (0)
#define ATT_PK(b, k) (bf16x8){lo[b][k][0], lo[b][k][1], lo[b][k][2], lo[b][k][3], hi[b][k][0], hi[b][k][1], hi[b][k][2], hi[b][k][3]}
#define ATT_MM2(da, db) do { \
        o[da] = __builtin_amdgcn_mfma_f32_32x32x16_bf16(pa0, ATT_PK(0, 0), o[da], 0, 0, 0); o[db] = __builtin_amdgcn_mfma_f32_32x32x16_bf16(pa0, ATT_PK(1, 0), o[db], 0, 0, 0); \
        o[da] = __builtin_amdgcn_mfma_f32_32x32x16_bf16(pa1, ATT_PK(0, 1), o[da], 0, 0, 0); o[db] = __builtin_amdgcn_mfma_f32_32x32x16_bf16(pa1, ATT_PK(1, 1), o[db], 0, 0, 0); \
        o[da] = __builtin_amdgcn_mfma_f32_32x32x16_bf16(pa2, ATT_PK(0, 2), o[da], 0, 0, 0); o[db] = __builtin_amdgcn_mfma_f32_32x32x16_bf16(pa2, ATT_PK(1, 2), o[db], 0, 0, 0); \
        o[da] = __builtin_amdgcn_mfma_f32_32x32x16_bf16(pa3, ATT_PK(0, 3), o[da], 0, 0, 0); o[db] = __builtin_amdgcn_mfma_f32_32x32x16_bf16(pa3, ATT_PK(1, 3), o[db], 0, 0, 0); } while (0)
__device__ __forceinline__ void pv(f32x16* o, int vb, bf16x8 pa0, bf16x8 pa1, bf16x8 pa2, bf16x8 pa3) {
    s16x4 lo[2][4], hi[2][4];
    ATT_VRD(0, 0);
    ATT_VRD(1, 1);
    asm volatile("s_waitcnt lgkmcnt(0)" ::: "memory"); __builtin_amdgcn_sched_barrier(0);
    ATT_MM2(0, 1); __builtin_amdgcn_sched_barrier(0);
    ATT_VRD(0, 2);
    ATT_VRD(1, 3);
    asm volatile("s_waitcnt lgkmcnt(0)" ::: "memory"); __builtin_amdgcn_sched_barrier(0);
    ATT_MM2(2, 3);
}
#undef ATT_MM2
#undef ATT_VRD
#undef ATT_PK
__device__ __forceinline__ void attn_pass(const Args& A, int z, int b, int h, int qrow0, bool isctx, LAS char* shm, f32x16* o) {
    const int tid = opaque_tid(), lane = tid & 63, r32 = lane & 31, hi = lane >> 5; const int wid = __builtin_amdgcn_readfirstlane(tid >> 6);
    const int NT = isctx ? 4 : 68;
    LAS float* wsf = (LAS float*)(shm + LDS_WS) + wid * 64;
    const int vb0 = (int)(unsigned)(size_t)(shm + LDS_V) + ((lane >> 4) & 1) * 32 + (lane & 3) * 8 + (4 * hi + ((lane & 15) >> 2)) * 64;
    const bf16_t* Qw = A.Q + (size_t)(qrow0 + wid * 32 + r32) * 1024 + h * 128 + z * 64;
    bf16x8 qr[4];
#pragma unroll
    for (int d0 = 0; d0 < 4; ++d0) qr[d0] = *(const bf16x8*)(Qw + d0 * 16 + hi * 8);
    const bf16_t* Kh = A.K + h * 128 + z * 64 + wid * 8 + (size_t)lane * 1024;
    const int pc0 = wid, pc1 = wid + 8;
    const bf16_t* Vh0 = A.V + h * 128 + (pc0 >> 2) * 32 + (lane & 3) * 8 + (size_t)(16 * (pc0 & 3) + (lane >> 2)) * 1024;
    const bf16_t* Vh1 = A.V + h * 128 + (pc1 >> 2) * 32 + (lane & 3) * 8 + (size_t)(16 * (pc1 & 3) + (lane >> 2)) * 1024;
    const int ctxrow = TL + b * 256, latrow = b * 4096;
#define ATT_TROW(t) ((isctx || (t) < 4) ? (ctxrow + 64 * (t)) : (latrow + 64 * ((t) - 4)))
#define ATT_DMA(t, slot, vslot) do { const size_t ro_ = (size_t)ATT_TROW(t) * 1024; \
        __builtin_amdgcn_global_load_lds((const unsigned*)(Kh + ro_), (LAS unsigned*)(shm + LDS_K + (slot) * KSLOT + wid * 1024), 16, 0, 0); \
        __builtin_amdgcn_global_load_lds((const unsigned*)(Vh0 + ro_), (LAS unsigned*)(shm + LDS_V + (vslot) * VSLOT + pc0 * 1024), 16, 0, 0); \
        __builtin_amdgcn_global_load_lds((const unsigned*)(Vh1 + ro_), (LAS unsigned*)(shm + LDS_V + (vslot) * VSLOT + pc1 * 1024), 16, 0, 0); } while (0)
    float mhat = 0.f, l_reg = 0.f;
#pragma unroll
    for (int d = 0; d < 4; ++d) o[d] = f32x16{};
    ATT_DMA(0, 0, 0);
    if (NT > 1) ATT_DMA(1, 1, 1);
    asm volatile("s_waitcnt vmcnt(0) lgkmcnt(0)\n\ts_barrier" ::: "memory");
    f32x16 sc0, sc1;
    { bf16x8 kf[8]; kload(kf, shm + LDS_K, r32, hi); qk_mm(sc0, sc1, kf, qr); }
    if (NT > 2) ATT_DMA(2, 2, 2);
    int sl_cur = 0;
#pragma unroll 1
    for (int t = 0; t < NT; ++t) {
        const int sl_n1 = (sl_cur == 2) ? 0 : sl_cur + 1;
        if (t > 0) {
            asm volatile("s_waitcnt vmcnt(0) lgkmcnt(0)\n\ts_barrier" ::: "memory");
            const int sl_p2 = (sl_cur == 0) ? 2 : sl_cur - 1;
            if (t + 2 < NT) ATT_DMA(t + 2, sl_p2, sl_p2);
        }
        bf16x8 kf[8];
        kload(kf, shm + LDS_K + sl_n1 * KSLOT, r32, hi);
        const float rm = rowmax(sc0, sc1);
        if (t == 0) { mhat = rm; }
        else if (__any(rm - mhat > 8.f)) {
            const float dl = fmaxf(rm - mhat, 0.f); mhat += dl;
            const float f = __builtin_amdgcn_exp2f(-dl); l_reg *= f;
            if (hi == 0) wsf[r32] = f;
            asm volatile("s_waitcnt lgkmcnt(0)" ::: "memory");
#pragma unroll
            for (int r = 0; r < 16; ++r) { const float fr_ = wsf[crow(r, hi)];
#pragma unroll
                for (int d = 0; d < 4; ++d) o[d][r] *= fr_; }
            asm volatile("s_waitcnt lgkmcnt(0)" ::: "memory");
        }
        __builtin_amdgcn_sched_barrier(0);
        f32x16 pn0, pn1;
        qk_mm(pn0, pn1, kf, qr);
        f32x2_t sacc = {0.f, 0.f};
#pragma unroll
        for (int r = 0; r < 16; r += 2) { sc0[r] = __builtin_amdgcn_exp2f(sc0[r] - mhat); sc0[r + 1] = __builtin_amdgcn_exp2f(sc0[r + 1] - mhat); sc1[r] = __builtin_amdgcn_exp2f(sc1[r] - mhat); sc1[r + 1] = __builtin_amdgcn_exp2f(sc1[r + 1] - mhat);
            sacc += (f32x2_t){sc0[r], sc0[r + 1]}; sacc += (f32x2_t){sc1[r], sc1[r + 1]}; }
        l_reg += sacc.x + sacc.y;
        u32x4 pw0, pw1, pw2, pw3;
        pw0 = (u32x4){pkbf(sc0[0], sc0[1]), pkbf(sc0[2], sc0[3]), pkbf(sc0[4], sc0[5]), pkbf(sc0[6], sc0[7])};
        pw1 = (u32x4){pkbf(sc0[8], sc0[9]), pkbf(sc0[10], sc0[11]), pkbf(sc0[12], sc0[13]), pkbf(sc0[14], sc0[15])};
        pw2 = (u32x4){pkbf(sc1[0], sc1[1]), pkbf(sc1[2], sc1[3]), pkbf(sc1[4], sc1[5]), pkbf(sc1[6], sc1[7])};
        pw3 = (u32x4){pkbf(sc1[8], sc1[9]), pkbf(sc1[10], sc1[11]), pkbf(sc1[12], sc1[13]), pkbf(sc1[14], sc1[15])};
#pragma unroll
        for (int i = 0; i < 8; ++i) { __builtin_amdgcn_sched_group_barrier(0x008, 1, 0); __builtin_amdgcn_sched_group_barrier(0x002, 14, 0); }
        __builtin_amdgcn_sched_barrier(0);
        pv(o, vb0 + sl_cur * VSLOT, __builtin_bit_cast(bf16x8, pw0), __builtin_bit_cast(bf16x8, pw1), __builtin_bit_cast(bf16x8, pw2), __builtin_bit_cast(bf16x8, pw3));
        sc0 = pn0; sc1 = pn1;
        sl_cur = sl_n1;
    }
    asm volatile("s_waitcnt lgkmcnt(0)\n\ts_barrier" ::: "memory");
#undef ATT_DMA
#undef ATT_TROW
    { auto rr = __builtin_amdgcn_permlane32_swap(__float_as_uint(l_reg), __float_as_uint(l_reg), false, false); l_reg = __uint_as_float(rr[0]) + __uint_as_float(rr[1]); }
    asm volatile("s_waitcnt lgkmcnt(0)" ::: "memory");
    if (hi == 0) wsf[32 + r32] = l_reg;
    asm volatile("s_waitcnt lgkmcnt(0)" ::: "memory");
#pragma unroll
    for (int r = 0; r < 16; ++r) { const float rl = 1.0f / wsf[32 + crow(r, hi)];
#pragma unroll
        for (int d = 0; d < 4; ++d) o[d][r] *= rl; }
    asm volatile("s_waitcnt lgkmcnt(0)" ::: "memory");
}
__device__ __forceinline__ void attn_unit(const Args& A, int b, int h, int qb, bool isctx, LAS char* shm) {
    const int tid = opaque_tid(), lane = tid & 63, r32 = lane & 31, hi = lane >> 5; const int wid = __builtin_amdgcn_readfirstlane(tid >> 6);
    const int qrow0 = isctx ? (TL + b * 256) : (b * 4096 + qb * 256);
    f32x16 o[4];
    LAS unsigned* o1s = (LAS unsigned*)(shm + LDS_O1) + wid * 2048 + lane;
    attn_pass(A, 0, b, h, qrow0, isctx, shm, o);
#pragma unroll
    for (int d = 0; d < 4; ++d)
#pragma unroll
        for (int r = 0; r < 16; r += 2) o1s[(d * 8 + (r >> 1)) * 64] = pkbf(o[d][r], o[d][r + 1]);
    asm volatile("s_waitcnt lgkmcnt(0)" ::: "memory");
    attn_pass(A, 1, b, h, qrow0, isctx, shm, o);
    float ss[16];
#pragma unroll
    for (int r = 0; r < 16; r += 2) { float s0 = 0.f, s1 = 0.f;
#pragma unroll
        for (int d = 0; d < 4; ++d) { const unsigned pk = o1s[(d * 8 + (r >> 1)) * 64];
            const float v0 = bflo(pk) - A.lam * o[d][r], v1 = bfhi(pk) - A.lam * o[d][r + 1]; o[d][r] = v0; o[d][r + 1] = v1; s0 += v0 * v0; s1 += v1 * v1; }
        ss[r] = s0; ss[r + 1] = s1; }
#pragma unroll
    for (int msk = 1; msk < 32; msk <<= 1)
#pragma unroll
        for (int r = 0; r < 16; ++r) ss[r] += __shfl_xor(ss[r], msk);
    float gn[4];
#pragma unroll
    for (int d = 0; d < 4; ++d) gn[d] = A.gain[d * 32 + r32] * A.oml;
#pragma unroll
    for (int r = 0; r < 16; ++r) {
        const float rstd = rsqrtf(ss[r] * (1.0f / 128.0f) + 1e-5f);
        const size_t off = (size_t)(qrow0 + wid * 32 + crow(r, hi)) * 1024 + h * 128 + r32;
#pragma unroll
        for (int d = 0; d < 4; ++d) { const float zv = bf1(A.Z[off + d * 32]); const float v = o[d][r] * rstd * gn[d] * silu_f(zv);
            A.O[off + d * 32] = (bf16_t)(pkbf(v, 0.f) & 0xffffu); }
        asm volatile("" ::: "memory");
    }
}
__device__ __forceinline__ void attn_phase(const Args& A, LAS char* shm, int G, int bid) {
    const int vcu = (G % 8 == 0) ? (bid % 8) * (G / 8) + bid / 8 : bid;
#pragma unroll 1
    for (int u = vcu; u < A.n_units; u += G) {
        const bool isctx = u >= 1024; const int bh = isctx ? (u - 1024) : (u >> 4); const int qb = isctx ? 0 : (u & 15);
        attn_unit(A, bh >> 3, bh & 7, qb, isctx, shm);
        asm volatile("s_waitcnt vmcnt(0) lgkmcnt(0)\n\ts_barrier" ::: "memory");
    }
}
}
typedef unsigned short bf16_t;
typedef float f32x4 __attribute__((ext_vector_type(4)));
typedef unsigned u32x4 __attribute__((ext_vector_type(4)));
typedef unsigned u32x2 __attribute__((ext_vector_type(2)));
constexpr size_t MiB = 1u << 20;
constexpr size_t WS_CTL = 0, WS_MOD = 1 * MiB, WS_ROPE = 1 * MiB + 512 * 1024, WS_BZ = 2 * MiB;
constexpr size_t WS_WDAIN = 9 * MiB, WS_WDAOUT = 25 * MiB, WS_WFNT = 29 * MiB, WS_WFNZ = 33 * MiB, WS_WFNOUT = 35 * MiB, WS_WRWIN = 37 * MiB, WS_WRWOUT = 46 * MiB;
constexpr size_t WS_XC = 48 * MiB, WS_HB = 56 * MiB, WS_BIG = 124 * MiB;
constexpr size_t WS_Q = WS_BIG, WS_K = WS_BIG + 68 * MiB, WS_V = WS_BIG + 136 * MiB, WS_Z = WS_BIG + 204 * MiB;
constexpr size_t WS_ATL = WS_BIG, WS_ATC = WS_BIG + 128 * MiB, WS_ZB = WS_BIG + 136 * MiB, WS_DFTL = 396 * MiB, WS_DFTC = 460 * MiB, WS_FOLD = WS_BIG + 204 * MiB;
constexpr size_t WS_P = WS_BIG, WS_Y1 = 413 * MiB, WS_END = 482 * MiB;
constexpr int RWN = 4352;
constexpr int LDS_BYTES = 147456;

struct Params { const float* in[28]; float* out; unsigned char* ws; };

__device__ __forceinline__ float wave_sum(float v) {
#pragma unroll
    for (int o = 1; o < 64; o <<= 1) v += __shfl_xor(v, o);
    return v;
}
__device__ __forceinline__ void tr_item(const float* W, int ldw, int N, bf16_t* WT, int ldt, LAS float* scr, int item, int lane) {
    const int nblk = N / 32, kb = item / nblk, nb = item % nblk, k0 = 64 * kb, n0 = 32 * nb;
#pragma unroll 8
    for (int i = 0; i < 32; ++i) { const int kk = 2 * i + (lane >> 5); scr[kk * 33 + (lane & 31)] = W[(size_t)(k0 + kk) * ldw + n0 + (lane & 31)]; }
    asm volatile("s_waitcnt lgkmcnt(0)" ::: "memory");
    const int c = lane & 7;
#pragma unroll
    for (int j = 0; j < 4; ++j) { const int n = (lane >> 3) + 8 * j; const LAS float* s = scr + (8 * c) * 33 + n;
        u32x4 o; o.x = pkbf(s[0 * 33], s[1 * 33]); o.y = pkbf(s[2 * 33], s[3 * 33]); o.z = pkbf(s[4 * 33], s[5 * 33]); o.w = pkbf(s[6 * 33], s[7 * 33]);
        *(u32x4*)(WT + (size_t)(n0 + n) * ldt + k0 + 8 * c) = o; }
    asm volatile("s_waitcnt lgkmcnt(0)" ::: "memory");
}
__device__ __forceinline__ void prologue(const Params& p, LAS char* lds, int G, int bid) {
    const int tid = opaque_tid(), lane = tid & 63, wid = tid >> 6;
    unsigned char* ws = p.ws;
    {
        LAS float* scr = (LAS float*)(lds + wid * 8448);
        const int gw = bid * 8 + wid, NGW = G * 8;
        for (int it = gw; it < 8832; it += NGW) {
            int r = it;
            if (r < 2048) { tr_item(p.in[8], 4096, 4096, (bf16_t*)(ws + WS_WDAIN), 1024, scr, r, lane); continue; } r -= 2048;
            if (r < 2048) { tr_item(p.in[8] + (size_t)1024 * 4096, 4096, 4096, (bf16_t*)(ws + WS_WDAIN + 8 * MiB), 1024, scr, r, lane); continue; } r -= 2048;
            if (r < 512) { tr_item(p.in[12], 1024, 1024, (bf16_t*)(ws + WS_WDAOUT), 1024, scr, r, lane); continue; } r -= 512;
            if (r < 512) { tr_item(p.in[12] + (size_t)1024 * 1024, 1024, 1024, (bf16_t*)(ws + WS_WDAOUT + 2 * MiB), 1024, scr, r, lane); continue; } r -= 512;
            if (r < 512) { tr_item(p.in[13] + 1024, 2048, 1024, (bf16_t*)(ws + WS_WFNZ), 1024, scr, r, lane); continue; } r -= 512;
            if (r < 512) { tr_item(p.in[15], 1024, 1024, (bf16_t*)(ws + WS_WFNOUT), 1024, scr, r, lane); continue; } r -= 512;
            if (r < 2176) { tr_item(p.in[16], RWN, RWN, (bf16_t*)(ws + WS_WRWIN), 1024, scr, r, lane); continue; } r -= 2176;
            tr_item(p.in[27], 1024, 1024, (bf16_t*)(ws + WS_WRWOUT), 1024, scr, r, lane);
        }
    }
    __syncthreads();
    for (int it = bid; it < 256; it += G) {
        const int g = it >> 5, cs = (it >> 4) & 1, kq = it & 15;
        LAS float* Wcs = (LAS float*)lds; LAS float* win = (LAS float*)(lds + 65536); LAS float* tab = (LAS float*)(lds + 65536 + 33024);
        if (tid < 128) { float s, c; sincospif((float)tid / 64.f, &s, &c); tab[tid] = (cs ? s : c) * 0.08838834764831845f; }
        __syncthreads();
        {
            const int e = tid & 127, cq = tid >> 7; float acc[32];
#pragma unroll
            for (int i = 0; i < 32; ++i) acc[i] = 0.f;
            const float* Wg = p.in[14] + (size_t)g * 128 * 128;
            for (int m = 0; m < 128; ++m) { const float wg = Wg[m * 128 + e];
#pragma unroll
                for (int i = 0; i < 32; ++i) acc[i] += tab[(m * (cq + 4 * i)) & 127] * wg; }
#pragma unroll
            for (int i = 0; i < 32; ++i) Wcs[(cq + 4 * i) * 128 + e] = acc[i];
        }
#pragma unroll
        for (int i = 0; i < 16; ++i) { const int idx = tid + 512 * i, kin = idx >> 7, c = idx & 127; win[kin * 129 + c] = p.in[13][(size_t)(kq * 64 + kin) * 2048 + g * 128 + c]; }
        __syncthreads();
        {
            const int kin = tid & 63, eg = tid >> 6; float acc[16];
#pragma unroll
            for (int i = 0; i < 16; ++i) acc[i] = 0.f;
            for (int c = 0; c < 128; ++c) { const float a = win[kin * 129 + c];
#pragma unroll
                for (int i = 0; i < 16; ++i) acc[i] += a * Wcs[c * 128 + eg * 16 + i]; }
            bf16_t* WT = (bf16_t*)(ws + WS_WFNT);
#pragma unroll
            for (int i = 0; i < 16; ++i) WT[(size_t)(cs * 1024 + g * 128 + eg * 16 + i) * 1024 + kq * 64 + kin] = (bf16_t)(pkbf(acc[i], 0.f) & 0xffffu);
        }
        __syncthreads();
    }
    {
        LAS float* tc = (LAS float*)lds; LAS float* ts = (LAS float*)(lds + 16384);
        for (int j = tid; j < 4096; j += 512) { float s, c; sincospif((float)j / 2048.f, &s, &c); tc[j] = c; ts[j] = -s; }
        __syncthreads();
        bf16_t* DL = (bf16_t*)(ws + WS_DFTL); bf16_t* DC = (bf16_t*)(ws + WS_DFTC);
        for (int k = bid; k < 2048; k += G) {
            const int j0 = (tid & 255) * 8; const bool sn = tid >= 256; float v8[8];
#pragma unroll
            for (int i = 0; i < 8; ++i) { const int idx = (k * (j0 + i)) & 4095; v8[i] = (sn ? -ts[idx] : tc[idx]) * 0.015625f; }
            u32x4 o; o.x = pkbf(v8[0], v8[1]); o.y = pkbf(v8[2], v8[3]); o.z = pkbf(v8[4], v8[5]); o.w = pkbf(v8[6], v8[7]);
            *(u32x4*)(DL + (sn ? (size_t)2048 * 2048 : (size_t)0) + (size_t)k * 2048 + j0) = o;
        }
        for (int k = bid; k < 256; k += G) {
            if (tid < 64) { const int cs = tid >> 5, l0 = (tid & 31) * 8; float v8[8];
#pragma unroll
                for (int i = 0; i < 8; ++i) { const int idx = ((k * (l0 + i)) & 255) * 16; v8[i] = (cs ? ts[idx] : tc[idx]) * 0.0625f; }
                u32x4 o; o.x = pkbf(v8[0], v8[1]); o.y = pkbf(v8[2], v8[3]); o.z = pkbf(v8[4], v8[5]); o.w = pkbf(v8[6], v8[7]);
                *(u32x4*)(DC + (size_t)k * 512 + cs * 256 + l0) = o; }
        }
        __syncthreads();
    }
    {
        LAS float* sc = (LAS float*)lds; LAS float* red = (LAS float*)(lds + 40960);
        bool have = false;
        for (int it = bid; it < 192; it += G) {
            if (!have) { for (int idx = tid; idx < 9216; idx += 512) { const int r = idx >> 10, k = idx & 1023; const float cv = r < 8 ? p.in[1][r * 1024 + k] : p.in[3][k]; sc[idx] = cv / (1.f + __expf(-cv)); } have = true; __syncthreads(); }
            const int i = it / 48, n = (it % 48) * 64 + (tid & 63), kq = tid >> 6;
            const float* w = p.in[5] + (size_t)i * 1024 * 3072 + n;
            float acc[9];
#pragma unroll
            for (int r = 0; r < 9; ++r) acc[r] = 0.f;
            for (int k = kq * 128; k < kq * 128 + 128; ++k) { const float wv = w[(size_t)k * 3072];
#pragma unroll
                for (int r = 0; r < 9; ++r) acc[r] += sc[r * 1024 + k] * wv; }
#pragma unroll
            for (int r = 0; r < 9; ++r) red[(kq * 9 + r) * 64 + (tid & 63)] = acc[r];
            __syncthreads();
            for (int idx = tid; idx < 576; idx += 512) { const int r = idx >> 6, col = idx & 63; float s = 0.f;
#pragma unroll
                for (int q = 0; q < 8; ++q) s += red[(q * 9 + r) * 64 + col];
                const int nn = (it % 48) * 64 + col;
                ((float*)(ws + WS_MOD))[(size_t)(i * 9 + r) * 3072 + nn] = s + p.in[6][i * 3072 + nn]; }
            __syncthreads();
        }
    }
    if (bid == 0) { for (int t = tid; t < 1024; t += 512) { const int pos = t >> 4, qd = t & 15; const float inv = powf(10000.f, -(float)qd / 16.f); const float ang = (float)pos * inv;
            ((float*)(ws + WS_ROPE))[t] = cosf(ang); ((float*)(ws + WS_ROPE))[1024 + t] = sinf(ang); } }
}
__device__ __forceinline__ void ph_phase(const float* xlat, const float* xctx, const float* gain, const float* mod, bf16_t* Hb, int G, int bid) {
    const int tid_ = opaque_tid(); const int lane = tid_ & 63, wid = tid_ >> 6;
    for (int row = bid * 8 + wid; row < TT; row += G * 8) {
        const bool lat = row < TL; const float* src = lat ? xlat + (size_t)row * 1024 : xctx + (size_t)(row - TL) * 1024; const int r = lat ? (row >> 12) : 8;
        f32x4 v[4]; float ss = 0.f;
#pragma unroll
        for (int j = 0; j < 4; ++j) { v[j] = *(const f32x4*)(src + 4 * lane + 256 * j); ss += (v[j].x * v[j].x + v[j].y * v[j].y) + (v[j].z * v[j].z + v[j].w * v[j].w); }
        const float rstd = rsqrtf(wave_sum(ss) * (1.f / 1024.f) + 1e-6f);
        const float* mr = mod + r * 3072;
#pragma unroll
        for (int j = 0; j < 4; ++j) { const int col = 4 * lane + 256 * j; const f32x4 g4 = *(const f32x4*)(gain + col), sh = *(const f32x4*)(mr + col), sc = *(const f32x4*)(mr + 1024 + col);
            const f32x4 y = v[j] * rstd * g4 * (sc + 1.f) + sh; u32x2 o; o.x = pkbf(y.x, y.y); o.y = pkbf(y.z, y.w);
            *(u32x2*)(Hb + (size_t)row * 1024 + col) = o; }
    }
}
__device__ __forceinline__ void final_phase(float* x, const float* gain, int G, int bid) {
    const int tid_ = opaque_tid(); const int lane = tid_ & 63, wid = tid_ >> 6;
    for (int row = bid * 8 + wid; row < TL; row += G * 8) {
        float* src = x + (size_t)row * 1024; f32x4 v[4]; float ss = 0.f;
#pragma unroll
        for (int j = 0; j < 4; ++j) { v[j] = *(const f32x4*)(src + 4 * lane + 256 * j); ss += (v[j].x * v[j].x + v[j].y * v[j].y) + (v[j].z * v[j].z + v[j].w * v[j].w); }
        const float rstd = rsqrtf(wave_sum(ss) * (1.f / 1024.f) + 1e-6f);
#pragma unroll
        for (int j = 0; j < 4; ++j) { const int col = 4 * lane + 256 * j; const f32x4 g4 = *(const f32x4*)(gain + col); *(f32x4*)(src + col) = v[j] * rstd * g4; }
    }
}
__device__ __forceinline__ void fnet_fold(const bf16_t* ATL, bf16_t* E, bf16_t* O, float* TA, const bf16_t* Z, bf16_t* OG, int G, int bid) {
    const int tid_ = opaque_tid(); const int lane = tid_ & 63, wid = tid_ >> 6;
    for (int row = bid * 8 + wid; row < 8192; row += G * 8) {
        const bf16_t* a1 = ATL + (size_t)row * 8192; const bf16_t* a2 = a1 + 4096; bf16_t* e = E + (size_t)row * 2048; bf16_t* od = O + (size_t)row * 2048;
        float alt = 0.f;
#pragma unroll 2
        for (int it = 0; it < 4; ++it) {
            const int j0 = (it * 64 + lane) * 8;
            const u32x4 x = *(const u32x4*)(a1 + j0), y = *(const u32x4*)(a2 + j0);
            const int mb = 4096 - j0 - 8;
            const u32x4 xm = *(const u32x4*)(a1 + mb), ym = *(const u32x4*)(a2 + mb);
            const unsigned short xe = (j0 == 0) ? (unsigned short)0 : a1[4096 - j0], ye = (j0 == 0) ? (unsigned short)0 : a2[4096 - j0];
            float fa[8], fs[8], ma[8], ms[8];
#pragma unroll
            for (int i = 0; i < 4; ++i) { fa[2 * i] = bflo(x[i]); fa[2 * i + 1] = bfhi(x[i]); fs[2 * i] = bflo(y[i]); fs[2 * i + 1] = bfhi(y[i]);
                ma[2 * i] = bflo(xm[i]); ma[2 * i + 1] = bfhi(xm[i]); ms[2 * i] = bflo(ym[i]); ms[2 * i + 1] = bfhi(ym[i]); }
            float oc[8], os[8];
            oc[0] = fa[0] + bf1(xe); os[0] = fs[0] - bf1(ye);
#pragma unroll
            for (int i = 1; i < 8; ++i) { oc[i] = fa[i] + ma[8 - i]; os[i] = fs[i] - ms[8 - i]; }
            if (j0 == 0) { oc[0] = fa[0]; os[0] = 0.f; }
            u32x4 o; o.x = pkbf(oc[0], oc[1]); o.y = pkbf(oc[2], oc[3]); o.z = pkbf(oc[4], oc[5]); o.w = pkbf(oc[6], oc[7]);
            *(u32x4*)(e + j0) = o;
            alt += (bflo(o.x) - bfhi(o.x)) + (bflo(o.y) - bfhi(o.y)) + (bflo(o.z) - bfhi(o.z)) + (bflo(o.w) - bfhi(o.w));
            o.x = pkbf(os[0], os[1]); o.y = pkbf(os[2], os[3]); o.z = pkbf(os[4], os[5]); o.w = pkbf(os[6], os[7]);
            *(u32x4*)(od + j0) = o;
        }
        alt = wave_sum(alt);
        if (lane == 0) { const float amid = bf1(a1[2048]); TA[row] = amid * 0.015625f;
            const int b = row >> 10, n = row & 1023; const size_t off = (size_t)(b * 4096 + 2048) * 1024 + n;
            const float yv = (alt + amid) * 0.015625f * silu_f(bf1(Z[off]));
            OG[off] = (bf16_t)(pkbf(yv, 0.f) & 0xffffu); }
    }
}
__device__ __forceinline__ void sh8(const bf16_t* P, size_t row, int co, bool hm, bool hp, const float* mu, float* out) {
    const u32x4 z4 = {0u, 0u, 0u, 0u};
    const u32x4 c0 = *(const u32x4*)(P + row * RWN + co);
    const u32x4 cm = hm ? *(const u32x4*)(P + (row - 1) * RWN + co) : z4;
    const u32x4 cp = hp ? *(const u32x4*)(P + (row + 1) * RWN + co) : z4;
    const f32x4 m0 = *(const f32x4*)(mu + co), m1 = *(const f32x4*)(mu + co + 4);
#pragma unroll
    for (int i = 0; i < 4; ++i) {
        const float a0 = bflo(c0[i]), a1 = bfhi(c0[i]);
        const float n0 = 0.5f * (bflo(cm[i]) + bflo(cp[i])), n1 = 0.5f * (bfhi(cm[i]) + bfhi(cp[i]));
        const float mu0 = (2 * i < 4) ? m0[(2 * i) & 3] : m1[(2 * i) & 3], mu1 = (2 * i + 1 < 4) ? m0[(2 * i + 1) & 3] : m1[(2 * i + 1) & 3];
        out[2 * i] = a0 + mu0 * (n0 - a0); out[2 * i + 1] = a1 + mu1 * (n1 - a1);
    }
}
template <int CTRL> __device__ __forceinline__ float dpp_f(float v) { return __int_as_float(__builtin_amdgcn_update_dpp(0, __float_as_int(v), CTRL, 0xf, 0xf, true)); }
__device__ __forceinline__ float sum8(float v) { v += dpp_f<0xB1>(v); v += dpp_f<0x4E>(v); v += dpp_f<0x141>(v); return v; }
__device__ __forceinline__ float fast_tanh(float x) { const float e = __expf(2.f * x); return 1.f - 2.f * __builtin_amdgcn_rcpf(e + 1.f); }
__device__ __forceinline__ float fast_sigmoid(float x) { return __builtin_amdgcn_rcpf(1.f + __expf(-x)); }
struct RwArgs { const bf16_t* P; bf16_t* Y0; bf16_t* Y1; float* BZ; const float *mu, *w0, *w_up, *a0, *a_up, *k_k, *k_a, *r_k; };
struct Raw3 { u32x4 c0, cm, cp; };
__device__ __forceinline__ Raw3 ld3(const bf16_t* P, size_t row, int co, bool hm, bool hp) {
    const u32x4 z4 = {0u, 0u, 0u, 0u}; Raw3 r;
    r.c0 = *(const u32x4*)(P + row * RWN + co);
    r.cm = hm ? *(const u32x4*)(P + (row - 1) * RWN + co) : z4;
    r.cp = hp ? *(const u32x4*)(P + (row + 1) * RWN + co) : z4;
    return r;
}
__device__ __forceinline__ void shift8(const Raw3& R, const float* mu, int co, float* out) {
    const f32x4 m0 = *(const f32x4*)(mu + co), m1 = *(const f32x4*)(mu + co + 4);
#pragma unroll
    for (int i = 0; i < 4; ++i) {
        const float a0 = bflo(R.c0[i]), a1 = bfhi(R.c0[i]);
        const float n0 = 0.5f * (bflo(R.cm[i]) + bflo(R.cp[i])), n1 = 0.5f * (bfhi(R.cm[i]) + bfhi(R.cp[i]));
        const float mu0 = (2 * i < 4) ? m0[(2 * i) & 3] : m1[(2 * i) & 3], mu1 = (2 * i + 1 < 4) ? m0[(2 * i + 1) & 3] : m1[(2 * i + 1) & 3];
        out[2 * i] = a0 + mu0 * (n0 - a0); out[2 * i + 1] = a1 + mu1 * (n1 - a1);
    }
}
__device__ __forceinline__ void rwkv_scan(const RwArgs& A, LAS char* lds, int G, int bid) {
    typedef short bfx8 __attribute__((ext_vector_type(8)));
    const int tid = opaque_tid(), lane = tid & 63; const int q = __builtin_amdgcn_readfirstlane(tid >> 6);
    LAS float* sW = (LAS float*)lds; LAS float* sA = sW + 4096; LAS float* sB = sA + 4096; LAS float* sKD = sB + 4096; LAS float* sR = sKD + 4096; LAS float* sV = sR + 4096;
    LAS bf16_t* WUPt = (LAS bf16_t*)(sV + 4096); LAS bf16_t* AUPt = WUPt + 64 * 72;
    LAS bf16_t* T1 = (LAS bf16_t*)sW; LAS bf16_t* T2 = (LAS bf16_t*)sKD;
    const int s = tid >> 3, dg = tid & 7, d0 = dg * 8;
#pragma unroll 1
    for (int chain = bid; chain < 256; chain += G) {
        const int z = chain >> 7, b = (chain >> 4) & 7, hh = chain & 15;
        __syncthreads();
        for (int idx = tid; idx < 4096; idx += 512) { const int r = idx >> 6, d = idx & 63;
            WUPt[d * 72 + r] = (bf16_t)(pkbf(A.w_up[(size_t)(z * 64 + r) * 1024 + hh * 64 + d], 0.f) & 0xffffu);
            AUPt[d * 72 + r] = (bf16_t)(pkbf(A.a_up[(size_t)(z * 64 + r) * 1024 + hh * 64 + d], 0.f) & 0xffffu); }
        f32x2_t S2[4];
#pragma unroll
        for (int j = 0; j < 4; ++j) S2[j] = (f32x2_t){0.f, 0.f};
        bf16_t* Yz = z ? A.Y1 : A.Y0;
        const int c_r = hh * 64 + d0, c_k = 1024 + hh * 64 + d0, c_v = 2048 + hh * 64 + d0, c_wd = 3072 + z * 64 + d0, c_ad = 3200 + z * 64 + d0;
#define RW_ROWOF(c, rowv, hmv, hpv) do { const int sidx_ = (c) * 64 + s; int L_, n_, rb_; \
            if ((c) < 4) { L_ = 256; n_ = z ? (255 - sidx_) : sidx_; rb_ = TL + b * 256; } else { L_ = 4096; const int sl_ = sidx_ - 256; n_ = z ? (4095 - sl_) : sl_; rb_ = b * 4096; } \
            rowv = (size_t)(rb_ + n_); hmv = n_ > 0; hpv = n_ < L_ - 1; } while (0)
        size_t row; bool hm, hp;
        RW_ROWOF(0, row, hm, hp);
        Raw3 Rr = ld3(A.P, row, c_r, hm, hp), Rk = ld3(A.P, row, c_k, hm, hp), Rv = ld3(A.P, row, c_v, hm, hp), Rw = ld3(A.P, row, c_wd, hm, hp), Ra = ld3(A.P, row, c_ad, hm, hp);
#pragma unroll 1
        for (int c = 0; c < 68; ++c) {
            asm volatile("" ::: "memory");
            const size_t crow_ = row;
            {
                float r8[8], k8[8], v8[8], t8[8];
                shift8(Rr, A.mu, c_r, r8); shift8(Rk, A.mu, c_k, k8); shift8(Rv, A.mu, c_v, v8);
                *(LAS f32x4*)(sR + s * 64 + d0) = (f32x4){r8[0], r8[1], r8[2], r8[3]}; *(LAS f32x4*)(sR + s * 64 + d0 + 4) = (f32x4){r8[4], r8[5], r8[6], r8[7]};
                *(LAS f32x4*)(sV + s * 64 + d0) = (f32x4){v8[0], v8[1], v8[2], v8[3]}; *(LAS f32x4*)(sV + s * 64 + d0 + 4) = (f32x4){v8[4], v8[5], v8[6], v8[7]};
                *(LAS f32x4*)(sB + s * 64 + d0) = (f32x4){k8[0], k8[1], k8[2], k8[3]}; *(LAS f32x4*)(sB + s * 64 + d0 + 4) = (f32x4){k8[4], k8[5], k8[6], k8[7]};
                float kkr[8], ssq = 0.f;
                const f32x4 kk0 = *(const f32x4*)(A.k_k + hh * 64 + d0), kk1 = *(const f32x4*)(A.k_k + hh * 64 + d0 + 4);
#pragma unroll
                for (int i = 0; i < 8; ++i) { kkr[i] = k8[i] * (i < 4 ? kk0[i & 3] : kk1[i & 3]); ssq += kkr[i] * kkr[i]; }
                ssq = sum8(ssq);
                const float rs = -rsqrtf(ssq + 1e-12f);
                *(LAS f32x4*)(sA + s * 64 + d0) = (f32x4){kkr[0] * rs, kkr[1] * rs, kkr[2] * rs, kkr[3] * rs}; *(LAS f32x4*)(sA + s * 64 + d0 + 4) = (f32x4){kkr[4] * rs, kkr[5] * rs, kkr[6] * rs, kkr[7] * rs};
                shift8(Rw, A.mu, c_wd, t8);
                { u32x4 o; o.x = pkbf(fast_tanh(t8[0]), fast_tanh(t8[1])); o.y = pkbf(fast_tanh(t8[2]), fast_tanh(t8[3])); o.z = pkbf(fast_tanh(t8[4]), fast_tanh(t8[5])); o.w = pkbf(fast_tanh(t8[6]), fast_tanh(t8[7]));
                  *(LAS u32x4*)(T1 + s * 72 + d0) = o; }
                shift8(Ra, A.mu, c_ad, t8);
                { u32x4 o; o.x = pkbf(t8[0], t8[1]); o.y = pkbf(t8[2], t8[3]); o.z = pkbf(t8[4], t8[5]); o.w = pkbf(t8[6], t8[7]);
                  *(LAS u32x4*)(T2 + s * 72 + d0) = o; }
            }
            if (c + 1 < 68) { RW_ROWOF(c + 1, row, hm, hp);
                Rr = ld3(A.P, row, c_r, hm, hp); Rk = ld3(A.P, row, c_k, hm, hp); Rv = ld3(A.P, row, c_v, hm, hp); Rw = ld3(A.P, row, c_wd, hm, hp); Ra = ld3(A.P, row, c_ad, hm, hp); }
            __syncthreads();
            const int mt = q & 3, nh = q >> 2, fr = lane & 15, fq = lane >> 4;
            f32x4 accw[2], acca[2];
            {
                bfx8 aw[2], aa[2];
#pragma unroll
                for (int kk = 0; kk < 2; ++kk) { aw[kk] = *(const LAS bfx8*)(T1 + (16 * mt + fr) * 72 + kk * 32 + fq * 8); aa[kk] = *(const LAS bfx8*)(T2 + (16 * mt + fr) * 72 + kk * 32 + fq * 8); }
#pragma unroll
                for (int nt = 0; nt < 2; ++nt) { accw[nt] = (f32x4){0.f, 0.f, 0.f, 0.f}; acca[nt] = (f32x4){0.f, 0.f, 0.f, 0.f};
#pragma unroll
                    for (int kk = 0; kk < 2; ++kk) {
                        const bfx8 bw = *(const LAS bfx8*)(WUPt + (32 * nh + 16 * nt + fr) * 72 + kk * 32 + fq * 8), ba = *(const LAS bfx8*)(AUPt + (32 * nh + 16 * nt + fr) * 72 + kk * 32 + fq * 8);
                        accw[nt] = __builtin_amdgcn_mfma_f32_16x16x32_bf16(aw[kk], bw, accw[nt], 0, 0, 0);
                        acca[nt] = __builtin_amdgcn_mfma_f32_16x16x32_bf16(aa[kk], ba, acca[nt], 0, 0, 0); } }
            }
            __syncthreads();
#pragma unroll
            for (int nt = 0; nt < 2; ++nt) { const int d = 32 * nh + 16 * nt + fr, dcol = hh * 64 + d;
                const float w0d = A.w0[z * 1024 + dcol], a0d = A.a0[z * 1024 + dcol], kad = A.k_a[dcol];
#pragma unroll
                for (int j = 0; j < 4; ++j) { const int idx = (16 * mt + 4 * fq + j) * 64 + d;
                    const float x = -(w0d + accw[nt][j]);
                    const float sp = fmaxf(x, 0.f) + __logf(1.f + __expf(-fabsf(x)));
                    const float w = __expf(-__expf(-sp - 0.5f));
                    const float asig = fast_sigmoid(a0d + acca[nt][j]);
                    const float nkk = sA[idx], kraw = sB[idx];
                    sW[idx] = w; sB[idx] = -nkk * asig; sKD[idx] = kraw * (1.f + (asig - 1.f) * kad); } }
            __syncthreads();
            {
                const f32x4 ra = *(const LAS f32x4*)(sR + s * 64 + d0), rb = *(const LAS f32x4*)(sR + s * 64 + d0 + 4), ka = *(const LAS f32x4*)(sKD + s * 64 + d0), kb = *(const LAS f32x4*)(sKD + s * 64 + d0 + 4);
                const f32x4 q0 = *(const f32x4*)(A.r_k + hh * 64 + d0), q1 = *(const f32x4*)(A.r_k + hh * 64 + d0 + 4);
                float bz = 0.f;
#pragma unroll
                for (int i = 0; i < 4; ++i) { bz += ra[i] * ka[i] * q0[i]; bz += rb[i] * kb[i] * q1[i]; }
                bz = sum8(bz);
                if (dg == 0) A.BZ[((size_t)z * TT + crow_) * 16 + hh] = bz;
            }
            {
                const int rl = lane >> 3, cg = lane & 7, irow = 8 * q + rl;
                const LAS float* bw = sW + 8 * cg; const LAS float* ba_ = sA + 8 * cg; const LAS float* bb_ = sB + 8 * cg; const LAS float* bk = sKD + 8 * cg; const LAS float* br = sR + 8 * cg;
                LAS float* bv = sV + irow;
                f32x4 w0 = *(const LAS f32x4*)(bw), w1 = *(const LAS f32x4*)(bw + 4), a0 = *(const LAS f32x4*)(ba_), a1 = *(const LAS f32x4*)(ba_ + 4);
                f32x4 b0 = *(const LAS f32x4*)(bb_), b1 = *(const LAS f32x4*)(bb_ + 4), k0 = *(const LAS f32x4*)(bk), k1 = *(const LAS f32x4*)(bk + 4);
                f32x4 r0 = *(const LAS f32x4*)(br), r1 = *(const LAS f32x4*)(br + 4); float vi = bv[0];
#pragma unroll 2
                for (int st = 0; st < 64; ++st) {
                    const int on = ((st + 1) & 63) * 64;
                    const f32x4 nw0 = *(const LAS f32x4*)(bw + on), nw1 = *(const LAS f32x4*)(bw + on + 4), na0 = *(const LAS f32x4*)(ba_ + on), na1 = *(const LAS f32x4*)(ba_ + on + 4);
                    const f32x4 nb0 = *(const LAS f32x4*)(bb_ + on), nb1 = *(const LAS f32x4*)(bb_ + on + 4), nk0 = *(const LAS f32x4*)(bk + on), nk1 = *(const LAS f32x4*)(bk + on + 4);
                    const f32x4 nr0 = *(const LAS f32x4*)(br + on), nr1 = *(const LAS f32x4*)(br + on + 4); const float nvi = bv[on];
                    f32x2_t pp2 = S2[0] * (f32x2_t){a0[0], a0[1]};
                    pp2 = S2[1] * (f32x2_t){a0[2], a0[3]} + pp2; pp2 = S2[2] * (f32x2_t){a1[0], a1[1]} + pp2; pp2 = S2[3] * (f32x2_t){a1[2], a1[3]} + pp2;
                    const float sa = sum8(pp2.x + pp2.y);
                    const f32x2_t sa2 = {sa, sa}, v2 = {vi, vi};
                    S2[0] = S2[0] * (f32x2_t){w0[0], w0[1]} + sa2 * (f32x2_t){b0[0], b0[1]} + v2 * (f32x2_t){k0[0], k0[1]};
                    S2[1] = S2[1] * (f32x2_t){w0[2], w0[3]} + sa2 * (f32x2_t){b0[2], b0[3]} + v2 * (f32x2_t){k0[2], k0[3]};
                    S2[2] = S2[2] * (f32x2_t){w1[0], w1[1]} + sa2 * (f32x2_t){b1[0], b1[1]} + v2 * (f32x2_t){k1[0], k1[1]};
                    S2[3] = S2[3] * (f32x2_t){w1[2], w1[3]} + sa2 * (f32x2_t){b1[2], b1[3]} + v2 * (f32x2_t){k1[2], k1[3]};
                    f32x2_t y2 = S2[0] * (f32x2_t){r0[0], r0[1]};
                    y2 = S2[1] * (f32x2_t){r0[2], r0[3]} + y2; y2 = S2[2] * (f32x2_t){r1[0], r1[1]} + y2; y2 = S2[3] * (f32x2_t){r1[2], r1[3]} + y2;
                    const float yv = sum8(y2.x + y2.y);
                    if (cg == 0) bv[st * 64] = yv;
                    w0 = nw0; w1 = nw1; a0 = na0; a1 = na1; b0 = nb0; b1 = nb1; k0 = nk0; k1 = nk1; r0 = nr0; r1 = nr1; vi = nvi;
                }
            }
            __syncthreads();
            { u32x4 o; const LAS float* yr = sV + s * 64 + d0;
              o.x = pkbf(yr[0], yr[1]); o.y = pkbf(yr[2], yr[3]); o.z = pkbf(yr[4], yr[5]); o.w = pkbf(yr[6], yr[7]);
              *(u32x4*)(Yz + crow_ * 1024 + hh * 64 + d0) = o; }
            __syncthreads();
        }
#undef RW_ROWOF
    }
}
__device__ __forceinline__ void rwkv_out(const RwArgs& A, const float* ln_w, const float* ln_b, bf16_t* OG, int G, int bid) {
    const int tid_ = opaque_tid(); const int lane = tid_ & 63, wid = tid_ >> 6; const int c0 = lane * 16, head = lane >> 2;
    for (int row = bid * 8 + wid; row < TT; row += G * 8) {
        const bool lat = row < TL; const int L = lat ? 4096 : 256; const int n = lat ? (row & 4095) : ((row - TL) & 255); const bool hm = n > 0, hp = n < L - 1;
        float y[16], vv[16];
        { const u32x4 a0 = *(const u32x4*)(A.Y0 + (size_t)row * 1024 + c0), a1 = *(const u32x4*)(A.Y0 + (size_t)row * 1024 + c0 + 8);
          const u32x4 b0 = *(const u32x4*)(A.Y1 + (size_t)row * 1024 + c0), b1 = *(const u32x4*)(A.Y1 + (size_t)row * 1024 + c0 + 8);
#pragma unroll
          for (int i = 0; i < 4; ++i) { y[2 * i] = bflo(a0[i]) + bflo(b0[i]); y[2 * i + 1] = bfhi(a0[i]) + bfhi(b0[i]); y[8 + 2 * i] = bflo(a1[i]) + bflo(b1[i]); y[8 + 2 * i + 1] = bfhi(a1[i]) + bfhi(b1[i]); } }
        float s1 = 0.f;
#pragma unroll
        for (int i = 0; i < 16; ++i) s1 += y[i];
        s1 += __shfl_xor(s1, 1); s1 += __shfl_xor(s1, 2); const float mean = s1 * (1.f / 64.f);
        float s2 = 0.f;
#pragma unroll
        for (int i = 0; i < 16; ++i) { y[i] -= mean; s2 += y[i] * y[i]; }
        s2 += __shfl_xor(s2, 1); s2 += __shfl_xor(s2, 2); const float rstd = rsqrtf(s2 * (1.f / 64.f) + 64e-5f);
        sh8(A.P, (size_t)row, 2048 + c0, hm, hp, A.mu, vv); sh8(A.P, (size_t)row, 2048 + c0 + 8, hm, hp, A.mu, vv + 8);
        const float bz = 0.5f * (A.BZ[(size_t)row * 16 + head] + A.BZ[((size_t)TT + row) * 16 + head]);
        const u32x4 z0 = *(const u32x4*)(A.P + (size_t)row * RWN + 3328 + c0), z1 = *(const u32x4*)(A.P + (size_t)row * RWN + 3328 + c0 + 8);
        float ov[16];
#pragma unroll
        for (int i = 0; i < 16; ++i) { const unsigned zw = (i < 8) ? z0[(i >> 1) & 3] : z1[(i >> 1) & 3]; const float zz = (i & 1) ? bfhi(zw) : bflo(zw);
            ov[i] = (y[i] * rstd * ln_w[c0 + i] + ln_b[c0 + i] + bz * vv[i]) * silu_f(zz); }
        u32x4 o0, o1; o0.x = pkbf(ov[0], ov[1]); o0.y = pkbf(ov[2], ov[3]); o0.z = pkbf(ov[4], ov[5]); o0.w = pkbf(ov[6], ov[7]);
        o1.x = pkbf(ov[8], ov[9]); o1.y = pkbf(ov[10], ov[11]); o1.z = pkbf(ov[12], ov[13]); o1.w = pkbf(ov[14], ov[15]);
        *(u32x4*)(OG + (size_t)row * 1024 + c0) = o0; *(u32x4*)(OG + (size_t)row * 1024 + c0 + 8) = o1;
    }
}
#ifdef SKIP_GEMM
#define GEMM_PHASE(EPI, AP, BP, MM, NN, KK, EOBJ) do { (void)EOBJ; } while (0)
#else
#define GEMM_PHASE(EPI, AP, BP, MM, NN, KK, EOBJ) do { pg8::Gemm g_{(const bf16_t*)(AP), (const bf16_t*)(BP), (MM), (NN), (KK)}; pg8::StaticOrder S_; S_.init((MM), (NN), G, bid); \
    pg8::gemm_phase<EPI, pg8::StaticOrder, true, true>((PG8_LAS unsigned char*)lds, g_, S_, EOBJ); } while (0)
#endif
#ifdef SKIP_EpiAttnIn
#define GEMM_PHASE_EpiAttnIn(EPI, AP, BP, MM, NN, KK, EOBJ) do { (void)EOBJ; } while (0)
#else
#define GEMM_PHASE_EpiAttnIn GEMM_PHASE
#endif
#ifdef SKIP_EpiFnT
#define GEMM_PHASE_EpiFnT(EPI, AP, BP, MM, NN, KK, EOBJ) do { (void)EOBJ; } while (0)
#else
#define GEMM_PHASE_EpiFnT GEMM_PHASE
#endif
#ifdef SKIP_EpiPlain
#define GEMM_PHASE_EpiPlain(EPI, AP, BP, MM, NN, KK, EOBJ) do { (void)EOBJ; } while (0)
#else
#define GEMM_PHASE_EpiPlain GEMM_PHASE
#endif
#ifdef SKIP_EpiDft
#define GEMM_PHASE_EpiDft(EPI, AP, BP, MM, NN, KK, EOBJ) do { (void)EOBJ; } while (0)
#else
#define GEMM_PHASE_EpiDft GEMM_PHASE
#endif
#ifdef SKIP_EpiResid
#define GEMM_PHASE_EpiResid(EPI, AP, BP, MM, NN, KK, EOBJ) do { (void)EOBJ; } while (0)
#else
#define GEMM_PHASE_EpiResid GEMM_PHASE
#endif
#define XB_TMO      128
#define XB_XCNT(j)  (256  + 64 * (j))
#define XB_XSUB(j)  (1280 + 64 * (j))
#define XB_XGEN(j)  (2304 + 64 * (j))
#define XB_TOP      3328
#define XB_TOPGEN   3392
#define XCD_BAR_WORDS 3456
#define XB_SPIN_CAP (1u << 18)

__device__ __forceinline__ unsigned xb_ld(unsigned* p)              { return __hip_atomic_load(p, __ATOMIC_RELAXED, __HIP_MEMORY_SCOPE_AGENT); }
__device__ __forceinline__ unsigned xb_add(unsigned* p, unsigned v) { return __hip_atomic_fetch_add(p, v, __ATOMIC_RELAXED, __HIP_MEMORY_SCOPE_AGENT); }
__device__ __forceinline__ unsigned xb_xcc_id() { return (unsigned)__builtin_amdgcn_s_getreg((3 << 11) | 20) & 0xFu; }
#define XB_SPIN(cond, bar) do { unsigned _sp = 0; while (cond) { __builtin_amdgcn_s_sleep(1); \
    if ((++_sp & 255u) == 0u) { if (xb_ld(&(bar)[XB_TMO])) break; if (_sp > XB_SPIN_CAP) { atomicAdd(&(bar)[XB_TMO], 1u); break; } } } } while (0)

struct XcdBarrier {
    unsigned* bar; unsigned x;
    volatile LAS unsigned* st;
};

__device__ __forceinline__ XcdBarrier xcd_barrier_post(unsigned* bar, volatile LAS unsigned* st) {
    XcdBarrier b; b.bar = bar; b.x = xb_xcc_id(); b.st = st;
    if (threadIdx.x == 0) (void)xb_add(&bar[XB_XCNT(b.x)], 1u);
    return b;
}
__device__ __forceinline__ void xcd_barrier_complete(unsigned* bar, unsigned x, unsigned& nloc, unsigned& nx) {
    const unsigned G = gridDim.x * gridDim.y * gridDim.z;
    unsigned sum, cnt, mine, sp = 0u;
    for (;;) {
        sum = 0u; cnt = 0u; mine = 0u;
#pragma unroll
        for (unsigned j = 0; j < 16; ++j) { const unsigned c = xb_ld(&bar[XB_XCNT(j)]); sum += c; cnt += (c > 0u) ? 1u : 0u; mine = (j == x) ? c : mine; }
        if (sum == G) break;
        __builtin_amdgcn_s_sleep(1);
        if ((++sp & 255u) == 0u) { if (xb_ld(&bar[XB_TMO])) break; if (sp > XB_SPIN_CAP) { atomicAdd(&bar[XB_TMO], 1u); break; } }
    }
    nloc = mine > 0u ? mine : 1u; nx = cnt > 0u ? cnt : 1u;
}

__device__ __forceinline__ void xcd_barrier(const XcdBarrier& b) {
    asm volatile("s_waitcnt vmcnt(0)" ::: "memory");
    __syncthreads();
    if (threadIdx.x == 0) {
        unsigned* bar = b.bar;
        __builtin_amdgcn_s_waitcnt(0);
        unsigned nloc = b.st[0], nx = b.st[1];
        if (nloc == 0u) { xcd_barrier_complete(bar, b.x, nloc, nx); b.st[0] = nloc; b.st[1] = nx; }
        const unsigned old = xb_add(&bar[XB_XSUB(b.x)], 1u);
        const unsigned gen = old / nloc;
        if (old + 1u == (gen + 1u) * nloc) {
            __builtin_amdgcn_fence(__ATOMIC_RELEASE, "agent");
            asm volatile("s_waitcnt vmcnt(0)" ::: "memory");
            const unsigned og = xb_add(&bar[XB_TOP], 1u);
            const unsigned tg = og / nx;
            if (og + 1u == (tg + 1u) * nx) xb_add(&bar[XB_TOPGEN], 1u);
            else XB_SPIN(xb_ld(&bar[XB_TOPGEN]) == tg, bar);
            __builtin_amdgcn_fence(__ATOMIC_ACQUIRE, "agent");
            xb_add(&bar[XB_XGEN(b.x)], 1u);
            asm volatile("s_waitcnt vmcnt(0)" ::: "memory");
        } else {
            XB_SPIN(xb_ld(&bar[XB_XGEN(b.x)]) == gen, bar);
            __builtin_amdgcn_fence(__ATOMIC_ACQUIRE, "agent");
            asm volatile("s_waitcnt vmcnt(0)" ::: "memory");
        }
    }
    __syncthreads();
}

#define GRID_SYNC() xcd_barrier(xbar)
template <int layer> __device__ __forceinline__ void layer_body(const Params& p, LAS char* lds, const XcdBarrier& xbar, int G, int bid) {
    unsigned char* ws = p.ws;
    float* mod = (float*)(ws + WS_MOD);
    const float* ropeC = (const float*)(ws + WS_ROPE); const float* ropeS = ropeC + 1024;
    bf16_t* Hb = (bf16_t*)(ws + WS_HB);
    float* XC = (float*)(ws + WS_XC);
    const float* x_in = p.in[0]; const float* ctx_in = p.in[2];
        const float* xl = layer == 0 ? x_in : p.out; const float* xc = layer == 0 ? ctx_in : XC;
        const float* modl = mod + (size_t)layer * 9 * 3072;
        ph_phase(xl, xc, p.in[4] + layer * 1024, modl, Hb, G, bid);
        GRID_SYNC();
        const int Mout = (layer == 3) ? TL : TT;
        const bf16_t* Wout;
        if constexpr (layer == 0 || layer == 3) {
            const int j = layer == 0 ? 0 : 1;
            pg8::EpiAttnIn E{(bf16_t*)(ws + WS_Q), (bf16_t*)(ws + WS_K), (bf16_t*)(ws + WS_V), (bf16_t*)(ws + WS_Z), ropeC, ropeS};
            GEMM_PHASE_EpiAttnIn(pg8::EpiAttnIn, Hb, ws + WS_WDAIN + (size_t)j * 8 * MiB, TT, 4096, 1024, E);
#ifdef PROBE_GIN2
            GEMM_PHASE_EpiAttnIn(pg8::EpiAttnIn, Hb, ws + WS_WDAIN + (size_t)j * 8 * MiB, TT, 4096, 1024, E);
#endif
            GRID_SYNC();
            float lam;
            { const int lane = opaque_tid() & 63; const float* lq = p.in[9] + j * 128; const float* lk = p.in[10] + j * 128;
              const float s0 = wave_sum(lq[lane] * lk[lane]), s1 = wave_sum(lq[64 + lane] * lk[64 + lane]);
              const float li = 0.8f - 0.6f * expf(-0.3f * (float)layer); lam = expf(s0) - expf(s1) + li;
              att::Args A{(const bf16_t*)(ws + WS_Q), (const bf16_t*)(ws + WS_K), (const bf16_t*)(ws + WS_V), (const bf16_t*)(ws + WS_Z), Hb, p.in[11] + j * 128, lam, 1.f - li, layer == 3 ? 1024 : 1088};
#ifndef SKIP_ATT
              att::attn_phase(A, lds, G, bid);
#endif
#ifdef PROBE_ATT2
              att::attn_phase(A, lds, G, bid);
#endif
            }
            GRID_SYNC();
            Wout = (const bf16_t*)(ws + WS_WDAOUT + (size_t)j * 2 * MiB);
        } else if constexpr (layer == 1) {
            { pg8::EpiFnT E{(bf16_t*)(ws + WS_ATL), (bf16_t*)(ws + WS_ATC)};
              GEMM_PHASE_EpiFnT(pg8::EpiFnT, ws + WS_WFNT, Hb, 2048, TT, 1024, E); }
            { pg8::EpiPlain E{(bf16_t*)(ws + WS_ZB), 1024};
              GEMM_PHASE_EpiPlain(pg8::EpiPlain, Hb, ws + WS_WFNZ, TT, 1024, 1024, E); }
            GRID_SYNC();
            fnet_fold((const bf16_t*)(ws + WS_ATL), (bf16_t*)(ws + WS_FOLD), (bf16_t*)(ws + WS_FOLD + 32 * MiB), (float*)(ws + WS_BZ), (const bf16_t*)(ws + WS_ZB), Hb, G, bid);
            GRID_SYNC();
            { pg8::EpiPlain E{(bf16_t*)(ws + WS_ATL), 8192};
              GEMM_PHASE_EpiPlain(pg8::EpiPlain, ws + WS_DFTL, ws + WS_FOLD, 2048, 8192, 2048, E); }
            GRID_SYNC();
            { pg8::EpiDftSym E{(const bf16_t*)(ws + WS_ATL), (const float*)(ws + WS_BZ), (const bf16_t*)(ws + WS_ZB), Hb};
              GEMM_PHASE(pg8::EpiDftSym, ws + WS_DFTL + 8 * MiB, ws + WS_FOLD + 32 * MiB, 2048, 8192, 2048, E); }
            { pg8::EpiDft E{(const bf16_t*)(ws + WS_ZB), Hb, TL, 256};
              GEMM_PHASE_EpiDft(pg8::EpiDft, ws + WS_DFTC, ws + WS_ATC, 256, 8192, 512, E); }
            GRID_SYNC();
            Wout = (const bf16_t*)(ws + WS_WFNOUT);
        } else {
            { pg8::EpiPlain E{(bf16_t*)(ws + WS_P), RWN};
              GEMM_PHASE_EpiPlain(pg8::EpiPlain, Hb, ws + WS_WRWIN, TT, RWN, 1024, E); }
            GRID_SYNC();
            RwArgs A{(const bf16_t*)(ws + WS_P), Hb, (bf16_t*)(ws + WS_Y1), (float*)(ws + WS_BZ), p.in[17], p.in[18], p.in[19], p.in[20], p.in[21], p.in[22], p.in[23], p.in[24]};
#ifndef SKIP_SCAN
            rwkv_scan(A, lds, G, bid);
#endif
#ifdef PROBE_SCAN2
            rwkv_scan(A, lds, G, bid);
#endif
            GRID_SYNC();
#ifndef SKIP_RWOUT
            rwkv_out(A, p.in[25], p.in[26], Hb, G, bid);
#endif
            GRID_SYNC();
            Wout = (const bf16_t*)(ws + WS_WRWOUT);
        }
        { pg8::EpiResid E{xl, xc, p.out, XC, modl + 2048};
          GEMM_PHASE_EpiResid(pg8::EpiResid, Hb, Wout, Mout, 1024, 1024, E); }
        GRID_SYNC();
    }
__global__ void __launch_bounds__(512, 2) fwd_megakernel(Params p) {
    extern __shared__ __attribute__((aligned(16))) unsigned char lds_raw[];
    LAS char* lds = (LAS char*)lds_raw;
    cg::grid_group grid = cg::this_grid();
    const int G = gridDim.x, bid = blockIdx.x;
    volatile LAS unsigned* xst = (volatile LAS unsigned*)(lds + LDS_BYTES - 256);
    if (threadIdx.x < 2) xst[threadIdx.x] = 0u;
    __syncthreads();
    const XcdBarrier xbar = xcd_barrier_post((unsigned*)(p.ws + WS_CTL), xst);

#ifndef SKIP_PRO
    prologue(p, lds, G, bid);
#endif
#ifdef PROBE_PRO2
    __syncthreads(); prologue(p, lds, G, bid);
#endif
    grid.sync();
    layer_body<0>(p, lds, xbar, G, bid);
    layer_body<1>(p, lds, xbar, G, bid);
    layer_body<2>(p, lds, xbar, G, bid);
    layer_body<3>(p, lds, xbar, G, bid);
    final_phase(p.out, p.in[7], G, bid);
}

extern "C" void kernel_launch(void* const* d_in, const int* in_sizes, int n_in, void* d_out, int out_size, void* d_ws, size_t ws_size, hipStream_t stream) {
    static int grid = 0;
    if (grid == 0) {
        if (n_in != 28 || out_size != TL * 1024 || ws_size < WS_END) { fprintf(stderr, "kernel_launch: unexpected shapes: n_in %d out %d ws %zu\n", n_in, out_size, ws_size); grid = -1; return; }
        int dev = 0, cus = 0, per_cu = 0;
        hipGetDevice(&dev); hipDeviceGetAttribute(&cus, hipDeviceAttributeMultiprocessorCount, dev);
        if (hipFuncSetAttribute((const void*)fwd_megakernel, hipFuncAttributeMaxDynamicSharedMemorySize, LDS_BYTES) != hipSuccess) { fprintf(stderr, "kernel_launch: hipFuncSetAttribute failed\n"); grid = -1; return; }
        if (hipOccupancyMaxActiveBlocksPerMultiprocessor(&per_cu, (const void*)fwd_megakernel, 512, LDS_BYTES) != hipSuccess || per_cu < 1) { fprintf(stderr, "kernel_launch: occupancy query failed (%d)\n", per_cu); per_cu = 1; }
        (void)hipGetLastError();
        grid = cus * per_cu;
    }
    if (grid < 0) return;
    if (hipMemsetAsync((char*)d_ws + WS_CTL, 0, 65536, stream) != hipSuccess) { fprintf(stderr, "kernel_launch: hipMemsetAsync failed\n"); return; }
    Params p{};
    for (int i = 0; i < 28; ++i) p.in[i] = (const float*)d_in[i];
    p.out = (float*)d_out; p.ws = (unsigned char*)d_ws;
    void* args[] = {&p};
    hipError_t e = hipLaunchCooperativeKernel((const void*)fwd_megakernel, dim3(grid), dim3(512), args, LDS_BYTES, stream);
    if (e != hipSuccess) fprintf(stderr, "cooperative launch failed: %s (grid %d)\n", hipGetErrorString(e), grid);
}
```

```cpp
#include <hip/hip_runtime.h>
#include <hip/hip_cooperative_groups.h>
#include <cstdio>
#include <cstdint>
#include <cmath>
namespace cg = cooperative_groups;

constexpr int TL = 32768, TCX = 2048, TT = TL + TCX, DM = 1024;
constexpr float QK_C2 = 0.125f * 1.4426950408889634f;
typedef float f32x2_t __attribute__((ext_vector_type(2)));
typedef __bf16 bf16x2_t __attribute__((ext_vector_type(2)));
__device__ __forceinline__ unsigned pkbf(float lo, float hi) { f32x2_t v = {lo, hi}; bf16x2_t b = __builtin_convertvector(v, bf16x2_t); return __builtin_bit_cast(unsigned, b); }
__device__ __forceinline__ float bflo(unsigned u) { return __uint_as_float(u << 16); }
__device__ __forceinline__ float bfhi(unsigned u) { return __uint_as_float(u & 0xffff0000u); }
__device__ __forceinline__ float bf1(unsigned short u) { return __uint_as_float(((unsigned)u) << 16); }
__device__ __forceinline__ float silu_f(float z) { return z * __builtin_amdgcn_rcpf(1.f + __expf(-z)); }
__device__ __forceinline__ int opaque_tid() { int t = threadIdx.x; asm volatile("" : "+v"(t)); return t; }
namespace pg8 {
#define PG8_LAS __attribute__((address_space(3)))
typedef unsigned short bf16_t;
typedef short bf16x8 __attribute__((ext_vector_type(8)));
typedef float f32x4 __attribute__((ext_vector_type(4)));
typedef unsigned u32x4 __attribute__((ext_vector_type(4)));
constexpr int BM = 256, BK = 64, HALF = 128, HTB = HALF * BK * 2  , STAGE_BYTES = 8 * HTB, NXCD = 8, WGM = 8;

__host__ __device__ __forceinline__ int lds_byte(int r, int c) { const int st = (r >> 4) * 2 + (c >> 5), rr = r & 15, cc = c & 31, ob = rr * 64 + cc * 2; return st * 1024 + (ob ^ (((ob >> 9) & 1) << 5)); }
__host__ __device__ __forceinline__ void stage_rc(int b, int& R, int& C) { const int st = b / 1024, sb = b % 1024, swz = sb ^ (((sb >> 9) & 1) << 5); R = (st >> 1) * 16 + swz / 64; C = (st & 1) * 32 + (swz % 64) / 2; }
__host__ __device__ __forceinline__ int perm32(int rho) { const int n = rho >> 4, i = rho & 15; return 8 * (i >> 2) + 4 * n + (i & 3); }

struct Unit { int pm, pn; };
struct Gemm { const bf16_t* A; const bf16_t* Bt; int M, N, K; };

struct StaticOrder {
    int nM, nN, nwg, G, c;
    __host__ __device__ void init(int M, int N, int G_, int c_) { nM = M / BM; nN = N / BM; nwg = nM * nN; G = G_; c = c_; }
    __host__ __device__ bool next(int i, Unit& u) const {
        const long L = (long)i * G + c; if (L >= nwg) return false;
        int wgid = (int)L; { const int q = nwg / NXCD, r = nwg % NXCD, xcd = wgid % NXCD, off = wgid / NXCD; wgid = (xcd < r ? xcd * (q + 1) : r * (q + 1) + (xcd - r) * q) + off; }
        const int nig = WGM * nN, gid = wgid / nig, fm = gid * WGM, gsz = (nM - fm) < WGM ? (nM - fm) : WGM;
        u.pm = fm + ((wgid % nig) % gsz); u.pn = (wgid % nig) / gsz; return true;
    }
    __device__ __forceinline__ void a_ready(const Unit&) const {}
    __device__ __forceinline__ void done(const Unit&) const {}
};

struct EpiAttnIn {
    static constexpr bool PERM = true, AFTER_DRAIN = false;
    bf16_t* Q; bf16_t* Kb; bf16_t* V; bf16_t* Z; const float* ropeC; const float* ropeS;
    __device__ __forceinline__ void operator()(const f32x4 (&acc)[2][2][4][2], const Unit& u, int wr, int wc, int fr, int fq) const {
        const int sect = u.pn >> 2;
        bf16_t* base = sect == 0 ? Q : sect == 1 ? Kb : sect == 2 ? V : Z;
        const int colt = (u.pn & 3) * 256 + wc * 32 + 8 * fq;
        const int row0 = u.pm * BM + wr * 64 + fr;
        const bool rope = (u.pm < 128) && (sect < 2);
        const float sc = (sect == 0) ? QK_C2 : 1.f;
        const int axis = wc & 1;
#pragma unroll
        for (int ai = 0; ai < 2; ++ai)
#pragma unroll
            for (int m = 0; m < 4; ++m) {
                const int row = row0 + ai * HALF + m * 16;
                const int ntok = row & 4095;
                const int pos = axis ? (ntok & 63) : (ntok >> 6);
                bf16_t* rowp;
                if (sect == 1) rowp = base + (size_t)(row >> 6) * 65536 + (size_t)(colt >> 3) * 512 + (row & 63) * 8;
                else if (sect == 2) rowp = base + (size_t)(row >> 6) * 65536 + (size_t)(colt >> 7) * 8192 + (((colt & 127) >> 5) * 4 + ((row & 63) >> 4)) * 512 + (row & 15) * 32 + (colt & 31);
                else rowp = base + (size_t)row * 1024 + colt;
#pragma unroll
                for (int bj = 0; bj < 2; ++bj) {
                    f32x4 v0 = acc[ai][bj][m][0], v1 = acc[ai][bj][m][1];
                    if (rope) {
                        const f32x4 c0 = *(const f32x4*)(ropeC + pos * 16 + 8 * (fq & 1)), c1 = *(const f32x4*)(ropeC + pos * 16 + 8 * (fq & 1) + 4);
                        const f32x4 s0 = *(const f32x4*)(ropeS + pos * 16 + 8 * (fq & 1)), s1 = *(const f32x4*)(ropeS + pos * 16 + 8 * (fq & 1) + 4);
                        f32x4 p0, p1;
#pragma unroll
                        for (int i = 0; i < 4; ++i) { p0[i] = __shfl_xor(v0[i], 32); p1[i] = __shfl_xor(v1[i], 32); }
                        if (fq < 2) { v0 = v0 * c0 - p0 * s0; v1 = v1 * c1 - p1 * s1; }
                        else        { v0 = v0 * c0 + p0 * s0; v1 = v1 * c1 + p1 * s1; }
                    }
                    v0 = v0 * sc; v1 = v1 * sc;
                    u32x4 w; w.x = pkbf(v0[0], v0[1]); w.y = pkbf(v0[2], v0[3]); w.z = pkbf(v1[0], v1[1]); w.w = pkbf(v1[2], v1[3]);
                    *(u32x4*)(rowp + (sect == 1 || sect == 2 ? bj * 8192 : bj * HALF)) = w;
                }
            }
    }
};
struct EpiPlain {
    static constexpr bool PERM = true, AFTER_DRAIN = false;
    bf16_t* O; int ldc;
    __device__ __forceinline__ void operator()(const f32x4 (&acc)[2][2][4][2], const Unit& u, int wr, int wc, int fr, int fq) const {
        const int row0 = u.pm * BM + wr * 64 + fr, col0 = u.pn * BM + wc * 32 + 8 * fq;
#pragma unroll
        for (int ai = 0; ai < 2; ++ai)
#pragma unroll
            for (int m = 0; m < 4; ++m) { bf16_t* rowp = O + (size_t)(row0 + ai * HALF + m * 16) * ldc + col0;
#pragma unroll
                for (int bj = 0; bj < 2; ++bj) { const f32x4 v0 = acc[ai][bj][m][0], v1 = acc[ai][bj][m][1];
                    u32x4 w; w.x = pkbf(v0[0], v0[1]); w.y = pkbf(v0[2], v0[3]); w.z = pkbf(v1[0], v1[1]); w.w = pkbf(v1[2], v1[3]);
                    *(u32x4*)(rowp + bj * HALF) = w; } }
    }
};
struct EpiResid {
    static constexpr bool PERM = false, AFTER_DRAIN = false;
    const float* xin_lat; const float* xin_ctx; float* xout_lat; float* xout_ctx; const float* gate;
    __device__ __forceinline__ void operator()(const f32x4 (&acc)[2][2][4][2], const Unit& u, int wr, int wc, int fr, int fq) const {
        const int row0 = u.pm * BM + wr * 64 + fr, col0 = u.pn * BM + wc * 32 + 4 * fq;
#pragma unroll
        for (int ai = 0; ai < 2; ++ai)
#pragma unroll
            for (int m = 0; m < 4; ++m) {
                const int row = row0 + ai * HALF + m * 16; const bool lat = row < TL; const int r = lat ? (row >> 12) : 8;
                const float* xi = lat ? xin_lat + (size_t)row * 1024 : xin_ctx + (size_t)(row - TL) * 1024;
                float* xo = lat ? xout_lat + (size_t)row * 1024 : xout_ctx + (size_t)(row - TL) * 1024;
                const float* g = gate + r * 3072;
#pragma unroll
                for (int bj = 0; bj < 2; ++bj)
#pragma unroll
                    for (int n = 0; n < 2; ++n) { const int col = col0 + bj * HALF + n * 16;
                        const f32x4 g4 = *(const f32x4*)(g + col), x4 = *(const f32x4*)(xi + col);
                        *(f32x4*)(xo + col) = x4 + g4 * acc[ai][bj][m][n]; }
            }
    }
};
struct EpiFnT {
    static constexpr bool PERM = true, AFTER_DRAIN = false;
    bf16_t* ATL; bf16_t* ATC;
    __device__ __forceinline__ void operator()(const f32x4 (&acc)[2][2][4][2], const Unit& u, int wr, int wc, int fr, int fq) const {
        const int row0 = u.pm * BM + wr * 64 + fr, col0 = u.pn * BM + wc * 32 + 8 * fq;
#pragma unroll
        for (int ai = 0; ai < 2; ++ai)
#pragma unroll
            for (int m = 0; m < 4; ++m) { const int mp = row0 + ai * HALF + m * 16, cs = mp >> 10, n = mp & 1023;
#pragma unroll
                for (int bj = 0; bj < 2; ++bj) { const int t0 = col0 + bj * HALF; bf16_t* dst;
                    if (t0 < TL) { const int b = t0 >> 12, l = t0 & 4095; dst = ATL + ((size_t)((b * 1024 + n) * 2 + cs)) * 4096 + l; }
                    else { const int tc = t0 - TL, b = tc >> 8, l = tc & 255; dst = ATC + ((size_t)((b * 1024 + n) * 2 + cs)) * 256 + l; }
                    const f32x4 v0 = acc[ai][bj][m][0], v1 = acc[ai][bj][m][1];
                    u32x4 w; w.x = pkbf(v0[0], v0[1]); w.y = pkbf(v0[2], v0[3]); w.z = pkbf(v1[0], v1[1]); w.w = pkbf(v1[2], v1[3]);
                    *(u32x4*)dst = w; } }
    }
};
struct EpiDft {
    static constexpr bool PERM = true, AFTER_DRAIN = false;
    const bf16_t* Z; bf16_t* OG; int rowbase; int L;
    __device__ __forceinline__ void operator()(const f32x4 (&acc)[2][2][4][2], const Unit& u, int wr, int wc, int fr, int fq) const {
        const int k0 = u.pm * BM + wr * 64 + fr; const int b = u.pn >> 2; const int n0 = (u.pn & 3) * 256 + wc * 32 + 8 * fq;
#pragma unroll
        for (int ai = 0; ai < 2; ++ai)
#pragma unroll
            for (int m = 0; m < 4; ++m) { const size_t R = (size_t)(rowbase + b * L + k0 + ai * HALF + m * 16);
#pragma unroll
                for (int bj = 0; bj < 2; ++bj) { const size_t off = R * 1024 + n0 + bj * HALF;
                    const u32x4 zz = *(const u32x4*)(Z + off);
                    const f32x4 v0 = acc[ai][bj][m][0], v1 = acc[ai][bj][m][1];
                    u32x4 w;
                    w.x = pkbf(v0[0] * silu_f(bflo(zz.x)), v0[1] * silu_f(bfhi(zz.x))); w.y = pkbf(v0[2] * silu_f(bflo(zz.y)), v0[3] * silu_f(bfhi(zz.y)));
                    w.z = pkbf(v1[0] * silu_f(bflo(zz.z)), v1[1] * silu_f(bfhi(zz.z))); w.w = pkbf(v1[2] * silu_f(bflo(zz.w)), v1[3] * silu_f(bfhi(zz.w)));
                    *(u32x4*)(OG + off) = w; } }
    }
};
struct EpiDftSym {
    static constexpr bool PERM = true, AFTER_DRAIN = false;
    const bf16_t* Pb; const float* TA; const bf16_t* Z; bf16_t* OG;
    __device__ __forceinline__ void operator()(const f32x4 (&acc)[2][2][4][2], const Unit& u, int wr, int wc, int fr, int fq) const {
        const int k0 = u.pm * BM + wr * 64 + fr; const int b = u.pn >> 2; const int c0 = u.pn * BM + wc * 32 + 8 * fq; const int n0 = c0 & 1023;
#pragma unroll
        for (int bj = 0; bj < 2; ++bj) {
            const f32x4 t0 = *(const f32x4*)(TA + c0 + bj * HALF), t1 = *(const f32x4*)(TA + c0 + bj * HALF + 4);
#pragma unroll
            for (int ai = 0; ai < 2; ++ai)
#pragma unroll
                for (int m = 0; m < 4; ++m) { const int k = k0 + ai * HALF + m * 16; const float sg = (k & 1) ? -1.f : 1.f;
                    const u32x4 pp = *(const u32x4*)(Pb + (size_t)k * 8192 + c0 + bj * HALF);
                    const f32x4 q0 = acc[ai][bj][m][0], q1 = acc[ai][bj][m][1];
                    float pt[8];
                    pt[0] = bflo(pp.x) + sg * t0[0]; pt[1] = bfhi(pp.x) + sg * t0[1]; pt[2] = bflo(pp.y) + sg * t0[2]; pt[3] = bfhi(pp.y) + sg * t0[3];
                    pt[4] = bflo(pp.z) + sg * t1[0]; pt[5] = bfhi(pp.z) + sg * t1[1]; pt[6] = bflo(pp.w) + sg * t1[2]; pt[7] = bfhi(pp.w) + sg * t1[3];
                    { const size_t off = (size_t)(b * 4096 + k) * 1024 + n0 + bj * HALF; const u32x4 zz = *(const u32x4*)(Z + off); u32x4 w;
                      w.x = pkbf((pt[0] - q0[0]) * silu_f(bflo(zz.x)), (pt[1] - q0[1]) * silu_f(bfhi(zz.x))); w.y = pkbf((pt[2] - q0[2]) * silu_f(bflo(zz.y)), (pt[3] - q0[3]) * silu_f(bfhi(zz.y)));
                      w.z = pkbf((pt[4] - q1[0]) * silu_f(bflo(zz.z)), (pt[5] - q1[1]) * silu_f(bfhi(zz.z))); w.w = pkbf((pt[6] - q1[2]) * silu_f(bflo(zz.w)), (pt[7] - q1[3]) * silu_f(bfhi(zz.w)));
                      *(u32x4*)(OG + off) = w; }
                    if (k >= 1) { const size_t off = (size_t)(b * 4096 + 4096 - k) * 1024 + n0 + bj * HALF; const u32x4 zz = *(const u32x4*)(Z + off); u32x4 w;
                      w.x = pkbf((pt[0] + q0[0]) * silu_f(bflo(zz.x)), (pt[1] + q0[1]) * silu_f(bfhi(zz.x))); w.y = pkbf((pt[2] + q0[2]) * silu_f(bflo(zz.y)), (pt[3] + q0[3]) * silu_f(bfhi(zz.y)));
                      w.z = pkbf((pt[4] + q1[0]) * silu_f(bflo(zz.z)), (pt[5] + q1[1]) * silu_f(bfhi(zz.z))); w.w = pkbf((pt[6] + q1[2]) * silu_f(bflo(zz.w)), (pt[7] + q1[3]) * silu_f(bfhi(zz.w)));
                      *(u32x4*)(OG + off) = w; }
                    asm volatile("" ::: "memory");
                }
        }
    }
};
template <class Epi, class Sched, bool ALIGN_EPI = false, bool SP2 = false>
__device__ __forceinline__ void gemm_phase(PG8_LAS unsigned char* lds, const Gemm g, const Sched& S, const Epi& E) {
    const int tid = opaque_tid(), wid = __builtin_amdgcn_readfirstlane(tid >> 6), lane = tid & 63, wr = wid >> 2, wc = wid & 3, fr = lane & 15, fq = lane >> 4;
    const int K = g.K, nt = K / BK;
    unsigned voffA[2], voffB[2];
#pragma unroll
    for (int i = 0; i < 2; ++i) { int R, C; stage_rc(tid * 16 + i * 8192, R, C); const int Rb = Epi::PERM ? ((R & ~31) + perm32(R & 31)) : R;
        voffA[i] = (unsigned)(R * K + C) * 2u; voffB[i] = (unsigned)(Rb * K + C) * 2u; }
    const size_t kstep = (size_t)(BK * 2);
    const size_t hstep = (size_t)HALF * K * 2;
    const size_t tstep = 2 * hstep;
    const unsigned ldsw = (unsigned)wid * 1024u;
    const int aoff = lds_byte(wr * 64 + fr, fq * 8), boff = lds_byte(wc * 32 + fr, fq * 8);
#define PG8_SA(b, h) (((b) * 2 + (h)) * HTB)
#define PG8_SB(b, h) ((4 + (b) * 2 + (h)) * HTB)
#define PG8_STAGE(bufoff, gbase, voff) do { _Pragma("unroll") for (int _i = 0; _i < 2; ++_i) \
        __builtin_amdgcn_global_load_lds((const unsigned*)((const char*)(gbase) + (voff)[_i]), (PG8_LAS unsigned*)(lds + (bufoff) + ldsw + _i * 8192), 16, 0, 0); } while (0)
#define PG8_LDA(dst, b, h) do { _Pragma("unroll") for (int m = 0; m < 4; ++m) _Pragma("unroll") for (int k = 0; k < 2; ++k) dst[m][k] = *(const PG8_LAS bf16x8*)(lds + PG8_SA(b, h) + aoff + m * 2048 + k * 1024); } while (0)
#define PG8_LDB(dst, b, h) do { _Pragma("unroll") for (int n = 0; n < 2; ++n) _Pragma("unroll") for (int k = 0; k < 2; ++k) dst[n][k] = *(const PG8_LAS bf16x8*)(lds + PG8_SB(b, h) + boff + n * 2048 + k * 1024); } while (0)
#define PG8_MMA(ai, bj, At, Bt) do { __builtin_amdgcn_s_setprio(1); _Pragma("unroll") for (int m = 0; m < 4; ++m) _Pragma("unroll") for (int n = 0; n < 2; ++n) _Pragma("unroll") for (int k = 0; k < 2; ++k) \
        acc[ai][bj][m][n] = __builtin_amdgcn_mfma_f32_16x16x32_bf16(Bt[n][k], At[m][k], acc[ai][bj][m][n], 0, 0, 0); __builtin_amdgcn_s_setprio(0); } while (0)
#define PG8_WAIT_V(n) asm volatile("s_waitcnt vmcnt(" #n ")" ::: "memory")
#define PG8_WAIT_L(n) asm volatile("s_waitcnt lgkmcnt(" #n ")" ::: "memory")
#define PG8_BAR __builtin_amdgcn_s_barrier()
#define PG8_SCHED __builtin_amdgcn_sched_barrier(0)
    Unit cur, nxt; int ui = 0;
    if (!S.next(0, cur)) return;
    f32x4 acc[2][2][4][2];
#pragma unroll
    for (int a = 0; a < 2; ++a)
#pragma unroll
        for (int b = 0; b < 2; ++b)
#pragma unroll
            for (int m = 0; m < 4; ++m)
#pragma unroll
                for (int n = 0; n < 2; ++n) acc[a][b][m][n] = (f32x4){0.f, 0.f, 0.f, 0.f};
    bf16x8 At[4][2], B0[2][2], B1[2][2];
    const char* cA = (const char*)g.A + (size_t)cur.pm * tstep; const char* cB = (const char*)g.Bt + (size_t)cur.pn * tstep;
    S.a_ready(cur);
    if constexpr (SP2) {
        PG8_STAGE(PG8_SB(0, 0), cB, voffB); PG8_STAGE(PG8_SB(0, 1), cB + hstep, voffB); PG8_STAGE(PG8_SA(0, 0), cA, voffA); PG8_STAGE(PG8_SA(0, 1), cA + hstep, voffA);
        if (wr == 1) PG8_BAR;
        PG8_WAIT_V(2); PG8_BAR;
        PG8_STAGE(PG8_SB(1, 0), cB + kstep, voffB); PG8_STAGE(PG8_SA(1, 0), cA + kstep, voffA); PG8_STAGE(PG8_SB(1, 1), cB + hstep + kstep, voffB);
        PG8_WAIT_V(6); PG8_BAR;
    } else {
        PG8_STAGE(PG8_SB(0, 0), cB, voffB); PG8_STAGE(PG8_SA(0, 0), cA, voffA); PG8_STAGE(PG8_SB(0, 1), cB + hstep, voffB); PG8_STAGE(PG8_SA(0, 1), cA + hstep, voffA);
        if (wr == 1) PG8_BAR;
        PG8_WAIT_V(4); PG8_BAR;
        PG8_STAGE(PG8_SB(1, 0), cB + kstep, voffB); PG8_STAGE(PG8_SA(1, 0), cA + kstep, voffA); PG8_STAGE(PG8_SB(1, 1), cB + hstep + kstep, voffB);
        PG8_WAIT_V(6); PG8_BAR;
    }
    for (;;) {
        const bool has_next = S.next(ui + 1, nxt);
        const char* nA = has_next ? (const char*)g.A + (size_t)nxt.pm * tstep : cA; const char* nB = has_next ? (const char*)g.Bt + (size_t)nxt.pn * tstep : cB;
        for (int t = 0; t < nt; t += 2) {
            const bool last = (t == nt - 2);
            const char* a1 = cA + (size_t)(t + 1) * kstep;
            const char* a2 = last ? nA : cA + (size_t)(t + 2) * kstep; const char* b2 = last ? nB : cB + (size_t)(t + 2) * kstep;
            const char* a3 = a2 + kstep; const char* b3 = b2 + kstep;
            if (last && has_next) S.a_ready(nxt);
            if constexpr (SP2) {
            PG8_LDB(B0, 0, 0); PG8_LDB(B1, 0, 1); PG8_SCHED; PG8_LDA(At, 0, 0); PG8_STAGE(PG8_SA(1, 1), a1 + hstep, voffA);
            PG8_WAIT_V(8); PG8_WAIT_L(0); PG8_BAR; PG8_MMA(0, 0, At, B0); PG8_MMA(0, 1, At, B1); PG8_BAR; PG8_SCHED;
            PG8_LDA(At, 0, 1); PG8_STAGE(PG8_SB(0, 0), b2, voffB); PG8_STAGE(PG8_SB(0, 1), b2 + hstep, voffB); PG8_STAGE(PG8_SA(0, 0), a2, voffA);
            PG8_WAIT_V(8); PG8_WAIT_L(0); PG8_BAR; PG8_MMA(1, 0, At, B0); PG8_MMA(1, 1, At, B1); PG8_BAR; PG8_SCHED;
            PG8_LDB(B0, 1, 0); PG8_LDB(B1, 1, 1); PG8_SCHED; PG8_LDA(At, 1, 0); PG8_STAGE(PG8_SA(0, 1), a2 + hstep, voffA);
            PG8_WAIT_V(8); PG8_WAIT_L(0); PG8_BAR; PG8_MMA(0, 0, At, B0); PG8_MMA(0, 1, At, B1); PG8_BAR; PG8_SCHED;
            PG8_LDA(At, 1, 1); PG8_STAGE(PG8_SB(1, 0), b3, voffB); PG8_STAGE(PG8_SB(1, 1), b3 + hstep, voffB); PG8_STAGE(PG8_SA(1, 0), a3, voffA);
            PG8_WAIT_V(8); PG8_WAIT_L(0); PG8_BAR; PG8_MMA(1, 0, At, B0); PG8_MMA(1, 1, At, B1); PG8_BAR; PG8_SCHED;
            } else {
            PG8_LDB(B0, 0, 0); PG8_SCHED; PG8_LDA(At, 0, 0); PG8_STAGE(PG8_SA(1, 1), a1 + hstep, voffA);
            PG8_WAIT_L(8); PG8_BAR; PG8_WAIT_L(0); PG8_MMA(0, 0, At, B0); PG8_BAR; PG8_SCHED;
            PG8_LDB(B1, 0, 1); PG8_STAGE(PG8_SB(0, 0), b2, voffB);
            PG8_BAR; PG8_WAIT_L(0); PG8_MMA(0, 1, At, B1); PG8_BAR;
            PG8_LDA(At, 0, 1); PG8_STAGE(PG8_SA(0, 0), a2, voffA);
            PG8_BAR; PG8_WAIT_L(0); PG8_MMA(1, 0, At, B0); PG8_BAR; PG8_SCHED;
            PG8_STAGE(PG8_SB(0, 1), b2 + hstep, voffB);
            PG8_WAIT_V(6); PG8_BAR; PG8_MMA(1, 1, At, B1); PG8_BAR;
            PG8_LDB(B0, 1, 0); PG8_SCHED; PG8_LDA(At, 1, 0); PG8_STAGE(PG8_SA(0, 1), a2 + hstep, voffA);
            PG8_WAIT_L(8); PG8_BAR; PG8_WAIT_L(0); PG8_MMA(0, 0, At, B0); PG8_BAR; PG8_SCHED;
            PG8_LDB(B1, 1, 1); PG8_STAGE(PG8_SB(1, 0), b3, voffB);
            PG8_BAR; PG8_WAIT_L(0); PG8_MMA(0, 1, At, B1); PG8_BAR;
            PG8_LDA(At, 1, 1); PG8_STAGE(PG8_SA(1, 0), a3, voffA);
            PG8_BAR; PG8_WAIT_L(0); PG8_MMA(1, 0, At, B0); PG8_BAR; PG8_SCHED;
            PG8_STAGE(PG8_SB(1, 1), b3 + hstep, voffB);
            PG8_WAIT_V(6); PG8_BAR; PG8_MMA(1, 1, At, B1); PG8_BAR;
            }
        }
        if constexpr (ALIGN_EPI) { if (wr == 0) PG8_BAR; }
        if constexpr (!Epi::AFTER_DRAIN) { E(acc, cur, wr, wc, fr, fq); S.done(cur); }
        if (!has_next) break;
#pragma unroll
        for (int a = 0; a < 2; ++a)
#pragma unroll
            for (int b = 0; b < 2; ++b)
#pragma unroll
                for (int m = 0; m < 4; ++m)
#pragma unroll
                    for (int n = 0; n < 2; ++n) acc[a][b][m][n] = (f32x4){0.f, 0.f, 0.f, 0.f};
        cur = nxt; cA = nA; cB = nB; ++ui;
        if constexpr (ALIGN_EPI) { if (wr == 1) PG8_BAR; }
    }
    PG8_WAIT_V(0);
    if constexpr (!ALIGN_EPI) { if (wr == 0) PG8_BAR; }
    PG8_BAR;
    if constexpr (Epi::AFTER_DRAIN) { E.fused(acc, cur, wr, wc, fr, fq, lds, wid, lane); S.done(cur); }
#undef PG8_SA
#undef PG8_SB
#undef PG8_STAGE
#undef PG8_LDA
#undef PG8_LDB
#undef PG8_MMA
#undef PG8_WAIT_V
#undef PG8_WAIT_L
#undef PG8_BAR
#undef PG8_SCHED
}
}
#define LAS __attribute__((address_space(3)))
namespace att {
using bf16x8 = __attribute__((ext_vector_type(8))) short;
using s16x4 = __attribute__((ext_vector_type(4))) short;
using f32x16 = __attribute__((ext_vector_type(16))) float;
using u32x4 = __attribute__((ext_vector_type(4))) unsigned;
typedef unsigned short bf16_t;
__device__ __forceinline__ int crow(int r, int hi) { return (r & 3) + 8 * (r >> 2) + 4 * hi; }
constexpr int KSLOT = 8192, VSLOT = 16384, LDS_K = 0, LDS_V = 3 * KSLOT, LDS_WS = LDS_V + 3 * VSLOT, LDS_O1 = LDS_WS + 2048;
struct Args { const bf16_t* Q; const bf16_t* K; const bf16_t* V; const bf16_t* Z; bf16_t* O; const float* gain; float lam; float oml; int n_units; };

__device__ __forceinline__ void qkt(f32x16& p0, f32x16& p1, const LAS char* Kslot, const bf16x8* qr, const f32x16& negm, int r32, int hi) {
    const LAS char* kb = Kslot + hi * 1024 + r32 * 16;
    bf16x8 kf[8];
#pragma unroll
    for (int d0 = 0; d0 < 4; ++d0) { kf[2 * d0] = *(const LAS bf16x8*)(kb + d0 * 2048); kf[2 * d0 + 1] = *(const LAS bf16x8*)(kb + d0 * 2048 + 512); }
    asm volatile("s_waitcnt lgkmcnt(0)" ::: "memory"); __builtin_amdgcn_sched_barrier(0);
    p0 = __builtin_amdgcn_mfma_f32_32x32x16_bf16(kf[0], qr[0], negm, 0, 0, 0); p1 = __builtin_amdgcn_mfma_f32_32x32x16_bf16(kf[1], qr[0], negm, 0, 0, 0);
#pragma unroll
    for (int d0 = 1; d0 < 4; ++d0) { p0 = __builtin_amdgcn_mfma_f32_32x32x16_bf16(kf[2 * d0], qr[d0], p0, 0, 0, 0); p1 = __builtin_amdgcn_mfma_f32_32x32x16_bf16(kf[2 * d0 + 1], qr[d0], p1, 0, 0, 0); }
}
__device__ __forceinline__ void kload(bf16x8* kf, const LAS char* Kslot, int r32, int hi) {
    const LAS char* kb = Kslot + hi * 1024 + r32 * 16;
#pragma unroll
    for (int d0 = 0; d0 < 4; ++d0) { kf[2 * d0] = *(const LAS bf16x8*)(kb + d0 * 2048); kf[2 * d0 + 1] = *(const LAS bf16x8*)(kb + d0 * 2048 + 512); }
}
__device__ __forceinline__ void qk_mm(f32x16& p0, f32x16& p1, const bf16x8* kf, const bf16x8* qr) {
    const f32x16 z = f32x16{};
    p0 = __builtin_amdgcn_mfma_f32_32x32x16_bf16(kf[0], qr[0], z, 0, 0, 0); p1 = __builtin_amdgcn_mfma_f32_32x32x16_bf16(kf[1], qr[0], z, 0, 0, 0);
#pragma unroll
    for (int d0 = 1; d0 < 4; ++d0) { p0 = __builtin_amdgcn_mfma_f32_32x32x16_bf16(kf[2 * d0], qr[d0], p0, 0, 0, 0); p1 = __builtin_amdgcn_mfma_f32_32x32x16_bf16(kf[2 * d0 + 1], qr[d0], p1, 0, 0, 0); }
}
__device__ __forceinline__ float rowmax(const f32x16& p0, const f32x16& p1) {
    float a = fmaxf(p0[0], p1[0]);
#pragma unroll
    for (int r = 1; r < 16; ++r) a = fmaxf(a, fmaxf(p0[r], p1[r]));
    auto rr = __builtin_amdgcn_permlane32_swap(__float_as_uint(a), __float_as_uint(a), false, false);
    return fmaxf(__uint_as_float(rr[0]), __uint_as_float(rr[1]));
}
#define ATT_VRD(buf, d0) do { _Pragma("unroll") for (int ks = 0; ks < 4; ++ks) { \
        asm volatile("ds_read_b64_tr_b16 %0,%1 offset:%c2" : "=&v"(lo[buf][ks]) : "v"(vb), "i"((d0) * 4096 + ks * 1024) : "memory"); \
        asm volatile("ds_read_b64_tr_b16 %0,%1 offset:%c2" : "=&v"(hi[buf][ks]) : "v"(vb), "i"((d0) * 4096 + ks * 1024 + 512) : "memory"); } } while (0)
#define ATT_PK(b, k) (bf16x8){lo[b][k][0], lo[b][k][1], lo[b][k][2], lo[b][k][3], hi[b][k][0], hi[b][k][1], hi[b][k][2], hi[b][k][3]}
#define ATT_MM2(da, db) do { \
        o[da] = __builtin_amdgcn_mfma_f32_32x32x16_bf16(pa0, ATT_PK(0, 0), o[da], 0, 0, 0); o[db] = __builtin_amdgcn_mfma_f32_32x32x16_bf16(pa0, ATT_PK(1, 0), o[db], 0, 0, 0); \
        o[da] = __builtin_amdgcn_mfma_f32_32x32x16_bf16(pa1, ATT_PK(0, 1), o[da], 0, 0, 0); o[db] = __builtin_amdgcn_mfma_f32_32x32x16_bf16(pa1, ATT_PK(1, 1), o[db], 0, 0, 0); \
        o[da] = __builtin_amdgcn_mfma_f32_32x32x16_bf16(pa2, ATT_PK(0, 2), o[da], 0, 0, 0); o[db] = __builtin_amdgcn_mfma_f32_32x32x16_bf16(pa2, ATT_PK(1, 2), o[db], 0, 0, 0); \
        o[da] = __builtin_amdgcn_mfma_f32_32x32x16_bf16(pa3, ATT_PK(0, 3), o[da], 0, 0, 0); o[db] = __builtin_amdgcn_mfma_f32_32x32x16_bf16(pa3, ATT_PK(1, 3), o[db], 0, 0, 0); } while (0)
__device__ __forceinline__ void pv(f32x16* o, int vb, bf16x8 pa0, bf16x8 pa1, bf16x8 pa2, bf16x8 pa3) {
    s16x4 lo[2][4], hi[2][4];
    ATT_VRD(0, 0);
    ATT_VRD(1, 1);
    asm volatile("s_waitcnt lgkmcnt(0)" ::: "memory"); __builtin_amdgcn_sched_barrier(0);
    ATT_MM2(0, 1); __builtin_amdgcn_sched_barrier(0);
    ATT_VRD(0, 2);
    ATT_VRD(1, 3);
    asm volatile("s_waitcnt lgkmcnt(0)" ::: "memory"); __builtin_amdgcn_sched_barrier(0);
    ATT_MM2(2, 3);
}
#undef ATT_MM2
#undef ATT_VRD
#undef ATT_PK
__device__ __forceinline__ void attn_pass(const Args& A, int z, int b, int h, int qrow0, bool isctx, LAS char* shm, f32x16* o) {
    const int tid = opaque_tid(), lane = tid & 63, r32 = lane & 31, hi = lane >> 5; const int wid = __builtin_amdgcn_readfirstlane(tid >> 6);
    const int NT = isctx ? 4 : 68;
    LAS float* wsf = (LAS float*)(shm + LDS_WS) + wid * 64;
    const int vb0 = (int)(unsigned)(size_t)(shm + LDS_V) + ((lane >> 4) & 1) * 32 + (lane & 3) * 8 + (4 * hi + ((lane & 15) >> 2)) * 64;
    const bf16_t* Qw = A.Q + (size_t)(qrow0 + wid * 32 + r32) * 1024 + h * 128 + z * 64;
    bf16x8 qr[4];
#pragma unroll
    for (int d0 = 0; d0 < 4; ++d0) qr[d0] = *(const bf16x8*)(Qw + d0 * 16 + hi * 8);
    const bf16_t* Kh = A.K + (size_t)((h * 2 + z) * 8 + wid) * 512 + lane * 8;
    const int pc0 = wid, pc1 = wid + 8;
    const bf16_t* Vh0 = A.V + (size_t)h * 8192 + pc0 * 512 + lane * 8;
    const bf16_t* Vh1 = A.V + (size_t)h * 8192 + pc1 * 512 + lane * 8;
    const int ctxrow = TL + b * 256, latrow = b * 4096;
#define ATT_TROW(t) ((isctx || (t) < 4) ? (ctxrow + 64 * (t)) : (latrow + 64 * ((t) - 4)))
#define ATT_DMA(t, slot, vslot) do { const size_t ro_ = (size_t)(ATT_TROW(t) >> 6) * 65536; \
        __builtin_amdgcn_global_load_lds((const unsigned*)(Kh + ro_), (LAS unsigned*)(shm + LDS_K + (slot) * KSLOT + wid * 1024), 16, 0, 0); \
        __builtin_amdgcn_global_load_lds((const unsigned*)(Vh0 + ro_), (LAS unsigned*)(shm + LDS_V + (vslot) * VSLOT + pc0 * 1024), 16, 0, 0); \
        __builtin_amdgcn_global_load_lds((const unsigned*)(Vh1 + ro_), (LAS unsigned*)(shm + LDS_V + (vslot) * VSLOT + pc1 * 1024), 16, 0, 0); } while (0)
    float mhat = 0.f, l_reg = 0.f;
#pragma unroll
    for (int d = 0; d < 4; ++d) o[d] = f32x16{};
    ATT_DMA(0, 0, 0);
    if (NT > 1) ATT_DMA(1, 1, 1);
    asm volatile("s_waitcnt vmcnt(0) lgkmcnt(0)\n\ts_barrier" ::: "memory");
    f32x16 sc0, sc1;
    { bf16x8 kf[8]; kload(kf, shm + LDS_K, r32, hi); qk_mm(sc0, sc1, kf, qr); }
    if (NT > 2) ATT_DMA(2, 2, 2);
    int sl_cur = 0;
#pragma unroll 1
    for (int t = 0; t < NT; ++t) {
        const int sl_n1 = (sl_cur == 2) ? 0 : sl_cur + 1;
        if (t > 0) {
            asm volatile("s_waitcnt vmcnt(0) lgkmcnt(0)\n\ts_barrier" ::: "memory");
            const int sl_p2 = (sl_cur == 0) ? 2 : sl_cur - 1;
            if (t + 2 < NT) ATT_DMA(t + 2, sl_p2, sl_p2);
        }
        bf16x8 kf[8];
        kload(kf, shm + LDS_K + sl_n1 * KSLOT, r32, hi);
        const float rm = rowmax(sc0, sc1);
        if (t == 0) { mhat = rm; }
        else if (__any(rm - mhat > 8.f)) {
            const float dl = fmaxf(rm - mhat, 0.f); mhat += dl;
            const float f = __builtin_amdgcn_exp2f(-dl); l_reg *= f;
            if (hi == 0) wsf[r32] = f;
            asm volatile("s_waitcnt lgkmcnt(0)" ::: "memory");
#pragma unroll
            for (int r = 0; r < 16; ++r) { const float fr_ = wsf[crow(r, hi)];
#pragma unroll
                for (int d = 0; d < 4; ++d) o[d][r] *= fr_; }
            asm volatile("s_waitcnt lgkmcnt(0)" ::: "memory");
        }
        __builtin_amdgcn_sched_barrier(0);
        f32x16 pn0, pn1;
        qk_mm(pn0, pn1, kf, qr);
        f32x2_t sacc = {0.f, 0.f};
#pragma unroll
        for (int r = 0; r < 16; r += 2) { sc0[r] = __builtin_amdgcn_exp2f(sc0[r] - mhat); sc0[r + 1] = __builtin_amdgcn_exp2f(sc0[r + 1] - mhat); sc1[r] = __builtin_amdgcn_exp2f(sc1[r] - mhat); sc1[r + 1] = __builtin_amdgcn_exp2f(sc1[r + 1] - mhat);
            sacc += (f32x2_t){sc0[r], sc0[r + 1]}; sacc += (f32x2_t){sc1[r], sc1[r + 1]}; }
        l_reg += sacc.x + sacc.y;
        u32x4 pw0, pw1, pw2, pw3;
        pw0 = (u32x4){pkbf(sc0[0], sc0[1]), pkbf(sc0[2], sc0[3]), pkbf(sc0[4], sc0[5]), pkbf(sc0[6], sc0[7])};
        pw1 = (u32x4){pkbf(sc0[8], sc0[9]), pkbf(sc0[10], sc0[11]), pkbf(sc0[12], sc0[13]), pkbf(sc0[14], sc0[15])};
        pw2 = (u32x4){pkbf(sc1[0], sc1[1]), pkbf(sc1[2], sc1[3]), pkbf(sc1[4], sc1[5]), pkbf(sc1[6], sc1[7])};
        pw3 = (u32x4){pkbf(sc1[8], sc1[9]), pkbf(sc1[10], sc1[11]), pkbf(sc1[12], sc1[13]), pkbf(sc1[14], sc1[15])};
#pragma unroll
        for (int i = 0; i < 8; ++i) { __builtin_amdgcn_sched_group_barrier(0x008, 1, 0); __builtin_amdgcn_sched_group_barrier(0x002, 14, 0); }
        __builtin_amdgcn_sched_barrier(0);
        pv(o, vb0 + sl_cur * VSLOT, __builtin_bit_cast(bf16x8, pw0), __builtin_bit_cast(bf16x8, pw1), __builtin_bit_cast(bf16x8, pw2), __builtin_bit_cast(bf16x8, pw3));
        sc0 = pn0; sc1 = pn1;
        sl_cur = sl_n1;
    }
    asm volatile("s_waitcnt lgkmcnt(0)\n\ts_barrier" ::: "memory");
#undef ATT_DMA
#undef ATT_TROW
    { auto rr = __builtin_amdgcn_permlane32_swap(__float_as_uint(l_reg), __float_as_uint(l_reg), false, false); l_reg = __uint_as_float(rr[0]) + __uint_as_float(rr[1]); }
    asm volatile("s_waitcnt lgkmcnt(0)" ::: "memory");
    if (hi == 0) wsf[32 + r32] = l_reg;
    asm volatile("s_waitcnt lgkmcnt(0)" ::: "memory");
#pragma unroll
    for (int r = 0; r < 16; ++r) { const float rl = 1.0f / wsf[32 + crow(r, hi)];
#pragma unroll
        for (int d = 0; d < 4; ++d) o[d][r] *= rl; }
    asm volatile("s_waitcnt lgkmcnt(0)" ::: "memory");
}
__device__ __forceinline__ void attn_unit(const Args& A, int b, int h, int qb, bool isctx, LAS char* shm) {
    const int tid = opaque_tid(), lane = tid & 63, r32 = lane & 31, hi = lane >> 5; const int wid = __builtin_amdgcn_readfirstlane(tid >> 6);
    const int qrow0 = isctx ? (TL + b * 256) : (b * 4096 + qb * 256);
    f32x16 o[4];
    LAS unsigned* o1s = (LAS unsigned*)(shm + LDS_O1) + wid * 2048 + lane;
    attn_pass(A, 0, b, h, qrow0, isctx, shm, o);
#pragma unroll
    for (int d = 0; d < 4; ++d)
#pragma unroll
        for (int r = 0; r < 16; r += 2) o1s[(d * 8 + (r >> 1)) * 64] = pkbf(o[d][r], o[d][r + 1]);
    asm volatile("s_waitcnt lgkmcnt(0)" ::: "memory");
    attn_pass(A, 1, b, h, qrow0, isctx, shm, o);
    float ss[16];
#pragma unroll
    for (int r = 0; r < 16; r += 2) { float s0 = 0.f, s1 = 0.f;
#pragma unroll
        for (int d = 0; d < 4; ++d) { const unsigned pk = o1s[(d * 8 + (r >> 1)) * 64];
            const float v0 = bflo(pk) - A.lam * o[d][r], v1 = bfhi(pk) - A.lam * o[d][r + 1]; o[d][r] = v0; o[d][r + 1] = v1; s0 += v0 * v0; s1 += v1 * v1; }
        ss[r] = s0; ss[r + 1] = s1; }
#pragma unroll
    for (int msk = 1; msk < 32; msk <<= 1)
#pragma unroll
        for (int r = 0; r < 16; ++r) ss[r] += __shfl_xor(ss[r], msk);
    float gn[4];
#pragma unroll
    for (int d = 0; d < 4; ++d) gn[d] = A.gain[d * 32 + r32] * A.oml;
#pragma unroll
    for (int r = 0; r < 16; ++r) {
        const float rstd = rsqrtf(ss[r] * (1.0f / 128.0f) + 1e-5f);
        const size_t off = (size_t)(qrow0 + wid * 32 + crow(r, hi)) * 1024 + h * 128 + r32;
#pragma unroll
        for (int d = 0; d < 4; ++d) { const float zv = bf1(A.Z[off + d * 32]); const float v = o[d][r] * rstd * gn[d] * silu_f(zv);
            A.O[off + d * 32] = (bf16_t)(pkbf(v, 0.f) & 0xffffu); }
        asm volatile("" ::: "memory");
    }
}
__device__ __forceinline__ void attn_phase(const Args& A, LAS char* shm, int G, int bid) {
    const int vcu = (G % 8 == 0) ? (bid % 8) * (G / 8) + bid / 8 : bid;
#pragma unroll 1
    for (int u = vcu; u < A.n_units; u += G) {
        const bool isctx = u >= 1024; const int bh = isctx ? (u - 1024) : (u >> 4); const int qb = isctx ? 0 : (u & 15);
        attn_unit(A, bh >> 3, bh & 7, qb, isctx, shm);
        asm volatile("s_waitcnt vmcnt(0) lgkmcnt(0)\n\ts_barrier" ::: "memory");
    }
}
}
typedef unsigned short bf16_t;
typedef float f32x4 __attribute__((ext_vector_type(4)));
typedef unsigned u32x4 __attribute__((ext_vector_type(4)));
typedef unsigned u32x2 __attribute__((ext_vector_type(2)));
constexpr size_t MiB = 1u << 20;
constexpr size_t WS_CTL = 0, WS_MOD = 1 * MiB, WS_ROPE = 1 * MiB + 512 * 1024, WS_BZ = 2 * MiB;
constexpr size_t WS_WDAIN = 9 * MiB, WS_WDAOUT = 25 * MiB, WS_WFNT = 29 * MiB, WS_WFNZ = 33 * MiB, WS_WFNOUT = 35 * MiB, WS_WRWIN = 37 * MiB, WS_WRWOUT = 46 * MiB;
constexpr size_t WS_XC = 48 * MiB, WS_HB = 56 * MiB, WS_BIG = 124 * MiB;
constexpr size_t WS_Q = WS_BIG, WS_K = WS_BIG + 68 * MiB, WS_V = WS_BIG + 136 * MiB, WS_Z = WS_BIG + 204 * MiB;
constexpr size_t WS_ATL = WS_BIG, WS_ATC = WS_BIG + 128 * MiB, WS_ZB = WS_BIG + 136 * MiB, WS_DFTL = 396 * MiB, WS_DFTC = 460 * MiB, WS_FOLD = WS_BIG + 204 * MiB;
constexpr size_t WS_P = WS_BIG, WS_Y1 = 413 * MiB, WS_END = 482 * MiB;
constexpr int RWN = 4352;
constexpr int LDS_BYTES = 147456;

struct Params { const float* in[28]; float* out; unsigned char* ws; };

__device__ __forceinline__ float wave_sum(float v) {
#pragma unroll
    for (int o = 1; o < 64; o <<= 1) v += __shfl_xor(v, o);
    return v;
}
__device__ __forceinline__ void tr_item(const float* W, int ldw, int N, bf16_t* WT, int ldt, LAS float* scr, int item, int lane) {
    const int nblk = N / 32, kb = item / nblk, nb = item % nblk, k0 = 64 * kb, n0 = 32 * nb;
#pragma unroll 8
    for (int i = 0; i < 32; ++i) { const int kk = 2 * i + (lane >> 5); scr[kk * 33 + (lane & 31)] = W[(size_t)(k0 + kk) * ldw + n0 + (lane & 31)]; }
    asm volatile("s_waitcnt lgkmcnt(0)" ::: "memory");
    const int c = lane & 7;
#pragma unroll
    for (int j = 0; j < 4; ++j) { const int n = (lane >> 3) + 8 * j; const LAS float* s = scr + (8 * c) * 33 + n;
        u32x4 o; o.x = pkbf(s[0 * 33], s[1 * 33]); o.y = pkbf(s[2 * 33], s[3 * 33]); o.z = pkbf(s[4 * 33], s[5 * 33]); o.w = pkbf(s[6 * 33], s[7 * 33]);
        *(u32x4*)(WT + (size_t)(n0 + n) * ldt + k0 + 8 * c) = o; }
    asm volatile("s_waitcnt lgkmcnt(0)" ::: "memory");
}
__device__ __forceinline__ void prologue(const Params& p, LAS char* lds, int G, int bid) {
    const int tid = opaque_tid(), lane = tid & 63, wid = tid >> 6;
    unsigned char* ws = p.ws;
    {
        LAS float* scr = (LAS float*)(lds + wid * 8448);
        const int gw = bid * 8 + wid, NGW = G * 8;
        for (int it = gw; it < 8832; it += NGW) {
            int r = it;
            if (r < 2048) { tr_item(p.in[8], 4096, 4096, (bf16_t*)(ws + WS_WDAIN), 1024, scr, r, lane); continue; } r -= 2048;
            if (r < 2048) { tr_item(p.in[8] + (size_t)1024 * 4096, 4096, 4096, (bf16_t*)(ws + WS_WDAIN + 8 * MiB), 1024, scr, r, lane); continue; } r -= 2048;
            if (r < 512) { tr_item(p.in[12], 1024, 1024, (bf16_t*)(ws + WS_WDAOUT), 1024, scr, r, lane); continue; } r -= 512;
            if (r < 512) { tr_item(p.in[12] + (size_t)1024 * 1024, 1024, 1024, (bf16_t*)(ws + WS_WDAOUT + 2 * MiB), 1024, scr, r, lane); continue; } r -= 512;
            if (r < 512) { tr_item(p.in[13] + 1024, 2048, 1024, (bf16_t*)(ws + WS_WFNZ), 1024, scr, r, lane); continue; } r -= 512;
            if (r < 512) { tr_item(p.in[15], 1024, 1024, (bf16_t*)(ws + WS_WFNOUT), 1024, scr, r, lane); continue; } r -= 512;
            if (r < 2176) { tr_item(p.in[16], RWN, RWN, (bf16_t*)(ws + WS_WRWIN), 1024, scr, r, lane); continue; } r -= 2176;
            tr_item(p.in[27], 1024, 1024, (bf16_t*)(ws + WS_WRWOUT), 1024, scr, r, lane);
        }
    }
    __syncthreads();
    for (int it = bid; it < 256; it += G) {
        const int g = it >> 5, cs = (it >> 4) & 1, kq = it & 15;
        LAS float* Wcs = (LAS float*)lds; LAS float* win = (LAS float*)(lds + 65536); LAS float* tab = (LAS float*)(lds + 65536 + 33024);
        if (tid < 128) { float s, c; sincospif((float)tid / 64.f, &s, &c); tab[tid] = (cs ? s : c) * 0.08838834764831845f; }
        __syncthreads();
        {
            const int e = tid & 127, cq = tid >> 7; float acc[32];
#pragma unroll
            for (int i = 0; i < 32; ++i) acc[i] = 0.f;
            const float* Wg = p.in[14] + (size_t)g * 128 * 128;
            for (int m = 0; m < 128; ++m) { const float wg = Wg[m * 128 + e];
#pragma unroll
                for (int i = 0; i < 32; ++i) acc[i] += tab[(m * (cq + 4 * i)) & 127] * wg; }
#pragma unroll
            for (int i = 0; i < 32; ++i) Wcs[(cq + 4 * i) * 128 + e] = acc[i];
        }
#pragma unroll
        for (int i = 0; i < 16; ++i) { const int idx = tid + 512 * i, kin = idx >> 7, c = idx & 127; win[kin * 129 + c] = p.in[13][(size_t)(kq * 64 + kin) * 2048 + g * 128 + c]; }
        __syncthreads();
        {
            const int kin = tid & 63, eg = tid >> 6; float acc[16];
#pragma unroll
            for (int i = 0; i < 16; ++i) acc[i] = 0.f;
            for (int c = 0; c < 128; ++c) { const float a = win[kin * 129 + c];
#pragma unroll
                for (int i = 0; i < 16; ++i) acc[i] += a * Wcs[c * 128 + eg * 16 + i]; }
            bf16_t* WT = (bf16_t*)(ws + WS_WFNT);
#pragma unroll
            for (int i = 0; i < 16; ++i) WT[(size_t)(cs * 1024 + g * 128 + eg * 16 + i) * 1024 + kq * 64 + kin] = (bf16_t)(pkbf(acc[i], 0.f) & 0xffffu);
        }
        __syncthreads();
    }
    {
        LAS float* tc = (LAS float*)lds; LAS float* ts = (LAS float*)(lds + 16384);
        for (int j = tid; j < 4096; j += 512) { float s, c; sincospif((float)j / 2048.f, &s, &c); tc[j] = c; ts[j] = -s; }
        __syncthreads();
        bf16_t* DL = (bf16_t*)(ws + WS_DFTL); bf16_t* DC = (bf16_t*)(ws + WS_DFTC);
        for (int k = bid; k < 2048; k += G) {
            const int j0 = (tid & 255) * 8; const bool sn = tid >= 256; float v8[8];
#pragma unroll
            for (int i = 0; i < 8; ++i) { const int idx = (k * (j0 + i)) & 4095; v8[i] = (sn ? -ts[idx] : tc[idx]) * 0.015625f; }
            u32x4 o; o.x = pkbf(v8[0], v8[1]); o.y = pkbf(v8[2], v8[3]); o.z = pkbf(v8[4], v8[5]); o.w = pkbf(v8[6], v8[7]);
            *(u32x4*)(DL + (sn ? (size_t)2048 * 2048 : (size_t)0) + (size_t)k * 2048 + j0) = o;
        }
        for (int k = bid; k < 256; k += G) {
            if (tid < 64) { const int cs = tid >> 5, l0 = (tid & 31) * 8; float v8[8];
#pragma unroll
                for (int i = 0; i < 8; ++i) { const int idx = ((k * (l0 + i)) & 255) * 16; v8[i] = (cs ? ts[idx] : tc[idx]) * 0.0625f; }
                u32x4 o; o.x = pkbf(v8[0], v8[1]); o.y = pkbf(v8[2], v8[3]); o.z = pkbf(v8[4], v8[5]); o.w = pkbf(v8[6], v8[7]);
                *(u32x4*)(DC + (size_t)k * 512 + cs * 256 + l0) = o; }
        }
        __syncthreads();
    }
    {
        LAS float* sc = (LAS float*)lds; LAS float* red = (LAS float*)(lds + 40960);
        bool have = false;
        for (int it = bid; it < 192; it += G) {
            if (!have) { for (int idx = tid; idx < 9216; idx += 512) { const int r = idx >> 10, k = idx & 1023; const float cv = r < 8 ? p.in[1][r * 1024 + k] : p.in[3][k]; sc[idx] = cv / (1.f + __expf(-cv)); } have = true; __syncthreads(); }
            const int i = it / 48, n = (it % 48) * 64 + (tid & 63), kq = tid >> 6;
            const float* w = p.in[5] + (size_t)i * 1024 * 3072 + n;
            float acc[9];
#pragma unroll
            for (int r = 0; r < 9; ++r) acc[r] = 0.f;
            for (int k = kq * 128; k < kq * 128 + 128; ++k) { const float wv = w[(size_t)k * 3072];
#pragma unroll
                for (int r = 0; r < 9; ++r) acc[r] += sc[r * 1024 + k] * wv; }
#pragma unroll
            for (int r = 0; r < 9; ++r) red[(kq * 9 + r) * 64 + (tid & 63)] = acc[r];
            __syncthreads();
            for (int idx = tid; idx < 576; idx += 512) { const int r = idx >> 6, col = idx & 63; float s = 0.f;
#pragma unroll
                for (int q = 0; q < 8; ++q) s += red[(q * 9 + r) * 64 + col];
                const int nn = (it % 48) * 64 + col;
                ((float*)(ws + WS_MOD))[(size_t)(i * 9 + r) * 3072 + nn] = s + p.in[6][i * 3072 + nn]; }
            __syncthreads();
        }
    }
    if (bid == 0) { for (int t = tid; t < 1024; t += 512) { const int pos = t >> 4, qd = t & 15; const float inv = powf(10000.f, -(float)qd / 16.f); const float ang = (float)pos * inv;
            ((float*)(ws + WS_ROPE))[t] = cosf(ang); ((float*)(ws + WS_ROPE))[1024 + t] = sinf(ang); } }
}
__device__ __forceinline__ void ph_phase(const float* xlat, const float* xctx, const float* gain, const float* mod, bf16_t* Hb, int G, int bid) {
    const int tid_ = opaque_tid(); const int lane = tid_ & 63, wid = tid_ >> 6;
    for (int row = bid * 8 + wid; row < TT; row += G * 8) {
        const bool lat = row < TL; const float* src = lat ? xlat + (size_t)row * 1024 : xctx + (size_t)(row - TL) * 1024; const int r = lat ? (row >> 12) : 8;
        f32x4 v[4]; float ss = 0.f;
#pragma unroll
        for (int j = 0; j < 4; ++j) { v[j] = *(const f32x4*)(src + 4 * lane + 256 * j); ss += (v[j].x * v[j].x + v[j].y * v[j].y) + (v[j].z * v[j].z + v[j].w * v[j].w); }
        const float rstd = rsqrtf(wave_sum(ss) * (1.f / 1024.f) + 1e-6f);
        const float* mr = mod + r * 3072;
#pragma unroll
        for (int j = 0; j < 4; ++j) { const int col = 4 * lane + 256 * j; const f32x4 g4 = *(const f32x4*)(gain + col), sh = *(const f32x4*)(mr + col), sc = *(const f32x4*)(mr + 1024 + col);
            const f32x4 y = v[j] * rstd * g4 * (sc + 1.f) + sh; u32x2 o; o.x = pkbf(y.x, y.y); o.y = pkbf(y.z, y.w);
            *(u32x2*)(Hb + (size_t)row * 1024 + col) = o; }
    }
}
__device__ __forceinline__ void final_phase(float* x, const float* gain, int G, int bid) {
    const int tid_ = opaque_tid(); const int lane = tid_ & 63, wid = tid_ >> 6;
    for (int row = bid * 8 + wid; row < TL; row += G * 8) {
        float* src = x + (size_t)row * 1024; f32x4 v[4]; float ss = 0.f;
#pragma unroll
        for (int j = 0; j < 4; ++j) { v[j] = *(const f32x4*)(src + 4 * lane + 256 * j); ss += (v[j].x * v[j].x + v[j].y * v[j].y) + (v[j].z * v[j].z + v[j].w * v[j].w); }
        const float rstd = rsqrtf(wave_sum(ss) * (1.f / 1024.f) + 1e-6f);
#pragma unroll
        for (int j = 0; j < 4; ++j) { const int col = 4 * lane + 256 * j; const f32x4 g4 = *(const f32x4*)(gain + col); *(f32x4*)(src + col) = v[j] * rstd * g4; }
    }
}
__device__ __forceinline__ void fnet_fold(const bf16_t* ATL, bf16_t* E, bf16_t* O, float* TA, const bf16_t* Z, bf16_t* OG, int G, int bid) {
    const int tid_ = opaque_tid(); const int lane = tid_ & 63, wid = tid_ >> 6;
    for (int row = bid * 8 + wid; row < 8192; row += G * 8) {
        const bf16_t* a1 = ATL + (size_t)row * 8192; const bf16_t* a2 = a1 + 4096; bf16_t* e = E + (size_t)row * 2048; bf16_t* od = O + (size_t)row * 2048;
        float alt = 0.f;
#pragma unroll 2
        for (int it = 0; it < 4; ++it) {
            const int j0 = (it * 64 + lane) * 8;
            const u32x4 x = *(const u32x4*)(a1 + j0), y = *(const u32x4*)(a2 + j0);
            const int mb = 4096 - j0 - 8;
            const u32x4 xm = *(const u32x4*)(a1 + mb), ym = *(const u32x4*)(a2 + mb);
            const unsigned short xe = (j0 == 0) ? (unsigned short)0 : a1[4096 - j0], ye = (j0 == 0) ? (unsigned short)0 : a2[4096 - j0];
            float fa[8], fs[8], ma[8], ms[8];
#pragma unroll
            for (int i = 0; i < 4; ++i) { fa[2 * i] = bflo(x[i]); fa[2 * i + 1] = bfhi(x[i]); fs[2 * i] = bflo(y[i]); fs[2 * i + 1] = bfhi(y[i]);
                ma[2 * i] = bflo(xm[i]); ma[2 * i + 1] = bfhi(xm[i]); ms[2 * i] = bflo(ym[i]); ms[2 * i + 1] = bfhi(ym[i]); }
            float oc[8], os[8];
            oc[0] = fa[0] + bf1(xe); os[0] = fs[0] - bf1(ye);
#pragma unroll
            for (int i = 1; i < 8; ++i) { oc[i] = fa[i] + ma[8 - i]; os[i] = fs[i] - ms[8 - i]; }
            if (j0 == 0) { oc[0] = fa[0]; os[0] = 0.f; }
            u32x4 o; o.x = pkbf(oc[0], oc[1]); o.y = pkbf(oc[2], oc[3]); o.z = pkbf(oc[4], oc[5]); o.w = pkbf(oc[6], oc[7]);
            *(u32x4*)(e + j0) = o;
            alt += (bflo(o.x) - bfhi(o.x)) + (bflo(o.y) - bfhi(o.y)) + (bflo(o.z) - bfhi(o.z)) + (bflo(o.w) - bfhi(o.w));
            o.x = pkbf(os[0], os[1]); o.y = pkbf(os[2], os[3]); o.z = pkbf(os[4], os[5]); o.w = pkbf(os[6], os[7]);
            *(u32x4*)(od + j0) = o;
        }
        alt = wave_sum(alt);
        if (lane == 0) { const float amid = bf1(a1[2048]); TA[row] = amid * 0.015625f;
            const int b = row >> 10, n = row & 1023; const size_t off = (size_t)(b * 4096 + 2048) * 1024 + n;
            const float yv = (alt + amid) * 0.015625f * silu_f(bf1(Z[off]));
            OG[off] = (bf16_t)(pkbf(yv, 0.f) & 0xffffu); }
    }
}
__device__ __forceinline__ void sh8(const bf16_t* P, size_t row, int co, bool hm, bool hp, const float* mu, float* out) {
    const u32x4 z4 = {0u, 0u, 0u, 0u};
    const u32x4 c0 = *(const u32x4*)(P + row * RWN + co);
    const u32x4 cm = hm ? *(const u32x4*)(P + (row - 1) * RWN + co) : z4;
    const u32x4 cp = hp ? *(const u32x4*)(P + (row + 1) * RWN + co) : z4;
    const f32x4 m0 = *(const f32x4*)(mu + co), m1 = *(const f32x4*)(mu + co + 4);
#pragma unroll
    for (int i = 0; i < 4; ++i) {
        const float a0 = bflo(c0[i]), a1 = bfhi(c0[i]);
        const float n0 = 0.5f * (bflo(cm[i]) + bflo(cp[i])), n1 = 0.5f * (bfhi(cm[i]) + bfhi(cp[i]));
        const float mu0 = (2 * i < 4) ? m0[(2 * i) & 3] : m1[(2 * i) & 3], mu1 = (2 * i + 1 < 4) ? m0[(2 * i + 1) & 3] : m1[(2 * i + 1) & 3];
        out[2 * i] = a0 + mu0 * (n0 - a0); out[2 * i + 1] = a1 + mu1 * (n1 - a1);
    }
}
template <int CTRL> __device__ __forceinline__ float dpp_f(float v) { return __int_as_float(__builtin_amdgcn_update_dpp(0, __float_as_int(v), CTRL, 0xf, 0xf, true)); }
__device__ __forceinline__ float sum8(float v) { v += dpp_f<0xB1>(v); v += dpp_f<0x4E>(v); v += dpp_f<0x141>(v); return v; }
__device__ __forceinline__ float fast_tanh(float x) { const float e = __expf(2.f * x); return 1.f - 2.f * __builtin_amdgcn_rcpf(e + 1.f); }
__device__ __forceinline__ float fast_sigmoid(float x) { return __builtin_amdgcn_rcpf(1.f + __expf(-x)); }
struct RwArgs { const bf16_t* P; bf16_t* Y0; bf16_t* Y1; float* BZ; const float *mu, *w0, *w_up, *a0, *a_up, *k_k, *k_a, *r_k; };
struct Raw3 { u32x4 c0, cm, cp; };
__device__ __forceinline__ Raw3 ld3(const bf16_t* P, size_t row, int co, bool hm, bool hp) {
    const u32x4 z4 = {0u, 0u, 0u, 0u}; Raw3 r;
    r.c0 = *(const u32x4*)(P + row * RWN + co);
    r.cm = hm ? *(const u32x4*)(P + (row - 1) * RWN + co) : z4;
    r.cp = hp ? *(const u32x4*)(P + (row + 1) * RWN + co) : z4;
    return r;
}
__device__ __forceinline__ void shift8(const Raw3& R, const float* mu, int co, float* out) {
    const f32x4 m0 = *(const f32x4*)(mu + co), m1 = *(const f32x4*)(mu + co + 4);
#pragma unroll
    for (int i = 0; i < 4; ++i) {
        const float a0 = bflo(R.c0[i]), a1 = bfhi(R.c0[i]);
        const float n0 = 0.5f * (bflo(R.cm[i]) + bflo(R.cp[i])), n1 = 0.5f * (bfhi(R.cm[i]) + bfhi(R.cp[i]));
        const float mu0 = (2 * i < 4) ? m0[(2 * i) & 3] : m1[(2 * i) & 3], mu1 = (2 * i + 1 < 4) ? m0[(2 * i + 1) & 3] : m1[(2 * i + 1) & 3];
        out[2 * i] = a0 + mu0 * (n0 - a0); out[2 * i + 1] = a1 + mu1 * (n1 - a1);
    }
}
__device__ __forceinline__ void rwkv_scan(const RwArgs& A, LAS char* lds, int G, int bid) {
    typedef short bfx8 __attribute__((ext_vector_type(8)));
    const int tid = opaque_tid(), lane = tid & 63; const int q = __builtin_amdgcn_readfirstlane(tid >> 6);
    LAS float* sW = (LAS float*)lds; LAS float* sA = sW + 4096; LAS float* sB = sA + 4096; LAS float* sKD = sB + 4096; LAS float* sR = sKD + 4096; LAS float* sV = sR + 4096;
    LAS bf16_t* WUPt = (LAS bf16_t*)(sV + 4096); LAS bf16_t* AUPt = WUPt + 64 * 72;
    LAS bf16_t* T1 = (LAS bf16_t*)sW; LAS bf16_t* T2 = (LAS bf16_t*)sKD;
    const int s = tid >> 3, dg = tid & 7, d0 = dg * 8;
#pragma unroll 1
    for (int chain = bid; chain < 256; chain += G) {
        const int z = chain >> 7, b = (chain >> 4) & 7, hh = chain & 15;
        __syncthreads();
        for (int idx = tid; idx < 4096; idx += 512) { const int r = idx >> 6, d = idx & 63;
            WUPt[d * 72 + r] = (bf16_t)(pkbf(A.w_up[(size_t)(z * 64 + r) * 1024 + hh * 64 + d], 0.f) & 0xffffu);
            AUPt[d * 72 + r] = (bf16_t)(pkbf(A.a_up[(size_t)(z * 64 + r) * 1024 + hh * 64 + d], 0.f) & 0xffffu); }
        f32x2_t S2[4];
#pragma unroll
        for (int j = 0; j < 4; ++j) S2[j] = (f32x2_t){0.f, 0.f};
        bf16_t* Yz = z ? A.Y1 : A.Y0;
        const int c_r = hh * 64 + d0, c_k = 1024 + hh * 64 + d0, c_v = 2048 + hh * 64 + d0, c_wd = 3072 + z * 64 + d0, c_ad = 3200 + z * 64 + d0;
#define RW_ROWOF(c, rowv, hmv, hpv) do { const int sidx_ = (c) * 64 + s; int L_, n_, rb_; \
            if ((c) < 4) { L_ = 256; n_ = z ? (255 - sidx_) : sidx_; rb_ = TL + b * 256; } else { L_ = 4096; const int sl_ = sidx_ - 256; n_ = z ? (4095 - sl_) : sl_; rb_ = b * 4096; } \
            rowv = (size_t)(rb_ + n_); hmv = n_ > 0; hpv = n_ < L_ - 1; } while (0)
        size_t row; bool hm, hp;
        RW_ROWOF(0, row, hm, hp);
        Raw3 Rr = ld3(A.P, row, c_r, hm, hp), Rk = ld3(A.P, row, c_k, hm, hp), Rv = ld3(A.P, row, c_v, hm, hp), Rw = ld3(A.P, row, c_wd, hm, hp), Ra = ld3(A.P, row, c_ad, hm, hp);
#pragma unroll 1
        for (int c = 0; c < 68; ++c) {
            asm volatile("" ::: "memory");
            const size_t crow_ = row;
            {
                float r8[8], k8[8], v8[8], t8[8];
                shift8(Rr, A.mu, c_r, r8); shift8(Rk, A.mu, c_k, k8); shift8(Rv, A.mu, c_v, v8);
                *(LAS f32x4*)(sR + s * 64 + d0) = (f32x4){r8[0], r8[1], r8[2], r8[3]}; *(LAS f32x4*)(sR + s * 64 + d0 + 4) = (f32x4){r8[4], r8[5], r8[6], r8[7]};
                *(LAS f32x4*)(sV + s * 64 + d0) = (f32x4){v8[0], v8[1], v8[2], v8[3]}; *(LAS f32x4*)(sV + s * 64 + d0 + 4) = (f32x4){v8[4], v8[5], v8[6], v8[7]};
                *(LAS f32x4*)(sB + s * 64 + d0) = (f32x4){k8[0], k8[1], k8[2], k8[3]}; *(LAS f32x4*)(sB + s * 64 + d0 + 4) = (f32x4){k8[4], k8[5], k8[6], k8[7]};
                float kkr[8], ssq = 0.f;
                const f32x4 kk0 = *(const f32x4*)(A.k_k + hh * 64 + d0), kk1 = *(const f32x4*)(A.k_k + hh * 64 + d0 + 4);
#pragma unroll
                for (int i = 0; i < 8; ++i) { kkr[i] = k8[i] * (i < 4 ? kk0[i & 3] : kk1[i & 3]); ssq += kkr[i] * kkr[i]; }
                ssq = sum8(ssq);
                const float rs = -rsqrtf(ssq + 1e-12f);
                *(LAS f32x4*)(sA + s * 64 + d0) = (f32x4){kkr[0] * rs, kkr[1] * rs, kkr[2] * rs, kkr[3] * rs}; *(LAS f32x4*)(sA + s * 64 + d0 + 4) = (f32x4){kkr[4] * rs, kkr[5] * rs, kkr[6] * rs, kkr[7] * rs};
                shift8(Rw, A.mu, c_wd, t8);
                { u32x4 o; o.x = pkbf(fast_tanh(t8[0]), fast_tanh(t8[1])); o.y = pkbf(fast_tanh(t8[2]), fast_tanh(t8[3])); o.z = pkbf(fast_tanh(t8[4]), fast_tanh(t8[5])); o.w = pkbf(fast_tanh(t8[6]), fast_tanh(t8[7]));
                  *(LAS u32x4*)(T1 + s * 72 + d0) = o; }
                shift8(Ra, A.mu, c_ad, t8);
                { u32x4 o; o.x = pkbf(t8[0], t8[1]); o.y = pkbf(t8[2], t8[3]); o.z = pkbf(t8[4], t8[5]); o.w = pkbf(t8[6], t8[7]);
                  *(LAS u32x4*)(T2 + s * 72 + d0) = o; }
            }
            if (c + 1 < 68) { RW_ROWOF(c + 1, row, hm, hp);
                Rr = ld3(A.P, row, c_r, hm, hp); Rk = ld3(A.P, row, c_k, hm, hp); Rv = ld3(A.P, row, c_v, hm, hp); Rw = ld3(A.P, row, c_wd, hm, hp); Ra = ld3(A.P, row, c_ad, hm, hp); }
            __syncthreads();
            const int mt = q & 3, nh = q >> 2, fr = lane & 15, fq = lane >> 4;
            f32x4 accw[2], acca[2];
            {
                bfx8 aw[2], aa[2];
#pragma unroll
                for (int kk = 0; kk < 2; ++kk) { aw[kk] = *(const LAS bfx8*)(T1 + (16 * mt + fr) * 72 + kk * 32 + fq * 8); aa[kk] = *(const LAS bfx8*)(T2 + (16 * mt + fr) * 72 + kk * 32 + fq * 8); }
#pragma unroll
                for (int nt = 0; nt < 2; ++nt) { accw[nt] = (f32x4){0.f, 0.f, 0.f, 0.f}; acca[nt] = (f32x4){0.f, 0.f, 0.f, 0.f};
#pragma unroll
                    for (int kk = 0; kk < 2; ++kk) {
                        const bfx8 bw = *(const LAS bfx8*)(WUPt + (32 * nh + 16 * nt + fr) * 72 + kk * 32 + fq * 8), ba = *(const LAS bfx8*)(AUPt + (32 * nh + 16 * nt + fr) * 72 + kk * 32 + fq * 8);
                        accw[nt] = __builtin_amdgcn_mfma_f32_16x16x32_bf16(aw[kk], bw, accw[nt], 0, 0, 0);
                        acca[nt] = __builtin_amdgcn_mfma_f32_16x16x32_bf16(aa[kk], ba, acca[nt], 0, 0, 0); } }
            }
            __syncthreads();
#pragma unroll
            for (int nt = 0; nt < 2; ++nt) { const int d = 32 * nh + 16 * nt + fr, dcol = hh * 64 + d;
                const float w0d = A.w0[z * 1024 + dcol], a0d = A.a0[z * 1024 + dcol], kad = A.k_a[dcol];
#pragma unroll
                for (int j = 0; j < 4; ++j) { const int idx = (16 * mt + 4 * fq + j) * 64 + d;
                    const float x = -(w0d + accw[nt][j]);
                    const float sp = fmaxf(x, 0.f) + __logf(1.f + __expf(-fabsf(x)));
                    const float w = __expf(-__expf(-sp - 0.5f));
                    const float asig = fast_sigmoid(a0d + acca[nt][j]);
                    const float nkk = sA[idx], kraw = sB[idx];
                    sW[idx] = w; sB[idx] = -nkk * asig; sKD[idx] = kraw * (1.f + (asig - 1.f) * kad); } }
            __syncthreads();
            {
                const f32x4 ra = *(const LAS f32x4*)(sR + s * 64 + d0), rb = *(const LAS f32x4*)(sR + s * 64 + d0 + 4), ka = *(const LAS f32x4*)(sKD + s * 64 + d0), kb = *(const LAS f32x4*)(sKD + s * 64 + d0 + 4);
                const f32x4 q0 = *(const f32x4*)(A.r_k + hh * 64 + d0), q1 = *(const f32x4*)(A.r_k + hh * 64 + d0 + 4);
                float bz = 0.f;
#pragma unroll
                for (int i = 0; i < 4; ++i) { bz += ra[i] * ka[i] * q0[i]; bz += rb[i] * kb[i] * q1[i]; }
                bz = sum8(bz);
                if (dg == 0) A.BZ[((size_t)z * TT + crow_) * 16 + hh] = bz;
            }
            {
                const int rl = lane >> 3, cg = lane & 7, irow = 8 * q + rl;
                const LAS float* bw = sW + 8 * cg; const LAS float* ba_ = sA + 8 * cg; const LAS float* bb_ = sB + 8 * cg; const LAS float* bk = sKD + 8 * cg; const LAS float* br = sR + 8 * cg;
                LAS float* bv = sV + irow;
                f32x4 w0 = *(const LAS f32x4*)(bw), w1 = *(const LAS f32x4*)(bw + 4), a0 = *(const LAS f32x4*)(ba_), a1 = *(const LAS f32x4*)(ba_ + 4);
                f32x4 b0 = *(const LAS f32x4*)(bb_), b1 = *(const LAS f32x4*)(bb_ + 4), k0 = *(const LAS f32x4*)(bk), k1 = *(const LAS f32x4*)(bk + 4);
                f32x4 r0 = *(const LAS f32x4*)(br), r1 = *(const LAS f32x4*)(br + 4); float vi = bv[0];
#pragma unroll 2
                for (int st = 0; st < 64; ++st) {
                    const int on = ((st + 1) & 63) * 64;
                    const f32x4 nw0 = *(const LAS f32x4*)(bw + on), nw1 = *(const LAS f32x4*)(bw + on + 4), na0 = *(const LAS f32x4*)(ba_ + on), na1 = *(const LAS f32x4*)(ba_ + on + 4);
                    const f32x4 nb0 = *(const LAS f32x4*)(bb_ + on), nb1 = *(const LAS f32x4*)(bb_ + on + 4), nk0 = *(const LAS f32x4*)(bk + on), nk1 = *(const LAS f32x4*)(bk + on + 4);
                    const f32x4 nr0 = *(const LAS f32x4*)(br + on), nr1 = *(const LAS f32x4*)(br + on + 4); const float nvi = bv[on];
                    f32x2_t pp2 = S2[0] * (f32x2_t){a0[0], a0[1]};
                    pp2 = S2[1] * (f32x2_t){a0[2], a0[3]} + pp2; pp2 = S2[2] * (f32x2_t){a1[0], a1[1]} + pp2; pp2 = S2[3] * (f32x2_t){a1[2], a1[3]} + pp2;
                    const float sa = sum8(pp2.x + pp2.y);
                    const f32x2_t sa2 = {sa, sa}, v2 = {vi, vi};
                    S2[0] = S2[0] * (f32x2_t){w0[0], w0[1]} + sa2 * (f32x2_t){b0[0], b0[1]} + v2 * (f32x2_t){k0[0], k0[1]};
                    S2[1] = S2[1] * (f32x2_t){w0[2], w0[3]} + sa2 * (f32x2_t){b0[2], b0[3]} + v2 * (f32x2_t){k0[2], k0[3]};
                    S2[2] = S2[2] * (f32x2_t){w1[0], w1[1]} + sa2 * (f32x2_t){b1[0], b1[1]} + v2 * (f32x2_t){k1[0], k1[1]};
                    S2[3] = S2[3] * (f32x2_t){w1[2], w1[3]} + sa2 * (f32x2_t){b1[2], b1[3]} + v2 * (f32x2_t){k1[2], k1[3]};
                    f32x2_t y2 = S2[0] * (f32x2_t){r0[0], r0[1]};
                    y2 = S2[1] * (f32x2_t){r0[2], r0[3]} + y2; y2 = S2[2] * (f32x2_t){r1[0], r1[1]} + y2; y2 = S2[3] * (f32x2_t){r1[2], r1[3]} + y2;
                    const float yv = sum8(y2.x + y2.y);
                    if (cg == 0) bv[st * 64] = yv;
                    w0 = nw0; w1 = nw1; a0 = na0; a1 = na1; b0 = nb0; b1 = nb1; k0 = nk0; k1 = nk1; r0 = nr0; r1 = nr1; vi = nvi;
                }
            }
            __syncthreads();
            { u32x4 o; const LAS float* yr = sV + s * 64 + d0;
              o.x = pkbf(yr[0], yr[1]); o.y = pkbf(yr[2], yr[3]); o.z = pkbf(yr[4], yr[5]); o.w = pkbf(yr[6], yr[7]);
              *(u32x4*)(Yz + crow_ * 1024 + hh * 64 + d0) = o; }
            __syncthreads();
        }
#undef RW_ROWOF
    }
}
__device__ __forceinline__ void rwkv_out(const RwArgs& A, const float* ln_w, const float* ln_b, bf16_t* OG, int G, int bid) {
    const int tid_ = opaque_tid(); const int lane = tid_ & 63, wid = tid_ >> 6; const int c0 = lane * 16, head = lane >> 2;
    for (int row = bid * 8 + wid; row < TT; row += G * 8) {
        const bool lat = row < TL; const int L = lat ? 4096 : 256; const int n = lat ? (row & 4095) : ((row - TL) & 255); const bool hm = n > 0, hp = n < L - 1;
        float y[16], vv[16];
        { const u32x4 a0 = *(const u32x4*)(A.Y0 + (size_t)row * 1024 + c0), a1 = *(const u32x4*)(A.Y0 + (size_t)row * 1024 + c0 + 8);
          const u32x4 b0 = *(const u32x4*)(A.Y1 + (size_t)row * 1024 + c0), b1 = *(const u32x4*)(A.Y1 + (size_t)row * 1024 + c0 + 8);
#pragma unroll
          for (int i = 0; i < 4; ++i) { y[2 * i] = bflo(a0[i]) + bflo(b0[i]); y[2 * i + 1] = bfhi(a0[i]) + bfhi(b0[i]); y[8 + 2 * i] = bflo(a1[i]) + bflo(b1[i]); y[8 + 2 * i + 1] = bfhi(a1[i]) + bfhi(b1[i]); } }
        float s1 = 0.f;
#pragma unroll
        for (int i = 0; i < 16; ++i) s1 += y[i];
        s1 += __shfl_xor(s1, 1); s1 += __shfl_xor(s1, 2); const float mean = s1 * (1.f / 64.f);
        float s2 = 0.f;
#pragma unroll
        for (int i = 0; i < 16; ++i) { y[i] -= mean; s2 += y[i] * y[i]; }
        s2 += __shfl_xor(s2, 1); s2 += __shfl_xor(s2, 2); const float rstd = rsqrtf(s2 * (1.f / 64.f) + 64e-5f);
        sh8(A.P, (size_t)row, 2048 + c0, hm, hp, A.mu, vv); sh8(A.P, (size_t)row, 2048 + c0 + 8, hm, hp, A.mu, vv + 8);
        const float bz = 0.5f * (A.BZ[(size_t)row * 16 + head] + A.BZ[((size_t)TT + row) * 16 + head]);
        const u32x4 z0 = *(const u32x4*)(A.P + (size_t)row * RWN + 3328 + c0), z1 = *(const u32x4*)(A.P + (size_t)row * RWN + 3328 + c0 + 8);
        float ov[16];
#pragma unroll
        for (int i = 0; i < 16; ++i) { const unsigned zw = (i < 8) ? z0[(i >> 1) & 3] : z1[(i >> 1) & 3]; const float zz = (i & 1) ? bfhi(zw) : bflo(zw);
            ov[i] = (y[i] * rstd * ln_w[c0 + i] + ln_b[c0 + i] + bz * vv[i]) * silu_f(zz); }
        u32x4 o0, o1; o0.x = pkbf(ov[0], ov[1]); o0.y = pkbf(ov[2], ov[3]); o0.z = pkbf(ov[4], ov[5]); o0.w = pkbf(ov[6], ov[7]);
        o1.x = pkbf(ov[8], ov[9]); o1.y = pkbf(ov[10], ov[11]); o1.z = pkbf(ov[12], ov[13]); o1.w = pkbf(ov[14], ov[15]);
        *(u32x4*)(OG + (size_t)row * 1024 + c0) = o0; *(u32x4*)(OG + (size_t)row * 1024 + c0 + 8) = o1;
    }
}
#ifdef SKIP_GEMM
#define GEMM_PHASE(EPI, AP, BP, MM, NN, KK, EOBJ) do { (void)EOBJ; } while (0)
#else
#define GEMM_PHASE(EPI, AP, BP, MM, NN, KK, EOBJ) do { pg8::Gemm g_{(const bf16_t*)(AP), (const bf16_t*)(BP), (MM), (NN), (KK)}; pg8::StaticOrder S_; S_.init((MM), (NN), G, bid); \
    pg8::gemm_phase<EPI, pg8::StaticOrder, true, true>((PG8_LAS unsigned char*)lds, g_, S_, EOBJ); } while (0)
#endif
#ifdef SKIP_EpiAttnIn
#define GEMM_PHASE_EpiAttnIn(EPI, AP, BP, MM, NN, KK, EOBJ) do { (void)EOBJ; } while (0)
#else
#define GEMM_PHASE_EpiAttnIn GEMM_PHASE
#endif
#ifdef SKIP_EpiFnT
#define GEMM_PHASE_EpiFnT(EPI, AP, BP, MM, NN, KK, EOBJ) do { (void)EOBJ; } while (0)
#else
#define GEMM_PHASE_EpiFnT GEMM_PHASE
#endif
#ifdef SKIP_EpiPlain
#define GEMM_PHASE_EpiPlain(EPI, AP, BP, MM, NN, KK, EOBJ) do { (void)EOBJ; } while (0)
#else
#define GEMM_PHASE_EpiPlain GEMM_PHASE
#endif
#ifdef SKIP_EpiDft
#define GEMM_PHASE_EpiDft(EPI, AP, BP, MM, NN, KK, EOBJ) do { (void)EOBJ; } while (0)
#else
#define GEMM_PHASE_EpiDft GEMM_PHASE
#endif
#ifdef SKIP_EpiResid
#define GEMM_PHASE_EpiResid(EPI, AP, BP, MM, NN, KK, EOBJ) do { (void)EOBJ; } while (0)
#else
#define GEMM_PHASE_EpiResid GEMM_PHASE
#endif
#define XB_TMO      128
#define XB_XCNT(j)  (256  + 64 * (j))
#define XB_XSUB(j)  (1280 + 64 * (j))
#define XB_XGEN(j)  (2304 + 64 * (j))
#define XB_TOP      3328
#define XB_TOPGEN   3392
#define XCD_BAR_WORDS 3456
#define XB_SPIN_CAP (1u << 18)

__device__ __forceinline__ unsigned xb_ld(unsigned* p)              { return __hip_atomic_load(p, __ATOMIC_RELAXED, __HIP_MEMORY_SCOPE_AGENT); }
__device__ __forceinline__ unsigned xb_add(unsigned* p, unsigned v) { return __hip_atomic_fetch_add(p, v, __ATOMIC_RELAXED, __HIP_MEMORY_SCOPE_AGENT); }
__device__ __forceinline__ unsigned xb_xcc_id() { return (unsigned)__builtin_amdgcn_s_getreg((3 << 11) | 20) & 0xFu; }
#define XB_SPIN(cond, bar) do { unsigned _sp = 0; while (cond) { __builtin_amdgcn_s_sleep(1); \
    if ((++_sp & 255u) == 0u) { if (xb_ld(&(bar)[XB_TMO])) break; if (_sp > XB_SPIN_CAP) { atomicAdd(&(bar)[XB_TMO], 1u); break; } } } } while (0)

struct XcdBarrier {
    unsigned* bar; unsigned x;
    volatile LAS unsigned* st;
};

__device__ __forceinline__ XcdBarrier xcd_barrier_post(unsigned* bar, volatile LAS unsigned* st) {
    XcdBarrier b; b.bar = bar; b.x = xb_xcc_id(); b.st = st;
    if (threadIdx.x == 0) (void)xb_add(&bar[XB_XCNT(b.x)], 1u);
    return b;
}
__device__ __forceinline__ void xcd_barrier_complete(unsigned* bar, unsigned x, unsigned& nloc, unsigned& nx) {
    const unsigned G = gridDim.x * gridDim.y * gridDim.z;
    unsigned sum, cnt, mine, sp = 0u;
    for (;;) {
        sum = 0u; cnt = 0u; mine = 0u;
#pragma unroll
        for (unsigned j = 0; j < 16; ++j) { const unsigned c = xb_ld(&bar[XB_XCNT(j)]); sum += c; cnt += (c > 0u) ? 1u : 0u; mine = (j == x) ? c : mine; }
        if (sum == G) break;
        __builtin_amdgcn_s_sleep(1);
        if ((++sp & 255u) == 0u) { if (xb_ld(&bar[XB_TMO])) break; if (sp > XB_SPIN_CAP) { atomicAdd(&bar[XB_TMO], 1u); break; } }
    }
    nloc = mine > 0u ? mine : 1u; nx = cnt > 0u ? cnt : 1u;
}

__device__ __forceinline__ void xcd_barrier(const XcdBarrier& b) {
    asm volatile("s_waitcnt vmcnt(0)" ::: "memory");
    __syncthreads();
    if (threadIdx.x == 0) {
        unsigned* bar = b.bar;
        __builtin_amdgcn_s_waitcnt(0);
        unsigned nloc = b.st[0], nx = b.st[1];
        if (nloc == 0u) { xcd_barrier_complete(bar, b.x, nloc, nx); b.st[0] = nloc; b.st[1] = nx; }
        const unsigned old = xb_add(&bar[XB_XSUB(b.x)], 1u);
        const unsigned gen = old / nloc;
        if (old + 1u == (gen + 1u) * nloc) {
            __builtin_amdgcn_fence(__ATOMIC_RELEASE, "agent");
            asm volatile("s_waitcnt vmcnt(0)" ::: "memory");
            const unsigned og = xb_add(&bar[XB_TOP], 1u);
            const unsigned tg = og / nx;
            if (og + 1u == (tg + 1u) * nx) xb_add(&bar[XB_TOPGEN], 1u);
            else XB_SPIN(xb_ld(&bar[XB_TOPGEN]) == tg, bar);
            __builtin_amdgcn_fence(__ATOMIC_ACQUIRE, "agent");
            xb_add(&bar[XB_XGEN(b.x)], 1u);
            asm volatile("s_waitcnt vmcnt(0)" ::: "memory");
        } else {
            XB_SPIN(xb_ld(&bar[XB_XGEN(b.x)]) == gen, bar);
            __builtin_amdgcn_fence(__ATOMIC_ACQUIRE, "agent");
            asm volatile("s_waitcnt vmcnt(0)" ::: "memory");
        }
    }
    __syncthreads();
}

#define GRID_SYNC() xcd_barrier(xbar)
template <int layer> __device__ __forceinline__ void layer_body(const Params& p, LAS char* lds, const XcdBarrier& xbar, int G, int bid) {
    unsigned char* ws = p.ws;
    float* mod = (float*)(ws + WS_MOD);
    const float* ropeC = (const float*)(ws + WS_ROPE); const float* ropeS = ropeC + 1024;
    bf16_t* Hb = (bf16_t*)(ws + WS_HB);
    float* XC = (float*)(ws + WS_XC);
    const float* x_in = p.in[0]; const float* ctx_in = p.in[2];
        const float* xl = layer == 0 ? x_in : p.out; const float* xc = layer == 0 ? ctx_in : XC;
        const float* modl = mod + (size_t)layer * 9 * 3072;
        ph_phase(xl, xc, p.in[4] + layer * 1024, modl, Hb, G, bid);
        GRID_SYNC();
        const int Mout = (layer == 3) ? TL : TT;
        const bf16_t* Wout;
        if constexpr (layer == 0 || layer == 3) {
            const int j = layer == 0 ? 0 : 1;
            pg8::EpiAttnIn E{(bf16_t*)(ws + WS_Q), (bf16_t*)(ws + WS_K), (bf16_t*)(ws + WS_V), (bf16_t*)(ws + WS_Z), ropeC, ropeS};
            GEMM_PHASE_EpiAttnIn(pg8::EpiAttnIn, Hb, ws + WS_WDAIN + (size_t)j * 8 * MiB, TT, 4096, 1024, E);
#ifdef PROBE_GIN2
            GEMM_PHASE_EpiAttnIn(pg8::EpiAttnIn, Hb, ws + WS_WDAIN + (size_t)j * 8 * MiB, TT, 4096, 1024, E);
#endif
            GRID_SYNC();
            float lam;
            { const int lane = opaque_tid() & 63; const float* lq = p.in[9] + j * 128; const float* lk = p.in[10] + j * 128;
              const float s0 = wave_sum(lq[lane] * lk[lane]), s1 = wave_sum(lq[64 + lane] * lk[64 + lane]);
              const float li = 0.8f - 0.6f * expf(-0.3f * (float)layer); lam = expf(s0) - expf(s1) + li;
              att::Args A{(const bf16_t*)(ws + WS_Q), (const bf16_t*)(ws + WS_K), (const bf16_t*)(ws + WS_V), (const bf16_t*)(ws + WS_Z), Hb, p.in[11] + j * 128, lam, 1.f - li, layer == 3 ? 1024 : 1088};
#ifndef SKIP_ATT
              att::attn_phase(A, lds, G, bid);
#endif
#ifdef PROBE_ATT2
              att::attn_phase(A, lds, G, bid);
#endif
            }
            GRID_SYNC();
            Wout = (const bf16_t*)(ws + WS_WDAOUT + (size_t)j * 2 * MiB);
        } else if constexpr (layer == 1) {
            { pg8::EpiFnT E{(bf16_t*)(ws + WS_ATL), (bf16_t*)(ws + WS_ATC)};
              GEMM_PHASE_EpiFnT(pg8::EpiFnT, ws + WS_WFNT, Hb, 2048, TT, 1024, E); }
            { pg8::EpiPlain E{(bf16_t*)(ws + WS_ZB), 1024};
              GEMM_PHASE_EpiPlain(pg8::EpiPlain, Hb, ws + WS_WFNZ, TT, 1024, 1024, E); }
            GRID_SYNC();
            fnet_fold((const bf16_t*)(ws + WS_ATL), (bf16_t*)(ws + WS_FOLD), (bf16_t*)(ws + WS_FOLD + 32 * MiB), (float*)(ws + WS_BZ), (const bf16_t*)(ws + WS_ZB), Hb, G, bid);
            GRID_SYNC();
            { pg8::EpiPlain E{(bf16_t*)(ws + WS_ATL), 8192};
              GEMM_PHASE_EpiPlain(pg8::EpiPlain, ws + WS_DFTL, ws + WS_FOLD, 2048, 8192, 2048, E); }
            GRID_SYNC();
            { pg8::EpiDftSym E{(const bf16_t*)(ws + WS_ATL), (const float*)(ws + WS_BZ), (const bf16_t*)(ws + WS_ZB), Hb};
              GEMM_PHASE(pg8::EpiDftSym, ws + WS_DFTL + 8 * MiB, ws + WS_FOLD + 32 * MiB, 2048, 8192, 2048, E); }
            { pg8::EpiDft E{(const bf16_t*)(ws + WS_ZB), Hb, TL, 256};
              GEMM_PHASE_EpiDft(pg8::EpiDft, ws + WS_DFTC, ws + WS_ATC, 256, 8192, 512, E); }
            GRID_SYNC();
            Wout = (const bf16_t*)(ws + WS_WFNOUT);
        } else {
            { pg8::EpiPlain E{(bf16_t*)(ws + WS_P), RWN};
              GEMM_PHASE_EpiPlain(pg8::EpiPlain, Hb, ws + WS_WRWIN, TT, RWN, 1024, E); }
            GRID_SYNC();
            RwArgs A{(const bf16_t*)(ws + WS_P), Hb, (bf16_t*)(ws + WS_Y1), (float*)(ws + WS_BZ), p.in[17], p.in[18], p.in[19], p.in[20], p.in[21], p.in[22], p.in[23], p.in[24]};
#ifndef SKIP_SCAN
            rwkv_scan(A, lds, G, bid);
#endif
#ifdef PROBE_SCAN2
            rwkv_scan(A, lds, G, bid);
#endif
            GRID_SYNC();
#ifndef SKIP_RWOUT
            rwkv_out(A, p.in[25], p.in[26], Hb, G, bid);
#endif
            GRID_SYNC();
            Wout = (const bf16_t*)(ws + WS_WRWOUT);
        }
        { pg8::EpiResid E{xl, xc, p.out, XC, modl + 2048};
          GEMM_PHASE_EpiResid(pg8::EpiResid, Hb, Wout, Mout, 1024, 1024, E); }
        GRID_SYNC();
    }
__global__ void __launch_bounds__(512, 2) fwd_megakernel(Params p) {
    extern __shared__ __attribute__((aligned(16))) unsigned char lds_raw[];
    LAS char* lds = (LAS char*)lds_raw;
    cg::grid_group grid = cg::this_grid();
    const int G = gridDim.x, bid = blockIdx.x;
    volatile LAS unsigned* xst = (volatile LAS unsigned*)(lds + LDS_BYTES - 256);
    if (threadIdx.x < 2) xst[threadIdx.x] = 0u;
    __syncthreads();
    const XcdBarrier xbar = xcd_barrier_post((unsigned*)(p.ws + WS_CTL), xst);

#ifndef SKIP_PRO
    prologue(p, lds, G, bid);
#endif
#ifdef PROBE_PRO2
    __syncthreads(); prologue(p, lds, G, bid);
#endif
    grid.sync();
    layer_body<0>(p, lds, xbar, G, bid);
    layer_body<1>(p, lds, xbar, G, bid);
    layer_body<2>(p, lds, xbar, G, bid);
    layer_body<3>(p, lds, xbar, G, bid);
    final_phase(p.out, p.in[7], G, bid);
}

extern "C" void kernel_launch(void* const* d_in, const int* in_sizes, int n_in, void* d_out, int out_size, void* d_ws, size_t ws_size, hipStream_t stream) {
    static int grid = 0;
    if (grid == 0) {
        if (n_in != 28 || out_size != TL * 1024 || ws_size < WS_END) { fprintf(stderr, "kernel_launch: unexpected shapes: n_in %d out %d ws %zu\n", n_in, out_size, ws_size); grid = -1; return; }
        int dev = 0, cus = 0, per_cu = 0;
        hipGetDevice(&dev); hipDeviceGetAttribute(&cus, hipDeviceAttributeMultiprocessorCount, dev);
        if (hipFuncSetAttribute((const void*)fwd_megakernel, hipFuncAttributeMaxDynamicSharedMemorySize, LDS_BYTES) != hipSuccess) { fprintf(stderr, "kernel_launch: hipFuncSetAttribute failed\n"); grid = -1; return; }
        if (hipOccupancyMaxActiveBlocksPerMultiprocessor(&per_cu, (const void*)fwd_megakernel, 512, LDS_BYTES) != hipSuccess || per_cu < 1) { fprintf(stderr, "kernel_launch: occupancy query failed (%d)\n", per_cu); per_cu = 1; }
        (void)hipGetLastError();
        grid = cus * per_cu;
    }
    if (grid < 0) return;
    if (hipMemsetAsync((char*)d_ws + WS_CTL, 0, 65536, stream) != hipSuccess) { fprintf(stderr, "kernel_launch: hipMemsetAsync failed\n"); return; }
    Params p{};
    for (int i = 0; i < 28; ++i) p.in[i] = (const float*)d_in[i];
    p.out = (float*)d_out; p.ws = (unsigned char*)d_ws;
    void* args[] = {&p};
    hipError_t e = hipLaunchCooperativeKernel((const void*)fwd_megakernel, dim3(grid), dim3(512), args, LDS_BYTES, stream);
    if (e != hipSuccess) fprintf(stderr, "cooperative launch failed: %s (grid %d)\n", hipGetErrorString(e), grid);
}
```

```cpp
#include <hip/hip_runtime.h>
#include <hip/hip_cooperative_groups.h>
#include <cstdio>
#include <cstdint>
#include <cmath>
namespace cg = cooperative_groups;

constexpr int TL = 32768, TCX = 2048, TT = TL + TCX, DM = 1024;
constexpr float QK_C2 = 0.125f * 1.4426950408889634f;
typedef float f32x2_t __attribute__((ext_vector_type(2)));
typedef __bf16 bf16x2_t __attribute__((ext_vector_type(2)));
__device__ __forceinline__ unsigned pkbf(float lo, float hi) { f32x2_t v = {lo, hi}; bf16x2_t b = __builtin_convertvector(v, bf16x2_t); return __builtin_bit_cast(unsigned, b); }
__device__ __forceinline__ float bflo(unsigned u) { return __uint_as_float(u << 16); }
__device__ __forceinline__ float bfhi(unsigned u) { return __uint_as_float(u & 0xffff0000u); }
__device__ __forceinline__ float bf1(unsigned short u) { return __uint_as_float(((unsigned)u) << 16); }
__device__ __forceinline__ float silu_f(float z) { return z * __builtin_amdgcn_rcpf(1.f + __expf(-z)); }
__device__ __forceinline__ int opaque_tid() { int t = threadIdx.x; asm volatile("" : "+v"(t)); return t; }
namespace pg8 {
#define PG8_LAS __attribute__((address_space(3)))
typedef unsigned short bf16_t;
typedef short bf16x8 __attribute__((ext_vector_type(8)));
typedef float f32x4 __attribute__((ext_vector_type(4)));
typedef unsigned u32x4 __attribute__((ext_vector_type(4)));
constexpr int BM = 256, BK = 64, HALF = 128, HTB = HALF * BK * 2  , STAGE_BYTES = 8 * HTB, NXCD = 8, WGM = 8;

__host__ __device__ __forceinline__ int lds_byte(int r, int c) { const int st = (r >> 4) * 2 + (c >> 5), rr = r & 15, cc = c & 31, ob = rr * 64 + cc * 2; return st * 1024 + (ob ^ (((ob >> 9) & 1) << 5)); }
__host__ __device__ __forceinline__ void stage_rc(int b, int& R, int& C) { const int st = b / 1024, sb = b % 1024, swz = sb ^ (((sb >> 9) & 1) << 5); R = (st >> 1) * 16 + swz / 64; C = (st & 1) * 32 + (swz % 64) / 2; }
__host__ __device__ __forceinline__ int perm32(int rho) { const int n = rho >> 4, i = rho & 15; return 8 * (i >> 2) + 4 * n + (i & 3); }

struct Unit { int pm, pn; };
struct Gemm { const bf16_t* A; const bf16_t* Bt; int M, N, K; };

struct StaticOrder {
    int nM, nN, nwg, G, c;
    __host__ __device__ void init(int M, int N, int G_, int c_) { nM = M / BM; nN = N / BM; nwg = nM * nN; G = G_; c = c_; }
    __host__ __device__ bool next(int i, Unit& u) const {
        const long L = (long)i * G + c; if (L >= nwg) return false;
        int wgid = (int)L; { const int q = nwg / NXCD, r = nwg % NXCD, xcd = wgid % NXCD, off = wgid / NXCD; wgid = (xcd < r ? xcd * (q + 1) : r * (q + 1) + (xcd - r) * q) + off; }
        const int nig = WGM * nN, gid = wgid / nig, fm = gid * WGM, gsz = (nM - fm) < WGM ? (nM - fm) : WGM;
        u.pm = fm + ((wgid % nig) % gsz); u.pn = (wgid % nig) / gsz; return true;
    }
    __device__ __forceinline__ void a_ready(const Unit&) const {}
    __device__ __forceinline__ void done(const Unit&) const {}
};

struct EpiAttnIn {
    static constexpr bool PERM = true, AFTER_DRAIN = false;
    bf16_t* Q; bf16_t* Kb; bf16_t* V; bf16_t* Z; const float* ropeC; const float* ropeS;
    __device__ __forceinline__ void operator()(const f32x4 (&acc)[2][2][4][2], const Unit& u, int wr, int wc, int fr, int fq) const {
        const int sect = u.pn >> 2;
        bf16_t* base = sect == 0 ? Q : sect == 1 ? Kb : sect == 2 ? V : Z;
        const int colt = (u.pn & 3) * 256 + wc * 32 + 8 * fq;
        const int row0 = u.pm * BM + wr * 64 + fr;
        const bool rope = (u.pm < 128) && (sect < 2);
        const float sc = (sect == 0) ? QK_C2 : 1.f;
        const int axis = wc & 1;
#pragma unroll
        for (int ai = 0; ai < 2; ++ai)
#pragma unroll
            for (int m = 0; m < 4; ++m) {
                const int row = row0 + ai * HALF + m * 16;
                const int ntok = row & 4095;
                const int pos = axis ? (ntok & 63) : (ntok >> 6);
                bf16_t* rowp;
                if (sect == 1) rowp = base + (size_t)(row >> 6) * 65536 + (size_t)(colt >> 3) * 512 + (row & 63) * 8;
                else if (sect == 2) rowp = base + (size_t)(row >> 6) * 65536 + (size_t)(colt >> 7) * 8192 + (((colt & 127) >> 5) * 4 + ((row & 63) >> 4)) * 512 + (row & 15) * 32 + (colt & 31);
                else rowp = base + (size_t)row * 1024 + colt;
#pragma unroll
                for (int bj = 0; bj < 2; ++bj) {
                    f32x4 v0 = acc[ai][bj][m][0], v1 = acc[ai][bj][m][1];
                    if (rope) {
                        const f32x4 c0 = *(const f32x4*)(ropeC + pos * 16 + 8 * (fq & 1)), c1 = *(const f32x4*)(ropeC + pos * 16 + 8 * (fq & 1) + 4);
                        const f32x4 s0 = *(const f32x4*)(ropeS + pos * 16 + 8 * (fq & 1)), s1 = *(const f32x4*)(ropeS + pos * 16 + 8 * (fq & 1) + 4);
                        f32x4 p0, p1;
#pragma unroll
                        for (int i = 0; i < 4; ++i) { p0[i] = __shfl_xor(v0[i], 32); p1[i] = __shfl_xor(v1[i], 32); }
                        if (fq < 2) { v0 = v0 * c0 - p0 * s0; v1 = v1 * c1 - p1 * s1; }
                        else        { v0 = v0 * c0 + p0 * s0; v1 = v1 * c1 + p1 * s1; }
                    }
                    v0 = v0 * sc; v1 = v1 * sc;
                    u32x4 w; w.x = pkbf(v0[0], v0[1]); w.y = pkbf(v0[2], v0[3]); w.z = pkbf(v1[0], v1[1]); w.w = pkbf(v1[2], v1[3]);
                    *(u32x4*)(rowp + (sect == 1 || sect == 2 ? bj * 8192 : bj * HALF)) = w;
                }
            }
    }
};
struct EpiPlain {
    static constexpr bool PERM = true, AFTER_DRAIN = false;
    bf16_t* O; int ldc;
    __device__ __forceinline__ void operator()(const f32x4 (&acc)[2][2][4][2], const Unit& u, int wr, int wc, int fr, int fq) const {
        const int row0 = u.pm * BM + wr * 64 + fr, col0 = u.pn * BM + wc * 32 + 8 * fq;
#pragma unroll
        for (int ai = 0; ai < 2; ++ai)
#pragma unroll
            for (int m = 0; m < 4; ++m) { bf16_t* rowp = O + (size_t)(row0 + ai * HALF + m * 16) * ldc + col0;
#pragma unroll
                for (int bj = 0; bj < 2; ++bj) { const f32x4 v0 = acc[ai][bj][m][0], v1 = acc[ai][bj][m][1];
                    u32x4 w; w.x = pkbf(v0[0], v0[1]); w.y = pkbf(v0[2], v0[3]); w.z = pkbf(v1[0], v1[1]); w.w = pkbf(v1[2], v1[3]);
                    *(u32x4*)(rowp + bj * HALF) = w; } }
    }
};
struct EpiResid {
    static constexpr bool PERM = false, AFTER_DRAIN = false;
    const float* xin_lat; const float* xin_ctx; float* xout_lat; float* xout_ctx; const float* gate;
    __device__ __forceinline__ void operator()(const f32x4 (&acc)[2][2][4][2], const Unit& u, int wr, int wc, int fr, int fq) const {
        const int row0 = u.pm * BM + wr * 64 + fr, col0 = u.pn * BM + wc * 32 + 4 * fq;
#pragma unroll
        for (int ai = 0; ai < 2; ++ai)
#pragma unroll
            for (int m = 0; m < 4; ++m) {
                const int row = row0 + ai * HALF + m * 16; const bool lat = row < TL; const int r = lat ? (row >> 12) : 8;
                const float* xi = lat ? xin_lat + (size_t)row * 1024 : xin_ctx + (size_t)(row - TL) * 1024;
                float* xo = lat ? xout_lat + (size_t)row * 1024 : xout_ctx + (size_t)(row - TL) * 1024;
                const float* g = gate + r * 3072;
#pragma unroll
                for (int bj = 0; bj < 2; ++bj)
#pragma unroll
                    for (int n = 0; n < 2; ++n) { const int col = col0 + bj * HALF + n * 16;
                        const f32x4 g4 = *(const f32x4*)(g + col), x4 = *(const f32x4*)(xi + col);
                        *(f32x4*)(xo + col) = x4 + g4 * acc[ai][bj][m][n]; }
            }
    }
};
struct EpiFnT {
    static constexpr bool PERM = true, AFTER_DRAIN = false;
    bf16_t* ATL; bf16_t* ATC;
    __device__ __forceinline__ void operator()(const f32x4 (&acc)[2][2][4][2], const Unit& u, int wr, int wc, int fr, int fq) const {
        const int row0 = u.pm * BM + wr * 64 + fr, col0 = u.pn * BM + wc * 32 + 8 * fq;
#pragma unroll
        for (int ai = 0; ai < 2; ++ai)
#pragma unroll
            for (int m = 0; m < 4; ++m) { const int mp = row0 + ai * HALF + m * 16, cs = mp >> 10, n = mp & 1023;
#pragma unroll
                for (int bj = 0; bj < 2; ++bj) { const int t0 = col0 + bj * HALF; bf16_t* dst;
                    if (t0 < TL) { const int b = t0 >> 12, l = t0 & 4095; dst = ATL + ((size_t)((b * 1024 + n) * 2 + cs)) * 4096 + l; }
                    else { const int tc = t0 - TL, b = tc >> 8, l = tc & 255; dst = ATC + ((size_t)((b * 1024 + n) * 2 + cs)) * 256 + l; }
                    const f32x4 v0 = acc[ai][bj][m][0], v1 = acc[ai][bj][m][1];
                    u32x4 w; w.x = pkbf(v0[0], v0[1]); w.y = pkbf(v0[2], v0[3]); w.z = pkbf(v1[0], v1[1]); w.w = pkbf(v1[2], v1[3]);
                    *(u32x4*)dst = w; } }
    }
};
struct EpiDft {
    static constexpr bool PERM = true, AFTER_DRAIN = false;
    const bf16_t* Z; bf16_t* OG; int rowbase; int L;
    __device__ __forceinline__ void operator()(const f32x4 (&acc)[2][2][4][2], const Unit& u, int wr, int wc, int fr, int fq) const {
        const int k0 = u.pm * BM + wr * 64 + fr; const int b = u.pn >> 2; const int n0 = (u.pn & 3) * 256 + wc * 32 + 8 * fq;
#pragma unroll
        for (int ai = 0; ai < 2; ++ai)
#pragma unroll
            for (int m = 0; m < 4; ++m) { const size_t R = (size_t)(rowbase + b * L + k0 + ai * HALF + m * 16);
#pragma unroll
                for (int bj = 0; bj < 2; ++bj) { const size_t off = R * 1024 + n0 + bj * HALF;
                    const u32x4 zz = *(const u32x4*)(Z + off);
                    const f32x4 v0 = acc[ai][bj][m][0], v1 = acc[ai][bj][m][1];
                    u32x4 w;
                    w.x = pkbf(v0[0] * silu_f(bflo(zz.x)), v0[1] * silu_f(bfhi(zz.x))); w.y = pkbf(v0[2] * silu_f(bflo(zz.y)), v0[3] * silu_f(bfhi(zz.y)));
                    w.z = pkbf(v1[0] * silu_f(bflo(zz.z)), v1[1] * silu_f(bfhi(zz.z))); w.w = pkbf(v1[2] * silu_f(bflo(zz.w)), v1[3] * silu_f(bfhi(zz.w)));
                    *(u32x4*)(OG + off) = w; } }
    }
};
struct EpiDftSym {
    static constexpr bool PERM = true, AFTER_DRAIN = false;
    const bf16_t* Pb; const float* TA; const bf16_t* Z; bf16_t* OG;
    __device__ __forceinline__ void operator()(const f32x4 (&acc)[2][2][4][2], const Unit& u, int wr, int wc, int fr, int fq) const {
        const int k0 = u.pm * BM + wr * 64 + fr; const int b = u.pn >> 2; const int c0 = u.pn * BM + wc * 32 + 8 * fq; const int n0 = c0 & 1023;
#pragma unroll
        for (int bj = 0; bj < 2; ++bj) {
            const f32x4 t0 = *(const f32x4*)(TA + c0 + bj * HALF), t1 = *(const f32x4*)(TA + c0 + bj * HALF + 4);
#pragma unroll
            for (int ai = 0; ai < 2; ++ai)
#pragma unroll
                for (int m = 0; m < 4; ++m) { const int k = k0 + ai * HALF + m * 16; const float sg = (k & 1) ? -1.f : 1.f;
                    const u32x4 pp = *(const u32x4*)(Pb + (size_t)k * 8192 + c0 + bj * HALF);
                    const f32x4 q0 = acc[ai][bj][m][0], q1 = acc[ai][bj][m][1];
                    float pt[8];
                    pt[0] = bflo(pp.x) + sg * t0[0]; pt[1] = bfhi(pp.x) + sg * t0[1]; pt[2] = bflo(pp.y) + sg * t0[2]; pt[3] = bfhi(pp.y) + sg * t0[3];
                    pt[4] = bflo(pp.z) + sg * t1[0]; pt[5] = bfhi(pp.z) + sg * t1[1]; pt[6] = bflo(pp.w) + sg * t1[2]; pt[7] = bfhi(pp.w) + sg * t1[3];
                    { const size_t off = (size_t)(b * 4096 + k) * 1024 + n0 + bj * HALF; const u32x4 zz = *(const u32x4*)(Z + off); u32x4 w;
                      w.x = pkbf((pt[0] - q0[0]) * silu_f(bflo(zz.x)), (pt[1] - q0[1]) * silu_f(bfhi(zz.x))); w.y = pkbf((pt[2] - q0[2]) * silu_f(bflo(zz.y)), (pt[3] - q0[3]) * silu_f(bfhi(zz.y)));
                      w.z = pkbf((pt[4] - q1[0]) * silu_f(bflo(zz.z)), (pt[5] - q1[1]) * silu_f(bfhi(zz.z))); w.w = pkbf((pt[6] - q1[2]) * silu_f(bflo(zz.w)), (pt[7] - q1[3]) * silu_f(bfhi(zz.w)));
                      *(u32x4*)(OG + off) = w; }
                    if (k >= 1) { const size_t off = (size_t)(b * 4096 + 4096 - k) * 1024 + n0 + bj * HALF; const u32x4 zz = *(const u32x4*)(Z + off); u32x4 w;
                      w.x = pkbf((pt[0] + q0[0]) * silu_f(bflo(zz.x)), (pt[1] + q0[1]) * silu_f(bfhi(zz.x))); w.y = pkbf((pt[2] + q0[2]) * silu_f(bflo(zz.y)), (pt[3] + q0[3]) * silu_f(bfhi(zz.y)));
                      w.z = pkbf((pt[4] + q1[0]) * silu_f(bflo(zz.z)), (pt[5] + q1[1]) * silu_f(bfhi(zz.z))); w.w = pkbf((pt[6] + q1[2]) * silu_f(bflo(zz.w)), (pt[7] + q1[3]) * silu_f(bfhi(zz.w)));
                      *(u32x4*)(OG + off) = w; }
                    asm volatile("" ::: "memory");
                }
        }
    }
};
template <class Epi, class Sched, bool ALIGN_EPI = false, bool SP2 = false>
__device__ __forceinline__ void gemm_phase(PG8_LAS unsigned char* lds, const Gemm g, const Sched& S, const Epi& E) {
    const int tid = opaque_tid(), wid = __builtin_amdgcn_readfirstlane(tid >> 6), lane = tid & 63, wr = wid >> 2, wc = wid & 3, fr = lane & 15, fq = lane >> 4;
    const int K = g.K, nt = K / BK;
    unsigned voffA[2], voffB[2];
#pragma unroll
    for (int i = 0; i < 2; ++i) { int R, C; stage_rc(tid * 16 + i * 8192, R, C); const int Rb = Epi::PERM ? ((R & ~31) + perm32(R & 31)) : R;
        voffA[i] = (unsigned)(R * K + C) * 2u; voffB[i] = (unsigned)(Rb * K + C) * 2u; }
    const size_t kstep = (size_t)(BK * 2);
    const size_t hstep = (size_t)HALF * K * 2;
    const size_t tstep = 2 * hstep;
    const unsigned ldsw = (unsigned)wid * 1024u;
    const int aoff = lds_byte(wr * 64 + fr, fq * 8), boff = lds_byte(wc * 32 + fr, fq * 8);
#define PG8_SA(b, h) (((b) * 2 + (h)) * HTB)
#define PG8_SB(b, h) ((4 + (b) * 2 + (h)) * HTB)
#define PG8_STAGE(bufoff, gbase, voff) do { _Pragma("unroll") for (int _i = 0; _i < 2; ++_i) \
        __builtin_amdgcn_global_load_lds((const unsigned*)((const char*)(gbase) + (voff)[_i]), (PG8_LAS unsigned*)(lds + (bufoff) + ldsw + _i * 8192), 16, 0, 0); } while (0)
#define PG8_LDA(dst, b, h) do { _Pragma("unroll") for (int m = 0; m < 4; ++m) _Pragma("unroll") for (int k = 0; k < 2; ++k) dst[m][k] = *(const PG8_LAS bf16x8*)(lds + PG8_SA(b, h) + aoff + m * 2048 + k * 1024); } while (0)
#define PG8_LDB(dst, b, h) do { _Pragma("unroll") for (int n = 0; n < 2; ++n) _Pragma("unroll") for (int k = 0; k < 2; ++k) dst[n][k] = *(const PG8_LAS bf16x8*)(lds + PG8_SB(b, h) + boff + n * 2048 + k * 1024); } while (0)
#define PG8_MMA(ai, bj, At, Bt) do { __builtin_amdgcn_s_setprio(1); _Pragma("unroll") for (int m = 0; m < 4; ++m) _Pragma("unroll") for (int n = 0; n < 2; ++n) _Pragma("unroll") for (int k = 0; k < 2; ++k) \
        acc[ai][bj][m][n] = __builtin_amdgcn_mfma_f32_16x16x32_bf16(Bt[n][k], At[m][k], acc[ai][bj][m][n], 0, 0, 0); __builtin_amdgcn_s_setprio(0); } while (0)
#define PG8_WAIT_V(n) asm volatile("s_waitcnt vmcnt(" #n ")" ::: "memory")
#define PG8_WAIT_L(n) asm volatile("s_waitcnt lgkmcnt(" #n ")" ::: "memory")
#define PG8_BAR __builtin_amdgcn_s_barrier()
#define PG8_SCHED __builtin_amdgcn_sched_barrier(0)
    Unit cur, nxt; int ui = 0;
    if (!S.next(0, cur)) return;
    f32x4 acc[2][2][4][2];
#pragma unroll
    for (int a = 0; a < 2; ++a)
#pragma unroll
        for (int b = 0; b < 2; ++b)
#pragma unroll
            for (int m = 0; m < 4; ++m)
#pragma unroll
                for (int n = 0; n < 2; ++n) acc[a][b][m][n] = (f32x4){0.f, 0.f, 0.f, 0.f};
    bf16x8 At[4][2], B0[2][2], B1[2][2];
    const char* cA = (const char*)g.A + (size_t)cur.pm * tstep; const char* cB = (const char*)g.Bt + (size_t)cur.pn * tstep;
    S.a_ready(cur);
    if constexpr (SP2) {
        PG8_STAGE(PG8_SB(0, 0), cB, voffB); PG8_STAGE(PG8_SB(0, 1), cB + hstep, voffB); PG8_STAGE(PG8_SA(0, 0), cA, voffA); PG8_STAGE(PG8_SA(0, 1), cA + hstep, voffA);
        if (wr == 1) PG8_BAR;
        PG8_WAIT_V(2); PG8_BAR;
        PG8_STAGE(PG8_SB(1, 0), cB + kstep, voffB); PG8_STAGE(PG8_SA(1, 0), cA + kstep, voffA); PG8_STAGE(PG8_SB(1, 1), cB + hstep + kstep, voffB);
        PG8_WAIT_V(6); PG8_BAR;
    } else {
        PG8_STAGE(PG8_SB(0, 0), cB, voffB); PG8_STAGE(PG8_SA(0, 0), cA, voffA); PG8_STAGE(PG8_SB(0, 1), cB + hstep, voffB); PG8_STAGE(PG8_SA(0, 1), cA + hstep, voffA);
        if (wr == 1) PG8_BAR;
        PG8_WAIT_V(4); PG8_BAR;
        PG8_STAGE(PG8_SB(1, 0), cB + kstep, voffB); PG8_STAGE(PG8_SA(1, 0), cA + kstep, voffA); PG8_STAGE(PG8_SB(1, 1), cB + hstep + kstep, voffB);
        PG8_WAIT_V(6); PG8_BAR;
    }
    for (;;) {
        const bool has_next = S.next(ui + 1, nxt);
        const char* nA = has_next ? (const char*)g.A + (size_t)nxt.pm * tstep : cA; const char* nB = has_next ? (const char*)g.Bt + (size_t)nxt.pn * tstep : cB;
        for (int t = 0; t < nt; t += 2) {
            const bool last = (t == nt - 2);
            const char* a1 = cA + (size_t)(t + 1) * kstep;
            const char* a2 = last ? nA : cA + (size_t)(t + 2) * kstep; const char* b2 = last ? nB : cB + (size_t)(t + 2) * kstep;
            const char* a3 = a2 + kstep; const char* b3 = b2 + kstep;
            if (last && has_next) S.a_ready(nxt);
            if constexpr (SP2) {
            PG8_LDB(B0, 0, 0); PG8_LDB(B1, 0, 1); PG8_SCHED; PG8_LDA(At, 0, 0); PG8_STAGE(PG8_SA(1, 1), a1 + hstep, voffA);
            PG8_WAIT_V(8); PG8_WAIT_L(0); PG8_BAR; PG8_MMA(0, 0, At, B0); PG8_MMA(0, 1, At, B1); PG8_BAR; PG8_SCHED;
            PG8_LDA(At, 0, 1); PG8_STAGE(PG8_SB(0, 0), b2, voffB); PG8_STAGE(PG8_SB(0, 1), b2 + hstep, voffB); PG8_STAGE(PG8_SA(0, 0), a2, voffA);
            PG8_WAIT_V(8); PG8_WAIT_L(0); PG8_BAR; PG8_MMA(1, 0, At, B0); PG8_MMA(1, 1, At, B1); PG8_BAR; PG8_SCHED;
            PG8_LDB(B0, 1, 0); PG8_LDB(B1, 1, 1); PG8_SCHED; PG8_LDA(At, 1, 0); PG8_STAGE(PG8_SA(0, 1), a2 + hstep, voffA);
            PG8_WAIT_V(8); PG8_WAIT_L(0); PG8_BAR; PG8_MMA(0, 0, At, B0); PG8_MMA(0, 1, At, B1); PG8_BAR; PG8_SCHED;
            PG8_LDA(At, 1, 1); PG8_STAGE(PG8_SB(1, 0), b3, voffB); PG8_STAGE(PG8_SB(1, 1), b3 + hstep, voffB); PG8_STAGE(PG8_SA(1, 0), a3, voffA);
            PG8_WAIT_V(8); PG8_WAIT_L(0); PG8_BAR; PG8_MMA(1, 0, At, B0); PG8_MMA(1, 1, At, B1); PG8_BAR; PG8_SCHED;
            } else {
            PG8_LDB(B0, 0, 0); PG8_SCHED; PG8_LDA(At, 0, 0); PG8_STAGE(PG8_SA(1, 1), a1 + hstep, voffA);
            PG8_WAIT_L(8); PG8_BAR; PG8_WAIT_L(0); PG8_MMA(0, 0, At, B0); PG8_BAR; PG8_SCHED;
            PG8_LDB(B1, 0, 1); PG8_STAGE(PG8_SB(0, 0), b2, voffB);
            PG8_BAR; PG8_WAIT_L(0); PG8_MMA(0, 1, At, B1); PG8_BAR;
            PG8_LDA(At, 0, 1); PG8_STAGE(PG8_SA(0, 0), a2, voffA);
            PG8_BAR; PG8_WAIT_L(0); PG8_MMA(1, 0, At, B0); PG8_BAR; PG8_SCHED;
            PG8_STAGE(PG8_SB(0, 1), b2 + hstep, voffB);
            PG8_WAIT_V(6); PG8_BAR; PG8_MMA(1, 1, At, B1); PG8_BAR;
            PG8_LDB(B0, 1, 0); PG8_SCHED; PG8_LDA(At, 1, 0); PG8_STAGE(PG8_SA(0, 1), a2 + hstep, voffA);
            PG8_WAIT_L(8); PG8_BAR; PG8_WAIT_L(0); PG8_MMA(0, 0, At, B0); PG8_BAR; PG8_SCHED;
            PG8_LDB(B1, 1, 1); PG8_STAGE(PG8_SB(1, 0), b3, voffB);
            PG8_BAR; PG8_WAIT_L(0); PG8_MMA(0, 1, At, B1); PG8_BAR;
            PG8_LDA(At, 1, 1); PG8_STAGE(PG8_SA(1, 0), a3, voffA);
            PG8_BAR; PG8_WAIT_L(0); PG8_MMA(1, 0, At, B0); PG8_BAR; PG8_SCHED;
            PG8_STAGE(PG8_SB(1, 1), b3 + hstep, voffB);
            PG8_WAIT_V(6); PG8_BAR; PG8_MMA(1, 1, At, B1); PG8_BAR;
            }
        }
        if constexpr (ALIGN_EPI) { if (wr == 0) PG8_BAR; }
        if constexpr (!Epi::AFTER_DRAIN) { E(acc, cur, wr, wc, fr, fq); S.done(cur); }
        if (!has_next) break;
#pragma unroll
        for (int a = 0; a < 2; ++a)
#pragma unroll
            for (int b = 0; b < 2; ++b)
#pragma unroll
                for (int m = 0; m < 4; ++m)
#pragma unroll
                    for (int n = 0; n < 2; ++n) acc[a][b][m][n] = (f32x4){0.f, 0.f, 0.f, 0.f};
        cur = nxt; cA = nA; cB = nB; ++ui;
        if constexpr (ALIGN_EPI) { if (wr == 1) PG8_BAR; }
    }
    PG8_WAIT_V(0);
    if constexpr (!ALIGN_EPI) { if (wr == 0) PG8_BAR; }
    PG8_BAR;
    if constexpr (Epi::AFTER_DRAIN) { E.fused(acc, cur, wr, wc, fr, fq, lds, wid, lane); S.done(cur); }
#undef PG8_SA
#undef PG8_SB
#undef PG8_STAGE
#undef PG8_LDA
#undef PG8_LDB
#undef PG8_MMA
#undef PG8_WAIT_V
#undef PG8_WAIT_L
#undef PG8_BAR
#undef PG8_SCHED
}
}
#define LAS __attribute__((address_space(3)))
namespace att {
using bf16x8 = __attribute__((ext_vector_type(8))) short;
using s16x4 = __attribute__((ext_vector_type(4))) short;
using f32x16 = __attribute__((ext_vector_type(16))) float;
using u32x4 = __attribute__((ext_vector_type(4))) unsigned;
typedef unsigned short bf16_t;
__device__ __forceinline__ int crow(int r, int hi) { return (r & 3) + 8 * (r >> 2) + 4 * hi; }
constexpr int KSLOT = 8192, VSLOT = 16384, LDS_K = 0, LDS_V = 3 * KSLOT, LDS_WS = LDS_V + 4 * VSLOT, LDS_CNT = LDS_WS + 2048;
struct Args { const bf16_t* Q; const bf16_t* K; const bf16_t* V; const bf16_t* Z; bf16_t* O; const float* gain; float lam; float oml; int n_units; unsigned* o1g; };

__device__ __forceinline__ void qkt(f32x16& p0, f32x16& p1, const LAS char* Kslot, const bf16x8* qr, const f32x16& negm, int r32, int hi) {
    const LAS char* kb = Kslot + hi * 1024 + r32 * 16;
    bf16x8 kf[8];
#pragma unroll
    for (int d0 = 0; d0 < 4; ++d0) { kf[2 * d0] = *(const LAS bf16x8*)(kb + d0 * 2048); kf[2 * d0 + 1] = *(const LAS bf16x8*)(kb + d0 * 2048 + 512); }
    asm volatile("s_waitcnt lgkmcnt(0)" ::: "memory"); __builtin_amdgcn_sched_barrier(0);
    p0 = __builtin_amdgcn_mfma_f32_32x32x16_bf16(kf[0], qr[0], negm, 0, 0, 0); p1 = __builtin_amdgcn_mfma_f32_32x32x16_bf16(kf[1], qr[0], negm, 0, 0, 0);
#pragma unroll
    for (int d0 = 1; d0 < 4; ++d0) { p0 = __builtin_amdgcn_mfma_f32_32x32x16_bf16(kf[2 * d0], qr[d0], p0, 0, 0, 0); p1 = __builtin_amdgcn_mfma_f32_32x32x16_bf16(kf[2 * d0 + 1], qr[d0], p1, 0, 0, 0); }
}
__device__ __forceinline__ void kload(bf16x8* kf, const LAS char* Kslot, int r32, int hi) {
    const LAS char* kb = Kslot + hi * 1024 + r32 * 16;
#pragma unroll
    for (int d0 = 0; d0 < 4; ++d0) { kf[2 * d0] = *(const LAS bf16x8*)(kb + d0 * 2048); kf[2 * d0 + 1] = *(const LAS bf16x8*)(kb + d0 * 2048 + 512); }
}
__device__ __forceinline__ void qk_mm(f32x16& p0, f32x16& p1, const bf16x8* kf, const bf16x8* qr, const f32x16& z) {
    p0 = __builtin_amdgcn_mfma_f32_32x32x16_bf16(kf[0], qr[0], z, 0, 0, 0); p1 = __builtin_amdgcn_mfma_f32_32x32x16_bf16(kf[1], qr[0], z, 0, 0, 0);
#pragma unroll
    for (int d0 = 1; d0 < 4; ++d0) { p0 = __builtin_amdgcn_mfma_f32_32x32x16_bf16(kf[2 * d0], qr[d0], p0, 0, 0, 0); p1 = __builtin_amdgcn_mfma_f32_32x32x16_bf16(kf[2 * d0 + 1], qr[d0], p1, 0, 0, 0); }
}
__device__ __forceinline__ float max3a(float a, float b, float c) { float r; asm("v_max3_f32 %0, %1, %2, %3" : "=v"(r) : "v"(a), "v"(b), "v"(c)); return r; }
__device__ __forceinline__ float rowmax(const f32x16& p0, const f32x16& p1) {
    float a = max3a(p0[0], p0[1], p0[2]), b = max3a(p1[0], p1[1], p1[2]);
#pragma unroll
    for (int r = 3; r < 15; r += 2) { a = max3a(a, p0[r], p0[r + 1]); b = max3a(b, p1[r], p1[r + 1]); }
    a = max3a(a, p0[15], p1[15]);
    float m; asm("v_max_f32 %0, %1, %2" : "=v"(m) : "v"(a), "v"(b));
    asm volatile("s_nop 1" ::: "memory");
    auto rr = __builtin_amdgcn_permlane32_swap(__float_as_uint(m), __float_as_uint(m), false, false);
    float o; asm("v_max_f32 %0, %1, %2" : "=v"(o) : "v"(__uint_as_float(rr[0])), "v"(__uint_as_float(rr[1])));
    return o;
}
#define ATT_VRD(buf, d0) do { _Pragma("unroll") for (int ks = 0; ks < 4; ++ks) { \
        asm volatile("ds_read_b64_tr_b16 %0,%1 offset:%c2" : "=&v"(lo[buf][ks]) : "v"(vb), "i"((d0) * 4096 + ks * 1024) : "memory"); \
        asm volatile("ds_read_b64_tr_b16 %0,%1 offset:%c2" : "=&v"(hi[buf][ks]) : "v"(vb), "i"((d0) * 4096 + ks * 1024 + 512) : "memory"); } } while (0)
#define ATT_PK(b, k) (bf16x8){lo[b][k][0], lo[b][k][1], lo[b][k][2], lo[b][k][3], hi[b][k][0], hi[b][k][1], hi[b][k][2], hi[b][k][3]}
#define ATT_MM2(da, db) do { \
        o[da] = __builtin_amdgcn_mfma_f32_32x32x16_bf16(pa0, ATT_PK(0, 0), o[da], 0, 0, 0); o[db] = __builtin_amdgcn_mfma_f32_32x32x16_bf16(pa0, ATT_PK(1, 0), o[db], 0, 0, 0); \
        o[da] = __builtin_amdgcn_mfma_f32_32x32x16_bf16(pa1, ATT_PK(0, 1), o[da], 0, 0, 0); o[db] = __builtin_amdgcn_mfma_f32_32x32x16_bf16(pa1, ATT_PK(1, 1), o[db], 0, 0, 0); \
        o[da] = __builtin_amdgcn_mfma_f32_32x32x16_bf16(pa2, ATT_PK(0, 2), o[da], 0, 0, 0); o[db] = __builtin_amdgcn_mfma_f32_32x32x16_bf16(pa2, ATT_PK(1, 2), o[db], 0, 0, 0); \
        o[da] = __builtin_amdgcn_mfma_f32_32x32x16_bf16(pa3, ATT_PK(0, 3), o[da], 0, 0, 0); o[db] = __builtin_amdgcn_mfma_f32_32x32x16_bf16(pa3, ATT_PK(1, 3), o[db], 0, 0, 0); } while (0)
__device__ __forceinline__ void pv(f32x16* o, int vb, bf16x8 pa0, bf16x8 pa1, bf16x8 pa2, bf16x8 pa3) {
    s16x4 lo[2][4], hi[2][4];
    ATT_VRD(0, 0);
    ATT_VRD(1, 1);
    asm volatile("s_waitcnt lgkmcnt(0)" ::: "memory"); __builtin_amdgcn_sched_barrier(0);
    ATT_MM2(0, 1); __builtin_amdgcn_sched_barrier(0);
    ATT_VRD(0, 2);
    ATT_VRD(1, 3);
    asm volatile("s_waitcnt lgkmcnt(0)" ::: "memory"); __builtin_amdgcn_sched_barrier(0);
    ATT_MM2(2, 3);
}
#undef ATT_MM2
#undef ATT_VRD
#undef ATT_PK
__device__ __forceinline__ void attn_pass(const Args& A, int z, int b, int h, int qrow0, bool isctx, bool pathB, LAS char* shm, f32x16* o) {
    const int tid = opaque_tid(), lane = tid & 63, r32 = lane & 31, hi = lane >> 5; const int wid = __builtin_amdgcn_readfirstlane(tid >> 6);
    const int NT = isctx ? 4 : 68;
    LAS float* wsf = (LAS float*)(shm + LDS_WS) + wid * 64;
    const int vb0 = (int)(unsigned)(size_t)(shm + LDS_V) + ((lane >> 4) & 1) * 32 + (lane & 3) * 8 + (4 * hi + ((lane & 15) >> 2)) * 64;
    const bf16_t* Qw = A.Q + (size_t)(qrow0 + wid * 32 + r32) * 1024 + h * 128 + z * 64;
    bf16x8 qr[4];
#pragma unroll
    for (int d0 = 0; d0 < 4; ++d0) qr[d0] = *(const bf16x8*)(Qw + d0 * 16 + hi * 8);
    const bf16_t* Kh = A.K + (size_t)((h * 2 + z) * 8 + wid) * 512 + lane * 8;
    const int pc0 = wid, pc1 = wid + 8;
    const bf16_t* Vh0 = A.V + (size_t)h * 8192 + pc0 * 512 + lane * 8;
    const bf16_t* Vh1 = A.V + (size_t)h * 8192 + pc1 * 512 + lane * 8;
    const int ctxrow = TL + b * 256, latrow = b * 4096;
#define ATT_TROW(t) ((isctx || (t) < 4) ? (ctxrow + 64 * (t)) : (latrow + 64 * ((t) - 4)))
#define ATT_DMA(t, slot, vslot) do { const size_t ro_ = (size_t)(ATT_TROW(t) >> 6) * 65536; \
        __builtin_amdgcn_global_load_lds((const unsigned*)(Kh + ro_), (LAS unsigned*)(shm + LDS_K + (slot) * KSLOT + wid * 1024), 16, 0, 0); \
        __builtin_amdgcn_global_load_lds((const unsigned*)(Vh0 + ro_), (LAS unsigned*)(shm + LDS_V + (vslot) * VSLOT + pc0 * 1024), 16, 0, 0); \
        __builtin_amdgcn_global_load_lds((const unsigned*)(Vh1 + ro_), (LAS unsigned*)(shm + LDS_V + (vslot) * VSLOT + pc1 * 1024), 16, 0, 0); } while (0)
    float mhat = 0.f, l_reg = 0.f;
    const f32x16 negm = f32x16{};
#pragma unroll
    for (int d = 0; d < 4; ++d) o[d] = f32x16{};
    ATT_DMA(0, 0, 0);
    if (NT > 1) ATT_DMA(1, 1, 1);
    asm volatile("s_waitcnt vmcnt(0) lgkmcnt(0)\n\ts_barrier" ::: "memory");
    f32x16 sc0, sc1;
    { bf16x8 kf[8]; kload(kf, shm + LDS_K, r32, hi); qk_mm(sc0, sc1, kf, qr, negm); asm volatile("s_nop 15\n\ts_nop 15" : "+v"(sc0), "+v"(sc1)); }
    if (NT > 2) ATT_DMA(2, 2, 2);
    int k_cur = 0, v_cur = 0, v_prev = 3;
    u32x4 pw0 = {0u, 0u, 0u, 0u}, pw1 = pw0, pw2 = pw0, pw3 = pw0;
#pragma unroll 1
    for (int t = 0; t <= NT; ++t) {
        const int k_n1 = (k_cur == 2) ? 0 : k_cur + 1;
        if (t > 0) {
            asm volatile("s_waitcnt vmcnt(0) lgkmcnt(0)\n\ts_barrier" ::: "memory");
            const int k_p2 = (k_cur == 0) ? 2 : k_cur - 1;
            const int v_p2 = (v_cur + 2) & 3;
            if (t + 2 < NT) ATT_DMA(t + 2, k_p2, v_p2);
        }
        if (pathB && t > 0) {
            pv(o, vb0 + v_prev * VSLOT, __builtin_bit_cast(bf16x8, pw0), __builtin_bit_cast(bf16x8, pw1), __builtin_bit_cast(bf16x8, pw2), __builtin_bit_cast(bf16x8, pw3)); }
        if (t < NT) {
        const float rm = rowmax(sc0, sc1);
        if (t == 0) { mhat = rm; }
        else if (__any(rm - mhat > 8.f)) {
            const float dl = fmaxf(rm - mhat, 0.f); mhat += dl;
            const float f = __builtin_amdgcn_exp2f(-dl); l_reg *= f;
            if (hi == 0) wsf[r32] = f;
            asm volatile("s_waitcnt lgkmcnt(0)" ::: "memory");
#pragma unroll
            for (int r = 0; r < 16; ++r) { const float fr_ = wsf[crow(r, hi)];
#pragma unroll
                for (int d = 0; d < 4; ++d) o[d][r] *= fr_; }
            asm volatile("s_waitcnt lgkmcnt(0)" ::: "memory");
        }
        bf16x8 kf[8];
        kload(kf, shm + LDS_K + k_n1 * KSLOT, r32, hi);
        __builtin_amdgcn_sched_barrier(0);
        f32x16 pn0, pn1;
        qk_mm(pn0, pn1, kf, qr, negm);
        f32x2_t sacc = {0.f, 0.f};
#pragma unroll
        for (int r = 0; r < 16; r += 2) { sc0[r] = __builtin_amdgcn_exp2f(sc0[r] - mhat); sc0[r + 1] = __builtin_amdgcn_exp2f(sc0[r + 1] - mhat); sc1[r] = __builtin_amdgcn_exp2f(sc1[r] - mhat); sc1[r + 1] = __builtin_amdgcn_exp2f(sc1[r + 1] - mhat);
            sacc += (f32x2_t){sc0[r], sc0[r + 1]}; sacc += (f32x2_t){sc1[r], sc1[r + 1]}; }
        l_reg += sacc.x + sacc.y;
        pw0 = (u32x4){pkbf(sc0[0], sc0[1]), pkbf(sc0[2], sc0[3]), pkbf(sc0[4], sc0[5]), pkbf(sc0[6], sc0[7])};
        pw1 = (u32x4){pkbf(sc0[8], sc0[9]), pkbf(sc0[10], sc0[11]), pkbf(sc0[12], sc0[13]), pkbf(sc0[14], sc0[15])};
        pw2 = (u32x4){pkbf(sc1[0], sc1[1]), pkbf(sc1[2], sc1[3]), pkbf(sc1[4], sc1[5]), pkbf(sc1[6], sc1[7])};
        pw3 = (u32x4){pkbf(sc1[8], sc1[9]), pkbf(sc1[10], sc1[11]), pkbf(sc1[12], sc1[13]), pkbf(sc1[14], sc1[15])};
#pragma unroll
        for (int i = 0; i < 8; ++i) { __builtin_amdgcn_sched_group_barrier(0x008, 1, 0); __builtin_amdgcn_sched_group_barrier(0x002, 13, 0); }
        __builtin_amdgcn_sched_barrier(0);
        if (!pathB) {
            pv(o, vb0 + v_cur * VSLOT, __builtin_bit_cast(bf16x8, pw0), __builtin_bit_cast(bf16x8, pw1), __builtin_bit_cast(bf16x8, pw2), __builtin_bit_cast(bf16x8, pw3)); }
        sc0 = pn0; sc1 = pn1;
        }
        k_cur = k_n1; v_prev = v_cur; v_cur = (v_cur + 1) & 3;
    }
    asm volatile("s_waitcnt lgkmcnt(0)\n\ts_barrier" ::: "memory");
#undef ATT_DMA
#undef ATT_TROW
    { auto rr = __builtin_amdgcn_permlane32_swap(__float_as_uint(l_reg), __float_as_uint(l_reg), false, false); l_reg = __uint_as_float(rr[0]) + __uint_as_float(rr[1]); }
    asm volatile("s_waitcnt lgkmcnt(0)" ::: "memory");
    if (hi == 0) wsf[32 + r32] = l_reg;
    asm volatile("s_waitcnt lgkmcnt(0)" ::: "memory");
#pragma unroll
    for (int r = 0; r < 16; ++r) { const float rl = 1.0f / wsf[32 + crow(r, hi)];
#pragma unroll
        for (int d = 0; d < 4; ++d) o[d][r] *= rl; }
    asm volatile("s_waitcnt lgkmcnt(0)" ::: "memory");
}
__device__ __forceinline__ void attn_unit(const Args& A, int b, int h, int qb, bool isctx, bool pathB, LAS char* shm) {
    const int tid = opaque_tid(), lane = tid & 63, r32 = lane & 31, hi = lane >> 5; const int wid = __builtin_amdgcn_readfirstlane(tid >> 6);
    const int qrow0 = isctx ? (TL + b * 256) : (b * 4096 + qb * 256);
    f32x16 o[4];
    unsigned* o1s = A.o1g + wid * 2048 + lane;
    attn_pass(A, 0, b, h, qrow0, isctx, pathB, shm, o);
#pragma unroll
    for (int d = 0; d < 4; ++d)
#pragma unroll
        for (int r = 0; r < 16; r += 2) o1s[(d * 8 + (r >> 1)) * 64] = pkbf(o[d][r], o[d][r + 1]);
    asm volatile("s_waitcnt lgkmcnt(0)" ::: "memory");
    attn_pass(A, 1, b, h, qrow0, isctx, pathB, shm, o);
    float ss[16];
#pragma unroll
    for (int r = 0; r < 16; r += 2) { float s0 = 0.f, s1 = 0.f;
#pragma unroll
        for (int d = 0; d < 4; ++d) { const unsigned pk = o1s[(d * 8 + (r >> 1)) * 64];
            const float v0 = bflo(pk) - A.lam * o[d][r], v1 = bfhi(pk) - A.lam * o[d][r + 1]; o[d][r] = v0; o[d][r + 1] = v1; s0 += v0 * v0; s1 += v1 * v1; }
        ss[r] = s0; ss[r + 1] = s1; }
#pragma unroll
    for (int msk = 1; msk < 32; msk <<= 1)
#pragma unroll
        for (int r = 0; r < 16; ++r) ss[r] += __shfl_xor(ss[r], msk);
    float gn[4];
#pragma unroll
    for (int d = 0; d < 4; ++d) gn[d] = A.gain[d * 32 + r32] * A.oml;
#pragma unroll
    for (int r = 0; r < 16; ++r) {
        const float rstd = rsqrtf(ss[r] * (1.0f / 128.0f) + 1e-5f);
        const size_t off = (size_t)(qrow0 + wid * 32 + crow(r, hi)) * 1024 + h * 128 + r32;
#pragma unroll
        for (int d = 0; d < 4; ++d) { const float zv = bf1(A.Z[off + d * 32]); const float v = o[d][r] * rstd * gn[d] * silu_f(zv);
            A.O[off + d * 32] = (bf16_t)(pkbf(v, 0.f) & 0xffffu); }
        asm volatile("" ::: "memory");
    }
}
__device__ __forceinline__ void attn_phase(const Args& A, LAS char* shm, int G, int bid) {
    const int vcu = (G % 8 == 0) ? (bid % 8) * (G / 8) + bid / 8 : bid;
    bool pathB;
    { const int tid = opaque_tid(); LAS unsigned* cnt = (LAS unsigned*)(shm + LDS_CNT);
      if (tid < 4) cnt[tid] = 0u;
      __syncthreads();
      const unsigned simd = (unsigned)__builtin_amdgcn_s_getreg((1 << 11) | (4 << 6) | 4) & 3u;
      unsigned slot = 0u; if ((tid & 63) == 0) slot = __hip_atomic_fetch_add(cnt + simd, 1u, __ATOMIC_RELAXED, __HIP_MEMORY_SCOPE_WORKGROUP);
      slot = (unsigned)__builtin_amdgcn_readfirstlane((int)slot);
      pathB = (slot & 1u) != 0u;
      __syncthreads(); }
#pragma unroll 1
    for (int u = vcu; u < A.n_units; u += G) {
        const bool isctx = u >= 1024; const int bh = isctx ? (u - 1024) : (u >> 4); const int qb = isctx ? 0 : (u & 15);
        attn_unit(A, bh >> 3, bh & 7, qb, isctx, pathB, shm);
        asm volatile("s_waitcnt vmcnt(0) lgkmcnt(0)\n\ts_barrier" ::: "memory");
    }
}
}
typedef unsigned short bf16_t;
typedef float f32x4 __attribute__((ext_vector_type(4)));
typedef unsigned u32x4 __attribute__((ext_vector_type(4)));
typedef unsigned u32x2 __attribute__((ext_vector_type(2)));
constexpr size_t MiB = 1u << 20;
constexpr size_t WS_CTL = 0, WS_MOD = 1 * MiB, WS_ROPE = 1 * MiB + 512 * 1024, WS_BZ = 2 * MiB;
constexpr size_t WS_WDAIN = 9 * MiB, WS_WDAOUT = 25 * MiB, WS_WFNT = 29 * MiB, WS_WFNZ = 33 * MiB, WS_WFNOUT = 35 * MiB, WS_WRWIN = 37 * MiB, WS_WRWOUT = 46 * MiB;
constexpr size_t WS_XC = 48 * MiB, WS_HB = 56 * MiB, WS_BIG = 124 * MiB;
constexpr size_t WS_Q = WS_BIG, WS_K = WS_BIG + 68 * MiB, WS_V = WS_BIG + 136 * MiB, WS_Z = WS_BIG + 204 * MiB;
constexpr size_t WS_ATL = WS_BIG, WS_ATC = WS_BIG + 128 * MiB, WS_ZB = WS_BIG + 136 * MiB, WS_DFTL = 396 * MiB, WS_DFTC = 460 * MiB, WS_FOLD = WS_BIG + 204 * MiB;
constexpr size_t WS_P = WS_BIG, WS_Y1 = 413 * MiB, WS_END = 482 * MiB;
constexpr int RWN = 4352;
constexpr int LDS_BYTES = 147456;

struct Params { const float* in[28]; float* out; unsigned char* ws; };

__device__ __forceinline__ float wave_sum(float v) {
#pragma unroll
    for (int o = 1; o < 64; o <<= 1) v += __shfl_xor(v, o);
    return v;
}
__device__ __forceinline__ void tr_item(const float* W, int ldw, int N, bf16_t* WT, int ldt, LAS float* scr, int item, int lane) {
    const int nblk = N / 32, kb = item / nblk, nb = item % nblk, k0 = 64 * kb, n0 = 32 * nb;
#pragma unroll 8
    for (int i = 0; i < 32; ++i) { const int kk = 2 * i + (lane >> 5); scr[kk * 33 + (lane & 31)] = W[(size_t)(k0 + kk) * ldw + n0 + (lane & 31)]; }
    asm volatile("s_waitcnt lgkmcnt(0)" ::: "memory");
    const int c = lane & 7;
#pragma unroll
    for (int j = 0; j < 4; ++j) { const int n = (lane >> 3) + 8 * j; const LAS float* s = scr + (8 * c) * 33 + n;
        u32x4 o; o.x = pkbf(s[0 * 33], s[1 * 33]); o.y = pkbf(s[2 * 33], s[3 * 33]); o.z = pkbf(s[4 * 33], s[5 * 33]); o.w = pkbf(s[6 * 33], s[7 * 33]);
        *(u32x4*)(WT + (size_t)(n0 + n) * ldt + k0 + 8 * c) = o; }
    asm volatile("s_waitcnt lgkmcnt(0)" ::: "memory");
}
__device__ __forceinline__ void prologue(const Params& p, LAS char* lds, int G, int bid) {
    const int tid = opaque_tid(), lane = tid & 63, wid = tid >> 6;
    unsigned char* ws = p.ws;
    {
        LAS float* scr = (LAS float*)(lds + wid * 8448);
        const int gw = bid * 8 + wid, NGW = G * 8;
        for (int it = gw; it < 8832; it += NGW) {
            int r = it;
            if (r < 2048) { tr_item(p.in[8], 4096, 4096, (bf16_t*)(ws + WS_WDAIN), 1024, scr, r, lane); continue; } r -= 2048;
            if (r < 2048) { tr_item(p.in[8] + (size_t)1024 * 4096, 4096, 4096, (bf16_t*)(ws + WS_WDAIN + 8 * MiB), 1024, scr, r, lane); continue; } r -= 2048;
            if (r < 512) { tr_item(p.in[12], 1024, 1024, (bf16_t*)(ws + WS_WDAOUT), 1024, scr, r, lane); continue; } r -= 512;
            if (r < 512) { tr_item(p.in[12] + (size_t)1024 * 1024, 1024, 1024, (bf16_t*)(ws + WS_WDAOUT + 2 * MiB), 1024, scr, r, lane); continue; } r -= 512;
            if (r < 512) { tr_item(p.in[13] + 1024, 2048, 1024, (bf16_t*)(ws + WS_WFNZ), 1024, scr, r, lane); continue; } r -= 512;
            if (r < 512) { tr_item(p.in[15], 1024, 1024, (bf16_t*)(ws + WS_WFNOUT), 1024, scr, r, lane); continue; } r -= 512;
            if (r < 2176) { tr_item(p.in[16], RWN, RWN, (bf16_t*)(ws + WS_WRWIN), 1024, scr, r, lane); continue; } r -= 2176;
            tr_item(p.in[27], 1024, 1024, (bf16_t*)(ws + WS_WRWOUT), 1024, scr, r, lane);
        }
    }
    __syncthreads();
    for (int it = bid; it < 256; it += G) {
        const int g = it >> 5, cs = (it >> 4) & 1, kq = it & 15;
        LAS float* Wcs = (LAS float*)lds; LAS float* win = (LAS float*)(lds + 65536); LAS float* tab = (LAS float*)(lds + 65536 + 33024);
        if (tid < 128) { float s, c; sincospif((float)tid / 64.f, &s, &c); tab[tid] = (cs ? s : c) * 0.08838834764831845f; }
        __syncthreads();
        {
            const int e = tid & 127, cq = tid >> 7; float acc[32];
#pragma unroll
            for (int i = 0; i < 32; ++i) acc[i] = 0.f;
            const float* Wg = p.in[14] + (size_t)g * 128 * 128;
            for (int m = 0; m < 128; ++m) { const float wg = Wg[m * 128 + e];
#pragma unroll
                for (int i = 0; i < 32; ++i) acc[i] += tab[(m * (cq + 4 * i)) & 127] * wg; }
#pragma unroll
            for (int i = 0; i < 32; ++i) Wcs[(cq + 4 * i) * 128 + e] = acc[i];
        }
#pragma unroll
        for (int i = 0; i < 16; ++i) { const int idx = tid + 512 * i, kin = idx >> 7, c = idx & 127; win[kin * 129 + c] = p.in[13][(size_t)(kq * 64 + kin) * 2048 + g * 128 + c]; }
        __syncthreads();
        {
            const int kin = tid & 63, eg = tid >> 6; float acc[16];
#pragma unroll
            for (int i = 0; i < 16; ++i) acc[i] = 0.f;
            for (int c = 0; c < 128; ++c) { const float a = win[kin * 129 + c];
#pragma unroll
                for (int i = 0; i < 16; ++i) acc[i] += a * Wcs[c * 128 + eg * 16 + i]; }
            bf16_t* WT = (bf16_t*)(ws + WS_WFNT);
#pragma unroll
            for (int i = 0; i < 16; ++i) WT[(size_t)(cs * 1024 + g * 128 + eg * 16 + i) * 1024 + kq * 64 + kin] = (bf16_t)(pkbf(acc[i], 0.f) & 0xffffu);
        }
        __syncthreads();
    }
    {
        LAS float* tc = (LAS float*)lds; LAS float* ts = (LAS float*)(lds + 16384);
        for (int j = tid; j < 4096; j += 512) { float s, c; sincospif((float)j / 2048.f, &s, &c); tc[j] = c; ts[j] = -s; }
        __syncthreads();
        bf16_t* DL = (bf16_t*)(ws + WS_DFTL); bf16_t* DC = (bf16_t*)(ws + WS_DFTC);
        for (int k = bid; k < 2048; k += G) {
            const int j0 = (tid & 255) * 8; const bool sn = tid >= 256; float v8[8];
#pragma unroll
            for (int i = 0; i < 8; ++i) { const int idx = (k * (j0 + i)) & 4095; v8[i] = (sn ? -ts[idx] : tc[idx]) * 0.015625f; }
            u32x4 o; o.x = pkbf(v8[0], v8[1]); o.y = pkbf(v8[2], v8[3]); o.z = pkbf(v8[4], v8[5]); o.w = pkbf(v8[6], v8[7]);
            *(u32x4*)(DL + (sn ? (size_t)2048 * 2048 : (size_t)0) + (size_t)k * 2048 + j0) = o;
        }
        for (int k = bid; k < 256; k += G) {
            if (tid < 64) { const int cs = tid >> 5, l0 = (tid & 31) * 8; float v8[8];
#pragma unroll
                for (int i = 0; i < 8; ++i) { const int idx = ((k * (l0 + i)) & 255) * 16; v8[i] = (cs ? ts[idx] : tc[idx]) * 0.0625f; }
                u32x4 o; o.x = pkbf(v8[0], v8[1]); o.y = pkbf(v8[2], v8[3]); o.z = pkbf(v8[4], v8[5]); o.w = pkbf(v8[6], v8[7]);
                *(u32x4*)(DC + (size_t)k * 512 + cs * 256 + l0) = o; }
        }
        __syncthreads();
    }
    {
        LAS float* sc = (LAS float*)lds; LAS float* red = (LAS float*)(lds + 40960);
        bool have = false;
        for (int it = bid; it < 192; it += G) {
            if (!have) { for (int idx = tid; idx < 9216; idx += 512) { const int r = idx >> 10, k = idx & 1023; const float cv = r < 8 ? p.in[1][r * 1024 + k] : p.in[3][k]; sc[idx] = cv / (1.f + __expf(-cv)); } have = true; __syncthreads(); }
            const int i = it / 48, n = (it % 48) * 64 + (tid & 63), kq = tid >> 6;
            const float* w = p.in[5] + (size_t)i * 1024 * 3072 + n;
            float acc[9];
#pragma unroll
            for (int r = 0; r < 9; ++r) acc[r] = 0.f;
            for (int k = kq * 128; k < kq * 128 + 128; ++k) { const float wv = w[(size_t)k * 3072];
#pragma unroll
                for (int r = 0; r < 9; ++r) acc[r] += sc[r * 1024 + k] * wv; }
#pragma unroll
            for (int r = 0; r < 9; ++r) red[(kq * 9 + r) * 64 + (tid & 63)] = acc[r];
            __syncthreads();
            for (int idx = tid; idx < 576; idx += 512) { const int r = idx >> 6, col = idx & 63; float s = 0.f;
#pragma unroll
                for (int q = 0; q < 8; ++q) s += red[(q * 9 + r) * 64 + col];
                const int nn = (it % 48) * 64 + col;
                ((float*)(ws + WS_MOD))[(size_t)(i * 9 + r) * 3072 + nn] = s + p.in[6][i * 3072 + nn]; }
            __syncthreads();
        }
    }
    if (bid == 0) { for (int t = tid; t < 1024; t += 512) { const int pos = t >> 4, qd = t & 15; const float inv = powf(10000.f, -(float)qd / 16.f); const float ang = (float)pos * inv;
            ((float*)(ws + WS_ROPE))[t] = cosf(ang); ((float*)(ws + WS_ROPE))[1024 + t] = sinf(ang); } }
}
__device__ __forceinline__ void ph_phase(const float* xlat, const float* xctx, const float* gain, const float* mod, bf16_t* Hb, int G, int bid) {
    const int tid_ = opaque_tid(); const int lane = tid_ & 63, wid = tid_ >> 6;
    const int stride = G * 8;
    for (int row0 = bid * 8 + wid; row0 < TT; row0 += 2 * stride) {
        const int row1 = row0 + stride; const bool has1 = row1 < TT;
        const float* s0 = row0 < TL ? xlat + (size_t)row0 * 1024 : xctx + (size_t)(row0 - TL) * 1024;
        const float* s1 = !has1 ? s0 : (row1 < TL ? xlat + (size_t)row1 * 1024 : xctx + (size_t)(row1 - TL) * 1024);
        f32x4 v0[4], v1[4]; float q0 = 0.f, q1 = 0.f;
#pragma unroll
        for (int j = 0; j < 4; ++j) { v0[j] = *(const f32x4*)(s0 + 4 * lane + 256 * j); v1[j] = *(const f32x4*)(s1 + 4 * lane + 256 * j); }
#pragma unroll
        for (int j = 0; j < 4; ++j) { q0 += (v0[j].x * v0[j].x + v0[j].y * v0[j].y) + (v0[j].z * v0[j].z + v0[j].w * v0[j].w); q1 += (v1[j].x * v1[j].x + v1[j].y * v1[j].y) + (v1[j].z * v1[j].z + v1[j].w * v1[j].w); }
        const float r0 = rsqrtf(wave_sum(q0) * (1.f / 1024.f) + 1e-6f), r1 = rsqrtf(wave_sum(q1) * (1.f / 1024.f) + 1e-6f);
        const float* m0 = mod + (row0 < TL ? (row0 >> 12) : 8) * 3072; const float* m1 = mod + (row1 < TL ? (row1 >> 12) : 8) * 3072;
#pragma unroll
        for (int j = 0; j < 4; ++j) { const int col = 4 * lane + 256 * j; const f32x4 g4 = *(const f32x4*)(gain + col);
            { const f32x4 sh = *(const f32x4*)(m0 + col), sc = *(const f32x4*)(m0 + 1024 + col); const f32x4 y = v0[j] * r0 * g4 * (sc + 1.f) + sh; u32x2 o; o.x = pkbf(y.x, y.y); o.y = pkbf(y.z, y.w); *(u32x2*)(Hb + (size_t)row0 * 1024 + col) = o; }
            if (has1) { const f32x4 sh = *(const f32x4*)(m1 + col), sc = *(const f32x4*)(m1 + 1024 + col); const f32x4 y = v1[j] * r1 * g4 * (sc + 1.f) + sh; u32x2 o; o.x = pkbf(y.x, y.y); o.y = pkbf(y.z, y.w); *(u32x2*)(Hb + (size_t)row1 * 1024 + col) = o; } }
    }
}
__device__ __forceinline__ void final_phase(float* x, const float* gain, int G, int bid) {
    const int tid_ = opaque_tid(); const int lane = tid_ & 63, wid = tid_ >> 6;
    const int stride = G * 8;
    for (int row0 = bid * 8 + wid; row0 < TL; row0 += 2 * stride) {
        const int row1 = row0 + stride; const bool has1 = row1 < TL;
        float* s0 = x + (size_t)row0 * 1024; float* s1 = has1 ? x + (size_t)row1 * 1024 : s0;
        f32x4 v0[4], v1[4]; float q0 = 0.f, q1 = 0.f;
#pragma unroll
        for (int j = 0; j < 4; ++j) { v0[j] = *(const f32x4*)(s0 + 4 * lane + 256 * j); v1[j] = *(const f32x4*)(s1 + 4 * lane + 256 * j); }
#pragma unroll
        for (int j = 0; j < 4; ++j) { q0 += (v0[j].x * v0[j].x + v0[j].y * v0[j].y) + (v0[j].z * v0[j].z + v0[j].w * v0[j].w); q1 += (v1[j].x * v1[j].x + v1[j].y * v1[j].y) + (v1[j].z * v1[j].z + v1[j].w * v1[j].w); }
        const float r0 = rsqrtf(wave_sum(q0) * (1.f / 1024.f) + 1e-6f), r1 = rsqrtf(wave_sum(q1) * (1.f / 1024.f) + 1e-6f);
#pragma unroll
        for (int j = 0; j < 4; ++j) { const int col = 4 * lane + 256 * j; const f32x4 g4 = *(const f32x4*)(gain + col);
            *(f32x4*)(s0 + col) = v0[j] * r0 * g4;
            if (has1) *(f32x4*)(s1 + col) = v1[j] * r1 * g4; }
    }
}
__device__ __forceinline__ void fnet_fold(const bf16_t* ATL, bf16_t* E, bf16_t* O, float* TA, const bf16_t* Z, bf16_t* OG, int G, int bid) {
    const int tid_ = opaque_tid(); const int lane = tid_ & 63, wid = tid_ >> 6;
    for (int row = bid * 8 + wid; row < 8192; row += G * 8) {
        const bf16_t* a1 = ATL + (size_t)row * 8192; const bf16_t* a2 = a1 + 4096; bf16_t* e = E + (size_t)row * 2048; bf16_t* od = O + (size_t)row * 2048;
        float alt = 0.f;
#pragma unroll 2
        for (int it = 0; it < 4; ++it) {
            const int j0 = (it * 64 + lane) * 8;
            const u32x4 x = *(const u32x4*)(a1 + j0), y = *(const u32x4*)(a2 + j0);
            const int mb = 4096 - j0 - 8;
            const u32x4 xm = *(const u32x4*)(a1 + mb), ym = *(const u32x4*)(a2 + mb);
            const unsigned short xe = (j0 == 0) ? (unsigned short)0 : a1[4096 - j0], ye = (j0 == 0) ? (unsigned short)0 : a2[4096 - j0];
            float fa[8], fs[8], ma[8], ms[8];
#pragma unroll
            for (int i = 0; i < 4; ++i) { fa[2 * i] = bflo(x[i]); fa[2 * i + 1] = bfhi(x[i]); fs[2 * i] = bflo(y[i]); fs[2 * i + 1] = bfhi(y[i]);
                ma[2 * i] = bflo(xm[i]); ma[2 * i + 1] = bfhi(xm[i]); ms[2 * i] = bflo(ym[i]); ms[2 * i + 1] = bfhi(ym[i]); }
            float oc[8], os[8];
            oc[0] = fa[0] + bf1(xe); os[0] = fs[0] - bf1(ye);
#pragma unroll
            for (int i = 1; i < 8; ++i) { oc[i] = fa[i] + ma[8 - i]; os[i] = fs[i] - ms[8 - i]; }
            if (j0 == 0) { oc[0] = fa[0]; os[0] = 0.f; }
            u32x4 o; o.x = pkbf(oc[0], oc[1]); o.y = pkbf(oc[2], oc[3]); o.z = pkbf(oc[4], oc[5]); o.w = pkbf(oc[6], oc[7]);
            *(u32x4*)(e + j0) = o;
            alt += (bflo(o.x) - bfhi(o.x)) + (bflo(o.y) - bfhi(o.y)) + (bflo(o.z) - bfhi(o.z)) + (bflo(o.w) - bfhi(o.w));
            o.x = pkbf(os[0], os[1]); o.y = pkbf(os[2], os[3]); o.z = pkbf(os[4], os[5]); o.w = pkbf(os[6], os[7]);
            *(u32x4*)(od + j0) = o;
        }
        alt = wave_sum(alt);
        if (lane == 0) { const float amid = bf1(a1[2048]); TA[row] = amid * 0.015625f;
            const int b = row >> 10, n = row & 1023; const size_t off = (size_t)(b * 4096 + 2048) * 1024 + n;
            const float yv = (alt + amid) * 0.015625f * silu_f(bf1(Z[off]));
            OG[off] = (bf16_t)(pkbf(yv, 0.f) & 0xffffu); }
    }
}
__device__ __forceinline__ void sh8(const bf16_t* P, size_t row, int co, bool hm, bool hp, const float* mu, float* out) {
    const u32x4 z4 = {0u, 0u, 0u, 0u};
    const u32x4 c0 = *(const u32x4*)(P + row * RWN + co);
    const u32x4 cm = hm ? *(const u32x4*)(P + (row - 1) * RWN + co) : z4;
    const u32x4 cp = hp ? *(const u32x4*)(P + (row + 1) * RWN + co) : z4;
    const f32x4 m0 = *(const f32x4*)(mu + co), m1 = *(const f32x4*)(mu + co + 4);
#pragma unroll
    for (int i = 0; i < 4; ++i) {
        const float a0 = bflo(c0[i]), a1 = bfhi(c0[i]);
        const float n0 = 0.5f * (bflo(cm[i]) + bflo(cp[i])), n1 = 0.5f * (bfhi(cm[i]) + bfhi(cp[i]));
        const float mu0 = (2 * i < 4) ? m0[(2 * i) & 3] : m1[(2 * i) & 3], mu1 = (2 * i + 1 < 4) ? m0[(2 * i + 1) & 3] : m1[(2 * i + 1) & 3];
        out[2 * i] = a0 + mu0 * (n0 - a0); out[2 * i + 1] = a1 + mu1 * (n1 - a1);
    }
}
template <int CTRL> __device__ __forceinline__ float dpp_f(float v) { return __int_as_float(__builtin_amdgcn_update_dpp(0, __float_as_int(v), CTRL, 0xf, 0xf, true)); }
__device__ __forceinline__ float sum8(float v) { v += dpp_f<0xB1>(v); v += dpp_f<0x4E>(v); v += dpp_f<0x141>(v); return v; }
__device__ __forceinline__ float fast_tanh(float x) { const float e = __expf(2.f * x); return 1.f - 2.f * __builtin_amdgcn_rcpf(e + 1.f); }
__device__ __forceinline__ float fast_sigmoid(float x) { return __builtin_amdgcn_rcpf(1.f + __expf(-x)); }
struct RwArgs { const bf16_t* P; bf16_t* Y0; bf16_t* Y1; float* BZ; const float *mu, *w0, *w_up, *a0, *a_up, *k_k, *k_a, *r_k; };
struct Raw3 { u32x4 c0, cm, cp; };
__device__ __forceinline__ Raw3 ld3(const bf16_t* P, size_t row, int co, bool hm, bool hp) {
    const u32x4 z4 = {0u, 0u, 0u, 0u}; Raw3 r;
    r.c0 = *(const u32x4*)(P + row * RWN + co);
    r.cm = hm ? *(const u32x4*)(P + (row - 1) * RWN + co) : z4;
    r.cp = hp ? *(const u32x4*)(P + (row + 1) * RWN + co) : z4;
    return r;
}
__device__ __forceinline__ void shift8(const Raw3& R, const float* mu, int co, float* out) {
    const f32x4 m0 = *(const f32x4*)(mu + co), m1 = *(const f32x4*)(mu + co + 4);
#pragma unroll
    for (int i = 0; i < 4; ++i) {
        const float a0 = bflo(R.c0[i]), a1 = bfhi(R.c0[i]);
        const float n0 = 0.5f * (bflo(R.cm[i]) + bflo(R.cp[i])), n1 = 0.5f * (bfhi(R.cm[i]) + bfhi(R.cp[i]));
        const float mu0 = (2 * i < 4) ? m0[(2 * i) & 3] : m1[(2 * i) & 3], mu1 = (2 * i + 1 < 4) ? m0[(2 * i + 1) & 3] : m1[(2 * i + 1) & 3];
        out[2 * i] = a0 + mu0 * (n0 - a0); out[2 * i + 1] = a1 + mu1 * (n1 - a1);
    }
}
__device__ __forceinline__ void rwkv_scan(const RwArgs& A, LAS char* lds, int G, int bid) {
    typedef short bfx8 __attribute__((ext_vector_type(8)));
    const int tid = opaque_tid(), lane = tid & 63; const int q = __builtin_amdgcn_readfirstlane(tid >> 6);
    LAS float* sW = (LAS float*)lds; LAS float* sA = sW + 4096; LAS float* sB = sA + 4096; LAS float* sKD = sB + 4096; LAS float* sR = sKD + 4096; LAS float* sV = sR + 4096;
    LAS bf16_t* WUPt = (LAS bf16_t*)(sV + 4096); LAS bf16_t* AUPt = WUPt + 64 * 72;
    LAS bf16_t* T1 = (LAS bf16_t*)sW; LAS bf16_t* T2 = (LAS bf16_t*)sKD;
    const int s = tid >> 3, dg = tid & 7, d0 = dg * 8;
#pragma unroll 1
    for (int chain = bid; chain < 256; chain += G) {
        const int z = chain >> 7, b = (chain >> 4) & 7, hh = chain & 15;
        __syncthreads();
        for (int idx = tid; idx < 4096; idx += 512) { const int r = idx >> 6, d = idx & 63;
            WUPt[d * 72 + r] = (bf16_t)(pkbf(A.w_up[(size_t)(z * 64 + r) * 1024 + hh * 64 + d], 0.f) & 0xffffu);
            AUPt[d * 72 + r] = (bf16_t)(pkbf(A.a_up[(size_t)(z * 64 + r) * 1024 + hh * 64 + d], 0.f) & 0xffffu); }
        f32x2_t S2[4];
#pragma unroll
        for (int j = 0; j < 4; ++j) S2[j] = (f32x2_t){0.f, 0.f};
        bf16_t* Yz = z ? A.Y1 : A.Y0;
        const int c_r = hh * 64 + d0, c_k = 1024 + hh * 64 + d0, c_v = 2048 + hh * 64 + d0, c_wd = 3072 + z * 64 + d0, c_ad = 3200 + z * 64 + d0;
#define RW_ROWOF(c, rowv, hmv, hpv) do { const int sidx_ = (c) * 64 + s; int L_, n_, rb_; \
            if ((c) < 4) { L_ = 256; n_ = z ? (255 - sidx_) : sidx_; rb_ = TL + b * 256; } else { L_ = 4096; const int sl_ = sidx_ - 256; n_ = z ? (4095 - sl_) : sl_; rb_ = b * 4096; } \
            rowv = (size_t)(rb_ + n_); hmv = n_ > 0; hpv = n_ < L_ - 1; } while (0)
        size_t row; bool hm, hp;
        RW_ROWOF(0, row, hm, hp);
        Raw3 Rr = ld3(A.P, row, c_r, hm, hp), Rk = ld3(A.P, row, c_k, hm, hp), Rv = ld3(A.P, row, c_v, hm, hp), Rw = ld3(A.P, row, c_wd, hm, hp), Ra = ld3(A.P, row, c_ad, hm, hp);
#pragma unroll 1
        for (int c = 0; c < 68; ++c) {
            asm volatile("" ::: "memory");
            const size_t crow_ = row;
            {
                float r8[8], k8[8], v8[8], t8[8];
                shift8(Rr, A.mu, c_r, r8); shift8(Rk, A.mu, c_k, k8); shift8(Rv, A.mu, c_v, v8);
                *(LAS f32x4*)(sR + s * 64 + d0) = (f32x4){r8[0], r8[1], r8[2], r8[3]}; *(LAS f32x4*)(sR + s * 64 + d0 + 4) = (f32x4){r8[4], r8[5], r8[6], r8[7]};
                *(LAS f32x4*)(sV + s * 64 + d0) = (f32x4){v8[0], v8[1], v8[2], v8[3]}; *(LAS f32x4*)(sV + s * 64 + d0 + 4) = (f32x4){v8[4], v8[5], v8[6], v8[7]};
                *(LAS f32x4*)(sB + s * 64 + d0) = (f32x4){k8[0], k8[1], k8[2], k8[3]}; *(LAS f32x4*)(sB + s * 64 + d0 + 4) = (f32x4){k8[4], k8[5], k8[6], k8[7]};
                float kkr[8], ssq = 0.f;
                const f32x4 kk0 = *(const f32x4*)(A.k_k + hh * 64 + d0), kk1 = *(const f32x4*)(A.k_k + hh * 64 + d0 + 4);
#pragma unroll
                for (int i = 0; i < 8; ++i) { kkr[i] = k8[i] * (i < 4 ? kk0[i & 3] : kk1[i & 3]); ssq += kkr[i] * kkr[i]; }
                ssq = sum8(ssq);
                const float rs = -rsqrtf(ssq + 1e-12f);
                *(LAS f32x4*)(sA + s * 64 + d0) = (f32x4){kkr[0] * rs, kkr[1] * rs, kkr[2] * rs, kkr[3] * rs}; *(LAS f32x4*)(sA + s * 64 + d0 + 4) = (f32x4){kkr[4] * rs, kkr[5] * rs, kkr[6] * rs, kkr[7] * rs};
                shift8(Rw, A.mu, c_wd, t8);
                { u32x4 o; o.x = pkbf(fast_tanh(t8[0]), fast_tanh(t8[1])); o.y = pkbf(fast_tanh(t8[2]), fast_tanh(t8[3])); o.z = pkbf(fast_tanh(t8[4]), fast_tanh(t8[5])); o.w = pkbf(fast_tanh(t8[6]), fast_tanh(t8[7]));
                  *(LAS u32x4*)(T1 + s * 72 + d0) = o; }
                shift8(Ra, A.mu, c_ad, t8);
                { u32x4 o; o.x = pkbf(t8[0], t8[1]); o.y = pkbf(t8[2], t8[3]); o.z = pkbf(t8[4], t8[5]); o.w = pkbf(t8[6], t8[7]);
                  *(LAS u32x4*)(T2 + s * 72 + d0) = o; }
            }
            if (c + 1 < 68) { RW_ROWOF(c + 1, row, hm, hp);
                Rr = ld3(A.P, row, c_r, hm, hp); Rk = ld3(A.P, row, c_k, hm, hp); Rv = ld3(A.P, row, c_v, hm, hp); Rw = ld3(A.P, row, c_wd, hm, hp); Ra = ld3(A.P, row, c_ad, hm, hp); }
            __syncthreads();
            const int mt = q & 3, nh = q >> 2, fr = lane & 15, fq = lane >> 4;
            f32x4 accw[2], acca[2];
            {
                bfx8 aw[2], aa[2];
#pragma unroll
                for (int kk = 0; kk < 2; ++kk) { aw[kk] = *(const LAS bfx8*)(T1 + (16 * mt + fr) * 72 + kk * 32 + fq * 8); aa[kk] = *(const LAS bfx8*)(T2 + (16 * mt + fr) * 72 + kk * 32 + fq * 8); }
#pragma unroll
                for (int nt = 0; nt < 2; ++nt) { accw[nt] = (f32x4){0.f, 0.f, 0.f, 0.f}; acca[nt] = (f32x4){0.f, 0.f, 0.f, 0.f};
#pragma unroll
                    for (int kk = 0; kk < 2; ++kk) {
                        const bfx8 bw = *(const LAS bfx8*)(WUPt + (32 * nh + 16 * nt + fr) * 72 + kk * 32 + fq * 8), ba = *(const LAS bfx8*)(AUPt + (32 * nh + 16 * nt + fr) * 72 + kk * 32 + fq * 8);
                        accw[nt] = __builtin_amdgcn_mfma_f32_16x16x32_bf16(aw[kk], bw, accw[nt], 0, 0, 0);
                        acca[nt] = __builtin_amdgcn_mfma_f32_16x16x32_bf16(aa[kk], ba, acca[nt], 0, 0, 0); } }
            }
            __syncthreads();
#pragma unroll
            for (int nt = 0; nt < 2; ++nt) { const int d = 32 * nh + 16 * nt + fr, dcol = hh * 64 + d;
                const float w0d = A.w0[z * 1024 + dcol], a0d = A.a0[z * 1024 + dcol], kad = A.k_a[dcol];
#pragma unroll
                for (int j = 0; j < 4; ++j) { const int idx = (16 * mt + 4 * fq + j) * 64 + d;
                    const float x = -(w0d + accw[nt][j]);
                    const float sp = fmaxf(x, 0.f) + __logf(1.f + __expf(-fabsf(x)));
                    const float w = __expf(-__expf(-sp - 0.5f));
                    const float asig = fast_sigmoid(a0d + acca[nt][j]);
                    const float nkk = sA[idx], kraw = sB[idx];
                    sW[idx] = w; sB[idx] = -nkk * asig; sKD[idx] = kraw * (1.f + (asig - 1.f) * kad); } }
            __syncthreads();
            {
                const f32x4 ra = *(const LAS f32x4*)(sR + s * 64 + d0), rb = *(const LAS f32x4*)(sR + s * 64 + d0 + 4), ka = *(const LAS f32x4*)(sKD + s * 64 + d0), kb = *(const LAS f32x4*)(sKD + s * 64 + d0 + 4);
                const f32x4 q0 = *(const f32x4*)(A.r_k + hh * 64 + d0), q1 = *(const f32x4*)(A.r_k + hh * 64 + d0 + 4);
                float bz = 0.f;
#pragma unroll
                for (int i = 0; i < 4; ++i) { bz += ra[i] * ka[i] * q0[i]; bz += rb[i] * kb[i] * q1[i]; }
                bz = sum8(bz);
                if (dg == 0) A.BZ[((size_t)z * TT + crow_) * 16 + hh] = bz;
            }
            {
                const int rl = lane >> 3, cg = lane & 7, irow = 8 * q + rl;
                const LAS float* bw = sW + 8 * cg; const LAS float* ba_ = sA + 8 * cg; const LAS float* bb_ = sB + 8 * cg; const LAS float* bk = sKD + 8 * cg; const LAS float* br = sR + 8 * cg;
                LAS float* bv = sV + irow;
                f32x4 w0 = *(const LAS f32x4*)(bw), w1 = *(const LAS f32x4*)(bw + 4), a0 = *(const LAS f32x4*)(ba_), a1 = *(const LAS f32x4*)(ba_ + 4);
                f32x4 b0 = *(const LAS f32x4*)(bb_), b1 = *(const LAS f32x4*)(bb_ + 4), k0 = *(const LAS f32x4*)(bk), k1 = *(const LAS f32x4*)(bk + 4);
                f32x4 r0 = *(const LAS f32x4*)(br), r1 = *(const LAS f32x4*)(br + 4); float vi = bv[0];
#pragma unroll 2
                for (int st = 0; st < 64; ++st) {
                    const int on = ((st + 1) & 63) * 64;
                    const f32x4 nw0 = *(const LAS f32x4*)(bw + on), nw1 = *(const LAS f32x4*)(bw + on + 4), na0 = *(const LAS f32x4*)(ba_ + on), na1 = *(const LAS f32x4*)(ba_ + on + 4);
                    const f32x4 nb0 = *(const LAS f32x4*)(bb_ + on), nb1 = *(const LAS f32x4*)(bb_ + on + 4), nk0 = *(const LAS f32x4*)(bk + on), nk1 = *(const LAS f32x4*)(bk + on + 4);
                    const f32x4 nr0 = *(const LAS f32x4*)(br + on), nr1 = *(const LAS f32x4*)(br + on + 4); const float nvi = bv[on];
                    f32x2_t pp2 = S2[0] * (f32x2_t){a0[0], a0[1]};
                    pp2 = S2[1] * (f32x2_t){a0[2], a0[3]} + pp2; pp2 = S2[2] * (f32x2_t){a1[0], a1[1]} + pp2; pp2 = S2[3] * (f32x2_t){a1[2], a1[3]} + pp2;
                    const float sa = sum8(pp2.x + pp2.y);
                    const f32x2_t sa2 = {sa, sa}, v2 = {vi, vi};
                    S2[0] = S2[0] * (f32x2_t){w0[0], w0[1]} + sa2 * (f32x2_t){b0[0], b0[1]} + v2 * (f32x2_t){k0[0], k0[1]};
                    S2[1] = S2[1] * (f32x2_t){w0[2], w0[3]} + sa2 * (f32x2_t){b0[2], b0[3]} + v2 * (f32x2_t){k0[2], k0[3]};
                    S2[2] = S2[2] * (f32x2_t){w1[0], w1[1]} + sa2 * (f32x2_t){b1[0], b1[1]} + v2 * (f32x2_t){k1[0], k1[1]};
                    S2[3] = S2[3] * (f32x2_t){w1[2], w1[3]} + sa2 * (f32x2_t){b1[2], b1[3]} + v2 * (f32x2_t){k1[2], k1[3]};
                    f32x2_t y2 = S2[0] * (f32x2_t){r0[0], r0[1]};
                    y2 = S2[1] * (f32x2_t){r0[2], r0[3]} + y2; y2 = S2[2] * (f32x2_t){r1[0], r1[1]} + y2; y2 = S2[3] * (f32x2_t){r1[2], r1[3]} + y2;
                    const float yv = sum8(y2.x + y2.y);
                    if (cg == 0) bv[st * 64] = yv;
                    w0 = nw0; w1 = nw1; a0 = na0; a1 = na1; b0 = nb0; b1 = nb1; k0 = nk0; k1 = nk1; r0 = nr0; r1 = nr1; vi = nvi;
                }
            }
            __syncthreads();
            { u32x4 o; const LAS float* yr = sV + s * 64 + d0;
              o.x = pkbf(yr[0], yr[1]); o.y = pkbf(yr[2], yr[3]); o.z = pkbf(yr[4], yr[5]); o.w = pkbf(yr[6], yr[7]);
              *(u32x4*)(Yz + crow_ * 1024 + hh * 64 + d0) = o; }
            __syncthreads();
        }
#undef RW_ROWOF
    }
}
__device__ __forceinline__ void rwkv_out(const RwArgs& A, const float* ln_w, const float* ln_b, bf16_t* OG, int G, int bid) {
    const int tid_ = opaque_tid(); const int lane = tid_ & 63, wid = tid_ >> 6; const int c0 = lane * 16, head = lane >> 2;
    for (int row = bid * 8 + wid; row < TT; row += G * 8) {
        const bool lat = row < TL; const int L = lat ? 4096 : 256; const int n = lat ? (row & 4095) : ((row - TL) & 255); const bool hm = n > 0, hp = n < L - 1;
        float y[16], vv[16];
        { const u32x4 a0 = *(const u32x4*)(A.Y0 + (size_t)row * 1024 + c0), a1 = *(const u32x4*)(A.Y0 + (size_t)row * 1024 + c0 + 8);
          const u32x4 b0 = *(const u32x4*)(A.Y1 + (size_t)row * 1024 + c0), b1 = *(const u32x4*)(A.Y1 + (size_t)row * 1024 + c0 + 8);
#pragma unroll
          for (int i = 0; i < 4; ++i) { y[2 * i] = bflo(a0[i]) + bflo(b0[i]); y[2 * i + 1] = bfhi(a0[i]) + bfhi(b0[i]); y[8 + 2 * i] = bflo(a1[i]) + bflo(b1[i]); y[8 + 2 * i + 1] = bfhi(a1[i]) + bfhi(b1[i]); } }
        float s1 = 0.f;
#pragma unroll
        for (int i = 0; i < 16; ++i) s1 += y[i];
        s1 += __shfl_xor(s1, 1); s1 += __shfl_xor(s1, 2); const float mean = s1 * (1.f / 64.f);
        float s2 = 0.f;
#pragma unroll
        for (int i = 0; i < 16; ++i) { y[i] -= mean; s2 += y[i] * y[i]; }
        s2 += __shfl_xor(s2, 1); s2 += __shfl_xor(s2, 2); const float rstd = rsqrtf(s2 * (1.f / 64.f) + 64e-5f);
        sh8(A.P, (size_t)row, 2048 + c0, hm, hp, A.mu, vv); sh8(A.P, (size_t)row, 2048 + c0 + 8, hm, hp, A.mu, vv + 8);
        const float bz = 0.5f * (A.BZ[(size_t)row * 16 + head] + A.BZ[((size_t)TT + row) * 16 + head]);
        const u32x4 z0 = *(const u32x4*)(A.P + (size_t)row * RWN + 3328 + c0), z1 = *(const u32x4*)(A.P + (size_t)row * RWN + 3328 + c0 + 8);
        float ov[16];
#pragma unroll
        for (int i = 0; i < 16; ++i) { const unsigned zw = (i < 8) ? z0[(i >> 1) & 3] : z1[(i >> 1) & 3]; const float zz = (i & 1) ? bfhi(zw) : bflo(zw);
            ov[i] = (y[i] * rstd * ln_w[c0 + i] + ln_b[c0 + i] + bz * vv[i]) * silu_f(zz); }
        u32x4 o0, o1; o0.x = pkbf(ov[0], ov[1]); o0.y = pkbf(ov[2], ov[3]); o0.z = pkbf(ov[4], ov[5]); o0.w = pkbf(ov[6], ov[7]);
        o1.x = pkbf(ov[8], ov[9]); o1.y = pkbf(ov[10], ov[11]); o1.z = pkbf(ov[12], ov[13]); o1.w = pkbf(ov[14], ov[15]);
        *(u32x4*)(OG + (size_t)row * 1024 + c0) = o0; *(u32x4*)(OG + (size_t)row * 1024 + c0 + 8) = o1;
    }
}
#ifdef SKIP_GEMM
#define GEMM_PHASE(EPI, AP, BP, MM, NN, KK, EOBJ) do { (void)EOBJ; } while (0)
#else
#define GEMM_PHASE(EPI, AP, BP, MM, NN, KK, EOBJ) do { pg8::Gemm g_{(const bf16_t*)(AP), (const bf16_t*)(BP), (MM), (NN), (KK)}; pg8::StaticOrder S_; S_.init((MM), (NN), G, bid); \
    pg8::gemm_phase<EPI, pg8::StaticOrder, true, true>((PG8_LAS unsigned char*)lds, g_, S_, EOBJ); } while (0)
#endif
#ifdef SKIP_EpiAttnIn
#define GEMM_PHASE_EpiAttnIn(EPI, AP, BP, MM, NN, KK, EOBJ) do { (void)EOBJ; } while (0)
#else
#define GEMM_PHASE_EpiAttnIn GEMM_PHASE
#endif
#ifdef SKIP_EpiFnT
#define GEMM_PHASE_EpiFnT(EPI, AP, BP, MM, NN, KK, EOBJ) do { (void)EOBJ; } while (0)
#else
#define GEMM_PHASE_EpiFnT GEMM_PHASE
#endif
#ifdef SKIP_EpiPlain
#define GEMM_PHASE_EpiPlain(EPI, AP, BP, MM, NN, KK, EOBJ) do { (void)EOBJ; } while (0)
#else
#define GEMM_PHASE_EpiPlain GEMM_PHASE
#endif
#ifdef SKIP_EpiDft
#define GEMM_PHASE_EpiDft(EPI, AP, BP, MM, NN, KK, EOBJ) do { (void)EOBJ; } while (0)
#else
#define GEMM_PHASE_EpiDft GEMM_PHASE
#endif
#ifdef SKIP_EpiResid
#define GEMM_PHASE_EpiResid(EPI, AP, BP, MM, NN, KK, EOBJ) do { (void)EOBJ; } while (0)
#else
#define GEMM_PHASE_EpiResid GEMM_PHASE
#endif
#define XB_TMO      128
#define XB_XCNT(j)  (256  + 64 * (j))
#define XB_XSUB(j)  (1280 + 64 * (j))
#define XB_XGEN(j)  (2304 + 64 * (j))
#define XB_TOP      3328
#define XB_TOPGEN   3392
#define XCD_BAR_WORDS 3456
#define XB_SPIN_CAP (1u << 18)

__device__ __forceinline__ unsigned xb_ld(unsigned* p)              { return __hip_atomic_load(p, __ATOMIC_RELAXED, __HIP_MEMORY_SCOPE_AGENT); }
__device__ __forceinline__ unsigned xb_add(unsigned* p, unsigned v) { return __hip_atomic_fetch_add(p, v, __ATOMIC_RELAXED, __HIP_MEMORY_SCOPE_AGENT); }
__device__ __forceinline__ unsigned xb_xcc_id() { return (unsigned)__builtin_amdgcn_s_getreg((3 << 11) | 20) & 0xFu; }
#define XB_SPIN(cond, bar) do { unsigned _sp = 0; while (cond) { __builtin_amdgcn_s_sleep(1); \
    if ((++_sp & 255u) == 0u) { if (xb_ld(&(bar)[XB_TMO])) break; if (_sp > XB_SPIN_CAP) { atomicAdd(&(bar)[XB_TMO], 1u); break; } } } } while (0)

struct XcdBarrier {
    unsigned* bar; unsigned x;
    volatile LAS unsigned* st;
};

__device__ __forceinline__ XcdBarrier xcd_barrier_post(unsigned* bar, volatile LAS unsigned* st) {
    XcdBarrier b; b.bar = bar; b.x = xb_xcc_id(); b.st = st;
    if (threadIdx.x == 0) (void)xb_add(&bar[XB_XCNT(b.x)], 1u);
    return b;
}
__device__ __forceinline__ void xcd_barrier_complete(unsigned* bar, unsigned x, unsigned& nloc, unsigned& nx) {
    const unsigned G = gridDim.x * gridDim.y * gridDim.z;
    unsigned sum, cnt, mine, sp = 0u;
    for (;;) {
        sum = 0u; cnt = 0u; mine = 0u;
#pragma unroll
        for (unsigned j = 0; j < 16; ++j) { const unsigned c = xb_ld(&bar[XB_XCNT(j)]); sum += c; cnt += (c > 0u) ? 1u : 0u; mine = (j == x) ? c : mine; }
        if (sum == G) break;
        __builtin_amdgcn_s_sleep(1);
        if ((++sp & 255u) == 0u) { if (xb_ld(&bar[XB_TMO])) break; if (sp > XB_SPIN_CAP) { atomicAdd(&bar[XB_TMO], 1u); break; } }
    }
    nloc = mine > 0u ? mine : 1u; nx = cnt > 0u ? cnt : 1u;
}

__device__ __forceinline__ void xcd_barrier(const XcdBarrier& b) {
    asm volatile("s_waitcnt vmcnt(0)" ::: "memory");
    __syncthreads();
    if (threadIdx.x == 0) {
        unsigned* bar = b.bar;
        __builtin_amdgcn_s_waitcnt(0);
        unsigned nloc = b.st[0], nx = b.st[1];
        if (nloc == 0u) { xcd_barrier_complete(bar, b.x, nloc, nx); b.st[0] = nloc; b.st[1] = nx; }
        const unsigned old = xb_add(&bar[XB_XSUB(b.x)], 1u);
        const unsigned gen = old / nloc;
        if (old + 1u == (gen + 1u) * nloc) {
            __builtin_amdgcn_fence(__ATOMIC_RELEASE, "agent");
            asm volatile("s_waitcnt vmcnt(0)" ::: "memory");
            const unsigned og = xb_add(&bar[XB_TOP], 1u);
            const unsigned tg = og / nx;
            if (og + 1u == (tg + 1u) * nx) xb_add(&bar[XB_TOPGEN], 1u);
            else XB_SPIN(xb_ld(&bar[XB_TOPGEN]) == tg, bar);
            __builtin_amdgcn_fence(__ATOMIC_ACQUIRE, "agent");
            xb_add(&bar[XB_XGEN(b.x)], 1u);
            asm volatile("s_waitcnt vmcnt(0)" ::: "memory");
        } else {
            XB_SPIN(xb_ld(&bar[XB_XGEN(b.x)]) == gen, bar);
            __builtin_amdgcn_fence(__ATOMIC_ACQUIRE, "agent");
            asm volatile("s_waitcnt vmcnt(0)" ::: "memory");
        }
    }
    __syncthreads();
}

#define GRID_SYNC() xcd_barrier(xbar)
template <int layer> __device__ __forceinline__ void layer_body(const Params& p, LAS char* lds, const XcdBarrier& xbar, int G, int bid) {
    unsigned char* ws = p.ws;
    float* mod = (float*)(ws + WS_MOD);
    const float* ropeC = (const float*)(ws + WS_ROPE); const float* ropeS = ropeC + 1024;
    bf16_t* Hb = (bf16_t*)(ws + WS_HB);
    float* XC = (float*)(ws + WS_XC);
    const float* x_in = p.in[0]; const float* ctx_in = p.in[2];
        const float* xl = layer == 0 ? x_in : p.out; const float* xc = layer == 0 ? ctx_in : XC;
        const float* modl = mod + (size_t)layer * 9 * 3072;
        ph_phase(xl, xc, p.in[4] + layer * 1024, modl, Hb, G, bid);
        GRID_SYNC();
        const int Mout = (layer == 3) ? TL : TT;
        const bf16_t* Wout;
        if constexpr (layer == 0 || layer == 3) {
            const int j = layer == 0 ? 0 : 1;
            pg8::EpiAttnIn E{(bf16_t*)(ws + WS_Q), (bf16_t*)(ws + WS_K), (bf16_t*)(ws + WS_V), (bf16_t*)(ws + WS_Z), ropeC, ropeS};
            GEMM_PHASE_EpiAttnIn(pg8::EpiAttnIn, Hb, ws + WS_WDAIN + (size_t)j * 8 * MiB, TT, 4096, 1024, E);
#ifdef PROBE_GIN2
            GEMM_PHASE_EpiAttnIn(pg8::EpiAttnIn, Hb, ws + WS_WDAIN + (size_t)j * 8 * MiB, TT, 4096, 1024, E);
#endif
            GRID_SYNC();
            float lam;
            { const int lane = opaque_tid() & 63; const float* lq = p.in[9] + j * 128; const float* lk = p.in[10] + j * 128;
              const float s0 = wave_sum(lq[lane] * lk[lane]), s1 = wave_sum(lq[64 + lane] * lk[64 + lane]);
              const float li = 0.8f - 0.6f * expf(-0.3f * (float)layer); lam = expf(s0) - expf(s1) + li;
              att::Args A{(const bf16_t*)(ws + WS_Q), (const bf16_t*)(ws + WS_K), (const bf16_t*)(ws + WS_V), (const bf16_t*)(ws + WS_Z), Hb, p.in[11] + j * 128, lam, 1.f - li, layer == 3 ? 1024 : 1088, (unsigned*)(ws + WS_Y1) + (size_t)bid * 8 * 2048};
#ifndef SKIP_ATT
              att::attn_phase(A, lds, G, bid);
#endif
#ifdef PROBE_ATT2
              att::attn_phase(A, lds, G, bid);
#endif
            }
            GRID_SYNC();
            Wout = (const bf16_t*)(ws + WS_WDAOUT + (size_t)j * 2 * MiB);
        } else if constexpr (layer == 1) {
            { pg8::EpiFnT E{(bf16_t*)(ws + WS_ATL), (bf16_t*)(ws + WS_ATC)};
              GEMM_PHASE_EpiFnT(pg8::EpiFnT, ws + WS_WFNT, Hb, 2048, TT, 1024, E); }
            { pg8::EpiPlain E{(bf16_t*)(ws + WS_ZB), 1024};
              GEMM_PHASE_EpiPlain(pg8::EpiPlain, Hb, ws + WS_WFNZ, TT, 1024, 1024, E); }
            GRID_SYNC();
            fnet_fold((const bf16_t*)(ws + WS_ATL), (bf16_t*)(ws + WS_FOLD), (bf16_t*)(ws + WS_FOLD + 32 * MiB), (float*)(ws + WS_BZ), (const bf16_t*)(ws + WS_ZB), Hb, G, bid);
            GRID_SYNC();
            { pg8::EpiPlain E{(bf16_t*)(ws + WS_ATL), 8192};
              GEMM_PHASE_EpiPlain(pg8::EpiPlain, ws + WS_DFTL, ws + WS_FOLD, 2048, 8192, 2048, E); }
            GRID_SYNC();
            { pg8::EpiDftSym E{(const bf16_t*)(ws + WS_ATL), (const float*)(ws + WS_BZ), (const bf16_t*)(ws + WS_ZB), Hb};
              GEMM_PHASE(pg8::EpiDftSym, ws + WS_DFTL + 8 * MiB, ws + WS_FOLD + 32 * MiB, 2048, 8192, 2048, E); }
            { pg8::EpiDft E{(const bf16_t*)(ws + WS_ZB), Hb, TL, 256};
              GEMM_PHASE_EpiDft(pg8::EpiDft, ws + WS_DFTC, ws + WS_ATC, 256, 8192, 512, E); }
            GRID_SYNC();
            Wout = (const bf16_t*)(ws + WS_WFNOUT);
        } else {
            { pg8::EpiPlain E{(bf16_t*)(ws + WS_P), RWN};
              GEMM_PHASE_EpiPlain(pg8::EpiPlain, Hb, ws + WS_WRWIN, TT, RWN, 1024, E); }
            GRID_SYNC();
            RwArgs A{(const bf16_t*)(ws + WS_P), Hb, (bf16_t*)(ws + WS_Y1), (float*)(ws + WS_BZ), p.in[17], p.in[18], p.in[19], p.in[20], p.in[21], p.in[22], p.in[23], p.in[24]};
#ifndef SKIP_SCAN
            rwkv_scan(A, lds, G, bid);
#endif
#ifdef PROBE_SCAN2
            rwkv_scan(A, lds, G, bid);
#endif
            GRID_SYNC();
#ifndef SKIP_RWOUT
            rwkv_out(A, p.in[25], p.in[26], Hb, G, bid);
#endif
            GRID_SYNC();
            Wout = (const bf16_t*)(ws + WS_WRWOUT);
        }
        { pg8::EpiResid E{xl, xc, p.out, XC, modl + 2048};
          GEMM_PHASE_EpiResid(pg8::EpiResid, Hb, Wout, Mout, 1024, 1024, E); }
        GRID_SYNC();
    }
__global__ void __launch_bounds__(512, 2) fwd_megakernel(Params p) {
    extern __shared__ __attribute__((aligned(16))) unsigned char lds_raw[];
    LAS char* lds = (LAS char*)lds_raw;
    cg::grid_group grid = cg::this_grid();
    const int G = gridDim.x, bid = blockIdx.x;
    volatile LAS unsigned* xst = (volatile LAS unsigned*)(lds + LDS_BYTES - 256);
    if (threadIdx.x < 2) xst[threadIdx.x] = 0u;
    __syncthreads();
    const XcdBarrier xbar = xcd_barrier_post((unsigned*)(p.ws + WS_CTL), xst);

#ifndef SKIP_PRO
    prologue(p, lds, G, bid);
#endif
#ifdef PROBE_PRO2
    __syncthreads(); prologue(p, lds, G, bid);
#endif
    grid.sync();
    layer_body<0>(p, lds, xbar, G, bid);
    layer_body<1>(p, lds, xbar, G, bid);
    layer_body<2>(p, lds, xbar, G, bid);
    layer_body<3>(p, lds, xbar, G, bid);
    final_phase(p.out, p.in[7], G, bid);
}

extern "C" void kernel_launch(void* const* d_in, const int* in_sizes, int n_in, void* d_out, int out_size, void* d_ws, size_t ws_size, hipStream_t stream) {
    static int grid = 0;
    if (grid == 0) {
        if (n_in != 28 || out_size != TL * 1024 || ws_size < WS_END) { fprintf(stderr, "kernel_launch: unexpected shapes: n_in %d out %d ws %zu\n", n_in, out_size, ws_size); grid = -1; return; }
        int dev = 0, cus = 0, per_cu = 0;
        hipGetDevice(&dev); hipDeviceGetAttribute(&cus, hipDeviceAttributeMultiprocessorCount, dev);
        if (hipFuncSetAttribute((const void*)fwd_megakernel, hipFuncAttributeMaxDynamicSharedMemorySize, LDS_BYTES) != hipSuccess) { fprintf(stderr, "kernel_launch: hipFuncSetAttribute failed\n"); grid = -1; return; }
        if (hipOccupancyMaxActiveBlocksPerMultiprocessor(&per_cu, (const void*)fwd_megakernel, 512, LDS_BYTES) != hipSuccess || per_cu < 1) { fprintf(stderr, "kernel_launch: occupancy query failed (%d)\n", per_cu); per_cu = 1; }
        (void)hipGetLastError();
        grid = cus * per_cu;
    }
    if (grid < 0) return;
    if (hipMemsetAsync((char*)d_ws + WS_CTL, 0, 65536, stream) != hipSuccess) { fprintf(stderr, "kernel_launch: hipMemsetAsync failed\n"); return; }
    Params p{};
    for (int i = 0; i < 28; ++i) p.in[i] = (const float*)d_in[i];
    p.out = (float*)d_out; p.ws = (unsigned char*)d_ws;
    void* args[] = {&p};
    hipError_t e = hipLaunchCooperativeKernel((const void*)fwd_megakernel, dim3(grid), dim3(512), args, LDS_BYTES, stream);
    if (e != hipSuccess) fprintf(stderr, "cooperative launch failed: %s (grid %d)\n", hipGetErrorString(e), grid);
}
```

```cpp
#include <hip/hip_runtime.h>
#include <hip/hip_cooperative_groups.h>
#include <cstdio>
#include <cstdint>
#include <cmath>
namespace cg = cooperative_groups;

constexpr int TL = 32768, TCX = 2048, TT = TL + TCX, DM = 1024;
constexpr float QK_C2 = 0.125f * 1.4426950408889634f;
typedef float f32x2_t __attribute__((ext_vector_type(2)));
typedef __bf16 bf16x2_t __attribute__((ext_vector_type(2)));
__device__ __forceinline__ unsigned pkbf(float lo, float hi) { f32x2_t v = {lo, hi}; bf16x2_t b = __builtin_convertvector(v, bf16x2_t); return __builtin_bit_cast(unsigned, b); }
__device__ __forceinline__ float bflo(unsigned u) { return __uint_as_float(u << 16); }
__device__ __forceinline__ float bfhi(unsigned u) { return __uint_as_float(u & 0xffff0000u); }
__device__ __forceinline__ float bf1(unsigned short u) { return __uint_as_float(((unsigned)u) << 16); }
__device__ __forceinline__ float silu_f(float z) { return z * __builtin_amdgcn_rcpf(1.f + __expf(-z)); }
__device__ __forceinline__ int opaque_tid() { int t = threadIdx.x; asm volatile("" : "+v"(t)); return t; }
namespace pg8 {
#define PG8_LAS __attribute__((address_space(3)))
typedef unsigned short bf16_t;
typedef short bf16x8 __attribute__((ext_vector_type(8)));
typedef float f32x4 __attribute__((ext_vector_type(4)));
typedef unsigned u32x4 __attribute__((ext_vector_type(4)));
constexpr int BM = 256, BK = 64, HALF = 128, HTB = HALF * BK * 2  , STAGE_BYTES = 8 * HTB, NXCD = 8, WGM = 8;

__host__ __device__ __forceinline__ int lds_byte(int r, int c) { const int st = (r >> 4) * 2 + (c >> 5), rr = r & 15, cc = c & 31, ob = rr * 64 + cc * 2; return st * 1024 + (ob ^ (((ob >> 9) & 1) << 5)); }
__host__ __device__ __forceinline__ void stage_rc(int b, int& R, int& C) { const int st = b / 1024, sb = b % 1024, swz = sb ^ (((sb >> 9) & 1) << 5); R = (st >> 1) * 16 + swz / 64; C = (st & 1) * 32 + (swz % 64) / 2; }
__host__ __device__ __forceinline__ int perm32(int rho) { const int n = rho >> 4, i = rho & 15; return 8 * (i >> 2) + 4 * n + (i & 3); }

struct Unit { int pm, pn; };
struct Gemm { const bf16_t* A; const bf16_t* Bt; int M, N, K; };

struct StaticOrder {
    int nM, nN, nwg, G, c;
    __host__ __device__ void init(int M, int N, int G_, int c_) { nM = M / BM; nN = N / BM; nwg = nM * nN; G = G_; c = c_; }
    __host__ __device__ bool next(int i, Unit& u) const {
        const long L = (long)i * G + c; if (L >= nwg) return false;
        int wgid = (int)L; { const int q = nwg / NXCD, r = nwg % NXCD, xcd = wgid % NXCD, off = wgid / NXCD; wgid = (xcd < r ? xcd * (q + 1) : r * (q + 1) + (xcd - r) * q) + off; }
        const int nig = WGM * nN, gid = wgid / nig, fm = gid * WGM, gsz = (nM - fm) < WGM ? (nM - fm) : WGM;
        u.pm = fm + ((wgid % nig) % gsz); u.pn = (wgid % nig) / gsz; return true;
    }
    __device__ __forceinline__ void a_ready(const Unit&) const {}
    __device__ __forceinline__ void done(const Unit&) const {}
};

struct EpiAttnIn {
    static constexpr bool PERM = true, AFTER_DRAIN = false;
    bf16_t* Q; bf16_t* Kb; bf16_t* V; bf16_t* Z; const float* ropeC; const float* ropeS;
    __device__ __forceinline__ void operator()(const f32x4 (&acc)[2][2][4][2], const Unit& u, int wr, int wc, int fr, int fq) const {
        const int sect = u.pn >> 2;
        bf16_t* base = sect == 0 ? Q : sect == 1 ? Kb : sect == 2 ? V : Z;
        const int colt = (u.pn & 3) * 256 + wc * 32 + 8 * fq;
        const int row0 = u.pm * BM + wr * 64 + fr;
        const bool rope = (u.pm < 128) && (sect < 2);
        const float sc = (sect == 0) ? QK_C2 : 1.f;
        const int axis = wc & 1;
#pragma unroll
        for (int ai = 0; ai < 2; ++ai)
#pragma unroll
            for (int m = 0; m < 4; ++m) {
                const int row = row0 + ai * HALF + m * 16;
                const int ntok = row & 4095;
                const int pos = axis ? (ntok & 63) : (ntok >> 6);
                bf16_t* rowp;
                if (sect == 1) rowp = base + (size_t)(row >> 6) * 65536 + (size_t)(colt >> 3) * 512 + (row & 63) * 8;
                else if (sect == 2) rowp = base + (size_t)(row >> 6) * 65536 + (size_t)(colt >> 7) * 8192 + (((colt & 127) >> 5) * 4 + ((row & 63) >> 4)) * 512 + (row & 15) * 32 + (colt & 31);
                else rowp = base + (size_t)row * 1024 + colt;
#pragma unroll
                for (int bj = 0; bj < 2; ++bj) {
                    f32x4 v0 = acc[ai][bj][m][0], v1 = acc[ai][bj][m][1];
                    if (rope) {
                        const f32x4 c0 = *(const f32x4*)(ropeC + pos * 16 + 8 * (fq & 1)), c1 = *(const f32x4*)(ropeC + pos * 16 + 8 * (fq & 1) + 4);
                        const f32x4 s0 = *(const f32x4*)(ropeS + pos * 16 + 8 * (fq & 1)), s1 = *(const f32x4*)(ropeS + pos * 16 + 8 * (fq & 1) + 4);
                        f32x4 p0, p1;
#pragma unroll
                        for (int i = 0; i < 4; ++i) { p0[i] = __shfl_xor(v0[i], 32); p1[i] = __shfl_xor(v1[i], 32); }
                        if (fq < 2) { v0 = v0 * c0 - p0 * s0; v1 = v1 * c1 - p1 * s1; }
                        else        { v0 = v0 * c0 + p0 * s0; v1 = v1 * c1 + p1 * s1; }
                    }
                    v0 = v0 * sc; v1 = v1 * sc;
                    u32x4 w; w.x = pkbf(v0[0], v0[1]); w.y = pkbf(v0[2], v0[3]); w.z = pkbf(v1[0], v1[1]); w.w = pkbf(v1[2], v1[3]);
                    *(u32x4*)(rowp + (sect == 1 || sect == 2 ? bj * 8192 : bj * HALF)) = w;
                }
            }
    }
};
struct EpiPlain {
    static constexpr bool PERM = true, AFTER_DRAIN = false;
    bf16_t* O; int ldc;
    __device__ __forceinline__ void operator()(const f32x4 (&acc)[2][2][4][2], const Unit& u, int wr, int wc, int fr, int fq) const {
        const int row0 = u.pm * BM + wr * 64 + fr, col0 = u.pn * BM + wc * 32 + 8 * fq;
#pragma unroll
        for (int ai = 0; ai < 2; ++ai)
#pragma unroll
            for (int m = 0; m < 4; ++m) { bf16_t* rowp = O + (size_t)(row0 + ai * HALF + m * 16) * ldc + col0;
#pragma unroll
                for (int bj = 0; bj < 2; ++bj) { const f32x4 v0 = acc[ai][bj][m][0], v1 = acc[ai][bj][m][1];
                    u32x4 w; w.x = pkbf(v0[0], v0[1]); w.y = pkbf(v0[2], v0[3]); w.z = pkbf(v1[0], v1[1]); w.w = pkbf(v1[2], v1[3]);
                    *(u32x4*)(rowp + bj * HALF) = w; } }
    }
};
struct EpiResid {
    static constexpr bool PERM = false, AFTER_DRAIN = false;
    const float* xin_lat; const float* xin_ctx; float* xout_lat; float* xout_ctx; const float* gate;
    __device__ __forceinline__ void operator()(const f32x4 (&acc)[2][2][4][2], const Unit& u, int wr, int wc, int fr, int fq) const {
        const int rowt = u.pm * BM; const bool lat = rowt < TL; const int r = lat ? (rowt >> 12) : 8;
        const int row0 = rowt + wr * 64 + fr, col0 = u.pn * BM + wc * 32 + 4 * fq;
        const float* xi = lat ? xin_lat + (size_t)row0 * 1024 + col0 : xin_ctx + (size_t)(row0 - TL) * 1024 + col0;
        float* xo = lat ? xout_lat + (size_t)row0 * 1024 + col0 : xout_ctx + (size_t)(row0 - TL) * 1024 + col0;
        f32x4 g[2][2];
#pragma unroll
        for (int bj = 0; bj < 2; ++bj)
#pragma unroll
            for (int n = 0; n < 2; ++n) g[bj][n] = *(const f32x4*)(gate + r * 3072 + col0 + bj * HALF + n * 16);
#pragma unroll
        for (int ai = 0; ai < 2; ++ai) {
            f32x4 pre[4][2][2];
#pragma unroll
            for (int m = 0; m < 4; ++m)
#pragma unroll
                for (int bj = 0; bj < 2; ++bj)
#pragma unroll
                    for (int n = 0; n < 2; ++n) pre[m][bj][n] = *(const f32x4*)(xi + (size_t)(ai * HALF + m * 16) * 1024 + bj * HALF + n * 16);
            asm volatile("" ::: "memory");
#pragma unroll
            for (int m = 0; m < 4; ++m)
#pragma unroll
                for (int bj = 0; bj < 2; ++bj)
#pragma unroll
                    for (int n = 0; n < 2; ++n) *(f32x4*)(xo + (size_t)(ai * HALF + m * 16) * 1024 + bj * HALF + n * 16) = pre[m][bj][n] + g[bj][n] * acc[ai][bj][m][n];
            asm volatile("" ::: "memory");
        }
    }
};
struct EpiFnT {
    static constexpr bool PERM = true, AFTER_DRAIN = false;
    bf16_t* ATL; bf16_t* ATC;
    __device__ __forceinline__ void operator()(const f32x4 (&acc)[2][2][4][2], const Unit& u, int wr, int wc, int fr, int fq) const {
        const int row0 = u.pm * BM + wr * 64 + fr, col0 = u.pn * BM + wc * 32 + 8 * fq;
#pragma unroll
        for (int ai = 0; ai < 2; ++ai)
#pragma unroll
            for (int m = 0; m < 4; ++m) { const int mp = row0 + ai * HALF + m * 16, cs = mp >> 10, n = mp & 1023;
#pragma unroll
                for (int bj = 0; bj < 2; ++bj) { const int t0 = col0 + bj * HALF; bf16_t* dst;
                    if (t0 < TL) { const int b = t0 >> 12, l = t0 & 4095; dst = ATL + ((size_t)((b * 1024 + n) * 2 + cs)) * 4096 + l; }
                    else { const int tc = t0 - TL, b = tc >> 8, l = tc & 255; dst = ATC + ((size_t)((b * 1024 + n) * 2 + cs)) * 256 + l; }
                    const f32x4 v0 = acc[ai][bj][m][0], v1 = acc[ai][bj][m][1];
                    u32x4 w; w.x = pkbf(v0[0], v0[1]); w.y = pkbf(v0[2], v0[3]); w.z = pkbf(v1[0], v1[1]); w.w = pkbf(v1[2], v1[3]);
                    *(u32x4*)dst = w; } }
    }
};
struct EpiDft {
    static constexpr bool PERM = true, AFTER_DRAIN = false;
    const bf16_t* Z; bf16_t* OG; int rowbase; int L;
    __device__ __forceinline__ void operator()(const f32x4 (&acc)[2][2][4][2], const Unit& u, int wr, int wc, int fr, int fq) const {
        const int k0 = u.pm * BM + wr * 64 + fr; const int b = u.pn >> 2; const int n0 = (u.pn & 3) * 256 + wc * 32 + 8 * fq;
#pragma unroll
        for (int ai = 0; ai < 2; ++ai)
#pragma unroll
            for (int m = 0; m < 4; ++m) { const size_t R = (size_t)(rowbase + b * L + k0 + ai * HALF + m * 16);
#pragma unroll
                for (int bj = 0; bj < 2; ++bj) { const size_t off = R * 1024 + n0 + bj * HALF;
                    const u32x4 zz = *(const u32x4*)(Z + off);
                    const f32x4 v0 = acc[ai][bj][m][0], v1 = acc[ai][bj][m][1];
                    u32x4 w;
                    w.x = pkbf(v0[0] * silu_f(bflo(zz.x)), v0[1] * silu_f(bfhi(zz.x))); w.y = pkbf(v0[2] * silu_f(bflo(zz.y)), v0[3] * silu_f(bfhi(zz.y)));
                    w.z = pkbf(v1[0] * silu_f(bflo(zz.z)), v1[1] * silu_f(bfhi(zz.z))); w.w = pkbf(v1[2] * silu_f(bflo(zz.w)), v1[3] * silu_f(bfhi(zz.w)));
                    *(u32x4*)(OG + off) = w; } }
    }
};
struct EpiDftSym {
    static constexpr bool PERM = true, AFTER_DRAIN = false;
    const bf16_t* Pb; const float* TA; const bf16_t* Z; bf16_t* OG;
    __device__ __forceinline__ void operator()(const f32x4 (&acc)[2][2][4][2], const Unit& u, int wr, int wc, int fr, int fq) const {
        const int k0 = u.pm * BM + wr * 64 + fr; const int b = u.pn >> 2; const int c0 = u.pn * BM + wc * 32 + 8 * fq; const int n0 = c0 & 1023;
#pragma unroll
        for (int bj = 0; bj < 2; ++bj) {
            const f32x4 t0 = *(const f32x4*)(TA + c0 + bj * HALF), t1 = *(const f32x4*)(TA + c0 + bj * HALF + 4);
#pragma unroll
            for (int ai = 0; ai < 2; ++ai)
#pragma unroll
                for (int m = 0; m < 4; ++m) { const int k = k0 + ai * HALF + m * 16; const float sg = (k & 1) ? -1.f : 1.f;
                    const u32x4 pp = *(const u32x4*)(Pb + (size_t)k * 8192 + c0 + bj * HALF);
                    const f32x4 q0 = acc[ai][bj][m][0], q1 = acc[ai][bj][m][1];
                    float pt[8];
                    pt[0] = bflo(pp.x) + sg * t0[0]; pt[1] = bfhi(pp.x) + sg * t0[1]; pt[2] = bflo(pp.y) + sg * t0[2]; pt[3] = bfhi(pp.y) + sg * t0[3];
                    pt[4] = bflo(pp.z) + sg * t1[0]; pt[5] = bfhi(pp.z) + sg * t1[1]; pt[6] = bflo(pp.w) + sg * t1[2]; pt[7] = bfhi(pp.w) + sg * t1[3];
                    { const size_t off = (size_t)(b * 4096 + k) * 1024 + n0 + bj * HALF; const u32x4 zz = *(const u32x4*)(Z + off); u32x4 w;
                      w.x = pkbf((pt[0] - q0[0]) * silu_f(bflo(zz.x)), (pt[1] - q0[1]) * silu_f(bfhi(zz.x))); w.y = pkbf((pt[2] - q0[2]) * silu_f(bflo(zz.y)), (pt[3] - q0[3]) * silu_f(bfhi(zz.y)));
                      w.z = pkbf((pt[4] - q1[0]) * silu_f(bflo(zz.z)), (pt[5] - q1[1]) * silu_f(bfhi(zz.z))); w.w = pkbf((pt[6] - q1[2]) * silu_f(bflo(zz.w)), (pt[7] - q1[3]) * silu_f(bfhi(zz.w)));
                      *(u32x4*)(OG + off) = w; }
                    if (k >= 1) { const size_t off = (size_t)(b * 4096 + 4096 - k) * 1024 + n0 + bj * HALF; const u32x4 zz = *(const u32x4*)(Z + off); u32x4 w;
                      w.x = pkbf((pt[0] + q0[0]) * silu_f(bflo(zz.x)), (pt[1] + q0[1]) * silu_f(bfhi(zz.x))); w.y = pkbf((pt[2] + q0[2]) * silu_f(bflo(zz.y)), (pt[3] + q0[3]) * silu_f(bfhi(zz.y)));
                      w.z = pkbf((pt[4] + q1[0]) * silu_f(bflo(zz.z)), (pt[5] + q1[1]) * silu_f(bfhi(zz.z))); w.w = pkbf((pt[6] + q1[2]) * silu_f(bflo(zz.w)), (pt[7] + q1[3]) * silu_f(bfhi(zz.w)));
                      *(u32x4*)(OG + off) = w; }
                    asm volatile("" ::: "memory");
                }
        }
    }
};
template <class Epi, class Sched, bool ALIGN_EPI = false, bool SP2 = false>
__device__ __forceinline__ void gemm_phase(PG8_LAS unsigned char* lds, const Gemm g, const Sched& S, const Epi& E) {
    const int tid = opaque_tid(), wid = __builtin_amdgcn_readfirstlane(tid >> 6), lane = tid & 63, wr = wid >> 2, wc = wid & 3, fr = lane & 15, fq = lane >> 4;
    const int K = g.K, nt = K / BK;
    unsigned voffA[2], voffB[2];
#pragma unroll
    for (int i = 0; i < 2; ++i) { int R, C; stage_rc(tid * 16 + i * 8192, R, C); const int Rb = Epi::PERM ? ((R & ~31) + perm32(R & 31)) : R;
        voffA[i] = (unsigned)(R * K + C) * 2u; voffB[i] = (unsigned)(Rb * K + C) * 2u; }
    const size_t kstep = (size_t)(BK * 2);
    const size_t hstep = (size_t)HALF * K * 2;
    const size_t tstep = 2 * hstep;
    const unsigned ldsw = (unsigned)wid * 1024u;
    const int aoff = lds_byte(wr * 64 + fr, fq * 8), boff = lds_byte(wc * 32 + fr, fq * 8);
#define PG8_SA(b, h) (((b) * 2 + (h)) * HTB)
#define PG8_SB(b, h) ((4 + (b) * 2 + (h)) * HTB)
#define PG8_STAGE(bufoff, gbase, voff) do { _Pragma("unroll") for (int _i = 0; _i < 2; ++_i) \
        __builtin_amdgcn_global_load_lds((const unsigned*)((const char*)(gbase) + (voff)[_i]), (PG8_LAS unsigned*)(lds + (bufoff) + ldsw + _i * 8192), 16, 0, 0); } while (0)
#define PG8_LDA(dst, b, h) do { _Pragma("unroll") for (int m = 0; m < 4; ++m) _Pragma("unroll") for (int k = 0; k < 2; ++k) dst[m][k] = *(const PG8_LAS bf16x8*)(lds + PG8_SA(b, h) + aoff + m * 2048 + k * 1024); } while (0)
#define PG8_LDB(dst, b, h) do { _Pragma("unroll") for (int n = 0; n < 2; ++n) _Pragma("unroll") for (int k = 0; k < 2; ++k) dst[n][k] = *(const PG8_LAS bf16x8*)(lds + PG8_SB(b, h) + boff + n * 2048 + k * 1024); } while (0)
#define PG8_MMA(ai, bj, At, Bt) do { __builtin_amdgcn_s_setprio(1); _Pragma("unroll") for (int m = 0; m < 4; ++m) _Pragma("unroll") for (int n = 0; n < 2; ++n) _Pragma("unroll") for (int k = 0; k < 2; ++k) \
        acc[ai][bj][m][n] = __builtin_amdgcn_mfma_f32_16x16x32_bf16(Bt[n][k], At[m][k], acc[ai][bj][m][n], 0, 0, 0); __builtin_amdgcn_s_setprio(0); } while (0)
#define PG8_WAIT_V(n) asm volatile("s_waitcnt vmcnt(" #n ")" ::: "memory")
#define PG8_WAIT_L(n) asm volatile("s_waitcnt lgkmcnt(" #n ")" ::: "memory")
#define PG8_BAR __builtin_amdgcn_s_barrier()
#define PG8_SCHED __builtin_amdgcn_sched_barrier(0)
    Unit cur, nxt; int ui = 0;
    if (!S.next(0, cur)) return;
    f32x4 acc[2][2][4][2];
#pragma unroll
    for (int a = 0; a < 2; ++a)
#pragma unroll
        for (int b = 0; b < 2; ++b)
#pragma unroll
            for (int m = 0; m < 4; ++m)
#pragma unroll
                for (int n = 0; n < 2; ++n) acc[a][b][m][n] = (f32x4){0.f, 0.f, 0.f, 0.f};
    bf16x8 At[4][2], B0[2][2], B1[2][2];
    const char* cA = (const char*)g.A + (size_t)cur.pm * tstep; const char* cB = (const char*)g.Bt + (size_t)cur.pn * tstep;
    S.a_ready(cur);
    if constexpr (SP2) {
        PG8_STAGE(PG8_SB(0, 0), cB, voffB); PG8_STAGE(PG8_SB(0, 1), cB + hstep, voffB); PG8_STAGE(PG8_SA(0, 0), cA, voffA); PG8_STAGE(PG8_SA(0, 1), cA + hstep, voffA);
        if (wr == 1) PG8_BAR;
        PG8_WAIT_V(2); PG8_BAR;
        PG8_STAGE(PG8_SB(1, 0), cB + kstep, voffB); PG8_STAGE(PG8_SA(1, 0), cA + kstep, voffA); PG8_STAGE(PG8_SB(1, 1), cB + hstep + kstep, voffB);
        PG8_WAIT_V(6); PG8_BAR;
    } else {
        PG8_STAGE(PG8_SB(0, 0), cB, voffB); PG8_STAGE(PG8_SA(0, 0), cA, voffA); PG8_STAGE(PG8_SB(0, 1), cB + hstep, voffB); PG8_STAGE(PG8_SA(0, 1), cA + hstep, voffA);
        if (wr == 1) PG8_BAR;
        PG8_WAIT_V(4); PG8_BAR;
        PG8_STAGE(PG8_SB(1, 0), cB + kstep, voffB); PG8_STAGE(PG8_SA(1, 0), cA + kstep, voffA); PG8_STAGE(PG8_SB(1, 1), cB + hstep + kstep, voffB);
        PG8_WAIT_V(6); PG8_BAR;
    }
    for (;;) {
        const bool has_next = S.next(ui + 1, nxt);
        const char* nA = has_next ? (const char*)g.A + (size_t)nxt.pm * tstep : cA; const char* nB = has_next ? (const char*)g.Bt + (size_t)nxt.pn * tstep : cB;
        for (int t = 0; t < nt; t += 2) {
            const bool last = (t == nt - 2);
            const char* a1 = cA + (size_t)(t + 1) * kstep;
            const char* a2 = last ? nA : cA + (size_t)(t + 2) * kstep; const char* b2 = last ? nB : cB + (size_t)(t + 2) * kstep;
            const char* a3 = a2 + kstep; const char* b3 = b2 + kstep;
            if (last && has_next) S.a_ready(nxt);
            if constexpr (SP2) {
            PG8_LDB(B0, 0, 0); PG8_LDB(B1, 0, 1); PG8_SCHED; PG8_LDA(At, 0, 0); PG8_STAGE(PG8_SA(1, 1), a1 + hstep, voffA);
            PG8_WAIT_V(8); PG8_WAIT_L(0); PG8_BAR; PG8_MMA(0, 0, At, B0); PG8_MMA(0, 1, At, B1); PG8_BAR; PG8_SCHED;
            PG8_LDA(At, 0, 1); PG8_STAGE(PG8_SB(0, 0), b2, voffB); PG8_STAGE(PG8_SB(0, 1), b2 + hstep, voffB); PG8_STAGE(PG8_SA(0, 0), a2, voffA);
            PG8_WAIT_V(8); PG8_WAIT_L(0); PG8_BAR; PG8_MMA(1, 0, At, B0); PG8_MMA(1, 1, At, B1); PG8_BAR; PG8_SCHED;
            PG8_LDB(B0, 1, 0); PG8_LDB(B1, 1, 1); PG8_SCHED; PG8_LDA(At, 1, 0); PG8_STAGE(PG8_SA(0, 1), a2 + hstep, voffA);
            PG8_WAIT_V(8); PG8_WAIT_L(0); PG8_BAR; PG8_MMA(0, 0, At, B0); PG8_MMA(0, 1, At, B1); PG8_BAR; PG8_SCHED;
            PG8_LDA(At, 1, 1); PG8_STAGE(PG8_SB(1, 0), b3, voffB); PG8_STAGE(PG8_SB(1, 1), b3 + hstep, voffB); PG8_STAGE(PG8_SA(1, 0), a3, voffA);
            PG8_WAIT_V(8); PG8_WAIT_L(0); PG8_BAR; PG8_MMA(1, 0, At, B0); PG8_MMA(1, 1, At, B1); PG8_BAR; PG8_SCHED;
            } else {
            PG8_LDB(B0, 0, 0); PG8_SCHED; PG8_LDA(At, 0, 0); PG8_STAGE(PG8_SA(1, 1), a1 + hstep, voffA);
            PG8_WAIT_L(8); PG8_BAR; PG8_WAIT_L(0); PG8_MMA(0, 0, At, B0); PG8_BAR; PG8_SCHED;
            PG8_LDB(B1, 0, 1); PG8_STAGE(PG8_SB(0, 0), b2, voffB);
            PG8_BAR; PG8_WAIT_L(0); PG8_MMA(0, 1, At, B1); PG8_BAR;
            PG8_LDA(At, 0, 1); PG8_STAGE(PG8_SA(0, 0), a2, voffA);
            PG8_BAR; PG8_WAIT_L(0); PG8_MMA(1, 0, At, B0); PG8_BAR; PG8_SCHED;
            PG8_STAGE(PG8_SB(0, 1), b2 + hstep, voffB);
            PG8_WAIT_V(6); PG8_BAR; PG8_MMA(1, 1, At, B1); PG8_BAR;
            PG8_LDB(B0, 1, 0); PG8_SCHED; PG8_LDA(At, 1, 0); PG8_STAGE(PG8_SA(0, 1), a2 + hstep, voffA);
            PG8_WAIT_L(8); PG8_BAR; PG8_WAIT_L(0); PG8_MMA(0, 0, At, B0); PG8_BAR; PG8_SCHED;
            PG8_LDB(B1, 1, 1); PG8_STAGE(PG8_SB(1, 0), b3, voffB);
            PG8_BAR; PG8_WAIT_L(0); PG8_MMA(0, 1, At, B1); PG8_BAR;
            PG8_LDA(At, 1, 1); PG8_STAGE(PG8_SA(1, 0), a3, voffA);
            PG8_BAR; PG8_WAIT_L(0); PG8_MMA(1, 0, At, B0); PG8_BAR; PG8_SCHED;
            PG8_STAGE(PG8_SB(1, 1), b3 + hstep, voffB);
            PG8_WAIT_V(6); PG8_BAR; PG8_MMA(1, 1, At, B1); PG8_BAR;
            }
        }
        if constexpr (ALIGN_EPI) { if (wr == 0) PG8_BAR; }
        if constexpr (!Epi::AFTER_DRAIN) { E(acc, cur, wr, wc, fr, fq); S.done(cur); }
        if (!has_next) break;
#pragma unroll
        for (int a = 0; a < 2; ++a)
#pragma unroll
            for (int b = 0; b < 2; ++b)
#pragma unroll
                for (int m = 0; m < 4; ++m)
#pragma unroll
                    for (int n = 0; n < 2; ++n) acc[a][b][m][n] = (f32x4){0.f, 0.f, 0.f, 0.f};
        cur = nxt; cA = nA; cB = nB; ++ui;
        if constexpr (ALIGN_EPI) { if (wr == 1) PG8_BAR; }
    }
    PG8_WAIT_V(0);
    if constexpr (!ALIGN_EPI) { if (wr == 0) PG8_BAR; }
    PG8_BAR;
    if constexpr (Epi::AFTER_DRAIN) { E.fused(acc, cur, wr, wc, fr, fq, lds, wid, lane); S.done(cur); }
#undef PG8_SA
#undef PG8_SB
#undef PG8_STAGE
#undef PG8_LDA
#undef PG8_LDB
#undef PG8_MMA
#undef PG8_WAIT_V
#undef PG8_WAIT_L
#undef PG8_BAR
#undef PG8_SCHED
}
}
#define LAS __attribute__((address_space(3)))
namespace att {
using bf16x8 = __attribute__((ext_vector_type(8))) short;
using s16x4 = __attribute__((ext_vector_type(4))) short;
using f32x16 = __attribute__((ext_vector_type(16))) float;
using u32x4 = __attribute__((ext_vector_type(4))) unsigned;
typedef unsigned short bf16_t;
__device__ __forceinline__ int crow(int r, int hi) { return (r & 3) + 8 * (r >> 2) + 4 * hi; }
constexpr int KSLOT = 8192, VSLOT = 16384, LDS_K = 0, LDS_V = 3 * KSLOT, LDS_WS = LDS_V + 4 * VSLOT, LDS_CNT = LDS_WS + 2048;
struct Args { const bf16_t* Q; const bf16_t* K; const bf16_t* V; const bf16_t* Z; bf16_t* O; const float* gain; float lam; float oml; int n_units; unsigned* o1g; };

__device__ __forceinline__ void qkt(f32x16& p0, f32x16& p1, const LAS char* Kslot, const bf16x8* qr, const f32x16& negm, int r32, int hi) {
    const LAS char* kb = Kslot + hi * 1024 + r32 * 16;
    bf16x8 kf[8];
#pragma unroll
    for (int d0 = 0; d0 < 4; ++d0) { kf[2 * d0] = *(const LAS bf16x8*)(kb + d0 * 2048); kf[2 * d0 + 1] = *(const LAS bf16x8*)(kb + d0 * 2048 + 512); }
    asm volatile("s_waitcnt lgkmcnt(0)" ::: "memory"); __builtin_amdgcn_sched_barrier(0);
    p0 = __builtin_amdgcn_mfma_f32_32x32x16_bf16(kf[0], qr[0], negm, 0, 0, 0); p1 = __builtin_amdgcn_mfma_f32_32x32x16_bf16(kf[1], qr[0], negm, 0, 0, 0);
#pragma unroll
    for (int d0 = 1; d0 < 4; ++d0) { p0 = __builtin_amdgcn_mfma_f32_32x32x16_bf16(kf[2 * d0], qr[d0], p0, 0, 0, 0); p1 = __builtin_amdgcn_mfma_f32_32x32x16_bf16(kf[2 * d0 + 1], qr[d0], p1, 0, 0, 0); }
}
__device__ __forceinline__ void kload(bf16x8* kf, const LAS char* Kslot, int r32, int hi) {
    const LAS char* kb = Kslot + hi * 1024 + r32 * 16;
#pragma unroll
    for (int d0 = 0; d0 < 4; ++d0) { kf[2 * d0] = *(const LAS bf16x8*)(kb + d0 * 2048); kf[2 * d0 + 1] = *(const LAS bf16x8*)(kb + d0 * 2048 + 512); }
}
__device__ __forceinline__ void qk_mm(f32x16& p0, f32x16& p1, const bf16x8* kf, const bf16x8* qr, const f32x16& z) {
    p0 = __builtin_amdgcn_mfma_f32_32x32x16_bf16(kf[0], qr[0], z, 0, 0, 0); p1 = __builtin_amdgcn_mfma_f32_32x32x16_bf16(kf[1], qr[0], z, 0, 0, 0);
#pragma unroll
    for (int d0 = 1; d0 < 4; ++d0) { p0 = __builtin_amdgcn_mfma_f32_32x32x16_bf16(kf[2 * d0], qr[d0], p0, 0, 0, 0); p1 = __builtin_amdgcn_mfma_f32_32x32x16_bf16(kf[2 * d0 + 1], qr[d0], p1, 0, 0, 0); }
}
__device__ __forceinline__ float max3a(float a, float b, float c) { float r; asm("v_max3_f32 %0, %1, %2, %3" : "=v"(r) : "v"(a), "v"(b), "v"(c)); return r; }
__device__ __forceinline__ float rowmax(const f32x16& p0, const f32x16& p1) {
    float a = max3a(p0[0], p0[1], p0[2]), b = max3a(p1[0], p1[1], p1[2]);
#pragma unroll
    for (int r = 3; r < 15; r += 2) { a = max3a(a, p0[r], p0[r + 1]); b = max3a(b, p1[r], p1[r + 1]); }
    a = max3a(a, p0[15], p1[15]);
    float m; asm("v_max_f32 %0, %1, %2" : "=v"(m) : "v"(a), "v"(b));
    asm volatile("s_nop 1" ::: "memory");
    auto rr = __builtin_amdgcn_permlane32_swap(__float_as_uint(m), __float_as_uint(m), false, false);
    float o; asm("v_max_f32 %0, %1, %2" : "=v"(o) : "v"(__uint_as_float(rr[0])), "v"(__uint_as_float(rr[1])));
    return o;
}
#define ATT_VRD(buf, d0) do { _Pragma("unroll") for (int ks = 0; ks < 4; ++ks) { \
        asm volatile("ds_read_b64_tr_b16 %0,%1 offset:%c2" : "=&v"(lo[buf][ks]) : "v"(vb), "i"((d0) * 4096 + ks * 1024) : "memory"); \
        asm volatile("ds_read_b64_tr_b16 %0,%1 offset:%c2" : "=&v"(hi[buf][ks]) : "v"(vb), "i"((d0) * 4096 + ks * 1024 + 512) : "memory"); } } while (0)
#define ATT_PK(b, k) (bf16x8){lo[b][k][0], lo[b][k][1], lo[b][k][2], lo[b][k][3], hi[b][k][0], hi[b][k][1], hi[b][k][2], hi[b][k][3]}
#define ATT_MM2(da, db) do { \
        o[da] = __builtin_amdgcn_mfma_f32_32x32x16_bf16(pa0, ATT_PK(0, 0), o[da], 0, 0, 0); o[db] = __builtin_amdgcn_mfma_f32_32x32x16_bf16(pa0, ATT_PK(1, 0), o[db], 0, 0, 0); \
        o[da] = __builtin_amdgcn_mfma_f32_32x32x16_bf16(pa1, ATT_PK(0, 1), o[da], 0, 0, 0); o[db] = __builtin_amdgcn_mfma_f32_32x32x16_bf16(pa1, ATT_PK(1, 1), o[db], 0, 0, 0); \
        o[da] = __builtin_amdgcn_mfma_f32_32x32x16_bf16(pa2, ATT_PK(0, 2), o[da], 0, 0, 0); o[db] = __builtin_amdgcn_mfma_f32_32x32x16_bf16(pa2, ATT_PK(1, 2), o[db], 0, 0, 0); \
        o[da] = __builtin_amdgcn_mfma_f32_32x32x16_bf16(pa3, ATT_PK(0, 3), o[da], 0, 0, 0); o[db] = __builtin_amdgcn_mfma_f32_32x32x16_bf16(pa3, ATT_PK(1, 3), o[db], 0, 0, 0); } while (0)
__device__ __forceinline__ void pv(f32x16* o, int vb, bf16x8 pa0, bf16x8 pa1, bf16x8 pa2, bf16x8 pa3) {
    s16x4 lo[2][4], hi[2][4];
    ATT_VRD(0, 0);
    ATT_VRD(1, 1);
    asm volatile("s_waitcnt lgkmcnt(0)" ::: "memory"); __builtin_amdgcn_sched_barrier(0);
    ATT_MM2(0, 1); __builtin_amdgcn_sched_barrier(0);
    ATT_VRD(0, 2);
    ATT_VRD(1, 3);
    asm volatile("s_waitcnt lgkmcnt(0)" ::: "memory"); __builtin_amdgcn_sched_barrier(0);
    ATT_MM2(2, 3);
}
#undef ATT_MM2
#undef ATT_VRD
#undef ATT_PK
__device__ __forceinline__ void attn_pass(const Args& A, int z, int b, int h, int qrow0, bool isctx, bool pathB, LAS char* shm, f32x16* o) {
    const int tid = opaque_tid(), lane = tid & 63, r32 = lane & 31, hi = lane >> 5; const int wid = __builtin_amdgcn_readfirstlane(tid >> 6);
    const int NT = isctx ? 4 : 68;
    LAS float* wsf = (LAS float*)(shm + LDS_WS) + wid * 64;
    const int vb0 = (int)(unsigned)(size_t)(shm + LDS_V) + ((lane >> 4) & 1) * 32 + (lane & 3) * 8 + (4 * hi + ((lane & 15) >> 2)) * 64;
    const bf16_t* Qw = A.Q + (size_t)(qrow0 + wid * 32 + r32) * 1024 + h * 128 + z * 64;
    bf16x8 qr[4];
#pragma unroll
    for (int d0 = 0; d0 < 4; ++d0) qr[d0] = *(const bf16x8*)(Qw + d0 * 16 + hi * 8);
    const bf16_t* Kh = A.K + (size_t)((h * 2 + z) * 8 + wid) * 512 + lane * 8;
    const int pc0 = wid, pc1 = wid + 8;
    const bf16_t* Vh0 = A.V + (size_t)h * 8192 + pc0 * 512 + lane * 8;
    const bf16_t* Vh1 = A.V + (size_t)h * 8192 + pc1 * 512 + lane * 8;
    const int ctxrow = TL + b * 256, latrow = b * 4096;
#define ATT_TROW(t) ((isctx || (t) < 4) ? (ctxrow + 64 * (t)) : (latrow + 64 * ((t) - 4)))
#define ATT_DMA(t, slot, vslot) do { const size_t ro_ = (size_t)(ATT_TROW(t) >> 6) * 65536; \
        __builtin_amdgcn_global_load_lds((const unsigned*)(Kh + ro_), (LAS unsigned*)(shm + LDS_K + (slot) * KSLOT + wid * 1024), 16, 0, 0); \
        __builtin_amdgcn_global_load_lds((const unsigned*)(Vh0 + ro_), (LAS unsigned*)(shm + LDS_V + (vslot) * VSLOT + pc0 * 1024), 16, 0, 0); \
        __builtin_amdgcn_global_load_lds((const unsigned*)(Vh1 + ro_), (LAS unsigned*)(shm + LDS_V + (vslot) * VSLOT + pc1 * 1024), 16, 0, 0); } while (0)
    float mhat = 0.f, l_reg = 0.f;
    const f32x16 negm = f32x16{};
#pragma unroll
    for (int d = 0; d < 4; ++d) o[d] = f32x16{};
    ATT_DMA(0, 0, 0);
    if (NT > 1) ATT_DMA(1, 1, 1);
    asm volatile("s_waitcnt vmcnt(0) lgkmcnt(0)\n\ts_barrier" ::: "memory");
    f32x16 sc0, sc1;
    { bf16x8 kf[8]; kload(kf, shm + LDS_K, r32, hi); qk_mm(sc0, sc1, kf, qr, negm); asm volatile("s_nop 15\n\ts_nop 15" : "+v"(sc0), "+v"(sc1)); }
    if (NT > 2) ATT_DMA(2, 2, 2);
    int k_cur = 0, v_cur = 0, v_prev = 3;
    u32x4 pw0 = {0u, 0u, 0u, 0u}, pw1 = pw0, pw2 = pw0, pw3 = pw0;
#pragma unroll 1
    for (int t = 0; t <= NT; ++t) {
        const int k_n1 = (k_cur == 2) ? 0 : k_cur + 1;
        if (t > 0) {
            asm volatile("s_waitcnt vmcnt(0) lgkmcnt(0)\n\ts_barrier" ::: "memory");
            const int k_p2 = (k_cur == 0) ? 2 : k_cur - 1;
            const int v_p2 = (v_cur + 2) & 3;
            if (t + 2 < NT) ATT_DMA(t + 2, k_p2, v_p2);
        }
        if (pathB && t > 0) {
            pv(o, vb0 + v_prev * VSLOT, __builtin_bit_cast(bf16x8, pw0), __builtin_bit_cast(bf16x8, pw1), __builtin_bit_cast(bf16x8, pw2), __builtin_bit_cast(bf16x8, pw3)); }
        if (t < NT) {
        const float rm = rowmax(sc0, sc1);
        if (t == 0) { mhat = rm; }
        else if (__any(rm - mhat > 8.f)) {
            const float dl = fmaxf(rm - mhat, 0.f); mhat += dl;
            const float f = __builtin_amdgcn_exp2f(-dl); l_reg *= f;
            if (hi == 0) wsf[r32] = f;
            asm volatile("s_waitcnt lgkmcnt(0)" ::: "memory");
#pragma unroll
            for (int r = 0; r < 16; ++r) { const float fr_ = wsf[crow(r, hi)];
#pragma unroll
                for (int d = 0; d < 4; ++d) o[d][r] *= fr_; }
            asm volatile("s_waitcnt lgkmcnt(0)" ::: "memory");
        }
        bf16x8 kf[8];
        kload(kf, shm + LDS_K + k_n1 * KSLOT, r32, hi);
        __builtin_amdgcn_sched_barrier(0);
        f32x16 pn0, pn1;
        qk_mm(pn0, pn1, kf, qr, negm);
        f32x2_t sacc = {0.f, 0.f};
#pragma unroll
        for (int r = 0; r < 16; r += 2) { sc0[r] = __builtin_amdgcn_exp2f(sc0[r] - mhat); sc0[r + 1] = __builtin_amdgcn_exp2f(sc0[r + 1] - mhat); sc1[r] = __builtin_amdgcn_exp2f(sc1[r] - mhat); sc1[r + 1] = __builtin_amdgcn_exp2f(sc1[r + 1] - mhat);
            sacc += (f32x2_t){sc0[r], sc0[r + 1]}; sacc += (f32x2_t){sc1[r], sc1[r + 1]}; }
        l_reg += sacc.x + sacc.y;
        pw0 = (u32x4){pkbf(sc0[0], sc0[1]), pkbf(sc0[2], sc0[3]), pkbf(sc0[4], sc0[5]), pkbf(sc0[6], sc0[7])};
        pw1 = (u32x4){pkbf(sc0[8], sc0[9]), pkbf(sc0[10], sc0[11]), pkbf(sc0[12], sc0[13]), pkbf(sc0[14], sc0[15])};
        pw2 = (u32x4){pkbf(sc1[0], sc1[1]), pkbf(sc1[2], sc1[3]), pkbf(sc1[4], sc1[5]), pkbf(sc1[6], sc1[7])};
        pw3 = (u32x4){pkbf(sc1[8], sc1[9]), pkbf(sc1[10], sc1[11]), pkbf(sc1[12], sc1[13]), pkbf(sc1[14], sc1[15])};
#pragma unroll
        for (int i = 0; i < 8; ++i) { __builtin_amdgcn_sched_group_barrier(0x008, 1, 0); __builtin_amdgcn_sched_group_barrier(0x002, 13, 0); }
        __builtin_amdgcn_sched_barrier(0);
        if (!pathB) {
            pv(o, vb0 + v_cur * VSLOT, __builtin_bit_cast(bf16x8, pw0), __builtin_bit_cast(bf16x8, pw1), __builtin_bit_cast(bf16x8, pw2), __builtin_bit_cast(bf16x8, pw3)); }
        sc0 = pn0; sc1 = pn1;
        }
        k_cur = k_n1; v_prev = v_cur; v_cur = (v_cur + 1) & 3;
    }
    asm volatile("s_waitcnt lgkmcnt(0)\n\ts_barrier" ::: "memory");
#undef ATT_DMA
#undef ATT_TROW
    { auto rr = __builtin_amdgcn_permlane32_swap(__float_as_uint(l_reg), __float_as_uint(l_reg), false, false); l_reg = __uint_as_float(rr[0]) + __uint_as_float(rr[1]); }
    asm volatile("s_waitcnt lgkmcnt(0)" ::: "memory");
    if (hi == 0) wsf[32 + r32] = l_reg;
    asm volatile("s_waitcnt lgkmcnt(0)" ::: "memory");
#pragma unroll
    for (int r = 0; r < 16; ++r) { const float rl = 1.0f / wsf[32 + crow(r, hi)];
#pragma unroll
        for (int d = 0; d < 4; ++d) o[d][r] *= rl; }
    asm volatile("s_waitcnt lgkmcnt(0)" ::: "memory");
}
__device__ __forceinline__ void attn_unit(const Args& A, int b, int h, int qb, bool isctx, bool pathB, LAS char* shm) {
    const int tid = opaque_tid(), lane = tid & 63, r32 = lane & 31, hi = lane >> 5; const int wid = __builtin_amdgcn_readfirstlane(tid >> 6);
    const int qrow0 = isctx ? (TL + b * 256) : (b * 4096 + qb * 256);
    f32x16 o[4];
    unsigned* o1s = A.o1g + wid * 2048 + lane;
    attn_pass(A, 0, b, h, qrow0, isctx, pathB, shm, o);
#pragma unroll
    for (int d = 0; d < 4; ++d)
#pragma unroll
        for (int r = 0; r < 16; r += 2) o1s[(d * 8 + (r >> 1)) * 64] = pkbf(o[d][r], o[d][r + 1]);
    asm volatile("s_waitcnt lgkmcnt(0)" ::: "memory");
    attn_pass(A, 1, b, h, qrow0, isctx, pathB, shm, o);
    float ss[16];
#pragma unroll
    for (int r = 0; r < 16; r += 2) { float s0 = 0.f, s1 = 0.f;
#pragma unroll
        for (int d = 0; d < 4; ++d) { const unsigned pk = o1s[(d * 8 + (r >> 1)) * 64];
            const float v0 = bflo(pk) - A.lam * o[d][r], v1 = bfhi(pk) - A.lam * o[d][r + 1]; o[d][r] = v0; o[d][r + 1] = v1; s0 += v0 * v0; s1 += v1 * v1; }
        ss[r] = s0; ss[r + 1] = s1; }
#pragma unroll
    for (int msk = 1; msk < 32; msk <<= 1)
#pragma unroll
        for (int r = 0; r < 16; ++r) ss[r] += __shfl_xor(ss[r], msk);
    float gn[4];
#pragma unroll
    for (int d = 0; d < 4; ++d) gn[d] = A.gain[d * 32 + r32] * A.oml;
#pragma unroll
    for (int r = 0; r < 16; ++r) {
        const float rstd = rsqrtf(ss[r] * (1.0f / 128.0f) + 1e-5f);
        const size_t off = (size_t)(qrow0 + wid * 32 + crow(r, hi)) * 1024 + h * 128 + r32;
#pragma unroll
        for (int d = 0; d < 4; ++d) { const float zv = bf1(A.Z[off + d * 32]); const float v = o[d][r] * rstd * gn[d] * silu_f(zv);
            A.O[off + d * 32] = (bf16_t)(pkbf(v, 0.f) & 0xffffu); }
        asm volatile("" ::: "memory");
    }
}
__device__ __forceinline__ void attn_phase(const Args& A, LAS char* shm, int G, int bid) {
    const int vcu = (G % 8 == 0) ? (bid % 8) * (G / 8) + bid / 8 : bid;
    bool pathB;
    { const int tid = opaque_tid(); LAS unsigned* cnt = (LAS unsigned*)(shm + LDS_CNT);
      if (tid < 4) cnt[tid] = 0u;
      __syncthreads();
      const unsigned simd = (unsigned)__builtin_amdgcn_s_getreg((1 << 11) | (4 << 6) | 4) & 3u;
      unsigned slot = 0u; if ((tid & 63) == 0) slot = __hip_atomic_fetch_add(cnt + simd, 1u, __ATOMIC_RELAXED, __HIP_MEMORY_SCOPE_WORKGROUP);
      slot = (unsigned)__builtin_amdgcn_readfirstlane((int)slot);
      pathB = (slot & 1u) != 0u;
      __syncthreads(); }
#pragma unroll 1
    for (int u = vcu; u < A.n_units; u += G) {
        const bool isctx = u >= 1024; const int bh = isctx ? (u - 1024) : (u >> 4); const int qb = isctx ? 0 : (u & 15);
        attn_unit(A, bh >> 3, bh & 7, qb, isctx, pathB, shm);
        asm volatile("s_waitcnt vmcnt(0) lgkmcnt(0)\n\ts_barrier" ::: "memory");
    }
}
}
typedef unsigned short bf16_t;
typedef float f32x4 __attribute__((ext_vector_type(4)));
typedef unsigned u32x4 __attribute__((ext_vector_type(4)));
typedef unsigned u32x2 __attribute__((ext_vector_type(2)));
constexpr size_t MiB = 1u << 20;
constexpr size_t WS_CTL = 0, WS_MOD = 1 * MiB, WS_ROPE = 1 * MiB + 512 * 1024, WS_BZ = 2 * MiB;
constexpr size_t WS_WDAIN = 9 * MiB, WS_WDAOUT = 25 * MiB, WS_WFNT = 29 * MiB, WS_WFNZ = 33 * MiB, WS_WFNOUT = 35 * MiB, WS_WRWIN = 37 * MiB, WS_WRWOUT = 46 * MiB;
constexpr size_t WS_XC = 48 * MiB, WS_HB = 56 * MiB, WS_BIG = 124 * MiB;
constexpr size_t WS_Q = WS_BIG, WS_K = WS_BIG + 68 * MiB, WS_V = WS_BIG + 136 * MiB, WS_Z = WS_BIG + 204 * MiB;
constexpr size_t WS_ATL = WS_BIG, WS_ATC = WS_BIG + 128 * MiB, WS_ZB = WS_BIG + 136 * MiB, WS_DFTL = 396 * MiB, WS_DFTC = 460 * MiB, WS_FOLD = WS_BIG + 204 * MiB;
constexpr size_t WS_P = WS_BIG, WS_Y1 = 413 * MiB, WS_END = 482 * MiB;
constexpr int RWN = 4352;
constexpr int LDS_BYTES = 147456;

struct Params { const float* in[28]; float* out; unsigned char* ws; };

__device__ __forceinline__ float wave_sum(float v) {
#pragma unroll
    for (int o = 1; o < 64; o <<= 1) v += __shfl_xor(v, o);
    return v;
}
__device__ __forceinline__ void tr_item(const float* W, int ldw, int N, bf16_t* WT, int ldt, LAS float* scr, int item, int lane) {
    const int nblk = N / 32, kb = item / nblk, nb = item % nblk, k0 = 64 * kb, n0 = 32 * nb;
#pragma unroll 8
    for (int i = 0; i < 32; ++i) { const int kk = 2 * i + (lane >> 5); scr[kk * 33 + (lane & 31)] = W[(size_t)(k0 + kk) * ldw + n0 + (lane & 31)]; }
    asm volatile("s_waitcnt lgkmcnt(0)" ::: "memory");
    const int c = lane & 7;
#pragma unroll
    for (int j = 0; j < 4; ++j) { const int n = (lane >> 3) + 8 * j; const LAS float* s = scr + (8 * c) * 33 + n;
        u32x4 o; o.x = pkbf(s[0 * 33], s[1 * 33]); o.y = pkbf(s[2 * 33], s[3 * 33]); o.z = pkbf(s[4 * 33], s[5 * 33]); o.w = pkbf(s[6 * 33], s[7 * 33]);
        *(u32x4*)(WT + (size_t)(n0 + n) * ldt + k0 + 8 * c) = o; }
    asm volatile("s_waitcnt lgkmcnt(0)" ::: "memory");
}
__device__ __forceinline__ void prologue(const Params& p, LAS char* lds, int G, int bid) {
    const int tid = opaque_tid(), lane = tid & 63, wid = tid >> 6;
    unsigned char* ws = p.ws;
    {
        LAS float* scr = (LAS float*)(lds + wid * 8448);
        const int gw = bid * 8 + wid, NGW = G * 8;
        for (int it = gw; it < 8832; it += NGW) {
            int r = it;
            if (r < 2048) { tr_item(p.in[8], 4096, 4096, (bf16_t*)(ws + WS_WDAIN), 1024, scr, r, lane); continue; } r -= 2048;
            if (r < 2048) { tr_item(p.in[8] + (size_t)1024 * 4096, 4096, 4096, (bf16_t*)(ws + WS_WDAIN + 8 * MiB), 1024, scr, r, lane); continue; } r -= 2048;
            if (r < 512) { tr_item(p.in[12], 1024, 1024, (bf16_t*)(ws + WS_WDAOUT), 1024, scr, r, lane); continue; } r -= 512;
            if (r < 512) { tr_item(p.in[12] + (size_t)1024 * 1024, 1024, 1024, (bf16_t*)(ws + WS_WDAOUT + 2 * MiB), 1024, scr, r, lane); continue; } r -= 512;
            if (r < 512) { tr_item(p.in[13] + 1024, 2048, 1024, (bf16_t*)(ws + WS_WFNZ), 1024, scr, r, lane); continue; } r -= 512;
            if (r < 512) { tr_item(p.in[15], 1024, 1024, (bf16_t*)(ws + WS_WFNOUT), 1024, scr, r, lane); continue; } r -= 512;
            if (r < 2176) { tr_item(p.in[16], RWN, RWN, (bf16_t*)(ws + WS_WRWIN), 1024, scr, r, lane); continue; } r -= 2176;
            tr_item(p.in[27], 1024, 1024, (bf16_t*)(ws + WS_WRWOUT), 1024, scr, r, lane);
        }
    }
    __syncthreads();
    for (int it = bid; it < 256; it += G) {
        const int g = it >> 5, cs = (it >> 4) & 1, kq = it & 15;
        LAS float* Wcs = (LAS float*)lds; LAS float* win = (LAS float*)(lds + 65536); LAS float* tab = (LAS float*)(lds + 65536 + 33024);
        if (tid < 128) { float s, c; sincospif((float)tid / 64.f, &s, &c); tab[tid] = (cs ? s : c) * 0.08838834764831845f; }
        __syncthreads();
        {
            const int e = tid & 127, cq = tid >> 7; float acc[32];
#pragma unroll
            for (int i = 0; i < 32; ++i) acc[i] = 0.f;
            const float* Wg = p.in[14] + (size_t)g * 128 * 128;
            for (int m = 0; m < 128; ++m) { const float wg = Wg[m * 128 + e];
#pragma unroll
                for (int i = 0; i < 32; ++i) acc[i] += tab[(m * (cq + 4 * i)) & 127] * wg; }
#pragma unroll
            for (int i = 0; i < 32; ++i) Wcs[(cq + 4 * i) * 128 + e] = acc[i];
        }
#pragma unroll
        for (int i = 0; i < 16; ++i) { const int idx = tid + 512 * i, kin = idx >> 7, c = idx & 127; win[kin * 129 + c] = p.in[13][(size_t)(kq * 64 + kin) * 2048 + g * 128 + c]; }
        __syncthreads();
        {
            const int kin = tid & 63, eg = tid >> 6; float acc[16];
#pragma unroll
            for (int i = 0; i < 16; ++i) acc[i] = 0.f;
            for (int c = 0; c < 128; ++c) { const float a = win[kin * 129 + c];
#pragma unroll
                for (int i = 0; i < 16; ++i) acc[i] += a * Wcs[c * 128 + eg * 16 + i]; }
            bf16_t* WT = (bf16_t*)(ws + WS_WFNT);
#pragma unroll
            for (int i = 0; i < 16; ++i) WT[(size_t)(cs * 1024 + g * 128 + eg * 16 + i) * 1024 + kq * 64 + kin] = (bf16_t)(pkbf(acc[i], 0.f) & 0xffffu);
        }
        __syncthreads();
    }
    {
        LAS float* tc = (LAS float*)lds; LAS float* ts = (LAS float*)(lds + 16384);
        for (int j = tid; j < 4096; j += 512) { float s, c; sincospif((float)j / 2048.f, &s, &c); tc[j] = c; ts[j] = -s; }
        __syncthreads();
        bf16_t* DL = (bf16_t*)(ws + WS_DFTL); bf16_t* DC = (bf16_t*)(ws + WS_DFTC);
        for (int k = bid; k < 2048; k += G) {
            const int j0 = (tid & 255) * 8; const bool sn = tid >= 256; float v8[8];
#pragma unroll
            for (int i = 0; i < 8; ++i) { const int idx = (k * (j0 + i)) & 4095; v8[i] = (sn ? -ts[idx] : tc[idx]) * 0.015625f; }
            u32x4 o; o.x = pkbf(v8[0], v8[1]); o.y = pkbf(v8[2], v8[3]); o.z = pkbf(v8[4], v8[5]); o.w = pkbf(v8[6], v8[7]);
            *(u32x4*)(DL + (sn ? (size_t)2048 * 2048 : (size_t)0) + (size_t)k * 2048 + j0) = o;
        }
        for (int k = bid; k < 256; k += G) {
            if (tid < 64) { const int cs = tid >> 5, l0 = (tid & 31) * 8; float v8[8];
#pragma unroll
                for (int i = 0; i < 8; ++i) { const int idx = ((k * (l0 + i)) & 255) * 16; v8[i] = (cs ? ts[idx] : tc[idx]) * 0.0625f; }
                u32x4 o; o.x = pkbf(v8[0], v8[1]); o.y = pkbf(v8[2], v8[3]); o.z = pkbf(v8[4], v8[5]); o.w = pkbf(v8[6], v8[7]);
                *(u32x4*)(DC + (size_t)k * 512 + cs * 256 + l0) = o; }
        }
        __syncthreads();
    }
    {
        LAS float* sc = (LAS float*)lds; LAS float* red = (LAS float*)(lds + 40960);
        bool have = false;
        for (int it = bid; it < 192; it += G) {
            if (!have) { for (int idx = tid; idx < 9216; idx += 512) { const int r = idx >> 10, k = idx & 1023; const float cv = r < 8 ? p.in[1][r * 1024 + k] : p.in[3][k]; sc[idx] = cv / (1.f + __expf(-cv)); } have = true; __syncthreads(); }
            const int i = it / 48, n = (it % 48) * 64 + (tid & 63), kq = tid >> 6;
            const float* w = p.in[5] + (size_t)i * 1024 * 3072 + n;
            float acc[9];
#pragma unroll
            for (int r = 0; r < 9; ++r) acc[r] = 0.f;
            for (int k = kq * 128; k < kq * 128 + 128; ++k) { const float wv = w[(size_t)k * 3072];
#pragma unroll
                for (int r = 0; r < 9; ++r) acc[r] += sc[r * 1024 + k] * wv; }
#pragma unroll
            for (int r = 0; r < 9; ++r) red[(kq * 9 + r) * 64 + (tid & 63)] = acc[r];
            __syncthreads();
            for (int idx = tid; idx < 576; idx += 512) { const int r = idx >> 6, col = idx & 63; float s = 0.f;
#pragma unroll
                for (int q = 0; q < 8; ++q) s += red[(q * 9 + r) * 64 + col];
                const int nn = (it % 48) * 64 + col;
                ((float*)(ws + WS_MOD))[(size_t)(i * 9 + r) * 3072 + nn] = s + p.in[6][i * 3072 + nn]; }
            __syncthreads();
        }
    }
    if (bid == 0) { for (int t = tid; t < 1024; t += 512) { const int pos = t >> 4, qd = t & 15; const float inv = powf(10000.f, -(float)qd / 16.f); const float ang = (float)pos * inv;
            ((float*)(ws + WS_ROPE))[t] = cosf(ang); ((float*)(ws + WS_ROPE))[1024 + t] = sinf(ang); } }
}
__device__ __forceinline__ void ph_phase(const float* xlat, const float* xctx, const float* gain, const float* mod, bf16_t* Hb, int G, int bid) {
    const int tid_ = opaque_tid(); const int lane = tid_ & 63, wid = tid_ >> 6;
    const int stride = G * 8;
    for (int row0 = bid * 8 + wid; row0 < TT; row0 += 2 * stride) {
        const int row1 = row0 + stride; const bool has1 = row1 < TT;
        const float* s0 = row0 < TL ? xlat + (size_t)row0 * 1024 : xctx + (size_t)(row0 - TL) * 1024;
        const float* s1 = !has1 ? s0 : (row1 < TL ? xlat + (size_t)row1 * 1024 : xctx + (size_t)(row1 - TL) * 1024);
        f32x4 v0[4], v1[4]; float q0 = 0.f, q1 = 0.f;
#pragma unroll
        for (int j = 0; j < 4; ++j) { v0[j] = *(const f32x4*)(s0 + 4 * lane + 256 * j); v1[j] = *(const f32x4*)(s1 + 4 * lane + 256 * j); }
#pragma unroll
        for (int j = 0; j < 4; ++j) { q0 += (v0[j].x * v0[j].x + v0[j].y * v0[j].y) + (v0[j].z * v0[j].z + v0[j].w * v0[j].w); q1 += (v1[j].x * v1[j].x + v1[j].y * v1[j].y) + (v1[j].z * v1[j].z + v1[j].w * v1[j].w); }
        const float r0 = rsqrtf(wave_sum(q0) * (1.f / 1024.f) + 1e-6f), r1 = rsqrtf(wave_sum(q1) * (1.f / 1024.f) + 1e-6f);
        const float* m0 = mod + (row0 < TL ? (row0 >> 12) : 8) * 3072; const float* m1 = mod + (row1 < TL ? (row1 >> 12) : 8) * 3072;
#pragma unroll
        for (int j = 0; j < 4; ++j) { const int col = 4 * lane + 256 * j; const f32x4 g4 = *(const f32x4*)(gain + col);
            { const f32x4 sh = *(const f32x4*)(m0 + col), sc = *(const f32x4*)(m0 + 1024 + col); const f32x4 y = v0[j] * r0 * g4 * (sc + 1.f) + sh; u32x2 o; o.x = pkbf(y.x, y.y); o.y = pkbf(y.z, y.w); *(u32x2*)(Hb + (size_t)row0 * 1024 + col) = o; }
            if (has1) { const f32x4 sh = *(const f32x4*)(m1 + col), sc = *(const f32x4*)(m1 + 1024 + col); const f32x4 y = v1[j] * r1 * g4 * (sc + 1.f) + sh; u32x2 o; o.x = pkbf(y.x, y.y); o.y = pkbf(y.z, y.w); *(u32x2*)(Hb + (size_t)row1 * 1024 + col) = o; } }
    }
}
__device__ __forceinline__ void final_phase(float* x, const float* gain, int G, int bid) {
    const int tid_ = opaque_tid(); const int lane = tid_ & 63, wid = tid_ >> 6;
    const int stride = G * 8;
    for (int row0 = bid * 8 + wid; row0 < TL; row0 += 2 * stride) {
        const int row1 = row0 + stride; const bool has1 = row1 < TL;
        float* s0 = x + (size_t)row0 * 1024; float* s1 = has1 ? x + (size_t)row1 * 1024 : s0;
        f32x4 v0[4], v1[4]; float q0 = 0.f, q1 = 0.f;
#pragma unroll
        for (int j = 0; j < 4; ++j) { v0[j] = *(const f32x4*)(s0 + 4 * lane + 256 * j); v1[j] = *(const f32x4*)(s1 + 4 * lane + 256 * j); }
#pragma unroll
        for (int j = 0; j < 4; ++j) { q0 += (v0[j].x * v0[j].x + v0[j].y * v0[j].y) + (v0[j].z * v0[j].z + v0[j].w * v0[j].w); q1 += (v1[j].x * v1[j].x + v1[j].y * v1[j].y) + (v1[j].z * v1[j].z + v1[j].w * v1[j].w); }
        const float r0 = rsqrtf(wave_sum(q0) * (1.f / 1024.f) + 1e-6f), r1 = rsqrtf(wave_sum(q1) * (1.f / 1024.f) + 1e-6f);
#pragma unroll
        for (int j = 0; j < 4; ++j) { const int col = 4 * lane + 256 * j; const f32x4 g4 = *(const f32x4*)(gain + col);
            *(f32x4*)(s0 + col) = v0[j] * r0 * g4;
            if (has1) *(f32x4*)(s1 + col) = v1[j] * r1 * g4; }
    }
}
__device__ __forceinline__ void fnet_fold(const bf16_t* ATL, bf16_t* E, bf16_t* O, float* TA, const bf16_t* Z, bf16_t* OG, int G, int bid) {
    const int tid_ = opaque_tid(); const int lane = tid_ & 63, wid = tid_ >> 6;
    for (int row = bid * 8 + wid; row < 8192; row += G * 8) {
        const bf16_t* a1 = ATL + (size_t)row * 8192; const bf16_t* a2 = a1 + 4096; bf16_t* e = E + (size_t)row * 2048; bf16_t* od = O + (size_t)row * 2048;
        float alt = 0.f;
#pragma unroll 2
        for (int it = 0; it < 4; ++it) {
            const int j0 = (it * 64 + lane) * 8;
            const u32x4 x = *(const u32x4*)(a1 + j0), y = *(const u32x4*)(a2 + j0);
            const int mb = 4096 - j0 - 8;
            const u32x4 xm = *(const u32x4*)(a1 + mb), ym = *(const u32x4*)(a2 + mb);
            const unsigned short xe = (j0 == 0) ? (unsigned short)0 : a1[4096 - j0], ye = (j0 == 0) ? (unsigned short)0 : a2[4096 - j0];
            float fa[8], fs[8], ma[8], ms[8];
#pragma unroll
            for (int i = 0; i < 4; ++i) { fa[2 * i] = bflo(x[i]); fa[2 * i + 1] = bfhi(x[i]); fs[2 * i] = bflo(y[i]); fs[2 * i + 1] = bfhi(y[i]);
                ma[2 * i] = bflo(xm[i]); ma[2 * i + 1] = bfhi(xm[i]); ms[2 * i] = bflo(ym[i]); ms[2 * i + 1] = bfhi(ym[i]); }
            float oc[8], os[8];
            oc[0] = fa[0] + bf1(xe); os[0] = fs[0] - bf1(ye);
#pragma unroll
            for (int i = 1; i < 8; ++i) { oc[i] = fa[i] + ma[8 - i]; os[i] = fs[i] - ms[8 - i]; }
            if (j0 == 0) { oc[0] = fa[0]; os[0] = 0.f; }
            u32x4 o; o.x = pkbf(oc[0], oc[1]); o.y = pkbf(oc[2], oc[3]); o.z = pkbf(oc[4], oc[5]); o.w = pkbf(oc[6], oc[7]);
            *(u32x4*)(e + j0) = o;
            alt += (bflo(o.x) - bfhi(o.x)) + (bflo(o.y) - bfhi(o.y)) + (bflo(o.z) - bfhi(o.z)) + (bflo(o.w) - bfhi(o.w));
            o.x = pkbf(os[0], os[1]); o.y = pkbf(os[2], os[3]); o.z = pkbf(os[4], os[5]); o.w = pkbf(os[6], os[7]);
            *(u32x4*)(od + j0) = o;
        }
        alt = wave_sum(alt);
        if (lane == 0) { const float amid = bf1(a1[2048]); TA[row] = amid * 0.015625f;
            const int b = row >> 10, n = row & 1023; const size_t off = (size_t)(b * 4096 + 2048) * 1024 + n;
            const float yv = (alt + amid) * 0.015625f * silu_f(bf1(Z[off]));
            OG[off] = (bf16_t)(pkbf(yv, 0.f) & 0xffffu); }
    }
}
__device__ __forceinline__ void sh8(const bf16_t* P, size_t row, int co, bool hm, bool hp, const float* mu, float* out) {
    const u32x4 z4 = {0u, 0u, 0u, 0u};
    const u32x4 c0 = *(const u32x4*)(P + row * RWN + co);
    const u32x4 cm = hm ? *(const u32x4*)(P + (row - 1) * RWN + co) : z4;
    const u32x4 cp = hp ? *(const u32x4*)(P + (row + 1) * RWN + co) : z4;
    const f32x4 m0 = *(const f32x4*)(mu + co), m1 = *(const f32x4*)(mu + co + 4);
#pragma unroll
    for (int i = 0; i < 4; ++i) {
        const float a0 = bflo(c0[i]), a1 = bfhi(c0[i]);
        const float n0 = 0.5f * (bflo(cm[i]) + bflo(cp[i])), n1 = 0.5f * (bfhi(cm[i]) + bfhi(cp[i]));
        const float mu0 = (2 * i < 4) ? m0[(2 * i) & 3] : m1[(2 * i) & 3], mu1 = (2 * i + 1 < 4) ? m0[(2 * i + 1) & 3] : m1[(2 * i + 1) & 3];
        out[2 * i] = a0 + mu0 * (n0 - a0); out[2 * i + 1] = a1 + mu1 * (n1 - a1);
    }
}
template <int CTRL> __device__ __forceinline__ float dpp_f(float v) { return __int_as_float(__builtin_amdgcn_update_dpp(0, __float_as_int(v), CTRL, 0xf, 0xf, true)); }
__device__ __forceinline__ float sum8(float v) { v += dpp_f<0xB1>(v); v += dpp_f<0x4E>(v); v += dpp_f<0x141>(v); return v; }
__device__ __forceinline__ float fast_tanh(float x) { const float e = __expf(2.f * x); return 1.f - 2.f * __builtin_amdgcn_rcpf(e + 1.f); }
__device__ __forceinline__ float fast_sigmoid(float x) { return __builtin_amdgcn_rcpf(1.f + __expf(-x)); }
struct RwArgs { const bf16_t* P; bf16_t* Y0; bf16_t* Y1; float* BZ; const float *mu, *w0, *w_up, *a0, *a_up, *k_k, *k_a, *r_k; };
struct Raw3 { u32x4 c0, cm, cp; };
__device__ __forceinline__ Raw3 ld3(const bf16_t* P, size_t row, int co, bool hm, bool hp) {
    const u32x4 z4 = {0u, 0u, 0u, 0u}; Raw3 r;
    r.c0 = *(const u32x4*)(P + row * RWN + co);
    r.cm = hm ? *(const u32x4*)(P + (row - 1) * RWN + co) : z4;
    r.cp = hp ? *(const u32x4*)(P + (row + 1) * RWN + co) : z4;
    return r;
}
__device__ __forceinline__ void shift8(const Raw3& R, const float* mu, int co, float* out) {
    const f32x4 m0 = *(const f32x4*)(mu + co), m1 = *(const f32x4*)(mu + co + 4);
#pragma unroll
    for (int i = 0; i < 4; ++i) {
        const float a0 = bflo(R.c0[i]), a1 = bfhi(R.c0[i]);
        const float n0 = 0.5f * (bflo(R.cm[i]) + bflo(R.cp[i])), n1 = 0.5f * (bfhi(R.cm[i]) + bfhi(R.cp[i]));
        const float mu0 = (2 * i < 4) ? m0[(2 * i) & 3] : m1[(2 * i) & 3], mu1 = (2 * i + 1 < 4) ? m0[(2 * i + 1) & 3] : m1[(2 * i + 1) & 3];
        out[2 * i] = a0 + mu0 * (n0 - a0); out[2 * i + 1] = a1 + mu1 * (n1 - a1);
    }
}
__device__ __forceinline__ void rwkv_scan(const RwArgs& A, LAS char* lds, int G, int bid) {
    typedef short bfx8 __attribute__((ext_vector_type(8)));
    const int tid = opaque_tid(), lane = tid & 63; const int q = __builtin_amdgcn_readfirstlane(tid >> 6);
    LAS float* sW = (LAS float*)lds; LAS float* sA = sW + 4096; LAS float* sB = sA + 4096; LAS float* sKD = sB + 4096; LAS float* sR = sKD + 4096; LAS float* sV = sR + 4096;
    LAS bf16_t* WUPt = (LAS bf16_t*)(sV + 4096); LAS bf16_t* AUPt = WUPt + 64 * 72;
    LAS bf16_t* T1 = (LAS bf16_t*)sW; LAS bf16_t* T2 = (LAS bf16_t*)sKD;
    const int s = tid >> 3, dg = tid & 7, d0 = dg * 8;
#pragma unroll 1
    for (int chain = bid; chain < 256; chain += G) {
        const int z = chain >> 7, b = (chain >> 4) & 7, hh = chain & 15;
        __syncthreads();
        for (int idx = tid; idx < 4096; idx += 512) { const int r = idx >> 6, d = idx & 63;
            WUPt[d * 72 + r] = (bf16_t)(pkbf(A.w_up[(size_t)(z * 64 + r) * 1024 + hh * 64 + d], 0.f) & 0xffffu);
            AUPt[d * 72 + r] = (bf16_t)(pkbf(A.a_up[(size_t)(z * 64 + r) * 1024 + hh * 64 + d], 0.f) & 0xffffu); }
        f32x2_t S2[4];
#pragma unroll
        for (int j = 0; j < 4; ++j) S2[j] = (f32x2_t){0.f, 0.f};
        bf16_t* Yz = z ? A.Y1 : A.Y0;
        const int c_r = hh * 64 + d0, c_k = 1024 + hh * 64 + d0, c_v = 2048 + hh * 64 + d0, c_wd = 3072 + z * 64 + d0, c_ad = 3200 + z * 64 + d0;
#define RW_ROWOF(c, rowv, hmv, hpv) do { const int sidx_ = (c) * 64 + s; int L_, n_, rb_; \
            if ((c) < 4) { L_ = 256; n_ = z ? (255 - sidx_) : sidx_; rb_ = TL + b * 256; } else { L_ = 4096; const int sl_ = sidx_ - 256; n_ = z ? (4095 - sl_) : sl_; rb_ = b * 4096; } \
            rowv = (size_t)(rb_ + n_); hmv = n_ > 0; hpv = n_ < L_ - 1; } while (0)
        size_t row; bool hm, hp;
        RW_ROWOF(0, row, hm, hp);
        Raw3 Rr = ld3(A.P, row, c_r, hm, hp), Rk = ld3(A.P, row, c_k, hm, hp), Rv = ld3(A.P, row, c_v, hm, hp), Rw = ld3(A.P, row, c_wd, hm, hp), Ra = ld3(A.P, row, c_ad, hm, hp);
#pragma unroll 1
        for (int c = 0; c < 68; ++c) {
            asm volatile("" ::: "memory");
            const size_t crow_ = row;
            {
                float r8[8], k8[8], v8[8], t8[8];
                shift8(Rr, A.mu, c_r, r8); shift8(Rk, A.mu, c_k, k8); shift8(Rv, A.mu, c_v, v8);
                *(LAS f32x4*)(sR + s * 64 + d0) = (f32x4){r8[0], r8[1], r8[2], r8[3]}; *(LAS f32x4*)(sR + s * 64 + d0 + 4) = (f32x4){r8[4], r8[5], r8[6], r8[7]};
                *(LAS f32x4*)(sV + s * 64 + d0) = (f32x4){v8[0], v8[1], v8[2], v8[3]}; *(LAS f32x4*)(sV + s * 64 + d0 + 4) = (f32x4){v8[4], v8[5], v8[6], v8[7]};
                *(LAS f32x4*)(sB + s * 64 + d0) = (f32x4){k8[0], k8[1], k8[2], k8[3]}; *(LAS f32x4*)(sB + s * 64 + d0 + 4) = (f32x4){k8[4], k8[5], k8[6], k8[7]};
                float kkr[8], ssq = 0.f;
                const f32x4 kk0 = *(const f32x4*)(A.k_k + hh * 64 + d0), kk1 = *(const f32x4*)(A.k_k + hh * 64 + d0 + 4);
#pragma unroll
                for (int i = 0; i < 8; ++i) { kkr[i] = k8[i] * (i < 4 ? kk0[i & 3] : kk1[i & 3]); ssq += kkr[i] * kkr[i]; }
                ssq = sum8(ssq);
                const float rs = -rsqrtf(ssq + 1e-12f);
                *(LAS f32x4*)(sA + s * 64 + d0) = (f32x4){kkr[0] * rs, kkr[1] * rs, kkr[2] * rs, kkr[3] * rs}; *(LAS f32x4*)(sA + s * 64 + d0 + 4) = (f32x4){kkr[4] * rs, kkr[5] * rs, kkr[6] * rs, kkr[7] * rs};
                shift8(Rw, A.mu, c_wd, t8);
                { u32x4 o; o.x = pkbf(fast_tanh(t8[0]), fast_tanh(t8[1])); o.y = pkbf(fast_tanh(t8[2]), fast_tanh(t8[3])); o.z = pkbf(fast_tanh(t8[4]), fast_tanh(t8[5])); o.w = pkbf(fast_tanh(t8[6]), fast_tanh(t8[7]));
                  *(LAS u32x4*)(T1 + s * 72 + d0) = o; }
                shift8(Ra, A.mu, c_ad, t8);
                { u32x4 o; o.x = pkbf(t8[0], t8[1]); o.y = pkbf(t8[2], t8[3]); o.z = pkbf(t8[4], t8[5]); o.w = pkbf(t8[6], t8[7]);
                  *(LAS u32x4*)(T2 + s * 72 + d0) = o; }
            }
            if (c + 1 < 68) { RW_ROWOF(c + 1, row, hm, hp);
                Rr = ld3(A.P, row, c_r, hm, hp); Rk = ld3(A.P, row, c_k, hm, hp); Rv = ld3(A.P, row, c_v, hm, hp); Rw = ld3(A.P, row, c_wd, hm, hp); Ra = ld3(A.P, row, c_ad, hm, hp); }
            __syncthreads();
            const int mt = q & 3, nh = q >> 2, fr = lane & 15, fq = lane >> 4;
            f32x4 accw[2], acca[2];
            {
                bfx8 aw[2], aa[2];
#pragma unroll
                for (int kk = 0; kk < 2; ++kk) { aw[kk] = *(const LAS bfx8*)(T1 + (16 * mt + fr) * 72 + kk * 32 + fq * 8); aa[kk] = *(const LAS bfx8*)(T2 + (16 * mt + fr) * 72 + kk * 32 + fq * 8); }
#pragma unroll
                for (int nt = 0; nt < 2; ++nt) { accw[nt] = (f32x4){0.f, 0.f, 0.f, 0.f}; acca[nt] = (f32x4){0.f, 0.f, 0.f, 0.f};
#pragma unroll
                    for (int kk = 0; kk < 2; ++kk) {
                        const bfx8 bw = *(const LAS bfx8*)(WUPt + (32 * nh + 16 * nt + fr) * 72 + kk * 32 + fq * 8), ba = *(const LAS bfx8*)(AUPt + (32 * nh + 16 * nt + fr) * 72 + kk * 32 + fq * 8);
                        accw[nt] = __builtin_amdgcn_mfma_f32_16x16x32_bf16(aw[kk], bw, accw[nt], 0, 0, 0);
                        acca[nt] = __builtin_amdgcn_mfma_f32_16x16x32_bf16(aa[kk], ba, acca[nt], 0, 0, 0); } }
            }
            __syncthreads();
#pragma unroll
            for (int nt = 0; nt < 2; ++nt) { const int d = 32 * nh + 16 * nt + fr, dcol = hh * 64 + d;
                const float w0d = A.w0[z * 1024 + dcol], a0d = A.a0[z * 1024 + dcol], kad = A.k_a[dcol];
#pragma unroll
                for (int j = 0; j < 4; ++j) { const int idx = (16 * mt + 4 * fq + j) * 64 + d;
                    const float x = -(w0d + accw[nt][j]);
                    const float sp = fmaxf(x, 0.f) + __logf(1.f + __expf(-fabsf(x)));
                    const float w = __expf(-__expf(-sp - 0.5f));
                    const float asig = fast_sigmoid(a0d + acca[nt][j]);
                    const float nkk = sA[idx], kraw = sB[idx];
                    sW[idx] = w; sB[idx] = -nkk * asig; sKD[idx] = kraw * (1.f + (asig - 1.f) * kad); } }
            __syncthreads();
            {
                const f32x4 ra = *(const LAS f32x4*)(sR + s * 64 + d0), rb = *(const LAS f32x4*)(sR + s * 64 + d0 + 4), ka = *(const LAS f32x4*)(sKD + s * 64 + d0), kb = *(const LAS f32x4*)(sKD + s * 64 + d0 + 4);
                const f32x4 q0 = *(const f32x4*)(A.r_k + hh * 64 + d0), q1 = *(const f32x4*)(A.r_k + hh * 64 + d0 + 4);
                float bz = 0.f;
#pragma unroll
                for (int i = 0; i < 4; ++i) { bz += ra[i] * ka[i] * q0[i]; bz += rb[i] * kb[i] * q1[i]; }
                bz = sum8(bz);
                if (dg == 0) A.BZ[((size_t)z * TT + crow_) * 16 + hh] = bz;
            }
            {
                const int rl = lane >> 3, cg = lane & 7, irow = 8 * q + rl;
                const LAS float* bw = sW + 8 * cg; const LAS float* ba_ = sA + 8 * cg; const LAS float* bb_ = sB + 8 * cg; const LAS float* bk = sKD + 8 * cg; const LAS float* br = sR + 8 * cg;
                LAS float* bv = sV + irow;
                f32x4 w0 = *(const LAS f32x4*)(bw), w1 = *(const LAS f32x4*)(bw + 4), a0 = *(const LAS f32x4*)(ba_), a1 = *(const LAS f32x4*)(ba_ + 4);
                f32x4 b0 = *(const LAS f32x4*)(bb_), b1 = *(const LAS f32x4*)(bb_ + 4), k0 = *(const LAS f32x4*)(bk), k1 = *(const LAS f32x4*)(bk + 4);
                f32x4 r0 = *(const LAS f32x4*)(br), r1 = *(const LAS f32x4*)(br + 4); float vi = bv[0];
#pragma unroll 2
                for (int st = 0; st < 64; ++st) {
                    const int on = ((st + 1) & 63) * 64;
                    const f32x4 nw0 = *(const LAS f32x4*)(bw + on), nw1 = *(const LAS f32x4*)(bw + on + 4), na0 = *(const LAS f32x4*)(ba_ + on), na1 = *(const LAS f32x4*)(ba_ + on + 4);
                    const f32x4 nb0 = *(const LAS f32x4*)(bb_ + on), nb1 = *(const LAS f32x4*)(bb_ + on + 4), nk0 = *(const LAS f32x4*)(bk + on), nk1 = *(const LAS f32x4*)(bk + on + 4);
                    const f32x4 nr0 = *(const LAS f32x4*)(br + on), nr1 = *(const LAS f32x4*)(br + on + 4); const float nvi = bv[on];
                    f32x2_t pp2 = S2[0] * (f32x2_t){a0[0], a0[1]};
                    pp2 = S2[1] * (f32x2_t){a0[2], a0[3]} + pp2; pp2 = S2[2] * (f32x2_t){a1[0], a1[1]} + pp2; pp2 = S2[3] * (f32x2_t){a1[2], a1[3]} + pp2;
                    const float sa = sum8(pp2.x + pp2.y);
                    const f32x2_t sa2 = {sa, sa}, v2 = {vi, vi};
                    S2[0] = S2[0] * (f32x2_t){w0[0], w0[1]} + sa2 * (f32x2_t){b0[0], b0[1]} + v2 * (f32x2_t){k0[0], k0[1]};
                    S2[1] = S2[1] * (f32x2_t){w0[2], w0[3]} + sa2 * (f32x2_t){b0[2], b0[3]} + v2 * (f32x2_t){k0[2], k0[3]};
                    S2[2] = S2[2] * (f32x2_t){w1[0], w1[1]} + sa2 * (f32x2_t){b1[0], b1[1]} + v2 * (f32x2_t){k1[0], k1[1]};
                    S2[3] = S2[3] * (f32x2_t){w1[2], w1[3]} + sa2 * (f32x2_t){b1[2], b1[3]} + v2 * (f32x2_t){k1[2], k1[3]};
                    f32x2_t y2 = S2[0] * (f32x2_t){r0[0], r0[1]};
                    y2 = S2[1] * (f32x2_t){r0[2], r0[3]} + y2; y2 = S2[2] * (f32x2_t){r1[0], r1[1]} + y2; y2 = S2[3] * (f32x2_t){r1[2], r1[3]} + y2;
                    const float yv = sum8(y2.x + y2.y);
                    if (cg == 0) bv[st * 64] = yv;
                    w0 = nw0; w1 = nw1; a0 = na0; a1 = na1; b0 = nb0; b1 = nb1; k0 = nk0; k1 = nk1; r0 = nr0; r1 = nr1; vi = nvi;
                }
            }
            __syncthreads();
            { u32x4 o; const LAS float* yr = sV + s * 64 + d0;
              o.x = pkbf(yr[0], yr[1]); o.y = pkbf(yr[2], yr[3]); o.z = pkbf(yr[4], yr[5]); o.w = pkbf(yr[6], yr[7]);
              *(u32x4*)(Yz + crow_ * 1024 + hh * 64 + d0) = o; }
            __syncthreads();
        }
#undef RW_ROWOF
    }
}
__device__ __forceinline__ void rwkv_out(const RwArgs& A, const float* ln_w, const float* ln_b, bf16_t* OG, int G, int bid) {
    const int tid_ = opaque_tid(); const int lane = tid_ & 63, wid = tid_ >> 6; const int c0 = lane * 16, head = lane >> 2;
    for (int row = bid * 8 + wid; row < TT; row += G * 8) {
        const bool lat = row < TL; const int L = lat ? 4096 : 256; const int n = lat ? (row & 4095) : ((row - TL) & 255); const bool hm = n > 0, hp = n < L - 1;
        float y[16], vv[16];
        { const u32x4 a0 = *(const u32x4*)(A.Y0 + (size_t)row * 1024 + c0), a1 = *(const u32x4*)(A.Y0 + (size_t)row * 1024 + c0 + 8);
          const u32x4 b0 = *(const u32x4*)(A.Y1 + (size_t)row * 1024 + c0), b1 = *(const u32x4*)(A.Y1 + (size_t)row * 1024 + c0 + 8);
#pragma unroll
          for (int i = 0; i < 4; ++i) { y[2 * i] = bflo(a0[i]) + bflo(b0[i]); y[2 * i + 1] = bfhi(a0[i]) + bfhi(b0[i]); y[8 + 2 * i] = bflo(a1[i]) + bflo(b1[i]); y[8 + 2 * i + 1] = bfhi(a1[i]) + bfhi(b1[i]); } }
        float s1 = 0.f;
#pragma unroll
        for (int i = 0; i < 16; ++i) s1 += y[i];
        s1 += __shfl_xor(s1, 1); s1 += __shfl_xor(s1, 2); const float mean = s1 * (1.f / 64.f);
        float s2 = 0.f;
#pragma unroll
        for (int i = 0; i < 16; ++i) { y[i] -= mean; s2 += y[i] * y[i]; }
        s2 += __shfl_xor(s2, 1); s2 += __shfl_xor(s2, 2); const float rstd = rsqrtf(s2 * (1.f / 64.f) + 64e-5f);
        sh8(A.P, (size_t)row, 2048 + c0, hm, hp, A.mu, vv); sh8(A.P, (size_t)row, 2048 + c0 + 8, hm, hp, A.mu, vv + 8);
        const float bz = 0.5f * (A.BZ[(size_t)row * 16 + head] + A.BZ[((size_t)TT + row) * 16 + head]);
        const u32x4 z0 = *(const u32x4*)(A.P + (size_t)row * RWN + 3328 + c0), z1 = *(const u32x4*)(A.P + (size_t)row * RWN + 3328 + c0 + 8);
        float ov[16];
#pragma unroll
        for (int i = 0; i < 16; ++i) { const unsigned zw = (i < 8) ? z0[(i >> 1) & 3] : z1[(i >> 1) & 3]; const float zz = (i & 1) ? bfhi(zw) : bflo(zw);
            ov[i] = (y[i] * rstd * ln_w[c0 + i] + ln_b[c0 + i] + bz * vv[i]) * silu_f(zz); }
        u32x4 o0, o1; o0.x = pkbf(ov[0], ov[1]); o0.y = pkbf(ov[2], ov[3]); o0.z = pkbf(ov[4], ov[5]); o0.w = pkbf(ov[6], ov[7]);
        o1.x = pkbf(ov[8], ov[9]); o1.y = pkbf(ov[10], ov[11]); o1.z = pkbf(ov[12], ov[13]); o1.w = pkbf(ov[14], ov[15]);
        *(u32x4*)(OG + (size_t)row * 1024 + c0) = o0; *(u32x4*)(OG + (size_t)row * 1024 + c0 + 8) = o1;
    }
}
#ifdef SKIP_GEMM
#define GEMM_PHASE(EPI, AP, BP, MM, NN, KK, EOBJ) do { (void)EOBJ; } while (0)
#else
#define GEMM_PHASE(EPI, AP, BP, MM, NN, KK, EOBJ) do { pg8::Gemm g_{(const bf16_t*)(AP), (const bf16_t*)(BP), (MM), (NN), (KK)}; pg8::StaticOrder S_; S_.init((MM), (NN), G, bid); \
    pg8::gemm_phase<EPI, pg8::StaticOrder, true, true>((PG8_LAS unsigned char*)lds, g_, S_, EOBJ); } while (0)
#endif
#ifdef SKIP_EpiAttnIn
#define GEMM_PHASE_EpiAttnIn(EPI, AP, BP, MM, NN, KK, EOBJ) do { (void)EOBJ; } while (0)
#else
#define GEMM_PHASE_EpiAttnIn GEMM_PHASE
#endif
#ifdef SKIP_EpiFnT
#define GEMM_PHASE_EpiFnT(EPI, AP, BP, MM, NN, KK, EOBJ) do { (void)EOBJ; } while (0)
#else
#define GEMM_PHASE_EpiFnT GEMM_PHASE
#endif
#ifdef SKIP_EpiPlain
#define GEMM_PHASE_EpiPlain(EPI, AP, BP, MM, NN, KK, EOBJ) do { (void)EOBJ; } while (0)
#else
#define GEMM_PHASE_EpiPlain GEMM_PHASE
#endif
#ifdef SKIP_EpiDft
#define GEMM_PHASE_EpiDft(EPI, AP, BP, MM, NN, KK, EOBJ) do { (void)EOBJ; } while (0)
#else
#define GEMM_PHASE_EpiDft GEMM_PHASE
#endif
#ifdef SKIP_EpiResid
#define GEMM_PHASE_EpiResid(EPI, AP, BP, MM, NN, KK, EOBJ) do { (void)EOBJ; } while (0)
#else
#define GEMM_PHASE_EpiResid GEMM_PHASE
#endif
#define XB_TMO      128
#define XB_XCNT(j)  (256  + 64 * (j))
#define XB_XSUB(j)  (1280 + 64 * (j))
#define XB_XGEN(j)  (2304 + 64 * (j))
#define XB_TOP      3328
#define XB_TOPGEN   3392
#define XCD_BAR_WORDS 3456
#define XB_SPIN_CAP (1u << 18)

__device__ __forceinline__ unsigned xb_ld(unsigned* p)              { return __hip_atomic_load(p, __ATOMIC_RELAXED, __HIP_MEMORY_SCOPE_AGENT); }
__device__ __forceinline__ unsigned xb_add(unsigned* p, unsigned v) { return __hip_atomic_fetch_add(p, v, __ATOMIC_RELAXED, __HIP_MEMORY_SCOPE_AGENT); }
__device__ __forceinline__ unsigned xb_xcc_id() { return (unsigned)__builtin_amdgcn_s_getreg((3 << 11) | 20) & 0xFu; }
#define XB_SPIN(cond, bar) do { unsigned _sp = 0; while (cond) { __builtin_amdgcn_s_sleep(1); \
    if ((++_sp & 255u) == 0u) { if (xb_ld(&(bar)[XB_TMO])) break; if (_sp > XB_SPIN_CAP) { atomicAdd(&(bar)[XB_TMO], 1u); break; } } } } while (0)

struct XcdBarrier {
    unsigned* bar; unsigned x;
    volatile LAS unsigned* st;
};

__device__ __forceinline__ XcdBarrier xcd_barrier_post(unsigned* bar, volatile LAS unsigned* st) {
    XcdBarrier b; b.bar = bar; b.x = xb_xcc_id(); b.st = st;
    if (threadIdx.x == 0) (void)xb_add(&bar[XB_XCNT(b.x)], 1u);
    return b;
}
__device__ __forceinline__ void xcd_barrier_complete(unsigned* bar, unsigned x, unsigned& nloc, unsigned& nx) {
    const unsigned G = gridDim.x * gridDim.y * gridDim.z;
    unsigned sum, cnt, mine, sp = 0u;
    for (;;) {
        sum = 0u; cnt = 0u; mine = 0u;
#pragma unroll
        for (unsigned j = 0; j < 16; ++j) { const unsigned c = xb_ld(&bar[XB_XCNT(j)]); sum += c; cnt += (c > 0u) ? 1u : 0u; mine = (j == x) ? c : mine; }
        if (sum == G) break;
        __builtin_amdgcn_s_sleep(1);
        if ((++sp & 255u) == 0u) { if (xb_ld(&bar[XB_TMO])) break; if (sp > XB_SPIN_CAP) { atomicAdd(&bar[XB_TMO], 1u); break; } }
    }
    nloc = mine > 0u ? mine : 1u; nx = cnt > 0u ? cnt : 1u;
}

__device__ __forceinline__ void xcd_barrier(const XcdBarrier& b) {
    asm volatile("s_waitcnt vmcnt(0)" ::: "memory");
    __syncthreads();
    if (threadIdx.x == 0) {
        unsigned* bar = b.bar;
        __builtin_amdgcn_s_waitcnt(0);
        unsigned nloc = b.st[0], nx = b.st[1];
        if (nloc == 0u) { xcd_barrier_complete(bar, b.x, nloc, nx); b.st[0] = nloc; b.st[1] = nx; }
        const unsigned old = xb_add(&bar[XB_XSUB(b.x)], 1u);
        const unsigned gen = old / nloc;
        if (old + 1u == (gen + 1u) * nloc) {
            __builtin_amdgcn_fence(__ATOMIC_RELEASE, "agent");
            asm volatile("s_waitcnt vmcnt(0)" ::: "memory");
            const unsigned og = xb_add(&bar[XB_TOP], 1u);
            const unsigned tg = og / nx;
            if (og + 1u == (tg + 1u) * nx) xb_add(&bar[XB_TOPGEN], 1u);
            else XB_SPIN(xb_ld(&bar[XB_TOPGEN]) == tg, bar);
            __builtin_amdgcn_fence(__ATOMIC_ACQUIRE, "agent");
            xb_add(&bar[XB_XGEN(b.x)], 1u);
            asm volatile("s_waitcnt vmcnt(0)" ::: "memory");
        } else {
            XB_SPIN(xb_ld(&bar[XB_XGEN(b.x)]) == gen, bar);
            __builtin_amdgcn_fence(__ATOMIC_ACQUIRE, "agent");
            asm volatile("s_waitcnt vmcnt(0)" ::: "memory");
        }
    }
    __syncthreads();
}

#define GRID_SYNC() xcd_barrier(xbar)
template <int layer> __device__ __forceinline__ void layer_body(const Params& p, LAS char* lds, const XcdBarrier& xbar, int G, int bid) {
    unsigned char* ws = p.ws;
    float* mod = (float*)(ws + WS_MOD);
    const float* ropeC = (const float*)(ws + WS_ROPE); const float* ropeS = ropeC + 1024;
    bf16_t* Hb = (bf16_t*)(ws + WS_HB);
    float* XC = (float*)(ws + WS_XC);
    const float* x_in = p.in[0]; const float* ctx_in = p.in[2];
        const float* xl = layer == 0 ? x_in : p.out; const float* xc = layer == 0 ? ctx_in : XC;
        const float* modl = mod + (size_t)layer * 9 * 3072;
        ph_phase(xl, xc, p.in[4] + layer * 1024, modl, Hb, G, bid);
#ifdef PROBE_PH2
        ph_phase(xl, xc, p.in[4] + layer * 1024, modl, Hb, G, bid);
#endif
        GRID_SYNC();
        const int Mout = (layer == 3) ? TL : TT;
        const bf16_t* Wout;
        if constexpr (layer == 0 || layer == 3) {
            const int j = layer == 0 ? 0 : 1;
            pg8::EpiAttnIn E{(bf16_t*)(ws + WS_Q), (bf16_t*)(ws + WS_K), (bf16_t*)(ws + WS_V), (bf16_t*)(ws + WS_Z), ropeC, ropeS};
            GEMM_PHASE_EpiAttnIn(pg8::EpiAttnIn, Hb, ws + WS_WDAIN + (size_t)j * 8 * MiB, TT, 4096, 1024, E);
#ifdef PROBE_GIN2
            GEMM_PHASE_EpiAttnIn(pg8::EpiAttnIn, Hb, ws + WS_WDAIN + (size_t)j * 8 * MiB, TT, 4096, 1024, E);
#endif
            GRID_SYNC();
            float lam;
            { const int lane = opaque_tid() & 63; const float* lq = p.in[9] + j * 128; const float* lk = p.in[10] + j * 128;
              const float s0 = wave_sum(lq[lane] * lk[lane]), s1 = wave_sum(lq[64 + lane] * lk[64 + lane]);
              const float li = 0.8f - 0.6f * expf(-0.3f * (float)layer); lam = expf(s0) - expf(s1) + li;
              att::Args A{(const bf16_t*)(ws + WS_Q), (const bf16_t*)(ws + WS_K), (const bf16_t*)(ws + WS_V), (const bf16_t*)(ws + WS_Z), Hb, p.in[11] + j * 128, lam, 1.f - li, layer == 3 ? 1024 : 1088, (unsigned*)(ws + WS_Y1) + (size_t)bid * 8 * 2048};
#ifndef SKIP_ATT
              att::attn_phase(A, lds, G, bid);
#endif
#ifdef PROBE_ATT2
              att::attn_phase(A, lds, G, bid);
#endif
            }
            GRID_SYNC();
            Wout = (const bf16_t*)(ws + WS_WDAOUT + (size_t)j * 2 * MiB);
        } else if constexpr (layer == 1) {
            { pg8::EpiFnT E{(bf16_t*)(ws + WS_ATL), (bf16_t*)(ws + WS_ATC)};
              GEMM_PHASE_EpiFnT(pg8::EpiFnT, ws + WS_WFNT, Hb, 2048, TT, 1024, E); }
            { pg8::EpiPlain E{(bf16_t*)(ws + WS_ZB), 1024};
              GEMM_PHASE_EpiPlain(pg8::EpiPlain, Hb, ws + WS_WFNZ, TT, 1024, 1024, E); }
            GRID_SYNC();
            fnet_fold((const bf16_t*)(ws + WS_ATL), (bf16_t*)(ws + WS_FOLD), (bf16_t*)(ws + WS_FOLD + 32 * MiB), (float*)(ws + WS_BZ), (const bf16_t*)(ws + WS_ZB), Hb, G, bid);
            GRID_SYNC();
            { pg8::EpiPlain E{(bf16_t*)(ws + WS_ATL), 8192};
              GEMM_PHASE_EpiPlain(pg8::EpiPlain, ws + WS_DFTL, ws + WS_FOLD, 2048, 8192, 2048, E); }
            GRID_SYNC();
            { pg8::EpiDftSym E{(const bf16_t*)(ws + WS_ATL), (const float*)(ws + WS_BZ), (const bf16_t*)(ws + WS_ZB), Hb};
              GEMM_PHASE(pg8::EpiDftSym, ws + WS_DFTL + 8 * MiB, ws + WS_FOLD + 32 * MiB, 2048, 8192, 2048, E); }
            { pg8::EpiDft E{(const bf16_t*)(ws + WS_ZB), Hb, TL, 256};
              GEMM_PHASE_EpiDft(pg8::EpiDft, ws + WS_DFTC, ws + WS_ATC, 256, 8192, 512, E); }
            GRID_SYNC();
            Wout = (const bf16_t*)(ws + WS_WFNOUT);
        } else {
            { pg8::EpiPlain E{(bf16_t*)(ws + WS_P), RWN};
              GEMM_PHASE_EpiPlain(pg8::EpiPlain, Hb, ws + WS_WRWIN, TT, RWN, 1024, E); }
            GRID_SYNC();
            RwArgs A{(const bf16_t*)(ws + WS_P), Hb, (bf16_t*)(ws + WS_Y1), (float*)(ws + WS_BZ), p.in[17], p.in[18], p.in[19], p.in[20], p.in[21], p.in[22], p.in[23], p.in[24]};
#ifndef SKIP_SCAN
            rwkv_scan(A, lds, G, bid);
#endif
#ifdef PROBE_SCAN2
            rwkv_scan(A, lds, G, bid);
#endif
            GRID_SYNC();
#ifndef SKIP_RWOUT
            rwkv_out(A, p.in[25], p.in[26], Hb, G, bid);
#endif
            GRID_SYNC();
            Wout = (const bf16_t*)(ws + WS_WRWOUT);
        }
        { pg8::EpiResid E{xl, xc, p.out, XC, modl + 2048};
          GEMM_PHASE_EpiResid(pg8::EpiResid, Hb, Wout, Mout, 1024, 1024, E);
#ifdef PROBE_OUT2
          if (layer == 0) { GEMM_PHASE_EpiResid(pg8::EpiResid, Hb, Wout, Mout, 1024, 1024, E); }
#endif
        }
        GRID_SYNC();
    }
__global__ void __launch_bounds__(512, 2) fwd_megakernel(Params p) {
    extern __shared__ __attribute__((aligned(16))) unsigned char lds_raw[];
    LAS char* lds = (LAS char*)lds_raw;
    cg::grid_group grid = cg::this_grid();
    const int G = gridDim.x, bid = blockIdx.x;
    volatile LAS unsigned* xst = (volatile LAS unsigned*)(lds + LDS_BYTES - 256);
    if (threadIdx.x < 2) xst[threadIdx.x] = 0u;
    __syncthreads();
    const XcdBarrier xbar = xcd_barrier_post((unsigned*)(p.ws + WS_CTL), xst);

#ifndef SKIP_PRO
    prologue(p, lds, G, bid);
#endif
#ifdef PROBE_PRO2
    __syncthreads(); prologue(p, lds, G, bid);
#endif
    grid.sync();
    layer_body<0>(p, lds, xbar, G, bid);
    layer_body<1>(p, lds, xbar, G, bid);
    layer_body<2>(p, lds, xbar, G, bid);
    layer_body<3>(p, lds, xbar, G, bid);
    final_phase(p.out, p.in[7], G, bid);
}

extern "C" void kernel_launch(void* const* d_in, const int* in_sizes, int n_in, void* d_out, int out_size, void* d_ws, size_t ws_size, hipStream_t stream) {
    static int grid = 0;
    if (grid == 0) {
        if (n_in != 28 || out_size != TL * 1024 || ws_size < WS_END) { fprintf(stderr, "kernel_launch: unexpected shapes: n_in %d out %d ws %zu\n", n_in, out_size, ws_size); grid = -1; return; }
        int dev = 0, cus = 0, per_cu = 0;
        hipGetDevice(&dev); hipDeviceGetAttribute(&cus, hipDeviceAttributeMultiprocessorCount, dev);
        if (hipFuncSetAttribute((const void*)fwd_megakernel, hipFuncAttributeMaxDynamicSharedMemorySize, LDS_BYTES) != hipSuccess) { fprintf(stderr, "kernel_launch: hipFuncSetAttribute failed\n"); grid = -1; return; }
        if (hipOccupancyMaxActiveBlocksPerMultiprocessor(&per_cu, (const void*)fwd_megakernel, 512, LDS_BYTES) != hipSuccess || per_cu < 1) { fprintf(stderr, "kernel_launch: occupancy query failed (%d)\n", per_cu); per_cu = 1; }
        (void)hipGetLastError();
        grid = cus * per_cu;
    }
    if (grid < 0) return;
    if (hipMemsetAsync((char*)d_ws + WS_CTL, 0, 65536, stream) != hipSuccess) { fprintf(stderr, "kernel_launch: hipMemsetAsync failed\n"); return; }
    Params p{};
    for (int i = 0; i < 28; ++i) p.in[i] = (const float*)d_in[i];
    p.out = (float*)d_out; p.ws = (unsigned char*)d_ws;
    void* args[] = {&p};
    hipError_t e = hipLaunchCooperativeKernel((const void*)fwd_megakernel, dim3(grid), dim3(512), args, LDS_BYTES, stream);
    if (e != hipSuccess) fprintf(stderr, "cooperative launch failed: %s (grid %d)\n", hipGetErrorString(e), grid);
}
```

```cpp
#include <hip/hip_runtime.h>
#include <hip/hip_cooperative_groups.h>
#include <cstdio>
#include <cstdint>
#include <cmath>
namespace cg = cooperative_groups;

constexpr int TL = 32768, TCX = 2048, TT = TL + TCX, DM = 1024;
constexpr float QK_C2 = 0.125f * 1.4426950408889634f;
typedef float f32x2_t __attribute__((ext_vector_type(2)));
typedef __bf16 bf16x2_t __attribute__((ext_vector_type(2)));
__device__ __forceinline__ unsigned pkbf(float lo, float hi) { f32x2_t v = {lo, hi}; bf16x2_t b = __builtin_convertvector(v, bf16x2_t); return __builtin_bit_cast(unsigned, b); }
__device__ __forceinline__ float bflo(unsigned u) { return __uint_as_float(u << 16); }
__device__ __forceinline__ float bfhi(unsigned u) { return __uint_as_float(u & 0xffff0000u); }
__device__ __forceinline__ float bf1(unsigned short u) { return __uint_as_float(((unsigned)u) << 16); }
__device__ __forceinline__ float silu_f(float z) { return z * __builtin_amdgcn_rcpf(1.f + __expf(-z)); }
__device__ __forceinline__ int opaque_tid() { int t = threadIdx.x; asm volatile("" : "+v"(t)); return t; }
namespace pg8 {
#define PG8_LAS __attribute__((address_space(3)))
typedef unsigned short bf16_t;
typedef short bf16x8 __attribute__((ext_vector_type(8)));
typedef float f32x4 __attribute__((ext_vector_type(4)));
typedef unsigned u32x4 __attribute__((ext_vector_type(4)));
constexpr int BM = 256, BK = 64, HALF = 128, HTB = HALF * BK * 2  , STAGE_BYTES = 8 * HTB, NXCD = 8, WGM = 8;

__host__ __device__ __forceinline__ int lds_byte(int r, int c) { const int st = (r >> 4) * 2 + (c >> 5), rr = r & 15, cc = c & 31, ob = rr * 64 + cc * 2; return st * 1024 + (ob ^ (((ob >> 9) & 1) << 5)); }
__host__ __device__ __forceinline__ void stage_rc(int b, int& R, int& C) { const int st = b / 1024, sb = b % 1024, swz = sb ^ (((sb >> 9) & 1) << 5); R = (st >> 1) * 16 + swz / 64; C = (st & 1) * 32 + (swz % 64) / 2; }
__host__ __device__ __forceinline__ int perm32(int rho) { const int n = rho >> 4, i = rho & 15; return 8 * (i >> 2) + 4 * n + (i & 3); }

struct Unit { int pm, pn; };
struct Gemm { const bf16_t* A; const bf16_t* Bt; int M, N, K; };

struct StaticOrder {
    int nM, nN, nwg, G, c;
    __host__ __device__ void init(int M, int N, int G_, int c_) { nM = M / BM; nN = N / BM; nwg = nM * nN; G = G_; c = c_; }
    __host__ __device__ bool next(int i, Unit& u) const {
        const long L = (long)i * G + c; if (L >= nwg) return false;
        int wgid = (int)L; { const int q = nwg / NXCD, r = nwg % NXCD, xcd = wgid % NXCD, off = wgid / NXCD; wgid = (xcd < r ? xcd * (q + 1) : r * (q + 1) + (xcd - r) * q) + off; }
        const int nig = WGM * nN, gid = wgid / nig, fm = gid * WGM, gsz = (nM - fm) < WGM ? (nM - fm) : WGM;
        u.pm = fm + ((wgid % nig) % gsz); u.pn = (wgid % nig) / gsz; return true;
    }
    __device__ __forceinline__ void a_ready(const Unit&) const {}
    __device__ __forceinline__ void done(const Unit&) const {}
};

struct EpiAttnIn {
    static constexpr bool PERM = true, AFTER_DRAIN = false;
    bf16_t* Q; bf16_t* Kb; bf16_t* V; bf16_t* Z; const float* ropeC; const float* ropeS;
    __device__ __forceinline__ void operator()(const f32x4 (&acc)[2][2][4][2], const Unit& u, int wr, int wc, int fr, int fq) const {
        const int sect = u.pn >> 2;
        bf16_t* base = sect == 0 ? Q : sect == 1 ? Kb : sect == 2 ? V : Z;
        const int colt = (u.pn & 3) * 256 + wc * 32 + 8 * fq;
        const int row0 = u.pm * BM + wr * 64 + fr;
        const bool rope = (u.pm < 128) && (sect < 2);
        const float sc = (sect == 0) ? QK_C2 : 1.f;
        const int axis = wc & 1;
#pragma unroll
        for (int ai = 0; ai < 2; ++ai)
#pragma unroll
            for (int m = 0; m < 4; ++m) {
                const int row = row0 + ai * HALF + m * 16;
                const int ntok = row & 4095;
                const int pos = axis ? (ntok & 63) : (ntok >> 6);
                bf16_t* rowp;
                if (sect == 1) rowp = base + (size_t)(row >> 6) * 65536 + (size_t)(colt >> 3) * 512 + (row & 63) * 8;
                else if (sect == 2) rowp = base + (size_t)(row >> 6) * 65536 + (size_t)(colt >> 7) * 8192 + (((colt & 127) >> 5) * 4 + ((row & 63) >> 4)) * 512 + (row & 15) * 32 + (colt & 31);
                else rowp = base + (size_t)row * 1024 + colt;
#pragma unroll
                for (int bj = 0; bj < 2; ++bj) {
                    f32x4 v0 = acc[ai][bj][m][0], v1 = acc[ai][bj][m][1];
                    if (rope) {
                        const f32x4 c0 = *(const f32x4*)(ropeC + pos * 16 + 8 * (fq & 1)), c1 = *(const f32x4*)(ropeC + pos * 16 + 8 * (fq & 1) + 4);
                        const f32x4 s0 = *(const f32x4*)(ropeS + pos * 16 + 8 * (fq & 1)), s1 = *(const f32x4*)(ropeS + pos * 16 + 8 * (fq & 1) + 4);
                        f32x4 p0, p1;
#pragma unroll
                        for (int i = 0; i < 4; ++i) { p0[i] = __shfl_xor(v0[i], 32); p1[i] = __shfl_xor(v1[i], 32); }
                        if (fq < 2) { v0 = v0 * c0 - p0 * s0; v1 = v1 * c1 - p1 * s1; }
                        else        { v0 = v0 * c0 + p0 * s0; v1 = v1 * c1 + p1 * s1; }
                    }
                    v0 = v0 * sc; v1 = v1 * sc;
                    u32x4 w; w.x = pkbf(v0[0], v0[1]); w.y = pkbf(v0[2], v0[3]); w.z = pkbf(v1[0], v1[1]); w.w = pkbf(v1[2], v1[3]);
                    *(u32x4*)(rowp + (sect == 1 || sect == 2 ? bj * 8192 : bj * HALF)) = w;
                }
            }
    }
};
struct EpiPlain {
    static constexpr bool PERM = true, AFTER_DRAIN = false;
    bf16_t* O; int ldc;
    __device__ __forceinline__ void operator()(const f32x4 (&acc)[2][2][4][2], const Unit& u, int wr, int wc, int fr, int fq) const {
        const int row0 = u.pm * BM + wr * 64 + fr, col0 = u.pn * BM + wc * 32 + 8 * fq;
#pragma unroll
        for (int ai = 0; ai < 2; ++ai)
#pragma unroll
            for (int m = 0; m < 4; ++m) { bf16_t* rowp = O + (size_t)(row0 + ai * HALF + m * 16) * ldc + col0;
#pragma unroll
                for (int bj = 0; bj < 2; ++bj) { const f32x4 v0 = acc[ai][bj][m][0], v1 = acc[ai][bj][m][1];
                    u32x4 w; w.x = pkbf(v0[0], v0[1]); w.y = pkbf(v0[2], v0[3]); w.z = pkbf(v1[0], v1[1]); w.w = pkbf(v1[2], v1[3]);
                    *(u32x4*)(rowp + bj * HALF) = w; } }
    }
};
struct EpiResid {
    static constexpr bool PERM = false, AFTER_DRAIN = false;
    const float* xin_lat; const float* xin_ctx; float* xout_lat; float* xout_ctx; const float* gate;
    __device__ __forceinline__ void operator()(const f32x4 (&acc)[2][2][4][2], const Unit& u, int wr, int wc, int fr, int fq) const {
        const int rowt = u.pm * BM; const bool lat = rowt < TL; const int r = lat ? (rowt >> 12) : 8;
        const int row0 = rowt + wr * 64 + fr, col0 = u.pn * BM + wc * 32 + 4 * fq;
        const float* xi = lat ? xin_lat + (size_t)row0 * 1024 + col0 : xin_ctx + (size_t)(row0 - TL) * 1024 + col0;
        float* xo = lat ? xout_lat + (size_t)row0 * 1024 + col0 : xout_ctx + (size_t)(row0 - TL) * 1024 + col0;
        f32x4 g[2][2];
#pragma unroll
        for (int bj = 0; bj < 2; ++bj)
#pragma unroll
            for (int n = 0; n < 2; ++n) g[bj][n] = *(const f32x4*)(gate + r * 3072 + col0 + bj * HALF + n * 16);
#pragma unroll
        for (int ai = 0; ai < 2; ++ai) {
            f32x4 pre[4][2][2];
#pragma unroll
            for (int m = 0; m < 4; ++m)
#pragma unroll
                for (int bj = 0; bj < 2; ++bj)
#pragma unroll
                    for (int n = 0; n < 2; ++n) pre[m][bj][n] = *(const f32x4*)(xi + (size_t)(ai * HALF + m * 16) * 1024 + bj * HALF + n * 16);
            asm volatile("" ::: "memory");
#pragma unroll
            for (int m = 0; m < 4; ++m)
#pragma unroll
                for (int bj = 0; bj < 2; ++bj)
#pragma unroll
                    for (int n = 0; n < 2; ++n) *(f32x4*)(xo + (size_t)(ai * HALF + m * 16) * 1024 + bj * HALF + n * 16) = pre[m][bj][n] + g[bj][n] * acc[ai][bj][m][n];
            asm volatile("" ::: "memory");
        }
    }
};
struct EpiFnT {
    static constexpr bool PERM = true, AFTER_DRAIN = false;
    bf16_t* ATL; bf16_t* ATC;
    __device__ __forceinline__ void operator()(const f32x4 (&acc)[2][2][4][2], const Unit& u, int wr, int wc, int fr, int fq) const {
        const int row0 = u.pm * BM + wr * 64 + fr, col0 = u.pn * BM + wc * 32 + 8 * fq;
#pragma unroll
        for (int ai = 0; ai < 2; ++ai)
#pragma unroll
            for (int m = 0; m < 4; ++m) { const int mp = row0 + ai * HALF + m * 16, cs = mp >> 10, n = mp & 1023;
#pragma unroll
                for (int bj = 0; bj < 2; ++bj) { const int t0 = col0 + bj * HALF; bf16_t* dst;
                    if (t0 < TL) { const int b = t0 >> 12, l = t0 & 4095; dst = ATL + ((size_t)((b * 1024 + n) * 2 + cs)) * 4096 + l; }
                    else { const int tc = t0 - TL, b = tc >> 8, l = tc & 255; dst = ATC + ((size_t)((b * 1024 + n) * 2 + cs)) * 256 + l; }
                    const f32x4 v0 = acc[ai][bj][m][0], v1 = acc[ai][bj][m][1];
                    u32x4 w; w.x = pkbf(v0[0], v0[1]); w.y = pkbf(v0[2], v0[3]); w.z = pkbf(v1[0], v1[1]); w.w = pkbf(v1[2], v1[3]);
                    *(u32x4*)dst = w; } }
    }
};
struct EpiDft {
    static constexpr bool PERM = true, AFTER_DRAIN = false;
    const bf16_t* Z; bf16_t* OG; int rowbase; int L;
    __device__ __forceinline__ void operator()(const f32x4 (&acc)[2][2][4][2], const Unit& u, int wr, int wc, int fr, int fq) const {
        const int k0 = u.pm * BM + wr * 64 + fr; const int b = u.pn >> 2; const int n0 = (u.pn & 3) * 256 + wc * 32 + 8 * fq;
#pragma unroll
        for (int ai = 0; ai < 2; ++ai)
#pragma unroll
            for (int m = 0; m < 4; ++m) { const size_t R = (size_t)(rowbase + b * L + k0 + ai * HALF + m * 16);
#pragma unroll
                for (int bj = 0; bj < 2; ++bj) { const size_t off = R * 1024 + n0 + bj * HALF;
                    const u32x4 zz = *(const u32x4*)(Z + off);
                    const f32x4 v0 = acc[ai][bj][m][0], v1 = acc[ai][bj][m][1];
                    u32x4 w;
                    w.x = pkbf(v0[0] * silu_f(bflo(zz.x)), v0[1] * silu_f(bfhi(zz.x))); w.y = pkbf(v0[2] * silu_f(bflo(zz.y)), v0[3] * silu_f(bfhi(zz.y)));
                    w.z = pkbf(v1[0] * silu_f(bflo(zz.z)), v1[1] * silu_f(bfhi(zz.z))); w.w = pkbf(v1[2] * silu_f(bflo(zz.w)), v1[3] * silu_f(bfhi(zz.w)));
                    *(u32x4*)(OG + off) = w; } }
    }
};
struct EpiDftSym {
    static constexpr bool PERM = true, AFTER_DRAIN = false;
    const bf16_t* Pb; const float* TA; const bf16_t* Z; bf16_t* OG;
    __device__ __forceinline__ void operator()(const f32x4 (&acc)[2][2][4][2], const Unit& u, int wr, int wc, int fr, int fq) const {
        const int k0 = u.pm * BM + wr * 64 + fr; const int b = u.pn >> 2; const int c0 = u.pn * BM + wc * 32 + 8 * fq; const int n0 = c0 & 1023;
#pragma unroll
        for (int bj = 0; bj < 2; ++bj) {
            const f32x4 t0 = *(const f32x4*)(TA + c0 + bj * HALF), t1 = *(const f32x4*)(TA + c0 + bj * HALF + 4);
#pragma unroll
            for (int ai = 0; ai < 2; ++ai)
#pragma unroll
                for (int m = 0; m < 4; ++m) { const int k = k0 + ai * HALF + m * 16; const float sg = (k & 1) ? -1.f : 1.f;
                    const u32x4 pp = *(const u32x4*)(Pb + (size_t)k * 8192 + c0 + bj * HALF);
                    const f32x4 q0 = acc[ai][bj][m][0], q1 = acc[ai][bj][m][1];
                    float pt[8];
                    pt[0] = bflo(pp.x) + sg * t0[0]; pt[1] = bfhi(pp.x) + sg * t0[1]; pt[2] = bflo(pp.y) + sg * t0[2]; pt[3] = bfhi(pp.y) + sg * t0[3];
                    pt[4] = bflo(pp.z) + sg * t1[0]; pt[5] = bfhi(pp.z) + sg * t1[1]; pt[6] = bflo(pp.w) + sg * t1[2]; pt[7] = bfhi(pp.w) + sg * t1[3];
                    { const size_t off = (size_t)(b * 4096 + k) * 1024 + n0 + bj * HALF; const u32x4 zz = *(const u32x4*)(Z + off); u32x4 w;
                      w.x = pkbf((pt[0] - q0[0]) * silu_f(bflo(zz.x)), (pt[1] - q0[1]) * silu_f(bfhi(zz.x))); w.y = pkbf((pt[2] - q0[2]) * silu_f(bflo(zz.y)), (pt[3] - q0[3]) * silu_f(bfhi(zz.y)));
                      w.z = pkbf((pt[4] - q1[0]) * silu_f(bflo(zz.z)), (pt[5] - q1[1]) * silu_f(bfhi(zz.z))); w.w = pkbf((pt[6] - q1[2]) * silu_f(bflo(zz.w)), (pt[7] - q1[3]) * silu_f(bfhi(zz.w)));
                      *(u32x4*)(OG + off) = w; }
                    if (k >= 1) { const size_t off = (size_t)(b * 4096 + 4096 - k) * 1024 + n0 + bj * HALF; const u32x4 zz = *(const u32x4*)(Z + off); u32x4 w;
                      w.x = pkbf((pt[0] + q0[0]) * silu_f(bflo(zz.x)), (pt[1] + q0[1]) * silu_f(bfhi(zz.x))); w.y = pkbf((pt[2] + q0[2]) * silu_f(bflo(zz.y)), (pt[3] + q0[3]) * silu_f(bfhi(zz.y)));
                      w.z = pkbf((pt[4] + q1[0]) * silu_f(bflo(zz.z)), (pt[5] + q1[1]) * silu_f(bfhi(zz.z))); w.w = pkbf((pt[6] + q1[2]) * silu_f(bflo(zz.w)), (pt[7] + q1[3]) * silu_f(bfhi(zz.w)));
                      *(u32x4*)(OG + off) = w; }
                    asm volatile("" ::: "memory");
                }
        }
    }
};
template <class Epi, class Sched, bool ALIGN_EPI = false, bool SP2 = false>
__device__ __forceinline__ void gemm_phase(PG8_LAS unsigned char* lds, const Gemm g, const Sched& S, const Epi& E) {
    const int tid = opaque_tid(), wid = __builtin_amdgcn_readfirstlane(tid >> 6), lane = tid & 63, wr = wid >> 2, wc = wid & 3, fr = lane & 15, fq = lane >> 4;
    const int K = g.K, nt = K / BK;
    unsigned voffA[2], voffB[2];
#pragma unroll
    for (int i = 0; i < 2; ++i) { int R, C; stage_rc(tid * 16 + i * 8192, R, C); const int Rb = Epi::PERM ? ((R & ~31) + perm32(R & 31)) : R;
        voffA[i] = (unsigned)(R * K + C) * 2u; voffB[i] = (unsigned)(Rb * K + C) * 2u; }
    const size_t kstep = (size_t)(BK * 2);
    const size_t hstep = (size_t)HALF * K * 2;
    const size_t tstep = 2 * hstep;
    const unsigned ldsw = (unsigned)wid * 1024u;
    const int aoff = lds_byte(wr * 64 + fr, fq * 8), boff = lds_byte(wc * 32 + fr, fq * 8);
#define PG8_SA(b, h) (((b) * 2 + (h)) * HTB)
#define PG8_SB(b, h) ((4 + (b) * 2 + (h)) * HTB)
#define PG8_STAGE(bufoff, gbase, voff) do { _Pragma("unroll") for (int _i = 0; _i < 2; ++_i) \
        __builtin_amdgcn_global_load_lds((const unsigned*)((const char*)(gbase) + (voff)[_i]), (PG8_LAS unsigned*)(lds + (bufoff) + ldsw + _i * 8192), 16, 0, 0); } while (0)
#define PG8_LDA(dst, b, h) do { _Pragma("unroll") for (int m = 0; m < 4; ++m) _Pragma("unroll") for (int k = 0; k < 2; ++k) dst[m][k] = *(const PG8_LAS bf16x8*)(lds + PG8_SA(b, h) + aoff + m * 2048 + k * 1024); } while (0)
#define PG8_LDB(dst, b, h) do { _Pragma("unroll") for (int n = 0; n < 2; ++n) _Pragma("unroll") for (int k = 0; k < 2; ++k) dst[n][k] = *(const PG8_LAS bf16x8*)(lds + PG8_SB(b, h) + boff + n * 2048 + k * 1024); } while (0)
#define PG8_MMA(ai, bj, At, Bt) do { __builtin_amdgcn_s_setprio(1); _Pragma("unroll") for (int m = 0; m < 4; ++m) _Pragma("unroll") for (int n = 0; n < 2; ++n) _Pragma("unroll") for (int k = 0; k < 2; ++k) \
        acc[ai][bj][m][n] = __builtin_amdgcn_mfma_f32_16x16x32_bf16(Bt[n][k], At[m][k], acc[ai][bj][m][n], 0, 0, 0); __builtin_amdgcn_s_setprio(0); } while (0)
#define PG8_WAIT_V(n) asm volatile("s_waitcnt vmcnt(" #n ")" ::: "memory")
#define PG8_WAIT_L(n) asm volatile("s_waitcnt lgkmcnt(" #n ")" ::: "memory")
#define PG8_BAR __builtin_amdgcn_s_barrier()
#define PG8_SCHED __builtin_amdgcn_sched_barrier(0)
    Unit cur, nxt; int ui = 0;
    if (!S.next(0, cur)) return;
    f32x4 acc[2][2][4][2];
#pragma unroll
    for (int a = 0; a < 2; ++a)
#pragma unroll
        for (int b = 0; b < 2; ++b)
#pragma unroll
            for (int m = 0; m < 4; ++m)
#pragma unroll
                for (int n = 0; n < 2; ++n) acc[a][b][m][n] = (f32x4){0.f, 0.f, 0.f, 0.f};
    bf16x8 At[4][2], B0[2][2], B1[2][2];
    const char* cA = (const char*)g.A + (size_t)cur.pm * tstep; const char* cB = (const char*)g.Bt + (size_t)cur.pn * tstep;
    S.a_ready(cur);
    if constexpr (SP2) {
        PG8_STAGE(PG8_SB(0, 0), cB, voffB); PG8_STAGE(PG8_SB(0, 1), cB + hstep, voffB); PG8_STAGE(PG8_SA(0, 0), cA, voffA); PG8_STAGE(PG8_SA(0, 1), cA + hstep, voffA);
        if (wr == 1) PG8_BAR;
        PG8_WAIT_V(2); PG8_BAR;
        PG8_STAGE(PG8_SB(1, 0), cB + kstep, voffB); PG8_STAGE(PG8_SA(1, 0), cA + kstep, voffA); PG8_STAGE(PG8_SB(1, 1), cB + hstep + kstep, voffB);
        PG8_WAIT_V(6); PG8_BAR;
    } else {
        PG8_STAGE(PG8_SB(0, 0), cB, voffB); PG8_STAGE(PG8_SA(0, 0), cA, voffA); PG8_STAGE(PG8_SB(0, 1), cB + hstep, voffB); PG8_STAGE(PG8_SA(0, 1), cA + hstep, voffA);
        if (wr == 1) PG8_BAR;
        PG8_WAIT_V(4); PG8_BAR;
        PG8_STAGE(PG8_SB(1, 0), cB + kstep, voffB); PG8_STAGE(PG8_SA(1, 0), cA + kstep, voffA); PG8_STAGE(PG8_SB(1, 1), cB + hstep + kstep, voffB);
        PG8_WAIT_V(6); PG8_BAR;
    }
    for (;;) {
        const bool has_next = S.next(ui + 1, nxt);
        const char* nA = has_next ? (const char*)g.A + (size_t)nxt.pm * tstep : cA; const char* nB = has_next ? (const char*)g.Bt + (size_t)nxt.pn * tstep : cB;
        for (int t = 0; t < nt; t += 2) {
            const bool last = (t == nt - 2);
            const char* a1 = cA + (size_t)(t + 1) * kstep;
            const char* a2 = last ? nA : cA + (size_t)(t + 2) * kstep; const char* b2 = last ? nB : cB + (size_t)(t + 2) * kstep;
            const char* a3 = a2 + kstep; const char* b3 = b2 + kstep;
            if (last && has_next) S.a_ready(nxt);
            if constexpr (SP2) {
            PG8_LDB(B0, 0, 0); PG8_LDB(B1, 0, 1); PG8_SCHED; PG8_LDA(At, 0, 0); PG8_STAGE(PG8_SA(1, 1), a1 + hstep, voffA);
            PG8_WAIT_V(8); PG8_WAIT_L(0); PG8_BAR; PG8_MMA(0, 0, At, B0); PG8_MMA(0, 1, At, B1); PG8_BAR; PG8_SCHED;
            PG8_LDA(At, 0, 1); PG8_STAGE(PG8_SB(0, 0), b2, voffB); PG8_STAGE(PG8_SB(0, 1), b2 + hstep, voffB); PG8_STAGE(PG8_SA(0, 0), a2, voffA);
            PG8_WAIT_V(8); PG8_WAIT_L(0); PG8_BAR; PG8_MMA(1, 0, At, B0); PG8_MMA(1, 1, At, B1); PG8_BAR; PG8_SCHED;
            PG8_LDB(B0, 1, 0); PG8_LDB(B1, 1, 1); PG8_SCHED; PG8_LDA(At, 1, 0); PG8_STAGE(PG8_SA(0, 1), a2 + hstep, voffA);
            PG8_WAIT_V(8); PG8_WAIT_L(0); PG8_BAR; PG8_MMA(0, 0, At, B0); PG8_MMA(0, 1, At, B1); PG8_BAR; PG8_SCHED;
            PG8_LDA(At, 1, 1); PG8_STAGE(PG8_SB(1, 0), b3, voffB); PG8_STAGE(PG8_SB(1, 1), b3 + hstep, voffB); PG8_STAGE(PG8_SA(1, 0), a3, voffA);
            PG8_WAIT_V(8); PG8_WAIT_L(0); PG8_BAR; PG8_MMA(1, 0, At, B0); PG8_MMA(1, 1, At, B1); PG8_BAR; PG8_SCHED;
            } else {
            PG8_LDB(B0, 0, 0); PG8_SCHED; PG8_LDA(At, 0, 0); PG8_STAGE(PG8_SA(1, 1), a1 + hstep, voffA);
            PG8_WAIT_L(8); PG8_BAR; PG8_WAIT_L(0); PG8_MMA(0, 0, At, B0); PG8_BAR; PG8_SCHED;
            PG8_LDB(B1, 0, 1); PG8_STAGE(PG8_SB(0, 0), b2, voffB);
            PG8_BAR; PG8_WAIT_L(0); PG8_MMA(0, 1, At, B1); PG8_BAR;
            PG8_LDA(At, 0, 1); PG8_STAGE(PG8_SA(0, 0), a2, voffA);
            PG8_BAR; PG8_WAIT_L(0); PG8_MMA(1, 0, At, B0); PG8_BAR; PG8_SCHED;
            PG8_STAGE(PG8_SB(0, 1), b2 + hstep, voffB);
            PG8_WAIT_V(6); PG8_BAR; PG8_MMA(1, 1, At, B1); PG8_BAR;
            PG8_LDB(B0, 1, 0); PG8_SCHED; PG8_LDA(At, 1, 0); PG8_STAGE(PG8_SA(0, 1), a2 + hstep, voffA);
            PG8_WAIT_L(8); PG8_BAR; PG8_WAIT_L(0); PG8_MMA(0, 0, At, B0); PG8_BAR; PG8_SCHED;
            PG8_LDB(B1, 1, 1); PG8_STAGE(PG8_SB(1, 0), b3, voffB);
            PG8_BAR; PG8_WAIT_L(0); PG8_MMA(0, 1, At, B1); PG8_BAR;
            PG8_LDA(At, 1, 1); PG8_STAGE(PG8_SA(1, 0), a3, voffA);
            PG8_BAR; PG8_WAIT_L(0); PG8_MMA(1, 0, At, B0); PG8_BAR; PG8_SCHED;
            PG8_STAGE(PG8_SB(1, 1), b3 + hstep, voffB);
            PG8_WAIT_V(6); PG8_BAR; PG8_MMA(1, 1, At, B1); PG8_BAR;
            }
        }
        if constexpr (ALIGN_EPI) { if (wr == 0) PG8_BAR; }
        if constexpr (!Epi::AFTER_DRAIN) { E(acc, cur, wr, wc, fr, fq); S.done(cur); }
        if (!has_next) break;
#pragma unroll
        for (int a = 0; a < 2; ++a)
#pragma unroll
            for (int b = 0; b < 2; ++b)
#pragma unroll
                for (int m = 0; m < 4; ++m)
#pragma unroll
                    for (int n = 0; n < 2; ++n) acc[a][b][m][n] = (f32x4){0.f, 0.f, 0.f, 0.f};
        cur = nxt; cA = nA; cB = nB; ++ui;
        if constexpr (ALIGN_EPI) { if (wr == 1) PG8_BAR; }
    }
    PG8_WAIT_V(0);
    if constexpr (!ALIGN_EPI) { if (wr == 0) PG8_BAR; }
    PG8_BAR;
    if constexpr (Epi::AFTER_DRAIN) { E.fused(acc, cur, wr, wc, fr, fq, lds, wid, lane); S.done(cur); }
#undef PG8_SA
#undef PG8_SB
#undef PG8_STAGE
#undef PG8_LDA
#undef PG8_LDB
#undef PG8_MMA
#undef PG8_WAIT_V
#undef PG8_WAIT_L
#undef PG8_BAR
#undef PG8_SCHED
}
}
#define LAS __attribute__((address_space(3)))
namespace att {
using bf16x8 = __attribute__((ext_vector_type(8))) short;
using s16x4 = __attribute__((ext_vector_type(4))) short;
using f32x16 = __attribute__((ext_vector_type(16))) float;
using u32x4 = __attribute__((ext_vector_type(4))) unsigned;
typedef unsigned short bf16_t;
__device__ __forceinline__ int crow(int r, int hi) { return (r & 3) + 8 * (r >> 2) + 4 * hi; }
constexpr int KSLOT = 8192, VSLOT = 16384, LDS_K = 0, LDS_V = 3 * KSLOT, LDS_WS = LDS_V + 4 * VSLOT, LDS_CNT = LDS_WS + 2048;
struct Args { const bf16_t* Q; const bf16_t* K; const bf16_t* V; const bf16_t* Z; bf16_t* O; const float* gain; float lam; float oml; int n_units; unsigned* o1g; };

__device__ __forceinline__ void qkt(f32x16& p0, f32x16& p1, const LAS char* Kslot, const bf16x8* qr, const f32x16& negm, int r32, int hi) {
    const LAS char* kb = Kslot + hi * 1024 + r32 * 16;
    bf16x8 kf[8];
#pragma unroll
    for (int d0 = 0; d0 < 4; ++d0) { kf[2 * d0] = *(const LAS bf16x8*)(kb + d0 * 2048); kf[2 * d0 + 1] = *(const LAS bf16x8*)(kb + d0 * 2048 + 512); }
    asm volatile("s_waitcnt lgkmcnt(0)" ::: "memory"); __builtin_amdgcn_sched_barrier(0);
    p0 = __builtin_amdgcn_mfma_f32_32x32x16_bf16(kf[0], qr[0], negm, 0, 0, 0); p1 = __builtin_amdgcn_mfma_f32_32x32x16_bf16(kf[1], qr[0], negm, 0, 0, 0);
#pragma unroll
    for (int d0 = 1; d0 < 4; ++d0) { p0 = __builtin_amdgcn_mfma_f32_32x32x16_bf16(kf[2 * d0], qr[d0], p0, 0, 0, 0); p1 = __builtin_amdgcn_mfma_f32_32x32x16_bf16(kf[2 * d0 + 1], qr[d0], p1, 0, 0, 0); }
}
__device__ __forceinline__ void kload(bf16x8* kf, const LAS char* Kslot, int r32, int hi) {
    const LAS char* kb = Kslot + hi * 1024 + r32 * 16;
#pragma unroll
    for (int d0 = 0; d0 < 4; ++d0) { kf[2 * d0] = *(const LAS bf16x8*)(kb + d0 * 2048); kf[2 * d0 + 1] = *(const LAS bf16x8*)(kb + d0 * 2048 + 512); }
}
__device__ __forceinline__ void qk_mm(f32x16& p0, f32x16& p1, const bf16x8* kf, const bf16x8* qr, const f32x16& z) {
    p0 = __builtin_amdgcn_mfma_f32_32x32x16_bf16(kf[0], qr[0], z, 0, 0, 0); p1 = __builtin_amdgcn_mfma_f32_32x32x16_bf16(kf[1], qr[0], z, 0, 0, 0);
#pragma unroll
    for (int d0 = 1; d0 < 4; ++d0) { p0 = __builtin_amdgcn_mfma_f32_32x32x16_bf16(kf[2 * d0], qr[d0], p0, 0, 0, 0); p1 = __builtin_amdgcn_mfma_f32_32x32x16_bf16(kf[2 * d0 + 1], qr[d0], p1, 0, 0, 0); }
}
__device__ __forceinline__ float max3a(float a, float b, float c) { float r; asm("v_max3_f32 %0, %1, %2, %3" : "=v"(r) : "v"(a), "v"(b), "v"(c)); return r; }
__device__ __forceinline__ float rowmax(const f32x16& p0, const f32x16& p1) {
    float a = max3a(p0[0], p0[1], p0[2]), b = max3a(p1[0], p1[1], p1[2]);
#pragma unroll
    for (int r = 3; r < 15; r += 2) { a = max3a(a, p0[r], p0[r + 1]); b = max3a(b, p1[r], p1[r + 1]); }
    a = max3a(a, p0[15], p1[15]);
    float m; asm("v_max_f32 %0, %1, %2" : "=v"(m) : "v"(a), "v"(b));
    asm volatile("s_nop 1" ::: "memory");
    auto rr = __builtin_amdgcn_permlane32_swap(__float_as_uint(m), __float_as_uint(m), false, false);
    float o; asm("v_max_f32 %0, %1, %2" : "=v"(o) : "v"(__uint_as_float(rr[0])), "v"(__uint_as_float(rr[1])));
    return o;
}
#define ATT_VRD(buf, d0) do { _Pragma("unroll") for (int ks = 0; ks < 4; ++ks) { \
        asm volatile("ds_read_b64_tr_b16 %0,%1 offset:%c2" : "=&v"(lo[buf][ks]) : "v"(vb), "i"((d0) * 4096 + ks * 1024) : "memory"); \
        asm volatile("ds_read_b64_tr_b16 %0,%1 offset:%c2" : "=&v"(hi[buf][ks]) : "v"(vb), "i"((d0) * 4096 + ks * 1024 + 512) : "memory"); } } while (0)
#define ATT_PK(b, k) (bf16x8){lo[b][k][0], lo[b][k][1], lo[b][k][2], lo[b][k][3], hi[b][k][0], hi[b][k][1], hi[b][k][2], hi[b][k][3]}
#define ATT_MM2(da, db) do { \
        o[da] = __builtin_amdgcn_mfma_f32_32x32x16_bf16(pa0, ATT_PK(0, 0), o[da], 0, 0, 0); o[db] = __builtin_amdgcn_mfma_f32_32x32x16_bf16(pa0, ATT_PK(1, 0), o[db], 0, 0, 0); \
        o[da] = __builtin_amdgcn_mfma_f32_32x32x16_bf16(pa1, ATT_PK(0, 1), o[da], 0, 0, 0); o[db] = __builtin_amdgcn_mfma_f32_32x32x16_bf16(pa1, ATT_PK(1, 1), o[db], 0, 0, 0); \
        o[da] = __builtin_amdgcn_mfma_f32_32x32x16_bf16(pa2, ATT_PK(0, 2), o[da], 0, 0, 0); o[db] = __builtin_amdgcn_mfma_f32_32x32x16_bf16(pa2, ATT_PK(1, 2), o[db], 0, 0, 0); \
        o[da] = __builtin_amdgcn_mfma_f32_32x32x16_bf16(pa3, ATT_PK(0, 3), o[da], 0, 0, 0); o[db] = __builtin_amdgcn_mfma_f32_32x32x16_bf16(pa3, ATT_PK(1, 3), o[db], 0, 0, 0); } while (0)
__device__ __forceinline__ void pv(f32x16* o, int vb, bf16x8 pa0, bf16x8 pa1, bf16x8 pa2, bf16x8 pa3) {
    s16x4 lo[2][4], hi[2][4];
    ATT_VRD(0, 0);
    ATT_VRD(1, 1);
    asm volatile("s_waitcnt lgkmcnt(0)" ::: "memory"); __builtin_amdgcn_sched_barrier(0);
    ATT_MM2(0, 1); __builtin_amdgcn_sched_barrier(0);
    ATT_VRD(0, 2);
    ATT_VRD(1, 3);
    asm volatile("s_waitcnt lgkmcnt(0)" ::: "memory"); __builtin_amdgcn_sched_barrier(0);
    ATT_MM2(2, 3);
}
#undef ATT_MM2
#undef ATT_VRD
#undef ATT_PK
__device__ __forceinline__ void attn_pass(const Args& A, int z, int b, int h, int qrow0, bool isctx, bool pathB, LAS char* shm, f32x16* o) {
    const int tid = opaque_tid(), lane = tid & 63, r32 = lane & 31, hi = lane >> 5; const int wid = __builtin_amdgcn_readfirstlane(tid >> 6);
    const int NT = isctx ? 4 : 68;
    LAS float* wsf = (LAS float*)(shm + LDS_WS) + wid * 64;
    const int vb0 = (int)(unsigned)(size_t)(shm + LDS_V) + ((lane >> 4) & 1) * 32 + (lane & 3) * 8 + (4 * hi + ((lane & 15) >> 2)) * 64;
    const bf16_t* Qw = A.Q + (size_t)(qrow0 + wid * 32 + r32) * 1024 + h * 128 + z * 64;
    bf16x8 qr[4];
#pragma unroll
    for (int d0 = 0; d0 < 4; ++d0) qr[d0] = *(const bf16x8*)(Qw + d0 * 16 + hi * 8);
    const bf16_t* Kh = A.K + (size_t)((h * 2 + z) * 8 + wid) * 512 + lane * 8;
    const int pc0 = wid, pc1 = wid + 8;
    const bf16_t* Vh0 = A.V + (size_t)h * 8192 + pc0 * 512 + lane * 8;
    const bf16_t* Vh1 = A.V + (size_t)h * 8192 + pc1 * 512 + lane * 8;
    const int ctxrow = TL + b * 256, latrow = b * 4096;
#define ATT_TROW(t) ((isctx || (t) < 4) ? (ctxrow + 64 * (t)) : (latrow + 64 * ((t) - 4)))
#define ATT_DMA(t, slot, vslot) do { const size_t ro_ = (size_t)(ATT_TROW(t) >> 6) * 65536; \
        __builtin_amdgcn_global_load_lds((const unsigned*)(Kh + ro_), (LAS unsigned*)(shm + LDS_K + (slot) * KSLOT + wid * 1024), 16, 0, 0); \
        __builtin_amdgcn_global_load_lds((const unsigned*)(Vh0 + ro_), (LAS unsigned*)(shm + LDS_V + (vslot) * VSLOT + pc0 * 1024), 16, 0, 0); \
        __builtin_amdgcn_global_load_lds((const unsigned*)(Vh1 + ro_), (LAS unsigned*)(shm + LDS_V + (vslot) * VSLOT + pc1 * 1024), 16, 0, 0); } while (0)
    float mhat = 0.f, l_reg = 0.f;
    const f32x16 negm = f32x16{};
#pragma unroll
    for (int d = 0; d < 4; ++d) o[d] = f32x16{};
    ATT_DMA(0, 0, 0);
    if (NT > 1) ATT_DMA(1, 1, 1);
    asm volatile("s_waitcnt vmcnt(0) lgkmcnt(0)\n\ts_barrier" ::: "memory");
    f32x16 sc0, sc1;
    { bf16x8 kf[8]; kload(kf, shm + LDS_K, r32, hi); qk_mm(sc0, sc1, kf, qr, negm); asm volatile("s_nop 15\n\ts_nop 15" : "+v"(sc0), "+v"(sc1)); }
    if (NT > 2) ATT_DMA(2, 2, 2);
    int k_cur = 0, v_cur = 0, v_prev = 3;
    u32x4 pw0 = {0u, 0u, 0u, 0u}, pw1 = pw0, pw2 = pw0, pw3 = pw0;
#pragma unroll 1
    for (int t = 0; t <= NT; ++t) {
        const int k_n1 = (k_cur == 2) ? 0 : k_cur + 1;
        if (t > 0) {
            asm volatile("s_waitcnt vmcnt(0) lgkmcnt(0)\n\ts_barrier" ::: "memory");
            const int k_p2 = (k_cur == 0) ? 2 : k_cur - 1;
            const int v_p2 = (v_cur + 2) & 3;
            if (t + 2 < NT) ATT_DMA(t + 2, k_p2, v_p2);
        }
        if (pathB && t > 0) {
            pv(o, vb0 + v_prev * VSLOT, __builtin_bit_cast(bf16x8, pw0), __builtin_bit_cast(bf16x8, pw1), __builtin_bit_cast(bf16x8, pw2), __builtin_bit_cast(bf16x8, pw3)); }
        if (t < NT) {
        const float rm = rowmax(sc0, sc1);
        if (t == 0) { mhat = rm; }
        else if (__any(rm - mhat > 8.f)) {
            const float dl = fmaxf(rm - mhat, 0.f); mhat += dl;
            const float f = __builtin_amdgcn_exp2f(-dl); l_reg *= f;
            if (hi == 0) wsf[r32] = f;
            asm volatile("s_waitcnt lgkmcnt(0)" ::: "memory");
#pragma unroll
            for (int r = 0; r < 16; ++r) { const float fr_ = wsf[crow(r, hi)];
#pragma unroll
                for (int d = 0; d < 4; ++d) o[d][r] *= fr_; }
            asm volatile("s_waitcnt lgkmcnt(0)" ::: "memory");
        }
        bf16x8 kf[8];
        kload(kf, shm + LDS_K + k_n1 * KSLOT, r32, hi);
        __builtin_amdgcn_sched_barrier(0);
        f32x16 pn0, pn1;
        qk_mm(pn0, pn1, kf, qr, negm);
        f32x2_t sacc = {0.f, 0.f};
#pragma unroll
        for (int r = 0; r < 16; r += 2) { sc0[r] = __builtin_amdgcn_exp2f(sc0[r] - mhat); sc0[r + 1] = __builtin_amdgcn_exp2f(sc0[r + 1] - mhat); sc1[r] = __builtin_amdgcn_exp2f(sc1[r] - mhat); sc1[r + 1] = __builtin_amdgcn_exp2f(sc1[r + 1] - mhat);
            sacc += (f32x2_t){sc0[r], sc0[r + 1]}; sacc += (f32x2_t){sc1[r], sc1[r + 1]}; }
        l_reg += sacc.x + sacc.y;
        pw0 = (u32x4){pkbf(sc0[0], sc0[1]), pkbf(sc0[2], sc0[3]), pkbf(sc0[4], sc0[5]), pkbf(sc0[6], sc0[7])};
        pw1 = (u32x4){pkbf(sc0[8], sc0[9]), pkbf(sc0[10], sc0[11]), pkbf(sc0[12], sc0[13]), pkbf(sc0[14], sc0[15])};
        pw2 = (u32x4){pkbf(sc1[0], sc1[1]), pkbf(sc1[2], sc1[3]), pkbf(sc1[4], sc1[5]), pkbf(sc1[6], sc1[7])};
        pw3 = (u32x4){pkbf(sc1[8], sc1[9]), pkbf(sc1[10], sc1[11]), pkbf(sc1[12], sc1[13]), pkbf(sc1[14], sc1[15])};
#pragma unroll
        for (int i = 0; i < 8; ++i) { __builtin_amdgcn_sched_group_barrier(0x008, 1, 0); __builtin_amdgcn_sched_group_barrier(0x002, 13, 0); }
        __builtin_amdgcn_sched_barrier(0);
        if (!pathB) {
            pv(o, vb0 + v_cur * VSLOT, __builtin_bit_cast(bf16x8, pw0), __builtin_bit_cast(bf16x8, pw1), __builtin_bit_cast(bf16x8, pw2), __builtin_bit_cast(bf16x8, pw3)); }
        sc0 = pn0; sc1 = pn1;
        }
        k_cur = k_n1; v_prev = v_cur; v_cur = (v_cur + 1) & 3;
    }
    asm volatile("s_waitcnt lgkmcnt(0)\n\ts_barrier" ::: "memory");
#undef ATT_DMA
#undef ATT_TROW
    { auto rr = __builtin_amdgcn_permlane32_swap(__float_as_uint(l_reg), __float_as_uint(l_reg), false, false); l_reg = __uint_as_float(rr[0]) + __uint_as_float(rr[1]); }
    asm volatile("s_waitcnt lgkmcnt(0)" ::: "memory");
    if (hi == 0) wsf[32 + r32] = l_reg;
    asm volatile("s_waitcnt lgkmcnt(0)" ::: "memory");
#pragma unroll
    for (int r = 0; r < 16; ++r) { const float rl = 1.0f / wsf[32 + crow(r, hi)];
#pragma unroll
        for (int d = 0; d < 4; ++d) o[d][r] *= rl; }
    asm volatile("s_waitcnt lgkmcnt(0)" ::: "memory");
}
__device__ __forceinline__ void attn_unit(const Args& A, int b, int h, int qb, bool isctx, bool pathB, LAS char* shm) {
    const int tid = opaque_tid(), lane = tid & 63, r32 = lane & 31, hi = lane >> 5; const int wid = __builtin_amdgcn_readfirstlane(tid >> 6);
    const int qrow0 = isctx ? (TL + b * 256) : (b * 4096 + qb * 256);
    f32x16 o[4];
    unsigned* o1s = A.o1g + wid * 2048 + lane;
    attn_pass(A, 0, b, h, qrow0, isctx, pathB, shm, o);
#pragma unroll
    for (int d = 0; d < 4; ++d)
#pragma unroll
        for (int r = 0; r < 16; r += 2) o1s[(d * 8 + (r >> 1)) * 64] = pkbf(o[d][r], o[d][r + 1]);
    asm volatile("s_waitcnt lgkmcnt(0)" ::: "memory");
    attn_pass(A, 1, b, h, qrow0, isctx, pathB, shm, o);
    float ss[16];
#pragma unroll
    for (int r = 0; r < 16; r += 2) { float s0 = 0.f, s1 = 0.f;
#pragma unroll
        for (int d = 0; d < 4; ++d) { const unsigned pk = o1s[(d * 8 + (r >> 1)) * 64];
            const float v0 = bflo(pk) - A.lam * o[d][r], v1 = bfhi(pk) - A.lam * o[d][r + 1]; o[d][r] = v0; o[d][r + 1] = v1; s0 += v0 * v0; s1 += v1 * v1; }
        ss[r] = s0; ss[r + 1] = s1; }
#pragma unroll
    for (int msk = 1; msk < 32; msk <<= 1)
#pragma unroll
        for (int r = 0; r < 16; ++r) ss[r] += __shfl_xor(ss[r], msk);
    float gn[4];
#pragma unroll
    for (int d = 0; d < 4; ++d) gn[d] = A.gain[d * 32 + r32] * A.oml;
#pragma unroll
    for (int r = 0; r < 16; ++r) {
        const float rstd = rsqrtf(ss[r] * (1.0f / 128.0f) + 1e-5f);
        const size_t off = (size_t)(qrow0 + wid * 32 + crow(r, hi)) * 1024 + h * 128 + r32;
#pragma unroll
        for (int d = 0; d < 4; ++d) { const float zv = bf1(A.Z[off + d * 32]); const float v = o[d][r] * rstd * gn[d] * silu_f(zv);
            A.O[off + d * 32] = (bf16_t)(pkbf(v, 0.f) & 0xffffu); }
        asm volatile("" ::: "memory");
    }
}
__device__ __forceinline__ void attn_phase(const Args& A, LAS char* shm, int G, int bid) {
    const int vcu = (G % 8 == 0) ? (bid % 8) * (G / 8) + bid / 8 : bid;
    bool pathB;
    { const int tid = opaque_tid(); LAS unsigned* cnt = (LAS unsigned*)(shm + LDS_CNT);
      if (tid < 4) cnt[tid] = 0u;
      __syncthreads();
      const unsigned simd = (unsigned)__builtin_amdgcn_s_getreg((1 << 11) | (4 << 6) | 4) & 3u;
      unsigned slot = 0u; if ((tid & 63) == 0) slot = __hip_atomic_fetch_add(cnt + simd, 1u, __ATOMIC_RELAXED, __HIP_MEMORY_SCOPE_WORKGROUP);
      slot = (unsigned)__builtin_amdgcn_readfirstlane((int)slot);
      pathB = (slot & 1u) != 0u;
      __syncthreads(); }
#pragma unroll 1
    for (int u = vcu; u < A.n_units; u += G) {
        const bool isctx = u >= 1024; const int bh = isctx ? (u - 1024) : (u >> 4); const int qb = isctx ? 0 : (u & 15);
        attn_unit(A, bh >> 3, bh & 7, qb, isctx, pathB, shm);
        asm volatile("s_waitcnt vmcnt(0) lgkmcnt(0)\n\ts_barrier" ::: "memory");
    }
}
}
typedef unsigned short bf16_t;
typedef float f32x4 __attribute__((ext_vector_type(4)));
typedef unsigned u32x4 __attribute__((ext_vector_type(4)));
typedef unsigned u32x2 __attribute__((ext_vector_type(2)));
constexpr size_t MiB = 1u << 20;
constexpr size_t WS_CTL = 0, WS_MOD = 1 * MiB, WS_ROPE = 1 * MiB + 512 * 1024, WS_BZ = 2 * MiB;
constexpr size_t WS_WDAIN = 9 * MiB, WS_WDAOUT = 25 * MiB, WS_WFNT = 29 * MiB, WS_WFNZ = 33 * MiB, WS_WFNOUT = 35 * MiB, WS_WRWIN = 37 * MiB, WS_WRWOUT = 46 * MiB;
constexpr size_t WS_XC = 48 * MiB, WS_HB = 56 * MiB, WS_BIG = 124 * MiB;
constexpr size_t WS_Q = WS_BIG, WS_K = WS_BIG + 68 * MiB, WS_V = WS_BIG + 136 * MiB, WS_Z = WS_BIG + 204 * MiB;
constexpr size_t WS_ATL = WS_BIG, WS_ATC = WS_BIG + 128 * MiB, WS_ZB = WS_BIG + 136 * MiB, WS_DFTL = 396 * MiB, WS_DFTC = 460 * MiB, WS_FOLD = WS_BIG + 204 * MiB;
constexpr size_t WS_P = WS_BIG, WS_Y1 = 413 * MiB, WS_END = 482 * MiB;
constexpr int RWN = 4352;
constexpr int LDS_BYTES = 147456;

struct Params { const float* in[28]; float* out; unsigned char* ws; };

__device__ __forceinline__ float wave_sum(float v) {
#pragma unroll
    for (int o = 1; o < 64; o <<= 1) v += __shfl_xor(v, o);
    return v;
}
__device__ __forceinline__ void tr_item(const float* W, int ldw, int N, bf16_t* WT, int ldt, LAS float* scr, int item, int lane) {
    const int nblk = N / 32, kb = item / nblk, nb = item % nblk, k0 = 64 * kb, n0 = 32 * nb;
#pragma unroll 8
    for (int i = 0; i < 32; ++i) { const int kk = 2 * i + (lane >> 5); scr[kk * 33 + (lane & 31)] = W[(size_t)(k0 + kk) * ldw + n0 + (lane & 31)]; }
    asm volatile("s_waitcnt lgkmcnt(0)" ::: "memory");
    const int c = lane & 7;
#pragma unroll
    for (int j = 0; j < 4; ++j) { const int n = (lane >> 3) + 8 * j; const LAS float* s = scr + (8 * c) * 33 + n;
        u32x4 o; o.x = pkbf(s[0 * 33], s[1 * 33]); o.y = pkbf(s[2 * 33], s[3 * 33]); o.z = pkbf(s[4 * 33], s[5 * 33]); o.w = pkbf(s[6 * 33], s[7 * 33]);
        *(u32x4*)(WT + (size_t)(n0 + n) * ldt + k0 + 8 * c) = o; }
    asm volatile("s_waitcnt lgkmcnt(0)" ::: "memory");
}
__device__ __forceinline__ void prologue(const Params& p, LAS char* lds, int G, int bid) {
    const int tid = opaque_tid(), lane = tid & 63, wid = tid >> 6;
    unsigned char* ws = p.ws;
    {
        LAS float* scr = (LAS float*)(lds + wid * 8448);
        const int gw = bid * 8 + wid, NGW = G * 8;
        for (int it = gw; it < 8832; it += NGW) {
            int r = it;
            if (r < 2048) { tr_item(p.in[8], 4096, 4096, (bf16_t*)(ws + WS_WDAIN), 1024, scr, r, lane); continue; } r -= 2048;
            if (r < 2048) { tr_item(p.in[8] + (size_t)1024 * 4096, 4096, 4096, (bf16_t*)(ws + WS_WDAIN + 8 * MiB), 1024, scr, r, lane); continue; } r -= 2048;
            if (r < 512) { tr_item(p.in[12], 1024, 1024, (bf16_t*)(ws + WS_WDAOUT), 1024, scr, r, lane); continue; } r -= 512;
            if (r < 512) { tr_item(p.in[12] + (size_t)1024 * 1024, 1024, 1024, (bf16_t*)(ws + WS_WDAOUT + 2 * MiB), 1024, scr, r, lane); continue; } r -= 512;
            if (r < 512) { tr_item(p.in[13] + 1024, 2048, 1024, (bf16_t*)(ws + WS_WFNZ), 1024, scr, r, lane); continue; } r -= 512;
            if (r < 512) { tr_item(p.in[15], 1024, 1024, (bf16_t*)(ws + WS_WFNOUT), 1024, scr, r, lane); continue; } r -= 512;
            if (r < 2176) { tr_item(p.in[16], RWN, RWN, (bf16_t*)(ws + WS_WRWIN), 1024, scr, r, lane); continue; } r -= 2176;
            tr_item(p.in[27], 1024, 1024, (bf16_t*)(ws + WS_WRWOUT), 1024, scr, r, lane);
        }
    }
    __syncthreads();
    for (int it = bid; it < 256; it += G) {
        const int g = it >> 5, cs = (it >> 4) & 1, kq = it & 15;
        LAS float* Wcs = (LAS float*)lds; LAS float* win = (LAS float*)(lds + 65536); LAS float* tab = (LAS float*)(lds + 65536 + 33024);
        if (tid < 128) { float s, c; sincospif((float)tid / 64.f, &s, &c); tab[tid] = (cs ? s : c) * 0.08838834764831845f; }
        __syncthreads();
        {
            const int e = tid & 127, cq = tid >> 7; float acc[32];
#pragma unroll
            for (int i = 0; i < 32; ++i) acc[i] = 0.f;
            const float* Wg = p.in[14] + (size_t)g * 128 * 128;
            for (int m = 0; m < 128; ++m) { const float wg = Wg[m * 128 + e];
#pragma unroll
                for (int i = 0; i < 32; ++i) acc[i] += tab[(m * (cq + 4 * i)) & 127] * wg; }
#pragma unroll
            for (int i = 0; i < 32; ++i) Wcs[(cq + 4 * i) * 128 + e] = acc[i];
        }
#pragma unroll
        for (int i = 0; i < 16; ++i) { const int idx = tid + 512 * i, kin = idx >> 7, c = idx & 127; win[kin * 129 + c] = p.in[13][(size_t)(kq * 64 + kin) * 2048 + g * 128 + c]; }
        __syncthreads();
        {
            const int kin = tid & 63, eg = tid >> 6; float acc[16];
#pragma unroll
            for (int i = 0; i < 16; ++i) acc[i] = 0.f;
            for (int c = 0; c < 128; ++c) { const float a = win[kin * 129 + c];
#pragma unroll
                for (int i = 0; i < 16; ++i) acc[i] += a * Wcs[c * 128 + eg * 16 + i]; }
            bf16_t* WT = (bf16_t*)(ws + WS_WFNT);
#pragma unroll
            for (int i = 0; i < 16; ++i) WT[(size_t)(cs * 1024 + g * 128 + eg * 16 + i) * 1024 + kq * 64 + kin] = (bf16_t)(pkbf(acc[i], 0.f) & 0xffffu);
        }
        __syncthreads();
    }
    {
        LAS float* tc = (LAS float*)lds; LAS float* ts = (LAS float*)(lds + 16384);
        for (int j = tid; j < 4096; j += 512) { float s, c; sincospif((float)j / 2048.f, &s, &c); tc[j] = c; ts[j] = -s; }
        __syncthreads();
        bf16_t* DL = (bf16_t*)(ws + WS_DFTL); bf16_t* DC = (bf16_t*)(ws + WS_DFTC);
        for (int k = bid; k < 2048; k += G) {
            const int j0 = (tid & 255) * 8; const bool sn = tid >= 256; float v8[8];
#pragma unroll
            for (int i = 0; i < 8; ++i) { const int idx = (k * (j0 + i)) & 4095; v8[i] = (sn ? -ts[idx] : tc[idx]) * 0.015625f; }
            u32x4 o; o.x = pkbf(v8[0], v8[1]); o.y = pkbf(v8[2], v8[3]); o.z = pkbf(v8[4], v8[5]); o.w = pkbf(v8[6], v8[7]);
            *(u32x4*)(DL + (sn ? (size_t)2048 * 2048 : (size_t)0) + (size_t)k * 2048 + j0) = o;
        }
        for (int k = bid; k < 256; k += G) {
            if (tid < 64) { const int cs = tid >> 5, l0 = (tid & 31) * 8; float v8[8];
#pragma unroll
                for (int i = 0; i < 8; ++i) { const int idx = ((k * (l0 + i)) & 255) * 16; v8[i] = (cs ? ts[idx] : tc[idx]) * 0.0625f; }
                u32x4 o; o.x = pkbf(v8[0], v8[1]); o.y = pkbf(v8[2], v8[3]); o.z = pkbf(v8[4], v8[5]); o.w = pkbf(v8[6], v8[7]);
                *(u32x4*)(DC + (size_t)k * 512 + cs * 256 + l0) = o; }
        }
        __syncthreads();
    }
    {
        LAS float* sc = (LAS float*)lds; LAS float* red = (LAS float*)(lds + 40960);
        bool have = false;
        for (int it = bid; it < 192; it += G) {
            if (!have) { for (int idx = tid; idx < 9216; idx += 512) { const int r = idx >> 10, k = idx & 1023; const float cv = r < 8 ? p.in[1][r * 1024 + k] : p.in[3][k]; sc[idx] = cv / (1.f + __expf(-cv)); } have = true; __syncthreads(); }
            const int i = it / 48, n = (it % 48) * 64 + (tid & 63), kq = tid >> 6;
            const float* w = p.in[5] + (size_t)i * 1024 * 3072 + n;
            float acc[9];
#pragma unroll
            for (int r = 0; r < 9; ++r) acc[r] = 0.f;
            for (int k = kq * 128; k < kq * 128 + 128; ++k) { const float wv = w[(size_t)k * 3072];
#pragma unroll
                for (int r = 0; r < 9; ++r) acc[r] += sc[r * 1024 + k] * wv; }
#pragma unroll
            for (int r = 0; r < 9; ++r) red[(kq * 9 + r) * 64 + (tid & 63)] = acc[r];
            __syncthreads();
            for (int idx = tid; idx < 576; idx += 512) { const int r = idx >> 6, col = idx & 63; float s = 0.f;
#pragma unroll
                for (int q = 0; q < 8; ++q) s += red[(q * 9 + r) * 64 + col];
                const int nn = (it % 48) * 64 + col;
                ((float*)(ws + WS_MOD))[(size_t)(i * 9 + r) * 3072 + nn] = s + p.in[6][i * 3072 + nn]; }
            __syncthreads();
        }
    }
    if (bid == 0) { for (int t = tid; t < 1024; t += 512) { const int pos = t >> 4, qd = t & 15; const float inv = powf(10000.f, -(float)qd / 16.f); const float ang = (float)pos * inv;
            ((float*)(ws + WS_ROPE))[t] = cosf(ang); ((float*)(ws + WS_ROPE))[1024 + t] = sinf(ang); } }
}
__device__ __forceinline__ void ph_phase(const float* xlat, const float* xctx, const float* gain, const float* mod, bf16_t* Hb, int G, int bid) {
    const int tid_ = opaque_tid(); const int lane = tid_ & 63, wid = tid_ >> 6;
    const int stride = G * 8;
    for (int row0 = bid * 8 + wid; row0 < TT; row0 += 2 * stride) {
        const int row1 = row0 + stride; const bool has1 = row1 < TT;
        const float* s0 = row0 < TL ? xlat + (size_t)row0 * 1024 : xctx + (size_t)(row0 - TL) * 1024;
        const float* s1 = !has1 ? s0 : (row1 < TL ? xlat + (size_t)row1 * 1024 : xctx + (size_t)(row1 - TL) * 1024);
        f32x4 v0[4], v1[4]; float q0 = 0.f, q1 = 0.f;
#pragma unroll
        for (int j = 0; j < 4; ++j) { v0[j] = *(const f32x4*)(s0 + 4 * lane + 256 * j); v1[j] = *(const f32x4*)(s1 + 4 * lane + 256 * j); }
#pragma unroll
        for (int j = 0; j < 4; ++j) { q0 += (v0[j].x * v0[j].x + v0[j].y * v0[j].y) + (v0[j].z * v0[j].z + v0[j].w * v0[j].w); q1 += (v1[j].x * v1[j].x + v1[j].y * v1[j].y) + (v1[j].z * v1[j].z + v1[j].w * v1[j].w); }
        const float r0 = rsqrtf(wave_sum(q0) * (1.f / 1024.f) + 1e-6f), r1 = rsqrtf(wave_sum(q1) * (1.f / 1024.f) + 1e-6f);
        const float* m0 = mod + (row0 < TL ? (row0 >> 12) : 8) * 3072; const float* m1 = mod + (row1 < TL ? (row1 >> 12) : 8) * 3072;
#pragma unroll
        for (int j = 0; j < 4; ++j) { const int col = 4 * lane + 256 * j; const f32x4 g4 = *(const f32x4*)(gain + col);
            { const f32x4 sh = *(const f32x4*)(m0 + col), sc = *(const f32x4*)(m0 + 1024 + col); const f32x4 y = v0[j] * r0 * g4 * (sc + 1.f) + sh; u32x2 o; o.x = pkbf(y.x, y.y); o.y = pkbf(y.z, y.w); *(u32x2*)(Hb + (size_t)row0 * 1024 + col) = o; }
            if (has1) { const f32x4 sh = *(const f32x4*)(m1 + col), sc = *(const f32x4*)(m1 + 1024 + col); const f32x4 y = v1[j] * r1 * g4 * (sc + 1.f) + sh; u32x2 o; o.x = pkbf(y.x, y.y); o.y = pkbf(y.z, y.w); *(u32x2*)(Hb + (size_t)row1 * 1024 + col) = o; } }
    }
}
__device__ __forceinline__ void final_phase(float* x, const float* gain, int G, int bid) {
    const int tid_ = opaque_tid(); const int lane = tid_ & 63, wid = tid_ >> 6;
    const int stride = G * 8;
    for (int row0 = bid * 8 + wid; row0 < TL; row0 += 2 * stride) {
        const int row1 = row0 + stride; const bool has1 = row1 < TL;
        float* s0 = x + (size_t)row0 * 1024; float* s1 = has1 ? x + (size_t)row1 * 1024 : s0;
        f32x4 v0[4], v1[4]; float q0 = 0.f, q1 = 0.f;
#pragma unroll
        for (int j = 0; j < 4; ++j) { v0[j] = *(const f32x4*)(s0 + 4 * lane + 256 * j); v1[j] = *(const f32x4*)(s1 + 4 * lane + 256 * j); }
#pragma unroll
        for (int j = 0; j < 4; ++j) { q0 += (v0[j].x * v0[j].x + v0[j].y * v0[j].y) + (v0[j].z * v0[j].z + v0[j].w * v0[j].w); q1 += (v1[j].x * v1[j].x + v1[j].y * v1[j].y) + (v1[j].z * v1[j].z + v1[j].w * v1[j].w); }
        const float r0 = rsqrtf(wave_sum(q0) * (1.f / 1024.f) + 1e-6f), r1 = rsqrtf(wave_sum(q1) * (1.f / 1024.f) + 1e-6f);
#pragma unroll
        for (int j = 0; j < 4; ++j) { const int col = 4 * lane + 256 * j; const f32x4 g4 = *(const f32x4*)(gain + col);
            *(f32x4*)(s0 + col) = v0[j] * r0 * g4;
            if (has1) *(f32x4*)(s1 + col) = v1[j] * r1 * g4; }
    }
}
__device__ __forceinline__ void fnet_fold(const bf16_t* ATL, bf16_t* E, bf16_t* O, float* TA, const bf16_t* Z, bf16_t* OG, int G, int bid) {
    const int tid_ = opaque_tid(); const int lane = tid_ & 63, wid = tid_ >> 6;
    for (int row = bid * 8 + wid; row < 8192; row += G * 8) {
        const bf16_t* a1 = ATL + (size_t)row * 8192; const bf16_t* a2 = a1 + 4096; bf16_t* e = E + (size_t)row * 2048; bf16_t* od = O + (size_t)row * 2048;
        float alt = 0.f;
#pragma unroll 2
        for (int it = 0; it < 4; ++it) {
            const int j0 = (it * 64 + lane) * 8;
            const u32x4 x = *(const u32x4*)(a1 + j0), y = *(const u32x4*)(a2 + j0);
            const int mb = 4096 - j0 - 8;
            const u32x4 xm = *(const u32x4*)(a1 + mb), ym = *(const u32x4*)(a2 + mb);
            const unsigned short xe = (j0 == 0) ? (unsigned short)0 : a1[4096 - j0], ye = (j0 == 0) ? (unsigned short)0 : a2[4096 - j0];
            float fa[8], fs[8], ma[8], ms[8];
#pragma unroll
            for (int i = 0; i < 4; ++i) { fa[2 * i] = bflo(x[i]); fa[2 * i + 1] = bfhi(x[i]); fs[2 * i] = bflo(y[i]); fs[2 * i + 1] = bfhi(y[i]);
                ma[2 * i] = bflo(xm[i]); ma[2 * i + 1] = bfhi(xm[i]); ms[2 * i] = bflo(ym[i]); ms[2 * i + 1] = bfhi(ym[i]); }
            float oc[8], os[8];
            oc[0] = fa[0] + bf1(xe); os[0] = fs[0] - bf1(ye);
#pragma unroll
            for (int i = 1; i < 8; ++i) { oc[i] = fa[i] + ma[8 - i]; os[i] = fs[i] - ms[8 - i]; }
            if (j0 == 0) { oc[0] = fa[0]; os[0] = 0.f; }
            u32x4 o; o.x = pkbf(oc[0], oc[1]); o.y = pkbf(oc[2], oc[3]); o.z = pkbf(oc[4], oc[5]); o.w = pkbf(oc[6], oc[7]);
            *(u32x4*)(e + j0) = o;
            alt += (bflo(o.x) - bfhi(o.x)) + (bflo(o.y) - bfhi(o.y)) + (bflo(o.z) - bfhi(o.z)) + (bflo(o.w) - bfhi(o.w));
            o.x = pkbf(os[0], os[1]); o.y = pkbf(os[2], os[3]); o.z = pkbf(os[4], os[5]); o.w = pkbf(os[6], os[7]);
            *(u32x4*)(od + j0) = o;
        }
        alt = wave_sum(alt);
        if (lane == 0) { const float amid = bf1(a1[2048]); TA[row] = amid * 0.015625f;
            const int b = row >> 10, n = row & 1023; const size_t off = (size_t)(b * 4096 + 2048) * 1024 + n;
            const float yv = (alt + amid) * 0.015625f * silu_f(bf1(Z[off]));
            OG[off] = (bf16_t)(pkbf(yv, 0.f) & 0xffffu); }
    }
}
__device__ __forceinline__ void sh8(const bf16_t* P, size_t row, int co, bool hm, bool hp, const float* mu, float* out) {
    const u32x4 z4 = {0u, 0u, 0u, 0u};
    const u32x4 c0 = *(const u32x4*)(P + row * RWN + co);
    const u32x4 cm = hm ? *(const u32x4*)(P + (row - 1) * RWN + co) : z4;
    const u32x4 cp = hp ? *(const u32x4*)(P + (row + 1) * RWN + co) : z4;
    const f32x4 m0 = *(const f32x4*)(mu + co), m1 = *(const f32x4*)(mu + co + 4);
#pragma unroll
    for (int i = 0; i < 4; ++i) {
        const float a0 = bflo(c0[i]), a1 = bfhi(c0[i]);
        const float n0 = 0.5f * (bflo(cm[i]) + bflo(cp[i])), n1 = 0.5f * (bfhi(cm[i]) + bfhi(cp[i]));
        const float mu0 = (2 * i < 4) ? m0[(2 * i) & 3] : m1[(2 * i) & 3], mu1 = (2 * i + 1 < 4) ? m0[(2 * i + 1) & 3] : m1[(2 * i + 1) & 3];
        out[2 * i] = a0 + mu0 * (n0 - a0); out[2 * i + 1] = a1 + mu1 * (n1 - a1);
    }
}
template <int CTRL> __device__ __forceinline__ float dpp_f(float v) { return __int_as_float(__builtin_amdgcn_update_dpp(0, __float_as_int(v), CTRL, 0xf, 0xf, true)); }
__device__ __forceinline__ float sum8(float v) { v += dpp_f<0xB1>(v); v += dpp_f<0x4E>(v); v += dpp_f<0x141>(v); return v; }
__device__ __forceinline__ float fast_tanh(float x) { const float e = __expf(2.f * x); return 1.f - 2.f * __builtin_amdgcn_rcpf(e + 1.f); }
__device__ __forceinline__ float fast_sigmoid(float x) { return __builtin_amdgcn_rcpf(1.f + __expf(-x)); }
struct RwArgs { const bf16_t* P; bf16_t* Y0; bf16_t* Y1; float* BZ; const float *mu, *w0, *w_up, *a0, *a_up, *k_k, *k_a, *r_k; };
struct Raw3 { u32x4 c0, cm, cp; };
__device__ __forceinline__ Raw3 ld3(const bf16_t* P, size_t row, int co, bool hm, bool hp) {
    const u32x4 z4 = {0u, 0u, 0u, 0u}; Raw3 r;
    r.c0 = *(const u32x4*)(P + row * RWN + co);
    r.cm = hm ? *(const u32x4*)(P + (row - 1) * RWN + co) : z4;
    r.cp = hp ? *(const u32x4*)(P + (row + 1) * RWN + co) : z4;
    return r;
}
__device__ __forceinline__ void shift8(const Raw3& R, const float* mu, int co, float* out) {
    const f32x4 m0 = *(const f32x4*)(mu + co), m1 = *(const f32x4*)(mu + co + 4);
#pragma unroll
    for (int i = 0; i < 4; ++i) {
        const float a0 = bflo(R.c0[i]), a1 = bfhi(R.c0[i]);
        const float n0 = 0.5f * (bflo(R.cm[i]) + bflo(R.cp[i])), n1 = 0.5f * (bfhi(R.cm[i]) + bfhi(R.cp[i]));
        const float mu0 = (2 * i < 4) ? m0[(2 * i) & 3] : m1[(2 * i) & 3], mu1 = (2 * i + 1 < 4) ? m0[(2 * i + 1) & 3] : m1[(2 * i + 1) & 3];
        out[2 * i] = a0 + mu0 * (n0 - a0); out[2 * i + 1] = a1 + mu1 * (n1 - a1);
    }
}
__device__ __forceinline__ void rwkv_scan(const RwArgs& A, LAS char* lds, int G, int bid) {
    typedef short bfx8 __attribute__((ext_vector_type(8)));
    const int tid = opaque_tid(), lane = tid & 63; const int q = __builtin_amdgcn_readfirstlane(tid >> 6);
    LAS float* sW = (LAS float*)lds; LAS float* sA = sW + 4096; LAS float* sB = sA + 4096; LAS float* sKD = sB + 4096; LAS float* sR = sKD + 4096; LAS float* sV = sR + 4096;
    LAS bf16_t* WUPt = (LAS bf16_t*)(sV + 4096); LAS bf16_t* AUPt = WUPt + 64 * 72;
    LAS bf16_t* T1 = (LAS bf16_t*)sW; LAS bf16_t* T2 = (LAS bf16_t*)sKD;
    const int s = tid >> 3, dg = tid & 7, d0 = dg * 8;
#pragma unroll 1
    for (int chain = bid; chain < 256; chain += G) {
        const int z = chain >> 7, b = (chain >> 4) & 7, hh = chain & 15;
        __syncthreads();
        for (int idx = tid; idx < 4096; idx += 512) { const int r = idx >> 6, d = idx & 63;
            WUPt[d * 72 + r] = (bf16_t)(pkbf(A.w_up[(size_t)(z * 64 + r) * 1024 + hh * 64 + d], 0.f) & 0xffffu);
            AUPt[d * 72 + r] = (bf16_t)(pkbf(A.a_up[(size_t)(z * 64 + r) * 1024 + hh * 64 + d], 0.f) & 0xffffu); }
        f32x2_t S2[4];
#pragma unroll
        for (int j = 0; j < 4; ++j) S2[j] = (f32x2_t){0.f, 0.f};
        bf16_t* Yz = z ? A.Y1 : A.Y0;
        const int c_r = hh * 64 + d0, c_k = 1024 + hh * 64 + d0, c_v = 2048 + hh * 64 + d0, c_wd = 3072 + z * 64 + d0, c_ad = 3200 + z * 64 + d0;
#define RW_ROWOF(c, rowv, hmv, hpv) do { const int sidx_ = (c) * 64 + s; int L_, n_, rb_; \
            if ((c) < 4) { L_ = 256; n_ = z ? (255 - sidx_) : sidx_; rb_ = TL + b * 256; } else { L_ = 4096; const int sl_ = sidx_ - 256; n_ = z ? (4095 - sl_) : sl_; rb_ = b * 4096; } \
            rowv = (size_t)(rb_ + n_); hmv = n_ > 0; hpv = n_ < L_ - 1; } while (0)
        size_t row; bool hm, hp;
        RW_ROWOF(0, row, hm, hp);
        Raw3 Rr = ld3(A.P, row, c_r, hm, hp), Rk = ld3(A.P, row, c_k, hm, hp), Rv = ld3(A.P, row, c_v, hm, hp), Rw = ld3(A.P, row, c_wd, hm, hp), Ra = ld3(A.P, row, c_ad, hm, hp);
#pragma unroll 1
        for (int c = 0; c < 68; ++c) {
            asm volatile("" ::: "memory");
            const size_t crow_ = row;
            {
                float r8[8], k8[8], v8[8], t8[8];
                shift8(Rr, A.mu, c_r, r8); shift8(Rk, A.mu, c_k, k8); shift8(Rv, A.mu, c_v, v8);
                *(LAS f32x4*)(sR + s * 64 + d0) = (f32x4){r8[0], r8[1], r8[2], r8[3]}; *(LAS f32x4*)(sR + s * 64 + d0 + 4) = (f32x4){r8[4], r8[5], r8[6], r8[7]};
                *(LAS f32x4*)(sV + s * 64 + d0) = (f32x4){v8[0], v8[1], v8[2], v8[3]}; *(LAS f32x4*)(sV + s * 64 + d0 + 4) = (f32x4){v8[4], v8[5], v8[6], v8[7]};
                *(LAS f32x4*)(sB + s * 64 + d0) = (f32x4){k8[0], k8[1], k8[2], k8[3]}; *(LAS f32x4*)(sB + s * 64 + d0 + 4) = (f32x4){k8[4], k8[5], k8[6], k8[7]};
                float kkr[8], ssq = 0.f;
                const f32x4 kk0 = *(const f32x4*)(A.k_k + hh * 64 + d0), kk1 = *(const f32x4*)(A.k_k + hh * 64 + d0 + 4);
#pragma unroll
                for (int i = 0; i < 8; ++i) { kkr[i] = k8[i] * (i < 4 ? kk0[i & 3] : kk1[i & 3]); ssq += kkr[i] * kkr[i]; }
                ssq = sum8(ssq);
                const float rs = -rsqrtf(ssq + 1e-12f);
                *(LAS f32x4*)(sA + s * 64 + d0) = (f32x4){kkr[0] * rs, kkr[1] * rs, kkr[2] * rs, kkr[3] * rs}; *(LAS f32x4*)(sA + s * 64 + d0 + 4) = (f32x4){kkr[4] * rs, kkr[5] * rs, kkr[6] * rs, kkr[7] * rs};
                shift8(Rw, A.mu, c_wd, t8);
                { u32x4 o; o.x = pkbf(fast_tanh(t8[0]), fast_tanh(t8[1])); o.y = pkbf(fast_tanh(t8[2]), fast_tanh(t8[3])); o.z = pkbf(fast_tanh(t8[4]), fast_tanh(t8[5])); o.w = pkbf(fast_tanh(t8[6]), fast_tanh(t8[7]));
                  *(LAS u32x4*)(T1 + s * 72 + d0) = o; }
                shift8(Ra, A.mu, c_ad, t8);
                { u32x4 o; o.x = pkbf(t8[0], t8[1]); o.y = pkbf(t8[2], t8[3]); o.z = pkbf(t8[4], t8[5]); o.w = pkbf(t8[6], t8[7]);
                  *(LAS u32x4*)(T2 + s * 72 + d0) = o; }
            }
            if (c + 1 < 68) { RW_ROWOF(c + 1, row, hm, hp);
                Rr = ld3(A.P, row, c_r, hm, hp); Rk = ld3(A.P, row, c_k, hm, hp); Rv = ld3(A.P, row, c_v, hm, hp); Rw = ld3(A.P, row, c_wd, hm, hp); Ra = ld3(A.P, row, c_ad, hm, hp); }
            __syncthreads();
            const int mt = q & 3, nh = q >> 2, fr = lane & 15, fq = lane >> 4;
            f32x4 accw[2], acca[2];
            {
                bfx8 aw[2], aa[2];
#pragma unroll
                for (int kk = 0; kk < 2; ++kk) { aw[kk] = *(const LAS bfx8*)(T1 + (16 * mt + fr) * 72 + kk * 32 + fq * 8); aa[kk] = *(const LAS bfx8*)(T2 + (16 * mt + fr) * 72 + kk * 32 + fq * 8); }
#pragma unroll
                for (int nt = 0; nt < 2; ++nt) { accw[nt] = (f32x4){0.f, 0.f, 0.f, 0.f}; acca[nt] = (f32x4){0.f, 0.f, 0.f, 0.f};
#pragma unroll
                    for (int kk = 0; kk < 2; ++kk) {
                        const bfx8 bw = *(const LAS bfx8*)(WUPt + (32 * nh + 16 * nt + fr) * 72 + kk * 32 + fq * 8), ba = *(const LAS bfx8*)(AUPt + (32 * nh + 16 * nt + fr) * 72 + kk * 32 + fq * 8);
                        accw[nt] = __builtin_amdgcn_mfma_f32_16x16x32_bf16(aw[kk], bw, accw[nt], 0, 0, 0);
                        acca[nt] = __builtin_amdgcn_mfma_f32_16x16x32_bf16(aa[kk], ba, acca[nt], 0, 0, 0); } }
            }
            __syncthreads();
#pragma unroll
            for (int nt = 0; nt < 2; ++nt) { const int d = 32 * nh + 16 * nt + fr, dcol = hh * 64 + d;
                const float w0d = A.w0[z * 1024 + dcol], a0d = A.a0[z * 1024 + dcol], kad = A.k_a[dcol];
#pragma unroll
                for (int j = 0; j < 4; ++j) { const int idx = (16 * mt + 4 * fq + j) * 64 + d;
                    const float x = -(w0d + accw[nt][j]);
                    const float sp = fmaxf(x, 0.f) + __logf(1.f + __expf(-fabsf(x)));
                    const float w = __expf(-__expf(-sp - 0.5f));
                    const float asig = fast_sigmoid(a0d + acca[nt][j]);
                    const float nkk = sA[idx], kraw = sB[idx];
                    sW[idx] = w; sB[idx] = -nkk * asig; sKD[idx] = kraw * (1.f + (asig - 1.f) * kad); } }
            __syncthreads();
            {
                const f32x4 ra = *(const LAS f32x4*)(sR + s * 64 + d0), rb = *(const LAS f32x4*)(sR + s * 64 + d0 + 4), ka = *(const LAS f32x4*)(sKD + s * 64 + d0), kb = *(const LAS f32x4*)(sKD + s * 64 + d0 + 4);
                const f32x4 q0 = *(const f32x4*)(A.r_k + hh * 64 + d0), q1 = *(const f32x4*)(A.r_k + hh * 64 + d0 + 4);
                float bz = 0.f;
#pragma unroll
                for (int i = 0; i < 4; ++i) { bz += ra[i] * ka[i] * q0[i]; bz += rb[i] * kb[i] * q1[i]; }
                bz = sum8(bz);
                if (dg == 0) A.BZ[((size_t)z * TT + crow_) * 16 + hh] = bz;
            }
            {
                const int rl = lane >> 3, cg = lane & 7, irow = 8 * q + rl;
                const LAS float* bw = sW + 8 * cg; const LAS float* ba_ = sA + 8 * cg; const LAS float* bb_ = sB + 8 * cg; const LAS float* bk = sKD + 8 * cg; const LAS float* br = sR + 8 * cg;
                LAS float* bv = sV + irow;
                f32x4 w0 = *(const LAS f32x4*)(bw), w1 = *(const LAS f32x4*)(bw + 4), a0 = *(const LAS f32x4*)(ba_), a1 = *(const LAS f32x4*)(ba_ + 4);
                f32x4 b0 = *(const LAS f32x4*)(bb_), b1 = *(const LAS f32x4*)(bb_ + 4), k0 = *(const LAS f32x4*)(bk), k1 = *(const LAS f32x4*)(bk + 4);
                f32x4 r0 = *(const LAS f32x4*)(br), r1 = *(const LAS f32x4*)(br + 4); float vi = bv[0];
#pragma unroll 4
                for (int st = 0; st < 64; ++st) {
                    const int on = ((st + 1) & 63) * 64;
                    const f32x4 nw0 = *(const LAS f32x4*)(bw + on), nw1 = *(const LAS f32x4*)(bw + on + 4), na0 = *(const LAS f32x4*)(ba_ + on), na1 = *(const LAS f32x4*)(ba_ + on + 4);
                    const f32x4 nb0 = *(const LAS f32x4*)(bb_ + on), nb1 = *(const LAS f32x4*)(bb_ + on + 4), nk0 = *(const LAS f32x4*)(bk + on), nk1 = *(const LAS f32x4*)(bk + on + 4);
                    const f32x4 nr0 = *(const LAS f32x4*)(br + on), nr1 = *(const LAS f32x4*)(br + on + 4); const float nvi = bv[on];
                    f32x2_t pp2 = S2[0] * (f32x2_t){a0[0], a0[1]};
                    pp2 = S2[1] * (f32x2_t){a0[2], a0[3]} + pp2; pp2 = S2[2] * (f32x2_t){a1[0], a1[1]} + pp2; pp2 = S2[3] * (f32x2_t){a1[2], a1[3]} + pp2;
                    const float sa = sum8(pp2.x + pp2.y);
                    const f32x2_t sa2 = {sa, sa}, v2 = {vi, vi};
                    S2[0] = S2[0] * (f32x2_t){w0[0], w0[1]} + sa2 * (f32x2_t){b0[0], b0[1]} + v2 * (f32x2_t){k0[0], k0[1]};
                    S2[1] = S2[1] * (f32x2_t){w0[2], w0[3]} + sa2 * (f32x2_t){b0[2], b0[3]} + v2 * (f32x2_t){k0[2], k0[3]};
                    S2[2] = S2[2] * (f32x2_t){w1[0], w1[1]} + sa2 * (f32x2_t){b1[0], b1[1]} + v2 * (f32x2_t){k1[0], k1[1]};
                    S2[3] = S2[3] * (f32x2_t){w1[2], w1[3]} + sa2 * (f32x2_t){b1[2], b1[3]} + v2 * (f32x2_t){k1[2], k1[3]};
                    f32x2_t y2 = S2[0] * (f32x2_t){r0[0], r0[1]};
                    y2 = S2[1] * (f32x2_t){r0[2], r0[3]} + y2; y2 = S2[2] * (f32x2_t){r1[0], r1[1]} + y2; y2 = S2[3] * (f32x2_t){r1[2], r1[3]} + y2;
                    const float yv = sum8(y2.x + y2.y);
                    if (cg == 0) bv[st * 64] = yv;
                    w0 = nw0; w1 = nw1; a0 = na0; a1 = na1; b0 = nb0; b1 = nb1; k0 = nk0; k1 = nk1; r0 = nr0; r1 = nr1; vi = nvi;
                }
            }
            __syncthreads();
            { u32x4 o; const LAS float* yr = sV + s * 64 + d0;
              o.x = pkbf(yr[0], yr[1]); o.y = pkbf(yr[2], yr[3]); o.z = pkbf(yr[4], yr[5]); o.w = pkbf(yr[6], yr[7]);
              *(u32x4*)(Yz + crow_ * 1024 + hh * 64 + d0) = o; }
            __syncthreads();
        }
#undef RW_ROWOF
    }
}
__device__ __forceinline__ void rwkv_out(const RwArgs& A, const float* ln_w, const float* ln_b, bf16_t* OG, int G, int bid) {
    const int tid_ = opaque_tid(); const int lane = tid_ & 63, wid = tid_ >> 6; const int c0 = lane * 16, head = lane >> 2;
    for (int row = bid * 8 + wid; row < TT; row += G * 8) {
        const bool lat = row < TL; const int L = lat ? 4096 : 256; const int n = lat ? (row & 4095) : ((row - TL) & 255); const bool hm = n > 0, hp = n < L - 1;
        float y[16], vv[16];
        { const u32x4 a0 = *(const u32x4*)(A.Y0 + (size_t)row * 1024 + c0), a1 = *(const u32x4*)(A.Y0 + (size_t)row * 1024 + c0 + 8);
          const u32x4 b0 = *(const u32x4*)(A.Y1 + (size_t)row * 1024 + c0), b1 = *(const u32x4*)(A.Y1 + (size_t)row * 1024 + c0 + 8);
#pragma unroll
          for (int i = 0; i < 4; ++i) { y[2 * i] = bflo(a0[i]) + bflo(b0[i]); y[2 * i + 1] = bfhi(a0[i]) + bfhi(b0[i]); y[8 + 2 * i] = bflo(a1[i]) + bflo(b1[i]); y[8 + 2 * i + 1] = bfhi(a1[i]) + bfhi(b1[i]); } }
        float s1 = 0.f;
#pragma unroll
        for (int i = 0; i < 16; ++i) s1 += y[i];
        s1 += __shfl_xor(s1, 1); s1 += __shfl_xor(s1, 2); const float mean = s1 * (1.f / 64.f);
        float s2 = 0.f;
#pragma unroll
        for (int i = 0; i < 16; ++i) { y[i] -= mean; s2 += y[i] * y[i]; }
        s2 += __shfl_xor(s2, 1); s2 += __shfl_xor(s2, 2); const float rstd = rsqrtf(s2 * (1.f / 64.f) + 64e-5f);
        sh8(A.P, (size_t)row, 2048 + c0, hm, hp, A.mu, vv); sh8(A.P, (size_t)row, 2048 + c0 + 8, hm, hp, A.mu, vv + 8);
        const float bz = 0.5f * (A.BZ[(size_t)row * 16 + head] + A.BZ[((size_t)TT + row) * 16 + head]);
        const u32x4 z0 = *(const u32x4*)(A.P + (size_t)row * RWN + 3328 + c0), z1 = *(const u32x4*)(A.P + (size_t)row * RWN + 3328 + c0 + 8);
        float ov[16];
#pragma unroll
        for (int i = 0; i < 16; ++i) { const unsigned zw = (i < 8) ? z0[(i >> 1) & 3] : z1[(i >> 1) & 3]; const float zz = (i & 1) ? bfhi(zw) : bflo(zw);
            ov[i] = (y[i] * rstd * ln_w[c0 + i] + ln_b[c0 + i] + bz * vv[i]) * silu_f(zz); }
        u32x4 o0, o1; o0.x = pkbf(ov[0], ov[1]); o0.y = pkbf(ov[2], ov[3]); o0.z = pkbf(ov[4], ov[5]); o0.w = pkbf(ov[6], ov[7]);
        o1.x = pkbf(ov[8], ov[9]); o1.y = pkbf(ov[10], ov[11]); o1.z = pkbf(ov[12], ov[13]); o1.w = pkbf(ov[14], ov[15]);
        *(u32x4*)(OG + (size_t)row * 1024 + c0) = o0; *(u32x4*)(OG + (size_t)row * 1024 + c0 + 8) = o1;
    }
}
#ifdef SKIP_GEMM
#define GEMM_PHASE(EPI, AP, BP, MM, NN, KK, EOBJ) do { (void)EOBJ; } while (0)
#else
#define GEMM_PHASE(EPI, AP, BP, MM, NN, KK, EOBJ) do { pg8::Gemm g_{(const bf16_t*)(AP), (const bf16_t*)(BP), (MM), (NN), (KK)}; pg8::StaticOrder S_; S_.init((MM), (NN), G, bid); \
    pg8::gemm_phase<EPI, pg8::StaticOrder, true, true>((PG8_LAS unsigned char*)lds, g_, S_, EOBJ); } while (0)
#endif
#ifdef SKIP_EpiAttnIn
#define GEMM_PHASE_EpiAttnIn(EPI, AP, BP, MM, NN, KK, EOBJ) do { (void)EOBJ; } while (0)
#else
#define GEMM_PHASE_EpiAttnIn GEMM_PHASE
#endif
#ifdef SKIP_EpiFnT
#define GEMM_PHASE_EpiFnT(EPI, AP, BP, MM, NN, KK, EOBJ) do { (void)EOBJ; } while (0)
#else
#define GEMM_PHASE_EpiFnT GEMM_PHASE
#endif
#ifdef SKIP_EpiPlain
#define GEMM_PHASE_EpiPlain(EPI, AP, BP, MM, NN, KK, EOBJ) do { (void)EOBJ; } while (0)
#else
#define GEMM_PHASE_EpiPlain GEMM_PHASE
#endif
#ifdef SKIP_EpiDft
#define GEMM_PHASE_EpiDft(EPI, AP, BP, MM, NN, KK, EOBJ) do { (void)EOBJ; } while (0)
#else
#define GEMM_PHASE_EpiDft GEMM_PHASE
#endif
#ifdef SKIP_EpiResid
#define GEMM_PHASE_EpiResid(EPI, AP, BP, MM, NN, KK, EOBJ) do { (void)EOBJ; } while (0)
#else
#define GEMM_PHASE_EpiResid GEMM_PHASE
#endif
#define XB_TMO      128
#define XB_XCNT(j)  (256  + 64 * (j))
#define XB_XSUB(j)  (1280 + 64 * (j))
#define XB_XGEN(j)  (2304 + 64 * (j))
#define XB_TOP      3328
#define XB_TOPGEN   3392
#define XCD_BAR_WORDS 3456
#define XB_SPIN_CAP (1u << 18)

__device__ __forceinline__ unsigned xb_ld(unsigned* p)              { return __hip_atomic_load(p, __ATOMIC_RELAXED, __HIP_MEMORY_SCOPE_AGENT); }
__device__ __forceinline__ unsigned xb_add(unsigned* p, unsigned v) { return __hip_atomic_fetch_add(p, v, __ATOMIC_RELAXED, __HIP_MEMORY_SCOPE_AGENT); }
__device__ __forceinline__ unsigned xb_xcc_id() { return (unsigned)__builtin_amdgcn_s_getreg((3 << 11) | 20) & 0xFu; }
#define XB_SPIN(cond, bar) do { unsigned _sp = 0; while (cond) { __builtin_amdgcn_s_sleep(1); \
    if ((++_sp & 255u) == 0u) { if (xb_ld(&(bar)[XB_TMO])) break; if (_sp > XB_SPIN_CAP) { atomicAdd(&(bar)[XB_TMO], 1u); break; } } } } while (0)

struct XcdBarrier {
    unsigned* bar; unsigned x;
    volatile LAS unsigned* st;
};

__device__ __forceinline__ XcdBarrier xcd_barrier_post(unsigned* bar, volatile LAS unsigned* st) {
    XcdBarrier b; b.bar = bar; b.x = xb_xcc_id(); b.st = st;
    if (threadIdx.x == 0) (void)xb_add(&bar[XB_XCNT(b.x)], 1u);
    return b;
}
__device__ __forceinline__ void xcd_barrier_complete(unsigned* bar, unsigned x, unsigned& nloc, unsigned& nx) {
    const unsigned G = gridDim.x * gridDim.y * gridDim.z;
    unsigned sum, cnt, mine, sp = 0u;
    for (;;) {
        sum = 0u; cnt = 0u; mine = 0u;
#pragma unroll
        for (unsigned j = 0; j < 16; ++j) { const unsigned c = xb_ld(&bar[XB_XCNT(j)]); sum += c; cnt += (c > 0u) ? 1u : 0u; mine = (j == x) ? c : mine; }
        if (sum == G) break;
        __builtin_amdgcn_s_sleep(1);
        if ((++sp & 255u) == 0u) { if (xb_ld(&bar[XB_TMO])) break; if (sp > XB_SPIN_CAP) { atomicAdd(&bar[XB_TMO], 1u); break; } }
    }
    nloc = mine > 0u ? mine : 1u; nx = cnt > 0u ? cnt : 1u;
}

__device__ __forceinline__ void xcd_barrier(const XcdBarrier& b) {
    asm volatile("s_waitcnt vmcnt(0)" ::: "memory");
    __syncthreads();
    if (threadIdx.x == 0) {
        unsigned* bar = b.bar;
        __builtin_amdgcn_s_waitcnt(0);
        unsigned nloc = b.st[0], nx = b.st[1];
        if (nloc == 0u) { xcd_barrier_complete(bar, b.x, nloc, nx); b.st[0] = nloc; b.st[1] = nx; }
        const unsigned old = xb_add(&bar[XB_XSUB(b.x)], 1u);
        const unsigned gen = old / nloc;
        if (old + 1u == (gen + 1u) * nloc) {
            __builtin_amdgcn_fence(__ATOMIC_RELEASE, "agent");
            asm volatile("s_waitcnt vmcnt(0)" ::: "memory");
            const unsigned og = xb_add(&bar[XB_TOP], 1u);
            const unsigned tg = og / nx;
            if (og + 1u == (tg + 1u) * nx) xb_add(&bar[XB_TOPGEN], 1u);
            else XB_SPIN(xb_ld(&bar[XB_TOPGEN]) == tg, bar);
            __builtin_amdgcn_fence(__ATOMIC_ACQUIRE, "agent");
            xb_add(&bar[XB_XGEN(b.x)], 1u);
            asm volatile("s_waitcnt vmcnt(0)" ::: "memory");
        } else {
            XB_SPIN(xb_ld(&bar[XB_XGEN(b.x)]) == gen, bar);
            __builtin_amdgcn_fence(__ATOMIC_ACQUIRE, "agent");
            asm volatile("s_waitcnt vmcnt(0)" ::: "memory");
        }
    }
    __syncthreads();
}

#define GRID_SYNC() xcd_barrier(xbar)
template <int layer> __device__ __forceinline__ void layer_body(const Params& p, LAS char* lds, const XcdBarrier& xbar, int G, int bid) {
    unsigned char* ws = p.ws;
    float* mod = (float*)(ws + WS_MOD);
    const float* ropeC = (const float*)(ws + WS_ROPE); const float* ropeS = ropeC + 1024;
    bf16_t* Hb = (bf16_t*)(ws + WS_HB);
    float* XC = (float*)(ws + WS_XC);
    const float* x_in = p.in[0]; const float* ctx_in = p.in[2];
        const float* xl = layer == 0 ? x_in : p.out; const float* xc = layer == 0 ? ctx_in : XC;
        const float* modl = mod + (size_t)layer * 9 * 3072;
        ph_phase(xl, xc, p.in[4] + layer * 1024, modl, Hb, G, bid);
#ifdef PROBE_PH2
        ph_phase(xl, xc, p.in[4] + layer * 1024, modl, Hb, G, bid);
#endif
        GRID_SYNC();
        const int Mout = (layer == 3) ? TL : TT;
        const bf16_t* Wout;
        if constexpr (layer == 0 || layer == 3) {
            const int j = layer == 0 ? 0 : 1;
            pg8::EpiAttnIn E{(bf16_t*)(ws + WS_Q), (bf16_t*)(ws + WS_K), (bf16_t*)(ws + WS_V), (bf16_t*)(ws + WS_Z), ropeC, ropeS};
            GEMM_PHASE_EpiAttnIn(pg8::EpiAttnIn, Hb, ws + WS_WDAIN + (size_t)j * 8 * MiB, TT, 4096, 1024, E);
#ifdef PROBE_GIN2
            GEMM_PHASE_EpiAttnIn(pg8::EpiAttnIn, Hb, ws + WS_WDAIN + (size_t)j * 8 * MiB, TT, 4096, 1024, E);
#endif
            GRID_SYNC();
            float lam;
            { const int lane = opaque_tid() & 63; const float* lq = p.in[9] + j * 128; const float* lk = p.in[10] + j * 128;
              const float s0 = wave_sum(lq[lane] * lk[lane]), s1 = wave_sum(lq[64 + lane] * lk[64 + lane]);
              const float li = 0.8f - 0.6f * expf(-0.3f * (float)layer); lam = expf(s0) - expf(s1) + li;
              att::Args A{(const bf16_t*)(ws + WS_Q), (const bf16_t*)(ws + WS_K), (const bf16_t*)(ws + WS_V), (const bf16_t*)(ws + WS_Z), Hb, p.in[11] + j * 128, lam, 1.f - li, layer == 3 ? 1024 : 1088, (unsigned*)(ws + WS_Y1) + (size_t)bid * 8 * 2048};
#ifndef SKIP_ATT
              att::attn_phase(A, lds, G, bid);
#endif
#ifdef PROBE_ATT2
              att::attn_phase(A, lds, G, bid);
#endif
            }
            GRID_SYNC();
            Wout = (const bf16_t*)(ws + WS_WDAOUT + (size_t)j * 2 * MiB);
        } else if constexpr (layer == 1) {
            { pg8::EpiFnT E{(bf16_t*)(ws + WS_ATL), (bf16_t*)(ws + WS_ATC)};
              GEMM_PHASE_EpiFnT(pg8::EpiFnT, ws + WS_WFNT, Hb, 2048, TT, 1024, E); }
            { pg8::EpiPlain E{(bf16_t*)(ws + WS_ZB), 1024};
              GEMM_PHASE_EpiPlain(pg8::EpiPlain, Hb, ws + WS_WFNZ, TT, 1024, 1024, E); }
            GRID_SYNC();
            fnet_fold((const bf16_t*)(ws + WS_ATL), (bf16_t*)(ws + WS_FOLD), (bf16_t*)(ws + WS_FOLD + 32 * MiB), (float*)(ws + WS_BZ), (const bf16_t*)(ws + WS_ZB), Hb, G, bid);
            GRID_SYNC();
            { pg8::EpiPlain E{(bf16_t*)(ws + WS_ATL), 8192};
              GEMM_PHASE_EpiPlain(pg8::EpiPlain, ws + WS_DFTL, ws + WS_FOLD, 2048, 8192, 2048, E); }
            GRID_SYNC();
            { pg8::EpiDftSym E{(const bf16_t*)(ws + WS_ATL), (const float*)(ws + WS_BZ), (const bf16_t*)(ws + WS_ZB), Hb};
              GEMM_PHASE(pg8::EpiDftSym, ws + WS_DFTL + 8 * MiB, ws + WS_FOLD + 32 * MiB, 2048, 8192, 2048, E); }
            { pg8::EpiDft E{(const bf16_t*)(ws + WS_ZB), Hb, TL, 256};
              GEMM_PHASE_EpiDft(pg8::EpiDft, ws + WS_DFTC, ws + WS_ATC, 256, 8192, 512, E); }
            GRID_SYNC();
            Wout = (const bf16_t*)(ws + WS_WFNOUT);
        } else {
            { pg8::EpiPlain E{(bf16_t*)(ws + WS_P), RWN};
              GEMM_PHASE_EpiPlain(pg8::EpiPlain, Hb, ws + WS_WRWIN, TT, RWN, 1024, E); }
            GRID_SYNC();
            RwArgs A{(const bf16_t*)(ws + WS_P), Hb, (bf16_t*)(ws + WS_Y1), (float*)(ws + WS_BZ), p.in[17], p.in[18], p.in[19], p.in[20], p.in[21], p.in[22], p.in[23], p.in[24]};
#ifndef SKIP_SCAN
            rwkv_scan(A, lds, G, bid);
#endif
#ifdef PROBE_SCAN2
            rwkv_scan(A, lds, G, bid);
#endif
            GRID_SYNC();
#ifndef SKIP_RWOUT
            rwkv_out(A, p.in[25], p.in[26], Hb, G, bid);
#endif
            GRID_SYNC();
            Wout = (const bf16_t*)(ws + WS_WRWOUT);
        }
        { pg8::EpiResid E{xl, xc, p.out, XC, modl + 2048};
          GEMM_PHASE_EpiResid(pg8::EpiResid, Hb, Wout, Mout, 1024, 1024, E);
#ifdef PROBE_OUT2
          if (layer == 0) { GEMM_PHASE_EpiResid(pg8::EpiResid, Hb, Wout, Mout, 1024, 1024, E); }
#endif
        }
        GRID_SYNC();
    }
__global__ void __launch_bounds__(512, 2) fwd_megakernel(Params p) {
    extern __shared__ __attribute__((aligned(16))) unsigned char lds_raw[];
    LAS char* lds = (LAS char*)lds_raw;
    cg::grid_group grid = cg::this_grid();
    const int G = gridDim.x, bid = blockIdx.x;
    volatile LAS unsigned* xst = (volatile LAS unsigned*)(lds + LDS_BYTES - 256);
    if (threadIdx.x < 2) xst[threadIdx.x] = 0u;
    __syncthreads();
    const XcdBarrier xbar = xcd_barrier_post((unsigned*)(p.ws + WS_CTL), xst);

#ifndef SKIP_PRO
    prologue(p, lds, G, bid);
#endif
#ifdef PROBE_PRO2
    __syncthreads(); prologue(p, lds, G, bid);
#endif
    grid.sync();
    layer_body<0>(p, lds, xbar, G, bid);
    layer_body<1>(p, lds, xbar, G, bid);
    layer_body<2>(p, lds, xbar, G, bid);
    layer_body<3>(p, lds, xbar, G, bid);
    final_phase(p.out, p.in[7], G, bid);
}

extern "C" void kernel_launch(void* const* d_in, const int* in_sizes, int n_in, void* d_out, int out_size, void* d_ws, size_t ws_size, hipStream_t stream) {
    static int grid = 0;
    if (grid == 0) {
        if (n_in != 28 || out_size != TL * 1024 || ws_size < WS_END) { fprintf(stderr, "kernel_launch: unexpected shapes: n_in %d out %d ws %zu\n", n_in, out_size, ws_size); grid = -1; return; }
        int dev = 0, cus = 0, per_cu = 0;
        hipGetDevice(&dev); hipDeviceGetAttribute(&cus, hipDeviceAttributeMultiprocessorCount, dev);
        if (hipFuncSetAttribute((const void*)fwd_megakernel, hipFuncAttributeMaxDynamicSharedMemorySize, LDS_BYTES) != hipSuccess) { fprintf(stderr, "kernel_launch: hipFuncSetAttribute failed\n"); grid = -1; return; }
        if (hipOccupancyMaxActiveBlocksPerMultiprocessor(&per_cu, (const void*)fwd_megakernel, 512, LDS_BYTES) != hipSuccess || per_cu < 1) { fprintf(stderr, "kernel_launch: occupancy query failed (%d)\n", per_cu); per_cu = 1; }
        (void)hipGetLastError();
        grid = cus * per_cu;
    }
    if (grid < 0) return;
    if (hipMemsetAsync((char*)d_ws + WS_CTL, 0, 65536, stream) != hipSuccess) { fprintf(stderr, "kernel_launch: hipMemsetAsync failed\n"); return; }
    Params p{};
    for (int i = 0; i < 28; ++i) p.in[i] = (const float*)d_in[i];
    p.out = (float*)d_out; p.ws = (unsigned char*)d_ws;
    void* args[] = {&p};
    hipError_t e = hipLaunchCooperativeKernel((const void*)fwd_megakernel, dim3(grid), dim3(512), args, LDS_BYTES, stream);
    if (e != hipSuccess) fprintf(stderr, "cooperative launch failed: %s (grid %d)\n", hipGetErrorString(e), grid);
}
```

```cpp
#include <hip/hip_runtime.h>
#include <hip/hip_cooperative_groups.h>
#include <cstdio>
#include <cstdint>
#include <cmath>
namespace cg = cooperative_groups;

constexpr int TL = 32768, TCX = 2048, TT = TL + TCX, DM = 1024;
constexpr float QK_C2 = 0.125f * 1.4426950408889634f;
typedef float f32x2_t __attribute__((ext_vector_type(2)));
typedef __bf16 bf16x2_t __attribute__((ext_vector_type(2)));
__device__ __forceinline__ unsigned pkbf(float lo, float hi) { f32x2_t v = {lo, hi}; bf16x2_t b = __builtin_convertvector(v, bf16x2_t); return __builtin_bit_cast(unsigned, b); }
__device__ __forceinline__ float bflo(unsigned u) { return __uint_as_float(u << 16); }
__device__ __forceinline__ float bfhi(unsigned u) { return __uint_as_float(u & 0xffff0000u); }
__device__ __forceinline__ float bf1(unsigned short u) { return __uint_as_float(((unsigned)u) << 16); }
__device__ __forceinline__ float silu_f(float z) { return z * __builtin_amdgcn_rcpf(1.f + __expf(-z)); }
__device__ __forceinline__ int opaque_tid() { int t = threadIdx.x; asm volatile("" : "+v"(t)); return t; }
namespace pg8 {
#define PG8_LAS __attribute__((address_space(3)))
typedef unsigned short bf16_t;
typedef short bf16x8 __attribute__((ext_vector_type(8)));
typedef float f32x4 __attribute__((ext_vector_type(4)));
typedef unsigned u32x4 __attribute__((ext_vector_type(4)));
constexpr int BM = 256, BK = 64, HALF = 128, HTB = HALF * BK * 2  , STAGE_BYTES = 8 * HTB, NXCD = 8, WGM = 8;

__host__ __device__ __forceinline__ int lds_byte(int r, int c) { const int st = (r >> 4) * 2 + (c >> 5), rr = r & 15, cc = c & 31, ob = rr * 64 + cc * 2; return st * 1024 + (ob ^ (((ob >> 9) & 1) << 5)); }
__host__ __device__ __forceinline__ void stage_rc(int b, int& R, int& C) { const int st = b / 1024, sb = b % 1024, swz = sb ^ (((sb >> 9) & 1) << 5); R = (st >> 1) * 16 + swz / 64; C = (st & 1) * 32 + (swz % 64) / 2; }
__host__ __device__ __forceinline__ int perm32(int rho) { const int n = rho >> 4, i = rho & 15; return 8 * (i >> 2) + 4 * n + (i & 3); }

struct Unit { int pm, pn; };
struct Gemm { const bf16_t* A; const bf16_t* Bt; int M, N, K; };

struct StaticOrder {
    int nM, nN, nwg, G, c;
    __host__ __device__ void init(int M, int N, int G_, int c_) { nM = M / BM; nN = N / BM; nwg = nM * nN; G = G_; c = c_; }
    __host__ __device__ bool next(int i, Unit& u) const {
        const long L = (long)i * G + c; if (L >= nwg) return false;
        int wgid = (int)L; { const int q = nwg / NXCD, r = nwg % NXCD, xcd = wgid % NXCD, off = wgid / NXCD; wgid = (xcd < r ? xcd * (q + 1) : r * (q + 1) + (xcd - r) * q) + off; }
        const int nig = WGM * nN, gid = wgid / nig, fm = gid * WGM, gsz = (nM - fm) < WGM ? (nM - fm) : WGM;
        u.pm = fm + ((wgid % nig) % gsz); u.pn = (wgid % nig) / gsz; return true;
    }
    __device__ __forceinline__ void a_ready(const Unit&) const {}
    __device__ __forceinline__ void done(const Unit&) const {}
};

struct EpiAttnIn {
    static constexpr bool PERM = true, AFTER_DRAIN = false;
    bf16_t* Q; bf16_t* Kb; bf16_t* V; bf16_t* Z; const float* ropeC; const float* ropeS;
    __device__ __forceinline__ void operator()(const f32x4 (&acc)[2][2][4][2], const Unit& u, int wr, int wc, int fr, int fq) const {
        const int sect = u.pn >> 2;
        bf16_t* base = sect == 0 ? Q : sect == 1 ? Kb : sect == 2 ? V : Z;
        const int colt = (u.pn & 3) * 256 + wc * 32 + 8 * fq;
        const int row0 = u.pm * BM + wr * 64 + fr;
        const bool rope = (u.pm < 128) && (sect < 2);
        const float sc = (sect == 0) ? QK_C2 : 1.f;
        const int axis = wc & 1;
#pragma unroll
        for (int ai = 0; ai < 2; ++ai)
#pragma unroll
            for (int m = 0; m < 4; ++m) {
                const int row = row0 + ai * HALF + m * 16;
                const int ntok = row & 4095;
                const int pos = axis ? (ntok & 63) : (ntok >> 6);
                bf16_t* rowp;
                if (sect == 1) rowp = base + (size_t)(row >> 6) * 65536 + (size_t)(colt >> 3) * 512 + (row & 63) * 8;
                else if (sect == 2) rowp = base + (size_t)(row >> 6) * 65536 + (size_t)(colt >> 7) * 8192 + (((colt & 127) >> 5) * 4 + ((row & 63) >> 4)) * 512 + (row & 15) * 32 + (colt & 31);
                else rowp = base + (size_t)row * 1024 + colt;
#pragma unroll
                for (int bj = 0; bj < 2; ++bj) {
                    f32x4 v0 = acc[ai][bj][m][0], v1 = acc[ai][bj][m][1];
                    if (rope) {
                        const f32x4 c0 = *(const f32x4*)(ropeC + pos * 16 + 8 * (fq & 1)), c1 = *(const f32x4*)(ropeC + pos * 16 + 8 * (fq & 1) + 4);
                        const f32x4 s0 = *(const f32x4*)(ropeS + pos * 16 + 8 * (fq & 1)), s1 = *(const f32x4*)(ropeS + pos * 16 + 8 * (fq & 1) + 4);
                        f32x4 p0, p1;
#pragma unroll
                        for (int i = 0; i < 4; ++i) { p0[i] = __shfl_xor(v0[i], 32); p1[i] = __shfl_xor(v1[i], 32); }
                        if (fq < 2) { v0 = v0 * c0 - p0 * s0; v1 = v1 * c1 - p1 * s1; }
                        else        { v0 = v0 * c0 + p0 * s0; v1 = v1 * c1 + p1 * s1; }
                    }
                    v0 = v0 * sc; v1 = v1 * sc;
                    u32x4 w; w.x = pkbf(v0[0], v0[1]); w.y = pkbf(v0[2], v0[3]); w.z = pkbf(v1[0], v1[1]); w.w = pkbf(v1[2], v1[3]);
                    *(u32x4*)(rowp + (sect == 1 || sect == 2 ? bj * 8192 : bj * HALF)) = w;
                }
            }
    }
};
struct EpiPlain {
    static constexpr bool PERM = true, AFTER_DRAIN = false;
    bf16_t* O; int ldc;
    __device__ __forceinline__ void operator()(const f32x4 (&acc)[2][2][4][2], const Unit& u, int wr, int wc, int fr, int fq) const {
        const int row0 = u.pm * BM + wr * 64 + fr, col0 = u.pn * BM + wc * 32 + 8 * fq;
#pragma unroll
        for (int ai = 0; ai < 2; ++ai)
#pragma unroll
            for (int m = 0; m < 4; ++m) { bf16_t* rowp = O + (size_t)(row0 + ai * HALF + m * 16) * ldc + col0;
#pragma unroll
                for (int bj = 0; bj < 2; ++bj) { const f32x4 v0 = acc[ai][bj][m][0], v1 = acc[ai][bj][m][1];
                    u32x4 w; w.x = pkbf(v0[0], v0[1]); w.y = pkbf(v0[2], v0[3]); w.z = pkbf(v1[0], v1[1]); w.w = pkbf(v1[2], v1[3]);
                    *(u32x4*)(rowp + bj * HALF) = w; } }
    }
};
struct EpiResid {
    static constexpr bool PERM = false, AFTER_DRAIN = false;
    const float* xin_lat; const float* xin_ctx; float* xout_lat; float* xout_ctx; const float* gate;
    __device__ __forceinline__ void operator()(const f32x4 (&acc)[2][2][4][2], const Unit& u, int wr, int wc, int fr, int fq) const {
        const int rowt = u.pm * BM; const bool lat = rowt < TL; const int r = lat ? (rowt >> 12) : 8;
        const int row0 = rowt + wr * 64 + fr, col0 = u.pn * BM + wc * 32 + 4 * fq;
        const float* xi = lat ? xin_lat + (size_t)row0 * 1024 + col0 : xin_ctx + (size_t)(row0 - TL) * 1024 + col0;
        float* xo = lat ? xout_lat + (size_t)row0 * 1024 + col0 : xout_ctx + (size_t)(row0 - TL) * 1024 + col0;
        f32x4 g[2][2];
#pragma unroll
        for (int bj = 0; bj < 2; ++bj)
#pragma unroll
            for (int n = 0; n < 2; ++n) g[bj][n] = *(const f32x4*)(gate + r * 3072 + col0 + bj * HALF + n * 16);
#pragma unroll
        for (int ai = 0; ai < 2; ++ai) {
            f32x4 pre[4][2][2];
#pragma unroll
            for (int m = 0; m < 4; ++m)
#pragma unroll
                for (int bj = 0; bj < 2; ++bj)
#pragma unroll
                    for (int n = 0; n < 2; ++n) pre[m][bj][n] = *(const f32x4*)(xi + (size_t)(ai * HALF + m * 16) * 1024 + bj * HALF + n * 16);
            asm volatile("" ::: "memory");
#pragma unroll
            for (int m = 0; m < 4; ++m)
#pragma unroll
                for (int bj = 0; bj < 2; ++bj)
#pragma unroll
                    for (int n = 0; n < 2; ++n) *(f32x4*)(xo + (size_t)(ai * HALF + m * 16) * 1024 + bj * HALF + n * 16) = pre[m][bj][n] + g[bj][n] * acc[ai][bj][m][n];
            asm volatile("" ::: "memory");
        }
    }
};
struct EpiFnT {
    static constexpr bool PERM = true, AFTER_DRAIN = false;
    bf16_t* ATL; bf16_t* ATC;
    __device__ __forceinline__ void operator()(const f32x4 (&acc)[2][2][4][2], const Unit& u, int wr, int wc, int fr, int fq) const {
        const int row0 = u.pm * BM + wr * 64 + fr, col0 = u.pn * BM + wc * 32 + 8 * fq;
#pragma unroll
        for (int ai = 0; ai < 2; ++ai)
#pragma unroll
            for (int m = 0; m < 4; ++m) { const int mp = row0 + ai * HALF + m * 16, cs = mp >> 10, n = mp & 1023;
#pragma unroll
                for (int bj = 0; bj < 2; ++bj) { const int t0 = col0 + bj * HALF; bf16_t* dst;
                    if (t0 < TL) { const int b = t0 >> 12, l = t0 & 4095; dst = ATL + ((size_t)((b * 1024 + n) * 2 + cs)) * 4096 + l; }
                    else { const int tc = t0 - TL, b = tc >> 8, l = tc & 255; dst = ATC + ((size_t)((b * 1024 + n) * 2 + cs)) * 256 + l; }
                    const f32x4 v0 = acc[ai][bj][m][0], v1 = acc[ai][bj][m][1];
                    u32x4 w; w.x = pkbf(v0[0], v0[1]); w.y = pkbf(v0[2], v0[3]); w.z = pkbf(v1[0], v1[1]); w.w = pkbf(v1[2], v1[3]);
                    *(u32x4*)dst = w; } }
    }
};
struct EpiDft {
    static constexpr bool PERM = true, AFTER_DRAIN = false;
    const bf16_t* Z; bf16_t* OG; int rowbase; int L;
    __device__ __forceinline__ void operator()(const f32x4 (&acc)[2][2][4][2], const Unit& u, int wr, int wc, int fr, int fq) const {
        const int k0 = u.pm * BM + wr * 64 + fr; const int b = u.pn >> 2; const int n0 = (u.pn & 3) * 256 + wc * 32 + 8 * fq;
#pragma unroll
        for (int ai = 0; ai < 2; ++ai)
#pragma unroll
            for (int m = 0; m < 4; ++m) { const size_t R = (size_t)(rowbase + b * L + k0 + ai * HALF + m * 16);
#pragma unroll
                for (int bj = 0; bj < 2; ++bj) { const size_t off = R * 1024 + n0 + bj * HALF;
                    const u32x4 zz = *(const u32x4*)(Z + off);
                    const f32x4 v0 = acc[ai][bj][m][0], v1 = acc[ai][bj][m][1];
                    u32x4 w;
                    w.x = pkbf(v0[0] * silu_f(bflo(zz.x)), v0[1] * silu_f(bfhi(zz.x))); w.y = pkbf(v0[2] * silu_f(bflo(zz.y)), v0[3] * silu_f(bfhi(zz.y)));
                    w.z = pkbf(v1[0] * silu_f(bflo(zz.z)), v1[1] * silu_f(bfhi(zz.z))); w.w = pkbf(v1[2] * silu_f(bflo(zz.w)), v1[3] * silu_f(bfhi(zz.w)));
                    *(u32x4*)(OG + off) = w; } }
    }
};
struct EpiDftSym {
    static constexpr bool PERM = true, AFTER_DRAIN = false;
    const bf16_t* Pb; const float* TA; const bf16_t* Z; bf16_t* OG;
    __device__ __forceinline__ void operator()(const f32x4 (&acc)[2][2][4][2], const Unit& u, int wr, int wc, int fr, int fq) const {
        const int k0 = u.pm * BM + wr * 64 + fr; const int b = u.pn >> 2; const int c0 = u.pn * BM + wc * 32 + 8 * fq; const int n0 = c0 & 1023;
#pragma unroll
        for (int bj = 0; bj < 2; ++bj) {
            const f32x4 t0 = *(const f32x4*)(TA + c0 + bj * HALF), t1 = *(const f32x4*)(TA + c0 + bj * HALF + 4);
#pragma unroll
            for (int aim = 0; aim < 4; ++aim) { const int ai = aim >> 1, mh = (aim & 1) * 2;
                u32x4 pp[4], z1[4], z2[4];
#pragma unroll
                for (int m = mh; m < mh + 2; ++m) { const int k = k0 + ai * HALF + m * 16;
                    pp[m] = *(const u32x4*)(Pb + (size_t)k * 8192 + c0 + bj * HALF);
                    z1[m] = *(const u32x4*)(Z + (size_t)(b * 4096 + k) * 1024 + n0 + bj * HALF);
                    z2[m] = *(const u32x4*)(Z + (size_t)(b * 4096 + ((4096 - k) & 4095)) * 1024 + n0 + bj * HALF); }
                asm volatile("" ::: "memory");
#pragma unroll
                for (int m = mh; m < mh + 2; ++m) { const int k = k0 + ai * HALF + m * 16; const float sg = (k & 1) ? -1.f : 1.f;
                    const f32x4 q0 = acc[ai][bj][m][0], q1 = acc[ai][bj][m][1];
                    float pt[8];
                    pt[0] = bflo(pp[m].x) + sg * t0[0]; pt[1] = bfhi(pp[m].x) + sg * t0[1]; pt[2] = bflo(pp[m].y) + sg * t0[2]; pt[3] = bfhi(pp[m].y) + sg * t0[3];
                    pt[4] = bflo(pp[m].z) + sg * t1[0]; pt[5] = bfhi(pp[m].z) + sg * t1[1]; pt[6] = bflo(pp[m].w) + sg * t1[2]; pt[7] = bfhi(pp[m].w) + sg * t1[3];
                    { const size_t off = (size_t)(b * 4096 + k) * 1024 + n0 + bj * HALF; const u32x4 zz = z1[m]; u32x4 w;
                      w.x = pkbf((pt[0] - q0[0]) * silu_f(bflo(zz.x)), (pt[1] - q0[1]) * silu_f(bfhi(zz.x))); w.y = pkbf((pt[2] - q0[2]) * silu_f(bflo(zz.y)), (pt[3] - q0[3]) * silu_f(bfhi(zz.y)));
                      w.z = pkbf((pt[4] - q1[0]) * silu_f(bflo(zz.z)), (pt[5] - q1[1]) * silu_f(bfhi(zz.z))); w.w = pkbf((pt[6] - q1[2]) * silu_f(bflo(zz.w)), (pt[7] - q1[3]) * silu_f(bfhi(zz.w)));
                      *(u32x4*)(OG + off) = w; }
                    if (k >= 1) { const size_t off = (size_t)(b * 4096 + 4096 - k) * 1024 + n0 + bj * HALF; const u32x4 zz = z2[m]; u32x4 w;
                      w.x = pkbf((pt[0] + q0[0]) * silu_f(bflo(zz.x)), (pt[1] + q0[1]) * silu_f(bfhi(zz.x))); w.y = pkbf((pt[2] + q0[2]) * silu_f(bflo(zz.y)), (pt[3] + q0[3]) * silu_f(bfhi(zz.y)));
                      w.z = pkbf((pt[4] + q1[0]) * silu_f(bflo(zz.z)), (pt[5] + q1[1]) * silu_f(bfhi(zz.z))); w.w = pkbf((pt[6] + q1[2]) * silu_f(bflo(zz.w)), (pt[7] + q1[3]) * silu_f(bfhi(zz.w)));
                      *(u32x4*)(OG + off) = w; }
                }
                asm volatile("" ::: "memory");
            }
        }
    }
};
template <class Epi, class Sched, bool ALIGN_EPI = false, bool SP2 = false>
__device__ __forceinline__ void gemm_phase(PG8_LAS unsigned char* lds, const Gemm g, const Sched& S, const Epi& E) {
    const int tid = opaque_tid(), wid = __builtin_amdgcn_readfirstlane(tid >> 6), lane = tid & 63, wr = wid >> 2, wc = wid & 3, fr = lane & 15, fq = lane >> 4;
    const int K = g.K, nt = K / BK;
    unsigned voffA[2], voffB[2];
#pragma unroll
    for (int i = 0; i < 2; ++i) { int R, C; stage_rc(tid * 16 + i * 8192, R, C); const int Rb = Epi::PERM ? ((R & ~31) + perm32(R & 31)) : R;
        voffA[i] = (unsigned)(R * K + C) * 2u; voffB[i] = (unsigned)(Rb * K + C) * 2u; }
    const size_t kstep = (size_t)(BK * 2);
    const size_t hstep = (size_t)HALF * K * 2;
    const size_t tstep = 2 * hstep;
    const unsigned ldsw = (unsigned)wid * 1024u;
    const int aoff = lds_byte(wr * 64 + fr, fq * 8), boff = lds_byte(wc * 32 + fr, fq * 8);
#define PG8_SA(b, h) (((b) * 2 + (h)) * HTB)
#define PG8_SB(b, h) ((4 + (b) * 2 + (h)) * HTB)
#define PG8_STAGE(bufoff, gbase, voff) do { _Pragma("unroll") for (int _i = 0; _i < 2; ++_i) \
        __builtin_amdgcn_global_load_lds((const unsigned*)((const char*)(gbase) + (voff)[_i]), (PG8_LAS unsigned*)(lds + (bufoff) + ldsw + _i * 8192), 16, 0, 0); } while (0)
#define PG8_LDA(dst, b, h) do { _Pragma("unroll") for (int m = 0; m < 4; ++m) _Pragma("unroll") for (int k = 0; k < 2; ++k) dst[m][k] = *(const PG8_LAS bf16x8*)(lds + PG8_SA(b, h) + aoff + m * 2048 + k * 1024); } while (0)
#define PG8_LDB(dst, b, h) do { _Pragma("unroll") for (int n = 0; n < 2; ++n) _Pragma("unroll") for (int k = 0; k < 2; ++k) dst[n][k] = *(const PG8_LAS bf16x8*)(lds + PG8_SB(b, h) + boff + n * 2048 + k * 1024); } while (0)
#define PG8_MMA(ai, bj, At, Bt) do { __builtin_amdgcn_s_setprio(1); _Pragma("unroll") for (int m = 0; m < 4; ++m) _Pragma("unroll") for (int n = 0; n < 2; ++n) _Pragma("unroll") for (int k = 0; k < 2; ++k) \
        acc[ai][bj][m][n] = __builtin_amdgcn_mfma_f32_16x16x32_bf16(Bt[n][k], At[m][k], acc[ai][bj][m][n], 0, 0, 0); __builtin_amdgcn_s_setprio(0); } while (0)
#define PG8_WAIT_V(n) asm volatile("s_waitcnt vmcnt(" #n ")" ::: "memory")
#define PG8_WAIT_L(n) asm volatile("s_waitcnt lgkmcnt(" #n ")" ::: "memory")
#define PG8_BAR __builtin_amdgcn_s_barrier()
#define PG8_SCHED __builtin_amdgcn_sched_barrier(0)
    Unit cur, nxt; int ui = 0;
    if (!S.next(0, cur)) return;
    f32x4 acc[2][2][4][2];
#pragma unroll
    for (int a = 0; a < 2; ++a)
#pragma unroll
        for (int b = 0; b < 2; ++b)
#pragma unroll
            for (int m = 0; m < 4; ++m)
#pragma unroll
                for (int n = 0; n < 2; ++n) acc[a][b][m][n] = (f32x4){0.f, 0.f, 0.f, 0.f};
    bf16x8 At[4][2], B0[2][2], B1[2][2];
    const char* cA = (const char*)g.A + (size_t)cur.pm * tstep; const char* cB = (const char*)g.Bt + (size_t)cur.pn * tstep;
    S.a_ready(cur);
    if constexpr (SP2) {
        PG8_STAGE(PG8_SB(0, 0), cB, voffB); PG8_STAGE(PG8_SB(0, 1), cB + hstep, voffB); PG8_STAGE(PG8_SA(0, 0), cA, voffA); PG8_STAGE(PG8_SA(0, 1), cA + hstep, voffA);
        if (wr == 1) PG8_BAR;
        PG8_WAIT_V(2); PG8_BAR;
        PG8_STAGE(PG8_SB(1, 0), cB + kstep, voffB); PG8_STAGE(PG8_SA(1, 0), cA + kstep, voffA); PG8_STAGE(PG8_SB(1, 1), cB + hstep + kstep, voffB);
        PG8_WAIT_V(6); PG8_BAR;
    } else {
        PG8_STAGE(PG8_SB(0, 0), cB, voffB); PG8_STAGE(PG8_SA(0, 0), cA, voffA); PG8_STAGE(PG8_SB(0, 1), cB + hstep, voffB); PG8_STAGE(PG8_SA(0, 1), cA + hstep, voffA);
        if (wr == 1) PG8_BAR;
        PG8_WAIT_V(4); PG8_BAR;
        PG8_STAGE(PG8_SB(1, 0), cB + kstep, voffB); PG8_STAGE(PG8_SA(1, 0), cA + kstep, voffA); PG8_STAGE(PG8_SB(1, 1), cB + hstep + kstep, voffB);
        PG8_WAIT_V(6); PG8_BAR;
    }
    for (;;) {
        const bool has_next = S.next(ui + 1, nxt);
        const char* nA = has_next ? (const char*)g.A + (size_t)nxt.pm * tstep : cA; const char* nB = has_next ? (const char*)g.Bt + (size_t)nxt.pn * tstep : cB;
        for (int t = 0; t < nt; t += 2) {
            const bool last = (t == nt - 2);
            const char* a1 = cA + (size_t)(t + 1) * kstep;
            const char* a2 = last ? nA : cA + (size_t)(t + 2) * kstep; const char* b2 = last ? nB : cB + (size_t)(t + 2) * kstep;
            const char* a3 = a2 + kstep; const char* b3 = b2 + kstep;
            if (last && has_next) S.a_ready(nxt);
            if constexpr (SP2) {
            PG8_LDB(B0, 0, 0); PG8_LDB(B1, 0, 1); PG8_SCHED; PG8_LDA(At, 0, 0); PG8_STAGE(PG8_SA(1, 1), a1 + hstep, voffA);
            PG8_WAIT_V(8); PG8_WAIT_L(0); PG8_BAR; PG8_MMA(0, 0, At, B0); PG8_MMA(0, 1, At, B1); PG8_BAR; PG8_SCHED;
            PG8_LDA(At, 0, 1); PG8_STAGE(PG8_SB(0, 0), b2, voffB); PG8_STAGE(PG8_SB(0, 1), b2 + hstep, voffB); PG8_STAGE(PG8_SA(0, 0), a2, voffA);
            PG8_WAIT_V(8); PG8_WAIT_L(0); PG8_BAR; PG8_MMA(1, 0, At, B0); PG8_MMA(1, 1, At, B1); PG8_BAR; PG8_SCHED;
            PG8_LDB(B0, 1, 0); PG8_LDB(B1, 1, 1); PG8_SCHED; PG8_LDA(At, 1, 0); PG8_STAGE(PG8_SA(0, 1), a2 + hstep, voffA);
            PG8_WAIT_V(8); PG8_WAIT_L(0); PG8_BAR; PG8_MMA(0, 0, At, B0); PG8_MMA(0, 1, At, B1); PG8_BAR; PG8_SCHED;
            PG8_LDA(At, 1, 1); PG8_STAGE(PG8_SB(1, 0), b3, voffB); PG8_STAGE(PG8_SB(1, 1), b3 + hstep, voffB); PG8_STAGE(PG8_SA(1, 0), a3, voffA);
            PG8_WAIT_V(8); PG8_WAIT_L(0); PG8_BAR; PG8_MMA(1, 0, At, B0); PG8_MMA(1, 1, At, B1); PG8_BAR; PG8_SCHED;
            } else {
            PG8_LDB(B0, 0, 0); PG8_SCHED; PG8_LDA(At, 0, 0); PG8_STAGE(PG8_SA(1, 1), a1 + hstep, voffA);
            PG8_WAIT_L(8); PG8_BAR; PG8_WAIT_L(0); PG8_MMA(0, 0, At, B0); PG8_BAR; PG8_SCHED;
            PG8_LDB(B1, 0, 1); PG8_STAGE(PG8_SB(0, 0), b2, voffB);
            PG8_BAR; PG8_WAIT_L(0); PG8_MMA(0, 1, At, B1); PG8_BAR;
            PG8_LDA(At, 0, 1); PG8_STAGE(PG8_SA(0, 0), a2, voffA);
            PG8_BAR; PG8_WAIT_L(0); PG8_MMA(1, 0, At, B0); PG8_BAR; PG8_SCHED;
            PG8_STAGE(PG8_SB(0, 1), b2 + hstep, voffB);
            PG8_WAIT_V(6); PG8_BAR; PG8_MMA(1, 1, At, B1); PG8_BAR;
            PG8_LDB(B0, 1, 0); PG8_SCHED; PG8_LDA(At, 1, 0); PG8_STAGE(PG8_SA(0, 1), a2 + hstep, voffA);
            PG8_WAIT_L(8); PG8_BAR; PG8_WAIT_L(0); PG8_MMA(0, 0, At, B0); PG8_BAR; PG8_SCHED;
            PG8_LDB(B1, 1, 1); PG8_STAGE(PG8_SB(1, 0), b3, voffB);
            PG8_BAR; PG8_WAIT_L(0); PG8_MMA(0, 1, At, B1); PG8_BAR;
            PG8_LDA(At, 1, 1); PG8_STAGE(PG8_SA(1, 0), a3, voffA);
            PG8_BAR; PG8_WAIT_L(0); PG8_MMA(1, 0, At, B0); PG8_BAR; PG8_SCHED;
            PG8_STAGE(PG8_SB(1, 1), b3 + hstep, voffB);
            PG8_WAIT_V(6); PG8_BAR; PG8_MMA(1, 1, At, B1); PG8_BAR;
            }
        }
        if constexpr (ALIGN_EPI) { if (wr == 0) PG8_BAR; }
        if constexpr (!Epi::AFTER_DRAIN) { E(acc, cur, wr, wc, fr, fq); S.done(cur); }
        if (!has_next) break;
#pragma unroll
        for (int a = 0; a < 2; ++a)
#pragma unroll
            for (int b = 0; b < 2; ++b)
#pragma unroll
                for (int m = 0; m < 4; ++m)
#pragma unroll
                    for (int n = 0; n < 2; ++n) acc[a][b][m][n] = (f32x4){0.f, 0.f, 0.f, 0.f};
        cur = nxt; cA = nA; cB = nB; ++ui;
        if constexpr (ALIGN_EPI) { if (wr == 1) PG8_BAR; }
    }
    PG8_WAIT_V(0);
    if constexpr (!ALIGN_EPI) { if (wr == 0) PG8_BAR; }
    PG8_BAR;
    if constexpr (Epi::AFTER_DRAIN) { E.fused(acc, cur, wr, wc, fr, fq, lds, wid, lane); S.done(cur); }
#undef PG8_SA
#undef PG8_SB
#undef PG8_STAGE
#undef PG8_LDA
#undef PG8_LDB
#undef PG8_MMA
#undef PG8_WAIT_V
#undef PG8_WAIT_L
#undef PG8_BAR
#undef PG8_SCHED
}
}
#define LAS __attribute__((address_space(3)))
namespace att {
using bf16x8 = __attribute__((ext_vector_type(8))) short;
using s16x4 = __attribute__((ext_vector_type(4))) short;
using f32x16 = __attribute__((ext_vector_type(16))) float;
using u32x4 = __attribute__((ext_vector_type(4))) unsigned;
typedef unsigned short bf16_t;
__device__ __forceinline__ int crow(int r, int hi) { return (r & 3) + 8 * (r >> 2) + 4 * hi; }
constexpr int KSLOT = 8192, VSLOT = 16384, LDS_K = 0, LDS_V = 3 * KSLOT, LDS_WS = LDS_V + 4 * VSLOT, LDS_CNT = LDS_WS + 2048;
struct Args { const bf16_t* Q; const bf16_t* K; const bf16_t* V; const bf16_t* Z; bf16_t* O; const float* gain; float lam; float oml; int n_units; unsigned* o1g; };

__device__ __forceinline__ void qkt(f32x16& p0, f32x16& p1, const LAS char* Kslot, const bf16x8* qr, const f32x16& negm, int r32, int hi) {
    const LAS char* kb = Kslot + hi * 1024 + r32 * 16;
    bf16x8 kf[8];
#pragma unroll
    for (int d0 = 0; d0 < 4; ++d0) { kf[2 * d0] = *(const LAS bf16x8*)(kb + d0 * 2048); kf[2 * d0 + 1] = *(const LAS bf16x8*)(kb + d0 * 2048 + 512); }
    asm volatile("s_waitcnt lgkmcnt(0)" ::: "memory"); __builtin_amdgcn_sched_barrier(0);
    p0 = __builtin_amdgcn_mfma_f32_32x32x16_bf16(kf[0], qr[0], negm, 0, 0, 0); p1 = __builtin_amdgcn_mfma_f32_32x32x16_bf16(kf[1], qr[0], negm, 0, 0, 0);
#pragma unroll
    for (int d0 = 1; d0 < 4; ++d0) { p0 = __builtin_amdgcn_mfma_f32_32x32x16_bf16(kf[2 * d0], qr[d0], p0, 0, 0, 0); p1 = __builtin_amdgcn_mfma_f32_32x32x16_bf16(kf[2 * d0 + 1], qr[d0], p1, 0, 0, 0); }
}
__device__ __forceinline__ void kload(bf16x8* kf, const LAS char* Kslot, int r32, int hi) {
    const LAS char* kb = Kslot + hi * 1024 + r32 * 16;
#pragma unroll
    for (int d0 = 0; d0 < 4; ++d0) { kf[2 * d0] = *(const LAS bf16x8*)(kb + d0 * 2048); kf[2 * d0 + 1] = *(const LAS bf16x8*)(kb + d0 * 2048 + 512); }
}
__device__ __forceinline__ void qk_mm(f32x16& p0, f32x16& p1, const bf16x8* kf, const bf16x8* qr, const f32x16& z) {
    p0 = __builtin_amdgcn_mfma_f32_32x32x16_bf16(kf[0], qr[0], z, 0, 0, 0); p1 = __builtin_amdgcn_mfma_f32_32x32x16_bf16(kf[1], qr[0], z, 0, 0, 0);
#pragma unroll
    for (int d0 = 1; d0 < 4; ++d0) { p0 = __builtin_amdgcn_mfma_f32_32x32x16_bf16(kf[2 * d0], qr[d0], p0, 0, 0, 0); p1 = __builtin_amdgcn_mfma_f32_32x32x16_bf16(kf[2 * d0 + 1], qr[d0], p1, 0, 0, 0); }
}
__device__ __forceinline__ float max3a(float a, float b, float c) { float r; asm("v_max3_f32 %0, %1, %2, %3" : "=v"(r) : "v"(a), "v"(b), "v"(c)); return r; }
__device__ __forceinline__ float rowmax(const f32x16& p0, const f32x16& p1) {
    float a = max3a(p0[0], p0[1], p0[2]), b = max3a(p1[0], p1[1], p1[2]);
#pragma unroll
    for (int r = 3; r < 15; r += 2) { a = max3a(a, p0[r], p0[r + 1]); b = max3a(b, p1[r], p1[r + 1]); }
    a = max3a(a, p0[15], p1[15]);
    float m; asm("v_max_f32 %0, %1, %2" : "=v"(m) : "v"(a), "v"(b));
    asm volatile("s_nop 1" ::: "memory");
    auto rr = __builtin_amdgcn_permlane32_swap(__float_as_uint(m), __float_as_uint(m), false, false);
    float o; asm("v_max_f32 %0, %1, %2" : "=v"(o) : "v"(__uint_as_float(rr[0])), "v"(__uint_as_float(rr[1])));
    return o;
}
#define ATT_VRD(buf, d0) do { _Pragma("unroll") for (int ks = 0; ks < 4; ++ks) { \
        asm volatile("ds_read_b64_tr_b16 %0,%1 offset:%c2" : "=&v"(lo[buf][ks]) : "v"(vb), "i"((d0) * 4096 + ks * 1024) : "memory"); \
        asm volatile("ds_read_b64_tr_b16 %0,%1 offset:%c2" : "=&v"(hi[buf][ks]) : "v"(vb), "i"((d0) * 4096 + ks * 1024 + 512) : "memory"); } } while (0)
#define ATT_PK(b, k) (bf16x8){lo[b][k][0], lo[b][k][1], lo[b][k][2], lo[b][k][3], hi[b][k][0], hi[b][k][1], hi[b][k][2], hi[b][k][3]}
#define ATT_MM2(da, db) do { \
        o[da] = __builtin_amdgcn_mfma_f32_32x32x16_bf16(pa0, ATT_PK(0, 0), o[da], 0, 0, 0); o[db] = __builtin_amdgcn_mfma_f32_32x32x16_bf16(pa0, ATT_PK(1, 0), o[db], 0, 0, 0); \
        o[da] = __builtin_amdgcn_mfma_f32_32x32x16_bf16(pa1, ATT_PK(0, 1), o[da], 0, 0, 0); o[db] = __builtin_amdgcn_mfma_f32_32x32x16_bf16(pa1, ATT_PK(1, 1), o[db], 0, 0, 0); \
        o[da] = __builtin_amdgcn_mfma_f32_32x32x16_bf16(pa2, ATT_PK(0, 2), o[da], 0, 0, 0); o[db] = __builtin_amdgcn_mfma_f32_32x32x16_bf16(pa2, ATT_PK(1, 2), o[db], 0, 0, 0); \
        o[da] = __builtin_amdgcn_mfma_f32_32x32x16_bf16(pa3, ATT_PK(0, 3), o[da], 0, 0, 0); o[db] = __builtin_amdgcn_mfma_f32_32x32x16_bf16(pa3, ATT_PK(1, 3), o[db], 0, 0, 0); } while (0)
__device__ __forceinline__ void pv(f32x16* o, int vb, bf16x8 pa0, bf16x8 pa1, bf16x8 pa2, bf16x8 pa3) {
    s16x4 lo[2][4], hi[2][4];
    ATT_VRD(0, 0);
    ATT_VRD(1, 1);
    asm volatile("s_waitcnt lgkmcnt(0)" ::: "memory"); __builtin_amdgcn_sched_barrier(0);
    ATT_MM2(0, 1); __builtin_amdgcn_sched_barrier(0);
    ATT_VRD(0, 2);
    ATT_VRD(1, 3);
    asm volatile("s_waitcnt lgkmcnt(0)" ::: "memory"); __builtin_amdgcn_sched_barrier(0);
    ATT_MM2(2, 3);
}
#undef ATT_MM2
#undef ATT_VRD
#undef ATT_PK
__device__ __forceinline__ void attn_pass(const Args& A, int z, int b, int h, int qrow0, bool isctx, bool pathB, LAS char* shm, f32x16* o) {
    const int tid = opaque_tid(), lane = tid & 63, r32 = lane & 31, hi = lane >> 5; const int wid = __builtin_amdgcn_readfirstlane(tid >> 6);
    const int NT = isctx ? 4 : 68;
    LAS float* wsf = (LAS float*)(shm + LDS_WS) + wid * 64;
    const int vb0 = (int)(unsigned)(size_t)(shm + LDS_V) + ((lane >> 4) & 1) * 32 + (lane & 3) * 8 + (4 * hi + ((lane & 15) >> 2)) * 64;
    const bf16_t* Qw = A.Q + (size_t)(qrow0 + wid * 32 + r32) * 1024 + h * 128 + z * 64;
    bf16x8 qr[4];
#pragma unroll
    for (int d0 = 0; d0 < 4; ++d0) qr[d0] = *(const bf16x8*)(Qw + d0 * 16 + hi * 8);
    const bf16_t* Kh = A.K + (size_t)((h * 2 + z) * 8 + wid) * 512 + lane * 8;
    const int pc0 = wid, pc1 = wid + 8;
    const bf16_t* Vh0 = A.V + (size_t)h * 8192 + pc0 * 512 + lane * 8;
    const bf16_t* Vh1 = A.V + (size_t)h * 8192 + pc1 * 512 + lane * 8;
    const int ctxrow = TL + b * 256, latrow = b * 4096;
#define ATT_TROW(t) ((isctx || (t) < 4) ? (ctxrow + 64 * (t)) : (latrow + 64 * ((t) - 4)))
#define ATT_DMA(t, slot, vslot) do { const size_t ro_ = (size_t)(ATT_TROW(t) >> 6) * 65536; \
        __builtin_amdgcn_global_load_lds((const unsigned*)(Kh + ro_), (LAS unsigned*)(shm + LDS_K + (slot) * KSLOT + wid * 1024), 16, 0, 0); \
        __builtin_amdgcn_global_load_lds((const unsigned*)(Vh0 + ro_), (LAS unsigned*)(shm + LDS_V + (vslot) * VSLOT + pc0 * 1024), 16, 0, 0); \
        __builtin_amdgcn_global_load_lds((const unsigned*)(Vh1 + ro_), (LAS unsigned*)(shm + LDS_V + (vslot) * VSLOT + pc1 * 1024), 16, 0, 0); } while (0)
    float mhat = 0.f, l_reg = 0.f;
    const f32x16 negm = f32x16{};
#pragma unroll
    for (int d = 0; d < 4; ++d) o[d] = f32x16{};
    ATT_DMA(0, 0, 0);
    if (NT > 1) ATT_DMA(1, 1, 1);
    asm volatile("s_waitcnt vmcnt(0) lgkmcnt(0)\n\ts_barrier" ::: "memory");
    f32x16 sc0, sc1;
    { bf16x8 kf[8]; kload(kf, shm + LDS_K, r32, hi); qk_mm(sc0, sc1, kf, qr, negm); asm volatile("s_nop 15\n\ts_nop 15" : "+v"(sc0), "+v"(sc1)); }
    if (NT > 2) ATT_DMA(2, 2, 2);
    int k_cur = 0, v_cur = 0, v_prev = 3;
    u32x4 pw0 = {0u, 0u, 0u, 0u}, pw1 = pw0, pw2 = pw0, pw3 = pw0;
#pragma unroll 1
    for (int t = 0; t <= NT; ++t) {
        const int k_n1 = (k_cur == 2) ? 0 : k_cur + 1;
        if (t > 0) {
            asm volatile("s_waitcnt vmcnt(0) lgkmcnt(0)\n\ts_barrier" ::: "memory");
            const int k_p2 = (k_cur == 0) ? 2 : k_cur - 1;
            const int v_p2 = (v_cur + 2) & 3;
            if (t + 2 < NT) ATT_DMA(t + 2, k_p2, v_p2);
        }
        if (pathB && t > 0) {
            pv(o, vb0 + v_prev * VSLOT, __builtin_bit_cast(bf16x8, pw0), __builtin_bit_cast(bf16x8, pw1), __builtin_bit_cast(bf16x8, pw2), __builtin_bit_cast(bf16x8, pw3)); }
        if (t < NT) {
        const float rm = rowmax(sc0, sc1);
        if (t == 0) { mhat = rm; }
        else if (__any(rm - mhat > 8.f)) {
            const float dl = fmaxf(rm - mhat, 0.f); mhat += dl;
            const float f = __builtin_amdgcn_exp2f(-dl); l_reg *= f;
            if (hi == 0) wsf[r32] = f;
            asm volatile("s_waitcnt lgkmcnt(0)" ::: "memory");
#pragma unroll
            for (int r = 0; r < 16; ++r) { const float fr_ = wsf[crow(r, hi)];
#pragma unroll
                for (int d = 0; d < 4; ++d) o[d][r] *= fr_; }
            asm volatile("s_waitcnt lgkmcnt(0)" ::: "memory");
        }
        bf16x8 kf[8];
        kload(kf, shm + LDS_K + k_n1 * KSLOT, r32, hi);
        __builtin_amdgcn_sched_barrier(0);
        f32x16 pn0, pn1;
        qk_mm(pn0, pn1, kf, qr, negm);
        f32x2_t sacc = {0.f, 0.f};
#pragma unroll
        for (int r = 0; r < 16; r += 2) { sc0[r] = __builtin_amdgcn_exp2f(sc0[r] - mhat); sc0[r + 1] = __builtin_amdgcn_exp2f(sc0[r + 1] - mhat); sc1[r] = __builtin_amdgcn_exp2f(sc1[r] - mhat); sc1[r + 1] = __builtin_amdgcn_exp2f(sc1[r + 1] - mhat);
            sacc += (f32x2_t){sc0[r], sc0[r + 1]}; sacc += (f32x2_t){sc1[r], sc1[r + 1]}; }
        l_reg += sacc.x + sacc.y;
        pw0 = (u32x4){pkbf(sc0[0], sc0[1]), pkbf(sc0[2], sc0[3]), pkbf(sc0[4], sc0[5]), pkbf(sc0[6], sc0[7])};
        pw1 = (u32x4){pkbf(sc0[8], sc0[9]), pkbf(sc0[10], sc0[11]), pkbf(sc0[12], sc0[13]), pkbf(sc0[14], sc0[15])};
        pw2 = (u32x4){pkbf(sc1[0], sc1[1]), pkbf(sc1[2], sc1[3]), pkbf(sc1[4], sc1[5]), pkbf(sc1[6], sc1[7])};
        pw3 = (u32x4){pkbf(sc1[8], sc1[9]), pkbf(sc1[10], sc1[11]), pkbf(sc1[12], sc1[13]), pkbf(sc1[14], sc1[15])};
#pragma unroll
        for (int i = 0; i < 8; ++i) { __builtin_amdgcn_sched_group_barrier(0x008, 1, 0); __builtin_amdgcn_sched_group_barrier(0x002, 13, 0); }
        __builtin_amdgcn_sched_barrier(0);
        if (!pathB) {
            pv(o, vb0 + v_cur * VSLOT, __builtin_bit_cast(bf16x8, pw0), __builtin_bit_cast(bf16x8, pw1), __builtin_bit_cast(bf16x8, pw2), __builtin_bit_cast(bf16x8, pw3)); }
        sc0 = pn0; sc1 = pn1;
        }
        k_cur = k_n1; v_prev = v_cur; v_cur = (v_cur + 1) & 3;
    }
    asm volatile("s_waitcnt lgkmcnt(0)\n\ts_barrier" ::: "memory");
#undef ATT_DMA
#undef ATT_TROW
    { auto rr = __builtin_amdgcn_permlane32_swap(__float_as_uint(l_reg), __float_as_uint(l_reg), false, false); l_reg = __uint_as_float(rr[0]) + __uint_as_float(rr[1]); }
    asm volatile("s_waitcnt lgkmcnt(0)" ::: "memory");
    if (hi == 0) wsf[32 + r32] = l_reg;
    asm volatile("s_waitcnt lgkmcnt(0)" ::: "memory");
#pragma unroll
    for (int r = 0; r < 16; ++r) { const float rl = 1.0f / wsf[32 + crow(r, hi)];
#pragma unroll
        for (int d = 0; d < 4; ++d) o[d][r] *= rl; }
    asm volatile("s_waitcnt lgkmcnt(0)" ::: "memory");
}
__device__ __forceinline__ void attn_unit(const Args& A, int b, int h, int qb, bool isctx, bool pathB, LAS char* shm) {
    const int tid = opaque_tid(), lane = tid & 63, r32 = lane & 31, hi = lane >> 5; const int wid = __builtin_amdgcn_readfirstlane(tid >> 6);
    const int qrow0 = isctx ? (TL + b * 256) : (b * 4096 + qb * 256);
    f32x16 o[4];
    unsigned* o1s = A.o1g + wid * 2048 + lane;
    attn_pass(A, 0, b, h, qrow0, isctx, pathB, shm, o);
#pragma unroll
    for (int d = 0; d < 4; ++d)
#pragma unroll
        for (int r = 0; r < 16; r += 2) o1s[(d * 8 + (r >> 1)) * 64] = pkbf(o[d][r], o[d][r + 1]);
    asm volatile("s_waitcnt lgkmcnt(0)" ::: "memory");
    attn_pass(A, 1, b, h, qrow0, isctx, pathB, shm, o);
    float ss[16];
#pragma unroll
    for (int r = 0; r < 16; r += 2) { float s0 = 0.f, s1 = 0.f;
#pragma unroll
        for (int d = 0; d < 4; ++d) { const unsigned pk = o1s[(d * 8 + (r >> 1)) * 64];
            const float v0 = bflo(pk) - A.lam * o[d][r], v1 = bfhi(pk) - A.lam * o[d][r + 1]; o[d][r] = v0; o[d][r + 1] = v1; s0 += v0 * v0; s1 += v1 * v1; }
        ss[r] = s0; ss[r + 1] = s1; }
#pragma unroll
    for (int msk = 1; msk < 32; msk <<= 1)
#pragma unroll
        for (int r = 0; r < 16; ++r) ss[r] += __shfl_xor(ss[r], msk);
    float gn[4];
#pragma unroll
    for (int d = 0; d < 4; ++d) gn[d] = A.gain[d * 32 + r32] * A.oml;
#pragma unroll
    for (int r = 0; r < 16; ++r) {
        const float rstd = rsqrtf(ss[r] * (1.0f / 128.0f) + 1e-5f);
        const size_t off = (size_t)(qrow0 + wid * 32 + crow(r, hi)) * 1024 + h * 128 + r32;
#pragma unroll
        for (int d = 0; d < 4; ++d) { const float zv = bf1(A.Z[off + d * 32]); const float v = o[d][r] * rstd * gn[d] * silu_f(zv);
            A.O[off + d * 32] = (bf16_t)(pkbf(v, 0.f) & 0xffffu); }
        asm volatile("" ::: "memory");
    }
}
__device__ __forceinline__ void attn_phase(const Args& A, LAS char* shm, int G, int bid) {
    const int vcu = (G % 8 == 0) ? (bid % 8) * (G / 8) + bid / 8 : bid;
    bool pathB;
    { const int tid = opaque_tid(); LAS unsigned* cnt = (LAS unsigned*)(shm + LDS_CNT);
      if (tid < 4) cnt[tid] = 0u;
      __syncthreads();
      const unsigned simd = (unsigned)__builtin_amdgcn_s_getreg((1 << 11) | (4 << 6) | 4) & 3u;
      unsigned slot = 0u; if ((tid & 63) == 0) slot = __hip_atomic_fetch_add(cnt + simd, 1u, __ATOMIC_RELAXED, __HIP_MEMORY_SCOPE_WORKGROUP);
      slot = (unsigned)__builtin_amdgcn_readfirstlane((int)slot);
      pathB = (slot & 1u) != 0u;
      __syncthreads(); }
#pragma unroll 1
    for (int u = vcu; u < A.n_units; u += G) {
        const bool isctx = u >= 1024; const int bh = isctx ? (u - 1024) : (u >> 4); const int qb = isctx ? 0 : (u & 15);
        attn_unit(A, bh >> 3, bh & 7, qb, isctx, pathB, shm);
        asm volatile("s_waitcnt vmcnt(0) lgkmcnt(0)\n\ts_barrier" ::: "memory");
    }
}
}
typedef unsigned short bf16_t;
typedef float f32x4 __attribute__((ext_vector_type(4)));
typedef unsigned u32x4 __attribute__((ext_vector_type(4)));
typedef unsigned u32x2 __attribute__((ext_vector_type(2)));
constexpr size_t MiB = 1u << 20;
constexpr size_t WS_CTL = 0, WS_MOD = 1 * MiB, WS_ROPE = 1 * MiB + 512 * 1024, WS_BZ = 2 * MiB;
constexpr size_t WS_WDAIN = 9 * MiB, WS_WDAOUT = 25 * MiB, WS_WFNT = 29 * MiB, WS_WFNZ = 33 * MiB, WS_WFNOUT = 35 * MiB, WS_WRWIN = 37 * MiB, WS_WRWOUT = 46 * MiB;
constexpr size_t WS_XC = 48 * MiB, WS_HB = 56 * MiB, WS_BIG = 124 * MiB;
constexpr size_t WS_Q = WS_BIG, WS_K = WS_BIG + 68 * MiB, WS_V = WS_BIG + 136 * MiB, WS_Z = WS_BIG + 204 * MiB;
constexpr size_t WS_ATL = WS_BIG, WS_ATC = WS_BIG + 128 * MiB, WS_ZB = WS_BIG + 136 * MiB, WS_DFTL = 396 * MiB, WS_DFTC = 460 * MiB, WS_FOLD = WS_BIG + 204 * MiB;
constexpr size_t WS_P = WS_BIG, WS_Y1 = 413 * MiB, WS_END = 482 * MiB;
constexpr int RWN = 4352;
constexpr int LDS_BYTES = 147456;

struct Params { const float* in[28]; float* out; unsigned char* ws; };

__device__ __forceinline__ float wave_sum(float v) {
#pragma unroll
    for (int o = 1; o < 64; o <<= 1) v += __shfl_xor(v, o);
    return v;
}
__device__ __forceinline__ void tr_item(const float* W, int ldw, int N, bf16_t* WT, int ldt, LAS float* scr, int item, int lane) {
    const int nblk = N / 32, kb = item / nblk, nb = item % nblk, k0 = 64 * kb, n0 = 32 * nb;
    float v_[32];
#pragma unroll
    for (int i = 0; i < 32; ++i) v_[i] = W[(size_t)(k0 + 2 * i + (lane >> 5)) * ldw + n0 + (lane & 31)];
#pragma unroll
    for (int i = 0; i < 32; ++i) scr[(2 * i + (lane >> 5)) * 33 + (lane & 31)] = v_[i];
    asm volatile("s_waitcnt lgkmcnt(0)" ::: "memory");
    const int c = lane & 7;
#pragma unroll
    for (int j = 0; j < 4; ++j) { const int n = (lane >> 3) + 8 * j; const LAS float* s = scr + (8 * c) * 33 + n;
        u32x4 o; o.x = pkbf(s[0 * 33], s[1 * 33]); o.y = pkbf(s[2 * 33], s[3 * 33]); o.z = pkbf(s[4 * 33], s[5 * 33]); o.w = pkbf(s[6 * 33], s[7 * 33]);
        *(u32x4*)(WT + (size_t)(n0 + n) * ldt + k0 + 8 * c) = o; }
    asm volatile("s_waitcnt lgkmcnt(0)" ::: "memory");
}
__device__ __forceinline__ void prologue(const Params& p, LAS char* lds, int G, int bid) {
    const int tid = opaque_tid(), lane = tid & 63, wid = tid >> 6;
    unsigned char* ws = p.ws;
    {
        LAS float* scr = (LAS float*)(lds + wid * 8448);
        const int gw = bid * 8 + wid, NGW = G * 8;
        for (int it = gw; it < 8832; it += NGW) {
            int r = it;
            if (r < 2048) { tr_item(p.in[8], 4096, 4096, (bf16_t*)(ws + WS_WDAIN), 1024, scr, r, lane); continue; } r -= 2048;
            if (r < 2048) { tr_item(p.in[8] + (size_t)1024 * 4096, 4096, 4096, (bf16_t*)(ws + WS_WDAIN + 8 * MiB), 1024, scr, r, lane); continue; } r -= 2048;
            if (r < 512) { tr_item(p.in[12], 1024, 1024, (bf16_t*)(ws + WS_WDAOUT), 1024, scr, r, lane); continue; } r -= 512;
            if (r < 512) { tr_item(p.in[12] + (size_t)1024 * 1024, 1024, 1024, (bf16_t*)(ws + WS_WDAOUT + 2 * MiB), 1024, scr, r, lane); continue; } r -= 512;
            if (r < 512) { tr_item(p.in[13] + 1024, 2048, 1024, (bf16_t*)(ws + WS_WFNZ), 1024, scr, r, lane); continue; } r -= 512;
            if (r < 512) { tr_item(p.in[15], 1024, 1024, (bf16_t*)(ws + WS_WFNOUT), 1024, scr, r, lane); continue; } r -= 512;
            if (r < 2176) { tr_item(p.in[16], RWN, RWN, (bf16_t*)(ws + WS_WRWIN), 1024, scr, r, lane); continue; } r -= 2176;
            tr_item(p.in[27], 1024, 1024, (bf16_t*)(ws + WS_WRWOUT), 1024, scr, r, lane);
        }
    }
    __syncthreads();
    for (int it = bid; it < 256; it += G) {
        const int g = it >> 5, cs = (it >> 4) & 1, kq = it & 15;
        LAS float* Wcs = (LAS float*)lds; LAS float* win = (LAS float*)(lds + 65536); LAS float* tab = (LAS float*)(lds + 65536 + 33024);
        if (tid < 128) { float s, c; sincospif((float)tid / 64.f, &s, &c); tab[tid] = (cs ? s : c) * 0.08838834764831845f; }
        __syncthreads();
        {
            const int e0 = (tid & 31) * 4, cq = tid >> 5; f32x4 acc[8];
#pragma unroll
            for (int i = 0; i < 8; ++i) acc[i] = (f32x4){0.f, 0.f, 0.f, 0.f};
            const float* Wg = p.in[14] + (size_t)g * 128 * 128;
            for (int m = 0; m < 128; ++m) { const f32x4 wg = *(const f32x4*)(Wg + m * 128 + e0);
#pragma unroll
                for (int i = 0; i < 8; ++i) acc[i] += wg * tab[(m * (cq + 16 * i)) & 127]; }
#pragma unroll
            for (int i = 0; i < 8; ++i) *(LAS f32x4*)(Wcs + (cq + 16 * i) * 128 + e0) = acc[i];
        }
#pragma unroll
        for (int i = 0; i < 16; ++i) { const int idx = tid + 512 * i, kin = idx >> 7, c = idx & 127; win[kin * 129 + c] = p.in[13][(size_t)(kq * 64 + kin) * 2048 + g * 128 + c]; }
        __syncthreads();
        {
            const int kin = tid & 63, eg = tid >> 6; float acc[16];
#pragma unroll
            for (int i = 0; i < 16; ++i) acc[i] = 0.f;
            for (int c = 0; c < 128; ++c) { const float a = win[kin * 129 + c];
#pragma unroll
                for (int i = 0; i < 16; ++i) acc[i] += a * Wcs[c * 128 + eg * 16 + i]; }
            bf16_t* WT = (bf16_t*)(ws + WS_WFNT);
#pragma unroll
            for (int i = 0; i < 16; ++i) WT[(size_t)(cs * 1024 + g * 128 + eg * 16 + i) * 1024 + kq * 64 + kin] = (bf16_t)(pkbf(acc[i], 0.f) & 0xffffu);
        }
        __syncthreads();
    }
    {
        LAS float* tc = (LAS float*)lds; LAS float* ts = (LAS float*)(lds + 16384);
        for (int j = tid; j < 4096; j += 512) { float s, c; sincospif((float)j / 2048.f, &s, &c); tc[j] = c; ts[j] = -s; }
        __syncthreads();
        bf16_t* DL = (bf16_t*)(ws + WS_DFTL); bf16_t* DC = (bf16_t*)(ws + WS_DFTC);
        for (int k = bid; k < 2048; k += G) {
            const int j0 = (tid & 255) * 8; const bool sn = tid >= 256; float v8[8];
#pragma unroll
            for (int i = 0; i < 8; ++i) { const int idx = (k * (j0 + i)) & 4095; v8[i] = (sn ? -ts[idx] : tc[idx]) * 0.015625f; }
            u32x4 o; o.x = pkbf(v8[0], v8[1]); o.y = pkbf(v8[2], v8[3]); o.z = pkbf(v8[4], v8[5]); o.w = pkbf(v8[6], v8[7]);
            *(u32x4*)(DL + (sn ? (size_t)2048 * 2048 : (size_t)0) + (size_t)k * 2048 + j0) = o;
        }
        for (int k = bid; k < 256; k += G) {
            if (tid < 64) { const int cs = tid >> 5, l0 = (tid & 31) * 8; float v8[8];
#pragma unroll
                for (int i = 0; i < 8; ++i) { const int idx = ((k * (l0 + i)) & 255) * 16; v8[i] = (cs ? ts[idx] : tc[idx]) * 0.0625f; }
                u32x4 o; o.x = pkbf(v8[0], v8[1]); o.y = pkbf(v8[2], v8[3]); o.z = pkbf(v8[4], v8[5]); o.w = pkbf(v8[6], v8[7]);
                *(u32x4*)(DC + (size_t)k * 512 + cs * 256 + l0) = o; }
        }
        __syncthreads();
    }
    {
        LAS float* sc = (LAS float*)lds; LAS float* red = (LAS float*)(lds + 40960);
        bool have = false;
        for (int it = bid; it < 192; it += G) {
            if (!have) { for (int idx = tid; idx < 9216; idx += 512) { const int r = idx >> 10, k = idx & 1023; const float cv = r < 8 ? p.in[1][r * 1024 + k] : p.in[3][k]; sc[idx] = cv / (1.f + __expf(-cv)); } have = true; __syncthreads(); }
            const int i = it / 48, n = (it % 48) * 64 + (tid & 63), kq = tid >> 6;
            const float* w = p.in[5] + (size_t)i * 1024 * 3072 + n;
            float acc[9];
#pragma unroll
            for (int r = 0; r < 9; ++r) acc[r] = 0.f;
            for (int k = kq * 128; k < kq * 128 + 128; k += 4) { const float w0 = w[(size_t)k * 3072], w1 = w[(size_t)(k + 1) * 3072], w2 = w[(size_t)(k + 2) * 3072], w3 = w[(size_t)(k + 3) * 3072];
#pragma unroll
                for (int r = 0; r < 9; ++r) { const f32x4 s4 = *(const LAS f32x4*)(sc + r * 1024 + k); acc[r] += (s4[0] * w0 + s4[1] * w1) + (s4[2] * w2 + s4[3] * w3); } }
#pragma unroll
            for (int r = 0; r < 9; ++r) red[(kq * 9 + r) * 64 + (tid & 63)] = acc[r];
            __syncthreads();
            for (int idx = tid; idx < 576; idx += 512) { const int r = idx >> 6, col = idx & 63; float s = 0.f;
#pragma unroll
                for (int q = 0; q < 8; ++q) s += red[(q * 9 + r) * 64 + col];
                const int nn = (it % 48) * 64 + col;
                ((float*)(ws + WS_MOD))[(size_t)(i * 9 + r) * 3072 + nn] = s + p.in[6][i * 3072 + nn]; }
            __syncthreads();
        }
    }
    if (bid == 0) { for (int t = tid; t < 1024; t += 512) { const int pos = t >> 4, qd = t & 15; const float inv = powf(10000.f, -(float)qd / 16.f); const float ang = (float)pos * inv;
            ((float*)(ws + WS_ROPE))[t] = cosf(ang); ((float*)(ws + WS_ROPE))[1024 + t] = sinf(ang); } }
}
__device__ __forceinline__ void ph_phase(const float* xlat, const float* xctx, const float* gain, const float* mod, bf16_t* Hb, int G, int bid) {
    const int tid_ = opaque_tid(); const int lane = tid_ & 63, wid = tid_ >> 6;
    const int stride = G * 8;
    for (int row0 = bid * 8 + wid; row0 < TT; row0 += 2 * stride) {
        const int row1 = row0 + stride; const bool has1 = row1 < TT;
        const float* s0 = row0 < TL ? xlat + (size_t)row0 * 1024 : xctx + (size_t)(row0 - TL) * 1024;
        const float* s1 = !has1 ? s0 : (row1 < TL ? xlat + (size_t)row1 * 1024 : xctx + (size_t)(row1 - TL) * 1024);
        f32x4 v0[4], v1[4]; float q0 = 0.f, q1 = 0.f;
#pragma unroll
        for (int j = 0; j < 4; ++j) { v0[j] = *(const f32x4*)(s0 + 4 * lane + 256 * j); v1[j] = *(const f32x4*)(s1 + 4 * lane + 256 * j); }
#pragma unroll
        for (int j = 0; j < 4; ++j) { q0 += (v0[j].x * v0[j].x + v0[j].y * v0[j].y) + (v0[j].z * v0[j].z + v0[j].w * v0[j].w); q1 += (v1[j].x * v1[j].x + v1[j].y * v1[j].y) + (v1[j].z * v1[j].z + v1[j].w * v1[j].w); }
        const float r0 = rsqrtf(wave_sum(q0) * (1.f / 1024.f) + 1e-6f), r1 = rsqrtf(wave_sum(q1) * (1.f / 1024.f) + 1e-6f);
        const float* m0 = mod + (row0 < TL ? (row0 >> 12) : 8) * 3072; const float* m1 = mod + (row1 < TL ? (row1 >> 12) : 8) * 3072;
#pragma unroll
        for (int j = 0; j < 4; ++j) { const int col = 4 * lane + 256 * j; const f32x4 g4 = *(const f32x4*)(gain + col);
            { const f32x4 sh = *(const f32x4*)(m0 + col), sc = *(const f32x4*)(m0 + 1024 + col); const f32x4 y = v0[j] * r0 * g4 * (sc + 1.f) + sh; u32x2 o; o.x = pkbf(y.x, y.y); o.y = pkbf(y.z, y.w); *(u32x2*)(Hb + (size_t)row0 * 1024 + col) = o; }
            if (has1) { const f32x4 sh = *(const f32x4*)(m1 + col), sc = *(const f32x4*)(m1 + 1024 + col); const f32x4 y = v1[j] * r1 * g4 * (sc + 1.f) + sh; u32x2 o; o.x = pkbf(y.x, y.y); o.y = pkbf(y.z, y.w); *(u32x2*)(Hb + (size_t)row1 * 1024 + col) = o; } }
    }
}
__device__ __forceinline__ void final_phase(float* x, const float* gain, int G, int bid) {
    const int tid_ = opaque_tid(); const int lane = tid_ & 63, wid = tid_ >> 6;
    const int stride = G * 8;
    for (int row0 = bid * 8 + wid; row0 < TL; row0 += 2 * stride) {
        const int row1 = row0 + stride; const bool has1 = row1 < TL;
        float* s0 = x + (size_t)row0 * 1024; float* s1 = has1 ? x + (size_t)row1 * 1024 : s0;
        f32x4 v0[4], v1[4]; float q0 = 0.f, q1 = 0.f;
#pragma unroll
        for (int j = 0; j < 4; ++j) { v0[j] = *(const f32x4*)(s0 + 4 * lane + 256 * j); v1[j] = *(const f32x4*)(s1 + 4 * lane + 256 * j); }
#pragma unroll
        for (int j = 0; j < 4; ++j) { q0 += (v0[j].x * v0[j].x + v0[j].y * v0[j].y) + (v0[j].z * v0[j].z + v0[j].w * v0[j].w); q1 += (v1[j].x * v1[j].x + v1[j].y * v1[j].y) + (v1[j].z * v1[j].z + v1[j].w * v1[j].w); }
        const float r0 = rsqrtf(wave_sum(q0) * (1.f / 1024.f) + 1e-6f), r1 = rsqrtf(wave_sum(q1) * (1.f / 1024.f) + 1e-6f);
#pragma unroll
        for (int j = 0; j < 4; ++j) { const int col = 4 * lane + 256 * j; const f32x4 g4 = *(const f32x4*)(gain + col);
            *(f32x4*)(s0 + col) = v0[j] * r0 * g4;
            if (has1) *(f32x4*)(s1 + col) = v1[j] * r1 * g4; }
    }
}
__device__ __forceinline__ void fnet_fold(const bf16_t* ATL, bf16_t* E, bf16_t* O, float* TA, const bf16_t* Z, bf16_t* OG, int G, int bid) {
    const int tid_ = opaque_tid(); const int lane = tid_ & 63, wid = tid_ >> 6;
    for (int row = bid * 8 + wid; row < 8192; row += G * 8) {
        const bf16_t* a1 = ATL + (size_t)row * 8192; const bf16_t* a2 = a1 + 4096; bf16_t* e = E + (size_t)row * 2048; bf16_t* od = O + (size_t)row * 2048;
        float alt = 0.f;
#pragma unroll 2
        for (int it = 0; it < 4; ++it) {
            const int j0 = (it * 64 + lane) * 8;
            const u32x4 x = *(const u32x4*)(a1 + j0), y = *(const u32x4*)(a2 + j0);
            const int mb = 4096 - j0 - 8;
            const u32x4 xm = *(const u32x4*)(a1 + mb), ym = *(const u32x4*)(a2 + mb);
            const unsigned short xe = (j0 == 0) ? (unsigned short)0 : a1[4096 - j0], ye = (j0 == 0) ? (unsigned short)0 : a2[4096 - j0];
            float fa[8], fs[8], ma[8], ms[8];
#pragma unroll
            for (int i = 0; i < 4; ++i) { fa[2 * i] = bflo(x[i]); fa[2 * i + 1] = bfhi(x[i]); fs[2 * i] = bflo(y[i]); fs[2 * i + 1] = bfhi(y[i]);
                ma[2 * i] = bflo(xm[i]); ma[2 * i + 1] = bfhi(xm[i]); ms[2 * i] = bflo(ym[i]); ms[2 * i + 1] = bfhi(ym[i]); }
            float oc[8], os[8];
            oc[0] = fa[0] + bf1(xe); os[0] = fs[0] - bf1(ye);
#pragma unroll
            for (int i = 1; i < 8; ++i) { oc[i] = fa[i] + ma[8 - i]; os[i] = fs[i] - ms[8 - i]; }
            if (j0 == 0) { oc[0] = fa[0]; os[0] = 0.f; }
            u32x4 o; o.x = pkbf(oc[0], oc[1]); o.y = pkbf(oc[2], oc[3]); o.z = pkbf(oc[4], oc[5]); o.w = pkbf(oc[6], oc[7]);
            *(u32x4*)(e + j0) = o;
            alt += (bflo(o.x) - bfhi(o.x)) + (bflo(o.y) - bfhi(o.y)) + (bflo(o.z) - bfhi(o.z)) + (bflo(o.w) - bfhi(o.w));
            o.x = pkbf(os[0], os[1]); o.y = pkbf(os[2], os[3]); o.z = pkbf(os[4], os[5]); o.w = pkbf(os[6], os[7]);
            *(u32x4*)(od + j0) = o;
        }
        alt = wave_sum(alt);
        if (lane == 0) { const float amid = bf1(a1[2048]); TA[row] = amid * 0.015625f;
            const int b = row >> 10, n = row & 1023; const size_t off = (size_t)(b * 4096 + 2048) * 1024 + n;
            const float yv = (alt + amid) * 0.015625f * silu_f(bf1(Z[off]));
            OG[off] = (bf16_t)(pkbf(yv, 0.f) & 0xffffu); }
    }
}
__device__ __forceinline__ void sh8(const bf16_t* P, size_t row, int co, bool hm, bool hp, const float* mu, float* out) {
    const u32x4 z4 = {0u, 0u, 0u, 0u};
    const u32x4 c0 = *(const u32x4*)(P + row * RWN + co);
    const u32x4 cm = hm ? *(const u32x4*)(P + (row - 1) * RWN + co) : z4;
    const u32x4 cp = hp ? *(const u32x4*)(P + (row + 1) * RWN + co) : z4;
    const f32x4 m0 = *(const f32x4*)(mu + co), m1 = *(const f32x4*)(mu + co + 4);
#pragma unroll
    for (int i = 0; i < 4; ++i) {
        const float a0 = bflo(c0[i]), a1 = bfhi(c0[i]);
        const float n0 = 0.5f * (bflo(cm[i]) + bflo(cp[i])), n1 = 0.5f * (bfhi(cm[i]) + bfhi(cp[i]));
        const float mu0 = (2 * i < 4) ? m0[(2 * i) & 3] : m1[(2 * i) & 3], mu1 = (2 * i + 1 < 4) ? m0[(2 * i + 1) & 3] : m1[(2 * i + 1) & 3];
        out[2 * i] = a0 + mu0 * (n0 - a0); out[2 * i + 1] = a1 + mu1 * (n1 - a1);
    }
}
template <int CTRL> __device__ __forceinline__ float dpp_f(float v) { return __int_as_float(__builtin_amdgcn_update_dpp(0, __float_as_int(v), CTRL, 0xf, 0xf, true)); }
__device__ __forceinline__ float sum8(float v) { v += dpp_f<0xB1>(v); v += dpp_f<0x4E>(v); v += dpp_f<0x141>(v); return v; }
__device__ __forceinline__ float fast_tanh(float x) { const float e = __expf(2.f * x); return 1.f - 2.f * __builtin_amdgcn_rcpf(e + 1.f); }
__device__ __forceinline__ float fast_sigmoid(float x) { return __builtin_amdgcn_rcpf(1.f + __expf(-x)); }
struct RwArgs { const bf16_t* P; bf16_t* Y0; bf16_t* Y1; float* BZ; const float *mu, *w0, *w_up, *a0, *a_up, *k_k, *k_a, *r_k; };
struct Raw3 { u32x4 c0, cm, cp; };
__device__ __forceinline__ Raw3 ld3(const bf16_t* P, size_t row, int co, bool hm, bool hp) {
    const u32x4 z4 = {0u, 0u, 0u, 0u}; Raw3 r;
    r.c0 = *(const u32x4*)(P + row * RWN + co);
    r.cm = hm ? *(const u32x4*)(P + (row - 1) * RWN + co) : z4;
    r.cp = hp ? *(const u32x4*)(P + (row + 1) * RWN + co) : z4;
    return r;
}
__device__ __forceinline__ void shift8(const Raw3& R, const float* mu, int co, float* out) {
    const f32x4 m0 = *(const f32x4*)(mu + co), m1 = *(const f32x4*)(mu + co + 4);
#pragma unroll
    for (int i = 0; i < 4; ++i) {
        const float a0 = bflo(R.c0[i]), a1 = bfhi(R.c0[i]);
        const float n0 = 0.5f * (bflo(R.cm[i]) + bflo(R.cp[i])), n1 = 0.5f * (bfhi(R.cm[i]) + bfhi(R.cp[i]));
        const float mu0 = (2 * i < 4) ? m0[(2 * i) & 3] : m1[(2 * i) & 3], mu1 = (2 * i + 1 < 4) ? m0[(2 * i + 1) & 3] : m1[(2 * i + 1) & 3];
        out[2 * i] = a0 + mu0 * (n0 - a0); out[2 * i + 1] = a1 + mu1 * (n1 - a1);
    }
}
__device__ __forceinline__ void rwkv_scan(const RwArgs& A, LAS char* lds, int G, int bid) {
    typedef short bfx8 __attribute__((ext_vector_type(8)));
    const int tid = opaque_tid(), lane = tid & 63; const int q = __builtin_amdgcn_readfirstlane(tid >> 6);
    LAS float* sW = (LAS float*)lds; LAS float* sA = sW + 4096; LAS float* sB = sA + 4096; LAS float* sKD = sB + 4096; LAS float* sR = sKD + 4096; LAS float* sV = sR + 4096;
    LAS bf16_t* WUPt = (LAS bf16_t*)(sV + 4096); LAS bf16_t* AUPt = WUPt + 64 * 72;
    LAS bf16_t* T1 = (LAS bf16_t*)sW; LAS bf16_t* T2 = (LAS bf16_t*)sKD;
    const int s = tid >> 3, dg = tid & 7, d0 = dg * 8;
#pragma unroll 1
    for (int chain = bid; chain < 256; chain += G) {
        const int z = chain >> 7, b = (chain >> 4) & 7, hh = chain & 15;
        __syncthreads();
        for (int idx = tid; idx < 4096; idx += 512) { const int r = idx >> 6, d = idx & 63;
            WUPt[d * 72 + r] = (bf16_t)(pkbf(A.w_up[(size_t)(z * 64 + r) * 1024 + hh * 64 + d], 0.f) & 0xffffu);
            AUPt[d * 72 + r] = (bf16_t)(pkbf(A.a_up[(size_t)(z * 64 + r) * 1024 + hh * 64 + d], 0.f) & 0xffffu); }
        f32x2_t S2[4];
#pragma unroll
        for (int j = 0; j < 4; ++j) S2[j] = (f32x2_t){0.f, 0.f};
        bf16_t* Yz = z ? A.Y1 : A.Y0;
        const int c_r = hh * 64 + d0, c_k = 1024 + hh * 64 + d0, c_v = 2048 + hh * 64 + d0, c_wd = 3072 + z * 64 + d0, c_ad = 3200 + z * 64 + d0;
#define RW_ROWOF(c, rowv, hmv, hpv) do { const int sidx_ = (c) * 64 + s; int L_, n_, rb_; \
            if ((c) < 4) { L_ = 256; n_ = z ? (255 - sidx_) : sidx_; rb_ = TL + b * 256; } else { L_ = 4096; const int sl_ = sidx_ - 256; n_ = z ? (4095 - sl_) : sl_; rb_ = b * 4096; } \
            rowv = (size_t)(rb_ + n_); hmv = n_ > 0; hpv = n_ < L_ - 1; } while (0)
        size_t row; bool hm, hp;
        RW_ROWOF(0, row, hm, hp);
        Raw3 Rr = ld3(A.P, row, c_r, hm, hp), Rk = ld3(A.P, row, c_k, hm, hp), Rv = ld3(A.P, row, c_v, hm, hp), Rw = ld3(A.P, row, c_wd, hm, hp), Ra = ld3(A.P, row, c_ad, hm, hp);
#pragma unroll 1
        for (int c = 0; c < 68; ++c) {
            asm volatile("" ::: "memory");
            const size_t crow_ = row;
            {
                float r8[8], k8[8], v8[8], t8[8];
                shift8(Rr, A.mu, c_r, r8); shift8(Rk, A.mu, c_k, k8); shift8(Rv, A.mu, c_v, v8);
                *(LAS f32x4*)(sR + s * 64 + d0) = (f32x4){r8[0], r8[1], r8[2], r8[3]}; *(LAS f32x4*)(sR + s * 64 + d0 + 4) = (f32x4){r8[4], r8[5], r8[6], r8[7]};
                *(LAS f32x4*)(sV + s * 64 + d0) = (f32x4){v8[0], v8[1], v8[2], v8[3]}; *(LAS f32x4*)(sV + s * 64 + d0 + 4) = (f32x4){v8[4], v8[5], v8[6], v8[7]};
                *(LAS f32x4*)(sB + s * 64 + d0) = (f32x4){k8[0], k8[1], k8[2], k8[3]}; *(LAS f32x4*)(sB + s * 64 + d0 + 4) = (f32x4){k8[4], k8[5], k8[6], k8[7]};
                float kkr[8], ssq = 0.f;
                const f32x4 kk0 = *(const f32x4*)(A.k_k + hh * 64 + d0), kk1 = *(const f32x4*)(A.k_k + hh * 64 + d0 + 4);
#pragma unroll
                for (int i = 0; i < 8; ++i) { kkr[i] = k8[i] * (i < 4 ? kk0[i & 3] : kk1[i & 3]); ssq += kkr[i] * kkr[i]; }
                ssq = sum8(ssq);
                const float rs = -rsqrtf(ssq + 1e-12f);
                *(LAS f32x4*)(sA + s * 64 + d0) = (f32x4){kkr[0] * rs, kkr[1] * rs, kkr[2] * rs, kkr[3] * rs}; *(LAS f32x4*)(sA + s * 64 + d0 + 4) = (f32x4){kkr[4] * rs, kkr[5] * rs, kkr[6] * rs, kkr[7] * rs};
                shift8(Rw, A.mu, c_wd, t8);
                { u32x4 o; o.x = pkbf(fast_tanh(t8[0]), fast_tanh(t8[1])); o.y = pkbf(fast_tanh(t8[2]), fast_tanh(t8[3])); o.z = pkbf(fast_tanh(t8[4]), fast_tanh(t8[5])); o.w = pkbf(fast_tanh(t8[6]), fast_tanh(t8[7]));
                  *(LAS u32x4*)(T1 + s * 72 + d0) = o; }
                shift8(Ra, A.mu, c_ad, t8);
                { u32x4 o; o.x = pkbf(t8[0], t8[1]); o.y = pkbf(t8[2], t8[3]); o.z = pkbf(t8[4], t8[5]); o.w = pkbf(t8[6], t8[7]);
                  *(LAS u32x4*)(T2 + s * 72 + d0) = o; }
            }
            if (c + 1 < 68) { RW_ROWOF(c + 1, row, hm, hp);
                Rr = ld3(A.P, row, c_r, hm, hp); Rk = ld3(A.P, row, c_k, hm, hp); Rv = ld3(A.P, row, c_v, hm, hp); Rw = ld3(A.P, row, c_wd, hm, hp); Ra = ld3(A.P, row, c_ad, hm, hp); }
            __syncthreads();
            const int mt = q & 3, nh = q >> 2, fr = lane & 15, fq = lane >> 4;
            f32x4 accw[2], acca[2];
            {
                bfx8 aw[2], aa[2];
#pragma unroll
                for (int kk = 0; kk < 2; ++kk) { aw[kk] = *(const LAS bfx8*)(T1 + (16 * mt + fr) * 72 + kk * 32 + fq * 8); aa[kk] = *(const LAS bfx8*)(T2 + (16 * mt + fr) * 72 + kk * 32 + fq * 8); }
#pragma unroll
                for (int nt = 0; nt < 2; ++nt) { accw[nt] = (f32x4){0.f, 0.f, 0.f, 0.f}; acca[nt] = (f32x4){0.f, 0.f, 0.f, 0.f};
#pragma unroll
                    for (int kk = 0; kk < 2; ++kk) {
                        const bfx8 bw = *(const LAS bfx8*)(WUPt + (32 * nh + 16 * nt + fr) * 72 + kk * 32 + fq * 8), ba = *(const LAS bfx8*)(AUPt + (32 * nh + 16 * nt + fr) * 72 + kk * 32 + fq * 8);
                        accw[nt] = __builtin_amdgcn_mfma_f32_16x16x32_bf16(aw[kk], bw, accw[nt], 0, 0, 0);
                        acca[nt] = __builtin_amdgcn_mfma_f32_16x16x32_bf16(aa[kk], ba, acca[nt], 0, 0, 0); } }
            }
            __syncthreads();
#pragma unroll
            for (int nt = 0; nt < 2; ++nt) { const int d = 32 * nh + 16 * nt + fr, dcol = hh * 64 + d;
                const float w0d = A.w0[z * 1024 + dcol], a0d = A.a0[z * 1024 + dcol], kad = A.k_a[dcol];
#pragma unroll
                for (int j = 0; j < 4; ++j) { const int idx = (16 * mt + 4 * fq + j) * 64 + d;
                    const float x = -(w0d + accw[nt][j]);
                    const float sp = fmaxf(x, 0.f) + __logf(1.f + __expf(-fabsf(x)));
                    const float w = __expf(-__expf(-sp - 0.5f));
                    const float asig = fast_sigmoid(a0d + acca[nt][j]);
                    const float nkk = sA[idx], kraw = sB[idx];
                    sW[idx] = w; sB[idx] = -nkk * asig; sKD[idx] = kraw * (1.f + (asig - 1.f) * kad); } }
            __syncthreads();
            {
                const f32x4 ra = *(const LAS f32x4*)(sR + s * 64 + d0), rb = *(const LAS f32x4*)(sR + s * 64 + d0 + 4), ka = *(const LAS f32x4*)(sKD + s * 64 + d0), kb = *(const LAS f32x4*)(sKD + s * 64 + d0 + 4);
                const f32x4 q0 = *(const f32x4*)(A.r_k + hh * 64 + d0), q1 = *(const f32x4*)(A.r_k + hh * 64 + d0 + 4);
                float bz = 0.f;
#pragma unroll
                for (int i = 0; i < 4; ++i) { bz += ra[i] * ka[i] * q0[i]; bz += rb[i] * kb[i] * q1[i]; }
                bz = sum8(bz);
                if (dg == 0) A.BZ[((size_t)z * TT + crow_) * 16 + hh] = bz;
            }
            {
                const int rl = lane >> 3, cg = lane & 7, irow = 8 * q + rl;
                const LAS float* bw = sW + 8 * cg; const LAS float* ba_ = sA + 8 * cg; const LAS float* bb_ = sB + 8 * cg; const LAS float* bk = sKD + 8 * cg; const LAS float* br = sR + 8 * cg;
                LAS float* bv = sV + irow;
                f32x4 w0 = *(const LAS f32x4*)(bw), w1 = *(const LAS f32x4*)(bw + 4), a0 = *(const LAS f32x4*)(ba_), a1 = *(const LAS f32x4*)(ba_ + 4);
                f32x4 b0 = *(const LAS f32x4*)(bb_), b1 = *(const LAS f32x4*)(bb_ + 4), k0 = *(const LAS f32x4*)(bk), k1 = *(const LAS f32x4*)(bk + 4);
                f32x4 r0 = *(const LAS f32x4*)(br), r1 = *(const LAS f32x4*)(br + 4); float vi = bv[0];
#pragma unroll 4
                for (int st = 0; st < 64; ++st) {
                    const int on = ((st + 1) & 63) * 64;
                    const f32x4 nw0 = *(const LAS f32x4*)(bw + on), nw1 = *(const LAS f32x4*)(bw + on + 4), na0 = *(const LAS f32x4*)(ba_ + on), na1 = *(const LAS f32x4*)(ba_ + on + 4);
                    const f32x4 nb0 = *(const LAS f32x4*)(bb_ + on), nb1 = *(const LAS f32x4*)(bb_ + on + 4), nk0 = *(const LAS f32x4*)(bk + on), nk1 = *(const LAS f32x4*)(bk + on + 4);
                    const f32x4 nr0 = *(const LAS f32x4*)(br + on), nr1 = *(const LAS f32x4*)(br + on + 4); const float nvi = bv[on];
                    f32x2_t pp2 = S2[0] * (f32x2_t){a0[0], a0[1]};
                    pp2 = S2[1] * (f32x2_t){a0[2], a0[3]} + pp2; pp2 = S2[2] * (f32x2_t){a1[0], a1[1]} + pp2; pp2 = S2[3] * (f32x2_t){a1[2], a1[3]} + pp2;
                    const float sa = sum8(pp2.x + pp2.y);
                    const f32x2_t sa2 = {sa, sa}, v2 = {vi, vi};
                    S2[0] = S2[0] * (f32x2_t){w0[0], w0[1]} + sa2 * (f32x2_t){b0[0], b0[1]} + v2 * (f32x2_t){k0[0], k0[1]};
                    S2[1] = S2[1] * (f32x2_t){w0[2], w0[3]} + sa2 * (f32x2_t){b0[2], b0[3]} + v2 * (f32x2_t){k0[2], k0[3]};
                    S2[2] = S2[2] * (f32x2_t){w1[0], w1[1]} + sa2 * (f32x2_t){b1[0], b1[1]} + v2 * (f32x2_t){k1[0], k1[1]};
                    S2[3] = S2[3] * (f32x2_t){w1[2], w1[3]} + sa2 * (f32x2_t){b1[2], b1[3]} + v2 * (f32x2_t){k1[2], k1[3]};
                    f32x2_t y2 = S2[0] * (f32x2_t){r0[0], r0[1]};
                    y2 = S2[1] * (f32x2_t){r0[2], r0[3]} + y2; y2 = S2[2] * (f32x2_t){r1[0], r1[1]} + y2; y2 = S2[3] * (f32x2_t){r1[2], r1[3]} + y2;
                    const float yv = sum8(y2.x + y2.y);
                    if (cg == 0) bv[st * 64] = yv;
                    w0 = nw0; w1 = nw1; a0 = na0; a1 = na1; b0 = nb0; b1 = nb1; k0 = nk0; k1 = nk1; r0 = nr0; r1 = nr1; vi = nvi;
                }
            }
            __syncthreads();
            { u32x4 o; const LAS float* yr = sV + s * 64 + d0;
              o.x = pkbf(yr[0], yr[1]); o.y = pkbf(yr[2], yr[3]); o.z = pkbf(yr[4], yr[5]); o.w = pkbf(yr[6], yr[7]);
              *(u32x4*)(Yz + crow_ * 1024 + hh * 64 + d0) = o; }
            __syncthreads();
        }
#undef RW_ROWOF
    }
}
__device__ __forceinline__ void rwkv_out(const RwArgs& A, const float* ln_w, const float* ln_b, bf16_t* OG, int G, int bid) {
    const int tid_ = opaque_tid(); const int lane = tid_ & 63, wid = tid_ >> 6; const int c0 = lane * 16, head = lane >> 2;
    for (int row = bid * 8 + wid; row < TT; row += G * 8) {
        const bool lat = row < TL; const int L = lat ? 4096 : 256; const int n = lat ? (row & 4095) : ((row - TL) & 255); const bool hm = n > 0, hp = n < L - 1;
        float y[16], vv[16];
        { const u32x4 a0 = *(const u32x4*)(A.Y0 + (size_t)row * 1024 + c0), a1 = *(const u32x4*)(A.Y0 + (size_t)row * 1024 + c0 + 8);
          const u32x4 b0 = *(const u32x4*)(A.Y1 + (size_t)row * 1024 + c0), b1 = *(const u32x4*)(A.Y1 + (size_t)row * 1024 + c0 + 8);
#pragma unroll
          for (int i = 0; i < 4; ++i) { y[2 * i] = bflo(a0[i]) + bflo(b0[i]); y[2 * i + 1] = bfhi(a0[i]) + bfhi(b0[i]); y[8 + 2 * i] = bflo(a1[i]) + bflo(b1[i]); y[8 + 2 * i + 1] = bfhi(a1[i]) + bfhi(b1[i]); } }
        float s1 = 0.f;
#pragma unroll
        for (int i = 0; i < 16; ++i) s1 += y[i];
        s1 += __shfl_xor(s1, 1); s1 += __shfl_xor(s1, 2); const float mean = s1 * (1.f / 64.f);
        float s2 = 0.f;
#pragma unroll
        for (int i = 0; i < 16; ++i) { y[i] -= mean; s2 += y[i] * y[i]; }
        s2 += __shfl_xor(s2, 1); s2 += __shfl_xor(s2, 2); const float rstd = rsqrtf(s2 * (1.f / 64.f) + 64e-5f);
        sh8(A.P, (size_t)row, 2048 + c0, hm, hp, A.mu, vv); sh8(A.P, (size_t)row, 2048 + c0 + 8, hm, hp, A.mu, vv + 8);
        const float bz = 0.5f * (A.BZ[(size_t)row * 16 + head] + A.BZ[((size_t)TT + row) * 16 + head]);
        const u32x4 z0 = *(const u32x4*)(A.P + (size_t)row * RWN + 3328 + c0), z1 = *(const u32x4*)(A.P + (size_t)row * RWN + 3328 + c0 + 8);
        float ov[16];
#pragma unroll
        for (int i = 0; i < 16; ++i) { const unsigned zw = (i < 8) ? z0[(i >> 1) & 3] : z1[(i >> 1) & 3]; const float zz = (i & 1) ? bfhi(zw) : bflo(zw);
            ov[i] = (y[i] * rstd * ln_w[c0 + i] + ln_b[c0 + i] + bz * vv[i]) * silu_f(zz); }
        u32x4 o0, o1; o0.x = pkbf(ov[0], ov[1]); o0.y = pkbf(ov[2], ov[3]); o0.z = pkbf(ov[4], ov[5]); o0.w = pkbf(ov[6], ov[7]);
        o1.x = pkbf(ov[8], ov[9]); o1.y = pkbf(ov[10], ov[11]); o1.z = pkbf(ov[12], ov[13]); o1.w = pkbf(ov[14], ov[15]);
        *(u32x4*)(OG + (size_t)row * 1024 + c0) = o0; *(u32x4*)(OG + (size_t)row * 1024 + c0 + 8) = o1;
    }
}
#ifdef SKIP_GEMM
#define GEMM_PHASE(EPI, AP, BP, MM, NN, KK, EOBJ) do { (void)EOBJ; } while (0)
#else
#ifndef STAGGER_TICKS
#define STAGGER_TICKS 1500
#endif
__device__ __forceinline__ void stagger_wait(int bid, int units_per_cu_x2) {
    if ((bid & 1) && units_per_cu_x2 >= 4) { const unsigned long long t0 = __builtin_amdgcn_s_memrealtime(); while (__builtin_amdgcn_s_memrealtime() - t0 < (unsigned long long)STAGGER_TICKS) __builtin_amdgcn_s_sleep(32); }
}
#define GEMM_PHASE(EPI, AP, BP, MM, NN, KK, EOBJ) do { pg8::Gemm g_{(const bf16_t*)(AP), (const bf16_t*)(BP), (MM), (NN), (KK)}; pg8::StaticOrder S_; S_.init((MM), (NN), G, bid); \
    pg8::gemm_phase<EPI, pg8::StaticOrder, true, true>((PG8_LAS unsigned char*)lds, g_, S_, EOBJ); } while (0)
#endif
#ifdef SKIP_EpiAttnIn
#define GEMM_PHASE_EpiAttnIn(EPI, AP, BP, MM, NN, KK, EOBJ) do { (void)EOBJ; } while (0)
#else
#define GEMM_PHASE_EpiAttnIn GEMM_PHASE
#endif
#ifdef SKIP_EpiFnT
#define GEMM_PHASE_EpiFnT(EPI, AP, BP, MM, NN, KK, EOBJ) do { (void)EOBJ; } while (0)
#else
#define GEMM_PHASE_EpiFnT GEMM_PHASE
#endif
#ifdef SKIP_EpiPlain
#define GEMM_PHASE_EpiPlain(EPI, AP, BP, MM, NN, KK, EOBJ) do { (void)EOBJ; } while (0)
#else
#define GEMM_PHASE_EpiPlain GEMM_PHASE
#endif
#ifdef SKIP_EpiDft
#define GEMM_PHASE_EpiDft(EPI, AP, BP, MM, NN, KK, EOBJ) do { (void)EOBJ; } while (0)
#else
#define GEMM_PHASE_EpiDft GEMM_PHASE
#endif
#ifdef SKIP_EpiResid
#define GEMM_PHASE_EpiResid(EPI, AP, BP, MM, NN, KK, EOBJ) do { (void)EOBJ; } while (0)
#else
#define GEMM_PHASE_EpiResid GEMM_PHASE
#endif
#define XB_TMO      128
#define XB_XCNT(j)  (256  + 64 * (j))
#define XB_XSUB(j)  (1280 + 64 * (j))
#define XB_XGEN(j)  (2304 + 64 * (j))
#define XB_TOP      3328
#define XB_TOPGEN   3392
#define XCD_BAR_WORDS 3456
#define XB_SPIN_CAP (1u << 18)

__device__ __forceinline__ unsigned xb_ld(unsigned* p)              { return __hip_atomic_load(p, __ATOMIC_RELAXED, __HIP_MEMORY_SCOPE_AGENT); }
__device__ __forceinline__ unsigned xb_add(unsigned* p, unsigned v) { return __hip_atomic_fetch_add(p, v, __ATOMIC_RELAXED, __HIP_MEMORY_SCOPE_AGENT); }
__device__ __forceinline__ unsigned xb_xcc_id() { return (unsigned)__builtin_amdgcn_s_getreg((3 << 11) | 20) & 0xFu; }
#define XB_SPIN(cond, bar) do { unsigned _sp = 0; while (cond) { __builtin_amdgcn_s_sleep(1); \
    if ((++_sp & 255u) == 0u) { if (xb_ld(&(bar)[XB_TMO])) break; if (_sp > XB_SPIN_CAP) { atomicAdd(&(bar)[XB_TMO], 1u); break; } } } } while (0)

struct XcdBarrier {
    unsigned* bar; unsigned x;
    volatile LAS unsigned* st;
};

__device__ __forceinline__ XcdBarrier xcd_barrier_post(unsigned* bar, volatile LAS unsigned* st) {
    XcdBarrier b; b.bar = bar; b.x = xb_xcc_id(); b.st = st;
    if (threadIdx.x == 0) (void)xb_add(&bar[XB_XCNT(b.x)], 1u);
    return b;
}
__device__ __forceinline__ void xcd_barrier_complete(unsigned* bar, unsigned x, unsigned& nloc, unsigned& nx) {
    const unsigned G = gridDim.x * gridDim.y * gridDim.z;
    unsigned sum, cnt, mine, sp = 0u;
    for (;;) {
        sum = 0u; cnt = 0u; mine = 0u;
#pragma unroll
        for (unsigned j = 0; j < 16; ++j) { const unsigned c = xb_ld(&bar[XB_XCNT(j)]); sum += c; cnt += (c > 0u) ? 1u : 0u; mine = (j == x) ? c : mine; }
        if (sum == G) break;
        __builtin_amdgcn_s_sleep(1);
        if ((++sp & 255u) == 0u) { if (xb_ld(&bar[XB_TMO])) break; if (sp > XB_SPIN_CAP) { atomicAdd(&bar[XB_TMO], 1u); break; } }
    }
    nloc = mine > 0u ? mine : 1u; nx = cnt > 0u ? cnt : 1u;
}

__device__ __forceinline__ void xcd_barrier(const XcdBarrier& b) {
    asm volatile("s_waitcnt vmcnt(0)" ::: "memory");
    __syncthreads();
    if (threadIdx.x == 0) {
        unsigned* bar = b.bar;
        __builtin_amdgcn_s_waitcnt(0);
        unsigned nloc = b.st[0], nx = b.st[1];
        if (nloc == 0u) { xcd_barrier_complete(bar, b.x, nloc, nx); b.st[0] = nloc; b.st[1] = nx; }
        const unsigned old = xb_add(&bar[XB_XSUB(b.x)], 1u);
        const unsigned gen = old / nloc;
        if (old + 1u == (gen + 1u) * nloc) {
            __builtin_amdgcn_fence(__ATOMIC_RELEASE, "agent");
            asm volatile("s_waitcnt vmcnt(0)" ::: "memory");
            const unsigned og = xb_add(&bar[XB_TOP], 1u);
            const unsigned tg = og / nx;
            if (og + 1u == (tg + 1u) * nx) xb_add(&bar[XB_TOPGEN], 1u);
            else XB_SPIN(xb_ld(&bar[XB_TOPGEN]) == tg, bar);
            __builtin_amdgcn_fence(__ATOMIC_ACQUIRE, "agent");
            xb_add(&bar[XB_XGEN(b.x)], 1u);
            asm volatile("s_waitcnt vmcnt(0)" ::: "memory");
        } else {
            XB_SPIN(xb_ld(&bar[XB_XGEN(b.x)]) == gen, bar);
            __builtin_amdgcn_fence(__ATOMIC_ACQUIRE, "agent");
            asm volatile("s_waitcnt vmcnt(0)" ::: "memory");
        }
    }
    __syncthreads();
}

#define GRID_SYNC() xcd_barrier(xbar)
template <int layer> __device__ __forceinline__ void layer_body(const Params& p, LAS char* lds, const XcdBarrier& xbar, int G, int bid) {
    unsigned char* ws = p.ws;
    float* mod = (float*)(ws + WS_MOD);
    const float* ropeC = (const float*)(ws + WS_ROPE); const float* ropeS = ropeC + 1024;
    bf16_t* Hb = (bf16_t*)(ws + WS_HB);
    float* XC = (float*)(ws + WS_XC);
    const float* x_in = p.in[0]; const float* ctx_in = p.in[2];
        const float* xl = layer == 0 ? x_in : p.out; const float* xc = layer == 0 ? ctx_in : XC;
        const float* modl = mod + (size_t)layer * 9 * 3072;
        ph_phase(xl, xc, p.in[4] + layer * 1024, modl, Hb, G, bid);
#ifdef PROBE_PH2
        ph_phase(xl, xc, p.in[4] + layer * 1024, modl, Hb, G, bid);
#endif
        GRID_SYNC();
        const int Mout = (layer == 3) ? TL : TT;
        const bf16_t* Wout;
        if constexpr (layer == 0 || layer == 3) {
            const int j = layer == 0 ? 0 : 1;
            pg8::EpiAttnIn E{(bf16_t*)(ws + WS_Q), (bf16_t*)(ws + WS_K), (bf16_t*)(ws + WS_V), (bf16_t*)(ws + WS_Z), ropeC, ropeS};
            GEMM_PHASE_EpiAttnIn(pg8::EpiAttnIn, Hb, ws + WS_WDAIN + (size_t)j * 8 * MiB, TT, 4096, 1024, E);
#ifdef PROBE_GIN2
            GEMM_PHASE_EpiAttnIn(pg8::EpiAttnIn, Hb, ws + WS_WDAIN + (size_t)j * 8 * MiB, TT, 4096, 1024, E);
#endif
            GRID_SYNC();
            float lam;
            { const int lane = opaque_tid() & 63; const float* lq = p.in[9] + j * 128; const float* lk = p.in[10] + j * 128;
              const float s0 = wave_sum(lq[lane] * lk[lane]), s1 = wave_sum(lq[64 + lane] * lk[64 + lane]);
              const float li = 0.8f - 0.6f * expf(-0.3f * (float)layer); lam = expf(s0) - expf(s1) + li;
              att::Args A{(const bf16_t*)(ws + WS_Q), (const bf16_t*)(ws + WS_K), (const bf16_t*)(ws + WS_V), (const bf16_t*)(ws + WS_Z), Hb, p.in[11] + j * 128, lam, 1.f - li, layer == 3 ? 1024 : 1088, (unsigned*)(ws + WS_Y1) + (size_t)bid * 8 * 2048};
#ifndef SKIP_ATT
              att::attn_phase(A, lds, G, bid);
#endif
#ifdef PROBE_ATT2
              att::attn_phase(A, lds, G, bid);
#endif
            }
            GRID_SYNC();
            Wout = (const bf16_t*)(ws + WS_WDAOUT + (size_t)j * 2 * MiB);
        } else if constexpr (layer == 1) {
            { pg8::EpiFnT E{(bf16_t*)(ws + WS_ATL), (bf16_t*)(ws + WS_ATC)};
              GEMM_PHASE_EpiFnT(pg8::EpiFnT, ws + WS_WFNT, Hb, 2048, TT, 1024, E); }
            { pg8::EpiPlain E{(bf16_t*)(ws + WS_ZB), 1024};
              GEMM_PHASE_EpiPlain(pg8::EpiPlain, Hb, ws + WS_WFNZ, TT, 1024, 1024, E); }
            GRID_SYNC();
            fnet_fold((const bf16_t*)(ws + WS_ATL), (bf16_t*)(ws + WS_FOLD), (bf16_t*)(ws + WS_FOLD + 32 * MiB), (float*)(ws + WS_BZ), (const bf16_t*)(ws + WS_ZB), Hb, G, bid);
            GRID_SYNC();
            { pg8::EpiPlain E{(bf16_t*)(ws + WS_ATL), 8192};
              GEMM_PHASE_EpiPlain(pg8::EpiPlain, ws + WS_DFTL, ws + WS_FOLD, 2048, 8192, 2048, E); }
            GRID_SYNC();
            { pg8::EpiDftSym E{(const bf16_t*)(ws + WS_ATL), (const float*)(ws + WS_BZ), (const bf16_t*)(ws + WS_ZB), Hb};
              GEMM_PHASE(pg8::EpiDftSym, ws + WS_DFTL + 8 * MiB, ws + WS_FOLD + 32 * MiB, 2048, 8192, 2048, E); }
            { pg8::EpiDft E{(const bf16_t*)(ws + WS_ZB), Hb, TL, 256};
              GEMM_PHASE_EpiDft(pg8::EpiDft, ws + WS_DFTC, ws + WS_ATC, 256, 8192, 512, E); }
            GRID_SYNC();
            Wout = (const bf16_t*)(ws + WS_WFNOUT);
        } else {
            { pg8::EpiPlain E{(bf16_t*)(ws + WS_P), RWN};
              GEMM_PHASE_EpiPlain(pg8::EpiPlain, Hb, ws + WS_WRWIN, TT, RWN, 1024, E); }
            GRID_SYNC();
            RwArgs A{(const bf16_t*)(ws + WS_P), Hb, (bf16_t*)(ws + WS_Y1), (float*)(ws + WS_BZ), p.in[17], p.in[18], p.in[19], p.in[20], p.in[21], p.in[22], p.in[23], p.in[24]};
#ifndef SKIP_SCAN
            rwkv_scan(A, lds, G, bid);
#endif
#ifdef PROBE_SCAN2
            rwkv_scan(A, lds, G, bid);
#endif
            GRID_SYNC();
#ifndef SKIP_RWOUT
            rwkv_out(A, p.in[25], p.in[26], Hb, G, bid);
#endif
            GRID_SYNC();
            Wout = (const bf16_t*)(ws + WS_WRWOUT);
        }
        { pg8::EpiResid E{xl, xc, p.out, XC, modl + 2048};
          GEMM_PHASE_EpiResid(pg8::EpiResid, Hb, Wout, Mout, 1024, 1024, E);
#ifdef PROBE_OUT2
          if (layer == 0) { GEMM_PHASE_EpiResid(pg8::EpiResid, Hb, Wout, Mout, 1024, 1024, E); }
#endif
        }
        GRID_SYNC();
    }
__global__ void __launch_bounds__(512, 2) fwd_megakernel(Params p) {
    extern __shared__ __attribute__((aligned(16))) unsigned char lds_raw[];
    LAS char* lds = (LAS char*)lds_raw;
    cg::grid_group grid = cg::this_grid();
    const int G = gridDim.x, bid = blockIdx.x;
    volatile LAS unsigned* xst = (volatile LAS unsigned*)(lds + LDS_BYTES - 256);
    if (threadIdx.x < 2) xst[threadIdx.x] = 0u;
    __syncthreads();
    const XcdBarrier xbar = xcd_barrier_post((unsigned*)(p.ws + WS_CTL), xst);

#ifndef SKIP_PRO
    prologue(p, lds, G, bid);
#endif
#ifdef PROBE_PRO2
    __syncthreads(); prologue(p, lds, G, bid);
#endif
    grid.sync();
    layer_body<0>(p, lds, xbar, G, bid);
    layer_body<1>(p, lds, xbar, G, bid);
    layer_body<2>(p, lds, xbar, G, bid);
    layer_body<3>(p, lds, xbar, G, bid);
    final_phase(p.out, p.in[7], G, bid);
}

extern "C" void kernel_launch(void* const* d_in, const int* in_sizes, int n_in, void* d_out, int out_size, void* d_ws, size_t ws_size, hipStream_t stream) {
    static int grid = 0;
    if (grid == 0) {
        if (n_in != 28 || out_size != TL * 1024 || ws_size < WS_END) { fprintf(stderr, "kernel_launch: unexpected shapes: n_in %d out %d ws %zu\n", n_in, out_size, ws_size); grid = -1; return; }
        int dev = 0, cus = 0, per_cu = 0;
        hipGetDevice(&dev); hipDeviceGetAttribute(&cus, hipDeviceAttributeMultiprocessorCount, dev);
        if (hipFuncSetAttribute((const void*)fwd_megakernel, hipFuncAttributeMaxDynamicSharedMemorySize, LDS_BYTES) != hipSuccess) { fprintf(stderr, "kernel_launch: hipFuncSetAttribute failed\n"); grid = -1; return; }
        if (hipOccupancyMaxActiveBlocksPerMultiprocessor(&per_cu, (const void*)fwd_megakernel, 512, LDS_BYTES) != hipSuccess || per_cu < 1) { fprintf(stderr, "kernel_launch: occupancy query failed (%d)\n", per_cu); per_cu = 1; }
        (void)hipGetLastError();
        grid = cus * per_cu;
    }
    if (grid < 0) return;
    if (hipMemsetAsync((char*)d_ws + WS_CTL, 0, 65536, stream) != hipSuccess) { fprintf(stderr, "kernel_launch: hipMemsetAsync failed\n"); return; }
    Params p{};
    for (int i = 0; i < 28; ++i) p.in[i] = (const float*)d_in[i];
    p.out = (float*)d_out; p.ws = (unsigned char*)d_ws;
    void* args[] = {&p};
    hipError_t e = hipLaunchCooperativeKernel((const void*)fwd_megakernel, dim3(grid), dim3(512), args, LDS_BYTES, stream);
    if (e != hipSuccess) fprintf(stderr, "cooperative launch failed: %s (grid %d)\n", hipGetErrorString(e), grid);
}
```

```cpp
#include <hip/hip_runtime.h>
#include <hip/hip_cooperative_groups.h>
#include <cstdio>
#include <cstdint>
#include <cmath>
namespace cg = cooperative_groups;

constexpr int TL = 32768, TCX = 2048, TT = TL + TCX, DM = 1024;
constexpr float QK_C2 = 0.125f * 1.4426950408889634f;
typedef float f32x2_t __attribute__((ext_vector_type(2)));
typedef __bf16 bf16x2_t __attribute__((ext_vector_type(2)));
__device__ __forceinline__ unsigned pkbf(float lo, float hi) { f32x2_t v = {lo, hi}; bf16x2_t b = __builtin_convertvector(v, bf16x2_t); return __builtin_bit_cast(unsigned, b); }
__device__ __forceinline__ float bflo(unsigned u) { return __uint_as_float(u << 16); }
__device__ __forceinline__ float bfhi(unsigned u) { return __uint_as_float(u & 0xffff0000u); }
__device__ __forceinline__ float bf1(unsigned short u) { return __uint_as_float(((unsigned)u) << 16); }
__device__ __forceinline__ float silu_f(float z) { return z * __builtin_amdgcn_rcpf(1.f + __expf(-z)); }
__device__ __forceinline__ int opaque_tid() { int t = threadIdx.x; asm volatile("" : "+v"(t)); return t; }
namespace pg8 {
#define PG8_LAS __attribute__((address_space(3)))
typedef unsigned short bf16_t;
typedef short bf16x8 __attribute__((ext_vector_type(8)));
typedef float f32x4 __attribute__((ext_vector_type(4)));
typedef unsigned u32x4 __attribute__((ext_vector_type(4)));
constexpr int BM = 256, BK = 64, HALF = 128, HTB = HALF * BK * 2  , STAGE_BYTES = 8 * HTB, NXCD = 8, WGM = 8;

__host__ __device__ __forceinline__ int lds_byte(int r, int c) { const int st = (r >> 4) * 2 + (c >> 5), rr = r & 15, cc = c & 31, ob = rr * 64 + cc * 2; return st * 1024 + (ob ^ (((ob >> 9) & 1) << 5)); }
__host__ __device__ __forceinline__ void stage_rc(int b, int& R, int& C) { const int st = b / 1024, sb = b % 1024, swz = sb ^ (((sb >> 9) & 1) << 5); R = (st >> 1) * 16 + swz / 64; C = (st & 1) * 32 + (swz % 64) / 2; }
__host__ __device__ __forceinline__ int perm32(int rho) { const int n = rho >> 4, i = rho & 15; return 8 * (i >> 2) + 4 * n + (i & 3); }

struct Unit { int pm, pn; };
struct Gemm { const bf16_t* A; const bf16_t* Bt; int M, N, K; };

struct StaticOrder {
    int nM, nN, nwg, G, c;
    __host__ __device__ void init(int M, int N, int G_, int c_) { nM = M / BM; nN = N / BM; nwg = nM * nN; G = G_; c = c_; }
    __host__ __device__ bool next(int i, Unit& u) const {
        const long L = (long)i * G + c; if (L >= nwg) return false;
        int wgid = (int)L; { const int q = nwg / NXCD, r = nwg % NXCD, xcd = wgid % NXCD, off = wgid / NXCD; wgid = (xcd < r ? xcd * (q + 1) : r * (q + 1) + (xcd - r) * q) + off; }
        const int nig = WGM * nN, gid = wgid / nig, fm = gid * WGM, gsz = (nM - fm) < WGM ? (nM - fm) : WGM;
        u.pm = fm + ((wgid % nig) % gsz); u.pn = (wgid % nig) / gsz; return true;
    }
    __device__ __forceinline__ void a_ready(const Unit&) const {}
    __device__ __forceinline__ void done(const Unit&) const {}
};

struct EpiAttnIn {
    static constexpr bool PERM = true, AFTER_DRAIN = false;
    bf16_t* Q; bf16_t* Kb; bf16_t* V; bf16_t* Z; const float* ropeC; const float* ropeS;
    __device__ __forceinline__ void operator()(const f32x4 (&acc)[2][2][4][2], const Unit& u, int wr, int wc, int fr, int fq) const {
        const int sect = u.pn >> 2;
        bf16_t* base = sect == 0 ? Q : sect == 1 ? Kb : sect == 2 ? V : Z;
        const int colt = (u.pn & 3) * 256 + wc * 32 + 8 * fq;
        const int row0 = u.pm * BM + wr * 64 + fr;
        const bool rope = (u.pm < 128) && (sect < 2);
        const float sc = (sect == 0) ? QK_C2 : 1.f;
        const int axis = wc & 1;
#pragma unroll
        for (int ai = 0; ai < 2; ++ai)
#pragma unroll
            for (int m = 0; m < 4; ++m) {
                const int row = row0 + ai * HALF + m * 16;
                const int ntok = row & 4095;
                const int pos = axis ? (ntok & 63) : (ntok >> 6);
                bf16_t* rowp;
                if (sect == 1) rowp = base + (size_t)(row >> 6) * 65536 + (size_t)(colt >> 3) * 512 + (row & 63) * 8;
                else if (sect == 2) rowp = base + (size_t)(row >> 6) * 65536 + (size_t)(colt >> 7) * 8192 + (((colt & 127) >> 5) * 4 + ((row & 63) >> 4)) * 512 + (row & 15) * 32 + (colt & 31);
                else rowp = base + (size_t)row * 1024 + colt;
#pragma unroll
                for (int bj = 0; bj < 2; ++bj) {
                    f32x4 v0 = acc[ai][bj][m][0], v1 = acc[ai][bj][m][1];
                    if (rope) {
                        const f32x4 c0 = *(const f32x4*)(ropeC + pos * 16 + 8 * (fq & 1)), c1 = *(const f32x4*)(ropeC + pos * 16 + 8 * (fq & 1) + 4);
                        const f32x4 s0 = *(const f32x4*)(ropeS + pos * 16 + 8 * (fq & 1)), s1 = *(const f32x4*)(ropeS + pos * 16 + 8 * (fq & 1) + 4);
                        f32x4 p0, p1;
#pragma unroll
                        for (int i = 0; i < 4; ++i) { p0[i] = __shfl_xor(v0[i], 32); p1[i] = __shfl_xor(v1[i], 32); }
                        if (fq < 2) { v0 = v0 * c0 - p0 * s0; v1 = v1 * c1 - p1 * s1; }
                        else        { v0 = v0 * c0 + p0 * s0; v1 = v1 * c1 + p1 * s1; }
                    }
                    v0 = v0 * sc; v1 = v1 * sc;
                    u32x4 w; w.x = pkbf(v0[0], v0[1]); w.y = pkbf(v0[2], v0[3]); w.z = pkbf(v1[0], v1[1]); w.w = pkbf(v1[2], v1[3]);
                    *(u32x4*)(rowp + (sect == 1 || sect == 2 ? bj * 8192 : bj * HALF)) = w;
                }
            }
    }
};
struct EpiPlain {
    static constexpr bool PERM = true, AFTER_DRAIN = false;
    bf16_t* O; int ldc;
    __device__ __forceinline__ void operator()(const f32x4 (&acc)[2][2][4][2], const Unit& u, int wr, int wc, int fr, int fq) const {
        const int row0 = u.pm * BM + wr * 64 + fr, col0 = u.pn * BM + wc * 32 + 8 * fq;
#pragma unroll
        for (int ai = 0; ai < 2; ++ai)
#pragma unroll
            for (int m = 0; m < 4; ++m) { bf16_t* rowp = O + (size_t)(row0 + ai * HALF + m * 16) * ldc + col0;
#pragma unroll
                for (int bj = 0; bj < 2; ++bj) { const f32x4 v0 = acc[ai][bj][m][0], v1 = acc[ai][bj][m][1];
                    u32x4 w; w.x = pkbf(v0[0], v0[1]); w.y = pkbf(v0[2], v0[3]); w.z = pkbf(v1[0], v1[1]); w.w = pkbf(v1[2], v1[3]);
                    *(u32x4*)(rowp + bj * HALF) = w; } }
    }
};
struct EpiResid {
    static constexpr bool PERM = false, AFTER_DRAIN = false;
    const float* xin_lat; const float* xin_ctx; float* xout_lat; float* xout_ctx; const float* gate;
    __device__ __forceinline__ void operator()(const f32x4 (&acc)[2][2][4][2], const Unit& u, int wr, int wc, int fr, int fq) const {
        const int rowt = u.pm * BM; const bool lat = rowt < TL; const int r = lat ? (rowt >> 12) : 8;
        const int row0 = rowt + wr * 64 + fr, col0 = u.pn * BM + wc * 32 + 4 * fq;
        const float* xi = lat ? xin_lat + (size_t)row0 * 1024 + col0 : xin_ctx + (size_t)(row0 - TL) * 1024 + col0;
        float* xo = lat ? xout_lat + (size_t)row0 * 1024 + col0 : xout_ctx + (size_t)(row0 - TL) * 1024 + col0;
        f32x4 g[2][2];
#pragma unroll
        for (int bj = 0; bj < 2; ++bj)
#pragma unroll
            for (int n = 0; n < 2; ++n) g[bj][n] = *(const f32x4*)(gate + r * 3072 + col0 + bj * HALF + n * 16);
#pragma unroll
        for (int ai = 0; ai < 2; ++ai) {
            f32x4 pre[4][2][2];
#pragma unroll
            for (int m = 0; m < 4; ++m)
#pragma unroll
                for (int bj = 0; bj < 2; ++bj)
#pragma unroll
                    for (int n = 0; n < 2; ++n) pre[m][bj][n] = *(const f32x4*)(xi + (size_t)(ai * HALF + m * 16) * 1024 + bj * HALF + n * 16);
            asm volatile("" ::: "memory");
#pragma unroll
            for (int m = 0; m < 4; ++m)
#pragma unroll
                for (int bj = 0; bj < 2; ++bj)
#pragma unroll
                    for (int n = 0; n < 2; ++n) *(f32x4*)(xo + (size_t)(ai * HALF + m * 16) * 1024 + bj * HALF + n * 16) = pre[m][bj][n] + g[bj][n] * acc[ai][bj][m][n];
            asm volatile("" ::: "memory");
        }
    }
};
struct EpiFnT {
    static constexpr bool PERM = true, AFTER_DRAIN = false;
    bf16_t* ATL; bf16_t* ATC;
    __device__ __forceinline__ void operator()(const f32x4 (&acc)[2][2][4][2], const Unit& u, int wr, int wc, int fr, int fq) const {
        const int row0 = u.pm * BM + wr * 64 + fr, col0 = u.pn * BM + wc * 32 + 8 * fq;
#pragma unroll
        for (int ai = 0; ai < 2; ++ai)
#pragma unroll
            for (int m = 0; m < 4; ++m) { const int mp = row0 + ai * HALF + m * 16, cs = mp >> 10, n = mp & 1023;
#pragma unroll
                for (int bj = 0; bj < 2; ++bj) { const int t0 = col0 + bj * HALF; bf16_t* dst;
                    if (t0 < TL) { const int b = t0 >> 12, l = t0 & 4095; dst = ATL + ((size_t)((b * 1024 + n) * 2 + cs)) * 4096 + l; }
                    else { const int tc = t0 - TL, b = tc >> 8, l = tc & 255; dst = ATC + ((size_t)((b * 1024 + n) * 2 + cs)) * 256 + l; }
                    const f32x4 v0 = acc[ai][bj][m][0], v1 = acc[ai][bj][m][1];
                    u32x4 w; w.x = pkbf(v0[0], v0[1]); w.y = pkbf(v0[2], v0[3]); w.z = pkbf(v1[0], v1[1]); w.w = pkbf(v1[2], v1[3]);
                    *(u32x4*)dst = w; } }
    }
};
struct EpiDft {
    static constexpr bool PERM = true, AFTER_DRAIN = false;
    const bf16_t* Z; bf16_t* OG; int rowbase; int L;
    __device__ __forceinline__ void operator()(const f32x4 (&acc)[2][2][4][2], const Unit& u, int wr, int wc, int fr, int fq) const {
        const int k0 = u.pm * BM + wr * 64 + fr; const int b = u.pn >> 2; const int n0 = (u.pn & 3) * 256 + wc * 32 + 8 * fq;
#pragma unroll
        for (int ai = 0; ai < 2; ++ai)
#pragma unroll
            for (int m = 0; m < 4; ++m) { const size_t R = (size_t)(rowbase + b * L + k0 + ai * HALF + m * 16);
#pragma unroll
                for (int bj = 0; bj < 2; ++bj) { const size_t off = R * 1024 + n0 + bj * HALF;
                    const u32x4 zz = *(const u32x4*)(Z + off);
                    const f32x4 v0 = acc[ai][bj][m][0], v1 = acc[ai][bj][m][1];
                    u32x4 w;
                    w.x = pkbf(v0[0] * silu_f(bflo(zz.x)), v0[1] * silu_f(bfhi(zz.x))); w.y = pkbf(v0[2] * silu_f(bflo(zz.y)), v0[3] * silu_f(bfhi(zz.y)));
                    w.z = pkbf(v1[0] * silu_f(bflo(zz.z)), v1[1] * silu_f(bfhi(zz.z))); w.w = pkbf(v1[2] * silu_f(bflo(zz.w)), v1[3] * silu_f(bfhi(zz.w)));
                    *(u32x4*)(OG + off) = w; } }
    }
};
struct EpiDftSym {
    static constexpr bool PERM = true, AFTER_DRAIN = false;
    const bf16_t* Pb; const float* TA; const bf16_t* Z; bf16_t* OG;
    __device__ __forceinline__ void operator()(const f32x4 (&acc)[2][2][4][2], const Unit& u, int wr, int wc, int fr, int fq) const {
        const int k0 = u.pm * BM + wr * 64 + fr; const int b = u.pn >> 2; const int c0 = u.pn * BM + wc * 32 + 8 * fq; const int n0 = c0 & 1023;
#pragma unroll
        for (int bj = 0; bj < 2; ++bj) {
            const f32x4 t0 = *(const f32x4*)(TA + c0 + bj * HALF), t1 = *(const f32x4*)(TA + c0 + bj * HALF + 4);
#pragma unroll
            for (int aim = 0; aim < 4; ++aim) { const int ai = aim >> 1, mh = (aim & 1) * 2;
                u32x4 pp[4], z1[4], z2[4];
#pragma unroll
                for (int m = mh; m < mh + 2; ++m) { const int k = k0 + ai * HALF + m * 16;
                    pp[m] = *(const u32x4*)(Pb + (size_t)k * 8192 + c0 + bj * HALF);
                    z1[m] = *(const u32x4*)(Z + (size_t)(b * 4096 + k) * 1024 + n0 + bj * HALF);
                    z2[m] = *(const u32x4*)(Z + (size_t)(b * 4096 + ((4096 - k) & 4095)) * 1024 + n0 + bj * HALF); }
                asm volatile("" ::: "memory");
#pragma unroll
                for (int m = mh; m < mh + 2; ++m) { const int k = k0 + ai * HALF + m * 16; const float sg = (k & 1) ? -1.f : 1.f;
                    const f32x4 q0 = acc[ai][bj][m][0], q1 = acc[ai][bj][m][1];
                    float pt[8];
                    pt[0] = bflo(pp[m].x) + sg * t0[0]; pt[1] = bfhi(pp[m].x) + sg * t0[1]; pt[2] = bflo(pp[m].y) + sg * t0[2]; pt[3] = bfhi(pp[m].y) + sg * t0[3];
                    pt[4] = bflo(pp[m].z) + sg * t1[0]; pt[5] = bfhi(pp[m].z) + sg * t1[1]; pt[6] = bflo(pp[m].w) + sg * t1[2]; pt[7] = bfhi(pp[m].w) + sg * t1[3];
                    { const size_t off = (size_t)(b * 4096 + k) * 1024 + n0 + bj * HALF; const u32x4 zz = z1[m]; u32x4 w;
                      w.x = pkbf((pt[0] - q0[0]) * silu_f(bflo(zz.x)), (pt[1] - q0[1]) * silu_f(bfhi(zz.x))); w.y = pkbf((pt[2] - q0[2]) * silu_f(bflo(zz.y)), (pt[3] - q0[3]) * silu_f(bfhi(zz.y)));
                      w.z = pkbf((pt[4] - q1[0]) * silu_f(bflo(zz.z)), (pt[5] - q1[1]) * silu_f(bfhi(zz.z))); w.w = pkbf((pt[6] - q1[2]) * silu_f(bflo(zz.w)), (pt[7] - q1[3]) * silu_f(bfhi(zz.w)));
                      *(u32x4*)(OG + off) = w; }
                    if (k >= 1) { const size_t off = (size_t)(b * 4096 + 4096 - k) * 1024 + n0 + bj * HALF; const u32x4 zz = z2[m]; u32x4 w;
                      w.x = pkbf((pt[0] + q0[0]) * silu_f(bflo(zz.x)), (pt[1] + q0[1]) * silu_f(bfhi(zz.x))); w.y = pkbf((pt[2] + q0[2]) * silu_f(bflo(zz.y)), (pt[3] + q0[3]) * silu_f(bfhi(zz.y)));
                      w.z = pkbf((pt[4] + q1[0]) * silu_f(bflo(zz.z)), (pt[5] + q1[1]) * silu_f(bfhi(zz.z))); w.w = pkbf((pt[6] + q1[2]) * silu_f(bflo(zz.w)), (pt[7] + q1[3]) * silu_f(bfhi(zz.w)));
                      *(u32x4*)(OG + off) = w; }
                }
                asm volatile("" ::: "memory");
            }
        }
    }
};
template <class Epi, class Sched, bool ALIGN_EPI = false, bool SP2 = false>
__device__ __forceinline__ void gemm_phase(PG8_LAS unsigned char* lds, const Gemm g, const Sched& S, const Epi& E) {
    const int tid = opaque_tid(), wid = __builtin_amdgcn_readfirstlane(tid >> 6), lane = tid & 63, wr = wid >> 2, wc = wid & 3, fr = lane & 15, fq = lane >> 4;
    const int K = g.K, nt = K / BK;
    unsigned voffA[2], voffB[2];
#pragma unroll
    for (int i = 0; i < 2; ++i) { int R, C; stage_rc(tid * 16 + i * 8192, R, C); const int Rb = Epi::PERM ? ((R & ~31) + perm32(R & 31)) : R;
        voffA[i] = (unsigned)(R * K + C) * 2u; voffB[i] = (unsigned)(Rb * K + C) * 2u; }
    const size_t kstep = (size_t)(BK * 2);
    const size_t hstep = (size_t)HALF * K * 2;
    const size_t tstep = 2 * hstep;
    const unsigned ldsw = (unsigned)wid * 1024u;
    const int aoff = lds_byte(wr * 64 + fr, fq * 8), boff = lds_byte(wc * 32 + fr, fq * 8);
#define PG8_SA(b, h) (((b) * 2 + (h)) * HTB)
#define PG8_SB(b, h) ((4 + (b) * 2 + (h)) * HTB)
#define PG8_STAGE(bufoff, gbase, voff) do { _Pragma("unroll") for (int _i = 0; _i < 2; ++_i) \
        __builtin_amdgcn_global_load_lds((const unsigned*)((const char*)(gbase) + (voff)[_i]), (PG8_LAS unsigned*)(lds + (bufoff) + ldsw + _i * 8192), 16, 0, 0); } while (0)
#define PG8_LDA(dst, b, h) do { _Pragma("unroll") for (int m = 0; m < 4; ++m) _Pragma("unroll") for (int k = 0; k < 2; ++k) dst[m][k] = *(const PG8_LAS bf16x8*)(lds + PG8_SA(b, h) + aoff + m * 2048 + k * 1024); } while (0)
#define PG8_LDB(dst, b, h) do { _Pragma("unroll") for (int n = 0; n < 2; ++n) _Pragma("unroll") for (int k = 0; k < 2; ++k) dst[n][k] = *(const PG8_LAS bf16x8*)(lds + PG8_SB(b, h) + boff + n * 2048 + k * 1024); } while (0)
#define PG8_MMA(ai, bj, At, Bt) do { __builtin_amdgcn_s_setprio(1); _Pragma("unroll") for (int m = 0; m < 4; ++m) _Pragma("unroll") for (int n = 0; n < 2; ++n) _Pragma("unroll") for (int k = 0; k < 2; ++k) \
        acc[ai][bj][m][n] = __builtin_amdgcn_mfma_f32_16x16x32_bf16(Bt[n][k], At[m][k], acc[ai][bj][m][n], 0, 0, 0); __builtin_amdgcn_s_setprio(0); } while (0)
#define PG8_WAIT_V(n) asm volatile("s_waitcnt vmcnt(" #n ")" ::: "memory")
#define PG8_WAIT_L(n) asm volatile("s_waitcnt lgkmcnt(" #n ")" ::: "memory")
#define PG8_BAR __builtin_amdgcn_s_barrier()
#define PG8_SCHED __builtin_amdgcn_sched_barrier(0)
    Unit cur, nxt; int ui = 0;
    if (!S.next(0, cur)) return;
    f32x4 acc[2][2][4][2];
#pragma unroll
    for (int a = 0; a < 2; ++a)
#pragma unroll
        for (int b = 0; b < 2; ++b)
#pragma unroll
            for (int m = 0; m < 4; ++m)
#pragma unroll
                for (int n = 0; n < 2; ++n) acc[a][b][m][n] = (f32x4){0.f, 0.f, 0.f, 0.f};
    bf16x8 At[4][2], B0[2][2], B1[2][2];
    const char* cA = (const char*)g.A + (size_t)cur.pm * tstep; const char* cB = (const char*)g.Bt + (size_t)cur.pn * tstep;
    S.a_ready(cur);
    if constexpr (SP2) {
        PG8_STAGE(PG8_SB(0, 0), cB, voffB); PG8_STAGE(PG8_SB(0, 1), cB + hstep, voffB); PG8_STAGE(PG8_SA(0, 0), cA, voffA); PG8_STAGE(PG8_SA(0, 1), cA + hstep, voffA);
        if (wr == 1) PG8_BAR;
        PG8_WAIT_V(2); PG8_BAR;
        PG8_STAGE(PG8_SB(1, 0), cB + kstep, voffB); PG8_STAGE(PG8_SA(1, 0), cA + kstep, voffA); PG8_STAGE(PG8_SB(1, 1), cB + hstep + kstep, voffB);
        PG8_WAIT_V(6); PG8_BAR;
    } else {
        PG8_STAGE(PG8_SB(0, 0), cB, voffB); PG8_STAGE(PG8_SA(0, 0), cA, voffA); PG8_STAGE(PG8_SB(0, 1), cB + hstep, voffB); PG8_STAGE(PG8_SA(0, 1), cA + hstep, voffA);
        if (wr == 1) PG8_BAR;
        PG8_WAIT_V(4); PG8_BAR;
        PG8_STAGE(PG8_SB(1, 0), cB + kstep, voffB); PG8_STAGE(PG8_SA(1, 0), cA + kstep, voffA); PG8_STAGE(PG8_SB(1, 1), cB + hstep + kstep, voffB);
        PG8_WAIT_V(6); PG8_BAR;
    }
    for (;;) {
        const bool has_next = S.next(ui + 1, nxt);
        const char* nA = has_next ? (const char*)g.A + (size_t)nxt.pm * tstep : cA; const char* nB = has_next ? (const char*)g.Bt + (size_t)nxt.pn * tstep : cB;
        for (int t = 0; t < nt; t += 2) {
            const bool last = (t == nt - 2);
            const char* a1 = cA + (size_t)(t + 1) * kstep;
            const char* a2 = last ? nA : cA + (size_t)(t + 2) * kstep; const char* b2 = last ? nB : cB + (size_t)(t + 2) * kstep;
            const char* a3 = a2 + kstep; const char* b3 = b2 + kstep;
            if (last && has_next) S.a_ready(nxt);
            if constexpr (SP2) {
            PG8_LDB(B0, 0, 0); PG8_LDB(B1, 0, 1); PG8_SCHED; PG8_LDA(At, 0, 0); PG8_STAGE(PG8_SA(1, 1), a1 + hstep, voffA);
            PG8_WAIT_V(8); PG8_WAIT_L(0); PG8_BAR; PG8_MMA(0, 0, At, B0); PG8_MMA(0, 1, At, B1); PG8_BAR; PG8_SCHED;
            PG8_LDA(At, 0, 1); PG8_STAGE(PG8_SB(0, 0), b2, voffB); PG8_STAGE(PG8_SB(0, 1), b2 + hstep, voffB); PG8_STAGE(PG8_SA(0, 0), a2, voffA);
            PG8_WAIT_V(8); PG8_WAIT_L(0); PG8_BAR; PG8_MMA(1, 0, At, B0); PG8_MMA(1, 1, At, B1); PG8_BAR; PG8_SCHED;
            PG8_LDB(B0, 1, 0); PG8_LDB(B1, 1, 1); PG8_SCHED; PG8_LDA(At, 1, 0); PG8_STAGE(PG8_SA(0, 1), a2 + hstep, voffA);
            PG8_WAIT_V(8); PG8_WAIT_L(0); PG8_BAR; PG8_MMA(0, 0, At, B0); PG8_MMA(0, 1, At, B1); PG8_BAR; PG8_SCHED;
            PG8_LDA(At, 1, 1); PG8_STAGE(PG8_SB(1, 0), b3, voffB); PG8_STAGE(PG8_SB(1, 1), b3 + hstep, voffB); PG8_STAGE(PG8_SA(1, 0), a3, voffA);
            PG8_WAIT_V(8); PG8_WAIT_L(0); PG8_BAR; PG8_MMA(1, 0, At, B0); PG8_MMA(1, 1, At, B1); PG8_BAR; PG8_SCHED;
            } else {
            PG8_LDB(B0, 0, 0); PG8_SCHED; PG8_LDA(At, 0, 0); PG8_STAGE(PG8_SA(1, 1), a1 + hstep, voffA);
            PG8_WAIT_L(8); PG8_BAR; PG8_WAIT_L(0); PG8_MMA(0, 0, At, B0); PG8_BAR; PG8_SCHED;
            PG8_LDB(B1, 0, 1); PG8_STAGE(PG8_SB(0, 0), b2, voffB);
            PG8_BAR; PG8_WAIT_L(0); PG8_MMA(0, 1, At, B1); PG8_BAR;
            PG8_LDA(At, 0, 1); PG8_STAGE(PG8_SA(0, 0), a2, voffA);
            PG8_BAR; PG8_WAIT_L(0); PG8_MMA(1, 0, At, B0); PG8_BAR; PG8_SCHED;
            PG8_STAGE(PG8_SB(0, 1), b2 + hstep, voffB);
            PG8_WAIT_V(6); PG8_BAR; PG8_MMA(1, 1, At, B1); PG8_BAR;
            PG8_LDB(B0, 1, 0); PG8_SCHED; PG8_LDA(At, 1, 0); PG8_STAGE(PG8_SA(0, 1), a2 + hstep, voffA);
            PG8_WAIT_L(8); PG8_BAR; PG8_WAIT_L(0); PG8_MMA(0, 0, At, B0); PG8_BAR; PG8_SCHED;
            PG8_LDB(B1, 1, 1); PG8_STAGE(PG8_SB(1, 0), b3, voffB);
            PG8_BAR; PG8_WAIT_L(0); PG8_MMA(0, 1, At, B1); PG8_BAR;
            PG8_LDA(At, 1, 1); PG8_STAGE(PG8_SA(1, 0), a3, voffA);
            PG8_BAR; PG8_WAIT_L(0); PG8_MMA(1, 0, At, B0); PG8_BAR; PG8_SCHED;
            PG8_STAGE(PG8_SB(1, 1), b3 + hstep, voffB);
            PG8_WAIT_V(6); PG8_BAR; PG8_MMA(1, 1, At, B1); PG8_BAR;
            }
        }
        if constexpr (ALIGN_EPI) { if (wr == 0) PG8_BAR; }
        if constexpr (!Epi::AFTER_DRAIN) { E(acc, cur, wr, wc, fr, fq); S.done(cur); }
        if (!has_next) break;
#pragma unroll
        for (int a = 0; a < 2; ++a)
#pragma unroll
            for (int b = 0; b < 2; ++b)
#pragma unroll
                for (int m = 0; m < 4; ++m)
#pragma unroll
                    for (int n = 0; n < 2; ++n) acc[a][b][m][n] = (f32x4){0.f, 0.f, 0.f, 0.f};
        cur = nxt; cA = nA; cB = nB; ++ui;
        if constexpr (ALIGN_EPI) { if (wr == 1) PG8_BAR; }
    }
    PG8_WAIT_V(0);
    if constexpr (!ALIGN_EPI) { if (wr == 0) PG8_BAR; }
    PG8_BAR;
    if constexpr (Epi::AFTER_DRAIN) { E.fused(acc, cur, wr, wc, fr, fq, lds, wid, lane); S.done(cur); }
#undef PG8_SA
#undef PG8_SB
#undef PG8_STAGE
#undef PG8_LDA
#undef PG8_LDB
#undef PG8_MMA
#undef PG8_WAIT_V
#undef PG8_WAIT_L
#undef PG8_BAR
#undef PG8_SCHED
}
}
#define LAS __attribute__((address_space(3)))
namespace att {
using bf16x8 = __attribute__((ext_vector_type(8))) short;
using s16x4 = __attribute__((ext_vector_type(4))) short;
using f32x16 = __attribute__((ext_vector_type(16))) float;
using u32x4 = __attribute__((ext_vector_type(4))) unsigned;
typedef unsigned short bf16_t;
__device__ __forceinline__ int crow(int r, int hi) { return (r & 3) + 8 * (r >> 2) + 4 * hi; }
constexpr int KSLOT = 8192, VSLOT = 16384, LDS_K = 0, LDS_V = 3 * KSLOT, LDS_WS = LDS_V + 4 * VSLOT, LDS_CNT = LDS_WS + 2048;
struct Args { const bf16_t* Q; const bf16_t* K; const bf16_t* V; const bf16_t* Z; bf16_t* O; const float* gain; float lam; float oml; int n_units; unsigned* o1g; };

__device__ __forceinline__ void qkt(f32x16& p0, f32x16& p1, const LAS char* Kslot, const bf16x8* qr, const f32x16& negm, int r32, int hi) {
    const LAS char* kb = Kslot + hi * 1024 + r32 * 16;
    bf16x8 kf[8];
#pragma unroll
    for (int d0 = 0; d0 < 4; ++d0) { kf[2 * d0] = *(const LAS bf16x8*)(kb + d0 * 2048); kf[2 * d0 + 1] = *(const LAS bf16x8*)(kb + d0 * 2048 + 512); }
    asm volatile("s_waitcnt lgkmcnt(0)" ::: "memory"); __builtin_amdgcn_sched_barrier(0);
    p0 = __builtin_amdgcn_mfma_f32_32x32x16_bf16(kf[0], qr[0], negm, 0, 0, 0); p1 = __builtin_amdgcn_mfma_f32_32x32x16_bf16(kf[1], qr[0], negm, 0, 0, 0);
#pragma unroll
    for (int d0 = 1; d0 < 4; ++d0) { p0 = __builtin_amdgcn_mfma_f32_32x32x16_bf16(kf[2 * d0], qr[d0], p0, 0, 0, 0); p1 = __builtin_amdgcn_mfma_f32_32x32x16_bf16(kf[2 * d0 + 1], qr[d0], p1, 0, 0, 0); }
}
__device__ __forceinline__ void kload(bf16x8* kf, const LAS char* Kslot, int r32, int hi) {
    const LAS char* kb = Kslot + hi * 1024 + r32 * 16;
#pragma unroll
    for (int d0 = 0; d0 < 4; ++d0) { kf[2 * d0] = *(const LAS bf16x8*)(kb + d0 * 2048); kf[2 * d0 + 1] = *(const LAS bf16x8*)(kb + d0 * 2048 + 512); }
}
__device__ __forceinline__ void qk_mm(f32x16& p0, f32x16& p1, const bf16x8* kf, const bf16x8* qr, const f32x16& z) {
    p0 = __builtin_amdgcn_mfma_f32_32x32x16_bf16(kf[0], qr[0], z, 0, 0, 0); p1 = __builtin_amdgcn_mfma_f32_32x32x16_bf16(kf[1], qr[0], z, 0, 0, 0);
#pragma unroll
    for (int d0 = 1; d0 < 4; ++d0) { p0 = __builtin_amdgcn_mfma_f32_32x32x16_bf16(kf[2 * d0], qr[d0], p0, 0, 0, 0); p1 = __builtin_amdgcn_mfma_f32_32x32x16_bf16(kf[2 * d0 + 1], qr[d0], p1, 0, 0, 0); }
}
__device__ __forceinline__ float max3a(float a, float b, float c) { float r; asm("v_max3_f32 %0, %1, %2, %3" : "=v"(r) : "v"(a), "v"(b), "v"(c)); return r; }
__device__ __forceinline__ float rowmax(const f32x16& p0, const f32x16& p1) {
    float a = max3a(p0[0], p0[1], p0[2]), b = max3a(p1[0], p1[1], p1[2]);
#pragma unroll
    for (int r = 3; r < 15; r += 2) { a = max3a(a, p0[r], p0[r + 1]); b = max3a(b, p1[r], p1[r + 1]); }
    a = max3a(a, p0[15], p1[15]);
    float m; asm("v_max_f32 %0, %1, %2" : "=v"(m) : "v"(a), "v"(b));
    asm volatile("s_nop 1" ::: "memory");
    auto rr = __builtin_amdgcn_permlane32_swap(__float_as_uint(m), __float_as_uint(m), false, false);
    float o; asm("v_max_f32 %0, %1, %2" : "=v"(o) : "v"(__uint_as_float(rr[0])), "v"(__uint_as_float(rr[1])));
    return o;
}
#define ATT_VRD(buf, d0) do { _Pragma("unroll") for (int ks = 0; ks < 4; ++ks) { \
        asm volatile("ds_read_b64_tr_b16 %0,%1 offset:%c2" : "=&v"(lo[buf][ks]) : "v"(vb), "i"((d0) * 4096 + ks * 1024) : "memory"); \
        asm volatile("ds_read_b64_tr_b16 %0,%1 offset:%c2" : "=&v"(hi[buf][ks]) : "v"(vb), "i"((d0) * 4096 + ks * 1024 + 512) : "memory"); } } while (0)
#define ATT_PK(b, k) (bf16x8){lo[b][k][0], lo[b][k][1], lo[b][k][2], lo[b][k][3], hi[b][k][0], hi[b][k][1], hi[b][k][2], hi[b][k][3]}
#define ATT_MM2(da, db) do { \
        o[da] = __builtin_amdgcn_mfma_f32_32x32x16_bf16(pa0, ATT_PK(0, 0), o[da], 0, 0, 0); o[db] = __builtin_amdgcn_mfma_f32_32x32x16_bf16(pa0, ATT_PK(1, 0), o[db], 0, 0, 0); \
        o[da] = __builtin_amdgcn_mfma_f32_32x32x16_bf16(pa1, ATT_PK(0, 1), o[da], 0, 0, 0); o[db] = __builtin_amdgcn_mfma_f32_32x32x16_bf16(pa1, ATT_PK(1, 1), o[db], 0, 0, 0); \
        o[da] = __builtin_amdgcn_mfma_f32_32x32x16_bf16(pa2, ATT_PK(0, 2), o[da], 0, 0, 0); o[db] = __builtin_amdgcn_mfma_f32_32x32x16_bf16(pa2, ATT_PK(1, 2), o[db], 0, 0, 0); \
        o[da] = __builtin_amdgcn_mfma_f32_32x32x16_bf16(pa3, ATT_PK(0, 3), o[da], 0, 0, 0); o[db] = __builtin_amdgcn_mfma_f32_32x32x16_bf16(pa3, ATT_PK(1, 3), o[db], 0, 0, 0); } while (0)
__device__ __forceinline__ void pv(f32x16* o, int vb, bf16x8 pa0, bf16x8 pa1, bf16x8 pa2, bf16x8 pa3) {
    s16x4 lo[2][4], hi[2][4];
    ATT_VRD(0, 0);
    ATT_VRD(1, 1);
    asm volatile("s_waitcnt lgkmcnt(0)" ::: "memory"); __builtin_amdgcn_sched_barrier(0);
    ATT_MM2(0, 1); __builtin_amdgcn_sched_barrier(0);
    ATT_VRD(0, 2);
    ATT_VRD(1, 3);
    asm volatile("s_waitcnt lgkmcnt(0)" ::: "memory"); __builtin_amdgcn_sched_barrier(0);
    ATT_MM2(2, 3);
}
#undef ATT_MM2
#undef ATT_VRD
#undef ATT_PK
__device__ __forceinline__ void attn_pass(const Args& A, int z, int b, int h, int qrow0, bool isctx, bool pathB, LAS char* shm, f32x16* o) {
    const int tid = opaque_tid(), lane = tid & 63, r32 = lane & 31, hi = lane >> 5; const int wid = __builtin_amdgcn_readfirstlane(tid >> 6);
    const int NT = isctx ? 4 : 68;
    LAS float* wsf = (LAS float*)(shm + LDS_WS) + wid * 64;
    const int vb0 = (int)(unsigned)(size_t)(shm + LDS_V) + ((lane >> 4) & 1) * 32 + (lane & 3) * 8 + (4 * hi + ((lane & 15) >> 2)) * 64;
    const bf16_t* Qw = A.Q + (size_t)(qrow0 + wid * 32 + r32) * 1024 + h * 128 + z * 64;
    bf16x8 qr[4];
#pragma unroll
    for (int d0 = 0; d0 < 4; ++d0) qr[d0] = *(const bf16x8*)(Qw + d0 * 16 + hi * 8);
    const bf16_t* Kh = A.K + (size_t)((h * 2 + z) * 8 + wid) * 512 + lane * 8;
    const int pc0 = wid, pc1 = wid + 8;
    const bf16_t* Vh0 = A.V + (size_t)h * 8192 + pc0 * 512 + lane * 8;
    const bf16_t* Vh1 = A.V + (size_t)h * 8192 + pc1 * 512 + lane * 8;
    const int ctxrow = TL + b * 256, latrow = b * 4096;
#define ATT_TROW(t) ((isctx || (t) < 4) ? (ctxrow + 64 * (t)) : (latrow + 64 * ((t) - 4)))
#define ATT_DMA(t, slot, vslot) do { const size_t ro_ = (size_t)(ATT_TROW(t) >> 6) * 65536; \
        __builtin_amdgcn_global_load_lds((const unsigned*)(Kh + ro_), (LAS unsigned*)(shm + LDS_K + (slot) * KSLOT + wid * 1024), 16, 0, 0); \
        __builtin_amdgcn_global_load_lds((const unsigned*)(Vh0 + ro_), (LAS unsigned*)(shm + LDS_V + (vslot) * VSLOT + pc0 * 1024), 16, 0, 0); \
        __builtin_amdgcn_global_load_lds((const unsigned*)(Vh1 + ro_), (LAS unsigned*)(shm + LDS_V + (vslot) * VSLOT + pc1 * 1024), 16, 0, 0); } while (0)
    float mhat = 0.f, l_reg = 0.f;
    const f32x16 negm = f32x16{};
#pragma unroll
    for (int d = 0; d < 4; ++d) o[d] = f32x16{};
    ATT_DMA(0, 0, 0);
    if (NT > 1) ATT_DMA(1, 1, 1);
    asm volatile("s_waitcnt vmcnt(0) lgkmcnt(0)\n\ts_barrier" ::: "memory");
    f32x16 sc0, sc1;
    { bf16x8 kf[8]; kload(kf, shm + LDS_K, r32, hi); qk_mm(sc0, sc1, kf, qr, negm); asm volatile("s_nop 15\n\ts_nop 15" : "+v"(sc0), "+v"(sc1)); }
    if (NT > 2) ATT_DMA(2, 2, 2);
    int k_cur = 0, v_cur = 0, v_prev = 3;
    u32x4 pw0 = {0u, 0u, 0u, 0u}, pw1 = pw0, pw2 = pw0, pw3 = pw0;
#pragma unroll 1
    for (int t = 0; t <= NT; ++t) {
        const int k_n1 = (k_cur == 2) ? 0 : k_cur + 1;
        if (t > 0) {
            asm volatile("s_waitcnt vmcnt(0) lgkmcnt(0)\n\ts_barrier" ::: "memory");
            const int k_p2 = (k_cur == 0) ? 2 : k_cur - 1;
            const int v_p2 = (v_cur + 2) & 3;
            if (t + 2 < NT) ATT_DMA(t + 2, k_p2, v_p2);
        }
        if (pathB && t > 0) {
            pv(o, vb0 + v_prev * VSLOT, __builtin_bit_cast(bf16x8, pw0), __builtin_bit_cast(bf16x8, pw1), __builtin_bit_cast(bf16x8, pw2), __builtin_bit_cast(bf16x8, pw3)); }
        if (t < NT) {
        const float rm = rowmax(sc0, sc1);
        if (t == 0) { mhat = rm; }
        else if (__any(rm - mhat > 8.f)) {
            const float dl = fmaxf(rm - mhat, 0.f); mhat += dl;
            const float f = __builtin_amdgcn_exp2f(-dl); l_reg *= f;
            if (hi == 0) wsf[r32] = f;
            asm volatile("s_waitcnt lgkmcnt(0)" ::: "memory");
#pragma unroll
            for (int r = 0; r < 16; ++r) { const float fr_ = wsf[crow(r, hi)];
#pragma unroll
                for (int d = 0; d < 4; ++d) o[d][r] *= fr_; }
            asm volatile("s_waitcnt lgkmcnt(0)" ::: "memory");
        }
        bf16x8 kf[8];
        kload(kf, shm + LDS_K + k_n1 * KSLOT, r32, hi);
        __builtin_amdgcn_sched_barrier(0);
        f32x16 pn0, pn1;
        qk_mm(pn0, pn1, kf, qr, negm);
        f32x2_t sacc = {0.f, 0.f};
#pragma unroll
        for (int r = 0; r < 16; r += 2) { sc0[r] = __builtin_amdgcn_exp2f(sc0[r] - mhat); sc0[r + 1] = __builtin_amdgcn_exp2f(sc0[r + 1] - mhat); sc1[r] = __builtin_amdgcn_exp2f(sc1[r] - mhat); sc1[r + 1] = __builtin_amdgcn_exp2f(sc1[r + 1] - mhat);
            sacc += (f32x2_t){sc0[r], sc0[r + 1]}; sacc += (f32x2_t){sc1[r], sc1[r + 1]}; }
        l_reg += sacc.x + sacc.y;
        pw0 = (u32x4){pkbf(sc0[0], sc0[1]), pkbf(sc0[2], sc0[3]), pkbf(sc0[4], sc0[5]), pkbf(sc0[6], sc0[7])};
        pw1 = (u32x4){pkbf(sc0[8], sc0[9]), pkbf(sc0[10], sc0[11]), pkbf(sc0[12], sc0[13]), pkbf(sc0[14], sc0[15])};
        pw2 = (u32x4){pkbf(sc1[0], sc1[1]), pkbf(sc1[2], sc1[3]), pkbf(sc1[4], sc1[5]), pkbf(sc1[6], sc1[7])};
        pw3 = (u32x4){pkbf(sc1[8], sc1[9]), pkbf(sc1[10], sc1[11]), pkbf(sc1[12], sc1[13]), pkbf(sc1[14], sc1[15])};
#pragma unroll
        for (int i = 0; i < 8; ++i) { __builtin_amdgcn_sched_group_barrier(0x008, 1, 0); __builtin_amdgcn_sched_group_barrier(0x002, 13, 0); }
        __builtin_amdgcn_sched_barrier(0);
        if (!pathB) {
            pv(o, vb0 + v_cur * VSLOT, __builtin_bit_cast(bf16x8, pw0), __builtin_bit_cast(bf16x8, pw1), __builtin_bit_cast(bf16x8, pw2), __builtin_bit_cast(bf16x8, pw3)); }
        sc0 = pn0; sc1 = pn1;
        }
        k_cur = k_n1; v_prev = v_cur; v_cur = (v_cur + 1) & 3;
    }
    asm volatile("s_waitcnt lgkmcnt(0)\n\ts_barrier" ::: "memory");
#undef ATT_DMA
#undef ATT_TROW
    { auto rr = __builtin_amdgcn_permlane32_swap(__float_as_uint(l_reg), __float_as_uint(l_reg), false, false); l_reg = __uint_as_float(rr[0]) + __uint_as_float(rr[1]); }
    asm volatile("s_waitcnt lgkmcnt(0)" ::: "memory");
    if (hi == 0) wsf[32 + r32] = l_reg;
    asm volatile("s_waitcnt lgkmcnt(0)" ::: "memory");
#pragma unroll
    for (int r = 0; r < 16; ++r) { const float rl = 1.0f / wsf[32 + crow(r, hi)];
#pragma unroll
        for (int d = 0; d < 4; ++d) o[d][r] *= rl; }
    asm volatile("s_waitcnt lgkmcnt(0)" ::: "memory");
}
__device__ __forceinline__ void attn_unit(const Args& A, int b, int h, int qb, bool isctx, bool pathB, LAS char* shm) {
    const int tid = opaque_tid(), lane = tid & 63, r32 = lane & 31, hi = lane >> 5; const int wid = __builtin_amdgcn_readfirstlane(tid >> 6);
    const int qrow0 = isctx ? (TL + b * 256) : (b * 4096 + qb * 256);
    f32x16 o[4];
    unsigned* o1s = A.o1g + wid * 2048 + lane;
    attn_pass(A, 0, b, h, qrow0, isctx, pathB, shm, o);
#pragma unroll
    for (int d = 0; d < 4; ++d)
#pragma unroll
        for (int r = 0; r < 16; r += 2) o1s[(d * 8 + (r >> 1)) * 64] = pkbf(o[d][r], o[d][r + 1]);
    asm volatile("s_waitcnt lgkmcnt(0)" ::: "memory");
    attn_pass(A, 1, b, h, qrow0, isctx, pathB, shm, o);
    float ss[16];
#pragma unroll
    for (int r = 0; r < 16; r += 2) { float s0 = 0.f, s1 = 0.f;
#pragma unroll
        for (int d = 0; d < 4; ++d) { const unsigned pk = o1s[(d * 8 + (r >> 1)) * 64];
            const float v0 = bflo(pk) - A.lam * o[d][r], v1 = bfhi(pk) - A.lam * o[d][r + 1]; o[d][r] = v0; o[d][r + 1] = v1; s0 += v0 * v0; s1 += v1 * v1; }
        ss[r] = s0; ss[r + 1] = s1; }
#pragma unroll
    for (int msk = 1; msk < 32; msk <<= 1)
#pragma unroll
        for (int r = 0; r < 16; ++r) ss[r] += __shfl_xor(ss[r], msk);
    float gn[4];
#pragma unroll
    for (int d = 0; d < 4; ++d) gn[d] = A.gain[d * 32 + r32] * A.oml;
#pragma unroll
    for (int rb = 0; rb < 16; rb += 8) {
        unsigned short zr[8][4];
#pragma unroll
        for (int r = 0; r < 8; ++r) { const size_t off = (size_t)(qrow0 + wid * 32 + crow(rb + r, hi)) * 1024 + h * 128 + r32;
#pragma unroll
            for (int d = 0; d < 4; ++d) zr[r][d] = A.Z[off + d * 32]; }
        asm volatile("" ::: "memory");
#pragma unroll
        for (int r = 0; r < 8; ++r) { const float rstd = rsqrtf(ss[rb + r] * (1.0f / 128.0f) + 1e-5f);
            const size_t off = (size_t)(qrow0 + wid * 32 + crow(rb + r, hi)) * 1024 + h * 128 + r32;
#pragma unroll
            for (int d = 0; d < 4; ++d) { const float v = o[d][rb + r] * rstd * gn[d] * silu_f(bf1(zr[r][d]));
                A.O[off + d * 32] = (bf16_t)(pkbf(v, 0.f) & 0xffffu); } }
        asm volatile("" ::: "memory");
    }
}
__device__ __forceinline__ void attn_phase(const Args& A, LAS char* shm, int G, int bid) {
    const int vcu = (G % 8 == 0) ? (bid % 8) * (G / 8) + bid / 8 : bid;
    bool pathB;
    { const int tid = opaque_tid(); LAS unsigned* cnt = (LAS unsigned*)(shm + LDS_CNT);
      if (tid < 4) cnt[tid] = 0u;
      __syncthreads();
      const unsigned simd = (unsigned)__builtin_amdgcn_s_getreg((1 << 11) | (4 << 6) | 4) & 3u;
      unsigned slot = 0u; if ((tid & 63) == 0) slot = __hip_atomic_fetch_add(cnt + simd, 1u, __ATOMIC_RELAXED, __HIP_MEMORY_SCOPE_WORKGROUP);
      slot = (unsigned)__builtin_amdgcn_readfirstlane((int)slot);
      pathB = (slot & 1u) != 0u;
      __syncthreads(); }
#pragma unroll 1
    for (int u = vcu; u < A.n_units; u += G) {
        const bool isctx = u >= 1024; const int bh = isctx ? (u - 1024) : (u >> 4); const int qb = isctx ? 0 : (u & 15);
        attn_unit(A, bh >> 3, bh & 7, qb, isctx, pathB, shm);
        asm volatile("s_waitcnt vmcnt(0) lgkmcnt(0)\n\ts_barrier" ::: "memory");
    }
}
}
typedef unsigned short bf16_t;
typedef float f32x4 __attribute__((ext_vector_type(4)));
typedef unsigned u32x4 __attribute__((ext_vector_type(4)));
typedef unsigned u32x2 __attribute__((ext_vector_type(2)));
constexpr size_t MiB = 1u << 20;
constexpr size_t WS_CTL = 0, WS_MOD = 1 * MiB, WS_ROPE = 1 * MiB + 512 * 1024, WS_BZ = 2 * MiB;
constexpr size_t WS_WDAIN = 9 * MiB, WS_WDAOUT = 25 * MiB, WS_WFNT = 29 * MiB, WS_WFNZ = 33 * MiB, WS_WFNOUT = 35 * MiB, WS_WRWIN = 37 * MiB, WS_WRWOUT = 46 * MiB;
constexpr size_t WS_XC = 48 * MiB, WS_HB = 56 * MiB, WS_BIG = 124 * MiB;
constexpr size_t WS_Q = WS_BIG, WS_K = WS_BIG + 68 * MiB, WS_V = WS_BIG + 136 * MiB, WS_Z = WS_BIG + 204 * MiB;
constexpr size_t WS_ATL = WS_BIG, WS_ATC = WS_BIG + 128 * MiB, WS_ZB = WS_BIG + 136 * MiB, WS_DFTL = 396 * MiB, WS_DFTC = 460 * MiB, WS_FOLD = WS_BIG + 204 * MiB;
constexpr size_t WS_P = WS_BIG, WS_Y1 = 413 * MiB, WS_END = 482 * MiB;
constexpr int RWN = 4352;
constexpr int LDS_BYTES = 147456;

struct Params { const float* in[28]; float* out; unsigned char* ws; };

__device__ __forceinline__ float wave_sum(float v) {
#pragma unroll
    for (int o = 1; o < 64; o <<= 1) v += __shfl_xor(v, o);
    return v;
}
__device__ __forceinline__ void tr_item(const float* W, int ldw, int N, bf16_t* WT, int ldt, LAS float* scr, int item, int lane) {
    const int nblk = N / 32, kb = item / nblk, nb = item % nblk, k0 = 64 * kb, n0 = 32 * nb;
    float v_[32];
#pragma unroll
    for (int i = 0; i < 32; ++i) v_[i] = W[(size_t)(k0 + 2 * i + (lane >> 5)) * ldw + n0 + (lane & 31)];
#pragma unroll
    for (int i = 0; i < 32; ++i) scr[(2 * i + (lane >> 5)) * 33 + (lane & 31)] = v_[i];
    asm volatile("s_waitcnt lgkmcnt(0)" ::: "memory");
    const int c = lane & 7;
#pragma unroll
    for (int j = 0; j < 4; ++j) { const int n = (lane >> 3) + 8 * j; const LAS float* s = scr + (8 * c) * 33 + n;
        u32x4 o; o.x = pkbf(s[0 * 33], s[1 * 33]); o.y = pkbf(s[2 * 33], s[3 * 33]); o.z = pkbf(s[4 * 33], s[5 * 33]); o.w = pkbf(s[6 * 33], s[7 * 33]);
        *(u32x4*)(WT + (size_t)(n0 + n) * ldt + k0 + 8 * c) = o; }
    asm volatile("s_waitcnt lgkmcnt(0)" ::: "memory");
}
__device__ __forceinline__ void prologue(const Params& p, LAS char* lds, int G, int bid) {
    const int tid = opaque_tid(), lane = tid & 63, wid = tid >> 6;
    unsigned char* ws = p.ws;
    {
        LAS float* scr = (LAS float*)(lds + wid * 8448);
        const int gw = bid * 8 + wid, NGW = G * 8;
        for (int it = gw; it < 8832; it += NGW) {
            int r = it;
            if (r < 2048) { tr_item(p.in[8], 4096, 4096, (bf16_t*)(ws + WS_WDAIN), 1024, scr, r, lane); continue; } r -= 2048;
            if (r < 2048) { tr_item(p.in[8] + (size_t)1024 * 4096, 4096, 4096, (bf16_t*)(ws + WS_WDAIN + 8 * MiB), 1024, scr, r, lane); continue; } r -= 2048;
            if (r < 512) { tr_item(p.in[12], 1024, 1024, (bf16_t*)(ws + WS_WDAOUT), 1024, scr, r, lane); continue; } r -= 512;
            if (r < 512) { tr_item(p.in[12] + (size_t)1024 * 1024, 1024, 1024, (bf16_t*)(ws + WS_WDAOUT + 2 * MiB), 1024, scr, r, lane); continue; } r -= 512;
            if (r < 512) { tr_item(p.in[13] + 1024, 2048, 1024, (bf16_t*)(ws + WS_WFNZ), 1024, scr, r, lane); continue; } r -= 512;
            if (r < 512) { tr_item(p.in[15], 1024, 1024, (bf16_t*)(ws + WS_WFNOUT), 1024, scr, r, lane); continue; } r -= 512;
            if (r < 2176) { tr_item(p.in[16], RWN, RWN, (bf16_t*)(ws + WS_WRWIN), 1024, scr, r, lane); continue; } r -= 2176;
            tr_item(p.in[27], 1024, 1024, (bf16_t*)(ws + WS_WRWOUT), 1024, scr, r, lane);
        }
    }
    __syncthreads();
    for (int it = bid; it < 256; it += G) {
        const int g = it >> 5, cs = (it >> 4) & 1, kq = it & 15;
        LAS float* Wcs = (LAS float*)lds; LAS float* win = (LAS float*)(lds + 65536); LAS float* tab = (LAS float*)(lds + 65536 + 33024);
        if (tid < 128) { float s, c; sincospif((float)tid / 64.f, &s, &c); tab[tid] = (cs ? s : c) * 0.08838834764831845f; }
        __syncthreads();
        {
            const int e0 = (tid & 31) * 4, cq = tid >> 5; f32x4 acc[8];
#pragma unroll
            for (int i = 0; i < 8; ++i) acc[i] = (f32x4){0.f, 0.f, 0.f, 0.f};
            const float* Wg = p.in[14] + (size_t)g * 128 * 128;
            for (int m = 0; m < 128; ++m) { const f32x4 wg = *(const f32x4*)(Wg + m * 128 + e0);
#pragma unroll
                for (int i = 0; i < 8; ++i) acc[i] += wg * tab[(m * (cq + 16 * i)) & 127]; }
#pragma unroll
            for (int i = 0; i < 8; ++i) *(LAS f32x4*)(Wcs + (cq + 16 * i) * 128 + e0) = acc[i];
        }
#pragma unroll
        for (int i = 0; i < 16; ++i) { const int idx = tid + 512 * i, kin = idx >> 7, c = idx & 127; win[kin * 129 + c] = p.in[13][(size_t)(kq * 64 + kin) * 2048 + g * 128 + c]; }
        __syncthreads();
        {
            const int kin = tid & 63, eg = tid >> 6; float acc[16];
#pragma unroll
            for (int i = 0; i < 16; ++i) acc[i] = 0.f;
            for (int c = 0; c < 128; ++c) { const float a = win[kin * 129 + c];
#pragma unroll
                for (int i = 0; i < 16; ++i) acc[i] += a * Wcs[c * 128 + eg * 16 + i]; }
            bf16_t* WT = (bf16_t*)(ws + WS_WFNT);
#pragma unroll
            for (int i = 0; i < 16; ++i) WT[(size_t)(cs * 1024 + g * 128 + eg * 16 + i) * 1024 + kq * 64 + kin] = (bf16_t)(pkbf(acc[i], 0.f) & 0xffffu);
        }
        __syncthreads();
    }
    {
        LAS float* tc = (LAS float*)lds; LAS float* ts = (LAS float*)(lds + 16384);
        for (int j = tid; j < 4096; j += 512) { float s, c; sincospif((float)j / 2048.f, &s, &c); tc[j] = c; ts[j] = -s; }
        __syncthreads();
        bf16_t* DL = (bf16_t*)(ws + WS_DFTL); bf16_t* DC = (bf16_t*)(ws + WS_DFTC);
        for (int k = bid; k < 2048; k += G) {
            const int j0 = (tid & 255) * 8; const bool sn = tid >= 256; float v8[8];
#pragma unroll
            for (int i = 0; i < 8; ++i) { const int idx = (k * (j0 + i)) & 4095; v8[i] = (sn ? -ts[idx] : tc[idx]) * 0.015625f; }
            u32x4 o; o.x = pkbf(v8[0], v8[1]); o.y = pkbf(v8[2], v8[3]); o.z = pkbf(v8[4], v8[5]); o.w = pkbf(v8[6], v8[7]);
            *(u32x4*)(DL + (sn ? (size_t)2048 * 2048 : (size_t)0) + (size_t)k * 2048 + j0) = o;
        }
        for (int k = bid; k < 256; k += G) {
            if (tid < 64) { const int cs = tid >> 5, l0 = (tid & 31) * 8; float v8[8];
#pragma unroll
                for (int i = 0; i < 8; ++i) { const int idx = ((k * (l0 + i)) & 255) * 16; v8[i] = (cs ? ts[idx] : tc[idx]) * 0.0625f; }
                u32x4 o; o.x = pkbf(v8[0], v8[1]); o.y = pkbf(v8[2], v8[3]); o.z = pkbf(v8[4], v8[5]); o.w = pkbf(v8[6], v8[7]);
                *(u32x4*)(DC + (size_t)k * 512 + cs * 256 + l0) = o; }
        }
        __syncthreads();
    }
    {
        LAS float* sc = (LAS float*)lds; LAS float* red = (LAS float*)(lds + 40960);
        bool have = false;
        for (int it = bid; it < 192; it += G) {
            if (!have) { for (int idx = tid; idx < 9216; idx += 512) { const int r = idx >> 10, k = idx & 1023; const float cv = r < 8 ? p.in[1][r * 1024 + k] : p.in[3][k]; sc[idx] = cv / (1.f + __expf(-cv)); } have = true; __syncthreads(); }
            const int i = it / 48, n = (it % 48) * 64 + (tid & 63), kq = tid >> 6;
            const float* w = p.in[5] + (size_t)i * 1024 * 3072 + n;
            float acc[9];
#pragma unroll
            for (int r = 0; r < 9; ++r) acc[r] = 0.f;
            for (int k = kq * 128; k < kq * 128 + 128; k += 4) { const float w0 = w[(size_t)k * 3072], w1 = w[(size_t)(k + 1) * 3072], w2 = w[(size_t)(k + 2) * 3072], w3 = w[(size_t)(k + 3) * 3072];
#pragma unroll
                for (int r = 0; r < 9; ++r) { const f32x4 s4 = *(const LAS f32x4*)(sc + r * 1024 + k); acc[r] += (s4[0] * w0 + s4[1] * w1) + (s4[2] * w2 + s4[3] * w3); } }
#pragma unroll
            for (int r = 0; r < 9; ++r) red[(kq * 9 + r) * 64 + (tid & 63)] = acc[r];
            __syncthreads();
            for (int idx = tid; idx < 576; idx += 512) { const int r = idx >> 6, col = idx & 63; float s = 0.f;
#pragma unroll
                for (int q = 0; q < 8; ++q) s += red[(q * 9 + r) * 64 + col];
                const int nn = (it % 48) * 64 + col;
                ((float*)(ws + WS_MOD))[(size_t)(i * 9 + r) * 3072 + nn] = s + p.in[6][i * 3072 + nn]; }
            __syncthreads();
        }
    }
    if (bid == 0) { for (int t = tid; t < 1024; t += 512) { const int pos = t >> 4, qd = t & 15; const float inv = powf(10000.f, -(float)qd / 16.f); const float ang = (float)pos * inv;
            ((float*)(ws + WS_ROPE))[t] = cosf(ang); ((float*)(ws + WS_ROPE))[1024 + t] = sinf(ang); } }
}
__device__ __forceinline__ void ph_phase(const float* xlat, const float* xctx, const float* gain, const float* mod, bf16_t* Hb, int G, int bid) {
    const int tid_ = opaque_tid(); const int lane = tid_ & 63, wid = tid_ >> 6;
    const int stride = G * 8;
    for (int row0 = bid * 8 + wid; row0 < TT; row0 += 2 * stride) {
        const int row1 = row0 + stride; const bool has1 = row1 < TT;
        const float* s0 = row0 < TL ? xlat + (size_t)row0 * 1024 : xctx + (size_t)(row0 - TL) * 1024;
        const float* s1 = !has1 ? s0 : (row1 < TL ? xlat + (size_t)row1 * 1024 : xctx + (size_t)(row1 - TL) * 1024);
        f32x4 v0[4], v1[4]; float q0 = 0.f, q1 = 0.f;
#pragma unroll
        for (int j = 0; j < 4; ++j) { v0[j] = *(const f32x4*)(s0 + 4 * lane + 256 * j); v1[j] = *(const f32x4*)(s1 + 4 * lane + 256 * j); }
#pragma unroll
        for (int j = 0; j < 4; ++j) { q0 += (v0[j].x * v0[j].x + v0[j].y * v0[j].y) + (v0[j].z * v0[j].z + v0[j].w * v0[j].w); q1 += (v1[j].x * v1[j].x + v1[j].y * v1[j].y) + (v1[j].z * v1[j].z + v1[j].w * v1[j].w); }
        const float r0 = rsqrtf(wave_sum(q0) * (1.f / 1024.f) + 1e-6f), r1 = rsqrtf(wave_sum(q1) * (1.f / 1024.f) + 1e-6f);
        const float* m0 = mod + (row0 < TL ? (row0 >> 12) : 8) * 3072; const float* m1 = mod + (row1 < TL ? (row1 >> 12) : 8) * 3072;
#pragma unroll
        for (int j = 0; j < 4; ++j) { const int col = 4 * lane + 256 * j; const f32x4 g4 = *(const f32x4*)(gain + col);
            { const f32x4 sh = *(const f32x4*)(m0 + col), sc = *(const f32x4*)(m0 + 1024 + col); const f32x4 y = v0[j] * r0 * g4 * (sc + 1.f) + sh; u32x2 o; o.x = pkbf(y.x, y.y); o.y = pkbf(y.z, y.w); *(u32x2*)(Hb + (size_t)row0 * 1024 + col) = o; }
            if (has1) { const f32x4 sh = *(const f32x4*)(m1 + col), sc = *(const f32x4*)(m1 + 1024 + col); const f32x4 y = v1[j] * r1 * g4 * (sc + 1.f) + sh; u32x2 o; o.x = pkbf(y.x, y.y); o.y = pkbf(y.z, y.w); *(u32x2*)(Hb + (size_t)row1 * 1024 + col) = o; } }
    }
}
__device__ __forceinline__ void final_phase(float* x, const float* gain, int G, int bid) {
    const int tid_ = opaque_tid(); const int lane = tid_ & 63, wid = tid_ >> 6;
    const int stride = G * 8;
    for (int row0 = bid * 8 + wid; row0 < TL; row0 += 2 * stride) {
        const int row1 = row0 + stride; const bool has1 = row1 < TL;
        float* s0 = x + (size_t)row0 * 1024; float* s1 = has1 ? x + (size_t)row1 * 1024 : s0;
        f32x4 v0[4], v1[4]; float q0 = 0.f, q1 = 0.f;
#pragma unroll
        for (int j = 0; j < 4; ++j) { v0[j] = *(const f32x4*)(s0 + 4 * lane + 256 * j); v1[j] = *(const f32x4*)(s1 + 4 * lane + 256 * j); }
#pragma unroll
        for (int j = 0; j < 4; ++j) { q0 += (v0[j].x * v0[j].x + v0[j].y * v0[j].y) + (v0[j].z * v0[j].z + v0[j].w * v0[j].w); q1 += (v1[j].x * v1[j].x + v1[j].y * v1[j].y) + (v1[j].z * v1[j].z + v1[j].w * v1[j].w); }
        const float r0 = rsqrtf(wave_sum(q0) * (1.f / 1024.f) + 1e-6f), r1 = rsqrtf(wave_sum(q1) * (1.f / 1024.f) + 1e-6f);
#pragma unroll
        for (int j = 0; j < 4; ++j) { const int col = 4 * lane + 256 * j; const f32x4 g4 = *(const f32x4*)(gain + col);
            *(f32x4*)(s0 + col) = v0[j] * r0 * g4;
            if (has1) *(f32x4*)(s1 + col) = v1[j] * r1 * g4; }
    }
}
__device__ __forceinline__ void fnet_fold(const bf16_t* ATL, bf16_t* E, bf16_t* O, float* TA, const bf16_t* Z, bf16_t* OG, int G, int bid) {
    const int tid_ = opaque_tid(); const int lane = tid_ & 63, wid = tid_ >> 6;
    for (int row = bid * 8 + wid; row < 8192; row += G * 8) {
        const bf16_t* a1 = ATL + (size_t)row * 8192; const bf16_t* a2 = a1 + 4096; bf16_t* e = E + (size_t)row * 2048; bf16_t* od = O + (size_t)row * 2048;
        float alt = 0.f;
#pragma unroll 2
        for (int it = 0; it < 4; ++it) {
            const int j0 = (it * 64 + lane) * 8;
            const u32x4 x = *(const u32x4*)(a1 + j0), y = *(const u32x4*)(a2 + j0);
            const int mb = 4096 - j0 - 8;
            const u32x4 xm = *(const u32x4*)(a1 + mb), ym = *(const u32x4*)(a2 + mb);
            const unsigned short xe = (j0 == 0) ? (unsigned short)0 : a1[4096 - j0], ye = (j0 == 0) ? (unsigned short)0 : a2[4096 - j0];
            float fa[8], fs[8], ma[8], ms[8];
#pragma unroll
            for (int i = 0; i < 4; ++i) { fa[2 * i] = bflo(x[i]); fa[2 * i + 1] = bfhi(x[i]); fs[2 * i] = bflo(y[i]); fs[2 * i + 1] = bfhi(y[i]);
                ma[2 * i] = bflo(xm[i]); ma[2 * i + 1] = bfhi(xm[i]); ms[2 * i] = bflo(ym[i]); ms[2 * i + 1] = bfhi(ym[i]); }
            float oc[8], os[8];
            oc[0] = fa[0] + bf1(xe); os[0] = fs[0] - bf1(ye);
#pragma unroll
            for (int i = 1; i < 8; ++i) { oc[i] = fa[i] + ma[8 - i]; os[i] = fs[i] - ms[8 - i]; }
            if (j0 == 0) { oc[0] = fa[0]; os[0] = 0.f; }
            u32x4 o; o.x = pkbf(oc[0], oc[1]); o.y = pkbf(oc[2], oc[3]); o.z = pkbf(oc[4], oc[5]); o.w = pkbf(oc[6], oc[7]);
            *(u32x4*)(e + j0) = o;
            alt += (bflo(o.x) - bfhi(o.x)) + (bflo(o.y) - bfhi(o.y)) + (bflo(o.z) - bfhi(o.z)) + (bflo(o.w) - bfhi(o.w));
            o.x = pkbf(os[0], os[1]); o.y = pkbf(os[2], os[3]); o.z = pkbf(os[4], os[5]); o.w = pkbf(os[6], os[7]);
            *(u32x4*)(od + j0) = o;
        }
        alt = wave_sum(alt);
        if (lane == 0) { const float amid = bf1(a1[2048]); TA[row] = amid * 0.015625f;
            const int b = row >> 10, n = row & 1023; const size_t off = (size_t)(b * 4096 + 2048) * 1024 + n;
            const float yv = (alt + amid) * 0.015625f * silu_f(bf1(Z[off]));
            OG[off] = (bf16_t)(pkbf(yv, 0.f) & 0xffffu); }
    }
}
__device__ __forceinline__ void sh8(const bf16_t* P, size_t row, int co, bool hm, bool hp, const float* mu, float* out) {
    const u32x4 z4 = {0u, 0u, 0u, 0u};
    const u32x4 c0 = *(const u32x4*)(P + row * RWN + co);
    const u32x4 cm = hm ? *(const u32x4*)(P + (row - 1) * RWN + co) : z4;
    const u32x4 cp = hp ? *(const u32x4*)(P + (row + 1) * RWN + co) : z4;
    const f32x4 m0 = *(const f32x4*)(mu + co), m1 = *(const f32x4*)(mu + co + 4);
#pragma unroll
    for (int i = 0; i < 4; ++i) {
        const float a0 = bflo(c0[i]), a1 = bfhi(c0[i]);
        const float n0 = 0.5f * (bflo(cm[i]) + bflo(cp[i])), n1 = 0.5f * (bfhi(cm[i]) + bfhi(cp[i]));
        const float mu0 = (2 * i < 4) ? m0[(2 * i) & 3] : m1[(2 * i) & 3], mu1 = (2 * i + 1 < 4) ? m0[(2 * i + 1) & 3] : m1[(2 * i + 1) & 3];
        out[2 * i] = a0 + mu0 * (n0 - a0); out[2 * i + 1] = a1 + mu1 * (n1 - a1);
    }
}
template <int CTRL> __device__ __forceinline__ float dpp_f(float v) { return __int_as_float(__builtin_amdgcn_update_dpp(0, __float_as_int(v), CTRL, 0xf, 0xf, true)); }
__device__ __forceinline__ float sum8(float v) { v += dpp_f<0xB1>(v); v += dpp_f<0x4E>(v); v += dpp_f<0x141>(v); return v; }
__device__ __forceinline__ float fast_tanh(float x) { const float e = __expf(2.f * x); return 1.f - 2.f * __builtin_amdgcn_rcpf(e + 1.f); }
__device__ __forceinline__ float fast_sigmoid(float x) { return __builtin_amdgcn_rcpf(1.f + __expf(-x)); }
struct RwArgs { const bf16_t* P; bf16_t* Y0; bf16_t* Y1; float* BZ; const float *mu, *w0, *w_up, *a0, *a_up, *k_k, *k_a, *r_k; };
struct Raw3 { u32x4 c0, cm, cp; };
__device__ __forceinline__ Raw3 ld3(const bf16_t* P, size_t row, int co, bool hm, bool hp) {
    const u32x4 z4 = {0u, 0u, 0u, 0u}; Raw3 r;
    r.c0 = *(const u32x4*)(P + row * RWN + co);
    r.cm = hm ? *(const u32x4*)(P + (row - 1) * RWN + co) : z4;
    r.cp = hp ? *(const u32x4*)(P + (row + 1) * RWN + co) : z4;
    return r;
}
__device__ __forceinline__ void shift8(const Raw3& R, const float* mu, int co, float* out) {
    const f32x4 m0 = *(const f32x4*)(mu + co), m1 = *(const f32x4*)(mu + co + 4);
#pragma unroll
    for (int i = 0; i < 4; ++i) {
        const float a0 = bflo(R.c0[i]), a1 = bfhi(R.c0[i]);
        const float n0 = 0.5f * (bflo(R.cm[i]) + bflo(R.cp[i])), n1 = 0.5f * (bfhi(R.cm[i]) + bfhi(R.cp[i]));
        const float mu0 = (2 * i < 4) ? m0[(2 * i) & 3] : m1[(2 * i) & 3], mu1 = (2 * i + 1 < 4) ? m0[(2 * i + 1) & 3] : m1[(2 * i + 1) & 3];
        out[2 * i] = a0 + mu0 * (n0 - a0); out[2 * i + 1] = a1 + mu1 * (n1 - a1);
    }
}
__device__ __forceinline__ void shift8r(const Raw3& R, const float* mu, float* out) {
#pragma unroll
    for (int i = 0; i < 4; ++i) {
        const float a0 = bflo(R.c0[i]), a1 = bfhi(R.c0[i]);
        const float n0 = 0.5f * (bflo(R.cm[i]) + bflo(R.cp[i])), n1 = 0.5f * (bfhi(R.cm[i]) + bfhi(R.cp[i]));
        out[2 * i] = a0 + mu[2 * i] * (n0 - a0); out[2 * i + 1] = a1 + mu[2 * i + 1] * (n1 - a1);
    }
}
__device__ __forceinline__ void rwkv_scan(const RwArgs& A, LAS char* lds, int G, int bid) {
    typedef short bfx8 __attribute__((ext_vector_type(8)));
    const int tid = opaque_tid(), lane = tid & 63; const int q = __builtin_amdgcn_readfirstlane(tid >> 6);
    LAS float* sW = (LAS float*)lds; LAS float* sA = sW + 4096; LAS float* sB = sA + 4096; LAS float* sKD = sB + 4096; LAS float* sR = sKD + 4096; LAS float* sV = sR + 4096;
    LAS bf16_t* WUPt = (LAS bf16_t*)(sV + 4096); LAS bf16_t* AUPt = WUPt + 64 * 72;
    LAS bf16_t* T1 = (LAS bf16_t*)sW; LAS bf16_t* T2 = (LAS bf16_t*)sKD;
    const int s = tid >> 3, dg = tid & 7, d0 = dg * 8;
#pragma unroll 1
    for (int chain = bid; chain < 256; chain += G) {
        const int z = chain >> 7, b = (chain >> 4) & 7, hh = chain & 15;
        __syncthreads();
        for (int idx = tid; idx < 4096; idx += 512) { const int r = idx >> 6, d = idx & 63;
            WUPt[d * 72 + r] = (bf16_t)(pkbf(A.w_up[(size_t)(z * 64 + r) * 1024 + hh * 64 + d], 0.f) & 0xffffu);
            AUPt[d * 72 + r] = (bf16_t)(pkbf(A.a_up[(size_t)(z * 64 + r) * 1024 + hh * 64 + d], 0.f) & 0xffffu); }
        f32x2_t S2[4];
#pragma unroll
        for (int j = 0; j < 4; ++j) S2[j] = (f32x2_t){0.f, 0.f};
        bf16_t* Yz = z ? A.Y1 : A.Y0;
        const int c_r = hh * 64 + d0, c_k = 1024 + hh * 64 + d0, c_v = 2048 + hh * 64 + d0, c_wd = 3072 + z * 64 + d0, c_ad = 3200 + z * 64 + d0;
#define RW_ROWOF(c, rowv, hmv, hpv) do { const int sidx_ = (c) * 64 + s; int L_, n_, rb_; \
            if ((c) < 4) { L_ = 256; n_ = z ? (255 - sidx_) : sidx_; rb_ = TL + b * 256; } else { L_ = 4096; const int sl_ = sidx_ - 256; n_ = z ? (4095 - sl_) : sl_; rb_ = b * 4096; } \
            rowv = (size_t)(rb_ + n_); hmv = n_ > 0; hpv = n_ < L_ - 1; } while (0)
        size_t row; bool hm, hp;
        RW_ROWOF(0, row, hm, hp);
        Raw3 Rr = ld3(A.P, row, c_r, hm, hp), Rk = ld3(A.P, row, c_k, hm, hp), Rv = ld3(A.P, row, c_v, hm, hp), Rw = ld3(A.P, row, c_wd, hm, hp), Ra = ld3(A.P, row, c_ad, hm, hp);
#pragma unroll 1
        for (int c = 0; c < 68; ++c) {
            asm volatile("" ::: "memory");
            const size_t crow_ = row;
            {
                float r8[8], k8[8], v8[8], t8[8];
                shift8(Rr, A.mu, c_r, r8); shift8(Rk, A.mu, c_k, k8); shift8(Rv, A.mu, c_v, v8);
                *(LAS f32x4*)(sR + s * 64 + d0) = (f32x4){r8[0], r8[1], r8[2], r8[3]}; *(LAS f32x4*)(sR + s * 64 + d0 + 4) = (f32x4){r8[4], r8[5], r8[6], r8[7]};
                *(LAS f32x4*)(sV + s * 64 + d0) = (f32x4){v8[0], v8[1], v8[2], v8[3]}; *(LAS f32x4*)(sV + s * 64 + d0 + 4) = (f32x4){v8[4], v8[5], v8[6], v8[7]};
                *(LAS f32x4*)(sB + s * 64 + d0) = (f32x4){k8[0], k8[1], k8[2], k8[3]}; *(LAS f32x4*)(sB + s * 64 + d0 + 4) = (f32x4){k8[4], k8[5], k8[6], k8[7]};
                float kkr[8], ssq = 0.f;
                const f32x4 kk0 = *(const f32x4*)(A.k_k + hh * 64 + d0), kk1 = *(const f32x4*)(A.k_k + hh * 64 + d0 + 4);
#pragma unroll
                for (int i = 0; i < 8; ++i) { kkr[i] = k8[i] * (i < 4 ? kk0[i & 3] : kk1[i & 3]); ssq += kkr[i] * kkr[i]; }
                ssq = sum8(ssq);
                const float rs = -rsqrtf(ssq + 1e-12f);
                *(LAS f32x4*)(sA + s * 64 + d0) = (f32x4){kkr[0] * rs, kkr[1] * rs, kkr[2] * rs, kkr[3] * rs}; *(LAS f32x4*)(sA + s * 64 + d0 + 4) = (f32x4){kkr[4] * rs, kkr[5] * rs, kkr[6] * rs, kkr[7] * rs};
                shift8(Rw, A.mu, c_wd, t8);
                { u32x4 o; o.x = pkbf(fast_tanh(t8[0]), fast_tanh(t8[1])); o.y = pkbf(fast_tanh(t8[2]), fast_tanh(t8[3])); o.z = pkbf(fast_tanh(t8[4]), fast_tanh(t8[5])); o.w = pkbf(fast_tanh(t8[6]), fast_tanh(t8[7]));
                  *(LAS u32x4*)(T1 + s * 72 + d0) = o; }
                shift8(Ra, A.mu, c_ad, t8);
                { u32x4 o; o.x = pkbf(t8[0], t8[1]); o.y = pkbf(t8[2], t8[3]); o.z = pkbf(t8[4], t8[5]); o.w = pkbf(t8[6], t8[7]);
                  *(LAS u32x4*)(T2 + s * 72 + d0) = o; }
            }
            if (c + 1 < 68) { RW_ROWOF(c + 1, row, hm, hp);
                Rr = ld3(A.P, row, c_r, hm, hp); Rk = ld3(A.P, row, c_k, hm, hp); Rv = ld3(A.P, row, c_v, hm, hp); Rw = ld3(A.P, row, c_wd, hm, hp); Ra = ld3(A.P, row, c_ad, hm, hp); }
            __syncthreads();
            const int mt = q & 3, nh = q >> 2, fr = lane & 15, fq = lane >> 4;
            f32x4 accw[2], acca[2];
            {
                bfx8 aw[2], aa[2];
#pragma unroll
                for (int kk = 0; kk < 2; ++kk) { aw[kk] = *(const LAS bfx8*)(T1 + (16 * mt + fr) * 72 + kk * 32 + fq * 8); aa[kk] = *(const LAS bfx8*)(T2 + (16 * mt + fr) * 72 + kk * 32 + fq * 8); }
#pragma unroll
                for (int nt = 0; nt < 2; ++nt) { accw[nt] = (f32x4){0.f, 0.f, 0.f, 0.f}; acca[nt] = (f32x4){0.f, 0.f, 0.f, 0.f};
#pragma unroll
                    for (int kk = 0; kk < 2; ++kk) {
                        const bfx8 bw = *(const LAS bfx8*)(WUPt + (32 * nh + 16 * nt + fr) * 72 + kk * 32 + fq * 8), ba = *(const LAS bfx8*)(AUPt + (32 * nh + 16 * nt + fr) * 72 + kk * 32 + fq * 8);
                        accw[nt] = __builtin_amdgcn_mfma_f32_16x16x32_bf16(aw[kk], bw, accw[nt], 0, 0, 0);
                        acca[nt] = __builtin_amdgcn_mfma_f32_16x16x32_bf16(aa[kk], ba, acca[nt], 0, 0, 0); } }
            }
            __syncthreads();
#pragma unroll
            for (int nt = 0; nt < 2; ++nt) { const int d = 32 * nh + 16 * nt + fr, dcol = hh * 64 + d;
                const float w0d = A.w0[z * 1024 + dcol], a0d = A.a0[z * 1024 + dcol], kad = A.k_a[dcol];
#pragma unroll
                for (int j = 0; j < 4; ++j) { const int idx = (16 * mt + 4 * fq + j) * 64 + d;
                    const float x = -(w0d + accw[nt][j]);
                    const float sp = fmaxf(x, 0.f) + __logf(1.f + __expf(-fabsf(x)));
                    const float w = __expf(-__expf(-sp - 0.5f));
                    const float asig = fast_sigmoid(a0d + acca[nt][j]);
                    const float nkk = sA[idx], kraw = sB[idx];
                    sW[idx] = w; sB[idx] = -nkk * asig; sKD[idx] = kraw * (1.f + (asig - 1.f) * kad); } }
            __syncthreads();
            {
                const f32x4 ra = *(const LAS f32x4*)(sR + s * 64 + d0), rb = *(const LAS f32x4*)(sR + s * 64 + d0 + 4), ka = *(const LAS f32x4*)(sKD + s * 64 + d0), kb = *(const LAS f32x4*)(sKD + s * 64 + d0 + 4);
                const f32x4 q0 = *(const f32x4*)(A.r_k + hh * 64 + d0), q1 = *(const f32x4*)(A.r_k + hh * 64 + d0 + 4);
                float bz = 0.f;
#pragma unroll
                for (int i = 0; i < 4; ++i) { bz += ra[i] * ka[i] * q0[i]; bz += rb[i] * kb[i] * q1[i]; }
                bz = sum8(bz);
                if (dg == 0) A.BZ[((size_t)z * TT + crow_) * 16 + hh] = bz;
            }
            {
                const int rl = lane >> 3, cg = lane & 7, irow = 8 * q + rl;
                const LAS float* bw = sW + 8 * cg; const LAS float* ba_ = sA + 8 * cg; const LAS float* bb_ = sB + 8 * cg; const LAS float* bk = sKD + 8 * cg; const LAS float* br = sR + 8 * cg;
                LAS float* bv = sV + irow;
                f32x4 w0 = *(const LAS f32x4*)(bw), w1 = *(const LAS f32x4*)(bw + 4), a0 = *(const LAS f32x4*)(ba_), a1 = *(const LAS f32x4*)(ba_ + 4);
                f32x4 b0 = *(const LAS f32x4*)(bb_), b1 = *(const LAS f32x4*)(bb_ + 4), k0 = *(const LAS f32x4*)(bk), k1 = *(const LAS f32x4*)(bk + 4);
                f32x4 r0 = *(const LAS f32x4*)(br), r1 = *(const LAS f32x4*)(br + 4); float vi = bv[0];
#pragma unroll 4
                for (int st = 0; st < 64; ++st) {
                    const int on = ((st + 1) & 63) * 64;
                    const f32x4 nw0 = *(const LAS f32x4*)(bw + on), nw1 = *(const LAS f32x4*)(bw + on + 4), na0 = *(const LAS f32x4*)(ba_ + on), na1 = *(const LAS f32x4*)(ba_ + on + 4);
                    const f32x4 nb0 = *(const LAS f32x4*)(bb_ + on), nb1 = *(const LAS f32x4*)(bb_ + on + 4), nk0 = *(const LAS f32x4*)(bk + on), nk1 = *(const LAS f32x4*)(bk + on + 4);
                    const f32x4 nr0 = *(const LAS f32x4*)(br + on), nr1 = *(const LAS f32x4*)(br + on + 4); const float nvi = bv[on];
                    f32x2_t pp2 = S2[0] * (f32x2_t){a0[0], a0[1]};
                    pp2 = S2[1] * (f32x2_t){a0[2], a0[3]} + pp2; pp2 = S2[2] * (f32x2_t){a1[0], a1[1]} + pp2; pp2 = S2[3] * (f32x2_t){a1[2], a1[3]} + pp2;
                    const float sa = sum8(pp2.x + pp2.y);
                    const f32x2_t sa2 = {sa, sa}, v2 = {vi, vi};
                    S2[0] = S2[0] * (f32x2_t){w0[0], w0[1]} + sa2 * (f32x2_t){b0[0], b0[1]} + v2 * (f32x2_t){k0[0], k0[1]};
                    S2[1] = S2[1] * (f32x2_t){w0[2], w0[3]} + sa2 * (f32x2_t){b0[2], b0[3]} + v2 * (f32x2_t){k0[2], k0[3]};
                    S2[2] = S2[2] * (f32x2_t){w1[0], w1[1]} + sa2 * (f32x2_t){b1[0], b1[1]} + v2 * (f32x2_t){k1[0], k1[1]};
                    S2[3] = S2[3] * (f32x2_t){w1[2], w1[3]} + sa2 * (f32x2_t){b1[2], b1[3]} + v2 * (f32x2_t){k1[2], k1[3]};
                    f32x2_t y2 = S2[0] * (f32x2_t){r0[0], r0[1]};
                    y2 = S2[1] * (f32x2_t){r0[2], r0[3]} + y2; y2 = S2[2] * (f32x2_t){r1[0], r1[1]} + y2; y2 = S2[3] * (f32x2_t){r1[2], r1[3]} + y2;
                    const float yv = sum8(y2.x + y2.y);
                    if (cg == 0) bv[st * 64] = yv;
                    w0 = nw0; w1 = nw1; a0 = na0; a1 = na1; b0 = nb0; b1 = nb1; k0 = nk0; k1 = nk1; r0 = nr0; r1 = nr1; vi = nvi;
                }
            }
            __syncthreads();
            { u32x4 o; const LAS float* yr = sV + s * 64 + d0;
              o.x = pkbf(yr[0], yr[1]); o.y = pkbf(yr[2], yr[3]); o.z = pkbf(yr[4], yr[5]); o.w = pkbf(yr[6], yr[7]);
              *(u32x4*)(Yz + crow_ * 1024 + hh * 64 + d0) = o; }
            __syncthreads();
        }
#undef RW_ROWOF
    }
}
__device__ __forceinline__ void rwkv_out(const RwArgs& A, const float* ln_w, const float* ln_b, bf16_t* OG, int G, int bid) {
    const int tid_ = opaque_tid(); const int lane = tid_ & 63, wid = tid_ >> 6; const int c0 = lane * 16, head = lane >> 2;
    float lw[16], lb[16], muv[16];
#pragma unroll
    for (int i = 0; i < 16; ++i) { lw[i] = ln_w[c0 + i]; lb[i] = ln_b[c0 + i]; muv[i] = A.mu[2048 + c0 + i]; }
    for (int row = bid * 8 + wid; row < TT; row += G * 8) {
        const bool lat = row < TL; const int L = lat ? 4096 : 256; const int n = lat ? (row & 4095) : ((row - TL) & 255); const bool hm = n > 0, hp = n < L - 1;
        const u32x4 a0 = *(const u32x4*)(A.Y0 + (size_t)row * 1024 + c0), a1 = *(const u32x4*)(A.Y0 + (size_t)row * 1024 + c0 + 8);
        const u32x4 b0 = *(const u32x4*)(A.Y1 + (size_t)row * 1024 + c0), b1 = *(const u32x4*)(A.Y1 + (size_t)row * 1024 + c0 + 8);
        const Raw3 v0 = ld3(A.P, (size_t)row, 2048 + c0, hm, hp), v1 = ld3(A.P, (size_t)row, 2048 + c0 + 8, hm, hp);
        const u32x4 z0 = *(const u32x4*)(A.P + (size_t)row * RWN + 3328 + c0), z1 = *(const u32x4*)(A.P + (size_t)row * RWN + 3328 + c0 + 8);
        const float bz = 0.5f * (A.BZ[(size_t)row * 16 + head] + A.BZ[((size_t)TT + row) * 16 + head]);
        float y[16], vv[16];
#pragma unroll
        for (int i = 0; i < 4; ++i) { y[2 * i] = bflo(a0[i]) + bflo(b0[i]); y[2 * i + 1] = bfhi(a0[i]) + bfhi(b0[i]); y[8 + 2 * i] = bflo(a1[i]) + bflo(b1[i]); y[8 + 2 * i + 1] = bfhi(a1[i]) + bfhi(b1[i]); }
        float s1 = 0.f;
#pragma unroll
        for (int i = 0; i < 16; ++i) s1 += y[i];
        s1 += __shfl_xor(s1, 1); s1 += __shfl_xor(s1, 2); const float mean = s1 * (1.f / 64.f);
        float s2 = 0.f;
#pragma unroll
        for (int i = 0; i < 16; ++i) { y[i] -= mean; s2 += y[i] * y[i]; }
        s2 += __shfl_xor(s2, 1); s2 += __shfl_xor(s2, 2); const float rstd = rsqrtf(s2 * (1.f / 64.f) + 64e-5f);
        shift8r(v0, muv, vv); shift8r(v1, muv + 8, vv + 8);
        float ov[16];
#pragma unroll
        for (int i = 0; i < 16; ++i) { const unsigned zw = (i < 8) ? z0[(i >> 1) & 3] : z1[(i >> 1) & 3]; const float zz = (i & 1) ? bfhi(zw) : bflo(zw);
            ov[i] = (y[i] * rstd * lw[i] + lb[i] + bz * vv[i]) * silu_f(zz); }
        u32x4 o0, o1; o0.x = pkbf(ov[0], ov[1]); o0.y = pkbf(ov[2], ov[3]); o0.z = pkbf(ov[4], ov[5]); o0.w = pkbf(ov[6], ov[7]);
        o1.x = pkbf(ov[8], ov[9]); o1.y = pkbf(ov[10], ov[11]); o1.z = pkbf(ov[12], ov[13]); o1.w = pkbf(ov[14], ov[15]);
        *(u32x4*)(OG + (size_t)row * 1024 + c0) = o0; *(u32x4*)(OG + (size_t)row * 1024 + c0 + 8) = o1;
    }
}
#ifdef SKIP_GEMM
#define GEMM_PHASE(EPI, AP, BP, MM, NN, KK, EOBJ) do { (void)EOBJ; } while (0)
#else
#ifndef STAGGER_TICKS
#define STAGGER_TICKS 1500
#endif
__device__ __forceinline__ void stagger_wait(int bid, int units_per_cu_x2) {
    if ((bid & 1) && units_per_cu_x2 >= 4) { const unsigned long long t0 = __builtin_amdgcn_s_memrealtime(); while (__builtin_amdgcn_s_memrealtime() - t0 < (unsigned long long)STAGGER_TICKS) __builtin_amdgcn_s_sleep(32); }
}
#define GEMM_PHASE(EPI, AP, BP, MM, NN, KK, EOBJ) do { pg8::Gemm g_{(const bf16_t*)(AP), (const bf16_t*)(BP), (MM), (NN), (KK)}; pg8::StaticOrder S_; S_.init((MM), (NN), G, bid); \
    pg8::gemm_phase<EPI, pg8::StaticOrder, true, true>((PG8_LAS unsigned char*)lds, g_, S_, EOBJ); } while (0)
#endif
#ifdef SKIP_EpiAttnIn
#define GEMM_PHASE_EpiAttnIn(EPI, AP, BP, MM, NN, KK, EOBJ) do { (void)EOBJ; } while (0)
#else
#define GEMM_PHASE_EpiAttnIn GEMM_PHASE
#endif
#ifdef SKIP_EpiFnT
#define GEMM_PHASE_EpiFnT(EPI, AP, BP, MM, NN, KK, EOBJ) do { (void)EOBJ; } while (0)
#else
#define GEMM_PHASE_EpiFnT GEMM_PHASE
#endif
#ifdef SKIP_EpiPlain
#define GEMM_PHASE_EpiPlain(EPI, AP, BP, MM, NN, KK, EOBJ) do { (void)EOBJ; } while (0)
#else
#define GEMM_PHASE_EpiPlain GEMM_PHASE
#endif
#ifdef SKIP_EpiDft
#define GEMM_PHASE_EpiDft(EPI, AP, BP, MM, NN, KK, EOBJ) do { (void)EOBJ; } while (0)
#else
#define GEMM_PHASE_EpiDft GEMM_PHASE
#endif
#ifdef SKIP_EpiResid
#define GEMM_PHASE_EpiResid(EPI, AP, BP, MM, NN, KK, EOBJ) do { (void)EOBJ; } while (0)
#else
#define GEMM_PHASE_EpiResid GEMM_PHASE
#endif
#define XB_TMO      128
#define XB_XCNT(j)  (256  + 64 * (j))
#define XB_XSUB(j)  (1280 + 64 * (j))
#define XB_XGEN(j)  (2304 + 64 * (j))
#define XB_TOP      3328
#define XB_TOPGEN   3392
#define XCD_BAR_WORDS 3456
#define XB_SPIN_CAP (1u << 18)

__device__ __forceinline__ unsigned xb_ld(unsigned* p)              { return __hip_atomic_load(p, __ATOMIC_RELAXED, __HIP_MEMORY_SCOPE_AGENT); }
__device__ __forceinline__ unsigned xb_add(unsigned* p, unsigned v) { return __hip_atomic_fetch_add(p, v, __ATOMIC_RELAXED, __HIP_MEMORY_SCOPE_AGENT); }
__device__ __forceinline__ unsigned xb_xcc_id() { return (unsigned)__builtin_amdgcn_s_getreg((3 << 11) | 20) & 0xFu; }
#define XB_SPIN(cond, bar) do { unsigned _sp = 0; while (cond) { __builtin_amdgcn_s_sleep(1); \
    if ((++_sp & 255u) == 0u) { if (xb_ld(&(bar)[XB_TMO])) break; if (_sp > XB_SPIN_CAP) { atomicAdd(&(bar)[XB_TMO], 1u); break; } } } } while (0)

struct XcdBarrier {
    unsigned* bar; unsigned x;
    volatile LAS unsigned* st;
};

__device__ __forceinline__ XcdBarrier xcd_barrier_post(unsigned* bar, volatile LAS unsigned* st) {
    XcdBarrier b; b.bar = bar; b.x = xb_xcc_id(); b.st = st;
    if (threadIdx.x == 0) (void)xb_add(&bar[XB_XCNT(b.x)], 1u);
    return b;
}
__device__ __forceinline__ void xcd_barrier_complete(unsigned* bar, unsigned x, unsigned& nloc, unsigned& nx) {
    const unsigned G = gridDim.x * gridDim.y * gridDim.z;
    unsigned sum, cnt, mine, sp = 0u;
    for (;;) {
        sum = 0u; cnt = 0u; mine = 0u;
#pragma unroll
        for (unsigned j = 0; j < 16; ++j) { const unsigned c = xb_ld(&bar[XB_XCNT(j)]); sum += c; cnt += (c > 0u) ? 1u : 0u; mine = (j == x) ? c : mine; }
        if (sum == G) break;
        __builtin_amdgcn_s_sleep(1);
        if ((++sp & 255u) == 0u) { if (xb_ld(&bar[XB_TMO])) break; if (sp > XB_SPIN_CAP) { atomicAdd(&bar[XB_TMO], 1u); break; } }
    }
    nloc = mine > 0u ? mine : 1u; nx = cnt > 0u ? cnt : 1u;
}

__device__ __forceinline__ void xcd_barrier(const XcdBarrier& b) {
    asm volatile("s_waitcnt vmcnt(0)" ::: "memory");
    __syncthreads();
    if (threadIdx.x == 0) {
        unsigned* bar = b.bar;
        __builtin_amdgcn_s_waitcnt(0);
        unsigned nloc = b.st[0], nx = b.st[1];
        if (nloc == 0u) { xcd_barrier_complete(bar, b.x, nloc, nx); b.st[0] = nloc; b.st[1] = nx; }
        const unsigned old = xb_add(&bar[XB_XSUB(b.x)], 1u);
        const unsigned gen = old / nloc;
        if (old + 1u == (gen + 1u) * nloc) {
            __builtin_amdgcn_fence(__ATOMIC_RELEASE, "agent");
            asm volatile("s_waitcnt vmcnt(0)" ::: "memory");
            const unsigned og = xb_add(&bar[XB_TOP], 1u);
            const unsigned tg = og / nx;
            if (og + 1u == (tg + 1u) * nx) xb_add(&bar[XB_TOPGEN], 1u);
            else XB_SPIN(xb_ld(&bar[XB_TOPGEN]) == tg, bar);
            __builtin_amdgcn_fence(__ATOMIC_ACQUIRE, "agent");
            xb_add(&bar[XB_XGEN(b.x)], 1u);
            asm volatile("s_waitcnt vmcnt(0)" ::: "memory");
        } else {
            XB_SPIN(xb_ld(&bar[XB_XGEN(b.x)]) == gen, bar);
            __builtin_amdgcn_fence(__ATOMIC_ACQUIRE, "agent");
            asm volatile("s_waitcnt vmcnt(0)" ::: "memory");
        }
    }
    __syncthreads();
}

#define GRID_SYNC() xcd_barrier(xbar)
template <int layer> __device__ __forceinline__ void layer_body(const Params& p, LAS char* lds, const XcdBarrier& xbar, int G, int bid) {
    unsigned char* ws = p.ws;
    float* mod = (float*)(ws + WS_MOD);
    const float* ropeC = (const float*)(ws + WS_ROPE); const float* ropeS = ropeC + 1024;
    bf16_t* Hb = (bf16_t*)(ws + WS_HB);
    float* XC = (float*)(ws + WS_XC);
    const float* x_in = p.in[0]; const float* ctx_in = p.in[2];
        const float* xl = layer == 0 ? x_in : p.out; const float* xc = layer == 0 ? ctx_in : XC;
        const float* modl = mod + (size_t)layer * 9 * 3072;
        ph_phase(xl, xc, p.in[4] + layer * 1024, modl, Hb, G, bid);
#ifdef PROBE_PH2
        ph_phase(xl, xc, p.in[4] + layer * 1024, modl, Hb, G, bid);
#endif
        GRID_SYNC();
        const int Mout = (layer == 3) ? TL : TT;
        const bf16_t* Wout;
        if constexpr (layer == 0 || layer == 3) {
            const int j = layer == 0 ? 0 : 1;
            pg8::EpiAttnIn E{(bf16_t*)(ws + WS_Q), (bf16_t*)(ws + WS_K), (bf16_t*)(ws + WS_V), (bf16_t*)(ws + WS_Z), ropeC, ropeS};
            GEMM_PHASE_EpiAttnIn(pg8::EpiAttnIn, Hb, ws + WS_WDAIN + (size_t)j * 8 * MiB, TT, 4096, 1024, E);
#ifdef PROBE_GIN2
            GEMM_PHASE_EpiAttnIn(pg8::EpiAttnIn, Hb, ws + WS_WDAIN + (size_t)j * 8 * MiB, TT, 4096, 1024, E);
#endif
            GRID_SYNC();
            float lam;
            { const int lane = opaque_tid() & 63; const float* lq = p.in[9] + j * 128; const float* lk = p.in[10] + j * 128;
              const float s0 = wave_sum(lq[lane] * lk[lane]), s1 = wave_sum(lq[64 + lane] * lk[64 + lane]);
              const float li = 0.8f - 0.6f * expf(-0.3f * (float)layer); lam = expf(s0) - expf(s1) + li;
              att::Args A{(const bf16_t*)(ws + WS_Q), (const bf16_t*)(ws + WS_K), (const bf16_t*)(ws + WS_V), (const bf16_t*)(ws + WS_Z), Hb, p.in[11] + j * 128, lam, 1.f - li, layer == 3 ? 1024 : 1088, (unsigned*)(ws + WS_Y1) + (size_t)bid * 8 * 2048};
#ifndef SKIP_ATT
              att::attn_phase(A, lds, G, bid);
#endif
#ifdef PROBE_ATT2
              att::attn_phase(A, lds, G, bid);
#endif
            }
            GRID_SYNC();
            Wout = (const bf16_t*)(ws + WS_WDAOUT + (size_t)j * 2 * MiB);
        } else if constexpr (layer == 1) {
            { pg8::EpiFnT E{(bf16_t*)(ws + WS_ATL), (bf16_t*)(ws + WS_ATC)};
              GEMM_PHASE_EpiFnT(pg8::EpiFnT, ws + WS_WFNT, Hb, 2048, TT, 1024, E); }
            { pg8::EpiPlain E{(bf16_t*)(ws + WS_ZB), 1024};
              GEMM_PHASE_EpiPlain(pg8::EpiPlain, Hb, ws + WS_WFNZ, TT, 1024, 1024, E); }
            GRID_SYNC();
            fnet_fold((const bf16_t*)(ws + WS_ATL), (bf16_t*)(ws + WS_FOLD), (bf16_t*)(ws + WS_FOLD + 32 * MiB), (float*)(ws + WS_BZ), (const bf16_t*)(ws + WS_ZB), Hb, G, bid);
            GRID_SYNC();
            { pg8::EpiPlain E{(bf16_t*)(ws + WS_ATL), 8192};
              GEMM_PHASE_EpiPlain(pg8::EpiPlain, ws + WS_DFTL, ws + WS_FOLD, 2048, 8192, 2048, E); }
            GRID_SYNC();
            { pg8::EpiDftSym E{(const bf16_t*)(ws + WS_ATL), (const float*)(ws + WS_BZ), (const bf16_t*)(ws + WS_ZB), Hb};
              GEMM_PHASE(pg8::EpiDftSym, ws + WS_DFTL + 8 * MiB, ws + WS_FOLD + 32 * MiB, 2048, 8192, 2048, E); }
            { pg8::EpiDft E{(const bf16_t*)(ws + WS_ZB), Hb, TL, 256};
              GEMM_PHASE_EpiDft(pg8::EpiDft, ws + WS_DFTC, ws + WS_ATC, 256, 8192, 512, E); }
            GRID_SYNC();
            Wout = (const bf16_t*)(ws + WS_WFNOUT);
        } else {
            { pg8::EpiPlain E{(bf16_t*)(ws + WS_P), RWN};
              GEMM_PHASE_EpiPlain(pg8::EpiPlain, Hb, ws + WS_WRWIN, TT, RWN, 1024, E); }
            GRID_SYNC();
            RwArgs A{(const bf16_t*)(ws + WS_P), Hb, (bf16_t*)(ws + WS_Y1), (float*)(ws + WS_BZ), p.in[17], p.in[18], p.in[19], p.in[20], p.in[21], p.in[22], p.in[23], p.in[24]};
#ifndef SKIP_SCAN
            rwkv_scan(A, lds, G, bid);
#endif
#ifdef PROBE_SCAN2
            rwkv_scan(A, lds, G, bid);
#endif
            GRID_SYNC();
#ifndef SKIP_RWOUT
            rwkv_out(A, p.in[25], p.in[26], Hb, G, bid);
#endif
            GRID_SYNC();
            Wout = (const bf16_t*)(ws + WS_WRWOUT);
        }
        { pg8::EpiResid E{xl, xc, p.out, XC, modl + 2048};
          GEMM_PHASE_EpiResid(pg8::EpiResid, Hb, Wout, Mout, 1024, 1024, E);
#ifdef PROBE_OUT2
          if (layer == 0) { GEMM_PHASE_EpiResid(pg8::EpiResid, Hb, Wout, Mout, 1024, 1024, E); }
#endif
        }
        GRID_SYNC();
    }
__global__ void __launch_bounds__(512, 2) fwd_megakernel(Params p) {
    extern __shared__ __attribute__((aligned(16))) unsigned char lds_raw[];
    LAS char* lds = (LAS char*)lds_raw;
    cg::grid_group grid = cg::this_grid();
    const int G = gridDim.x, bid = blockIdx.x;
    volatile LAS unsigned* xst = (volatile LAS unsigned*)(lds + LDS_BYTES - 256);
    if (threadIdx.x < 2) xst[threadIdx.x] = 0u;
    __syncthreads();
    const XcdBarrier xbar = xcd_barrier_post((unsigned*)(p.ws + WS_CTL), xst);

#ifndef SKIP_PRO
    prologue(p, lds, G, bid);
#endif
#ifdef PROBE_PRO2
    __syncthreads(); prologue(p, lds, G, bid);
#endif
    grid.sync();
    layer_body<0>(p, lds, xbar, G, bid);
    layer_body<1>(p, lds, xbar, G, bid);
    layer_body<2>(p, lds, xbar, G, bid);
    layer_body<3>(p, lds, xbar, G, bid);
    final_phase(p.out, p.in[7], G, bid);
}

extern "C" void kernel_launch(void* const* d_in, const int* in_sizes, int n_in, void* d_out, int out_size, void* d_ws, size_t ws_size, hipStream_t stream) {
    static int grid = 0;
    if (grid == 0) {
        if (n_in != 28 || out_size != TL * 1024 || ws_size < WS_END) { fprintf(stderr, "kernel_launch: unexpected shapes: n_in %d out %d ws %zu\n", n_in, out_size, ws_size); grid = -1; return; }
        int dev = 0, cus = 0, per_cu = 0;
        hipGetDevice(&dev); hipDeviceGetAttribute(&cus, hipDeviceAttributeMultiprocessorCount, dev);
        if (hipFuncSetAttribute((const void*)fwd_megakernel, hipFuncAttributeMaxDynamicSharedMemorySize, LDS_BYTES) != hipSuccess) { fprintf(stderr, "kernel_launch: hipFuncSetAttribute failed\n"); grid = -1; return; }
        if (hipOccupancyMaxActiveBlocksPerMultiprocessor(&per_cu, (const void*)fwd_megakernel, 512, LDS_BYTES) != hipSuccess || per_cu < 1) { fprintf(stderr, "kernel_launch: occupancy query failed (%d)\n", per_cu); per_cu = 1; }
        (void)hipGetLastError();
        grid = cus * per_cu;
    }
    if (grid < 0) return;
    if (hipMemsetAsync((char*)d_ws + WS_CTL, 0, 65536, stream) != hipSuccess) { fprintf(stderr, "kernel_launch: hipMemsetAsync failed\n"); return; }
    Params p{};
    for (int i = 0; i < 28; ++i) p.in[i] = (const float*)d_in[i];
    p.out = (float*)d_out; p.ws = (unsigned char*)d_ws;
    void* args[] = {&p};
    hipError_t e = hipLaunchCooperativeKernel((const void*)fwd_megakernel, dim3(grid), dim3(512), args, LDS_BYTES, stream);
    if (e != hipSuccess) fprintf(stderr, "cooperative launch failed: %s (grid %d)\n", hipGetErrorString(e), grid);
}
```

```cpp
#include <hip/hip_runtime.h>
#include <hip/hip_cooperative_groups.h>
#include <cstdio>
#include <cstdint>
#include <cmath>
namespace cg = cooperative_groups;

constexpr int TL = 32768, TCX = 2048, TT = TL + TCX, DM = 1024;
constexpr float QK_C2 = 0.125f * 1.4426950408889634f;
typedef float f32x2_t __attribute__((ext_vector_type(2)));
typedef __bf16 bf16x2_t __attribute__((ext_vector_type(2)));
__device__ __forceinline__ unsigned pkbf(float lo, float hi) { f32x2_t v = {lo, hi}; bf16x2_t b = __builtin_convertvector(v, bf16x2_t); return __builtin_bit_cast(unsigned, b); }
__device__ __forceinline__ float bflo(unsigned u) { return __uint_as_float(u << 16); }
__device__ __forceinline__ float bfhi(unsigned u) { return __uint_as_float(u & 0xffff0000u); }
__device__ __forceinline__ float bf1(unsigned short u) { return __uint_as_float(((unsigned)u) << 16); }
__device__ __forceinline__ float silu_f(float z) { return z * __builtin_amdgcn_rcpf(1.f + __expf(-z)); }
__device__ __forceinline__ int opaque_tid() { int t = threadIdx.x; asm volatile("" : "+v"(t)); return t; }
namespace pg8 {
#define PG8_LAS __attribute__((address_space(3)))
typedef unsigned short bf16_t;
typedef short bf16x8 __attribute__((ext_vector_type(8)));
typedef float f32x4 __attribute__((ext_vector_type(4)));
typedef unsigned u32x4 __attribute__((ext_vector_type(4)));
constexpr int BM = 256, BK = 64, HALF = 128, HTB = HALF * BK * 2  , STAGE_BYTES = 8 * HTB, NXCD = 8, WGM = 8;

__host__ __device__ __forceinline__ int lds_byte(int r, int c) { const int st = (r >> 4) * 2 + (c >> 5), rr = r & 15, cc = c & 31, ob = rr * 64 + cc * 2; return st * 1024 + (ob ^ (((ob >> 9) & 1) << 5)); }
__host__ __device__ __forceinline__ void stage_rc(int b, int& R, int& C) { const int st = b / 1024, sb = b % 1024, swz = sb ^ (((sb >> 9) & 1) << 5); R = (st >> 1) * 16 + swz / 64; C = (st & 1) * 32 + (swz % 64) / 2; }
__host__ __device__ __forceinline__ int perm32(int rho) { const int n = rho >> 4, i = rho & 15; return 8 * (i >> 2) + 4 * n + (i & 3); }

struct Unit { int pm, pn; };
struct Gemm { const bf16_t* A; const bf16_t* Bt; int M, N, K; };

struct StaticOrder {
    int nM, nN, nwg, G, c;
    __host__ __device__ void init(int M, int N, int G_, int c_) { nM = M / BM; nN = N / BM; nwg = nM * nN; G = G_; c = c_; }
    __host__ __device__ bool next(int i, Unit& u) const {
        const long L = (long)i * G + c; if (L >= nwg) return false;
        int wgid = (int)L; { const int q = nwg / NXCD, r = nwg % NXCD, xcd = wgid % NXCD, off = wgid / NXCD; wgid = (xcd < r ? xcd * (q + 1) : r * (q + 1) + (xcd - r) * q) + off; }
        const int nig = WGM * nN, gid = wgid / nig, fm = gid * WGM, gsz = (nM - fm) < WGM ? (nM - fm) : WGM;
        u.pm = fm + ((wgid % nig) % gsz); u.pn = (wgid % nig) / gsz; return true;
    }
    __device__ __forceinline__ void a_ready(const Unit&) const {}
    __device__ __forceinline__ void done(const Unit&) const {}
};

struct EpiAttnIn {
    static constexpr bool PERM = true, AFTER_DRAIN = false;
    bf16_t* Q; bf16_t* Kb; bf16_t* V; bf16_t* Z; const float* ropeC; const float* ropeS;
    __device__ __forceinline__ void operator()(const f32x4 (&acc)[2][2][4][2], const Unit& u, int wr, int wc, int fr, int fq) const {
        const int sect = u.pn >> 2;
        bf16_t* base = sect == 0 ? Q : sect == 1 ? Kb : sect == 2 ? V : Z;
        const int colt = (u.pn & 3) * 256 + wc * 32 + 8 * fq;
        const int row0 = u.pm * BM + wr * 64 + fr;
        const bool rope = (u.pm < 128) && (sect < 2);
        const float sc = (sect == 0) ? QK_C2 : 1.f;
        const int axis = wc & 1;
#pragma unroll
        for (int ai = 0; ai < 2; ++ai)
#pragma unroll
            for (int m = 0; m < 4; ++m) {
                const int row = row0 + ai * HALF + m * 16;
                const int ntok = row & 4095;
                const int pos = axis ? (ntok & 63) : (ntok >> 6);
                bf16_t* rowp;
                if (sect == 1) rowp = base + (size_t)(row >> 6) * 65536 + (size_t)(colt >> 3) * 512 + (row & 63) * 8;
                else if (sect == 2) rowp = base + (size_t)(row >> 6) * 65536 + (size_t)(colt >> 7) * 8192 + (((colt & 127) >> 5) * 4 + ((row & 63) >> 4)) * 512 + (row & 15) * 32 + (colt & 31);
                else rowp = base + (size_t)row * 1024 + colt;
#pragma unroll
                for (int bj = 0; bj < 2; ++bj) {
                    f32x4 v0 = acc[ai][bj][m][0], v1 = acc[ai][bj][m][1];
                    if (rope) {
                        const f32x4 c0 = *(const f32x4*)(ropeC + pos * 16 + 8 * (fq & 1)), c1 = *(const f32x4*)(ropeC + pos * 16 + 8 * (fq & 1) + 4);
                        const f32x4 s0 = *(const f32x4*)(ropeS + pos * 16 + 8 * (fq & 1)), s1 = *(const f32x4*)(ropeS + pos * 16 + 8 * (fq & 1) + 4);
                        f32x4 p0, p1;
#pragma unroll
                        for (int i = 0; i < 4; ++i) { p0[i] = __shfl_xor(v0[i], 32); p1[i] = __shfl_xor(v1[i], 32); }
                        if (fq < 2) { v0 = v0 * c0 - p0 * s0; v1 = v1 * c1 - p1 * s1; }
                        else        { v0 = v0 * c0 + p0 * s0; v1 = v1 * c1 + p1 * s1; }
                    }
                    v0 = v0 * sc; v1 = v1 * sc;
                    u32x4 w; w.x = pkbf(v0[0], v0[1]); w.y = pkbf(v0[2], v0[3]); w.z = pkbf(v1[0], v1[1]); w.w = pkbf(v1[2], v1[3]);
                    *(u32x4*)(rowp + (sect == 1 || sect == 2 ? bj * 8192 : bj * HALF)) = w;
                }
            }
    }
};
struct EpiPlain {
    static constexpr bool PERM = true, AFTER_DRAIN = false;
    bf16_t* O; int ldc;
    __device__ __forceinline__ void operator()(const f32x4 (&acc)[2][2][4][2], const Unit& u, int wr, int wc, int fr, int fq) const {
        const int row0 = u.pm * BM + wr * 64 + fr, col0 = u.pn * BM + wc * 32 + 8 * fq;
#pragma unroll
        for (int ai = 0; ai < 2; ++ai)
#pragma unroll
            for (int m = 0; m < 4; ++m) { bf16_t* rowp = O + (size_t)(row0 + ai * HALF + m * 16) * ldc + col0;
#pragma unroll
                for (int bj = 0; bj < 2; ++bj) { const f32x4 v0 = acc[ai][bj][m][0], v1 = acc[ai][bj][m][1];
                    u32x4 w; w.x = pkbf(v0[0], v0[1]); w.y = pkbf(v0[2], v0[3]); w.z = pkbf(v1[0], v1[1]); w.w = pkbf(v1[2], v1[3]);
                    *(u32x4*)(rowp + bj * HALF) = w; } }
    }
};
struct EpiResid {
    static constexpr bool PERM = false, AFTER_DRAIN = false;
    const float* xin_lat; const float* xin_ctx; float* xout_lat; float* xout_ctx; const float* gate; int row_off;
    __device__ __forceinline__ void operator()(const f32x4 (&acc)[2][2][4][2], const Unit& u, int wr, int wc, int fr, int fq) const {
        const int rowt = row_off + u.pm * BM; const bool lat = rowt < TL; const int r = lat ? (rowt >> 12) : 8;
        const int row0 = rowt + wr * 64 + fr, col0 = u.pn * BM + wc * 32 + 4 * fq;
        const float* xi = lat ? xin_lat + (size_t)row0 * 1024 + col0 : xin_ctx + (size_t)(row0 - TL) * 1024 + col0;
        float* xo = lat ? xout_lat + (size_t)row0 * 1024 + col0 : xout_ctx + (size_t)(row0 - TL) * 1024 + col0;
        f32x4 g[2][2];
#pragma unroll
        for (int bj = 0; bj < 2; ++bj)
#pragma unroll
            for (int n = 0; n < 2; ++n) g[bj][n] = *(const f32x4*)(gate + r * 3072 + col0 + bj * HALF + n * 16);
#pragma unroll
        for (int ai = 0; ai < 2; ++ai) {
            f32x4 pre[4][2][2];
#pragma unroll
            for (int m = 0; m < 4; ++m)
#pragma unroll
                for (int bj = 0; bj < 2; ++bj)
#pragma unroll
                    for (int n = 0; n < 2; ++n) pre[m][bj][n] = *(const f32x4*)(xi + (size_t)(ai * HALF + m * 16) * 1024 + bj * HALF + n * 16);
            asm volatile("" ::: "memory");
#pragma unroll
            for (int m = 0; m < 4; ++m)
#pragma unroll
                for (int bj = 0; bj < 2; ++bj)
#pragma unroll
                    for (int n = 0; n < 2; ++n) *(f32x4*)(xo + (size_t)(ai * HALF + m * 16) * 1024 + bj * HALF + n * 16) = pre[m][bj][n] + g[bj][n] * acc[ai][bj][m][n];
            asm volatile("" ::: "memory");
        }
    }
};
struct EpiFnT {
    static constexpr bool PERM = true, AFTER_DRAIN = false;
    bf16_t* ATL; bf16_t* ATC;
    __device__ __forceinline__ void operator()(const f32x4 (&acc)[2][2][4][2], const Unit& u, int wr, int wc, int fr, int fq) const {
        const int row0 = u.pm * BM + wr * 64 + fr, col0 = u.pn * BM + wc * 32 + 8 * fq;
#pragma unroll
        for (int ai = 0; ai < 2; ++ai)
#pragma unroll
            for (int m = 0; m < 4; ++m) { const int mp = row0 + ai * HALF + m * 16, cs = mp >> 10, n = mp & 1023;
#pragma unroll
                for (int bj = 0; bj < 2; ++bj) { const int t0 = col0 + bj * HALF; bf16_t* dst;
                    if (t0 < TL) { const int b = t0 >> 12, l = t0 & 4095; dst = ATL + ((size_t)((b * 1024 + n) * 2 + cs)) * 4096 + l; }
                    else { const int tc = t0 - TL, b = tc >> 8, l = tc & 255; dst = ATC + ((size_t)((b * 1024 + n) * 2 + cs)) * 256 + l; }
                    const f32x4 v0 = acc[ai][bj][m][0], v1 = acc[ai][bj][m][1];
                    u32x4 w; w.x = pkbf(v0[0], v0[1]); w.y = pkbf(v0[2], v0[3]); w.z = pkbf(v1[0], v1[1]); w.w = pkbf(v1[2], v1[3]);
                    *(u32x4*)dst = w; } }
    }
};
struct EpiDft {
    static constexpr bool PERM = true, AFTER_DRAIN = false;
    const bf16_t* Z; bf16_t* OG; int rowbase; int L;
    __device__ __forceinline__ void operator()(const f32x4 (&acc)[2][2][4][2], const Unit& u, int wr, int wc, int fr, int fq) const {
        const int k0 = u.pm * BM + wr * 64 + fr; const int b = u.pn >> 2; const int n0 = (u.pn & 3) * 256 + wc * 32 + 8 * fq;
#pragma unroll
        for (int ai = 0; ai < 2; ++ai)
#pragma unroll
            for (int m = 0; m < 4; ++m) { const size_t R = (size_t)(rowbase + b * L + k0 + ai * HALF + m * 16);
#pragma unroll
                for (int bj = 0; bj < 2; ++bj) { const size_t off = R * 1024 + n0 + bj * HALF;
                    const u32x4 zz = *(const u32x4*)(Z + off);
                    const f32x4 v0 = acc[ai][bj][m][0], v1 = acc[ai][bj][m][1];
                    u32x4 w;
                    w.x = pkbf(v0[0] * silu_f(bflo(zz.x)), v0[1] * silu_f(bfhi(zz.x))); w.y = pkbf(v0[2] * silu_f(bflo(zz.y)), v0[3] * silu_f(bfhi(zz.y)));
                    w.z = pkbf(v1[0] * silu_f(bflo(zz.z)), v1[1] * silu_f(bfhi(zz.z))); w.w = pkbf(v1[2] * silu_f(bflo(zz.w)), v1[3] * silu_f(bfhi(zz.w)));
                    *(u32x4*)(OG + off) = w; } }
    }
};
struct EpiDftSym {
    static constexpr bool PERM = true, AFTER_DRAIN = false;
    const bf16_t* Pb; const float* TA; const bf16_t* Z; bf16_t* OG;
    __device__ __forceinline__ void operator()(const f32x4 (&acc)[2][2][4][2], const Unit& u, int wr, int wc, int fr, int fq) const {
        const int k0 = u.pm * BM + wr * 64 + fr; const int b = u.pn >> 2; const int c0 = u.pn * BM + wc * 32 + 8 * fq; const int n0 = c0 & 1023;
#pragma unroll
        for (int bj = 0; bj < 2; ++bj) {
            const f32x4 t0 = *(const f32x4*)(TA + c0 + bj * HALF), t1 = *(const f32x4*)(TA + c0 + bj * HALF + 4);
#pragma unroll
            for (int aim = 0; aim < 4; ++aim) { const int ai = aim >> 1, mh = (aim & 1) * 2;
                u32x4 pp[4], z1[4], z2[4];
#pragma unroll
                for (int m = mh; m < mh + 2; ++m) { const int k = k0 + ai * HALF + m * 16;
                    pp[m] = *(const u32x4*)(Pb + (size_t)k * 8192 + c0 + bj * HALF);
                    z1[m] = *(const u32x4*)(Z + (size_t)(b * 4096 + k) * 1024 + n0 + bj * HALF);
                    z2[m] = *(const u32x4*)(Z + (size_t)(b * 4096 + ((4096 - k) & 4095)) * 1024 + n0 + bj * HALF); }
                asm volatile("" ::: "memory");
#pragma unroll
                for (int m = mh; m < mh + 2; ++m) { const int k = k0 + ai * HALF + m * 16; const float sg = (k & 1) ? -1.f : 1.f;
                    const f32x4 q0 = acc[ai][bj][m][0], q1 = acc[ai][bj][m][1];
                    float pt[8];
                    pt[0] = bflo(pp[m].x) + sg * t0[0]; pt[1] = bfhi(pp[m].x) + sg * t0[1]; pt[2] = bflo(pp[m].y) + sg * t0[2]; pt[3] = bfhi(pp[m].y) + sg * t0[3];
                    pt[4] = bflo(pp[m].z) + sg * t1[0]; pt[5] = bfhi(pp[m].z) + sg * t1[1]; pt[6] = bflo(pp[m].w) + sg * t1[2]; pt[7] = bfhi(pp[m].w) + sg * t1[3];
                    { const size_t off = (size_t)(b * 4096 + k) * 1024 + n0 + bj * HALF; const u32x4 zz = z1[m]; u32x4 w;
                      w.x = pkbf((pt[0] - q0[0]) * silu_f(bflo(zz.x)), (pt[1] - q0[1]) * silu_f(bfhi(zz.x))); w.y = pkbf((pt[2] - q0[2]) * silu_f(bflo(zz.y)), (pt[3] - q0[3]) * silu_f(bfhi(zz.y)));
                      w.z = pkbf((pt[4] - q1[0]) * silu_f(bflo(zz.z)), (pt[5] - q1[1]) * silu_f(bfhi(zz.z))); w.w = pkbf((pt[6] - q1[2]) * silu_f(bflo(zz.w)), (pt[7] - q1[3]) * silu_f(bfhi(zz.w)));
                      *(u32x4*)(OG + off) = w; }
                    if (k >= 1) { const size_t off = (size_t)(b * 4096 + 4096 - k) * 1024 + n0 + bj * HALF; const u32x4 zz = z2[m]; u32x4 w;
                      w.x = pkbf((pt[0] + q0[0]) * silu_f(bflo(zz.x)), (pt[1] + q0[1]) * silu_f(bfhi(zz.x))); w.y = pkbf((pt[2] + q0[2]) * silu_f(bflo(zz.y)), (pt[3] + q0[3]) * silu_f(bfhi(zz.y)));
                      w.z = pkbf((pt[4] + q1[0]) * silu_f(bflo(zz.z)), (pt[5] + q1[1]) * silu_f(bfhi(zz.z))); w.w = pkbf((pt[6] + q1[2]) * silu_f(bflo(zz.w)), (pt[7] + q1[3]) * silu_f(bfhi(zz.w)));
                      *(u32x4*)(OG + off) = w; }
                }
                asm volatile("" ::: "memory");
            }
        }
    }
};
template <class Epi, class Sched, bool ALIGN_EPI = false, bool SP2 = false>
__device__ __forceinline__ void gemm_phase(PG8_LAS unsigned char* lds, const Gemm g, const Sched& S, const Epi& E) {
    const int tid = opaque_tid(), wid = __builtin_amdgcn_readfirstlane(tid >> 6), lane = tid & 63, wr = wid >> 2, wc = wid & 3, fr = lane & 15, fq = lane >> 4;
    const int K = g.K, nt = K / BK;
    unsigned voffA[2], voffB[2];
#pragma unroll
    for (int i = 0; i < 2; ++i) { int R, C; stage_rc(tid * 16 + i * 8192, R, C); const int Rb = Epi::PERM ? ((R & ~31) + perm32(R & 31)) : R;
        voffA[i] = (unsigned)(R * K + C) * 2u; voffB[i] = (unsigned)(Rb * K + C) * 2u; }
    const size_t kstep = (size_t)(BK * 2);
    const size_t hstep = (size_t)HALF * K * 2;
    const size_t tstep = 2 * hstep;
    const unsigned ldsw = (unsigned)wid * 1024u;
    const int aoff = lds_byte(wr * 64 + fr, fq * 8), boff = lds_byte(wc * 32 + fr, fq * 8);
#define PG8_SA(b, h) (((b) * 2 + (h)) * HTB)
#define PG8_SB(b, h) ((4 + (b) * 2 + (h)) * HTB)
#define PG8_STAGE(bufoff, gbase, voff) do { _Pragma("unroll") for (int _i = 0; _i < 2; ++_i) \
        __builtin_amdgcn_global_load_lds((const unsigned*)((const char*)(gbase) + (voff)[_i]), (PG8_LAS unsigned*)(lds + (bufoff) + ldsw + _i * 8192), 16, 0, 0); } while (0)
#define PG8_LDA(dst, b, h) do { _Pragma("unroll") for (int m = 0; m < 4; ++m) _Pragma("unroll") for (int k = 0; k < 2; ++k) dst[m][k] = *(const PG8_LAS bf16x8*)(lds + PG8_SA(b, h) + aoff + m * 2048 + k * 1024); } while (0)
#define PG8_LDB(dst, b, h) do { _Pragma("unroll") for (int n = 0; n < 2; ++n) _Pragma("unroll") for (int k = 0; k < 2; ++k) dst[n][k] = *(const PG8_LAS bf16x8*)(lds + PG8_SB(b, h) + boff + n * 2048 + k * 1024); } while (0)
#define PG8_MMA(ai, bj, At, Bt) do { __builtin_amdgcn_s_setprio(1); _Pragma("unroll") for (int m = 0; m < 4; ++m) _Pragma("unroll") for (int n = 0; n < 2; ++n) _Pragma("unroll") for (int k = 0; k < 2; ++k) \
        acc[ai][bj][m][n] = __builtin_amdgcn_mfma_f32_16x16x32_bf16(Bt[n][k], At[m][k], acc[ai][bj][m][n], 0, 0, 0); __builtin_amdgcn_s_setprio(0); } while (0)
#define PG8_WAIT_V(n) asm volatile("s_waitcnt vmcnt(" #n ")" ::: "memory")
#define PG8_WAIT_L(n) asm volatile("s_waitcnt lgkmcnt(" #n ")" ::: "memory")
#define PG8_BAR __builtin_amdgcn_s_barrier()
#define PG8_SCHED __builtin_amdgcn_sched_barrier(0)
    Unit cur, nxt; int ui = 0;
    if (!S.next(0, cur)) return;
    f32x4 acc[2][2][4][2];
#pragma unroll
    for (int a = 0; a < 2; ++a)
#pragma unroll
        for (int b = 0; b < 2; ++b)
#pragma unroll
            for (int m = 0; m < 4; ++m)
#pragma unroll
                for (int n = 0; n < 2; ++n) acc[a][b][m][n] = (f32x4){0.f, 0.f, 0.f, 0.f};
    bf16x8 At[4][2], B0[2][2], B1[2][2];
    const char* cA = (const char*)g.A + (size_t)cur.pm * tstep; const char* cB = (const char*)g.Bt + (size_t)cur.pn * tstep;
    S.a_ready(cur);
    if constexpr (SP2) {
        PG8_STAGE(PG8_SB(0, 0), cB, voffB); PG8_STAGE(PG8_SB(0, 1), cB + hstep, voffB); PG8_STAGE(PG8_SA(0, 0), cA, voffA); PG8_STAGE(PG8_SA(0, 1), cA + hstep, voffA);
        if (wr == 1) PG8_BAR;
        PG8_WAIT_V(2); PG8_BAR;
        PG8_STAGE(PG8_SB(1, 0), cB + kstep, voffB); PG8_STAGE(PG8_SA(1, 0), cA + kstep, voffA); PG8_STAGE(PG8_SB(1, 1), cB + hstep + kstep, voffB);
        PG8_WAIT_V(6); PG8_BAR;
    } else {
        PG8_STAGE(PG8_SB(0, 0), cB, voffB); PG8_STAGE(PG8_SA(0, 0), cA, voffA); PG8_STAGE(PG8_SB(0, 1), cB + hstep, voffB); PG8_STAGE(PG8_SA(0, 1), cA + hstep, voffA);
        if (wr == 1) PG8_BAR;
        PG8_WAIT_V(4); PG8_BAR;
        PG8_STAGE(PG8_SB(1, 0), cB + kstep, voffB); PG8_STAGE(PG8_SA(1, 0), cA + kstep, voffA); PG8_STAGE(PG8_SB(1, 1), cB + hstep + kstep, voffB);
        PG8_WAIT_V(6); PG8_BAR;
    }
    for (;;) {
        const bool has_next = S.next(ui + 1, nxt);
        const char* nA = has_next ? (const char*)g.A + (size_t)nxt.pm * tstep : cA; const char* nB = has_next ? (const char*)g.Bt + (size_t)nxt.pn * tstep : cB;
        for (int t = 0; t < nt; t += 2) {
            const bool last = (t == nt - 2);
            const char* a1 = cA + (size_t)(t + 1) * kstep;
            const char* a2 = last ? nA : cA + (size_t)(t + 2) * kstep; const char* b2 = last ? nB : cB + (size_t)(t + 2) * kstep;
            const char* a3 = a2 + kstep; const char* b3 = b2 + kstep;
            if (last && has_next) S.a_ready(nxt);
            if constexpr (SP2) {
            PG8_LDB(B0, 0, 0); PG8_LDB(B1, 0, 1); PG8_SCHED; PG8_LDA(At, 0, 0); PG8_STAGE(PG8_SA(1, 1), a1 + hstep, voffA);
            PG8_WAIT_V(8); PG8_WAIT_L(0); PG8_BAR; PG8_MMA(0, 0, At, B0); PG8_MMA(0, 1, At, B1); PG8_BAR; PG8_SCHED;
            PG8_LDA(At, 0, 1); PG8_STAGE(PG8_SB(0, 0), b2, voffB); PG8_STAGE(PG8_SB(0, 1), b2 + hstep, voffB); PG8_STAGE(PG8_SA(0, 0), a2, voffA);
            PG8_WAIT_V(8); PG8_WAIT_L(0); PG8_BAR; PG8_MMA(1, 0, At, B0); PG8_MMA(1, 1, At, B1); PG8_BAR; PG8_SCHED;
            PG8_LDB(B0, 1, 0); PG8_LDB(B1, 1, 1); PG8_SCHED; PG8_LDA(At, 1, 0); PG8_STAGE(PG8_SA(0, 1), a2 + hstep, voffA);
            PG8_WAIT_V(8); PG8_WAIT_L(0); PG8_BAR; PG8_MMA(0, 0, At, B0); PG8_MMA(0, 1, At, B1); PG8_BAR; PG8_SCHED;
            PG8_LDA(At, 1, 1); PG8_STAGE(PG8_SB(1, 0), b3, voffB); PG8_STAGE(PG8_SB(1, 1), b3 + hstep, voffB); PG8_STAGE(PG8_SA(1, 0), a3, voffA);
            PG8_WAIT_V(8); PG8_WAIT_L(0); PG8_BAR; PG8_MMA(1, 0, At, B0); PG8_MMA(1, 1, At, B1); PG8_BAR; PG8_SCHED;
            } else {
            PG8_LDB(B0, 0, 0); PG8_SCHED; PG8_LDA(At, 0, 0); PG8_STAGE(PG8_SA(1, 1), a1 + hstep, voffA);
            PG8_WAIT_L(8); PG8_BAR; PG8_WAIT_L(0); PG8_MMA(0, 0, At, B0); PG8_BAR; PG8_SCHED;
            PG8_LDB(B1, 0, 1); PG8_STAGE(PG8_SB(0, 0), b2, voffB);
            PG8_BAR; PG8_WAIT_L(0); PG8_MMA(0, 1, At, B1); PG8_BAR;
            PG8_LDA(At, 0, 1); PG8_STAGE(PG8_SA(0, 0), a2, voffA);
            PG8_BAR; PG8_WAIT_L(0); PG8_MMA(1, 0, At, B0); PG8_BAR; PG8_SCHED;
            PG8_STAGE(PG8_SB(0, 1), b2 + hstep, voffB);
            PG8_WAIT_V(6); PG8_BAR; PG8_MMA(1, 1, At, B1); PG8_BAR;
            PG8_LDB(B0, 1, 0); PG8_SCHED; PG8_LDA(At, 1, 0); PG8_STAGE(PG8_SA(0, 1), a2 + hstep, voffA);
            PG8_WAIT_L(8); PG8_BAR; PG8_WAIT_L(0); PG8_MMA(0, 0, At, B0); PG8_BAR; PG8_SCHED;
            PG8_LDB(B1, 1, 1); PG8_STAGE(PG8_SB(1, 0), b3, voffB);
            PG8_BAR; PG8_WAIT_L(0); PG8_MMA(0, 1, At, B1); PG8_BAR;
            PG8_LDA(At, 1, 1); PG8_STAGE(PG8_SA(1, 0), a3, voffA);
            PG8_BAR; PG8_WAIT_L(0); PG8_MMA(1, 0, At, B0); PG8_BAR; PG8_SCHED;
            PG8_STAGE(PG8_SB(1, 1), b3 + hstep, voffB);
            PG8_WAIT_V(6); PG8_BAR; PG8_MMA(1, 1, At, B1); PG8_BAR;
            }
        }
        if constexpr (ALIGN_EPI) { if (wr == 0) PG8_BAR; }
        if constexpr (!Epi::AFTER_DRAIN) { E(acc, cur, wr, wc, fr, fq); S.done(cur); }
        if (!has_next) break;
#pragma unroll
        for (int a = 0; a < 2; ++a)
#pragma unroll
            for (int b = 0; b < 2; ++b)
#pragma unroll
                for (int m = 0; m < 4; ++m)
#pragma unroll
                    for (int n = 0; n < 2; ++n) acc[a][b][m][n] = (f32x4){0.f, 0.f, 0.f, 0.f};
        cur = nxt; cA = nA; cB = nB; ++ui;
        if constexpr (ALIGN_EPI) { if (wr == 1) PG8_BAR; }
    }
    PG8_WAIT_V(0);
    if constexpr (!ALIGN_EPI) { if (wr == 0) PG8_BAR; }
    PG8_BAR;
    if constexpr (Epi::AFTER_DRAIN) { E.fused(acc, cur, wr, wc, fr, fq, lds, wid, lane); S.done(cur); }
#undef PG8_SA
#undef PG8_SB
#undef PG8_STAGE
#undef PG8_LDA
#undef PG8_LDB
#undef PG8_MMA
#undef PG8_WAIT_V
#undef PG8_WAIT_L
#undef PG8_BAR
#undef PG8_SCHED
}
}
#define LAS __attribute__((address_space(3)))
namespace att {
using bf16x8 = __attribute__((ext_vector_type(8))) short;
using s16x4 = __attribute__((ext_vector_type(4))) short;
using f32x16 = __attribute__((ext_vector_type(16))) float;
using u32x4 = __attribute__((ext_vector_type(4))) unsigned;
typedef unsigned short bf16_t;
__device__ __forceinline__ int crow(int r, int hi) { return (r & 3) + 8 * (r >> 2) + 4 * hi; }
typedef float f32x4_t __attribute__((ext_vector_type(4)));
template <int CTRL> __device__ __forceinline__ float adpp(float v) { return __int_as_float(__builtin_amdgcn_update_dpp(0, __float_as_int(v), CTRL, 0xf, 0xf, true)); }
constexpr int KSLOT = 8192, VSLOT = 16384, LDS_K = 0, LDS_V = 3 * KSLOT, LDS_WS = LDS_V + 4 * VSLOT, LDS_CNT = LDS_WS + 2048;
struct Args { const bf16_t* Q; const bf16_t* K; const bf16_t* V; const bf16_t* Z; bf16_t* O; const float* gain; float lam; float oml; int n_units; unsigned* o1g; };

__device__ __forceinline__ void qkt(f32x16& p0, f32x16& p1, const LAS char* Kslot, const bf16x8* qr, const f32x16& negm, int r32, int hi) {
    const LAS char* kb = Kslot + hi * 1024 + r32 * 16;
    bf16x8 kf[8];
#pragma unroll
    for (int d0 = 0; d0 < 4; ++d0) { kf[2 * d0] = *(const LAS bf16x8*)(kb + d0 * 2048); kf[2 * d0 + 1] = *(const LAS bf16x8*)(kb + d0 * 2048 + 512); }
    asm volatile("s_waitcnt lgkmcnt(0)" ::: "memory"); __builtin_amdgcn_sched_barrier(0);
    p0 = __builtin_amdgcn_mfma_f32_32x32x16_bf16(kf[0], qr[0], negm, 0, 0, 0); p1 = __builtin_amdgcn_mfma_f32_32x32x16_bf16(kf[1], qr[0], negm, 0, 0, 0);
#pragma unroll
    for (int d0 = 1; d0 < 4; ++d0) { p0 = __builtin_amdgcn_mfma_f32_32x32x16_bf16(kf[2 * d0], qr[d0], p0, 0, 0, 0); p1 = __builtin_amdgcn_mfma_f32_32x32x16_bf16(kf[2 * d0 + 1], qr[d0], p1, 0, 0, 0); }
}
__device__ __forceinline__ void kload(bf16x8* kf, const LAS char* Kslot, int r32, int hi) {
    const LAS char* kb = Kslot + hi * 1024 + r32 * 16;
#pragma unroll
    for (int d0 = 0; d0 < 4; ++d0) { kf[2 * d0] = *(const LAS bf16x8*)(kb + d0 * 2048); kf[2 * d0 + 1] = *(const LAS bf16x8*)(kb + d0 * 2048 + 512); }
}
__device__ __forceinline__ void qk_mm(f32x16& p0, f32x16& p1, const bf16x8* kf, const bf16x8* qr, const f32x16& z) {
    p0 = __builtin_amdgcn_mfma_f32_32x32x16_bf16(kf[0], qr[0], z, 0, 0, 0); p1 = __builtin_amdgcn_mfma_f32_32x32x16_bf16(kf[1], qr[0], z, 0, 0, 0);
#pragma unroll
    for (int d0 = 1; d0 < 4; ++d0) { p0 = __builtin_amdgcn_mfma_f32_32x32x16_bf16(kf[2 * d0], qr[d0], p0, 0, 0, 0); p1 = __builtin_amdgcn_mfma_f32_32x32x16_bf16(kf[2 * d0 + 1], qr[d0], p1, 0, 0, 0); }
}
__device__ __forceinline__ float max3a(float a, float b, float c) { float r; asm("v_max3_f32 %0, %1, %2, %3" : "=v"(r) : "v"(a), "v"(b), "v"(c)); return r; }
__device__ __forceinline__ float rowmax(const f32x16& p0, const f32x16& p1) {
    float a = max3a(p0[0], p0[1], p0[2]), b = max3a(p1[0], p1[1], p1[2]);
#pragma unroll
    for (int r = 3; r < 15; r += 2) { a = max3a(a, p0[r], p0[r + 1]); b = max3a(b, p1[r], p1[r + 1]); }
    a = max3a(a, p0[15], p1[15]);
    float m; asm("v_max_f32 %0, %1, %2" : "=v"(m) : "v"(a), "v"(b));
    asm volatile("s_nop 1" ::: "memory");
    auto rr = __builtin_amdgcn_permlane32_swap(__float_as_uint(m), __float_as_uint(m), false, false);
    float o; asm("v_max_f32 %0, %1, %2" : "=v"(o) : "v"(__uint_as_float(rr[0])), "v"(__uint_as_float(rr[1])));
    return o;
}
#define ATT_VRD(buf, d0) do { _Pragma("unroll") for (int ks = 0; ks < 4; ++ks) { \
        asm volatile("ds_read_b64_tr_b16 %0,%1 offset:%c2" : "=&v"(lo[buf][ks]) : "v"(vb), "i"((d0) * 4096 + ks * 1024) : "memory"); \
        asm volatile("ds_read_b64_tr_b16 %0,%1 offset:%c2" : "=&v"(hi[buf][ks]) : "v"(vb), "i"((d0) * 4096 + ks * 1024 + 512) : "memory"); } } while (0)
#define ATT_PK(b, k) (bf16x8){lo[b][k][0], lo[b][k][1], lo[b][k][2], lo[b][k][3], hi[b][k][0], hi[b][k][1], hi[b][k][2], hi[b][k][3]}
#define ATT_MM2(da, db) do { \
        o[da] = __builtin_amdgcn_mfma_f32_32x32x16_bf16(pa0, ATT_PK(0, 0), o[da], 0, 0, 0); o[db] = __builtin_amdgcn_mfma_f32_32x32x16_bf16(pa0, ATT_PK(1, 0), o[db], 0, 0, 0); \
        o[da] = __builtin_amdgcn_mfma_f32_32x32x16_bf16(pa1, ATT_PK(0, 1), o[da], 0, 0, 0); o[db] = __builtin_amdgcn_mfma_f32_32x32x16_bf16(pa1, ATT_PK(1, 1), o[db], 0, 0, 0); \
        o[da] = __builtin_amdgcn_mfma_f32_32x32x16_bf16(pa2, ATT_PK(0, 2), o[da], 0, 0, 0); o[db] = __builtin_amdgcn_mfma_f32_32x32x16_bf16(pa2, ATT_PK(1, 2), o[db], 0, 0, 0); \
        o[da] = __builtin_amdgcn_mfma_f32_32x32x16_bf16(pa3, ATT_PK(0, 3), o[da], 0, 0, 0); o[db] = __builtin_amdgcn_mfma_f32_32x32x16_bf16(pa3, ATT_PK(1, 3), o[db], 0, 0, 0); } while (0)
__device__ __forceinline__ void pv(f32x16* o, int vb, bf16x8 pa0, bf16x8 pa1, bf16x8 pa2, bf16x8 pa3) {
    s16x4 lo[2][4], hi[2][4];
    ATT_VRD(0, 0);
    ATT_VRD(1, 1);
    asm volatile("s_waitcnt lgkmcnt(0)" ::: "memory"); __builtin_amdgcn_sched_barrier(0);
    ATT_MM2(0, 1); __builtin_amdgcn_sched_barrier(0);
    ATT_VRD(0, 2);
    ATT_VRD(1, 3);
    asm volatile("s_waitcnt lgkmcnt(0)" ::: "memory"); __builtin_amdgcn_sched_barrier(0);
    ATT_MM2(2, 3);
}
#undef ATT_MM2
#undef ATT_VRD
#undef ATT_PK
__device__ __forceinline__ void attn_pass(const Args& A, int z, int b, int h, int qrow0, bool isctx, bool pathB, LAS char* shm, f32x16* o) {
    const int tid = opaque_tid(), lane = tid & 63, r32 = lane & 31, hi = lane >> 5; const int wid = __builtin_amdgcn_readfirstlane(tid >> 6);
    const int NT = isctx ? 4 : 68;
    LAS float* wsf = (LAS float*)(shm + LDS_WS) + wid * 64;
    const int vb0 = (int)(unsigned)(size_t)(shm + LDS_V) + ((lane >> 4) & 1) * 32 + (lane & 3) * 8 + (4 * hi + ((lane & 15) >> 2)) * 64;
    const bf16_t* Qw = A.Q + (size_t)(qrow0 + wid * 32 + r32) * 1024 + h * 128 + z * 64;
    bf16x8 qr[4];
#pragma unroll
    for (int d0 = 0; d0 < 4; ++d0) qr[d0] = *(const bf16x8*)(Qw + d0 * 16 + hi * 8);
    const bf16_t* Kh = A.K + (size_t)((h * 2 + z) * 8 + wid) * 512 + lane * 8;
    const int pc0 = wid, pc1 = wid + 8;
    const bf16_t* Vh0 = A.V + (size_t)h * 8192 + pc0 * 512 + lane * 8;
    const bf16_t* Vh1 = A.V + (size_t)h * 8192 + pc1 * 512 + lane * 8;
    const int ctxrow = TL + b * 256, latrow = b * 4096;
#define ATT_TROW(t) ((isctx || (t) < 4) ? (ctxrow + 64 * (t)) : (latrow + 64 * ((t) - 4)))
#define ATT_DMA(t, slot, vslot) do { const size_t ro_ = (size_t)(ATT_TROW(t) >> 6) * 65536; \
        __builtin_amdgcn_global_load_lds((const unsigned*)(Kh + ro_), (LAS unsigned*)(shm + LDS_K + (slot) * KSLOT + wid * 1024), 16, 0, 0); \
        __builtin_amdgcn_global_load_lds((const unsigned*)(Vh0 + ro_), (LAS unsigned*)(shm + LDS_V + (vslot) * VSLOT + pc0 * 1024), 16, 0, 0); \
        __builtin_amdgcn_global_load_lds((const unsigned*)(Vh1 + ro_), (LAS unsigned*)(shm + LDS_V + (vslot) * VSLOT + pc1 * 1024), 16, 0, 0); } while (0)
    float mhat = 0.f, l_reg = 0.f;
    const f32x16 negm = f32x16{};
#pragma unroll
    for (int d = 0; d < 4; ++d) o[d] = f32x16{};
    ATT_DMA(0, 0, 0);
    if (NT > 1) ATT_DMA(1, 1, 1);
    asm volatile("s_waitcnt vmcnt(0) lgkmcnt(0)\n\ts_barrier" ::: "memory");
    f32x16 sc0, sc1;
    { bf16x8 kf[8]; kload(kf, shm + LDS_K, r32, hi); qk_mm(sc0, sc1, kf, qr, negm); asm volatile("s_nop 15\n\ts_nop 15" : "+v"(sc0), "+v"(sc1)); }
    if (NT > 2) ATT_DMA(2, 2, 2);
    int k_cur = 0, v_cur = 0, v_prev = 3;
    u32x4 pw0 = {0u, 0u, 0u, 0u}, pw1 = pw0, pw2 = pw0, pw3 = pw0;
#pragma unroll 1
    for (int t = 0; t <= NT; ++t) {
        const int k_n1 = (k_cur == 2) ? 0 : k_cur + 1;
        if (t > 0) {
            asm volatile("s_waitcnt vmcnt(0) lgkmcnt(0)\n\ts_barrier" ::: "memory");
            const int k_p2 = (k_cur == 0) ? 2 : k_cur - 1;
            const int v_p2 = (v_cur + 2) & 3;
            if (t + 2 < NT) ATT_DMA(t + 2, k_p2, v_p2);
        }
        if (pathB && t > 0) {
            pv(o, vb0 + v_prev * VSLOT, __builtin_bit_cast(bf16x8, pw0), __builtin_bit_cast(bf16x8, pw1), __builtin_bit_cast(bf16x8, pw2), __builtin_bit_cast(bf16x8, pw3)); }
        if (t < NT) {
        const float rm = rowmax(sc0, sc1);
        if (t == 0) { mhat = rm; }
        else if (__any(rm - mhat > 8.f)) {
            const float dl = fmaxf(rm - mhat, 0.f); mhat += dl;
            const float f = __builtin_amdgcn_exp2f(-dl); l_reg *= f;
            if (hi == 0) wsf[r32] = f;
            asm volatile("s_waitcnt lgkmcnt(0)" ::: "memory");
#pragma unroll
            for (int r = 0; r < 16; ++r) { const float fr_ = wsf[crow(r, hi)];
#pragma unroll
                for (int d = 0; d < 4; ++d) o[d][r] *= fr_; }
            asm volatile("s_waitcnt lgkmcnt(0)" ::: "memory");
        }
        bf16x8 kf[8];
        kload(kf, shm + LDS_K + k_n1 * KSLOT, r32, hi);
        __builtin_amdgcn_sched_barrier(0);
        f32x16 pn0, pn1;
        qk_mm(pn0, pn1, kf, qr, negm);
        f32x2_t sacc = {0.f, 0.f};
#pragma unroll
        for (int r = 0; r < 16; r += 2) { sc0[r] = __builtin_amdgcn_exp2f(sc0[r] - mhat); sc0[r + 1] = __builtin_amdgcn_exp2f(sc0[r + 1] - mhat); sc1[r] = __builtin_amdgcn_exp2f(sc1[r] - mhat); sc1[r + 1] = __builtin_amdgcn_exp2f(sc1[r + 1] - mhat);
            sacc += (f32x2_t){sc0[r], sc0[r + 1]}; sacc += (f32x2_t){sc1[r], sc1[r + 1]}; }
        l_reg += sacc.x + sacc.y;
        pw0 = (u32x4){pkbf(sc0[0], sc0[1]), pkbf(sc0[2], sc0[3]), pkbf(sc0[4], sc0[5]), pkbf(sc0[6], sc0[7])};
        pw1 = (u32x4){pkbf(sc0[8], sc0[9]), pkbf(sc0[10], sc0[11]), pkbf(sc0[12], sc0[13]), pkbf(sc0[14], sc0[15])};
        pw2 = (u32x4){pkbf(sc1[0], sc1[1]), pkbf(sc1[2], sc1[3]), pkbf(sc1[4], sc1[5]), pkbf(sc1[6], sc1[7])};
        pw3 = (u32x4){pkbf(sc1[8], sc1[9]), pkbf(sc1[10], sc1[11]), pkbf(sc1[12], sc1[13]), pkbf(sc1[14], sc1[15])};
#pragma unroll
        for (int i = 0; i < 8; ++i) { __builtin_amdgcn_sched_group_barrier(0x008, 1, 0); __builtin_amdgcn_sched_group_barrier(0x002, 13, 0); }
        __builtin_amdgcn_sched_barrier(0);
        if (!pathB) {
            pv(o, vb0 + v_cur * VSLOT, __builtin_bit_cast(bf16x8, pw0), __builtin_bit_cast(bf16x8, pw1), __builtin_bit_cast(bf16x8, pw2), __builtin_bit_cast(bf16x8, pw3)); }
        sc0 = pn0; sc1 = pn1;
        }
        k_cur = k_n1; v_prev = v_cur; v_cur = (v_cur + 1) & 3;
    }
    asm volatile("s_waitcnt lgkmcnt(0)\n\ts_barrier" ::: "memory");
#undef ATT_DMA
#undef ATT_TROW
    { auto rr = __builtin_amdgcn_permlane32_swap(__float_as_uint(l_reg), __float_as_uint(l_reg), false, false); l_reg = __uint_as_float(rr[0]) + __uint_as_float(rr[1]); }
    asm volatile("s_waitcnt lgkmcnt(0)" ::: "memory");
    if (hi == 0) wsf[32 + r32] = l_reg;
    asm volatile("s_waitcnt lgkmcnt(0)" ::: "memory");
#pragma unroll
    for (int r = 0; r < 16; ++r) { const float rl = 1.0f / wsf[32 + crow(r, hi)];
#pragma unroll
        for (int d = 0; d < 4; ++d) o[d][r] *= rl; }
    asm volatile("s_waitcnt lgkmcnt(0)" ::: "memory");
}
__device__ __forceinline__ void attn_unit(const Args& A, int b, int h, int qb, bool isctx, bool pathB, LAS char* shm) {
    const int tid = opaque_tid(), lane = tid & 63, r32 = lane & 31, hi = lane >> 5; const int wid = __builtin_amdgcn_readfirstlane(tid >> 6);
    const int qrow0 = isctx ? (TL + b * 256) : (b * 4096 + qb * 256);
    f32x16 o[4];
    unsigned* o1s = A.o1g + wid * 2048 + lane;
    attn_pass(A, 0, b, h, qrow0, isctx, pathB, shm, o);
#pragma unroll
    for (int d = 0; d < 4; ++d)
#pragma unroll
        for (int r = 0; r < 16; r += 2) o1s[(d * 8 + (r >> 1)) * 64] = pkbf(o[d][r], o[d][r + 1]);
    asm volatile("s_waitcnt lgkmcnt(0)" ::: "memory");
    attn_pass(A, 1, b, h, qrow0, isctx, pathB, shm, o);
#pragma unroll
    for (int r = 0; r < 16; r += 2)
#pragma unroll
        for (int d = 0; d < 4; ++d) { const unsigned pk = o1s[(d * 8 + (r >> 1)) * 64]; o[d][r] = bflo(pk) - A.lam * o[d][r]; o[d][r + 1] = bfhi(pk) - A.lam * o[d][r + 1]; }
    LAS float* stg = (LAS float*)shm + wid * (32 * 68);
    const int rq = lane >> 3, cq = lane & 7;
    float vals[2][4][8]; float ssr[4] = {0.f, 0.f, 0.f, 0.f};
#pragma unroll
    for (int hf = 0; hf < 2; ++hf) {
#pragma unroll
        for (int r = 0; r < 16; ++r) { stg[crow(r, hi) * 68 + r32] = o[2 * hf][r]; stg[crow(r, hi) * 68 + 32 + r32] = o[2 * hf + 1][r]; }
        asm volatile("s_waitcnt lgkmcnt(0)" ::: "memory");
#pragma unroll
        for (int i = 0; i < 4; ++i) { const f32x4_t u0 = *(const LAS f32x4_t*)(stg + (rq + 8 * i) * 68 + cq * 8), u1 = *(const LAS f32x4_t*)(stg + (rq + 8 * i) * 68 + cq * 8 + 4);
#pragma unroll
            for (int c = 0; c < 4; ++c) { vals[hf][i][c] = u0[c]; vals[hf][i][4 + c] = u1[c]; ssr[i] += u0[c] * u0[c] + u1[c] * u1[c]; } }
        asm volatile("s_waitcnt lgkmcnt(0)" ::: "memory");
    }
#pragma unroll
    for (int i = 0; i < 4; ++i) { float v = ssr[i]; v += adpp<0xB1>(v); v += adpp<0x4E>(v); v += adpp<0x141>(v); ssr[i] = rsqrtf(v * (1.0f / 128.0f) + 1e-5f) * A.oml; }
#pragma unroll
    for (int hf = 0; hf < 2; ++hf) {
        const int col = h * 128 + hf * 64 + cq * 8;
        const f32x4_t g0 = *(const f32x4_t*)(A.gain + hf * 64 + cq * 8), g1 = *(const f32x4_t*)(A.gain + hf * 64 + cq * 8 + 4);
        u32x4 zz[4];
#pragma unroll
        for (int i = 0; i < 4; ++i) zz[i] = *(const u32x4*)(A.Z + (size_t)(qrow0 + wid * 32 + rq + 8 * i) * 1024 + col);
#pragma unroll
        for (int i = 0; i < 4; ++i) { const float rs = ssr[i]; const float* vv = vals[hf][i]; u32x4 w;
            w.x = pkbf(vv[0] * rs * g0[0] * silu_f(bflo(zz[i].x)), vv[1] * rs * g0[1] * silu_f(bfhi(zz[i].x)));
            w.y = pkbf(vv[2] * rs * g0[2] * silu_f(bflo(zz[i].y)), vv[3] * rs * g0[3] * silu_f(bfhi(zz[i].y)));
            w.z = pkbf(vv[4] * rs * g1[0] * silu_f(bflo(zz[i].z)), vv[5] * rs * g1[1] * silu_f(bfhi(zz[i].z)));
            w.w = pkbf(vv[6] * rs * g1[2] * silu_f(bflo(zz[i].w)), vv[7] * rs * g1[3] * silu_f(bfhi(zz[i].w)));
            *(u32x4*)(A.O + (size_t)(qrow0 + wid * 32 + rq + 8 * i) * 1024 + col) = w; }
    }
}
__device__ __forceinline__ void attn_phase(const Args& A, LAS char* shm, int G, int bid) {
    const int vcu = (G % 8 == 0) ? (bid % 8) * (G / 8) + bid / 8 : bid;
    bool pathB;
    { const int tid = opaque_tid(); LAS unsigned* cnt = (LAS unsigned*)(shm + LDS_CNT);
      if (tid < 4) cnt[tid] = 0u;
      __syncthreads();
      const unsigned simd = (unsigned)__builtin_amdgcn_s_getreg((1 << 11) | (4 << 6) | 4) & 3u;
      unsigned slot = 0u; if ((tid & 63) == 0) slot = __hip_atomic_fetch_add(cnt + simd, 1u, __ATOMIC_RELAXED, __HIP_MEMORY_SCOPE_WORKGROUP);
      slot = (unsigned)__builtin_amdgcn_readfirstlane((int)slot);
      pathB = (slot & 1u) != 0u;
      __syncthreads(); }
#pragma unroll 1
    for (int u = vcu; u < A.n_units; u += G) {
        const bool isctx = u >= 1024; const int bh = isctx ? (u - 1024) : (u >> 4); const int qb = isctx ? 0 : (u & 15);
        attn_unit(A, bh >> 3, bh & 7, qb, isctx, pathB, shm);
        asm volatile("s_waitcnt vmcnt(0) lgkmcnt(0)\n\ts_barrier" ::: "memory");
    }
}
}
typedef unsigned short bf16_t;
typedef float f32x4 __attribute__((ext_vector_type(4)));
typedef unsigned u32x4 __attribute__((ext_vector_type(4)));
typedef unsigned u32x2 __attribute__((ext_vector_type(2)));
constexpr size_t MiB = 1u << 20;
constexpr size_t WS_CTL = 0, WS_MOD = 1 * MiB, WS_ROPE = 1 * MiB + 512 * 1024, WS_BZ = 2 * MiB;
constexpr size_t WS_WDAIN = 9 * MiB, WS_WDAOUT = 25 * MiB, WS_WFNT = 29 * MiB, WS_WFNZ = 33 * MiB, WS_WFNOUT = 35 * MiB, WS_WRWIN = 37 * MiB, WS_WRWOUT = 46 * MiB;
constexpr size_t WS_XC = 48 * MiB, WS_HB = 56 * MiB, WS_BIG = 124 * MiB;
constexpr size_t WS_Q = WS_BIG, WS_K = WS_BIG + 68 * MiB, WS_V = WS_BIG + 136 * MiB, WS_Z = WS_BIG + 204 * MiB;
constexpr size_t WS_ATL = WS_BIG, WS_ATC = WS_BIG + 128 * MiB, WS_ZB = WS_BIG + 136 * MiB, WS_DFTL = 396 * MiB, WS_DFTC = 460 * MiB, WS_FOLD = WS_BIG + 204 * MiB;
constexpr size_t WS_P = WS_BIG, WS_Y1 = 413 * MiB, WS_END = 482 * MiB;
constexpr int RWN = 4352;
constexpr int LDS_BYTES = 147456;

struct Params { const float* in[28]; float* out; unsigned char* ws; };

__device__ __forceinline__ float wave_sum(float v) {
#pragma unroll
    for (int o = 1; o < 64; o <<= 1) v += __shfl_xor(v, o);
    return v;
}
__device__ __forceinline__ void tr_item(const float* W, int ldw, int N, bf16_t* WT, int ldt, LAS float* scr, int item, int lane) {
    const int nblk = N / 32, kb = item / nblk, nb = item % nblk, k0 = 64 * kb, n0 = 32 * nb;
    float v_[32];
#pragma unroll
    for (int i = 0; i < 32; ++i) v_[i] = W[(size_t)(k0 + 2 * i + (lane >> 5)) * ldw + n0 + (lane & 31)];
#pragma unroll
    for (int i = 0; i < 32; ++i) scr[(2 * i + (lane >> 5)) * 33 + (lane & 31)] = v_[i];
    asm volatile("s_waitcnt lgkmcnt(0)" ::: "memory");
    const int c = lane & 7;
#pragma unroll
    for (int j = 0; j < 4; ++j) { const int n = (lane >> 3) + 8 * j; const LAS float* s = scr + (8 * c) * 33 + n;
        u32x4 o; o.x = pkbf(s[0 * 33], s[1 * 33]); o.y = pkbf(s[2 * 33], s[3 * 33]); o.z = pkbf(s[4 * 33], s[5 * 33]); o.w = pkbf(s[6 * 33], s[7 * 33]);
        *(u32x4*)(WT + (size_t)(n0 + n) * ldt + k0 + 8 * c) = o; }
    asm volatile("s_waitcnt lgkmcnt(0)" ::: "memory");
}
__device__ __forceinline__ void prologue(const Params& p, LAS char* lds, int G, int bid) {
    const int tid = opaque_tid(), lane = tid & 63, wid = tid >> 6;
    unsigned char* ws = p.ws;
    {
        LAS float* scr = (LAS float*)(lds + wid * 8448);
        const int gw = bid * 8 + wid, NGW = G * 8;
        for (int it = gw; it < 8832; it += NGW) {
            int r = it;
            if (r < 2048) { tr_item(p.in[8], 4096, 4096, (bf16_t*)(ws + WS_WDAIN), 1024, scr, r, lane); continue; } r -= 2048;
            if (r < 2048) { tr_item(p.in[8] + (size_t)1024 * 4096, 4096, 4096, (bf16_t*)(ws + WS_WDAIN + 8 * MiB), 1024, scr, r, lane); continue; } r -= 2048;
            if (r < 512) { tr_item(p.in[12], 1024, 1024, (bf16_t*)(ws + WS_WDAOUT), 1024, scr, r, lane); continue; } r -= 512;
            if (r < 512) { tr_item(p.in[12] + (size_t)1024 * 1024, 1024, 1024, (bf16_t*)(ws + WS_WDAOUT + 2 * MiB), 1024, scr, r, lane); continue; } r -= 512;
            if (r < 512) { tr_item(p.in[13] + 1024, 2048, 1024, (bf16_t*)(ws + WS_WFNZ), 1024, scr, r, lane); continue; } r -= 512;
            if (r < 512) { tr_item(p.in[15], 1024, 1024, (bf16_t*)(ws + WS_WFNOUT), 1024, scr, r, lane); continue; } r -= 512;
            if (r < 2176) { tr_item(p.in[16], RWN, RWN, (bf16_t*)(ws + WS_WRWIN), 1024, scr, r, lane); continue; } r -= 2176;
            tr_item(p.in[27], 1024, 1024, (bf16_t*)(ws + WS_WRWOUT), 1024, scr, r, lane);
        }
    }
    __syncthreads();
    for (int it = bid; it < 256; it += G) {
        const int g = it >> 5, cs = (it >> 4) & 1, kq = it & 15;
        LAS float* Wcs = (LAS float*)lds; LAS float* win = (LAS float*)(lds + 65536); LAS float* tab = (LAS float*)(lds + 65536 + 33024);
        if (tid < 128) { float s, c; sincospif((float)tid / 64.f, &s, &c); tab[tid] = (cs ? s : c) * 0.08838834764831845f; }
        __syncthreads();
        {
            const int e0 = (tid & 31) * 4, cq = tid >> 5; f32x4 acc[8];
#pragma unroll
            for (int i = 0; i < 8; ++i) acc[i] = (f32x4){0.f, 0.f, 0.f, 0.f};
            const float* Wg = p.in[14] + (size_t)g * 128 * 128;
            for (int m = 0; m < 128; ++m) { const f32x4 wg = *(const f32x4*)(Wg + m * 128 + e0);
#pragma unroll
                for (int i = 0; i < 8; ++i) acc[i] += wg * tab[(m * (cq + 16 * i)) & 127]; }
#pragma unroll
            for (int i = 0; i < 8; ++i) *(LAS f32x4*)(Wcs + (cq + 16 * i) * 128 + e0) = acc[i];
        }
#pragma unroll
        for (int i = 0; i < 16; ++i) { const int idx = tid + 512 * i, kin = idx >> 7, c = idx & 127; win[kin * 129 + c] = p.in[13][(size_t)(kq * 64 + kin) * 2048 + g * 128 + c]; }
        __syncthreads();
        {
            const int kin = tid & 63, eg = tid >> 6; float acc[16];
#pragma unroll
            for (int i = 0; i < 16; ++i) acc[i] = 0.f;
            for (int c = 0; c < 128; ++c) { const float a = win[kin * 129 + c];
#pragma unroll
                for (int i = 0; i < 16; ++i) acc[i] += a * Wcs[c * 128 + eg * 16 + i]; }
            bf16_t* WT = (bf16_t*)(ws + WS_WFNT);
#pragma unroll
            for (int i = 0; i < 16; ++i) WT[(size_t)(cs * 1024 + g * 128 + eg * 16 + i) * 1024 + kq * 64 + kin] = (bf16_t)(pkbf(acc[i], 0.f) & 0xffffu);
        }
        __syncthreads();
    }
    {
        LAS float* tc = (LAS float*)lds; LAS float* ts = (LAS float*)(lds + 16384);
        for (int j = tid; j < 4096; j += 512) { float s, c; sincospif((float)j / 2048.f, &s, &c); tc[j] = c; ts[j] = -s; }
        __syncthreads();
        bf16_t* DL = (bf16_t*)(ws + WS_DFTL); bf16_t* DC = (bf16_t*)(ws + WS_DFTC);
        for (int k = bid; k < 2048; k += G) {
            const int j0 = (tid & 255) * 8; const bool sn = tid >= 256; float v8[8];
#pragma unroll
            for (int i = 0; i < 8; ++i) { const int idx = (k * (j0 + i)) & 4095; v8[i] = (sn ? -ts[idx] : tc[idx]) * 0.015625f; }
            u32x4 o; o.x = pkbf(v8[0], v8[1]); o.y = pkbf(v8[2], v8[3]); o.z = pkbf(v8[4], v8[5]); o.w = pkbf(v8[6], v8[7]);
            *(u32x4*)(DL + (sn ? (size_t)2048 * 2048 : (size_t)0) + (size_t)k * 2048 + j0) = o;
        }
        for (int k = bid; k < 256; k += G) {
            if (tid < 64) { const int cs = tid >> 5, l0 = (tid & 31) * 8; float v8[8];
#pragma unroll
                for (int i = 0; i < 8; ++i) { const int idx = ((k * (l0 + i)) & 255) * 16; v8[i] = (cs ? ts[idx] : tc[idx]) * 0.0625f; }
                u32x4 o; o.x = pkbf(v8[0], v8[1]); o.y = pkbf(v8[2], v8[3]); o.z = pkbf(v8[4], v8[5]); o.w = pkbf(v8[6], v8[7]);
                *(u32x4*)(DC + (size_t)k * 512 + cs * 256 + l0) = o; }
        }
        __syncthreads();
    }
    {
        LAS float* sc = (LAS float*)lds; LAS float* red = (LAS float*)(lds + 40960);
        bool have = false;
        for (int it = bid; it < 192; it += G) {
            if (!have) { for (int idx = tid; idx < 9216; idx += 512) { const int r = idx >> 10, k = idx & 1023; const float cv = r < 8 ? p.in[1][r * 1024 + k] : p.in[3][k]; sc[idx] = cv / (1.f + __expf(-cv)); } have = true; __syncthreads(); }
            const int i = it / 48, n = (it % 48) * 64 + (tid & 63), kq = tid >> 6;
            const float* w = p.in[5] + (size_t)i * 1024 * 3072 + n;
            float acc[9];
#pragma unroll
            for (int r = 0; r < 9; ++r) acc[r] = 0.f;
            for (int k = kq * 128; k < kq * 128 + 128; k += 4) { const float w0 = w[(size_t)k * 3072], w1 = w[(size_t)(k + 1) * 3072], w2 = w[(size_t)(k + 2) * 3072], w3 = w[(size_t)(k + 3) * 3072];
#pragma unroll
                for (int r = 0; r < 9; ++r) { const f32x4 s4 = *(const LAS f32x4*)(sc + r * 1024 + k); acc[r] += (s4[0] * w0 + s4[1] * w1) + (s4[2] * w2 + s4[3] * w3); } }
#pragma unroll
            for (int r = 0; r < 9; ++r) red[(kq * 9 + r) * 64 + (tid & 63)] = acc[r];
            __syncthreads();
            for (int idx = tid; idx < 576; idx += 512) { const int r = idx >> 6, col = idx & 63; float s = 0.f;
#pragma unroll
                for (int q = 0; q < 8; ++q) s += red[(q * 9 + r) * 64 + col];
                const int nn = (it % 48) * 64 + col;
                ((float*)(ws + WS_MOD))[(size_t)(i * 9 + r) * 3072 + nn] = s + p.in[6][i * 3072 + nn]; }
            __syncthreads();
        }
    }
    if (bid == 0) { for (int t = tid; t < 1024; t += 512) { const int pos = t >> 4, qd = t & 15; const float inv = powf(10000.f, -(float)qd / 16.f); const float ang = (float)pos * inv;
            ((float*)(ws + WS_ROPE))[t] = cosf(ang); ((float*)(ws + WS_ROPE))[1024 + t] = sinf(ang); } }
}
__device__ __forceinline__ void ph_phase(const float* xlat, const float* xctx, const float* gain, const float* mod, bf16_t* Hb, int G, int bid, int r0 = 0, int r1 = TT) {
    const int tid_ = opaque_tid(); const int lane = tid_ & 63, wid = tid_ >> 6;
    const int stride = G * 8;
    for (int row0 = r0 + bid * 8 + wid; row0 < r1; row0 += 2 * stride) {
        const int row1 = row0 + stride; const bool has1 = row1 < r1;
        const float* s0 = row0 < TL ? xlat + (size_t)row0 * 1024 : xctx + (size_t)(row0 - TL) * 1024;
        const float* s1 = !has1 ? s0 : (row1 < TL ? xlat + (size_t)row1 * 1024 : xctx + (size_t)(row1 - TL) * 1024);
        f32x4 v0[4], v1[4]; float q0 = 0.f, q1 = 0.f;
#pragma unroll
        for (int j = 0; j < 4; ++j) { v0[j] = *(const f32x4*)(s0 + 4 * lane + 256 * j); v1[j] = *(const f32x4*)(s1 + 4 * lane + 256 * j); }
#pragma unroll
        for (int j = 0; j < 4; ++j) { q0 += (v0[j].x * v0[j].x + v0[j].y * v0[j].y) + (v0[j].z * v0[j].z + v0[j].w * v0[j].w); q1 += (v1[j].x * v1[j].x + v1[j].y * v1[j].y) + (v1[j].z * v1[j].z + v1[j].w * v1[j].w); }
        const float r0 = rsqrtf(wave_sum(q0) * (1.f / 1024.f) + 1e-6f), r1 = rsqrtf(wave_sum(q1) * (1.f / 1024.f) + 1e-6f);
        const float* m0 = mod + (row0 < TL ? (row0 >> 12) : 8) * 3072; const float* m1 = mod + (row1 < TL ? (row1 >> 12) : 8) * 3072;
#pragma unroll
        for (int j = 0; j < 4; ++j) { const int col = 4 * lane + 256 * j; const f32x4 g4 = *(const f32x4*)(gain + col);
            { const f32x4 sh = *(const f32x4*)(m0 + col), sc = *(const f32x4*)(m0 + 1024 + col); const f32x4 y = v0[j] * r0 * g4 * (sc + 1.f) + sh; u32x2 o; o.x = pkbf(y.x, y.y); o.y = pkbf(y.z, y.w); *(u32x2*)(Hb + (size_t)row0 * 1024 + col) = o; }
            if (has1) { const f32x4 sh = *(const f32x4*)(m1 + col), sc = *(const f32x4*)(m1 + 1024 + col); const f32x4 y = v1[j] * r1 * g4 * (sc + 1.f) + sh; u32x2 o; o.x = pkbf(y.x, y.y); o.y = pkbf(y.z, y.w); *(u32x2*)(Hb + (size_t)row1 * 1024 + col) = o; } }
    }
}
__device__ __forceinline__ void final_phase(float* x, const float* gain, int G, int bid) {
    const int tid_ = opaque_tid(); const int lane = tid_ & 63, wid = tid_ >> 6;
    const int stride = G * 8;
    for (int row0 = bid * 8 + wid; row0 < TL; row0 += 2 * stride) {
        const int row1 = row0 + stride; const bool has1 = row1 < TL;
        float* s0 = x + (size_t)row0 * 1024; float* s1 = has1 ? x + (size_t)row1 * 1024 : s0;
        f32x4 v0[4], v1[4]; float q0 = 0.f, q1 = 0.f;
#pragma unroll
        for (int j = 0; j < 4; ++j) { v0[j] = *(const f32x4*)(s0 + 4 * lane + 256 * j); v1[j] = *(const f32x4*)(s1 + 4 * lane + 256 * j); }
#pragma unroll
        for (int j = 0; j < 4; ++j) { q0 += (v0[j].x * v0[j].x + v0[j].y * v0[j].y) + (v0[j].z * v0[j].z + v0[j].w * v0[j].w); q1 += (v1[j].x * v1[j].x + v1[j].y * v1[j].y) + (v1[j].z * v1[j].z + v1[j].w * v1[j].w); }
        const float r0 = rsqrtf(wave_sum(q0) * (1.f / 1024.f) + 1e-6f), r1 = rsqrtf(wave_sum(q1) * (1.f / 1024.f) + 1e-6f);
#pragma unroll
        for (int j = 0; j < 4; ++j) { const int col = 4 * lane + 256 * j; const f32x4 g4 = *(const f32x4*)(gain + col);
            *(f32x4*)(s0 + col) = v0[j] * r0 * g4;
            if (has1) *(f32x4*)(s1 + col) = v1[j] * r1 * g4; }
    }
}
__device__ __forceinline__ void fnet_fold(const bf16_t* ATL, bf16_t* E, bf16_t* O, float* TA, const bf16_t* Z, bf16_t* OG, int G, int bid) {
    const int tid_ = opaque_tid(); const int lane = tid_ & 63, wid = tid_ >> 6;
    for (int row = bid * 8 + wid; row < 8192; row += G * 8) {
        const bf16_t* a1 = ATL + (size_t)row * 8192; const bf16_t* a2 = a1 + 4096; bf16_t* e = E + (size_t)row * 2048; bf16_t* od = O + (size_t)row * 2048;
        float alt = 0.f;
#pragma unroll 2
        for (int it = 0; it < 4; ++it) {
            const int j0 = (it * 64 + lane) * 8;
            const u32x4 x = *(const u32x4*)(a1 + j0), y = *(const u32x4*)(a2 + j0);
            const int mb = 4096 - j0 - 8;
            const u32x4 xm = *(const u32x4*)(a1 + mb), ym = *(const u32x4*)(a2 + mb);
            const unsigned short xe = (j0 == 0) ? (unsigned short)0 : a1[4096 - j0], ye = (j0 == 0) ? (unsigned short)0 : a2[4096 - j0];
            float fa[8], fs[8], ma[8], ms[8];
#pragma unroll
            for (int i = 0; i < 4; ++i) { fa[2 * i] = bflo(x[i]); fa[2 * i + 1] = bfhi(x[i]); fs[2 * i] = bflo(y[i]); fs[2 * i + 1] = bfhi(y[i]);
                ma[2 * i] = bflo(xm[i]); ma[2 * i + 1] = bfhi(xm[i]); ms[2 * i] = bflo(ym[i]); ms[2 * i + 1] = bfhi(ym[i]); }
            float oc[8], os[8];
            oc[0] = fa[0] + bf1(xe); os[0] = fs[0] - bf1(ye);
#pragma unroll
            for (int i = 1; i < 8; ++i) { oc[i] = fa[i] + ma[8 - i]; os[i] = fs[i] - ms[8 - i]; }
            if (j0 == 0) { oc[0] = fa[0]; os[0] = 0.f; }
            u32x4 o; o.x = pkbf(oc[0], oc[1]); o.y = pkbf(oc[2], oc[3]); o.z = pkbf(oc[4], oc[5]); o.w = pkbf(oc[6], oc[7]);
            *(u32x4*)(e + j0) = o;
            alt += (bflo(o.x) - bfhi(o.x)) + (bflo(o.y) - bfhi(o.y)) + (bflo(o.z) - bfhi(o.z)) + (bflo(o.w) - bfhi(o.w));
            o.x = pkbf(os[0], os[1]); o.y = pkbf(os[2], os[3]); o.z = pkbf(os[4], os[5]); o.w = pkbf(os[6], os[7]);
            *(u32x4*)(od + j0) = o;
        }
        alt = wave_sum(alt);
        if (lane == 0) { const float amid = bf1(a1[2048]); TA[row] = amid * 0.015625f;
            const int b = row >> 10, n = row & 1023; const size_t off = (size_t)(b * 4096 + 2048) * 1024 + n;
            const float yv = (alt + amid) * 0.015625f * silu_f(bf1(Z[off]));
            OG[off] = (bf16_t)(pkbf(yv, 0.f) & 0xffffu); }
    }
}
__device__ __forceinline__ void sh8(const bf16_t* P, size_t row, int co, bool hm, bool hp, const float* mu, float* out) {
    const u32x4 z4 = {0u, 0u, 0u, 0u};
    const u32x4 c0 = *(const u32x4*)(P + row * RWN + co);
    const u32x4 cm = hm ? *(const u32x4*)(P + (row - 1) * RWN + co) : z4;
    const u32x4 cp = hp ? *(const u32x4*)(P + (row + 1) * RWN + co) : z4;
    const f32x4 m0 = *(const f32x4*)(mu + co), m1 = *(const f32x4*)(mu + co + 4);
#pragma unroll
    for (int i = 0; i < 4; ++i) {
        const float a0 = bflo(c0[i]), a1 = bfhi(c0[i]);
        const float n0 = 0.5f * (bflo(cm[i]) + bflo(cp[i])), n1 = 0.5f * (bfhi(cm[i]) + bfhi(cp[i]));
        const float mu0 = (2 * i < 4) ? m0[(2 * i) & 3] : m1[(2 * i) & 3], mu1 = (2 * i + 1 < 4) ? m0[(2 * i + 1) & 3] : m1[(2 * i + 1) & 3];
        out[2 * i] = a0 + mu0 * (n0 - a0); out[2 * i + 1] = a1 + mu1 * (n1 - a1);
    }
}
template <int CTRL> __device__ __forceinline__ float dpp_f(float v) { return __int_as_float(__builtin_amdgcn_update_dpp(0, __float_as_int(v), CTRL, 0xf, 0xf, true)); }
__device__ __forceinline__ float sum8(float v) { v += dpp_f<0xB1>(v); v += dpp_f<0x4E>(v); v += dpp_f<0x141>(v); return v; }
__device__ __forceinline__ float fast_tanh(float x) { const float e = __expf(2.f * x); return 1.f - 2.f * __builtin_amdgcn_rcpf(e + 1.f); }
__device__ __forceinline__ float fast_sigmoid(float x) { return __builtin_amdgcn_rcpf(1.f + __expf(-x)); }
struct RwArgs { const bf16_t* P; bf16_t* Y0; bf16_t* Y1; float* BZ; const float *mu, *w0, *w_up, *a0, *a_up, *k_k, *k_a, *r_k; };
struct Raw3 { u32x4 c0, cm, cp; };
__device__ __forceinline__ Raw3 ld3(const bf16_t* P, size_t row, int co, bool hm, bool hp) {
    const u32x4 z4 = {0u, 0u, 0u, 0u}; Raw3 r;
    r.c0 = *(const u32x4*)(P + row * RWN + co);
    r.cm = hm ? *(const u32x4*)(P + (row - 1) * RWN + co) : z4;
    r.cp = hp ? *(const u32x4*)(P + (row + 1) * RWN + co) : z4;
    return r;
}
__device__ __forceinline__ void shift8(const Raw3& R, const float* mu, int co, float* out) {
    const f32x4 m0 = *(const f32x4*)(mu + co), m1 = *(const f32x4*)(mu + co + 4);
#pragma unroll
    for (int i = 0; i < 4; ++i) {
        const float a0 = bflo(R.c0[i]), a1 = bfhi(R.c0[i]);
        const float n0 = 0.5f * (bflo(R.cm[i]) + bflo(R.cp[i])), n1 = 0.5f * (bfhi(R.cm[i]) + bfhi(R.cp[i]));
        const float mu0 = (2 * i < 4) ? m0[(2 * i) & 3] : m1[(2 * i) & 3], mu1 = (2 * i + 1 < 4) ? m0[(2 * i + 1) & 3] : m1[(2 * i + 1) & 3];
        out[2 * i] = a0 + mu0 * (n0 - a0); out[2 * i + 1] = a1 + mu1 * (n1 - a1);
    }
}
__device__ __forceinline__ void shift8l(const Raw3& R, const LAS float* mu, float* out) {
    const f32x4 m0 = *(const LAS f32x4*)(mu), m1 = *(const LAS f32x4*)(mu + 4);
    const float mm[8] = {m0[0], m0[1], m0[2], m0[3], m1[0], m1[1], m1[2], m1[3]};
#pragma unroll
    for (int i = 0; i < 4; ++i) {
        const float a0 = bflo(R.c0[i]), a1 = bfhi(R.c0[i]);
        const float n0 = 0.5f * (bflo(R.cm[i]) + bflo(R.cp[i])), n1 = 0.5f * (bfhi(R.cm[i]) + bfhi(R.cp[i]));
        out[2 * i] = a0 + mm[2 * i] * (n0 - a0); out[2 * i + 1] = a1 + mm[2 * i + 1] * (n1 - a1);
    }
}
__device__ __forceinline__ void shift8r(const Raw3& R, const float* mu, float* out) {
#pragma unroll
    for (int i = 0; i < 4; ++i) {
        const float a0 = bflo(R.c0[i]), a1 = bfhi(R.c0[i]);
        const float n0 = 0.5f * (bflo(R.cm[i]) + bflo(R.cp[i])), n1 = 0.5f * (bfhi(R.cm[i]) + bfhi(R.cp[i]));
        out[2 * i] = a0 + mu[2 * i] * (n0 - a0); out[2 * i + 1] = a1 + mu[2 * i + 1] * (n1 - a1);
    }
}
__device__ __forceinline__ void rwkv_scan(const RwArgs& A, LAS char* lds, int G, int bid) {
    typedef short bfx8 __attribute__((ext_vector_type(8)));
    const int tid = opaque_tid(), lane = tid & 63; const int q = __builtin_amdgcn_readfirstlane(tid >> 6);
    LAS float* sW = (LAS float*)lds; LAS float* sA = sW + 4096; LAS float* sB = sA + 4096; LAS float* sKD = sB + 4096; LAS float* sR = sKD + 4096; LAS float* sV = sR + 4096;
    LAS bf16_t* WUPt = (LAS bf16_t*)(sV + 4096); LAS bf16_t* AUPt = WUPt + 64 * 72;
    LAS bf16_t* T1 = (LAS bf16_t*)sW; LAS bf16_t* T2 = (LAS bf16_t*)sKD;
    const int s = tid >> 3, dg = tid & 7, d0 = dg * 8;
#pragma unroll 1
    for (int chain = bid; chain < 256; chain += G) {
        const int z = chain >> 7, b = (chain >> 4) & 7, hh = chain & 15;
        __syncthreads();
        for (int idx = tid; idx < 4096; idx += 512) { const int r = idx >> 6, d = idx & 63;
            WUPt[d * 72 + r] = (bf16_t)(pkbf(A.w_up[(size_t)(z * 64 + r) * 1024 + hh * 64 + d], 0.f) & 0xffffu);
            AUPt[d * 72 + r] = (bf16_t)(pkbf(A.a_up[(size_t)(z * 64 + r) * 1024 + hh * 64 + d], 0.f) & 0xffffu); }
        f32x2_t S2[4];
#pragma unroll
        for (int j = 0; j < 4; ++j) S2[j] = (f32x2_t){0.f, 0.f};
        bf16_t* Yz = z ? A.Y1 : A.Y0;
        const int c_r = hh * 64 + d0, c_k = 1024 + hh * 64 + d0, c_v = 2048 + hh * 64 + d0, c_wd = 3072 + z * 64 + d0, c_ad = 3200 + z * 64 + d0;
#define RW_ROWOF(c, rowv, hmv, hpv) do { const int sidx_ = (c) * 64 + s; int L_, n_, rb_; \
            if ((c) < 4) { L_ = 256; n_ = z ? (255 - sidx_) : sidx_; rb_ = TL + b * 256; } else { L_ = 4096; const int sl_ = sidx_ - 256; n_ = z ? (4095 - sl_) : sl_; rb_ = b * 4096; } \
            rowv = (size_t)(rb_ + n_); hmv = n_ > 0; hpv = n_ < L_ - 1; } while (0)
        size_t row; bool hm, hp;
        RW_ROWOF(0, row, hm, hp);
        Raw3 Rr = ld3(A.P, row, c_r, hm, hp), Rk = ld3(A.P, row, c_k, hm, hp), Rv = ld3(A.P, row, c_v, hm, hp), Rw = ld3(A.P, row, c_wd, hm, hp), Ra = ld3(A.P, row, c_ad, hm, hp);
#pragma unroll 1
        for (int c = 0; c < 68; ++c) {
            asm volatile("" ::: "memory");
            const size_t crow_ = row;
            {
                float r8[8], k8[8], v8[8], t8[8];
                shift8(Rr, A.mu, c_r, r8); shift8(Rk, A.mu, c_k, k8); shift8(Rv, A.mu, c_v, v8);
                *(LAS f32x4*)(sR + s * 64 + d0) = (f32x4){r8[0], r8[1], r8[2], r8[3]}; *(LAS f32x4*)(sR + s * 64 + d0 + 4) = (f32x4){r8[4], r8[5], r8[6], r8[7]};
                *(LAS f32x4*)(sV + s * 64 + d0) = (f32x4){v8[0], v8[1], v8[2], v8[3]}; *(LAS f32x4*)(sV + s * 64 + d0 + 4) = (f32x4){v8[4], v8[5], v8[6], v8[7]};
                *(LAS f32x4*)(sB + s * 64 + d0) = (f32x4){k8[0], k8[1], k8[2], k8[3]}; *(LAS f32x4*)(sB + s * 64 + d0 + 4) = (f32x4){k8[4], k8[5], k8[6], k8[7]};
                float kkr[8], ssq = 0.f;
                const f32x4 kk0 = *(const f32x4*)(A.k_k + hh * 64 + d0), kk1 = *(const f32x4*)(A.k_k + hh * 64 + d0 + 4);
#pragma unroll
                for (int i = 0; i < 8; ++i) { kkr[i] = k8[i] * (i < 4 ? kk0[i & 3] : kk1[i & 3]); ssq += kkr[i] * kkr[i]; }
                ssq = sum8(ssq);
                const float rs = -rsqrtf(ssq + 1e-12f);
                *(LAS f32x4*)(sA + s * 64 + d0) = (f32x4){kkr[0] * rs, kkr[1] * rs, kkr[2] * rs, kkr[3] * rs}; *(LAS f32x4*)(sA + s * 64 + d0 + 4) = (f32x4){kkr[4] * rs, kkr[5] * rs, kkr[6] * rs, kkr[7] * rs};
                shift8(Rw, A.mu, c_wd, t8);
                { u32x4 o; o.x = pkbf(fast_tanh(t8[0]), fast_tanh(t8[1])); o.y = pkbf(fast_tanh(t8[2]), fast_tanh(t8[3])); o.z = pkbf(fast_tanh(t8[4]), fast_tanh(t8[5])); o.w = pkbf(fast_tanh(t8[6]), fast_tanh(t8[7]));
                  *(LAS u32x4*)(T1 + s * 72 + d0) = o; }
                shift8(Ra, A.mu, c_ad, t8);
                { u32x4 o; o.x = pkbf(t8[0], t8[1]); o.y = pkbf(t8[2], t8[3]); o.z = pkbf(t8[4], t8[5]); o.w = pkbf(t8[6], t8[7]);
                  *(LAS u32x4*)(T2 + s * 72 + d0) = o; }
            }
            if (c + 1 < 68) { RW_ROWOF(c + 1, row, hm, hp);
                Rr = ld3(A.P, row, c_r, hm, hp); Rk = ld3(A.P, row, c_k, hm, hp); Rv = ld3(A.P, row, c_v, hm, hp); Rw = ld3(A.P, row, c_wd, hm, hp); Ra = ld3(A.P, row, c_ad, hm, hp); }
            __syncthreads();
            const int mt = q & 3, nh = q >> 2, fr = lane & 15, fq = lane >> 4;
            f32x4 accw[2], acca[2];
            {
                bfx8 aw[2], aa[2];
#pragma unroll
                for (int kk = 0; kk < 2; ++kk) { aw[kk] = *(const LAS bfx8*)(T1 + (16 * mt + fr) * 72 + kk * 32 + fq * 8); aa[kk] = *(const LAS bfx8*)(T2 + (16 * mt + fr) * 72 + kk * 32 + fq * 8); }
#pragma unroll
                for (int nt = 0; nt < 2; ++nt) { accw[nt] = (f32x4){0.f, 0.f, 0.f, 0.f}; acca[nt] = (f32x4){0.f, 0.f, 0.f, 0.f};
#pragma unroll
                    for (int kk = 0; kk < 2; ++kk) {
                        const bfx8 bw = *(const LAS bfx8*)(WUPt + (32 * nh + 16 * nt + fr) * 72 + kk * 32 + fq * 8), ba = *(const LAS bfx8*)(AUPt + (32 * nh + 16 * nt + fr) * 72 + kk * 32 + fq * 8);
                        accw[nt] = __builtin_amdgcn_mfma_f32_16x16x32_bf16(aw[kk], bw, accw[nt], 0, 0, 0);
                        acca[nt] = __builtin_amdgcn_mfma_f32_16x16x32_bf16(aa[kk], ba, acca[nt], 0, 0, 0); } }
            }
            __syncthreads();
#pragma unroll
            for (int nt = 0; nt < 2; ++nt) { const int d = 32 * nh + 16 * nt + fr, dcol = hh * 64 + d;
                const float w0d = A.w0[z * 1024 + dcol], a0d = A.a0[z * 1024 + dcol], kad = A.k_a[dcol];
#pragma unroll
                for (int j = 0; j < 4; ++j) { const int idx = (16 * mt + 4 * fq + j) * 64 + d;
                    const float x = -(w0d + accw[nt][j]);
                    const float sp = fmaxf(x, 0.f) + __logf(1.f + __expf(-fabsf(x)));
                    const float w = __expf(-__expf(-sp - 0.5f));
                    const float asig = fast_sigmoid(a0d + acca[nt][j]);
                    const float nkk = sA[idx], kraw = sB[idx];
                    sW[idx] = w; sB[idx] = -nkk * asig; sKD[idx] = kraw * (1.f + (asig - 1.f) * kad); } }
            __syncthreads();
            {
                const f32x4 ra = *(const LAS f32x4*)(sR + s * 64 + d0), rb = *(const LAS f32x4*)(sR + s * 64 + d0 + 4), ka = *(const LAS f32x4*)(sKD + s * 64 + d0), kb = *(const LAS f32x4*)(sKD + s * 64 + d0 + 4);
                const f32x4 q0 = *(const f32x4*)(A.r_k + hh * 64 + d0), q1 = *(const f32x4*)(A.r_k + hh * 64 + d0 + 4);
                float bz = 0.f;
#pragma unroll
                for (int i = 0; i < 4; ++i) { bz += ra[i] * ka[i] * q0[i]; bz += rb[i] * kb[i] * q1[i]; }
                bz = sum8(bz);
                if (dg == 0) A.BZ[((size_t)z * TT + crow_) * 16 + hh] = bz;
            }
            {
                const int rl = lane >> 3, cg = lane & 7, irow = 8 * q + rl;
                const LAS float* bw = sW + 8 * cg; const LAS float* ba_ = sA + 8 * cg; const LAS float* bb_ = sB + 8 * cg; const LAS float* bk = sKD + 8 * cg; const LAS float* br = sR + 8 * cg;
                LAS float* bv = sV + irow;
                f32x4 w0 = *(const LAS f32x4*)(bw), w1 = *(const LAS f32x4*)(bw + 4), a0 = *(const LAS f32x4*)(ba_), a1 = *(const LAS f32x4*)(ba_ + 4);
                f32x4 b0 = *(const LAS f32x4*)(bb_), b1 = *(const LAS f32x4*)(bb_ + 4), k0 = *(const LAS f32x4*)(bk), k1 = *(const LAS f32x4*)(bk + 4);
                f32x4 r0 = *(const LAS f32x4*)(br), r1 = *(const LAS f32x4*)(br + 4); float vi = bv[0];
#pragma unroll 4
                for (int st = 0; st < 64; ++st) {
                    const int on = ((st + 1) & 63) * 64;
                    const f32x4 nw0 = *(const LAS f32x4*)(bw + on), nw1 = *(const LAS f32x4*)(bw + on + 4), na0 = *(const LAS f32x4*)(ba_ + on), na1 = *(const LAS f32x4*)(ba_ + on + 4);
                    const f32x4 nb0 = *(const LAS f32x4*)(bb_ + on), nb1 = *(const LAS f32x4*)(bb_ + on + 4), nk0 = *(const LAS f32x4*)(bk + on), nk1 = *(const LAS f32x4*)(bk + on + 4);
                    const f32x4 nr0 = *(const LAS f32x4*)(br + on), nr1 = *(const LAS f32x4*)(br + on + 4); const float nvi = bv[on];
                    f32x2_t pp2 = S2[0] * (f32x2_t){a0[0], a0[1]};
                    pp2 = S2[1] * (f32x2_t){a0[2], a0[3]} + pp2; pp2 = S2[2] * (f32x2_t){a1[0], a1[1]} + pp2; pp2 = S2[3] * (f32x2_t){a1[2], a1[3]} + pp2;
                    const float sa = sum8(pp2.x + pp2.y);
                    const f32x2_t sa2 = {sa, sa}, v2 = {vi, vi};
                    S2[0] = S2[0] * (f32x2_t){w0[0], w0[1]} + sa2 * (f32x2_t){b0[0], b0[1]} + v2 * (f32x2_t){k0[0], k0[1]};
                    S2[1] = S2[1] * (f32x2_t){w0[2], w0[3]} + sa2 * (f32x2_t){b0[2], b0[3]} + v2 * (f32x2_t){k0[2], k0[3]};
                    S2[2] = S2[2] * (f32x2_t){w1[0], w1[1]} + sa2 * (f32x2_t){b1[0], b1[1]} + v2 * (f32x2_t){k1[0], k1[1]};
                    S2[3] = S2[3] * (f32x2_t){w1[2], w1[3]} + sa2 * (f32x2_t){b1[2], b1[3]} + v2 * (f32x2_t){k1[2], k1[3]};
                    f32x2_t y2 = S2[0] * (f32x2_t){r0[0], r0[1]};
                    y2 = S2[1] * (f32x2_t){r0[2], r0[3]} + y2; y2 = S2[2] * (f32x2_t){r1[0], r1[1]} + y2; y2 = S2[3] * (f32x2_t){r1[2], r1[3]} + y2;
                    const float yv = sum8(y2.x + y2.y);
                    if (cg == 0) bv[st * 64] = yv;
                    w0 = nw0; w1 = nw1; a0 = na0; a1 = na1; b0 = nb0; b1 = nb1; k0 = nk0; k1 = nk1; r0 = nr0; r1 = nr1; vi = nvi;
                }
            }
            __syncthreads();
            { u32x4 o; const LAS float* yr = sV + s * 64 + d0;
              o.x = pkbf(yr[0], yr[1]); o.y = pkbf(yr[2], yr[3]); o.z = pkbf(yr[4], yr[5]); o.w = pkbf(yr[6], yr[7]);
              *(u32x4*)(Yz + crow_ * 1024 + hh * 64 + d0) = o; }
            __syncthreads();
        }
#undef RW_ROWOF
    }
}
__device__ __forceinline__ void rwkv_out(const RwArgs& A, const float* ln_w, const float* ln_b, bf16_t* OG, int G, int bid) {
    const int tid_ = opaque_tid(); const int lane = tid_ & 63, wid = tid_ >> 6; const int c0 = lane * 16, head = lane >> 2;
    float lw[16], lb[16], muv[16];
#pragma unroll
    for (int i = 0; i < 16; ++i) { lw[i] = ln_w[c0 + i]; lb[i] = ln_b[c0 + i]; muv[i] = A.mu[2048 + c0 + i]; }
    for (int row = bid * 8 + wid; row < TT; row += G * 8) {
        const bool lat = row < TL; const int L = lat ? 4096 : 256; const int n = lat ? (row & 4095) : ((row - TL) & 255); const bool hm = n > 0, hp = n < L - 1;
        const u32x4 a0 = *(const u32x4*)(A.Y0 + (size_t)row * 1024 + c0), a1 = *(const u32x4*)(A.Y0 + (size_t)row * 1024 + c0 + 8);
        const u32x4 b0 = *(const u32x4*)(A.Y1 + (size_t)row * 1024 + c0), b1 = *(const u32x4*)(A.Y1 + (size_t)row * 1024 + c0 + 8);
        const Raw3 v0 = ld3(A.P, (size_t)row, 2048 + c0, hm, hp), v1 = ld3(A.P, (size_t)row, 2048 + c0 + 8, hm, hp);
        const u32x4 z0 = *(const u32x4*)(A.P + (size_t)row * RWN + 3328 + c0), z1 = *(const u32x4*)(A.P + (size_t)row * RWN + 3328 + c0 + 8);
        const float bz = 0.5f * (A.BZ[(size_t)row * 16 + head] + A.BZ[((size_t)TT + row) * 16 + head]);
        float y[16], vv[16];
#pragma unroll
        for (int i = 0; i < 4; ++i) { y[2 * i] = bflo(a0[i]) + bflo(b0[i]); y[2 * i + 1] = bfhi(a0[i]) + bfhi(b0[i]); y[8 + 2 * i] = bflo(a1[i]) + bflo(b1[i]); y[8 + 2 * i + 1] = bfhi(a1[i]) + bfhi(b1[i]); }
        float s1 = 0.f;
#pragma unroll
        for (int i = 0; i < 16; ++i) s1 += y[i];
        s1 += __shfl_xor(s1, 1); s1 += __shfl_xor(s1, 2); const float mean = s1 * (1.f / 64.f);
        float s2 = 0.f;
#pragma unroll
        for (int i = 0; i < 16; ++i) { y[i] -= mean; s2 += y[i] * y[i]; }
        s2 += __shfl_xor(s2, 1); s2 += __shfl_xor(s2, 2); const float rstd = rsqrtf(s2 * (1.f / 64.f) + 64e-5f);
        shift8r(v0, muv, vv); shift8r(v1, muv + 8, vv + 8);
        float ov[16];
#pragma unroll
        for (int i = 0; i < 16; ++i) { const unsigned zw = (i < 8) ? z0[(i >> 1) & 3] : z1[(i >> 1) & 3]; const float zz = (i & 1) ? bfhi(zw) : bflo(zw);
            ov[i] = (y[i] * rstd * lw[i] + lb[i] + bz * vv[i]) * silu_f(zz); }
        u32x4 o0, o1; o0.x = pkbf(ov[0], ov[1]); o0.y = pkbf(ov[2], ov[3]); o0.z = pkbf(ov[4], ov[5]); o0.w = pkbf(ov[6], ov[7]);
        o1.x = pkbf(ov[8], ov[9]); o1.y = pkbf(ov[10], ov[11]); o1.z = pkbf(ov[12], ov[13]); o1.w = pkbf(ov[14], ov[15]);
        *(u32x4*)(OG + (size_t)row * 1024 + c0) = o0; *(u32x4*)(OG + (size_t)row * 1024 + c0 + 8) = o1;
    }
}
#ifdef SKIP_GEMM
#define GEMM_PHASE(EPI, AP, BP, MM, NN, KK, EOBJ) do { (void)EOBJ; } while (0)
#else
#ifndef STAGGER_TICKS
#define STAGGER_TICKS 1500
#endif
__device__ __forceinline__ void stagger_wait(int bid, int units_per_cu_x2) {
    if ((bid & 1) && units_per_cu_x2 >= 4) { const unsigned long long t0 = __builtin_amdgcn_s_memrealtime(); while (__builtin_amdgcn_s_memrealtime() - t0 < (unsigned long long)STAGGER_TICKS) __builtin_amdgcn_s_sleep(32); }
}
#define GEMM_PHASE(EPI, AP, BP, MM, NN, KK, EOBJ) do { pg8::Gemm g_{(const bf16_t*)(AP), (const bf16_t*)(BP), (MM), (NN), (KK)}; pg8::StaticOrder S_; S_.init((MM), (NN), G, bid); \
    pg8::gemm_phase<EPI, pg8::StaticOrder, true, true>((PG8_LAS unsigned char*)lds, g_, S_, EOBJ); } while (0)
#endif
#ifdef SKIP_EpiAttnIn
#define GEMM_PHASE_EpiAttnIn(EPI, AP, BP, MM, NN, KK, EOBJ) do { (void)EOBJ; } while (0)
#else
#define GEMM_PHASE_EpiAttnIn GEMM_PHASE
#endif
#ifdef SKIP_EpiFnT
#define GEMM_PHASE_EpiFnT(EPI, AP, BP, MM, NN, KK, EOBJ) do { (void)EOBJ; } while (0)
#else
#define GEMM_PHASE_EpiFnT GEMM_PHASE
#endif
#ifdef SKIP_EpiPlain
#define GEMM_PHASE_EpiPlain(EPI, AP, BP, MM, NN, KK, EOBJ) do { (void)EOBJ; } while (0)
#else
#define GEMM_PHASE_EpiPlain GEMM_PHASE
#endif
#ifdef SKIP_EpiDft
#define GEMM_PHASE_EpiDft(EPI, AP, BP, MM, NN, KK, EOBJ) do { (void)EOBJ; } while (0)
#else
#define GEMM_PHASE_EpiDft GEMM_PHASE
#endif
#ifdef SKIP_EpiResid
#define GEMM_PHASE_EpiResid(EPI, AP, BP, MM, NN, KK, EOBJ) do { (void)EOBJ; } while (0)
#else
#define GEMM_PHASE_EpiResid GEMM_PHASE
#endif
#define XB_TMO      128
#define XB_XCNT(j)  (256  + 64 * (j))
#define XB_XSUB(j)  (1280 + 64 * (j))
#define XB_XGEN(j)  (2304 + 64 * (j))
#define XB_TOP      3328
#define XB_TOPGEN   3392
#define XCD_BAR_WORDS 3456
#define XB_SPIN_CAP (1u << 18)

__device__ __forceinline__ unsigned xb_ld(unsigned* p)              { return __hip_atomic_load(p, __ATOMIC_RELAXED, __HIP_MEMORY_SCOPE_AGENT); }
__device__ __forceinline__ unsigned xb_add(unsigned* p, unsigned v) { return __hip_atomic_fetch_add(p, v, __ATOMIC_RELAXED, __HIP_MEMORY_SCOPE_AGENT); }
__device__ __forceinline__ unsigned xb_xcc_id() { return (unsigned)__builtin_amdgcn_s_getreg((3 << 11) | 20) & 0xFu; }
#define XB_SPIN(cond, bar) do { unsigned _sp = 0; while (cond) { __builtin_amdgcn_s_sleep(1); \
    if ((++_sp & 255u) == 0u) { if (xb_ld(&(bar)[XB_TMO])) break; if (_sp > XB_SPIN_CAP) { atomicAdd(&(bar)[XB_TMO], 1u); break; } } } } while (0)

struct XcdBarrier {
    unsigned* bar; unsigned x;
    volatile LAS unsigned* st;
};

__device__ __forceinline__ XcdBarrier xcd_barrier_post(unsigned* bar, volatile LAS unsigned* st) {
    XcdBarrier b; b.bar = bar; b.x = xb_xcc_id(); b.st = st;
    if (threadIdx.x == 0) (void)xb_add(&bar[XB_XCNT(b.x)], 1u);
    return b;
}
__device__ __forceinline__ void xcd_barrier_complete(unsigned* bar, unsigned x, unsigned& nloc, unsigned& nx) {
    const unsigned G = gridDim.x * gridDim.y * gridDim.z;
    unsigned sum, cnt, mine, sp = 0u;
    for (;;) {
        sum = 0u; cnt = 0u; mine = 0u;
#pragma unroll
        for (unsigned j = 0; j < 16; ++j) { const unsigned c = xb_ld(&bar[XB_XCNT(j)]); sum += c; cnt += (c > 0u) ? 1u : 0u; mine = (j == x) ? c : mine; }
        if (sum == G) break;
        __builtin_amdgcn_s_sleep(1);
        if ((++sp & 255u) == 0u) { if (xb_ld(&bar[XB_TMO])) break; if (sp > XB_SPIN_CAP) { atomicAdd(&bar[XB_TMO], 1u); break; } }
    }
    nloc = mine > 0u ? mine : 1u; nx = cnt > 0u ? cnt : 1u;
}

__device__ __forceinline__ void xcd_barrier(const XcdBarrier& b) {
    asm volatile("s_waitcnt vmcnt(0)" ::: "memory");
    __syncthreads();
    if (threadIdx.x == 0) {
        unsigned* bar = b.bar;
        __builtin_amdgcn_s_waitcnt(0);
        unsigned nloc = b.st[0], nx = b.st[1];
        if (nloc == 0u) { xcd_barrier_complete(bar, b.x, nloc, nx); b.st[0] = nloc; b.st[1] = nx; }
        const unsigned old = xb_add(&bar[XB_XSUB(b.x)], 1u);
        const unsigned gen = old / nloc;
        if (old + 1u == (gen + 1u) * nloc) {
            __builtin_amdgcn_fence(__ATOMIC_RELEASE, "agent");
            asm volatile("s_waitcnt vmcnt(0)" ::: "memory");
            const unsigned og = xb_add(&bar[XB_TOP], 1u);
            const unsigned tg = og / nx;
            if (og + 1u == (tg + 1u) * nx) xb_add(&bar[XB_TOPGEN], 1u);
            else XB_SPIN(xb_ld(&bar[XB_TOPGEN]) == tg, bar);
            __builtin_amdgcn_fence(__ATOMIC_ACQUIRE, "agent");
            xb_add(&bar[XB_XGEN(b.x)], 1u);
            asm volatile("s_waitcnt vmcnt(0)" ::: "memory");
        } else {
            XB_SPIN(xb_ld(&bar[XB_XGEN(b.x)]) == gen, bar);
            __builtin_amdgcn_fence(__ATOMIC_ACQUIRE, "agent");
            asm volatile("s_waitcnt vmcnt(0)" ::: "memory");
        }
    }
    __syncthreads();
}

#define GRID_SYNC() xcd_barrier(xbar)
template <int layer> __device__ __forceinline__ void layer_body(const Params& p, LAS char* lds, const XcdBarrier& xbar, int G, int bid) {
    unsigned char* ws = p.ws;
    float* mod = (float*)(ws + WS_MOD);
    const float* ropeC = (const float*)(ws + WS_ROPE); const float* ropeS = ropeC + 1024;
    bf16_t* Hb = (bf16_t*)(ws + WS_HB);
    float* XC = (float*)(ws + WS_XC);
    const float* x_in = p.in[0]; const float* ctx_in = p.in[2];
        const float* xl = layer == 0 ? x_in : p.out; const float* xc = layer == 0 ? ctx_in : XC;
        const float* modl = mod + (size_t)layer * 9 * 3072;
        if constexpr (layer == 0) {
            ph_phase(xl, xc, p.in[4] + layer * 1024, modl, Hb, G, bid);
            GRID_SYNC();
        }
        const int Mout = (layer == 3) ? TL : TT;
        const bf16_t* Wout;
        if constexpr (layer == 0 || layer == 3) {
            const int j = layer == 0 ? 0 : 1;
            pg8::EpiAttnIn E{(bf16_t*)(ws + WS_Q), (bf16_t*)(ws + WS_K), (bf16_t*)(ws + WS_V), (bf16_t*)(ws + WS_Z), ropeC, ropeS};
            GEMM_PHASE_EpiAttnIn(pg8::EpiAttnIn, Hb, ws + WS_WDAIN + (size_t)j * 8 * MiB, TT, 4096, 1024, E);
#ifdef PROBE_GIN2
            GEMM_PHASE_EpiAttnIn(pg8::EpiAttnIn, Hb, ws + WS_WDAIN + (size_t)j * 8 * MiB, TT, 4096, 1024, E);
#endif
            GRID_SYNC();
            float lam;
            { const int lane = opaque_tid() & 63; const float* lq = p.in[9] + j * 128; const float* lk = p.in[10] + j * 128;
              const float s0 = wave_sum(lq[lane] * lk[lane]), s1 = wave_sum(lq[64 + lane] * lk[64 + lane]);
              const float li = 0.8f - 0.6f * expf(-0.3f * (float)layer); lam = expf(s0) - expf(s1) + li;
              att::Args A{(const bf16_t*)(ws + WS_Q), (const bf16_t*)(ws + WS_K), (const bf16_t*)(ws + WS_V), (const bf16_t*)(ws + WS_Z), Hb, p.in[11] + j * 128, lam, 1.f - li, layer == 3 ? 1024 : 1088, (unsigned*)(ws + WS_Y1) + (size_t)bid * 8 * 2048};
#ifndef SKIP_ATT
              att::attn_phase(A, lds, G, bid);
#endif
#ifdef PROBE_ATT2
              att::attn_phase(A, lds, G, bid);
#endif
            }
            GRID_SYNC();
            Wout = (const bf16_t*)(ws + WS_WDAOUT + (size_t)j * 2 * MiB);
        } else if constexpr (layer == 1) {
            { pg8::EpiFnT E{(bf16_t*)(ws + WS_ATL), (bf16_t*)(ws + WS_ATC)};
              GEMM_PHASE_EpiFnT(pg8::EpiFnT, ws + WS_WFNT, Hb, 2048, TT, 1024, E); }
            { pg8::EpiPlain E{(bf16_t*)(ws + WS_ZB), 1024};
              GEMM_PHASE_EpiPlain(pg8::EpiPlain, Hb, ws + WS_WFNZ, TT, 1024, 1024, E); }
            GRID_SYNC();
            fnet_fold((const bf16_t*)(ws + WS_ATL), (bf16_t*)(ws + WS_FOLD), (bf16_t*)(ws + WS_FOLD + 32 * MiB), (float*)(ws + WS_BZ), (const bf16_t*)(ws + WS_ZB), Hb, G, bid);
            GRID_SYNC();
            { pg8::EpiPlain E{(bf16_t*)(ws + WS_ATL), 8192};
              GEMM_PHASE_EpiPlain(pg8::EpiPlain, ws + WS_DFTL, ws + WS_FOLD, 2048, 8192, 2048, E); }
            GRID_SYNC();
            { pg8::EpiDftSym E{(const bf16_t*)(ws + WS_ATL), (const float*)(ws + WS_BZ), (const bf16_t*)(ws + WS_ZB), Hb};
              GEMM_PHASE(pg8::EpiDftSym, ws + WS_DFTL + 8 * MiB, ws + WS_FOLD + 32 * MiB, 2048, 8192, 2048, E); }
            { pg8::EpiDft E{(const bf16_t*)(ws + WS_ZB), Hb, TL, 256};
              GEMM_PHASE_EpiDft(pg8::EpiDft, ws + WS_DFTC, ws + WS_ATC, 256, 8192, 512, E); }
            GRID_SYNC();
            Wout = (const bf16_t*)(ws + WS_WFNOUT);
        } else {
            { pg8::EpiPlain E{(bf16_t*)(ws + WS_P), RWN};
              GEMM_PHASE_EpiPlain(pg8::EpiPlain, Hb, ws + WS_WRWIN, TT, RWN, 1024, E); }
            GRID_SYNC();
            RwArgs A{(const bf16_t*)(ws + WS_P), Hb, (bf16_t*)(ws + WS_Y1), (float*)(ws + WS_BZ), p.in[17], p.in[18], p.in[19], p.in[20], p.in[21], p.in[22], p.in[23], p.in[24]};
#ifndef SKIP_SCAN
            rwkv_scan(A, lds, G, bid);
#endif
#ifdef PROBE_SCAN2
            rwkv_scan(A, lds, G, bid);
#endif
            GRID_SYNC();
#ifndef SKIP_RWOUT
            rwkv_out(A, p.in[25], p.in[26], Hb, G, bid);
#endif
            GRID_SYNC();
            Wout = (const bf16_t*)(ws + WS_WRWOUT);
        }
        if constexpr (layer == 3) {
            pg8::EpiResid E{xl, xc, p.out, XC, modl + 2048, 0};
            GEMM_PHASE_EpiResid(pg8::EpiResid, Hb, Wout, TL, 1024, 1024, E);
            GRID_SYNC();
        } else {
            { pg8::EpiResid E{xl, xc, p.out, XC, modl + 2048, 0};
              GEMM_PHASE_EpiResid(pg8::EpiResid, Hb, Wout, TL, 1024, 1024, E); }
            GRID_SYNC();
            const float* gain_n = p.in[4] + (layer + 1) * 1024; const float* mod_n = mod + (size_t)(layer + 1) * 9 * 3072;
            const int nctx = 32;
            if (G > 2 * nctx) {
                if (bid < nctx) { const int G_real = G; { const int G = nctx; (void)G_real;
                    pg8::EpiResid E{xl, xc, p.out, XC, modl + 2048, TL};
                    GEMM_PHASE_EpiResid(pg8::EpiResid, Hb + (size_t)TL * 1024, Wout, TCX, 1024, 1024, E); } }
                else ph_phase(p.out, XC, gain_n, mod_n, Hb, G - nctx, bid - nctx, 0, TL);
                GRID_SYNC();
                ph_phase(p.out, XC, gain_n, mod_n, Hb, G, bid, TL, TT);
            } else {
                { pg8::EpiResid E{xl, xc, p.out, XC, modl + 2048, TL};
                  GEMM_PHASE_EpiResid(pg8::EpiResid, Hb + (size_t)TL * 1024, Wout, TCX, 1024, 1024, E); }
                GRID_SYNC();
                ph_phase(p.out, XC, gain_n, mod_n, Hb, G, bid);
            }
            GRID_SYNC();
        }
    }
__global__ void __launch_bounds__(512, 2) fwd_megakernel(Params p) {
    extern __shared__ __attribute__((aligned(16))) unsigned char lds_raw[];
    LAS char* lds = (LAS char*)lds_raw;
    cg::grid_group grid = cg::this_grid();
    const int G = gridDim.x, bid = blockIdx.x;
    volatile LAS unsigned* xst = (volatile LAS unsigned*)(lds + LDS_BYTES - 256);
    if (threadIdx.x < 2) xst[threadIdx.x] = 0u;
    __syncthreads();
    const XcdBarrier xbar = xcd_barrier_post((unsigned*)(p.ws + WS_CTL), xst);

#ifndef SKIP_PRO
    prologue(p, lds, G, bid);
#endif
#ifdef PROBE_PRO2
    __syncthreads(); prologue(p, lds, G, bid);
#endif
    grid.sync();
    layer_body<0>(p, lds, xbar, G, bid);
    layer_body<1>(p, lds, xbar, G, bid);
    layer_body<2>(p, lds, xbar, G, bid);
    layer_body<3>(p, lds, xbar, G, bid);
    final_phase(p.out, p.in[7], G, bid);
}

extern "C" void kernel_launch(void* const* d_in, const int* in_sizes, int n_in, void* d_out, int out_size, void* d_ws, size_t ws_size, hipStream_t stream) {
    static int grid = 0;
    if (grid == 0) {
        if (n_in != 28 || out_size != TL * 1024 || ws_size < WS_END) { fprintf(stderr, "kernel_launch: unexpected shapes: n_in %d out %d ws %zu\n", n_in, out_size, ws_size); grid = -1; return; }
        int dev = 0, cus = 0, per_cu = 0;
        hipGetDevice(&dev); hipDeviceGetAttribute(&cus, hipDeviceAttributeMultiprocessorCount, dev);
        if (hipFuncSetAttribute((const void*)fwd_megakernel, hipFuncAttributeMaxDynamicSharedMemorySize, LDS_BYTES) != hipSuccess) { fprintf(stderr, "kernel_launch: hipFuncSetAttribute failed\n"); grid = -1; return; }
        if (hipOccupancyMaxActiveBlocksPerMultiprocessor(&per_cu, (const void*)fwd_megakernel, 512, LDS_BYTES) != hipSuccess || per_cu < 1) { fprintf(stderr, "kernel_launch: occupancy query failed (%d)\n", per_cu); per_cu = 1; }
        (void)hipGetLastError();
        grid = cus * per_cu;
    }
    if (grid < 0) return;
    if (hipMemsetAsync((char*)d_ws + WS_CTL, 0, 65536, stream) != hipSuccess) { fprintf(stderr, "kernel_launch: hipMemsetAsync failed\n"); return; }
    Params p{};
    for (int i = 0; i < 28; ++i) p.in[i] = (const float*)d_in[i];
    p.out = (float*)d_out; p.ws = (unsigned char*)d_ws;
    void* args[] = {&p};
    hipError_t e = hipLaunchCooperativeKernel((const void*)fwd_megakernel, dim3(grid), dim3(512), args, LDS_BYTES, stream);
    if (e != hipSuccess) fprintf(stderr, "cooperative launch failed: %s (grid %d)\n", hipGetErrorString(e), grid);
}
```

```cpp
#include <hip/hip_runtime.h>
#include <hip/hip_cooperative_groups.h>
#include <cstdio>
#include <cstdint>
#include <cmath>
namespace cg = cooperative_groups;

constexpr int TL = 32768, TCX = 2048, TT = TL + TCX, DM = 1024;
constexpr float QK_C2 = 0.125f * 1.4426950408889634f;
typedef float f32x2_t __attribute__((ext_vector_type(2)));
typedef __bf16 bf16x2_t __attribute__((ext_vector_type(2)));
__device__ __forceinline__ unsigned pkbf(float lo, float hi) { f32x2_t v = {lo, hi}; bf16x2_t b = __builtin_convertvector(v, bf16x2_t); return __builtin_bit_cast(unsigned, b); }
__device__ __forceinline__ float bflo(unsigned u) { return __uint_as_float(u << 16); }
__device__ __forceinline__ float bfhi(unsigned u) { return __uint_as_float(u & 0xffff0000u); }
__device__ __forceinline__ float bf1(unsigned short u) { return __uint_as_float(((unsigned)u) << 16); }
__device__ __forceinline__ float silu_f(float z) { return z * __builtin_amdgcn_rcpf(1.f + __expf(-z)); }
__device__ __forceinline__ int opaque_tid() { int t = threadIdx.x; asm volatile("" : "+v"(t)); return t; }
namespace pg8 {
#define PG8_LAS __attribute__((address_space(3)))
typedef unsigned short bf16_t;
typedef short bf16x8 __attribute__((ext_vector_type(8)));
typedef float f32x4 __attribute__((ext_vector_type(4)));
typedef unsigned u32x4 __attribute__((ext_vector_type(4)));
constexpr int BM = 256, BK = 64, HALF = 128, HTB = HALF * BK * 2  , STAGE_BYTES = 8 * HTB, NXCD = 8, WGM = 8;

__host__ __device__ __forceinline__ int lds_byte(int r, int c) { const int st = (r >> 4) * 2 + (c >> 5), rr = r & 15, cc = c & 31, ob = rr * 64 + cc * 2; return st * 1024 + (ob ^ (((ob >> 9) & 1) << 5)); }
__host__ __device__ __forceinline__ void stage_rc(int b, int& R, int& C) { const int st = b / 1024, sb = b % 1024, swz = sb ^ (((sb >> 9) & 1) << 5); R = (st >> 1) * 16 + swz / 64; C = (st & 1) * 32 + (swz % 64) / 2; }
__host__ __device__ __forceinline__ int perm32(int rho) { const int n = rho >> 4, i = rho & 15; return 8 * (i >> 2) + 4 * n + (i & 3); }

struct Unit { int pm, pn; };
struct Gemm { const bf16_t* A; const bf16_t* Bt; int M, N, K; };

struct StaticOrder {
    int nM, nN, nwg, G, c;
    __host__ __device__ void init(int M, int N, int G_, int c_) { nM = M / BM; nN = N / BM; nwg = nM * nN; G = G_; c = c_; }
    __host__ __device__ bool next(int i, Unit& u) const {
        const long L = (long)i * G + c; if (L >= nwg) return false;
        int wgid = (int)L; { const int q = nwg / NXCD, r = nwg % NXCD, xcd = wgid % NXCD, off = wgid / NXCD; wgid = (xcd < r ? xcd * (q + 1) : r * (q + 1) + (xcd - r) * q) + off; }
        const int nig = WGM * nN, gid = wgid / nig, fm = gid * WGM, gsz = (nM - fm) < WGM ? (nM - fm) : WGM;
        u.pm = fm + ((wgid % nig) % gsz); u.pn = (wgid % nig) / gsz; return true;
    }
    __device__ __forceinline__ void a_ready(const Unit&) const {}
    __device__ __forceinline__ void done(const Unit&) const {}
};

struct EpiAttnIn {
    static constexpr bool PERM = true, AFTER_DRAIN = false;
    bf16_t* Q; bf16_t* Kb; bf16_t* V; bf16_t* Z; const float* ropeC; const float* ropeS;
    __device__ __forceinline__ void operator()(const f32x4 (&acc)[2][2][4][2], const Unit& u, int wr, int wc, int fr, int fq) const {
        const int sect = u.pn >> 2;
        bf16_t* base = sect == 0 ? Q : sect == 1 ? Kb : sect == 2 ? V : Z;
        const int colt = (u.pn & 3) * 256 + wc * 32 + 8 * fq;
        const int row0 = u.pm * BM + wr * 64 + fr;
        const bool rope = (u.pm < 128) && (sect < 2);
        const float sc = (sect == 0) ? QK_C2 : 1.f;
        const int axis = wc & 1;
#pragma unroll
        for (int ai = 0; ai < 2; ++ai)
#pragma unroll
            for (int m = 0; m < 4; ++m) {
                const int row = row0 + ai * HALF + m * 16;
                const int ntok = row & 4095;
                const int pos = axis ? (ntok & 63) : (ntok >> 6);
                bf16_t* rowp;
                if (sect == 1) rowp = base + (size_t)(row >> 6) * 65536 + (size_t)(colt >> 3) * 512 + (row & 63) * 8;
                else if (sect == 2) rowp = base + (size_t)(row >> 6) * 65536 + (size_t)(colt >> 7) * 8192 + (((colt & 127) >> 5) * 4 + ((row & 63) >> 4)) * 512 + (row & 15) * 32 + (colt & 31);
                else rowp = base + (size_t)row * 1024 + colt;
#pragma unroll
                for (int bj = 0; bj < 2; ++bj) {
                    f32x4 v0 = acc[ai][bj][m][0], v1 = acc[ai][bj][m][1];
                    if (rope) {
                        const f32x4 c0 = *(const f32x4*)(ropeC + pos * 16 + 8 * (fq & 1)), c1 = *(const f32x4*)(ropeC + pos * 16 + 8 * (fq & 1) + 4);
                        const f32x4 s0 = *(const f32x4*)(ropeS + pos * 16 + 8 * (fq & 1)), s1 = *(const f32x4*)(ropeS + pos * 16 + 8 * (fq & 1) + 4);
                        f32x4 p0, p1;
#pragma unroll
                        for (int i = 0; i < 4; ++i) { p0[i] = __shfl_xor(v0[i], 32); p1[i] = __shfl_xor(v1[i], 32); }
                        if (fq < 2) { v0 = v0 * c0 - p0 * s0; v1 = v1 * c1 - p1 * s1; }
                        else        { v0 = v0 * c0 + p0 * s0; v1 = v1 * c1 + p1 * s1; }
                    }
                    v0 = v0 * sc; v1 = v1 * sc;
                    u32x4 w; w.x = pkbf(v0[0], v0[1]); w.y = pkbf(v0[2], v0[3]); w.z = pkbf(v1[0], v1[1]); w.w = pkbf(v1[2], v1[3]);
                    *(u32x4*)(rowp + (sect == 1 || sect == 2 ? bj * 8192 : bj * HALF)) = w;
                }
            }
    }
};
struct EpiPlain {
    static constexpr bool PERM = true, AFTER_DRAIN = false;
    bf16_t* O; int ldc;
    __device__ __forceinline__ void operator()(const f32x4 (&acc)[2][2][4][2], const Unit& u, int wr, int wc, int fr, int fq) const {
        const int row0 = u.pm * BM + wr * 64 + fr, col0 = u.pn * BM + wc * 32 + 8 * fq;
#pragma unroll
        for (int ai = 0; ai < 2; ++ai)
#pragma unroll
            for (int m = 0; m < 4; ++m) { bf16_t* rowp = O + (size_t)(row0 + ai * HALF + m * 16) * ldc + col0;
#pragma unroll
                for (int bj = 0; bj < 2; ++bj) { const f32x4 v0 = acc[ai][bj][m][0], v1 = acc[ai][bj][m][1];
                    u32x4 w; w.x = pkbf(v0[0], v0[1]); w.y = pkbf(v0[2], v0[3]); w.z = pkbf(v1[0], v1[1]); w.w = pkbf(v1[2], v1[3]);
                    *(u32x4*)(rowp + bj * HALF) = w; } }
    }
};
struct EpiResid {
    static constexpr bool PERM = false, AFTER_DRAIN = false;
    const float* xin_lat; const float* xin_ctx; float* xout_lat; float* xout_ctx; const float* gate; int row_off;
    __device__ __forceinline__ void operator()(const f32x4 (&acc)[2][2][4][2], const Unit& u, int wr, int wc, int fr, int fq) const {
        const int rowt = row_off + u.pm * BM; const bool lat = rowt < TL; const int r = lat ? (rowt >> 12) : 8;
        const int row0 = rowt + wr * 64 + fr, col0 = u.pn * BM + wc * 32 + 4 * fq;
        const float* xi = lat ? xin_lat + (size_t)row0 * 1024 + col0 : xin_ctx + (size_t)(row0 - TL) * 1024 + col0;
        float* xo = lat ? xout_lat + (size_t)row0 * 1024 + col0 : xout_ctx + (size_t)(row0 - TL) * 1024 + col0;
        f32x4 g[2][2];
#pragma unroll
        for (int bj = 0; bj < 2; ++bj)
#pragma unroll
            for (int n = 0; n < 2; ++n) g[bj][n] = *(const f32x4*)(gate + r * 3072 + col0 + bj * HALF + n * 16);
#pragma unroll
        for (int ai = 0; ai < 2; ++ai) {
            f32x4 pre[4][2][2];
#pragma unroll
            for (int m = 0; m < 4; ++m)
#pragma unroll
                for (int bj = 0; bj < 2; ++bj)
#pragma unroll
                    for (int n = 0; n < 2; ++n) pre[m][bj][n] = *(const f32x4*)(xi + (size_t)(ai * HALF + m * 16) * 1024 + bj * HALF + n * 16);
            asm volatile("" ::: "memory");
#pragma unroll
            for (int m = 0; m < 4; ++m)
#pragma unroll
                for (int bj = 0; bj < 2; ++bj)
#pragma unroll
                    for (int n = 0; n < 2; ++n) *(f32x4*)(xo + (size_t)(ai * HALF + m * 16) * 1024 + bj * HALF + n * 16) = pre[m][bj][n] + g[bj][n] * acc[ai][bj][m][n];
            asm volatile("" ::: "memory");
        }
    }
};
struct EpiFnT {
    static constexpr bool PERM = true, AFTER_DRAIN = false;
    bf16_t* ATL; bf16_t* ATC;
    __device__ __forceinline__ void operator()(const f32x4 (&acc)[2][2][4][2], const Unit& u, int wr, int wc, int fr, int fq) const {
        const int row0 = u.pm * BM + wr * 64 + fr, col0 = u.pn * BM + wc * 32 + 8 * fq;
#pragma unroll
        for (int ai = 0; ai < 2; ++ai)
#pragma unroll
            for (int m = 0; m < 4; ++m) { const int mp = row0 + ai * HALF + m * 16, cs = mp >> 10, n = mp & 1023;
#pragma unroll
                for (int bj = 0; bj < 2; ++bj) { const int t0 = col0 + bj * HALF; bf16_t* dst;
                    if (t0 < TL) { const int b = t0 >> 12, l = t0 & 4095; dst = ATL + ((size_t)((b * 1024 + n) * 2 + cs)) * 4096 + l; }
                    else { const int tc = t0 - TL, b = tc >> 8, l = tc & 255; dst = ATC + ((size_t)((b * 1024 + n) * 2 + cs)) * 256 + l; }
                    const f32x4 v0 = acc[ai][bj][m][0], v1 = acc[ai][bj][m][1];
                    u32x4 w; w.x = pkbf(v0[0], v0[1]); w.y = pkbf(v0[2], v0[3]); w.z = pkbf(v1[0], v1[1]); w.w = pkbf(v1[2], v1[3]);
                    *(u32x4*)dst = w; } }
    }
};
struct EpiDft {
    static constexpr bool PERM = true, AFTER_DRAIN = false;
    const bf16_t* Z; bf16_t* OG; int rowbase; int L;
    __device__ __forceinline__ void operator()(const f32x4 (&acc)[2][2][4][2], const Unit& u, int wr, int wc, int fr, int fq) const {
        const int k0 = u.pm * BM + wr * 64 + fr; const int b = u.pn >> 2; const int n0 = (u.pn & 3) * 256 + wc * 32 + 8 * fq;
#pragma unroll
        for (int ai = 0; ai < 2; ++ai)
#pragma unroll
            for (int m = 0; m < 4; ++m) { const size_t R = (size_t)(rowbase + b * L + k0 + ai * HALF + m * 16);
#pragma unroll
                for (int bj = 0; bj < 2; ++bj) { const size_t off = R * 1024 + n0 + bj * HALF;
                    const u32x4 zz = *(const u32x4*)(Z + off);
                    const f32x4 v0 = acc[ai][bj][m][0], v1 = acc[ai][bj][m][1];
                    u32x4 w;
                    w.x = pkbf(v0[0] * silu_f(bflo(zz.x)), v0[1] * silu_f(bfhi(zz.x))); w.y = pkbf(v0[2] * silu_f(bflo(zz.y)), v0[3] * silu_f(bfhi(zz.y)));
                    w.z = pkbf(v1[0] * silu_f(bflo(zz.z)), v1[1] * silu_f(bfhi(zz.z))); w.w = pkbf(v1[2] * silu_f(bflo(zz.w)), v1[3] * silu_f(bfhi(zz.w)));
                    *(u32x4*)(OG + off) = w; } }
    }
};
struct EpiDftSym {
    static constexpr bool PERM = true, AFTER_DRAIN = false;
    const bf16_t* Pb; const float* TA; const bf16_t* Z; bf16_t* OG;
    __device__ __forceinline__ void operator()(const f32x4 (&acc)[2][2][4][2], const Unit& u, int wr, int wc, int fr, int fq) const {
        const int k0 = u.pm * BM + wr * 64 + fr; const int b = u.pn >> 2; const int c0 = u.pn * BM + wc * 32 + 8 * fq; const int n0 = c0 & 1023;
#pragma unroll
        for (int bj = 0; bj < 2; ++bj) {
            const f32x4 t0 = *(const f32x4*)(TA + c0 + bj * HALF), t1 = *(const f32x4*)(TA + c0 + bj * HALF + 4);
#pragma unroll
            for (int aim = 0; aim < 4; ++aim) { const int ai = aim >> 1, mh = (aim & 1) * 2;
                u32x4 pp[4], z1[4], z2[4];
#pragma unroll
                for (int m = mh; m < mh + 2; ++m) { const int k = k0 + ai * HALF + m * 16;
                    pp[m] = *(const u32x4*)(Pb + (size_t)k * 8192 + c0 + bj * HALF);
                    z1[m] = *(const u32x4*)(Z + (size_t)(b * 4096 + k) * 1024 + n0 + bj * HALF);
                    z2[m] = *(const u32x4*)(Z + (size_t)(b * 4096 + ((4096 - k) & 4095)) * 1024 + n0 + bj * HALF); }
                asm volatile("" ::: "memory");
#pragma unroll
                for (int m = mh; m < mh + 2; ++m) { const int k = k0 + ai * HALF + m * 16; const float sg = (k & 1) ? -1.f : 1.f;
                    const f32x4 q0 = acc[ai][bj][m][0], q1 = acc[ai][bj][m][1];
                    float pt[8];
                    pt[0] = bflo(pp[m].x) + sg * t0[0]; pt[1] = bfhi(pp[m].x) + sg * t0[1]; pt[2] = bflo(pp[m].y) + sg * t0[2]; pt[3] = bfhi(pp[m].y) + sg * t0[3];
                    pt[4] = bflo(pp[m].z) + sg * t1[0]; pt[5] = bfhi(pp[m].z) + sg * t1[1]; pt[6] = bflo(pp[m].w) + sg * t1[2]; pt[7] = bfhi(pp[m].w) + sg * t1[3];
                    { const size_t off = (size_t)(b * 4096 + k) * 1024 + n0 + bj * HALF; const u32x4 zz = z1[m]; u32x4 w;
                      w.x = pkbf((pt[0] - q0[0]) * silu_f(bflo(zz.x)), (pt[1] - q0[1]) * silu_f(bfhi(zz.x))); w.y = pkbf((pt[2] - q0[2]) * silu_f(bflo(zz.y)), (pt[3] - q0[3]) * silu_f(bfhi(zz.y)));
                      w.z = pkbf((pt[4] - q1[0]) * silu_f(bflo(zz.z)), (pt[5] - q1[1]) * silu_f(bfhi(zz.z))); w.w = pkbf((pt[6] - q1[2]) * silu_f(bflo(zz.w)), (pt[7] - q1[3]) * silu_f(bfhi(zz.w)));
                      *(u32x4*)(OG + off) = w; }
                    if (k >= 1) { const size_t off = (size_t)(b * 4096 + 4096 - k) * 1024 + n0 + bj * HALF; const u32x4 zz = z2[m]; u32x4 w;
                      w.x = pkbf((pt[0] + q0[0]) * silu_f(bflo(zz.x)), (pt[1] + q0[1]) * silu_f(bfhi(zz.x))); w.y = pkbf((pt[2] + q0[2]) * silu_f(bflo(zz.y)), (pt[3] + q0[3]) * silu_f(bfhi(zz.y)));
                      w.z = pkbf((pt[4] + q1[0]) * silu_f(bflo(zz.z)), (pt[5] + q1[1]) * silu_f(bfhi(zz.z))); w.w = pkbf((pt[6] + q1[2]) * silu_f(bflo(zz.w)), (pt[7] + q1[3]) * silu_f(bfhi(zz.w)));
                      *(u32x4*)(OG + off) = w; }
                }
                asm volatile("" ::: "memory");
            }
        }
    }
};
template <class Epi, class Sched, bool ALIGN_EPI = false, bool SP2 = false>
__device__ __forceinline__ void gemm_phase(PG8_LAS unsigned char* lds, const Gemm g, const Sched& S, const Epi& E) {
    const int tid = opaque_tid(), wid = __builtin_amdgcn_readfirstlane(tid >> 6), lane = tid & 63, wr = wid >> 2, wc = wid & 3, fr = lane & 15, fq = lane >> 4;
    const int K = g.K, nt = K / BK;
    unsigned voffA[2], voffB[2];
#pragma unroll
    for (int i = 0; i < 2; ++i) { int R, C; stage_rc(tid * 16 + i * 8192, R, C); const int Rb = Epi::PERM ? ((R & ~31) + perm32(R & 31)) : R;
        voffA[i] = (unsigned)(R * K + C) * 2u; voffB[i] = (unsigned)(Rb * K + C) * 2u; }
    const size_t kstep = (size_t)(BK * 2);
    const size_t hstep = (size_t)HALF * K * 2;
    const size_t tstep = 2 * hstep;
    const unsigned ldsw = (unsigned)wid * 1024u;
    const int aoff = lds_byte(wr * 64 + fr, fq * 8), boff = lds_byte(wc * 32 + fr, fq * 8);
#define PG8_SA(b, h) (((b) * 2 + (h)) * HTB)
#define PG8_SB(b, h) ((4 + (b) * 2 + (h)) * HTB)
#define PG8_STAGE(bufoff, gbase, voff) do { _Pragma("unroll") for (int _i = 0; _i < 2; ++_i) \
        __builtin_amdgcn_global_load_lds((const unsigned*)((const char*)(gbase) + (voff)[_i]), (PG8_LAS unsigned*)(lds + (bufoff) + ldsw + _i * 8192), 16, 0, 0); } while (0)
#define PG8_LDA(dst, b, h) do { _Pragma("unroll") for (int m = 0; m < 4; ++m) _Pragma("unroll") for (int k = 0; k < 2; ++k) dst[m][k] = *(const PG8_LAS bf16x8*)(lds + PG8_SA(b, h) + aoff + m * 2048 + k * 1024); } while (0)
#define PG8_LDB(dst, b, h) do { _Pragma("unroll") for (int n = 0; n < 2; ++n) _Pragma("unroll") for (int k = 0; k < 2; ++k) dst[n][k] = *(const PG8_LAS bf16x8*)(lds + PG8_SB(b, h) + boff + n * 2048 + k * 1024); } while (0)
#define PG8_MMA(ai, bj, At, Bt) do { __builtin_amdgcn_s_setprio(1); _Pragma("unroll") for (int m = 0; m < 4; ++m) _Pragma("unroll") for (int n = 0; n < 2; ++n) _Pragma("unroll") for (int k = 0; k < 2; ++k) \
        acc[ai][bj][m][n] = __builtin_amdgcn_mfma_f32_16x16x32_bf16(Bt[n][k], At[m][k], acc[ai][bj][m][n], 0, 0, 0); __builtin_amdgcn_s_setprio(0); } while (0)
#define PG8_WAIT_V(n) asm volatile("s_waitcnt vmcnt(" #n ")" ::: "memory")
#define PG8_WAIT_L(n) asm volatile("s_waitcnt lgkmcnt(" #n ")" ::: "memory")
#define PG8_BAR __builtin_amdgcn_s_barrier()
#define PG8_SCHED __builtin_amdgcn_sched_barrier(0)
    Unit cur, nxt; int ui = 0;
    if (!S.next(0, cur)) return;
    f32x4 acc[2][2][4][2];
#pragma unroll
    for (int a = 0; a < 2; ++a)
#pragma unroll
        for (int b = 0; b < 2; ++b)
#pragma unroll
            for (int m = 0; m < 4; ++m)
#pragma unroll
                for (int n = 0; n < 2; ++n) acc[a][b][m][n] = (f32x4){0.f, 0.f, 0.f, 0.f};
    bf16x8 At[4][2], B0[2][2], B1[2][2];
    const char* cA = (const char*)g.A + (size_t)cur.pm * tstep; const char* cB = (const char*)g.Bt + (size_t)cur.pn * tstep;
    S.a_ready(cur);
    if constexpr (SP2) {
        PG8_STAGE(PG8_SB(0, 0), cB, voffB); PG8_STAGE(PG8_SB(0, 1), cB + hstep, voffB); PG8_STAGE(PG8_SA(0, 0), cA, voffA); PG8_STAGE(PG8_SA(0, 1), cA + hstep, voffA);
        if (wr == 1) PG8_BAR;
        PG8_WAIT_V(2); PG8_BAR;
        PG8_STAGE(PG8_SB(1, 0), cB + kstep, voffB); PG8_STAGE(PG8_SA(1, 0), cA + kstep, voffA); PG8_STAGE(PG8_SB(1, 1), cB + hstep + kstep, voffB);
        PG8_WAIT_V(6); PG8_BAR;
    } else {
        PG8_STAGE(PG8_SB(0, 0), cB, voffB); PG8_STAGE(PG8_SA(0, 0), cA, voffA); PG8_STAGE(PG8_SB(0, 1), cB + hstep, voffB); PG8_STAGE(PG8_SA(0, 1), cA + hstep, voffA);
        if (wr == 1) PG8_BAR;
        PG8_WAIT_V(4); PG8_BAR;
        PG8_STAGE(PG8_SB(1, 0), cB + kstep, voffB); PG8_STAGE(PG8_SA(1, 0), cA + kstep, voffA); PG8_STAGE(PG8_SB(1, 1), cB + hstep + kstep, voffB);
        PG8_WAIT_V(6); PG8_BAR;
    }
    for (;;) {
        const bool has_next = S.next(ui + 1, nxt);
        const char* nA = has_next ? (const char*)g.A + (size_t)nxt.pm * tstep : cA; const char* nB = has_next ? (const char*)g.Bt + (size_t)nxt.pn * tstep : cB;
        for (int t = 0; t < nt; t += 2) {
            const bool last = (t == nt - 2);
            const char* a1 = cA + (size_t)(t + 1) * kstep;
            const char* a2 = last ? nA : cA + (size_t)(t + 2) * kstep; const char* b2 = last ? nB : cB + (size_t)(t + 2) * kstep;
            const char* a3 = a2 + kstep; const char* b3 = b2 + kstep;
            if (last && has_next) S.a_ready(nxt);
            if constexpr (SP2) {
            PG8_LDB(B0, 0, 0); PG8_LDB(B1, 0, 1); PG8_SCHED; PG8_LDA(At, 0, 0); PG8_STAGE(PG8_SA(1, 1), a1 + hstep, voffA);
            PG8_WAIT_V(8); PG8_WAIT_L(0); PG8_BAR; PG8_MMA(0, 0, At, B0); PG8_MMA(0, 1, At, B1); PG8_BAR; PG8_SCHED;
            PG8_LDA(At, 0, 1); PG8_STAGE(PG8_SB(0, 0), b2, voffB); PG8_STAGE(PG8_SB(0, 1), b2 + hstep, voffB); PG8_STAGE(PG8_SA(0, 0), a2, voffA);
            PG8_WAIT_V(8); PG8_WAIT_L(0); PG8_BAR; PG8_MMA(1, 0, At, B0); PG8_MMA(1, 1, At, B1); PG8_BAR; PG8_SCHED;
            PG8_LDB(B0, 1, 0); PG8_LDB(B1, 1, 1); PG8_SCHED; PG8_LDA(At, 1, 0); PG8_STAGE(PG8_SA(0, 1), a2 + hstep, voffA);
            PG8_WAIT_V(8); PG8_WAIT_L(0); PG8_BAR; PG8_MMA(0, 0, At, B0); PG8_MMA(0, 1, At, B1); PG8_BAR; PG8_SCHED;
            PG8_LDA(At, 1, 1); PG8_STAGE(PG8_SB(1, 0), b3, voffB); PG8_STAGE(PG8_SB(1, 1), b3 + hstep, voffB); PG8_STAGE(PG8_SA(1, 0), a3, voffA);
            PG8_WAIT_V(8); PG8_WAIT_L(0); PG8_BAR; PG8_MMA(1, 0, At, B0); PG8_MMA(1, 1, At, B1); PG8_BAR; PG8_SCHED;
            } else {
            PG8_LDB(B0, 0, 0); PG8_SCHED; PG8_LDA(At, 0, 0); PG8_STAGE(PG8_SA(1, 1), a1 + hstep, voffA);
            PG8_WAIT_L(8); PG8_BAR; PG8_WAIT_L(0); PG8_MMA(0, 0, At, B0); PG8_BAR; PG8_SCHED;
            PG8_LDB(B1, 0, 1); PG8_STAGE(PG8_SB(0, 0), b2, voffB);
            PG8_BAR; PG8_WAIT_L(0); PG8_MMA(0, 1, At, B1); PG8_BAR;
            PG8_LDA(At, 0, 1); PG8_STAGE(PG8_SA(0, 0), a2, voffA);
            PG8_BAR; PG8_WAIT_L(0); PG8_MMA(1, 0, At, B0); PG8_BAR; PG8_SCHED;
            PG8_STAGE(PG8_SB(0, 1), b2 + hstep, voffB);
            PG8_WAIT_V(6); PG8_BAR; PG8_MMA(1, 1, At, B1); PG8_BAR;
            PG8_LDB(B0, 1, 0); PG8_SCHED; PG8_LDA(At, 1, 0); PG8_STAGE(PG8_SA(0, 1), a2 + hstep, voffA);
            PG8_WAIT_L(8); PG8_BAR; PG8_WAIT_L(0); PG8_MMA(0, 0, At, B0); PG8_BAR; PG8_SCHED;
            PG8_LDB(B1, 1, 1); PG8_STAGE(PG8_SB(1, 0), b3, voffB);
            PG8_BAR; PG8_WAIT_L(0); PG8_MMA(0, 1, At, B1); PG8_BAR;
            PG8_LDA(At, 1, 1); PG8_STAGE(PG8_SA(1, 0), a3, voffA);
            PG8_BAR; PG8_WAIT_L(0); PG8_MMA(1, 0, At, B0); PG8_BAR; PG8_SCHED;
            PG8_STAGE(PG8_SB(1, 1), b3 + hstep, voffB);
            PG8_WAIT_V(6); PG8_BAR; PG8_MMA(1, 1, At, B1); PG8_BAR;
            }
        }
        if constexpr (ALIGN_EPI) { if (wr == 0) PG8_BAR; }
        if constexpr (!Epi::AFTER_DRAIN) { E(acc, cur, wr, wc, fr, fq); S.done(cur); }
        if (!has_next) break;
#pragma unroll
        for (int a = 0; a < 2; ++a)
#pragma unroll
            for (int b = 0; b < 2; ++b)
#pragma unroll
                for (int m = 0; m < 4; ++m)
#pragma unroll
                    for (int n = 0; n < 2; ++n) acc[a][b][m][n] = (f32x4){0.f, 0.f, 0.f, 0.f};
        cur = nxt; cA = nA; cB = nB; ++ui;
        if constexpr (ALIGN_EPI) { if (wr == 1) PG8_BAR; }
    }
    PG8_WAIT_V(0);
    if constexpr (!ALIGN_EPI) { if (wr == 0) PG8_BAR; }
    PG8_BAR;
    if constexpr (Epi::AFTER_DRAIN) { E.fused(acc, cur, wr, wc, fr, fq, lds, wid, lane); S.done(cur); }
#undef PG8_SA
#undef PG8_SB
#undef PG8_STAGE
#undef PG8_LDA
#undef PG8_LDB
#undef PG8_MMA
#undef PG8_WAIT_V
#undef PG8_WAIT_L
#undef PG8_BAR
#undef PG8_SCHED
}
}
#define LAS __attribute__((address_space(3)))
namespace att {
using bf16x8 = __attribute__((ext_vector_type(8))) short;
using s16x4 = __attribute__((ext_vector_type(4))) short;
using f32x16 = __attribute__((ext_vector_type(16))) float;
using u32x4 = __attribute__((ext_vector_type(4))) unsigned;
typedef unsigned short bf16_t;
__device__ __forceinline__ int crow(int r, int hi) { return (r & 3) + 8 * (r >> 2) + 4 * hi; }
typedef float f32x4_t __attribute__((ext_vector_type(4)));
template <int CTRL> __device__ __forceinline__ float adpp(float v) { return __int_as_float(__builtin_amdgcn_update_dpp(0, __float_as_int(v), CTRL, 0xf, 0xf, true)); }
constexpr int KSLOT = 8192, VSLOT = 16384, LDS_K = 0, LDS_V = 3 * KSLOT, LDS_WS = LDS_V + 4 * VSLOT, LDS_CNT = LDS_WS + 2048;
struct Args { const bf16_t* Q; const bf16_t* K; const bf16_t* V; const bf16_t* Z; bf16_t* O; const float* gain; float lam; float oml; int n_units; unsigned* o1g; };

__device__ __forceinline__ void qkt(f32x16& p0, f32x16& p1, const LAS char* Kslot, const bf16x8* qr, const f32x16& negm, int r32, int hi) {
    const LAS char* kb = Kslot + hi * 1024 + r32 * 16;
    bf16x8 kf[8];
#pragma unroll
    for (int d0 = 0; d0 < 4; ++d0) { kf[2 * d0] = *(const LAS bf16x8*)(kb + d0 * 2048); kf[2 * d0 + 1] = *(const LAS bf16x8*)(kb + d0 * 2048 + 512); }
    asm volatile("s_waitcnt lgkmcnt(0)" ::: "memory"); __builtin_amdgcn_sched_barrier(0);
    p0 = __builtin_amdgcn_mfma_f32_32x32x16_bf16(kf[0], qr[0], negm, 0, 0, 0); p1 = __builtin_amdgcn_mfma_f32_32x32x16_bf16(kf[1], qr[0], negm, 0, 0, 0);
#pragma unroll
    for (int d0 = 1; d0 < 4; ++d0) { p0 = __builtin_amdgcn_mfma_f32_32x32x16_bf16(kf[2 * d0], qr[d0], p0, 0, 0, 0); p1 = __builtin_amdgcn_mfma_f32_32x32x16_bf16(kf[2 * d0 + 1], qr[d0], p1, 0, 0, 0); }
}
__device__ __forceinline__ void kload(bf16x8* kf, const LAS char* Kslot, int r32, int hi) {
    const LAS char* kb = Kslot + hi * 1024 + r32 * 16;
#pragma unroll
    for (int d0 = 0; d0 < 2; ++d0) { kf[2 * d0] = *(const LAS bf16x8*)(kb + d0 * 2048); kf[2 * d0 + 1] = *(const LAS bf16x8*)(kb + d0 * 2048 + 512); }
}
__device__ __forceinline__ void qk_mm(f32x16& p0, f32x16& p1, const bf16x8* kf, const LAS char* Kslot, int r32, int hi, const bf16x8* qr, const f32x16& z) {
    const LAS char* kb = Kslot + hi * 1024 + r32 * 16;
    p0 = __builtin_amdgcn_mfma_f32_32x32x16_bf16(kf[0], qr[0], z, 0, 0, 0); p1 = __builtin_amdgcn_mfma_f32_32x32x16_bf16(kf[1], qr[0], z, 0, 0, 0);
    p0 = __builtin_amdgcn_mfma_f32_32x32x16_bf16(kf[2], qr[1], p0, 0, 0, 0); p1 = __builtin_amdgcn_mfma_f32_32x32x16_bf16(kf[3], qr[1], p1, 0, 0, 0);
    bf16x8 kg[4];
#pragma unroll
    for (int d0 = 2; d0 < 4; ++d0) { kg[2 * (d0 - 2)] = *(const LAS bf16x8*)(kb + d0 * 2048); kg[2 * (d0 - 2) + 1] = *(const LAS bf16x8*)(kb + d0 * 2048 + 512); }
    p0 = __builtin_amdgcn_mfma_f32_32x32x16_bf16(kg[0], qr[2], p0, 0, 0, 0); p1 = __builtin_amdgcn_mfma_f32_32x32x16_bf16(kg[1], qr[2], p1, 0, 0, 0);
    p0 = __builtin_amdgcn_mfma_f32_32x32x16_bf16(kg[2], qr[3], p0, 0, 0, 0); p1 = __builtin_amdgcn_mfma_f32_32x32x16_bf16(kg[3], qr[3], p1, 0, 0, 0);
}
__device__ __forceinline__ float max3a(float a, float b, float c) { float r; asm("v_max3_f32 %0, %1, %2, %3" : "=v"(r) : "v"(a), "v"(b), "v"(c)); return r; }
__device__ __forceinline__ float rowmax(const f32x16& p0, const f32x16& p1) {
    float a = max3a(p0[0], p0[1], p0[2]), b = max3a(p1[0], p1[1], p1[2]);
#pragma unroll
    for (int r = 3; r < 15; r += 2) { a = max3a(a, p0[r], p0[r + 1]); b = max3a(b, p1[r], p1[r + 1]); }
    a = max3a(a, p0[15], p1[15]);
    float m; asm("v_max_f32 %0, %1, %2" : "=v"(m) : "v"(a), "v"(b));
    asm volatile("s_nop 1" ::: "memory");
    auto rr = __builtin_amdgcn_permlane32_swap(__float_as_uint(m), __float_as_uint(m), false, false);
    float o; asm("v_max_f32 %0, %1, %2" : "=v"(o) : "v"(__uint_as_float(rr[0])), "v"(__uint_as_float(rr[1])));
    return o;
}
#define ATT_VRD(buf, d0) do { _Pragma("unroll") for (int ks = 0; ks < 4; ++ks) { \
        asm volatile("ds_read_b64_tr_b16 %0,%1 offset:%c2" : "=&v"(lo[buf][ks]) : "v"(vb), "i"((d0) * 4096 + ks * 1024) : "memory"); \
        asm volatile("ds_read_b64_tr_b16 %0,%1 offset:%c2" : "=&v"(hi[buf][ks]) : "v"(vb), "i"((d0) * 4096 + ks * 1024 + 512) : "memory"); } } while (0)
#define ATT_PK(b, k) (bf16x8){lo[b][k][0], lo[b][k][1], lo[b][k][2], lo[b][k][3], hi[b][k][0], hi[b][k][1], hi[b][k][2], hi[b][k][3]}
#define ATT_MM2(da, db) do { \
        o[da] = __builtin_amdgcn_mfma_f32_32x32x16_bf16(pa0, ATT_PK(0, 0), o[da], 0, 0, 0); o[db] = __builtin_amdgcn_mfma_f32_32x32x16_bf16(pa0, ATT_PK(1, 0), o[db], 0, 0, 0); \
        o[da] = __builtin_amdgcn_mfma_f32_32x32x16_bf16(pa1, ATT_PK(0, 1), o[da], 0, 0, 0); o[db] = __builtin_amdgcn_mfma_f32_32x32x16_bf16(pa1, ATT_PK(1, 1), o[db], 0, 0, 0); \
        o[da] = __builtin_amdgcn_mfma_f32_32x32x16_bf16(pa2, ATT_PK(0, 2), o[da], 0, 0, 0); o[db] = __builtin_amdgcn_mfma_f32_32x32x16_bf16(pa2, ATT_PK(1, 2), o[db], 0, 0, 0); \
        o[da] = __builtin_amdgcn_mfma_f32_32x32x16_bf16(pa3, ATT_PK(0, 3), o[da], 0, 0, 0); o[db] = __builtin_amdgcn_mfma_f32_32x32x16_bf16(pa3, ATT_PK(1, 3), o[db], 0, 0, 0); } while (0)
__device__ __forceinline__ void pv(f32x16* o, int vb, bf16x8 pa0, bf16x8 pa1, bf16x8 pa2, bf16x8 pa3) {
    s16x4 lo[2][4], hi[2][4];
    ATT_VRD(0, 0);
    ATT_VRD(1, 1);
    asm volatile("s_waitcnt lgkmcnt(0)" ::: "memory"); __builtin_amdgcn_sched_barrier(0);
    ATT_MM2(0, 1); __builtin_amdgcn_sched_barrier(0);
    ATT_VRD(0, 2);
    ATT_VRD(1, 3);
    asm volatile("s_waitcnt lgkmcnt(0)" ::: "memory"); __builtin_amdgcn_sched_barrier(0);
    ATT_MM2(2, 3);
}
#undef ATT_MM2
#undef ATT_VRD
#undef ATT_PK
__device__ __forceinline__ void attn_pass(const Args& A, int z, int b, int h, int qrow0, bool isctx, bool pathB, LAS char* shm, f32x16* o) {
    const int tid = opaque_tid(), lane = tid & 63, r32 = lane & 31, hi = lane >> 5; const int wid = __builtin_amdgcn_readfirstlane(tid >> 6);
    const int NT = isctx ? 4 : 68;
    LAS float* wsf = (LAS float*)(shm + LDS_WS) + wid * 64;
    const int vb0 = (int)(unsigned)(size_t)(shm + LDS_V) + ((lane >> 4) & 1) * 32 + (lane & 3) * 8 + (4 * hi + ((lane & 15) >> 2)) * 64;
    const bf16_t* Qw = A.Q + (size_t)(qrow0 + wid * 32 + r32) * 1024 + h * 128 + z * 64;
    bf16x8 qr[4];
#pragma unroll
    for (int d0 = 0; d0 < 4; ++d0) qr[d0] = *(const bf16x8*)(Qw + d0 * 16 + hi * 8);
    const bf16_t* Kh = A.K + (size_t)((h * 2 + z) * 8 + wid) * 512 + lane * 8;
    const int pc0 = wid, pc1 = wid + 8;
    const bf16_t* Vh0 = A.V + (size_t)h * 8192 + pc0 * 512 + lane * 8;
    const bf16_t* Vh1 = A.V + (size_t)h * 8192 + pc1 * 512 + lane * 8;
    const int ctxrow = TL + b * 256, latrow = b * 4096;
#define ATT_TROW(t) ((isctx || (t) < 4) ? (ctxrow + 64 * (t)) : (latrow + 64 * ((t) - 4)))
#define ATT_DMA(t, slot, vslot) do { const size_t ro_ = (size_t)(ATT_TROW(t) >> 6) * 65536; \
        __builtin_amdgcn_global_load_lds((const unsigned*)(Kh + ro_), (LAS unsigned*)(shm + LDS_K + (slot) * KSLOT + wid * 1024), 16, 0, 0); \
        __builtin_amdgcn_global_load_lds((const unsigned*)(Vh0 + ro_), (LAS unsigned*)(shm + LDS_V + (vslot) * VSLOT + pc0 * 1024), 16, 0, 0); \
        __builtin_amdgcn_global_load_lds((const unsigned*)(Vh1 + ro_), (LAS unsigned*)(shm + LDS_V + (vslot) * VSLOT + pc1 * 1024), 16, 0, 0); } while (0)
    float mhat = 0.f, l_reg = 0.f;
    const f32x16 negm = f32x16{};
#pragma unroll
    for (int d = 0; d < 4; ++d) o[d] = f32x16{};
    ATT_DMA(0, 0, 0);
    if (NT > 1) ATT_DMA(1, 1, 1);
    asm volatile("s_waitcnt vmcnt(0) lgkmcnt(0)\n\ts_barrier" ::: "memory");
    f32x16 sc0, sc1;
    { bf16x8 kf[4]; kload(kf, shm + LDS_K, r32, hi); qk_mm(sc0, sc1, kf, shm + LDS_K, r32, hi, qr, negm); asm volatile("s_nop 15\n\ts_nop 15" : "+v"(sc0), "+v"(sc1)); }
    if (NT > 2) ATT_DMA(2, 2, 2);
    int k_cur = 0, v_cur = 0, v_prev = 3;
    u32x4 pw0 = {0u, 0u, 0u, 0u}, pw1 = pw0, pw2 = pw0, pw3 = pw0;
#pragma unroll 1
    for (int t = 0; t <= NT; ++t) {
        const int k_n1 = (k_cur == 2) ? 0 : k_cur + 1;
        if (t > 0) {
            asm volatile("s_waitcnt vmcnt(0) lgkmcnt(0)\n\ts_barrier" ::: "memory");
            const int k_p2 = (k_cur == 0) ? 2 : k_cur - 1;
            const int v_p2 = (v_cur + 2) & 3;
            if (t + 2 < NT) ATT_DMA(t + 2, k_p2, v_p2);
        }
        if (pathB && t > 0) {
            pv(o, vb0 + v_prev * VSLOT, __builtin_bit_cast(bf16x8, pw0), __builtin_bit_cast(bf16x8, pw1), __builtin_bit_cast(bf16x8, pw2), __builtin_bit_cast(bf16x8, pw3)); }
        if (t < NT) {
        const float rm = rowmax(sc0, sc1);
        if (t == 0 || __any(rm > 8.f)) {
            const float dl = (t == 0) ? rm : fmaxf(rm, 0.f); mhat += dl;
#pragma unroll
            for (int r = 0; r < 16; ++r) { sc0[r] -= dl; sc1[r] -= dl; }
            if (t > 0) {
                const float f = __builtin_amdgcn_exp2f(-dl); l_reg *= f;
                if (hi == 0) wsf[r32] = f;
                asm volatile("s_waitcnt lgkmcnt(0)" ::: "memory");
#pragma unroll
                for (int r = 0; r < 16; ++r) { const float fr_ = wsf[crow(r, hi)];
#pragma unroll
                    for (int d = 0; d < 4; ++d) o[d][r] *= fr_; }
                asm volatile("s_waitcnt lgkmcnt(0)" ::: "memory");
            }
        }
        bf16x8 kf[4];
        kload(kf, shm + LDS_K + k_n1 * KSLOT, r32, hi);
        __builtin_amdgcn_sched_barrier(0);
        f32x16 pn0, pn1;
        { f32x16 nm;
#pragma unroll
          for (int r = 0; r < 16; ++r) nm[r] = -mhat;
          qk_mm(pn0, pn1, kf, shm + LDS_K + k_n1 * KSLOT, r32, hi, qr, nm); }
        f32x2_t sacc = {0.f, 0.f};
#pragma unroll
        for (int r = 0; r < 16; r += 2) { sc0[r] = __builtin_amdgcn_exp2f(sc0[r]); sc0[r + 1] = __builtin_amdgcn_exp2f(sc0[r + 1]); sc1[r] = __builtin_amdgcn_exp2f(sc1[r]); sc1[r + 1] = __builtin_amdgcn_exp2f(sc1[r + 1]);
            sacc += (f32x2_t){sc0[r], sc0[r + 1]}; sacc += (f32x2_t){sc1[r], sc1[r + 1]}; }
        l_reg += sacc.x + sacc.y;
        pw0 = (u32x4){pkbf(sc0[0], sc0[1]), pkbf(sc0[2], sc0[3]), pkbf(sc0[4], sc0[5]), pkbf(sc0[6], sc0[7])};
        pw1 = (u32x4){pkbf(sc0[8], sc0[9]), pkbf(sc0[10], sc0[11]), pkbf(sc0[12], sc0[13]), pkbf(sc0[14], sc0[15])};
        pw2 = (u32x4){pkbf(sc1[0], sc1[1]), pkbf(sc1[2], sc1[3]), pkbf(sc1[4], sc1[5]), pkbf(sc1[6], sc1[7])};
        pw3 = (u32x4){pkbf(sc1[8], sc1[9]), pkbf(sc1[10], sc1[11]), pkbf(sc1[12], sc1[13]), pkbf(sc1[14], sc1[15])};
#pragma unroll
        for (int i = 0; i < 8; ++i) { __builtin_amdgcn_sched_group_barrier(0x008, 1, 0); __builtin_amdgcn_sched_group_barrier(0x002, 10, 0); }
        __builtin_amdgcn_sched_barrier(0);
        if (!pathB) {
            pv(o, vb0 + v_cur * VSLOT, __builtin_bit_cast(bf16x8, pw0), __builtin_bit_cast(bf16x8, pw1), __builtin_bit_cast(bf16x8, pw2), __builtin_bit_cast(bf16x8, pw3)); }
        sc0 = pn0; sc1 = pn1;
        }
        k_cur = k_n1; v_prev = v_cur; v_cur = (v_cur + 1) & 3;
    }
    asm volatile("s_waitcnt lgkmcnt(0)\n\ts_barrier" ::: "memory");
#undef ATT_DMA
#undef ATT_TROW
    { auto rr = __builtin_amdgcn_permlane32_swap(__float_as_uint(l_reg), __float_as_uint(l_reg), false, false); l_reg = __uint_as_float(rr[0]) + __uint_as_float(rr[1]); }
    asm volatile("s_waitcnt lgkmcnt(0)" ::: "memory");
    if (hi == 0) wsf[32 + r32] = l_reg;
    asm volatile("s_waitcnt lgkmcnt(0)" ::: "memory");
#pragma unroll
    for (int r = 0; r < 16; ++r) { const float rl = 1.0f / wsf[32 + crow(r, hi)];
#pragma unroll
        for (int d = 0; d < 4; ++d) o[d][r] *= rl; }
    asm volatile("s_waitcnt lgkmcnt(0)" ::: "memory");
}
__device__ __forceinline__ void attn_unit(const Args& A, int b, int h, int qb, bool isctx, bool pathB, LAS char* shm) {
    const int tid = opaque_tid(), lane = tid & 63, r32 = lane & 31, hi = lane >> 5; const int wid = __builtin_amdgcn_readfirstlane(tid >> 6);
    const int qrow0 = isctx ? (TL + b * 256) : (b * 4096 + qb * 256);
    f32x16 o[4];
    unsigned* o1s = A.o1g + wid * 2048 + lane;
    attn_pass(A, 0, b, h, qrow0, isctx, pathB, shm, o);
#pragma unroll
    for (int d = 0; d < 4; ++d)
#pragma unroll
        for (int r = 0; r < 16; r += 2) o1s[(d * 8 + (r >> 1)) * 64] = pkbf(o[d][r], o[d][r + 1]);
    asm volatile("s_waitcnt lgkmcnt(0)" ::: "memory");
    attn_pass(A, 1, b, h, qrow0, isctx, pathB, shm, o);
#pragma unroll
    for (int r = 0; r < 16; r += 2)
#pragma unroll
        for (int d = 0; d < 4; ++d) { const unsigned pk = o1s[(d * 8 + (r >> 1)) * 64]; o[d][r] = bflo(pk) - A.lam * o[d][r]; o[d][r + 1] = bfhi(pk) - A.lam * o[d][r + 1]; }
    LAS float* stg = (LAS float*)shm + wid * (32 * 68);
    const int rq = lane >> 3, cq = lane & 7;
    float vals[2][4][8]; float ssr[4] = {0.f, 0.f, 0.f, 0.f};
#pragma unroll
    for (int hf = 0; hf < 2; ++hf) {
#pragma unroll
        for (int r = 0; r < 16; ++r) { stg[crow(r, hi) * 68 + r32] = o[2 * hf][r]; stg[crow(r, hi) * 68 + 32 + r32] = o[2 * hf + 1][r]; }
        asm volatile("s_waitcnt lgkmcnt(0)" ::: "memory");
#pragma unroll
        for (int i = 0; i < 4; ++i) { const f32x4_t u0 = *(const LAS f32x4_t*)(stg + (rq + 8 * i) * 68 + cq * 8), u1 = *(const LAS f32x4_t*)(stg + (rq + 8 * i) * 68 + cq * 8 + 4);
#pragma unroll
            for (int c = 0; c < 4; ++c) { vals[hf][i][c] = u0[c]; vals[hf][i][4 + c] = u1[c]; ssr[i] += u0[c] * u0[c] + u1[c] * u1[c]; } }
        asm volatile("s_waitcnt lgkmcnt(0)" ::: "memory");
    }
#pragma unroll
    for (int i = 0; i < 4; ++i) { float v = ssr[i]; v += adpp<0xB1>(v); v += adpp<0x4E>(v); v += adpp<0x141>(v); ssr[i] = rsqrtf(v * (1.0f / 128.0f) + 1e-5f) * A.oml; }
#pragma unroll
    for (int hf = 0; hf < 2; ++hf) {
        const int col = h * 128 + hf * 64 + cq * 8;
        const f32x4_t g0 = *(const f32x4_t*)(A.gain + hf * 64 + cq * 8), g1 = *(const f32x4_t*)(A.gain + hf * 64 + cq * 8 + 4);
        u32x4 zz[4];
#pragma unroll
        for (int i = 0; i < 4; ++i) zz[i] = *(const u32x4*)(A.Z + (size_t)(qrow0 + wid * 32 + rq + 8 * i) * 1024 + col);
#pragma unroll
        for (int i = 0; i < 4; ++i) { const float rs = ssr[i]; const float* vv = vals[hf][i]; u32x4 w;
            w.x = pkbf(vv[0] * rs * g0[0] * silu_f(bflo(zz[i].x)), vv[1] * rs * g0[1] * silu_f(bfhi(zz[i].x)));
            w.y = pkbf(vv[2] * rs * g0[2] * silu_f(bflo(zz[i].y)), vv[3] * rs * g0[3] * silu_f(bfhi(zz[i].y)));
            w.z = pkbf(vv[4] * rs * g1[0] * silu_f(bflo(zz[i].z)), vv[5] * rs * g1[1] * silu_f(bfhi(zz[i].z)));
            w.w = pkbf(vv[6] * rs * g1[2] * silu_f(bflo(zz[i].w)), vv[7] * rs * g1[3] * silu_f(bfhi(zz[i].w)));
            *(u32x4*)(A.O + (size_t)(qrow0 + wid * 32 + rq + 8 * i) * 1024 + col) = w; }
    }
}
__device__ __forceinline__ void attn_phase(const Args& A, LAS char* shm, int G, int bid) {
    const int vcu = (G % 8 == 0) ? (bid % 8) * (G / 8) + bid / 8 : bid;
    bool pathB;
    { const int tid = opaque_tid(); LAS unsigned* cnt = (LAS unsigned*)(shm + LDS_CNT);
      if (tid < 4) cnt[tid] = 0u;
      __syncthreads();
      const unsigned simd = (unsigned)__builtin_amdgcn_s_getreg((1 << 11) | (4 << 6) | 4) & 3u;
      unsigned slot = 0u; if ((tid & 63) == 0) slot = __hip_atomic_fetch_add(cnt + simd, 1u, __ATOMIC_RELAXED, __HIP_MEMORY_SCOPE_WORKGROUP);
      slot = (unsigned)__builtin_amdgcn_readfirstlane((int)slot);
      pathB = (slot & 1u) != 0u;
      __syncthreads(); }
#pragma unroll 1
    for (int u = vcu; u < A.n_units; u += G) {
        const bool isctx = u >= 1024; const int bh = isctx ? (u - 1024) : (u >> 4); const int qb = isctx ? 0 : (u & 15);
        attn_unit(A, bh >> 3, bh & 7, qb, isctx, pathB, shm);
        asm volatile("s_waitcnt vmcnt(0) lgkmcnt(0)\n\ts_barrier" ::: "memory");
    }
}
}
typedef unsigned short bf16_t;
typedef float f32x4 __attribute__((ext_vector_type(4)));
typedef unsigned u32x4 __attribute__((ext_vector_type(4)));
typedef unsigned u32x2 __attribute__((ext_vector_type(2)));
constexpr size_t MiB = 1u << 20;
constexpr size_t WS_CTL = 0, WS_MOD = 1 * MiB, WS_ROPE = 1 * MiB + 512 * 1024, WS_BZ = 2 * MiB;
constexpr size_t WS_WDAIN = 9 * MiB, WS_WDAOUT = 25 * MiB, WS_WFNT = 29 * MiB, WS_WFNZ = 33 * MiB, WS_WFNOUT = 35 * MiB, WS_WRWIN = 37 * MiB, WS_WRWOUT = 46 * MiB;
constexpr size_t WS_XC = 48 * MiB, WS_HB = 56 * MiB, WS_BIG = 124 * MiB;
constexpr size_t WS_Q = WS_BIG, WS_K = WS_BIG + 68 * MiB, WS_V = WS_BIG + 136 * MiB, WS_Z = WS_BIG + 204 * MiB;
constexpr size_t WS_ATL = WS_BIG, WS_ATC = WS_BIG + 128 * MiB, WS_ZB = WS_BIG + 136 * MiB, WS_DFTL = 396 * MiB, WS_DFTC = 460 * MiB, WS_FOLD = WS_BIG + 204 * MiB;
constexpr size_t WS_P = WS_BIG, WS_Y1 = 413 * MiB, WS_END = 482 * MiB;
constexpr int RWN = 4352;
constexpr int LDS_BYTES = 147456;

struct Params { const float* in[28]; float* out; unsigned char* ws; };

__device__ __forceinline__ float wave_sum(float v) {
#pragma unroll
    for (int o = 1; o < 64; o <<= 1) v += __shfl_xor(v, o);
    return v;
}
__device__ __forceinline__ void tr_item(const float* W, int ldw, int N, bf16_t* WT, int ldt, LAS float* scr, int item, int lane) {
    const int nblk = N / 32, kb = item / nblk, nb = item % nblk, k0 = 64 * kb, n0 = 32 * nb;
    float v_[32];
#pragma unroll
    for (int i = 0; i < 32; ++i) v_[i] = W[(size_t)(k0 + 2 * i + (lane >> 5)) * ldw + n0 + (lane & 31)];
#pragma unroll
    for (int i = 0; i < 32; ++i) scr[(2 * i + (lane >> 5)) * 33 + (lane & 31)] = v_[i];
    asm volatile("s_waitcnt lgkmcnt(0)" ::: "memory");
    const int c = lane & 7;
#pragma unroll
    for (int j = 0; j < 4; ++j) { const int n = (lane >> 3) + 8 * j; const LAS float* s = scr + (8 * c) * 33 + n;
        u32x4 o; o.x = pkbf(s[0 * 33], s[1 * 33]); o.y = pkbf(s[2 * 33], s[3 * 33]); o.z = pkbf(s[4 * 33], s[5 * 33]); o.w = pkbf(s[6 * 33], s[7 * 33]);
        *(u32x4*)(WT + (size_t)(n0 + n) * ldt + k0 + 8 * c) = o; }
    asm volatile("s_waitcnt lgkmcnt(0)" ::: "memory");
}
__device__ __forceinline__ void prologue(const Params& p, LAS char* lds, int G, int bid) {
    const int tid = opaque_tid(), lane = tid & 63, wid = tid >> 6;
    unsigned char* ws = p.ws;
    {
        LAS float* scr = (LAS float*)(lds + wid * 8448);
        const int gw = bid * 8 + wid, NGW = G * 8;
        for (int it = gw; it < 8832; it += NGW) {
            int r = it;
            if (r < 2048) { tr_item(p.in[8], 4096, 4096, (bf16_t*)(ws + WS_WDAIN), 1024, scr, r, lane); continue; } r -= 2048;
            if (r < 2048) { tr_item(p.in[8] + (size_t)1024 * 4096, 4096, 4096, (bf16_t*)(ws + WS_WDAIN + 8 * MiB), 1024, scr, r, lane); continue; } r -= 2048;
            if (r < 512) { tr_item(p.in[12], 1024, 1024, (bf16_t*)(ws + WS_WDAOUT), 1024, scr, r, lane); continue; } r -= 512;
            if (r < 512) { tr_item(p.in[12] + (size_t)1024 * 1024, 1024, 1024, (bf16_t*)(ws + WS_WDAOUT + 2 * MiB), 1024, scr, r, lane); continue; } r -= 512;
            if (r < 512) { tr_item(p.in[13] + 1024, 2048, 1024, (bf16_t*)(ws + WS_WFNZ), 1024, scr, r, lane); continue; } r -= 512;
            if (r < 512) { tr_item(p.in[15], 1024, 1024, (bf16_t*)(ws + WS_WFNOUT), 1024, scr, r, lane); continue; } r -= 512;
            if (r < 2176) { tr_item(p.in[16], RWN, RWN, (bf16_t*)(ws + WS_WRWIN), 1024, scr, r, lane); continue; } r -= 2176;
            tr_item(p.in[27], 1024, 1024, (bf16_t*)(ws + WS_WRWOUT), 1024, scr, r, lane);
        }
    }
    __syncthreads();
    for (int it = bid; it < 256; it += G) {
        const int g = it >> 5, cs = (it >> 4) & 1, kq = it & 15;
        LAS float* Wcs = (LAS float*)lds; LAS float* win = (LAS float*)(lds + 65536); LAS float* tab = (LAS float*)(lds + 65536 + 33024);
        if (tid < 128) { float s, c; sincospif((float)tid / 64.f, &s, &c); tab[tid] = (cs ? s : c) * 0.08838834764831845f; }
        __syncthreads();
        {
            const int e0 = (tid & 31) * 4, cq = tid >> 5; f32x4 acc[8];
#pragma unroll
            for (int i = 0; i < 8; ++i) acc[i] = (f32x4){0.f, 0.f, 0.f, 0.f};
            const float* Wg = p.in[14] + (size_t)g * 128 * 128;
            for (int m = 0; m < 128; ++m) { const f32x4 wg = *(const f32x4*)(Wg + m * 128 + e0);
#pragma unroll
                for (int i = 0; i < 8; ++i) acc[i] += wg * tab[(m * (cq + 16 * i)) & 127]; }
#pragma unroll
            for (int i = 0; i < 8; ++i) *(LAS f32x4*)(Wcs + (cq + 16 * i) * 128 + e0) = acc[i];
        }
#pragma unroll
        for (int i = 0; i < 16; ++i) { const int idx = tid + 512 * i, kin = idx >> 7, c = idx & 127; win[kin * 129 + c] = p.in[13][(size_t)(kq * 64 + kin) * 2048 + g * 128 + c]; }
        __syncthreads();
        {
            const int kin = tid & 63, eg = tid >> 6; float acc[16];
#pragma unroll
            for (int i = 0; i < 16; ++i) acc[i] = 0.f;
            for (int c = 0; c < 128; ++c) { const float a = win[kin * 129 + c];
#pragma unroll
                for (int i = 0; i < 16; ++i) acc[i] += a * Wcs[c * 128 + eg * 16 + i]; }
            bf16_t* WT = (bf16_t*)(ws + WS_WFNT);
#pragma unroll
            for (int i = 0; i < 16; ++i) WT[(size_t)(cs * 1024 + g * 128 + eg * 16 + i) * 1024 + kq * 64 + kin] = (bf16_t)(pkbf(acc[i], 0.f) & 0xffffu);
        }
        __syncthreads();
    }
    {
        LAS float* tc = (LAS float*)lds; LAS float* ts = (LAS float*)(lds + 16384);
        for (int j = tid; j < 4096; j += 512) { float s, c; sincospif((float)j / 2048.f, &s, &c); tc[j] = c; ts[j] = -s; }
        __syncthreads();
        bf16_t* DL = (bf16_t*)(ws + WS_DFTL); bf16_t* DC = (bf16_t*)(ws + WS_DFTC);
        for (int k = bid; k < 2048; k += G) {
            const int j0 = (tid & 255) * 8; const bool sn = tid >= 256; float v8[8];
#pragma unroll
            for (int i = 0; i < 8; ++i) { const int idx = (k * (j0 + i)) & 4095; v8[i] = (sn ? -ts[idx] : tc[idx]) * 0.015625f; }
            u32x4 o; o.x = pkbf(v8[0], v8[1]); o.y = pkbf(v8[2], v8[3]); o.z = pkbf(v8[4], v8[5]); o.w = pkbf(v8[6], v8[7]);
            *(u32x4*)(DL + (sn ? (size_t)2048 * 2048 : (size_t)0) + (size_t)k * 2048 + j0) = o;
        }
        for (int k = bid; k < 256; k += G) {
            if (tid < 64) { const int cs = tid >> 5, l0 = (tid & 31) * 8; float v8[8];
#pragma unroll
                for (int i = 0; i < 8; ++i) { const int idx = ((k * (l0 + i)) & 255) * 16; v8[i] = (cs ? ts[idx] : tc[idx]) * 0.0625f; }
                u32x4 o; o.x = pkbf(v8[0], v8[1]); o.y = pkbf(v8[2], v8[3]); o.z = pkbf(v8[4], v8[5]); o.w = pkbf(v8[6], v8[7]);
                *(u32x4*)(DC + (size_t)k * 512 + cs * 256 + l0) = o; }
        }
        __syncthreads();
    }
    {
        LAS float* sc = (LAS float*)lds; LAS float* red = (LAS float*)(lds + 40960);
        bool have = false;
        for (int it = bid; it < 192; it += G) {
            if (!have) { for (int idx = tid; idx < 9216; idx += 512) { const int r = idx >> 10, k = idx & 1023; const float cv = r < 8 ? p.in[1][r * 1024 + k] : p.in[3][k]; sc[idx] = cv / (1.f + __expf(-cv)); } have = true; __syncthreads(); }
            const int i = it / 48, n = (it % 48) * 64 + (tid & 63), kq = tid >> 6;
            const float* w = p.in[5] + (size_t)i * 1024 * 3072 + n;
            float acc[9];
#pragma unroll
            for (int r = 0; r < 9; ++r) acc[r] = 0.f;
            for (int k = kq * 128; k < kq * 128 + 128; k += 4) { const float w0 = w[(size_t)k * 3072], w1 = w[(size_t)(k + 1) * 3072], w2 = w[(size_t)(k + 2) * 3072], w3 = w[(size_t)(k + 3) * 3072];
#pragma unroll
                for (int r = 0; r < 9; ++r) { const f32x4 s4 = *(const LAS f32x4*)(sc + r * 1024 + k); acc[r] += (s4[0] * w0 + s4[1] * w1) + (s4[2] * w2 + s4[3] * w3); } }
#pragma unroll
            for (int r = 0; r < 9; ++r) red[(kq * 9 + r) * 64 + (tid & 63)] = acc[r];
            __syncthreads();
            for (int idx = tid; idx < 576; idx += 512) { const int r = idx >> 6, col = idx & 63; float s = 0.f;
#pragma unroll
                for (int q = 0; q < 8; ++q) s += red[(q * 9 + r) * 64 + col];
                const int nn = (it % 48) * 64 + col;
                ((float*)(ws + WS_MOD))[(size_t)(i * 9 + r) * 3072 + nn] = s + p.in[6][i * 3072 + nn]; }
            __syncthreads();
        }
    }
    if (bid == 0) { for (int t = tid; t < 1024; t += 512) { const int pos = t >> 4, qd = t & 15; const float inv = powf(10000.f, -(float)qd / 16.f); const float ang = (float)pos * inv;
            ((float*)(ws + WS_ROPE))[t] = cosf(ang); ((float*)(ws + WS_ROPE))[1024 + t] = sinf(ang); } }
}
__device__ __forceinline__ void ph_phase(const float* xlat, const float* xctx, const float* gain, const float* mod, bf16_t* Hb, int G, int bid, int r0 = 0, int r1 = TT) {
    const int tid_ = opaque_tid(); const int lane = tid_ & 63, wid = tid_ >> 6;
    const int stride = G * 8;
    for (int row0 = r0 + bid * 8 + wid; row0 < r1; row0 += 2 * stride) {
        const int row1 = row0 + stride; const bool has1 = row1 < r1;
        const float* s0 = row0 < TL ? xlat + (size_t)row0 * 1024 : xctx + (size_t)(row0 - TL) * 1024;
        const float* s1 = !has1 ? s0 : (row1 < TL ? xlat + (size_t)row1 * 1024 : xctx + (size_t)(row1 - TL) * 1024);
        f32x4 v0[4], v1[4]; float q0 = 0.f, q1 = 0.f;
#pragma unroll
        for (int j = 0; j < 4; ++j) { v0[j] = *(const f32x4*)(s0 + 4 * lane + 256 * j); v1[j] = *(const f32x4*)(s1 + 4 * lane + 256 * j); }
#pragma unroll
        for (int j = 0; j < 4; ++j) { q0 += (v0[j].x * v0[j].x + v0[j].y * v0[j].y) + (v0[j].z * v0[j].z + v0[j].w * v0[j].w); q1 += (v1[j].x * v1[j].x + v1[j].y * v1[j].y) + (v1[j].z * v1[j].z + v1[j].w * v1[j].w); }
        const float r0 = rsqrtf(wave_sum(q0) * (1.f / 1024.f) + 1e-6f), r1 = rsqrtf(wave_sum(q1) * (1.f / 1024.f) + 1e-6f);
        const float* m0 = mod + (row0 < TL ? (row0 >> 12) : 8) * 3072; const float* m1 = mod + (row1 < TL ? (row1 >> 12) : 8) * 3072;
#pragma unroll
        for (int j = 0; j < 4; ++j) { const int col = 4 * lane + 256 * j; const f32x4 g4 = *(const f32x4*)(gain + col);
            { const f32x4 sh = *(const f32x4*)(m0 + col), sc = *(const f32x4*)(m0 + 1024 + col); const f32x4 y = v0[j] * r0 * g4 * (sc + 1.f) + sh; u32x2 o; o.x = pkbf(y.x, y.y); o.y = pkbf(y.z, y.w); *(u32x2*)(Hb + (size_t)row0 * 1024 + col) = o; }
            if (has1) { const f32x4 sh = *(const f32x4*)(m1 + col), sc = *(const f32x4*)(m1 + 1024 + col); const f32x4 y = v1[j] * r1 * g4 * (sc + 1.f) + sh; u32x2 o; o.x = pkbf(y.x, y.y); o.y = pkbf(y.z, y.w); *(u32x2*)(Hb + (size_t)row1 * 1024 + col) = o; } }
    }
}
__device__ __forceinline__ void final_phase(float* x, const float* gain, int G, int bid) {
    const int tid_ = opaque_tid(); const int lane = tid_ & 63, wid = tid_ >> 6;
    const int stride = G * 8;
    for (int row0 = bid * 8 + wid; row0 < TL; row0 += 2 * stride) {
        const int row1 = row0 + stride; const bool has1 = row1 < TL;
        float* s0 = x + (size_t)row0 * 1024; float* s1 = has1 ? x + (size_t)row1 * 1024 : s0;
        f32x4 v0[4], v1[4]; float q0 = 0.f, q1 = 0.f;
#pragma unroll
        for (int j = 0; j < 4; ++j) { v0[j] = *(const f32x4*)(s0 + 4 * lane + 256 * j); v1[j] = *(const f32x4*)(s1 + 4 * lane + 256 * j); }
#pragma unroll
        for (int j = 0; j < 4; ++j) { q0 += (v0[j].x * v0[j].x + v0[j].y * v0[j].y) + (v0[j].z * v0[j].z + v0[j].w * v0[j].w); q1 += (v1[j].x * v1[j].x + v1[j].y * v1[j].y) + (v1[j].z * v1[j].z + v1[j].w * v1[j].w); }
        const float r0 = rsqrtf(wave_sum(q0) * (1.f / 1024.f) + 1e-6f), r1 = rsqrtf(wave_sum(q1) * (1.f / 1024.f) + 1e-6f);
#pragma unroll
        for (int j = 0; j < 4; ++j) { const int col = 4 * lane + 256 * j; const f32x4 g4 = *(const f32x4*)(gain + col);
            *(f32x4*)(s0 + col) = v0[j] * r0 * g4;
            if (has1) *(f32x4*)(s1 + col) = v1[j] * r1 * g4; }
    }
}
__device__ __forceinline__ void fnet_fold(const bf16_t* ATL, bf16_t* E, bf16_t* O, float* TA, const bf16_t* Z, bf16_t* OG, int G, int bid) {
    const int tid_ = opaque_tid(); const int lane = tid_ & 63, wid = tid_ >> 6;
    for (int row = bid * 8 + wid; row < 8192; row += G * 8) {
        const bf16_t* a1 = ATL + (size_t)row * 8192; const bf16_t* a2 = a1 + 4096; bf16_t* e = E + (size_t)row * 2048; bf16_t* od = O + (size_t)row * 2048;
        float alt = 0.f;
#pragma unroll 2
        for (int it = 0; it < 4; ++it) {
            const int j0 = (it * 64 + lane) * 8;
            const u32x4 x = *(const u32x4*)(a1 + j0), y = *(const u32x4*)(a2 + j0);
            const int mb = 4096 - j0 - 8;
            const u32x4 xm = *(const u32x4*)(a1 + mb), ym = *(const u32x4*)(a2 + mb);
            const unsigned short xe = (j0 == 0) ? (unsigned short)0 : a1[4096 - j0], ye = (j0 == 0) ? (unsigned short)0 : a2[4096 - j0];
            float fa[8], fs[8], ma[8], ms[8];
#pragma unroll
            for (int i = 0; i < 4; ++i) { fa[2 * i] = bflo(x[i]); fa[2 * i + 1] = bfhi(x[i]); fs[2 * i] = bflo(y[i]); fs[2 * i + 1] = bfhi(y[i]);
                ma[2 * i] = bflo(xm[i]); ma[2 * i + 1] = bfhi(xm[i]); ms[2 * i] = bflo(ym[i]); ms[2 * i + 1] = bfhi(ym[i]); }
            float oc[8], os[8];
            oc[0] = fa[0] + bf1(xe); os[0] = fs[0] - bf1(ye);
#pragma unroll
            for (int i = 1; i < 8; ++i) { oc[i] = fa[i] + ma[8 - i]; os[i] = fs[i] - ms[8 - i]; }
            if (j0 == 0) { oc[0] = fa[0]; os[0] = 0.f; }
            u32x4 o; o.x = pkbf(oc[0], oc[1]); o.y = pkbf(oc[2], oc[3]); o.z = pkbf(oc[4], oc[5]); o.w = pkbf(oc[6], oc[7]);
            *(u32x4*)(e + j0) = o;
            alt += (bflo(o.x) - bfhi(o.x)) + (bflo(o.y) - bfhi(o.y)) + (bflo(o.z) - bfhi(o.z)) + (bflo(o.w) - bfhi(o.w));
            o.x = pkbf(os[0], os[1]); o.y = pkbf(os[2], os[3]); o.z = pkbf(os[4], os[5]); o.w = pkbf(os[6], os[7]);
            *(u32x4*)(od + j0) = o;
        }
        alt = wave_sum(alt);
        if (lane == 0) { const float amid = bf1(a1[2048]); TA[row] = amid * 0.015625f;
            const int b = row >> 10, n = row & 1023; const size_t off = (size_t)(b * 4096 + 2048) * 1024 + n;
            const float yv = (alt + amid) * 0.015625f * silu_f(bf1(Z[off]));
            OG[off] = (bf16_t)(pkbf(yv, 0.f) & 0xffffu); }
    }
}
__device__ __forceinline__ void sh8(const bf16_t* P, size_t row, int co, bool hm, bool hp, const float* mu, float* out) {
    const u32x4 z4 = {0u, 0u, 0u, 0u};
    const u32x4 c0 = *(const u32x4*)(P + row * RWN + co);
    const u32x4 cm = hm ? *(const u32x4*)(P + (row - 1) * RWN + co) : z4;
    const u32x4 cp = hp ? *(const u32x4*)(P + (row + 1) * RWN + co) : z4;
    const f32x4 m0 = *(const f32x4*)(mu + co), m1 = *(const f32x4*)(mu + co + 4);
#pragma unroll
    for (int i = 0; i < 4; ++i) {
        const float a0 = bflo(c0[i]), a1 = bfhi(c0[i]);
        const float n0 = 0.5f * (bflo(cm[i]) + bflo(cp[i])), n1 = 0.5f * (bfhi(cm[i]) + bfhi(cp[i]));
        const float mu0 = (2 * i < 4) ? m0[(2 * i) & 3] : m1[(2 * i) & 3], mu1 = (2 * i + 1 < 4) ? m0[(2 * i + 1) & 3] : m1[(2 * i + 1) & 3];
        out[2 * i] = a0 + mu0 * (n0 - a0); out[2 * i + 1] = a1 + mu1 * (n1 - a1);
    }
}
template <int CTRL> __device__ __forceinline__ float dpp_f(float v) { return __int_as_float(__builtin_amdgcn_update_dpp(0, __float_as_int(v), CTRL, 0xf, 0xf, true)); }
__device__ __forceinline__ float sum8(float v) { v += dpp_f<0xB1>(v); v += dpp_f<0x4E>(v); v += dpp_f<0x141>(v); return v; }
__device__ __forceinline__ float fast_tanh(float x) { const float e = __expf(2.f * x); return 1.f - 2.f * __builtin_amdgcn_rcpf(e + 1.f); }
__device__ __forceinline__ float fast_sigmoid(float x) { return __builtin_amdgcn_rcpf(1.f + __expf(-x)); }
struct RwArgs { const bf16_t* P; bf16_t* Y0; bf16_t* Y1; float* BZ; const float *mu, *w0, *w_up, *a0, *a_up, *k_k, *k_a, *r_k; };
struct Raw3 { u32x4 c0, cm, cp; };
__device__ __forceinline__ Raw3 ld3(const bf16_t* P, size_t row, int co, bool hm, bool hp) {
    const u32x4 z4 = {0u, 0u, 0u, 0u}; Raw3 r;
    r.c0 = *(const u32x4*)(P + row * RWN + co);
    r.cm = hm ? *(const u32x4*)(P + (row - 1) * RWN + co) : z4;
    r.cp = hp ? *(const u32x4*)(P + (row + 1) * RWN + co) : z4;
    return r;
}
__device__ __forceinline__ void shift8(const Raw3& R, const float* mu, int co, float* out) {
    const f32x4 m0 = *(const f32x4*)(mu + co), m1 = *(const f32x4*)(mu + co + 4);
#pragma unroll
    for (int i = 0; i < 4; ++i) {
        const float a0 = bflo(R.c0[i]), a1 = bfhi(R.c0[i]);
        const float n0 = 0.5f * (bflo(R.cm[i]) + bflo(R.cp[i])), n1 = 0.5f * (bfhi(R.cm[i]) + bfhi(R.cp[i]));
        const float mu0 = (2 * i < 4) ? m0[(2 * i) & 3] : m1[(2 * i) & 3], mu1 = (2 * i + 1 < 4) ? m0[(2 * i + 1) & 3] : m1[(2 * i + 1) & 3];
        out[2 * i] = a0 + mu0 * (n0 - a0); out[2 * i + 1] = a1 + mu1 * (n1 - a1);
    }
}
__device__ __forceinline__ void shift8l(const Raw3& R, const LAS float* mu, float* out) {
    const f32x4 m0 = *(const LAS f32x4*)(mu), m1 = *(const LAS f32x4*)(mu + 4);
    const float mm[8] = {m0[0], m0[1], m0[2], m0[3], m1[0], m1[1], m1[2], m1[3]};
#pragma unroll
    for (int i = 0; i < 4; ++i) {
        const float a0 = bflo(R.c0[i]), a1 = bfhi(R.c0[i]);
        const float n0 = 0.5f * (bflo(R.cm[i]) + bflo(R.cp[i])), n1 = 0.5f * (bfhi(R.cm[i]) + bfhi(R.cp[i]));
        out[2 * i] = a0 + mm[2 * i] * (n0 - a0); out[2 * i + 1] = a1 + mm[2 * i + 1] * (n1 - a1);
    }
}
__device__ __forceinline__ void shift8r(const Raw3& R, const float* mu, float* out) {
#pragma unroll
    for (int i = 0; i < 4; ++i) {
        const float a0 = bflo(R.c0[i]), a1 = bfhi(R.c0[i]);
        const float n0 = 0.5f * (bflo(R.cm[i]) + bflo(R.cp[i])), n1 = 0.5f * (bfhi(R.cm[i]) + bfhi(R.cp[i]));
        out[2 * i] = a0 + mu[2 * i] * (n0 - a0); out[2 * i + 1] = a1 + mu[2 * i + 1] * (n1 - a1);
    }
}
__device__ __forceinline__ void rwkv_scan(const RwArgs& A, LAS char* lds, int G, int bid) {
    typedef short bfx8 __attribute__((ext_vector_type(8)));
    const int tid = opaque_tid(), lane = tid & 63; const int q = __builtin_amdgcn_readfirstlane(tid >> 6);
    LAS float* sW = (LAS float*)lds; LAS float* sA = sW + 4096; LAS float* sB = sA + 4096; LAS float* sKD = sB + 4096; LAS float* sR = sKD + 4096; LAS float* sV = sR + 4096;
    LAS bf16_t* WUPt = (LAS bf16_t*)(sV + 4096); LAS bf16_t* AUPt = WUPt + 64 * 72;
    LAS bf16_t* T1 = (LAS bf16_t*)sW; LAS bf16_t* T2 = (LAS bf16_t*)sKD;
    const int s = tid >> 3, dg = tid & 7, d0 = dg * 8;
#pragma unroll 1
    for (int chain = bid; chain < 256; chain += G) {
        const int z = chain >> 7, b = (chain >> 4) & 7, hh = chain & 15;
        __syncthreads();
        for (int idx = tid; idx < 4096; idx += 512) { const int r = idx >> 6, d = idx & 63;
            WUPt[d * 72 + r] = (bf16_t)(pkbf(A.w_up[(size_t)(z * 64 + r) * 1024 + hh * 64 + d], 0.f) & 0xffffu);
            AUPt[d * 72 + r] = (bf16_t)(pkbf(A.a_up[(size_t)(z * 64 + r) * 1024 + hh * 64 + d], 0.f) & 0xffffu); }
        f32x2_t S2[4];
#pragma unroll
        for (int j = 0; j < 4; ++j) S2[j] = (f32x2_t){0.f, 0.f};
        bf16_t* Yz = z ? A.Y1 : A.Y0;
        const int c_r = hh * 64 + d0, c_k = 1024 + hh * 64 + d0, c_v = 2048 + hh * 64 + d0, c_wd = 3072 + z * 64 + d0, c_ad = 3200 + z * 64 + d0;
#define RW_ROWOF(c, rowv, hmv, hpv) do { const int sidx_ = (c) * 64 + s; int L_, n_, rb_; \
            if ((c) < 4) { L_ = 256; n_ = z ? (255 - sidx_) : sidx_; rb_ = TL + b * 256; } else { L_ = 4096; const int sl_ = sidx_ - 256; n_ = z ? (4095 - sl_) : sl_; rb_ = b * 4096; } \
            rowv = (size_t)(rb_ + n_); hmv = n_ > 0; hpv = n_ < L_ - 1; } while (0)
        size_t row; bool hm, hp;
        RW_ROWOF(0, row, hm, hp);
        Raw3 Rr = ld3(A.P, row, c_r, hm, hp), Rk = ld3(A.P, row, c_k, hm, hp), Rv = ld3(A.P, row, c_v, hm, hp), Rw = ld3(A.P, row, c_wd, hm, hp), Ra = ld3(A.P, row, c_ad, hm, hp);
#pragma unroll 1
        for (int c = 0; c < 68; ++c) {
            asm volatile("" ::: "memory");
            const size_t crow_ = row;
            {
                float r8[8], k8[8], v8[8], t8[8];
                shift8(Rr, A.mu, c_r, r8); shift8(Rk, A.mu, c_k, k8); shift8(Rv, A.mu, c_v, v8);
                *(LAS f32x4*)(sR + s * 64 + d0) = (f32x4){r8[0], r8[1], r8[2], r8[3]}; *(LAS f32x4*)(sR + s * 64 + d0 + 4) = (f32x4){r8[4], r8[5], r8[6], r8[7]};
                *(LAS f32x4*)(sV + s * 64 + d0) = (f32x4){v8[0], v8[1], v8[2], v8[3]}; *(LAS f32x4*)(sV + s * 64 + d0 + 4) = (f32x4){v8[4], v8[5], v8[6], v8[7]};
                *(LAS f32x4*)(sB + s * 64 + d0) = (f32x4){k8[0], k8[1], k8[2], k8[3]}; *(LAS f32x4*)(sB + s * 64 + d0 + 4) = (f32x4){k8[4], k8[5], k8[6], k8[7]};
                float kkr[8], ssq = 0.f;
                const f32x4 kk0 = *(const f32x4*)(A.k_k + hh * 64 + d0), kk1 = *(const f32x4*)(A.k_k + hh * 64 + d0 + 4);
#pragma unroll
                for (int i = 0; i < 8; ++i) { kkr[i] = k8[i] * (i < 4 ? kk0[i & 3] : kk1[i & 3]); ssq += kkr[i] * kkr[i]; }
                ssq = sum8(ssq);
                const float rs = -rsqrtf(ssq + 1e-12f);
                *(LAS f32x4*)(sA + s * 64 + d0) = (f32x4){kkr[0] * rs, kkr[1] * rs, kkr[2] * rs, kkr[3] * rs}; *(LAS f32x4*)(sA + s * 64 + d0 + 4) = (f32x4){kkr[4] * rs, kkr[5] * rs, kkr[6] * rs, kkr[7] * rs};
                shift8(Rw, A.mu, c_wd, t8);
                { u32x4 o; o.x = pkbf(fast_tanh(t8[0]), fast_tanh(t8[1])); o.y = pkbf(fast_tanh(t8[2]), fast_tanh(t8[3])); o.z = pkbf(fast_tanh(t8[4]), fast_tanh(t8[5])); o.w = pkbf(fast_tanh(t8[6]), fast_tanh(t8[7]));
                  *(LAS u32x4*)(T1 + s * 72 + d0) = o; }
                shift8(Ra, A.mu, c_ad, t8);
                { u32x4 o; o.x = pkbf(t8[0], t8[1]); o.y = pkbf(t8[2], t8[3]); o.z = pkbf(t8[4], t8[5]); o.w = pkbf(t8[6], t8[7]);
                  *(LAS u32x4*)(T2 + s * 72 + d0) = o; }
            }
            if (c + 1 < 68) { RW_ROWOF(c + 1, row, hm, hp);
                Rr = ld3(A.P, row, c_r, hm, hp); Rk = ld3(A.P, row, c_k, hm, hp); Rv = ld3(A.P, row, c_v, hm, hp); Rw = ld3(A.P, row, c_wd, hm, hp); Ra = ld3(A.P, row, c_ad, hm, hp); }
            __syncthreads();
            const int mt = q & 3, nh = q >> 2, fr = lane & 15, fq = lane >> 4;
            f32x4 accw[2], acca[2];
            {
                bfx8 aw[2], aa[2];
#pragma unroll
                for (int kk = 0; kk < 2; ++kk) { aw[kk] = *(const LAS bfx8*)(T1 + (16 * mt + fr) * 72 + kk * 32 + fq * 8); aa[kk] = *(const LAS bfx8*)(T2 + (16 * mt + fr) * 72 + kk * 32 + fq * 8); }
#pragma unroll
                for (int nt = 0; nt < 2; ++nt) { accw[nt] = (f32x4){0.f, 0.f, 0.f, 0.f}; acca[nt] = (f32x4){0.f, 0.f, 0.f, 0.f};
#pragma unroll
                    for (int kk = 0; kk < 2; ++kk) {
                        const bfx8 bw = *(const LAS bfx8*)(WUPt + (32 * nh + 16 * nt + fr) * 72 + kk * 32 + fq * 8), ba = *(const LAS bfx8*)(AUPt + (32 * nh + 16 * nt + fr) * 72 + kk * 32 + fq * 8);
                        accw[nt] = __builtin_amdgcn_mfma_f32_16x16x32_bf16(aw[kk], bw, accw[nt], 0, 0, 0);
                        acca[nt] = __builtin_amdgcn_mfma_f32_16x16x32_bf16(aa[kk], ba, acca[nt], 0, 0, 0); } }
            }
            __syncthreads();
#pragma unroll
            for (int nt = 0; nt < 2; ++nt) { const int d = 32 * nh + 16 * nt + fr, dcol = hh * 64 + d;
                const float w0d = A.w0[z * 1024 + dcol], a0d = A.a0[z * 1024 + dcol], kad = A.k_a[dcol];
#pragma unroll
                for (int j = 0; j < 4; ++j) { const int idx = (16 * mt + 4 * fq + j) * 64 + d;
                    const float x = -(w0d + accw[nt][j]);
                    const float sp = fmaxf(x, 0.f) + __logf(1.f + __expf(-fabsf(x)));
                    const float w = __expf(-__expf(-sp - 0.5f));
                    const float asig = fast_sigmoid(a0d + acca[nt][j]);
                    const float nkk = sA[idx], kraw = sB[idx];
                    sW[idx] = w; sB[idx] = -nkk * asig; sKD[idx] = kraw * (1.f + (asig - 1.f) * kad); } }
            __syncthreads();
            {
                const f32x4 ra = *(const LAS f32x4*)(sR + s * 64 + d0), rb = *(const LAS f32x4*)(sR + s * 64 + d0 + 4), ka = *(const LAS f32x4*)(sKD + s * 64 + d0), kb = *(const LAS f32x4*)(sKD + s * 64 + d0 + 4);
                const f32x4 q0 = *(const f32x4*)(A.r_k + hh * 64 + d0), q1 = *(const f32x4*)(A.r_k + hh * 64 + d0 + 4);
                float bz = 0.f;
#pragma unroll
                for (int i = 0; i < 4; ++i) { bz += ra[i] * ka[i] * q0[i]; bz += rb[i] * kb[i] * q1[i]; }
                bz = sum8(bz);
                if (dg == 0) A.BZ[((size_t)z * TT + crow_) * 16 + hh] = bz;
            }
            {
                const int rl = lane >> 3, cg = lane & 7, irow = 8 * q + rl;
                const LAS float* bw = sW + 8 * cg; const LAS float* ba_ = sA + 8 * cg; const LAS float* bb_ = sB + 8 * cg; const LAS float* bk = sKD + 8 * cg; const LAS float* br = sR + 8 * cg;
                LAS float* bv = sV + irow;
                f32x4 w0 = *(const LAS f32x4*)(bw), w1 = *(const LAS f32x4*)(bw + 4), a0 = *(const LAS f32x4*)(ba_), a1 = *(const LAS f32x4*)(ba_ + 4);
                f32x4 b0 = *(const LAS f32x4*)(bb_), b1 = *(const LAS f32x4*)(bb_ + 4), k0 = *(const LAS f32x4*)(bk), k1 = *(const LAS f32x4*)(bk + 4);
                f32x4 r0 = *(const LAS f32x4*)(br), r1 = *(const LAS f32x4*)(br + 4); float vi = bv[0];
#pragma unroll 4
                for (int st = 0; st < 64; ++st) {
                    const int on = ((st + 1) & 63) * 64;
                    const f32x4 nw0 = *(const LAS f32x4*)(bw + on), nw1 = *(const LAS f32x4*)(bw + on + 4), na0 = *(const LAS f32x4*)(ba_ + on), na1 = *(const LAS f32x4*)(ba_ + on + 4);
                    const f32x4 nb0 = *(const LAS f32x4*)(bb_ + on), nb1 = *(const LAS f32x4*)(bb_ + on + 4), nk0 = *(const LAS f32x4*)(bk + on), nk1 = *(const LAS f32x4*)(bk + on + 4);
                    const f32x4 nr0 = *(const LAS f32x4*)(br + on), nr1 = *(const LAS f32x4*)(br + on + 4); const float nvi = bv[on];
                    f32x2_t pp2 = S2[0] * (f32x2_t){a0[0], a0[1]};
                    pp2 = S2[1] * (f32x2_t){a0[2], a0[3]} + pp2; pp2 = S2[2] * (f32x2_t){a1[0], a1[1]} + pp2; pp2 = S2[3] * (f32x2_t){a1[2], a1[3]} + pp2;
                    const float sa = sum8(pp2.x + pp2.y);
                    const f32x2_t sa2 = {sa, sa}, v2 = {vi, vi};
                    S2[0] = S2[0] * (f32x2_t){w0[0], w0[1]} + sa2 * (f32x2_t){b0[0], b0[1]} + v2 * (f32x2_t){k0[0], k0[1]};
                    S2[1] = S2[1] * (f32x2_t){w0[2], w0[3]} + sa2 * (f32x2_t){b0[2], b0[3]} + v2 * (f32x2_t){k0[2], k0[3]};
                    S2[2] = S2[2] * (f32x2_t){w1[0], w1[1]} + sa2 * (f32x2_t){b1[0], b1[1]} + v2 * (f32x2_t){k1[0], k1[1]};
                    S2[3] = S2[3] * (f32x2_t){w1[2], w1[3]} + sa2 * (f32x2_t){b1[2], b1[3]} + v2 * (f32x2_t){k1[2], k1[3]};
                    f32x2_t y2 = S2[0] * (f32x2_t){r0[0], r0[1]};
                    y2 = S2[1] * (f32x2_t){r0[2], r0[3]} + y2; y2 = S2[2] * (f32x2_t){r1[0], r1[1]} + y2; y2 = S2[3] * (f32x2_t){r1[2], r1[3]} + y2;
                    const float yv = sum8(y2.x + y2.y);
                    if (cg == 0) bv[st * 64] = yv;
                    w0 = nw0; w1 = nw1; a0 = na0; a1 = na1; b0 = nb0; b1 = nb1; k0 = nk0; k1 = nk1; r0 = nr0; r1 = nr1; vi = nvi;
                }
            }
            __syncthreads();
            { u32x4 o; const LAS float* yr = sV + s * 64 + d0;
              o.x = pkbf(yr[0], yr[1]); o.y = pkbf(yr[2], yr[3]); o.z = pkbf(yr[4], yr[5]); o.w = pkbf(yr[6], yr[7]);
              *(u32x4*)(Yz + crow_ * 1024 + hh * 64 + d0) = o; }
            __syncthreads();
        }
#undef RW_ROWOF
    }
}
__device__ __forceinline__ void rwkv_out(const RwArgs& A, const float* ln_w, const float* ln_b, bf16_t* OG, int G, int bid) {
    const int tid_ = opaque_tid(); const int lane = tid_ & 63, wid = tid_ >> 6; const int c0 = lane * 16, head = lane >> 2;
    float lw[16], lb[16], muv[16];
#pragma unroll
    for (int i = 0; i < 16; ++i) { lw[i] = ln_w[c0 + i]; lb[i] = ln_b[c0 + i]; muv[i] = A.mu[2048 + c0 + i]; }
    for (int row = bid * 8 + wid; row < TT; row += G * 8) {
        const bool lat = row < TL; const int L = lat ? 4096 : 256; const int n = lat ? (row & 4095) : ((row - TL) & 255); const bool hm = n > 0, hp = n < L - 1;
        const u32x4 a0 = *(const u32x4*)(A.Y0 + (size_t)row * 1024 + c0), a1 = *(const u32x4*)(A.Y0 + (size_t)row * 1024 + c0 + 8);
        const u32x4 b0 = *(const u32x4*)(A.Y1 + (size_t)row * 1024 + c0), b1 = *(const u32x4*)(A.Y1 + (size_t)row * 1024 + c0 + 8);
        const Raw3 v0 = ld3(A.P, (size_t)row, 2048 + c0, hm, hp), v1 = ld3(A.P, (size_t)row, 2048 + c0 + 8, hm, hp);
        const u32x4 z0 = *(const u32x4*)(A.P + (size_t)row * RWN + 3328 + c0), z1 = *(const u32x4*)(A.P + (size_t)row * RWN + 3328 + c0 + 8);
        const float bz = 0.5f * (A.BZ[(size_t)row * 16 + head] + A.BZ[((size_t)TT + row) * 16 + head]);
        float y[16], vv[16];
#pragma unroll
        for (int i = 0; i < 4; ++i) { y[2 * i] = bflo(a0[i]) + bflo(b0[i]); y[2 * i + 1] = bfhi(a0[i]) + bfhi(b0[i]); y[8 + 2 * i] = bflo(a1[i]) + bflo(b1[i]); y[8 + 2 * i + 1] = bfhi(a1[i]) + bfhi(b1[i]); }
        float s1 = 0.f;
#pragma unroll
        for (int i = 0; i < 16; ++i) s1 += y[i];
        s1 += __shfl_xor(s1, 1); s1 += __shfl_xor(s1, 2); const float mean = s1 * (1.f / 64.f);
        float s2 = 0.f;
#pragma unroll
        for (int i = 0; i < 16; ++i) { y[i] -= mean; s2 += y[i] * y[i]; }
        s2 += __shfl_xor(s2, 1); s2 += __shfl_xor(s2, 2); const float rstd = rsqrtf(s2 * (1.f / 64.f) + 64e-5f);
        shift8r(v0, muv, vv); shift8r(v1, muv + 8, vv + 8);
        float ov[16];
#pragma unroll
        for (int i = 0; i < 16; ++i) { const unsigned zw = (i < 8) ? z0[(i >> 1) & 3] : z1[(i >> 1) & 3]; const float zz = (i & 1) ? bfhi(zw) : bflo(zw);
            ov[i] = (y[i] * rstd * lw[i] + lb[i] + bz * vv[i]) * silu_f(zz); }
        u32x4 o0, o1; o0.x = pkbf(ov[0], ov[1]); o0.y = pkbf(ov[2], ov[3]); o0.z = pkbf(ov[4], ov[5]); o0.w = pkbf(ov[6], ov[7]);
        o1.x = pkbf(ov[8], ov[9]); o1.y = pkbf(ov[10], ov[11]); o1.z = pkbf(ov[12], ov[13]); o1.w = pkbf(ov[14], ov[15]);
        *(u32x4*)(OG + (size_t)row * 1024 + c0) = o0; *(u32x4*)(OG + (size_t)row * 1024 + c0 + 8) = o1;
    }
}
#ifdef SKIP_GEMM
#define GEMM_PHASE(EPI, AP, BP, MM, NN, KK, EOBJ) do { (void)EOBJ; } while (0)
#else
#ifndef STAGGER_TICKS
#define STAGGER_TICKS 1500
#endif
__device__ __forceinline__ void stagger_wait(int bid, int units_per_cu_x2) {
    if ((bid & 1) && units_per_cu_x2 >= 4) { const unsigned long long t0 = __builtin_amdgcn_s_memrealtime(); while (__builtin_amdgcn_s_memrealtime() - t0 < (unsigned long long)STAGGER_TICKS) __builtin_amdgcn_s_sleep(32); }
}
#define GEMM_PHASE(EPI, AP, BP, MM, NN, KK, EOBJ) do { pg8::Gemm g_{(const bf16_t*)(AP), (const bf16_t*)(BP), (MM), (NN), (KK)}; pg8::StaticOrder S_; S_.init((MM), (NN), G, bid); \
    pg8::gemm_phase<EPI, pg8::StaticOrder, true, true>((PG8_LAS unsigned char*)lds, g_, S_, EOBJ); } while (0)
#endif
#ifdef SKIP_EpiAttnIn
#define GEMM_PHASE_EpiAttnIn(EPI, AP, BP, MM, NN, KK, EOBJ) do { (void)EOBJ; } while (0)
#else
#define GEMM_PHASE_EpiAttnIn GEMM_PHASE
#endif
#ifdef SKIP_EpiFnT
#define GEMM_PHASE_EpiFnT(EPI, AP, BP, MM, NN, KK, EOBJ) do { (void)EOBJ; } while (0)
#else
#define GEMM_PHASE_EpiFnT GEMM_PHASE
#endif
#ifdef SKIP_EpiPlain
#define GEMM_PHASE_EpiPlain(EPI, AP, BP, MM, NN, KK, EOBJ) do { (void)EOBJ; } while (0)
#else
#define GEMM_PHASE_EpiPlain GEMM_PHASE
#endif
#ifdef SKIP_EpiDft
#define GEMM_PHASE_EpiDft(EPI, AP, BP, MM, NN, KK, EOBJ) do { (void)EOBJ; } while (0)
#else
#define GEMM_PHASE_EpiDft GEMM_PHASE
#endif
#ifdef SKIP_EpiResid
#define GEMM_PHASE_EpiResid(EPI, AP, BP, MM, NN, KK, EOBJ) do { (void)EOBJ; } while (0)
#else
#define GEMM_PHASE_EpiResid GEMM_PHASE
#endif
#define XB_TMO      128
#define XB_XCNT(j)  (256  + 64 * (j))
#define XB_XSUB(j)  (1280 + 64 * (j))
#define XB_XGEN(j)  (2304 + 64 * (j))
#define XB_TOP      3328
#define XB_TOPGEN   3392
#define XCD_BAR_WORDS 3456
#define XB_SPIN_CAP (1u << 18)

__device__ __forceinline__ unsigned xb_ld(unsigned* p)              { return __hip_atomic_load(p, __ATOMIC_RELAXED, __HIP_MEMORY_SCOPE_AGENT); }
__device__ __forceinline__ unsigned xb_add(unsigned* p, unsigned v) { return __hip_atomic_fetch_add(p, v, __ATOMIC_RELAXED, __HIP_MEMORY_SCOPE_AGENT); }
__device__ __forceinline__ unsigned xb_xcc_id() { return (unsigned)__builtin_amdgcn_s_getreg((3 << 11) | 20) & 0xFu; }
#define XB_SPIN(cond, bar) do { unsigned _sp = 0; while (cond) { __builtin_amdgcn_s_sleep(1); \
    if ((++_sp & 255u) == 0u) { if (xb_ld(&(bar)[XB_TMO])) break; if (_sp > XB_SPIN_CAP) { atomicAdd(&(bar)[XB_TMO], 1u); break; } } } } while (0)

struct XcdBarrier {
    unsigned* bar; unsigned x;
    volatile LAS unsigned* st;
};

__device__ __forceinline__ XcdBarrier xcd_barrier_post(unsigned* bar, volatile LAS unsigned* st) {
    XcdBarrier b; b.bar = bar; b.x = xb_xcc_id(); b.st = st;
    if (threadIdx.x == 0) (void)xb_add(&bar[XB_XCNT(b.x)], 1u);
    return b;
}
__device__ __forceinline__ void xcd_barrier_complete(unsigned* bar, unsigned x, unsigned& nloc, unsigned& nx) {
    const unsigned G = gridDim.x * gridDim.y * gridDim.z;
    unsigned sum, cnt, mine, sp = 0u;
    for (;;) {
        sum = 0u; cnt = 0u; mine = 0u;
#pragma unroll
        for (unsigned j = 0; j < 16; ++j) { const unsigned c = xb_ld(&bar[XB_XCNT(j)]); sum += c; cnt += (c > 0u) ? 1u : 0u; mine = (j == x) ? c : mine; }
        if (sum == G) break;
        __builtin_amdgcn_s_sleep(1);
        if ((++sp & 255u) == 0u) { if (xb_ld(&bar[XB_TMO])) break; if (sp > XB_SPIN_CAP) { atomicAdd(&bar[XB_TMO], 1u); break; } }
    }
    nloc = mine > 0u ? mine : 1u; nx = cnt > 0u ? cnt : 1u;
}

__device__ __forceinline__ void xcd_barrier(const XcdBarrier& b) {
    asm volatile("s_waitcnt vmcnt(0)" ::: "memory");
    __syncthreads();
    if (threadIdx.x == 0) {
        unsigned* bar = b.bar;
        __builtin_amdgcn_s_waitcnt(0);
        unsigned nloc = b.st[0], nx = b.st[1];
        if (nloc == 0u) { xcd_barrier_complete(bar, b.x, nloc, nx); b.st[0] = nloc; b.st[1] = nx; }
        const unsigned old = xb_add(&bar[XB_XSUB(b.x)], 1u);
        const unsigned gen = old / nloc;
        if (old + 1u == (gen + 1u) * nloc) {
            __builtin_amdgcn_fence(__ATOMIC_RELEASE, "agent");
            asm volatile("s_waitcnt vmcnt(0)" ::: "memory");
            const unsigned og = xb_add(&bar[XB_TOP], 1u);
            const unsigned tg = og / nx;
            if (og + 1u == (tg + 1u) * nx) xb_add(&bar[XB_TOPGEN], 1u);
            else XB_SPIN(xb_ld(&bar[XB_TOPGEN]) == tg, bar);
            __builtin_amdgcn_fence(__ATOMIC_ACQUIRE, "agent");
            xb_add(&bar[XB_XGEN(b.x)], 1u);
            asm volatile("s_waitcnt vmcnt(0)" ::: "memory");
        } else {
            XB_SPIN(xb_ld(&bar[XB_XGEN(b.x)]) == gen, bar);
            __builtin_amdgcn_fence(__ATOMIC_ACQUIRE, "agent");
            asm volatile("s_waitcnt vmcnt(0)" ::: "memory");
        }
    }
    __syncthreads();
}

#define GRID_SYNC() xcd_barrier(xbar)
template <int layer> __device__ __forceinline__ void layer_body(const Params& p, LAS char* lds, const XcdBarrier& xbar, int G, int bid) {
    unsigned char* ws = p.ws;
    float* mod = (float*)(ws + WS_MOD);
    const float* ropeC = (const float*)(ws + WS_ROPE); const float* ropeS = ropeC + 1024;
    bf16_t* Hb = (bf16_t*)(ws + WS_HB);
    float* XC = (float*)(ws + WS_XC);
    const float* x_in = p.in[0]; const float* ctx_in = p.in[2];
        const float* xl = layer == 0 ? x_in : p.out; const float* xc = layer == 0 ? ctx_in : XC;
        const float* modl = mod + (size_t)layer * 9 * 3072;
        if constexpr (layer == 0) {
            ph_phase(xl, xc, p.in[4] + layer * 1024, modl, Hb, G, bid);
            GRID_SYNC();
        }
        const int Mout = (layer == 3) ? TL : TT;
        const bf16_t* Wout;
        if constexpr (layer == 0 || layer == 3) {
            const int j = layer == 0 ? 0 : 1;
            pg8::EpiAttnIn E{(bf16_t*)(ws + WS_Q), (bf16_t*)(ws + WS_K), (bf16_t*)(ws + WS_V), (bf16_t*)(ws + WS_Z), ropeC, ropeS};
            GEMM_PHASE_EpiAttnIn(pg8::EpiAttnIn, Hb, ws + WS_WDAIN + (size_t)j * 8 * MiB, TT, 4096, 1024, E);
#ifdef PROBE_GIN2
            GEMM_PHASE_EpiAttnIn(pg8::EpiAttnIn, Hb, ws + WS_WDAIN + (size_t)j * 8 * MiB, TT, 4096, 1024, E);
#endif
            GRID_SYNC();
            float lam;
            { const int lane = opaque_tid() & 63; const float* lq = p.in[9] + j * 128; const float* lk = p.in[10] + j * 128;
              const float s0 = wave_sum(lq[lane] * lk[lane]), s1 = wave_sum(lq[64 + lane] * lk[64 + lane]);
              const float li = 0.8f - 0.6f * expf(-0.3f * (float)layer); lam = expf(s0) - expf(s1) + li;
              att::Args A{(const bf16_t*)(ws + WS_Q), (const bf16_t*)(ws + WS_K), (const bf16_t*)(ws + WS_V), (const bf16_t*)(ws + WS_Z), Hb, p.in[11] + j * 128, lam, 1.f - li, layer == 3 ? 1024 : 1088, (unsigned*)(ws + WS_Y1) + (size_t)bid * 8 * 2048};
#ifndef SKIP_ATT
              att::attn_phase(A, lds, G, bid);
#endif
#ifdef PROBE_ATT2
              att::attn_phase(A, lds, G, bid);
#endif
            }
            GRID_SYNC();
            Wout = (const bf16_t*)(ws + WS_WDAOUT + (size_t)j * 2 * MiB);
        } else if constexpr (layer == 1) {
            { pg8::EpiFnT E{(bf16_t*)(ws + WS_ATL), (bf16_t*)(ws + WS_ATC)};
              GEMM_PHASE_EpiFnT(pg8::EpiFnT, ws + WS_WFNT, Hb, 2048, TT, 1024, E); }
            { pg8::EpiPlain E{(bf16_t*)(ws + WS_ZB), 1024};
              GEMM_PHASE_EpiPlain(pg8::EpiPlain, Hb, ws + WS_WFNZ, TT, 1024, 1024, E); }
            GRID_SYNC();
            fnet_fold((const bf16_t*)(ws + WS_ATL), (bf16_t*)(ws + WS_FOLD), (bf16_t*)(ws + WS_FOLD + 32 * MiB), (float*)(ws + WS_BZ), (const bf16_t*)(ws + WS_ZB), Hb, G, bid);
            GRID_SYNC();
            { pg8::EpiPlain E{(bf16_t*)(ws + WS_ATL), 8192};
              GEMM_PHASE_EpiPlain(pg8::EpiPlain, ws + WS_DFTL, ws + WS_FOLD, 2048, 8192, 2048, E); }
            GRID_SYNC();
            { pg8::EpiDftSym E{(const bf16_t*)(ws + WS_ATL), (const float*)(ws + WS_BZ), (const bf16_t*)(ws + WS_ZB), Hb};
              GEMM_PHASE(pg8::EpiDftSym, ws + WS_DFTL + 8 * MiB, ws + WS_FOLD + 32 * MiB, 2048, 8192, 2048, E); }
            { pg8::EpiDft E{(const bf16_t*)(ws + WS_ZB), Hb, TL, 256};
              GEMM_PHASE_EpiDft(pg8::EpiDft, ws + WS_DFTC, ws + WS_ATC, 256, 8192, 512, E); }
            GRID_SYNC();
            Wout = (const bf16_t*)(ws + WS_WFNOUT);
        } else {
            { pg8::EpiPlain E{(bf16_t*)(ws + WS_P), RWN};
              GEMM_PHASE_EpiPlain(pg8::EpiPlain, Hb, ws + WS_WRWIN, TT, RWN, 1024, E); }
            GRID_SYNC();
            RwArgs A{(const bf16_t*)(ws + WS_P), Hb, (bf16_t*)(ws + WS_Y1), (float*)(ws + WS_BZ), p.in[17], p.in[18], p.in[19], p.in[20], p.in[21], p.in[22], p.in[23], p.in[24]};
#ifndef SKIP_SCAN
            rwkv_scan(A, lds, G, bid);
#endif
#ifdef PROBE_SCAN2
            rwkv_scan(A, lds, G, bid);
#endif
            GRID_SYNC();
#ifndef SKIP_RWOUT
            rwkv_out(A, p.in[25], p.in[26], Hb, G, bid);
#endif
            GRID_SYNC();
            Wout = (const bf16_t*)(ws + WS_WRWOUT);
        }
        if constexpr (layer == 3) {
            pg8::EpiResid E{xl, xc, p.out, XC, modl + 2048, 0};
            GEMM_PHASE_EpiResid(pg8::EpiResid, Hb, Wout, TL, 1024, 1024, E);
            GRID_SYNC();
        } else {
            { pg8::EpiResid E{xl, xc, p.out, XC, modl + 2048, 0};
              GEMM_PHASE_EpiResid(pg8::EpiResid, Hb, Wout, TL, 1024, 1024, E); }
            GRID_SYNC();
            const float* gain_n = p.in[4] + (layer + 1) * 1024; const float* mod_n = mod + (size_t)(layer + 1) * 9 * 3072;
            const int nctx = 32;
            if (G > 2 * nctx) {
                if (bid < nctx) { const int G_real = G; { const int G = nctx; (void)G_real;
                    pg8::EpiResid E{xl, xc, p.out, XC, modl + 2048, TL};
                    GEMM_PHASE_EpiResid(pg8::EpiResid, Hb + (size_t)TL * 1024, Wout, TCX, 1024, 1024, E); } }
                else ph_phase(p.out, XC, gain_n, mod_n, Hb, G - nctx, bid - nctx, 0, TL);
                GRID_SYNC();
                ph_phase(p.out, XC, gain_n, mod_n, Hb, G, bid, TL, TT);
            } else {
                { pg8::EpiResid E{xl, xc, p.out, XC, modl + 2048, TL};
                  GEMM_PHASE_EpiResid(pg8::EpiResid, Hb + (size_t)TL * 1024, Wout, TCX, 1024, 1024, E); }
                GRID_SYNC();
                ph_phase(p.out, XC, gain_n, mod_n, Hb, G, bid);
            }
            GRID_SYNC();
        }
    }
__global__ void __launch_bounds__(512, 2) fwd_megakernel(Params p) {
    extern __shared__ __attribute__((aligned(16))) unsigned char lds_raw[];
    LAS char* lds = (LAS char*)lds_raw;
    cg::grid_group grid = cg::this_grid();
    const int G = gridDim.x, bid = blockIdx.x;
    volatile LAS unsigned* xst = (volatile LAS unsigned*)(lds + LDS_BYTES - 256);
    if (threadIdx.x < 2) xst[threadIdx.x] = 0u;
    __syncthreads();
    const XcdBarrier xbar = xcd_barrier_post((unsigned*)(p.ws + WS_CTL), xst);

#ifndef SKIP_PRO
    prologue(p, lds, G, bid);
#endif
#ifdef PROBE_PRO2
    __syncthreads(); prologue(p, lds, G, bid);
#endif
    grid.sync();
    layer_body<0>(p, lds, xbar, G, bid);
    layer_body<1>(p, lds, xbar, G, bid);
    layer_body<2>(p, lds, xbar, G, bid);
    layer_body<3>(p, lds, xbar, G, bid);
    final_phase(p.out, p.in[7], G, bid);
}

extern "C" void kernel_launch(void* const* d_in, const int* in_sizes, int n_in, void* d_out, int out_size, void* d_ws, size_t ws_size, hipStream_t stream) {
    static int grid = 0;
    if (grid == 0) {
        if (n_in != 28 || out_size != TL * 1024 || ws_size < WS_END) { fprintf(stderr, "kernel_launch: unexpected shapes: n_in %d out %d ws %zu\n", n_in, out_size, ws_size); grid = -1; return; }
        int dev = 0, cus = 0, per_cu = 0;
        hipGetDevice(&dev); hipDeviceGetAttribute(&cus, hipDeviceAttributeMultiprocessorCount, dev);
        if (hipFuncSetAttribute((const void*)fwd_megakernel, hipFuncAttributeMaxDynamicSharedMemorySize, LDS_BYTES) != hipSuccess) { fprintf(stderr, "kernel_launch: hipFuncSetAttribute failed\n"); grid = -1; return; }
        if (hipOccupancyMaxActiveBlocksPerMultiprocessor(&per_cu, (const void*)fwd_megakernel, 512, LDS_BYTES) != hipSuccess || per_cu < 1) { fprintf(stderr, "kernel_launch: occupancy query failed (%d)\n", per_cu); per_cu = 1; }
        (void)hipGetLastError();
        grid = cus * per_cu;
    }
    if (grid < 0) return;
    if (hipMemsetAsync((char*)d_ws + WS_CTL, 0, 65536, stream) != hipSuccess) { fprintf(stderr, "kernel_launch: hipMemsetAsync failed\n"); return; }
    Params p{};
    for (int i = 0; i < 28; ++i) p.in[i] = (const float*)d_in[i];
    p.out = (float*)d_out; p.ws = (unsigned char*)d_ws;
    void* args[] = {&p};
    hipError_t e = hipLaunchCooperativeKernel((const void*)fwd_megakernel, dim3(grid), dim3(512), args, LDS_BYTES, stream);
    if (e != hipSuccess) fprintf(stderr, "cooperative launch failed: %s (grid %d)\n", hipGetErrorString(e), grid);
}
```

```cpp
#include <hip/hip_runtime.h>
#include <hip/hip_cooperative_groups.h>
#include <cstdio>
#include <cstdint>
#include <cmath>
namespace cg = cooperative_groups;

constexpr int TL = 32768, TCX = 2048, TT = TL + TCX, DM = 1024;
constexpr float QK_C2 = 0.125f * 1.4426950408889634f;
typedef float f32x2_t __attribute__((ext_vector_type(2)));
typedef __bf16 bf16x2_t __attribute__((ext_vector_type(2)));
__device__ __forceinline__ unsigned pkbf(float lo, float hi) { f32x2_t v = {lo, hi}; bf16x2_t b = __builtin_convertvector(v, bf16x2_t); return __builtin_bit_cast(unsigned, b); }
__device__ __forceinline__ float bflo(unsigned u) { return __uint_as_float(u << 16); }
__device__ __forceinline__ float bfhi(unsigned u) { return __uint_as_float(u & 0xffff0000u); }
__device__ __forceinline__ float bf1(unsigned short u) { return __uint_as_float(((unsigned)u) << 16); }
__device__ __forceinline__ float silu_f(float z) { return z * __builtin_amdgcn_rcpf(1.f + __expf(-z)); }
__device__ __forceinline__ int opaque_tid() { int t = threadIdx.x; asm volatile("" : "+v"(t)); return t; }
namespace pg8 {
#define PG8_LAS __attribute__((address_space(3)))
typedef unsigned short bf16_t;
typedef short bf16x8 __attribute__((ext_vector_type(8)));
typedef float f32x4 __attribute__((ext_vector_type(4)));
typedef unsigned u32x4 __attribute__((ext_vector_type(4)));
constexpr int BM = 256, BK = 64, HALF = 128, HTB = HALF * BK * 2  , STAGE_BYTES = 8 * HTB, NXCD = 8, WGM = 8;

__host__ __device__ __forceinline__ int lds_byte(int r, int c) { const int st = (r >> 4) * 2 + (c >> 5), rr = r & 15, cc = c & 31, ob = rr * 64 + cc * 2; return st * 1024 + (ob ^ (((ob >> 9) & 1) << 5)); }
__host__ __device__ __forceinline__ void stage_rc(int b, int& R, int& C) { const int st = b / 1024, sb = b % 1024, swz = sb ^ (((sb >> 9) & 1) << 5); R = (st >> 1) * 16 + swz / 64; C = (st & 1) * 32 + (swz % 64) / 2; }
__host__ __device__ __forceinline__ int perm32(int rho) { const int n = rho >> 4, i = rho & 15; return 8 * (i >> 2) + 4 * n + (i & 3); }

struct Unit { int pm, pn; };
struct Gemm { const bf16_t* A; const bf16_t* Bt; int M, N, K; };

struct StaticOrder {
    int nM, nN, nwg, G, c;
    __host__ __device__ void init(int M, int N, int G_, int c_) { nM = M / BM; nN = N / BM; nwg = nM * nN; G = G_; c = c_; }
    __host__ __device__ bool next(int i, Unit& u) const {
        const long L = (long)i * G + c; if (L >= nwg) return false;
        int wgid = (int)L; { const int q = nwg / NXCD, r = nwg % NXCD, xcd = wgid % NXCD, off = wgid / NXCD; wgid = (xcd < r ? xcd * (q + 1) : r * (q + 1) + (xcd - r) * q) + off; }
        const int nig = WGM * nN, gid = wgid / nig, fm = gid * WGM, gsz = (nM - fm) < WGM ? (nM - fm) : WGM;
        u.pm = fm + ((wgid % nig) % gsz); u.pn = (wgid % nig) / gsz; return true;
    }
    __device__ __forceinline__ void a_ready(const Unit&) const {}
    __device__ __forceinline__ void done(const Unit&) const {}
};

struct EpiAttnIn {
    static constexpr bool PERM = true, AFTER_DRAIN = false;
    bf16_t* Q; bf16_t* Kb; bf16_t* V; bf16_t* Z; const PG8_LAS float* ropeC; const PG8_LAS float* ropeS;
    __device__ __forceinline__ void operator()(const f32x4 (&acc)[2][2][4][2], const Unit& u, int wr, int wc, int fr, int fq) const {
        const int sect = u.pn >> 2;
        bf16_t* base = sect == 0 ? Q : sect == 1 ? Kb : sect == 2 ? V : Z;
        const int colt = (u.pn & 3) * 256 + wc * 32 + 8 * fq;
        const int row0 = u.pm * BM + wr * 64 + fr;
        const bool rope = (u.pm < 128) && (sect < 2);
        const float sc = (sect == 0) ? QK_C2 : 1.f;
        const int axis = wc & 1;
#pragma unroll
        for (int ai = 0; ai < 2; ++ai)
#pragma unroll
            for (int m = 0; m < 4; ++m) {
                const int row = row0 + ai * HALF + m * 16;
                const int ntok = row & 4095;
                const int pos = axis ? (ntok & 63) : (ntok >> 6);
                bf16_t* rowp;
                if (sect == 1) rowp = base + (size_t)(row >> 6) * 65536 + (size_t)(colt >> 3) * 512 + (row & 63) * 8;
                else if (sect == 2) rowp = base + (size_t)(row >> 6) * 65536 + (size_t)(colt >> 7) * 8192 + (((colt & 127) >> 5) * 4 + ((row & 63) >> 4)) * 512 + (row & 15) * 32 + (colt & 31);
                else rowp = base + (size_t)row * 1024 + colt;
#pragma unroll
                for (int bj = 0; bj < 2; ++bj) {
                    f32x4 v0 = acc[ai][bj][m][0], v1 = acc[ai][bj][m][1];
                    if (rope) {
                        const f32x4 c0 = *(const PG8_LAS f32x4*)(ropeC + pos * 16 + 8 * (fq & 1)), c1 = *(const PG8_LAS f32x4*)(ropeC + pos * 16 + 8 * (fq & 1) + 4);
                        const f32x4 s0 = *(const PG8_LAS f32x4*)(ropeS + pos * 16 + 8 * (fq & 1)), s1 = *(const PG8_LAS f32x4*)(ropeS + pos * 16 + 8 * (fq & 1) + 4);
                        f32x4 p0, p1;
#pragma unroll
                        for (int i = 0; i < 4; ++i) { p0[i] = __shfl_xor(v0[i], 32); p1[i] = __shfl_xor(v1[i], 32); }
                        if (fq < 2) { v0 = v0 * c0 - p0 * s0; v1 = v1 * c1 - p1 * s1; }
                        else        { v0 = v0 * c0 + p0 * s0; v1 = v1 * c1 + p1 * s1; }
                    }
                    v0 = v0 * sc; v1 = v1 * sc;
                    u32x4 w; w.x = pkbf(v0[0], v0[1]); w.y = pkbf(v0[2], v0[3]); w.z = pkbf(v1[0], v1[1]); w.w = pkbf(v1[2], v1[3]);
                    *(u32x4*)(rowp + (sect == 1 || sect == 2 ? bj * 8192 : bj * HALF)) = w;
                }
            }
    }
};
struct EpiPlain {
    static constexpr bool PERM = true, AFTER_DRAIN = false;
    bf16_t* O; int ldc;
    __device__ __forceinline__ void operator()(const f32x4 (&acc)[2][2][4][2], const Unit& u, int wr, int wc, int fr, int fq) const {
        const int row0 = u.pm * BM + wr * 64 + fr, col0 = u.pn * BM + wc * 32 + 8 * fq;
#pragma unroll
        for (int ai = 0; ai < 2; ++ai)
#pragma unroll
            for (int m = 0; m < 4; ++m) { bf16_t* rowp = O + (size_t)(row0 + ai * HALF + m * 16) * ldc + col0;
#pragma unroll
                for (int bj = 0; bj < 2; ++bj) { const f32x4 v0 = acc[ai][bj][m][0], v1 = acc[ai][bj][m][1];
                    u32x4 w; w.x = pkbf(v0[0], v0[1]); w.y = pkbf(v0[2], v0[3]); w.z = pkbf(v1[0], v1[1]); w.w = pkbf(v1[2], v1[3]);
                    *(u32x4*)(rowp + bj * HALF) = w; } }
    }
};
struct EpiResid {
    static constexpr bool PERM = false, AFTER_DRAIN = false;
    const float* xin_lat; const float* xin_ctx; float* xout_lat; float* xout_ctx; const float* gate; int row_off;
    __device__ __forceinline__ void operator()(const f32x4 (&acc)[2][2][4][2], const Unit& u, int wr, int wc, int fr, int fq) const {
        const int rowt = row_off + u.pm * BM; const bool lat = rowt < TL; const int r = lat ? (rowt >> 12) : 8;
        const int row0 = rowt + wr * 64 + fr, col0 = u.pn * BM + wc * 32 + 4 * fq;
        const float* xi = lat ? xin_lat + (size_t)row0 * 1024 + col0 : xin_ctx + (size_t)(row0 - TL) * 1024 + col0;
        float* xo = lat ? xout_lat + (size_t)row0 * 1024 + col0 : xout_ctx + (size_t)(row0 - TL) * 1024 + col0;
        f32x4 g[2][2];
#pragma unroll
        for (int bj = 0; bj < 2; ++bj)
#pragma unroll
            for (int n = 0; n < 2; ++n) g[bj][n] = *(const f32x4*)(gate + r * 3072 + col0 + bj * HALF + n * 16);
#pragma unroll
        for (int ai = 0; ai < 2; ++ai) {
            f32x4 pre[4][2][2];
#pragma unroll
            for (int m = 0; m < 4; ++m)
#pragma unroll
                for (int bj = 0; bj < 2; ++bj)
#pragma unroll
                    for (int n = 0; n < 2; ++n) pre[m][bj][n] = *(const f32x4*)(xi + (size_t)(ai * HALF + m * 16) * 1024 + bj * HALF + n * 16);
            asm volatile("" ::: "memory");
#pragma unroll
            for (int m = 0; m < 4; ++m)
#pragma unroll
                for (int bj = 0; bj < 2; ++bj)
#pragma unroll
                    for (int n = 0; n < 2; ++n) *(f32x4*)(xo + (size_t)(ai * HALF + m * 16) * 1024 + bj * HALF + n * 16) = pre[m][bj][n] + g[bj][n] * acc[ai][bj][m][n];
            asm volatile("" ::: "memory");
        }
    }
};
struct EpiFnT {
    static constexpr bool PERM = true, AFTER_DRAIN = false;
    bf16_t* ATL; bf16_t* ATC;
    __device__ __forceinline__ void operator()(const f32x4 (&acc)[2][2][4][2], const Unit& u, int wr, int wc, int fr, int fq) const {
        const int row0 = u.pm * BM + wr * 64 + fr, col0 = u.pn * BM + wc * 32 + 8 * fq;
#pragma unroll
        for (int ai = 0; ai < 2; ++ai)
#pragma unroll
            for (int m = 0; m < 4; ++m) { const int mp = row0 + ai * HALF + m * 16, cs = mp >> 10, n = mp & 1023;
#pragma unroll
                for (int bj = 0; bj < 2; ++bj) { const int t0 = col0 + bj * HALF; bf16_t* dst;
                    if (t0 < TL) { const int b = t0 >> 12, l = t0 & 4095; dst = ATL + ((size_t)((b * 1024 + n) * 2 + cs)) * 4096 + l; }
                    else { const int tc = t0 - TL, b = tc >> 8, l = tc & 255; dst = ATC + ((size_t)((b * 1024 + n) * 2 + cs)) * 256 + l; }
                    const f32x4 v0 = acc[ai][bj][m][0], v1 = acc[ai][bj][m][1];
                    u32x4 w; w.x = pkbf(v0[0], v0[1]); w.y = pkbf(v0[2], v0[3]); w.z = pkbf(v1[0], v1[1]); w.w = pkbf(v1[2], v1[3]);
                    *(u32x4*)dst = w; } }
    }
};
struct EpiDft {
    static constexpr bool PERM = true, AFTER_DRAIN = false;
    const bf16_t* Z; bf16_t* OG; int rowbase; int L;
    __device__ __forceinline__ void operator()(const f32x4 (&acc)[2][2][4][2], const Unit& u, int wr, int wc, int fr, int fq) const {
        const int k0 = u.pm * BM + wr * 64 + fr; const int b = u.pn >> 2; const int n0 = (u.pn & 3) * 256 + wc * 32 + 8 * fq;
#pragma unroll
        for (int ai = 0; ai < 2; ++ai)
#pragma unroll
            for (int m = 0; m < 4; ++m) { const size_t R = (size_t)(rowbase + b * L + k0 + ai * HALF + m * 16);
#pragma unroll
                for (int bj = 0; bj < 2; ++bj) { const size_t off = R * 1024 + n0 + bj * HALF;
                    const u32x4 zz = *(const u32x4*)(Z + off);
                    const f32x4 v0 = acc[ai][bj][m][0], v1 = acc[ai][bj][m][1];
                    u32x4 w;
                    w.x = pkbf(v0[0] * silu_f(bflo(zz.x)), v0[1] * silu_f(bfhi(zz.x))); w.y = pkbf(v0[2] * silu_f(bflo(zz.y)), v0[3] * silu_f(bfhi(zz.y)));
                    w.z = pkbf(v1[0] * silu_f(bflo(zz.z)), v1[1] * silu_f(bfhi(zz.z))); w.w = pkbf(v1[2] * silu_f(bflo(zz.w)), v1[3] * silu_f(bfhi(zz.w)));
                    *(u32x4*)(OG + off) = w; } }
    }
};
struct EpiDftSym {
    static constexpr bool PERM = true, AFTER_DRAIN = false;
    const bf16_t* Pb; const float* TA; const bf16_t* Z; bf16_t* OG;
    __device__ __forceinline__ void operator()(const f32x4 (&acc)[2][2][4][2], const Unit& u, int wr, int wc, int fr, int fq) const {
        const int k0 = u.pm * BM + wr * 64 + fr; const int b = u.pn >> 2; const int c0 = u.pn * BM + wc * 32 + 8 * fq; const int n0 = c0 & 1023;
#pragma unroll
        for (int bj = 0; bj < 2; ++bj) {
            const f32x4 t0 = *(const f32x4*)(TA + c0 + bj * HALF), t1 = *(const f32x4*)(TA + c0 + bj * HALF + 4);
#pragma unroll
            for (int aim = 0; aim < 4; ++aim) { const int ai = aim >> 1, mh = (aim & 1) * 2;
                u32x4 pp[4], z1[4], z2[4];
#pragma unroll
                for (int m = mh; m < mh + 2; ++m) { const int k = k0 + ai * HALF + m * 16;
                    pp[m] = *(const u32x4*)(Pb + (size_t)k * 8192 + c0 + bj * HALF);
                    z1[m] = *(const u32x4*)(Z + (size_t)(b * 4096 + k) * 1024 + n0 + bj * HALF);
                    z2[m] = *(const u32x4*)(Z + (size_t)(b * 4096 + ((4096 - k) & 4095)) * 1024 + n0 + bj * HALF); }
                asm volatile("" ::: "memory");
#pragma unroll
                for (int m = mh; m < mh + 2; ++m) { const int k = k0 + ai * HALF + m * 16; const float sg = (k & 1) ? -1.f : 1.f;
                    const f32x4 q0 = acc[ai][bj][m][0], q1 = acc[ai][bj][m][1];
                    float pt[8];
                    pt[0] = bflo(pp[m].x) + sg * t0[0]; pt[1] = bfhi(pp[m].x) + sg * t0[1]; pt[2] = bflo(pp[m].y) + sg * t0[2]; pt[3] = bfhi(pp[m].y) + sg * t0[3];
                    pt[4] = bflo(pp[m].z) + sg * t1[0]; pt[5] = bfhi(pp[m].z) + sg * t1[1]; pt[6] = bflo(pp[m].w) + sg * t1[2]; pt[7] = bfhi(pp[m].w) + sg * t1[3];
                    { const size_t off = (size_t)(b * 4096 + k) * 1024 + n0 + bj * HALF; const u32x4 zz = z1[m]; u32x4 w;
                      w.x = pkbf((pt[0] - q0[0]) * silu_f(bflo(zz.x)), (pt[1] - q0[1]) * silu_f(bfhi(zz.x))); w.y = pkbf((pt[2] - q0[2]) * silu_f(bflo(zz.y)), (pt[3] - q0[3]) * silu_f(bfhi(zz.y)));
                      w.z = pkbf((pt[4] - q1[0]) * silu_f(bflo(zz.z)), (pt[5] - q1[1]) * silu_f(bfhi(zz.z))); w.w = pkbf((pt[6] - q1[2]) * silu_f(bflo(zz.w)), (pt[7] - q1[3]) * silu_f(bfhi(zz.w)));
                      *(u32x4*)(OG + off) = w; }
                    if (k >= 1) { const size_t off = (size_t)(b * 4096 + 4096 - k) * 1024 + n0 + bj * HALF; const u32x4 zz = z2[m]; u32x4 w;
                      w.x = pkbf((pt[0] + q0[0]) * silu_f(bflo(zz.x)), (pt[1] + q0[1]) * silu_f(bfhi(zz.x))); w.y = pkbf((pt[2] + q0[2]) * silu_f(bflo(zz.y)), (pt[3] + q0[3]) * silu_f(bfhi(zz.y)));
                      w.z = pkbf((pt[4] + q1[0]) * silu_f(bflo(zz.z)), (pt[5] + q1[1]) * silu_f(bfhi(zz.z))); w.w = pkbf((pt[6] + q1[2]) * silu_f(bflo(zz.w)), (pt[7] + q1[3]) * silu_f(bfhi(zz.w)));
                      *(u32x4*)(OG + off) = w; }
                }
                asm volatile("" ::: "memory");
            }
        }
    }
};
template <class Epi, class Sched, bool ALIGN_EPI = false, bool SP2 = false>
__device__ __forceinline__ void gemm_phase(PG8_LAS unsigned char* lds, const Gemm g, const Sched& S, const Epi& E) {
    const int tid = opaque_tid(), wid = __builtin_amdgcn_readfirstlane(tid >> 6), lane = tid & 63, wr = wid >> 2, wc = wid & 3, fr = lane & 15, fq = lane >> 4;
    const int K = g.K, nt = K / BK;
    unsigned voffA[2], voffB[2];
#pragma unroll
    for (int i = 0; i < 2; ++i) { int R, C; stage_rc(tid * 16 + i * 8192, R, C); const int Rb = Epi::PERM ? ((R & ~31) + perm32(R & 31)) : R;
        voffA[i] = (unsigned)(R * K + C) * 2u; voffB[i] = (unsigned)(Rb * K + C) * 2u; }
    const size_t kstep = (size_t)(BK * 2);
    const size_t hstep = (size_t)HALF * K * 2;
    const size_t tstep = 2 * hstep;
    const unsigned ldsw = (unsigned)wid * 1024u;
    const int aoff = lds_byte(wr * 64 + fr, fq * 8), boff = lds_byte(wc * 32 + fr, fq * 8);
#define PG8_SA(b, h) (((b) * 2 + (h)) * HTB)
#define PG8_SB(b, h) ((4 + (b) * 2 + (h)) * HTB)
#define PG8_STAGE(bufoff, gbase, voff) do { _Pragma("unroll") for (int _i = 0; _i < 2; ++_i) \
        __builtin_amdgcn_global_load_lds((const unsigned*)((const char*)(gbase) + (voff)[_i]), (PG8_LAS unsigned*)(lds + (bufoff) + ldsw + _i * 8192), 16, 0, 0); } while (0)
#define PG8_LDA(dst, b, h) do { _Pragma("unroll") for (int m = 0; m < 4; ++m) _Pragma("unroll") for (int k = 0; k < 2; ++k) dst[m][k] = *(const PG8_LAS bf16x8*)(lds + PG8_SA(b, h) + aoff + m * 2048 + k * 1024); } while (0)
#define PG8_LDB(dst, b, h) do { _Pragma("unroll") for (int n = 0; n < 2; ++n) _Pragma("unroll") for (int k = 0; k < 2; ++k) dst[n][k] = *(const PG8_LAS bf16x8*)(lds + PG8_SB(b, h) + boff + n * 2048 + k * 1024); } while (0)
#define PG8_MMA(ai, bj, At, Bt) do { __builtin_amdgcn_s_setprio(1); _Pragma("unroll") for (int m = 0; m < 4; ++m) _Pragma("unroll") for (int n = 0; n < 2; ++n) _Pragma("unroll") for (int k = 0; k < 2; ++k) \
        acc[ai][bj][m][n] = __builtin_amdgcn_mfma_f32_16x16x32_bf16(Bt[n][k], At[m][k], acc[ai][bj][m][n], 0, 0, 0); __builtin_amdgcn_s_setprio(0); } while (0)
#define PG8_WAIT_V(n) asm volatile("s_waitcnt vmcnt(" #n ")" ::: "memory")
#define PG8_WAIT_L(n) asm volatile("s_waitcnt lgkmcnt(" #n ")" ::: "memory")
#define PG8_BAR __builtin_amdgcn_s_barrier()
#define PG8_SCHED __builtin_amdgcn_sched_barrier(0)
    Unit cur, nxt; int ui = 0;
    if (!S.next(0, cur)) return;
    f32x4 acc[2][2][4][2];
#pragma unroll
    for (int a = 0; a < 2; ++a)
#pragma unroll
        for (int b = 0; b < 2; ++b)
#pragma unroll
            for (int m = 0; m < 4; ++m)
#pragma unroll
                for (int n = 0; n < 2; ++n) acc[a][b][m][n] = (f32x4){0.f, 0.f, 0.f, 0.f};
    bf16x8 At[4][2], B0[2][2], B1[2][2];
    const char* cA = (const char*)g.A + (size_t)cur.pm * tstep; const char* cB = (const char*)g.Bt + (size_t)cur.pn * tstep;
    S.a_ready(cur);
    if constexpr (SP2) {
        PG8_STAGE(PG8_SB(0, 0), cB, voffB); PG8_STAGE(PG8_SB(0, 1), cB + hstep, voffB); PG8_STAGE(PG8_SA(0, 0), cA, voffA); PG8_STAGE(PG8_SA(0, 1), cA + hstep, voffA);
        if (wr == 1) PG8_BAR;
        PG8_WAIT_V(2); PG8_BAR;
        PG8_STAGE(PG8_SB(1, 0), cB + kstep, voffB); PG8_STAGE(PG8_SA(1, 0), cA + kstep, voffA); PG8_STAGE(PG8_SB(1, 1), cB + hstep + kstep, voffB);
        PG8_WAIT_V(6); PG8_BAR;
    } else {
        PG8_STAGE(PG8_SB(0, 0), cB, voffB); PG8_STAGE(PG8_SA(0, 0), cA, voffA); PG8_STAGE(PG8_SB(0, 1), cB + hstep, voffB); PG8_STAGE(PG8_SA(0, 1), cA + hstep, voffA);
        if (wr == 1) PG8_BAR;
        PG8_WAIT_V(4); PG8_BAR;
        PG8_STAGE(PG8_SB(1, 0), cB + kstep, voffB); PG8_STAGE(PG8_SA(1, 0), cA + kstep, voffA); PG8_STAGE(PG8_SB(1, 1), cB + hstep + kstep, voffB);
        PG8_WAIT_V(6); PG8_BAR;
    }
    for (;;) {
        const bool has_next = S.next(ui + 1, nxt);
        const char* nA = has_next ? (const char*)g.A + (size_t)nxt.pm * tstep : cA; const char* nB = has_next ? (const char*)g.Bt + (size_t)nxt.pn * tstep : cB;
        for (int t = 0; t < nt; t += 2) {
            const bool last = (t == nt - 2);
            const char* a1 = cA + (size_t)(t + 1) * kstep;
            const char* a2 = last ? nA : cA + (size_t)(t + 2) * kstep; const char* b2 = last ? nB : cB + (size_t)(t + 2) * kstep;
            const char* a3 = a2 + kstep; const char* b3 = b2 + kstep;
            if (last && has_next) S.a_ready(nxt);
            if constexpr (SP2) {
            PG8_LDB(B0, 0, 0); PG8_LDB(B1, 0, 1); PG8_SCHED; PG8_LDA(At, 0, 0); PG8_STAGE(PG8_SA(1, 1), a1 + hstep, voffA);
            PG8_WAIT_V(8); PG8_WAIT_L(0); PG8_BAR; PG8_MMA(0, 0, At, B0); PG8_MMA(0, 1, At, B1); PG8_BAR; PG8_SCHED;
            PG8_LDA(At, 0, 1); PG8_STAGE(PG8_SB(0, 0), b2, voffB); PG8_STAGE(PG8_SB(0, 1), b2 + hstep, voffB); PG8_STAGE(PG8_SA(0, 0), a2, voffA);
            PG8_WAIT_V(8); PG8_WAIT_L(0); PG8_BAR; PG8_MMA(1, 0, At, B0); PG8_MMA(1, 1, At, B1); PG8_BAR; PG8_SCHED;
            PG8_LDB(B0, 1, 0); PG8_LDB(B1, 1, 1); PG8_SCHED; PG8_LDA(At, 1, 0); PG8_STAGE(PG8_SA(0, 1), a2 + hstep, voffA);
            PG8_WAIT_V(8); PG8_WAIT_L(0); PG8_BAR; PG8_MMA(0, 0, At, B0); PG8_MMA(0, 1, At, B1); PG8_BAR; PG8_SCHED;
            PG8_LDA(At, 1, 1); PG8_STAGE(PG8_SB(1, 0), b3, voffB); PG8_STAGE(PG8_SB(1, 1), b3 + hstep, voffB); PG8_STAGE(PG8_SA(1, 0), a3, voffA);
            PG8_WAIT_V(8); PG8_WAIT_L(0); PG8_BAR; PG8_MMA(1, 0, At, B0); PG8_MMA(1, 1, At, B1); PG8_BAR; PG8_SCHED;
            } else {
            PG8_LDB(B0, 0, 0); PG8_SCHED; PG8_LDA(At, 0, 0); PG8_STAGE(PG8_SA(1, 1), a1 + hstep, voffA);
            PG8_WAIT_L(8); PG8_BAR; PG8_WAIT_L(0); PG8_MMA(0, 0, At, B0); PG8_BAR; PG8_SCHED;
            PG8_LDB(B1, 0, 1); PG8_STAGE(PG8_SB(0, 0), b2, voffB);
            PG8_BAR; PG8_WAIT_L(0); PG8_MMA(0, 1, At, B1); PG8_BAR;
            PG8_LDA(At, 0, 1); PG8_STAGE(PG8_SA(0, 0), a2, voffA);
            PG8_BAR; PG8_WAIT_L(0); PG8_MMA(1, 0, At, B0); PG8_BAR; PG8_SCHED;
            PG8_STAGE(PG8_SB(0, 1), b2 + hstep, voffB);
            PG8_WAIT_V(6); PG8_BAR; PG8_MMA(1, 1, At, B1); PG8_BAR;
            PG8_LDB(B0, 1, 0); PG8_SCHED; PG8_LDA(At, 1, 0); PG8_STAGE(PG8_SA(0, 1), a2 + hstep, voffA);
            PG8_WAIT_L(8); PG8_BAR; PG8_WAIT_L(0); PG8_MMA(0, 0, At, B0); PG8_BAR; PG8_SCHED;
            PG8_LDB(B1, 1, 1); PG8_STAGE(PG8_SB(1, 0), b3, voffB);
            PG8_BAR; PG8_WAIT_L(0); PG8_MMA(0, 1, At, B1); PG8_BAR;
            PG8_LDA(At, 1, 1); PG8_STAGE(PG8_SA(1, 0), a3, voffA);
            PG8_BAR; PG8_WAIT_L(0); PG8_MMA(1, 0, At, B0); PG8_BAR; PG8_SCHED;
            PG8_STAGE(PG8_SB(1, 1), b3 + hstep, voffB);
            PG8_WAIT_V(6); PG8_BAR; PG8_MMA(1, 1, At, B1); PG8_BAR;
            }
        }
        if constexpr (ALIGN_EPI) { if (wr == 0) PG8_BAR; }
        if constexpr (!Epi::AFTER_DRAIN) { E(acc, cur, wr, wc, fr, fq); S.done(cur); }
        if (!has_next) break;
#pragma unroll
        for (int a = 0; a < 2; ++a)
#pragma unroll
            for (int b = 0; b < 2; ++b)
#pragma unroll
                for (int m = 0; m < 4; ++m)
#pragma unroll
                    for (int n = 0; n < 2; ++n) acc[a][b][m][n] = (f32x4){0.f, 0.f, 0.f, 0.f};
        cur = nxt; cA = nA; cB = nB; ++ui;
        if constexpr (ALIGN_EPI) { if (wr == 1) PG8_BAR; }
    }
    PG8_WAIT_V(0);
    if constexpr (!ALIGN_EPI) { if (wr == 0) PG8_BAR; }
    PG8_BAR;
    if constexpr (Epi::AFTER_DRAIN) { E.fused(acc, cur, wr, wc, fr, fq, lds, wid, lane); S.done(cur); }
#undef PG8_SA
#undef PG8_SB
#undef PG8_STAGE
#undef PG8_LDA
#undef PG8_LDB
#undef PG8_MMA
#undef PG8_WAIT_V
#undef PG8_WAIT_L
#undef PG8_BAR
#undef PG8_SCHED
}
}
#define LAS __attribute__((address_space(3)))
namespace att {
using bf16x8 = __attribute__((ext_vector_type(8))) short;
using s16x4 = __attribute__((ext_vector_type(4))) short;
using f32x16 = __attribute__((ext_vector_type(16))) float;
using u32x4 = __attribute__((ext_vector_type(4))) unsigned;
typedef unsigned short bf16_t;
__device__ __forceinline__ int crow(int r, int hi) { return (r & 3) + 8 * (r >> 2) + 4 * hi; }
typedef float f32x4_t __attribute__((ext_vector_type(4)));
template <int CTRL> __device__ __forceinline__ float adpp(float v) { return __int_as_float(__builtin_amdgcn_update_dpp(0, __float_as_int(v), CTRL, 0xf, 0xf, true)); }
constexpr int KSLOT = 8192, VSLOT = 16384, LDS_K = 0, LDS_V = 3 * KSLOT, LDS_WS = LDS_V + 4 * VSLOT, LDS_CNT = LDS_WS + 2048;
struct Args { const bf16_t* Q; const bf16_t* K; const bf16_t* V; const bf16_t* Z; bf16_t* O; const float* gain; float lam; float oml; int n_units; unsigned* o1g; };

__device__ __forceinline__ void qkt(f32x16& p0, f32x16& p1, const LAS char* Kslot, const bf16x8* qr, const f32x16& negm, int r32, int hi) {
    const LAS char* kb = Kslot + hi * 1024 + r32 * 16;
    bf16x8 kf[8];
#pragma unroll
    for (int d0 = 0; d0 < 4; ++d0) { kf[2 * d0] = *(const LAS bf16x8*)(kb + d0 * 2048); kf[2 * d0 + 1] = *(const LAS bf16x8*)(kb + d0 * 2048 + 512); }
    asm volatile("s_waitcnt lgkmcnt(0)" ::: "memory"); __builtin_amdgcn_sched_barrier(0);
    p0 = __builtin_amdgcn_mfma_f32_32x32x16_bf16(kf[0], qr[0], negm, 0, 0, 0); p1 = __builtin_amdgcn_mfma_f32_32x32x16_bf16(kf[1], qr[0], negm, 0, 0, 0);
#pragma unroll
    for (int d0 = 1; d0 < 4; ++d0) { p0 = __builtin_amdgcn_mfma_f32_32x32x16_bf16(kf[2 * d0], qr[d0], p0, 0, 0, 0); p1 = __builtin_amdgcn_mfma_f32_32x32x16_bf16(kf[2 * d0 + 1], qr[d0], p1, 0, 0, 0); }
}
__device__ __forceinline__ void kload(bf16x8* kf, const LAS char* Kslot, int r32, int hi) {
    const LAS char* kb = Kslot + hi * 1024 + r32 * 16;
#pragma unroll
    for (int d0 = 0; d0 < 2; ++d0) { kf[2 * d0] = *(const LAS bf16x8*)(kb + d0 * 2048); kf[2 * d0 + 1] = *(const LAS bf16x8*)(kb + d0 * 2048 + 512); }
}
__device__ __forceinline__ void qk_mm(f32x16& p0, f32x16& p1, const bf16x8* kf, const LAS char* Kslot, int r32, int hi, const bf16x8* qr, const f32x16& z) {
    const LAS char* kb = Kslot + hi * 1024 + r32 * 16;
    p0 = __builtin_amdgcn_mfma_f32_32x32x16_bf16(kf[0], qr[0], z, 0, 0, 0); p1 = __builtin_amdgcn_mfma_f32_32x32x16_bf16(kf[1], qr[0], z, 0, 0, 0);
    p0 = __builtin_amdgcn_mfma_f32_32x32x16_bf16(kf[2], qr[1], p0, 0, 0, 0); p1 = __builtin_amdgcn_mfma_f32_32x32x16_bf16(kf[3], qr[1], p1, 0, 0, 0);
    bf16x8 kg[4];
#pragma unroll
    for (int d0 = 2; d0 < 4; ++d0) { kg[2 * (d0 - 2)] = *(const LAS bf16x8*)(kb + d0 * 2048); kg[2 * (d0 - 2) + 1] = *(const LAS bf16x8*)(kb + d0 * 2048 + 512); }
    p0 = __builtin_amdgcn_mfma_f32_32x32x16_bf16(kg[0], qr[2], p0, 0, 0, 0); p1 = __builtin_amdgcn_mfma_f32_32x32x16_bf16(kg[1], qr[2], p1, 0, 0, 0);
    p0 = __builtin_amdgcn_mfma_f32_32x32x16_bf16(kg[2], qr[3], p0, 0, 0, 0); p1 = __builtin_amdgcn_mfma_f32_32x32x16_bf16(kg[3], qr[3], p1, 0, 0, 0);
}
__device__ __forceinline__ float max3a(float a, float b, float c) { float r; asm("v_max3_f32 %0, %1, %2, %3" : "=v"(r) : "v"(a), "v"(b), "v"(c)); return r; }
__device__ __forceinline__ float rowmax(const f32x16& p0, const f32x16& p1) {
    float a = max3a(p0[0], p0[1], p0[2]), b = max3a(p1[0], p1[1], p1[2]);
#pragma unroll
    for (int r = 3; r < 15; r += 2) { a = max3a(a, p0[r], p0[r + 1]); b = max3a(b, p1[r], p1[r + 1]); }
    a = max3a(a, p0[15], p1[15]);
    float m; asm("v_max_f32 %0, %1, %2" : "=v"(m) : "v"(a), "v"(b));
    asm volatile("s_nop 1" ::: "memory");
    auto rr = __builtin_amdgcn_permlane32_swap(__float_as_uint(m), __float_as_uint(m), false, false);
    float o; asm("v_max_f32 %0, %1, %2" : "=v"(o) : "v"(__uint_as_float(rr[0])), "v"(__uint_as_float(rr[1])));
    return o;
}
#define ATT_VRD(buf, d0) do { _Pragma("unroll") for (int ks = 0; ks < 4; ++ks) { \
        asm volatile("ds_read_b64_tr_b16 %0,%1 offset:%c2" : "=&v"(lo[buf][ks]) : "v"(vb), "i"((d0) * 4096 + ks * 1024) : "memory"); \
        asm volatile("ds_read_b64_tr_b16 %0,%1 offset:%c2" : "=&v"(hi[buf][ks]) : "v"(vb), "i"((d0) * 4096 + ks * 1024 + 512) : "memory"); } } while (0)
#define ATT_PK(b, k) (bf16x8){lo[b][k][0], lo[b][k][1], lo[b][k][2], lo[b][k][3], hi[b][k][0], hi[b][k][1], hi[b][k][2], hi[b][k][3]}
#define ATT_MM2(da, db) do { \
        o[da] = __builtin_amdgcn_mfma_f32_32x32x16_bf16(pa0, ATT_PK(0, 0), o[da], 0, 0, 0); o[db] = __builtin_amdgcn_mfma_f32_32x32x16_bf16(pa0, ATT_PK(1, 0), o[db], 0, 0, 0); \
        o[da] = __builtin_amdgcn_mfma_f32_32x32x16_bf16(pa1, ATT_PK(0, 1), o[da], 0, 0, 0); o[db] = __builtin_amdgcn_mfma_f32_32x32x16_bf16(pa1, ATT_PK(1, 1), o[db], 0, 0, 0); \
        o[da] = __builtin_amdgcn_mfma_f32_32x32x16_bf16(pa2, ATT_PK(0, 2), o[da], 0, 0, 0); o[db] = __builtin_amdgcn_mfma_f32_32x32x16_bf16(pa2, ATT_PK(1, 2), o[db], 0, 0, 0); \
        o[da] = __builtin_amdgcn_mfma_f32_32x32x16_bf16(pa3, ATT_PK(0, 3), o[da], 0, 0, 0); o[db] = __builtin_amdgcn_mfma_f32_32x32x16_bf16(pa3, ATT_PK(1, 3), o[db], 0, 0, 0); } while (0)
__device__ __forceinline__ void pv(f32x16* o, int vb, bf16x8 pa0, bf16x8 pa1, bf16x8 pa2, bf16x8 pa3) {
    s16x4 lo[2][4], hi[2][4];
    ATT_VRD(0, 0);
    ATT_VRD(1, 1);
    asm volatile("s_waitcnt lgkmcnt(0)" ::: "memory"); __builtin_amdgcn_sched_barrier(0);
    ATT_MM2(0, 1); __builtin_amdgcn_sched_barrier(0);
    ATT_VRD(0, 2);
    ATT_VRD(1, 3);
    asm volatile("s_waitcnt lgkmcnt(0)" ::: "memory"); __builtin_amdgcn_sched_barrier(0);
    ATT_MM2(2, 3);
}
#undef ATT_MM2
#undef ATT_VRD
#undef ATT_PK
__device__ __forceinline__ void attn_pass(const Args& A, int z, int b, int h, int qrow0, bool isctx, bool pathB, LAS char* shm, f32x16* o) {
    const int tid = opaque_tid(), lane = tid & 63, r32 = lane & 31, hi = lane >> 5; const int wid = __builtin_amdgcn_readfirstlane(tid >> 6);
    const int NT = isctx ? 4 : 68;
    LAS float* wsf = (LAS float*)(shm + LDS_WS) + wid * 64;
    const int vb0 = (int)(unsigned)(size_t)(shm + LDS_V) + ((lane >> 4) & 1) * 32 + (lane & 3) * 8 + (4 * hi + ((lane & 15) >> 2)) * 64;
    const bf16_t* Qw = A.Q + (size_t)(qrow0 + wid * 32 + r32) * 1024 + h * 128 + z * 64;
    bf16x8 qr[4];
#pragma unroll
    for (int d0 = 0; d0 < 4; ++d0) qr[d0] = *(const bf16x8*)(Qw + d0 * 16 + hi * 8);
    const bf16_t* Kh = A.K + (size_t)((h * 2 + z) * 8 + wid) * 512 + lane * 8;
    const int pc0 = wid, pc1 = wid + 8;
    const bf16_t* Vh0 = A.V + (size_t)h * 8192 + pc0 * 512 + lane * 8;
    const bf16_t* Vh1 = A.V + (size_t)h * 8192 + pc1 * 512 + lane * 8;
    const int ctxrow = TL + b * 256, latrow = b * 4096;
#define ATT_TROW(t) ((isctx || (t) < 4) ? (ctxrow + 64 * (t)) : (latrow + 64 * ((t) - 4)))
#define ATT_DMA(t, slot, vslot) do { const size_t ro_ = (size_t)(ATT_TROW(t) >> 6) * 65536; \
        __builtin_amdgcn_global_load_lds((const unsigned*)(Kh + ro_), (LAS unsigned*)(shm + LDS_K + (slot) * KSLOT + wid * 1024), 16, 0, 0); \
        __builtin_amdgcn_global_load_lds((const unsigned*)(Vh0 + ro_), (LAS unsigned*)(shm + LDS_V + (vslot) * VSLOT + pc0 * 1024), 16, 0, 0); \
        __builtin_amdgcn_global_load_lds((const unsigned*)(Vh1 + ro_), (LAS unsigned*)(shm + LDS_V + (vslot) * VSLOT + pc1 * 1024), 16, 0, 0); } while (0)
    float mhat = 0.f, l_reg = 0.f;
    const f32x16 negm = f32x16{};
#pragma unroll
    for (int d = 0; d < 4; ++d) o[d] = f32x16{};
    ATT_DMA(0, 0, 0);
    if (NT > 1) ATT_DMA(1, 1, 1);
    asm volatile("s_waitcnt vmcnt(0) lgkmcnt(0)\n\ts_barrier" ::: "memory");
    f32x16 sc0, sc1;
    { bf16x8 kf[4]; kload(kf, shm + LDS_K, r32, hi); qk_mm(sc0, sc1, kf, shm + LDS_K, r32, hi, qr, negm); asm volatile("s_nop 15\n\ts_nop 15" : "+v"(sc0), "+v"(sc1)); }
    if (NT > 2) ATT_DMA(2, 2, 2);
    int k_cur = 0, v_cur = 0, v_prev = 3;
    u32x4 pw0 = {0u, 0u, 0u, 0u}, pw1 = pw0, pw2 = pw0, pw3 = pw0;
#pragma unroll 1
    for (int t = 0; t <= NT; ++t) {
        const int k_n1 = (k_cur == 2) ? 0 : k_cur + 1;
        if (t > 0) {
            asm volatile("s_waitcnt vmcnt(0) lgkmcnt(0)\n\ts_barrier" ::: "memory");
            const int k_p2 = (k_cur == 0) ? 2 : k_cur - 1;
            const int v_p2 = (v_cur + 2) & 3;
            if (t + 2 < NT) ATT_DMA(t + 2, k_p2, v_p2);
        }
        if (pathB && t > 0) {
            pv(o, vb0 + v_prev * VSLOT, __builtin_bit_cast(bf16x8, pw0), __builtin_bit_cast(bf16x8, pw1), __builtin_bit_cast(bf16x8, pw2), __builtin_bit_cast(bf16x8, pw3)); }
        if (t < NT) {
        const float rm = rowmax(sc0, sc1);
        if (t == 0 || __any(rm > 8.f)) {
            const float dl = (t == 0) ? rm : fmaxf(rm, 0.f); mhat += dl;
#pragma unroll
            for (int r = 0; r < 16; ++r) { sc0[r] -= dl; sc1[r] -= dl; }
            if (t > 0) {
                const float f = __builtin_amdgcn_exp2f(-dl); l_reg *= f;
                if (hi == 0) wsf[r32] = f;
                asm volatile("s_waitcnt lgkmcnt(0)" ::: "memory");
#pragma unroll
                for (int r = 0; r < 16; ++r) { const float fr_ = wsf[crow(r, hi)];
#pragma unroll
                    for (int d = 0; d < 4; ++d) o[d][r] *= fr_; }
                asm volatile("s_waitcnt lgkmcnt(0)" ::: "memory");
            }
        }
        bf16x8 kf[4];
        kload(kf, shm + LDS_K + k_n1 * KSLOT, r32, hi);
        __builtin_amdgcn_sched_barrier(0);
        f32x16 pn0, pn1;
        { f32x16 nm;
#pragma unroll
          for (int r = 0; r < 16; ++r) nm[r] = -mhat;
          qk_mm(pn0, pn1, kf, shm + LDS_K + k_n1 * KSLOT, r32, hi, qr, nm); }
        f32x2_t sacc = {0.f, 0.f};
#pragma unroll
        for (int r = 0; r < 16; r += 2) { sc0[r] = __builtin_amdgcn_exp2f(sc0[r]); sc0[r + 1] = __builtin_amdgcn_exp2f(sc0[r + 1]); sc1[r] = __builtin_amdgcn_exp2f(sc1[r]); sc1[r + 1] = __builtin_amdgcn_exp2f(sc1[r + 1]);
            sacc += (f32x2_t){sc0[r], sc0[r + 1]}; sacc += (f32x2_t){sc1[r], sc1[r + 1]}; }
        l_reg += sacc.x + sacc.y;
        pw0 = (u32x4){pkbf(sc0[0], sc0[1]), pkbf(sc0[2], sc0[3]), pkbf(sc0[4], sc0[5]), pkbf(sc0[6], sc0[7])};
        pw1 = (u32x4){pkbf(sc0[8], sc0[9]), pkbf(sc0[10], sc0[11]), pkbf(sc0[12], sc0[13]), pkbf(sc0[14], sc0[15])};
        pw2 = (u32x4){pkbf(sc1[0], sc1[1]), pkbf(sc1[2], sc1[3]), pkbf(sc1[4], sc1[5]), pkbf(sc1[6], sc1[7])};
        pw3 = (u32x4){pkbf(sc1[8], sc1[9]), pkbf(sc1[10], sc1[11]), pkbf(sc1[12], sc1[13]), pkbf(sc1[14], sc1[15])};
#pragma unroll
        for (int i = 0; i < 8; ++i) { __builtin_amdgcn_sched_group_barrier(0x008, 1, 0); __builtin_amdgcn_sched_group_barrier(0x002, 10, 0); }
        __builtin_amdgcn_sched_barrier(0);
        if (!pathB) {
            pv(o, vb0 + v_cur * VSLOT, __builtin_bit_cast(bf16x8, pw0), __builtin_bit_cast(bf16x8, pw1), __builtin_bit_cast(bf16x8, pw2), __builtin_bit_cast(bf16x8, pw3)); }
        sc0 = pn0; sc1 = pn1;
        }
        k_cur = k_n1; v_prev = v_cur; v_cur = (v_cur + 1) & 3;
    }
    asm volatile("s_waitcnt lgkmcnt(0)\n\ts_barrier" ::: "memory");
#undef ATT_DMA
#undef ATT_TROW
    { auto rr = __builtin_amdgcn_permlane32_swap(__float_as_uint(l_reg), __float_as_uint(l_reg), false, false); l_reg = __uint_as_float(rr[0]) + __uint_as_float(rr[1]); }
    asm volatile("s_waitcnt lgkmcnt(0)" ::: "memory");
    if (hi == 0) wsf[32 + r32] = l_reg;
    asm volatile("s_waitcnt lgkmcnt(0)" ::: "memory");
#pragma unroll
    for (int r = 0; r < 16; ++r) { const float rl = 1.0f / wsf[32 + crow(r, hi)];
#pragma unroll
        for (int d = 0; d < 4; ++d) o[d][r] *= rl; }
    asm volatile("s_waitcnt lgkmcnt(0)" ::: "memory");
}
__device__ __forceinline__ void attn_unit(const Args& A, int b, int h, int qb, bool isctx, bool pathB, LAS char* shm) {
    const int tid = opaque_tid(), lane = tid & 63, r32 = lane & 31, hi = lane >> 5; const int wid = __builtin_amdgcn_readfirstlane(tid >> 6);
    const int qrow0 = isctx ? (TL + b * 256) : (b * 4096 + qb * 256);
    f32x16 o[4];
    unsigned* o1s = A.o1g + wid * 2048 + lane;
    attn_pass(A, 0, b, h, qrow0, isctx, pathB, shm, o);
#pragma unroll
    for (int d = 0; d < 4; ++d)
#pragma unroll
        for (int r = 0; r < 16; r += 2) o1s[(d * 8 + (r >> 1)) * 64] = pkbf(o[d][r], o[d][r + 1]);
    asm volatile("s_waitcnt lgkmcnt(0)" ::: "memory");
    attn_pass(A, 1, b, h, qrow0, isctx, pathB, shm, o);
#pragma unroll
    for (int r = 0; r < 16; r += 2)
#pragma unroll
        for (int d = 0; d < 4; ++d) { const unsigned pk = o1s[(d * 8 + (r >> 1)) * 64]; o[d][r] = bflo(pk) - A.lam * o[d][r]; o[d][r + 1] = bfhi(pk) - A.lam * o[d][r + 1]; }
    LAS float* stg = (LAS float*)shm + wid * (32 * 68);
    const int rq = lane >> 3, cq = lane & 7;
    float vals[2][4][8]; float ssr[4] = {0.f, 0.f, 0.f, 0.f};
#pragma unroll
    for (int hf = 0; hf < 2; ++hf) {
#pragma unroll
        for (int r = 0; r < 16; ++r) { stg[crow(r, hi) * 68 + r32] = o[2 * hf][r]; stg[crow(r, hi) * 68 + 32 + r32] = o[2 * hf + 1][r]; }
        asm volatile("s_waitcnt lgkmcnt(0)" ::: "memory");
#pragma unroll
        for (int i = 0; i < 4; ++i) { const f32x4_t u0 = *(const LAS f32x4_t*)(stg + (rq + 8 * i) * 68 + cq * 8), u1 = *(const LAS f32x4_t*)(stg + (rq + 8 * i) * 68 + cq * 8 + 4);
#pragma unroll
            for (int c = 0; c < 4; ++c) { vals[hf][i][c] = u0[c]; vals[hf][i][4 + c] = u1[c]; ssr[i] += u0[c] * u0[c] + u1[c] * u1[c]; } }
        asm volatile("s_waitcnt lgkmcnt(0)" ::: "memory");
    }
#pragma unroll
    for (int i = 0; i < 4; ++i) { float v = ssr[i]; v += adpp<0xB1>(v); v += adpp<0x4E>(v); v += adpp<0x141>(v); ssr[i] = rsqrtf(v * (1.0f / 128.0f) + 1e-5f) * A.oml; }
#pragma unroll
    for (int hf = 0; hf < 2; ++hf) {
        const int col = h * 128 + hf * 64 + cq * 8;
        const f32x4_t g0 = *(const f32x4_t*)(A.gain + hf * 64 + cq * 8), g1 = *(const f32x4_t*)(A.gain + hf * 64 + cq * 8 + 4);
        u32x4 zz[4];
#pragma unroll
        for (int i = 0; i < 4; ++i) zz[i] = *(const u32x4*)(A.Z + (size_t)(qrow0 + wid * 32 + rq + 8 * i) * 1024 + col);
#pragma unroll
        for (int i = 0; i < 4; ++i) { const float rs = ssr[i]; const float* vv = vals[hf][i]; u32x4 w;
            w.x = pkbf(vv[0] * rs * g0[0] * silu_f(bflo(zz[i].x)), vv[1] * rs * g0[1] * silu_f(bfhi(zz[i].x)));
            w.y = pkbf(vv[2] * rs * g0[2] * silu_f(bflo(zz[i].y)), vv[3] * rs * g0[3] * silu_f(bfhi(zz[i].y)));
            w.z = pkbf(vv[4] * rs * g1[0] * silu_f(bflo(zz[i].z)), vv[5] * rs * g1[1] * silu_f(bfhi(zz[i].z)));
            w.w = pkbf(vv[6] * rs * g1[2] * silu_f(bflo(zz[i].w)), vv[7] * rs * g1[3] * silu_f(bfhi(zz[i].w)));
            *(u32x4*)(A.O + (size_t)(qrow0 + wid * 32 + rq + 8 * i) * 1024 + col) = w; }
    }
}
__device__ __forceinline__ void attn_phase(const Args& A, LAS char* shm, int G, int bid) {
    const int vcu = (G % 8 == 0) ? (bid % 8) * (G / 8) + bid / 8 : bid;
    bool pathB;
    { const int tid = opaque_tid(); LAS unsigned* cnt = (LAS unsigned*)(shm + LDS_CNT);
      if (tid < 4) cnt[tid] = 0u;
      __syncthreads();
      const unsigned simd = (unsigned)__builtin_amdgcn_s_getreg((1 << 11) | (4 << 6) | 4) & 3u;
      unsigned slot = 0u; if ((tid & 63) == 0) slot = __hip_atomic_fetch_add(cnt + simd, 1u, __ATOMIC_RELAXED, __HIP_MEMORY_SCOPE_WORKGROUP);
      slot = (unsigned)__builtin_amdgcn_readfirstlane((int)slot);
      pathB = (slot & 1u) != 0u;
      __syncthreads(); }
#pragma unroll 1
    for (int u = vcu; u < A.n_units; u += G) {
        const bool isctx = u >= 1024; const int bh = isctx ? (u - 1024) : (u >> 4); const int qb = isctx ? 0 : (u & 15);
        attn_unit(A, bh >> 3, bh & 7, qb, isctx, pathB, shm);
        asm volatile("s_waitcnt vmcnt(0) lgkmcnt(0)\n\ts_barrier" ::: "memory");
    }
}
}
typedef unsigned short bf16_t;
typedef float f32x4 __attribute__((ext_vector_type(4)));
typedef unsigned u32x4 __attribute__((ext_vector_type(4)));
typedef unsigned u32x2 __attribute__((ext_vector_type(2)));
constexpr size_t MiB = 1u << 20;
constexpr size_t WS_CTL = 0, WS_MOD = 1 * MiB, WS_ROPE = 1 * MiB + 512 * 1024, WS_BZ = 2 * MiB;
constexpr size_t WS_WDAIN = 9 * MiB, WS_WDAOUT = 25 * MiB, WS_WFNT = 29 * MiB, WS_WFNZ = 33 * MiB, WS_WFNOUT = 35 * MiB, WS_WRWIN = 37 * MiB, WS_WRWOUT = 46 * MiB;
constexpr size_t WS_XC = 48 * MiB, WS_HB = 56 * MiB, WS_BIG = 124 * MiB;
constexpr size_t WS_Q = WS_BIG, WS_K = WS_BIG + 68 * MiB, WS_V = WS_BIG + 136 * MiB, WS_Z = WS_BIG + 204 * MiB;
constexpr size_t WS_ATL = WS_BIG, WS_ATC = WS_BIG + 128 * MiB, WS_ZB = WS_BIG + 136 * MiB, WS_DFTL = 396 * MiB, WS_DFTC = 460 * MiB, WS_FOLD = WS_BIG + 204 * MiB;
constexpr size_t WS_P = WS_BIG, WS_Y1 = 413 * MiB, WS_END = 482 * MiB;
constexpr int RWN = 4352;
constexpr int LDS_BYTES = 147456;

struct Params { const float* in[28]; float* out; unsigned char* ws; };

__device__ __forceinline__ float wave_sum(float v) {
#pragma unroll
    for (int o = 1; o < 64; o <<= 1) v += __shfl_xor(v, o);
    return v;
}
__device__ __forceinline__ void tr_item(const float* W, int ldw, int N, bf16_t* WT, int ldt, LAS float* scr, int item, int lane) {
    const int nblk = N / 32, kb = item / nblk, nb = item % nblk, k0 = 64 * kb, n0 = 32 * nb;
    float v_[32];
#pragma unroll
    for (int i = 0; i < 32; ++i) v_[i] = W[(size_t)(k0 + 2 * i + (lane >> 5)) * ldw + n0 + (lane & 31)];
#pragma unroll
    for (int i = 0; i < 32; ++i) scr[(2 * i + (lane >> 5)) * 33 + (lane & 31)] = v_[i];
    asm volatile("s_waitcnt lgkmcnt(0)" ::: "memory");
    const int c = lane & 7;
#pragma unroll
    for (int j = 0; j < 4; ++j) { const int n = (lane >> 3) + 8 * j; const LAS float* s = scr + (8 * c) * 33 + n;
        u32x4 o; o.x = pkbf(s[0 * 33], s[1 * 33]); o.y = pkbf(s[2 * 33], s[3 * 33]); o.z = pkbf(s[4 * 33], s[5 * 33]); o.w = pkbf(s[6 * 33], s[7 * 33]);
        *(u32x4*)(WT + (size_t)(n0 + n) * ldt + k0 + 8 * c) = o; }
    asm volatile("s_waitcnt lgkmcnt(0)" ::: "memory");
}
__device__ __forceinline__ void prologue(const Params& p, LAS char* lds, int G, int bid) {
    const int tid = opaque_tid(), lane = tid & 63, wid = tid >> 6;
    unsigned char* ws = p.ws;
    {
        LAS float* scr = (LAS float*)(lds + wid * 8448);
        const int gw = bid * 8 + wid, NGW = G * 8;
        for (int it = gw; it < 8832; it += NGW) {
            int r = it;
            if (r < 2048) { tr_item(p.in[8], 4096, 4096, (bf16_t*)(ws + WS_WDAIN), 1024, scr, r, lane); continue; } r -= 2048;
            if (r < 2048) { tr_item(p.in[8] + (size_t)1024 * 4096, 4096, 4096, (bf16_t*)(ws + WS_WDAIN + 8 * MiB), 1024, scr, r, lane); continue; } r -= 2048;
            if (r < 512) { tr_item(p.in[12], 1024, 1024, (bf16_t*)(ws + WS_WDAOUT), 1024, scr, r, lane); continue; } r -= 512;
            if (r < 512) { tr_item(p.in[12] + (size_t)1024 * 1024, 1024, 1024, (bf16_t*)(ws + WS_WDAOUT + 2 * MiB), 1024, scr, r, lane); continue; } r -= 512;
            if (r < 512) { tr_item(p.in[13] + 1024, 2048, 1024, (bf16_t*)(ws + WS_WFNZ), 1024, scr, r, lane); continue; } r -= 512;
            if (r < 512) { tr_item(p.in[15], 1024, 1024, (bf16_t*)(ws + WS_WFNOUT), 1024, scr, r, lane); continue; } r -= 512;
            if (r < 2176) { tr_item(p.in[16], RWN, RWN, (bf16_t*)(ws + WS_WRWIN), 1024, scr, r, lane); continue; } r -= 2176;
            tr_item(p.in[27], 1024, 1024, (bf16_t*)(ws + WS_WRWOUT), 1024, scr, r, lane);
        }
    }
    __syncthreads();
    for (int it = bid; it < 256; it += G) {
        const int g = it >> 5, cs = (it >> 4) & 1, kq = it & 15;
        LAS float* Wcs = (LAS float*)lds; LAS float* win = (LAS float*)(lds + 65536); LAS float* tab = (LAS float*)(lds + 65536 + 33024);
        if (tid < 128) { float s, c; sincospif((float)tid / 64.f, &s, &c); tab[tid] = (cs ? s : c) * 0.08838834764831845f; }
        __syncthreads();
        {
            const int e0 = (tid & 31) * 4, cq = tid >> 5; f32x4 acc[8];
#pragma unroll
            for (int i = 0; i < 8; ++i) acc[i] = (f32x4){0.f, 0.f, 0.f, 0.f};
            const float* Wg = p.in[14] + (size_t)g * 128 * 128;
            for (int m = 0; m < 128; ++m) { const f32x4 wg = *(const f32x4*)(Wg + m * 128 + e0);
#pragma unroll
                for (int i = 0; i < 8; ++i) acc[i] += wg * tab[(m * (cq + 16 * i)) & 127]; }
#pragma unroll
            for (int i = 0; i < 8; ++i) *(LAS f32x4*)(Wcs + (cq + 16 * i) * 128 + e0) = acc[i];
        }
#pragma unroll
        for (int i = 0; i < 16; ++i) { const int idx = tid + 512 * i, kin = idx >> 7, c = idx & 127; win[kin * 129 + c] = p.in[13][(size_t)(kq * 64 + kin) * 2048 + g * 128 + c]; }
        __syncthreads();
        {
            const int kin = tid & 63, eg = tid >> 6; float acc[16];
#pragma unroll
            for (int i = 0; i < 16; ++i) acc[i] = 0.f;
            for (int c = 0; c < 128; ++c) { const float a = win[kin * 129 + c];
#pragma unroll
                for (int i = 0; i < 16; ++i) acc[i] += a * Wcs[c * 128 + eg * 16 + i]; }
            bf16_t* WT = (bf16_t*)(ws + WS_WFNT);
#pragma unroll
            for (int i = 0; i < 16; ++i) WT[(size_t)(cs * 1024 + g * 128 + eg * 16 + i) * 1024 + kq * 64 + kin] = (bf16_t)(pkbf(acc[i], 0.f) & 0xffffu);
        }
        __syncthreads();
    }
    {
        LAS float* tc = (LAS float*)lds; LAS float* ts = (LAS float*)(lds + 16384);
        for (int j = tid; j < 4096; j += 512) { float s, c; sincospif((float)j / 2048.f, &s, &c); tc[j] = c; ts[j] = -s; }
        __syncthreads();
        bf16_t* DL = (bf16_t*)(ws + WS_DFTL); bf16_t* DC = (bf16_t*)(ws + WS_DFTC);
        for (int k = bid; k < 2048; k += G) {
            const int j0 = (tid & 255) * 8; const bool sn = tid >= 256; float v8[8];
#pragma unroll
            for (int i = 0; i < 8; ++i) { const int idx = (k * (j0 + i)) & 4095; v8[i] = (sn ? -ts[idx] : tc[idx]) * 0.015625f; }
            u32x4 o; o.x = pkbf(v8[0], v8[1]); o.y = pkbf(v8[2], v8[3]); o.z = pkbf(v8[4], v8[5]); o.w = pkbf(v8[6], v8[7]);
            *(u32x4*)(DL + (sn ? (size_t)2048 * 2048 : (size_t)0) + (size_t)k * 2048 + j0) = o;
        }
        for (int k = bid; k < 256; k += G) {
            if (tid < 64) { const int cs = tid >> 5, l0 = (tid & 31) * 8; float v8[8];
#pragma unroll
                for (int i = 0; i < 8; ++i) { const int idx = ((k * (l0 + i)) & 255) * 16; v8[i] = (cs ? ts[idx] : tc[idx]) * 0.0625f; }
                u32x4 o; o.x = pkbf(v8[0], v8[1]); o.y = pkbf(v8[2], v8[3]); o.z = pkbf(v8[4], v8[5]); o.w = pkbf(v8[6], v8[7]);
                *(u32x4*)(DC + (size_t)k * 512 + cs * 256 + l0) = o; }
        }
        __syncthreads();
    }
    {
        LAS float* sc = (LAS float*)lds; LAS float* red = (LAS float*)(lds + 40960);
        bool have = false;
        for (int it = bid; it < 192; it += G) {
            if (!have) { for (int idx = tid; idx < 9216; idx += 512) { const int r = idx >> 10, k = idx & 1023; const float cv = r < 8 ? p.in[1][r * 1024 + k] : p.in[3][k]; sc[idx] = cv / (1.f + __expf(-cv)); } have = true; __syncthreads(); }
            const int i = it / 48, n = (it % 48) * 64 + (tid & 63), kq = tid >> 6;
            const float* w = p.in[5] + (size_t)i * 1024 * 3072 + n;
            float acc[9];
#pragma unroll
            for (int r = 0; r < 9; ++r) acc[r] = 0.f;
            for (int k = kq * 128; k < kq * 128 + 128; k += 4) { const float w0 = w[(size_t)k * 3072], w1 = w[(size_t)(k + 1) * 3072], w2 = w[(size_t)(k + 2) * 3072], w3 = w[(size_t)(k + 3) * 3072];
#pragma unroll
                for (int r = 0; r < 9; ++r) { const f32x4 s4 = *(const LAS f32x4*)(sc + r * 1024 + k); acc[r] += (s4[0] * w0 + s4[1] * w1) + (s4[2] * w2 + s4[3] * w3); } }
#pragma unroll
            for (int r = 0; r < 9; ++r) red[(kq * 9 + r) * 64 + (tid & 63)] = acc[r];
            __syncthreads();
            for (int idx = tid; idx < 576; idx += 512) { const int r = idx >> 6, col = idx & 63; float s = 0.f;
#pragma unroll
                for (int q = 0; q < 8; ++q) s += red[(q * 9 + r) * 64 + col];
                const int nn = (it % 48) * 64 + col;
                ((float*)(ws + WS_MOD))[(size_t)(i * 9 + r) * 3072 + nn] = s + p.in[6][i * 3072 + nn]; }
            __syncthreads();
        }
    }
    if (bid == 0) { for (int t = tid; t < 1024; t += 512) { const int pos = t >> 4, qd = t & 15; const float inv = powf(10000.f, -(float)qd / 16.f); const float ang = (float)pos * inv;
            ((float*)(ws + WS_ROPE))[t] = cosf(ang); ((float*)(ws + WS_ROPE))[1024 + t] = sinf(ang); } }
}
__device__ __forceinline__ void ph_phase(const float* xlat, const float* xctx, const float* gain, const float* mod, bf16_t* Hb, int G, int bid, int r0 = 0, int r1 = TT) {
    const int tid_ = opaque_tid(); const int lane = tid_ & 63, wid = tid_ >> 6;
    const int stride = G * 8;
    for (int row0 = r0 + bid * 8 + wid; row0 < r1; row0 += 2 * stride) {
        const int row1 = row0 + stride; const bool has1 = row1 < r1;
        const float* s0 = row0 < TL ? xlat + (size_t)row0 * 1024 : xctx + (size_t)(row0 - TL) * 1024;
        const float* s1 = !has1 ? s0 : (row1 < TL ? xlat + (size_t)row1 * 1024 : xctx + (size_t)(row1 - TL) * 1024);
        f32x4 v0[4], v1[4]; float q0 = 0.f, q1 = 0.f;
#pragma unroll
        for (int j = 0; j < 4; ++j) { v0[j] = *(const f32x4*)(s0 + 4 * lane + 256 * j); v1[j] = *(const f32x4*)(s1 + 4 * lane + 256 * j); }
#pragma unroll
        for (int j = 0; j < 4; ++j) { q0 += (v0[j].x * v0[j].x + v0[j].y * v0[j].y) + (v0[j].z * v0[j].z + v0[j].w * v0[j].w); q1 += (v1[j].x * v1[j].x + v1[j].y * v1[j].y) + (v1[j].z * v1[j].z + v1[j].w * v1[j].w); }
        const float r0 = rsqrtf(wave_sum(q0) * (1.f / 1024.f) + 1e-6f), r1 = rsqrtf(wave_sum(q1) * (1.f / 1024.f) + 1e-6f);
        const float* m0 = mod + (row0 < TL ? (row0 >> 12) : 8) * 3072; const float* m1 = mod + (row1 < TL ? (row1 >> 12) : 8) * 3072;
#pragma unroll
        for (int j = 0; j < 4; ++j) { const int col = 4 * lane + 256 * j; const f32x4 g4 = *(const f32x4*)(gain + col);
            { const f32x4 sh = *(const f32x4*)(m0 + col), sc = *(const f32x4*)(m0 + 1024 + col); const f32x4 y = v0[j] * r0 * g4 * (sc + 1.f) + sh; u32x2 o; o.x = pkbf(y.x, y.y); o.y = pkbf(y.z, y.w); *(u32x2*)(Hb + (size_t)row0 * 1024 + col) = o; }
            if (has1) { const f32x4 sh = *(const f32x4*)(m1 + col), sc = *(const f32x4*)(m1 + 1024 + col); const f32x4 y = v1[j] * r1 * g4 * (sc + 1.f) + sh; u32x2 o; o.x = pkbf(y.x, y.y); o.y = pkbf(y.z, y.w); *(u32x2*)(Hb + (size_t)row1 * 1024 + col) = o; } }
    }
}
__device__ __forceinline__ void final_phase(float* x, const float* gain, int G, int bid) {
    const int tid_ = opaque_tid(); const int lane = tid_ & 63, wid = tid_ >> 6;
    const int stride = G * 8;
    for (int row0 = bid * 8 + wid; row0 < TL; row0 += 2 * stride) {
        const int row1 = row0 + stride; const bool has1 = row1 < TL;
        float* s0 = x + (size_t)row0 * 1024; float* s1 = has1 ? x + (size_t)row1 * 1024 : s0;
        f32x4 v0[4], v1[4]; float q0 = 0.f, q1 = 0.f;
#pragma unroll
        for (int j = 0; j < 4; ++j) { v0[j] = *(const f32x4*)(s0 + 4 * lane + 256 * j); v1[j] = *(const f32x4*)(s1 + 4 * lane + 256 * j); }
#pragma unroll
        for (int j = 0; j < 4; ++j) { q0 += (v0[j].x * v0[j].x + v0[j].y * v0[j].y) + (v0[j].z * v0[j].z + v0[j].w * v0[j].w); q1 += (v1[j].x * v1[j].x + v1[j].y * v1[j].y) + (v1[j].z * v1[j].z + v1[j].w * v1[j].w); }
        const float r0 = rsqrtf(wave_sum(q0) * (1.f / 1024.f) + 1e-6f), r1 = rsqrtf(wave_sum(q1) * (1.f / 1024.f) + 1e-6f);
#pragma unroll
        for (int j = 0; j < 4; ++j) { const int col = 4 * lane + 256 * j; const f32x4 g4 = *(const f32x4*)(gain + col);
            *(f32x4*)(s0 + col) = v0[j] * r0 * g4;
            if (has1) *(f32x4*)(s1 + col) = v1[j] * r1 * g4; }
    }
}
__device__ __forceinline__ void fnet_fold(const bf16_t* ATL, bf16_t* E, bf16_t* O, float* TA, const bf16_t* Z, bf16_t* OG, int G, int bid) {
    const int tid_ = opaque_tid(); const int lane = tid_ & 63, wid = tid_ >> 6;
    for (int row = bid * 8 + wid; row < 8192; row += G * 8) {
        const bf16_t* a1 = ATL + (size_t)row * 8192; const bf16_t* a2 = a1 + 4096; bf16_t* e = E + (size_t)row * 2048; bf16_t* od = O + (size_t)row * 2048;
        float alt = 0.f;
#pragma unroll 2
        for (int it = 0; it < 4; ++it) {
            const int j0 = (it * 64 + lane) * 8;
            const u32x4 x = *(const u32x4*)(a1 + j0), y = *(const u32x4*)(a2 + j0);
            const int mb = 4096 - j0 - 8;
            const u32x4 xm = *(const u32x4*)(a1 + mb), ym = *(const u32x4*)(a2 + mb);
            const unsigned short xe = (j0 == 0) ? (unsigned short)0 : a1[4096 - j0], ye = (j0 == 0) ? (unsigned short)0 : a2[4096 - j0];
            float fa[8], fs[8], ma[8], ms[8];
#pragma unroll
            for (int i = 0; i < 4; ++i) { fa[2 * i] = bflo(x[i]); fa[2 * i + 1] = bfhi(x[i]); fs[2 * i] = bflo(y[i]); fs[2 * i + 1] = bfhi(y[i]);
                ma[2 * i] = bflo(xm[i]); ma[2 * i + 1] = bfhi(xm[i]); ms[2 * i] = bflo(ym[i]); ms[2 * i + 1] = bfhi(ym[i]); }
            float oc[8], os[8];
            oc[0] = fa[0] + bf1(xe); os[0] = fs[0] - bf1(ye);
#pragma unroll
            for (int i = 1; i < 8; ++i) { oc[i] = fa[i] + ma[8 - i]; os[i] = fs[i] - ms[8 - i]; }
            if (j0 == 0) { oc[0] = fa[0]; os[0] = 0.f; }
            u32x4 o; o.x = pkbf(oc[0], oc[1]); o.y = pkbf(oc[2], oc[3]); o.z = pkbf(oc[4], oc[5]); o.w = pkbf(oc[6], oc[7]);
            *(u32x4*)(e + j0) = o;
            alt += (bflo(o.x) - bfhi(o.x)) + (bflo(o.y) - bfhi(o.y)) + (bflo(o.z) - bfhi(o.z)) + (bflo(o.w) - bfhi(o.w));
            o.x = pkbf(os[0], os[1]); o.y = pkbf(os[2], os[3]); o.z = pkbf(os[4], os[5]); o.w = pkbf(os[6], os[7]);
            *(u32x4*)(od + j0) = o;
        }
        alt = wave_sum(alt);
        if (lane == 0) { const float amid = bf1(a1[2048]); TA[row] = amid * 0.015625f;
            const int b = row >> 10, n = row & 1023; const size_t off = (size_t)(b * 4096 + 2048) * 1024 + n;
            const float yv = (alt + amid) * 0.015625f * silu_f(bf1(Z[off]));
            OG[off] = (bf16_t)(pkbf(yv, 0.f) & 0xffffu); }
    }
}
__device__ __forceinline__ void sh8(const bf16_t* P, size_t row, int co, bool hm, bool hp, const float* mu, float* out) {
    const u32x4 z4 = {0u, 0u, 0u, 0u};
    const u32x4 c0 = *(const u32x4*)(P + row * RWN + co);
    const u32x4 cm = hm ? *(const u32x4*)(P + (row - 1) * RWN + co) : z4;
    const u32x4 cp = hp ? *(const u32x4*)(P + (row + 1) * RWN + co) : z4;
    const f32x4 m0 = *(const f32x4*)(mu + co), m1 = *(const f32x4*)(mu + co + 4);
#pragma unroll
    for (int i = 0; i < 4; ++i) {
        const float a0 = bflo(c0[i]), a1 = bfhi(c0[i]);
        const float n0 = 0.5f * (bflo(cm[i]) + bflo(cp[i])), n1 = 0.5f * (bfhi(cm[i]) + bfhi(cp[i]));
        const float mu0 = (2 * i < 4) ? m0[(2 * i) & 3] : m1[(2 * i) & 3], mu1 = (2 * i + 1 < 4) ? m0[(2 * i + 1) & 3] : m1[(2 * i + 1) & 3];
        out[2 * i] = a0 + mu0 * (n0 - a0); out[2 * i + 1] = a1 + mu1 * (n1 - a1);
    }
}
template <int CTRL> __device__ __forceinline__ float dpp_f(float v) { return __int_as_float(__builtin_amdgcn_update_dpp(0, __float_as_int(v), CTRL, 0xf, 0xf, true)); }
__device__ __forceinline__ float sum8(float v) { v += dpp_f<0xB1>(v); v += dpp_f<0x4E>(v); v += dpp_f<0x141>(v); return v; }
__device__ __forceinline__ float fast_tanh(float x) { const float e = __expf(2.f * x); return 1.f - 2.f * __builtin_amdgcn_rcpf(e + 1.f); }
__device__ __forceinline__ float fast_sigmoid(float x) { return __builtin_amdgcn_rcpf(1.f + __expf(-x)); }
struct RwArgs { const bf16_t* P; bf16_t* Y0; bf16_t* Y1; float* BZ; const float *mu, *w0, *w_up, *a0, *a_up, *k_k, *k_a, *r_k; };
struct Raw3 { u32x4 c0, cm, cp; };
__device__ __forceinline__ Raw3 ld3(const bf16_t* P, size_t row, int co, bool hm, bool hp) {
    const u32x4 z4 = {0u, 0u, 0u, 0u}; Raw3 r;
    r.c0 = *(const u32x4*)(P + row * RWN + co);
    r.cm = hm ? *(const u32x4*)(P + (row - 1) * RWN + co) : z4;
    r.cp = hp ? *(const u32x4*)(P + (row + 1) * RWN + co) : z4;
    return r;
}
__device__ __forceinline__ void shift8(const Raw3& R, const float* mu, int co, float* out) {
    const f32x4 m0 = *(const f32x4*)(mu + co), m1 = *(const f32x4*)(mu + co + 4);
#pragma unroll
    for (int i = 0; i < 4; ++i) {
        const float a0 = bflo(R.c0[i]), a1 = bfhi(R.c0[i]);
        const float n0 = 0.5f * (bflo(R.cm[i]) + bflo(R.cp[i])), n1 = 0.5f * (bfhi(R.cm[i]) + bfhi(R.cp[i]));
        const float mu0 = (2 * i < 4) ? m0[(2 * i) & 3] : m1[(2 * i) & 3], mu1 = (2 * i + 1 < 4) ? m0[(2 * i + 1) & 3] : m1[(2 * i + 1) & 3];
        out[2 * i] = a0 + mu0 * (n0 - a0); out[2 * i + 1] = a1 + mu1 * (n1 - a1);
    }
}
__device__ __forceinline__ void shift8l(const Raw3& R, const LAS float* mu, float* out) {
    const f32x4 m0 = *(const LAS f32x4*)(mu), m1 = *(const LAS f32x4*)(mu + 4);
    const float mm[8] = {m0[0], m0[1], m0[2], m0[3], m1[0], m1[1], m1[2], m1[3]};
#pragma unroll
    for (int i = 0; i < 4; ++i) {
        const float a0 = bflo(R.c0[i]), a1 = bfhi(R.c0[i]);
        const float n0 = 0.5f * (bflo(R.cm[i]) + bflo(R.cp[i])), n1 = 0.5f * (bfhi(R.cm[i]) + bfhi(R.cp[i]));
        out[2 * i] = a0 + mm[2 * i] * (n0 - a0); out[2 * i + 1] = a1 + mm[2 * i + 1] * (n1 - a1);
    }
}
__device__ __forceinline__ void shift8r(const Raw3& R, const float* mu, float* out) {
#pragma unroll
    for (int i = 0; i < 4; ++i) {
        const float a0 = bflo(R.c0[i]), a1 = bfhi(R.c0[i]);
        const float n0 = 0.5f * (bflo(R.cm[i]) + bflo(R.cp[i])), n1 = 0.5f * (bfhi(R.cm[i]) + bfhi(R.cp[i]));
        out[2 * i] = a0 + mu[2 * i] * (n0 - a0); out[2 * i + 1] = a1 + mu[2 * i + 1] * (n1 - a1);
    }
}
__device__ __forceinline__ void rwkv_scan(const RwArgs& A, LAS char* lds, int G, int bid) {
    typedef short bfx8 __attribute__((ext_vector_type(8)));
    const int tid = opaque_tid(), lane = tid & 63; const int q = __builtin_amdgcn_readfirstlane(tid >> 6);
    LAS float* sW = (LAS float*)lds; LAS float* sA = sW + 4096; LAS float* sB = sA + 4096; LAS float* sKD = sB + 4096; LAS float* sR = sKD + 4096; LAS float* sV = sR + 4096;
    LAS bf16_t* WUPt = (LAS bf16_t*)(sV + 4096); LAS bf16_t* AUPt = WUPt + 64 * 72;
    LAS bf16_t* T1 = (LAS bf16_t*)sW; LAS bf16_t* T2 = (LAS bf16_t*)sKD;
    const int s = tid >> 3, dg = tid & 7, d0 = dg * 8;
#pragma unroll 1
    for (int chain = bid; chain < 256; chain += G) {
        const int z = chain >> 7, b = (chain >> 4) & 7, hh = chain & 15;
        __syncthreads();
        for (int idx = tid; idx < 4096; idx += 512) { const int r = idx >> 6, d = idx & 63;
            WUPt[d * 72 + r] = (bf16_t)(pkbf(A.w_up[(size_t)(z * 64 + r) * 1024 + hh * 64 + d], 0.f) & 0xffffu);
            AUPt[d * 72 + r] = (bf16_t)(pkbf(A.a_up[(size_t)(z * 64 + r) * 1024 + hh * 64 + d], 0.f) & 0xffffu); }
        f32x2_t S2[4];
#pragma unroll
        for (int j = 0; j < 4; ++j) S2[j] = (f32x2_t){0.f, 0.f};
        bf16_t* Yz = z ? A.Y1 : A.Y0;
        const int c_r = hh * 64 + d0, c_k = 1024 + hh * 64 + d0, c_v = 2048 + hh * 64 + d0, c_wd = 3072 + z * 64 + d0, c_ad = 3200 + z * 64 + d0;
#define RW_ROWOF(c, rowv, hmv, hpv) do { const int sidx_ = (c) * 64 + s; int L_, n_, rb_; \
            if ((c) < 4) { L_ = 256; n_ = z ? (255 - sidx_) : sidx_; rb_ = TL + b * 256; } else { L_ = 4096; const int sl_ = sidx_ - 256; n_ = z ? (4095 - sl_) : sl_; rb_ = b * 4096; } \
            rowv = (size_t)(rb_ + n_); hmv = n_ > 0; hpv = n_ < L_ - 1; } while (0)
        size_t row; bool hm, hp;
        RW_ROWOF(0, row, hm, hp);
        Raw3 Rr = ld3(A.P, row, c_r, hm, hp), Rk = ld3(A.P, row, c_k, hm, hp), Rv = ld3(A.P, row, c_v, hm, hp), Rw = ld3(A.P, row, c_wd, hm, hp), Ra = ld3(A.P, row, c_ad, hm, hp);
#pragma unroll 1
        for (int c = 0; c < 68; ++c) {
            asm volatile("" ::: "memory");
            const size_t crow_ = row;
            {
                float r8[8], k8[8], v8[8], t8[8];
                shift8(Rr, A.mu, c_r, r8); shift8(Rk, A.mu, c_k, k8); shift8(Rv, A.mu, c_v, v8);
                *(LAS f32x4*)(sR + s * 64 + d0) = (f32x4){r8[0], r8[1], r8[2], r8[3]}; *(LAS f32x4*)(sR + s * 64 + d0 + 4) = (f32x4){r8[4], r8[5], r8[6], r8[7]};
                *(LAS f32x4*)(sV + s * 64 + d0) = (f32x4){v8[0], v8[1], v8[2], v8[3]}; *(LAS f32x4*)(sV + s * 64 + d0 + 4) = (f32x4){v8[4], v8[5], v8[6], v8[7]};
                *(LAS f32x4*)(sB + s * 64 + d0) = (f32x4){k8[0], k8[1], k8[2], k8[3]}; *(LAS f32x4*)(sB + s * 64 + d0 + 4) = (f32x4){k8[4], k8[5], k8[6], k8[7]};
                float kkr[8], ssq = 0.f;
                const f32x4 kk0 = *(const f32x4*)(A.k_k + hh * 64 + d0), kk1 = *(const f32x4*)(A.k_k + hh * 64 + d0 + 4);
#pragma unroll
                for (int i = 0; i < 8; ++i) { kkr[i] = k8[i] * (i < 4 ? kk0[i & 3] : kk1[i & 3]); ssq += kkr[i] * kkr[i]; }
                ssq = sum8(ssq);
                const float rs = -rsqrtf(ssq + 1e-12f);
                *(LAS f32x4*)(sA + s * 64 + d0) = (f32x4){kkr[0] * rs, kkr[1] * rs, kkr[2] * rs, kkr[3] * rs}; *(LAS f32x4*)(sA + s * 64 + d0 + 4) = (f32x4){kkr[4] * rs, kkr[5] * rs, kkr[6] * rs, kkr[7] * rs};
                shift8(Rw, A.mu, c_wd, t8);
                { u32x4 o; o.x = pkbf(fast_tanh(t8[0]), fast_tanh(t8[1])); o.y = pkbf(fast_tanh(t8[2]), fast_tanh(t8[3])); o.z = pkbf(fast_tanh(t8[4]), fast_tanh(t8[5])); o.w = pkbf(fast_tanh(t8[6]), fast_tanh(t8[7]));
                  *(LAS u32x4*)(T1 + s * 72 + d0) = o; }
                shift8(Ra, A.mu, c_ad, t8);
                { u32x4 o; o.x = pkbf(t8[0], t8[1]); o.y = pkbf(t8[2], t8[3]); o.z = pkbf(t8[4], t8[5]); o.w = pkbf(t8[6], t8[7]);
                  *(LAS u32x4*)(T2 + s * 72 + d0) = o; }
            }
            if (c + 1 < 68) { RW_ROWOF(c + 1, row, hm, hp);
                Rr = ld3(A.P, row, c_r, hm, hp); Rk = ld3(A.P, row, c_k, hm, hp); Rv = ld3(A.P, row, c_v, hm, hp); Rw = ld3(A.P, row, c_wd, hm, hp); Ra = ld3(A.P, row, c_ad, hm, hp); }
            __syncthreads();
            const int mt = q & 3, nh = q >> 2, fr = lane & 15, fq = lane >> 4;
            f32x4 accw[2], acca[2];
            {
                bfx8 aw[2], aa[2];
#pragma unroll
                for (int kk = 0; kk < 2; ++kk) { aw[kk] = *(const LAS bfx8*)(T1 + (16 * mt + fr) * 72 + kk * 32 + fq * 8); aa[kk] = *(const LAS bfx8*)(T2 + (16 * mt + fr) * 72 + kk * 32 + fq * 8); }
#pragma unroll
                for (int nt = 0; nt < 2; ++nt) { accw[nt] = (f32x4){0.f, 0.f, 0.f, 0.f}; acca[nt] = (f32x4){0.f, 0.f, 0.f, 0.f};
#pragma unroll
                    for (int kk = 0; kk < 2; ++kk) {
                        const bfx8 bw = *(const LAS bfx8*)(WUPt + (32 * nh + 16 * nt + fr) * 72 + kk * 32 + fq * 8), ba = *(const LAS bfx8*)(AUPt + (32 * nh + 16 * nt + fr) * 72 + kk * 32 + fq * 8);
                        accw[nt] = __builtin_amdgcn_mfma_f32_16x16x32_bf16(aw[kk], bw, accw[nt], 0, 0, 0);
                        acca[nt] = __builtin_amdgcn_mfma_f32_16x16x32_bf16(aa[kk], ba, acca[nt], 0, 0, 0); } }
            }
            __syncthreads();
#pragma unroll
            for (int nt = 0; nt < 2; ++nt) { const int d = 32 * nh + 16 * nt + fr, dcol = hh * 64 + d;
                const float w0d = A.w0[z * 1024 + dcol], a0d = A.a0[z * 1024 + dcol], kad = A.k_a[dcol];
#pragma unroll
                for (int j = 0; j < 4; ++j) { const int idx = (16 * mt + 4 * fq + j) * 64 + d;
                    const float x = -(w0d + accw[nt][j]);
                    const float sp = fmaxf(x, 0.f) + __logf(1.f + __expf(-fabsf(x)));
                    const float w = __expf(-__expf(-sp - 0.5f));
                    const float asig = fast_sigmoid(a0d + acca[nt][j]);
                    const float nkk = sA[idx], kraw = sB[idx];
                    sW[idx] = w; sB[idx] = -nkk * asig; sKD[idx] = kraw * (1.f + (asig - 1.f) * kad); } }
            __syncthreads();
            {
                const f32x4 ra = *(const LAS f32x4*)(sR + s * 64 + d0), rb = *(const LAS f32x4*)(sR + s * 64 + d0 + 4), ka = *(const LAS f32x4*)(sKD + s * 64 + d0), kb = *(const LAS f32x4*)(sKD + s * 64 + d0 + 4);
                const f32x4 q0 = *(const f32x4*)(A.r_k + hh * 64 + d0), q1 = *(const f32x4*)(A.r_k + hh * 64 + d0 + 4);
                float bz = 0.f;
#pragma unroll
                for (int i = 0; i < 4; ++i) { bz += ra[i] * ka[i] * q0[i]; bz += rb[i] * kb[i] * q1[i]; }
                bz = sum8(bz);
                if (dg == 0) A.BZ[((size_t)z * TT + crow_) * 16 + hh] = bz;
            }
            {
                const int rl = lane >> 3, cg = lane & 7, irow = 8 * q + rl;
                const LAS float* bw = sW + 8 * cg; const LAS float* ba_ = sA + 8 * cg; const LAS float* bb_ = sB + 8 * cg; const LAS float* bk = sKD + 8 * cg; const LAS float* br = sR + 8 * cg;
                LAS float* bv = sV + irow;
                f32x4 w0 = *(const LAS f32x4*)(bw), w1 = *(const LAS f32x4*)(bw + 4), a0 = *(const LAS f32x4*)(ba_), a1 = *(const LAS f32x4*)(ba_ + 4);
                f32x4 b0 = *(const LAS f32x4*)(bb_), b1 = *(const LAS f32x4*)(bb_ + 4), k0 = *(const LAS f32x4*)(bk), k1 = *(const LAS f32x4*)(bk + 4);
                f32x4 r0 = *(const LAS f32x4*)(br), r1 = *(const LAS f32x4*)(br + 4); float vi = bv[0];
#pragma unroll 4
                for (int st = 0; st < 64; ++st) {
                    const int on = ((st + 1) & 63) * 64;
                    const f32x4 nw0 = *(const LAS f32x4*)(bw + on), nw1 = *(const LAS f32x4*)(bw + on + 4), na0 = *(const LAS f32x4*)(ba_ + on), na1 = *(const LAS f32x4*)(ba_ + on + 4);
                    const f32x4 nb0 = *(const LAS f32x4*)(bb_ + on), nb1 = *(const LAS f32x4*)(bb_ + on + 4), nk0 = *(const LAS f32x4*)(bk + on), nk1 = *(const LAS f32x4*)(bk + on + 4);
                    const f32x4 nr0 = *(const LAS f32x4*)(br + on), nr1 = *(const LAS f32x4*)(br + on + 4); const float nvi = bv[on];
                    f32x2_t pp2 = S2[0] * (f32x2_t){a0[0], a0[1]};
                    pp2 = S2[1] * (f32x2_t){a0[2], a0[3]} + pp2; pp2 = S2[2] * (f32x2_t){a1[0], a1[1]} + pp2; pp2 = S2[3] * (f32x2_t){a1[2], a1[3]} + pp2;
                    const float sa = sum8(pp2.x + pp2.y);
                    const f32x2_t sa2 = {sa, sa}, v2 = {vi, vi};
                    S2[0] = S2[0] * (f32x2_t){w0[0], w0[1]} + sa2 * (f32x2_t){b0[0], b0[1]} + v2 * (f32x2_t){k0[0], k0[1]};
                    S2[1] = S2[1] * (f32x2_t){w0[2], w0[3]} + sa2 * (f32x2_t){b0[2], b0[3]} + v2 * (f32x2_t){k0[2], k0[3]};
                    S2[2] = S2[2] * (f32x2_t){w1[0], w1[1]} + sa2 * (f32x2_t){b1[0], b1[1]} + v2 * (f32x2_t){k1[0], k1[1]};
                    S2[3] = S2[3] * (f32x2_t){w1[2], w1[3]} + sa2 * (f32x2_t){b1[2], b1[3]} + v2 * (f32x2_t){k1[2], k1[3]};
                    f32x2_t y2 = S2[0] * (f32x2_t){r0[0], r0[1]};
                    y2 = S2[1] * (f32x2_t){r0[2], r0[3]} + y2; y2 = S2[2] * (f32x2_t){r1[0], r1[1]} + y2; y2 = S2[3] * (f32x2_t){r1[2], r1[3]} + y2;
                    const float yv = sum8(y2.x + y2.y);
                    if (cg == 0) bv[st * 64] = yv;
                    w0 = nw0; w1 = nw1; a0 = na0; a1 = na1; b0 = nb0; b1 = nb1; k0 = nk0; k1 = nk1; r0 = nr0; r1 = nr1; vi = nvi;
                }
            }
            __syncthreads();
            { u32x4 o; const LAS float* yr = sV + s * 64 + d0;
              o.x = pkbf(yr[0], yr[1]); o.y = pkbf(yr[2], yr[3]); o.z = pkbf(yr[4], yr[5]); o.w = pkbf(yr[6], yr[7]);
              *(u32x4*)(Yz + crow_ * 1024 + hh * 64 + d0) = o; }
            __syncthreads();
        }
#undef RW_ROWOF
    }
}
__device__ __forceinline__ void rwkv_out(const RwArgs& A, const float* ln_w, const float* ln_b, bf16_t* OG, int G, int bid) {
    const int tid_ = opaque_tid(); const int lane = tid_ & 63, wid = tid_ >> 6; const int c0 = lane * 16, head = lane >> 2;
    float lw[16], lb[16], muv[16];
#pragma unroll
    for (int i = 0; i < 16; ++i) { lw[i] = ln_w[c0 + i]; lb[i] = ln_b[c0 + i]; muv[i] = A.mu[2048 + c0 + i]; }
    for (int row = bid * 8 + wid; row < TT; row += G * 8) {
        const bool lat = row < TL; const int L = lat ? 4096 : 256; const int n = lat ? (row & 4095) : ((row - TL) & 255); const bool hm = n > 0, hp = n < L - 1;
        const u32x4 a0 = *(const u32x4*)(A.Y0 + (size_t)row * 1024 + c0), a1 = *(const u32x4*)(A.Y0 + (size_t)row * 1024 + c0 + 8);
        const u32x4 b0 = *(const u32x4*)(A.Y1 + (size_t)row * 1024 + c0), b1 = *(const u32x4*)(A.Y1 + (size_t)row * 1024 + c0 + 8);
        const Raw3 v0 = ld3(A.P, (size_t)row, 2048 + c0, hm, hp), v1 = ld3(A.P, (size_t)row, 2048 + c0 + 8, hm, hp);
        const u32x4 z0 = *(const u32x4*)(A.P + (size_t)row * RWN + 3328 + c0), z1 = *(const u32x4*)(A.P + (size_t)row * RWN + 3328 + c0 + 8);
        const float bz = 0.5f * (A.BZ[(size_t)row * 16 + head] + A.BZ[((size_t)TT + row) * 16 + head]);
        float y[16], vv[16];
#pragma unroll
        for (int i = 0; i < 4; ++i) { y[2 * i] = bflo(a0[i]) + bflo(b0[i]); y[2 * i + 1] = bfhi(a0[i]) + bfhi(b0[i]); y[8 + 2 * i] = bflo(a1[i]) + bflo(b1[i]); y[8 + 2 * i + 1] = bfhi(a1[i]) + bfhi(b1[i]); }
        float s1 = 0.f;
#pragma unroll
        for (int i = 0; i < 16; ++i) s1 += y[i];
        s1 += __shfl_xor(s1, 1); s1 += __shfl_xor(s1, 2); const float mean = s1 * (1.f / 64.f);
        float s2 = 0.f;
#pragma unroll
        for (int i = 0; i < 16; ++i) { y[i] -= mean; s2 += y[i] * y[i]; }
        s2 += __shfl_xor(s2, 1); s2 += __shfl_xor(s2, 2); const float rstd = rsqrtf(s2 * (1.f / 64.f) + 64e-5f);
        shift8r(v0, muv, vv); shift8r(v1, muv + 8, vv + 8);
        float ov[16];
#pragma unroll
        for (int i = 0; i < 16; ++i) { const unsigned zw = (i < 8) ? z0[(i >> 1) & 3] : z1[(i >> 1) & 3]; const float zz = (i & 1) ? bfhi(zw) : bflo(zw);
            ov[i] = (y[i] * rstd * lw[i] + lb[i] + bz * vv[i]) * silu_f(zz); }
        u32x4 o0, o1; o0.x = pkbf(ov[0], ov[1]); o0.y = pkbf(ov[2], ov[3]); o0.z = pkbf(ov[4], ov[5]); o0.w = pkbf(ov[6], ov[7]);
        o1.x = pkbf(ov[8], ov[9]); o1.y = pkbf(ov[10], ov[11]); o1.z = pkbf(ov[12], ov[13]); o1.w = pkbf(ov[14], ov[15]);
        *(u32x4*)(OG + (size_t)row * 1024 + c0) = o0; *(u32x4*)(OG + (size_t)row * 1024 + c0 + 8) = o1;
    }
}
#ifdef SKIP_GEMM
#define GEMM_PHASE(EPI, AP, BP, MM, NN, KK, EOBJ) do { (void)EOBJ; } while (0)
#else
#ifndef STAGGER_TICKS
#define STAGGER_TICKS 1500
#endif
__device__ __forceinline__ void stagger_wait(int bid, int units_per_cu_x2) {
    if ((bid & 1) && units_per_cu_x2 >= 4) { const unsigned long long t0 = __builtin_amdgcn_s_memrealtime(); while (__builtin_amdgcn_s_memrealtime() - t0 < (unsigned long long)STAGGER_TICKS) __builtin_amdgcn_s_sleep(32); }
}
#define GEMM_PHASE(EPI, AP, BP, MM, NN, KK, EOBJ) do { pg8::Gemm g_{(const bf16_t*)(AP), (const bf16_t*)(BP), (MM), (NN), (KK)}; pg8::StaticOrder S_; S_.init((MM), (NN), G, bid); \
    pg8::gemm_phase<EPI, pg8::StaticOrder, true, true>((PG8_LAS unsigned char*)lds, g_, S_, EOBJ); } while (0)
#endif
#ifdef SKIP_EpiAttnIn
#define GEMM_PHASE_EpiAttnIn(EPI, AP, BP, MM, NN, KK, EOBJ) do { (void)EOBJ; } while (0)
#else
#define GEMM_PHASE_EpiAttnIn GEMM_PHASE
#endif
#ifdef SKIP_EpiFnT
#define GEMM_PHASE_EpiFnT(EPI, AP, BP, MM, NN, KK, EOBJ) do { (void)EOBJ; } while (0)
#else
#define GEMM_PHASE_EpiFnT GEMM_PHASE
#endif
#ifdef SKIP_EpiPlain
#define GEMM_PHASE_EpiPlain(EPI, AP, BP, MM, NN, KK, EOBJ) do { (void)EOBJ; } while (0)
#else
#define GEMM_PHASE_EpiPlain GEMM_PHASE
#endif
#ifdef SKIP_EpiDft
#define GEMM_PHASE_EpiDft(EPI, AP, BP, MM, NN, KK, EOBJ) do { (void)EOBJ; } while (0)
#else
#define GEMM_PHASE_EpiDft GEMM_PHASE
#endif
#ifdef SKIP_EpiResid
#define GEMM_PHASE_EpiResid(EPI, AP, BP, MM, NN, KK, EOBJ) do { (void)EOBJ; } while (0)
#else
#define GEMM_PHASE_EpiResid GEMM_PHASE
#endif
#define XB_TMO      128
#define XB_XCNT(j)  (256  + 64 * (j))
#define XB_XSUB(j)  (1280 + 64 * (j))
#define XB_XGEN(j)  (2304 + 64 * (j))
#define XB_TOP      3328
#define XB_TOPGEN   3392
#define XCD_BAR_WORDS 3456
#define XB_SPIN_CAP (1u << 18)

__device__ __forceinline__ unsigned xb_ld(unsigned* p)              { return __hip_atomic_load(p, __ATOMIC_RELAXED, __HIP_MEMORY_SCOPE_AGENT); }
__device__ __forceinline__ unsigned xb_add(unsigned* p, unsigned v) { return __hip_atomic_fetch_add(p, v, __ATOMIC_RELAXED, __HIP_MEMORY_SCOPE_AGENT); }
__device__ __forceinline__ unsigned xb_xcc_id() { return (unsigned)__builtin_amdgcn_s_getreg((3 << 11) | 20) & 0xFu; }
#define XB_SPIN(cond, bar) do { unsigned _sp = 0; while (cond) { __builtin_amdgcn_s_sleep(1); \
    if ((++_sp & 255u) == 0u) { if (xb_ld(&(bar)[XB_TMO])) break; if (_sp > XB_SPIN_CAP) { atomicAdd(&(bar)[XB_TMO], 1u); break; } } } } while (0)

struct XcdBarrier {
    unsigned* bar; unsigned x;
    volatile LAS unsigned* st;
};

__device__ __forceinline__ XcdBarrier xcd_barrier_post(unsigned* bar, volatile LAS unsigned* st) {
    XcdBarrier b; b.bar = bar; b.x = xb_xcc_id(); b.st = st;
    if (threadIdx.x == 0) (void)xb_add(&bar[XB_XCNT(b.x)], 1u);
    return b;
}
__device__ __forceinline__ void xcd_barrier_complete(unsigned* bar, unsigned x, unsigned& nloc, unsigned& nx) {
    const unsigned G = gridDim.x * gridDim.y * gridDim.z;
    unsigned sum, cnt, mine, sp = 0u;
    for (;;) {
        sum = 0u; cnt = 0u; mine = 0u;
#pragma unroll
        for (unsigned j = 0; j < 16; ++j) { const unsigned c = xb_ld(&bar[XB_XCNT(j)]); sum += c; cnt += (c > 0u) ? 1u : 0u; mine = (j == x) ? c : mine; }
        if (sum == G) break;
        __builtin_amdgcn_s_sleep(1);
        if ((++sp & 255u) == 0u) { if (xb_ld(&bar[XB_TMO])) break; if (sp > XB_SPIN_CAP) { atomicAdd(&bar[XB_TMO], 1u); break; } }
    }
    nloc = mine > 0u ? mine : 1u; nx = cnt > 0u ? cnt : 1u;
}

__device__ __forceinline__ void xcd_barrier(const XcdBarrier& b) {
    asm volatile("s_waitcnt vmcnt(0)" ::: "memory");
    __syncthreads();
    if (threadIdx.x == 0) {
        unsigned* bar = b.bar;
        __builtin_amdgcn_s_waitcnt(0);
        unsigned nloc = b.st[0], nx = b.st[1];
        if (nloc == 0u) { xcd_barrier_complete(bar, b.x, nloc, nx); b.st[0] = nloc; b.st[1] = nx; }
        const unsigned old = xb_add(&bar[XB_XSUB(b.x)], 1u);
        const unsigned gen = old / nloc;
        if (old + 1u == (gen + 1u) * nloc) {
            __builtin_amdgcn_fence(__ATOMIC_RELEASE, "agent");
            asm volatile("s_waitcnt vmcnt(0)" ::: "memory");
            const unsigned og = xb_add(&bar[XB_TOP], 1u);
            const unsigned tg = og / nx;
            if (og + 1u == (tg + 1u) * nx) xb_add(&bar[XB_TOPGEN], 1u);
            else XB_SPIN(xb_ld(&bar[XB_TOPGEN]) == tg, bar);
            __builtin_amdgcn_fence(__ATOMIC_ACQUIRE, "agent");
            xb_add(&bar[XB_XGEN(b.x)], 1u);
            asm volatile("s_waitcnt vmcnt(0)" ::: "memory");
        } else {
            XB_SPIN(xb_ld(&bar[XB_XGEN(b.x)]) == gen, bar);
            __builtin_amdgcn_fence(__ATOMIC_ACQUIRE, "agent");
            asm volatile("s_waitcnt vmcnt(0)" ::: "memory");
        }
    }
    __syncthreads();
}

#define GRID_SYNC() xcd_barrier(xbar)
template <int layer> __device__ __forceinline__ void layer_body(const Params& p, LAS char* lds, const XcdBarrier& xbar, int G, int bid) {
    unsigned char* ws = p.ws;
    float* mod = (float*)(ws + WS_MOD);
    const float* ropeC = (const float*)(ws + WS_ROPE); const float* ropeS = ropeC + 1024;
    bf16_t* Hb = (bf16_t*)(ws + WS_HB);
    float* XC = (float*)(ws + WS_XC);
    const float* x_in = p.in[0]; const float* ctx_in = p.in[2];
        const float* xl = layer == 0 ? x_in : p.out; const float* xc = layer == 0 ? ctx_in : XC;
        const float* modl = mod + (size_t)layer * 9 * 3072;
        if constexpr (layer == 0) {
            ph_phase(xl, xc, p.in[4] + layer * 1024, modl, Hb, G, bid);
            GRID_SYNC();
        }
        const int Mout = (layer == 3) ? TL : TT;
        const bf16_t* Wout;
        if constexpr (layer == 0 || layer == 3) {
            const int j = layer == 0 ? 0 : 1;
            LAS float* ropeL = (LAS float*)(lds + 131072);
            for (int t_ = opaque_tid(); t_ < 2048; t_ += 512) ropeL[t_] = ropeC[t_];
            __syncthreads();
            pg8::EpiAttnIn E{(bf16_t*)(ws + WS_Q), (bf16_t*)(ws + WS_K), (bf16_t*)(ws + WS_V), (bf16_t*)(ws + WS_Z), (const PG8_LAS float*)ropeL, (const PG8_LAS float*)ropeL + 1024};
            GEMM_PHASE_EpiAttnIn(pg8::EpiAttnIn, Hb, ws + WS_WDAIN + (size_t)j * 8 * MiB, TT, 4096, 1024, E);
#ifdef PROBE_GIN2
            GEMM_PHASE_EpiAttnIn(pg8::EpiAttnIn, Hb, ws + WS_WDAIN + (size_t)j * 8 * MiB, TT, 4096, 1024, E);
#endif
            GRID_SYNC();
            float lam;
            { const int lane = opaque_tid() & 63; const float* lq = p.in[9] + j * 128; const float* lk = p.in[10] + j * 128;
              const float s0 = wave_sum(lq[lane] * lk[lane]), s1 = wave_sum(lq[64 + lane] * lk[64 + lane]);
              const float li = 0.8f - 0.6f * expf(-0.3f * (float)layer); lam = expf(s0) - expf(s1) + li;
              att::Args A{(const bf16_t*)(ws + WS_Q), (const bf16_t*)(ws + WS_K), (const bf16_t*)(ws + WS_V), (const bf16_t*)(ws + WS_Z), Hb, p.in[11] + j * 128, lam, 1.f - li, layer == 3 ? 1024 : 1088, (unsigned*)(ws + WS_Y1) + (size_t)bid * 8 * 2048};
#ifndef SKIP_ATT
              att::attn_phase(A, lds, G, bid);
#endif
#ifdef PROBE_ATT2
              att::attn_phase(A, lds, G, bid);
#endif
            }
            GRID_SYNC();
            Wout = (const bf16_t*)(ws + WS_WDAOUT + (size_t)j * 2 * MiB);
        } else if constexpr (layer == 1) {
            { pg8::EpiFnT E{(bf16_t*)(ws + WS_ATL), (bf16_t*)(ws + WS_ATC)};
              GEMM_PHASE_EpiFnT(pg8::EpiFnT, ws + WS_WFNT, Hb, 2048, TT, 1024, E); }
            { pg8::EpiPlain E{(bf16_t*)(ws + WS_ZB), 1024};
              GEMM_PHASE_EpiPlain(pg8::EpiPlain, Hb, ws + WS_WFNZ, TT, 1024, 1024, E); }
            GRID_SYNC();
            fnet_fold((const bf16_t*)(ws + WS_ATL), (bf16_t*)(ws + WS_FOLD), (bf16_t*)(ws + WS_FOLD + 32 * MiB), (float*)(ws + WS_BZ), (const bf16_t*)(ws + WS_ZB), Hb, G, bid);
            GRID_SYNC();
            { pg8::EpiPlain E{(bf16_t*)(ws + WS_ATL), 8192};
              GEMM_PHASE_EpiPlain(pg8::EpiPlain, ws + WS_DFTL, ws + WS_FOLD, 2048, 8192, 2048, E); }
            GRID_SYNC();
            { pg8::EpiDftSym E{(const bf16_t*)(ws + WS_ATL), (const float*)(ws + WS_BZ), (const bf16_t*)(ws + WS_ZB), Hb};
              GEMM_PHASE(pg8::EpiDftSym, ws + WS_DFTL + 8 * MiB, ws + WS_FOLD + 32 * MiB, 2048, 8192, 2048, E); }
            { pg8::EpiDft E{(const bf16_t*)(ws + WS_ZB), Hb, TL, 256};
              GEMM_PHASE_EpiDft(pg8::EpiDft, ws + WS_DFTC, ws + WS_ATC, 256, 8192, 512, E); }
            GRID_SYNC();
            Wout = (const bf16_t*)(ws + WS_WFNOUT);
        } else {
            { pg8::EpiPlain E{(bf16_t*)(ws + WS_P), RWN};
              GEMM_PHASE_EpiPlain(pg8::EpiPlain, Hb, ws + WS_WRWIN, TT, RWN, 1024, E); }
            GRID_SYNC();
            RwArgs A{(const bf16_t*)(ws + WS_P), Hb, (bf16_t*)(ws + WS_Y1), (float*)(ws + WS_BZ), p.in[17], p.in[18], p.in[19], p.in[20], p.in[21], p.in[22], p.in[23], p.in[24]};
#ifndef SKIP_SCAN
            rwkv_scan(A, lds, G, bid);
#endif
#ifdef PROBE_SCAN2
            rwkv_scan(A, lds, G, bid);
#endif
            GRID_SYNC();
#ifndef SKIP_RWOUT
            rwkv_out(A, p.in[25], p.in[26], Hb, G, bid);
#endif
            GRID_SYNC();
            Wout = (const bf16_t*)(ws + WS_WRWOUT);
        }
        if constexpr (layer == 3) {
            pg8::EpiResid E{xl, xc, p.out, XC, modl + 2048, 0};
            GEMM_PHASE_EpiResid(pg8::EpiResid, Hb, Wout, TL, 1024, 1024, E);
            GRID_SYNC();
        } else {
            { pg8::EpiResid E{xl, xc, p.out, XC, modl + 2048, 0};
              GEMM_PHASE_EpiResid(pg8::EpiResid, Hb, Wout, TL, 1024, 1024, E); }
            GRID_SYNC();
            const float* gain_n = p.in[4] + (layer + 1) * 1024; const float* mod_n = mod + (size_t)(layer + 1) * 9 * 3072;
            const int nctx = 32;
            if (G > 2 * nctx) {
                if (bid < nctx) { const int G_real = G; { const int G = nctx; (void)G_real;
                    pg8::EpiResid E{xl, xc, p.out, XC, modl + 2048, TL};
                    GEMM_PHASE_EpiResid(pg8::EpiResid, Hb + (size_t)TL * 1024, Wout, TCX, 1024, 1024, E); } }
                else ph_phase(p.out, XC, gain_n, mod_n, Hb, G - nctx, bid - nctx, 0, TL);
                GRID_SYNC();
                ph_phase(p.out, XC, gain_n, mod_n, Hb, G, bid, TL, TT);
            } else {
                { pg8::EpiResid E{xl, xc, p.out, XC, modl + 2048, TL};
                  GEMM_PHASE_EpiResid(pg8::EpiResid, Hb + (size_t)TL * 1024, Wout, TCX, 1024, 1024, E); }
                GRID_SYNC();
                ph_phase(p.out, XC, gain_n, mod_n, Hb, G, bid);
            }
            GRID_SYNC();
        }
    }
__global__ void __launch_bounds__(512, 2) fwd_megakernel(Params p) {
    extern __shared__ __attribute__((aligned(16))) unsigned char lds_raw[];
    LAS char* lds = (LAS char*)lds_raw;
    cg::grid_group grid = cg::this_grid();
    const int G = gridDim.x, bid = blockIdx.x;
    volatile LAS unsigned* xst = (volatile LAS unsigned*)(lds + LDS_BYTES - 256);
    if (threadIdx.x < 2) xst[threadIdx.x] = 0u;
    __syncthreads();
    const XcdBarrier xbar = xcd_barrier_post((unsigned*)(p.ws + WS_CTL), xst);

#ifndef SKIP_PRO
    prologue(p, lds, G, bid);
#endif
#ifdef PROBE_PRO2
    __syncthreads(); prologue(p, lds, G, bid);
#endif
    grid.sync();
    layer_body<0>(p, lds, xbar, G, bid);
    layer_body<1>(p, lds, xbar, G, bid);
    layer_body<2>(p, lds, xbar, G, bid);
    layer_body<3>(p, lds, xbar, G, bid);
    final_phase(p.out, p.in[7], G, bid);
}

extern "C" void kernel_launch(void* const* d_in, const int* in_sizes, int n_in, void* d_out, int out_size, void* d_ws, size_t ws_size, hipStream_t stream) {
    static int grid = 0;
    if (grid == 0) {
        if (n_in != 28 || out_size != TL * 1024 || ws_size < WS_END) { fprintf(stderr, "kernel_launch: unexpected shapes: n_in %d out %d ws %zu\n", n_in, out_size, ws_size); grid = -1; return; }
        int dev = 0, cus = 0, per_cu = 0;
        hipGetDevice(&dev); hipDeviceGetAttribute(&cus, hipDeviceAttributeMultiprocessorCount, dev);
        if (hipFuncSetAttribute((const void*)fwd_megakernel, hipFuncAttributeMaxDynamicSharedMemorySize, LDS_BYTES) != hipSuccess) { fprintf(stderr, "kernel_launch: hipFuncSetAttribute failed\n"); grid = -1; return; }
        if (hipOccupancyMaxActiveBlocksPerMultiprocessor(&per_cu, (const void*)fwd_megakernel, 512, LDS_BYTES) != hipSuccess || per_cu < 1) { fprintf(stderr, "kernel_launch: occupancy query failed (%d)\n", per_cu); per_cu = 1; }
        (void)hipGetLastError();
        grid = cus * per_cu;
    }
    if (grid < 0) return;
    if (hipMemsetAsync((char*)d_ws + WS_CTL, 0, 65536, stream) != hipSuccess) { fprintf(stderr, "kernel_launch: hipMemsetAsync failed\n"); return; }
    Params p{};
    for (int i = 0; i < 28; ++i) p.in[i] = (const float*)d_in[i];
    p.out = (float*)d_out; p.ws = (unsigned char*)d_ws;
    void* args[] = {&p};
    hipError_t e = hipLaunchCooperativeKernel((const void*)fwd_megakernel, dim3(grid), dim3(512), args, LDS_BYTES, stream);
    if (e != hipSuccess) fprintf(stderr, "cooperative launch failed: %s (grid %d)\n", hipGetErrorString(e), grid);
}
```

```cpp
#include <hip/hip_runtime.h>
#include <hip/hip_cooperative_groups.h>
#include <cstdio>
#include <cstdint>
#include <cmath>
namespace cg = cooperative_groups;

constexpr int TL = 32768, TCX = 2048, TT = TL + TCX, DM = 1024;
constexpr float QK_C2 = 0.125f * 1.4426950408889634f;
typedef float f32x2_t __attribute__((ext_vector_type(2)));
typedef __bf16 bf16x2_t __attribute__((ext_vector_type(2)));
__device__ __forceinline__ unsigned pkbf(float lo, float hi) { f32x2_t v = {lo, hi}; bf16x2_t b = __builtin_convertvector(v, bf16x2_t); return __builtin_bit_cast(unsigned, b); }
__device__ __forceinline__ float bflo(unsigned u) { return __uint_as_float(u << 16); }
__device__ __forceinline__ float bfhi(unsigned u) { return __uint_as_float(u & 0xffff0000u); }
__device__ __forceinline__ float bf1(unsigned short u) { return __uint_as_float(((unsigned)u) << 16); }
__device__ __forceinline__ float silu_f(float z) { return z * __builtin_amdgcn_rcpf(1.f + __expf(-z)); }
__device__ __forceinline__ int opaque_tid() { int t = threadIdx.x; asm volatile("" : "+v"(t)); return t; }
namespace pg8 {
#define PG8_LAS __attribute__((address_space(3)))
typedef unsigned short bf16_t;
typedef short bf16x8 __attribute__((ext_vector_type(8)));
typedef float f32x4 __attribute__((ext_vector_type(4)));
typedef unsigned u32x4 __attribute__((ext_vector_type(4)));
constexpr int BM = 256, BK = 64, HALF = 128, HTB = HALF * BK * 2  , STAGE_BYTES = 8 * HTB, NXCD = 8, WGM = 8;

__host__ __device__ __forceinline__ int lds_byte(int r, int c) { const int st = (r >> 4) * 2 + (c >> 5), rr = r & 15, cc = c & 31, ob = rr * 64 + cc * 2; return st * 1024 + (ob ^ (((ob >> 9) & 1) << 5)); }
__host__ __device__ __forceinline__ void stage_rc(int b, int& R, int& C) { const int st = b / 1024, sb = b % 1024, swz = sb ^ (((sb >> 9) & 1) << 5); R = (st >> 1) * 16 + swz / 64; C = (st & 1) * 32 + (swz % 64) / 2; }
__host__ __device__ __forceinline__ int perm32(int rho) { const int n = rho >> 4, i = rho & 15; return 8 * (i >> 2) + 4 * n + (i & 3); }

struct Unit { int pm, pn; };
struct Gemm { const bf16_t* A; const bf16_t* Bt; int M, N, K; };

struct StaticOrder {
    int nM, nN, nwg, G, c;
    __host__ __device__ void init(int M, int N, int G_, int c_) { nM = M / BM; nN = N / BM; nwg = nM * nN; G = G_; c = c_; }
    __host__ __device__ bool next(int i, Unit& u) const {
        const long L = (long)i * G + c; if (L >= nwg) return false;
        int wgid = (int)L; { const int q = nwg / NXCD, r = nwg % NXCD, xcd = wgid % NXCD, off = wgid / NXCD; wgid = (xcd < r ? xcd * (q + 1) : r * (q + 1) + (xcd - r) * q) + off; }
        const int nig = WGM * nN, gid = wgid / nig, fm = gid * WGM, gsz = (nM - fm) < WGM ? (nM - fm) : WGM;
        u.pm = fm + ((wgid % nig) % gsz); u.pn = (wgid % nig) / gsz; return true;
    }
    __device__ __forceinline__ void a_ready(const Unit&) const {}
    __device__ __forceinline__ void done(const Unit&) const {}
};

struct EpiAttnIn {
    static constexpr bool PERM = true, AFTER_DRAIN = false;
    bf16_t* Q; bf16_t* Kb; bf16_t* V; bf16_t* Z; const PG8_LAS float* ropeC; const PG8_LAS float* ropeS;
    __device__ __forceinline__ void operator()(const f32x4 (&acc)[2][2][4][2], const Unit& u, int wr, int wc, int fr, int fq) const {
        const int sect = u.pn >> 2;
        bf16_t* base = sect == 0 ? Q : sect == 1 ? Kb : sect == 2 ? V : Z;
        const int colt = (u.pn & 3) * 256 + wc * 32 + 8 * fq;
        const int row0 = u.pm * BM + wr * 64 + fr;
        const bool rope = (u.pm < 128) && (sect < 2);
        const float sc = (sect == 0) ? QK_C2 : 1.f;
        const int axis = wc & 1;
#pragma unroll
        for (int ai = 0; ai < 2; ++ai)
#pragma unroll
            for (int m = 0; m < 4; ++m) {
                const int row = row0 + ai * HALF + m * 16;
                const int ntok = row & 4095;
                const int pos = axis ? (ntok & 63) : (ntok >> 6);
                bf16_t* rowp;
                if (sect == 1) rowp = base + (size_t)(row >> 6) * 65536 + (size_t)(colt >> 3) * 512 + (row & 63) * 8;
                else if (sect == 2) rowp = base + (size_t)(row >> 6) * 65536 + (size_t)(colt >> 7) * 8192 + (((colt & 127) >> 5) * 4 + ((row & 63) >> 4)) * 512 + (row & 15) * 32 + (colt & 31);
                else rowp = base + (size_t)row * 1024 + colt;
#pragma unroll
                for (int bj = 0; bj < 2; ++bj) {
                    f32x4 v0 = acc[ai][bj][m][0], v1 = acc[ai][bj][m][1];
                    if (rope) {
                        const f32x4 c0 = *(const PG8_LAS f32x4*)(ropeC + pos * 16 + 8 * (fq & 1)), c1 = *(const PG8_LAS f32x4*)(ropeC + pos * 16 + 8 * (fq & 1) + 4);
                        const f32x4 s0 = *(const PG8_LAS f32x4*)(ropeS + pos * 16 + 8 * (fq & 1)), s1 = *(const PG8_LAS f32x4*)(ropeS + pos * 16 + 8 * (fq & 1) + 4);
                        f32x4 p0, p1;
#pragma unroll
                        for (int i = 0; i < 4; ++i) { p0[i] = __shfl_xor(v0[i], 32); p1[i] = __shfl_xor(v1[i], 32); }
                        if (fq < 2) { v0 = v0 * c0 - p0 * s0; v1 = v1 * c1 - p1 * s1; }
                        else        { v0 = v0 * c0 + p0 * s0; v1 = v1 * c1 + p1 * s1; }
                    }
                    v0 = v0 * sc; v1 = v1 * sc;
                    u32x4 w; w.x = pkbf(v0[0], v0[1]); w.y = pkbf(v0[2], v0[3]); w.z = pkbf(v1[0], v1[1]); w.w = pkbf(v1[2], v1[3]);
                    *(u32x4*)(rowp + (sect == 1 || sect == 2 ? bj * 8192 : bj * HALF)) = w;
                }
            }
    }
};
struct EpiPlain {
    static constexpr bool PERM = true, AFTER_DRAIN = false;
    bf16_t* O; int ldc;
    __device__ __forceinline__ void operator()(const f32x4 (&acc)[2][2][4][2], const Unit& u, int wr, int wc, int fr, int fq) const {
        const int row0 = u.pm * BM + wr * 64 + fr, col0 = u.pn * BM + wc * 32 + 8 * fq;
#pragma unroll
        for (int ai = 0; ai < 2; ++ai)
#pragma unroll
            for (int m = 0; m < 4; ++m) { bf16_t* rowp = O + (size_t)(row0 + ai * HALF + m * 16) * ldc + col0;
#pragma unroll
                for (int bj = 0; bj < 2; ++bj) { const f32x4 v0 = acc[ai][bj][m][0], v1 = acc[ai][bj][m][1];
                    u32x4 w; w.x = pkbf(v0[0], v0[1]); w.y = pkbf(v0[2], v0[3]); w.z = pkbf(v1[0], v1[1]); w.w = pkbf(v1[2], v1[3]);
                    *(u32x4*)(rowp + bj * HALF) = w; } }
    }
};
struct EpiResid {
    static constexpr bool PERM = false, AFTER_DRAIN = false;
    const float* xin_lat; const float* xin_ctx; float* xout_lat; float* xout_ctx; const float* gate; int row_off;
    __device__ __forceinline__ void operator()(const f32x4 (&acc)[2][2][4][2], const Unit& u, int wr, int wc, int fr, int fq) const {
        const int rowt = row_off + u.pm * BM; const bool lat = rowt < TL; const int r = lat ? (rowt >> 12) : 8;
        const int row0 = rowt + wr * 64 + fr, col0 = u.pn * BM + wc * 32 + 4 * fq;
        const float* xi = lat ? xin_lat + (size_t)row0 * 1024 + col0 : xin_ctx + (size_t)(row0 - TL) * 1024 + col0;
        float* xo = lat ? xout_lat + (size_t)row0 * 1024 + col0 : xout_ctx + (size_t)(row0 - TL) * 1024 + col0;
        f32x4 g[2][2];
#pragma unroll
        for (int bj = 0; bj < 2; ++bj)
#pragma unroll
            for (int n = 0; n < 2; ++n) g[bj][n] = *(const f32x4*)(gate + r * 3072 + col0 + bj * HALF + n * 16);
#pragma unroll
        for (int ai = 0; ai < 2; ++ai) {
            f32x4 pre[4][2][2];
#pragma unroll
            for (int m = 0; m < 4; ++m)
#pragma unroll
                for (int bj = 0; bj < 2; ++bj)
#pragma unroll
                    for (int n = 0; n < 2; ++n) pre[m][bj][n] = *(const f32x4*)(xi + (size_t)(ai * HALF + m * 16) * 1024 + bj * HALF + n * 16);
            asm volatile("" ::: "memory");
#pragma unroll
            for (int m = 0; m < 4; ++m)
#pragma unroll
                for (int bj = 0; bj < 2; ++bj)
#pragma unroll
                    for (int n = 0; n < 2; ++n) *(f32x4*)(xo + (size_t)(ai * HALF + m * 16) * 1024 + bj * HALF + n * 16) = pre[m][bj][n] + g[bj][n] * acc[ai][bj][m][n];
            asm volatile("" ::: "memory");
        }
    }
};
struct EpiFnT {
    static constexpr bool PERM = true, AFTER_DRAIN = false;
    bf16_t* ATL; bf16_t* ATC;
    __device__ __forceinline__ void operator()(const f32x4 (&acc)[2][2][4][2], const Unit& u, int wr, int wc, int fr, int fq) const {
        const int row0 = u.pm * BM + wr * 64 + fr, col0 = u.pn * BM + wc * 32 + 8 * fq;
#pragma unroll
        for (int ai = 0; ai < 2; ++ai)
#pragma unroll
            for (int m = 0; m < 4; ++m) { const int mp = row0 + ai * HALF + m * 16, cs = mp >> 10, n = mp & 1023;
#pragma unroll
                for (int bj = 0; bj < 2; ++bj) { const int t0 = col0 + bj * HALF; bf16_t* dst;
                    if (t0 < TL) { const int b = t0 >> 12, l = t0 & 4095; dst = ATL + ((size_t)((b * 1024 + n) * 2 + cs)) * 4096 + l; }
                    else { const int tc = t0 - TL, b = tc >> 8, l = tc & 255; dst = ATC + ((size_t)((b * 1024 + n) * 2 + cs)) * 256 + l; }
                    const f32x4 v0 = acc[ai][bj][m][0], v1 = acc[ai][bj][m][1];
                    u32x4 w; w.x = pkbf(v0[0], v0[1]); w.y = pkbf(v0[2], v0[3]); w.z = pkbf(v1[0], v1[1]); w.w = pkbf(v1[2], v1[3]);
                    *(u32x4*)dst = w; } }
    }
};
struct EpiDft {
    static constexpr bool PERM = true, AFTER_DRAIN = false;
    const bf16_t* Z; bf16_t* OG; int rowbase; int L;
    __device__ __forceinline__ void operator()(const f32x4 (&acc)[2][2][4][2], const Unit& u, int wr, int wc, int fr, int fq) const {
        const int k0 = u.pm * BM + wr * 64 + fr; const int b = u.pn >> 2; const int n0 = (u.pn & 3) * 256 + wc * 32 + 8 * fq;
#pragma unroll
        for (int ai = 0; ai < 2; ++ai)
#pragma unroll
            for (int m = 0; m < 4; ++m) { const size_t R = (size_t)(rowbase + b * L + k0 + ai * HALF + m * 16);
#pragma unroll
                for (int bj = 0; bj < 2; ++bj) { const size_t off = R * 1024 + n0 + bj * HALF;
                    const u32x4 zz = *(const u32x4*)(Z + off);
                    const f32x4 v0 = acc[ai][bj][m][0], v1 = acc[ai][bj][m][1];
                    u32x4 w;
                    w.x = pkbf(v0[0] * silu_f(bflo(zz.x)), v0[1] * silu_f(bfhi(zz.x))); w.y = pkbf(v0[2] * silu_f(bflo(zz.y)), v0[3] * silu_f(bfhi(zz.y)));
                    w.z = pkbf(v1[0] * silu_f(bflo(zz.z)), v1[1] * silu_f(bfhi(zz.z))); w.w = pkbf(v1[2] * silu_f(bflo(zz.w)), v1[3] * silu_f(bfhi(zz.w)));
                    *(u32x4*)(OG + off) = w; } }
    }
};
struct EpiDftSym {
    static constexpr bool PERM = true, AFTER_DRAIN = false;
    const bf16_t* Pb; const float* TA; const bf16_t* Z; bf16_t* OG;
    __device__ __forceinline__ void operator()(const f32x4 (&acc)[2][2][4][2], const Unit& u, int wr, int wc, int fr, int fq) const {
        const int k0 = u.pm * BM + wr * 64 + fr; const int b = u.pn >> 2; const int c0 = u.pn * BM + wc * 32 + 8 * fq; const int n0 = c0 & 1023;
#pragma unroll
        for (int bj = 0; bj < 2; ++bj) {
            const f32x4 t0 = *(const f32x4*)(TA + c0 + bj * HALF), t1 = *(const f32x4*)(TA + c0 + bj * HALF + 4);
#pragma unroll
            for (int aim = 0; aim < 4; ++aim) { const int ai = aim >> 1, mh = (aim & 1) * 2;
                u32x4 pp[4], z1[4], z2[4];
#pragma unroll
                for (int m = mh; m < mh + 2; ++m) { const int k = k0 + ai * HALF + m * 16;
                    pp[m] = *(const u32x4*)(Pb + (size_t)k * 8192 + c0 + bj * HALF);
                    z1[m] = *(const u32x4*)(Z + (size_t)(b * 4096 + k) * 1024 + n0 + bj * HALF);
                    z2[m] = *(const u32x4*)(Z + (size_t)(b * 4096 + ((4096 - k) & 4095)) * 1024 + n0 + bj * HALF); }
                asm volatile("" ::: "memory");
#pragma unroll
                for (int m = mh; m < mh + 2; ++m) { const int k = k0 + ai * HALF + m * 16; const float sg = (k & 1) ? -1.f : 1.f;
                    const f32x4 q0 = acc[ai][bj][m][0], q1 = acc[ai][bj][m][1];
                    float pt[8];
                    pt[0] = bflo(pp[m].x) + sg * t0[0]; pt[1] = bfhi(pp[m].x) + sg * t0[1]; pt[2] = bflo(pp[m].y) + sg * t0[2]; pt[3] = bfhi(pp[m].y) + sg * t0[3];
                    pt[4] = bflo(pp[m].z) + sg * t1[0]; pt[5] = bfhi(pp[m].z) + sg * t1[1]; pt[6] = bflo(pp[m].w) + sg * t1[2]; pt[7] = bfhi(pp[m].w) + sg * t1[3];
                    { const size_t off = (size_t)(b * 4096 + k) * 1024 + n0 + bj * HALF; const u32x4 zz = z1[m]; u32x4 w;
                      w.x = pkbf((pt[0] - q0[0]) * silu_f(bflo(zz.x)), (pt[1] - q0[1]) * silu_f(bfhi(zz.x))); w.y = pkbf((pt[2] - q0[2]) * silu_f(bflo(zz.y)), (pt[3] - q0[3]) * silu_f(bfhi(zz.y)));
                      w.z = pkbf((pt[4] - q1[0]) * silu_f(bflo(zz.z)), (pt[5] - q1[1]) * silu_f(bfhi(zz.z))); w.w = pkbf((pt[6] - q1[2]) * silu_f(bflo(zz.w)), (pt[7] - q1[3]) * silu_f(bfhi(zz.w)));
                      *(u32x4*)(OG + off) = w; }
                    if (k >= 1) { const size_t off = (size_t)(b * 4096 + 4096 - k) * 1024 + n0 + bj * HALF; const u32x4 zz = z2[m]; u32x4 w;
                      w.x = pkbf((pt[0] + q0[0]) * silu_f(bflo(zz.x)), (pt[1] + q0[1]) * silu_f(bfhi(zz.x))); w.y = pkbf((pt[2] + q0[2]) * silu_f(bflo(zz.y)), (pt[3] + q0[3]) * silu_f(bfhi(zz.y)));
                      w.z = pkbf((pt[4] + q1[0]) * silu_f(bflo(zz.z)), (pt[5] + q1[1]) * silu_f(bfhi(zz.z))); w.w = pkbf((pt[6] + q1[2]) * silu_f(bflo(zz.w)), (pt[7] + q1[3]) * silu_f(bfhi(zz.w)));
                      *(u32x4*)(OG + off) = w; }
                }
                asm volatile("" ::: "memory");
            }
        }
    }
};
template <class Epi, class Sched, bool ALIGN_EPI = false, bool SP2 = false>
__device__ __forceinline__ void gemm_phase(PG8_LAS unsigned char* lds, const Gemm g, const Sched& S, const Epi& E) {
    const int tid = opaque_tid(), wid = __builtin_amdgcn_readfirstlane(tid >> 6), lane = tid & 63, wr = wid >> 2, wc = wid & 3, fr = lane & 15, fq = lane >> 4;
    const int K = g.K, nt = K / BK;
    unsigned voffA[2], voffB[2];
#pragma unroll
    for (int i = 0; i < 2; ++i) { int R, C; stage_rc(tid * 16 + i * 8192, R, C); const int Rb = Epi::PERM ? ((R & ~31) + perm32(R & 31)) : R;
        voffA[i] = (unsigned)(R * K + C) * 2u; voffB[i] = (unsigned)(Rb * K + C) * 2u; }
    const size_t kstep = (size_t)(BK * 2);
    const size_t hstep = (size_t)HALF * K * 2;
    const size_t tstep = 2 * hstep;
    const unsigned ldsw = (unsigned)wid * 1024u;
    const int aoff = lds_byte(wr * 64 + fr, fq * 8), boff = lds_byte(wc * 32 + fr, fq * 8);
#define PG8_SA(b, h) (((b) * 2 + (h)) * HTB)
#define PG8_SB(b, h) ((4 + (b) * 2 + (h)) * HTB)
#define PG8_STAGE(bufoff, gbase, voff) do { _Pragma("unroll") for (int _i = 0; _i < 2; ++_i) \
        __builtin_amdgcn_global_load_lds((const unsigned*)((const char*)(gbase) + (voff)[_i]), (PG8_LAS unsigned*)(lds + (bufoff) + ldsw + _i * 8192), 16, 0, 0); } while (0)
#define PG8_LDA(dst, b, h) do { _Pragma("unroll") for (int m = 0; m < 4; ++m) _Pragma("unroll") for (int k = 0; k < 2; ++k) dst[m][k] = *(const PG8_LAS bf16x8*)(lds + PG8_SA(b, h) + aoff + m * 2048 + k * 1024); } while (0)
#define PG8_LDB(dst, b, h) do { _Pragma("unroll") for (int n = 0; n < 2; ++n) _Pragma("unroll") for (int k = 0; k < 2; ++k) dst[n][k] = *(const PG8_LAS bf16x8*)(lds + PG8_SB(b, h) + boff + n * 2048 + k * 1024); } while (0)
#define PG8_MMA(ai, bj, At, Bt) do { __builtin_amdgcn_s_setprio(1); _Pragma("unroll") for (int m = 0; m < 4; ++m) _Pragma("unroll") for (int n = 0; n < 2; ++n) _Pragma("unroll") for (int k = 0; k < 2; ++k) \
        acc[ai][bj][m][n] = __builtin_amdgcn_mfma_f32_16x16x32_bf16(Bt[n][k], At[m][k], acc[ai][bj][m][n], 0, 0, 0); __builtin_amdgcn_s_setprio(0); } while (0)
#define PG8_WAIT_V(n) asm volatile("s_waitcnt vmcnt(" #n ")" ::: "memory")
#define PG8_WAIT_L(n) asm volatile("s_waitcnt lgkmcnt(" #n ")" ::: "memory")
#define PG8_BAR __builtin_amdgcn_s_barrier()
#define PG8_SCHED __builtin_amdgcn_sched_barrier(0)
    Unit cur, nxt; int ui = 0;
    if (!S.next(0, cur)) return;
    f32x4 acc[2][2][4][2];
#pragma unroll
    for (int a = 0; a < 2; ++a)
#pragma unroll
        for (int b = 0; b < 2; ++b)
#pragma unroll
            for (int m = 0; m < 4; ++m)
#pragma unroll
                for (int n = 0; n < 2; ++n) acc[a][b][m][n] = (f32x4){0.f, 0.f, 0.f, 0.f};
    bf16x8 At[4][2], B0[2][2], B1[2][2];
    const char* cA = (const char*)g.A + (size_t)cur.pm * tstep; const char* cB = (const char*)g.Bt + (size_t)cur.pn * tstep;
    S.a_ready(cur);
    if constexpr (SP2) {
        PG8_STAGE(PG8_SB(0, 0), cB, voffB); PG8_STAGE(PG8_SB(0, 1), cB + hstep, voffB); PG8_STAGE(PG8_SA(0, 0), cA, voffA); PG8_STAGE(PG8_SA(0, 1), cA + hstep, voffA);
        if (wr == 1) PG8_BAR;
        PG8_WAIT_V(2); PG8_BAR;
        PG8_STAGE(PG8_SB(1, 0), cB + kstep, voffB); PG8_STAGE(PG8_SA(1, 0), cA + kstep, voffA); PG8_STAGE(PG8_SB(1, 1), cB + hstep + kstep, voffB);
        PG8_WAIT_V(6); PG8_BAR;
    } else {
        PG8_STAGE(PG8_SB(0, 0), cB, voffB); PG8_STAGE(PG8_SA(0, 0), cA, voffA); PG8_STAGE(PG8_SB(0, 1), cB + hstep, voffB); PG8_STAGE(PG8_SA(0, 1), cA + hstep, voffA);
        if (wr == 1) PG8_BAR;
        PG8_WAIT_V(4); PG8_BAR;
        PG8_STAGE(PG8_SB(1, 0), cB + kstep, voffB); PG8_STAGE(PG8_SA(1, 0), cA + kstep, voffA); PG8_STAGE(PG8_SB(1, 1), cB + hstep + kstep, voffB);
        PG8_WAIT_V(6); PG8_BAR;
    }
    for (;;) {
        const bool has_next = S.next(ui + 1, nxt);
        const char* nA = has_next ? (const char*)g.A + (size_t)nxt.pm * tstep : cA; const char* nB = has_next ? (const char*)g.Bt + (size_t)nxt.pn * tstep : cB;
        for (int t = 0; t < nt; t += 2) {
            const bool last = (t == nt - 2);
            const char* a1 = cA + (size_t)(t + 1) * kstep;
            const char* a2 = last ? nA : cA + (size_t)(t + 2) * kstep; const char* b2 = last ? nB : cB + (size_t)(t + 2) * kstep;
            const char* a3 = a2 + kstep; const char* b3 = b2 + kstep;
            if (last && has_next) S.a_ready(nxt);
            if constexpr (SP2) {
            PG8_LDB(B0, 0, 0); PG8_LDB(B1, 0, 1); PG8_SCHED; PG8_LDA(At, 0, 0); PG8_STAGE(PG8_SA(1, 1), a1 + hstep, voffA);
            PG8_WAIT_V(8); PG8_WAIT_L(0); PG8_BAR; PG8_MMA(0, 0, At, B0); PG8_MMA(0, 1, At, B1); PG8_BAR; PG8_SCHED;
            PG8_LDA(At, 0, 1); PG8_STAGE(PG8_SB(0, 0), b2, voffB); PG8_STAGE(PG8_SB(0, 1), b2 + hstep, voffB); PG8_STAGE(PG8_SA(0, 0), a2, voffA);
            PG8_WAIT_V(8); PG8_WAIT_L(0); PG8_BAR; PG8_MMA(1, 0, At, B0); PG8_MMA(1, 1, At, B1); PG8_BAR; PG8_SCHED;
            PG8_LDB(B0, 1, 0); PG8_LDB(B1, 1, 1); PG8_SCHED; PG8_LDA(At, 1, 0); PG8_STAGE(PG8_SA(0, 1), a2 + hstep, voffA);
            PG8_WAIT_V(8); PG8_WAIT_L(0); PG8_BAR; PG8_MMA(0, 0, At, B0); PG8_MMA(0, 1, At, B1); PG8_BAR; PG8_SCHED;
            PG8_LDA(At, 1, 1); PG8_STAGE(PG8_SB(1, 0), b3, voffB); PG8_STAGE(PG8_SB(1, 1), b3 + hstep, voffB); PG8_STAGE(PG8_SA(1, 0), a3, voffA);
            PG8_WAIT_V(8); PG8_WAIT_L(0); PG8_BAR; PG8_MMA(1, 0, At, B0); PG8_MMA(1, 1, At, B1); PG8_BAR; PG8_SCHED;
            } else {
            PG8_LDB(B0, 0, 0); PG8_SCHED; PG8_LDA(At, 0, 0); PG8_STAGE(PG8_SA(1, 1), a1 + hstep, voffA);
            PG8_WAIT_L(8); PG8_BAR; PG8_WAIT_L(0); PG8_MMA(0, 0, At, B0); PG8_BAR; PG8_SCHED;
            PG8_LDB(B1, 0, 1); PG8_STAGE(PG8_SB(0, 0), b2, voffB);
            PG8_BAR; PG8_WAIT_L(0); PG8_MMA(0, 1, At, B1); PG8_BAR;
            PG8_LDA(At, 0, 1); PG8_STAGE(PG8_SA(0, 0), a2, voffA);
            PG8_BAR; PG8_WAIT_L(0); PG8_MMA(1, 0, At, B0); PG8_BAR; PG8_SCHED;
            PG8_STAGE(PG8_SB(0, 1), b2 + hstep, voffB);
            PG8_WAIT_V(6); PG8_BAR; PG8_MMA(1, 1, At, B1); PG8_BAR;
            PG8_LDB(B0, 1, 0); PG8_SCHED; PG8_LDA(At, 1, 0); PG8_STAGE(PG8_SA(0, 1), a2 + hstep, voffA);
            PG8_WAIT_L(8); PG8_BAR; PG8_WAIT_L(0); PG8_MMA(0, 0, At, B0); PG8_BAR; PG8_SCHED;
            PG8_LDB(B1, 1, 1); PG8_STAGE(PG8_SB(1, 0), b3, voffB);
            PG8_BAR; PG8_WAIT_L(0); PG8_MMA(0, 1, At, B1); PG8_BAR;
            PG8_LDA(At, 1, 1); PG8_STAGE(PG8_SA(1, 0), a3, voffA);
            PG8_BAR; PG8_WAIT_L(0); PG8_MMA(1, 0, At, B0); PG8_BAR; PG8_SCHED;
            PG8_STAGE(PG8_SB(1, 1), b3 + hstep, voffB);
            PG8_WAIT_V(6); PG8_BAR; PG8_MMA(1, 1, At, B1); PG8_BAR;
            }
        }
        if constexpr (ALIGN_EPI) { if (wr == 0) PG8_BAR; }
        if constexpr (!Epi::AFTER_DRAIN) { E(acc, cur, wr, wc, fr, fq); S.done(cur); }
        if (!has_next) break;
#pragma unroll
        for (int a = 0; a < 2; ++a)
#pragma unroll
            for (int b = 0; b < 2; ++b)
#pragma unroll
                for (int m = 0; m < 4; ++m)
#pragma unroll
                    for (int n = 0; n < 2; ++n) acc[a][b][m][n] = (f32x4){0.f, 0.f, 0.f, 0.f};
        cur = nxt; cA = nA; cB = nB; ++ui;
        if constexpr (ALIGN_EPI) { if (wr == 1) PG8_BAR; }
    }
    PG8_WAIT_V(0);
    if constexpr (!ALIGN_EPI) { if (wr == 0) PG8_BAR; }
    PG8_BAR;
    if constexpr (Epi::AFTER_DRAIN) { E.fused(acc, cur, wr, wc, fr, fq, lds, wid, lane); S.done(cur); }
#undef PG8_SA
#undef PG8_SB
#undef PG8_STAGE
#undef PG8_LDA
#undef PG8_LDB
#undef PG8_MMA
#undef PG8_WAIT_V
#undef PG8_WAIT_L
#undef PG8_BAR
#undef PG8_SCHED
}
}
#define LAS __attribute__((address_space(3)))
namespace att {
using bf16x8 = __attribute__((ext_vector_type(8))) short;
using s16x4 = __attribute__((ext_vector_type(4))) short;
using f32x16 = __attribute__((ext_vector_type(16))) float;
using u32x4 = __attribute__((ext_vector_type(4))) unsigned;
typedef unsigned short bf16_t;
__device__ __forceinline__ int crow(int r, int hi) { return (r & 3) + 8 * (r >> 2) + 4 * hi; }
typedef float f32x4_t __attribute__((ext_vector_type(4)));
template <int CTRL> __device__ __forceinline__ float adpp(float v) { return __int_as_float(__builtin_amdgcn_update_dpp(0, __float_as_int(v), CTRL, 0xf, 0xf, true)); }
constexpr int KSLOT = 8192, VSLOT = 16384, LDS_K = 0, LDS_V = 3 * KSLOT, LDS_WS = LDS_V + 4 * VSLOT, LDS_CNT = LDS_WS + 2048;
struct Args { const bf16_t* Q; const bf16_t* K; const bf16_t* V; const bf16_t* Z; bf16_t* O; const float* gain; float lam; float oml; int n_units; unsigned* o1g; };

__device__ __forceinline__ void qkt(f32x16& p0, f32x16& p1, const LAS char* Kslot, const bf16x8* qr, const f32x16& negm, int r32, int hi) {
    const LAS char* kb = Kslot + hi * 1024 + r32 * 16;
    bf16x8 kf[8];
#pragma unroll
    for (int d0 = 0; d0 < 4; ++d0) { kf[2 * d0] = *(const LAS bf16x8*)(kb + d0 * 2048); kf[2 * d0 + 1] = *(const LAS bf16x8*)(kb + d0 * 2048 + 512); }
    asm volatile("s_waitcnt lgkmcnt(0)" ::: "memory"); __builtin_amdgcn_sched_barrier(0);
    p0 = __builtin_amdgcn_mfma_f32_32x32x16_bf16(kf[0], qr[0], negm, 0, 0, 0); p1 = __builtin_amdgcn_mfma_f32_32x32x16_bf16(kf[1], qr[0], negm, 0, 0, 0);
#pragma unroll
    for (int d0 = 1; d0 < 4; ++d0) { p0 = __builtin_amdgcn_mfma_f32_32x32x16_bf16(kf[2 * d0], qr[d0], p0, 0, 0, 0); p1 = __builtin_amdgcn_mfma_f32_32x32x16_bf16(kf[2 * d0 + 1], qr[d0], p1, 0, 0, 0); }
}
__device__ __forceinline__ void kload(bf16x8* kf, const LAS char* Kslot, int r32, int hi) {
    const LAS char* kb = Kslot + hi * 1024 + r32 * 16;
#pragma unroll
    for (int d0 = 0; d0 < 2; ++d0) { kf[2 * d0] = *(const LAS bf16x8*)(kb + d0 * 2048); kf[2 * d0 + 1] = *(const LAS bf16x8*)(kb + d0 * 2048 + 512); }
}
__device__ __forceinline__ void qk_mm(f32x16& p0, f32x16& p1, const bf16x8* kf, const LAS char* Kslot, int r32, int hi, const bf16x8* qr, const f32x16& z) {
    const LAS char* kb = Kslot + hi * 1024 + r32 * 16;
    p0 = __builtin_amdgcn_mfma_f32_32x32x16_bf16(kf[0], qr[0], z, 0, 0, 0); p1 = __builtin_amdgcn_mfma_f32_32x32x16_bf16(kf[1], qr[0], z, 0, 0, 0);
    p0 = __builtin_amdgcn_mfma_f32_32x32x16_bf16(kf[2], qr[1], p0, 0, 0, 0); p1 = __builtin_amdgcn_mfma_f32_32x32x16_bf16(kf[3], qr[1], p1, 0, 0, 0);
    bf16x8 kg[4];
#pragma unroll
    for (int d0 = 2; d0 < 4; ++d0) { kg[2 * (d0 - 2)] = *(const LAS bf16x8*)(kb + d0 * 2048); kg[2 * (d0 - 2) + 1] = *(const LAS bf16x8*)(kb + d0 * 2048 + 512); }
    p0 = __builtin_amdgcn_mfma_f32_32x32x16_bf16(kg[0], qr[2], p0, 0, 0, 0); p1 = __builtin_amdgcn_mfma_f32_32x32x16_bf16(kg[1], qr[2], p1, 0, 0, 0);
    p0 = __builtin_amdgcn_mfma_f32_32x32x16_bf16(kg[2], qr[3], p0, 0, 0, 0); p1 = __builtin_amdgcn_mfma_f32_32x32x16_bf16(kg[3], qr[3], p1, 0, 0, 0);
}
__device__ __forceinline__ float max3a(float a, float b, float c) { float r; asm("v_max3_f32 %0, %1, %2, %3" : "=v"(r) : "v"(a), "v"(b), "v"(c)); return r; }
__device__ __forceinline__ float rowmax(const f32x16& p0, const f32x16& p1) {
    float a = max3a(p0[0], p0[1], p0[2]), b = max3a(p1[0], p1[1], p1[2]);
#pragma unroll
    for (int r = 3; r < 15; r += 2) { a = max3a(a, p0[r], p0[r + 1]); b = max3a(b, p1[r], p1[r + 1]); }
    a = max3a(a, p0[15], p1[15]);
    float m; asm("v_max_f32 %0, %1, %2" : "=v"(m) : "v"(a), "v"(b));
    asm volatile("s_nop 1" ::: "memory");
    auto rr = __builtin_amdgcn_permlane32_swap(__float_as_uint(m), __float_as_uint(m), false, false);
    float o; asm("v_max_f32 %0, %1, %2" : "=v"(o) : "v"(__uint_as_float(rr[0])), "v"(__uint_as_float(rr[1])));
    return o;
}
#define ATT_VRD(buf, d0) do { _Pragma("unroll") for (int ks = 0; ks < 4; ++ks) { \
        asm volatile("ds_read_b64_tr_b16 %0,%1 offset:%c2" : "=&v"(lo[buf][ks]) : "v"(vb), "i"((d0) * 4096 + ks * 1024) : "memory"); \
        asm volatile("ds_read_b64_tr_b16 %0,%1 offset:%c2" : "=&v"(hi[buf][ks]) : "v"(vb), "i"((d0) * 4096 + ks * 1024 + 512) : "memory"); } } while (0)
#define ATT_PK(b, k) (bf16x8){lo[b][k][0], lo[b][k][1], lo[b][k][2], lo[b][k][3], hi[b][k][0], hi[b][k][1], hi[b][k][2], hi[b][k][3]}
#define ATT_MM2(da, db) do { \
        o[da] = __builtin_amdgcn_mfma_f32_32x32x16_bf16(pa0, ATT_PK(0, 0), o[da], 0, 0, 0); o[db] = __builtin_amdgcn_mfma_f32_32x32x16_bf16(pa0, ATT_PK(1, 0), o[db], 0, 0, 0); \
        o[da] = __builtin_amdgcn_mfma_f32_32x32x16_bf16(pa1, ATT_PK(0, 1), o[da], 0, 0, 0); o[db] = __builtin_amdgcn_mfma_f32_32x32x16_bf16(pa1, ATT_PK(1, 1), o[db], 0, 0, 0); \
        o[da] = __builtin_amdgcn_mfma_f32_32x32x16_bf16(pa2, ATT_PK(0, 2), o[da], 0, 0, 0); o[db] = __builtin_amdgcn_mfma_f32_32x32x16_bf16(pa2, ATT_PK(1, 2), o[db], 0, 0, 0); \
        o[da] = __builtin_amdgcn_mfma_f32_32x32x16_bf16(pa3, ATT_PK(0, 3), o[da], 0, 0, 0); o[db] = __builtin_amdgcn_mfma_f32_32x32x16_bf16(pa3, ATT_PK(1, 3), o[db], 0, 0, 0); } while (0)
__device__ __forceinline__ void pv(f32x16* o, int vb, bf16x8 pa0, bf16x8 pa1, bf16x8 pa2, bf16x8 pa3) {
    s16x4 lo[2][4], hi[2][4];
    ATT_VRD(0, 0);
    ATT_VRD(1, 1);
    asm volatile("s_waitcnt lgkmcnt(0)" ::: "memory"); __builtin_amdgcn_sched_barrier(0);
    ATT_MM2(0, 1); __builtin_amdgcn_sched_barrier(0);
    ATT_VRD(0, 2);
    ATT_VRD(1, 3);
    asm volatile("s_waitcnt lgkmcnt(0)" ::: "memory"); __builtin_amdgcn_sched_barrier(0);
    ATT_MM2(2, 3);
}
#undef ATT_MM2
#undef ATT_VRD
#undef ATT_PK
__device__ __forceinline__ void attn_pass(const Args& A, int z, int b, int h, int qrow0, bool isctx, bool pathB, LAS char* shm, f32x16* o) {
    const int tid = opaque_tid(), lane = tid & 63, r32 = lane & 31, hi = lane >> 5; const int wid = __builtin_amdgcn_readfirstlane(tid >> 6);
    const int NT = isctx ? 4 : 68;
    LAS float* wsf = (LAS float*)(shm + LDS_WS) + wid * 64;
    const int vb0 = (int)(unsigned)(size_t)(shm + LDS_V) + ((lane >> 4) & 1) * 32 + (lane & 3) * 8 + (4 * hi + ((lane & 15) >> 2)) * 64;
    const bf16_t* Qw = A.Q + (size_t)(qrow0 + wid * 32 + r32) * 1024 + h * 128 + z * 64;
    bf16x8 qr[4];
#pragma unroll
    for (int d0 = 0; d0 < 4; ++d0) qr[d0] = *(const bf16x8*)(Qw + d0 * 16 + hi * 8);
    const bf16_t* Kh = A.K + (size_t)((h * 2 + z) * 8 + wid) * 512 + lane * 8;
    const int pc0 = wid, pc1 = wid + 8;
    const bf16_t* Vh0 = A.V + (size_t)h * 8192 + pc0 * 512 + lane * 8;
    const bf16_t* Vh1 = A.V + (size_t)h * 8192 + pc1 * 512 + lane * 8;
    const int ctxrow = TL + b * 256, latrow = b * 4096;
#define ATT_TROW(t) ((isctx || (t) < 4) ? (ctxrow + 64 * (t)) : (latrow + 64 * ((t) - 4)))
#define ATT_DMA(t, slot, vslot) do { const size_t ro_ = (size_t)(ATT_TROW(t) >> 6) * 65536; \
        __builtin_amdgcn_global_load_lds((const unsigned*)(Kh + ro_), (LAS unsigned*)(shm + LDS_K + (slot) * KSLOT + wid * 1024), 16, 0, 0); \
        __builtin_amdgcn_global_load_lds((const unsigned*)(Vh0 + ro_), (LAS unsigned*)(shm + LDS_V + (vslot) * VSLOT + pc0 * 1024), 16, 0, 0); \
        __builtin_amdgcn_global_load_lds((const unsigned*)(Vh1 + ro_), (LAS unsigned*)(shm + LDS_V + (vslot) * VSLOT + pc1 * 1024), 16, 0, 0); } while (0)
    float mhat = 0.f, l_reg = 0.f;
    const f32x16 negm = f32x16{};
#pragma unroll
    for (int d = 0; d < 4; ++d) o[d] = f32x16{};
    ATT_DMA(0, 0, 0);
    if (NT > 1) ATT_DMA(1, 1, 1);
    asm volatile("s_waitcnt vmcnt(0) lgkmcnt(0)\n\ts_barrier" ::: "memory");
    f32x16 sc0, sc1;
    { bf16x8 kf[4]; kload(kf, shm + LDS_K, r32, hi); qk_mm(sc0, sc1, kf, shm + LDS_K, r32, hi, qr, negm); asm volatile("s_nop 15\n\ts_nop 15" : "+v"(sc0), "+v"(sc1)); }
    if (NT > 2) ATT_DMA(2, 2, 2);
    int k_cur = 0, v_cur = 0, v_prev = 3;
    u32x4 pw0 = {0u, 0u, 0u, 0u}, pw1 = pw0, pw2 = pw0, pw3 = pw0;
#pragma unroll 1
    for (int t = 0; t <= NT; ++t) {
        const int k_n1 = (k_cur == 2) ? 0 : k_cur + 1;
        if (t > 0) {
            asm volatile("s_waitcnt vmcnt(0) lgkmcnt(0)\n\ts_barrier" ::: "memory");
            const int k_p2 = (k_cur == 0) ? 2 : k_cur - 1;
            const int v_p2 = (v_cur + 2) & 3;
            if (t + 2 < NT) ATT_DMA(t + 2, k_p2, v_p2);
        }
        if (pathB && t > 0) {
            pv(o, vb0 + v_prev * VSLOT, __builtin_bit_cast(bf16x8, pw0), __builtin_bit_cast(bf16x8, pw1), __builtin_bit_cast(bf16x8, pw2), __builtin_bit_cast(bf16x8, pw3)); }
        if (t < NT) {
        const float rm = rowmax(sc0, sc1);
        if (t == 0 || __any(rm > 8.f)) {
            const float dl = (t == 0) ? rm : fmaxf(rm, 0.f); mhat += dl;
#pragma unroll
            for (int r = 0; r < 16; ++r) { sc0[r] -= dl; sc1[r] -= dl; }
            if (t > 0) {
                const float f = __builtin_amdgcn_exp2f(-dl); l_reg *= f;
                if (hi == 0) wsf[r32] = f;
                asm volatile("s_waitcnt lgkmcnt(0)" ::: "memory");
#pragma unroll
                for (int r = 0; r < 16; ++r) { const float fr_ = wsf[crow(r, hi)];
#pragma unroll
                    for (int d = 0; d < 4; ++d) o[d][r] *= fr_; }
                asm volatile("s_waitcnt lgkmcnt(0)" ::: "memory");
            }
        }
        bf16x8 kf[4];
        kload(kf, shm + LDS_K + k_n1 * KSLOT, r32, hi);
        __builtin_amdgcn_sched_barrier(0);
        f32x16 pn0, pn1;
        { f32x16 nm;
#pragma unroll
          for (int r = 0; r < 16; ++r) nm[r] = -mhat;
          qk_mm(pn0, pn1, kf, shm + LDS_K + k_n1 * KSLOT, r32, hi, qr, nm); }
        f32x2_t sacc = {0.f, 0.f};
#pragma unroll
        for (int r = 0; r < 16; r += 2) { sc0[r] = __builtin_amdgcn_exp2f(sc0[r]); sc0[r + 1] = __builtin_amdgcn_exp2f(sc0[r + 1]); sc1[r] = __builtin_amdgcn_exp2f(sc1[r]); sc1[r + 1] = __builtin_amdgcn_exp2f(sc1[r + 1]);
            sacc += (f32x2_t){sc0[r], sc0[r + 1]}; sacc += (f32x2_t){sc1[r], sc1[r + 1]}; }
        l_reg += sacc.x + sacc.y;
        pw0 = (u32x4){pkbf(sc0[0], sc0[1]), pkbf(sc0[2], sc0[3]), pkbf(sc0[4], sc0[5]), pkbf(sc0[6], sc0[7])};
        pw1 = (u32x4){pkbf(sc0[8], sc0[9]), pkbf(sc0[10], sc0[11]), pkbf(sc0[12], sc0[13]), pkbf(sc0[14], sc0[15])};
        pw2 = (u32x4){pkbf(sc1[0], sc1[1]), pkbf(sc1[2], sc1[3]), pkbf(sc1[4], sc1[5]), pkbf(sc1[6], sc1[7])};
        pw3 = (u32x4){pkbf(sc1[8], sc1[9]), pkbf(sc1[10], sc1[11]), pkbf(sc1[12], sc1[13]), pkbf(sc1[14], sc1[15])};
#pragma unroll
        for (int i = 0; i < 8; ++i) { __builtin_amdgcn_sched_group_barrier(0x008, 1, 0); __builtin_amdgcn_sched_group_barrier(0x002, 10, 0); }
        __builtin_amdgcn_sched_barrier(0);
        if (!pathB) {
            pv(o, vb0 + v_cur * VSLOT, __builtin_bit_cast(bf16x8, pw0), __builtin_bit_cast(bf16x8, pw1), __builtin_bit_cast(bf16x8, pw2), __builtin_bit_cast(bf16x8, pw3)); }
        sc0 = pn0; sc1 = pn1;
        }
        k_cur = k_n1; v_prev = v_cur; v_cur = (v_cur + 1) & 3;
    }
    asm volatile("s_waitcnt lgkmcnt(0)\n\ts_barrier" ::: "memory");
#undef ATT_DMA
#undef ATT_TROW
    { auto rr = __builtin_amdgcn_permlane32_swap(__float_as_uint(l_reg), __float_as_uint(l_reg), false, false); l_reg = __uint_as_float(rr[0]) + __uint_as_float(rr[1]); }
    asm volatile("s_waitcnt lgkmcnt(0)" ::: "memory");
    if (hi == 0) wsf[32 + r32] = l_reg;
    asm volatile("s_waitcnt lgkmcnt(0)" ::: "memory");
#pragma unroll
    for (int r = 0; r < 16; ++r) { const float rl = 1.0f / wsf[32 + crow(r, hi)];
#pragma unroll
        for (int d = 0; d < 4; ++d) o[d][r] *= rl; }
    asm volatile("s_waitcnt lgkmcnt(0)" ::: "memory");
}
__device__ __forceinline__ void attn_unit(const Args& A, int b, int h, int qb, bool isctx, bool pathB, LAS char* shm) {
    const int tid = opaque_tid(), lane = tid & 63, r32 = lane & 31, hi = lane >> 5; const int wid = __builtin_amdgcn_readfirstlane(tid >> 6);
    const int qrow0 = isctx ? (TL + b * 256) : (b * 4096 + qb * 256);
    f32x16 o[4];
    unsigned* o1s = A.o1g + wid * 2048 + lane;
    attn_pass(A, 0, b, h, qrow0, isctx, pathB, shm, o);
#pragma unroll
    for (int d = 0; d < 4; ++d)
#pragma unroll
        for (int r = 0; r < 16; r += 2) o1s[(d * 8 + (r >> 1)) * 64] = pkbf(o[d][r], o[d][r + 1]);
    asm volatile("s_waitcnt lgkmcnt(0)" ::: "memory");
    attn_pass(A, 1, b, h, qrow0, isctx, pathB, shm, o);
#pragma unroll
    for (int r = 0; r < 16; r += 2)
#pragma unroll
        for (int d = 0; d < 4; ++d) { const unsigned pk = o1s[(d * 8 + (r >> 1)) * 64]; o[d][r] = bflo(pk) - A.lam * o[d][r]; o[d][r + 1] = bfhi(pk) - A.lam * o[d][r + 1]; }
    LAS float* stg = (LAS float*)shm + wid * (32 * 68);
    const int rq = lane >> 3, cq = lane & 7;
    float vals[2][4][8]; float ssr[4] = {0.f, 0.f, 0.f, 0.f};
#pragma unroll
    for (int hf = 0; hf < 2; ++hf) {
#pragma unroll
        for (int r = 0; r < 16; ++r) { stg[crow(r, hi) * 68 + r32] = o[2 * hf][r]; stg[crow(r, hi) * 68 + 32 + r32] = o[2 * hf + 1][r]; }
        asm volatile("s_waitcnt lgkmcnt(0)" ::: "memory");
#pragma unroll
        for (int i = 0; i < 4; ++i) { const f32x4_t u0 = *(const LAS f32x4_t*)(stg + (rq + 8 * i) * 68 + cq * 8), u1 = *(const LAS f32x4_t*)(stg + (rq + 8 * i) * 68 + cq * 8 + 4);
#pragma unroll
            for (int c = 0; c < 4; ++c) { vals[hf][i][c] = u0[c]; vals[hf][i][4 + c] = u1[c]; ssr[i] += u0[c] * u0[c] + u1[c] * u1[c]; } }
        asm volatile("s_waitcnt lgkmcnt(0)" ::: "memory");
    }
#pragma unroll
    for (int i = 0; i < 4; ++i) { float v = ssr[i]; v += adpp<0xB1>(v); v += adpp<0x4E>(v); v += adpp<0x141>(v); ssr[i] = rsqrtf(v * (1.0f / 128.0f) + 1e-5f) * A.oml; }
#pragma unroll
    for (int hf = 0; hf < 2; ++hf) {
        const int col = h * 128 + hf * 64 + cq * 8;
        const f32x4_t g0 = *(const f32x4_t*)(A.gain + hf * 64 + cq * 8), g1 = *(const f32x4_t*)(A.gain + hf * 64 + cq * 8 + 4);
        u32x4 zz[4];
#pragma unroll
        for (int i = 0; i < 4; ++i) zz[i] = *(const u32x4*)(A.Z + (size_t)(qrow0 + wid * 32 + rq + 8 * i) * 1024 + col);
#pragma unroll
        for (int i = 0; i < 4; ++i) { const float rs = ssr[i]; const float* vv = vals[hf][i]; u32x4 w;
            w.x = pkbf(vv[0] * rs * g0[0] * silu_f(bflo(zz[i].x)), vv[1] * rs * g0[1] * silu_f(bfhi(zz[i].x)));
            w.y = pkbf(vv[2] * rs * g0[2] * silu_f(bflo(zz[i].y)), vv[3] * rs * g0[3] * silu_f(bfhi(zz[i].y)));
            w.z = pkbf(vv[4] * rs * g1[0] * silu_f(bflo(zz[i].z)), vv[5] * rs * g1[1] * silu_f(bfhi(zz[i].z)));
            w.w = pkbf(vv[6] * rs * g1[2] * silu_f(bflo(zz[i].w)), vv[7] * rs * g1[3] * silu_f(bfhi(zz[i].w)));
            *(u32x4*)(A.O + (size_t)(qrow0 + wid * 32 + rq + 8 * i) * 1024 + col) = w; }
    }
}
__device__ __forceinline__ void attn_phase(const Args& A, LAS char* shm, int G, int bid) {
    const int vcu = (G % 8 == 0) ? (bid % 8) * (G / 8) + bid / 8 : bid;
    bool pathB;
    { const int tid = opaque_tid(); LAS unsigned* cnt = (LAS unsigned*)(shm + LDS_CNT);
      if (tid < 4) cnt[tid] = 0u;
      __syncthreads();
      const unsigned simd = (unsigned)__builtin_amdgcn_s_getreg((1 << 11) | (4 << 6) | 4) & 3u;
      unsigned slot = 0u; if ((tid & 63) == 0) slot = __hip_atomic_fetch_add(cnt + simd, 1u, __ATOMIC_RELAXED, __HIP_MEMORY_SCOPE_WORKGROUP);
      slot = (unsigned)__builtin_amdgcn_readfirstlane((int)slot);
      pathB = (slot & 1u) != 0u;
      __syncthreads(); }
#pragma unroll 1
    for (int u = vcu; u < A.n_units; u += G) {
        const bool isctx = u >= 1024; const int bh = isctx ? (u - 1024) : (u >> 4); const int qb = isctx ? 0 : (u & 15);
        attn_unit(A, bh >> 3, bh & 7, qb, isctx, pathB, shm);
        asm volatile("s_waitcnt vmcnt(0) lgkmcnt(0)\n\ts_barrier" ::: "memory");
    }
}
}
typedef unsigned short bf16_t;
typedef float f32x4 __attribute__((ext_vector_type(4)));
typedef unsigned u32x4 __attribute__((ext_vector_type(4)));
typedef unsigned u32x2 __attribute__((ext_vector_type(2)));
constexpr size_t MiB = 1u << 20;
constexpr size_t WS_CTL = 0, WS_MOD = 1 * MiB, WS_ROPE = 1 * MiB + 512 * 1024, WS_BZ = 2 * MiB;
constexpr size_t WS_WDAIN = 9 * MiB, WS_WDAOUT = 25 * MiB, WS_WFNT = 29 * MiB, WS_WFNZ = 33 * MiB, WS_WFNOUT = 35 * MiB, WS_WRWIN = 37 * MiB, WS_WRWOUT = 46 * MiB;
constexpr size_t WS_XC = 48 * MiB, WS_HB = 56 * MiB, WS_BIG = 124 * MiB;
constexpr size_t WS_Q = WS_BIG, WS_K = WS_BIG + 68 * MiB, WS_V = WS_BIG + 136 * MiB, WS_Z = WS_BIG + 204 * MiB;
constexpr size_t WS_ATL = WS_BIG, WS_ATC = WS_BIG + 128 * MiB, WS_ZB = WS_BIG + 136 * MiB, WS_DFTL = 396 * MiB, WS_DFTC = 460 * MiB, WS_FOLD = WS_BIG + 204 * MiB;
constexpr size_t WS_P = WS_BIG, WS_Y1 = 413 * MiB, WS_END = 482 * MiB;
constexpr int RWN = 4352;
constexpr int LDS_BYTES = 147456;

struct Params { const float* in[28]; float* out; unsigned char* ws; };

__device__ __forceinline__ float wave_sum(float v) {
#pragma unroll
    for (int o = 1; o < 64; o <<= 1) v += __shfl_xor(v, o);
    return v;
}
__device__ __forceinline__ void tr_item(const float* W, int ldw, int N, bf16_t* WT, int ldt, LAS float* scr, int item, int lane) {
    const int nblk = N / 32, kb = item / nblk, nb = item % nblk, k0 = 64 * kb, n0 = 32 * nb;
    float v_[32];
#pragma unroll
    for (int i = 0; i < 32; ++i) v_[i] = W[(size_t)(k0 + 2 * i + (lane >> 5)) * ldw + n0 + (lane & 31)];
#pragma unroll
    for (int i = 0; i < 32; ++i) scr[(2 * i + (lane >> 5)) * 33 + (lane & 31)] = v_[i];
    asm volatile("s_waitcnt lgkmcnt(0)" ::: "memory");
    const int c = lane & 7;
#pragma unroll
    for (int j = 0; j < 4; ++j) { const int n = (lane >> 3) + 8 * j; const LAS float* s = scr + (8 * c) * 33 + n;
        u32x4 o; o.x = pkbf(s[0 * 33], s[1 * 33]); o.y = pkbf(s[2 * 33], s[3 * 33]); o.z = pkbf(s[4 * 33], s[5 * 33]); o.w = pkbf(s[6 * 33], s[7 * 33]);
        *(u32x4*)(WT + (size_t)(n0 + n) * ldt + k0 + 8 * c) = o; }
    asm volatile("s_waitcnt lgkmcnt(0)" ::: "memory");
}
__device__ __forceinline__ void prologue(const Params& p, LAS char* lds, int G, int bid) {
    const int tid = opaque_tid(), lane = tid & 63, wid = tid >> 6;
    unsigned char* ws = p.ws;
    {
        LAS float* scr = (LAS float*)(lds + wid * 8448);
        const int gw = bid * 8 + wid, NGW = G * 8;
        for (int it = gw; it < 8832; it += NGW) {
            int r = it;
            if (r < 2048) { tr_item(p.in[8], 4096, 4096, (bf16_t*)(ws + WS_WDAIN), 1024, scr, r, lane); continue; } r -= 2048;
            if (r < 2048) { tr_item(p.in[8] + (size_t)1024 * 4096, 4096, 4096, (bf16_t*)(ws + WS_WDAIN + 8 * MiB), 1024, scr, r, lane); continue; } r -= 2048;
            if (r < 512) { tr_item(p.in[12], 1024, 1024, (bf16_t*)(ws + WS_WDAOUT), 1024, scr, r, lane); continue; } r -= 512;
            if (r < 512) { tr_item(p.in[12] + (size_t)1024 * 1024, 1024, 1024, (bf16_t*)(ws + WS_WDAOUT + 2 * MiB), 1024, scr, r, lane); continue; } r -= 512;
            if (r < 512) { tr_item(p.in[13] + 1024, 2048, 1024, (bf16_t*)(ws + WS_WFNZ), 1024, scr, r, lane); continue; } r -= 512;
            if (r < 512) { tr_item(p.in[15], 1024, 1024, (bf16_t*)(ws + WS_WFNOUT), 1024, scr, r, lane); continue; } r -= 512;
            if (r < 2176) { tr_item(p.in[16], RWN, RWN, (bf16_t*)(ws + WS_WRWIN), 1024, scr, r, lane); continue; } r -= 2176;
            tr_item(p.in[27], 1024, 1024, (bf16_t*)(ws + WS_WRWOUT), 1024, scr, r, lane);
        }
    }
    __syncthreads();
    for (int it = bid; it < 256; it += G) {
        const int g = it >> 5, cs = (it >> 4) & 1, kq = it & 15;
        LAS float* Wcs = (LAS float*)lds; LAS float* win = (LAS float*)(lds + 65536); LAS float* tab = (LAS float*)(lds + 65536 + 33024);
        if (tid < 128) { float s, c; sincospif((float)tid / 64.f, &s, &c); tab[tid] = (cs ? s : c) * 0.08838834764831845f; }
        __syncthreads();
        {
            const int e0 = (tid & 31) * 4, cq = tid >> 5; f32x4 acc[8];
#pragma unroll
            for (int i = 0; i < 8; ++i) acc[i] = (f32x4){0.f, 0.f, 0.f, 0.f};
            const float* Wg = p.in[14] + (size_t)g * 128 * 128;
            for (int m = 0; m < 128; ++m) { const f32x4 wg = *(const f32x4*)(Wg + m * 128 + e0);
#pragma unroll
                for (int i = 0; i < 8; ++i) acc[i] += wg * tab[(m * (cq + 16 * i)) & 127]; }
#pragma unroll
            for (int i = 0; i < 8; ++i) *(LAS f32x4*)(Wcs + (cq + 16 * i) * 128 + e0) = acc[i];
        }
#pragma unroll
        for (int i = 0; i < 16; ++i) { const int idx = tid + 512 * i, kin = idx >> 7, c = idx & 127; win[kin * 129 + c] = p.in[13][(size_t)(kq * 64 + kin) * 2048 + g * 128 + c]; }
        __syncthreads();
        {
            const int kin = tid & 63, eg = tid >> 6; float acc[16];
#pragma unroll
            for (int i = 0; i < 16; ++i) acc[i] = 0.f;
            for (int c = 0; c < 128; ++c) { const float a = win[kin * 129 + c];
#pragma unroll
                for (int i = 0; i < 16; ++i) acc[i] += a * Wcs[c * 128 + eg * 16 + i]; }
            bf16_t* WT = (bf16_t*)(ws + WS_WFNT);
#pragma unroll
            for (int i = 0; i < 16; ++i) WT[(size_t)(cs * 1024 + g * 128 + eg * 16 + i) * 1024 + kq * 64 + kin] = (bf16_t)(pkbf(acc[i], 0.f) & 0xffffu);
        }
        __syncthreads();
    }
    {
        LAS float* tc = (LAS float*)lds; LAS float* ts = (LAS float*)(lds + 16384);
        for (int j = tid; j < 4096; j += 512) { float s, c; sincospif((float)j / 2048.f, &s, &c); tc[j] = c; ts[j] = -s; }
        __syncthreads();
        bf16_t* DL = (bf16_t*)(ws + WS_DFTL); bf16_t* DC = (bf16_t*)(ws + WS_DFTC);
        for (int k = bid; k < 2048; k += G) {
            const int j0 = (tid & 255) * 8; const bool sn = tid >= 256; float v8[8];
#pragma unroll
            for (int i = 0; i < 8; ++i) { const int idx = (k * (j0 + i)) & 4095; v8[i] = (sn ? -ts[idx] : tc[idx]) * 0.015625f; }
            u32x4 o; o.x = pkbf(v8[0], v8[1]); o.y = pkbf(v8[2], v8[3]); o.z = pkbf(v8[4], v8[5]); o.w = pkbf(v8[6], v8[7]);
            *(u32x4*)(DL + (sn ? (size_t)2048 * 2048 : (size_t)0) + (size_t)k * 2048 + j0) = o;
        }
        for (int k = bid; k < 256; k += G) {
            if (tid < 64) { const int cs = tid >> 5, l0 = (tid & 31) * 8; float v8[8];
#pragma unroll
                for (int i = 0; i < 8; ++i) { const int idx = ((k * (l0 + i)) & 255) * 16; v8[i] = (cs ? ts[idx] : tc[idx]) * 0.0625f; }
                u32x4 o; o.x = pkbf(v8[0], v8[1]); o.y = pkbf(v8[2], v8[3]); o.z = pkbf(v8[4], v8[5]); o.w = pkbf(v8[6], v8[7]);
                *(u32x4*)(DC + (size_t)k * 512 + cs * 256 + l0) = o; }
        }
        __syncthreads();
    }
    {
        LAS float* sc = (LAS float*)lds; LAS float* red = (LAS float*)(lds + 40960);
        bool have = false;
        for (int it = bid; it < 192; it += G) {
            if (!have) { for (int idx = tid; idx < 9216; idx += 512) { const int r = idx >> 10, k = idx & 1023; const float cv = r < 8 ? p.in[1][r * 1024 + k] : p.in[3][k]; sc[idx] = cv / (1.f + __expf(-cv)); } have = true; __syncthreads(); }
            const int i = it / 48, n = (it % 48) * 64 + (tid & 63), kq = tid >> 6;
            const float* w = p.in[5] + (size_t)i * 1024 * 3072 + n;
            float acc[9];
#pragma unroll
            for (int r = 0; r < 9; ++r) acc[r] = 0.f;
            for (int k = kq * 128; k < kq * 128 + 128; k += 4) { const float w0 = w[(size_t)k * 3072], w1 = w[(size_t)(k + 1) * 3072], w2 = w[(size_t)(k + 2) * 3072], w3 = w[(size_t)(k + 3) * 3072];
#pragma unroll
                for (int r = 0; r < 9; ++r) { const f32x4 s4 = *(const LAS f32x4*)(sc + r * 1024 + k); acc[r] += (s4[0] * w0 + s4[1] * w1) + (s4[2] * w2 + s4[3] * w3); } }
#pragma unroll
            for (int r = 0; r < 9; ++r) red[(kq * 9 + r) * 64 + (tid & 63)] = acc[r];
            __syncthreads();
            for (int idx = tid; idx < 576; idx += 512) { const int r = idx >> 6, col = idx & 63; float s = 0.f;
#pragma unroll
                for (int q = 0; q < 8; ++q) s += red[(q * 9 + r) * 64 + col];
                const int nn = (it % 48) * 64 + col;
                ((float*)(ws + WS_MOD))[(size_t)(i * 9 + r) * 3072 + nn] = s + p.in[6][i * 3072 + nn]; }
            __syncthreads();
        }
    }
    if (bid == 0) { for (int t = tid; t < 1024; t += 512) { const int pos = t >> 4, qd = t & 15; const float inv = powf(10000.f, -(float)qd / 16.f); const float ang = (float)pos * inv;
            ((float*)(ws + WS_ROPE))[t] = cosf(ang); ((float*)(ws + WS_ROPE))[1024 + t] = sinf(ang); } }
}
__device__ __forceinline__ void ph_phase(const float* xlat, const float* xctx, const float* gain, const float* mod, bf16_t* Hb, int G, int bid, int r0 = 0, int r1 = TT) {
    const int tid_ = opaque_tid(); const int lane = tid_ & 63, wid = tid_ >> 6;
    const int stride = G * 8;
    for (int row0 = r0 + bid * 8 + wid; row0 < r1; row0 += 2 * stride) {
        const int row1 = row0 + stride; const bool has1 = row1 < r1;
        const float* s0 = row0 < TL ? xlat + (size_t)row0 * 1024 : xctx + (size_t)(row0 - TL) * 1024;
        const float* s1 = !has1 ? s0 : (row1 < TL ? xlat + (size_t)row1 * 1024 : xctx + (size_t)(row1 - TL) * 1024);
        f32x4 v0[4], v1[4]; float q0 = 0.f, q1 = 0.f;
#pragma unroll
        for (int j = 0; j < 4; ++j) { v0[j] = *(const f32x4*)(s0 + 4 * lane + 256 * j); v1[j] = *(const f32x4*)(s1 + 4 * lane + 256 * j); }
#pragma unroll
        for (int j = 0; j < 4; ++j) { q0 += (v0[j].x * v0[j].x + v0[j].y * v0[j].y) + (v0[j].z * v0[j].z + v0[j].w * v0[j].w); q1 += (v1[j].x * v1[j].x + v1[j].y * v1[j].y) + (v1[j].z * v1[j].z + v1[j].w * v1[j].w); }
        const float r0 = rsqrtf(wave_sum(q0) * (1.f / 1024.f) + 1e-6f), r1 = rsqrtf(wave_sum(q1) * (1.f / 1024.f) + 1e-6f);
        const float* m0 = mod + (row0 < TL ? (row0 >> 12) : 8) * 3072; const float* m1 = mod + (row1 < TL ? (row1 >> 12) : 8) * 3072;
#pragma unroll
        for (int j = 0; j < 4; ++j) { const int col = 4 * lane + 256 * j; const f32x4 g4 = *(const f32x4*)(gain + col);
            { const f32x4 sh = *(const f32x4*)(m0 + col), sc = *(const f32x4*)(m0 + 1024 + col); const f32x4 y = v0[j] * r0 * g4 * (sc + 1.f) + sh; u32x2 o; o.x = pkbf(y.x, y.y); o.y = pkbf(y.z, y.w); *(u32x2*)(Hb + (size_t)row0 * 1024 + col) = o; }
            if (has1) { const f32x4 sh = *(const f32x4*)(m1 + col), sc = *(const f32x4*)(m1 + 1024 + col); const f32x4 y = v1[j] * r1 * g4 * (sc + 1.f) + sh; u32x2 o; o.x = pkbf(y.x, y.y); o.y = pkbf(y.z, y.w); *(u32x2*)(Hb + (size_t)row1 * 1024 + col) = o; } }
    }
}
__device__ __forceinline__ void final_phase(float* x, const float* gain, int G, int bid) {
    const int tid_ = opaque_tid(); const int lane = tid_ & 63, wid = tid_ >> 6;
    const int stride = G * 8;
    for (int row0 = bid * 8 + wid; row0 < TL; row0 += 2 * stride) {
        const int row1 = row0 + stride; const bool has1 = row1 < TL;
        float* s0 = x + (size_t)row0 * 1024; float* s1 = has1 ? x + (size_t)row1 * 1024 : s0;
        f32x4 v0[4], v1[4]; float q0 = 0.f, q1 = 0.f;
#pragma unroll
        for (int j = 0; j < 4; ++j) { v0[j] = *(const f32x4*)(s0 + 4 * lane + 256 * j); v1[j] = *(const f32x4*)(s1 + 4 * lane + 256 * j); }
#pragma unroll
        for (int j = 0; j < 4; ++j) { q0 += (v0[j].x * v0[j].x + v0[j].y * v0[j].y) + (v0[j].z * v0[j].z + v0[j].w * v0[j].w); q1 += (v1[j].x * v1[j].x + v1[j].y * v1[j].y) + (v1[j].z * v1[j].z + v1[j].w * v1[j].w); }
        const float r0 = rsqrtf(wave_sum(q0) * (1.f / 1024.f) + 1e-6f), r1 = rsqrtf(wave_sum(q1) * (1.f / 1024.f) + 1e-6f);
#pragma unroll
        for (int j = 0; j < 4; ++j) { const int col = 4 * lane + 256 * j; const f32x4 g4 = *(const f32x4*)(gain + col);
            *(f32x4*)(s0 + col) = v0[j] * r0 * g4;
            if (has1) *(f32x4*)(s1 + col) = v1[j] * r1 * g4; }
    }
}
__device__ __forceinline__ void fnet_fold(const bf16_t* ATL, bf16_t* E, bf16_t* O, float* TA, const bf16_t* Z, bf16_t* OG, int G, int bid) {
    const int tid_ = opaque_tid(); const int lane = tid_ & 63, wid = tid_ >> 6;
    for (int row = bid * 8 + wid; row < 8192; row += G * 8) {
        const bf16_t* a1 = ATL + (size_t)row * 8192; const bf16_t* a2 = a1 + 4096; bf16_t* e = E + (size_t)row * 2048; bf16_t* od = O + (size_t)row * 2048;
        float alt = 0.f;
#pragma unroll 2
        for (int it = 0; it < 4; ++it) {
            const int j0 = (it * 64 + lane) * 8;
            const u32x4 x = *(const u32x4*)(a1 + j0), y = *(const u32x4*)(a2 + j0);
            const int mb = 4096 - j0 - 8;
            const u32x4 xm = *(const u32x4*)(a1 + mb), ym = *(const u32x4*)(a2 + mb);
            const unsigned short xe = (j0 == 0) ? (unsigned short)0 : a1[4096 - j0], ye = (j0 == 0) ? (unsigned short)0 : a2[4096 - j0];
            float fa[8], fs[8], ma[8], ms[8];
#pragma unroll
            for (int i = 0; i < 4; ++i) { fa[2 * i] = bflo(x[i]); fa[2 * i + 1] = bfhi(x[i]); fs[2 * i] = bflo(y[i]); fs[2 * i + 1] = bfhi(y[i]);
                ma[2 * i] = bflo(xm[i]); ma[2 * i + 1] = bfhi(xm[i]); ms[2 * i] = bflo(ym[i]); ms[2 * i + 1] = bfhi(ym[i]); }
            float oc[8], os[8];
            oc[0] = fa[0] + bf1(xe); os[0] = fs[0] - bf1(ye);
#pragma unroll
            for (int i = 1; i < 8; ++i) { oc[i] = fa[i] + ma[8 - i]; os[i] = fs[i] - ms[8 - i]; }
            if (j0 == 0) { oc[0] = fa[0]; os[0] = 0.f; }
            u32x4 o; o.x = pkbf(oc[0], oc[1]); o.y = pkbf(oc[2], oc[3]); o.z = pkbf(oc[4], oc[5]); o.w = pkbf(oc[6], oc[7]);
            *(u32x4*)(e + j0) = o;
            alt += (bflo(o.x) - bfhi(o.x)) + (bflo(o.y) - bfhi(o.y)) + (bflo(o.z) - bfhi(o.z)) + (bflo(o.w) - bfhi(o.w));
            o.x = pkbf(os[0], os[1]); o.y = pkbf(os[2], os[3]); o.z = pkbf(os[4], os[5]); o.w = pkbf(os[6], os[7]);
            *(u32x4*)(od + j0) = o;
        }
        alt = wave_sum(alt);
        if (lane == 0) { const float amid = bf1(a1[2048]); TA[row] = amid * 0.015625f;
            const int b = row >> 10, n = row & 1023; const size_t off = (size_t)(b * 4096 + 2048) * 1024 + n;
            const float yv = (alt + amid) * 0.015625f * silu_f(bf1(Z[off]));
            OG[off] = (bf16_t)(pkbf(yv, 0.f) & 0xffffu); }
    }
}
__device__ __forceinline__ void sh8(const bf16_t* P, size_t row, int co, bool hm, bool hp, const float* mu, float* out) {
    const u32x4 z4 = {0u, 0u, 0u, 0u};
    const u32x4 c0 = *(const u32x4*)(P + row * RWN + co);
    const u32x4 cm = hm ? *(const u32x4*)(P + (row - 1) * RWN + co) : z4;
    const u32x4 cp = hp ? *(const u32x4*)(P + (row + 1) * RWN + co) : z4;
    const f32x4 m0 = *(const f32x4*)(mu + co), m1 = *(const f32x4*)(mu + co + 4);
#pragma unroll
    for (int i = 0; i < 4; ++i) {
        const float a0 = bflo(c0[i]), a1 = bfhi(c0[i]);
        const float n0 = 0.5f * (bflo(cm[i]) + bflo(cp[i])), n1 = 0.5f * (bfhi(cm[i]) + bfhi(cp[i]));
        const float mu0 = (2 * i < 4) ? m0[(2 * i) & 3] : m1[(2 * i) & 3], mu1 = (2 * i + 1 < 4) ? m0[(2 * i + 1) & 3] : m1[(2 * i + 1) & 3];
        out[2 * i] = a0 + mu0 * (n0 - a0); out[2 * i + 1] = a1 + mu1 * (n1 - a1);
    }
}
template <int CTRL> __device__ __forceinline__ float dpp_f(float v) { return __int_as_float(__builtin_amdgcn_update_dpp(0, __float_as_int(v), CTRL, 0xf, 0xf, true)); }
__device__ __forceinline__ float sum8(float v) { v += dpp_f<0xB1>(v); v += dpp_f<0x4E>(v); v += dpp_f<0x141>(v); return v; }
__device__ __forceinline__ float fast_tanh(float x) { const float e = __expf(2.f * x); return 1.f - 2.f * __builtin_amdgcn_rcpf(e + 1.f); }
__device__ __forceinline__ float fast_sigmoid(float x) { return __builtin_amdgcn_rcpf(1.f + __expf(-x)); }
struct RwArgs { const bf16_t* P; bf16_t* Y0; bf16_t* Y1; float* BZ; const float *mu, *w0, *w_up, *a0, *a_up, *k_k, *k_a, *r_k; };
struct Raw3 { u32x4 c0, cm, cp; };
__device__ __forceinline__ Raw3 ld3(const bf16_t* P, size_t row, int co, bool hm, bool hp) {
    const u32x4 z4 = {0u, 0u, 0u, 0u}; Raw3 r;
    r.c0 = *(const u32x4*)(P + row * RWN + co);
    r.cm = hm ? *(const u32x4*)(P + (row - 1) * RWN + co) : z4;
    r.cp = hp ? *(const u32x4*)(P + (row + 1) * RWN + co) : z4;
    return r;
}
__device__ __forceinline__ void shift8(const Raw3& R, const float* mu, int co, float* out) {
    const f32x4 m0 = *(const f32x4*)(mu + co), m1 = *(const f32x4*)(mu + co + 4);
#pragma unroll
    for (int i = 0; i < 4; ++i) {
        const float a0 = bflo(R.c0[i]), a1 = bfhi(R.c0[i]);
        const float n0 = 0.5f * (bflo(R.cm[i]) + bflo(R.cp[i])), n1 = 0.5f * (bfhi(R.cm[i]) + bfhi(R.cp[i]));
        const float mu0 = (2 * i < 4) ? m0[(2 * i) & 3] : m1[(2 * i) & 3], mu1 = (2 * i + 1 < 4) ? m0[(2 * i + 1) & 3] : m1[(2 * i + 1) & 3];
        out[2 * i] = a0 + mu0 * (n0 - a0); out[2 * i + 1] = a1 + mu1 * (n1 - a1);
    }
}
__device__ __forceinline__ void shift8l(const Raw3& R, const LAS float* mu, float* out) {
    const f32x4 m0 = *(const LAS f32x4*)(mu), m1 = *(const LAS f32x4*)(mu + 4);
    const float mm[8] = {m0[0], m0[1], m0[2], m0[3], m1[0], m1[1], m1[2], m1[3]};
#pragma unroll
    for (int i = 0; i < 4; ++i) {
        const float a0 = bflo(R.c0[i]), a1 = bfhi(R.c0[i]);
        const float n0 = 0.5f * (bflo(R.cm[i]) + bflo(R.cp[i])), n1 = 0.5f * (bfhi(R.cm[i]) + bfhi(R.cp[i]));
        out[2 * i] = a0 + mm[2 * i] * (n0 - a0); out[2 * i + 1] = a1 + mm[2 * i + 1] * (n1 - a1);
    }
}
__device__ __forceinline__ void shift8r(const Raw3& R, const float* mu, float* out) {
#pragma unroll
    for (int i = 0; i < 4; ++i) {
        const float a0 = bflo(R.c0[i]), a1 = bfhi(R.c0[i]);
        const float n0 = 0.5f * (bflo(R.cm[i]) + bflo(R.cp[i])), n1 = 0.5f * (bfhi(R.cm[i]) + bfhi(R.cp[i]));
        out[2 * i] = a0 + mu[2 * i] * (n0 - a0); out[2 * i + 1] = a1 + mu[2 * i + 1] * (n1 - a1);
    }
}
__device__ __forceinline__ void rwkv_scan(const RwArgs& A, LAS char* lds, int G, int bid) {
    typedef short bfx8 __attribute__((ext_vector_type(8)));
    const int tid = opaque_tid(), lane = tid & 63; const int q = __builtin_amdgcn_readfirstlane(tid >> 6);
    LAS float* sW = (LAS float*)lds; LAS float* sA = sW + 4096; LAS float* sB = sA + 4096; LAS float* sKD = sB + 4096; LAS float* sR = sKD + 4096; LAS float* sV = sR + 4096;
    LAS bf16_t* WUPt = (LAS bf16_t*)(sV + 4096); LAS bf16_t* AUPt = WUPt + 64 * 72;
    LAS bf16_t* T1 = (LAS bf16_t*)sW; LAS bf16_t* T2 = (LAS bf16_t*)sKD;
    const int s = tid >> 3, dg = tid & 7, d0 = dg * 8;
#pragma unroll 1
    for (int chain = bid; chain < 256; chain += G) {
        const int z = chain >> 7, b = (chain >> 4) & 7, hh = chain & 15;
        __syncthreads();
        for (int idx = tid; idx < 4096; idx += 512) { const int r = idx >> 6, d = idx & 63;
            WUPt[d * 72 + r] = (bf16_t)(pkbf(A.w_up[(size_t)(z * 64 + r) * 1024 + hh * 64 + d], 0.f) & 0xffffu);
            AUPt[d * 72 + r] = (bf16_t)(pkbf(A.a_up[(size_t)(z * 64 + r) * 1024 + hh * 64 + d], 0.f) & 0xffffu); }
        f32x2_t S2[4];
#pragma unroll
        for (int j = 0; j < 4; ++j) S2[j] = (f32x2_t){0.f, 0.f};
        bf16_t* Yz = z ? A.Y1 : A.Y0;
        const int c_r = hh * 64 + d0, c_k = 1024 + hh * 64 + d0, c_v = 2048 + hh * 64 + d0, c_wd = 3072 + z * 64 + d0, c_ad = 3200 + z * 64 + d0;
#define RW_ROWOF(c, rowv, hmv, hpv) do { const int sidx_ = (c) * 64 + s; int L_, n_, rb_; \
            if ((c) < 4) { L_ = 256; n_ = z ? (255 - sidx_) : sidx_; rb_ = TL + b * 256; } else { L_ = 4096; const int sl_ = sidx_ - 256; n_ = z ? (4095 - sl_) : sl_; rb_ = b * 4096; } \
            rowv = (size_t)(rb_ + n_); hmv = n_ > 0; hpv = n_ < L_ - 1; } while (0)
        size_t row; bool hm, hp;
        RW_ROWOF(0, row, hm, hp);
        Raw3 Rr = ld3(A.P, row, c_r, hm, hp), Rk = ld3(A.P, row, c_k, hm, hp), Rv = ld3(A.P, row, c_v, hm, hp), Rw = ld3(A.P, row, c_wd, hm, hp), Ra = ld3(A.P, row, c_ad, hm, hp);
#pragma unroll 1
        for (int c = 0; c < 68; ++c) {
            asm volatile("" ::: "memory");
            const size_t crow_ = row;
            {
                float r8[8], k8[8], v8[8], t8[8];
                shift8(Rr, A.mu, c_r, r8); shift8(Rk, A.mu, c_k, k8); shift8(Rv, A.mu, c_v, v8);
                *(LAS f32x4*)(sR + s * 64 + d0) = (f32x4){r8[0], r8[1], r8[2], r8[3]}; *(LAS f32x4*)(sR + s * 64 + d0 + 4) = (f32x4){r8[4], r8[5], r8[6], r8[7]};
                *(LAS f32x4*)(sV + s * 64 + d0) = (f32x4){v8[0], v8[1], v8[2], v8[3]}; *(LAS f32x4*)(sV + s * 64 + d0 + 4) = (f32x4){v8[4], v8[5], v8[6], v8[7]};
                *(LAS f32x4*)(sB + s * 64 + d0) = (f32x4){k8[0], k8[1], k8[2], k8[3]}; *(LAS f32x4*)(sB + s * 64 + d0 + 4) = (f32x4){k8[4], k8[5], k8[6], k8[7]};
                float kkr[8], ssq = 0.f;
                const f32x4 kk0 = *(const f32x4*)(A.k_k + hh * 64 + d0), kk1 = *(const f32x4*)(A.k_k + hh * 64 + d0 + 4);
#pragma unroll
                for (int i = 0; i < 8; ++i) { kkr[i] = k8[i] * (i < 4 ? kk0[i & 3] : kk1[i & 3]); ssq += kkr[i] * kkr[i]; }
                ssq = sum8(ssq);
                const float rs = -rsqrtf(ssq + 1e-12f);
                *(LAS f32x4*)(sA + s * 64 + d0) = (f32x4){kkr[0] * rs, kkr[1] * rs, kkr[2] * rs, kkr[3] * rs}; *(LAS f32x4*)(sA + s * 64 + d0 + 4) = (f32x4){kkr[4] * rs, kkr[5] * rs, kkr[6] * rs, kkr[7] * rs};
                shift8(Rw, A.mu, c_wd, t8);
                { u32x4 o; o.x = pkbf(fast_tanh(t8[0]), fast_tanh(t8[1])); o.y = pkbf(fast_tanh(t8[2]), fast_tanh(t8[3])); o.z = pkbf(fast_tanh(t8[4]), fast_tanh(t8[5])); o.w = pkbf(fast_tanh(t8[6]), fast_tanh(t8[7]));
                  *(LAS u32x4*)(T1 + s * 72 + d0) = o; }
                shift8(Ra, A.mu, c_ad, t8);
                { u32x4 o; o.x = pkbf(t8[0], t8[1]); o.y = pkbf(t8[2], t8[3]); o.z = pkbf(t8[4], t8[5]); o.w = pkbf(t8[6], t8[7]);
                  *(LAS u32x4*)(T2 + s * 72 + d0) = o; }
            }
            if (c + 1 < 68) { RW_ROWOF(c + 1, row, hm, hp);
                Rr = ld3(A.P, row, c_r, hm, hp); Rk = ld3(A.P, row, c_k, hm, hp); Rv = ld3(A.P, row, c_v, hm, hp); Rw = ld3(A.P, row, c_wd, hm, hp); Ra = ld3(A.P, row, c_ad, hm, hp); }
            __syncthreads();
            const int mt = q & 3, nh = q >> 2, fr = lane & 15, fq = lane >> 4;
            f32x4 accw[2], acca[2];
            {
                bfx8 aw[2], aa[2];
#pragma unroll
                for (int kk = 0; kk < 2; ++kk) { aw[kk] = *(const LAS bfx8*)(T1 + (16 * mt + fr) * 72 + kk * 32 + fq * 8); aa[kk] = *(const LAS bfx8*)(T2 + (16 * mt + fr) * 72 + kk * 32 + fq * 8); }
#pragma unroll
                for (int nt = 0; nt < 2; ++nt) { accw[nt] = (f32x4){0.f, 0.f, 0.f, 0.f}; acca[nt] = (f32x4){0.f, 0.f, 0.f, 0.f};
#pragma unroll
                    for (int kk = 0; kk < 2; ++kk) {
                        const bfx8 bw = *(const LAS bfx8*)(WUPt + (32 * nh + 16 * nt + fr) * 72 + kk * 32 + fq * 8), ba = *(const LAS bfx8*)(AUPt + (32 * nh + 16 * nt + fr) * 72 + kk * 32 + fq * 8);
                        accw[nt] = __builtin_amdgcn_mfma_f32_16x16x32_bf16(aw[kk], bw, accw[nt], 0, 0, 0);
                        acca[nt] = __builtin_amdgcn_mfma_f32_16x16x32_bf16(aa[kk], ba, acca[nt], 0, 0, 0); } }
            }
            __syncthreads();
#pragma unroll
            for (int nt = 0; nt < 2; ++nt) { const int d = 32 * nh + 16 * nt + fr, dcol = hh * 64 + d;
                const float w0d = A.w0[z * 1024 + dcol], a0d = A.a0[z * 1024 + dcol], kad = A.k_a[dcol];
#pragma unroll
                for (int j = 0; j < 4; ++j) { const int idx = (16 * mt + 4 * fq + j) * 64 + d;
                    const float x = -(w0d + accw[nt][j]);
                    const float sp = fmaxf(x, 0.f) + __logf(1.f + __expf(-fabsf(x)));
                    const float w = __expf(-__expf(-sp - 0.5f));
                    const float asig = fast_sigmoid(a0d + acca[nt][j]);
                    const float nkk = sA[idx], kraw = sB[idx];
                    sW[idx] = w; sB[idx] = -nkk * asig; sKD[idx] = kraw * (1.f + (asig - 1.f) * kad); } }
            __syncthreads();
            {
                const f32x4 ra = *(const LAS f32x4*)(sR + s * 64 + d0), rb = *(const LAS f32x4*)(sR + s * 64 + d0 + 4), ka = *(const LAS f32x4*)(sKD + s * 64 + d0), kb = *(const LAS f32x4*)(sKD + s * 64 + d0 + 4);
                const f32x4 q0 = *(const f32x4*)(A.r_k + hh * 64 + d0), q1 = *(const f32x4*)(A.r_k + hh * 64 + d0 + 4);
                float bz = 0.f;
#pragma unroll
                for (int i = 0; i < 4; ++i) { bz += ra[i] * ka[i] * q0[i]; bz += rb[i] * kb[i] * q1[i]; }
                bz = sum8(bz);
                if (dg == 0) A.BZ[((size_t)z * TT + crow_) * 16 + hh] = bz;
            }
            {
                const int rl = lane >> 3, cg = lane & 7, irow = 8 * q + rl;
                const LAS float* bw = sW + 8 * cg; const LAS float* ba_ = sA + 8 * cg; const LAS float* bb_ = sB + 8 * cg; const LAS float* bk = sKD + 8 * cg; const LAS float* br = sR + 8 * cg;
                LAS float* bv = sV + irow;
                f32x4 w0 = *(const LAS f32x4*)(bw), w1 = *(const LAS f32x4*)(bw + 4), a0 = *(const LAS f32x4*)(ba_), a1 = *(const LAS f32x4*)(ba_ + 4);
                f32x4 b0 = *(const LAS f32x4*)(bb_), b1 = *(const LAS f32x4*)(bb_ + 4), k0 = *(const LAS f32x4*)(bk), k1 = *(const LAS f32x4*)(bk + 4);
                f32x4 r0 = *(const LAS f32x4*)(br), r1 = *(const LAS f32x4*)(br + 4); float vi = bv[0];
#pragma unroll 4
                for (int st = 0; st < 64; ++st) {
                    const int on = ((st + 1) & 63) * 64;
                    const f32x4 nw0 = *(const LAS f32x4*)(bw + on), nw1 = *(const LAS f32x4*)(bw + on + 4), na0 = *(const LAS f32x4*)(ba_ + on), na1 = *(const LAS f32x4*)(ba_ + on + 4);
                    const f32x4 nb0 = *(const LAS f32x4*)(bb_ + on), nb1 = *(const LAS f32x4*)(bb_ + on + 4), nk0 = *(const LAS f32x4*)(bk + on), nk1 = *(const LAS f32x4*)(bk + on + 4);
                    const f32x4 nr0 = *(const LAS f32x4*)(br + on), nr1 = *(const LAS f32x4*)(br + on + 4); const float nvi = bv[on];
                    f32x2_t pp2 = S2[0] * (f32x2_t){a0[0], a0[1]};
                    pp2 = S2[1] * (f32x2_t){a0[2], a0[3]} + pp2; pp2 = S2[2] * (f32x2_t){a1[0], a1[1]} + pp2; pp2 = S2[3] * (f32x2_t){a1[2], a1[3]} + pp2;
                    const float sa = sum8(pp2.x + pp2.y);
                    const f32x2_t sa2 = {sa, sa}, v2 = {vi, vi};
                    S2[0] = S2[0] * (f32x2_t){w0[0], w0[1]} + sa2 * (f32x2_t){b0[0], b0[1]} + v2 * (f32x2_t){k0[0], k0[1]};
                    S2[1] = S2[1] * (f32x2_t){w0[2], w0[3]} + sa2 * (f32x2_t){b0[2], b0[3]} + v2 * (f32x2_t){k0[2], k0[3]};
                    S2[2] = S2[2] * (f32x2_t){w1[0], w1[1]} + sa2 * (f32x2_t){b1[0], b1[1]} + v2 * (f32x2_t){k1[0], k1[1]};
                    S2[3] = S2[3] * (f32x2_t){w1[2], w1[3]} + sa2 * (f32x2_t){b1[2], b1[3]} + v2 * (f32x2_t){k1[2], k1[3]};
                    f32x2_t y2 = S2[0] * (f32x2_t){r0[0], r0[1]};
                    y2 = S2[1] * (f32x2_t){r0[2], r0[3]} + y2; y2 = S2[2] * (f32x2_t){r1[0], r1[1]} + y2; y2 = S2[3] * (f32x2_t){r1[2], r1[3]} + y2;
                    const float yv = sum8(y2.x + y2.y);
                    if (cg == 0) bv[st * 64] = yv;
                    w0 = nw0; w1 = nw1; a0 = na0; a1 = na1; b0 = nb0; b1 = nb1; k0 = nk0; k1 = nk1; r0 = nr0; r1 = nr1; vi = nvi;
                }
            }
            __syncthreads();
            { u32x4 o; const LAS float* yr = sV + s * 64 + d0;
              o.x = pkbf(yr[0], yr[1]); o.y = pkbf(yr[2], yr[3]); o.z = pkbf(yr[4], yr[5]); o.w = pkbf(yr[6], yr[7]);
              *(u32x4*)(Yz + crow_ * 1024 + hh * 64 + d0) = o; }
            __syncthreads();
        }
#undef RW_ROWOF
    }
}
__device__ __forceinline__ void rwkv_out(const RwArgs& A, const float* ln_w, const float* ln_b, bf16_t* OG, int G, int bid) {
    const int tid_ = opaque_tid(); const int lane = tid_ & 63, wid = tid_ >> 6; const int c0 = lane * 16, head = lane >> 2;
    float lw[16], lb[16], muv[16];
#pragma unroll
    for (int i = 0; i < 16; ++i) { lw[i] = ln_w[c0 + i]; lb[i] = ln_b[c0 + i]; muv[i] = A.mu[2048 + c0 + i]; }
    for (int row = bid * 8 + wid; row < TT; row += G * 8) {
        const bool lat = row < TL; const int L = lat ? 4096 : 256; const int n = lat ? (row & 4095) : ((row - TL) & 255); const bool hm = n > 0, hp = n < L - 1;
        const u32x4 a0 = *(const u32x4*)(A.Y0 + (size_t)row * 1024 + c0), a1 = *(const u32x4*)(A.Y0 + (size_t)row * 1024 + c0 + 8);
        const u32x4 b0 = *(const u32x4*)(A.Y1 + (size_t)row * 1024 + c0), b1 = *(const u32x4*)(A.Y1 + (size_t)row * 1024 + c0 + 8);
        const Raw3 v0 = ld3(A.P, (size_t)row, 2048 + c0, hm, hp), v1 = ld3(A.P, (size_t)row, 2048 + c0 + 8, hm, hp);
        const u32x4 z0 = *(const u32x4*)(A.P + (size_t)row * RWN + 3328 + c0), z1 = *(const u32x4*)(A.P + (size_t)row * RWN + 3328 + c0 + 8);
        const float bz = 0.5f * (A.BZ[(size_t)row * 16 + head] + A.BZ[((size_t)TT + row) * 16 + head]);
        float y[16], vv[16];
#pragma unroll
        for (int i = 0; i < 4; ++i) { y[2 * i] = bflo(a0[i]) + bflo(b0[i]); y[2 * i + 1] = bfhi(a0[i]) + bfhi(b0[i]); y[8 + 2 * i] = bflo(a1[i]) + bflo(b1[i]); y[8 + 2 * i + 1] = bfhi(a1[i]) + bfhi(b1[i]); }
        float s1 = 0.f;
#pragma unroll
        for (int i = 0; i < 16; ++i) s1 += y[i];
        s1 += __shfl_xor(s1, 1); s1 += __shfl_xor(s1, 2); const float mean = s1 * (1.f / 64.f);
        float s2 = 0.f;
#pragma unroll
        for (int i = 0; i < 16; ++i) { y[i] -= mean; s2 += y[i] * y[i]; }
        s2 += __shfl_xor(s2, 1); s2 += __shfl_xor(s2, 2); const float rstd = rsqrtf(s2 * (1.f / 64.f) + 64e-5f);
        shift8r(v0, muv, vv); shift8r(v1, muv + 8, vv + 8);
        float ov[16];
#pragma unroll
        for (int i = 0; i < 16; ++i) { const unsigned zw = (i < 8) ? z0[(i >> 1) & 3] : z1[(i >> 1) & 3]; const float zz = (i & 1) ? bfhi(zw) : bflo(zw);
            ov[i] = (y[i] * rstd * lw[i] + lb[i] + bz * vv[i]) * silu_f(zz); }
        u32x4 o0, o1; o0.x = pkbf(ov[0], ov[1]); o0.y = pkbf(ov[2], ov[3]); o0.z = pkbf(ov[4], ov[5]); o0.w = pkbf(ov[6], ov[7]);
        o1.x = pkbf(ov[8], ov[9]); o1.y = pkbf(ov[10], ov[11]); o1.z = pkbf(ov[12], ov[13]); o1.w = pkbf(ov[14], ov[15]);
        *(u32x4*)(OG + (size_t)row * 1024 + c0) = o0; *(u32x4*)(OG + (size_t)row * 1024 + c0 + 8) = o1;
    }
}
#ifdef SKIP_GEMM
#define GEMM_PHASE(EPI, AP, BP, MM, NN, KK, EOBJ) do { (void)EOBJ; } while (0)
#else
#ifndef STAGGER_TICKS
#define STAGGER_TICKS 1500
#endif
__device__ __forceinline__ void stagger_wait(int bid, int units_per_cu_x2) {
    if ((bid & 1) && units_per_cu_x2 >= 4) { const unsigned long long t0 = __builtin_amdgcn_s_memrealtime(); while (__builtin_amdgcn_s_memrealtime() - t0 < (unsigned long long)STAGGER_TICKS) __builtin_amdgcn_s_sleep(32); }
}
#define GEMM_PHASE(EPI, AP, BP, MM, NN, KK, EOBJ) do { pg8::Gemm g_{(const bf16_t*)(AP), (const bf16_t*)(BP), (MM), (NN), (KK)}; pg8::StaticOrder S_; S_.init((MM), (NN), G, bid); \
    pg8::gemm_phase<EPI, pg8::StaticOrder, true, true>((PG8_LAS unsigned char*)lds, g_, S_, EOBJ); } while (0)
#endif
#ifdef SKIP_EpiAttnIn
#define GEMM_PHASE_EpiAttnIn(EPI, AP, BP, MM, NN, KK, EOBJ) do { (void)EOBJ; } while (0)
#else
#define GEMM_PHASE_EpiAttnIn GEMM_PHASE
#endif
#ifdef SKIP_EpiFnT
#define GEMM_PHASE_EpiFnT(EPI, AP, BP, MM, NN, KK, EOBJ) do { (void)EOBJ; } while (0)
#else
#define GEMM_PHASE_EpiFnT GEMM_PHASE
#endif
#ifdef SKIP_EpiPlain
#define GEMM_PHASE_EpiPlain(EPI, AP, BP, MM, NN, KK, EOBJ) do { (void)EOBJ; } while (0)
#else
#define GEMM_PHASE_EpiPlain GEMM_PHASE
#endif
#ifdef SKIP_EpiDft
#define GEMM_PHASE_EpiDft(EPI, AP, BP, MM, NN, KK, EOBJ) do { (void)EOBJ; } while (0)
#else
#define GEMM_PHASE_EpiDft GEMM_PHASE
#endif
#ifdef SKIP_EpiResid
#define GEMM_PHASE_EpiResid(EPI, AP, BP, MM, NN, KK, EOBJ) do { (void)EOBJ; } while (0)
#else
#define GEMM_PHASE_EpiResid GEMM_PHASE
#endif
#define XB_TMO      128
#define XB_XCNT(j)  (256  + 64 * (j))
#define XB_XSUB(j)  (1280 + 64 * (j))
#define XB_XGEN(j)  (2304 + 64 * (j))
#define XB_TOP      3328
#define XB_TOPGEN   3392
#define XCD_BAR_WORDS 3456
#define XB_SPIN_CAP (1u << 18)

__device__ __forceinline__ unsigned xb_ld(unsigned* p)              { return __hip_atomic_load(p, __ATOMIC_RELAXED, __HIP_MEMORY_SCOPE_AGENT); }
__device__ __forceinline__ unsigned xb_add(unsigned* p, unsigned v) { return __hip_atomic_fetch_add(p, v, __ATOMIC_RELAXED, __HIP_MEMORY_SCOPE_AGENT); }
__device__ __forceinline__ unsigned xb_xcc_id() { return (unsigned)__builtin_amdgcn_s_getreg((3 << 11) | 20) & 0xFu; }
#define XB_SPIN(cond, bar) do { unsigned _sp = 0; while (cond) { __builtin_amdgcn_s_sleep(1); \
    if ((++_sp & 255u) == 0u) { if (xb_ld(&(bar)[XB_TMO])) break; if (_sp > XB_SPIN_CAP) { atomicAdd(&(bar)[XB_TMO], 1u); break; } } } } while (0)

struct XcdBarrier {
    unsigned* bar; unsigned x;
    volatile LAS unsigned* st;
};

__device__ __forceinline__ XcdBarrier xcd_barrier_post(unsigned* bar, volatile LAS unsigned* st) {
    XcdBarrier b; b.bar = bar; b.x = xb_xcc_id(); b.st = st;
    if (threadIdx.x == 0) (void)xb_add(&bar[XB_XCNT(b.x)], 1u);
    return b;
}
__device__ __forceinline__ void xcd_barrier_complete(unsigned* bar, unsigned x, unsigned& nloc, unsigned& nx) {
    const unsigned G = gridDim.x * gridDim.y * gridDim.z;
    unsigned sum, cnt, mine, sp = 0u;
    for (;;) {
        sum = 0u; cnt = 0u; mine = 0u;
#pragma unroll
        for (unsigned j = 0; j < 16; ++j) { const unsigned c = xb_ld(&bar[XB_XCNT(j)]); sum += c; cnt += (c > 0u) ? 1u : 0u; mine = (j == x) ? c : mine; }
        if (sum == G) break;
        __builtin_amdgcn_s_sleep(1);
        if ((++sp & 255u) == 0u) { if (xb_ld(&bar[XB_TMO])) break; if (sp > XB_SPIN_CAP) { atomicAdd(&bar[XB_TMO], 1u); break; } }
    }
    nloc = mine > 0u ? mine : 1u; nx = cnt > 0u ? cnt : 1u;
}

__device__ __forceinline__ void xcd_barrier(const XcdBarrier& b) {
    asm volatile("s_waitcnt vmcnt(0)" ::: "memory");
    __syncthreads();
    if (threadIdx.x == 0) {
        unsigned* bar = b.bar;
        __builtin_amdgcn_s_waitcnt(0);
        unsigned nloc = b.st[0], nx = b.st[1];
        if (nloc == 0u) { xcd_barrier_complete(bar, b.x, nloc, nx); b.st[0] = nloc; b.st[1] = nx; }
        const unsigned old = xb_add(&bar[XB_XSUB(b.x)], 1u);
        const unsigned gen = old / nloc;
        if (old + 1u == (gen + 1u) * nloc) {
            __builtin_amdgcn_fence(__ATOMIC_RELEASE, "agent");
            asm volatile("s_waitcnt vmcnt(0)" ::: "memory");
            const unsigned og = xb_add(&bar[XB_TOP], 1u);
            const unsigned tg = og / nx;
            if (og + 1u == (tg + 1u) * nx) xb_add(&bar[XB_TOPGEN], 1u);
            else XB_SPIN(xb_ld(&bar[XB_TOPGEN]) == tg, bar);
            __builtin_amdgcn_fence(__ATOMIC_ACQUIRE, "agent");
            xb_add(&bar[XB_XGEN(b.x)], 1u);
            asm volatile("s_waitcnt vmcnt(0)" ::: "memory");
        } else {
            XB_SPIN(xb_ld(&bar[XB_XGEN(b.x)]) == gen, bar);
            __builtin_amdgcn_fence(__ATOMIC_ACQUIRE, "agent");
            asm volatile("s_waitcnt vmcnt(0)" ::: "memory");
        }
    }
    __syncthreads();
}

#define GRID_SYNC() xcd_barrier(xbar)
template <int layer> __device__ __forceinline__ void layer_body(const Params& p, LAS char* lds, const XcdBarrier& xbar, int G, int bid) {
    unsigned char* ws = p.ws;
    float* mod = (float*)(ws + WS_MOD);
    const float* ropeC = (const float*)(ws + WS_ROPE); const float* ropeS = ropeC + 1024;
    bf16_t* Hb = (bf16_t*)(ws + WS_HB);
    float* XC = (float*)(ws + WS_XC);
    const float* x_in = p.in[0]; const float* ctx_in = p.in[2];
        const float* xl = layer == 0 ? x_in : p.out; const float* xc = layer == 0 ? ctx_in : XC;
        const float* modl = mod + (size_t)layer * 9 * 3072;
        if constexpr (layer == 0) {
            ph_phase(xl, xc, p.in[4] + layer * 1024, modl, Hb, G, bid);
            GRID_SYNC();
        }
        const int Mout = (layer == 3) ? TL : TT;
        const bf16_t* Wout;
        if constexpr (layer == 0 || layer == 3) {
            const int j = layer == 0 ? 0 : 1;
            LAS float* ropeL = (LAS float*)(lds + 131072);
            for (int t_ = opaque_tid(); t_ < 2048; t_ += 512) ropeL[t_] = ropeC[t_];
            __syncthreads();
            pg8::EpiAttnIn E{(bf16_t*)(ws + WS_Q), (bf16_t*)(ws + WS_K), (bf16_t*)(ws + WS_V), (bf16_t*)(ws + WS_Z), (const PG8_LAS float*)ropeL, (const PG8_LAS float*)ropeL + 1024};
            GEMM_PHASE_EpiAttnIn(pg8::EpiAttnIn, Hb, ws + WS_WDAIN + (size_t)j * 8 * MiB, TT, 4096, 1024, E);
#ifdef PROBE_GIN2
            GEMM_PHASE_EpiAttnIn(pg8::EpiAttnIn, Hb, ws + WS_WDAIN + (size_t)j * 8 * MiB, TT, 4096, 1024, E);
#endif
            GRID_SYNC();
            float lam;
            { const int lane = opaque_tid() & 63; const float* lq = p.in[9] + j * 128; const float* lk = p.in[10] + j * 128;
              const float s0 = wave_sum(lq[lane] * lk[lane]), s1 = wave_sum(lq[64 + lane] * lk[64 + lane]);
              const float li = 0.8f - 0.6f * expf(-0.3f * (float)layer); lam = expf(s0) - expf(s1) + li;
              att::Args A{(const bf16_t*)(ws + WS_Q), (const bf16_t*)(ws + WS_K), (const bf16_t*)(ws + WS_V), (const bf16_t*)(ws + WS_Z), Hb, p.in[11] + j * 128, lam, 1.f - li, layer == 3 ? 1024 : 1088, (unsigned*)(ws + WS_Y1) + (size_t)bid * 8 * 2048};
#ifndef SKIP_ATT
              att::attn_phase(A, lds, G, bid);
#endif
#ifdef PROBE_ATT2
              att::attn_phase(A, lds, G, bid);
#endif
            }
            GRID_SYNC();
            Wout = (const bf16_t*)(ws + WS_WDAOUT + (size_t)j * 2 * MiB);
        } else if constexpr (layer == 1) {
            { pg8::EpiFnT E{(bf16_t*)(ws + WS_ATL), (bf16_t*)(ws + WS_ATC)};
              GEMM_PHASE_EpiFnT(pg8::EpiFnT, ws + WS_WFNT, Hb, 2048, TT, 1024, E); }
            { pg8::EpiPlain E{(bf16_t*)(ws + WS_ZB), 1024};
              GEMM_PHASE_EpiPlain(pg8::EpiPlain, Hb, ws + WS_WFNZ, TL, 1024, 1024, E); }
            GRID_SYNC();
            if (G > 64) {
                if (bid < 32) { { const int G = 32;
                    pg8::EpiPlain E{(bf16_t*)(ws + WS_ZB) + (size_t)TL * 1024, 1024};
                    GEMM_PHASE_EpiPlain(pg8::EpiPlain, Hb + (size_t)TL * 1024, ws + WS_WFNZ, TCX, 1024, 1024, E); } }
                else fnet_fold((const bf16_t*)(ws + WS_ATL), (bf16_t*)(ws + WS_FOLD), (bf16_t*)(ws + WS_FOLD + 32 * MiB), (float*)(ws + WS_BZ), (const bf16_t*)(ws + WS_ZB), Hb, G - 32, bid - 32);
            } else {
                { pg8::EpiPlain E{(bf16_t*)(ws + WS_ZB) + (size_t)TL * 1024, 1024};
                  GEMM_PHASE_EpiPlain(pg8::EpiPlain, Hb + (size_t)TL * 1024, ws + WS_WFNZ, TCX, 1024, 1024, E); }
                fnet_fold((const bf16_t*)(ws + WS_ATL), (bf16_t*)(ws + WS_FOLD), (bf16_t*)(ws + WS_FOLD + 32 * MiB), (float*)(ws + WS_BZ), (const bf16_t*)(ws + WS_ZB), Hb, G, bid);
            }
            GRID_SYNC();
            { pg8::EpiPlain E{(bf16_t*)(ws + WS_ATL), 8192};
              GEMM_PHASE_EpiPlain(pg8::EpiPlain, ws + WS_DFTL, ws + WS_FOLD, 2048, 8192, 2048, E); }
            GRID_SYNC();
            { pg8::EpiDftSym E{(const bf16_t*)(ws + WS_ATL), (const float*)(ws + WS_BZ), (const bf16_t*)(ws + WS_ZB), Hb};
              GEMM_PHASE(pg8::EpiDftSym, ws + WS_DFTL + 8 * MiB, ws + WS_FOLD + 32 * MiB, 2048, 8192, 2048, E); }
            { pg8::EpiDft E{(const bf16_t*)(ws + WS_ZB), Hb, TL, 256};
              GEMM_PHASE_EpiDft(pg8::EpiDft, ws + WS_DFTC, ws + WS_ATC, 256, 8192, 512, E); }
            GRID_SYNC();
            Wout = (const bf16_t*)(ws + WS_WFNOUT);
        } else {
            { pg8::EpiPlain E{(bf16_t*)(ws + WS_P), RWN};
              GEMM_PHASE_EpiPlain(pg8::EpiPlain, Hb, ws + WS_WRWIN, TT, RWN, 1024, E); }
            GRID_SYNC();
            RwArgs A{(const bf16_t*)(ws + WS_P), Hb, (bf16_t*)(ws + WS_Y1), (float*)(ws + WS_BZ), p.in[17], p.in[18], p.in[19], p.in[20], p.in[21], p.in[22], p.in[23], p.in[24]};
#ifndef SKIP_SCAN
            rwkv_scan(A, lds, G, bid);
#endif
#ifdef PROBE_SCAN2
            rwkv_scan(A, lds, G, bid);
#endif
            GRID_SYNC();
#ifndef SKIP_RWOUT
            rwkv_out(A, p.in[25], p.in[26], Hb, G, bid);
#endif
            GRID_SYNC();
            Wout = (const bf16_t*)(ws + WS_WRWOUT);
        }
        if constexpr (layer == 3) {
            pg8::EpiResid E{xl, xc, p.out, XC, modl + 2048, 0};
            GEMM_PHASE_EpiResid(pg8::EpiResid, Hb, Wout, TL, 1024, 1024, E);
            GRID_SYNC();
        } else {
            { pg8::EpiResid E{xl, xc, p.out, XC, modl + 2048, 0};
              GEMM_PHASE_EpiResid(pg8::EpiResid, Hb, Wout, TL, 1024, 1024, E); }
            GRID_SYNC();
            const float* gain_n = p.in[4] + (layer + 1) * 1024; const float* mod_n = mod + (size_t)(layer + 1) * 9 * 3072;
            const int nctx = 32;
            if (G > 2 * nctx) {
                if (bid < nctx) { const int G_real = G; { const int G = nctx; (void)G_real;
                    pg8::EpiResid E{xl, xc, p.out, XC, modl + 2048, TL};
                    GEMM_PHASE_EpiResid(pg8::EpiResid, Hb + (size_t)TL * 1024, Wout, TCX, 1024, 1024, E); } }
                else ph_phase(p.out, XC, gain_n, mod_n, Hb, G - nctx, bid - nctx, 0, TL);
                GRID_SYNC();
                ph_phase(p.out, XC, gain_n, mod_n, Hb, G, bid, TL, TT);
            } else {
                { pg8::EpiResid E{xl, xc, p.out, XC, modl + 2048, TL};
                  GEMM_PHASE_EpiResid(pg8::EpiResid, Hb + (size_t)TL * 1024, Wout, TCX, 1024, 1024, E); }
                GRID_SYNC();
                ph_phase(p.out, XC, gain_n, mod_n, Hb, G, bid);
            }
            GRID_SYNC();
        }
    }
__global__ void __launch_bounds__(512, 2) fwd_megakernel(Params p) {
    extern __shared__ __attribute__((aligned(16))) unsigned char lds_raw[];
    LAS char* lds = (LAS char*)lds_raw;
    cg::grid_group grid = cg::this_grid();
    const int G = gridDim.x, bid = blockIdx.x;
    volatile LAS unsigned* xst = (volatile LAS unsigned*)(lds + LDS_BYTES - 256);
    if (threadIdx.x < 2) xst[threadIdx.x] = 0u;
    __syncthreads();
    const XcdBarrier xbar = xcd_barrier_post((unsigned*)(p.ws + WS_CTL), xst);

#ifndef SKIP_PRO
    prologue(p, lds, G, bid);
#endif
#ifdef PROBE_PRO2
    __syncthreads(); prologue(p, lds, G, bid);
#endif
    grid.sync();
    layer_body<0>(p, lds, xbar, G, bid);
    layer_body<1>(p, lds, xbar, G, bid);
    layer_body<2>(p, lds, xbar, G, bid);
    layer_body<3>(p, lds, xbar, G, bid);
    final_phase(p.out, p.in[7], G, bid);
}

extern "C" void kernel_launch(void* const* d_in, const int* in_sizes, int n_in, void* d_out, int out_size, void* d_ws, size_t ws_size, hipStream_t stream) {
    static int grid = 0;
    if (grid == 0) {
        if (n_in != 28 || out_size != TL * 1024 || ws_size < WS_END) { fprintf(stderr, "kernel_launch: unexpected shapes: n_in %d out %d ws %zu\n", n_in, out_size, ws_size); grid = -1; return; }
        int dev = 0, cus = 0, per_cu = 0;
        hipGetDevice(&dev); hipDeviceGetAttribute(&cus, hipDeviceAttributeMultiprocessorCount, dev);
        if (hipFuncSetAttribute((const void*)fwd_megakernel, hipFuncAttributeMaxDynamicSharedMemorySize, LDS_BYTES) != hipSuccess) { fprintf(stderr, "kernel_launch: hipFuncSetAttribute failed\n"); grid = -1; return; }
        if (hipOccupancyMaxActiveBlocksPerMultiprocessor(&per_cu, (const void*)fwd_megakernel, 512, LDS_BYTES) != hipSuccess || per_cu < 1) { fprintf(stderr, "kernel_launch: occupancy query failed (%d)\n", per_cu); per_cu = 1; }
        (void)hipGetLastError();
        grid = cus * per_cu;
    }
    if (grid < 0) return;
    if (hipMemsetAsync((char*)d_ws + WS_CTL, 0, 65536, stream) != hipSuccess) { fprintf(stderr, "kernel_launch: hipMemsetAsync failed\n"); return; }
    Params p{};
    for (int i = 0; i < 28; ++i) p.in[i] = (const float*)d_in[i];
    p.out = (float*)d_out; p.ws = (unsigned char*)d_ws;
    void* args[] = {&p};
    hipError_t e = hipLaunchCooperativeKernel((const void*)fwd_megakernel, dim3(grid), dim3(512), args, LDS_BYTES, stream);
    if (e != hipSuccess) fprintf(stderr, "cooperative launch failed: %s (grid %d)\n", hipGetErrorString(e), grid);
}
```

```cpp
#include <hip/hip_runtime.h>
#include <hip/hip_cooperative_groups.h>
#include <cstdio>
#include <cstdint>
#include <cmath>
namespace cg = cooperative_groups;

constexpr int TL = 32768, TCX = 2048, TT = TL + TCX, DM = 1024;
constexpr float QK_C2 = 0.125f * 1.4426950408889634f;
typedef float f32x2_t __attribute__((ext_vector_type(2)));
typedef __bf16 bf16x2_t __attribute__((ext_vector_type(2)));
__device__ __forceinline__ unsigned pkbf(float lo, float hi) { f32x2_t v = {lo, hi}; bf16x2_t b = __builtin_convertvector(v, bf16x2_t); return __builtin_bit_cast(unsigned, b); }
__device__ __forceinline__ float bflo(unsigned u) { return __uint_as_float(u << 16); }
__device__ __forceinline__ float bfhi(unsigned u) { return __uint_as_float(u & 0xffff0000u); }
__device__ __forceinline__ float bf1(unsigned short u) { return __uint_as_float(((unsigned)u) << 16); }
__device__ __forceinline__ float silu_f(float z) { return z * __builtin_amdgcn_rcpf(1.f + __expf(-z)); }
__device__ __forceinline__ int opaque_tid() { int t = threadIdx.x; asm volatile("" : "+v"(t)); return t; }
namespace pg8 {
#define PG8_LAS __attribute__((address_space(3)))
typedef unsigned short bf16_t;
typedef short bf16x8 __attribute__((ext_vector_type(8)));
typedef float f32x4 __attribute__((ext_vector_type(4)));
typedef unsigned u32x4 __attribute__((ext_vector_type(4)));
constexpr int BM = 256, BK = 64, HALF = 128, HTB = HALF * BK * 2  , STAGE_BYTES = 8 * HTB, NXCD = 8, WGM = 8;

__host__ __device__ __forceinline__ int lds_byte(int r, int c) { const int st = (r >> 4) * 2 + (c >> 5), rr = r & 15, cc = c & 31, ob = rr * 64 + cc * 2; return st * 1024 + (ob ^ (((ob >> 9) & 1) << 5)); }
__host__ __device__ __forceinline__ void stage_rc(int b, int& R, int& C) { const int st = b / 1024, sb = b % 1024, swz = sb ^ (((sb >> 9) & 1) << 5); R = (st >> 1) * 16 + swz / 64; C = (st & 1) * 32 + (swz % 64) / 2; }
__host__ __device__ __forceinline__ int perm32(int rho) { const int n = rho >> 4, i = rho & 15; return 8 * (i >> 2) + 4 * n + (i & 3); }

struct Unit { int pm, pn; };
struct Gemm { const bf16_t* A; const bf16_t* Bt; int M, N, K; };

struct StaticOrder {
    int nM, nN, nwg, G, c;
    __host__ __device__ void init(int M, int N, int G_, int c_) { nM = M / BM; nN = N / BM; nwg = nM * nN; G = G_; c = c_; }
    __host__ __device__ bool next(int i, Unit& u) const {
        const long L = (long)i * G + c; if (L >= nwg) return false;
        int wgid = (int)L; { const int q = nwg / NXCD, r = nwg % NXCD, xcd = wgid % NXCD, off = wgid / NXCD; wgid = (xcd < r ? xcd * (q + 1) : r * (q + 1) + (xcd - r) * q) + off; }
        const int nig = WGM * nN, gid = wgid / nig, fm = gid * WGM, gsz = (nM - fm) < WGM ? (nM - fm) : WGM;
        u.pm = fm + ((wgid % nig) % gsz); u.pn = (wgid % nig) / gsz; return true;
    }
    __device__ __forceinline__ void a_ready(const Unit&) const {}
    __device__ __forceinline__ void done(const Unit&) const {}
};

struct EpiAttnIn {
    static constexpr bool PERM = true, AFTER_DRAIN = false;
    bf16_t* Q; bf16_t* Kb; bf16_t* V; bf16_t* Z; const PG8_LAS float* ropeC; const PG8_LAS float* ropeS;
    __device__ __forceinline__ void operator()(const f32x4 (&acc)[2][2][4][2], const Unit& u, int wr, int wc, int fr, int fq) const {
        const int sect = u.pn >> 2;
        bf16_t* base = sect == 0 ? Q : sect == 1 ? Kb : sect == 2 ? V : Z;
        const int colt = (u.pn & 3) * 256 + wc * 32 + 8 * fq;
        const int row0 = u.pm * BM + wr * 64 + fr;
        const bool rope = (u.pm < 128) && (sect < 2);
        const float sc = (sect == 0) ? QK_C2 : 1.f;
        const int axis = wc & 1;
#pragma unroll
        for (int ai = 0; ai < 2; ++ai)
#pragma unroll
            for (int m = 0; m < 4; ++m) {
                const int row = row0 + ai * HALF + m * 16;
                const int ntok = row & 4095;
                const int pos = axis ? (ntok & 63) : (ntok >> 6);
                bf16_t* rowp;
                if (sect == 1) rowp = base + (size_t)(row >> 6) * 65536 + (size_t)(colt >> 3) * 512 + (row & 63) * 8;
                else if (sect == 2) rowp = base + (size_t)(row >> 6) * 65536 + (size_t)(colt >> 7) * 8192 + (((colt & 127) >> 5) * 4 + ((row & 63) >> 4)) * 512 + (row & 15) * 32 + (colt & 31);
                else rowp = base + (size_t)row * 1024 + colt;
#pragma unroll
                for (int bj = 0; bj < 2; ++bj) {
                    f32x4 v0 = acc[ai][bj][m][0], v1 = acc[ai][bj][m][1];
                    if (rope) {
                        const f32x4 c0 = *(const PG8_LAS f32x4*)(ropeC + pos * 16 + 8 * (fq & 1)), c1 = *(const PG8_LAS f32x4*)(ropeC + pos * 16 + 8 * (fq & 1) + 4);
                        const f32x4 s0 = *(const PG8_LAS f32x4*)(ropeS + pos * 16 + 8 * (fq & 1)), s1 = *(const PG8_LAS f32x4*)(ropeS + pos * 16 + 8 * (fq & 1) + 4);
                        f32x4 p0, p1;
#pragma unroll
                        for (int i = 0; i < 4; ++i) { p0[i] = __shfl_xor(v0[i], 32); p1[i] = __shfl_xor(v1[i], 32); }
                        if (fq < 2) { v0 = v0 * c0 - p0 * s0; v1 = v1 * c1 - p1 * s1; }
                        else        { v0 = v0 * c0 + p0 * s0; v1 = v1 * c1 + p1 * s1; }
                    }
                    v0 = v0 * sc; v1 = v1 * sc;
                    u32x4 w; w.x = pkbf(v0[0], v0[1]); w.y = pkbf(v0[2], v0[3]); w.z = pkbf(v1[0], v1[1]); w.w = pkbf(v1[2], v1[3]);
                    *(u32x4*)(rowp + (sect == 1 || sect == 2 ? bj * 8192 : bj * HALF)) = w;
                }
            }
    }
};
struct EpiPlain {
    static constexpr bool PERM = true, AFTER_DRAIN = false;
    bf16_t* O; int ldc;
    __device__ __forceinline__ void operator()(const f32x4 (&acc)[2][2][4][2], const Unit& u, int wr, int wc, int fr, int fq) const {
        const int row0 = u.pm * BM + wr * 64 + fr, col0 = u.pn * BM + wc * 32 + 8 * fq;
#pragma unroll
        for (int ai = 0; ai < 2; ++ai)
#pragma unroll
            for (int m = 0; m < 4; ++m) { bf16_t* rowp = O + (size_t)(row0 + ai * HALF + m * 16) * ldc + col0;
#pragma unroll
                for (int bj = 0; bj < 2; ++bj) { const f32x4 v0 = acc[ai][bj][m][0], v1 = acc[ai][bj][m][1];
                    u32x4 w; w.x = pkbf(v0[0], v0[1]); w.y = pkbf(v0[2], v0[3]); w.z = pkbf(v1[0], v1[1]); w.w = pkbf(v1[2], v1[3]);
                    *(u32x4*)(rowp + bj * HALF) = w; } }
    }
};
struct EpiResid {
    static constexpr bool PERM = false, AFTER_DRAIN = false;
    const float* xin_lat; const float* xin_ctx; float* xout_lat; float* xout_ctx; const float* gate; int row_off;
    __device__ __forceinline__ void operator()(const f32x4 (&acc)[2][2][4][2], const Unit& u, int wr, int wc, int fr, int fq) const {
        const int rowt = row_off + u.pm * BM; const bool lat = rowt < TL; const int r = lat ? (rowt >> 12) : 8;
        const int row0 = rowt + wr * 64 + fr, col0 = u.pn * BM + wc * 32 + 4 * fq;
        const float* xi = lat ? xin_lat + (size_t)row0 * 1024 + col0 : xin_ctx + (size_t)(row0 - TL) * 1024 + col0;
        float* xo = lat ? xout_lat + (size_t)row0 * 1024 + col0 : xout_ctx + (size_t)(row0 - TL) * 1024 + col0;
        f32x4 g[2][2];
#pragma unroll
        for (int bj = 0; bj < 2; ++bj)
#pragma unroll
            for (int n = 0; n < 2; ++n) g[bj][n] = *(const f32x4*)(gate + r * 3072 + col0 + bj * HALF + n * 16);
#pragma unroll
        for (int ai = 0; ai < 2; ++ai) {
            f32x4 pre[4][2][2];
#pragma unroll
            for (int m = 0; m < 4; ++m)
#pragma unroll
                for (int bj = 0; bj < 2; ++bj)
#pragma unroll
                    for (int n = 0; n < 2; ++n) pre[m][bj][n] = *(const f32x4*)(xi + (size_t)(ai * HALF + m * 16) * 1024 + bj * HALF + n * 16);
            asm volatile("" ::: "memory");
#pragma unroll
            for (int m = 0; m < 4; ++m)
#pragma unroll
                for (int bj = 0; bj < 2; ++bj)
#pragma unroll
                    for (int n = 0; n < 2; ++n) *(f32x4*)(xo + (size_t)(ai * HALF + m * 16) * 1024 + bj * HALF + n * 16) = pre[m][bj][n] + g[bj][n] * acc[ai][bj][m][n];
            asm volatile("" ::: "memory");
        }
    }
};
struct EpiFnT {
    static constexpr bool PERM = true, AFTER_DRAIN = false;
    bf16_t* ATL; bf16_t* ATC;
    __device__ __forceinline__ void operator()(const f32x4 (&acc)[2][2][4][2], const Unit& u, int wr, int wc, int fr, int fq) const {
        const int row0 = u.pm * BM + wr * 64 + fr, col0 = u.pn * BM + wc * 32 + 8 * fq;
#pragma unroll
        for (int ai = 0; ai < 2; ++ai)
#pragma unroll
            for (int m = 0; m < 4; ++m) { const int mp = row0 + ai * HALF + m * 16, cs = mp >> 10, n = mp & 1023;
#pragma unroll
                for (int bj = 0; bj < 2; ++bj) { const int t0 = col0 + bj * HALF; bf16_t* dst;
                    if (t0 < TL) { const int b = t0 >> 12, l = t0 & 4095; dst = ATL + ((size_t)((b * 1024 + n) * 2 + cs)) * 4096 + l; }
                    else { const int tc = t0 - TL, b = tc >> 8, l = tc & 255; dst = ATC + ((size_t)((b * 1024 + n) * 2 + cs)) * 256 + l; }
                    const f32x4 v0 = acc[ai][bj][m][0], v1 = acc[ai][bj][m][1];
                    u32x4 w; w.x = pkbf(v0[0], v0[1]); w.y = pkbf(v0[2], v0[3]); w.z = pkbf(v1[0], v1[1]); w.w = pkbf(v1[2], v1[3]);
                    *(u32x4*)dst = w; } }
    }
};
struct EpiDft {
    static constexpr bool PERM = true, AFTER_DRAIN = false;
    const bf16_t* Z; bf16_t* OG; int rowbase; int L;
    __device__ __forceinline__ void operator()(const f32x4 (&acc)[2][2][4][2], const Unit& u, int wr, int wc, int fr, int fq) const {
        const int k0 = u.pm * BM + wr * 64 + fr; const int b = u.pn >> 2; const int n0 = (u.pn & 3) * 256 + wc * 32 + 8 * fq;
#pragma unroll
        for (int ai = 0; ai < 2; ++ai)
#pragma unroll
            for (int m = 0; m < 4; ++m) { const size_t R = (size_t)(rowbase + b * L + k0 + ai * HALF + m * 16);
#pragma unroll
                for (int bj = 0; bj < 2; ++bj) { const size_t off = R * 1024 + n0 + bj * HALF;
                    const u32x4 zz = *(const u32x4*)(Z + off);
                    const f32x4 v0 = acc[ai][bj][m][0], v1 = acc[ai][bj][m][1];
                    u32x4 w;
                    w.x = pkbf(v0[0] * silu_f(bflo(zz.x)), v0[1] * silu_f(bfhi(zz.x))); w.y = pkbf(v0[2] * silu_f(bflo(zz.y)), v0[3] * silu_f(bfhi(zz.y)));
                    w.z = pkbf(v1[0] * silu_f(bflo(zz.z)), v1[1] * silu_f(bfhi(zz.z))); w.w = pkbf(v1[2] * silu_f(bflo(zz.w)), v1[3] * silu_f(bfhi(zz.w)));
                    *(u32x4*)(OG + off) = w; } }
    }
};
struct EpiDftSym {
    static constexpr bool PERM = true, AFTER_DRAIN = false;
    const bf16_t* Pb; const float* TA; const bf16_t* Z; bf16_t* OG;
    __device__ __forceinline__ void operator()(const f32x4 (&acc)[2][2][4][2], const Unit& u, int wr, int wc, int fr, int fq) const {
        const int k0 = u.pm * BM + wr * 64 + fr; const int b = u.pn >> 2; const int c0 = u.pn * BM + wc * 32 + 8 * fq; const int n0 = c0 & 1023;
#pragma unroll
        for (int bj = 0; bj < 2; ++bj) {
            const f32x4 t0 = *(const f32x4*)(TA + c0 + bj * HALF), t1 = *(const f32x4*)(TA + c0 + bj * HALF + 4);
#pragma unroll
            for (int aim = 0; aim < 4; ++aim) { const int ai = aim >> 1, mh = (aim & 1) * 2;
                u32x4 pp[4], z1[4], z2[4];
#pragma unroll
                for (int m = mh; m < mh + 2; ++m) { const int k = k0 + ai * HALF + m * 16;
                    pp[m] = *(const u32x4*)(Pb + (size_t)k * 8192 + c0 + bj * HALF);
                    z1[m] = *(const u32x4*)(Z + (size_t)(b * 4096 + k) * 1024 + n0 + bj * HALF);
                    z2[m] = *(const u32x4*)(Z + (size_t)(b * 4096 + ((4096 - k) & 4095)) * 1024 + n0 + bj * HALF); }
                asm volatile("" ::: "memory");
#pragma unroll
                for (int m = mh; m < mh + 2; ++m) { const int k = k0 + ai * HALF + m * 16; const float sg = (k & 1) ? -1.f : 1.f;
                    const f32x4 q0 = acc[ai][bj][m][0], q1 = acc[ai][bj][m][1];
                    float pt[8];
                    pt[0] = bflo(pp[m].x) + sg * t0[0]; pt[1] = bfhi(pp[m].x) + sg * t0[1]; pt[2] = bflo(pp[m].y) + sg * t0[2]; pt[3] = bfhi(pp[m].y) + sg * t0[3];
                    pt[4] = bflo(pp[m].z) + sg * t1[0]; pt[5] = bfhi(pp[m].z) + sg * t1[1]; pt[6] = bflo(pp[m].w) + sg * t1[2]; pt[7] = bfhi(pp[m].w) + sg * t1[3];
                    { const size_t off = (size_t)(b * 4096 + k) * 1024 + n0 + bj * HALF; const u32x4 zz = z1[m]; u32x4 w;
                      w.x = pkbf((pt[0] - q0[0]) * silu_f(bflo(zz.x)), (pt[1] - q0[1]) * silu_f(bfhi(zz.x))); w.y = pkbf((pt[2] - q0[2]) * silu_f(bflo(zz.y)), (pt[3] - q0[3]) * silu_f(bfhi(zz.y)));
                      w.z = pkbf((pt[4] - q1[0]) * silu_f(bflo(zz.z)), (pt[5] - q1[1]) * silu_f(bfhi(zz.z))); w.w = pkbf((pt[6] - q1[2]) * silu_f(bflo(zz.w)), (pt[7] - q1[3]) * silu_f(bfhi(zz.w)));
                      *(u32x4*)(OG + off) = w; }
                    if (k >= 1) { const size_t off = (size_t)(b * 4096 + 4096 - k) * 1024 + n0 + bj * HALF; const u32x4 zz = z2[m]; u32x4 w;
                      w.x = pkbf((pt[0] + q0[0]) * silu_f(bflo(zz.x)), (pt[1] + q0[1]) * silu_f(bfhi(zz.x))); w.y = pkbf((pt[2] + q0[2]) * silu_f(bflo(zz.y)), (pt[3] + q0[3]) * silu_f(bfhi(zz.y)));
                      w.z = pkbf((pt[4] + q1[0]) * silu_f(bflo(zz.z)), (pt[5] + q1[1]) * silu_f(bfhi(zz.z))); w.w = pkbf((pt[6] + q1[2]) * silu_f(bflo(zz.w)), (pt[7] + q1[3]) * silu_f(bfhi(zz.w)));
                      *(u32x4*)(OG + off) = w; }
                }
                asm volatile("" ::: "memory");
            }
        }
    }
};
template <class Epi, class Sched, bool ALIGN_EPI = false, bool SP2 = false>
__device__ __forceinline__ void gemm_phase(PG8_LAS unsigned char* lds, const Gemm g, const Sched& S, const Epi& E) {
    const int tid = opaque_tid(), wid = __builtin_amdgcn_readfirstlane(tid >> 6), lane = tid & 63, wr = wid >> 2, wc = wid & 3, fr = lane & 15, fq = lane >> 4;
    const int K = g.K, nt = K / BK;
    unsigned voffA[2], voffB[2];
#pragma unroll
    for (int i = 0; i < 2; ++i) { int R, C; stage_rc(tid * 16 + i * 8192, R, C); const int Rb = Epi::PERM ? ((R & ~31) + perm32(R & 31)) : R;
        voffA[i] = (unsigned)(R * K + C) * 2u; voffB[i] = (unsigned)(Rb * K + C) * 2u; }
    const size_t kstep = (size_t)(BK * 2);
    const size_t hstep = (size_t)HALF * K * 2;
    const size_t tstep = 2 * hstep;
    const unsigned ldsw = (unsigned)wid * 1024u;
    const int aoff = lds_byte(wr * 64 + fr, fq * 8), boff = lds_byte(wc * 32 + fr, fq * 8);
#define PG8_SA(b, h) (((b) * 2 + (h)) * HTB)
#define PG8_SB(b, h) ((4 + (b) * 2 + (h)) * HTB)
#define PG8_STAGE(bufoff, gbase, voff) do { _Pragma("unroll") for (int _i = 0; _i < 2; ++_i) \
        __builtin_amdgcn_global_load_lds((const unsigned*)((const char*)(gbase) + (voff)[_i]), (PG8_LAS unsigned*)(lds + (bufoff) + ldsw + _i * 8192), 16, 0, 0); } while (0)
#define PG8_LDA(dst, b, h) do { _Pragma("unroll") for (int m = 0; m < 4; ++m) _Pragma("unroll") for (int k = 0; k < 2; ++k) dst[m][k] = *(const PG8_LAS bf16x8*)(lds + PG8_SA(b, h) + aoff + m * 2048 + k * 1024); } while (0)
#define PG8_LDB(dst, b, h) do { _Pragma("unroll") for (int n = 0; n < 2; ++n) _Pragma("unroll") for (int k = 0; k < 2; ++k) dst[n][k] = *(const PG8_LAS bf16x8*)(lds + PG8_SB(b, h) + boff + n * 2048 + k * 1024); } while (0)
#define PG8_MMA(ai, bj, At, Bt) do { __builtin_amdgcn_s_setprio(1); _Pragma("unroll") for (int m = 0; m < 4; ++m) _Pragma("unroll") for (int n = 0; n < 2; ++n) _Pragma("unroll") for (int k = 0; k < 2; ++k) \
        acc[ai][bj][m][n] = __builtin_amdgcn_mfma_f32_16x16x32_bf16(Bt[n][k], At[m][k], acc[ai][bj][m][n], 0, 0, 0); __builtin_amdgcn_s_setprio(0); } while (0)
#define PG8_WAIT_V(n) asm volatile("s_waitcnt vmcnt(" #n ")" ::: "memory")
#define PG8_WAIT_L(n) asm volatile("s_waitcnt lgkmcnt(" #n ")" ::: "memory")
#define PG8_BAR __builtin_amdgcn_s_barrier()
#define PG8_SCHED __builtin_amdgcn_sched_barrier(0)
    Unit cur, nxt; int ui = 0;
    if (!S.next(0, cur)) return;
    f32x4 acc[2][2][4][2];
#pragma unroll
    for (int a = 0; a < 2; ++a)
#pragma unroll
        for (int b = 0; b < 2; ++b)
#pragma unroll
            for (int m = 0; m < 4; ++m)
#pragma unroll
                for (int n = 0; n < 2; ++n) acc[a][b][m][n] = (f32x4){0.f, 0.f, 0.f, 0.f};
    bf16x8 At[4][2], B0[2][2], B1[2][2];
    const char* cA = (const char*)g.A + (size_t)cur.pm * tstep; const char* cB = (const char*)g.Bt + (size_t)cur.pn * tstep;
    S.a_ready(cur);
    if constexpr (SP2) {
        PG8_STAGE(PG8_SB(0, 0), cB, voffB); PG8_STAGE(PG8_SB(0, 1), cB + hstep, voffB); PG8_STAGE(PG8_SA(0, 0), cA, voffA); PG8_STAGE(PG8_SA(0, 1), cA + hstep, voffA);
        if (wr == 1) PG8_BAR;
        PG8_WAIT_V(2); PG8_BAR;
        PG8_STAGE(PG8_SB(1, 0), cB + kstep, voffB); PG8_STAGE(PG8_SA(1, 0), cA + kstep, voffA); PG8_STAGE(PG8_SB(1, 1), cB + hstep + kstep, voffB);
        PG8_WAIT_V(6); PG8_BAR;
    } else {
        PG8_STAGE(PG8_SB(0, 0), cB, voffB); PG8_STAGE(PG8_SA(0, 0), cA, voffA); PG8_STAGE(PG8_SB(0, 1), cB + hstep, voffB); PG8_STAGE(PG8_SA(0, 1), cA + hstep, voffA);
        if (wr == 1) PG8_BAR;
        PG8_WAIT_V(4); PG8_BAR;
        PG8_STAGE(PG8_SB(1, 0), cB + kstep, voffB); PG8_STAGE(PG8_SA(1, 0), cA + kstep, voffA); PG8_STAGE(PG8_SB(1, 1), cB + hstep + kstep, voffB);
        PG8_WAIT_V(6); PG8_BAR;
    }
    for (;;) {
        const bool has_next = S.next(ui + 1, nxt);
        const char* nA = has_next ? (const char*)g.A + (size_t)nxt.pm * tstep : cA; const char* nB = has_next ? (const char*)g.Bt + (size_t)nxt.pn * tstep : cB;
        for (int t = 0; t < nt; t += 2) {
            const bool last = (t == nt - 2);
            const char* a1 = cA + (size_t)(t + 1) * kstep;
            const char* a2 = last ? nA : cA + (size_t)(t + 2) * kstep; const char* b2 = last ? nB : cB + (size_t)(t + 2) * kstep;
            const char* a3 = a2 + kstep; const char* b3 = b2 + kstep;
            if (last && has_next) S.a_ready(nxt);
            if constexpr (SP2) {
            PG8_LDB(B0, 0, 0); PG8_LDB(B1, 0, 1); PG8_SCHED; PG8_LDA(At, 0, 0); PG8_STAGE(PG8_SA(1, 1), a1 + hstep, voffA);
            PG8_WAIT_V(8); PG8_WAIT_L(0); PG8_BAR; PG8_MMA(0, 0, At, B0); PG8_MMA(0, 1, At, B1); PG8_BAR; PG8_SCHED;
            PG8_LDA(At, 0, 1); PG8_STAGE(PG8_SB(0, 0), b2, voffB); PG8_STAGE(PG8_SB(0, 1), b2 + hstep, voffB); PG8_STAGE(PG8_SA(0, 0), a2, voffA);
            PG8_WAIT_V(8); PG8_WAIT_L(0); PG8_BAR; PG8_MMA(1, 0, At, B0); PG8_MMA(1, 1, At, B1); PG8_BAR; PG8_SCHED;
            PG8_LDB(B0, 1, 0); PG8_LDB(B1, 1, 1); PG8_SCHED; PG8_LDA(At, 1, 0); PG8_STAGE(PG8_SA(0, 1), a2 + hstep, voffA);
            PG8_WAIT_V(8); PG8_WAIT_L(0); PG8_BAR; PG8_MMA(0, 0, At, B0); PG8_MMA(0, 1, At, B1); PG8_BAR; PG8_SCHED;
            PG8_LDA(At, 1, 1); PG8_STAGE(PG8_SB(1, 0), b3, voffB); PG8_STAGE(PG8_SB(1, 1), b3 + hstep, voffB); PG8_STAGE(PG8_SA(1, 0), a3, voffA);
            PG8_WAIT_V(8); PG8_WAIT_L(0); PG8_BAR; PG8_MMA(1, 0, At, B0); PG8_MMA(1, 1, At, B1); PG8_BAR; PG8_SCHED;
            } else {
            PG8_LDB(B0, 0, 0); PG8_SCHED; PG8_LDA(At, 0, 0); PG8_STAGE(PG8_SA(1, 1), a1 + hstep, voffA);
            PG8_WAIT_L(8); PG8_BAR; PG8_WAIT_L(0); PG8_MMA(0, 0, At, B0); PG8_BAR; PG8_SCHED;
            PG8_LDB(B1, 0, 1); PG8_STAGE(PG8_SB(0, 0), b2, voffB);
            PG8_BAR; PG8_WAIT_L(0); PG8_MMA(0, 1, At, B1); PG8_BAR;
            PG8_LDA(At, 0, 1); PG8_STAGE(PG8_SA(0, 0), a2, voffA);
            PG8_BAR; PG8_WAIT_L(0); PG8_MMA(1, 0, At, B0); PG8_BAR; PG8_SCHED;
            PG8_STAGE(PG8_SB(0, 1), b2 + hstep, voffB);
            PG8_WAIT_V(6); PG8_BAR; PG8_MMA(1, 1, At, B1); PG8_BAR;
            PG8_LDB(B0, 1, 0); PG8_SCHED; PG8_LDA(At, 1, 0); PG8_STAGE(PG8_SA(0, 1), a2 + hstep, voffA);
            PG8_WAIT_L(8); PG8_BAR; PG8_WAIT_L(0); PG8_MMA(0, 0, At, B0); PG8_BAR; PG8_SCHED;
            PG8_LDB(B1, 1, 1); PG8_STAGE(PG8_SB(1, 0), b3, voffB);
            PG8_BAR; PG8_WAIT_L(0); PG8_MMA(0, 1, At, B1); PG8_BAR;
            PG8_LDA(At, 1, 1); PG8_STAGE(PG8_SA(1, 0), a3, voffA);
            PG8_BAR; PG8_WAIT_L(0); PG8_MMA(1, 0, At, B0); PG8_BAR; PG8_SCHED;
            PG8_STAGE(PG8_SB(1, 1), b3 + hstep, voffB);
            PG8_WAIT_V(6); PG8_BAR; PG8_MMA(1, 1, At, B1); PG8_BAR;
            }
        }
        if constexpr (ALIGN_EPI) { if (wr == 0) PG8_BAR; }
        if constexpr (!Epi::AFTER_DRAIN) { E(acc, cur, wr, wc, fr, fq); S.done(cur); }
        if (!has_next) break;
#pragma unroll
        for (int a = 0; a < 2; ++a)
#pragma unroll
            for (int b = 0; b < 2; ++b)
#pragma unroll
                for (int m = 0; m < 4; ++m)
#pragma unroll
                    for (int n = 0; n < 2; ++n) acc[a][b][m][n] = (f32x4){0.f, 0.f, 0.f, 0.f};
        cur = nxt; cA = nA; cB = nB; ++ui;
        if constexpr (ALIGN_EPI) { if (wr == 1) PG8_BAR; }
    }
    PG8_WAIT_V(0);
    if constexpr (!ALIGN_EPI) { if (wr == 0) PG8_BAR; }
    PG8_BAR;
    if constexpr (Epi::AFTER_DRAIN) { E.fused(acc, cur, wr, wc, fr, fq, lds, wid, lane); S.done(cur); }
#undef PG8_SA
#undef PG8_SB
#undef PG8_STAGE
#undef PG8_LDA
#undef PG8_LDB
#undef PG8_MMA
#undef PG8_WAIT_V
#undef PG8_WAIT_L
#undef PG8_BAR
#undef PG8_SCHED
}
}
#define LAS __attribute__((address_space(3)))
namespace att {
using bf16x8 = __attribute__((ext_vector_type(8))) short;
using s16x4 = __attribute__((ext_vector_type(4))) short;
using f32x16 = __attribute__((ext_vector_type(16))) float;
using u32x4 = __attribute__((ext_vector_type(4))) unsigned;
typedef unsigned short bf16_t;
__device__ __forceinline__ int crow(int r, int hi) { return (r & 3) + 8 * (r >> 2) + 4 * hi; }
typedef float f32x4_t __attribute__((ext_vector_type(4)));
template <int CTRL> __device__ __forceinline__ float adpp(float v) { return __int_as_float(__builtin_amdgcn_update_dpp(0, __float_as_int(v), CTRL, 0xf, 0xf, true)); }
constexpr int KSLOT = 8192, VSLOT = 16384, LDS_K = 0, LDS_V = 3 * KSLOT, LDS_WS = LDS_V + 4 * VSLOT, LDS_CNT = LDS_WS + 2048;
struct Args { const bf16_t* Q; const bf16_t* K; const bf16_t* V; const bf16_t* Z; bf16_t* O; const float* gain; float lam; float oml; int n_units; unsigned* o1g; };

__device__ __forceinline__ void qkt(f32x16& p0, f32x16& p1, const LAS char* Kslot, const bf16x8* qr, const f32x16& negm, int r32, int hi) {
    const LAS char* kb = Kslot + hi * 1024 + r32 * 16;
    bf16x8 kf[8];
#pragma unroll
    for (int d0 = 0; d0 < 4; ++d0) { kf[2 * d0] = *(const LAS bf16x8*)(kb + d0 * 2048); kf[2 * d0 + 1] = *(const LAS bf16x8*)(kb + d0 * 2048 + 512); }
    asm volatile("s_waitcnt lgkmcnt(0)" ::: "memory"); __builtin_amdgcn_sched_barrier(0);
    p0 = __builtin_amdgcn_mfma_f32_32x32x16_bf16(kf[0], qr[0], negm, 0, 0, 0); p1 = __builtin_amdgcn_mfma_f32_32x32x16_bf16(kf[1], qr[0], negm, 0, 0, 0);
#pragma unroll
    for (int d0 = 1; d0 < 4; ++d0) { p0 = __builtin_amdgcn_mfma_f32_32x32x16_bf16(kf[2 * d0], qr[d0], p0, 0, 0, 0); p1 = __builtin_amdgcn_mfma_f32_32x32x16_bf16(kf[2 * d0 + 1], qr[d0], p1, 0, 0, 0); }
}
__device__ __forceinline__ void kload(bf16x8* kf, const LAS char* Kslot, int r32, int hi) {
    const LAS char* kb = Kslot + hi * 1024 + r32 * 16;
#pragma unroll
    for (int d0 = 0; d0 < 2; ++d0) { kf[2 * d0] = *(const LAS bf16x8*)(kb + d0 * 2048); kf[2 * d0 + 1] = *(const LAS bf16x8*)(kb + d0 * 2048 + 512); }
}
__device__ __forceinline__ void qk_mm(f32x16& p0, f32x16& p1, const bf16x8* kf, const LAS char* Kslot, int r32, int hi, const bf16x8* qr, const f32x16& z) {
    const LAS char* kb = Kslot + hi * 1024 + r32 * 16;
    p0 = __builtin_amdgcn_mfma_f32_32x32x16_bf16(kf[0], qr[0], z, 0, 0, 0); p1 = __builtin_amdgcn_mfma_f32_32x32x16_bf16(kf[1], qr[0], z, 0, 0, 0);
    p0 = __builtin_amdgcn_mfma_f32_32x32x16_bf16(kf[2], qr[1], p0, 0, 0, 0); p1 = __builtin_amdgcn_mfma_f32_32x32x16_bf16(kf[3], qr[1], p1, 0, 0, 0);
    bf16x8 kg[4];
#pragma unroll
    for (int d0 = 2; d0 < 4; ++d0) { kg[2 * (d0 - 2)] = *(const LAS bf16x8*)(kb + d0 * 2048); kg[2 * (d0 - 2) + 1] = *(const LAS bf16x8*)(kb + d0 * 2048 + 512); }
    p0 = __builtin_amdgcn_mfma_f32_32x32x16_bf16(kg[0], qr[2], p0, 0, 0, 0); p1 = __builtin_amdgcn_mfma_f32_32x32x16_bf16(kg[1], qr[2], p1, 0, 0, 0);
    p0 = __builtin_amdgcn_mfma_f32_32x32x16_bf16(kg[2], qr[3], p0, 0, 0, 0); p1 = __builtin_amdgcn_mfma_f32_32x32x16_bf16(kg[3], qr[3], p1, 0, 0, 0);
}
__device__ __forceinline__ float max3a(float a, float b, float c) { float r; asm("v_max3_f32 %0, %1, %2, %3" : "=v"(r) : "v"(a), "v"(b), "v"(c)); return r; }
__device__ __forceinline__ float rowmax(const f32x16& p0, const f32x16& p1) {
    float a = max3a(p0[0], p0[1], p0[2]), b = max3a(p1[0], p1[1], p1[2]);
#pragma unroll
    for (int r = 3; r < 15; r += 2) { a = max3a(a, p0[r], p0[r + 1]); b = max3a(b, p1[r], p1[r + 1]); }
    a = max3a(a, p0[15], p1[15]);
    float m; asm("v_max_f32 %0, %1, %2" : "=v"(m) : "v"(a), "v"(b));
    asm volatile("s_nop 1" ::: "memory");
    auto rr = __builtin_amdgcn_permlane32_swap(__float_as_uint(m), __float_as_uint(m), false, false);
    float o; asm("v_max_f32 %0, %1, %2" : "=v"(o) : "v"(__uint_as_float(rr[0])), "v"(__uint_as_float(rr[1])));
    return o;
}
#define ATT_VRD(buf, d0) do { _Pragma("unroll") for (int ks = 0; ks < 4; ++ks) { \
        asm volatile("ds_read_b64_tr_b16 %0,%1 offset:%c2" : "=&v"(lo[buf][ks]) : "v"(vb), "i"((d0) * 4096 + ks * 1024) : "memory"); \
        asm volatile("ds_read_b64_tr_b16 %0,%1 offset:%c2" : "=&v"(hi[buf][ks]) : "v"(vb), "i"((d0) * 4096 + ks * 1024 + 512) : "memory"); } } while (0)
#define ATT_PK(b, k) (bf16x8){lo[b][k][0], lo[b][k][1], lo[b][k][2], lo[b][k][3], hi[b][k][0], hi[b][k][1], hi[b][k][2], hi[b][k][3]}
#define ATT_MM2(da, db) do { \
        o[da] = __builtin_amdgcn_mfma_f32_32x32x16_bf16(pa0, ATT_PK(0, 0), o[da], 0, 0, 0); o[db] = __builtin_amdgcn_mfma_f32_32x32x16_bf16(pa0, ATT_PK(1, 0), o[db], 0, 0, 0); \
        o[da] = __builtin_amdgcn_mfma_f32_32x32x16_bf16(pa1, ATT_PK(0, 1), o[da], 0, 0, 0); o[db] = __builtin_amdgcn_mfma_f32_32x32x16_bf16(pa1, ATT_PK(1, 1), o[db], 0, 0, 0); \
        o[da] = __builtin_amdgcn_mfma_f32_32x32x16_bf16(pa2, ATT_PK(0, 2), o[da], 0, 0, 0); o[db] = __builtin_amdgcn_mfma_f32_32x32x16_bf16(pa2, ATT_PK(1, 2), o[db], 0, 0, 0); \
        o[da] = __builtin_amdgcn_mfma_f32_32x32x16_bf16(pa3, ATT_PK(0, 3), o[da], 0, 0, 0); o[db] = __builtin_amdgcn_mfma_f32_32x32x16_bf16(pa3, ATT_PK(1, 3), o[db], 0, 0, 0); } while (0)
__device__ __forceinline__ void pv(f32x16* o, int vb, bf16x8 pa0, bf16x8 pa1, bf16x8 pa2, bf16x8 pa3) {
    s16x4 lo[2][4], hi[2][4];
    ATT_VRD(0, 0);
    ATT_VRD(1, 1);
    asm volatile("s_waitcnt lgkmcnt(0)" ::: "memory"); __builtin_amdgcn_sched_barrier(0);
    ATT_MM2(0, 1); __builtin_amdgcn_sched_barrier(0);
    ATT_VRD(0, 2);
    ATT_VRD(1, 3);
    asm volatile("s_waitcnt lgkmcnt(0)" ::: "memory"); __builtin_amdgcn_sched_barrier(0);
    ATT_MM2(2, 3);
}
#undef ATT_MM2
#undef ATT_VRD
#undef ATT_PK
__device__ __forceinline__ void attn_pass(const Args& A, int z, int b, int h, int qrow0, bool isctx, bool pathB, LAS char* shm, f32x16* o) {
    const int tid = opaque_tid(), lane = tid & 63, r32 = lane & 31, hi = lane >> 5; const int wid = __builtin_amdgcn_readfirstlane(tid >> 6);
    const int NT = isctx ? 4 : 68;
    LAS float* wsf = (LAS float*)(shm + LDS_WS) + wid * 64;
    const int vb0 = (int)(unsigned)(size_t)(shm + LDS_V) + ((lane >> 4) & 1) * 32 + (lane & 3) * 8 + (4 * hi + ((lane & 15) >> 2)) * 64;
    const bf16_t* Qw = A.Q + (size_t)(qrow0 + wid * 32 + r32) * 1024 + h * 128 + z * 64;
    bf16x8 qr[4];
#pragma unroll
    for (int d0 = 0; d0 < 4; ++d0) qr[d0] = *(const bf16x8*)(Qw + d0 * 16 + hi * 8);
    const bf16_t* Kh = A.K + (size_t)((h * 2 + z) * 8 + wid) * 512 + lane * 8;
    const int pc0 = wid, pc1 = wid + 8;
    const bf16_t* Vh0 = A.V + (size_t)h * 8192 + pc0 * 512 + lane * 8;
    const bf16_t* Vh1 = A.V + (size_t)h * 8192 + pc1 * 512 + lane * 8;
    const int ctxrow = TL + b * 256, latrow = b * 4096;
#define ATT_TROW(t) ((isctx || (t) < 4) ? (ctxrow + 64 * (t)) : (latrow + 64 * ((t) - 4)))
#define ATT_DMA(t, slot, vslot) do { const size_t ro_ = (size_t)(ATT_TROW(t) >> 6) * 65536; \
        __builtin_amdgcn_global_load_lds((const unsigned*)(Kh + ro_), (LAS unsigned*)(shm + LDS_K + (slot) * KSLOT + wid * 1024), 16, 0, 0); \
        __builtin_amdgcn_global_load_lds((const unsigned*)(Vh0 + ro_), (LAS unsigned*)(shm + LDS_V + (vslot) * VSLOT + pc0 * 1024), 16, 0, 0); \
        __builtin_amdgcn_global_load_lds((const unsigned*)(Vh1 + ro_), (LAS unsigned*)(shm + LDS_V + (vslot) * VSLOT + pc1 * 1024), 16, 0, 0); } while (0)
    float mhat = 0.f, l_reg = 0.f;
    const f32x16 negm = f32x16{};
#pragma unroll
    for (int d = 0; d < 4; ++d) o[d] = f32x16{};
    ATT_DMA(0, 0, 0);
    if (NT > 1) ATT_DMA(1, 1, 1);
    asm volatile("s_waitcnt vmcnt(0) lgkmcnt(0)\n\ts_barrier" ::: "memory");
    f32x16 sc0, sc1;
    { bf16x8 kf[4]; kload(kf, shm + LDS_K, r32, hi); qk_mm(sc0, sc1, kf, shm + LDS_K, r32, hi, qr, negm); asm volatile("s_nop 15\n\ts_nop 15" : "+v"(sc0), "+v"(sc1)); }
    if (NT > 2) ATT_DMA(2, 2, 2);
    int k_cur = 0, v_cur = 0, v_prev = 3;
    u32x4 pw0 = {0u, 0u, 0u, 0u}, pw1 = pw0, pw2 = pw0, pw3 = pw0;
#pragma unroll 1
    for (int t = 0; t <= NT; ++t) {
        const int k_n1 = (k_cur == 2) ? 0 : k_cur + 1;
        if (t > 0) {
            asm volatile("s_waitcnt vmcnt(0) lgkmcnt(0)\n\ts_barrier" ::: "memory");
            const int k_p2 = (k_cur == 0) ? 2 : k_cur - 1;
            const int v_p2 = (v_cur + 2) & 3;
            if (t + 2 < NT) ATT_DMA(t + 2, k_p2, v_p2);
        }
        if (pathB && t > 0) {
            pv(o, vb0 + v_prev * VSLOT, __builtin_bit_cast(bf16x8, pw0), __builtin_bit_cast(bf16x8, pw1), __builtin_bit_cast(bf16x8, pw2), __builtin_bit_cast(bf16x8, pw3)); }
        if (t < NT) {
        const float rm = rowmax(sc0, sc1);
        if (t == 0 || __any(rm > 8.f)) {
            const float dl = (t == 0) ? rm : fmaxf(rm, 0.f); mhat += dl;
#pragma unroll
            for (int r = 0; r < 16; ++r) { sc0[r] -= dl; sc1[r] -= dl; }
            if (t > 0) {
                const float f = __builtin_amdgcn_exp2f(-dl); l_reg *= f;
                if (hi == 0) wsf[r32] = f;
                asm volatile("s_waitcnt lgkmcnt(0)" ::: "memory");
#pragma unroll
                for (int r = 0; r < 16; ++r) { const float fr_ = wsf[crow(r, hi)];
#pragma unroll
                    for (int d = 0; d < 4; ++d) o[d][r] *= fr_; }
                asm volatile("s_waitcnt lgkmcnt(0)" ::: "memory");
            }
        }
        bf16x8 kf[4];
        kload(kf, shm + LDS_K + k_n1 * KSLOT, r32, hi);
        __builtin_amdgcn_sched_barrier(0);
        f32x16 pn0, pn1;
        { f32x16 nm;
#pragma unroll
          for (int r = 0; r < 16; ++r) nm[r] = -mhat;
          qk_mm(pn0, pn1, kf, shm + LDS_K + k_n1 * KSLOT, r32, hi, qr, nm); }
        f32x2_t sacc = {0.f, 0.f};
#pragma unroll
        for (int r = 0; r < 16; r += 2) { sc0[r] = __builtin_amdgcn_exp2f(sc0[r]); sc0[r + 1] = __builtin_amdgcn_exp2f(sc0[r + 1]); sc1[r] = __builtin_amdgcn_exp2f(sc1[r]); sc1[r + 1] = __builtin_amdgcn_exp2f(sc1[r + 1]);
            sacc += (f32x2_t){sc0[r], sc0[r + 1]}; sacc += (f32x2_t){sc1[r], sc1[r + 1]}; }
        l_reg += sacc.x + sacc.y;
        pw0 = (u32x4){pkbf(sc0[0], sc0[1]), pkbf(sc0[2], sc0[3]), pkbf(sc0[4], sc0[5]), pkbf(sc0[6], sc0[7])};
        pw1 = (u32x4){pkbf(sc0[8], sc0[9]), pkbf(sc0[10], sc0[11]), pkbf(sc0[12], sc0[13]), pkbf(sc0[14], sc0[15])};
        pw2 = (u32x4){pkbf(sc1[0], sc1[1]), pkbf(sc1[2], sc1[3]), pkbf(sc1[4], sc1[5]), pkbf(sc1[6], sc1[7])};
        pw3 = (u32x4){pkbf(sc1[8], sc1[9]), pkbf(sc1[10], sc1[11]), pkbf(sc1[12], sc1[13]), pkbf(sc1[14], sc1[15])};
#pragma unroll
        for (int i = 0; i < 8; ++i) { __builtin_amdgcn_sched_group_barrier(0x008, 1, 0); __builtin_amdgcn_sched_group_barrier(0x002, 10, 0); }
        __builtin_amdgcn_sched_barrier(0);
        if (!pathB) {
            pv(o, vb0 + v_cur * VSLOT, __builtin_bit_cast(bf16x8, pw0), __builtin_bit_cast(bf16x8, pw1), __builtin_bit_cast(bf16x8, pw2), __builtin_bit_cast(bf16x8, pw3)); }
        sc0 = pn0; sc1 = pn1;
        }
        k_cur = k_n1; v_prev = v_cur; v_cur = (v_cur + 1) & 3;
    }
    asm volatile("s_waitcnt lgkmcnt(0)\n\ts_barrier" ::: "memory");
#undef ATT_DMA
#undef ATT_TROW
    { auto rr = __builtin_amdgcn_permlane32_swap(__float_as_uint(l_reg), __float_as_uint(l_reg), false, false); l_reg = __uint_as_float(rr[0]) + __uint_as_float(rr[1]); }
    asm volatile("s_waitcnt lgkmcnt(0)" ::: "memory");
    if (hi == 0) wsf[32 + r32] = l_reg;
    asm volatile("s_waitcnt lgkmcnt(0)" ::: "memory");
#pragma unroll
    for (int r = 0; r < 16; ++r) { const float rl = 1.0f / wsf[32 + crow(r, hi)];
#pragma unroll
        for (int d = 0; d < 4; ++d) o[d][r] *= rl; }
    asm volatile("s_waitcnt lgkmcnt(0)" ::: "memory");
}
__device__ __forceinline__ void attn_unit(const Args& A, int b, int h, int qb, bool isctx, bool pathB, LAS char* shm) {
    const int tid = opaque_tid(), lane = tid & 63, r32 = lane & 31, hi = lane >> 5; const int wid = __builtin_amdgcn_readfirstlane(tid >> 6);
    const int qrow0 = isctx ? (TL + b * 256) : (b * 4096 + qb * 256);
    f32x16 o[4];
    unsigned* o1s = A.o1g + wid * 2048 + lane;
    attn_pass(A, 0, b, h, qrow0, isctx, pathB, shm, o);
#pragma unroll
    for (int d = 0; d < 4; ++d)
#pragma unroll
        for (int r = 0; r < 16; r += 2) o1s[(d * 8 + (r >> 1)) * 64] = pkbf(o[d][r], o[d][r + 1]);
    asm volatile("s_waitcnt lgkmcnt(0)" ::: "memory");
    attn_pass(A, 1, b, h, qrow0, isctx, pathB, shm, o);
#pragma unroll
    for (int r = 0; r < 16; r += 2)
#pragma unroll
        for (int d = 0; d < 4; ++d) { const unsigned pk = o1s[(d * 8 + (r >> 1)) * 64]; o[d][r] = bflo(pk) - A.lam * o[d][r]; o[d][r + 1] = bfhi(pk) - A.lam * o[d][r + 1]; }
    LAS float* stg = (LAS float*)shm + wid * (32 * 68);
    const int rq = lane >> 3, cq = lane & 7;
    float vals[2][4][8]; float ssr[4] = {0.f, 0.f, 0.f, 0.f};
#pragma unroll
    for (int hf = 0; hf < 2; ++hf) {
#pragma unroll
        for (int r = 0; r < 16; ++r) { stg[crow(r, hi) * 68 + r32] = o[2 * hf][r]; stg[crow(r, hi) * 68 + 32 + r32] = o[2 * hf + 1][r]; }
        asm volatile("s_waitcnt lgkmcnt(0)" ::: "memory");
#pragma unroll
        for (int i = 0; i < 4; ++i) { const f32x4_t u0 = *(const LAS f32x4_t*)(stg + (rq + 8 * i) * 68 + cq * 8), u1 = *(const LAS f32x4_t*)(stg + (rq + 8 * i) * 68 + cq * 8 + 4);
#pragma unroll
            for (int c = 0; c < 4; ++c) { vals[hf][i][c] = u0[c]; vals[hf][i][4 + c] = u1[c]; ssr[i] += u0[c] * u0[c] + u1[c] * u1[c]; } }
        asm volatile("s_waitcnt lgkmcnt(0)" ::: "memory");
    }
#pragma unroll
    for (int i = 0; i < 4; ++i) { float v = ssr[i]; v += adpp<0xB1>(v); v += adpp<0x4E>(v); v += adpp<0x141>(v); ssr[i] = rsqrtf(v * (1.0f / 128.0f) + 1e-5f) * A.oml; }
#pragma unroll
    for (int hf = 0; hf < 2; ++hf) {
        const int col = h * 128 + hf * 64 + cq * 8;
        const f32x4_t g0 = *(const f32x4_t*)(A.gain + hf * 64 + cq * 8), g1 = *(const f32x4_t*)(A.gain + hf * 64 + cq * 8 + 4);
        u32x4 zz[4];
#pragma unroll
        for (int i = 0; i < 4; ++i) zz[i] = *(const u32x4*)(A.Z + (size_t)(qrow0 + wid * 32 + rq + 8 * i) * 1024 + col);
#pragma unroll
        for (int i = 0; i < 4; ++i) { const float rs = ssr[i]; const float* vv = vals[hf][i]; u32x4 w;
            w.x = pkbf(vv[0] * rs * g0[0] * silu_f(bflo(zz[i].x)), vv[1] * rs * g0[1] * silu_f(bfhi(zz[i].x)));
            w.y = pkbf(vv[2] * rs * g0[2] * silu_f(bflo(zz[i].y)), vv[3] * rs * g0[3] * silu_f(bfhi(zz[i].y)));
            w.z = pkbf(vv[4] * rs * g1[0] * silu_f(bflo(zz[i].z)), vv[5] * rs * g1[1] * silu_f(bfhi(zz[i].z)));
            w.w = pkbf(vv[6] * rs * g1[2] * silu_f(bflo(zz[i].w)), vv[7] * rs * g1[3] * silu_f(bfhi(zz[i].w)));
            *(u32x4*)(A.O + (size_t)(qrow0 + wid * 32 + rq + 8 * i) * 1024 + col) = w; }
    }
}
__device__ __forceinline__ void attn_phase(const Args& A, LAS char* shm, int G, int bid) {
    const int vcu = (G % 8 == 0) ? (bid % 8) * (G / 8) + bid / 8 : bid;
    bool pathB;
    { const int tid = opaque_tid(); LAS unsigned* cnt = (LAS unsigned*)(shm + LDS_CNT);
      if (tid < 4) cnt[tid] = 0u;
      __syncthreads();
      const unsigned simd = (unsigned)__builtin_amdgcn_s_getreg((1 << 11) | (4 << 6) | 4) & 3u;
      unsigned slot = 0u; if ((tid & 63) == 0) slot = __hip_atomic_fetch_add(cnt + simd, 1u, __ATOMIC_RELAXED, __HIP_MEMORY_SCOPE_WORKGROUP);
      slot = (unsigned)__builtin_amdgcn_readfirstlane((int)slot);
      pathB = (slot & 1u) != 0u;
      __syncthreads(); }
#pragma unroll 1
    for (int u = vcu; u < A.n_units; u += G) {
        const bool isctx = u >= 1024; const int bh = isctx ? (u - 1024) : (u >> 4); const int qb = isctx ? 0 : (u & 15);
        attn_unit(A, bh >> 3, bh & 7, qb, isctx, pathB, shm);
        asm volatile("s_waitcnt vmcnt(0) lgkmcnt(0)\n\ts_barrier" ::: "memory");
    }
}
}
typedef unsigned short bf16_t;
typedef float f32x4 __attribute__((ext_vector_type(4)));
typedef unsigned u32x4 __attribute__((ext_vector_type(4)));
typedef unsigned u32x2 __attribute__((ext_vector_type(2)));
constexpr size_t MiB = 1u << 20;
constexpr size_t WS_CTL = 0, WS_MOD = 1 * MiB, WS_ROPE = 1 * MiB + 512 * 1024, WS_BZ = 2 * MiB;
constexpr size_t WS_WDAIN = 9 * MiB, WS_WDAOUT = 25 * MiB, WS_WFNT = 29 * MiB, WS_WFNZ = 33 * MiB, WS_WFNOUT = 35 * MiB, WS_WRWIN = 37 * MiB, WS_WRWOUT = 46 * MiB;
constexpr size_t WS_XC = 48 * MiB, WS_HB = 56 * MiB, WS_BIG = 124 * MiB;
constexpr size_t WS_Q = WS_BIG, WS_K = WS_BIG + 68 * MiB, WS_V = WS_BIG + 136 * MiB, WS_Z = WS_BIG + 204 * MiB;
constexpr size_t WS_ATL = WS_BIG, WS_ATC = WS_BIG + 128 * MiB, WS_ZB = WS_BIG + 136 * MiB, WS_DFTL = 396 * MiB, WS_DFTC = 460 * MiB, WS_FOLD = WS_BIG + 204 * MiB;
constexpr size_t WS_P = WS_BIG, WS_Y1 = 413 * MiB, WS_END = 482 * MiB;
constexpr int RWN = 4352;
constexpr int LDS_BYTES = 147456;

struct Params { const float* in[28]; float* out; unsigned char* ws; };

__device__ __forceinline__ float wave_sum(float v) {
#pragma unroll
    for (int o = 1; o < 64; o <<= 1) v += __shfl_xor(v, o);
    return v;
}
__device__ __forceinline__ void tr_item(const float* W, int ldw, int N, bf16_t* WT, int ldt, LAS float* scr, int item, int lane) {
    const int nblk = N / 32, kb = item / nblk, nb = item % nblk, k0 = 64 * kb, n0 = 32 * nb;
    float v_[32];
#pragma unroll
    for (int i = 0; i < 32; ++i) v_[i] = W[(size_t)(k0 + 2 * i + (lane >> 5)) * ldw + n0 + (lane & 31)];
#pragma unroll
    for (int i = 0; i < 32; ++i) scr[(2 * i + (lane >> 5)) * 33 + (lane & 31)] = v_[i];
    asm volatile("s_waitcnt lgkmcnt(0)" ::: "memory");
    const int c = lane & 7;
#pragma unroll
    for (int j = 0; j < 4; ++j) { const int n = (lane >> 3) + 8 * j; const LAS float* s = scr + (8 * c) * 33 + n;
        u32x4 o; o.x = pkbf(s[0 * 33], s[1 * 33]); o.y = pkbf(s[2 * 33], s[3 * 33]); o.z = pkbf(s[4 * 33], s[5 * 33]); o.w = pkbf(s[6 * 33], s[7 * 33]);
        *(u32x4*)(WT + (size_t)(n0 + n) * ldt + k0 + 8 * c) = o; }
    asm volatile("s_waitcnt lgkmcnt(0)" ::: "memory");
}
__device__ __forceinline__ void prologue(const Params& p, LAS char* lds, int G, int bid) {
    const int tid = opaque_tid(), lane = tid & 63, wid = tid >> 6;
    unsigned char* ws = p.ws;
    {
        LAS float* scr = (LAS float*)(lds + wid * 8448);
        const int gw = bid * 8 + wid, NGW = G * 8;
        for (int it = gw; it < 8832; it += NGW) {
            int r = it;
            if (r < 2048) { tr_item(p.in[8], 4096, 4096, (bf16_t*)(ws + WS_WDAIN), 1024, scr, r, lane); continue; } r -= 2048;
            if (r < 2048) { tr_item(p.in[8] + (size_t)1024 * 4096, 4096, 4096, (bf16_t*)(ws + WS_WDAIN + 8 * MiB), 1024, scr, r, lane); continue; } r -= 2048;
            if (r < 512) { tr_item(p.in[12], 1024, 1024, (bf16_t*)(ws + WS_WDAOUT), 1024, scr, r, lane); continue; } r -= 512;
            if (r < 512) { tr_item(p.in[12] + (size_t)1024 * 1024, 1024, 1024, (bf16_t*)(ws + WS_WDAOUT + 2 * MiB), 1024, scr, r, lane); continue; } r -= 512;
            if (r < 512) { tr_item(p.in[13] + 1024, 2048, 1024, (bf16_t*)(ws + WS_WFNZ), 1024, scr, r, lane); continue; } r -= 512;
            if (r < 512) { tr_item(p.in[15], 1024, 1024, (bf16_t*)(ws + WS_WFNOUT), 1024, scr, r, lane); continue; } r -= 512;
            if (r < 2176) { tr_item(p.in[16], RWN, RWN, (bf16_t*)(ws + WS_WRWIN), 1024, scr, r, lane); continue; } r -= 2176;
            tr_item(p.in[27], 1024, 1024, (bf16_t*)(ws + WS_WRWOUT), 1024, scr, r, lane);
        }
    }
    __syncthreads();
    for (int it = bid; it < 256; it += G) {
        const int g = it >> 5, cs = (it >> 4) & 1, kq = it & 15;
        LAS float* Wcs = (LAS float*)lds; LAS float* win = (LAS float*)(lds + 65536); LAS float* tab = (LAS float*)(lds + 65536 + 33024);
        if (tid < 128) { float s, c; sincospif((float)tid / 64.f, &s, &c); tab[tid] = (cs ? s : c) * 0.08838834764831845f; }
        __syncthreads();
        {
            const int e0 = (tid & 31) * 4, cq = tid >> 5; f32x4 acc[8];
#pragma unroll
            for (int i = 0; i < 8; ++i) acc[i] = (f32x4){0.f, 0.f, 0.f, 0.f};
            const float* Wg = p.in[14] + (size_t)g * 128 * 128;
            for (int m = 0; m < 128; ++m) { const f32x4 wg = *(const f32x4*)(Wg + m * 128 + e0);
#pragma unroll
                for (int i = 0; i < 8; ++i) acc[i] += wg * tab[(m * (cq + 16 * i)) & 127]; }
#pragma unroll
            for (int i = 0; i < 8; ++i) *(LAS f32x4*)(Wcs + (cq + 16 * i) * 128 + e0) = acc[i];
        }
#pragma unroll
        for (int i = 0; i < 16; ++i) { const int idx = tid + 512 * i, kin = idx >> 7, c = idx & 127; win[kin * 129 + c] = p.in[13][(size_t)(kq * 64 + kin) * 2048 + g * 128 + c]; }
        __syncthreads();
        {
            const int kin = tid & 63, eg = tid >> 6; float acc[16];
#pragma unroll
            for (int i = 0; i < 16; ++i) acc[i] = 0.f;
            for (int c = 0; c < 128; ++c) { const float a = win[kin * 129 + c];
#pragma unroll
                for (int i = 0; i < 16; ++i) acc[i] += a * Wcs[c * 128 + eg * 16 + i]; }
            bf16_t* WT = (bf16_t*)(ws + WS_WFNT);
#pragma unroll
            for (int i = 0; i < 16; ++i) WT[(size_t)(cs * 1024 + g * 128 + eg * 16 + i) * 1024 + kq * 64 + kin] = (bf16_t)(pkbf(acc[i], 0.f) & 0xffffu);
        }
        __syncthreads();
    }
    {
        LAS float* tc = (LAS float*)lds; LAS float* ts = (LAS float*)(lds + 16384);
        for (int j = tid; j < 4096; j += 512) { float s, c; sincospif((float)j / 2048.f, &s, &c); tc[j] = c; ts[j] = -s; }
        __syncthreads();
        bf16_t* DL = (bf16_t*)(ws + WS_DFTL); bf16_t* DC = (bf16_t*)(ws + WS_DFTC);
        for (int k = bid; k < 2048; k += G) {
            const int j0 = (tid & 255) * 8; const bool sn = tid >= 256; float v8[8];
#pragma unroll
            for (int i = 0; i < 8; ++i) { const int idx = (k * (j0 + i)) & 4095; v8[i] = (sn ? -ts[idx] : tc[idx]) * 0.015625f; }
            u32x4 o; o.x = pkbf(v8[0], v8[1]); o.y = pkbf(v8[2], v8[3]); o.z = pkbf(v8[4], v8[5]); o.w = pkbf(v8[6], v8[7]);
            *(u32x4*)(DL + (sn ? (size_t)2048 * 2048 : (size_t)0) + (size_t)k * 2048 + j0) = o;
        }
        for (int k = bid; k < 256; k += G) {
            if (tid < 64) { const int cs = tid >> 5, l0 = (tid & 31) * 8; float v8[8];
#pragma unroll
                for (int i = 0; i < 8; ++i) { const int idx = ((k * (l0 + i)) & 255) * 16; v8[i] = (cs ? ts[idx] : tc[idx]) * 0.0625f; }
                u32x4 o; o.x = pkbf(v8[0], v8[1]); o.y = pkbf(v8[2], v8[3]); o.z = pkbf(v8[4], v8[5]); o.w = pkbf(v8[6], v8[7]);
                *(u32x4*)(DC + (size_t)k * 512 + cs * 256 + l0) = o; }
        }
        __syncthreads();
    }
    {
        LAS float* sc = (LAS float*)lds; LAS float* red = (LAS float*)(lds + 40960);
        bool have = false;
        for (int it = bid; it < 192; it += G) {
            if (!have) { for (int idx = tid; idx < 9216; idx += 512) { const int r = idx >> 10, k = idx & 1023; const float cv = r < 8 ? p.in[1][r * 1024 + k] : p.in[3][k]; sc[idx] = cv / (1.f + __expf(-cv)); } have = true; __syncthreads(); }
            const int i = it / 48, n = (it % 48) * 64 + (tid & 63), kq = tid >> 6;
            const float* w = p.in[5] + (size_t)i * 1024 * 3072 + n;
            float acc[9];
#pragma unroll
            for (int r = 0; r < 9; ++r) acc[r] = 0.f;
            for (int k = kq * 128; k < kq * 128 + 128; k += 4) { const float w0 = w[(size_t)k * 3072], w1 = w[(size_t)(k + 1) * 3072], w2 = w[(size_t)(k + 2) * 3072], w3 = w[(size_t)(k + 3) * 3072];
#pragma unroll
                for (int r = 0; r < 9; ++r) { const f32x4 s4 = *(const LAS f32x4*)(sc + r * 1024 + k); acc[r] += (s4[0] * w0 + s4[1] * w1) + (s4[2] * w2 + s4[3] * w3); } }
#pragma unroll
            for (int r = 0; r < 9; ++r) red[(kq * 9 + r) * 64 + (tid & 63)] = acc[r];
            __syncthreads();
            for (int idx = tid; idx < 576; idx += 512) { const int r = idx >> 6, col = idx & 63; float s = 0.f;
#pragma unroll
                for (int q = 0; q < 8; ++q) s += red[(q * 9 + r) * 64 + col];
                const int nn = (it % 48) * 64 + col;
                ((float*)(ws + WS_MOD))[(size_t)(i * 9 + r) * 3072 + nn] = s + p.in[6][i * 3072 + nn]; }
            __syncthreads();
        }
    }
    if (bid == 0) { for (int t = tid; t < 1024; t += 512) { const int pos = t >> 4, qd = t & 15; const float inv = powf(10000.f, -(float)qd / 16.f); const float ang = (float)pos * inv;
            ((float*)(ws + WS_ROPE))[t] = cosf(ang); ((float*)(ws + WS_ROPE))[1024 + t] = sinf(ang); } }
}
__device__ __forceinline__ void ph_phase(const float* xlat, const float* xctx, const float* gain, const float* mod, bf16_t* Hb, int G, int bid, int r0 = 0, int r1 = TT) {
    const int tid_ = opaque_tid(); const int lane = tid_ & 63, wid = tid_ >> 6;
    const int stride = G * 8;
    for (int row0 = r0 + bid * 8 + wid; row0 < r1; row0 += 2 * stride) {
        const int row1 = row0 + stride; const bool has1 = row1 < r1;
        const float* s0 = row0 < TL ? xlat + (size_t)row0 * 1024 : xctx + (size_t)(row0 - TL) * 1024;
        const float* s1 = !has1 ? s0 : (row1 < TL ? xlat + (size_t)row1 * 1024 : xctx + (size_t)(row1 - TL) * 1024);
        f32x4 v0[4], v1[4]; float q0 = 0.f, q1 = 0.f;
#pragma unroll
        for (int j = 0; j < 4; ++j) { v0[j] = *(const f32x4*)(s0 + 4 * lane + 256 * j); v1[j] = *(const f32x4*)(s1 + 4 * lane + 256 * j); }
#pragma unroll
        for (int j = 0; j < 4; ++j) { q0 += (v0[j].x * v0[j].x + v0[j].y * v0[j].y) + (v0[j].z * v0[j].z + v0[j].w * v0[j].w); q1 += (v1[j].x * v1[j].x + v1[j].y * v1[j].y) + (v1[j].z * v1[j].z + v1[j].w * v1[j].w); }
        const float r0 = rsqrtf(wave_sum(q0) * (1.f / 1024.f) + 1e-6f), r1 = rsqrtf(wave_sum(q1) * (1.f / 1024.f) + 1e-6f);
        const float* m0 = mod + (row0 < TL ? (row0 >> 12) : 8) * 3072; const float* m1 = mod + (row1 < TL ? (row1 >> 12) : 8) * 3072;
#pragma unroll
        for (int j = 0; j < 4; ++j) { const int col = 4 * lane + 256 * j; const f32x4 g4 = *(const f32x4*)(gain + col);
            { const f32x4 sh = *(const f32x4*)(m0 + col), sc = *(const f32x4*)(m0 + 1024 + col); const f32x4 y = v0[j] * r0 * g4 * (sc + 1.f) + sh; u32x2 o; o.x = pkbf(y.x, y.y); o.y = pkbf(y.z, y.w); *(u32x2*)(Hb + (size_t)row0 * 1024 + col) = o; }
            if (has1) { const f32x4 sh = *(const f32x4*)(m1 + col), sc = *(const f32x4*)(m1 + 1024 + col); const f32x4 y = v1[j] * r1 * g4 * (sc + 1.f) + sh; u32x2 o; o.x = pkbf(y.x, y.y); o.y = pkbf(y.z, y.w); *(u32x2*)(Hb + (size_t)row1 * 1024 + col) = o; } }
    }
}
__device__ __forceinline__ void final_phase(float* x, const float* gain, int G, int bid) {
    const int tid_ = opaque_tid(); const int lane = tid_ & 63, wid = tid_ >> 6;
    const int stride = G * 8;
    for (int row0 = bid * 8 + wid; row0 < TL; row0 += 2 * stride) {
        const int row1 = row0 + stride; const bool has1 = row1 < TL;
        float* s0 = x + (size_t)row0 * 1024; float* s1 = has1 ? x + (size_t)row1 * 1024 : s0;
        f32x4 v0[4], v1[4]; float q0 = 0.f, q1 = 0.f;
#pragma unroll
        for (int j = 0; j < 4; ++j) { v0[j] = *(const f32x4*)(s0 + 4 * lane + 256 * j); v1[j] = *(const f32x4*)(s1 + 4 * lane + 256 * j); }
#pragma unroll
        for (int j = 0; j < 4; ++j) { q0 += (v0[j].x * v0[j].x + v0[j].y * v0[j].y) + (v0[j].z * v0[j].z + v0[j].w * v0[j].w); q1 += (v1[j].x * v1[j].x + v1[j].y * v1[j].y) + (v1[j].z * v1[j].z + v1[j].w * v1[j].w); }
        const float r0 = rsqrtf(wave_sum(q0) * (1.f / 1024.f) + 1e-6f), r1 = rsqrtf(wave_sum(q1) * (1.f / 1024.f) + 1e-6f);
#pragma unroll
        for (int j = 0; j < 4; ++j) { const int col = 4 * lane + 256 * j; const f32x4 g4 = *(const f32x4*)(gain + col);
            *(f32x4*)(s0 + col) = v0[j] * r0 * g4;
            if (has1) *(f32x4*)(s1 + col) = v1[j] * r1 * g4; }
    }
}
__device__ __forceinline__ void fnet_fold(const bf16_t* ATL, bf16_t* E, bf16_t* O, float* TA, const bf16_t* Z, bf16_t* OG, int G, int bid) {
    const int tid_ = opaque_tid(); const int lane = tid_ & 63, wid = tid_ >> 6;
    for (int row = bid * 8 + wid; row < 8192; row += G * 8) {
        const bf16_t* a1 = ATL + (size_t)row * 8192; const bf16_t* a2 = a1 + 4096; bf16_t* e = E + (size_t)row * 2048; bf16_t* od = O + (size_t)row * 2048;
        float alt = 0.f;
#pragma unroll 2
        for (int it = 0; it < 4; ++it) {
            const int j0 = (it * 64 + lane) * 8;
            const u32x4 x = *(const u32x4*)(a1 + j0), y = *(const u32x4*)(a2 + j0);
            const int mb = 4096 - j0 - 8;
            const u32x4 xm = *(const u32x4*)(a1 + mb), ym = *(const u32x4*)(a2 + mb);
            const unsigned short xe = (j0 == 0) ? (unsigned short)0 : a1[4096 - j0], ye = (j0 == 0) ? (unsigned short)0 : a2[4096 - j0];
            float fa[8], fs[8], ma[8], ms[8];
#pragma unroll
            for (int i = 0; i < 4; ++i) { fa[2 * i] = bflo(x[i]); fa[2 * i + 1] = bfhi(x[i]); fs[2 * i] = bflo(y[i]); fs[2 * i + 1] = bfhi(y[i]);
                ma[2 * i] = bflo(xm[i]); ma[2 * i + 1] = bfhi(xm[i]); ms[2 * i] = bflo(ym[i]); ms[2 * i + 1] = bfhi(ym[i]); }
            float oc[8], os[8];
            oc[0] = fa[0] + bf1(xe); os[0] = fs[0] - bf1(ye);
#pragma unroll
            for (int i = 1; i < 8; ++i) { oc[i] = fa[i] + ma[8 - i]; os[i] = fs[i] - ms[8 - i]; }
            if (j0 == 0) { oc[0] = fa[0]; os[0] = 0.f; }
            u32x4 o; o.x = pkbf(oc[0], oc[1]); o.y = pkbf(oc[2], oc[3]); o.z = pkbf(oc[4], oc[5]); o.w = pkbf(oc[6], oc[7]);
            *(u32x4*)(e + j0) = o;
            alt += (bflo(o.x) - bfhi(o.x)) + (bflo(o.y) - bfhi(o.y)) + (bflo(o.z) - bfhi(o.z)) + (bflo(o.w) - bfhi(o.w));
            o.x = pkbf(os[0], os[1]); o.y = pkbf(os[2], os[3]); o.z = pkbf(os[4], os[5]); o.w = pkbf(os[6], os[7]);
            *(u32x4*)(od + j0) = o;
        }
        alt = wave_sum(alt);
        if (lane == 0) { const float amid = bf1(a1[2048]); TA[row] = amid * 0.015625f;
            const int b = row >> 10, n = row & 1023; const size_t off = (size_t)(b * 4096 + 2048) * 1024 + n;
            const float yv = (alt + amid) * 0.015625f * silu_f(bf1(Z[off]));
            OG[off] = (bf16_t)(pkbf(yv, 0.f) & 0xffffu); }
    }
}
__device__ __forceinline__ void sh8(const bf16_t* P, size_t row, int co, bool hm, bool hp, const float* mu, float* out) {
    const u32x4 z4 = {0u, 0u, 0u, 0u};
    const u32x4 c0 = *(const u32x4*)(P + row * RWN + co);
    const u32x4 cm = hm ? *(const u32x4*)(P + (row - 1) * RWN + co) : z4;
    const u32x4 cp = hp ? *(const u32x4*)(P + (row + 1) * RWN + co) : z4;
    const f32x4 m0 = *(const f32x4*)(mu + co), m1 = *(const f32x4*)(mu + co + 4);
#pragma unroll
    for (int i = 0; i < 4; ++i) {
        const float a0 = bflo(c0[i]), a1 = bfhi(c0[i]);
        const float n0 = 0.5f * (bflo(cm[i]) + bflo(cp[i])), n1 = 0.5f * (bfhi(cm[i]) + bfhi(cp[i]));
        const float mu0 = (2 * i < 4) ? m0[(2 * i) & 3] : m1[(2 * i) & 3], mu1 = (2 * i + 1 < 4) ? m0[(2 * i + 1) & 3] : m1[(2 * i + 1) & 3];
        out[2 * i] = a0 + mu0 * (n0 - a0); out[2 * i + 1] = a1 + mu1 * (n1 - a1);
    }
}
template <int CTRL> __device__ __forceinline__ float dpp_f(float v) { return __int_as_float(__builtin_amdgcn_update_dpp(0, __float_as_int(v), CTRL, 0xf, 0xf, true)); }
__device__ __forceinline__ float sum8(float v) { v += dpp_f<0xB1>(v); v += dpp_f<0x4E>(v); v += dpp_f<0x141>(v); return v; }
__device__ __forceinline__ float fast_tanh(float x) { const float e = __expf(2.f * x); return 1.f - 2.f * __builtin_amdgcn_rcpf(e + 1.f); }
__device__ __forceinline__ float fast_sigmoid(float x) { return __builtin_amdgcn_rcpf(1.f + __expf(-x)); }
struct RwArgs { const bf16_t* P; bf16_t* Y0; bf16_t* Y1; float* BZ; const float *mu, *w0, *w_up, *a0, *a_up, *k_k, *k_a, *r_k; };
struct Raw3 { u32x4 c0, cm, cp; };
__device__ __forceinline__ Raw3 ld3(const bf16_t* P, size_t row, int co, bool hm, bool hp) {
    const u32x4 z4 = {0u, 0u, 0u, 0u}; Raw3 r;
    r.c0 = *(const u32x4*)(P + row * RWN + co);
    r.cm = hm ? *(const u32x4*)(P + (row - 1) * RWN + co) : z4;
    r.cp = hp ? *(const u32x4*)(P + (row + 1) * RWN + co) : z4;
    return r;
}
__device__ __forceinline__ void shift8(const Raw3& R, const float* mu, int co, float* out) {
    const f32x4 m0 = *(const f32x4*)(mu + co), m1 = *(const f32x4*)(mu + co + 4);
#pragma unroll
    for (int i = 0; i < 4; ++i) {
        const float a0 = bflo(R.c0[i]), a1 = bfhi(R.c0[i]);
        const float n0 = 0.5f * (bflo(R.cm[i]) + bflo(R.cp[i])), n1 = 0.5f * (bfhi(R.cm[i]) + bfhi(R.cp[i]));
        const float mu0 = (2 * i < 4) ? m0[(2 * i) & 3] : m1[(2 * i) & 3], mu1 = (2 * i + 1 < 4) ? m0[(2 * i + 1) & 3] : m1[(2 * i + 1) & 3];
        out[2 * i] = a0 + mu0 * (n0 - a0); out[2 * i + 1] = a1 + mu1 * (n1 - a1);
    }
}
__device__ __forceinline__ void shift8l(const Raw3& R, const LAS float* mu, float* out) {
    const f32x4 m0 = *(const LAS f32x4*)(mu), m1 = *(const LAS f32x4*)(mu + 4);
    const float mm[8] = {m0[0], m0[1], m0[2], m0[3], m1[0], m1[1], m1[2], m1[3]};
#pragma unroll
    for (int i = 0; i < 4; ++i) {
        const float a0 = bflo(R.c0[i]), a1 = bfhi(R.c0[i]);
        const float n0 = 0.5f * (bflo(R.cm[i]) + bflo(R.cp[i])), n1 = 0.5f * (bfhi(R.cm[i]) + bfhi(R.cp[i]));
        out[2 * i] = a0 + mm[2 * i] * (n0 - a0); out[2 * i + 1] = a1 + mm[2 * i + 1] * (n1 - a1);
    }
}
__device__ __forceinline__ void shift8r(const Raw3& R, const float* mu, float* out) {
#pragma unroll
    for (int i = 0; i < 4; ++i) {
        const float a0 = bflo(R.c0[i]), a1 = bfhi(R.c0[i]);
        const float n0 = 0.5f * (bflo(R.cm[i]) + bflo(R.cp[i])), n1 = 0.5f * (bfhi(R.cm[i]) + bfhi(R.cp[i]));
        out[2 * i] = a0 + mu[2 * i] * (n0 - a0); out[2 * i + 1] = a1 + mu[2 * i + 1] * (n1 - a1);
    }
}
__device__ __forceinline__ void rwkv_scan(const RwArgs& A, LAS char* lds, int G, int bid) {
    typedef short bfx8 __attribute__((ext_vector_type(8)));
    const int tid = opaque_tid(), lane = tid & 63; const int q = __builtin_amdgcn_readfirstlane(tid >> 6);
    LAS float* sW = (LAS float*)lds; LAS float* sA = sW + 4096; LAS float* sB = sA + 4096; LAS float* sKD = sB + 4096; LAS float* sR = sKD + 4096; LAS float* sV = sR + 4096;
    LAS bf16_t* WUPt = (LAS bf16_t*)(sV + 4096); LAS bf16_t* AUPt = WUPt + 64 * 72;
    LAS bf16_t* T1 = (LAS bf16_t*)sW; LAS bf16_t* T2 = (LAS bf16_t*)sKD;
    const int s = tid >> 3, dg = tid & 7, d0 = dg * 8;
#pragma unroll 1
    for (int chain = bid; chain < 256; chain += G) {
        const int z = chain >> 7, b = (chain >> 4) & 7, hh = chain & 15;
        __syncthreads();
        for (int idx = tid; idx < 4096; idx += 512) { const int r = idx >> 6, d = idx & 63;
            WUPt[d * 72 + r] = (bf16_t)(pkbf(A.w_up[(size_t)(z * 64 + r) * 1024 + hh * 64 + d], 0.f) & 0xffffu);
            AUPt[d * 72 + r] = (bf16_t)(pkbf(A.a_up[(size_t)(z * 64 + r) * 1024 + hh * 64 + d], 0.f) & 0xffffu); }
        f32x2_t S2[4];
#pragma unroll
        for (int j = 0; j < 4; ++j) S2[j] = (f32x2_t){0.f, 0.f};
        bf16_t* Yz = z ? A.Y1 : A.Y0;
        const int c_r = hh * 64 + d0, c_k = 1024 + hh * 64 + d0, c_v = 2048 + hh * 64 + d0, c_wd = 3072 + z * 64 + d0, c_ad = 3200 + z * 64 + d0;
#define RW_ROWOF(c, rowv, hmv, hpv) do { const int sidx_ = (c) * 64 + s; int L_, n_, rb_; \
            if ((c) < 4) { L_ = 256; n_ = z ? (255 - sidx_) : sidx_; rb_ = TL + b * 256; } else { L_ = 4096; const int sl_ = sidx_ - 256; n_ = z ? (4095 - sl_) : sl_; rb_ = b * 4096; } \
            rowv = (size_t)(rb_ + n_); hmv = n_ > 0; hpv = n_ < L_ - 1; } while (0)
        size_t row; bool hm, hp;
        RW_ROWOF(0, row, hm, hp);
        Raw3 Rr = ld3(A.P, row, c_r, hm, hp), Rk = ld3(A.P, row, c_k, hm, hp), Rv = ld3(A.P, row, c_v, hm, hp), Rw = ld3(A.P, row, c_wd, hm, hp), Ra = ld3(A.P, row, c_ad, hm, hp);
#pragma unroll 1
        for (int c = 0; c < 68; ++c) {
            asm volatile("" ::: "memory");
            const size_t crow_ = row;
            {
                float r8[8], k8[8], v8[8], t8[8];
                shift8(Rr, A.mu, c_r, r8); shift8(Rk, A.mu, c_k, k8); shift8(Rv, A.mu, c_v, v8);
                *(LAS f32x4*)(sR + s * 64 + d0) = (f32x4){r8[0], r8[1], r8[2], r8[3]}; *(LAS f32x4*)(sR + s * 64 + d0 + 4) = (f32x4){r8[4], r8[5], r8[6], r8[7]};
                *(LAS f32x4*)(sV + s * 64 + d0) = (f32x4){v8[0], v8[1], v8[2], v8[3]}; *(LAS f32x4*)(sV + s * 64 + d0 + 4) = (f32x4){v8[4], v8[5], v8[6], v8[7]};
                *(LAS f32x4*)(sB + s * 64 + d0) = (f32x4){k8[0], k8[1], k8[2], k8[3]}; *(LAS f32x4*)(sB + s * 64 + d0 + 4) = (f32x4){k8[4], k8[5], k8[6], k8[7]};
                float kkr[8], ssq = 0.f;
                const f32x4 kk0 = *(const f32x4*)(A.k_k + hh * 64 + d0), kk1 = *(const f32x4*)(A.k_k + hh * 64 + d0 + 4);
#pragma unroll
                for (int i = 0; i < 8; ++i) { kkr[i] = k8[i] * (i < 4 ? kk0[i & 3] : kk1[i & 3]); ssq += kkr[i] * kkr[i]; }
                ssq = sum8(ssq);
                const float rs = -rsqrtf(ssq + 1e-12f);
                *(LAS f32x4*)(sA + s * 64 + d0) = (f32x4){kkr[0] * rs, kkr[1] * rs, kkr[2] * rs, kkr[3] * rs}; *(LAS f32x4*)(sA + s * 64 + d0 + 4) = (f32x4){kkr[4] * rs, kkr[5] * rs, kkr[6] * rs, kkr[7] * rs};
                shift8(Rw, A.mu, c_wd, t8);
                { u32x4 o; o.x = pkbf(fast_tanh(t8[0]), fast_tanh(t8[1])); o.y = pkbf(fast_tanh(t8[2]), fast_tanh(t8[3])); o.z = pkbf(fast_tanh(t8[4]), fast_tanh(t8[5])); o.w = pkbf(fast_tanh(t8[6]), fast_tanh(t8[7]));
                  *(LAS u32x4*)(T1 + s * 72 + d0) = o; }
                shift8(Ra, A.mu, c_ad, t8);
                { u32x4 o; o.x = pkbf(t8[0], t8[1]); o.y = pkbf(t8[2], t8[3]); o.z = pkbf(t8[4], t8[5]); o.w = pkbf(t8[6], t8[7]);
                  *(LAS u32x4*)(T2 + s * 72 + d0) = o; }
            }
            if (c + 1 < 68) { RW_ROWOF(c + 1, row, hm, hp);
                Rr = ld3(A.P, row, c_r, hm, hp); Rk = ld3(A.P, row, c_k, hm, hp); Rv = ld3(A.P, row, c_v, hm, hp); Rw = ld3(A.P, row, c_wd, hm, hp); Ra = ld3(A.P, row, c_ad, hm, hp); }
            __syncthreads();
            const int mt = q & 3, nh = q >> 2, fr = lane & 15, fq = lane >> 4;
            f32x4 accw[2], acca[2];
            {
                bfx8 aw[2], aa[2];
#pragma unroll
                for (int kk = 0; kk < 2; ++kk) { aw[kk] = *(const LAS bfx8*)(T1 + (16 * mt + fr) * 72 + kk * 32 + fq * 8); aa[kk] = *(const LAS bfx8*)(T2 + (16 * mt + fr) * 72 + kk * 32 + fq * 8); }
#pragma unroll
                for (int nt = 0; nt < 2; ++nt) { accw[nt] = (f32x4){0.f, 0.f, 0.f, 0.f}; acca[nt] = (f32x4){0.f, 0.f, 0.f, 0.f};
#pragma unroll
                    for (int kk = 0; kk < 2; ++kk) {
                        const bfx8 bw = *(const LAS bfx8*)(WUPt + (32 * nh + 16 * nt + fr) * 72 + kk * 32 + fq * 8), ba = *(const LAS bfx8*)(AUPt + (32 * nh + 16 * nt + fr) * 72 + kk * 32 + fq * 8);
                        accw[nt] = __builtin_amdgcn_mfma_f32_16x16x32_bf16(aw[kk], bw, accw[nt], 0, 0, 0);
                        acca[nt] = __builtin_amdgcn_mfma_f32_16x16x32_bf16(aa[kk], ba, acca[nt], 0, 0, 0); } }
            }
            __syncthreads();
#pragma unroll
            for (int nt = 0; nt < 2; ++nt) { const int d = 32 * nh + 16 * nt + fr, dcol = hh * 64 + d;
                const float w0d = A.w0[z * 1024 + dcol], a0d = A.a0[z * 1024 + dcol], kad = A.k_a[dcol];
#pragma unroll
                for (int j = 0; j < 4; ++j) { const int idx = (16 * mt + 4 * fq + j) * 64 + d;
                    const float x = -(w0d + accw[nt][j]);
                    const float sp = fmaxf(x, 0.f) + __logf(1.f + __expf(-fabsf(x)));
                    const float w = __expf(-__expf(-sp - 0.5f));
                    const float asig = fast_sigmoid(a0d + acca[nt][j]);
                    const float nkk = sA[idx], kraw = sB[idx];
                    sW[idx] = w; sB[idx] = -nkk * asig; sKD[idx] = kraw * (1.f + (asig - 1.f) * kad); } }
            __syncthreads();
            {
                const f32x4 ra = *(const LAS f32x4*)(sR + s * 64 + d0), rb = *(const LAS f32x4*)(sR + s * 64 + d0 + 4), ka = *(const LAS f32x4*)(sKD + s * 64 + d0), kb = *(const LAS f32x4*)(sKD + s * 64 + d0 + 4);
                const f32x4 q0 = *(const f32x4*)(A.r_k + hh * 64 + d0), q1 = *(const f32x4*)(A.r_k + hh * 64 + d0 + 4);
                float bz = 0.f;
#pragma unroll
                for (int i = 0; i < 4; ++i) { bz += ra[i] * ka[i] * q0[i]; bz += rb[i] * kb[i] * q1[i]; }
                bz = sum8(bz);
                if (dg == 0) A.BZ[((size_t)z * TT + crow_) * 16 + hh] = bz;
            }
            {
                const int rl = lane >> 3, cg = lane & 7, irow = 8 * q + rl;
                const LAS float* bw = sW + 8 * cg; const LAS float* ba_ = sA + 8 * cg; const LAS float* bb_ = sB + 8 * cg; const LAS float* bk = sKD + 8 * cg; const LAS float* br = sR + 8 * cg;
                LAS float* bv = sV + irow;
                LAS float* bvw = (cg == 0) ? bv : ((LAS float*)(lds + 118784) + lane);
                f32x4 w0 = *(const LAS f32x4*)(bw), w1 = *(const LAS f32x4*)(bw + 4), a0 = *(const LAS f32x4*)(ba_), a1 = *(const LAS f32x4*)(ba_ + 4);
                f32x4 b0 = *(const LAS f32x4*)(bb_), b1 = *(const LAS f32x4*)(bb_ + 4), k0 = *(const LAS f32x4*)(bk), k1 = *(const LAS f32x4*)(bk + 4);
                f32x4 r0 = *(const LAS f32x4*)(br), r1 = *(const LAS f32x4*)(br + 4); float vi = bv[0];
#pragma unroll 4
                for (int st = 0; st < 64; ++st) {
                    const int on = ((st + 1) & 63) * 64;
                    const f32x4 nw0 = *(const LAS f32x4*)(bw + on), nw1 = *(const LAS f32x4*)(bw + on + 4), na0 = *(const LAS f32x4*)(ba_ + on), na1 = *(const LAS f32x4*)(ba_ + on + 4);
                    const f32x4 nb0 = *(const LAS f32x4*)(bb_ + on), nb1 = *(const LAS f32x4*)(bb_ + on + 4), nk0 = *(const LAS f32x4*)(bk + on), nk1 = *(const LAS f32x4*)(bk + on + 4);
                    const f32x4 nr0 = *(const LAS f32x4*)(br + on), nr1 = *(const LAS f32x4*)(br + on + 4); const float nvi = bv[on];
                    f32x2_t pp2 = S2[0] * (f32x2_t){a0[0], a0[1]};
                    pp2 = S2[1] * (f32x2_t){a0[2], a0[3]} + pp2; pp2 = S2[2] * (f32x2_t){a1[0], a1[1]} + pp2; pp2 = S2[3] * (f32x2_t){a1[2], a1[3]} + pp2;
                    const float sa = sum8(pp2.x + pp2.y);
                    const f32x2_t sa2 = {sa, sa}, v2 = {vi, vi};
                    S2[0] = S2[0] * (f32x2_t){w0[0], w0[1]} + sa2 * (f32x2_t){b0[0], b0[1]} + v2 * (f32x2_t){k0[0], k0[1]};
                    S2[1] = S2[1] * (f32x2_t){w0[2], w0[3]} + sa2 * (f32x2_t){b0[2], b0[3]} + v2 * (f32x2_t){k0[2], k0[3]};
                    S2[2] = S2[2] * (f32x2_t){w1[0], w1[1]} + sa2 * (f32x2_t){b1[0], b1[1]} + v2 * (f32x2_t){k1[0], k1[1]};
                    S2[3] = S2[3] * (f32x2_t){w1[2], w1[3]} + sa2 * (f32x2_t){b1[2], b1[3]} + v2 * (f32x2_t){k1[2], k1[3]};
                    f32x2_t y2 = S2[0] * (f32x2_t){r0[0], r0[1]};
                    y2 = S2[1] * (f32x2_t){r0[2], r0[3]} + y2; y2 = S2[2] * (f32x2_t){r1[0], r1[1]} + y2; y2 = S2[3] * (f32x2_t){r1[2], r1[3]} + y2;
                    const float yv = sum8(y2.x + y2.y);
                    bvw[st * 64] = yv;
                    w0 = nw0; w1 = nw1; a0 = na0; a1 = na1; b0 = nb0; b1 = nb1; k0 = nk0; k1 = nk1; r0 = nr0; r1 = nr1; vi = nvi;
                }
            }
            __syncthreads();
            { u32x4 o; const LAS float* yr = sV + s * 64 + d0;
              o.x = pkbf(yr[0], yr[1]); o.y = pkbf(yr[2], yr[3]); o.z = pkbf(yr[4], yr[5]); o.w = pkbf(yr[6], yr[7]);
              *(u32x4*)(Yz + crow_ * 1024 + hh * 64 + d0) = o; }
            __syncthreads();
        }
#undef RW_ROWOF
    }
}
__device__ __forceinline__ void rwkv_out(const RwArgs& A, const float* ln_w, const float* ln_b, bf16_t* OG, int G, int bid) {
    const int tid_ = opaque_tid(); const int lane = tid_ & 63, wid = tid_ >> 6; const int c0 = lane * 16, head = lane >> 2;
    float lw[16], lb[16], muv[16];
#pragma unroll
    for (int i = 0; i < 16; ++i) { lw[i] = ln_w[c0 + i]; lb[i] = ln_b[c0 + i]; muv[i] = A.mu[2048 + c0 + i]; }
    for (int row = bid * 8 + wid; row < TT; row += G * 8) {
        const bool lat = row < TL; const int L = lat ? 4096 : 256; const int n = lat ? (row & 4095) : ((row - TL) & 255); const bool hm = n > 0, hp = n < L - 1;
        const u32x4 a0 = *(const u32x4*)(A.Y0 + (size_t)row * 1024 + c0), a1 = *(const u32x4*)(A.Y0 + (size_t)row * 1024 + c0 + 8);
        const u32x4 b0 = *(const u32x4*)(A.Y1 + (size_t)row * 1024 + c0), b1 = *(const u32x4*)(A.Y1 + (size_t)row * 1024 + c0 + 8);
        const Raw3 v0 = ld3(A.P, (size_t)row, 2048 + c0, hm, hp), v1 = ld3(A.P, (size_t)row, 2048 + c0 + 8, hm, hp);
        const u32x4 z0 = *(const u32x4*)(A.P + (size_t)row * RWN + 3328 + c0), z1 = *(const u32x4*)(A.P + (size_t)row * RWN + 3328 + c0 + 8);
        const float bz = 0.5f * (A.BZ[(size_t)row * 16 + head] + A.BZ[((size_t)TT + row) * 16 + head]);
        float y[16], vv[16];
#pragma unroll
        for (int i = 0; i < 4; ++i) { y[2 * i] = bflo(a0[i]) + bflo(b0[i]); y[2 * i + 1] = bfhi(a0[i]) + bfhi(b0[i]); y[8 + 2 * i] = bflo(a1[i]) + bflo(b1[i]); y[8 + 2 * i + 1] = bfhi(a1[i]) + bfhi(b1[i]); }
        float s1 = 0.f;
#pragma unroll
        for (int i = 0; i < 16; ++i) s1 += y[i];
        s1 += __shfl_xor(s1, 1); s1 += __shfl_xor(s1, 2); const float mean = s1 * (1.f / 64.f);
        float s2 = 0.f;
#pragma unroll
        for (int i = 0; i < 16; ++i) { y[i] -= mean; s2 += y[i] * y[i]; }
        s2 += __shfl_xor(s2, 1); s2 += __shfl_xor(s2, 2); const float rstd = rsqrtf(s2 * (1.f / 64.f) + 64e-5f);
        shift8r(v0, muv, vv); shift8r(v1, muv + 8, vv + 8);
        float ov[16];
#pragma unroll
        for (int i = 0; i < 16; ++i) { const unsigned zw = (i < 8) ? z0[(i >> 1) & 3] : z1[(i >> 1) & 3]; const float zz = (i & 1) ? bfhi(zw) : bflo(zw);
            ov[i] = (y[i] * rstd * lw[i] + lb[i] + bz * vv[i]) * silu_f(zz); }
        u32x4 o0, o1; o0.x = pkbf(ov[0], ov[1]); o0.y = pkbf(ov[2], ov[3]); o0.z = pkbf(ov[4], ov[5]); o0.w = pkbf(ov[6], ov[7]);
        o1.x = pkbf(ov[8], ov[9]); o1.y = pkbf(ov[10], ov[11]); o1.z = pkbf(ov[12], ov[13]); o1.w = pkbf(ov[14], ov[15]);
        *(u32x4*)(OG + (size_t)row * 1024 + c0) = o0; *(u32x4*)(OG + (size_t)row * 1024 + c0 + 8) = o1;
    }
}
#ifdef SKIP_GEMM
#define GEMM_PHASE(EPI, AP, BP, MM, NN, KK, EOBJ) do { (void)EOBJ; } while (0)
#else
#ifndef STAGGER_TICKS
#define STAGGER_TICKS 1500
#endif
__device__ __forceinline__ void stagger_wait(int bid, int units_per_cu_x2) {
    if ((bid & 1) && units_per_cu_x2 >= 4) { const unsigned long long t0 = __builtin_amdgcn_s_memrealtime(); while (__builtin_amdgcn_s_memrealtime() - t0 < (unsigned long long)STAGGER_TICKS) __builtin_amdgcn_s_sleep(32); }
}
#define GEMM_PHASE(EPI, AP, BP, MM, NN, KK, EOBJ) do { pg8::Gemm g_{(const bf16_t*)(AP), (const bf16_t*)(BP), (MM), (NN), (KK)}; pg8::StaticOrder S_; S_.init((MM), (NN), G, bid); \
    pg8::gemm_phase<EPI, pg8::StaticOrder, true, true>((PG8_LAS unsigned char*)lds, g_, S_, EOBJ); } while (0)
#endif
#ifdef SKIP_EpiAttnIn
#define GEMM_PHASE_EpiAttnIn(EPI, AP, BP, MM, NN, KK, EOBJ) do { (void)EOBJ; } while (0)
#else
#define GEMM_PHASE_EpiAttnIn GEMM_PHASE
#endif
#ifdef SKIP_EpiFnT
#define GEMM_PHASE_EpiFnT(EPI, AP, BP, MM, NN, KK, EOBJ) do { (void)EOBJ; } while (0)
#else
#define GEMM_PHASE_EpiFnT GEMM_PHASE
#endif
#ifdef SKIP_EpiPlain
#define GEMM_PHASE_EpiPlain(EPI, AP, BP, MM, NN, KK, EOBJ) do { (void)EOBJ; } while (0)
#else
#define GEMM_PHASE_EpiPlain GEMM_PHASE
#endif
#ifdef SKIP_EpiDft
#define GEMM_PHASE_EpiDft(EPI, AP, BP, MM, NN, KK, EOBJ) do { (void)EOBJ; } while (0)
#else
#define GEMM_PHASE_EpiDft GEMM_PHASE
#endif
#ifdef SKIP_EpiResid
#define GEMM_PHASE_EpiResid(EPI, AP, BP, MM, NN, KK, EOBJ) do { (void)EOBJ; } while (0)
#else
#define GEMM_PHASE_EpiResid GEMM_PHASE
#endif
#define XB_TMO      128
#define XB_XCNT(j)  (256  + 64 * (j))
#define XB_XSUB(j)  (1280 + 64 * (j))
#define XB_XGEN(j)  (2304 + 64 * (j))
#define XB_TOP      3328
#define XB_TOPGEN   3392
#define XCD_BAR_WORDS 3456
#define XB_SPIN_CAP (1u << 18)

__device__ __forceinline__ unsigned xb_ld(unsigned* p)              { return __hip_atomic_load(p, __ATOMIC_RELAXED, __HIP_MEMORY_SCOPE_AGENT); }
__device__ __forceinline__ unsigned xb_add(unsigned* p, unsigned v) { return __hip_atomic_fetch_add(p, v, __ATOMIC_RELAXED, __HIP_MEMORY_SCOPE_AGENT); }
__device__ __forceinline__ unsigned xb_xcc_id() { return (unsigned)__builtin_amdgcn_s_getreg((3 << 11) | 20) & 0xFu; }
#define XB_SPIN(cond, bar) do { unsigned _sp = 0; while (cond) { __builtin_amdgcn_s_sleep(1); \
    if ((++_sp & 255u) == 0u) { if (xb_ld(&(bar)[XB_TMO])) break; if (_sp > XB_SPIN_CAP) { atomicAdd(&(bar)[XB_TMO], 1u); break; } } } } while (0)

struct XcdBarrier {
    unsigned* bar; unsigned x;
    volatile LAS unsigned* st;
};

__device__ __forceinline__ XcdBarrier xcd_barrier_post(unsigned* bar, volatile LAS unsigned* st) {
    XcdBarrier b; b.bar = bar; b.x = xb_xcc_id(); b.st = st;
    if (threadIdx.x == 0) (void)xb_add(&bar[XB_XCNT(b.x)], 1u);
    return b;
}
__device__ __forceinline__ void xcd_barrier_complete(unsigned* bar, unsigned x, unsigned& nloc, unsigned& nx) {
    const unsigned G = gridDim.x * gridDim.y * gridDim.z;
    unsigned sum, cnt, mine, sp = 0u;
    for (;;) {
        sum = 0u; cnt = 0u; mine = 0u;
#pragma unroll
        for (unsigned j = 0; j < 16; ++j) { const unsigned c = xb_ld(&bar[XB_XCNT(j)]); sum += c; cnt += (c > 0u) ? 1u : 0u; mine = (j == x) ? c : mine; }
        if (sum == G) break;
        __builtin_amdgcn_s_sleep(1);
        if ((++sp & 255u) == 0u) { if (xb_ld(&bar[XB_TMO])) break; if (sp > XB_SPIN_CAP) { atomicAdd(&bar[XB_TMO], 1u); break; } }
    }
    nloc = mine > 0u ? mine : 1u; nx = cnt > 0u ? cnt : 1u;
}

__device__ __forceinline__ void xcd_barrier(const XcdBarrier& b) {
    asm volatile("s_waitcnt vmcnt(0)" ::: "memory");
    __syncthreads();
    if (threadIdx.x == 0) {
        unsigned* bar = b.bar;
        __builtin_amdgcn_s_waitcnt(0);
        unsigned nloc = b.st[0], nx = b.st[1];
        if (nloc == 0u) { xcd_barrier_complete(bar, b.x, nloc, nx); b.st[0] = nloc; b.st[1] = nx; }
        const unsigned old = xb_add(&bar[XB_XSUB(b.x)], 1u);
        const unsigned gen = old / nloc;
        if (old + 1u == (gen + 1u) * nloc) {
            __builtin_amdgcn_fence(__ATOMIC_RELEASE, "agent");
            asm volatile("s_waitcnt vmcnt(0)" ::: "memory");
            const unsigned og = xb_add(&bar[XB_TOP], 1u);
            const unsigned tg = og / nx;
            if (og + 1u == (tg + 1u) * nx) xb_add(&bar[XB_TOPGEN], 1u);
            else XB_SPIN(xb_ld(&bar[XB_TOPGEN]) == tg, bar);
            __builtin_amdgcn_fence(__ATOMIC_ACQUIRE, "agent");
            xb_add(&bar[XB_XGEN(b.x)], 1u);
            asm volatile("s_waitcnt vmcnt(0)" ::: "memory");
        } else {
            XB_SPIN(xb_ld(&bar[XB_XGEN(b.x)]) == gen, bar);
            __builtin_amdgcn_fence(__ATOMIC_ACQUIRE, "agent");
            asm volatile("s_waitcnt vmcnt(0)" ::: "memory");
        }
    }
    __syncthreads();
}

#define GRID_SYNC() xcd_barrier(xbar)
template <int layer> __device__ __forceinline__ void layer_body(const Params& p, LAS char* lds, const XcdBarrier& xbar, int G, int bid) {
    unsigned char* ws = p.ws;
    float* mod = (float*)(ws + WS_MOD);
    const float* ropeC = (const float*)(ws + WS_ROPE); const float* ropeS = ropeC + 1024;
    bf16_t* Hb = (bf16_t*)(ws + WS_HB);
    float* XC = (float*)(ws + WS_XC);
    const float* x_in = p.in[0]; const float* ctx_in = p.in[2];
        const float* xl = layer == 0 ? x_in : p.out; const float* xc = layer == 0 ? ctx_in : XC;
        const float* modl = mod + (size_t)layer * 9 * 3072;
        if constexpr (layer == 0) {
            ph_phase(xl, xc, p.in[4] + layer * 1024, modl, Hb, G, bid);
            GRID_SYNC();
        }
        const int Mout = (layer == 3) ? TL : TT;
        const bf16_t* Wout;
        if constexpr (layer == 0 || layer == 3) {
            const int j = layer == 0 ? 0 : 1;
            LAS float* ropeL = (LAS float*)(lds + 131072);
            for (int t_ = opaque_tid(); t_ < 2048; t_ += 512) ropeL[t_] = ropeC[t_];
            __syncthreads();
            pg8::EpiAttnIn E{(bf16_t*)(ws + WS_Q), (bf16_t*)(ws + WS_K), (bf16_t*)(ws + WS_V), (bf16_t*)(ws + WS_Z), (const PG8_LAS float*)ropeL, (const PG8_LAS float*)ropeL + 1024};
            GEMM_PHASE_EpiAttnIn(pg8::EpiAttnIn, Hb, ws + WS_WDAIN + (size_t)j * 8 * MiB, TT, 4096, 1024, E);
#ifdef PROBE_GIN2
            GEMM_PHASE_EpiAttnIn(pg8::EpiAttnIn, Hb, ws + WS_WDAIN + (size_t)j * 8 * MiB, TT, 4096, 1024, E);
#endif
            GRID_SYNC();
            float lam;
            { const int lane = opaque_tid() & 63; const float* lq = p.in[9] + j * 128; const float* lk = p.in[10] + j * 128;
              const float s0 = wave_sum(lq[lane] * lk[lane]), s1 = wave_sum(lq[64 + lane] * lk[64 + lane]);
              const float li = 0.8f - 0.6f * expf(-0.3f * (float)layer); lam = expf(s0) - expf(s1) + li;
              att::Args A{(const bf16_t*)(ws + WS_Q), (const bf16_t*)(ws + WS_K), (const bf16_t*)(ws + WS_V), (const bf16_t*)(ws + WS_Z), Hb, p.in[11] + j * 128, lam, 1.f - li, layer == 3 ? 1024 : 1088, (unsigned*)(ws + WS_Y1) + (size_t)bid * 8 * 2048};
#ifndef SKIP_ATT
              att::attn_phase(A, lds, G, bid);
#endif
#ifdef PROBE_ATT2
              att::attn_phase(A, lds, G, bid);
#endif
            }
            GRID_SYNC();
            Wout = (const bf16_t*)(ws + WS_WDAOUT + (size_t)j * 2 * MiB);
        } else if constexpr (layer == 1) {
            { pg8::EpiFnT E{(bf16_t*)(ws + WS_ATL), (bf16_t*)(ws + WS_ATC)};
              GEMM_PHASE_EpiFnT(pg8::EpiFnT, ws + WS_WFNT, Hb, 2048, TT, 1024, E); }
            { pg8::EpiPlain E{(bf16_t*)(ws + WS_ZB), 1024};
              GEMM_PHASE_EpiPlain(pg8::EpiPlain, Hb, ws + WS_WFNZ, TL, 1024, 1024, E); }
            GRID_SYNC();
            if (G > 64) {
                if (bid < 32) { { const int G = 32;
                    pg8::EpiPlain E{(bf16_t*)(ws + WS_ZB) + (size_t)TL * 1024, 1024};
                    GEMM_PHASE_EpiPlain(pg8::EpiPlain, Hb + (size_t)TL * 1024, ws + WS_WFNZ, TCX, 1024, 1024, E); } }
                else fnet_fold((const bf16_t*)(ws + WS_ATL), (bf16_t*)(ws + WS_FOLD), (bf16_t*)(ws + WS_FOLD + 32 * MiB), (float*)(ws + WS_BZ), (const bf16_t*)(ws + WS_ZB), Hb, G - 32, bid - 32);
            } else {
                { pg8::EpiPlain E{(bf16_t*)(ws + WS_ZB) + (size_t)TL * 1024, 1024};
                  GEMM_PHASE_EpiPlain(pg8::EpiPlain, Hb + (size_t)TL * 1024, ws + WS_WFNZ, TCX, 1024, 1024, E); }
                fnet_fold((const bf16_t*)(ws + WS_ATL), (bf16_t*)(ws + WS_FOLD), (bf16_t*)(ws + WS_FOLD + 32 * MiB), (float*)(ws + WS_BZ), (const bf16_t*)(ws + WS_ZB), Hb, G, bid);
            }
            GRID_SYNC();
            { pg8::EpiPlain E{(bf16_t*)(ws + WS_ATL), 8192};
              GEMM_PHASE_EpiPlain(pg8::EpiPlain, ws + WS_DFTL, ws + WS_FOLD, 2048, 8192, 2048, E); }
            GRID_SYNC();
            { pg8::EpiDftSym E{(const bf16_t*)(ws + WS_ATL), (const float*)(ws + WS_BZ), (const bf16_t*)(ws + WS_ZB), Hb};
              GEMM_PHASE(pg8::EpiDftSym, ws + WS_DFTL + 8 * MiB, ws + WS_FOLD + 32 * MiB, 2048, 8192, 2048, E); }
            { pg8::EpiDft E{(const bf16_t*)(ws + WS_ZB), Hb, TL, 256};
              GEMM_PHASE_EpiDft(pg8::EpiDft, ws + WS_DFTC, ws + WS_ATC, 256, 8192, 512, E); }
            GRID_SYNC();
            Wout = (const bf16_t*)(ws + WS_WFNOUT);
        } else {
            { pg8::EpiPlain E{(bf16_t*)(ws + WS_P), RWN};
              GEMM_PHASE_EpiPlain(pg8::EpiPlain, Hb, ws + WS_WRWIN, TT, RWN, 1024, E); }
            GRID_SYNC();
            RwArgs A{(const bf16_t*)(ws + WS_P), Hb, (bf16_t*)(ws + WS_Y1), (float*)(ws + WS_BZ), p.in[17], p.in[18], p.in[19], p.in[20], p.in[21], p.in[22], p.in[23], p.in[24]};
#ifndef SKIP_SCAN
            rwkv_scan(A, lds, G, bid);
#endif
#ifdef PROBE_SCAN2
            rwkv_scan(A, lds, G, bid);
#endif
            GRID_SYNC();
#ifndef SKIP_RWOUT
            rwkv_out(A, p.in[25], p.in[26], Hb, G, bid);
#endif
            GRID_SYNC();
            Wout = (const bf16_t*)(ws + WS_WRWOUT);
        }
        if constexpr (layer == 3) {
            pg8::EpiResid E{xl, xc, p.out, XC, modl + 2048, 0};
            GEMM_PHASE_EpiResid(pg8::EpiResid, Hb, Wout, TL, 1024, 1024, E);
            GRID_SYNC();
        } else {
            { pg8::EpiResid E{xl, xc, p.out, XC, modl + 2048, 0};
              GEMM_PHASE_EpiResid(pg8::EpiResid, Hb, Wout, TL, 1024, 1024, E); }
            GRID_SYNC();
            const float* gain_n = p.in[4] + (layer + 1) * 1024; const float* mod_n = mod + (size_t)(layer + 1) * 9 * 3072;
            const int nctx = 32;
            if (G > 2 * nctx) {
                if (bid < nctx) { const int G_real = G; { const int G = nctx; (void)G_real;
                    pg8::EpiResid E{xl, xc, p.out, XC, modl + 2048, TL};
                    GEMM_PHASE_EpiResid(pg8::EpiResid, Hb + (size_t)TL * 1024, Wout, TCX, 1024, 1024, E); } }
                else ph_phase(p.out, XC, gain_n, mod_n, Hb, G - nctx, bid - nctx, 0, TL);
                GRID_SYNC();
                ph_phase(p.out, XC, gain_n, mod_n, Hb, G, bid, TL, TT);
            } else {
                { pg8::EpiResid E{xl, xc, p.out, XC, modl + 2048, TL};
                  GEMM_PHASE_EpiResid(pg8::EpiResid, Hb + (size_t)TL * 1024, Wout, TCX, 1024, 1024, E); }
                GRID_SYNC();
                ph_phase(p.out, XC, gain_n, mod_n, Hb, G, bid);
            }
            GRID_SYNC();
        }
    }
__global__ void __launch_bounds__(512, 2) fwd_megakernel(Params p) {
    extern __shared__ __attribute__((aligned(16))) unsigned char lds_raw[];
    LAS char* lds = (LAS char*)lds_raw;
    cg::grid_group grid = cg::this_grid();
    const int G = gridDim.x, bid = blockIdx.x;
    volatile LAS unsigned* xst = (volatile LAS unsigned*)(lds + LDS_BYTES - 256);
    if (threadIdx.x < 2) xst[threadIdx.x] = 0u;
    __syncthreads();
    const XcdBarrier xbar = xcd_barrier_post((unsigned*)(p.ws + WS_CTL), xst);

#ifndef SKIP_PRO
    prologue(p, lds, G, bid);
#endif
#ifdef PROBE_PRO2
    __syncthreads(); prologue(p, lds, G, bid);
#endif
    grid.sync();
    layer_body<0>(p, lds, xbar, G, bid);
    layer_body<1>(p, lds, xbar, G, bid);
    layer_body<2>(p, lds, xbar, G, bid);
    layer_body<3>(p, lds, xbar, G, bid);
    final_phase(p.out, p.in[7], G, bid);
}

extern "C" void kernel_launch(void* const* d_in, const int* in_sizes, int n_in, void* d_out, int out_size, void* d_ws, size_t ws_size, hipStream_t stream) {
    static int grid = 0;
    if (grid == 0) {
        if (n_in != 28 || out_size != TL * 1024 || ws_size < WS_END) { fprintf(stderr, "kernel_launch: unexpected shapes: n_in %d out %d ws %zu\n", n_in, out_size, ws_size); grid = -1; return; }
        int dev = 0, cus = 0, per_cu = 0;
        hipGetDevice(&dev); hipDeviceGetAttribute(&cus, hipDeviceAttributeMultiprocessorCount, dev);
        if (hipFuncSetAttribute((const void*)fwd_megakernel, hipFuncAttributeMaxDynamicSharedMemorySize, LDS_BYTES) != hipSuccess) { fprintf(stderr, "kernel_launch: hipFuncSetAttribute failed\n"); grid = -1; return; }
        if (hipOccupancyMaxActiveBlocksPerMultiprocessor(&per_cu, (const void*)fwd_megakernel, 512, LDS_BYTES) != hipSuccess || per_cu < 1) { fprintf(stderr, "kernel_launch: occupancy query failed (%d)\n", per_cu); per_cu = 1; }
        (void)hipGetLastError();
        grid = cus * per_cu;
    }
    if (grid < 0) return;
    if (hipMemsetAsync((char*)d_ws + WS_CTL, 0, 65536, stream) != hipSuccess) { fprintf(stderr, "kernel_launch: hipMemsetAsync failed\n"); return; }
    Params p{};
    for (int i = 0; i < 28; ++i) p.in[i] = (const float*)d_in[i];
    p.out = (float*)d_out; p.ws = (unsigned char*)d_ws;
    void* args[] = {&p};
    hipError_t e = hipLaunchCooperativeKernel((const void*)fwd_megakernel, dim3(grid), dim3(512), args, LDS_BYTES, stream);
    if (e != hipSuccess) fprintf(stderr, "cooperative launch failed: %s (grid %d)\n", hipGetErrorString(e), grid);
}
```

```cpp
#include <hip/hip_runtime.h>
#include <hip/hip_cooperative_groups.h>
#include <cstdio>
#include <cstdint>
#include <cmath>
namespace cg = cooperative_groups;

constexpr int TL = 32768, TCX = 2048, TT = TL + TCX, DM = 1024;
constexpr float QK_C2 = 0.125f * 1.4426950408889634f;
typedef float f32x2_t __attribute__((ext_vector_type(2)));
typedef __bf16 bf16x2_t __attribute__((ext_vector_type(2)));
__device__ __forceinline__ unsigned pkbf(float lo, float hi) { f32x2_t v = {lo, hi}; bf16x2_t b = __builtin_convertvector(v, bf16x2_t); return __builtin_bit_cast(unsigned, b); }
__device__ __forceinline__ float bflo(unsigned u) { return __uint_as_float(u << 16); }
__device__ __forceinline__ float bfhi(unsigned u) { return __uint_as_float(u & 0xffff0000u); }
__device__ __forceinline__ float bf1(unsigned short u) { return __uint_as_float(((unsigned)u) << 16); }
__device__ __forceinline__ float silu_f(float z) { return z * __builtin_amdgcn_rcpf(1.f + __expf(-z)); }
__device__ __forceinline__ int opaque_tid() { int t = threadIdx.x; asm volatile("" : "+v"(t)); return t; }
namespace pg8 {
#define PG8_LAS __attribute__((address_space(3)))
typedef unsigned short bf16_t;
typedef short bf16x8 __attribute__((ext_vector_type(8)));
typedef float f32x4 __attribute__((ext_vector_type(4)));
typedef unsigned u32x4 __attribute__((ext_vector_type(4)));
constexpr int BM = 256, BK = 64, HALF = 128, HTB = HALF * BK * 2  , STAGE_BYTES = 8 * HTB, NXCD = 8, WGM = 8;

__host__ __device__ __forceinline__ int lds_byte(int r, int c) { const int st = (r >> 4) * 2 + (c >> 5), rr = r & 15, cc = c & 31, ob = rr * 64 + cc * 2; return st * 1024 + (ob ^ (((ob >> 9) & 1) << 5)); }
__host__ __device__ __forceinline__ void stage_rc(int b, int& R, int& C) { const int st = b / 1024, sb = b % 1024, swz = sb ^ (((sb >> 9) & 1) << 5); R = (st >> 1) * 16 + swz / 64; C = (st & 1) * 32 + (swz % 64) / 2; }
__host__ __device__ __forceinline__ int perm32(int rho) { const int n = rho >> 4, i = rho & 15; return 8 * (i >> 2) + 4 * n + (i & 3); }

struct Unit { int pm, pn; };
struct Gemm { const bf16_t* A; const bf16_t* Bt; int M, N, K; };

struct StaticOrder {
    int nM, nN, nwg, G, c;
    __host__ __device__ void init(int M, int N, int G_, int c_) { nM = M / BM; nN = N / BM; nwg = nM * nN; G = G_; c = c_; }
    __host__ __device__ bool next(int i, Unit& u) const {
        const long L = (long)i * G + c; if (L >= nwg) return false;
        int wgid = (int)L; { const int q = nwg / NXCD, r = nwg % NXCD, xcd = wgid % NXCD, off = wgid / NXCD; wgid = (xcd < r ? xcd * (q + 1) : r * (q + 1) + (xcd - r) * q) + off; }
        const int nig = WGM * nN, gid = wgid / nig, fm = gid * WGM, gsz = (nM - fm) < WGM ? (nM - fm) : WGM;
        u.pm = fm + ((wgid % nig) % gsz); u.pn = (wgid % nig) / gsz; return true;
    }
    __device__ __forceinline__ void a_ready(const Unit&) const {}
    __device__ __forceinline__ void done(const Unit&) const {}
};

struct EpiAttnIn {
    static constexpr bool PERM = true, AFTER_DRAIN = false;
    bf16_t* Q; bf16_t* Kb; bf16_t* V; bf16_t* Z; const PG8_LAS float* ropeC; const PG8_LAS float* ropeS;
    __device__ __forceinline__ void operator()(const f32x4 (&acc)[2][2][4][2], const Unit& u, int wr, int wc, int fr, int fq) const {
        const int sect = u.pn >> 2;
        bf16_t* base = sect == 0 ? Q : sect == 1 ? Kb : sect == 2 ? V : Z;
        const int colt = (u.pn & 3) * 256 + wc * 32 + 8 * fq;
        const int row0 = u.pm * BM + wr * 64 + fr;
        const bool rope = (u.pm < 128) && (sect < 2);
        const float sc = (sect == 0) ? QK_C2 : 1.f;
        const int axis = wc & 1;
#pragma unroll
        for (int ai = 0; ai < 2; ++ai)
#pragma unroll
            for (int m = 0; m < 4; ++m) {
                const int row = row0 + ai * HALF + m * 16;
                const int ntok = row & 4095;
                const int pos = axis ? (ntok & 63) : (ntok >> 6);
                bf16_t* rowp;
                if (sect == 1) rowp = base + (size_t)(row >> 6) * 65536 + (size_t)(colt >> 3) * 512 + (row & 63) * 8;
                else if (sect == 2) rowp = base + (size_t)(row >> 6) * 65536 + (size_t)(colt >> 7) * 8192 + (((colt & 127) >> 5) * 4 + ((row & 63) >> 4)) * 512 + (row & 15) * 32 + (colt & 31);
                else rowp = base + (size_t)row * 1024 + colt;
#pragma unroll
                for (int bj = 0; bj < 2; ++bj) {
                    f32x4 v0 = acc[ai][bj][m][0], v1 = acc[ai][bj][m][1];
                    if (rope) {
                        const f32x4 c0 = *(const PG8_LAS f32x4*)(ropeC + pos * 16 + 8 * (fq & 1)), c1 = *(const PG8_LAS f32x4*)(ropeC + pos * 16 + 8 * (fq & 1) + 4);
                        const f32x4 s0 = *(const PG8_LAS f32x4*)(ropeS + pos * 16 + 8 * (fq & 1)), s1 = *(const PG8_LAS f32x4*)(ropeS + pos * 16 + 8 * (fq & 1) + 4);
                        f32x4 p0, p1;
#pragma unroll
                        for (int i = 0; i < 4; ++i) { p0[i] = __shfl_xor(v0[i], 32); p1[i] = __shfl_xor(v1[i], 32); }
                        if (fq < 2) { v0 = v0 * c0 - p0 * s0; v1 = v1 * c1 - p1 * s1; }
                        else        { v0 = v0 * c0 + p0 * s0; v1 = v1 * c1 + p1 * s1; }
                    }
                    v0 = v0 * sc; v1 = v1 * sc;
                    u32x4 w; w.x = pkbf(v0[0], v0[1]); w.y = pkbf(v0[2], v0[3]); w.z = pkbf(v1[0], v1[1]); w.w = pkbf(v1[2], v1[3]);
                    *(u32x4*)(rowp + (sect == 1 || sect == 2 ? bj * 8192 : bj * HALF)) = w;
                }
            }
    }
};
struct EpiPlain {
    static constexpr bool PERM = true, AFTER_DRAIN = false;
    bf16_t* O; int ldc;
    __device__ __forceinline__ void operator()(const f32x4 (&acc)[2][2][4][2], const Unit& u, int wr, int wc, int fr, int fq) const {
        const int row0 = u.pm * BM + wr * 64 + fr, col0 = u.pn * BM + wc * 32 + 8 * fq;
#pragma unroll
        for (int ai = 0; ai < 2; ++ai)
#pragma unroll
            for (int m = 0; m < 4; ++m) { bf16_t* rowp = O + (size_t)(row0 + ai * HALF + m * 16) * ldc + col0;
#pragma unroll
                for (int bj = 0; bj < 2; ++bj) { const f32x4 v0 = acc[ai][bj][m][0], v1 = acc[ai][bj][m][1];
                    u32x4 w; w.x = pkbf(v0[0], v0[1]); w.y = pkbf(v0[2], v0[3]); w.z = pkbf(v1[0], v1[1]); w.w = pkbf(v1[2], v1[3]);
                    *(u32x4*)(rowp + bj * HALF) = w; } }
    }
};
struct EpiResid {
    static constexpr bool PERM = false, AFTER_DRAIN = false;
    const float* xin_lat; const float* xin_ctx; float* xout_lat; float* xout_ctx; const float* gate; int row_off;
    __device__ __forceinline__ void operator()(const f32x4 (&acc)[2][2][4][2], const Unit& u, int wr, int wc, int fr, int fq) const {
        const int rowt = row_off + u.pm * BM; const bool lat = rowt < TL; const int r = lat ? (rowt >> 12) : 8;
        const int row0 = rowt + wr * 64 + fr, col0 = u.pn * BM + wc * 32 + 4 * fq;
        const float* xi = lat ? xin_lat + (size_t)row0 * 1024 + col0 : xin_ctx + (size_t)(row0 - TL) * 1024 + col0;
        float* xo = lat ? xout_lat + (size_t)row0 * 1024 + col0 : xout_ctx + (size_t)(row0 - TL) * 1024 + col0;
        f32x4 g[2][2];
#pragma unroll
        for (int bj = 0; bj < 2; ++bj)
#pragma unroll
            for (int n = 0; n < 2; ++n) g[bj][n] = *(const f32x4*)(gate + r * 3072 + col0 + bj * HALF + n * 16);
#pragma unroll
        for (int ai = 0; ai < 2; ++ai) {
            f32x4 pre[4][2][2];
#pragma unroll
            for (int m = 0; m < 4; ++m)
#pragma unroll
                for (int bj = 0; bj < 2; ++bj)
#pragma unroll
                    for (int n = 0; n < 2; ++n) pre[m][bj][n] = *(const f32x4*)(xi + (size_t)(ai * HALF + m * 16) * 1024 + bj * HALF + n * 16);
            asm volatile("" ::: "memory");
#pragma unroll
            for (int m = 0; m < 4; ++m)
#pragma unroll
                for (int bj = 0; bj < 2; ++bj)
#pragma unroll
                    for (int n = 0; n < 2; ++n) *(f32x4*)(xo + (size_t)(ai * HALF + m * 16) * 1024 + bj * HALF + n * 16) = pre[m][bj][n] + g[bj][n] * acc[ai][bj][m][n];
            asm volatile("" ::: "memory");
        }
    }
};
struct EpiFnT {
    static constexpr bool PERM = true, AFTER_DRAIN = false;
    bf16_t* ATL; bf16_t* ATC;
    __device__ __forceinline__ void operator()(const f32x4 (&acc)[2][2][4][2], const Unit& u, int wr, int wc, int fr, int fq) const {
        const int row0 = u.pm * BM + wr * 64 + fr, col0 = u.pn * BM + wc * 32 + 8 * fq;
#pragma unroll
        for (int ai = 0; ai < 2; ++ai)
#pragma unroll
            for (int m = 0; m < 4; ++m) { const int mp = row0 + ai * HALF + m * 16, cs = mp >> 10, n = mp & 1023;
#pragma unroll
                for (int bj = 0; bj < 2; ++bj) { const int t0 = col0 + bj * HALF; bf16_t* dst;
                    if (t0 < TL) { const int b = t0 >> 12, l = t0 & 4095; dst = ATL + ((size_t)((b * 1024 + n) * 2 + cs)) * 4096 + l; }
                    else { const int tc = t0 - TL, b = tc >> 8, l = tc & 255; dst = ATC + ((size_t)((b * 1024 + n) * 2 + cs)) * 256 + l; }
                    const f32x4 v0 = acc[ai][bj][m][0], v1 = acc[ai][bj][m][1];
                    u32x4 w; w.x = pkbf(v0[0], v0[1]); w.y = pkbf(v0[2], v0[3]); w.z = pkbf(v1[0], v1[1]); w.w = pkbf(v1[2], v1[3]);
                    *(u32x4*)dst = w; } }
    }
};
struct EpiDft {
    static constexpr bool PERM = true, AFTER_DRAIN = false;
    const bf16_t* Z; bf16_t* OG; int rowbase; int L;
    __device__ __forceinline__ void operator()(const f32x4 (&acc)[2][2][4][2], const Unit& u, int wr, int wc, int fr, int fq) const {
        const int k0 = u.pm * BM + wr * 64 + fr; const int b = u.pn >> 2; const int n0 = (u.pn & 3) * 256 + wc * 32 + 8 * fq;
#pragma unroll
        for (int ai = 0; ai < 2; ++ai)
#pragma unroll
            for (int m = 0; m < 4; ++m) { const size_t R = (size_t)(rowbase + b * L + k0 + ai * HALF + m * 16);
#pragma unroll
                for (int bj = 0; bj < 2; ++bj) { const size_t off = R * 1024 + n0 + bj * HALF;
                    const u32x4 zz = *(const u32x4*)(Z + off);
                    const f32x4 v0 = acc[ai][bj][m][0], v1 = acc[ai][bj][m][1];
                    u32x4 w;
                    w.x = pkbf(v0[0] * silu_f(bflo(zz.x)), v0[1] * silu_f(bfhi(zz.x))); w.y = pkbf(v0[2] * silu_f(bflo(zz.y)), v0[3] * silu_f(bfhi(zz.y)));
                    w.z = pkbf(v1[0] * silu_f(bflo(zz.z)), v1[1] * silu_f(bfhi(zz.z))); w.w = pkbf(v1[2] * silu_f(bflo(zz.w)), v1[3] * silu_f(bfhi(zz.w)));
                    *(u32x4*)(OG + off) = w; } }
    }
};
struct EpiDftSym {
    static constexpr bool PERM = true, AFTER_DRAIN = false;
    const bf16_t* Pb; const float* TA; const bf16_t* Z; bf16_t* OG;
    __device__ __forceinline__ void operator()(const f32x4 (&acc)[2][2][4][2], const Unit& u, int wr, int wc, int fr, int fq) const {
        const int k0 = u.pm * BM + wr * 64 + fr; const int b = u.pn >> 2; const int c0 = u.pn * BM + wc * 32 + 8 * fq; const int n0 = c0 & 1023;
#pragma unroll
        for (int bj = 0; bj < 2; ++bj) {
            const f32x4 t0 = *(const f32x4*)(TA + c0 + bj * HALF), t1 = *(const f32x4*)(TA + c0 + bj * HALF + 4);
#pragma unroll
            for (int aim = 0; aim < 4; ++aim) { const int ai = aim >> 1, mh = (aim & 1) * 2;
                u32x4 pp[4], z1[4], z2[4];
#pragma unroll
                for (int m = mh; m < mh + 2; ++m) { const int k = k0 + ai * HALF + m * 16;
                    pp[m] = *(const u32x4*)(Pb + (size_t)k * 8192 + c0 + bj * HALF);
                    z1[m] = *(const u32x4*)(Z + (size_t)(b * 4096 + k) * 1024 + n0 + bj * HALF);
                    z2[m] = *(const u32x4*)(Z + (size_t)(b * 4096 + ((4096 - k) & 4095)) * 1024 + n0 + bj * HALF); }
                asm volatile("" ::: "memory");
#pragma unroll
                for (int m = mh; m < mh + 2; ++m) { const int k = k0 + ai * HALF + m * 16; const float sg = (k & 1) ? -1.f : 1.f;
                    const f32x4 q0 = acc[ai][bj][m][0], q1 = acc[ai][bj][m][1];
                    float pt[8];
                    pt[0] = bflo(pp[m].x) + sg * t0[0]; pt[1] = bfhi(pp[m].x) + sg * t0[1]; pt[2] = bflo(pp[m].y) + sg * t0[2]; pt[3] = bfhi(pp[m].y) + sg * t0[3];
                    pt[4] = bflo(pp[m].z) + sg * t1[0]; pt[5] = bfhi(pp[m].z) + sg * t1[1]; pt[6] = bflo(pp[m].w) + sg * t1[2]; pt[7] = bfhi(pp[m].w) + sg * t1[3];
                    { const size_t off = (size_t)(b * 4096 + k) * 1024 + n0 + bj * HALF; const u32x4 zz = z1[m]; u32x4 w;
                      w.x = pkbf((pt[0] - q0[0]) * silu_f(bflo(zz.x)), (pt[1] - q0[1]) * silu_f(bfhi(zz.x))); w.y = pkbf((pt[2] - q0[2]) * silu_f(bflo(zz.y)), (pt[3] - q0[3]) * silu_f(bfhi(zz.y)));
                      w.z = pkbf((pt[4] - q1[0]) * silu_f(bflo(zz.z)), (pt[5] - q1[1]) * silu_f(bfhi(zz.z))); w.w = pkbf((pt[6] - q1[2]) * silu_f(bflo(zz.w)), (pt[7] - q1[3]) * silu_f(bfhi(zz.w)));
                      *(u32x4*)(OG + off) = w; }
                    if (k >= 1) { const size_t off = (size_t)(b * 4096 + 4096 - k) * 1024 + n0 + bj * HALF; const u32x4 zz = z2[m]; u32x4 w;
                      w.x = pkbf((pt[0] + q0[0]) * silu_f(bflo(zz.x)), (pt[1] + q0[1]) * silu_f(bfhi(zz.x))); w.y = pkbf((pt[2] + q0[2]) * silu_f(bflo(zz.y)), (pt[3] + q0[3]) * silu_f(bfhi(zz.y)));
                      w.z = pkbf((pt[4] + q1[0]) * silu_f(bflo(zz.z)), (pt[5] + q1[1]) * silu_f(bfhi(zz.z))); w.w = pkbf((pt[6] + q1[2]) * silu_f(bflo(zz.w)), (pt[7] + q1[3]) * silu_f(bfhi(zz.w)));
                      *(u32x4*)(OG + off) = w; }
                }
                asm volatile("" ::: "memory");
            }
        }
    }
};
template <class Epi, class Sched, bool ALIGN_EPI = false, bool SP2 = false>
__device__ __forceinline__ void gemm_phase(PG8_LAS unsigned char* lds, const Gemm g, const Sched& S, const Epi& E) {
    const int tid = opaque_tid(), wid = __builtin_amdgcn_readfirstlane(tid >> 6), lane = tid & 63, wr = wid >> 2, wc = wid & 3, fr = lane & 15, fq = lane >> 4;
    const int K = g.K, nt = K / BK;
    unsigned voffA[2], voffB[2];
#pragma unroll
    for (int i = 0; i < 2; ++i) { int R, C; stage_rc(tid * 16 + i * 8192, R, C); const int Rb = Epi::PERM ? ((R & ~31) + perm32(R & 31)) : R;
        voffA[i] = (unsigned)(R * K + C) * 2u; voffB[i] = (unsigned)(Rb * K + C) * 2u; }
    const size_t kstep = (size_t)(BK * 2);
    const size_t hstep = (size_t)HALF * K * 2;
    const size_t tstep = 2 * hstep;
    const unsigned ldsw = (unsigned)wid * 1024u;
    const int aoff = lds_byte(wr * 64 + fr, fq * 8), boff = lds_byte(wc * 32 + fr, fq * 8);
#define PG8_SA(b, h) (((b) * 2 + (h)) * HTB)
#define PG8_SB(b, h) ((4 + (b) * 2 + (h)) * HTB)
#define PG8_STAGE(bufoff, gbase, voff) do { _Pragma("unroll") for (int _i = 0; _i < 2; ++_i) \
        __builtin_amdgcn_global_load_lds((const unsigned*)((const char*)(gbase) + (voff)[_i]), (PG8_LAS unsigned*)(lds + (bufoff) + ldsw + _i * 8192), 16, 0, 0); } while (0)
#define PG8_LDA(dst, b, h) do { _Pragma("unroll") for (int m = 0; m < 4; ++m) _Pragma("unroll") for (int k = 0; k < 2; ++k) dst[m][k] = *(const PG8_LAS bf16x8*)(lds + PG8_SA(b, h) + aoff + m * 2048 + k * 1024); } while (0)
#define PG8_LDB(dst, b, h) do { _Pragma("unroll") for (int n = 0; n < 2; ++n) _Pragma("unroll") for (int k = 0; k < 2; ++k) dst[n][k] = *(const PG8_LAS bf16x8*)(lds + PG8_SB(b, h) + boff + n * 2048 + k * 1024); } while (0)
#define PG8_MMA(ai, bj, At, Bt) do { __builtin_amdgcn_s_setprio(1); _Pragma("unroll") for (int m = 0; m < 4; ++m) _Pragma("unroll") for (int n = 0; n < 2; ++n) _Pragma("unroll") for (int k = 0; k < 2; ++k) \
        acc[ai][bj][m][n] = __builtin_amdgcn_mfma_f32_16x16x32_bf16(Bt[n][k], At[m][k], acc[ai][bj][m][n], 0, 0, 0); __builtin_amdgcn_s_setprio(0); } while (0)
#define PG8_WAIT_V(n) asm volatile("s_waitcnt vmcnt(" #n ")" ::: "memory")
#define PG8_WAIT_L(n) asm volatile("s_waitcnt lgkmcnt(" #n ")" ::: "memory")
#define PG8_BAR __builtin_amdgcn_s_barrier()
#define PG8_SCHED __builtin_amdgcn_sched_barrier(0)
    Unit cur, nxt; int ui = 0;
    if (!S.next(0, cur)) return;
    f32x4 acc[2][2][4][2];
#pragma unroll
    for (int a = 0; a < 2; ++a)
#pragma unroll
        for (int b = 0; b < 2; ++b)
#pragma unroll
            for (int m = 0; m < 4; ++m)
#pragma unroll
                for (int n = 0; n < 2; ++n) acc[a][b][m][n] = (f32x4){0.f, 0.f, 0.f, 0.f};
    bf16x8 At[4][2], B0[2][2], B1[2][2];
    const char* cA = (const char*)g.A + (size_t)cur.pm * tstep; const char* cB = (const char*)g.Bt + (size_t)cur.pn * tstep;
    S.a_ready(cur);
    if constexpr (SP2) {
        PG8_STAGE(PG8_SB(0, 0), cB, voffB); PG8_STAGE(PG8_SB(0, 1), cB + hstep, voffB); PG8_STAGE(PG8_SA(0, 0), cA, voffA); PG8_STAGE(PG8_SA(0, 1), cA + hstep, voffA);
        if (wr == 1) PG8_BAR;
        PG8_WAIT_V(2); PG8_BAR;
        PG8_STAGE(PG8_SB(1, 0), cB + kstep, voffB); PG8_STAGE(PG8_SA(1, 0), cA + kstep, voffA); PG8_STAGE(PG8_SB(1, 1), cB + hstep + kstep, voffB);
        PG8_WAIT_V(6); PG8_BAR;
    } else {
        PG8_STAGE(PG8_SB(0, 0), cB, voffB); PG8_STAGE(PG8_SA(0, 0), cA, voffA); PG8_STAGE(PG8_SB(0, 1), cB + hstep, voffB); PG8_STAGE(PG8_SA(0, 1), cA + hstep, voffA);
        if (wr == 1) PG8_BAR;
        PG8_WAIT_V(4); PG8_BAR;
        PG8_STAGE(PG8_SB(1, 0), cB + kstep, voffB); PG8_STAGE(PG8_SA(1, 0), cA + kstep, voffA); PG8_STAGE(PG8_SB(1, 1), cB + hstep + kstep, voffB);
        PG8_WAIT_V(6); PG8_BAR;
    }
    for (;;) {
        const bool has_next = S.next(ui + 1, nxt);
        const char* nA = has_next ? (const char*)g.A + (size_t)nxt.pm * tstep : cA; const char* nB = has_next ? (const char*)g.Bt + (size_t)nxt.pn * tstep : cB;
        for (int t = 0; t < nt; t += 2) {
            const bool last = (t == nt - 2);
            const char* a1 = cA + (size_t)(t + 1) * kstep;
            const char* a2 = last ? nA : cA + (size_t)(t + 2) * kstep; const char* b2 = last ? nB : cB + (size_t)(t + 2) * kstep;
            const char* a3 = a2 + kstep; const char* b3 = b2 + kstep;
            if (last && has_next) S.a_ready(nxt);
            if constexpr (SP2) {
            PG8_LDB(B0, 0, 0); PG8_LDB(B1, 0, 1); PG8_SCHED; PG8_LDA(At, 0, 0); PG8_STAGE(PG8_SA(1, 1), a1 + hstep, voffA);
            PG8_WAIT_V(8); PG8_WAIT_L(0); PG8_BAR; PG8_MMA(0, 0, At, B0); PG8_MMA(0, 1, At, B1); PG8_BAR; PG8_SCHED;
            PG8_LDA(At, 0, 1); PG8_STAGE(PG8_SB(0, 0), b2, voffB); PG8_STAGE(PG8_SB(0, 1), b2 + hstep, voffB); PG8_STAGE(PG8_SA(0, 0), a2, voffA);
            PG8_WAIT_V(8); PG8_WAIT_L(0); PG8_BAR; PG8_MMA(1, 0, At, B0); PG8_MMA(1, 1, At, B1); PG8_BAR; PG8_SCHED;
            PG8_LDB(B0, 1, 0); PG8_LDB(B1, 1, 1); PG8_SCHED; PG8_LDA(At, 1, 0); PG8_STAGE(PG8_SA(0, 1), a2 + hstep, voffA);
            PG8_WAIT_V(8); PG8_WAIT_L(0); PG8_BAR; PG8_MMA(0, 0, At, B0); PG8_MMA(0, 1, At, B1); PG8_BAR; PG8_SCHED;
            PG8_LDA(At, 1, 1); PG8_STAGE(PG8_SB(1, 0), b3, voffB); PG8_STAGE(PG8_SB(1, 1), b3 + hstep, voffB); PG8_STAGE(PG8_SA(1, 0), a3, voffA);
            PG8_WAIT_V(8); PG8_WAIT_L(0); PG8_BAR; PG8_MMA(1, 0, At, B0); PG8_MMA(1, 1, At, B1); PG8_BAR; PG8_SCHED;
            } else {
            PG8_LDB(B0, 0, 0); PG8_SCHED; PG8_LDA(At, 0, 0); PG8_STAGE(PG8_SA(1, 1), a1 + hstep, voffA);
            PG8_WAIT_L(8); PG8_BAR; PG8_WAIT_L(0); PG8_MMA(0, 0, At, B0); PG8_BAR; PG8_SCHED;
            PG8_LDB(B1, 0, 1); PG8_STAGE(PG8_SB(0, 0), b2, voffB);
            PG8_BAR; PG8_WAIT_L(0); PG8_MMA(0, 1, At, B1); PG8_BAR;
            PG8_LDA(At, 0, 1); PG8_STAGE(PG8_SA(0, 0), a2, voffA);
            PG8_BAR; PG8_WAIT_L(0); PG8_MMA(1, 0, At, B0); PG8_BAR; PG8_SCHED;
            PG8_STAGE(PG8_SB(0, 1), b2 + hstep, voffB);
            PG8_WAIT_V(6); PG8_BAR; PG8_MMA(1, 1, At, B1); PG8_BAR;
            PG8_LDB(B0, 1, 0); PG8_SCHED; PG8_LDA(At, 1, 0); PG8_STAGE(PG8_SA(0, 1), a2 + hstep, voffA);
            PG8_WAIT_L(8); PG8_BAR; PG8_WAIT_L(0); PG8_MMA(0, 0, At, B0); PG8_BAR; PG8_SCHED;
            PG8_LDB(B1, 1, 1); PG8_STAGE(PG8_SB(1, 0), b3, voffB);
            PG8_BAR; PG8_WAIT_L(0); PG8_MMA(0, 1, At, B1); PG8_BAR;
            PG8_LDA(At, 1, 1); PG8_STAGE(PG8_SA(1, 0), a3, voffA);
            PG8_BAR; PG8_WAIT_L(0); PG8_MMA(1, 0, At, B0); PG8_BAR; PG8_SCHED;
            PG8_STAGE(PG8_SB(1, 1), b3 + hstep, voffB);
            PG8_WAIT_V(6); PG8_BAR; PG8_MMA(1, 1, At, B1); PG8_BAR;
            }
        }
        if constexpr (ALIGN_EPI) { if (wr == 0) PG8_BAR; }
        if constexpr (!Epi::AFTER_DRAIN) { E(acc, cur, wr, wc, fr, fq); S.done(cur); }
        if (!has_next) break;
#pragma unroll
        for (int a = 0; a < 2; ++a)
#pragma unroll
            for (int b = 0; b < 2; ++b)
#pragma unroll
                for (int m = 0; m < 4; ++m)
#pragma unroll
                    for (int n = 0; n < 2; ++n) acc[a][b][m][n] = (f32x4){0.f, 0.f, 0.f, 0.f};
        cur = nxt; cA = nA; cB = nB; ++ui;
        if constexpr (ALIGN_EPI) { if (wr == 1) PG8_BAR; }
    }
    PG8_WAIT_V(0);
    if constexpr (!ALIGN_EPI) { if (wr == 0) PG8_BAR; }
    PG8_BAR;
    if constexpr (Epi::AFTER_DRAIN) { E.fused(acc, cur, wr, wc, fr, fq, lds, wid, lane); S.done(cur); }
#undef PG8_SA
#undef PG8_SB
#undef PG8_STAGE
#undef PG8_LDA
#undef PG8_LDB
#undef PG8_MMA
#undef PG8_WAIT_V
#undef PG8_WAIT_L
#undef PG8_BAR
#undef PG8_SCHED
}
}
#define LAS __attribute__((address_space(3)))
namespace att {
using bf16x8 = __attribute__((ext_vector_type(8))) short;
using s16x4 = __attribute__((ext_vector_type(4))) short;
using f32x16 = __attribute__((ext_vector_type(16))) float;
using u32x4 = __attribute__((ext_vector_type(4))) unsigned;
typedef unsigned short bf16_t;
__device__ __forceinline__ int crow(int r, int hi) { return (r & 3) + 8 * (r >> 2) + 4 * hi; }
typedef float f32x4_t __attribute__((ext_vector_type(4)));
template <int CTRL> __device__ __forceinline__ float adpp(float v) { return __int_as_float(__builtin_amdgcn_update_dpp(0, __float_as_int(v), CTRL, 0xf, 0xf, true)); }
constexpr int KSLOT = 8192, VSLOT = 16384, LDS_K = 0, LDS_V = 3 * KSLOT, LDS_WS = LDS_V + 4 * VSLOT, LDS_CNT = LDS_WS + 2048;
struct Args { const bf16_t* Q; const bf16_t* K; const bf16_t* V; const bf16_t* Z; bf16_t* O; const float* gain; float lam; float oml; int n_units; unsigned* o1g; };

__device__ __forceinline__ void qkt(f32x16& p0, f32x16& p1, const LAS char* Kslot, const bf16x8* qr, const f32x16& negm, int r32, int hi) {
    const LAS char* kb = Kslot + hi * 1024 + r32 * 16;
    bf16x8 kf[8];
#pragma unroll
    for (int d0 = 0; d0 < 4; ++d0) { kf[2 * d0] = *(const LAS bf16x8*)(kb + d0 * 2048); kf[2 * d0 + 1] = *(const LAS bf16x8*)(kb + d0 * 2048 + 512); }
    asm volatile("s_waitcnt lgkmcnt(0)" ::: "memory"); __builtin_amdgcn_sched_barrier(0);
    p0 = __builtin_amdgcn_mfma_f32_32x32x16_bf16(kf[0], qr[0], negm, 0, 0, 0); p1 = __builtin_amdgcn_mfma_f32_32x32x16_bf16(kf[1], qr[0], negm, 0, 0, 0);
#pragma unroll
    for (int d0 = 1; d0 < 4; ++d0) { p0 = __builtin_amdgcn_mfma_f32_32x32x16_bf16(kf[2 * d0], qr[d0], p0, 0, 0, 0); p1 = __builtin_amdgcn_mfma_f32_32x32x16_bf16(kf[2 * d0 + 1], qr[d0], p1, 0, 0, 0); }
}
__device__ __forceinline__ void kload(bf16x8* kf, const LAS char* Kslot, int r32, int hi) {
    const LAS char* kb = Kslot + hi * 1024 + r32 * 16;
#pragma unroll
    for (int d0 = 0; d0 < 2; ++d0) { kf[2 * d0] = *(const LAS bf16x8*)(kb + d0 * 2048); kf[2 * d0 + 1] = *(const LAS bf16x8*)(kb + d0 * 2048 + 512); }
}
__device__ __forceinline__ void qk_mm(f32x16& p0, f32x16& p1, const bf16x8* kf, const LAS char* Kslot, int r32, int hi, const bf16x8* qr, const f32x16& z) {
    const LAS char* kb = Kslot + hi * 1024 + r32 * 16;
    p0 = __builtin_amdgcn_mfma_f32_32x32x16_bf16(kf[0], qr[0], z, 0, 0, 0); p1 = __builtin_amdgcn_mfma_f32_32x32x16_bf16(kf[1], qr[0], z, 0, 0, 0);
    p0 = __builtin_amdgcn_mfma_f32_32x32x16_bf16(kf[2], qr[1], p0, 0, 0, 0); p1 = __builtin_amdgcn_mfma_f32_32x32x16_bf16(kf[3], qr[1], p1, 0, 0, 0);
    bf16x8 kg[4];
#pragma unroll
    for (int d0 = 2; d0 < 4; ++d0) { kg[2 * (d0 - 2)] = *(const LAS bf16x8*)(kb + d0 * 2048); kg[2 * (d0 - 2) + 1] = *(const LAS bf16x8*)(kb + d0 * 2048 + 512); }
    p0 = __builtin_amdgcn_mfma_f32_32x32x16_bf16(kg[0], qr[2], p0, 0, 0, 0); p1 = __builtin_amdgcn_mfma_f32_32x32x16_bf16(kg[1], qr[2], p1, 0, 0, 0);
    p0 = __builtin_amdgcn_mfma_f32_32x32x16_bf16(kg[2], qr[3], p0, 0, 0, 0); p1 = __builtin_amdgcn_mfma_f32_32x32x16_bf16(kg[3], qr[3], p1, 0, 0, 0);
}
__device__ __forceinline__ float max3a(float a, float b, float c) { float r; asm("v_max3_f32 %0, %1, %2, %3" : "=v"(r) : "v"(a), "v"(b), "v"(c)); return r; }
__device__ __forceinline__ float rowmax(const f32x16& p0, const f32x16& p1) {
    float a = max3a(p0[0], p0[1], p0[2]), b = max3a(p1[0], p1[1], p1[2]);
#pragma unroll
    for (int r = 3; r < 15; r += 2) { a = max3a(a, p0[r], p0[r + 1]); b = max3a(b, p1[r], p1[r + 1]); }
    a = max3a(a, p0[15], p1[15]);
    float m; asm("v_max_f32 %0, %1, %2" : "=v"(m) : "v"(a), "v"(b));
    asm volatile("s_nop 1" ::: "memory");
    auto rr = __builtin_amdgcn_permlane32_swap(__float_as_uint(m), __float_as_uint(m), false, false);
    float o; asm("v_max_f32 %0, %1, %2" : "=v"(o) : "v"(__uint_as_float(rr[0])), "v"(__uint_as_float(rr[1])));
    return o;
}
#define ATT_VRD(buf, d0) do { _Pragma("unroll") for (int ks = 0; ks < 4; ++ks) { \
        asm volatile("ds_read_b64_tr_b16 %0,%1 offset:%c2" : "=&v"(lo[buf][ks]) : "v"(vb), "i"((d0) * 4096 + ks * 1024) : "memory"); \
        asm volatile("ds_read_b64_tr_b16 %0,%1 offset:%c2" : "=&v"(hi[buf][ks]) : "v"(vb), "i"((d0) * 4096 + ks * 1024 + 512) : "memory"); } } while (0)
#define ATT_PK(b, k) (bf16x8){lo[b][k][0], lo[b][k][1], lo[b][k][2], lo[b][k][3], hi[b][k][0], hi[b][k][1], hi[b][k][2], hi[b][k][3]}
#define ATT_MM2(da, db) do { \
        o[da] = __builtin_amdgcn_mfma_f32_32x32x16_bf16(pa0, ATT_PK(0, 0), o[da], 0, 0, 0); o[db] = __builtin_amdgcn_mfma_f32_32x32x16_bf16(pa0, ATT_PK(1, 0), o[db], 0, 0, 0); \
        o[da] = __builtin_amdgcn_mfma_f32_32x32x16_bf16(pa1, ATT_PK(0, 1), o[da], 0, 0, 0); o[db] = __builtin_amdgcn_mfma_f32_32x32x16_bf16(pa1, ATT_PK(1, 1), o[db], 0, 0, 0); \
        o[da] = __builtin_amdgcn_mfma_f32_32x32x16_bf16(pa2, ATT_PK(0, 2), o[da], 0, 0, 0); o[db] = __builtin_amdgcn_mfma_f32_32x32x16_bf16(pa2, ATT_PK(1, 2), o[db], 0, 0, 0); \
        o[da] = __builtin_amdgcn_mfma_f32_32x32x16_bf16(pa3, ATT_PK(0, 3), o[da], 0, 0, 0); o[db] = __builtin_amdgcn_mfma_f32_32x32x16_bf16(pa3, ATT_PK(1, 3), o[db], 0, 0, 0); } while (0)
__device__ __forceinline__ void pv(f32x16* o, int vb, bf16x8 pa0, bf16x8 pa1, bf16x8 pa2, bf16x8 pa3) {
    s16x4 lo[2][4], hi[2][4];
    ATT_VRD(0, 0);
    ATT_VRD(1, 1);
    asm volatile("s_waitcnt lgkmcnt(0)" ::: "memory"); __builtin_amdgcn_sched_barrier(0);
    ATT_MM2(0, 1); __builtin_amdgcn_sched_barrier(0);
    ATT_VRD(0, 2);
    ATT_VRD(1, 3);
    asm volatile("s_waitcnt lgkmcnt(0)" ::: "memory"); __builtin_amdgcn_sched_barrier(0);
    ATT_MM2(2, 3);
}
#undef ATT_MM2
#undef ATT_VRD
#undef ATT_PK
__device__ __forceinline__ void attn_pass(const Args& A, int z, int b, int h, int qrow0, bool isctx, bool pathB, LAS char* shm, f32x16* o) {
    const int tid = opaque_tid(), lane = tid & 63, r32 = lane & 31, hi = lane >> 5; const int wid = __builtin_amdgcn_readfirstlane(tid >> 6);
    const int NT = isctx ? 4 : 68;
    LAS float* wsf = (LAS float*)(shm + LDS_WS) + wid * 64;
    const int vb0 = (int)(unsigned)(size_t)(shm + LDS_V) + ((lane >> 4) & 1) * 32 + (lane & 3) * 8 + (4 * hi + ((lane & 15) >> 2)) * 64;
    const bf16_t* Qw = A.Q + (size_t)(qrow0 + wid * 32 + r32) * 1024 + h * 128 + z * 64;
    bf16x8 qr[4];
#pragma unroll
    for (int d0 = 0; d0 < 4; ++d0) qr[d0] = *(const bf16x8*)(Qw + d0 * 16 + hi * 8);
    const bf16_t* Kh = A.K + (size_t)((h * 2 + z) * 8 + wid) * 512 + lane * 8;
    const int pc0 = wid, pc1 = wid + 8;
    const bf16_t* Vh0 = A.V + (size_t)h * 8192 + pc0 * 512 + lane * 8;
    const bf16_t* Vh1 = A.V + (size_t)h * 8192 + pc1 * 512 + lane * 8;
    const int ctxrow = TL + b * 256, latrow = b * 4096;
#define ATT_TROW(t) ((isctx || (t) < 4) ? (ctxrow + 64 * (t)) : (latrow + 64 * ((t) - 4)))
#define ATT_DMA(t, slot, vslot) do { const size_t ro_ = (size_t)(ATT_TROW(t) >> 6) * 65536; \
        __builtin_amdgcn_global_load_lds((const unsigned*)(Kh + ro_), (LAS unsigned*)(shm + LDS_K + (slot) * KSLOT + wid * 1024), 16, 0, 0); \
        __builtin_amdgcn_global_load_lds((const unsigned*)(Vh0 + ro_), (LAS unsigned*)(shm + LDS_V + (vslot) * VSLOT + pc0 * 1024), 16, 0, 0); \
        __builtin_amdgcn_global_load_lds((const unsigned*)(Vh1 + ro_), (LAS unsigned*)(shm + LDS_V + (vslot) * VSLOT + pc1 * 1024), 16, 0, 0); } while (0)
    float mhat = 0.f, l_reg = 0.f;
    const f32x16 negm = f32x16{};
#pragma unroll
    for (int d = 0; d < 4; ++d) o[d] = f32x16{};
    ATT_DMA(0, 0, 0);
    if (NT > 1) ATT_DMA(1, 1, 1);
    asm volatile("s_waitcnt vmcnt(0) lgkmcnt(0)\n\ts_barrier" ::: "memory");
    f32x16 sc0, sc1;
    { bf16x8 kf[4]; kload(kf, shm + LDS_K, r32, hi); qk_mm(sc0, sc1, kf, shm + LDS_K, r32, hi, qr, negm); asm volatile("s_nop 15\n\ts_nop 15" : "+v"(sc0), "+v"(sc1)); }
    if (NT > 2) ATT_DMA(2, 2, 2);
    int k_cur = 0, v_cur = 0, v_prev = 3;
    u32x4 pw0 = {0u, 0u, 0u, 0u}, pw1 = pw0, pw2 = pw0, pw3 = pw0;
#pragma unroll 1
    for (int t = 0; t <= NT; ++t) {
        const int k_n1 = (k_cur == 2) ? 0 : k_cur + 1;
        if (t > 0) {
            asm volatile("s_waitcnt vmcnt(0) lgkmcnt(0)\n\ts_barrier" ::: "memory");
            const int k_p2 = (k_cur == 0) ? 2 : k_cur - 1;
            const int v_p2 = (v_cur + 2) & 3;
            if (t + 2 < NT) ATT_DMA(t + 2, k_p2, v_p2);
        }
        if (pathB && t > 0) {
            pv(o, vb0 + v_prev * VSLOT, __builtin_bit_cast(bf16x8, pw0), __builtin_bit_cast(bf16x8, pw1), __builtin_bit_cast(bf16x8, pw2), __builtin_bit_cast(bf16x8, pw3)); }
        if (t < NT) {
        const float rm = rowmax(sc0, sc1);
        if (t == 0 || __any(rm > 8.f)) {
            const float dl = (t == 0) ? rm : fmaxf(rm, 0.f); mhat += dl;
#pragma unroll
            for (int r = 0; r < 16; ++r) { sc0[r] -= dl; sc1[r] -= dl; }
            if (t > 0) {
                const float f = __builtin_amdgcn_exp2f(-dl); l_reg *= f;
                if (hi == 0) wsf[r32] = f;
                asm volatile("s_waitcnt lgkmcnt(0)" ::: "memory");
#pragma unroll
                for (int r = 0; r < 16; ++r) { const float fr_ = wsf[crow(r, hi)];
#pragma unroll
                    for (int d = 0; d < 4; ++d) o[d][r] *= fr_; }
                asm volatile("s_waitcnt lgkmcnt(0)" ::: "memory");
            }
        }
        bf16x8 kf[4];
        kload(kf, shm + LDS_K + k_n1 * KSLOT, r32, hi);
        __builtin_amdgcn_sched_barrier(0);
        f32x16 pn0, pn1;
        { f32x16 nm;
#pragma unroll
          for (int r = 0; r < 16; ++r) nm[r] = -mhat;
          qk_mm(pn0, pn1, kf, shm + LDS_K + k_n1 * KSLOT, r32, hi, qr, nm); }
        f32x2_t sacc = {0.f, 0.f};
#pragma unroll
        for (int r = 0; r < 16; r += 2) { sc0[r] = __builtin_amdgcn_exp2f(sc0[r]); sc0[r + 1] = __builtin_amdgcn_exp2f(sc0[r + 1]); sc1[r] = __builtin_amdgcn_exp2f(sc1[r]); sc1[r + 1] = __builtin_amdgcn_exp2f(sc1[r + 1]);
            sacc += (f32x2_t){sc0[r], sc0[r + 1]}; sacc += (f32x2_t){sc1[r], sc1[r + 1]}; }
        l_reg += sacc.x + sacc.y;
        pw0 = (u32x4){pkbf(sc0[0], sc0[1]), pkbf(sc0[2], sc0[3]), pkbf(sc0[4], sc0[5]), pkbf(sc0[6], sc0[7])};
        pw1 = (u32x4){pkbf(sc0[8], sc0[9]), pkbf(sc0[10], sc0[11]), pkbf(sc0[12], sc0[13]), pkbf(sc0[14], sc0[15])};
        pw2 = (u32x4){pkbf(sc1[0], sc1[1]), pkbf(sc1[2], sc1[3]), pkbf(sc1[4], sc1[5]), pkbf(sc1[6], sc1[7])};
        pw3 = (u32x4){pkbf(sc1[8], sc1[9]), pkbf(sc1[10], sc1[11]), pkbf(sc1[12], sc1[13]), pkbf(sc1[14], sc1[15])};
#pragma unroll
        for (int i = 0; i < 8; ++i) { __builtin_amdgcn_sched_group_barrier(0x008, 1, 0); __builtin_amdgcn_sched_group_barrier(0x002, 10, 0); }
        __builtin_amdgcn_sched_barrier(0);
        if (!pathB) {
            pv(o, vb0 + v_cur * VSLOT, __builtin_bit_cast(bf16x8, pw0), __builtin_bit_cast(bf16x8, pw1), __builtin_bit_cast(bf16x8, pw2), __builtin_bit_cast(bf16x8, pw3)); }
        sc0 = pn0; sc1 = pn1;
        }
        k_cur = k_n1; v_prev = v_cur; v_cur = (v_cur + 1) & 3;
    }
    asm volatile("s_waitcnt lgkmcnt(0)\n\ts_barrier" ::: "memory");
#undef ATT_DMA
#undef ATT_TROW
    { auto rr = __builtin_amdgcn_permlane32_swap(__float_as_uint(l_reg), __float_as_uint(l_reg), false, false); l_reg = __uint_as_float(rr[0]) + __uint_as_float(rr[1]); }
    asm volatile("s_waitcnt lgkmcnt(0)" ::: "memory");
    if (hi == 0) wsf[32 + r32] = l_reg;
    asm volatile("s_waitcnt lgkmcnt(0)" ::: "memory");
#pragma unroll
    for (int r = 0; r < 16; ++r) { const float rl = 1.0f / wsf[32 + crow(r, hi)];
#pragma unroll
        for (int d = 0; d < 4; ++d) o[d][r] *= rl; }
    asm volatile("s_waitcnt lgkmcnt(0)" ::: "memory");
}
__device__ __forceinline__ void attn_unit(const Args& A, int b, int h, int qb, bool isctx, bool pathB, LAS char* shm) {
    const int tid = opaque_tid(), lane = tid & 63, r32 = lane & 31, hi = lane >> 5; const int wid = __builtin_amdgcn_readfirstlane(tid >> 6);
    const int qrow0 = isctx ? (TL + b * 256) : (b * 4096 + qb * 256);
    f32x16 o[4];
    unsigned* o1s = A.o1g + wid * 2048 + lane;
    attn_pass(A, 0, b, h, qrow0, isctx, pathB, shm, o);
#pragma unroll
    for (int d = 0; d < 4; ++d)
#pragma unroll
        for (int r = 0; r < 16; r += 2) o1s[(d * 8 + (r >> 1)) * 64] = pkbf(o[d][r], o[d][r + 1]);
    asm volatile("s_waitcnt lgkmcnt(0)" ::: "memory");
    attn_pass(A, 1, b, h, qrow0, isctx, pathB, shm, o);
#pragma unroll
    for (int r = 0; r < 16; r += 2)
#pragma unroll
        for (int d = 0; d < 4; ++d) { const unsigned pk = o1s[(d * 8 + (r >> 1)) * 64]; o[d][r] = bflo(pk) - A.lam * o[d][r]; o[d][r + 1] = bfhi(pk) - A.lam * o[d][r + 1]; }
    LAS float* stg = (LAS float*)shm + wid * (32 * 68);
    const int rq = lane >> 3, cq = lane & 7;
    float vals[2][4][8]; float ssr[4] = {0.f, 0.f, 0.f, 0.f};
#pragma unroll
    for (int hf = 0; hf < 2; ++hf) {
#pragma unroll
        for (int r = 0; r < 16; ++r) { stg[crow(r, hi) * 68 + r32] = o[2 * hf][r]; stg[crow(r, hi) * 68 + 32 + r32] = o[2 * hf + 1][r]; }
        asm volatile("s_waitcnt lgkmcnt(0)" ::: "memory");
#pragma unroll
        for (int i = 0; i < 4; ++i) { const f32x4_t u0 = *(const LAS f32x4_t*)(stg + (rq + 8 * i) * 68 + cq * 8), u1 = *(const LAS f32x4_t*)(stg + (rq + 8 * i) * 68 + cq * 8 + 4);
#pragma unroll
            for (int c = 0; c < 4; ++c) { vals[hf][i][c] = u0[c]; vals[hf][i][4 + c] = u1[c]; ssr[i] += u0[c] * u0[c] + u1[c] * u1[c]; } }
        asm volatile("s_waitcnt lgkmcnt(0)" ::: "memory");
    }
#pragma unroll
    for (int i = 0; i < 4; ++i) { float v = ssr[i]; v += adpp<0xB1>(v); v += adpp<0x4E>(v); v += adpp<0x141>(v); ssr[i] = rsqrtf(v * (1.0f / 128.0f) + 1e-5f) * A.oml; }
#pragma unroll
    for (int hf = 0; hf < 2; ++hf) {
        const int col = h * 128 + hf * 64 + cq * 8;
        const f32x4_t g0 = *(const f32x4_t*)(A.gain + hf * 64 + cq * 8), g1 = *(const f32x4_t*)(A.gain + hf * 64 + cq * 8 + 4);
        u32x4 zz[4];
#pragma unroll
        for (int i = 0; i < 4; ++i) zz[i] = *(const u32x4*)(A.Z + (size_t)(qrow0 + wid * 32 + rq + 8 * i) * 1024 + col);
#pragma unroll
        for (int i = 0; i < 4; ++i) { const float rs = ssr[i]; const float* vv = vals[hf][i]; u32x4 w;
            w.x = pkbf(vv[0] * rs * g0[0] * silu_f(bflo(zz[i].x)), vv[1] * rs * g0[1] * silu_f(bfhi(zz[i].x)));
            w.y = pkbf(vv[2] * rs * g0[2] * silu_f(bflo(zz[i].y)), vv[3] * rs * g0[3] * silu_f(bfhi(zz[i].y)));
            w.z = pkbf(vv[4] * rs * g1[0] * silu_f(bflo(zz[i].z)), vv[5] * rs * g1[1] * silu_f(bfhi(zz[i].z)));
            w.w = pkbf(vv[6] * rs * g1[2] * silu_f(bflo(zz[i].w)), vv[7] * rs * g1[3] * silu_f(bfhi(zz[i].w)));
            *(u32x4*)(A.O + (size_t)(qrow0 + wid * 32 + rq + 8 * i) * 1024 + col) = w; }
    }
}
__device__ __forceinline__ void attn_phase(const Args& A, LAS char* shm, int G, int bid) {
    const int vcu = (G % 8 == 0) ? (bid % 8) * (G / 8) + bid / 8 : bid;
    bool pathB;
    { const int tid = opaque_tid(); LAS unsigned* cnt = (LAS unsigned*)(shm + LDS_CNT);
      if (tid < 4) cnt[tid] = 0u;
      __syncthreads();
      const unsigned simd = (unsigned)__builtin_amdgcn_s_getreg((1 << 11) | (4 << 6) | 4) & 3u;
      unsigned slot = 0u; if ((tid & 63) == 0) slot = __hip_atomic_fetch_add(cnt + simd, 1u, __ATOMIC_RELAXED, __HIP_MEMORY_SCOPE_WORKGROUP);
      slot = (unsigned)__builtin_amdgcn_readfirstlane((int)slot);
      pathB = (slot & 1u) != 0u;
      __syncthreads(); }
#pragma unroll 1
    for (int u = vcu; u < A.n_units; u += G) {
        const bool isctx = u >= 1024; const int bh = isctx ? (u - 1024) : (u >> 4); const int qb = isctx ? 0 : (u & 15);
        attn_unit(A, bh >> 3, bh & 7, qb, isctx, pathB, shm);
        asm volatile("s_waitcnt vmcnt(0) lgkmcnt(0)\n\ts_barrier" ::: "memory");
    }
}
}
typedef unsigned short bf16_t;
typedef float f32x4 __attribute__((ext_vector_type(4)));
typedef unsigned u32x4 __attribute__((ext_vector_type(4)));
typedef unsigned u32x2 __attribute__((ext_vector_type(2)));
constexpr size_t MiB = 1u << 20;
constexpr size_t WS_CTL = 0, WS_MOD = 1 * MiB, WS_ROPE = 1 * MiB + 512 * 1024, WS_BZ = 2 * MiB;
constexpr size_t WS_WDAIN = 9 * MiB, WS_WDAOUT = 25 * MiB, WS_WFNT = 29 * MiB, WS_WFNZ = 33 * MiB, WS_WFNOUT = 35 * MiB, WS_WRWIN = 37 * MiB, WS_WRWOUT = 46 * MiB;
constexpr size_t WS_XC = 48 * MiB, WS_HB = 56 * MiB, WS_BIG = 124 * MiB;
constexpr size_t WS_Q = WS_BIG, WS_K = WS_BIG + 68 * MiB, WS_V = WS_BIG + 136 * MiB, WS_Z = WS_BIG + 204 * MiB;
constexpr size_t WS_ATL = WS_BIG, WS_ATC = WS_BIG + 128 * MiB, WS_ZB = WS_BIG + 136 * MiB, WS_DFTL = 396 * MiB, WS_DFTC = 460 * MiB, WS_FOLD = WS_BIG + 204 * MiB;
constexpr size_t WS_P = WS_BIG, WS_Y1 = 413 * MiB, WS_END = 482 * MiB;
constexpr int RWN = 4352;
constexpr int LDS_BYTES = 147456;

struct Params { const float* in[28]; float* out; unsigned char* ws; };

__device__ __forceinline__ float wave_sum(float v) {
#pragma unroll
    for (int o = 1; o < 64; o <<= 1) v += __shfl_xor(v, o);
    return v;
}
__device__ __forceinline__ void tr_item(const float* W, int ldw, int N, bf16_t* WT, int ldt, LAS float* scr, int item, int lane) {
    const int nblk = N / 32, kb = item / nblk, nb = item % nblk, k0 = 64 * kb, n0 = 32 * nb;
    float v_[32];
#pragma unroll
    for (int i = 0; i < 32; ++i) v_[i] = W[(size_t)(k0 + 2 * i + (lane >> 5)) * ldw + n0 + (lane & 31)];
#pragma unroll
    for (int i = 0; i < 32; ++i) scr[(2 * i + (lane >> 5)) * 33 + (lane & 31)] = v_[i];
    asm volatile("s_waitcnt lgkmcnt(0)" ::: "memory");
    const int c = lane & 7;
#pragma unroll
    for (int j = 0; j < 4; ++j) { const int n = (lane >> 3) + 8 * j; const LAS float* s = scr + (8 * c) * 33 + n;
        u32x4 o; o.x = pkbf(s[0 * 33], s[1 * 33]); o.y = pkbf(s[2 * 33], s[3 * 33]); o.z = pkbf(s[4 * 33], s[5 * 33]); o.w = pkbf(s[6 * 33], s[7 * 33]);
        *(u32x4*)(WT + (size_t)(n0 + n) * ldt + k0 + 8 * c) = o; }
    asm volatile("s_waitcnt lgkmcnt(0)" ::: "memory");
}
__device__ __forceinline__ void prologue(const Params& p, LAS char* lds, int G, int bid) {
    const int tid = opaque_tid(), lane = tid & 63, wid = tid >> 6;
    unsigned char* ws = p.ws;
    {
        LAS float* scr = (LAS float*)(lds + wid * 8448);
        const int gw = bid * 8 + wid, NGW = G * 8;
        for (int it = gw; it < 8832; it += NGW) {
            int r = it;
            if (r < 2048) { tr_item(p.in[8], 4096, 4096, (bf16_t*)(ws + WS_WDAIN), 1024, scr, r, lane); continue; } r -= 2048;
            if (r < 2048) { tr_item(p.in[8] + (size_t)1024 * 4096, 4096, 4096, (bf16_t*)(ws + WS_WDAIN + 8 * MiB), 1024, scr, r, lane); continue; } r -= 2048;
            if (r < 512) { tr_item(p.in[12], 1024, 1024, (bf16_t*)(ws + WS_WDAOUT), 1024, scr, r, lane); continue; } r -= 512;
            if (r < 512) { tr_item(p.in[12] + (size_t)1024 * 1024, 1024, 1024, (bf16_t*)(ws + WS_WDAOUT + 2 * MiB), 1024, scr, r, lane); continue; } r -= 512;
            if (r < 512) { tr_item(p.in[13] + 1024, 2048, 1024, (bf16_t*)(ws + WS_WFNZ), 1024, scr, r, lane); continue; } r -= 512;
            if (r < 512) { tr_item(p.in[15], 1024, 1024, (bf16_t*)(ws + WS_WFNOUT), 1024, scr, r, lane); continue; } r -= 512;
            if (r < 2176) { tr_item(p.in[16], RWN, RWN, (bf16_t*)(ws + WS_WRWIN), 1024, scr, r, lane); continue; } r -= 2176;
            tr_item(p.in[27], 1024, 1024, (bf16_t*)(ws + WS_WRWOUT), 1024, scr, r, lane);
        }
    }
    __syncthreads();
    for (int it = bid; it < 256; it += G) {
        const int g = it >> 5, cs = (it >> 4) & 1, kq = it & 15;
        LAS float* Wcs = (LAS float*)lds; LAS float* win = (LAS float*)(lds + 65536); LAS float* tab = (LAS float*)(lds + 65536 + 33024);
        if (tid < 128) { float s, c; sincospif((float)tid / 64.f, &s, &c); tab[tid] = (cs ? s : c) * 0.08838834764831845f; }
        __syncthreads();
        {
            const int e0 = (tid & 31) * 4, cq = tid >> 5; f32x4 acc[8];
#pragma unroll
            for (int i = 0; i < 8; ++i) acc[i] = (f32x4){0.f, 0.f, 0.f, 0.f};
            const float* Wg = p.in[14] + (size_t)g * 128 * 128;
            for (int m = 0; m < 128; ++m) { const f32x4 wg = *(const f32x4*)(Wg + m * 128 + e0);
#pragma unroll
                for (int i = 0; i < 8; ++i) acc[i] += wg * tab[(m * (cq + 16 * i)) & 127]; }
#pragma unroll
            for (int i = 0; i < 8; ++i) *(LAS f32x4*)(Wcs + (cq + 16 * i) * 128 + e0) = acc[i];
        }
#pragma unroll
        for (int i = 0; i < 16; ++i) { const int idx = tid + 512 * i, kin = idx >> 7, c = idx & 127; win[kin * 129 + c] = p.in[13][(size_t)(kq * 64 + kin) * 2048 + g * 128 + c]; }
        __syncthreads();
        {
            const int kin = tid & 63, eg = tid >> 6; float acc[16];
#pragma unroll
            for (int i = 0; i < 16; ++i) acc[i] = 0.f;
            for (int c = 0; c < 128; ++c) { const float a = win[kin * 129 + c];
#pragma unroll
                for (int i = 0; i < 16; ++i) acc[i] += a * Wcs[c * 128 + eg * 16 + i]; }
            bf16_t* WT = (bf16_t*)(ws + WS_WFNT);
#pragma unroll
            for (int i = 0; i < 16; ++i) WT[(size_t)(cs * 1024 + g * 128 + eg * 16 + i) * 1024 + kq * 64 + kin] = (bf16_t)(pkbf(acc[i], 0.f) & 0xffffu);
        }
        __syncthreads();
    }
    {
        LAS float* tc = (LAS float*)lds; LAS float* ts = (LAS float*)(lds + 16384);
        for (int j = tid; j < 4096; j += 512) { float s, c; sincospif((float)j / 2048.f, &s, &c); tc[j] = c; ts[j] = -s; }
        __syncthreads();
        bf16_t* DL = (bf16_t*)(ws + WS_DFTL); bf16_t* DC = (bf16_t*)(ws + WS_DFTC);
        for (int k = bid; k < 2048; k += G) {
            const int j0 = (tid & 255) * 8; const bool sn = tid >= 256; float v8[8];
#pragma unroll
            for (int i = 0; i < 8; ++i) { const int idx = (k * (j0 + i)) & 4095; v8[i] = (sn ? -ts[idx] : tc[idx]) * 0.015625f; }
            u32x4 o; o.x = pkbf(v8[0], v8[1]); o.y = pkbf(v8[2], v8[3]); o.z = pkbf(v8[4], v8[5]); o.w = pkbf(v8[6], v8[7]);
            *(u32x4*)(DL + (sn ? (size_t)2048 * 2048 : (size_t)0) + (size_t)k * 2048 + j0) = o;
        }
        for (int k = bid; k < 256; k += G) {
            if (tid < 64) { const int cs = tid >> 5, l0 = (tid & 31) * 8; float v8[8];
#pragma unroll
                for (int i = 0; i < 8; ++i) { const int idx = ((k * (l0 + i)) & 255) * 16; v8[i] = (cs ? ts[idx] : tc[idx]) * 0.0625f; }
                u32x4 o; o.x = pkbf(v8[0], v8[1]); o.y = pkbf(v8[2], v8[3]); o.z = pkbf(v8[4], v8[5]); o.w = pkbf(v8[6], v8[7]);
                *(u32x4*)(DC + (size_t)k * 512 + cs * 256 + l0) = o; }
        }
        __syncthreads();
    }
    {
        LAS float* sc = (LAS float*)lds; LAS float* red = (LAS float*)(lds + 40960);
        bool have = false;
        for (int it = bid; it < 192; it += G) {
            if (!have) { for (int idx = tid; idx < 9216; idx += 512) { const int r = idx >> 10, k = idx & 1023; const float cv = r < 8 ? p.in[1][r * 1024 + k] : p.in[3][k]; sc[idx] = cv / (1.f + __expf(-cv)); } have = true; __syncthreads(); }
            const int i = it / 48, n = (it % 48) * 64 + (tid & 63), kq = tid >> 6;
            const float* w = p.in[5] + (size_t)i * 1024 * 3072 + n;
            float acc[9];
#pragma unroll
            for (int r = 0; r < 9; ++r) acc[r] = 0.f;
            for (int k = kq * 128; k < kq * 128 + 128; k += 4) { const float w0 = w[(size_t)k * 3072], w1 = w[(size_t)(k + 1) * 3072], w2 = w[(size_t)(k + 2) * 3072], w3 = w[(size_t)(k + 3) * 3072];
#pragma unroll
                for (int r = 0; r < 9; ++r) { const f32x4 s4 = *(const LAS f32x4*)(sc + r * 1024 + k); acc[r] += (s4[0] * w0 + s4[1] * w1) + (s4[2] * w2 + s4[3] * w3); } }
#pragma unroll
            for (int r = 0; r < 9; ++r) red[(kq * 9 + r) * 64 + (tid & 63)] = acc[r];
            __syncthreads();
            for (int idx = tid; idx < 576; idx += 512) { const int r = idx >> 6, col = idx & 63; float s = 0.f;
#pragma unroll
                for (int q = 0; q < 8; ++q) s += red[(q * 9 + r) * 64 + col];
                const int nn = (it % 48) * 64 + col;
                ((float*)(ws + WS_MOD))[(size_t)(i * 9 + r) * 3072 + nn] = s + p.in[6][i * 3072 + nn]; }
            __syncthreads();
        }
    }
    if (bid == 0) { for (int t = tid; t < 1024; t += 512) { const int pos = t >> 4, qd = t & 15; const float inv = powf(10000.f, -(float)qd / 16.f); const float ang = (float)pos * inv;
            ((float*)(ws + WS_ROPE))[t] = cosf(ang); ((float*)(ws + WS_ROPE))[1024 + t] = sinf(ang); } }
}
__device__ __forceinline__ void ph_phase(const float* xlat, const float* xctx, const float* gain, const float* mod, bf16_t* Hb, int G, int bid, int r0 = 0, int r1 = TT) {
    const int tid_ = opaque_tid(); const int lane = tid_ & 63, wid = tid_ >> 6;
    const int stride = G * 8;
    for (int row0 = r0 + bid * 8 + wid; row0 < r1; row0 += 2 * stride) {
        const int row1 = row0 + stride; const bool has1 = row1 < r1;
        const float* s0 = row0 < TL ? xlat + (size_t)row0 * 1024 : xctx + (size_t)(row0 - TL) * 1024;
        const float* s1 = !has1 ? s0 : (row1 < TL ? xlat + (size_t)row1 * 1024 : xctx + (size_t)(row1 - TL) * 1024);
        f32x4 v0[4], v1[4]; float q0 = 0.f, q1 = 0.f;
#pragma unroll
        for (int j = 0; j < 4; ++j) { v0[j] = *(const f32x4*)(s0 + 4 * lane + 256 * j); v1[j] = *(const f32x4*)(s1 + 4 * lane + 256 * j); }
#pragma unroll
        for (int j = 0; j < 4; ++j) { q0 += (v0[j].x * v0[j].x + v0[j].y * v0[j].y) + (v0[j].z * v0[j].z + v0[j].w * v0[j].w); q1 += (v1[j].x * v1[j].x + v1[j].y * v1[j].y) + (v1[j].z * v1[j].z + v1[j].w * v1[j].w); }
        const float r0 = rsqrtf(wave_sum(q0) * (1.f / 1024.f) + 1e-6f), r1 = rsqrtf(wave_sum(q1) * (1.f / 1024.f) + 1e-6f);
        const float* m0 = mod + (row0 < TL ? (row0 >> 12) : 8) * 3072; const float* m1 = mod + (row1 < TL ? (row1 >> 12) : 8) * 3072;
#pragma unroll
        for (int j = 0; j < 4; ++j) { const int col = 4 * lane + 256 * j; const f32x4 g4 = *(const f32x4*)(gain + col);
            { const f32x4 sh = *(const f32x4*)(m0 + col), sc = *(const f32x4*)(m0 + 1024 + col); const f32x4 y = v0[j] * r0 * g4 * (sc + 1.f) + sh; u32x2 o; o.x = pkbf(y.x, y.y); o.y = pkbf(y.z, y.w); *(u32x2*)(Hb + (size_t)row0 * 1024 + col) = o; }
            if (has1) { const f32x4 sh = *(const f32x4*)(m1 + col), sc = *(const f32x4*)(m1 + 1024 + col); const f32x4 y = v1[j] * r1 * g4 * (sc + 1.f) + sh; u32x2 o; o.x = pkbf(y.x, y.y); o.y = pkbf(y.z, y.w); *(u32x2*)(Hb + (size_t)row1 * 1024 + col) = o; } }
    }
}
__device__ __forceinline__ void final_phase(float* x, const float* gain, int G, int bid) {
    const int tid_ = opaque_tid(); const int lane = tid_ & 63, wid = tid_ >> 6;
    const int stride = G * 8;
    for (int row0 = bid * 8 + wid; row0 < TL; row0 += 2 * stride) {
        const int row1 = row0 + stride; const bool has1 = row1 < TL;
        float* s0 = x + (size_t)row0 * 1024; float* s1 = has1 ? x + (size_t)row1 * 1024 : s0;
        f32x4 v0[4], v1[4]; float q0 = 0.f, q1 = 0.f;
#pragma unroll
        for (int j = 0; j < 4; ++j) { v0[j] = *(const f32x4*)(s0 + 4 * lane + 256 * j); v1[j] = *(const f32x4*)(s1 + 4 * lane + 256 * j); }
#pragma unroll
        for (int j = 0; j < 4; ++j) { q0 += (v0[j].x * v0[j].x + v0[j].y * v0[j].y) + (v0[j].z * v0[j].z + v0[j].w * v0[j].w); q1 += (v1[j].x * v1[j].x + v1[j].y * v1[j].y) + (v1[j].z * v1[j].z + v1[j].w * v1[j].w); }
        const float r0 = rsqrtf(wave_sum(q0) * (1.f / 1024.f) + 1e-6f), r1 = rsqrtf(wave_sum(q1) * (1.f / 1024.f) + 1e-6f);
#pragma unroll
        for (int j = 0; j < 4; ++j) { const int col = 4 * lane + 256 * j; const f32x4 g4 = *(const f32x4*)(gain + col);
            *(f32x4*)(s0 + col) = v0[j] * r0 * g4;
            if (has1) *(f32x4*)(s1 + col) = v1[j] * r1 * g4; }
    }
}
__device__ __forceinline__ void fnet_fold(const bf16_t* ATL, bf16_t* E, bf16_t* O, float* TA, const bf16_t* Z, bf16_t* OG, int G, int bid) {
    const int tid_ = opaque_tid(); const int lane = tid_ & 63, wid = tid_ >> 6;
    for (int row = bid * 8 + wid; row < 8192; row += G * 8) {
        const bf16_t* a1 = ATL + (size_t)row * 8192; const bf16_t* a2 = a1 + 4096; bf16_t* e = E + (size_t)row * 2048; bf16_t* od = O + (size_t)row * 2048;
        float alt = 0.f;
#pragma unroll 2
        for (int it = 0; it < 4; ++it) {
            const int j0 = (it * 64 + lane) * 8;
            const u32x4 x = *(const u32x4*)(a1 + j0), y = *(const u32x4*)(a2 + j0);
            const int mb = 4096 - j0 - 8;
            const u32x4 xm = *(const u32x4*)(a1 + mb), ym = *(const u32x4*)(a2 + mb);
            const unsigned short xe = (j0 == 0) ? (unsigned short)0 : a1[4096 - j0], ye = (j0 == 0) ? (unsigned short)0 : a2[4096 - j0];
            float fa[8], fs[8], ma[8], ms[8];
#pragma unroll
            for (int i = 0; i < 4; ++i) { fa[2 * i] = bflo(x[i]); fa[2 * i + 1] = bfhi(x[i]); fs[2 * i] = bflo(y[i]); fs[2 * i + 1] = bfhi(y[i]);
                ma[2 * i] = bflo(xm[i]); ma[2 * i + 1] = bfhi(xm[i]); ms[2 * i] = bflo(ym[i]); ms[2 * i + 1] = bfhi(ym[i]); }
            float oc[8], os[8];
            oc[0] = fa[0] + bf1(xe); os[0] = fs[0] - bf1(ye);
#pragma unroll
            for (int i = 1; i < 8; ++i) { oc[i] = fa[i] + ma[8 - i]; os[i] = fs[i] - ms[8 - i]; }
            if (j0 == 0) { oc[0] = fa[0]; os[0] = 0.f; }
            u32x4 o; o.x = pkbf(oc[0], oc[1]); o.y = pkbf(oc[2], oc[3]); o.z = pkbf(oc[4], oc[5]); o.w = pkbf(oc[6], oc[7]);
            *(u32x4*)(e + j0) = o;
            alt += (bflo(o.x) - bfhi(o.x)) + (bflo(o.y) - bfhi(o.y)) + (bflo(o.z) - bfhi(o.z)) + (bflo(o.w) - bfhi(o.w));
            o.x = pkbf(os[0], os[1]); o.y = pkbf(os[2], os[3]); o.z = pkbf(os[4], os[5]); o.w = pkbf(os[6], os[7]);
            *(u32x4*)(od + j0) = o;
        }
        alt = wave_sum(alt);
        if (lane == 0) { const float amid = bf1(a1[2048]); TA[row] = amid * 0.015625f;
            const int b = row >> 10, n = row & 1023; const size_t off = (size_t)(b * 4096 + 2048) * 1024 + n;
            const float yv = (alt + amid) * 0.015625f * silu_f(bf1(Z[off]));
            OG[off] = (bf16_t)(pkbf(yv, 0.f) & 0xffffu); }
    }
}
__device__ __forceinline__ void sh8(const bf16_t* P, size_t row, int co, bool hm, bool hp, const float* mu, float* out) {
    const u32x4 z4 = {0u, 0u, 0u, 0u};
    const u32x4 c0 = *(const u32x4*)(P + row * RWN + co);
    const u32x4 cm = hm ? *(const u32x4*)(P + (row - 1) * RWN + co) : z4;
    const u32x4 cp = hp ? *(const u32x4*)(P + (row + 1) * RWN + co) : z4;
    const f32x4 m0 = *(const f32x4*)(mu + co), m1 = *(const f32x4*)(mu + co + 4);
#pragma unroll
    for (int i = 0; i < 4; ++i) {
        const float a0 = bflo(c0[i]), a1 = bfhi(c0[i]);
        const float n0 = 0.5f * (bflo(cm[i]) + bflo(cp[i])), n1 = 0.5f * (bfhi(cm[i]) + bfhi(cp[i]));
        const float mu0 = (2 * i < 4) ? m0[(2 * i) & 3] : m1[(2 * i) & 3], mu1 = (2 * i + 1 < 4) ? m0[(2 * i + 1) & 3] : m1[(2 * i + 1) & 3];
        out[2 * i] = a0 + mu0 * (n0 - a0); out[2 * i + 1] = a1 + mu1 * (n1 - a1);
    }
}
template <int CTRL> __device__ __forceinline__ float dpp_f(float v) { return __int_as_float(__builtin_amdgcn_update_dpp(0, __float_as_int(v), CTRL, 0xf, 0xf, true)); }
__device__ __forceinline__ float sum8(float v) { v += dpp_f<0xB1>(v); v += dpp_f<0x4E>(v); v += dpp_f<0x141>(v); return v; }
__device__ __forceinline__ float fast_tanh(float x) { const float e = __expf(2.f * x); return 1.f - 2.f * __builtin_amdgcn_rcpf(e + 1.f); }
__device__ __forceinline__ float fast_sigmoid(float x) { return __builtin_amdgcn_rcpf(1.f + __expf(-x)); }
struct RwArgs { const bf16_t* P; bf16_t* Y0; bf16_t* Y1; float* BZ; const float *mu, *w0, *w_up, *a0, *a_up, *k_k, *k_a, *r_k; };
struct Raw3 { u32x4 c0, cm, cp; };
__device__ __forceinline__ Raw3 ld3(const bf16_t* P, size_t row, int co, bool hm, bool hp) {
    const u32x4 z4 = {0u, 0u, 0u, 0u}; Raw3 r;
    r.c0 = *(const u32x4*)(P + row * RWN + co);
    r.cm = hm ? *(const u32x4*)(P + (row - 1) * RWN + co) : z4;
    r.cp = hp ? *(const u32x4*)(P + (row + 1) * RWN + co) : z4;
    return r;
}
__device__ __forceinline__ void shift8(const Raw3& R, const float* mu, int co, float* out) {
    const f32x4 m0 = *(const f32x4*)(mu + co), m1 = *(const f32x4*)(mu + co + 4);
#pragma unroll
    for (int i = 0; i < 4; ++i) {
        const float a0 = bflo(R.c0[i]), a1 = bfhi(R.c0[i]);
        const float n0 = 0.5f * (bflo(R.cm[i]) + bflo(R.cp[i])), n1 = 0.5f * (bfhi(R.cm[i]) + bfhi(R.cp[i]));
        const float mu0 = (2 * i < 4) ? m0[(2 * i) & 3] : m1[(2 * i) & 3], mu1 = (2 * i + 1 < 4) ? m0[(2 * i + 1) & 3] : m1[(2 * i + 1) & 3];
        out[2 * i] = a0 + mu0 * (n0 - a0); out[2 * i + 1] = a1 + mu1 * (n1 - a1);
    }
}
__device__ __forceinline__ void shift8l(const Raw3& R, const LAS float* mu, float* out) {
    const f32x4 m0 = *(const LAS f32x4*)(mu), m1 = *(const LAS f32x4*)(mu + 4);
    const float mm[8] = {m0[0], m0[1], m0[2], m0[3], m1[0], m1[1], m1[2], m1[3]};
#pragma unroll
    for (int i = 0; i < 4; ++i) {
        const float a0 = bflo(R.c0[i]), a1 = bfhi(R.c0[i]);
        const float n0 = 0.5f * (bflo(R.cm[i]) + bflo(R.cp[i])), n1 = 0.5f * (bfhi(R.cm[i]) + bfhi(R.cp[i]));
        out[2 * i] = a0 + mm[2 * i] * (n0 - a0); out[2 * i + 1] = a1 + mm[2 * i + 1] * (n1 - a1);
    }
}
__device__ __forceinline__ void shift8r(const Raw3& R, const float* mu, float* out) {
#pragma unroll
    for (int i = 0; i < 4; ++i) {
        const float a0 = bflo(R.c0[i]), a1 = bfhi(R.c0[i]);
        const float n0 = 0.5f * (bflo(R.cm[i]) + bflo(R.cp[i])), n1 = 0.5f * (bfhi(R.cm[i]) + bfhi(R.cp[i]));
        out[2 * i] = a0 + mu[2 * i] * (n0 - a0); out[2 * i + 1] = a1 + mu[2 * i + 1] * (n1 - a1);
    }
}
__device__ __forceinline__ void rwkv_scan(const RwArgs& A, LAS char* lds, int G, int bid) {
    typedef short bfx8 __attribute__((ext_vector_type(8)));
    const int tid = opaque_tid(), lane = tid & 63; const int q = __builtin_amdgcn_readfirstlane(tid >> 6);
    LAS float* sW = (LAS float*)lds; LAS float* sA = sW + 4096; LAS float* sB = sA + 4096; LAS float* sKD = sB + 4096; LAS float* sR = sKD + 4096; LAS float* sV = sR + 4096;
    LAS bf16_t* WUPt = (LAS bf16_t*)(sV + 4096); LAS bf16_t* AUPt = WUPt + 64 * 72;
    LAS bf16_t* T1 = (LAS bf16_t*)(lds + 118784); LAS bf16_t* T2 = T1 + 64 * 72;
    const int s = tid >> 3, dg = tid & 7, d0 = dg * 8;
#pragma unroll 1
    for (int chain = bid; chain < 256; chain += G) {
        const int z = chain >> 7, b = (chain >> 4) & 7, hh = chain & 15;
        __syncthreads();
        for (int idx = tid; idx < 4096; idx += 512) { const int r = idx >> 6, d = idx & 63;
            WUPt[d * 72 + r] = (bf16_t)(pkbf(A.w_up[(size_t)(z * 64 + r) * 1024 + hh * 64 + d], 0.f) & 0xffffu);
            AUPt[d * 72 + r] = (bf16_t)(pkbf(A.a_up[(size_t)(z * 64 + r) * 1024 + hh * 64 + d], 0.f) & 0xffffu); }
        f32x2_t S2[4];
#pragma unroll
        for (int j = 0; j < 4; ++j) S2[j] = (f32x2_t){0.f, 0.f};
        bf16_t* Yz = z ? A.Y1 : A.Y0;
        const int c_r = hh * 64 + d0, c_k = 1024 + hh * 64 + d0, c_v = 2048 + hh * 64 + d0, c_wd = 3072 + z * 64 + d0, c_ad = 3200 + z * 64 + d0;
#define RW_ROWOF(c, rowv, hmv, hpv) do { const int sidx_ = (c) * 64 + s; int L_, n_, rb_; \
            if ((c) < 4) { L_ = 256; n_ = z ? (255 - sidx_) : sidx_; rb_ = TL + b * 256; } else { L_ = 4096; const int sl_ = sidx_ - 256; n_ = z ? (4095 - sl_) : sl_; rb_ = b * 4096; } \
            rowv = (size_t)(rb_ + n_); hmv = n_ > 0; hpv = n_ < L_ - 1; } while (0)
        size_t row; bool hm, hp;
        RW_ROWOF(0, row, hm, hp);
        Raw3 Rr = ld3(A.P, row, c_r, hm, hp), Rk = ld3(A.P, row, c_k, hm, hp), Rv = ld3(A.P, row, c_v, hm, hp), Rw = ld3(A.P, row, c_wd, hm, hp), Ra = ld3(A.P, row, c_ad, hm, hp);
#pragma unroll 1
        for (int c = 0; c < 68; ++c) {
            asm volatile("" ::: "memory");
            const size_t crow_ = row;
            {
                float r8[8], k8[8], v8[8], t8[8];
                shift8(Rr, A.mu, c_r, r8); shift8(Rk, A.mu, c_k, k8); shift8(Rv, A.mu, c_v, v8);
                *(LAS f32x4*)(sR + s * 64 + d0) = (f32x4){r8[0], r8[1], r8[2], r8[3]}; *(LAS f32x4*)(sR + s * 64 + d0 + 4) = (f32x4){r8[4], r8[5], r8[6], r8[7]};
                *(LAS f32x4*)(sV + s * 64 + d0) = (f32x4){v8[0], v8[1], v8[2], v8[3]}; *(LAS f32x4*)(sV + s * 64 + d0 + 4) = (f32x4){v8[4], v8[5], v8[6], v8[7]};
                *(LAS f32x4*)(sB + s * 64 + d0) = (f32x4){k8[0], k8[1], k8[2], k8[3]}; *(LAS f32x4*)(sB + s * 64 + d0 + 4) = (f32x4){k8[4], k8[5], k8[6], k8[7]};
                float kkr[8], ssq = 0.f;
                const f32x4 kk0 = *(const f32x4*)(A.k_k + hh * 64 + d0), kk1 = *(const f32x4*)(A.k_k + hh * 64 + d0 + 4);
#pragma unroll
                for (int i = 0; i < 8; ++i) { kkr[i] = k8[i] * (i < 4 ? kk0[i & 3] : kk1[i & 3]); ssq += kkr[i] * kkr[i]; }
                ssq = sum8(ssq);
                const float rs = -rsqrtf(ssq + 1e-12f);
                *(LAS f32x4*)(sA + s * 64 + d0) = (f32x4){kkr[0] * rs, kkr[1] * rs, kkr[2] * rs, kkr[3] * rs}; *(LAS f32x4*)(sA + s * 64 + d0 + 4) = (f32x4){kkr[4] * rs, kkr[5] * rs, kkr[6] * rs, kkr[7] * rs};
                shift8(Rw, A.mu, c_wd, t8);
                { u32x4 o; o.x = pkbf(fast_tanh(t8[0]), fast_tanh(t8[1])); o.y = pkbf(fast_tanh(t8[2]), fast_tanh(t8[3])); o.z = pkbf(fast_tanh(t8[4]), fast_tanh(t8[5])); o.w = pkbf(fast_tanh(t8[6]), fast_tanh(t8[7]));
                  *(LAS u32x4*)(T1 + s * 72 + d0) = o; }
                shift8(Ra, A.mu, c_ad, t8);
                { u32x4 o; o.x = pkbf(t8[0], t8[1]); o.y = pkbf(t8[2], t8[3]); o.z = pkbf(t8[4], t8[5]); o.w = pkbf(t8[6], t8[7]);
                  *(LAS u32x4*)(T2 + s * 72 + d0) = o; }
            }
            if (c + 1 < 68) { RW_ROWOF(c + 1, row, hm, hp);
                Rr = ld3(A.P, row, c_r, hm, hp); Rk = ld3(A.P, row, c_k, hm, hp); Rv = ld3(A.P, row, c_v, hm, hp); Rw = ld3(A.P, row, c_wd, hm, hp); Ra = ld3(A.P, row, c_ad, hm, hp); }
            __syncthreads();
            const int mt = q & 3, nh = q >> 2, fr = lane & 15, fq = lane >> 4;
            f32x4 accw[2], acca[2];
            {
                bfx8 aw[2], aa[2];
#pragma unroll
                for (int kk = 0; kk < 2; ++kk) { aw[kk] = *(const LAS bfx8*)(T1 + (16 * mt + fr) * 72 + kk * 32 + fq * 8); aa[kk] = *(const LAS bfx8*)(T2 + (16 * mt + fr) * 72 + kk * 32 + fq * 8); }
#pragma unroll
                for (int nt = 0; nt < 2; ++nt) { accw[nt] = (f32x4){0.f, 0.f, 0.f, 0.f}; acca[nt] = (f32x4){0.f, 0.f, 0.f, 0.f};
#pragma unroll
                    for (int kk = 0; kk < 2; ++kk) {
                        const bfx8 bw = *(const LAS bfx8*)(WUPt + (32 * nh + 16 * nt + fr) * 72 + kk * 32 + fq * 8), ba = *(const LAS bfx8*)(AUPt + (32 * nh + 16 * nt + fr) * 72 + kk * 32 + fq * 8);
                        accw[nt] = __builtin_amdgcn_mfma_f32_16x16x32_bf16(aw[kk], bw, accw[nt], 0, 0, 0);
                        acca[nt] = __builtin_amdgcn_mfma_f32_16x16x32_bf16(aa[kk], ba, acca[nt], 0, 0, 0); } }
            }
#pragma unroll
            for (int nt = 0; nt < 2; ++nt) { const int d = 32 * nh + 16 * nt + fr, dcol = hh * 64 + d;
                const float w0d = A.w0[z * 1024 + dcol], a0d = A.a0[z * 1024 + dcol], kad = A.k_a[dcol];
#pragma unroll
                for (int j = 0; j < 4; ++j) { const int idx = (16 * mt + 4 * fq + j) * 64 + d;
                    const float x = -(w0d + accw[nt][j]);
                    const float sp = fmaxf(x, 0.f) + __logf(1.f + __expf(-fabsf(x)));
                    const float w = __expf(-__expf(-sp - 0.5f));
                    const float asig = fast_sigmoid(a0d + acca[nt][j]);
                    const float nkk = sA[idx], kraw = sB[idx];
                    sW[idx] = w; sB[idx] = -nkk * asig; sKD[idx] = kraw * (1.f + (asig - 1.f) * kad); } }
            __syncthreads();
            {
                const f32x4 ra = *(const LAS f32x4*)(sR + s * 64 + d0), rb = *(const LAS f32x4*)(sR + s * 64 + d0 + 4), ka = *(const LAS f32x4*)(sKD + s * 64 + d0), kb = *(const LAS f32x4*)(sKD + s * 64 + d0 + 4);
                const f32x4 q0 = *(const f32x4*)(A.r_k + hh * 64 + d0), q1 = *(const f32x4*)(A.r_k + hh * 64 + d0 + 4);
                float bz = 0.f;
#pragma unroll
                for (int i = 0; i < 4; ++i) { bz += ra[i] * ka[i] * q0[i]; bz += rb[i] * kb[i] * q1[i]; }
                bz = sum8(bz);
                if (dg == 0) A.BZ[((size_t)z * TT + crow_) * 16 + hh] = bz;
            }
            {
                const int rl = lane >> 3, cg = lane & 7, irow = 8 * q + rl;
                const LAS float* bw = sW + 8 * cg; const LAS float* ba_ = sA + 8 * cg; const LAS float* bb_ = sB + 8 * cg; const LAS float* bk = sKD + 8 * cg; const LAS float* br = sR + 8 * cg;
                LAS float* bv = sV + irow;
                LAS float* bvw = (cg == 0) ? bv : ((LAS float*)(lds + 118784) + lane);
                f32x4 w0 = *(const LAS f32x4*)(bw), w1 = *(const LAS f32x4*)(bw + 4), a0 = *(const LAS f32x4*)(ba_), a1 = *(const LAS f32x4*)(ba_ + 4);
                f32x4 b0 = *(const LAS f32x4*)(bb_), b1 = *(const LAS f32x4*)(bb_ + 4), k0 = *(const LAS f32x4*)(bk), k1 = *(const LAS f32x4*)(bk + 4);
                f32x4 r0 = *(const LAS f32x4*)(br), r1 = *(const LAS f32x4*)(br + 4); float vi = bv[0];
#pragma unroll 4
                for (int st = 0; st < 64; ++st) {
                    const int on = ((st + 1) & 63) * 64;
                    const f32x4 nw0 = *(const LAS f32x4*)(bw + on), nw1 = *(const LAS f32x4*)(bw + on + 4), na0 = *(const LAS f32x4*)(ba_ + on), na1 = *(const LAS f32x4*)(ba_ + on + 4);
                    const f32x4 nb0 = *(const LAS f32x4*)(bb_ + on), nb1 = *(const LAS f32x4*)(bb_ + on + 4), nk0 = *(const LAS f32x4*)(bk + on), nk1 = *(const LAS f32x4*)(bk + on + 4);
                    const f32x4 nr0 = *(const LAS f32x4*)(br + on), nr1 = *(const LAS f32x4*)(br + on + 4); const float nvi = bv[on];
                    f32x2_t pp2 = S2[0] * (f32x2_t){a0[0], a0[1]};
                    pp2 = S2[1] * (f32x2_t){a0[2], a0[3]} + pp2; pp2 = S2[2] * (f32x2_t){a1[0], a1[1]} + pp2; pp2 = S2[3] * (f32x2_t){a1[2], a1[3]} + pp2;
                    const float sa = sum8(pp2.x + pp2.y);
                    const f32x2_t sa2 = {sa, sa}, v2 = {vi, vi};
                    S2[0] = S2[0] * (f32x2_t){w0[0], w0[1]} + sa2 * (f32x2_t){b0[0], b0[1]} + v2 * (f32x2_t){k0[0], k0[1]};
                    S2[1] = S2[1] * (f32x2_t){w0[2], w0[3]} + sa2 * (f32x2_t){b0[2], b0[3]} + v2 * (f32x2_t){k0[2], k0[3]};
                    S2[2] = S2[2] * (f32x2_t){w1[0], w1[1]} + sa2 * (f32x2_t){b1[0], b1[1]} + v2 * (f32x2_t){k1[0], k1[1]};
                    S2[3] = S2[3] * (f32x2_t){w1[2], w1[3]} + sa2 * (f32x2_t){b1[2], b1[3]} + v2 * (f32x2_t){k1[2], k1[3]};
                    f32x2_t y2 = S2[0] * (f32x2_t){r0[0], r0[1]};
                    y2 = S2[1] * (f32x2_t){r0[2], r0[3]} + y2; y2 = S2[2] * (f32x2_t){r1[0], r1[1]} + y2; y2 = S2[3] * (f32x2_t){r1[2], r1[3]} + y2;
                    const float yv = sum8(y2.x + y2.y);
                    bvw[st * 64] = yv;
                    w0 = nw0; w1 = nw1; a0 = na0; a1 = na1; b0 = nb0; b1 = nb1; k0 = nk0; k1 = nk1; r0 = nr0; r1 = nr1; vi = nvi;
                }
            }
            __syncthreads();
            { u32x4 o; const LAS float* yr = sV + s * 64 + d0;
              o.x = pkbf(yr[0], yr[1]); o.y = pkbf(yr[2], yr[3]); o.z = pkbf(yr[4], yr[5]); o.w = pkbf(yr[6], yr[7]);
              *(u32x4*)(Yz + crow_ * 1024 + hh * 64 + d0) = o; }
            __syncthreads();
        }
#undef RW_ROWOF
    }
}
__device__ __forceinline__ void rwkv_out(const RwArgs& A, const float* ln_w, const float* ln_b, bf16_t* OG, int G, int bid) {
    const int tid_ = opaque_tid(); const int lane = tid_ & 63, wid = tid_ >> 6; const int c0 = lane * 16, head = lane >> 2;
    float lw[16], lb[16], muv[16];
#pragma unroll
    for (int i = 0; i < 16; ++i) { lw[i] = ln_w[c0 + i]; lb[i] = ln_b[c0 + i]; muv[i] = A.mu[2048 + c0 + i]; }
    for (int row = bid * 8 + wid; row < TT; row += G * 8) {
        const bool lat = row < TL; const int L = lat ? 4096 : 256; const int n = lat ? (row & 4095) : ((row - TL) & 255); const bool hm = n > 0, hp = n < L - 1;
        const u32x4 a0 = *(const u32x4*)(A.Y0 + (size_t)row * 1024 + c0), a1 = *(const u32x4*)(A.Y0 + (size_t)row * 1024 + c0 + 8);
        const u32x4 b0 = *(const u32x4*)(A.Y1 + (size_t)row * 1024 + c0), b1 = *(const u32x4*)(A.Y1 + (size_t)row * 1024 + c0 + 8);
        const Raw3 v0 = ld3(A.P, (size_t)row, 2048 + c0, hm, hp), v1 = ld3(A.P, (size_t)row, 2048 + c0 + 8, hm, hp);
        const u32x4 z0 = *(const u32x4*)(A.P + (size_t)row * RWN + 3328 + c0), z1 = *(const u32x4*)(A.P + (size_t)row * RWN + 3328 + c0 + 8);
        const float bz = 0.5f * (A.BZ[(size_t)row * 16 + head] + A.BZ[((size_t)TT + row) * 16 + head]);
        float y[16], vv[16];
#pragma unroll
        for (int i = 0; i < 4; ++i) { y[2 * i] = bflo(a0[i]) + bflo(b0[i]); y[2 * i + 1] = bfhi(a0[i]) + bfhi(b0[i]); y[8 + 2 * i] = bflo(a1[i]) + bflo(b1[i]); y[8 + 2 * i + 1] = bfhi(a1[i]) + bfhi(b1[i]); }
        float s1 = 0.f;
#pragma unroll
        for (int i = 0; i < 16; ++i) s1 += y[i];
        s1 += __shfl_xor(s1, 1); s1 += __shfl_xor(s1, 2); const float mean = s1 * (1.f / 64.f);
        float s2 = 0.f;
#pragma unroll
        for (int i = 0; i < 16; ++i) { y[i] -= mean; s2 += y[i] * y[i]; }
        s2 += __shfl_xor(s2, 1); s2 += __shfl_xor(s2, 2); const float rstd = rsqrtf(s2 * (1.f / 64.f) + 64e-5f);
        shift8r(v0, muv, vv); shift8r(v1, muv + 8, vv + 8);
        float ov[16];
#pragma unroll
        for (int i = 0; i < 16; ++i) { const unsigned zw = (i < 8) ? z0[(i >> 1) & 3] : z1[(i >> 1) & 3]; const float zz = (i & 1) ? bfhi(zw) : bflo(zw);
            ov[i] = (y[i] * rstd * lw[i] + lb[i] + bz * vv[i]) * silu_f(zz); }
        u32x4 o0, o1; o0.x = pkbf(ov[0], ov[1]); o0.y = pkbf(ov[2], ov[3]); o0.z = pkbf(ov[4], ov[5]); o0.w = pkbf(ov[6], ov[7]);
        o1.x = pkbf(ov[8], ov[9]); o1.y = pkbf(ov[10], ov[11]); o1.z = pkbf(ov[12], ov[13]); o1.w = pkbf(ov[14], ov[15]);
        *(u32x4*)(OG + (size_t)row * 1024 + c0) = o0; *(u32x4*)(OG + (size_t)row * 1024 + c0 + 8) = o1;
    }
}
#ifdef SKIP_GEMM
#define GEMM_PHASE(EPI, AP, BP, MM, NN, KK, EOBJ) do { (void)EOBJ; } while (0)
#else
#ifndef STAGGER_TICKS
#define STAGGER_TICKS 1500
#endif
__device__ __forceinline__ void stagger_wait(int bid, int units_per_cu_x2) {
    if ((bid & 1) && units_per_cu_x2 >= 4) { const unsigned long long t0 = __builtin_amdgcn_s_memrealtime(); while (__builtin_amdgcn_s_memrealtime() - t0 < (unsigned long long)STAGGER_TICKS) __builtin_amdgcn_s_sleep(32); }
}
#define GEMM_PHASE(EPI, AP, BP, MM, NN, KK, EOBJ) do { pg8::Gemm g_{(const bf16_t*)(AP), (const bf16_t*)(BP), (MM), (NN), (KK)}; pg8::StaticOrder S_; S_.init((MM), (NN), G, bid); \
    pg8::gemm_phase<EPI, pg8::StaticOrder, true, true>((PG8_LAS unsigned char*)lds, g_, S_, EOBJ); } while (0)
#endif
#ifdef SKIP_EpiAttnIn
#define GEMM_PHASE_EpiAttnIn(EPI, AP, BP, MM, NN, KK, EOBJ) do { (void)EOBJ; } while (0)
#else
#define GEMM_PHASE_EpiAttnIn GEMM_PHASE
#endif
#ifdef SKIP_EpiFnT
#define GEMM_PHASE_EpiFnT(EPI, AP, BP, MM, NN, KK, EOBJ) do { (void)EOBJ; } while (0)
#else
#define GEMM_PHASE_EpiFnT GEMM_PHASE
#endif
#ifdef SKIP_EpiPlain
#define GEMM_PHASE_EpiPlain(EPI, AP, BP, MM, NN, KK, EOBJ) do { (void)EOBJ; } while (0)
#else
#define GEMM_PHASE_EpiPlain GEMM_PHASE
#endif
#ifdef SKIP_EpiDft
#define GEMM_PHASE_EpiDft(EPI, AP, BP, MM, NN, KK, EOBJ) do { (void)EOBJ; } while (0)
#else
#define GEMM_PHASE_EpiDft GEMM_PHASE
#endif
#ifdef SKIP_EpiResid
#define GEMM_PHASE_EpiResid(EPI, AP, BP, MM, NN, KK, EOBJ) do { (void)EOBJ; } while (0)
#else
#define GEMM_PHASE_EpiResid GEMM_PHASE
#endif
#define XB_TMO      128
#define XB_XCNT(j)  (256  + 64 * (j))
#define XB_XSUB(j)  (1280 + 64 * (j))
#define XB_XGEN(j)  (2304 + 64 * (j))
#define XB_TOP      3328
#define XB_TOPGEN   3392
#define XCD_BAR_WORDS 3456
#define XB_SPIN_CAP (1u << 18)

__device__ __forceinline__ unsigned xb_ld(unsigned* p)              { return __hip_atomic_load(p, __ATOMIC_RELAXED, __HIP_MEMORY_SCOPE_AGENT); }
__device__ __forceinline__ unsigned xb_add(unsigned* p, unsigned v) { return __hip_atomic_fetch_add(p, v, __ATOMIC_RELAXED, __HIP_MEMORY_SCOPE_AGENT); }
__device__ __forceinline__ unsigned xb_xcc_id() { return (unsigned)__builtin_amdgcn_s_getreg((3 << 11) | 20) & 0xFu; }
#define XB_SPIN(cond, bar) do { unsigned _sp = 0; while (cond) { __builtin_amdgcn_s_sleep(1); \
    if ((++_sp & 255u) == 0u) { if (xb_ld(&(bar)[XB_TMO])) break; if (_sp > XB_SPIN_CAP) { atomicAdd(&(bar)[XB_TMO], 1u); break; } } } } while (0)

struct XcdBarrier {
    unsigned* bar; unsigned x;
    volatile LAS unsigned* st;
};

__device__ __forceinline__ XcdBarrier xcd_barrier_post(unsigned* bar, volatile LAS unsigned* st) {
    XcdBarrier b; b.bar = bar; b.x = xb_xcc_id(); b.st = st;
    if (threadIdx.x == 0) (void)xb_add(&bar[XB_XCNT(b.x)], 1u);
    return b;
}
__device__ __forceinline__ void xcd_barrier_complete(unsigned* bar, unsigned x, unsigned& nloc, unsigned& nx) {
    const unsigned G = gridDim.x * gridDim.y * gridDim.z;
    unsigned sum, cnt, mine, sp = 0u;
    for (;;) {
        sum = 0u; cnt = 0u; mine = 0u;
#pragma unroll
        for (unsigned j = 0; j < 16; ++j) { const unsigned c = xb_ld(&bar[XB_XCNT(j)]); sum += c; cnt += (c > 0u) ? 1u : 0u; mine = (j == x) ? c : mine; }
        if (sum == G) break;
        __builtin_amdgcn_s_sleep(1);
        if ((++sp & 255u) == 0u) { if (xb_ld(&bar[XB_TMO])) break; if (sp > XB_SPIN_CAP) { atomicAdd(&bar[XB_TMO], 1u); break; } }
    }
    nloc = mine > 0u ? mine : 1u; nx = cnt > 0u ? cnt : 1u;
}

__device__ __forceinline__ void xcd_barrier(const XcdBarrier& b) {
    asm volatile("s_waitcnt vmcnt(0)" ::: "memory");
    __syncthreads();
    if (threadIdx.x == 0) {
        unsigned* bar = b.bar;
        __builtin_amdgcn_s_waitcnt(0);
        unsigned nloc = b.st[0], nx = b.st[1];
        if (nloc == 0u) { xcd_barrier_complete(bar, b.x, nloc, nx); b.st[0] = nloc; b.st[1] = nx; }
        const unsigned old = xb_add(&bar[XB_XSUB(b.x)], 1u);
        const unsigned gen = old / nloc;
        if (old + 1u == (gen + 1u) * nloc) {
            __builtin_amdgcn_fence(__ATOMIC_RELEASE, "agent");
            asm volatile("s_waitcnt vmcnt(0)" ::: "memory");
            const unsigned og = xb_add(&bar[XB_TOP], 1u);
            const unsigned tg = og / nx;
            if (og + 1u == (tg + 1u) * nx) xb_add(&bar[XB_TOPGEN], 1u);
            else XB_SPIN(xb_ld(&bar[XB_TOPGEN]) == tg, bar);
            __builtin_amdgcn_fence(__ATOMIC_ACQUIRE, "agent");
            xb_add(&bar[XB_XGEN(b.x)], 1u);
            asm volatile("s_waitcnt vmcnt(0)" ::: "memory");
        } else {
            XB_SPIN(xb_ld(&bar[XB_XGEN(b.x)]) == gen, bar);
            __builtin_amdgcn_fence(__ATOMIC_ACQUIRE, "agent");
            asm volatile("s_waitcnt vmcnt(0)" ::: "memory");
        }
    }
    __syncthreads();
}

#define GRID_SYNC() xcd_barrier(xbar)
template <int layer> __device__ __forceinline__ void layer_body(const Params& p, LAS char* lds, const XcdBarrier& xbar, int G, int bid) {
    unsigned char* ws = p.ws;
    float* mod = (float*)(ws + WS_MOD);
    const float* ropeC = (const float*)(ws + WS_ROPE); const float* ropeS = ropeC + 1024;
    bf16_t* Hb = (bf16_t*)(ws + WS_HB);
    float* XC = (float*)(ws + WS_XC);
    const float* x_in = p.in[0]; const float* ctx_in = p.in[2];
        const float* xl = layer == 0 ? x_in : p.out; const float* xc = layer == 0 ? ctx_in : XC;
        const float* modl = mod + (size_t)layer * 9 * 3072;
        if constexpr (layer == 0) {
            ph_phase(xl, xc, p.in[4] + layer * 1024, modl, Hb, G, bid);
            GRID_SYNC();
        }
        const int Mout = (layer == 3) ? TL : TT;
        const bf16_t* Wout;
        if constexpr (layer == 0 || layer == 3) {
            const int j = layer == 0 ? 0 : 1;
            LAS float* ropeL = (LAS float*)(lds + 131072);
            for (int t_ = opaque_tid(); t_ < 2048; t_ += 512) ropeL[t_] = ropeC[t_];
            __syncthreads();
            pg8::EpiAttnIn E{(bf16_t*)(ws + WS_Q), (bf16_t*)(ws + WS_K), (bf16_t*)(ws + WS_V), (bf16_t*)(ws + WS_Z), (const PG8_LAS float*)ropeL, (const PG8_LAS float*)ropeL + 1024};
            GEMM_PHASE_EpiAttnIn(pg8::EpiAttnIn, Hb, ws + WS_WDAIN + (size_t)j * 8 * MiB, TT, 4096, 1024, E);
#ifdef PROBE_GIN2
            GEMM_PHASE_EpiAttnIn(pg8::EpiAttnIn, Hb, ws + WS_WDAIN + (size_t)j * 8 * MiB, TT, 4096, 1024, E);
#endif
            GRID_SYNC();
            float lam;
            { const int lane = opaque_tid() & 63; const float* lq = p.in[9] + j * 128; const float* lk = p.in[10] + j * 128;
              const float s0 = wave_sum(lq[lane] * lk[lane]), s1 = wave_sum(lq[64 + lane] * lk[64 + lane]);
              const float li = 0.8f - 0.6f * expf(-0.3f * (float)layer); lam = expf(s0) - expf(s1) + li;
              att::Args A{(const bf16_t*)(ws + WS_Q), (const bf16_t*)(ws + WS_K), (const bf16_t*)(ws + WS_V), (const bf16_t*)(ws + WS_Z), Hb, p.in[11] + j * 128, lam, 1.f - li, layer == 3 ? 1024 : 1088, (unsigned*)(ws + WS_Y1) + (size_t)bid * 8 * 2048};
#ifndef SKIP_ATT
              att::attn_phase(A, lds, G, bid);
#endif
#ifdef PROBE_ATT2
              att::attn_phase(A, lds, G, bid);
#endif
            }
            GRID_SYNC();
            Wout = (const bf16_t*)(ws + WS_WDAOUT + (size_t)j * 2 * MiB);
        } else if constexpr (layer == 1) {
            { pg8::EpiFnT E{(bf16_t*)(ws + WS_ATL), (bf16_t*)(ws + WS_ATC)};
              GEMM_PHASE_EpiFnT(pg8::EpiFnT, ws + WS_WFNT, Hb, 2048, TT, 1024, E); }
            { pg8::EpiPlain E{(bf16_t*)(ws + WS_ZB), 1024};
              GEMM_PHASE_EpiPlain(pg8::EpiPlain, Hb, ws + WS_WFNZ, TL, 1024, 1024, E); }
            GRID_SYNC();
            if (G > 64) {
                if (bid < 32) { { const int G = 32;
                    pg8::EpiPlain E{(bf16_t*)(ws + WS_ZB) + (size_t)TL * 1024, 1024};
                    GEMM_PHASE_EpiPlain(pg8::EpiPlain, Hb + (size_t)TL * 1024, ws + WS_WFNZ, TCX, 1024, 1024, E); } }
                else fnet_fold((const bf16_t*)(ws + WS_ATL), (bf16_t*)(ws + WS_FOLD), (bf16_t*)(ws + WS_FOLD + 32 * MiB), (float*)(ws + WS_BZ), (const bf16_t*)(ws + WS_ZB), Hb, G - 32, bid - 32);
            } else {
                { pg8::EpiPlain E{(bf16_t*)(ws + WS_ZB) + (size_t)TL * 1024, 1024};
                  GEMM_PHASE_EpiPlain(pg8::EpiPlain, Hb + (size_t)TL * 1024, ws + WS_WFNZ, TCX, 1024, 1024, E); }
                fnet_fold((const bf16_t*)(ws + WS_ATL), (bf16_t*)(ws + WS_FOLD), (bf16_t*)(ws + WS_FOLD + 32 * MiB), (float*)(ws + WS_BZ), (const bf16_t*)(ws + WS_ZB), Hb, G, bid);
            }
            GRID_SYNC();
            { pg8::EpiPlain E{(bf16_t*)(ws + WS_ATL), 8192};
              GEMM_PHASE_EpiPlain(pg8::EpiPlain, ws + WS_DFTL, ws + WS_FOLD, 2048, 8192, 2048, E); }
            GRID_SYNC();
            { pg8::EpiDftSym E{(const bf16_t*)(ws + WS_ATL), (const float*)(ws + WS_BZ), (const bf16_t*)(ws + WS_ZB), Hb};
              GEMM_PHASE(pg8::EpiDftSym, ws + WS_DFTL + 8 * MiB, ws + WS_FOLD + 32 * MiB, 2048, 8192, 2048, E); }
            { pg8::EpiDft E{(const bf16_t*)(ws + WS_ZB), Hb, TL, 256};
              GEMM_PHASE_EpiDft(pg8::EpiDft, ws + WS_DFTC, ws + WS_ATC, 256, 8192, 512, E); }
            GRID_SYNC();
            Wout = (const bf16_t*)(ws + WS_WFNOUT);
        } else {
            { pg8::EpiPlain E{(bf16_t*)(ws + WS_P), RWN};
              GEMM_PHASE_EpiPlain(pg8::EpiPlain, Hb, ws + WS_WRWIN, TT, RWN, 1024, E); }
            GRID_SYNC();
            RwArgs A{(const bf16_t*)(ws + WS_P), Hb, (bf16_t*)(ws + WS_Y1), (float*)(ws + WS_BZ), p.in[17], p.in[18], p.in[19], p.in[20], p.in[21], p.in[22], p.in[23], p.in[24]};
#ifndef SKIP_SCAN
            rwkv_scan(A, lds, G, bid);
#endif
#ifdef PROBE_SCAN2
            rwkv_scan(A, lds, G, bid);
#endif
            GRID_SYNC();
#ifndef SKIP_RWOUT
            rwkv_out(A, p.in[25], p.in[26], Hb, G, bid);
#endif
            GRID_SYNC();
            Wout = (const bf16_t*)(ws + WS_WRWOUT);
        }
        if constexpr (layer == 3) {
            pg8::EpiResid E{xl, xc, p.out, XC, modl + 2048, 0};
            GEMM_PHASE_EpiResid(pg8::EpiResid, Hb, Wout, TL, 1024, 1024, E);
            GRID_SYNC();
        } else {
            { pg8::EpiResid E{xl, xc, p.out, XC, modl + 2048, 0};
              GEMM_PHASE_EpiResid(pg8::EpiResid, Hb, Wout, TL, 1024, 1024, E); }
            GRID_SYNC();
            const float* gain_n = p.in[4] + (layer + 1) * 1024; const float* mod_n = mod + (size_t)(layer + 1) * 9 * 3072;
            const int nctx = 32;
            if (G > 2 * nctx) {
                if (bid < nctx) { const int G_real = G; { const int G = nctx; (void)G_real;
                    pg8::EpiResid E{xl, xc, p.out, XC, modl + 2048, TL};
                    GEMM_PHASE_EpiResid(pg8::EpiResid, Hb + (size_t)TL * 1024, Wout, TCX, 1024, 1024, E); } }
                else ph_phase(p.out, XC, gain_n, mod_n, Hb, G - nctx, bid - nctx, 0, TL);
                GRID_SYNC();
                ph_phase(p.out, XC, gain_n, mod_n, Hb, G, bid, TL, TT);
            } else {
                { pg8::EpiResid E{xl, xc, p.out, XC, modl + 2048, TL};
                  GEMM_PHASE_EpiResid(pg8::EpiResid, Hb + (size_t)TL * 1024, Wout, TCX, 1024, 1024, E); }
                GRID_SYNC();
                ph_phase(p.out, XC, gain_n, mod_n, Hb, G, bid);
            }
            GRID_SYNC();
        }
    }
__global__ void __launch_bounds__(512, 2) fwd_megakernel(Params p) {
    extern __shared__ __attribute__((aligned(16))) unsigned char lds_raw[];
    LAS char* lds = (LAS char*)lds_raw;
    cg::grid_group grid = cg::this_grid();
    const int G = gridDim.x, bid = blockIdx.x;
    volatile LAS unsigned* xst = (volatile LAS unsigned*)(lds + LDS_BYTES - 256);
    if (threadIdx.x < 2) xst[threadIdx.x] = 0u;
    __syncthreads();
    const XcdBarrier xbar = xcd_barrier_post((unsigned*)(p.ws + WS_CTL), xst);

#ifndef SKIP_PRO
    prologue(p, lds, G, bid);
#endif
#ifdef PROBE_PRO2
    __syncthreads(); prologue(p, lds, G, bid);
#endif
    grid.sync();
    layer_body<0>(p, lds, xbar, G, bid);
    layer_body<1>(p, lds, xbar, G, bid);
    layer_body<2>(p, lds, xbar, G, bid);
    layer_body<3>(p, lds, xbar, G, bid);
    final_phase(p.out, p.in[7], G, bid);
}

extern "C" void kernel_launch(void* const* d_in, const int* in_sizes, int n_in, void* d_out, int out_size, void* d_ws, size_t ws_size, hipStream_t stream) {
    static int grid = 0;
    if (grid == 0) {
        if (n_in != 28 || out_size != TL * 1024 || ws_size < WS_END) { fprintf(stderr, "kernel_launch: unexpected shapes: n_in %d out %d ws %zu\n", n_in, out_size, ws_size); grid = -1; return; }
        int dev = 0, cus = 0, per_cu = 0;
        hipGetDevice(&dev); hipDeviceGetAttribute(&cus, hipDeviceAttributeMultiprocessorCount, dev);
        if (hipFuncSetAttribute((const void*)fwd_megakernel, hipFuncAttributeMaxDynamicSharedMemorySize, LDS_BYTES) != hipSuccess) { fprintf(stderr, "kernel_launch: hipFuncSetAttribute failed\n"); grid = -1; return; }
        if (hipOccupancyMaxActiveBlocksPerMultiprocessor(&per_cu, (const void*)fwd_megakernel, 512, LDS_BYTES) != hipSuccess || per_cu < 1) { fprintf(stderr, "kernel_launch: occupancy query failed (%d)\n", per_cu); per_cu = 1; }
        (void)hipGetLastError();
        grid = cus * per_cu;
    }
    if (grid < 0) return;
    if (hipMemsetAsync((char*)d_ws + WS_CTL, 0, 65536, stream) != hipSuccess) { fprintf(stderr, "kernel_launch: hipMemsetAsync failed\n"); return; }
    Params p{};
    for (int i = 0; i < 28; ++i) p.in[i] = (const float*)d_in[i];
    p.out = (float*)d_out; p.ws = (unsigned char*)d_ws;
    void* args[] = {&p};
    hipError_t e = hipLaunchCooperativeKernel((const void*)fwd_megakernel, dim3(grid), dim3(512), args, LDS_BYTES, stream);
    if (e != hipSuccess) fprintf(stderr, "cooperative launch failed: %s (grid %d)\n", hipGetErrorString(e), grid);
}
```
